# Optimizing an MI355X kernel written in HIP

```python
import math
import numpy as np
import jax
import jax.numpy as jnp
from jax import lax

D_MODEL = 1024
BATCH = 4
SEQ = 4096
DEPTH = 1
DEC_BATCH = 128
DEC_SEQ = 4
PAST_LEN = 2048
PAGE_SIZE = 128

HEAD_DIM = 64
NSA_HEADS = D_MODEL // 128
NSA_KV_HEADS = 2
DSA_HEADS = D_MODEL // 128
DSA_KV_HEADS = 2
N_NSA_KV = 6
CMP_BLOCK = 32
CMP_STRIDE = 16
CMP_HIDDEN = 2 * HEAD_DIM
SEL_BLOCK = 64
N_SEL = 16
WINDOW = 512
IDX_HEADS = 4
IDX_DIM = 64
DSA_TOPK_MAX = 256
ROPE_THETA = 10000.0
Q_BLOCK = 128
EPS = 1e-6
NEG = -1e30
FORCED_SCORE = 1e4

IN_WIDTHS = (
    NSA_HEADS * HEAD_DIM,
    N_NSA_KV * NSA_KV_HEADS * HEAD_DIM,
    NSA_HEADS * 3,
    NSA_HEADS * HEAD_DIM,
    DSA_HEADS * HEAD_DIM,
    2 * DSA_KV_HEADS * HEAD_DIM,
    IDX_HEADS * IDX_DIM,
    IDX_DIM,
    IDX_HEADS,
    DSA_HEADS * HEAD_DIM,
    2 * D_MODEL,
)
IN_TOTAL = sum(IN_WIDTHS)

kernel_name = 'nsa_dsa_gated_hybrid_step'


def rms_norm(x, g):
    xf = x.astype(jnp.float32)
    y = xf * lax.rsqrt(jnp.mean(xf * xf, axis=-1, keepdims=True) + EPS)
    return (y * g.astype(jnp.float32)).astype(x.dtype)


def rope(x, pos):
    half = x.shape[-1] // 2
    inv = ROPE_THETA ** (-jnp.arange(half, dtype=jnp.float32) / half)
    ang = pos.astype(jnp.float32)[:, None] * inv[None, :]
    cos = jnp.cos(ang)[:, None, :]
    sin = jnp.sin(ang)[:, None, :]
    xf = x.astype(jnp.float32)
    x1, x2 = xf[..., :half], xf[..., half:]
    return jnp.concatenate([x1 * cos - x2 * sin, x2 * cos + x1 * sin], axis=-1).astype(x.dtype)


def masked_softmax(s, mask):
    s = jnp.where(mask, s, NEG)
    p = jnp.where(mask, jnp.exp(s - jnp.max(s, axis=-1, keepdims=True)), 0.0)
    return p / jnp.maximum(jnp.sum(p, axis=-1, keepdims=True), 1e-30)


def ada_norm(x, c, norm_g, w_ada, b_ada):
    mod = jax.nn.silu(c) @ w_ada + b_ada
    shift, scale, gate = jnp.split(mod, 3, axis=-1)
    h = rms_norm(x, norm_g) * (1.0 + scale[:, None, :]) + shift[:, None, :]
    return h, gate


def in_projection(h, w_in, pos):
    Bx, T, _ = h.shape
    cuts = [int(v) for v in np.cumsum(IN_WIDTHS)[:-1]]
    nq, nkv, ng, nz, dq, dkv, iq, ik, iw, dz, mg = jnp.split(h @ w_in, cuts, axis=-1)
    nsa_q = nq.reshape(Bx, T, NSA_HEADS, HEAD_DIM)
    nkv = nkv.reshape(Bx, T, N_NSA_KV, NSA_KV_HEADS, HEAD_DIM)
    nsa_rows = jnp.stack([nkv[:, :, 0], nkv[:, :, 1], rope(nkv[:, :, 2], pos), nkv[:, :, 3]], axis=2)
    win_rows = jnp.stack([rope(nkv[:, :, 4], pos), nkv[:, :, 5]], axis=2)
    dkv = dkv.reshape(Bx, T, 2, DSA_KV_HEADS, HEAD_DIM)
    dsa_rows = jnp.stack([rope(dkv[:, :, 0], pos), dkv[:, :, 1]], axis=2)
    idx_rows = rope(ik[:, :, None, :], pos)[:, :, 0]
    f = {
        'nsa_q': nsa_q,
        'nsa_q_rot': rope(nsa_q, pos),
        'nsa_gate': jax.nn.sigmoid(ng.astype(jnp.float32)).reshape(Bx, T, NSA_HEADS, 3),
        'nsa_z': nz,
        'dsa_q': rope(dq.reshape(Bx, T, DSA_HEADS, HEAD_DIM), pos),
        'idx_q': rope(iq.reshape(Bx, T, IDX_HEADS, IDX_DIM), pos),
        'idx_w': iw,
        'dsa_z': dz,
        'merge': mg,
    }
    return f, nsa_rows, win_rows, dsa_rows, idx_rows


def nsa_context(nsa_all, cmp_pe, cmp_w1, cmp_w2):
    Bx, L = nsa_all.shape[:2]
    G = NSA_KV_HEADS
    n_cmp = (L - CMP_BLOCK) // CMP_STRIDE + 1
    starts = np.arange(n_cmp, dtype=np.int32) * CMP_STRIDE
    blk_idx = starts[:, None] + np.arange(CMP_BLOCK, dtype=np.int32)[None, :]

    def compress(rows, pe, w1, w2):
        blk = rows[:, blk_idx] + pe[None, None, :, None, :]
        flat = jnp.swapaxes(blk, 2, 3).reshape(Bx, n_cmp, G, CMP_BLOCK * HEAD_DIM)
        return jax.nn.silu(flat @ w1) @ w2

    ck = compress(nsa_all[:, :, 0], cmp_pe[0], cmp_w1[0], cmp_w2[0])
    cv = compress(nsa_all[:, :, 1], cmp_pe[1], cmp_w1[1], cmp_w2[1])
    cmp_end = jnp.asarray(starts + CMP_BLOCK - 1)
    n_slc = -(-L // SEL_BLOCK)
    j = np.arange(n_slc, dtype=np.int32)[None, :]
    overlap = (starts[:, None] < (j + 1) * SEL_BLOCK) & (starts[:, None] + CMP_BLOCK > j * SEL_BLOCK)
    overlap = jnp.asarray(overlap, dtype=jnp.float32)
    pad = n_slc * SEL_BLOCK - L
    slc = jnp.pad(nsa_all[:, :, 2:4], ((0, 0), (0, pad), (0, 0), (0, 0), (0, 0)))
    slc = slc.reshape(Bx, n_slc, SEL_BLOCK, 2, G, HEAD_DIM).transpose(3, 0, 4, 1, 2, 5)
    return (ck, cv, cmp_end, overlap, slc[0], slc[1], min(N_SEL, n_slc))


def nsa_attend(q, q_rot, gate, qpos, ctx, win_k, win_v, win_pos):
    ck, cv, cmp_end, overlap, slc_kb, slc_vb, n_sel = ctx
    Bx, Tq = q.shape[:2]
    G, Hg = NSA_KV_HEADS, NSA_HEADS // NSA_KV_HEADS
    scale = HEAD_DIM ** -0.5
    qg = q.reshape(Bx, Tq, G, Hg, HEAD_DIM)
    qr = q_rot.reshape(Bx, Tq, G, Hg, HEAD_DIM)
    s = jnp.einsum('btghd,bngd->btghn', qg, ck).astype(jnp.float32) * scale
    vis = (cmp_end[None, :] <= qpos[:, None])[None, :, None, None, :]
    p_cmp = masked_softmax(s, vis)
    o_cmp = jnp.einsum('btghn,bngd->btghd', p_cmp.astype(cv.dtype), cv)
    imp = jnp.einsum('btgn,nj->btgj', jnp.sum(p_cmp, axis=3), overlap)
    n_slc = slc_kb.shape[2]
    jb = jnp.arange(n_slc, dtype=jnp.int32)[None, :]
    cur = (qpos // SEL_BLOCK)[:, None]
    forced = (jb == 0) | (jb == cur) | (jb == cur - 1)
    imp = jnp.where(forced[None, :, None, :], FORCED_SCORE, imp)
    imp = jnp.where((jb > cur)[None, :, None, :], NEG, imp)
    top_val, top_idx = lax.top_k(imp, n_sel)
    blk_ok = top_val > 0.5 * NEG
    bi = jnp.arange(Bx)[:, None, None, None]
    gi = jnp.arange(G)[None, None, :, None]
    sk = slc_kb[bi, gi, top_idx].reshape(Bx, Tq, G, n_sel * SEL_BLOCK, HEAD_DIM)
    sv = slc_vb[bi, gi, top_idx].reshape(Bx, Tq, G, n_sel * SEL_BLOCK, HEAD_DIM)
    kpos = top_idx[..., None] * SEL_BLOCK + jnp.arange(SEL_BLOCK, dtype=jnp.int32)
    ok = (blk_ok[..., None] & (kpos <= qpos[None, :, None, None, None])).reshape(Bx, Tq, G, 1, n_sel * SEL_BLOCK)
    s = jnp.einsum('btghd,btgmd->btghm', qr, sk).astype(jnp.float32) * scale
    o_slc = jnp.einsum('btghm,btgmd->btghd', masked_softmax(s, ok).astype(sv.dtype), sv)
    s = jnp.einsum('btghd,bwgd->btghw', qr, win_k).astype(jnp.float32) * scale
    dist = qpos[:, None] - win_pos[None, :]
    wok = ((dist >= 0) & (dist < WINDOW) & (win_pos[None, :] >= 0))[None, :, None, None, :]
    o_win = jnp.einsum('btghw,bwgd->btghd', masked_softmax(s, wok).astype(win_v.dtype), win_v)
    g = gate.reshape(Bx, Tq, G, Hg, 3)
    o = g[..., 0:1] * o_cmp + g[..., 1:2] * o_slc + g[..., 2:3] * o_win
    return o.reshape(Bx, Tq, NSA_HEADS * HEAD_DIM).astype(q.dtype)


def dsa_attend(q, idx_q, idx_w, qpos, k, v, idx_k, topk):
    Bx, Tq = q.shape[:2]
    L = k.shape[1]
    G, Hg = DSA_KV_HEADS, DSA_HEADS // DSA_KV_HEADS
    causal = jnp.arange(L, dtype=jnp.int32)[None, :] <= qpos[:, None]
    dots = jnp.einsum('bthd,bsd->bths', idx_q, idx_k).astype(jnp.float32) * (IDX_DIM ** -0.5)
    score = jnp.einsum('bths,bth->bts', jax.nn.relu(dots), idx_w.astype(jnp.float32)) * (IDX_HEADS ** -0.5)
    score = jnp.where(causal[None], score, NEG)
    _, sel = lax.top_k(score, topk)
    bi = jnp.arange(Bx)[:, None, None]
    sk = k[bi, sel]
    sv = v[bi, sel]
    ok = (sel <= qpos[None, :, None])[:, :, None, None, :]
    qg = q.reshape(Bx, Tq, G, Hg, HEAD_DIM)
    s = jnp.einsum('btghd,btkgd->btghk', qg, sk).astype(jnp.float32) * (HEAD_DIM ** -0.5)
    o = jnp.einsum('btghk,btkgd->btghd', masked_softmax(s, ok).astype(sv.dtype), sv)
    return o.reshape(Bx, Tq, DSA_HEADS * HEAD_DIM)


def mixer_out(x, gate_ada, f, o_n, o_d, w_up_nsa, w_up_dsa, w_out):
    u_n = (o_n * jax.nn.silu(f['nsa_z'])) @ w_up_nsa
    u_d = (o_d * jax.nn.silu(f['dsa_z'])) @ w_up_dsa
    g_n, g_d = jnp.split(jax.nn.sigmoid(f['merge']), 2, axis=-1)
    return x + gate_ada[:, None, :] * ((g_n * u_n + g_d * u_d) @ w_out)


def gather_pages(pool, page_table):
    g = pool[page_table]
    return g.reshape((page_table.shape[0], -1) + pool.shape[2:])


def prompt_layer(x, c, norm_g, w_ada, b_ada, w_in, cmp_pe, cmp_w1, cmp_w2, w_up_nsa, w_up_dsa, w_out):
    Bx, T, _ = x.shape
    pos = jnp.arange(T, dtype=jnp.int32)
    h, gate_ada = ada_norm(x, c, norm_g, w_ada, b_ada)
    f, nsa_rows, win_rows, dsa_rows, idx_rows = in_projection(h, w_in, pos)
    ctx = nsa_context(nsa_rows, cmp_pe, cmp_w1, cmp_w2)
    topk = min(DSA_TOPK_MAX, T // 4)
    win_pad = jnp.pad(win_rows, ((0, 0), (WINDOW, 0), (0, 0), (0, 0), (0, 0)))
    dsa_k, dsa_v = dsa_rows[:, :, 0], dsa_rows[:, :, 1]

    def block(i):
        qs = i * Q_BLOCK
        sl = lambda a: lax.dynamic_slice_in_dim(a, qs, Q_BLOCK, axis=1)
        qpos = qs + jnp.arange(Q_BLOCK, dtype=jnp.int32)
        wkv = lax.dynamic_slice_in_dim(win_pad, qs, WINDOW + Q_BLOCK, axis=1)
        wpos = qs - WINDOW + jnp.arange(WINDOW + Q_BLOCK, dtype=jnp.int32)
        o_n = nsa_attend(sl(f['nsa_q']), sl(f['nsa_q_rot']), sl(f['nsa_gate']), qpos, ctx,
                         wkv[:, :, 0], wkv[:, :, 1], wpos)
        o_d = dsa_attend(sl(f['dsa_q']), sl(f['idx_q']), sl(f['idx_w']), qpos, dsa_k, dsa_v, idx_rows, topk)
        return o_n, o_d

    o_n, o_d = lax.map(block, jnp.arange(T // Q_BLOCK, dtype=jnp.int32))
    o_n = jnp.swapaxes(o_n, 0, 1).reshape(Bx, T, NSA_HEADS * HEAD_DIM)
    o_d = jnp.swapaxes(o_d, 0, 1).reshape(Bx, T, DSA_HEADS * HEAD_DIM)
    y = mixer_out(x, gate_ada, f, o_n, o_d, w_up_nsa, w_up_dsa, w_out)
    return y, nsa_rows, dsa_rows, idx_rows, win_rows[:, T - min(WINDOW, T):]


def sample_layer(x, c, cache_nsa, cache_dsa, cache_idx, win_state, page_table,
                 norm_g, w_ada, b_ada, w_in, cmp_pe, cmp_w1, cmp_w2, w_up_nsa, w_up_dsa, w_out):
    Bx, T, _ = x.shape
    past = page_table.shape[1] * cache_nsa.shape[1]
    pos = past + jnp.arange(T, dtype=jnp.int32)
    h, gate_ada = ada_norm(x, c, norm_g, w_ada, b_ada)
    f, nsa_rows, win_rows, dsa_rows, idx_rows = in_projection(h, w_in, pos)
    nsa_all = jnp.concatenate([gather_pages(cache_nsa, page_table), nsa_rows], axis=1)
    dsa_all = jnp.concatenate([gather_pages(cache_dsa, page_table), dsa_rows], axis=1)
    idx_all = jnp.concatenate([gather_pages(cache_idx, page_table), idx_rows], axis=1)
    win_all = jnp.concatenate([win_state, win_rows], axis=1)
    wb = win_state.shape[1]
    wpos = past - wb + jnp.arange(wb + T, dtype=jnp.int32)
    ctx = nsa_context(nsa_all, cmp_pe, cmp_w1, cmp_w2)
    topk = min(DSA_TOPK_MAX, (past + T) // 4)
    o_n = nsa_attend(f['nsa_q'], f['nsa_q_rot'], f['nsa_gate'], pos, ctx, win_all[:, :, 0], win_all[:, :, 1], wpos)
    o_d = dsa_attend(f['dsa_q'], f['idx_q'], f['idx_w'], pos, dsa_all[:, :, 0], dsa_all[:, :, 1], idx_all, topk)
    y = mixer_out(x, gate_ada, f, o_n, o_d, w_up_nsa, w_up_dsa, w_out)
    return y, nsa_rows, dsa_rows, idx_rows, win_all[:, T:]


def setup_inputs(seed: int = 0) -> dict:
    key = jax.random.key(seed)
    ks = jax.random.split(key, 20)
    f32 = jnp.float32
    n_pages = PAST_LEN // PAGE_SIZE
    n_used = DEC_BATCH * n_pages
    n_pool = n_used + (n_used + 3) // 4
    wb = min(WINDOW, PAST_LEN)
    width = NSA_HEADS * HEAD_DIM

    def nrm(k, shape, s=1.0):
        return jax.random.normal(k, shape, f32) * s

    page_table = jax.random.permutation(ks[0], n_pool)[:n_used].reshape(DEC_BATCH, n_pages).astype(jnp.int32)
    return {
        'x_prompt': nrm(ks[1], (BATCH, SEQ, D_MODEL)),
        'x_sample': nrm(ks[2], (DEC_BATCH, DEC_SEQ, D_MODEL)),
        'cache_nsa_kv': nrm(ks[3], (DEPTH, n_pool, PAGE_SIZE, 4, NSA_KV_HEADS, HEAD_DIM)),
        'cache_dsa_kv': nrm(ks[4], (DEPTH, n_pool, PAGE_SIZE, 2, DSA_KV_HEADS, HEAD_DIM)),
        'cache_dsa_idx_k': nrm(ks[5], (DEPTH, n_pool, PAGE_SIZE, IDX_DIM)),
        'state_nsa_win_kv': nrm(ks[6], (DEPTH, DEC_BATCH, wb, 2, NSA_KV_HEADS, HEAD_DIM)),
        'page_table': page_table,
        'c_prompt': nrm(ks[7], (BATCH, D_MODEL)),
        'c_sample': nrm(ks[8], (DEC_BATCH, D_MODEL)),
        'norm_g': 1.0 + nrm(ks[9], (DEPTH, D_MODEL), 0.02),
        'w_ada': nrm(ks[10], (DEPTH, D_MODEL, 3 * D_MODEL), 0.5 * D_MODEL ** -0.5),
        'b_ada': nrm(ks[11], (DEPTH, 3 * D_MODEL), 0.01),
        'w_in': nrm(ks[12], (DEPTH, D_MODEL, IN_TOTAL), D_MODEL ** -0.5),
        'cmp_pe': nrm(ks[13], (DEPTH, 2, CMP_BLOCK, HEAD_DIM), 0.1),
        'cmp_w1': nrm(ks[14], (DEPTH, 2, CMP_BLOCK * HEAD_DIM, CMP_HIDDEN), (CMP_BLOCK * HEAD_DIM) ** -0.5),
        'cmp_w2': nrm(ks[15], (DEPTH, 2, CMP_HIDDEN, HEAD_DIM), CMP_HIDDEN ** -0.5),
        'w_up_nsa': nrm(ks[16], (DEPTH, width, D_MODEL), width ** -0.5),
        'w_up_dsa': nrm(ks[17], (DEPTH, DSA_HEADS * HEAD_DIM, D_MODEL), (DSA_HEADS * HEAD_DIM) ** -0.5),
        'w_out': nrm(ks[18], (DEPTH, D_MODEL, D_MODEL), D_MODEL ** -0.5),
        'final_g': 1.0 + nrm(ks[19], (D_MODEL,), 0.02),
    }


def reference(x_prompt, x_sample, cache_nsa_kv, cache_dsa_kv, cache_dsa_idx_k, state_nsa_win_kv, page_table,
              c_prompt, c_sample, norm_g, w_ada, b_ada, w_in, cmp_pe, cmp_w1, cmp_w2,
              w_up_nsa, w_up_dsa, w_out, final_g):
    yp, ys = x_prompt, x_sample
    l_pn, l_pd, l_pi, l_pw, l_sn, l_sd, l_si, l_sw = [], [], [], [], [], [], [], []
    for l in range(DEPTH):
        w = (norm_g[l], w_ada[l], b_ada[l], w_in[l], cmp_pe[l], cmp_w1[l], cmp_w2[l],
             w_up_nsa[l], w_up_dsa[l], w_out[l])
        yp, pn, pd, pi, pw = prompt_layer(yp, c_prompt, *w)
        ys, sn, sd, si, sw = sample_layer(ys, c_sample, cache_nsa_kv[l], cache_dsa_kv[l], cache_dsa_idx_k[l],
                                          state_nsa_win_kv[l], page_table, *w)
        l_pn.append(pn); l_pd.append(pd); l_pi.append(pi); l_pw.append(pw)
        l_sn.append(sn); l_sd.append(sd); l_si.append(si); l_sw.append(sw)
    y_prompt = rms_norm(yp, final_g)
    y_sample = rms_norm(ys, final_g)
    new_nsa_kv_prompt = jnp.stack(l_pn, axis=0)
    new_dsa_kv_prompt = jnp.stack(l_pd, axis=0)
    new_idx_k_prompt = jnp.stack(l_pi, axis=0)
    new_win_prompt = jnp.stack(l_pw, axis=0)
    new_nsa_kv_sample = jnp.stack(l_sn, axis=0)
    new_dsa_kv_sample = jnp.stack(l_sd, axis=0)
    new_idx_k_sample = jnp.stack(l_si, axis=0)
    new_win_sample = jnp.stack(l_sw, axis=0)
    return (y_prompt, y_sample, new_nsa_kv_prompt, new_dsa_kv_prompt, new_idx_k_prompt, new_win_prompt,
            new_nsa_kv_sample, new_dsa_kv_sample, new_idx_k_sample, new_win_sample)
```

```cpp
#define MK_N_LAUNCHES 1
#include <hip/hip_runtime.h>
#include <cstdio>
#include <cstdint>
#ifndef MK_N_LAUNCHES
#define MK_N_LAUNCHES 1
#endif
namespace pg8 {
#define PG8_LAS __attribute__((address_space(3)))
typedef unsigned short bf16_t;
typedef short bf16x8 __attribute__((ext_vector_type(8)));
typedef float f32x4 __attribute__((ext_vector_type(4)));
typedef unsigned u32x4 __attribute__((ext_vector_type(4)));
constexpr int BM = 256, BK = 64, HALF = 128, HTB = HALF * BK * 2  , STAGE_BYTES = 8 * HTB, NXCD = 8, WGM = 8;

__host__ __device__ __forceinline__ int lds_byte(int r, int c) { const int st = (r >> 4) * 2 + (c >> 5), rr = r & 15, cc = c & 31, ob = rr * 64 + cc * 2; return st * 1024 + (ob ^ (((ob >> 9) & 1) << 5)); }
__host__ __device__ __forceinline__ void stage_rc(int b, int& R, int& C) { const int st = b / 1024, sb = b % 1024, swz = sb ^ (((sb >> 9) & 1) << 5); R = (st >> 1) * 16 + swz / 64; C = (st & 1) * 32 + (swz % 64) / 2; }
__host__ __device__ __forceinline__ int perm32(int rho) { const int n = rho >> 4, i = rho & 15; return 8 * (i >> 2) + 4 * n + (i & 3); }

struct Unit { int pm, pn; };
struct Gemm { const bf16_t* A; const bf16_t* Bt; int M, N, K; };

struct StaticOrder {
    int nM, nN, nwg, G, c;
    __host__ __device__ void init(int M, int N, int G_, int c_) { nM = M / BM; nN = N / BM; nwg = nM * nN; G = G_; c = c_; }
    __host__ __device__ bool next(int i, Unit& u) const {
        const long L = (long)i * G + c; if (L >= nwg) return false;
        int wgid = (int)L; { const int q = nwg / NXCD, r = nwg % NXCD, xcd = wgid % NXCD, off = wgid / NXCD; wgid = (xcd < r ? xcd * (q + 1) : r * (q + 1) + (xcd - r) * q) + off; }
        const int nig = WGM * nN, gid = wgid / nig, fm = gid * WGM, gsz = (nM - fm) < WGM ? (nM - fm) : WGM;
        u.pm = fm + ((wgid % nig) % gsz); u.pn = (wgid % nig) / gsz; return true;
    }
    __device__ __forceinline__ void a_ready(const Unit&) const {}
    __device__ __forceinline__ void done(const Unit&) const {}
};

typedef float f32x2p __attribute__((ext_vector_type(2))); typedef __bf16 bf16x2p __attribute__((ext_vector_type(2)));
__device__ __forceinline__ unsigned cvt_pk_bf16(float lo, float hi) { f32x2p v = {lo, hi}; bf16x2p b = __builtin_convertvector(v, bf16x2p); return __builtin_bit_cast(unsigned, b); }
template <class Epi, class Sched, bool ALIGN_EPI = false, bool SP2 = false>
__device__ __forceinline__ void gemm_phase(PG8_LAS unsigned char* lds, const Gemm g, const Sched& S, const Epi& E) {
    const int tid = threadIdx.x, wid = __builtin_amdgcn_readfirstlane(tid >> 6), lane = tid & 63, wr = wid >> 2, wc = wid & 3, fr = lane & 15, fq = lane >> 4;
    const int K = g.K, nt = K / BK;
    unsigned voffA[2], voffB[2];
#pragma unroll
    for (int i = 0; i < 2; ++i) { int R, C; stage_rc(tid * 16 + i * 8192, R, C); const int Rb = Epi::PERM ? ((R & ~31) + perm32(R & 31)) : R;
        voffA[i] = (unsigned)(R * K + C) * 2u; voffB[i] = (unsigned)(Rb * K + C) * 2u; }
    const size_t kstep = (size_t)(BK * 2);
    const size_t hstep = (size_t)HALF * K * 2;
    const size_t tstep = 2 * hstep;
    const unsigned ldsw = (unsigned)wid * 1024u;
    const int aoff = lds_byte(wr * 64 + fr, fq * 8), boff = lds_byte(wc * 32 + fr, fq * 8);
#define PG8_SA(b, h) (((b) * 2 + (h)) * HTB)
#define PG8_SB(b, h) ((4 + (b) * 2 + (h)) * HTB)
#define PG8_STAGE(bufoff, gbase, voff) do { _Pragma("unroll") for (int _i = 0; _i < 2; ++_i) \
        __builtin_amdgcn_global_load_lds((const unsigned*)((const char*)(gbase) + (voff)[_i]), (PG8_LAS unsigned*)(lds + (bufoff) + ldsw + _i * 8192), 16, 0, 0); } while (0)
#define PG8_LDA(dst, b, h) do { _Pragma("unroll") for (int m = 0; m < 4; ++m) _Pragma("unroll") for (int k = 0; k < 2; ++k) dst[m][k] = *(const PG8_LAS bf16x8*)(lds + PG8_SA(b, h) + aoff + m * 2048 + k * 1024); } while (0)
#define PG8_LDB(dst, b, h) do { _Pragma("unroll") for (int n = 0; n < 2; ++n) _Pragma("unroll") for (int k = 0; k < 2; ++k) dst[n][k] = *(const PG8_LAS bf16x8*)(lds + PG8_SB(b, h) + boff + n * 2048 + k * 1024); } while (0)
#define PG8_MMA(ai, bj, At, Bt) do { __builtin_amdgcn_s_setprio(1); _Pragma("unroll") for (int m = 0; m < 4; ++m) _Pragma("unroll") for (int n = 0; n < 2; ++n) _Pragma("unroll") for (int k = 0; k < 2; ++k) \
        acc[ai][bj][m][n] = __builtin_amdgcn_mfma_f32_16x16x32_bf16(Bt[n][k], At[m][k], acc[ai][bj][m][n], 0, 0, 0); __builtin_amdgcn_s_setprio(0); } while (0)
#define PG8_WAIT_V(n) asm volatile("s_waitcnt vmcnt(" #n ")" ::: "memory")
#define PG8_WAIT_L(n) asm volatile("s_waitcnt lgkmcnt(" #n ")" ::: "memory")
#define PG8_BAR __builtin_amdgcn_s_barrier()
#define PG8_SCHED __builtin_amdgcn_sched_barrier(0)
    Unit cur, nxt; int ui = 0;
    if (!S.next(0, cur)) return;
    f32x4 acc[2][2][4][2];
#pragma unroll
    for (int a = 0; a < 2; ++a)
#pragma unroll
        for (int b = 0; b < 2; ++b)
#pragma unroll
            for (int m = 0; m < 4; ++m)
#pragma unroll
                for (int n = 0; n < 2; ++n) acc[a][b][m][n] = (f32x4){0.f, 0.f, 0.f, 0.f};
    bf16x8 At[4][2], B0[2][2], B1[2][2];
    const char* cA = (const char*)g.A + (size_t)cur.pm * tstep; const char* cB = (const char*)g.Bt + (size_t)cur.pn * tstep;
    S.a_ready(cur);
    if constexpr (SP2) {
        PG8_STAGE(PG8_SB(0, 0), cB, voffB); PG8_STAGE(PG8_SB(0, 1), cB + hstep, voffB); PG8_STAGE(PG8_SA(0, 0), cA, voffA); PG8_STAGE(PG8_SA(0, 1), cA + hstep, voffA);
        if (wr == 1) PG8_BAR;
        PG8_WAIT_V(2); PG8_BAR;
        PG8_STAGE(PG8_SB(1, 0), cB + kstep, voffB); PG8_STAGE(PG8_SA(1, 0), cA + kstep, voffA); PG8_STAGE(PG8_SB(1, 1), cB + hstep + kstep, voffB);
        PG8_WAIT_V(6); PG8_BAR;
    } else {
        PG8_STAGE(PG8_SB(0, 0), cB, voffB); PG8_STAGE(PG8_SA(0, 0), cA, voffA); PG8_STAGE(PG8_SB(0, 1), cB + hstep, voffB); PG8_STAGE(PG8_SA(0, 1), cA + hstep, voffA);
        if (wr == 1) PG8_BAR;
        PG8_WAIT_V(4); PG8_BAR;
        PG8_STAGE(PG8_SB(1, 0), cB + kstep, voffB); PG8_STAGE(PG8_SA(1, 0), cA + kstep, voffA); PG8_STAGE(PG8_SB(1, 1), cB + hstep + kstep, voffB);
        PG8_WAIT_V(6); PG8_BAR;
    }
    for (;;) {
        const bool has_next = S.next(ui + 1, nxt);
        const char* nA = has_next ? (const char*)g.A + (size_t)nxt.pm * tstep : cA; const char* nB = has_next ? (const char*)g.Bt + (size_t)nxt.pn * tstep : cB;
        for (int t = 0; t < nt; t += 2) {
            const bool last = (t == nt - 2);
            const char* a1 = cA + (size_t)(t + 1) * kstep;
            const char* a2 = last ? nA : cA + (size_t)(t + 2) * kstep; const char* b2 = last ? nB : cB + (size_t)(t + 2) * kstep;
            const char* a3 = a2 + kstep; const char* b3 = b2 + kstep;
            if (last && has_next) S.a_ready(nxt);
            if constexpr (SP2) {
            PG8_LDB(B0, 0, 0); PG8_LDB(B1, 0, 1); PG8_SCHED; PG8_LDA(At, 0, 0); PG8_STAGE(PG8_SA(1, 1), a1 + hstep, voffA);
            PG8_WAIT_V(8); PG8_WAIT_L(0); PG8_BAR; PG8_MMA(0, 0, At, B0); PG8_MMA(0, 1, At, B1); PG8_BAR; PG8_SCHED;
            PG8_LDA(At, 0, 1); PG8_STAGE(PG8_SB(0, 0), b2, voffB); PG8_STAGE(PG8_SB(0, 1), b2 + hstep, voffB); PG8_STAGE(PG8_SA(0, 0), a2, voffA);
            PG8_WAIT_V(8); PG8_WAIT_L(0); PG8_BAR; PG8_MMA(1, 0, At, B0); PG8_MMA(1, 1, At, B1); PG8_BAR; PG8_SCHED;
            PG8_LDB(B0, 1, 0); PG8_LDB(B1, 1, 1); PG8_SCHED; PG8_LDA(At, 1, 0); PG8_STAGE(PG8_SA(0, 1), a2 + hstep, voffA);
            PG8_WAIT_V(8); PG8_WAIT_L(0); PG8_BAR; PG8_MMA(0, 0, At, B0); PG8_MMA(0, 1, At, B1); PG8_BAR; PG8_SCHED;
            PG8_LDA(At, 1, 1); PG8_STAGE(PG8_SB(1, 0), b3, voffB); PG8_STAGE(PG8_SB(1, 1), b3 + hstep, voffB); PG8_STAGE(PG8_SA(1, 0), a3, voffA);
            PG8_WAIT_V(8); PG8_WAIT_L(0); PG8_BAR; PG8_MMA(1, 0, At, B0); PG8_MMA(1, 1, At, B1); PG8_BAR; PG8_SCHED;
            } else {
            PG8_LDB(B0, 0, 0); PG8_SCHED; PG8_LDA(At, 0, 0); PG8_STAGE(PG8_SA(1, 1), a1 + hstep, voffA);
            PG8_WAIT_L(8); PG8_BAR; PG8_WAIT_L(0); PG8_MMA(0, 0, At, B0); PG8_BAR; PG8_SCHED;
            PG8_LDB(B1, 0, 1); PG8_STAGE(PG8_SB(0, 0), b2, voffB);
            PG8_BAR; PG8_WAIT_L(0); PG8_MMA(0, 1, At, B1); PG8_BAR;
            PG8_LDA(At, 0, 1); PG8_STAGE(PG8_SA(0, 0), a2, voffA);
            PG8_BAR; PG8_WAIT_L(0); PG8_MMA(1, 0, At, B0); PG8_BAR; PG8_SCHED;
            PG8_STAGE(PG8_SB(0, 1), b2 + hstep, voffB);
            PG8_WAIT_V(6); PG8_BAR; PG8_MMA(1, 1, At, B1); PG8_BAR;
            PG8_LDB(B0, 1, 0); PG8_SCHED; PG8_LDA(At, 1, 0); PG8_STAGE(PG8_SA(0, 1), a2 + hstep, voffA);
            PG8_WAIT_L(8); PG8_BAR; PG8_WAIT_L(0); PG8_MMA(0, 0, At, B0); PG8_BAR; PG8_SCHED;
            PG8_LDB(B1, 1, 1); PG8_STAGE(PG8_SB(1, 0), b3, voffB);
            PG8_BAR; PG8_WAIT_L(0); PG8_MMA(0, 1, At, B1); PG8_BAR;
            PG8_LDA(At, 1, 1); PG8_STAGE(PG8_SA(1, 0), a3, voffA);
            PG8_BAR; PG8_WAIT_L(0); PG8_MMA(1, 0, At, B0); PG8_BAR; PG8_SCHED;
            PG8_STAGE(PG8_SB(1, 1), b3 + hstep, voffB);
            PG8_WAIT_V(6); PG8_BAR; PG8_MMA(1, 1, At, B1); PG8_BAR;
            }
        }
        if constexpr (ALIGN_EPI) { if (wr == 0) PG8_BAR; }
        if constexpr (!Epi::AFTER_DRAIN) { E(acc, cur, wr, wc, fr, fq); S.done(cur); }
        if (!has_next) break;
#pragma unroll
        for (int a = 0; a < 2; ++a)
#pragma unroll
            for (int b = 0; b < 2; ++b)
#pragma unroll
                for (int m = 0; m < 4; ++m)
#pragma unroll
                    for (int n = 0; n < 2; ++n) acc[a][b][m][n] = (f32x4){0.f, 0.f, 0.f, 0.f};
        cur = nxt; cA = nA; cB = nB; ++ui;
        if constexpr (ALIGN_EPI) { if (wr == 1) PG8_BAR; }
    }
    PG8_WAIT_V(0);
    if constexpr (!ALIGN_EPI) { if (wr == 0) PG8_BAR; }
    PG8_BAR;
    if constexpr (Epi::AFTER_DRAIN) { E.fused(acc, cur, wr, wc, fr, fq, lds, wid, lane); S.done(cur); }
#undef PG8_SA
#undef PG8_SB
#undef PG8_STAGE
#undef PG8_LDA
#undef PG8_LDB
#undef PG8_MMA
#undef PG8_WAIT_V
#undef PG8_WAIT_L
#undef PG8_BAR
#undef PG8_SCHED
}
}

#define LAS __attribute__((address_space(3)))
typedef unsigned short bf16;
typedef short bf16x8 __attribute__((ext_vector_type(8)));
typedef float f32x4 __attribute__((ext_vector_type(4)));
typedef float f32x16 __attribute__((ext_vector_type(16)));
typedef unsigned u32x4 __attribute__((ext_vector_type(4)));
typedef unsigned u32x2 __attribute__((ext_vector_type(2)));

constexpr int DM = 1024, NBATCH = 4, SEQ = 4096, MP = NBATCH * SEQ, SBATCH = 128, STOK = 4, MS = SBATCH * STOK, MR = MP + MS;
constexpr int PASTL = 2048, PAGE = 128, NPG = 16;
constexpr int LS = 2112, LSW = 576;
constexpr int NPAD = 5632;
constexpr float C2 = 0.125f * 1.4426950408889634f;
constexpr int NWAVES = 8;

constexpr size_t O_YP = 0, O_YS = 16777216, O_NSAP = 17301504, O_DSAP = 25690112, O_IDXP = 29884416, O_WINP = 30932992,
                 O_NSAS = 31457280, O_DSAS = 31719424, O_IDXS = 31850496, O_WINS = 31883264, O_END = 48660480;

constexpr size_t MiB = 1u << 20;
constexpr size_t WS_CTL = 0, CTL_ZERO_BYTES = 1 * MiB;
constexpr size_t WS_MOD = 1 * MiB;
constexpr size_t WS_COS = 3 * MiB, WS_SIN = 4 * MiB;
constexpr size_t WS_BIAS1 = 5 * MiB;
constexpr size_t WS_W2T = 5 * MiB + 65536;
constexpr size_t WS_W1T = 6 * MiB;
constexpr size_t WS_WINT = 8 * MiB;
constexpr size_t WS_WUPN = 20 * MiB, WS_WUPD = 21 * MiB, WS_WOUT = 22 * MiB;
constexpr size_t WS_THR = 24 * MiB, WS_CUT = 24 * MiB + 131072;
constexpr size_t WS_GATES = 25 * MiB;
constexpr size_t WS_IW = 27 * MiB;
constexpr size_t WS_PCK = 28 * MiB, WS_PCVT = 28 * MiB + 262144;
constexpr size_t WS_SCK = 29 * MiB, WS_SCVT = 33 * MiB;
constexpr size_t WS_H = 40 * MiB;
constexpr size_t WS_QRAW = 80 * MiB, WS_QROT = 100 * MiB, WS_DQ = 120 * MiB, WS_IQ = 140 * MiB, WS_ZN = 150 * MiB, WS_ZD = 170 * MiB, WS_ONZ = 190 * MiB, WS_ODZ = 210 * MiB;
constexpr size_t WS_MG = 230 * MiB;
constexpr size_t WS_T1 = 300 * MiB;
constexpr size_t WS_M1 = 370 * MiB;
constexpr size_t WS_PCMPK = 410 * MiB, WS_PCMPV = 414 * MiB, WS_PSLCK = 418 * MiB, WS_PSLCVT = 422 * MiB, WS_PWINK = 426 * MiB, WS_PWINVT = 430 * MiB,
                 WS_PDSAK = 434 * MiB, WS_PDSAVT = 438 * MiB, WS_PIDXK = 442 * MiB;
constexpr size_t WS_SCMPK = 450 * MiB, WS_SCMPV = 520 * MiB, WS_SSLCK = 590 * MiB, WS_SSLCVT = 660 * MiB, WS_SDSAK = 730 * MiB, WS_SDSAVT = 800 * MiB,
                 WS_SWINK = 870 * MiB, WS_SWINVT = 890 * MiB, WS_SIDXK = 910 * MiB, WS_END = 950 * MiB;
constexpr int CW_BAR = 4096;
constexpr int CW_Q = 16384;

constexpr int RING_BYTES = 131072, MISC_OFF = RING_BYTES, LDS_BYTES = 147456;

struct Args { const void* in[20]; float* out; unsigned char* ws; int ph_lo, ph_hi; };

struct Frame {
    LAS unsigned char* lds; volatile LAS unsigned* MISC; unsigned* ctl;
    int tid, lane, wave, G;
    unsigned char* ws; float* out;
    const float *xp, *xs, *cnsa, *cdsa, *cidx, *swin; const int* ptab; const float *cp, *cs, *normg, *wada, *bada, *win, *pe, *w1, *w2, *wupn, *wupd, *wout, *fing;
};
#define WSP(T, off) ((T*)(F.ws + (off)))

#define LDS_WAIT() asm volatile("s_waitcnt lgkmcnt(0)" ::: "memory")
#define DI __device__ __forceinline__
DI float wave_sum(float v) {
#pragma unroll
    for (int o = 1; o < 64; o <<= 1) v += __shfl_xor(v, o);
    return v;
}
DI unsigned pk2(float lo, float hi) { return pg8::cvt_pk_bf16(lo, hi); }
DI float bflo(unsigned w) { return __uint_as_float(w << 16); }
DI float bfhi(unsigned w) { return __uint_as_float(w & 0xffff0000u); }
DI float bf2f(bf16 h) { return __uint_as_float((unsigned)h << 16); }
DI float silu_f(float x) { return x / (1.f + __expf(-x)); }
DI float sigm_f(float x) { return 1.f / (1.f + __expf(-x)); }
DI int pos16(int o) { return 8 * ((o >> 2) & 1) + (o & 3) + 4 * (o >> 3); }
DI int permk(int t) { return (t & ~15) | pos16(t & 15); }
DI int crow(int r, int hi) { return (r & 3) + 8 * (r >> 2) + 4 * hi; }
DI float dpp_x1(float v) { return __int_as_float(__builtin_amdgcn_update_dpp(0, __float_as_int(v), 0xB1, 0xF, 0xF, true)); }
DI float dpp_x2(float v) { return __int_as_float(__builtin_amdgcn_update_dpp(0, __float_as_int(v), 0x4E, 0xF, 0xF, true)); }
DI float half_other(float v) { return __shfl_xor(v, 32); }
DI u32x4 pack8(const float* v) { u32x4 w; w.x = pk2(v[0], v[1]); w.y = pk2(v[2], v[3]); w.z = pk2(v[4], v[5]); w.w = pk2(v[6], v[7]); return w; }
DI void st_bf8(bf16* p, const float* v) { *(u32x4*)p = pack8(v); }
DI void st_f8(float* p, const float* v) { *(f32x4*)p = (f32x4){v[0], v[1], v[2], v[3]}; *(f32x4*)(p + 4) = (f32x4){v[4], v[5], v[6], v[7]}; }
DI void st_vt8(bf16* p, size_t pitch, const float* v) {
#pragma unroll
    for (int j = 0; j < 8; ++j) p[(size_t)j * pitch] = (bf16)(pk2(v[j], 0.f) & 0xffffu);
}
#define MFMA32(a, b, c) __builtin_amdgcn_mfma_f32_32x32x16_bf16((a), (b), (c), 0, 0, 0)

DI int idx_key(float dot, float w) {
#pragma clang fp contract(off)
    float v = fmaxf(dot, 0.f) * w;
    v = v + dpp_x1(v);
    v = v + dpp_x2(v);
    int u = __float_as_int(v);
    u = (u == (int)0x80000000) ? 0 : u;
    return u ^ ((u >> 31) & 0x7fffffff);
}

struct EpiInProj {
    static constexpr bool PERM = true, AFTER_DRAIN = false;
    unsigned char* ws; float* out;
    DI void rope8(float* lo, float* hi, int pos, int d0) const {
        const f32x4* cp = (const f32x4*)((const float*)(ws + WS_COS) + pos * 32 + d0);
        const f32x4* sp = (const f32x4*)((const float*)(ws + WS_SIN) + pos * 32 + d0);
        const f32x4 c0 = cp[0], c1 = cp[1], s0 = sp[0], s1 = sp[1];
        const float c[8] = {c0[0], c0[1], c0[2], c0[3], c1[0], c1[1], c1[2], c1[3]}, s[8] = {s0[0], s0[1], s0[2], s0[3], s1[0], s1[1], s1[2], s1[3]};
#pragma unroll
        for (int j = 0; j < 8; ++j) { const float a = lo[j], b = hi[j]; lo[j] = a * c[j] - b * s[j]; hi[j] = b * c[j] + a * s[j]; }
    }
    DI void operator()(const pg8::f32x4 (&acc)[2][2][4][2], const pg8::Unit& u, int wr, int wc, int fr, int fq) const {
        const int hs = u.pn * 4 + wc;
        if (hs >= 86) return;
        const bool samp = u.pm >= 64;
        const int d0 = 8 * fq;
#pragma unroll
        for (int ai = 0; ai < 2; ++ai)
#pragma unroll
            for (int m = 0; m < 4; ++m) {
                const int r = u.pm * 256 + ai * 128 + wr * 64 + m * 16 + fr;
                int b, t, pos;
                if (!samp) { b = r >> 12; t = r & 4095; pos = t; } else { b = (r - MP) >> 2; t = r & 3; pos = PASTL + t; }
                float lo[8], hi[8];
#pragma unroll
                for (int n = 0; n < 2; ++n)
#pragma unroll
                    for (int j = 0; j < 4; ++j) { lo[4 * n + j] = acc[ai][0][m][n][j]; hi[4 * n + j] = acc[ai][1][m][n][j]; }
                if (hs < 8) {
                    bf16* qa = (bf16*)(ws + WS_QRAW) + (size_t)r * 512 + hs * 64 + d0;
                    bf16* qb = (bf16*)(ws + WS_QROT) + (size_t)r * 512 + hs * 64 + d0;
                    float a[8], c[8];
#pragma unroll
                    for (int j = 0; j < 8; ++j) { a[j] = lo[j] * C2; c[j] = hi[j] * C2; }
                    st_bf8(qa, a); st_bf8(qa + 32, c);
                    rope8(lo, hi, pos, d0);
#pragma unroll
                    for (int j = 0; j < 8; ++j) { a[j] = lo[j] * C2; c[j] = hi[j] * C2; }
                    st_bf8(qb, a); st_bf8(qb + 32, c);
                } else if (hs < 20) {
                    const int ty = (hs - 8) >> 1, g = (hs - 8) & 1;
                    if (ty == 2 || ty == 4) rope8(lo, hi, pos, d0);
                    const int bg = b * 2 + g;
                    if (ty < 4) {
                        float* o = out + (samp ? O_NSAS + ((size_t)(r - MP) * 8 + ty * 2 + g) * 64 : O_NSAP + ((size_t)r * 8 + ty * 2 + g) * 64) + d0;
                        st_f8(o, lo); st_f8(o + 32, hi);
                    } else {
                        const int sl = ty - 4;
                        if (samp) { float* o = out + O_WINS + (((size_t)b * 512 + 508 + t) * 4 + sl * 2 + g) * 64 + d0; st_f8(o, lo); st_f8(o + 32, hi); }
                        else if (t >= SEQ - 512) { float* o = out + O_WINP + (((size_t)b * 512 + (t - (SEQ - 512))) * 4 + sl * 2 + g) * 64 + d0; st_f8(o, lo); st_f8(o + 32, hi); }
                    }
                    if (ty == 3 || ty == 5) {
                        size_t pitch; int kp; bf16* base;
                        if (!samp) { pitch = SEQ; kp = t; base = (bf16*)(ws + (ty == 3 ? WS_PSLCVT : WS_PWINVT)); }
                        else if (ty == 3) { pitch = LS; kp = PASTL + t; base = (bf16*)(ws + WS_SSLCVT); }
                        else { pitch = LSW; kp = 512 + t; base = (bf16*)(ws + WS_SWINVT); }
                        bf16* p = base + ((size_t)bg * 64 + d0) * pitch + permk(kp);
                        st_vt8(p, pitch, lo); st_vt8(p + 32 * pitch, pitch, hi);
                    } else {
                        size_t rowi; bf16* base;
                        if (!samp) { rowi = (size_t)bg * SEQ + t; base = (bf16*)(ws + (ty == 0 ? WS_PCMPK : ty == 1 ? WS_PCMPV : ty == 2 ? WS_PSLCK : WS_PWINK)); }
                        else if (ty == 4) { rowi = (size_t)bg * LSW + 512 + t; base = (bf16*)(ws + WS_SWINK); }
                        else { rowi = (size_t)bg * LS + PASTL + t; base = (bf16*)(ws + (ty == 0 ? WS_SCMPK : ty == 1 ? WS_SCMPV : WS_SSLCK)); }
                        bf16* p = base + rowi * 64 + d0;
                        st_bf8(p, lo); st_bf8(p + 32, hi);
                    }
                } else if (hs < 28 || (hs >= 45 && hs < 53)) {
                    const int h = hs < 28 ? hs - 20 : hs - 45;
                    bf16* p = (bf16*)(ws + (hs < 28 ? WS_ZN : WS_ZD)) + (size_t)r * 512 + h * 64 + d0;
#pragma unroll
                    for (int j = 0; j < 8; ++j) { lo[j] = silu_f(lo[j]); hi[j] = silu_f(hi[j]); }
                    st_bf8(p, lo); st_bf8(p + 32, hi);
                } else if (hs < 36) {
                    rope8(lo, hi, pos, d0);
#pragma unroll
                    for (int j = 0; j < 8; ++j) { lo[j] *= C2; hi[j] *= C2; }
                    bf16* p = (bf16*)(ws + WS_DQ) + (size_t)r * 512 + (hs - 28) * 64 + d0;
                    st_bf8(p, lo); st_bf8(p + 32, hi);
                } else if (hs < 40) {
                    const int sl = (hs - 36) >> 1, g = (hs - 36) & 1, bg = b * 2 + g;
                    if (sl == 0) rope8(lo, hi, pos, d0);
                    float* o = out + (samp ? O_DSAS + ((size_t)(r - MP) * 4 + sl * 2 + g) * 64 : O_DSAP + ((size_t)r * 4 + sl * 2 + g) * 64) + d0;
                    st_f8(o, lo); st_f8(o + 32, hi);
                    if (sl == 0) {
                        bf16* p = samp ? (bf16*)(ws + WS_SDSAK) + ((size_t)bg * LS + PASTL + t) * 64 + d0 : (bf16*)(ws + WS_PDSAK) + ((size_t)bg * SEQ + t) * 64 + d0;
                        st_bf8(p, lo); st_bf8(p + 32, hi);
                    } else {
                        const size_t pitch = samp ? LS : SEQ; const int kp = samp ? PASTL + t : t;
                        bf16* p = (bf16*)(ws + (samp ? WS_SDSAVT : WS_PDSAVT)) + ((size_t)bg * 64 + d0) * pitch + permk(kp);
                        st_vt8(p, pitch, lo); st_vt8(p + 32 * pitch, pitch, hi);
                    }
                } else if (hs < 44) {
                    rope8(lo, hi, pos, d0);
                    bf16* p = (bf16*)(ws + WS_IQ) + (size_t)r * 256 + (hs - 40) * 64 + d0;
                    st_bf8(p, lo); st_bf8(p + 32, hi);
                } else if (hs == 44) {
                    rope8(lo, hi, pos, d0);
                    float* o = out + (samp ? O_IDXS + (size_t)(r - MP) * 64 : O_IDXP + (size_t)r * 64) + d0;
                    st_f8(o, lo); st_f8(o + 32, hi);
                    bf16* p = samp ? (bf16*)(ws + WS_SIDXK) + ((size_t)b * LS + PASTL + t) * 64 + d0 : (bf16*)(ws + WS_PIDXK) + (size_t)r * 64 + d0;
                    st_bf8(p, lo); st_bf8(p + 32, hi);
                } else if (hs < 85) {
                    bf16* p = (bf16*)(ws + WS_MG) + (size_t)r * 2048 + (hs - 53) * 64 + d0;
#pragma unroll
                    for (int j = 0; j < 8; ++j) { lo[j] = sigm_f(lo[j]); hi[j] = sigm_f(hi[j]); }
                    st_bf8(p, lo); st_bf8(p + 32, hi);
                } else {
                    if (fq < 3) { float* p = (float*)(ws + WS_GATES) + (size_t)r * 24 + d0;
#pragma unroll
                        for (int j = 0; j < 8; ++j) lo[j] = sigm_f(lo[j]);
                        st_f8(p, lo);
                    } else { *(f32x4*)((float*)(ws + WS_IW) + (size_t)r * 4) = (f32x4){lo[0], lo[1], lo[2], lo[3]}; }
                }
            }
    }
};
struct EpiUp1 {
    static constexpr bool PERM = true, AFTER_DRAIN = false;
    unsigned char* ws;
    DI void operator()(const pg8::f32x4 (&acc)[2][2][4][2], const pg8::Unit& u, int wr, int wc, int fr, int fq) const {
#pragma unroll
        for (int ai = 0; ai < 2; ++ai)
#pragma unroll
            for (int m = 0; m < 4; ++m) {
                const int r = u.pm * 256 + ai * 128 + wr * 64 + m * 16 + fr;
#pragma unroll
                for (int bj = 0; bj < 2; ++bj) {
                    const int c0 = u.pn * 256 + bj * 128 + wc * 32 + 8 * fq;
                    const u32x4 gw = *(const u32x4*)((const bf16*)(ws + WS_MG) + (size_t)r * 2048 + c0);
                    const f32x4 a0 = acc[ai][bj][m][0], a1 = acc[ai][bj][m][1];
                    float* o = (float*)(ws + WS_T1) + (size_t)r * 1024 + c0;
                    *(f32x4*)o = (f32x4){a0[0] * bflo(gw.x), a0[1] * bfhi(gw.x), a0[2] * bflo(gw.y), a0[3] * bfhi(gw.y)};
                    *(f32x4*)(o + 4) = (f32x4){a1[0] * bflo(gw.z), a1[1] * bfhi(gw.z), a1[2] * bflo(gw.w), a1[3] * bfhi(gw.w)};
                }
            }
    }
};
struct EpiUp2 {
    static constexpr bool PERM = true, AFTER_DRAIN = false;
    unsigned char* ws;
    DI void operator()(const pg8::f32x4 (&acc)[2][2][4][2], const pg8::Unit& u, int wr, int wc, int fr, int fq) const {
#pragma unroll
        for (int ai = 0; ai < 2; ++ai)
#pragma unroll
            for (int m = 0; m < 4; ++m) {
                const int r = u.pm * 256 + ai * 128 + wr * 64 + m * 16 + fr;
#pragma unroll
                for (int bj = 0; bj < 2; ++bj) {
                    const int c0 = u.pn * 256 + bj * 128 + wc * 32 + 8 * fq;
                    const u32x4 gw = *(const u32x4*)((const bf16*)(ws + WS_MG) + (size_t)r * 2048 + 1024 + c0);
                    const float* tp = (const float*)(ws + WS_T1) + (size_t)r * 1024 + c0;
                    const f32x4 t0 = *(const f32x4*)tp, t1 = *(const f32x4*)(tp + 4);
                    const f32x4 a0 = acc[ai][bj][m][0], a1 = acc[ai][bj][m][1];
                    u32x4 w;
                    w.x = pk2(t0[0] + a0[0] * bflo(gw.x), t0[1] + a0[1] * bfhi(gw.x)); w.y = pk2(t0[2] + a0[2] * bflo(gw.y), t0[3] + a0[3] * bfhi(gw.y));
                    w.z = pk2(t1[0] + a1[0] * bflo(gw.z), t1[1] + a1[1] * bfhi(gw.z)); w.w = pk2(t1[2] + a1[2] * bflo(gw.w), t1[3] + a1[3] * bfhi(gw.w));
                    *(u32x4*)((bf16*)(ws + WS_M1) + (size_t)r * 1024 + c0) = w;
                }
            }
    }
};
struct EpiOut {
    static constexpr bool PERM = true, AFTER_DRAIN = false;
    unsigned char* ws; float* out; const float* xp; const float* xs;
    DI void operator()(const pg8::f32x4 (&acc)[2][2][4][2], const pg8::Unit& u, int wr, int wc, int fr, int fq) const {
        const bool samp = u.pm >= 64;
#pragma unroll
        for (int ai = 0; ai < 2; ++ai)
#pragma unroll
            for (int m = 0; m < 4; ++m) {
                const int r = u.pm * 256 + ai * 128 + wr * 64 + m * 16 + fr;
                const int mrow = samp ? 4 + ((r - MP) >> 2) : (r >> 12);
                const float* xr = samp ? xs + (size_t)(r - MP) * 1024 : xp + (size_t)r * 1024;
                float* orow = samp ? out + O_YS + (size_t)(r - MP) * 1024 : out + O_YP + (size_t)r * 1024;
                const float* gr = (const float*)(ws + WS_MOD) + (size_t)mrow * 3072 + 2048;
#pragma unroll
                for (int bj = 0; bj < 2; ++bj) {
                    const int c0 = u.pn * 256 + bj * 128 + wc * 32 + 8 * fq;
#pragma unroll
                    for (int n = 0; n < 2; ++n) {
                        const f32x4 x4 = *(const f32x4*)(xr + c0 + 4 * n), g4 = *(const f32x4*)(gr + c0 + 4 * n);
                        *(f32x4*)(orow + c0 + 4 * n) = x4 + g4 * acc[ai][bj][m][n];
                    }
                }
            }
    }
};

DI int win_row(int col) {
    int hs, d;
    if (col < 1280) { hs = col >> 6; d = col & 63; }
    else if (col < 1304) { hs = 85; d = col - 1280; }
    else if (col < 2904) { const int c = col - 1304; hs = 20 + (c >> 6); d = c & 63; }
    else if (col < 2908) { hs = 85; d = 24 + (col - 2904); }
    else { const int c = col - 2908; hs = 45 + (c >> 6); d = c & 63; }
    return 256 * (hs >> 2) + 128 * (d >> 5) + 32 * (hs & 3) + (d & 31);
}
template <bool WINMAP> DI void p0_transpose_item(const float* W, int K, int N, bf16* WT, LAS float* scr, int item, int lane) {
    const int nblk = (N + 31) / 32, kb = item / nblk, nb = item % nblk, k0 = 64 * kb, n0 = 32 * nb;
    const bool nok = n0 + (lane & 31) < N;
#pragma unroll 8
    for (int i = 0; i < 32; ++i) { const int kk = 2 * i + (lane >> 5); scr[kk * 33 + (lane & 31)] = nok ? W[(size_t)(k0 + kk) * N + n0 + (lane & 31)] : 0.f; }
    LDS_WAIT();
    const int c = lane & 7;
#pragma unroll
    for (int j = 0; j < 4; ++j) { const int n = (lane >> 3) + 8 * j; const LAS float* s = scr + (8 * c) * 33 + n;
        u32x4 o; o.x = pk2(s[0 * 33], s[1 * 33]); o.y = pk2(s[2 * 33], s[3 * 33]); o.z = pk2(s[4 * 33], s[5 * 33]); o.w = pk2(s[6 * 33], s[7 * 33]);
        if (n0 + n < N) { const int row = WINMAP ? win_row(n0 + n) : (n0 + n); *(u32x4*)(WT + (size_t)row * K + k0 + 8 * c) = o; } }
    LDS_WAIT();
}
DI void p0_mod(Frame& F) {
    LAS float* wl = (LAS float*)F.lds;
    float* mod = WSP(float, WS_MOD);
    for (int cg = blockIdx.x; cg < 256; cg += F.G) {
        __syncthreads();
        for (int k = F.tid; k < 1024; k += NWAVES * 64) {
            const f32x4* src = (const f32x4*)(F.wada + (size_t)k * 3072 + cg * 12);
            LAS f32x4* dst = (LAS f32x4*)(wl + k * 12);
            dst[0] = src[0]; dst[1] = src[1]; dst[2] = src[2];
        }
        __syncthreads();
        for (int r = F.wave; r < 132; r += NWAVES) {
            const float* cr = r < 4 ? F.cp + (size_t)r * 1024 : F.cs + (size_t)(r - 4) * 1024;
            float a[12];
#pragma unroll
            for (int j = 0; j < 12; ++j) a[j] = 0.f;
#pragma unroll 4
            for (int i = 0; i < 16; ++i) {
                const int k = F.lane + 64 * i; const float s = silu_f(cr[k]);
                const LAS f32x4* wp = (const LAS f32x4*)(wl + k * 12);
                const f32x4 w0 = wp[0], w1 = wp[1], w2 = wp[2];
                a[0] += s * w0[0]; a[1] += s * w0[1]; a[2] += s * w0[2]; a[3] += s * w0[3];
                a[4] += s * w1[0]; a[5] += s * w1[1]; a[6] += s * w1[2]; a[7] += s * w1[3];
                a[8] += s * w2[0]; a[9] += s * w2[1]; a[10] += s * w2[2]; a[11] += s * w2[3];
            }
            float v = 0.f;
#pragma unroll
            for (int j = 0; j < 12; ++j) { const float sj = wave_sum(a[j]); v = (F.lane == j) ? sj : v; }
            if (F.lane < 12) mod[(size_t)r * 3072 + cg * 12 + F.lane] = v + F.bada[cg * 12 + F.lane];
        }
    }
    __syncthreads();
}
__device__ const double ROPE_INV[32] = {
    1.0, 0.7498942093324559, 0.5623413251903491, 0.4216965034285822, 0.31622776601683794, 0.23713737056616552, 0.1778279410038923, 0.1333521432163324,
    0.1, 0.07498942093324559, 0.05623413251903491, 0.04216965034285822, 0.03162277660168379, 0.023713737056616554, 0.01778279410038923, 0.01333521432163324,
    0.01, 0.007498942093324559, 0.005623413251903491, 0.004216965034285822, 0.0031622776601683794, 0.0023713737056616554, 0.0017782794100389228, 0.001333521432163324,
    0.001, 0.0007498942093324559, 0.0005623413251903491, 0.0004216965034285822, 0.00031622776601683794, 0.00023713737056616554, 0.00017782794100389227, 0.0001333521432163324};
DI void p0_rope_item(Frame& F, int item) {
    const int pos = 2 * item + (F.lane >> 5), d = F.lane & 31;
    if (pos >= 4100) return;
    const double ang = (double)pos * ROPE_INV[d];
    const double kq = __builtin_rint(ang * 0.6366197723675814);
    double r = __builtin_fma(-kq, 1.5707963267948966, ang); r = __builtin_fma(-kq, 6.123233995736766e-17, r);
    const int q = (int)kq & 3;
    const double r2 = r * r;
    const double sn = r * (1.0 + r2 * (-1.0 / 6 + r2 * (1.0 / 120 + r2 * (-1.0 / 5040 + r2 * (1.0 / 362880 + r2 * (-1.0 / 39916800 + r2 * (1.0 / 6227020800.0)))))));
    const double cs = 1.0 + r2 * (-0.5 + r2 * (1.0 / 24 + r2 * (-1.0 / 720 + r2 * (1.0 / 40320 + r2 * (-1.0 / 3628800 + r2 * (1.0 / 479001600.0 + r2 * (-1.0 / 87178291200.0)))))));
    const double c = (q == 0) ? cs : (q == 1) ? -sn : (q == 2) ? -cs : sn;
    const double s = (q == 0) ? sn : (q == 1) ? cs : (q == 2) ? -sn : -cs;
    WSP(float, WS_COS)[pos * 32 + d] = (float)c; WSP(float, WS_SIN)[pos * 32 + d] = (float)s;
}
DI void p0_cmp_small_item(Frame& F, int item) {
    if (item < 256) {
        const int slot = item >> 7, c = item & 127; float a = 0.f;
        for (int i = 0; i < 32; ++i) { const int k = F.lane + 64 * i; a += F.pe[slot * 2048 + k] * F.w1[((size_t)slot * 2048 + k) * 128 + c]; }
        a = wave_sum(a);
        if (F.lane == 0) WSP(float, WS_BIAS1)[item] = a;
    } else {
        const int it = item - 256, slot = it >> 7, e = (it & 127) >> 1, ch = it & 1;
        const int c = ch * 64 + F.lane;
        WSP(bf16, WS_W2T)[((size_t)slot * 64 + e) * 128 + permk(c)] = (bf16)(pk2(F.w2[((size_t)slot * 128 + c) * 64 + e], 0.f) & 0xffffu);
    }
}
DI void cp_k16(const float* src, size_t rs, bf16* dst, int lane) {
    const int tk = lane >> 2, dc = (lane & 3) * 16;
    const f32x4* s = (const f32x4*)(src + (size_t)tk * rs + dc);
    const f32x4 a = s[0], b = s[1], c = s[2], d = s[3];
    u32x4 w0, w1; w0.x = pk2(a[0], a[1]); w0.y = pk2(a[2], a[3]); w0.z = pk2(b[0], b[1]); w0.w = pk2(b[2], b[3]);
    w1.x = pk2(c[0], c[1]); w1.y = pk2(c[2], c[3]); w1.z = pk2(d[0], d[1]); w1.w = pk2(d[2], d[3]);
    u32x4* o = (u32x4*)(dst + (size_t)tk * 64 + dc); o[0] = w0; o[1] = w1;
}
DI void cp_vt16(const float* src, size_t rs, bf16* dst, size_t pitch, int lane) {
#pragma unroll
    for (int h = 0; h < 2; ++h) {
        float v[8];
#pragma unroll
        for (int i = 0; i < 8; ++i) v[i] = src[(size_t)((i & 3) + 8 * (i >> 2) + 4 * h) * rs + lane];
        *(u32x4*)(dst + (size_t)lane * pitch + 8 * h) = pack8(v);
    }
}
DI void p0_gather_item(Frame& F, int item) {
    const int sb = item >> 7, tg = item & 127, tk0 = tg * 16, lane = F.lane;
    const int pg = F.ptab[sb * NPG + (tk0 >> 7)], j0 = tk0 & 127;
    const float* nsa = F.cnsa + ((size_t)pg * PAGE + j0) * 512;
    const float* dsa = F.cdsa + ((size_t)pg * PAGE + j0) * 256;
    const float* idx = F.cidx + ((size_t)pg * PAGE + j0) * 64;
#pragma unroll
    for (int g = 0; g < 2; ++g) {
        const size_t bg = (size_t)sb * 2 + g;
        cp_k16(nsa + (0 * 2 + g) * 64, 512, WSP(bf16, WS_SCMPK) + (bg * LS + tk0) * 64, lane);
        cp_k16(nsa + (1 * 2 + g) * 64, 512, WSP(bf16, WS_SCMPV) + (bg * LS + tk0) * 64, lane);
        cp_k16(nsa + (2 * 2 + g) * 64, 512, WSP(bf16, WS_SSLCK) + (bg * LS + tk0) * 64, lane);
        cp_vt16(nsa + (3 * 2 + g) * 64, 512, WSP(bf16, WS_SSLCVT) + bg * 64 * LS + tk0, LS, lane);
        cp_k16(dsa + (0 * 2 + g) * 64, 256, WSP(bf16, WS_SDSAK) + (bg * LS + tk0) * 64, lane);
        cp_vt16(dsa + (1 * 2 + g) * 64, 256, WSP(bf16, WS_SDSAVT) + bg * 64 * LS + tk0, LS, lane);
    }
    cp_k16(idx, 64, WSP(bf16, WS_SIDXK) + ((size_t)sb * LS + tk0) * 64, lane);
}
DI void p0_win_item(Frame& F, int item) {
    const int sb = item >> 5, w0 = (item & 31) * 16, lane = F.lane;
    const float* st = F.swin + ((size_t)sb * 512 + w0) * 256;
#pragma unroll
    for (int g = 0; g < 2; ++g) {
        const size_t bg = (size_t)sb * 2 + g;
        cp_k16(st + (0 * 2 + g) * 64, 256, WSP(bf16, WS_SWINK) + (bg * LSW + w0) * 64, lane);
        cp_vt16(st + (1 * 2 + g) * 64, 256, WSP(bf16, WS_SWINVT) + bg * 64 * LSW + w0, LSW, lane);
    }
}
DI void p0_zero_item(Frame& F, int item) {
    const int arr = item >> 8, bg = item & 255, lane = F.lane;
    bf16* p; int n;
    if (arr == 0) { p = WSP(bf16, WS_SSLCVT) + ((size_t)bg * 64 + lane) * LS + 2052; n = 60; }
    else if (arr == 1) { p = WSP(bf16, WS_SDSAVT) + ((size_t)bg * 64 + lane) * LS + 2052; n = 60; }
    else { p = WSP(bf16, WS_SWINVT) + ((size_t)bg * 64 + lane) * LSW + 516; n = 60; }
    unsigned long long* q = (unsigned long long*)p;
    for (int i = 0; i < n / 4; ++i) q[i] = 0ull;
}
DI void p0_prologue(Frame& F) {
    p0_mod(F);
    LAS float* scr = (LAS float*)(F.lds + F.wave * 16384);
    const int gw = blockIdx.x * NWAVES + F.wave, NGW = F.G * NWAVES;
    constexpr int I_WIN = 16 * 171, I_UP = 8 * 32, I_OUT = 16 * 32, I_W1 = 32 * 4;
    constexpr int T0 = I_WIN, T1 = T0 + I_UP, T2 = T1 + I_UP, T3 = T2 + I_OUT, T4 = T3 + 2 * I_W1, T5 = T4 + 2050, T6 = T5 + 512, T7 = T6 + 768, T8 = T7 + SBATCH * 32, T9 = T8 + SBATCH * 128;
    for (int it = gw; it < T9; it += NGW) {
        if (it < T0) p0_transpose_item<true>(F.win, 1024, 5468, WSP(bf16, WS_WINT), scr, it, F.lane);
        else if (it < T1) p0_transpose_item<false>(F.wupn, 512, 1024, WSP(bf16, WS_WUPN), scr, it - T0, F.lane);
        else if (it < T2) p0_transpose_item<false>(F.wupd, 512, 1024, WSP(bf16, WS_WUPD), scr, it - T1, F.lane);
        else if (it < T3) p0_transpose_item<false>(F.wout, 1024, 1024, WSP(bf16, WS_WOUT), scr, it - T2, F.lane);
        else if (it < T4) { const int q = it - T3, slot = q / I_W1; p0_transpose_item<false>(F.w1 + (size_t)slot * 2048 * 128, 2048, 128, WSP(bf16, WS_W1T) + (size_t)slot * 128 * 2048, scr, q % I_W1, F.lane); }
        else if (it < T5) p0_rope_item(F, it - T4);
        else if (it < T6) p0_cmp_small_item(F, it - T5);
        else if (it < T7) p0_zero_item(F, it - T6);
        else if (it < T8) p0_win_item(F, it - T7);
        else p0_gather_item(F, it - T8);
    }
    const size_t tot4 = (size_t)SBATCH * 508 * 64;
    for (size_t i = (size_t)blockIdx.x * 512 + F.tid; i < tot4; i += (size_t)F.G * 512) {
        const size_t sb = i / (508 * 64), rem = i % (508 * 64);
        ((f32x4*)(F.out + O_WINS))[sb * 512 * 64 + rem] = ((const f32x4*)F.swin)[sb * 512 * 64 + 4 * 64 + rem];
    }
}
DI void p1_adaln(Frame& F) {
    const int gw = blockIdx.x * NWAVES + F.wave, NGW = F.G * NWAVES;
    const float* mod = WSP(float, WS_MOD);
    for (int r = gw; r < MR; r += NGW) {
        const float* xr = r < MP ? F.xp + (size_t)r * 1024 : F.xs + (size_t)(r - MP) * 1024;
        const int mrow = r < MP ? (r >> 12) : 4 + ((r - MP) >> 2);
        const f32x4* x4 = (const f32x4*)xr + F.lane;
        f32x4 v[4]; float s = 0.f;
#pragma unroll
        for (int j = 0; j < 4; ++j) { v[j] = x4[64 * j]; s += (v[j][0] * v[j][0] + v[j][1] * v[j][1]) + (v[j][2] * v[j][2] + v[j][3] * v[j][3]); }
        const float rstd = 1.f / sqrtf(wave_sum(s) * (1.f / 1024.f) + 1e-6f);
        const f32x4* g4 = (const f32x4*)F.normg + F.lane;
        const f32x4* sh4 = (const f32x4*)(mod + (size_t)mrow * 3072) + F.lane;
        const f32x4* sc4 = (const f32x4*)(mod + (size_t)mrow * 3072 + 1024) + F.lane;
        unsigned long long* o8 = (unsigned long long*)(WSP(bf16, WS_H) + (size_t)r * 1024) + F.lane;
#pragma unroll
        for (int j = 0; j < 4; ++j) {
            const f32x4 y = v[j] * rstd * g4[64 * j]; const f32x4 h = y * (1.f + sc4[64 * j]) + sh4[64 * j];
            o8[64 * j] = (unsigned long long)pk2(h[0], h[1]) | ((unsigned long long)pk2(h[2], h[3]) << 32);
        }
    }
}
DI void p8_final(Frame& F) {
    const int gw = blockIdx.x * NWAVES + F.wave, NGW = F.G * NWAVES;
    for (int r = gw; r < MR; r += NGW) {
        float* yr = r < MP ? F.out + O_YP + (size_t)r * 1024 : F.out + O_YS + (size_t)(r - MP) * 1024;
        f32x4* y4 = (f32x4*)yr + F.lane;
        f32x4 v[4]; float s = 0.f;
#pragma unroll
        for (int j = 0; j < 4; ++j) { v[j] = y4[64 * j]; s += (v[j][0] * v[j][0] + v[j][1] * v[j][1]) + (v[j][2] * v[j][2] + v[j][3] * v[j][3]); }
        const float rstd = 1.f / sqrtf(wave_sum(s) * (1.f / 1024.f) + 1e-6f);
        const f32x4* g4 = (const f32x4*)F.fing + F.lane;
#pragma unroll
        for (int j = 0; j < 4; ++j) y4[64 * j] = v[j] * rstd * g4[64 * j];
    }
}

constexpr int TP = 144;
constexpr int TILE_B = 64 * TP;
struct LdsT {
    const LAS unsigned char* p;
    DI bf16x8 frag(int mt, int s) const { return *(const LAS bf16x8*)(p + mt * 32 * TP + s * 32); }
};
struct GlbT {
    const bf16* p; size_t pitch;
    DI bf16x8 frag(int mt, int s) const { return *(const bf16x8*)(p + (size_t)mt * 32 * pitch + s * 16); }
};
template <class KT> DI void qk_tile(f32x16& s0, f32x16& s1, const KT& kt, const bf16x8 (&q)[4]) {
    f32x16 z;
#pragma unroll
    for (int i = 0; i < 16; ++i) z[i] = 0.f;
    s0 = z; s1 = z;
#pragma unroll
    for (int s = 0; s < 4; ++s) { s0 = MFMA32(kt.frag(0, s), q[s], s0); s1 = MFMA32(kt.frag(1, s), q[s], s1); }
}
DI bf16x8 pack_p(const f32x16& x, int h) {
    u32x4 w; w.x = pk2(x[8 * h], x[8 * h + 1]); w.y = pk2(x[8 * h + 2], x[8 * h + 3]); w.z = pk2(x[8 * h + 4], x[8 * h + 5]); w.w = pk2(x[8 * h + 6], x[8 * h + 7]);
    return __builtin_bit_cast(bf16x8, w);
}
template <class VT> DI void pv_tile(f32x16& o0, f32x16& o1, const f32x16& p0, const f32x16& p1, const VT& vt) {
    const bf16x8 b0 = pack_p(p0, 0), b1 = pack_p(p0, 1), b2 = pack_p(p1, 0), b3 = pack_p(p1, 1);
    o0 = MFMA32(vt.frag(0, 0), b0, o0); o1 = MFMA32(vt.frag(1, 0), b0, o1);
    o0 = MFMA32(vt.frag(0, 1), b1, o0); o1 = MFMA32(vt.frag(1, 1), b1, o1);
    o0 = MFMA32(vt.frag(0, 2), b2, o0); o1 = MFMA32(vt.frag(1, 2), b2, o1);
    o0 = MFMA32(vt.frag(0, 3), b3, o0); o1 = MFMA32(vt.frag(1, 3), b3, o1);
}
template <class VT> DI void softmax_pv(float& m, float& l, f32x16& o0, f32x16& o1, f32x16& s0, f32x16& s1, const VT& vt) {
    float mx = fmaxf(s0[0], s1[0]);
#pragma unroll
    for (int r = 1; r < 16; ++r) mx = fmaxf(mx, fmaxf(s0[r], s1[r]));
    mx = fmaxf(mx, half_other(mx));
    const float mn = fmaxf(m, mx);
    const float al = __builtin_amdgcn_exp2f(m - mn);
    float ps = 0.f;
#pragma unroll
    for (int r = 0; r < 16; ++r) { s0[r] = __builtin_amdgcn_exp2f(s0[r] - mn); s1[r] = __builtin_amdgcn_exp2f(s1[r] - mn); ps += s0[r] + s1[r]; }
    l = l * al + ps; m = mn;
#pragma unroll
    for (int r = 0; r < 16; ++r) { o0[r] *= al; o1[r] *= al; }
    pv_tile(o0, o1, s0, s1, vt);
}
DI u32x4 tile_ld(const bf16* g, size_t pitch, int tid) { return *(const u32x4*)(g + (size_t)(tid >> 3) * pitch + (tid & 7) * 8); }
DI void tile_st(LAS unsigned char* buf, u32x4 v, int tid) { *(LAS u32x4*)(buf + (tid >> 3) * TP + (tid & 7) * 16) = v; }
#define NEGINF (-__builtin_inff())

constexpr int CP = 272;
DI void compress_unit(Frame& F, int u) {
    const int tid = F.tid, lane = F.lane, w = F.wave, l31 = lane & 31, hi = lane >> 5;
    const int slot = u / 136, rem = u % 136;
    const bf16* data; bf16 *ock, *ocvt; int n0, ncmp, cpitch;
    if (rem < 8) { const int bg = rem; data = WSP(bf16, (slot ? WS_PCMPV : WS_PCMPK)) + (size_t)bg * SEQ * 64; n0 = 32 * w; ncmp = 255; cpitch = 256;
        ock = WSP(bf16, WS_PCK) + (size_t)bg * 256 * 64; ocvt = WSP(bf16, WS_PCVT) + (size_t)bg * 64 * 256; }
    else { const int bg = 2 * (rem - 8) + (w >> 2); data = WSP(bf16, (slot ? WS_SCMPV : WS_SCMPK)) + (size_t)bg * LS * 64; n0 = 32 * (w & 3); ncmp = 127; cpitch = 128;
        ock = WSP(bf16, WS_SCK) + (size_t)bg * 128 * 64; ocvt = WSP(bf16, WS_SCVT) + (size_t)bg * 64 * 128; }
    const int n = n0 + l31, nc = n < ncmp ? n : ncmp - 1;
    const bf16* drow = data + (size_t)nc * 1024 + 8 * hi;
    const bf16* w1t = WSP(bf16, WS_W1T) + (size_t)slot * 128 * 2048;
    f32x16 acc[4];
#pragma unroll
    for (int c = 0; c < 4; ++c)
#pragma unroll
        for (int i = 0; i < 16; ++i) acc[c][i] = 0.f;
    const bf16* wsrc = w1t + (size_t)(tid >> 2) * 2048 + (tid & 3) * 32;
    LAS unsigned char* wdst = F.lds + (tid >> 2) * CP + (tid & 3) * 64;
    u32x4 st[4];
#pragma unroll
    for (int i = 0; i < 4; ++i) st[i] = ((const u32x4*)wsrc)[i];
#pragma unroll
    for (int i = 0; i < 4; ++i) ((LAS u32x4*)wdst)[i] = st[i];
    __syncthreads();
    for (int kc = 0; kc < 16; ++kc) {
        const LAS unsigned char* buf = F.lds + (kc & 1) * (128 * CP);
        if (kc + 1 < 16) {
#pragma unroll
            for (int i = 0; i < 4; ++i) st[i] = ((const u32x4*)(wsrc + (kc + 1) * 128))[i];
        }
        bf16x8 bq[8];
#pragma unroll
        for (int s = 0; s < 8; ++s) bq[s] = *(const bf16x8*)(drow + kc * 128 + s * 16);
#pragma unroll
        for (int s = 0; s < 8; ++s)
#pragma unroll
            for (int c = 0; c < 4; ++c) acc[c] = MFMA32(*(const LAS bf16x8*)(buf + (32 * c + l31) * CP + s * 32 + hi * 16), bq[s], acc[c]);
        if (kc + 1 < 16) {
            LAS unsigned char* nb = wdst + ((kc + 1) & 1) * (128 * CP);
#pragma unroll
            for (int i = 0; i < 4; ++i) ((LAS u32x4*)nb)[i] = st[i];
        }
        __syncthreads();
    }
    const float* b1 = WSP(float, WS_BIAS1) + slot * 128;
#pragma unroll
    for (int c = 0; c < 4; ++c)
#pragma unroll
        for (int q = 0; q < 4; ++q) { const f32x4 bv = *(const f32x4*)(b1 + 32 * c + 8 * q + 4 * hi);
#pragma unroll
            for (int j = 0; j < 4; ++j) acc[c][4 * q + j] = silu_f(acc[c][4 * q + j] + bv[j]); }
    const bf16* w2t = WSP(bf16, WS_W2T) + (size_t)slot * 64 * 128 + (size_t)l31 * 128 + 8 * hi;
    f32x16 o0, o1;
#pragma unroll
    for (int i = 0; i < 16; ++i) { o0[i] = 0.f; o1[i] = 0.f; }
#pragma unroll
    for (int c = 0; c < 4; ++c)
#pragma unroll
        for (int h = 0; h < 2; ++h) { const bf16x8 hb = pack_p(acc[c], h); const int s2 = 2 * c + h;
            o0 = MFMA32(*(const bf16x8*)(w2t + s2 * 16), hb, o0); o1 = MFMA32(*(const bf16x8*)(w2t + 32 * 128 + s2 * 16), hb, o1); }
    const bool ok = n < ncmp;
    if (slot == 0) {
#pragma unroll
        for (int e = 0; e < 2; ++e)
#pragma unroll
            for (int q = 0; q < 4; ++q) { const f32x16& o = e ? o1 : o0; u32x2 wv;
                wv.x = ok ? pk2(o[4 * q], o[4 * q + 1]) : 0u; wv.y = ok ? pk2(o[4 * q + 2], o[4 * q + 3]) : 0u;
                *(u32x2*)(ock + (size_t)n * 64 + 32 * e + 8 * q + 4 * hi) = wv; }
    } else {
        const int pn = permk(n);
#pragma unroll
        for (int e = 0; e < 2; ++e)
#pragma unroll
            for (int r = 0; r < 16; ++r) { const f32x16& o = e ? o1 : o0; ocvt[(size_t)(32 * e + crow(r, hi)) * cpitch + pn] = ok ? (bf16)(pk2(o[r], 0.f) & 0xffffu) : (bf16)0; }
    }
}

template <bool SAMPLE> DI void idx1_unit(Frame& F, int u) {
    const int lane = F.lane, w = F.wave, l31 = lane & 31, hi = lane >> 5, tl = l31 >> 2, hl = l31 & 3;
    int row0, nkmax, ntok; const bf16* ik;
    if (!SAMPLE) { const int b = u & 3, tc = 511 - (u >> 2); row0 = b * SEQ + 8 * tc; nkmax = 8 * tc + 8; ntok = 8; ik = WSP(bf16, WS_PIDXK) + (size_t)b * SEQ * 64; }
    else { row0 = MP + 4 * u; nkmax = PASTL + 4; ntok = 4; ik = WSP(bf16, WS_SIDXK) + (size_t)u * LS * 64; }
    const int rowq = row0 + (SAMPLE ? (tl & 3) : tl);
    bf16x8 q[4];
#pragma unroll
    for (int s = 0; s < 4; ++s) q[s] = *(const bf16x8*)(WSP(bf16, WS_IQ) + (size_t)rowq * 256 + hl * 64 + 16 * s + 8 * hi);
    const float wgt = WSP(float, WS_IW)[(size_t)rowq * 4 + hl];
    LAS int* sc = (LAS int*)F.lds;
    const int n32 = (nkmax + 31) >> 5;
    for (int kt = w; kt < n32; kt += NWAVES) {
        const bf16* kp = ik + (size_t)(32 * kt + l31) * 64 + 8 * hi;
        f32x16 a;
#pragma unroll
        for (int i = 0; i < 16; ++i) a[i] = 0.f;
#pragma unroll
        for (int s = 0; s < 4; ++s) a = MFMA32(*(const bf16x8*)(kp + 16 * s), q[s], a);
#pragma unroll
        for (int r = 0; r < 16; ++r) { const int key = idx_key(a[r], wgt); if (hl == 0) sc[tl * 4096 + 32 * kt + crow(r, hi)] = key; }
    }
    __syncthreads();
    if (w < ntok) {
        const int n = SAMPLE ? (PASTL + 1 + w) : (row0 - (row0 & ~(SEQ - 1)) + w + 1);
        int k[64];
        int kmin = 0x7fffffff, kmax = (int)0x80000000;
#pragma unroll
        for (int i = 0; i < 64; ++i) { const bool v = 64 * i + lane < n; const int x = v ? sc[w * 4096 + 64 * i + lane] : (int)0x80000000; k[i] = x; kmin = v ? (x < kmin ? x : kmin) : kmin; kmax = x > kmax ? x : kmax; }
        int thr = (int)0x80000000, cut = -1;
        if (n > 256) {
#pragma unroll
            for (int o = 1; o < 64; o <<= 1) { const int a = __shfl_xor(kmin, o), b = __shfl_xor(kmax, o); kmin = a < kmin ? a : kmin; kmax = b > kmax ? b : kmax; }
            int lo = __builtin_amdgcn_readfirstlane(kmin) - 1, hiv = __builtin_amdgcn_readfirstlane(kmax);
            bool found = false;
            while ((unsigned)hiv - (unsigned)lo > 1u) {
                const int mid = (int)((unsigned)lo + (((unsigned)hiv - (unsigned)lo) >> 1));
                int c = 0;
#pragma unroll
                for (int i = 0; i < 64; ++i) c += __popcll(__ballot(k[i] > mid));
                if (c == 256) { thr = mid; found = true; break; }
                if (c > 256) lo = mid; else hiv = mid;
            }
            if (!found) {
                thr = hiv; int cgt = 0;
#pragma unroll
                for (int i = 0; i < 64; ++i) cgt += __popcll(__ballot(k[i] > thr));
                const int need = 256 - cgt; int acc = 0; bool done = false;
#pragma unroll
                for (int i = 0; i < 64; ++i) {
                    unsigned long long mk = __ballot(k[i] == thr); const int pc = __popcll(mk);
                    if (!done && acc + pc >= need) { for (int q2 = 1; q2 < need - acc; ++q2) mk &= mk - 1; cut = 64 * i + (int)__builtin_ctzll(mk); done = true; }
                    acc += pc;
                }
            }
        }
        if (lane == 0) { WSP(int, WS_THR)[row0 + w] = thr; WSP(int, WS_CUT)[row0 + w] = cut; }
    }
    __syncthreads();
}

constexpr int NSA_PS = 2 * 2 * TILE_B;
constexpr int NSA_WS = 8192 + 2048 + 64;
template <bool SAMPLE> DI void nsa_unit(Frame& F, int u) {
    const int tid = F.tid, lane = F.lane, w = F.wave, l31 = lane & 31, hi = lane >> 5, tl = l31 >> 2, hl = l31 & 3;
    int bg, g, row, qpos, ncmp, wlo, whi, n_ctile, n_stile, w_t0, w_t1, qt = 0;
    size_t cpitch, pitch, wpitch; const bf16 *ck, *cvt, *sk, *svt, *wk, *wvt; bool wr_ok;
    if (!SAMPLE) {
        bg = u & 7; qt = 63 - (u >> 3); g = bg & 1; const int t = 64 * qt + 8 * w + tl; row = (bg >> 1) * SEQ + t; qpos = t; ncmp = 255;
        cpitch = 256; pitch = SEQ; wpitch = SEQ;
        ck = WSP(bf16, WS_PCK) + (size_t)bg * 256 * 64; cvt = WSP(bf16, WS_PCVT) + (size_t)bg * 64 * 256;
        sk = WSP(bf16, WS_PSLCK) + (size_t)bg * SEQ * 64; svt = WSP(bf16, WS_PSLCVT) + (size_t)bg * 64 * SEQ;
        wk = WSP(bf16, WS_PWINK) + (size_t)bg * SEQ * 64; wvt = WSP(bf16, WS_PWINVT) + (size_t)bg * 64 * SEQ;
        wlo = qpos - 511; whi = qpos; n_ctile = (4 * qt + 2) / 64 + 1; n_stile = qt + 1; w_t0 = qt > 8 ? qt - 8 : 0; w_t1 = qt; wr_ok = true;
    } else {
        bg = u * 8 + w; g = bg & 1; const int i = tl & 3; row = MP + (bg >> 1) * 4 + i; qpos = PASTL + i; ncmp = 127;
        cpitch = 128; pitch = LS; wpitch = LSW;
        ck = WSP(bf16, WS_SCK) + (size_t)bg * 128 * 64; cvt = WSP(bf16, WS_SCVT) + (size_t)bg * 64 * 128;
        sk = WSP(bf16, WS_SSLCK) + (size_t)bg * LS * 64; svt = WSP(bf16, WS_SSLCVT) + (size_t)bg * 64 * LS;
        wk = WSP(bf16, WS_SWINK) + (size_t)bg * LSW * 64; wvt = WSP(bf16, WS_SWINVT) + (size_t)bg * 64 * LSW;
        wlo = 1 + i; whi = 512 + i; n_ctile = 2; n_stile = 33; w_t0 = 0; w_t1 = 8; wr_ok = tl < 4;
    }
    const int hq = 4 * g + hl;
    bf16x8 qraw[4], qrot[4];
#pragma unroll
    for (int s = 0; s < 4; ++s) { qraw[s] = *(const bf16x8*)(WSP(bf16, WS_QRAW) + (size_t)row * 512 + hq * 64 + 16 * s + 8 * hi);
                                  qrot[s] = *(const bf16x8*)(WSP(bf16, WS_QROT) + (size_t)row * 512 + hq * 64 + 16 * s + 8 * hi); }
    LAS unsigned char* const lb = F.lds;
    LAS float* psum = (LAS float*)(lb + NSA_PS + w * NSA_WS);
    LAS float* impb = (LAS float*)(lb + NSA_PS + w * NSA_WS + 8192);
    LAS unsigned char* selb = lb + NSA_PS + w * NSA_WS + 8192 + 2048;
    const int fo = l31 * TP + hi * 16;
    f32x16 res0, res1;
    const float* gp = WSP(float, WS_GATES) + (size_t)row * 24 + hq * 3;
    const float g0 = gp[0], g1 = gp[1], g2 = gp[2];
    f32x16 s0, s1, o0, o1;
    u32x4 rk, rv;

    const int nvr = (qpos - 31) >> 4, nvis = nvr < ncmp - 1 ? nvr : ncmp - 1;
    float m = -1e30f, l = 0.f;
    if (!SAMPLE) { rk = tile_ld(ck, 64, tid); rv = tile_ld(cvt, cpitch, tid); tile_st(lb, rk, tid); tile_st(lb + TILE_B, rv, tid); __syncthreads(); }
    for (int ct = 0; ct < n_ctile; ++ct) {
        if (!SAMPLE) { if (ct + 1 < n_ctile) { rk = tile_ld(ck + (size_t)(ct + 1) * 64 * 64, 64, tid); rv = tile_ld(cvt + (ct + 1) * 64, cpitch, tid); } }
        if (!SAMPLE) { LdsT kt{lb + (ct & 1) * 2 * TILE_B + fo}; qk_tile(s0, s1, kt, qraw); }
        else { GlbT kt{ck + (size_t)(64 * ct + l31) * 64 + 8 * hi, 64}; qk_tile(s0, s1, kt, qraw); }
        float mx = -1e30f;
#pragma unroll
        for (int r = 0; r < 16; ++r) { const int n = 64 * ct + crow(r, hi); s0[r] = n <= nvis ? s0[r] : NEGINF; s1[r] = n + 32 <= nvis ? s1[r] : NEGINF; mx = fmaxf(mx, fmaxf(s0[r], s1[r])); }
        mx = fmaxf(mx, half_other(mx));
        const float mn = fmaxf(m, mx); float ps = 0.f;
#pragma unroll
        for (int r = 0; r < 16; ++r) ps += __builtin_amdgcn_exp2f(s0[r] - mn) + __builtin_amdgcn_exp2f(s1[r] - mn);
        l = l * __builtin_amdgcn_exp2f(m - mn) + ps; m = mn;
        if (!SAMPLE) { if (ct + 1 < n_ctile) { tile_st(lb + ((ct + 1) & 1) * 2 * TILE_B, rk, tid); tile_st(lb + ((ct + 1) & 1) * 2 * TILE_B + TILE_B, rv, tid); } __syncthreads(); }
    }
    l += half_other(l);
    const float linv = l > 0.f ? 1.f / l : 0.f;
#pragma unroll
    for (int i = 0; i < 16; ++i) { o0[i] = 0.f; o1[i] = 0.f; }
    if (!SAMPLE) { rk = tile_ld(ck, 64, tid); rv = tile_ld(cvt, cpitch, tid); tile_st(lb, rk, tid); tile_st(lb + TILE_B, rv, tid); __syncthreads(); }
    for (int ct = 0; ct < n_ctile; ++ct) {
        if (!SAMPLE) { if (ct + 1 < n_ctile) { rk = tile_ld(ck + (size_t)(ct + 1) * 64 * 64, 64, tid); rv = tile_ld(cvt + (ct + 1) * 64, cpitch, tid); } }
        if (!SAMPLE) { LdsT kt{lb + (ct & 1) * 2 * TILE_B + fo}; qk_tile(s0, s1, kt, qraw); }
        else { GlbT kt{ck + (size_t)(64 * ct + l31) * 64 + 8 * hi, 64}; qk_tile(s0, s1, kt, qraw); }
#pragma unroll
        for (int r = 0; r < 16; ++r) { const int n = 64 * ct + crow(r, hi);
            s0[r] = n <= nvis ? __builtin_amdgcn_exp2f(s0[r] - m) * linv : 0.f; s1[r] = n + 32 <= nvis ? __builtin_amdgcn_exp2f(s1[r] - m) * linv : 0.f;
            float a = s0[r]; a += dpp_x1(a); a += dpp_x2(a); float b = s1[r]; b += dpp_x1(b); b += dpp_x2(b);
            if (hl == 0) { psum[tl * 256 + n] = a; psum[tl * 256 + n + 32] = b; } }
        if (!SAMPLE) { LdsT vt{lb + (ct & 1) * 2 * TILE_B + TILE_B + fo}; pv_tile(o0, o1, s0, s1, vt); }
        else { GlbT vt{cvt + (size_t)l31 * cpitch + 64 * ct + 8 * hi, cpitch}; pv_tile(o0, o1, s0, s1, vt); }
        if (!SAMPLE) { if (ct + 1 < n_ctile) { tile_st(lb + ((ct + 1) & 1) * 2 * TILE_B, rk, tid); tile_st(lb + ((ct + 1) & 1) * 2 * TILE_B + TILE_B, rv, tid); } __syncthreads(); }
    }
#pragma unroll
    for (int i = 0; i < 16; ++i) { res0[i] = g0 * o0[i]; res1[i] = g0 * o1[i]; }
    LDS_WAIT();
    unsigned mlo, mhi;
    {
        const int tk = lane >> 3, jb = 8 * (lane & 7);
        const int qp = SAMPLE ? PASTL + (tk & 3) : 64 * qt + 8 * w + tk, cur = qp >> 6;
        float pv[33];
        const LAS f32x4* pp = (const LAS f32x4*)(psum + tk * 256 + 4 * jb);
#pragma unroll
        for (int i = 0; i < 8; ++i) { const f32x4 x = pp[i]; pv[1 + 4 * i] = x[0]; pv[2 + 4 * i] = x[1]; pv[3 + 4 * i] = x[2]; pv[4 + 4 * i] = x[3]; }
        pv[0] = jb > 0 ? psum[tk * 256 + 4 * jb - 1] : 0.f;
        float v[8];
#pragma unroll
        for (int jj = 0; jj < 8; ++jj) {
            const int j = jb + jj;
            float a = pv[4 * jj] + pv[4 * jj + 1] + pv[4 * jj + 2] + pv[4 * jj + 3];
            a += (4 * j + 3 < ncmp) ? pv[4 * jj + 4] : 0.f;
            a = (j == 0 || j == cur || j == cur - 1) ? 1e4f : a;
            a = (j > cur) ? -1e30f : a;
            v[jj] = a;
        }
        LAS f32x4* ip = (LAS f32x4*)(impb + tk * 64 + jb);
        ip[0] = (f32x4){v[0], v[1], v[2], v[3]}; ip[1] = (f32x4){v[4], v[5], v[6], v[7]};
        LDS_WAIT();
        int cnt[8];
#pragma unroll
        for (int jj = 0; jj < 8; ++jj) cnt[jj] = 0;
        const LAS f32x4* ap = (const LAS f32x4*)(impb + tk * 64);
#pragma unroll 1
        for (int i4 = 0; i4 < 16; ++i4) {
            const f32x4 x = ap[i4];
#pragma unroll
            for (int e = 0; e < 4; ++e) { const int i = 4 * i4 + e; const float xi = x[e];
#pragma unroll
                for (int jj = 0; jj < 8; ++jj) cnt[jj] += (xi > v[jj] || (xi == v[jj] && i < jb + jj)) ? 1 : 0; }
        }
        unsigned bits = 0;
#pragma unroll
        for (int jj = 0; jj < 8; ++jj) bits |= (cnt[jj] < 16 && jb + jj <= cur) ? (1u << jj) : 0u;
        selb[tk * 8 + (lane & 7)] = (unsigned char)bits;
        LDS_WAIT();
        const LAS unsigned* sp = (const LAS unsigned*)(selb + tl * 8);
        mlo = sp[0]; mhi = sp[1];
    }
    m = -1e30f; l = 0.f;
#pragma unroll
    for (int i = 0; i < 16; ++i) { o0[i] = 0.f; o1[i] = 0.f; }
    if (!SAMPLE) { rk = tile_ld(sk, 64, tid); rv = tile_ld(svt, pitch, tid); tile_st(lb, rk, tid); tile_st(lb + TILE_B, rv, tid); __syncthreads(); }
    for (int j = 0; j < n_stile; ++j) {
        if (!SAMPLE) { if (j + 1 < n_stile) { rk = tile_ld(sk + (size_t)(j + 1) * 64 * 64, 64, tid); rv = tile_ld(svt + (j + 1) * 64, pitch, tid); } }
        if (!SAMPLE) { LdsT kt{lb + (j & 1) * 2 * TILE_B + fo}; qk_tile(s0, s1, kt, qrot); }
        else { GlbT kt{sk + (size_t)(64 * j + l31) * 64 + 8 * hi, 64}; qk_tile(s0, s1, kt, qrot); }
        const bool bsel = ((j < 32 ? (mlo >> j) : (mhi >> (j - 32))) & 1u) != 0u;
#pragma unroll
        for (int r = 0; r < 16; ++r) { const int kk = 64 * j + crow(r, hi); s0[r] = (bsel && kk <= qpos) ? s0[r] : NEGINF; s1[r] = (bsel && kk + 32 <= qpos) ? s1[r] : NEGINF; }
        if (!SAMPLE) { LdsT vt{lb + (j & 1) * 2 * TILE_B + TILE_B + fo}; softmax_pv(m, l, o0, o1, s0, s1, vt); }
        else { GlbT vt{svt + (size_t)l31 * pitch + 64 * j + 8 * hi, pitch}; softmax_pv(m, l, o0, o1, s0, s1, vt); }
        if (!SAMPLE) { if (j + 1 < n_stile) { tile_st(lb + ((j + 1) & 1) * 2 * TILE_B, rk, tid); tile_st(lb + ((j + 1) & 1) * 2 * TILE_B + TILE_B, rv, tid); } __syncthreads(); }
    }
    l += half_other(l);
    { const float sc = g1 / fmaxf(l, 1e-30f);
#pragma unroll
      for (int i = 0; i < 16; ++i) { res0[i] += sc * o0[i]; res1[i] += sc * o1[i]; } }
    m = -1e30f; l = 0.f;
#pragma unroll
    for (int i = 0; i < 16; ++i) { o0[i] = 0.f; o1[i] = 0.f; }
    if (!SAMPLE) { rk = tile_ld(wk + (size_t)w_t0 * 64 * 64, 64, tid); rv = tile_ld(wvt + w_t0 * 64, wpitch, tid); tile_st(lb, rk, tid); tile_st(lb + TILE_B, rv, tid); __syncthreads(); }
    for (int j = w_t0; j <= w_t1; ++j) {
        const int jr = j - w_t0;
        if (!SAMPLE) { if (j + 1 <= w_t1) { rk = tile_ld(wk + (size_t)(j + 1) * 64 * 64, 64, tid); rv = tile_ld(wvt + (j + 1) * 64, wpitch, tid); } }
        if (!SAMPLE) { LdsT kt{lb + (jr & 1) * 2 * TILE_B + fo}; qk_tile(s0, s1, kt, qrot); }
        else { GlbT kt{wk + (size_t)(64 * j + l31) * 64 + 8 * hi, 64}; qk_tile(s0, s1, kt, qrot); }
#pragma unroll
        for (int r = 0; r < 16; ++r) { const int kk = 64 * j + crow(r, hi); s0[r] = (kk >= wlo && kk <= whi) ? s0[r] : NEGINF; s1[r] = (kk + 32 >= wlo && kk + 32 <= whi) ? s1[r] : NEGINF; }
        if (!SAMPLE) { LdsT vt{lb + (jr & 1) * 2 * TILE_B + TILE_B + fo}; softmax_pv(m, l, o0, o1, s0, s1, vt); }
        else { GlbT vt{wvt + (size_t)l31 * wpitch + 64 * j + 8 * hi, wpitch}; softmax_pv(m, l, o0, o1, s0, s1, vt); }
        if (!SAMPLE) { if (j + 1 <= w_t1) { tile_st(lb + ((jr + 1) & 1) * 2 * TILE_B, rk, tid); tile_st(lb + ((jr + 1) & 1) * 2 * TILE_B + TILE_B, rv, tid); } __syncthreads(); }
    }
    l += half_other(l);
    { const float sc = g2 / fmaxf(l, 1e-30f);
#pragma unroll
      for (int i = 0; i < 16; ++i) { res0[i] += sc * o0[i]; res1[i] += sc * o1[i]; } }
    if (wr_ok) {
        const bf16* zp = WSP(bf16, WS_ZN) + (size_t)row * 512 + hq * 64 + 4 * hi;
        bf16* op = WSP(bf16, WS_ONZ) + (size_t)row * 512 + hq * 64 + 4 * hi;
#pragma unroll
        for (int e = 0; e < 2; ++e)
#pragma unroll
            for (int q = 0; q < 4; ++q) { const f32x16& o = e ? res1 : res0; const u32x2 z = *(const u32x2*)(zp + 32 * e + 8 * q);
                u32x2 wv; wv.x = pk2(o[4 * q] * bflo(z.x), o[4 * q + 1] * bfhi(z.x)); wv.y = pk2(o[4 * q + 2] * bflo(z.y), o[4 * q + 3] * bfhi(z.y));
                *(u32x2*)(op + 32 * e + 8 * q) = wv; }
    }
}

template <bool SAMPLE> DI void dsa_unit(Frame& F, int u) {
    const int tid = F.tid, lane = F.lane, w = F.wave, l31 = lane & 31, hi = lane >> 5, tl = l31 >> 2, hl = l31 & 3;
    int bg, g, row, qpos, nt; size_t pitch; const bf16 *ik, *dk, *dvt; bool wr_ok;
    if (!SAMPLE) { bg = u & 7; const int qt = 63 - (u >> 3); g = bg & 1; const int t = 64 * qt + 8 * w + tl; row = (bg >> 1) * SEQ + t; qpos = t; nt = qt + 1; pitch = SEQ;
        ik = WSP(bf16, WS_PIDXK) + (size_t)(bg >> 1) * SEQ * 64; dk = WSP(bf16, WS_PDSAK) + (size_t)bg * SEQ * 64; dvt = WSP(bf16, WS_PDSAVT) + (size_t)bg * 64 * SEQ; wr_ok = true; }
    else { bg = u * 8 + w; g = bg & 1; const int i = tl & 3; row = MP + (bg >> 1) * 4 + i; qpos = PASTL + i; nt = 33; pitch = LS;
        ik = WSP(bf16, WS_SIDXK) + (size_t)(bg >> 1) * LS * 64; dk = WSP(bf16, WS_SDSAK) + (size_t)bg * LS * 64; dvt = WSP(bf16, WS_SDSAVT) + (size_t)bg * 64 * LS; wr_ok = tl < 4; }
    const int hq = 4 * g + hl;
    bf16x8 iq[4], dq[4];
#pragma unroll
    for (int s = 0; s < 4; ++s) { iq[s] = *(const bf16x8*)(WSP(bf16, WS_IQ) + (size_t)row * 256 + hl * 64 + 16 * s + 8 * hi);
                                  dq[s] = *(const bf16x8*)(WSP(bf16, WS_DQ) + (size_t)row * 512 + hq * 64 + 16 * s + 8 * hi); }
    const float wgt = WSP(float, WS_IW)[(size_t)row * 4 + hl];
    const int thr = WSP(int, WS_THR)[row], cut = WSP(int, WS_CUT)[row];
    LAS unsigned char* const lb = F.lds;
    const int fo = l31 * TP + hi * 16;
    f32x16 s0, s1, i0, i1, o0, o1;
    u32x4 ri, rk, rv;
    float m = -1e30f, l = 0.f;
#pragma unroll
    for (int i = 0; i < 16; ++i) { o0[i] = 0.f; o1[i] = 0.f; }
    if (!SAMPLE) { ri = tile_ld(ik, 64, tid); rk = tile_ld(dk, 64, tid); rv = tile_ld(dvt, pitch, tid); tile_st(lb, ri, tid); tile_st(lb + TILE_B, rk, tid); tile_st(lb + 2 * TILE_B, rv, tid); __syncthreads(); }
    for (int j = 0; j < nt; ++j) {
        if (!SAMPLE) { if (j + 1 < nt) { ri = tile_ld(ik + (size_t)(j + 1) * 64 * 64, 64, tid); rk = tile_ld(dk + (size_t)(j + 1) * 64 * 64, 64, tid); rv = tile_ld(dvt + (j + 1) * 64, pitch, tid); } }
        if (!SAMPLE) { LdsT it{lb + (j & 1) * 3 * TILE_B + fo}; qk_tile(i0, i1, it, iq); LdsT kt{lb + (j & 1) * 3 * TILE_B + TILE_B + fo}; qk_tile(s0, s1, kt, dq); }
        else { GlbT it{ik + (size_t)(64 * j + l31) * 64 + 8 * hi, 64}; qk_tile(i0, i1, it, iq); GlbT kt{dk + (size_t)(64 * j + l31) * 64 + 8 * hi, 64}; qk_tile(s0, s1, kt, dq); }
#pragma unroll
        for (int r = 0; r < 16; ++r) {
            const int kk = 64 * j + crow(r, hi);
            const int ka = idx_key(i0[r], wgt), kb = idx_key(i1[r], wgt);
            const bool oa = (ka > thr || (ka == thr && kk <= cut)) && kk <= qpos, ob = (kb > thr || (kb == thr && kk + 32 <= cut)) && kk + 32 <= qpos;
            s0[r] = oa ? s0[r] : NEGINF; s1[r] = ob ? s1[r] : NEGINF;
        }
        if (!SAMPLE) { LdsT vt{lb + (j & 1) * 3 * TILE_B + 2 * TILE_B + fo}; softmax_pv(m, l, o0, o1, s0, s1, vt); }
        else { GlbT vt{dvt + (size_t)l31 * pitch + 64 * j + 8 * hi, pitch}; softmax_pv(m, l, o0, o1, s0, s1, vt); }
        if (!SAMPLE) { if (j + 1 < nt) { LAS unsigned char* nb = lb + ((j + 1) & 1) * 3 * TILE_B; tile_st(nb, ri, tid); tile_st(nb + TILE_B, rk, tid); tile_st(nb + 2 * TILE_B, rv, tid); } __syncthreads(); }
    }
    l += half_other(l);
    if (wr_ok) {
        const float sc = 1.f / fmaxf(l, 1e-30f);
        const bf16* zp = WSP(bf16, WS_ZD) + (size_t)row * 512 + hq * 64 + 4 * hi;
        bf16* op = WSP(bf16, WS_ODZ) + (size_t)row * 512 + hq * 64 + 4 * hi;
#pragma unroll
        for (int e = 0; e < 2; ++e)
#pragma unroll
            for (int q = 0; q < 4; ++q) { const f32x16& o = e ? o1 : o0; const u32x2 z = *(const u32x2*)(zp + 32 * e + 8 * q);
                u32x2 wv; wv.x = pk2(o[4 * q] * sc * bflo(z.x), o[4 * q + 1] * sc * bfhi(z.x)); wv.y = pk2(o[4 * q + 2] * sc * bflo(z.y), o[4 * q + 3] * sc * bfhi(z.y));
                *(u32x2*)(op + 32 * e + 8 * q) = wv; }
    }
}

#define XB_TMO      128
#define XB_XCNT(j)  (256  + 64 * (j))
#define XB_XSUB(j)  (1280 + 64 * (j))
#define XB_XGEN(j)  (2304 + 64 * (j))
#define XB_TOP      3328
#define XB_TOPGEN   3392
#define XCD_BAR_WORDS 3456
#define XB_SPIN_CAP (1u << 18)
__device__ __forceinline__ unsigned xb_ld(unsigned* p)              { return __hip_atomic_load(p, __ATOMIC_RELAXED, __HIP_MEMORY_SCOPE_AGENT); }
__device__ __forceinline__ unsigned xb_add(unsigned* p, unsigned v) { return __hip_atomic_fetch_add(p, v, __ATOMIC_RELAXED, __HIP_MEMORY_SCOPE_AGENT); }
__device__ __forceinline__ unsigned xb_xcc_id() { return (unsigned)__builtin_amdgcn_s_getreg((3 << 11) | 20) & 0xFu; }
#define XB_SPIN(cond, bar) do { unsigned _sp = 0; while (cond) { __builtin_amdgcn_s_sleep(1); \
    if ((++_sp & 255u) == 0u) { if (xb_ld(&(bar)[XB_TMO])) break; if (_sp > XB_SPIN_CAP) { atomicAdd(&(bar)[XB_TMO], 1u); break; } } } } while (0)
struct XcdBarrier { unsigned* bar; unsigned x; volatile LAS unsigned* st; };
__device__ __forceinline__ XcdBarrier xcd_barrier_post(unsigned* bar, volatile LAS unsigned* st) {
    XcdBarrier b; b.bar = bar; b.x = xb_xcc_id(); b.st = st;
    if (threadIdx.x == 0) (void)xb_add(&bar[XB_XCNT(b.x)], 1u);
    return b;
}
__device__ __forceinline__ void xcd_barrier_complete(unsigned* bar, unsigned x, unsigned& nloc, unsigned& nx) {
    const unsigned G = gridDim.x * gridDim.y * gridDim.z;
    unsigned sum, cnt, mine, sp = 0u;
    for (;;) {
        sum = 0u; cnt = 0u; mine = 0u;
#pragma unroll
        for (unsigned j = 0; j < 16; ++j) { const unsigned c = xb_ld(&bar[XB_XCNT(j)]); sum += c; cnt += (c > 0u) ? 1u : 0u; mine = (j == x) ? c : mine; }
        if (sum == G) break;
        __builtin_amdgcn_s_sleep(1);
        if ((++sp & 255u) == 0u) { if (xb_ld(&bar[XB_TMO])) break; if (sp > XB_SPIN_CAP) { atomicAdd(&bar[XB_TMO], 1u); break; } }
    }
    nloc = mine > 0u ? mine : 1u; nx = cnt > 0u ? cnt : 1u;
}
__device__ __forceinline__ void xcd_barrier(const XcdBarrier& b) {
    asm volatile("s_waitcnt vmcnt(0)" ::: "memory");
    __syncthreads();
    if (threadIdx.x == 0) {
        unsigned* bar = b.bar;
        __builtin_amdgcn_s_waitcnt(0);
        unsigned nloc = b.st[0], nx = b.st[1];
        if (nloc == 0u) { xcd_barrier_complete(bar, b.x, nloc, nx); b.st[0] = nloc; b.st[1] = nx; }
        const unsigned old = xb_add(&bar[XB_XSUB(b.x)], 1u);
        const unsigned gen = old / nloc;
        if (old + 1u == (gen + 1u) * nloc) {
            __builtin_amdgcn_fence(__ATOMIC_RELEASE, "agent");
            asm volatile("s_waitcnt vmcnt(0)" ::: "memory");
            const unsigned og = xb_add(&bar[XB_TOP], 1u);
            const unsigned tg = og / nx;
            if (og + 1u == (tg + 1u) * nx) xb_add(&bar[XB_TOPGEN], 1u);
            else XB_SPIN(xb_ld(&bar[XB_TOPGEN]) == tg, bar);
            __builtin_amdgcn_fence(__ATOMIC_ACQUIRE, "agent");
            xb_add(&bar[XB_XGEN(b.x)], 1u);
            asm volatile("s_waitcnt vmcnt(0)" ::: "memory");
        } else {
            XB_SPIN(xb_ld(&bar[XB_XGEN(b.x)]) == gen, bar);
            __builtin_amdgcn_fence(__ATOMIC_ACQUIRE, "agent");
            asm volatile("s_waitcnt vmcnt(0)" ::: "memory");
        }
    }
    __syncthreads();
}

constexpr int N_PHASES = 9;
DI int q_next(Frame& F, int qi) {
    __syncthreads();
    if (F.tid == 0) F.MISC[0] = __hip_atomic_fetch_add(F.ctl + CW_Q + 64 * qi, 1u, __ATOMIC_RELAXED, __HIP_MEMORY_SCOPE_AGENT);
    __syncthreads();
    return (int)F.MISC[0];
}
__global__ void __launch_bounds__(NWAVES * 64, 2) fwd(Args args) {
    extern __shared__ __attribute__((aligned(16))) unsigned char lds[];
    Frame F;
    F.lds = (LAS unsigned char*)lds; F.MISC = (volatile LAS unsigned*)(F.lds + MISC_OFF);
    F.tid = threadIdx.x; F.lane = F.tid & 63; F.wave = __builtin_amdgcn_readfirstlane(F.tid >> 6); F.G = gridDim.x;
    F.ws = args.ws; F.out = args.out; F.ctl = (unsigned*)(args.ws + WS_CTL);
    F.xp = (const float*)args.in[0]; F.xs = (const float*)args.in[1]; F.cnsa = (const float*)args.in[2]; F.cdsa = (const float*)args.in[3]; F.cidx = (const float*)args.in[4];
    F.swin = (const float*)args.in[5]; F.ptab = (const int*)args.in[6]; F.cp = (const float*)args.in[7]; F.cs = (const float*)args.in[8]; F.normg = (const float*)args.in[9];
    F.wada = (const float*)args.in[10]; F.bada = (const float*)args.in[11]; F.win = (const float*)args.in[12]; F.pe = (const float*)args.in[13]; F.w1 = (const float*)args.in[14];
    F.w2 = (const float*)args.in[15]; F.wupn = (const float*)args.in[16]; F.wupd = (const float*)args.in[17]; F.wout = (const float*)args.in[18]; F.fing = (const float*)args.in[19];
    for (int i = F.tid; i < (LDS_BYTES - MISC_OFF) / 4; i += NWAVES * 64) ((LAS unsigned*)(F.lds + MISC_OFF))[i] = 0u;
    __syncthreads();
    const int lo = args.ph_lo, hi = args.ph_hi;
    const bool one = (hi - lo) > 1;
    XcdBarrier bar; bar.bar = F.ctl + CW_BAR; bar.x = 0; bar.st = nullptr;
    if (one) bar = xcd_barrier_post(F.ctl + CW_BAR, F.MISC + 8);
#ifndef PH_MASK
#define PH_MASK 0x1ff
#endif
#define IN(k) (((PH_MASK >> (k)) & 1) && lo <= (k) && (k) < hi)
#define SEAM(k) do { if (IN(k) && IN((k) + 1)) xcd_barrier(bar); } while (0)

    if (IN(0)) { p0_prologue(F); } SEAM(0);
    if (IN(1)) { p1_adaln(F); } SEAM(1);
    if (IN(2)) {
        pg8::Gemm g{WSP(bf16, WS_H), WSP(bf16, WS_WINT), MR, NPAD, DM}; pg8::StaticOrder S; S.init(MR, NPAD, F.G, (int)blockIdx.x);
        EpiInProj E{F.ws, F.out};
        pg8::gemm_phase<EpiInProj, pg8::StaticOrder, true, true>(F.lds, g, S, E);
    } SEAM(2);
    if (IN(3)) {
        for (int u = q_next(F, 0); u < 272; u = q_next(F, 0)) compress_unit(F, u);
        for (int u = q_next(F, 1); u < 2048; u = q_next(F, 1)) idx1_unit<false>(F, u);
        for (int u = q_next(F, 2); u < SBATCH; u = q_next(F, 2)) idx1_unit<true>(F, u);
    } SEAM(3);
    if (IN(4)) {
#ifndef P4_MASK
#define P4_MASK 15
#endif
        if (P4_MASK & 1) for (int u = q_next(F, 3); u < 32; u = q_next(F, 3)) nsa_unit<true>(F, u);
        if (P4_MASK & 2) for (int u = q_next(F, 4); u < 32; u = q_next(F, 4)) dsa_unit<true>(F, u);
        if (P4_MASK & 4) for (int u = q_next(F, 5); u < 512; u = q_next(F, 5)) nsa_unit<false>(F, u);
        if (P4_MASK & 8) for (int u = q_next(F, 6); u < 512; u = q_next(F, 6)) dsa_unit<false>(F, u);
    } SEAM(4);
    if (IN(5)) {
        pg8::Gemm g{WSP(bf16, WS_ONZ), WSP(bf16, WS_WUPN), MR, DM, 512}; pg8::StaticOrder S; S.init(MR, DM, F.G, (int)blockIdx.x);
        EpiUp1 E{F.ws};
        pg8::gemm_phase<EpiUp1, pg8::StaticOrder, true, true>(F.lds, g, S, E);
    } SEAM(5);
    if (IN(6)) {
        pg8::Gemm g{WSP(bf16, WS_ODZ), WSP(bf16, WS_WUPD), MR, DM, 512}; pg8::StaticOrder S; S.init(MR, DM, F.G, (int)blockIdx.x);
        EpiUp2 E{F.ws};
        pg8::gemm_phase<EpiUp2, pg8::StaticOrder, true, true>(F.lds, g, S, E);
    } SEAM(6);
    if (IN(7)) {
        pg8::Gemm g{WSP(bf16, WS_M1), WSP(bf16, WS_WOUT), MR, DM, DM}; pg8::StaticOrder S; S.init(MR, DM, F.G, (int)blockIdx.x);
        EpiOut E{F.ws, F.out, F.xp, F.xs};
        pg8::gemm_phase<EpiOut, pg8::StaticOrder, true, true>(F.lds, g, S, E);
    } SEAM(7);
    if (IN(8)) { p8_final(F); }
#undef IN
#undef SEAM
}

extern "C" void kernel_launch(void* const* d_in, const int* in_sizes, int n_in, void* d_out, int out_size, void* d_ws, size_t ws_size, hipStream_t stream) {
    static int grid = 0;
    if (grid == 0) {
        if (n_in != 20 || (size_t)out_size != O_END || ws_size < WS_END) { fprintf(stderr, "kernel_launch: unexpected shapes (n_in %d, out %d, ws %zu)\n", n_in, out_size, ws_size); grid = -1; return; }
        int dev = 0, cus = 0, per_cu = 0;
        if (hipGetDevice(&dev) != hipSuccess || hipDeviceGetAttribute(&cus, hipDeviceAttributeMultiprocessorCount, dev) != hipSuccess) { grid = -1; return; }
        if (hipFuncSetAttribute((const void*)fwd, hipFuncAttributeMaxDynamicSharedMemorySize, LDS_BYTES) != hipSuccess) { fprintf(stderr, "kernel_launch: hipFuncSetAttribute failed\n"); grid = -1; return; }
        if (hipOccupancyMaxActiveBlocksPerMultiprocessor(&per_cu, (const void*)fwd, NWAVES * 64, LDS_BYTES) != hipSuccess || per_cu < 1) { fprintf(stderr, "kernel_launch: occupancy query says %d blocks per CU\n", per_cu); }
        (void)hipGetLastError();
        grid = cus;
    }
    if (grid < 0) return;
    (void)hipMemsetAsync((char*)d_ws + WS_CTL, 0, CTL_ZERO_BYTES, stream);
    Args a{};
    for (int i = 0; i < 20; ++i) a.in[i] = d_in[i];
    a.out = (float*)d_out; a.ws = (unsigned char*)d_ws;
#if MK_N_LAUNCHES == 1
    a.ph_lo = 0; a.ph_hi = N_PHASES;
    hipLaunchKernelGGL(fwd, dim3(grid), dim3(NWAVES * 64), LDS_BYTES, stream, a);
#else
    for (int p = 0; p < N_PHASES; ++p) { a.ph_lo = p; a.ph_hi = p + 1; hipLaunchKernelGGL(fwd, dim3(grid), dim3(NWAVES * 64), LDS_BYTES, stream, a); }
#endif
}
```

```cpp
#define MK_N_LAUNCHES 1
#include <hip/hip_runtime.h>
#include <cstdio>
#include <cstdint>
#ifndef MK_N_LAUNCHES
#define MK_N_LAUNCHES 1
#endif
namespace pg8 {
#define PG8_LAS __attribute__((address_space(3)))
typedef unsigned short bf16_t;
typedef short bf16x8 __attribute__((ext_vector_type(8)));
typedef float f32x4 __attribute__((ext_vector_type(4)));
typedef unsigned u32x4 __attribute__((ext_vector_type(4)));
constexpr int BM = 256, BK = 64, HALF = 128, HTB = HALF * BK * 2  , STAGE_BYTES = 8 * HTB, NXCD = 8, WGM = 8;

__host__ __device__ __forceinline__ int lds_byte(int r, int c) { const int st = (r >> 4) * 2 + (c >> 5), rr = r & 15, cc = c & 31, ob = rr * 64 + cc * 2; return st * 1024 + (ob ^ (((ob >> 9) & 1) << 5)); }
__host__ __device__ __forceinline__ void stage_rc(int b, int& R, int& C) { const int st = b / 1024, sb = b % 1024, swz = sb ^ (((sb >> 9) & 1) << 5); R = (st >> 1) * 16 + swz / 64; C = (st & 1) * 32 + (swz % 64) / 2; }
__host__ __device__ __forceinline__ int perm32(int rho) { const int n = rho >> 4, i = rho & 15; return 8 * (i >> 2) + 4 * n + (i & 3); }

struct Unit { int pm, pn; };
struct Gemm { const bf16_t* A; const bf16_t* Bt; int M, N, K; };

struct StaticOrder {
    int nM, nN, nwg, G, c;
    __host__ __device__ void init(int M, int N, int G_, int c_) { nM = M / BM; nN = N / BM; nwg = nM * nN; G = G_; c = c_; }
    __host__ __device__ bool next(int i, Unit& u) const {
        const long L = (long)i * G + c; if (L >= nwg) return false;
        int wgid = (int)L; { const int q = nwg / NXCD, r = nwg % NXCD, xcd = wgid % NXCD, off = wgid / NXCD; wgid = (xcd < r ? xcd * (q + 1) : r * (q + 1) + (xcd - r) * q) + off; }
        const int nig = WGM * nN, gid = wgid / nig, fm = gid * WGM, gsz = (nM - fm) < WGM ? (nM - fm) : WGM;
        u.pm = fm + ((wgid % nig) % gsz); u.pn = (wgid % nig) / gsz; return true;
    }
    __device__ __forceinline__ void a_ready(const Unit&) const {}
    __device__ __forceinline__ void done(const Unit&) const {}
};

typedef float f32x2p __attribute__((ext_vector_type(2))); typedef __bf16 bf16x2p __attribute__((ext_vector_type(2)));
__device__ __forceinline__ unsigned cvt_pk_bf16(float lo, float hi) { f32x2p v = {lo, hi}; bf16x2p b = __builtin_convertvector(v, bf16x2p); return __builtin_bit_cast(unsigned, b); }
template <class Epi, class Sched, bool ALIGN_EPI = false, bool SP2 = false>
__device__ __forceinline__ void gemm_phase(PG8_LAS unsigned char* lds, const Gemm g, const Sched& S, const Epi& E) {
    const int tid = threadIdx.x, wid = __builtin_amdgcn_readfirstlane(tid >> 6), lane = tid & 63, wr = wid >> 2, wc = wid & 3, fr = lane & 15, fq = lane >> 4;
    const int K = g.K, nt = K / BK;
    unsigned voffA[2], voffB[2];
#pragma unroll
    for (int i = 0; i < 2; ++i) { int R, C; stage_rc(tid * 16 + i * 8192, R, C); const int Rb = Epi::PERM ? ((R & ~31) + perm32(R & 31)) : R;
        voffA[i] = (unsigned)(R * K + C) * 2u; voffB[i] = (unsigned)(Rb * K + C) * 2u; }
    const size_t kstep = (size_t)(BK * 2);
    const size_t hstep = (size_t)HALF * K * 2;
    const size_t tstep = 2 * hstep;
    const unsigned ldsw = (unsigned)wid * 1024u;
    const int aoff = lds_byte(wr * 64 + fr, fq * 8), boff = lds_byte(wc * 32 + fr, fq * 8);
#define PG8_SA(b, h) (((b) * 2 + (h)) * HTB)
#define PG8_SB(b, h) ((4 + (b) * 2 + (h)) * HTB)
#define PG8_STAGE(bufoff, gbase, voff) do { _Pragma("unroll") for (int _i = 0; _i < 2; ++_i) \
        __builtin_amdgcn_global_load_lds((const unsigned*)((const char*)(gbase) + (voff)[_i]), (PG8_LAS unsigned*)(lds + (bufoff) + ldsw + _i * 8192), 16, 0, 0); } while (0)
#define PG8_LDA(dst, b, h) do { _Pragma("unroll") for (int m = 0; m < 4; ++m) _Pragma("unroll") for (int k = 0; k < 2; ++k) dst[m][k] = *(const PG8_LAS bf16x8*)(lds + PG8_SA(b, h) + aoff + m * 2048 + k * 1024); } while (0)
#define PG8_LDB(dst, b, h) do { _Pragma("unroll") for (int n = 0; n < 2; ++n) _Pragma("unroll") for (int k = 0; k < 2; ++k) dst[n][k] = *(const PG8_LAS bf16x8*)(lds + PG8_SB(b, h) + boff + n * 2048 + k * 1024); } while (0)
#define PG8_MMA(ai, bj, At, Bt) do { __builtin_amdgcn_s_setprio(1); _Pragma("unroll") for (int m = 0; m < 4; ++m) _Pragma("unroll") for (int n = 0; n < 2; ++n) _Pragma("unroll") for (int k = 0; k < 2; ++k) \
        acc[ai][bj][m][n] = __builtin_amdgcn_mfma_f32_16x16x32_bf16(Bt[n][k], At[m][k], acc[ai][bj][m][n], 0, 0, 0); __builtin_amdgcn_s_setprio(0); } while (0)
#define PG8_WAIT_V(n) asm volatile("s_waitcnt vmcnt(" #n ")" ::: "memory")
#define PG8_WAIT_L(n) asm volatile("s_waitcnt lgkmcnt(" #n ")" ::: "memory")
#define PG8_BAR __builtin_amdgcn_s_barrier()
#define PG8_SCHED __builtin_amdgcn_sched_barrier(0)
    Unit cur, nxt; int ui = 0;
    if (!S.next(0, cur)) return;
    f32x4 acc[2][2][4][2];
#pragma unroll
    for (int a = 0; a < 2; ++a)
#pragma unroll
        for (int b = 0; b < 2; ++b)
#pragma unroll
            for (int m = 0; m < 4; ++m)
#pragma unroll
                for (int n = 0; n < 2; ++n) acc[a][b][m][n] = (f32x4){0.f, 0.f, 0.f, 0.f};
    bf16x8 At[4][2], B0[2][2], B1[2][2];
    const char* cA = (const char*)g.A + (size_t)cur.pm * tstep; const char* cB = (const char*)g.Bt + (size_t)cur.pn * tstep;
    S.a_ready(cur);
    if constexpr (SP2) {
        PG8_STAGE(PG8_SB(0, 0), cB, voffB); PG8_STAGE(PG8_SB(0, 1), cB + hstep, voffB); PG8_STAGE(PG8_SA(0, 0), cA, voffA); PG8_STAGE(PG8_SA(0, 1), cA + hstep, voffA);
        if (wr == 1) PG8_BAR;
        PG8_WAIT_V(2); PG8_BAR;
        PG8_STAGE(PG8_SB(1, 0), cB + kstep, voffB); PG8_STAGE(PG8_SA(1, 0), cA + kstep, voffA); PG8_STAGE(PG8_SB(1, 1), cB + hstep + kstep, voffB);
        PG8_WAIT_V(6); PG8_BAR;
    } else {
        PG8_STAGE(PG8_SB(0, 0), cB, voffB); PG8_STAGE(PG8_SA(0, 0), cA, voffA); PG8_STAGE(PG8_SB(0, 1), cB + hstep, voffB); PG8_STAGE(PG8_SA(0, 1), cA + hstep, voffA);
        if (wr == 1) PG8_BAR;
        PG8_WAIT_V(4); PG8_BAR;
        PG8_STAGE(PG8_SB(1, 0), cB + kstep, voffB); PG8_STAGE(PG8_SA(1, 0), cA + kstep, voffA); PG8_STAGE(PG8_SB(1, 1), cB + hstep + kstep, voffB);
        PG8_WAIT_V(6); PG8_BAR;
    }
    for (;;) {
        const bool has_next = S.next(ui + 1, nxt);
        const char* nA = has_next ? (const char*)g.A + (size_t)nxt.pm * tstep : cA; const char* nB = has_next ? (const char*)g.Bt + (size_t)nxt.pn * tstep : cB;
        for (int t = 0; t < nt; t += 2) {
            const bool last = (t == nt - 2);
            const char* a1 = cA + (size_t)(t + 1) * kstep;
            const char* a2 = last ? nA : cA + (size_t)(t + 2) * kstep; const char* b2 = last ? nB : cB + (size_t)(t + 2) * kstep;
            const char* a3 = a2 + kstep; const char* b3 = b2 + kstep;
            if (last && has_next) S.a_ready(nxt);
            if constexpr (SP2) {
            PG8_LDB(B0, 0, 0); PG8_LDB(B1, 0, 1); PG8_SCHED; PG8_LDA(At, 0, 0); PG8_STAGE(PG8_SA(1, 1), a1 + hstep, voffA);
            PG8_WAIT_V(8); PG8_WAIT_L(0); PG8_BAR; PG8_MMA(0, 0, At, B0); PG8_MMA(0, 1, At, B1); PG8_BAR; PG8_SCHED;
            PG8_LDA(At, 0, 1); PG8_STAGE(PG8_SB(0, 0), b2, voffB); PG8_STAGE(PG8_SB(0, 1), b2 + hstep, voffB); PG8_STAGE(PG8_SA(0, 0), a2, voffA);
            PG8_WAIT_V(8); PG8_WAIT_L(0); PG8_BAR; PG8_MMA(1, 0, At, B0); PG8_MMA(1, 1, At, B1); PG8_BAR; PG8_SCHED;
            PG8_LDB(B0, 1, 0); PG8_LDB(B1, 1, 1); PG8_SCHED; PG8_LDA(At, 1, 0); PG8_STAGE(PG8_SA(0, 1), a2 + hstep, voffA);
            PG8_WAIT_V(8); PG8_WAIT_L(0); PG8_BAR; PG8_MMA(0, 0, At, B0); PG8_MMA(0, 1, At, B1); PG8_BAR; PG8_SCHED;
            PG8_LDA(At, 1, 1); PG8_STAGE(PG8_SB(1, 0), b3, voffB); PG8_STAGE(PG8_SB(1, 1), b3 + hstep, voffB); PG8_STAGE(PG8_SA(1, 0), a3, voffA);
            PG8_WAIT_V(8); PG8_WAIT_L(0); PG8_BAR; PG8_MMA(1, 0, At, B0); PG8_MMA(1, 1, At, B1); PG8_BAR; PG8_SCHED;
            } else {
            PG8_LDB(B0, 0, 0); PG8_SCHED; PG8_LDA(At, 0, 0); PG8_STAGE(PG8_SA(1, 1), a1 + hstep, voffA);
            PG8_WAIT_L(8); PG8_BAR; PG8_WAIT_L(0); PG8_MMA(0, 0, At, B0); PG8_BAR; PG8_SCHED;
            PG8_LDB(B1, 0, 1); PG8_STAGE(PG8_SB(0, 0), b2, voffB);
            PG8_BAR; PG8_WAIT_L(0); PG8_MMA(0, 1, At, B1); PG8_BAR;
            PG8_LDA(At, 0, 1); PG8_STAGE(PG8_SA(0, 0), a2, voffA);
            PG8_BAR; PG8_WAIT_L(0); PG8_MMA(1, 0, At, B0); PG8_BAR; PG8_SCHED;
            PG8_STAGE(PG8_SB(0, 1), b2 + hstep, voffB);
            PG8_WAIT_V(6); PG8_BAR; PG8_MMA(1, 1, At, B1); PG8_BAR;
            PG8_LDB(B0, 1, 0); PG8_SCHED; PG8_LDA(At, 1, 0); PG8_STAGE(PG8_SA(0, 1), a2 + hstep, voffA);
            PG8_WAIT_L(8); PG8_BAR; PG8_WAIT_L(0); PG8_MMA(0, 0, At, B0); PG8_BAR; PG8_SCHED;
            PG8_LDB(B1, 1, 1); PG8_STAGE(PG8_SB(1, 0), b3, voffB);
            PG8_BAR; PG8_WAIT_L(0); PG8_MMA(0, 1, At, B1); PG8_BAR;
            PG8_LDA(At, 1, 1); PG8_STAGE(PG8_SA(1, 0), a3, voffA);
            PG8_BAR; PG8_WAIT_L(0); PG8_MMA(1, 0, At, B0); PG8_BAR; PG8_SCHED;
            PG8_STAGE(PG8_SB(1, 1), b3 + hstep, voffB);
            PG8_WAIT_V(6); PG8_BAR; PG8_MMA(1, 1, At, B1); PG8_BAR;
            }
        }
        if constexpr (ALIGN_EPI) { if (wr == 0) PG8_BAR; }
        if constexpr (!Epi::AFTER_DRAIN) { E(acc, cur, wr, wc, fr, fq); S.done(cur); }
        if (!has_next) break;
#pragma unroll
        for (int a = 0; a < 2; ++a)
#pragma unroll
            for (int b = 0; b < 2; ++b)
#pragma unroll
                for (int m = 0; m < 4; ++m)
#pragma unroll
                    for (int n = 0; n < 2; ++n) acc[a][b][m][n] = (f32x4){0.f, 0.f, 0.f, 0.f};
        cur = nxt; cA = nA; cB = nB; ++ui;
        if constexpr (ALIGN_EPI) { if (wr == 1) PG8_BAR; }
    }
    PG8_WAIT_V(0);
    if constexpr (!ALIGN_EPI) { if (wr == 0) PG8_BAR; }
    PG8_BAR;
    if constexpr (Epi::AFTER_DRAIN) { E.fused(acc, cur, wr, wc, fr, fq, lds, wid, lane); S.done(cur); }
#undef PG8_SA
#undef PG8_SB
#undef PG8_STAGE
#undef PG8_LDA
#undef PG8_LDB
#undef PG8_MMA
#undef PG8_WAIT_V
#undef PG8_WAIT_L
#undef PG8_BAR
#undef PG8_SCHED
}
}

#define LAS __attribute__((address_space(3)))
typedef unsigned short bf16;
typedef short bf16x8 __attribute__((ext_vector_type(8)));
typedef float f32x4 __attribute__((ext_vector_type(4)));
typedef float f32x16 __attribute__((ext_vector_type(16)));
typedef unsigned u32x4 __attribute__((ext_vector_type(4)));
typedef unsigned u32x2 __attribute__((ext_vector_type(2)));

constexpr int DM = 1024, NBATCH = 4, SEQ = 4096, MP = NBATCH * SEQ, SBATCH = 128, STOK = 4, MS = SBATCH * STOK, MR = MP + MS;
constexpr int PASTL = 2048, PAGE = 128, NPG = 16;
constexpr int LS = 2112, LSW = 576;
constexpr int NPAD = 5632;
constexpr float C2 = 0.125f * 1.4426950408889634f;
constexpr int NWAVES = 8;

constexpr size_t O_YP = 0, O_YS = 16777216, O_NSAP = 17301504, O_DSAP = 25690112, O_IDXP = 29884416, O_WINP = 30932992,
                 O_NSAS = 31457280, O_DSAS = 31719424, O_IDXS = 31850496, O_WINS = 31883264, O_END = 48660480;

constexpr size_t MiB = 1u << 20;
constexpr size_t WS_CTL = 0, CTL_ZERO_BYTES = 1 * MiB;
constexpr size_t WS_MOD = 1 * MiB;
constexpr size_t WS_COS = 3 * MiB, WS_SIN = 4 * MiB;
constexpr size_t WS_BIAS1 = 5 * MiB;
constexpr size_t WS_W2T = 5 * MiB + 65536;
constexpr size_t WS_W1T = 6 * MiB;
constexpr size_t WS_WINT = 8 * MiB;
constexpr size_t WS_WUPN = 20 * MiB, WS_WUPD = 21 * MiB, WS_WOUT = 22 * MiB;
constexpr size_t WS_SELM = 960 * MiB;
constexpr size_t WS_GATES = 25 * MiB;
constexpr size_t WS_IW = 27 * MiB;
constexpr size_t WS_PCK = 28 * MiB, WS_PCVT = 28 * MiB + 262144;
constexpr size_t WS_SCK = 29 * MiB, WS_SCVT = 33 * MiB;
constexpr size_t WS_H = 40 * MiB;
constexpr size_t WS_QRAW = 80 * MiB, WS_QROT = 100 * MiB, WS_DQ = 120 * MiB, WS_IQ = 140 * MiB, WS_ZN = 150 * MiB, WS_ZD = 170 * MiB, WS_ONZ = 190 * MiB, WS_ODZ = 210 * MiB;
constexpr size_t WS_MG = 230 * MiB;
constexpr size_t WS_T1 = 300 * MiB;
constexpr size_t WS_M1 = 370 * MiB;
constexpr size_t WS_PCMPK = 410 * MiB, WS_PCMPV = 414 * MiB, WS_PSLCK = 418 * MiB, WS_PSLCVT = 422 * MiB, WS_PWINK = 426 * MiB, WS_PWINVT = 430 * MiB,
                 WS_PDSAK = 434 * MiB, WS_PDSAVT = 438 * MiB, WS_PIDXK = 442 * MiB;
constexpr size_t WS_SCMPK = 450 * MiB, WS_SCMPV = 520 * MiB, WS_SSLCK = 590 * MiB, WS_SSLCVT = 660 * MiB, WS_SDSAK = 730 * MiB, WS_SDSAVT = 800 * MiB,
                 WS_SWINK = 870 * MiB, WS_SWINVT = 890 * MiB, WS_SIDXK = 910 * MiB, WS_END = 970 * MiB;
constexpr int CW_BAR = 4096;
constexpr int CW_Q = 16384;

constexpr int RING_BYTES = 131072, MISC_OFF = RING_BYTES, LDS_BYTES = 147456;

struct Args { const void* in[20]; float* out; unsigned char* ws; int ph_lo, ph_hi; };

struct Frame {
    LAS unsigned char* lds; volatile LAS unsigned* MISC; unsigned* ctl;
    int tid, lane, wave, G;
    unsigned char* ws; float* out;
    const float *xp, *xs, *cnsa, *cdsa, *cidx, *swin; const int* ptab; const float *cp, *cs, *normg, *wada, *bada, *win, *pe, *w1, *w2, *wupn, *wupd, *wout, *fing;
};
#define WSP(T, off) ((T*)(F.ws + (off)))

#define LDS_WAIT() asm volatile("s_waitcnt lgkmcnt(0)" ::: "memory")
#define DI __device__ __forceinline__
DI float wave_sum(float v) {
#pragma unroll
    for (int o = 1; o < 64; o <<= 1) v += __shfl_xor(v, o);
    return v;
}
DI unsigned pk2(float lo, float hi) { return pg8::cvt_pk_bf16(lo, hi); }
DI float bflo(unsigned w) { return __uint_as_float(w << 16); }
DI float bfhi(unsigned w) { return __uint_as_float(w & 0xffff0000u); }
DI float bf2f(bf16 h) { return __uint_as_float((unsigned)h << 16); }
DI float silu_f(float x) { return x / (1.f + __expf(-x)); }
DI float sigm_f(float x) { return 1.f / (1.f + __expf(-x)); }
DI int pos16(int o) { return 8 * ((o >> 2) & 1) + (o & 3) + 4 * (o >> 3); }
DI int permk(int t) { return (t & ~15) | pos16(t & 15); }
DI int crow(int r, int hi) { return (r & 3) + 8 * (r >> 2) + 4 * hi; }
DI float dpp_x1(float v) { return __int_as_float(__builtin_amdgcn_update_dpp(0, __float_as_int(v), 0xB1, 0xF, 0xF, true)); }
DI float dpp_x2(float v) { return __int_as_float(__builtin_amdgcn_update_dpp(0, __float_as_int(v), 0x4E, 0xF, 0xF, true)); }
DI float half_other(float v) { return __shfl_xor(v, 32); }
DI u32x4 pack8(const float* v) { u32x4 w; w.x = pk2(v[0], v[1]); w.y = pk2(v[2], v[3]); w.z = pk2(v[4], v[5]); w.w = pk2(v[6], v[7]); return w; }
DI void st_bf8(bf16* p, const float* v) { *(u32x4*)p = pack8(v); }
DI void st_f8(float* p, const float* v) { *(f32x4*)p = (f32x4){v[0], v[1], v[2], v[3]}; *(f32x4*)(p + 4) = (f32x4){v[4], v[5], v[6], v[7]}; }
DI void st_vt8(bf16* p, size_t pitch, const float* v) {
#pragma unroll
    for (int j = 0; j < 8; ++j) p[(size_t)j * pitch] = (bf16)(pk2(v[j], 0.f) & 0xffffu);
}
#define NEGINF (-__builtin_inff())
#define MFMA32(a, b, c) __builtin_amdgcn_mfma_f32_32x32x16_bf16((a), (b), (c), 0, 0, 0)

DI int idx_key(float dot, float w) {
#pragma clang fp contract(off)
    float v = fmaxf(dot, 0.f) * w;
    v = v + dpp_x1(v);
    v = v + dpp_x2(v);
    int u = __float_as_int(v);
    u = (u == (int)0x80000000) ? 0 : u;
    return u ^ ((u >> 31) & 0x7fffffff);
}

struct EpiInProj {
    static constexpr bool PERM = true, AFTER_DRAIN = false;
    unsigned char* ws; float* out;
    DI void rope8(float* lo, float* hi, int pos, int d0) const {
        const f32x4* cp = (const f32x4*)((const float*)(ws + WS_COS) + pos * 32 + d0);
        const f32x4* sp = (const f32x4*)((const float*)(ws + WS_SIN) + pos * 32 + d0);
        const f32x4 c0 = cp[0], c1 = cp[1], s0 = sp[0], s1 = sp[1];
        const float c[8] = {c0[0], c0[1], c0[2], c0[3], c1[0], c1[1], c1[2], c1[3]}, s[8] = {s0[0], s0[1], s0[2], s0[3], s1[0], s1[1], s1[2], s1[3]};
#pragma unroll
        for (int j = 0; j < 8; ++j) { const float a = lo[j], b = hi[j]; lo[j] = a * c[j] - b * s[j]; hi[j] = b * c[j] + a * s[j]; }
    }
    DI void operator()(const pg8::f32x4 (&acc)[2][2][4][2], const pg8::Unit& u, int wr, int wc, int fr, int fq) const {
        const int hs = u.pn * 4 + wc;
        if (hs >= 86) return;
        const bool samp = u.pm >= 64;
        const int d0 = 8 * fq;
#pragma unroll
        for (int ai = 0; ai < 2; ++ai)
#pragma unroll
            for (int m = 0; m < 4; ++m) {
                const int r = u.pm * 256 + ai * 128 + wr * 64 + m * 16 + fr;
                int b, t, pos;
                if (!samp) { b = r >> 12; t = r & 4095; pos = t; } else { b = (r - MP) >> 2; t = r & 3; pos = PASTL + t; }
                float lo[8], hi[8];
#pragma unroll
                for (int n = 0; n < 2; ++n)
#pragma unroll
                    for (int j = 0; j < 4; ++j) { lo[4 * n + j] = acc[ai][0][m][n][j]; hi[4 * n + j] = acc[ai][1][m][n][j]; }
                if (hs < 8) {
                    bf16* qa = (bf16*)(ws + WS_QRAW) + (size_t)r * 512 + hs * 64 + d0;
                    bf16* qb = (bf16*)(ws + WS_QROT) + (size_t)r * 512 + hs * 64 + d0;
                    float a[8], c[8];
#pragma unroll
                    for (int j = 0; j < 8; ++j) { a[j] = lo[j] * C2; c[j] = hi[j] * C2; }
                    st_bf8(qa, a); st_bf8(qa + 32, c);
                    rope8(lo, hi, pos, d0);
#pragma unroll
                    for (int j = 0; j < 8; ++j) { a[j] = lo[j] * C2; c[j] = hi[j] * C2; }
                    st_bf8(qb, a); st_bf8(qb + 32, c);
                } else if (hs < 20) {
                    const int ty = (hs - 8) >> 1, g = (hs - 8) & 1;
                    if (ty == 2 || ty == 4) rope8(lo, hi, pos, d0);
                    const int bg = b * 2 + g;
                    if (ty < 4) {
                        float* o = out + (samp ? O_NSAS + ((size_t)(r - MP) * 8 + ty * 2 + g) * 64 : O_NSAP + ((size_t)r * 8 + ty * 2 + g) * 64) + d0;
                        st_f8(o, lo); st_f8(o + 32, hi);
                    } else {
                        const int sl = ty - 4;
                        if (samp) { float* o = out + O_WINS + (((size_t)b * 512 + 508 + t) * 4 + sl * 2 + g) * 64 + d0; st_f8(o, lo); st_f8(o + 32, hi); }
                        else if (t >= SEQ - 512) { float* o = out + O_WINP + (((size_t)b * 512 + (t - (SEQ - 512))) * 4 + sl * 2 + g) * 64 + d0; st_f8(o, lo); st_f8(o + 32, hi); }
                    }
                    if (ty == 3 || ty == 5) {
                        size_t pitch; int kp; bf16* base;
                        if (!samp) { pitch = SEQ; kp = t; base = (bf16*)(ws + (ty == 3 ? WS_PSLCVT : WS_PWINVT)); }
                        else if (ty == 3) { pitch = LS; kp = PASTL + t; base = (bf16*)(ws + WS_SSLCVT); }
                        else { pitch = LSW; kp = 512 + t; base = (bf16*)(ws + WS_SWINVT); }
                        bf16* p = base + ((size_t)bg * 64 + d0) * pitch + permk(kp);
                        st_vt8(p, pitch, lo); st_vt8(p + 32 * pitch, pitch, hi);
                    } else {
                        size_t rowi; bf16* base;
                        if (!samp) { rowi = (size_t)bg * SEQ + t; base = (bf16*)(ws + (ty == 0 ? WS_PCMPK : ty == 1 ? WS_PCMPV : ty == 2 ? WS_PSLCK : WS_PWINK)); }
                        else if (ty == 4) { rowi = (size_t)bg * LSW + 512 + t; base = (bf16*)(ws + WS_SWINK); }
                        else { rowi = (size_t)bg * LS + PASTL + t; base = (bf16*)(ws + (ty == 0 ? WS_SCMPK : ty == 1 ? WS_SCMPV : WS_SSLCK)); }
                        bf16* p = base + rowi * 64 + d0;
                        st_bf8(p, lo); st_bf8(p + 32, hi);
                    }
                } else if (hs < 28 || (hs >= 45 && hs < 53)) {
                    const int h = hs < 28 ? hs - 20 : hs - 45;
                    bf16* p = (bf16*)(ws + (hs < 28 ? WS_ZN : WS_ZD)) + (size_t)r * 512 + h * 64 + d0;
#pragma unroll
                    for (int j = 0; j < 8; ++j) { lo[j] = silu_f(lo[j]); hi[j] = silu_f(hi[j]); }
                    st_bf8(p, lo); st_bf8(p + 32, hi);
                } else if (hs < 36) {
                    rope8(lo, hi, pos, d0);
#pragma unroll
                    for (int j = 0; j < 8; ++j) { lo[j] *= C2; hi[j] *= C2; }
                    bf16* p = (bf16*)(ws + WS_DQ) + (size_t)r * 512 + (hs - 28) * 64 + d0;
                    st_bf8(p, lo); st_bf8(p + 32, hi);
                } else if (hs < 40) {
                    const int sl = (hs - 36) >> 1, g = (hs - 36) & 1, bg = b * 2 + g;
                    if (sl == 0) rope8(lo, hi, pos, d0);
                    float* o = out + (samp ? O_DSAS + ((size_t)(r - MP) * 4 + sl * 2 + g) * 64 : O_DSAP + ((size_t)r * 4 + sl * 2 + g) * 64) + d0;
                    st_f8(o, lo); st_f8(o + 32, hi);
                    if (sl == 0) {
                        bf16* p = samp ? (bf16*)(ws + WS_SDSAK) + ((size_t)bg * LS + PASTL + t) * 64 + d0 : (bf16*)(ws + WS_PDSAK) + ((size_t)bg * SEQ + t) * 64 + d0;
                        st_bf8(p, lo); st_bf8(p + 32, hi);
                    } else {
                        const size_t pitch = samp ? LS : SEQ; const int kp = samp ? PASTL + t : t;
                        bf16* p = (bf16*)(ws + (samp ? WS_SDSAVT : WS_PDSAVT)) + ((size_t)bg * 64 + d0) * pitch + permk(kp);
                        st_vt8(p, pitch, lo); st_vt8(p + 32 * pitch, pitch, hi);
                    }
                } else if (hs < 44) {
                    rope8(lo, hi, pos, d0);
                    bf16* p = (bf16*)(ws + WS_IQ) + (size_t)r * 256 + (hs - 40) * 64 + d0;
                    st_bf8(p, lo); st_bf8(p + 32, hi);
                } else if (hs == 44) {
                    rope8(lo, hi, pos, d0);
                    float* o = out + (samp ? O_IDXS + (size_t)(r - MP) * 64 : O_IDXP + (size_t)r * 64) + d0;
                    st_f8(o, lo); st_f8(o + 32, hi);
                    bf16* p = samp ? (bf16*)(ws + WS_SIDXK) + ((size_t)b * LS + PASTL + t) * 64 + d0 : (bf16*)(ws + WS_PIDXK) + (size_t)r * 64 + d0;
                    st_bf8(p, lo); st_bf8(p + 32, hi);
                } else if (hs < 85) {
                    bf16* p = (bf16*)(ws + WS_MG) + (size_t)r * 2048 + (hs - 53) * 64 + d0;
#pragma unroll
                    for (int j = 0; j < 8; ++j) { lo[j] = sigm_f(lo[j]); hi[j] = sigm_f(hi[j]); }
                    st_bf8(p, lo); st_bf8(p + 32, hi);
                } else {
                    if (fq < 3) { float* p = (float*)(ws + WS_GATES) + (size_t)r * 24 + d0;
#pragma unroll
                        for (int j = 0; j < 8; ++j) lo[j] = sigm_f(lo[j]);
                        st_f8(p, lo);
                    } else { *(f32x4*)((float*)(ws + WS_IW) + (size_t)r * 4) = (f32x4){lo[0], lo[1], lo[2], lo[3]}; }
                }
            }
    }
};
struct EpiUp1 {
    static constexpr bool PERM = true, AFTER_DRAIN = false;
    unsigned char* ws;
    DI void operator()(const pg8::f32x4 (&acc)[2][2][4][2], const pg8::Unit& u, int wr, int wc, int fr, int fq) const {
#pragma unroll
        for (int ai = 0; ai < 2; ++ai)
#pragma unroll
            for (int m = 0; m < 4; ++m) {
                const int r = u.pm * 256 + ai * 128 + wr * 64 + m * 16 + fr;
#pragma unroll
                for (int bj = 0; bj < 2; ++bj) {
                    const int c0 = u.pn * 256 + bj * 128 + wc * 32 + 8 * fq;
                    const u32x4 gw = *(const u32x4*)((const bf16*)(ws + WS_MG) + (size_t)r * 2048 + c0);
                    const f32x4 a0 = acc[ai][bj][m][0], a1 = acc[ai][bj][m][1];
                    float* o = (float*)(ws + WS_T1) + (size_t)r * 1024 + c0;
                    *(f32x4*)o = (f32x4){a0[0] * bflo(gw.x), a0[1] * bfhi(gw.x), a0[2] * bflo(gw.y), a0[3] * bfhi(gw.y)};
                    *(f32x4*)(o + 4) = (f32x4){a1[0] * bflo(gw.z), a1[1] * bfhi(gw.z), a1[2] * bflo(gw.w), a1[3] * bfhi(gw.w)};
                }
            }
    }
};
struct EpiUp2 {
    static constexpr bool PERM = true, AFTER_DRAIN = false;
    unsigned char* ws;
    DI void operator()(const pg8::f32x4 (&acc)[2][2][4][2], const pg8::Unit& u, int wr, int wc, int fr, int fq) const {
#pragma unroll
        for (int ai = 0; ai < 2; ++ai)
#pragma unroll
            for (int m = 0; m < 4; ++m) {
                const int r = u.pm * 256 + ai * 128 + wr * 64 + m * 16 + fr;
#pragma unroll
                for (int bj = 0; bj < 2; ++bj) {
                    const int c0 = u.pn * 256 + bj * 128 + wc * 32 + 8 * fq;
                    const u32x4 gw = *(const u32x4*)((const bf16*)(ws + WS_MG) + (size_t)r * 2048 + 1024 + c0);
                    const float* tp = (const float*)(ws + WS_T1) + (size_t)r * 1024 + c0;
                    const f32x4 t0 = *(const f32x4*)tp, t1 = *(const f32x4*)(tp + 4);
                    const f32x4 a0 = acc[ai][bj][m][0], a1 = acc[ai][bj][m][1];
                    u32x4 w;
                    w.x = pk2(t0[0] + a0[0] * bflo(gw.x), t0[1] + a0[1] * bfhi(gw.x)); w.y = pk2(t0[2] + a0[2] * bflo(gw.y), t0[3] + a0[3] * bfhi(gw.y));
                    w.z = pk2(t1[0] + a1[0] * bflo(gw.z), t1[1] + a1[1] * bfhi(gw.z)); w.w = pk2(t1[2] + a1[2] * bflo(gw.w), t1[3] + a1[3] * bfhi(gw.w));
                    *(u32x4*)((bf16*)(ws + WS_M1) + (size_t)r * 1024 + c0) = w;
                }
            }
    }
};
struct EpiOut {
    static constexpr bool PERM = true, AFTER_DRAIN = false;
    unsigned char* ws; float* out; const float* xp; const float* xs;
    DI void operator()(const pg8::f32x4 (&acc)[2][2][4][2], const pg8::Unit& u, int wr, int wc, int fr, int fq) const {
        const bool samp = u.pm >= 64;
#pragma unroll
        for (int ai = 0; ai < 2; ++ai)
#pragma unroll
            for (int m = 0; m < 4; ++m) {
                const int r = u.pm * 256 + ai * 128 + wr * 64 + m * 16 + fr;
                const int mrow = samp ? 4 + ((r - MP) >> 2) : (r >> 12);
                const float* xr = samp ? xs + (size_t)(r - MP) * 1024 : xp + (size_t)r * 1024;
                float* orow = samp ? out + O_YS + (size_t)(r - MP) * 1024 : out + O_YP + (size_t)r * 1024;
                const float* gr = (const float*)(ws + WS_MOD) + (size_t)mrow * 3072 + 2048;
#pragma unroll
                for (int bj = 0; bj < 2; ++bj) {
                    const int c0 = u.pn * 256 + bj * 128 + wc * 32 + 8 * fq;
#pragma unroll
                    for (int n = 0; n < 2; ++n) {
                        const f32x4 x4 = *(const f32x4*)(xr + c0 + 4 * n), g4 = *(const f32x4*)(gr + c0 + 4 * n);
                        *(f32x4*)(orow + c0 + 4 * n) = x4 + g4 * acc[ai][bj][m][n];
                    }
                }
            }
    }
};

DI int win_row(int col) {
    int hs, d;
    if (col < 1280) { hs = col >> 6; d = col & 63; }
    else if (col < 1304) { hs = 85; d = col - 1280; }
    else if (col < 2904) { const int c = col - 1304; hs = 20 + (c >> 6); d = c & 63; }
    else if (col < 2908) { hs = 85; d = 24 + (col - 2904); }
    else { const int c = col - 2908; hs = 45 + (c >> 6); d = c & 63; }
    return 256 * (hs >> 2) + 128 * (d >> 5) + 32 * (hs & 3) + (d & 31);
}
template <bool WINMAP> DI void p0_transpose_item(const float* W, int K, int N, bf16* WT, LAS float* scr, int item, int lane) {
    const int nblk = (N + 31) / 32, kb = item / nblk, nb = item % nblk, k0 = 64 * kb, n0 = 32 * nb;
    const bool nok = n0 + (lane & 31) < N;
#pragma unroll 8
    for (int i = 0; i < 32; ++i) { const int kk = 2 * i + (lane >> 5); scr[kk * 33 + (lane & 31)] = nok ? W[(size_t)(k0 + kk) * N + n0 + (lane & 31)] : 0.f; }
    LDS_WAIT();
    const int c = lane & 7;
#pragma unroll
    for (int j = 0; j < 4; ++j) { const int n = (lane >> 3) + 8 * j; const LAS float* s = scr + (8 * c) * 33 + n;
        u32x4 o; o.x = pk2(s[0 * 33], s[1 * 33]); o.y = pk2(s[2 * 33], s[3 * 33]); o.z = pk2(s[4 * 33], s[5 * 33]); o.w = pk2(s[6 * 33], s[7 * 33]);
        if (n0 + n < N) { const int row = WINMAP ? win_row(n0 + n) : (n0 + n); *(u32x4*)(WT + (size_t)row * K + k0 + 8 * c) = o; } }
    LDS_WAIT();
}
DI void p0_mod(Frame& F) {
    LAS float* wl = (LAS float*)F.lds;
    float* mod = WSP(float, WS_MOD);
    for (int cg = blockIdx.x; cg < 256; cg += F.G) {
        __syncthreads();
        for (int k = F.tid; k < 1024; k += NWAVES * 64) {
            const f32x4* src = (const f32x4*)(F.wada + (size_t)k * 3072 + cg * 12);
            LAS f32x4* dst = (LAS f32x4*)(wl + k * 12);
            dst[0] = src[0]; dst[1] = src[1]; dst[2] = src[2];
        }
        __syncthreads();
        for (int r = F.wave; r < 132; r += NWAVES) {
            const float* cr = r < 4 ? F.cp + (size_t)r * 1024 : F.cs + (size_t)(r - 4) * 1024;
            float a[12];
#pragma unroll
            for (int j = 0; j < 12; ++j) a[j] = 0.f;
#pragma unroll 4
            for (int i = 0; i < 16; ++i) {
                const int k = F.lane + 64 * i; const float s = silu_f(cr[k]);
                const LAS f32x4* wp = (const LAS f32x4*)(wl + k * 12);
                const f32x4 w0 = wp[0], w1 = wp[1], w2 = wp[2];
                a[0] += s * w0[0]; a[1] += s * w0[1]; a[2] += s * w0[2]; a[3] += s * w0[3];
                a[4] += s * w1[0]; a[5] += s * w1[1]; a[6] += s * w1[2]; a[7] += s * w1[3];
                a[8] += s * w2[0]; a[9] += s * w2[1]; a[10] += s * w2[2]; a[11] += s * w2[3];
            }
            float v = 0.f;
#pragma unroll
            for (int j = 0; j < 12; ++j) { const float sj = wave_sum(a[j]); v = (F.lane == j) ? sj : v; }
            if (F.lane < 12) mod[(size_t)r * 3072 + cg * 12 + F.lane] = v + F.bada[cg * 12 + F.lane];
        }
    }
    __syncthreads();
}
__device__ const double ROPE_INV[32] = {
    1.0, 0.7498942093324559, 0.5623413251903491, 0.4216965034285822, 0.31622776601683794, 0.23713737056616552, 0.1778279410038923, 0.1333521432163324,
    0.1, 0.07498942093324559, 0.05623413251903491, 0.04216965034285822, 0.03162277660168379, 0.023713737056616554, 0.01778279410038923, 0.01333521432163324,
    0.01, 0.007498942093324559, 0.005623413251903491, 0.004216965034285822, 0.0031622776601683794, 0.0023713737056616554, 0.0017782794100389228, 0.001333521432163324,
    0.001, 0.0007498942093324559, 0.0005623413251903491, 0.0004216965034285822, 0.00031622776601683794, 0.00023713737056616554, 0.00017782794100389227, 0.0001333521432163324};
DI void p0_rope_item(Frame& F, int item) {
    const int pos = 2 * item + (F.lane >> 5), d = F.lane & 31;
    if (pos >= 4100) return;
    const double ang = (double)pos * ROPE_INV[d];
    const double kq = __builtin_rint(ang * 0.6366197723675814);
    double r = __builtin_fma(-kq, 1.5707963267948966, ang); r = __builtin_fma(-kq, 6.123233995736766e-17, r);
    const int q = (int)kq & 3;
    const double r2 = r * r;
    const double sn = r * (1.0 + r2 * (-1.0 / 6 + r2 * (1.0 / 120 + r2 * (-1.0 / 5040 + r2 * (1.0 / 362880 + r2 * (-1.0 / 39916800 + r2 * (1.0 / 6227020800.0)))))));
    const double cs = 1.0 + r2 * (-0.5 + r2 * (1.0 / 24 + r2 * (-1.0 / 720 + r2 * (1.0 / 40320 + r2 * (-1.0 / 3628800 + r2 * (1.0 / 479001600.0 + r2 * (-1.0 / 87178291200.0)))))));
    const double c = (q == 0) ? cs : (q == 1) ? -sn : (q == 2) ? -cs : sn;
    const double s = (q == 0) ? sn : (q == 1) ? cs : (q == 2) ? -sn : -cs;
    WSP(float, WS_COS)[pos * 32 + d] = (float)c; WSP(float, WS_SIN)[pos * 32 + d] = (float)s;
}
DI void p0_cmp_small_item(Frame& F, int item) {
    if (item < 256) {
        const int slot = item >> 7, c = item & 127; float a = 0.f;
        for (int i = 0; i < 32; ++i) { const int k = F.lane + 64 * i; a += F.pe[slot * 2048 + k] * F.w1[((size_t)slot * 2048 + k) * 128 + c]; }
        a = wave_sum(a);
        if (F.lane == 0) WSP(float, WS_BIAS1)[item] = a;
    } else {
        const int it = item - 256, slot = it >> 7, e = (it & 127) >> 1, ch = it & 1;
        const int c = ch * 64 + F.lane;
        WSP(bf16, WS_W2T)[((size_t)slot * 64 + e) * 128 + permk(c)] = (bf16)(pk2(F.w2[((size_t)slot * 128 + c) * 64 + e], 0.f) & 0xffffu);
    }
}
DI void cp_k16(const float* src, size_t rs, bf16* dst, int lane) {
    const int tk = lane >> 2, dc = (lane & 3) * 16;
    const f32x4* s = (const f32x4*)(src + (size_t)tk * rs + dc);
    const f32x4 a = s[0], b = s[1], c = s[2], d = s[3];
    u32x4 w0, w1; w0.x = pk2(a[0], a[1]); w0.y = pk2(a[2], a[3]); w0.z = pk2(b[0], b[1]); w0.w = pk2(b[2], b[3]);
    w1.x = pk2(c[0], c[1]); w1.y = pk2(c[2], c[3]); w1.z = pk2(d[0], d[1]); w1.w = pk2(d[2], d[3]);
    u32x4* o = (u32x4*)(dst + (size_t)tk * 64 + dc); o[0] = w0; o[1] = w1;
}
DI void cp_vt16(const float* src, size_t rs, bf16* dst, size_t pitch, int lane) {
#pragma unroll
    for (int h = 0; h < 2; ++h) {
        float v[8];
#pragma unroll
        for (int i = 0; i < 8; ++i) v[i] = src[(size_t)((i & 3) + 8 * (i >> 2) + 4 * h) * rs + lane];
        *(u32x4*)(dst + (size_t)lane * pitch + 8 * h) = pack8(v);
    }
}
DI void p0_gather_item(Frame& F, int item) {
    const int sb = item >> 7, tg = item & 127, tk0 = tg * 16, lane = F.lane;
    const int pg = F.ptab[sb * NPG + (tk0 >> 7)], j0 = tk0 & 127;
    const float* nsa = F.cnsa + ((size_t)pg * PAGE + j0) * 512;
    const float* dsa = F.cdsa + ((size_t)pg * PAGE + j0) * 256;
    const float* idx = F.cidx + ((size_t)pg * PAGE + j0) * 64;
#pragma unroll
    for (int g = 0; g < 2; ++g) {
        const size_t bg = (size_t)sb * 2 + g;
        cp_k16(nsa + (0 * 2 + g) * 64, 512, WSP(bf16, WS_SCMPK) + (bg * LS + tk0) * 64, lane);
        cp_k16(nsa + (1 * 2 + g) * 64, 512, WSP(bf16, WS_SCMPV) + (bg * LS + tk0) * 64, lane);
        cp_k16(nsa + (2 * 2 + g) * 64, 512, WSP(bf16, WS_SSLCK) + (bg * LS + tk0) * 64, lane);
        cp_vt16(nsa + (3 * 2 + g) * 64, 512, WSP(bf16, WS_SSLCVT) + bg * 64 * LS + tk0, LS, lane);
        cp_k16(dsa + (0 * 2 + g) * 64, 256, WSP(bf16, WS_SDSAK) + (bg * LS + tk0) * 64, lane);
        cp_vt16(dsa + (1 * 2 + g) * 64, 256, WSP(bf16, WS_SDSAVT) + bg * 64 * LS + tk0, LS, lane);
    }
    cp_k16(idx, 64, WSP(bf16, WS_SIDXK) + ((size_t)sb * LS + tk0) * 64, lane);
}
DI void p0_win_item(Frame& F, int item) {
    const int sb = item >> 5, w0 = (item & 31) * 16, lane = F.lane;
    const float* st = F.swin + ((size_t)sb * 512 + w0) * 256;
#pragma unroll
    for (int g = 0; g < 2; ++g) {
        const size_t bg = (size_t)sb * 2 + g;
        cp_k16(st + (0 * 2 + g) * 64, 256, WSP(bf16, WS_SWINK) + (bg * LSW + w0) * 64, lane);
        cp_vt16(st + (1 * 2 + g) * 64, 256, WSP(bf16, WS_SWINVT) + bg * 64 * LSW + w0, LSW, lane);
    }
}
DI void p0_zero_item(Frame& F, int item) {
    const int arr = item >> 8, bg = item & 255, lane = F.lane;
    bf16* p; int n;
    if (arr == 0) { p = WSP(bf16, WS_SSLCVT) + ((size_t)bg * 64 + lane) * LS + 2052; n = 60; }
    else if (arr == 1) { p = WSP(bf16, WS_SDSAVT) + ((size_t)bg * 64 + lane) * LS + 2052; n = 60; }
    else { p = WSP(bf16, WS_SWINVT) + ((size_t)bg * 64 + lane) * LSW + 516; n = 60; }
    unsigned long long* q = (unsigned long long*)p;
    for (int i = 0; i < n / 4; ++i) q[i] = 0ull;
}
DI void p0_prologue(Frame& F) {
    p0_mod(F);
    LAS float* scr = (LAS float*)(F.lds + F.wave * 16384);
    const int gw = blockIdx.x * NWAVES + F.wave, NGW = F.G * NWAVES;
    constexpr int I_WIN = 16 * 171, I_UP = 8 * 32, I_OUT = 16 * 32, I_W1 = 32 * 4;
    constexpr int T0 = I_WIN, T1 = T0 + I_UP, T2 = T1 + I_UP, T3 = T2 + I_OUT, T4 = T3 + 2 * I_W1, T5 = T4 + 2050, T6 = T5 + 512, T7 = T6 + 768, T8 = T7 + SBATCH * 32, T9 = T8 + SBATCH * 128;
#ifdef ORACLE
    constexpr int TEND = T9;
#else
    constexpr int TEND = T7;
#endif
    for (int it = gw; it < TEND; it += NGW) {
        if (it < T0) p0_transpose_item<true>(F.win, 1024, 5468, WSP(bf16, WS_WINT), scr, it, F.lane);
        else if (it < T1) p0_transpose_item<false>(F.wupn, 512, 1024, WSP(bf16, WS_WUPN), scr, it - T0, F.lane);
        else if (it < T2) p0_transpose_item<false>(F.wupd, 512, 1024, WSP(bf16, WS_WUPD), scr, it - T1, F.lane);
        else if (it < T3) p0_transpose_item<false>(F.wout, 1024, 1024, WSP(bf16, WS_WOUT), scr, it - T2, F.lane);
        else if (it < T4) { const int q = it - T3, slot = q / I_W1; p0_transpose_item<false>(F.w1 + (size_t)slot * 2048 * 128, 2048, 128, WSP(bf16, WS_W1T) + (size_t)slot * 128 * 2048, scr, q % I_W1, F.lane); }
        else if (it < T5) p0_rope_item(F, it - T4);
        else if (it < T6) p0_cmp_small_item(F, it - T5);
        else if (it < T7) p0_zero_item(F, it - T6);
#ifdef ORACLE
        else if (it < T8) p0_win_item(F, it - T7);
        else p0_gather_item(F, it - T8);
#endif
    }
    const size_t tot4 = (size_t)SBATCH * 508 * 64;
    for (size_t i = (size_t)blockIdx.x * 512 + F.tid; i < tot4; i += (size_t)F.G * 512) {
        const size_t sb = i / (508 * 64), rem = i % (508 * 64);
        ((f32x4*)(F.out + O_WINS))[sb * 512 * 64 + rem] = ((const f32x4*)F.swin)[sb * 512 * 64 + 4 * 64 + rem];
    }
}
DI void p1_adaln(Frame& F) {
    const int gw = blockIdx.x * NWAVES + F.wave, NGW = F.G * NWAVES;
    const float* mod = WSP(float, WS_MOD);
    for (int r = gw; r < MR; r += NGW) {
        const float* xr = r < MP ? F.xp + (size_t)r * 1024 : F.xs + (size_t)(r - MP) * 1024;
        const int mrow = r < MP ? (r >> 12) : 4 + ((r - MP) >> 2);
        const f32x4* x4 = (const f32x4*)xr + F.lane;
        f32x4 v[4]; float s = 0.f;
#pragma unroll
        for (int j = 0; j < 4; ++j) { v[j] = x4[64 * j]; s += (v[j][0] * v[j][0] + v[j][1] * v[j][1]) + (v[j][2] * v[j][2] + v[j][3] * v[j][3]); }
        const float rstd = 1.f / sqrtf(wave_sum(s) * (1.f / 1024.f) + 1e-6f);
        const f32x4* g4 = (const f32x4*)F.normg + F.lane;
        const f32x4* sh4 = (const f32x4*)(mod + (size_t)mrow * 3072) + F.lane;
        const f32x4* sc4 = (const f32x4*)(mod + (size_t)mrow * 3072 + 1024) + F.lane;
        unsigned long long* o8 = (unsigned long long*)(WSP(bf16, WS_H) + (size_t)r * 1024) + F.lane;
#pragma unroll
        for (int j = 0; j < 4; ++j) {
            const f32x4 y = v[j] * rstd * g4[64 * j]; const f32x4 h = y * (1.f + sc4[64 * j]) + sh4[64 * j];
            o8[64 * j] = (unsigned long long)pk2(h[0], h[1]) | ((unsigned long long)pk2(h[2], h[3]) << 32);
        }
    }
}
DI void p8_final(Frame& F) {
    const int gw = blockIdx.x * NWAVES + F.wave, NGW = F.G * NWAVES;
    for (int r = gw; r < MR; r += NGW) {
        float* yr = r < MP ? F.out + O_YP + (size_t)r * 1024 : F.out + O_YS + (size_t)(r - MP) * 1024;
        f32x4* y4 = (f32x4*)yr + F.lane;
        f32x4 v[4]; float s = 0.f;
#pragma unroll
        for (int j = 0; j < 4; ++j) { v[j] = y4[64 * j]; s += (v[j][0] * v[j][0] + v[j][1] * v[j][1]) + (v[j][2] * v[j][2] + v[j][3] * v[j][3]); }
        const float rstd = 1.f / sqrtf(wave_sum(s) * (1.f / 1024.f) + 1e-6f);
        const f32x4* g4 = (const f32x4*)F.fing + F.lane;
#pragma unroll
        for (int j = 0; j < 4; ++j) y4[64 * j] = v[j] * rstd * g4[64 * j];
    }
}

constexpr int TP = 144;
constexpr int TILE_B = 64 * TP;
struct LdsT {
    const LAS unsigned char* p;
    DI bf16x8 frag(int mt, int s) const { return *(const LAS bf16x8*)(p + mt * 32 * TP + s * 32); }
};
struct GlbT {
    const bf16* base; unsigned off; unsigned pitch;
    DI bf16x8 frag(int mt, int s) const { return *(const bf16x8*)(base + (size_t)(off + (unsigned)mt * 32u * pitch + (unsigned)s * 16u)); }
};
template <class KT> DI void qk_tile(f32x16& s0, f32x16& s1, const KT& kt, const bf16x8 (&q)[4]) {
    f32x16 z;
#pragma unroll
    for (int i = 0; i < 16; ++i) z[i] = 0.f;
    s0 = z; s1 = z;
#pragma unroll
    for (int s = 0; s < 4; ++s) { s0 = MFMA32(kt.frag(0, s), q[s], s0); s1 = MFMA32(kt.frag(1, s), q[s], s1); }
}
DI bf16x8 cvt8(f32x4 a, f32x4 b) { u32x4 w; w.x = pk2(a[0], a[1]); w.y = pk2(a[2], a[3]); w.z = pk2(b[0], b[1]); w.w = pk2(b[2], b[3]); return __builtin_bit_cast(bf16x8, w); }
DI bf16x8 pack_p(const f32x16& x, int h) {
    u32x4 w; w.x = pk2(x[8 * h], x[8 * h + 1]); w.y = pk2(x[8 * h + 2], x[8 * h + 3]); w.z = pk2(x[8 * h + 4], x[8 * h + 5]); w.w = pk2(x[8 * h + 6], x[8 * h + 7]);
    return __builtin_bit_cast(bf16x8, w);
}
template <class VT> DI void pv_tile(f32x16& o0, f32x16& o1, const f32x16& p0, const f32x16& p1, const VT& vt) {
    const bf16x8 b0 = pack_p(p0, 0), b1 = pack_p(p0, 1), b2 = pack_p(p1, 0), b3 = pack_p(p1, 1);
    o0 = MFMA32(vt.frag(0, 0), b0, o0); o1 = MFMA32(vt.frag(1, 0), b0, o1);
    o0 = MFMA32(vt.frag(0, 1), b1, o0); o1 = MFMA32(vt.frag(1, 1), b1, o1);
    o0 = MFMA32(vt.frag(0, 2), b2, o0); o1 = MFMA32(vt.frag(1, 2), b2, o1);
    o0 = MFMA32(vt.frag(0, 3), b3, o0); o1 = MFMA32(vt.frag(1, 3), b3, o1);
}
struct Soft { float m, l; bool seen; f32x16 o0, o1, negm; };
DI void soft_init(Soft& S) {
    S.m = 0.f; S.l = 0.f; S.seen = false;
#pragma unroll
    for (int i = 0; i < 16; ++i) { S.o0[i] = 0.f; S.o1[i] = 0.f; S.negm[i] = 0.f; }
}
template <class KT> DI void qk_tile_c(f32x16& s0, f32x16& s1, const KT& kt, const bf16x8 (&q)[4], const f32x16& c) {
    s0 = MFMA32(kt.frag(0, 0), q[0], c); s1 = MFMA32(kt.frag(1, 0), q[0], c);
#pragma unroll
    for (int s = 1; s < 4; ++s) { s0 = MFMA32(kt.frag(0, s), q[s], s0); s1 = MFMA32(kt.frag(1, s), q[s], s1); }
}
template <class VT> DI void soft_step(Soft& S, f32x16& s0, f32x16& s1, const VT& vt) {
    float mx = fmaxf(s0[0], s1[0]);
#pragma unroll
    for (int r = 1; r < 16; ++r) mx = fmaxf(mx, fmaxf(s0[r], s1[r]));
    mx = fmaxf(mx, half_other(mx));
    const bool fin = mx > NEGINF;
    const bool need = (mx > 8.f) | (fin & !S.seen);
    if (__any(need)) {
        const float dl = need ? mx : 0.f;
        const float al = S.seen ? __builtin_amdgcn_exp2f(-dl) : 0.f;
        S.m += dl; S.l *= need ? al : 1.f;
        const float am = need ? al : 1.f;
#pragma unroll
        for (int r = 0; r < 16; ++r) { s0[r] -= dl; s1[r] -= dl; S.o0[r] *= am; S.o1[r] *= am; S.negm[r] = -S.m; }
    }
    S.seen = S.seen | fin;
    float ps = 0.f;
#pragma unroll
    for (int r = 0; r < 16; ++r) { s0[r] = __builtin_amdgcn_exp2f(s0[r]); s1[r] = __builtin_amdgcn_exp2f(s1[r]); ps += s0[r] + s1[r]; }
    S.l += ps;
    pv_tile(S.o0, S.o1, s0, s1, vt);
}
DI float as_f(int x) { return __int_as_float(x); }
DI float mask_sel(float s, int mm) { return __int_as_float((__float_as_int(s) & mm) | ((int)0xff800000 & ~mm)); }
DI u32x4 tile_ld(const bf16* g, size_t pitch, int tid) { return *(const u32x4*)(g + (size_t)(tid >> 3) * pitch + (tid & 7) * 8); }
DI void tile_st(LAS unsigned char* buf, u32x4 v, int tid) { *(LAS u32x4*)(buf + (tid >> 3) * TP + (tid & 7) * 16) = v; }

constexpr int CP = 272;
DI void compress_unit(Frame& F, int u) {
    const int tid = F.tid, lane = F.lane, w = F.wave, l31 = lane & 31, hi = lane >> 5;
    const int slot = u / 136, rem = u % 136;
    const bf16* data; bf16 *ock, *ocvt; int n0, ncmp, cpitch;
    if (rem < 8) { const int bg = rem; data = WSP(bf16, (slot ? WS_PCMPV : WS_PCMPK)) + (size_t)bg * SEQ * 64; n0 = 32 * w; ncmp = 255; cpitch = 256;
        ock = WSP(bf16, WS_PCK) + (size_t)bg * 256 * 64; ocvt = WSP(bf16, WS_PCVT) + (size_t)bg * 64 * 256; }
    else { const int bg = 2 * (rem - 8) + (w >> 2); data = WSP(bf16, (slot ? WS_SCMPV : WS_SCMPK)) + (size_t)bg * LS * 64; n0 = 32 * (w & 3); ncmp = 127; cpitch = 128;
        ock = WSP(bf16, WS_SCK) + (size_t)bg * 128 * 64; ocvt = WSP(bf16, WS_SCVT) + (size_t)bg * 64 * 128; }
    const int n = n0 + l31, nc = n < ncmp ? n : ncmp - 1;
    const bf16* drow = data + (size_t)nc * 1024 + 8 * hi;
    const bool paged = rem >= 8;
    const float *prA = nullptr, *prB = nullptr; int jsplit = 64;
    if (paged) { const int bg = 2 * (rem - 8) + (w >> 2), sb = bg >> 1, g = bg & 1, t0 = 16 * nc;
        const int pgA = F.ptab[sb * NPG + (t0 >> 7)], pgB = F.ptab[sb * NPG + ((t0 + 31) >> 7)];
        jsplit = 128 - (t0 & 127);
        prA = F.cnsa + ((size_t)pgA * PAGE + (t0 & 127)) * 512 + (slot * 2 + g) * 64 + 8 * hi;
        prB = F.cnsa + ((size_t)pgB * PAGE) * 512 + (slot * 2 + g) * 64 + 8 * hi - (size_t)jsplit * 512;
    }
    const bf16* w1t = WSP(bf16, WS_W1T) + (size_t)slot * 128 * 2048;
    f32x16 acc[4];
#pragma unroll
    for (int c = 0; c < 4; ++c)
#pragma unroll
        for (int i = 0; i < 16; ++i) acc[c][i] = 0.f;
    const bf16* wsrc = w1t + (size_t)(tid >> 2) * 2048 + (tid & 3) * 32;
    LAS unsigned char* wdst = F.lds + (tid >> 2) * CP + (tid & 3) * 64;
    u32x4 st[4];
#pragma unroll
    for (int i = 0; i < 4; ++i) st[i] = ((const u32x4*)wsrc)[i];
#pragma unroll
    for (int i = 0; i < 4; ++i) ((LAS u32x4*)wdst)[i] = st[i];
    __syncthreads();
    for (int kc = 0; kc < 16; ++kc) {
        const LAS unsigned char* buf = F.lds + (kc & 1) * (128 * CP);
        if (kc + 1 < 16) {
#pragma unroll
            for (int i = 0; i < 4; ++i) st[i] = ((const u32x4*)(wsrc + (kc + 1) * 128))[i];
        }
        bf16x8 bq[8];
        if (!paged) {
#pragma unroll
            for (int s = 0; s < 8; ++s) bq[s] = *(const bf16x8*)(drow + kc * 128 + s * 16);
        } else {
#pragma unroll
            for (int s = 0; s < 8; ++s) { const int j = 2 * kc + (s >> 2); const f32x4* q = (const f32x4*)((j < jsplit ? prA : prB) + (size_t)j * 512 + 16 * (s & 3)); bq[s] = cvt8(q[0], q[1]); }
        }
#pragma unroll
        for (int s = 0; s < 8; ++s)
#pragma unroll
            for (int c = 0; c < 4; ++c) acc[c] = MFMA32(*(const LAS bf16x8*)(buf + (32 * c + l31) * CP + s * 32 + hi * 16), bq[s], acc[c]);
        if (kc + 1 < 16) {
            LAS unsigned char* nb = wdst + ((kc + 1) & 1) * (128 * CP);
#pragma unroll
            for (int i = 0; i < 4; ++i) ((LAS u32x4*)nb)[i] = st[i];
        }
        __syncthreads();
    }
    const float* b1 = WSP(float, WS_BIAS1) + slot * 128;
#pragma unroll
    for (int c = 0; c < 4; ++c)
#pragma unroll
        for (int q = 0; q < 4; ++q) { const f32x4 bv = *(const f32x4*)(b1 + 32 * c + 8 * q + 4 * hi);
#pragma unroll
            for (int j = 0; j < 4; ++j) acc[c][4 * q + j] = silu_f(acc[c][4 * q + j] + bv[j]); }
    const bf16* w2t = WSP(bf16, WS_W2T) + (size_t)slot * 64 * 128 + (size_t)l31 * 128 + 8 * hi;
    f32x16 o0, o1;
#pragma unroll
    for (int i = 0; i < 16; ++i) { o0[i] = 0.f; o1[i] = 0.f; }
#pragma unroll
    for (int c = 0; c < 4; ++c)
#pragma unroll
        for (int h = 0; h < 2; ++h) { const bf16x8 hb = pack_p(acc[c], h); const int s2 = 2 * c + h;
            o0 = MFMA32(*(const bf16x8*)(w2t + s2 * 16), hb, o0); o1 = MFMA32(*(const bf16x8*)(w2t + 32 * 128 + s2 * 16), hb, o1); }
    const bool ok = n < ncmp;
    if (slot == 0) {
#pragma unroll
        for (int e = 0; e < 2; ++e)
#pragma unroll
            for (int q = 0; q < 4; ++q) { const f32x16& o = e ? o1 : o0; u32x2 wv;
                wv.x = ok ? pk2(o[4 * q], o[4 * q + 1]) : 0u; wv.y = ok ? pk2(o[4 * q + 2], o[4 * q + 3]) : 0u;
                *(u32x2*)(ock + (size_t)n * 64 + 32 * e + 8 * q + 4 * hi) = wv; }
    } else {
        const int pn = permk(n);
#pragma unroll
        for (int e = 0; e < 2; ++e)
#pragma unroll
            for (int r = 0; r < 16; ++r) { const f32x16& o = e ? o1 : o0; ocvt[(size_t)(32 * e + crow(r, hi)) * cpitch + pn] = ok ? (bf16)(pk2(o[r], 0.f) & 0xffffu) : (bf16)0; }
    }
}

template <bool SAMPLE> DI void idx1_unit(Frame& F, int u) {
    const int lane = F.lane, w = F.wave, l31 = lane & 31, hi = lane >> 5, tl = l31 >> 2, hl = l31 & 3;
    int row0, nkmax, ntok; const bf16* ik;
    if (!SAMPLE) { const int b = u & 3, tc = 511 - (u >> 2); row0 = b * SEQ + 8 * tc; nkmax = 8 * tc + 8; ntok = 8; ik = WSP(bf16, WS_PIDXK) + (size_t)b * SEQ * 64; }
    else { row0 = MP + 4 * u; nkmax = PASTL + 4; ntok = 4; ik = WSP(bf16, WS_SIDXK) + (size_t)u * LS * 64; }
    const int rowq = row0 + (SAMPLE ? (tl & 3) : tl);
    bf16x8 q[4];
#pragma unroll
    for (int s = 0; s < 4; ++s) q[s] = *(const bf16x8*)(WSP(bf16, WS_IQ) + (size_t)rowq * 256 + hl * 64 + 16 * s + 8 * hi);
    const float wgt = WSP(float, WS_IW)[(size_t)rowq * 4 + hl];
    LAS int* sc = (LAS int*)F.lds;
    const int n32 = (nkmax + 31) >> 5;
    for (int kt = w; kt < n32; kt += NWAVES) {
        const bf16* kp = ik + (size_t)(32 * kt + l31) * 64 + 8 * hi;
        f32x16 a;
#pragma unroll
        for (int i = 0; i < 16; ++i) a[i] = 0.f;
        if (SAMPLE && kt < 64) {
            const int pg = F.ptab[u * NPG + (kt >> 2)];
            const float* fp = F.cidx + ((size_t)pg * PAGE + (kt & 3) * 32 + l31) * 64 + 8 * hi;
#pragma unroll
            for (int s = 0; s < 4; ++s) { const f32x4* q4 = (const f32x4*)(fp + 16 * s); a = MFMA32(cvt8(q4[0], q4[1]), q[s], a); }
        } else {
#pragma unroll
            for (int s = 0; s < 4; ++s) a = MFMA32(*(const bf16x8*)(kp + 16 * s), q[s], a);
        }
#pragma unroll
        for (int r = 0; r < 16; ++r) { const int key = idx_key(a[r], wgt); if (hl == 0) sc[tl * 4096 + 32 * kt + crow(r, hi)] = key; }
    }
    __syncthreads();
    if (w < ntok) {
        const int n = SAMPLE ? (PASTL + 1 + w) : (row0 - (row0 & ~(SEQ - 1)) + w + 1);
        int k[64];
        int kmin = 0x7fffffff, kmax = (int)0x80000000;
#pragma unroll
        for (int i = 0; i < 64; ++i) { const bool v = 64 * i + lane < n; const int x = v ? sc[w * 4096 + 64 * i + lane] : (int)0x80000000; k[i] = x; kmin = v ? (x < kmin ? x : kmin) : kmin; kmax = x > kmax ? x : kmax; }
        int thr = (int)0x80000000, cut = -1;
        if (n > 256) {
#pragma unroll
            for (int o = 1; o < 64; o <<= 1) { const int a = __shfl_xor(kmin, o), b = __shfl_xor(kmax, o); kmin = a < kmin ? a : kmin; kmax = b > kmax ? b : kmax; }
            int lo = __builtin_amdgcn_readfirstlane(kmin) - 1, hiv = __builtin_amdgcn_readfirstlane(kmax);
            bool found = false;
            while ((unsigned)hiv - (unsigned)lo > 1u) {
                const int mid = (int)((unsigned)lo + (((unsigned)hiv - (unsigned)lo) >> 1));
                int c = 0;
#pragma unroll
                for (int i = 0; i < 64; ++i) c += __popcll(__ballot(k[i] > mid));
                if (c == 256) { thr = mid; found = true; break; }
                if (c > 256) lo = mid; else hiv = mid;
            }
            if (!found) {
                thr = hiv; int cgt = 0;
#pragma unroll
                for (int i = 0; i < 64; ++i) cgt += __popcll(__ballot(k[i] > thr));
                const int need = 256 - cgt; int acc = 0; bool done = false;
#pragma unroll
                for (int i = 0; i < 64; ++i) {
                    unsigned long long mk = __ballot(k[i] == thr); const int pc = __popcll(mk);
                    if (!done && acc + pc >= need) { for (int q2 = 1; q2 < need - acc; ++q2) mk &= mk - 1; cut = 64 * i + (int)__builtin_ctzll(mk); done = true; }
                    acc += pc;
                }
            }
        }
        unsigned long long myw = 0ull;
#pragma unroll
        for (int i = 0; i < 64; ++i) { const unsigned long long mk = __ballot((k[i] > thr) | ((k[i] == thr) & (64 * i + lane <= cut))); myw = (lane == i) ? mk : myw; }
        WSP(unsigned long long, WS_SELM)[(size_t)(row0 + w) * 64 + lane] = myw;
    }
    __syncthreads();
}

constexpr int NSA_PS = 2 * 2 * TILE_B;
constexpr int NSA_WS = 8192 + 2048 + 64;
#define PIN4(q) asm volatile("" : "+v"(q[0]), "+v"(q[1]), "+v"(q[2]), "+v"(q[3]))
template <bool SAMPLE> DI void nsa_unit(Frame& F, int u) {
    const int tid = F.tid, lane = F.lane, w = F.wave, l31 = lane & 31, hi = lane >> 5, tl = l31 >> 2, hl = l31 & 3;
    int bg, g, row, qpos, ncmp, wlo, whi, n_ctile, n_stile, w_t0, w_t1, qt = 0;
    size_t cpitch, pitch, wpitch; const bf16 *ck, *cvt, *sk, *svt, *wk, *wvt; bool wr_ok;
    if (!SAMPLE) {
        bg = u & 7; qt = 63 - (u >> 3); g = bg & 1; const int t = 64 * qt + 8 * w + tl; row = (bg >> 1) * SEQ + t; qpos = t; ncmp = 255;
        cpitch = 256; pitch = SEQ; wpitch = SEQ;
        ck = WSP(bf16, WS_PCK) + (size_t)bg * 256 * 64; cvt = WSP(bf16, WS_PCVT) + (size_t)bg * 64 * 256;
        sk = WSP(bf16, WS_PSLCK) + (size_t)bg * SEQ * 64; svt = WSP(bf16, WS_PSLCVT) + (size_t)bg * 64 * SEQ;
        wk = WSP(bf16, WS_PWINK) + (size_t)bg * SEQ * 64; wvt = WSP(bf16, WS_PWINVT) + (size_t)bg * 64 * SEQ;
        wlo = qpos - 511; whi = qpos; n_ctile = (4 * qt + 2) / 64 + 1; n_stile = qt + 1; w_t0 = qt > 8 ? qt - 8 : 0; w_t1 = qt; wr_ok = true;
    } else {
        bg = u * 8 + w; g = bg & 1; const int i = tl & 3; row = MP + (bg >> 1) * 4 + i; qpos = PASTL + i; ncmp = 127;
        cpitch = 128; pitch = LS; wpitch = LSW;
        ck = WSP(bf16, WS_SCK) + (size_t)bg * 128 * 64; cvt = WSP(bf16, WS_SCVT) + (size_t)bg * 64 * 128;
        sk = WSP(bf16, WS_SSLCK) + (size_t)bg * LS * 64; svt = WSP(bf16, WS_SSLCVT) + (size_t)bg * 64 * LS;
        wk = WSP(bf16, WS_SWINK) + (size_t)bg * LSW * 64; wvt = WSP(bf16, WS_SWINVT) + (size_t)bg * 64 * LSW;
        wlo = 1 + i; whi = 512 + i; n_ctile = 2; n_stile = 33; w_t0 = 0; w_t1 = 8; wr_ok = tl < 4;
    }
    const int hq = 4 * g + hl;
    bf16x8 qraw[4], qrot[4];
#pragma unroll
    for (int s = 0; s < 4; ++s) qraw[s] = *(const bf16x8*)(WSP(bf16, WS_QRAW) + (size_t)row * 512 + hq * 64 + 16 * s + 8 * hi);
    LAS unsigned char* const lb = F.lds;
    LAS float* psum = (LAS float*)(lb + NSA_PS + w * NSA_WS);
    LAS float* impb = (LAS float*)(lb + NSA_PS + w * NSA_WS + 8192);
    LAS unsigned char* selb = lb + NSA_PS + w * NSA_WS + 8192 + 2048;
    const int fo = l31 * TP + hi * 16;
    f32x16 res0, res1;
    const float* gp = WSP(float, WS_GATES) + (size_t)row * 24 + hq * 3;
    float g0 = gp[0], g1 = gp[1], g2 = gp[2];
    PIN4(qraw); asm volatile("" : "+v"(g0), "+v"(g1), "+v"(g2));
    f32x16 s0, s1;
    u32x4 rk, rv;
    Soft S;

    const int nvr = (qpos - 31) >> 4, nvis = nvr < ncmp - 1 ? nvr : ncmp - 1;
    float m = -1e30f, l = 0.f;
    if (!SAMPLE) { rk = tile_ld(ck, 64, tid); rv = tile_ld(cvt, cpitch, tid); tile_st(lb, rk, tid); tile_st(lb + TILE_B, rv, tid); __syncthreads(); }
    for (int ct = 0; ct < n_ctile; ++ct) {
        if (!SAMPLE) { if (ct + 1 < n_ctile) { rk = tile_ld(ck + (size_t)(ct + 1) * 64 * 64, 64, tid); rv = tile_ld(cvt + (ct + 1) * 64, cpitch, tid); } }
        if (!SAMPLE) { LdsT kt{lb + (ct & 1) * 2 * TILE_B + fo}; qk_tile(s0, s1, kt, qraw); }
        else { GlbT kt{ck, (unsigned)((64 * ct + l31) * 64 + 8 * hi), 64u}; qk_tile(s0, s1, kt, qraw); }
        float mx = -1e30f;
        const int nv2 = nvis - 64 * ct - 4 * hi;
#pragma unroll
        for (int r = 0; r < 16; ++r) { const int cr = (r & 3) + 8 * (r >> 2); s0[r] = cr <= nv2 ? s0[r] : NEGINF; s1[r] = cr + 32 <= nv2 ? s1[r] : NEGINF; mx = fmaxf(mx, fmaxf(s0[r], s1[r])); }
        mx = fmaxf(mx, half_other(mx));
        const float mn = fmaxf(m, mx); float ps = 0.f;
#pragma unroll
        for (int r = 0; r < 16; ++r) ps += __builtin_amdgcn_exp2f(s0[r] - mn) + __builtin_amdgcn_exp2f(s1[r] - mn);
        l = l * __builtin_amdgcn_exp2f(m - mn) + ps; m = mn;
        if (!SAMPLE) { if (ct + 1 < n_ctile) { tile_st(lb + ((ct + 1) & 1) * 2 * TILE_B, rk, tid); tile_st(lb + ((ct + 1) & 1) * 2 * TILE_B + TILE_B, rv, tid); } __syncthreads(); }
    }
    l += half_other(l);
    const float linv = l > 0.f ? 1.f / l : 0.f;
    soft_init(S);
    if (!SAMPLE) { rk = tile_ld(ck, 64, tid); rv = tile_ld(cvt, cpitch, tid); tile_st(lb, rk, tid); tile_st(lb + TILE_B, rv, tid); __syncthreads(); }
    for (int ct = 0; ct < n_ctile; ++ct) {
        if (!SAMPLE) { if (ct + 1 < n_ctile) { rk = tile_ld(ck + (size_t)(ct + 1) * 64 * 64, 64, tid); rv = tile_ld(cvt + (ct + 1) * 64, cpitch, tid); } }
        if (!SAMPLE) { LdsT kt{lb + (ct & 1) * 2 * TILE_B + fo}; qk_tile(s0, s1, kt, qraw); }
        else { GlbT kt{ck, (unsigned)((64 * ct + l31) * 64 + 8 * hi), 64u}; qk_tile(s0, s1, kt, qraw); }
        const int nv2 = nvis - 64 * ct - 4 * hi; LAS float* pw = psum + tl * 256 + 64 * ct + 4 * hi;
#pragma unroll
        for (int r = 0; r < 16; ++r) { const int cr = (r & 3) + 8 * (r >> 2);
            s0[r] = cr <= nv2 ? __builtin_amdgcn_exp2f(s0[r] - m) * linv : 0.f; s1[r] = cr + 32 <= nv2 ? __builtin_amdgcn_exp2f(s1[r] - m) * linv : 0.f;
            float a = s0[r]; a += dpp_x1(a); a += dpp_x2(a); float b = s1[r]; b += dpp_x1(b); b += dpp_x2(b);
            if (hl == 0) { pw[cr] = a; pw[cr + 32] = b; } }
        if (!SAMPLE) { LdsT vt{lb + (ct & 1) * 2 * TILE_B + TILE_B + fo}; pv_tile(S.o0, S.o1, s0, s1, vt); }
        else { GlbT vt{cvt, (unsigned)(l31 * (int)cpitch + 64 * ct + 8 * hi), (unsigned)cpitch}; pv_tile(S.o0, S.o1, s0, s1, vt); }
        if (!SAMPLE) { if (ct + 1 < n_ctile) { tile_st(lb + ((ct + 1) & 1) * 2 * TILE_B, rk, tid); tile_st(lb + ((ct + 1) & 1) * 2 * TILE_B + TILE_B, rv, tid); } __syncthreads(); }
    }
#pragma unroll
    for (int i = 0; i < 16; ++i) { res0[i] = g0 * S.o0[i]; res1[i] = g0 * S.o1[i]; }
    LDS_WAIT();
    unsigned mlo, mhi;
    {
        const int tk = lane >> 3, jb = 8 * (lane & 7);
        const int qp = SAMPLE ? PASTL + (tk & 3) : 64 * qt + 8 * w + tk, cur = qp >> 6;
        float pv[33];
        const LAS f32x4* pp = (const LAS f32x4*)(psum + tk * 256 + 4 * jb);
#pragma unroll
        for (int i = 0; i < 8; ++i) { const f32x4 x = pp[i]; pv[1 + 4 * i] = x[0]; pv[2 + 4 * i] = x[1]; pv[3 + 4 * i] = x[2]; pv[4 + 4 * i] = x[3]; }
        pv[0] = jb > 0 ? psum[tk * 256 + 4 * jb - 1] : 0.f;
        float v[8];
#pragma unroll
        for (int jj = 0; jj < 8; ++jj) {
            const int j = jb + jj;
            float a = pv[4 * jj] + pv[4 * jj + 1] + pv[4 * jj + 2] + pv[4 * jj + 3];
            a += (4 * j + 3 < ncmp) ? pv[4 * jj + 4] : 0.f;
            a = ((j == 0) | (j == cur) | (j == cur - 1)) ? 1e4f : a;
            a = (j > cur) ? -1e30f : a;
            v[jj] = a;
        }
        LAS f32x4* ip = (LAS f32x4*)(impb + tk * 64 + jb);
        ip[0] = (f32x4){v[0], v[1], v[2], v[3]}; ip[1] = (f32x4){v[4], v[5], v[6], v[7]};
        LDS_WAIT();
        int cnt[8];
#pragma unroll
        for (int jj = 0; jj < 8; ++jj) cnt[jj] = 0;
        const LAS f32x4* ap = (const LAS f32x4*)(impb + tk * 64);
#pragma unroll 1
        for (int i4 = 0; i4 < 16; ++i4) {
            const f32x4 x = ap[i4];
#pragma unroll
            for (int e = 0; e < 4; ++e) { const int i = 4 * i4 + e; const float xi = x[e];
#pragma unroll
                for (int jj = 0; jj < 8; ++jj) cnt[jj] += ((xi > v[jj]) | ((xi == v[jj]) & (i < jb + jj))) ? 1 : 0; }
        }
        unsigned bits = 0;
#pragma unroll
        for (int jj = 0; jj < 8; ++jj) bits |= ((cnt[jj] < 16) & (jb + jj <= cur)) ? (1u << jj) : 0u;
        selb[tk * 8 + (lane & 7)] = (unsigned char)bits;
        LDS_WAIT();
        const LAS unsigned* sp = (const LAS unsigned*)(selb + tl * 8);
        mlo = sp[0]; mhi = sp[1];
    }
#pragma unroll
    for (int s = 0; s < 4; ++s) qrot[s] = *(const bf16x8*)(WSP(bf16, WS_QROT) + (size_t)row * 512 + hq * 64 + 16 * s + 8 * hi);
    PIN4(qrot);
    soft_init(S);
    const int qrel = (qpos & 63) - 4 * hi;
    if (!SAMPLE) { rk = tile_ld(sk, 64, tid); rv = tile_ld(svt, pitch, tid); tile_st(lb, rk, tid); tile_st(lb + TILE_B, rv, tid); __syncthreads(); }
    for (int j = 0; j < n_stile; ++j) {
        if (!SAMPLE) { if (j + 1 < n_stile) { rk = tile_ld(sk + (size_t)(j + 1) * 64 * 64, 64, tid); rv = tile_ld(svt + (j + 1) * 64, pitch, tid); } }
        const bool bsel = ((j < 32 ? (mlo >> j) : (mhi >> (j - 32))) & 1u) != 0u;
        if (!SAMPLE) { LdsT kt{lb + (j & 1) * 2 * TILE_B + fo}; qk_tile_c(s0, s1, kt, qrot, S.negm); }
        else { GlbT kt{sk, (unsigned)((64 * j + l31) * 64 + 8 * hi), 64u}; qk_tile_c(s0, s1, kt, qrot, S.negm); }
        if (j == n_stile - 1) {
#pragma unroll
            for (int r = 0; r < 16; ++r) { const int cr = (r & 3) + 8 * (r >> 2); s0[r] = cr <= qrel ? s0[r] : NEGINF; s1[r] = cr + 32 <= qrel ? s1[r] : NEGINF; }
        } else {
#pragma unroll
            for (int r = 0; r < 16; ++r) { s0[r] = bsel ? s0[r] : NEGINF; s1[r] = bsel ? s1[r] : NEGINF; }
        }
        if (!SAMPLE) { LdsT vt{lb + (j & 1) * 2 * TILE_B + TILE_B + fo}; soft_step(S, s0, s1, vt); }
        else { GlbT vt{svt, (unsigned)(l31 * (int)pitch + 64 * j + 8 * hi), (unsigned)pitch}; soft_step(S, s0, s1, vt); }
        if (!SAMPLE) { if (j + 1 < n_stile) { tile_st(lb + ((j + 1) & 1) * 2 * TILE_B, rk, tid); tile_st(lb + ((j + 1) & 1) * 2 * TILE_B + TILE_B, rv, tid); } __syncthreads(); }
    }
    S.l += half_other(S.l);
    { const float sc = g1 / fmaxf(S.l, 1e-30f);
#pragma unroll
      for (int i = 0; i < 16; ++i) { res0[i] += sc * S.o0[i]; res1[i] += sc * S.o1[i]; } }
    soft_init(S);
    if (!SAMPLE) { rk = tile_ld(wk + (size_t)w_t0 * 64 * 64, 64, tid); rv = tile_ld(wvt + w_t0 * 64, wpitch, tid); tile_st(lb, rk, tid); tile_st(lb + TILE_B, rv, tid); __syncthreads(); }
    for (int j = w_t0; j <= w_t1; ++j) {
        const int jr = j - w_t0;
        if (!SAMPLE) { if (j + 1 <= w_t1) { rk = tile_ld(wk + (size_t)(j + 1) * 64 * 64, 64, tid); rv = tile_ld(wvt + (j + 1) * 64, wpitch, tid); } }
        if (!SAMPLE) { LdsT kt{lb + (jr & 1) * 2 * TILE_B + fo}; qk_tile_c(s0, s1, kt, qrot, S.negm); }
        else { GlbT kt{wk, (unsigned)((64 * j + l31) * 64 + 8 * hi), 64u}; qk_tile_c(s0, s1, kt, qrot, S.negm); }
        if ((j == w_t0) | (j == w_t1)) {
            const int lo_r = wlo - 64 * j - 4 * hi, hi_r = whi - 64 * j - 4 * hi;
#pragma unroll
            for (int r = 0; r < 16; ++r) { const int k0 = (r & 3) + 8 * (r >> 2); s0[r] = ((k0 >= lo_r) & (k0 <= hi_r)) ? s0[r] : NEGINF; s1[r] = ((k0 + 32 >= lo_r) & (k0 + 32 <= hi_r)) ? s1[r] : NEGINF; }
        }
        if (!SAMPLE) { LdsT vt{lb + (jr & 1) * 2 * TILE_B + TILE_B + fo}; soft_step(S, s0, s1, vt); }
        else { GlbT vt{wvt, (unsigned)(l31 * (int)wpitch + 64 * j + 8 * hi), (unsigned)wpitch}; soft_step(S, s0, s1, vt); }
        if (!SAMPLE) { if (j + 1 <= w_t1) { tile_st(lb + ((jr + 1) & 1) * 2 * TILE_B, rk, tid); tile_st(lb + ((jr + 1) & 1) * 2 * TILE_B + TILE_B, rv, tid); } __syncthreads(); }
    }
    S.l += half_other(S.l);
#ifdef BREAK_WIN
    S.l *= 1.1f;
#endif
    { const float sc = g2 / fmaxf(S.l, 1e-30f);
#pragma unroll
      for (int i = 0; i < 16; ++i) { res0[i] += sc * S.o0[i]; res1[i] += sc * S.o1[i]; } }
    if (wr_ok) {
        const bf16* zp = WSP(bf16, WS_ZN) + (size_t)row * 512 + hq * 64 + 4 * hi;
        bf16* op = WSP(bf16, WS_ONZ) + (size_t)row * 512 + hq * 64 + 4 * hi;
#pragma unroll
        for (int e = 0; e < 2; ++e)
#pragma unroll
            for (int q = 0; q < 4; ++q) { const f32x16& o = e ? res1 : res0; const u32x2 z = *(const u32x2*)(zp + 32 * e + 8 * q);
                u32x2 wv; wv.x = pk2(o[4 * q] * bflo(z.x), o[4 * q + 1] * bfhi(z.x)); wv.y = pk2(o[4 * q + 2] * bflo(z.y), o[4 * q + 3] * bfhi(z.y));
                *(u32x2*)(op + 32 * e + 8 * q) = wv; }
    }
}

template <bool SAMPLE> DI void dsa_unit(Frame& F, int u) {
    const int tid = F.tid, lane = F.lane, w = F.wave, l31 = lane & 31, hi = lane >> 5, tl = l31 >> 2, hl = l31 & 3;
    int bg, g, row, nt; size_t pitch; const bf16 *dk, *dvt; bool wr_ok;
    if (!SAMPLE) { bg = u & 7; const int qt = 63 - (u >> 3); g = bg & 1; const int t = 64 * qt + 8 * w + tl; row = (bg >> 1) * SEQ + t; nt = qt + 1; pitch = SEQ;
        dk = WSP(bf16, WS_PDSAK) + (size_t)bg * SEQ * 64; dvt = WSP(bf16, WS_PDSAVT) + (size_t)bg * 64 * SEQ; wr_ok = true; }
    else { bg = u * 8 + w; g = bg & 1; const int i = tl & 3; row = MP + (bg >> 1) * 4 + i; nt = 33; pitch = LS;
        dk = WSP(bf16, WS_SDSAK) + (size_t)bg * LS * 64; dvt = WSP(bf16, WS_SDSAVT) + (size_t)bg * 64 * LS; wr_ok = tl < 4; }
    const int hq = 4 * g + hl;
    bf16x8 dq[4];
#pragma unroll
    for (int s = 0; s < 4; ++s) dq[s] = *(const bf16x8*)(WSP(bf16, WS_DQ) + (size_t)row * 512 + hq * 64 + 16 * s + 8 * hi);
    const unsigned long long* selp = WSP(unsigned long long, WS_SELM) + (size_t)row * 64;
    unsigned long long selw = selp[0];
    PIN4(dq); asm volatile("" : "+v"(selw));
    LAS unsigned char* const lb = F.lds;
    const int fo = l31 * TP + hi * 16;
    f32x16 s0, s1;
    u32x4 rk, rv;
    Soft S; soft_init(S);
    if (!SAMPLE) { rk = tile_ld(dk, 64, tid); rv = tile_ld(dvt, pitch, tid); tile_st(lb, rk, tid); tile_st(lb + TILE_B, rv, tid); __syncthreads(); }
    for (int j = 0; j < nt; ++j) {
        unsigned long long seln = 0ull;
        if (!SAMPLE) { if (j + 1 < nt) { rk = tile_ld(dk + (size_t)(j + 1) * 64 * 64, 64, tid); rv = tile_ld(dvt + (j + 1) * 64, pitch, tid); } }
        if (j + 1 < nt) seln = selp[j + 1];
        if (!SAMPLE) { LdsT kt{lb + (j & 1) * 2 * TILE_B + fo}; qk_tile_c(s0, s1, kt, dq, S.negm); }
        else { GlbT kt{dk, (unsigned)((64 * j + l31) * 64 + 8 * hi), 64u}; qk_tile_c(s0, s1, kt, dq, S.negm); }
#ifdef BREAK_DSA
        selw |= 0x1111111111111111ull;
#endif
        const unsigned wa = (unsigned)selw >> (4 * hi), wb = (unsigned)(selw >> 32) >> (4 * hi);
#pragma unroll
        for (int r = 0; r < 16; ++r) { const int bp = (r & 3) + 8 * (r >> 2);
            s0[r] = mask_sel(s0[r], (int)(wa << (31 - bp)) >> 31); s1[r] = mask_sel(s1[r], (int)(wb << (31 - bp)) >> 31); }
        if (!SAMPLE) { LdsT vt{lb + (j & 1) * 2 * TILE_B + TILE_B + fo}; soft_step(S, s0, s1, vt); }
        else { GlbT vt{dvt, (unsigned)(l31 * (int)pitch + 64 * j + 8 * hi), (unsigned)pitch}; soft_step(S, s0, s1, vt); }
        selw = seln;
        if (!SAMPLE) { if (j + 1 < nt) { LAS unsigned char* nb = lb + ((j + 1) & 1) * 2 * TILE_B; tile_st(nb, rk, tid); tile_st(nb + TILE_B, rv, tid); } __syncthreads(); }
    }
    S.l += half_other(S.l);
    if (wr_ok) {
        const float sc = 1.f / fmaxf(S.l, 1e-30f);
        const bf16* zp = WSP(bf16, WS_ZD) + (size_t)row * 512 + hq * 64 + 4 * hi;
        bf16* op = WSP(bf16, WS_ODZ) + (size_t)row * 512 + hq * 64 + 4 * hi;
#pragma unroll
        for (int e = 0; e < 2; ++e)
#pragma unroll
            for (int q = 0; q < 4; ++q) { const f32x16& o = e ? S.o1 : S.o0; const u32x2 z = *(const u32x2*)(zp + 32 * e + 8 * q);
                u32x2 wv; wv.x = pk2(o[4 * q] * sc * bflo(z.x), o[4 * q + 1] * sc * bfhi(z.x)); wv.y = pk2(o[4 * q + 2] * sc * bflo(z.y), o[4 * q + 3] * sc * bfhi(z.y));
                *(u32x2*)(op + 32 * e + 8 * q) = wv; }
    }
}

struct PageK {
    const float* p; unsigned stride;
    DI bf16x8 frag(int mt, int s) const { const f32x4* q = (const f32x4*)(p + (size_t)((unsigned)mt * 32u * stride + (unsigned)s * 16u)); return cvt8(q[0], q[1]); }
};
struct PageV {
    const float* p; unsigned stride;
    DI bf16x8 frag(int dt, int s) const {
        float v[8];
#pragma unroll
        for (int i = 0; i < 8; ++i) v[i] = p[(size_t)((unsigned)(16 * s + (i & 3) + 8 * (i >> 2)) * stride + (unsigned)dt * 32u)];
        return __builtin_bit_cast(bf16x8, pack8(v));
    }
};
constexpr int XCH_W = 34 * 64;
constexpr int XCH_BYTES = 8 * XCH_W * 4;
DI void xch_put(LAS float* x, const Soft& S, int lane) {
    const float lt = S.l + half_other(S.l);
    x[lane] = S.seen ? S.m : NEGINF; x[64 + lane] = lt;
#pragma unroll
    for (int r = 0; r < 16; ++r) { x[(2 + r) * 64 + lane] = S.o0[r]; x[(18 + r) * 64 + lane] = S.o1[r]; }
}
DI void xch_get(const LAS float* xb, int w, int lane, float (&out)[4]) {
    float mw[8], M = -1e30f;
#pragma unroll
    for (int i = 0; i < 8; ++i) { mw[i] = xb[i * XCH_W + lane]; M = fmaxf(M, mw[i]); }
    float L = 0.f, o[4] = {0.f, 0.f, 0.f, 0.f};
#pragma unroll
    for (int i = 0; i < 8; ++i) { const float wt = __builtin_amdgcn_exp2f(mw[i] - M); L += wt * xb[i * XCH_W + 64 + lane];
#pragma unroll
        for (int k = 0; k < 4; ++k) o[k] += wt * xb[i * XCH_W + (2 + 4 * w + k) * 64 + lane]; }
    const float inv = 1.f / fmaxf(L, 1e-30f);
#pragma unroll
    for (int k = 0; k < 4; ++k) out[k] = o[k] * inv;
}
DI void nsa_sample_unit(Frame& F, int bg) {
    const int lane = F.lane, w = F.wave, l31 = lane & 31, hi = lane >> 5, tl = l31 >> 2, hl = l31 & 3;
    const int sb = bg >> 1, g = bg & 1, i = tl & 3, row = MP + sb * 4 + i, qpos = PASTL + i, hq = 4 * g + hl;
    LAS unsigned char* const lb = F.lds;
    LAS float* xch = (LAS float*)lb;
    LAS float* cmpb = (LAS float*)(lb + XCH_BYTES);
    LAS unsigned* mskb = (LAS unsigned*)(lb + XCH_BYTES + 8192);
    LAS float* psum = (LAS float*)(lb + XCH_BYTES + 8192 + 64);
    LAS float* impb = psum + 8 * 256;
    LAS unsigned char* selb = (LAS unsigned char*)(impb + 8 * 64);
    const float* gp = WSP(float, WS_GATES) + (size_t)row * 24 + hq * 3;
    float g0 = gp[0], g1 = gp[1], g2 = gp[2];
    bf16x8 qrot[4];
#pragma unroll
    for (int s = 0; s < 4; ++s) qrot[s] = *(const bf16x8*)(WSP(bf16, WS_QROT) + (size_t)row * 512 + hq * 64 + 16 * s + 8 * hi);
    f32x16 s0, s1;
    Soft S;
    __syncthreads();
    if (w == 0) {
        const bf16* ck = WSP(bf16, WS_SCK) + (size_t)bg * 128 * 64; const bf16* cvt = WSP(bf16, WS_SCVT) + (size_t)bg * 64 * 128;
        bf16x8 qraw[4];
#pragma unroll
        for (int s = 0; s < 4; ++s) qraw[s] = *(const bf16x8*)(WSP(bf16, WS_QRAW) + (size_t)row * 512 + hq * 64 + 16 * s + 8 * hi);
        const int ncmp = 127, nvis = 126;
        float m = -1e30f, l = 0.f;
        for (int ct = 0; ct < 2; ++ct) {
            GlbT kt{ck, (unsigned)((64 * ct + l31) * 64 + 8 * hi), 64u}; qk_tile(s0, s1, kt, qraw);
            float mx = -1e30f; const int nv2 = nvis - 64 * ct - 4 * hi;
#pragma unroll
            for (int r = 0; r < 16; ++r) { const int cr = (r & 3) + 8 * (r >> 2); s0[r] = cr <= nv2 ? s0[r] : NEGINF; s1[r] = cr + 32 <= nv2 ? s1[r] : NEGINF; mx = fmaxf(mx, fmaxf(s0[r], s1[r])); }
            mx = fmaxf(mx, half_other(mx));
            const float mn = fmaxf(m, mx); float ps = 0.f;
#pragma unroll
            for (int r = 0; r < 16; ++r) ps += __builtin_amdgcn_exp2f(s0[r] - mn) + __builtin_amdgcn_exp2f(s1[r] - mn);
            l = l * __builtin_amdgcn_exp2f(m - mn) + ps; m = mn;
        }
        l += half_other(l);
        const float linv = l > 0.f ? 1.f / l : 0.f;
        soft_init(S);
        for (int ct = 0; ct < 2; ++ct) {
            GlbT kt{ck, (unsigned)((64 * ct + l31) * 64 + 8 * hi), 64u}; qk_tile(s0, s1, kt, qraw);
            const int nv2 = nvis - 64 * ct - 4 * hi; LAS float* pw = psum + tl * 256 + 64 * ct + 4 * hi;
#pragma unroll
            for (int r = 0; r < 16; ++r) { const int cr = (r & 3) + 8 * (r >> 2);
                s0[r] = cr <= nv2 ? __builtin_amdgcn_exp2f(s0[r] - m) * linv : 0.f; s1[r] = cr + 32 <= nv2 ? __builtin_amdgcn_exp2f(s1[r] - m) * linv : 0.f;
                float a = s0[r]; a += dpp_x1(a); a += dpp_x2(a); float b = s1[r]; b += dpp_x1(b); b += dpp_x2(b);
                if (hl == 0) { pw[cr] = a; pw[cr + 32] = b; } }
            GlbT vt{cvt, (unsigned)(l31 * 128 + 64 * ct + 8 * hi), 128u}; pv_tile(S.o0, S.o1, s0, s1, vt);
        }
#pragma unroll
        for (int r = 0; r < 16; ++r) { cmpb[r * 64 + lane] = S.o0[r]; cmpb[(16 + r) * 64 + lane] = S.o1[r]; }
        LDS_WAIT();
        {
            const int tk = lane >> 3, jb = 8 * (lane & 7), cur = 32;
            float pv[33];
            const LAS f32x4* pp = (const LAS f32x4*)(psum + tk * 256 + 4 * jb);
#pragma unroll
            for (int q = 0; q < 8; ++q) { const f32x4 x = pp[q]; pv[1 + 4 * q] = x[0]; pv[2 + 4 * q] = x[1]; pv[3 + 4 * q] = x[2]; pv[4 + 4 * q] = x[3]; }
            pv[0] = jb > 0 ? psum[tk * 256 + 4 * jb - 1] : 0.f;
            float v[8];
#pragma unroll
            for (int jj = 0; jj < 8; ++jj) { const int j = jb + jj;
                float a = pv[4 * jj] + pv[4 * jj + 1] + pv[4 * jj + 2] + pv[4 * jj + 3];
                a += (4 * j + 3 < ncmp) ? pv[4 * jj + 4] : 0.f;
                a = ((j == 0) | (j == cur) | (j == cur - 1)) ? 1e4f : a;
                a = (j > cur) ? -1e30f : a;
                v[jj] = a; }
            LAS f32x4* ip = (LAS f32x4*)(impb + tk * 64 + jb);
            ip[0] = (f32x4){v[0], v[1], v[2], v[3]}; ip[1] = (f32x4){v[4], v[5], v[6], v[7]};
            LDS_WAIT();
            int cnt[8];
#pragma unroll
            for (int jj = 0; jj < 8; ++jj) cnt[jj] = 0;
            const LAS f32x4* ap = (const LAS f32x4*)(impb + tk * 64);
#pragma unroll 1
            for (int i4 = 0; i4 < 16; ++i4) { const f32x4 x = ap[i4];
#pragma unroll
                for (int e = 0; e < 4; ++e) { const int ii = 4 * i4 + e; const float xi = x[e];
#pragma unroll
                    for (int jj = 0; jj < 8; ++jj) cnt[jj] += ((xi > v[jj]) | ((xi == v[jj]) & (ii < jb + jj))) ? 1 : 0; } }
            unsigned bits = 0;
#pragma unroll
            for (int jj = 0; jj < 8; ++jj) bits |= ((cnt[jj] < 16) & (jb + jj <= cur)) ? (1u << jj) : 0u;
            selb[tk * 8 + (lane & 7)] = (unsigned char)bits;
            LDS_WAIT();
            if (lane < 16) mskb[lane] = ((const LAS unsigned*)selb)[lane];
        }
    }
    __syncthreads();
    const unsigned mlo = mskb[tl * 2], mhi = mskb[tl * 2 + 1];
    PIN4(qrot); asm volatile("" : "+v"(g0), "+v"(g1), "+v"(g2));
    soft_init(S);
    for (int j = w; j < 32; j += NWAVES) {
        const int pg = F.ptab[sb * NPG + (j >> 1)];
        const float* base = F.cnsa + ((size_t)pg * PAGE + (j & 1) * 64) * 512 + (2 * 2 + g) * 64;
        PageK kt{base + (size_t)l31 * 512 + 8 * hi, 512u}; qk_tile_c(s0, s1, kt, qrot, S.negm);
        const bool bsel = ((mlo >> j) & 1u) != 0u;
#pragma unroll
        for (int r = 0; r < 16; ++r) { s0[r] = bsel ? s0[r] : NEGINF; s1[r] = bsel ? s1[r] : NEGINF; }
        PageV vt{base + 128 + (size_t)(4 * hi) * 512 + l31, 512u}; soft_step(S, s0, s1, vt);
    }
    if (w == 0) {
        const bf16* sk = WSP(bf16, WS_SSLCK) + (size_t)bg * LS * 64; const bf16* svt = WSP(bf16, WS_SSLCVT) + (size_t)bg * 64 * LS;
        GlbT kt{sk, (unsigned)((2048 + l31) * 64 + 8 * hi), 64u}; qk_tile_c(s0, s1, kt, qrot, S.negm);
        const int qrel = i - 4 * hi;
#pragma unroll
        for (int r = 0; r < 16; ++r) { const int cr = (r & 3) + 8 * (r >> 2); s0[r] = cr <= qrel ? s0[r] : NEGINF; s1[r] = cr + 32 <= qrel ? s1[r] : NEGINF; }
        GlbT vt{svt, (unsigned)(l31 * LS + 2048 + 8 * hi), (unsigned)LS}; soft_step(S, s0, s1, vt);
    }
    xch_put(xch + w * XCH_W, S, lane);
    __syncthreads();
    float acc[4], part[4];
    xch_get(xch, w, lane, part);
#pragma unroll
    for (int k = 0; k < 4; ++k) acc[k] = g1 * part[k] + g0 * cmpb[(4 * w + k) * 64 + lane];
    __syncthreads();
    soft_init(S);
    {
        const float* base = F.swin + ((size_t)sb * 512 + 64 * w) * 256 + g * 64;
        PageK kt{base + (size_t)l31 * 256 + 8 * hi, 256u}; qk_tile_c(s0, s1, kt, qrot, S.negm);
        if (w == 0) {
            const int lo_r = 1 + i - 4 * hi;
#pragma unroll
            for (int r = 0; r < 16; ++r) { const int k0 = (r & 3) + 8 * (r >> 2); s0[r] = k0 >= lo_r ? s0[r] : NEGINF; s1[r] = k0 + 32 >= lo_r ? s1[r] : NEGINF; }
        }
        PageV vt{base + 128 + (size_t)(4 * hi) * 256 + l31, 256u}; soft_step(S, s0, s1, vt);
    }
    if (w == 0) {
        const bf16* wk = WSP(bf16, WS_SWINK) + (size_t)bg * LSW * 64; const bf16* wvt = WSP(bf16, WS_SWINVT) + (size_t)bg * 64 * LSW;
        GlbT kt{wk, (unsigned)((512 + l31) * 64 + 8 * hi), 64u}; qk_tile_c(s0, s1, kt, qrot, S.negm);
        const int hi_r = i - 4 * hi;
#pragma unroll
        for (int r = 0; r < 16; ++r) { const int k0 = (r & 3) + 8 * (r >> 2); s0[r] = k0 <= hi_r ? s0[r] : NEGINF; s1[r] = k0 + 32 <= hi_r ? s1[r] : NEGINF; }
        GlbT vt{wvt, (unsigned)(l31 * LSW + 512 + 8 * hi), (unsigned)LSW}; soft_step(S, s0, s1, vt);
    }
    xch_put(xch + w * XCH_W, S, lane);
    __syncthreads();
    xch_get(xch, w, lane, part);
#ifdef BREAK_WIN
#pragma unroll
    for (int k = 0; k < 4; ++k) part[k] *= 0.9f;
#endif
    if (tl < 4) {
        const int d0 = 32 * (w >> 2) + 8 * (w & 3) + 4 * hi;
        const u32x2 z = *(const u32x2*)(WSP(bf16, WS_ZN) + (size_t)row * 512 + hq * 64 + d0);
        u32x2 wv; wv.x = pk2((acc[0] + g2 * part[0]) * bflo(z.x), (acc[1] + g2 * part[1]) * bfhi(z.x)); wv.y = pk2((acc[2] + g2 * part[2]) * bflo(z.y), (acc[3] + g2 * part[3]) * bfhi(z.y));
        *(u32x2*)(WSP(bf16, WS_ONZ) + (size_t)row * 512 + hq * 64 + d0) = wv;
    }
}
DI void dsa_sample_unit(Frame& F, int bg) {
    const int lane = F.lane, w = F.wave, l31 = lane & 31, hi = lane >> 5, tl = l31 >> 2, hl = l31 & 3;
    const int sb = bg >> 1, g = bg & 1, i = tl & 3, row = MP + sb * 4 + i, hq = 4 * g + hl;
    LAS float* xch = (LAS float*)F.lds;
    bf16x8 dq[4];
#pragma unroll
    for (int s = 0; s < 4; ++s) dq[s] = *(const bf16x8*)(WSP(bf16, WS_DQ) + (size_t)row * 512 + hq * 64 + 16 * s + 8 * hi);
    const unsigned long long* selp = WSP(unsigned long long, WS_SELM) + (size_t)row * 64;
    PIN4(dq);
    f32x16 s0, s1;
    Soft S; soft_init(S);
    for (int j = w; j < 32; j += NWAVES) {
        unsigned long long selw = selp[j];
        const int pg = F.ptab[sb * NPG + (j >> 1)];
        const float* base = F.cdsa + ((size_t)pg * PAGE + (j & 1) * 64) * 256 + g * 64;
        PageK kt{base + (size_t)l31 * 256 + 8 * hi, 256u}; qk_tile_c(s0, s1, kt, dq, S.negm);
#ifdef BREAK_DSA
        selw |= 0x1111111111111111ull;
#endif
        const unsigned wa = (unsigned)selw >> (4 * hi), wb = (unsigned)(selw >> 32) >> (4 * hi);
#pragma unroll
        for (int r = 0; r < 16; ++r) { const int bp = (r & 3) + 8 * (r >> 2);
            s0[r] = mask_sel(s0[r], (int)(wa << (31 - bp)) >> 31); s1[r] = mask_sel(s1[r], (int)(wb << (31 - bp)) >> 31); }
        PageV vt{base + 128 + (size_t)(4 * hi) * 256 + l31, 256u}; soft_step(S, s0, s1, vt);
    }
    if (w == 0) {
        const unsigned long long selw = selp[32];
        const bf16* dk = WSP(bf16, WS_SDSAK) + (size_t)bg * LS * 64; const bf16* dvt = WSP(bf16, WS_SDSAVT) + (size_t)bg * 64 * LS;
        GlbT kt{dk, (unsigned)((2048 + l31) * 64 + 8 * hi), 64u}; qk_tile_c(s0, s1, kt, dq, S.negm);
        const unsigned wa = (unsigned)selw >> (4 * hi), wb = (unsigned)(selw >> 32) >> (4 * hi);
#pragma unroll
        for (int r = 0; r < 16; ++r) { const int bp = (r & 3) + 8 * (r >> 2);
            s0[r] = mask_sel(s0[r], (int)(wa << (31 - bp)) >> 31); s1[r] = mask_sel(s1[r], (int)(wb << (31 - bp)) >> 31); }
        GlbT vt{dvt, (unsigned)(l31 * LS + 2048 + 8 * hi), (unsigned)LS}; soft_step(S, s0, s1, vt);
    }
    __syncthreads();
    xch_put(xch + w * XCH_W, S, lane);
    __syncthreads();
    float part[4];
    xch_get(xch, w, lane, part);
    if (tl < 4) {
        const int d0 = 32 * (w >> 2) + 8 * (w & 3) + 4 * hi;
        const u32x2 z = *(const u32x2*)(WSP(bf16, WS_ZD) + (size_t)row * 512 + hq * 64 + d0);
        u32x2 wv; wv.x = pk2(part[0] * bflo(z.x), part[1] * bfhi(z.x)); wv.y = pk2(part[2] * bflo(z.y), part[3] * bfhi(z.y));
        *(u32x2*)(WSP(bf16, WS_ODZ) + (size_t)row * 512 + hq * 64 + d0) = wv;
    }
}

#ifdef ORACLE
constexpr size_t WS_ORC = 948 * MiB;
constexpr int ORC_ROWS = 128;
DI float blk_red(Frame& F, float v, bool ismax, LAS float* red) {
#pragma unroll
    for (int o = 1; o < 64; o <<= 1) { const float x = __shfl_xor(v, o); v = ismax ? fmaxf(v, x) : v + x; }
    __syncthreads();
    if (F.lane == 0) red[F.wave] = v;
    __syncthreads();
    float r = red[0];
    for (int i = 1; i < 8; ++i) r = ismax ? fmaxf(r, red[i]) : r + red[i];
    return r;
}
DI float dot64(const bf16* a, const bf16* b) { float s = 0.f; for (int d = 0; d < 64; ++d) s += bf2f(a[d]) * bf2f(b[d]); return s; }
DI void orc_softmax(Frame& F, LAS float* sc, LAS unsigned char* vf, int n, LAS float* red) {
    float mx = -3e38f;
    for (int k = F.tid; k < n; k += 512) if (vf[k]) mx = fmaxf(mx, sc[k]);
    mx = blk_red(F, mx, true, red);
    float sm = 0.f;
    for (int k = F.tid; k < n; k += 512) { const float p = vf[k] ? exp2f(sc[k] - mx) : 0.f; sc[k] = p; sm += p; }
    sm = blk_red(F, sm, false, red);
    const float inv = 1.f / fmaxf(sm, 1e-30f);
    for (int k = F.tid; k < n; k += 512) sc[k] *= inv;
    __syncthreads();
}
DI void oracle_row(Frame& F, int oi) {
    int row;
    if (oi < 96) { const int tl[24] = {0, 1, 30, 31, 32, 63, 64, 65, 127, 128, 255, 256, 257, 400, 511, 512, 513, 1000, 1023, 1024, 2047, 2500, 3583, 4095};
        int t = 0;
#pragma unroll
        for (int i = 0; i < 24; ++i) t = (oi % 24 == i) ? tl[i] : t;
        row = (oi / 24) * SEQ + t; }
    else { const int k = oi - 96; row = MP + (((k >> 2) * 37) % SBATCH) * 4 + (k & 3); }
    const bool samp = row >= MP;
    const int b = samp ? (row - MP) >> 2 : row >> 12, ti = samp ? (row & 3) : (row & 4095), qpos = samp ? PASTL + ti : ti;
    const int ncmp = samp ? 127 : 255; const size_t pitch = samp ? LS : SEQ, wpitch = samp ? LSW : SEQ, cpitch = samp ? 128 : 256;
    const int wlo = samp ? 1 + ti : (qpos - 511 > 0 ? qpos - 511 : 0), whi = samp ? 512 + ti : qpos;
    LAS float* sc = (LAS float*)F.lds;
    LAS float* s2 = sc + 4096;
    LAS float* psum = s2 + 4096;
    LAS float* imp = psum + 256;
    LAS float* resn = imp + 64;
    LAS float* resd = resn + 512;
    LAS float* red = resd + 512;
    LAS unsigned char* vf = (LAS unsigned char*)(red + 8);
    LAS unsigned char* selb = vf + 4096;
    const bf16* qraw = WSP(bf16, WS_QRAW) + (size_t)row * 512; const bf16* qrot = WSP(bf16, WS_QROT) + (size_t)row * 512;
    const bf16* dq = WSP(bf16, WS_DQ) + (size_t)row * 512; const bf16* iq = WSP(bf16, WS_IQ) + (size_t)row * 256;
    const float* gat = WSP(float, WS_GATES) + (size_t)row * 24; const float* iw = WSP(float, WS_IW) + (size_t)row * 4;
    const int nvr = (qpos - 31) >> 4, nvis = nvr < ncmp - 1 ? nvr : ncmp - 1, cur = qpos >> 6;
    for (int g = 0; g < 2; ++g) {
        const int bg = b * 2 + g;
        const bf16* ck = samp ? WSP(bf16, WS_SCK) + (size_t)bg * 128 * 64 : WSP(bf16, WS_PCK) + (size_t)bg * 256 * 64;
        const bf16* cvt = samp ? WSP(bf16, WS_SCVT) + (size_t)bg * 64 * 128 : WSP(bf16, WS_PCVT) + (size_t)bg * 64 * 256;
        const bf16* sk = samp ? WSP(bf16, WS_SSLCK) + (size_t)bg * LS * 64 : WSP(bf16, WS_PSLCK) + (size_t)bg * SEQ * 64;
        const bf16* svt = samp ? WSP(bf16, WS_SSLCVT) + (size_t)bg * 64 * LS : WSP(bf16, WS_PSLCVT) + (size_t)bg * 64 * SEQ;
        const bf16* wk = samp ? WSP(bf16, WS_SWINK) + (size_t)bg * LSW * 64 : WSP(bf16, WS_PWINK) + (size_t)bg * SEQ * 64;
        const bf16* wvt = samp ? WSP(bf16, WS_SWINVT) + (size_t)bg * 64 * LSW : WSP(bf16, WS_PWINVT) + (size_t)bg * 64 * SEQ;
        __syncthreads();
        if (F.tid < 256) psum[F.tid] = 0.f;
        for (int hl = 0; hl < 4; ++hl) {
            const int h = 4 * g + hl;
            __syncthreads();
            for (int n = F.tid; n < 256; n += 512) { const bool v = n <= nvis; vf[n] = v; sc[n] = v ? dot64(qraw + h * 64, ck + (size_t)n * 64) : 0.f; }
            __syncthreads();
            orc_softmax(F, sc, vf, 256, red);
            if (F.tid < 256) psum[F.tid] += sc[F.tid];
            if (F.tid < 64) { float a = 0.f; for (int n = 0; n <= nvis; ++n) a += sc[n] * bf2f(cvt[(size_t)F.tid * cpitch + permk(n)]); resn[h * 64 + F.tid] = gat[h * 3 + 0] * a; }
        }
        __syncthreads();
        if (F.tid < 64) { const int j = F.tid; float a = 0.f;
            for (int n = 4 * j - 1; n <= 4 * j + 3; ++n) if (n >= 0 && n < ncmp) a += psum[n];
            if (j == 0 || j == cur || j == cur - 1) a = 1e4f;
            if (j > cur) a = -1e30f;
            imp[j] = a; selb[j] = 0; }
        __syncthreads();
        if (F.tid == 0) { for (int k = 0; k < 16; ++k) { int best = -1; float bv = -3e38f; for (int j = 0; j < 64; ++j) if (!selb[j] && imp[j] > bv) { bv = imp[j]; best = j; }
                if (best >= 0) selb[best] = (bv > -5e29f) ? 1 : 2; }
            for (int j = 0; j < 64; ++j) selb[j] = selb[j] == 1 ? 1 : 0; }
        __syncthreads();
        for (int hl = 0; hl < 4; ++hl) {
            const int h = 4 * g + hl;
            __syncthreads();
            for (int k = F.tid; k <= qpos; k += 512) { const bool v = selb[k >> 6] != 0; vf[k] = v; sc[k] = v ? dot64(qrot + h * 64, sk + (size_t)k * 64) : 0.f; }
            __syncthreads();
            orc_softmax(F, sc, vf, qpos + 1, red);
            if (F.tid < 64) { float a = 0.f; for (int k = 0; k <= qpos; ++k) if (vf[k]) a += sc[k] * bf2f(svt[(size_t)F.tid * pitch + permk(k)]); resn[h * 64 + F.tid] += gat[h * 3 + 1] * a; }
            __syncthreads();
            for (int k = wlo + F.tid; k <= whi; k += 512) { vf[k - wlo] = 1; sc[k - wlo] = dot64(qrot + h * 64, wk + (size_t)k * 64); }
            __syncthreads();
            orc_softmax(F, sc, vf, whi - wlo + 1, red);
            if (F.tid < 64) { float a = 0.f; for (int k = wlo; k <= whi; ++k) a += sc[k - wlo] * bf2f(wvt[(size_t)F.tid * wpitch + permk(k)]); resn[h * 64 + F.tid] += gat[h * 3 + 2] * a; }
        }
    }
    __syncthreads();
    const bf16* ik = samp ? WSP(bf16, WS_SIDXK) + (size_t)b * LS * 64 : WSP(bf16, WS_PIDXK) + (size_t)b * SEQ * 64;
    for (int k = F.tid; k <= qpos; k += 512) { float a = 0.f; for (int h = 0; h < 4; ++h) a += fmaxf(dot64(iq + h * 64, ik + (size_t)k * 64), 0.f) * iw[h]; s2[k] = a; }
    __syncthreads();
    for (int k = F.tid; k <= qpos; k += 512) { const float v = s2[k]; int c = 0; for (int j = 0; j <= qpos; ++j) { const float x = s2[j]; c += (x > v || (x == v && j < k)) ? 1 : 0; } vf[k] = c < 256; }
    __syncthreads();
    for (int h = 0; h < 8; ++h) {
        const int bg = b * 2 + (h >> 2);
        const bf16* dk = samp ? WSP(bf16, WS_SDSAK) + (size_t)bg * LS * 64 : WSP(bf16, WS_PDSAK) + (size_t)bg * SEQ * 64;
        const bf16* dvt = samp ? WSP(bf16, WS_SDSAVT) + (size_t)bg * 64 * LS : WSP(bf16, WS_PDSAVT) + (size_t)bg * 64 * SEQ;
        __syncthreads();
        for (int k = F.tid; k <= qpos; k += 512) sc[k] = vf[k] ? dot64(dq + h * 64, dk + (size_t)k * 64) : 0.f;
        __syncthreads();
        orc_softmax(F, sc, vf, qpos + 1, red);
        if (F.tid < 64) { float a = 0.f; for (int k = 0; k <= qpos; ++k) if (vf[k]) a += sc[k] * bf2f(dvt[(size_t)F.tid * pitch + permk(k)]); resd[h * 64 + F.tid] = a; }
    }
    __syncthreads();
    float dn = 0.f, rn = 0.f, dd = 0.f, rd = 0.f;
    { const int e = F.tid;
      const float zn = bf2f(WSP(bf16, WS_ZN)[(size_t)row * 512 + e]), zd = bf2f(WSP(bf16, WS_ZD)[(size_t)row * 512 + e]);
      const float refn = resn[e] * zn, refd = resd[e] * zd;
      const float gotn = bf2f(WSP(bf16, WS_ONZ)[(size_t)row * 512 + e]), gotd = bf2f(WSP(bf16, WS_ODZ)[(size_t)row * 512 + e]);
      dn = (gotn - refn) * (gotn - refn); rn = refn * refn; dd = (gotd - refd) * (gotd - refd); rd = refd * refd; }
    dn = blk_red(F, dn, false, red); rn = blk_red(F, rn, false, red); dd = blk_red(F, dd, false, red); rd = blk_red(F, rd, false, red);
    float dc = 0.f, rc = 0.f;
    {
        const bool cs = oi >= 96; const int cbg = cs ? (oi * 5) % 256 : oi % 8, cn = cs ? (oi * 11) % 127 : (oi * 13) % 255;
        for (int slot = 0; slot < 2; ++slot) {
            const bf16* data = cs ? WSP(bf16, slot ? WS_SCMPV : WS_SCMPK) + (size_t)cbg * LS * 64 + (size_t)cn * 1024 : WSP(bf16, slot ? WS_PCMPV : WS_PCMPK) + (size_t)cbg * SEQ * 64 + (size_t)cn * 1024;
            __syncthreads();
            if (F.tid < 128) { float a = 0.f; for (int k = 0; k < 2048; ++k) a += (bf2f(data[k]) + F.pe[slot * 2048 + k]) * F.w1[((size_t)slot * 2048 + k) * 128 + F.tid]; sc[F.tid] = a / (1.f + expf(-a)); }
            __syncthreads();
            if (F.tid < 64) { float a = 0.f; for (int c = 0; c < 128; ++c) a += sc[c] * F.w2[((size_t)slot * 128 + c) * 64 + F.tid];
                float got;
                if (slot == 0) got = bf2f((cs ? WSP(bf16, WS_SCK) + (size_t)cbg * 128 * 64 : WSP(bf16, WS_PCK) + (size_t)cbg * 256 * 64)[(size_t)cn * 64 + F.tid]);
                else got = bf2f((cs ? WSP(bf16, WS_SCVT) + (size_t)cbg * 64 * 128 : WSP(bf16, WS_PCVT) + (size_t)cbg * 64 * 256)[(size_t)F.tid * (cs ? 128 : 256) + permk(cn)]);
                dc += (got - a) * (got - a); rc += a * a; }
        }
    }
    dc = blk_red(F, dc, false, red); rc = blk_red(F, rc, false, red);
    if (F.tid == 0) { float* o = WSP(float, WS_ORC) + oi * 8; o[0] = dn; o[1] = rn; o[2] = dd; o[3] = rd; o[4] = dc; o[5] = rc; }
    __syncthreads();
}
DI float oracle_value(Frame& F) {
    const float* o = WSP(float, WS_ORC);
    float bad = 0.f, acc = 0.f, mxe = 0.f;
    for (int i = 0; i < ORC_ROWS; ++i) { const int c = (ORACLE_MODE >= 6) ? 4 : (ORACLE_MODE & 1) ? 2 : 0; const float e = sqrtf(o[i * 8 + c] / fmaxf(o[i * 8 + c + 1], 1e-30f));
        bad += e > 0.03f ? 1.f : 0.f; acc += fminf(e, 1.f) * fminf(e, 1.f); mxe = fmaxf(mxe, fminf(e, 1.f)); }
    return (ORACLE_MODE < 2 || ORACLE_MODE == 6) ? bad / ORC_ROWS : (ORACLE_MODE < 4 || ORACLE_MODE == 7) ? sqrtf(acc / ORC_ROWS) : mxe;
}
#endif

#define XB_TMO      128
#define XB_XCNT(j)  (256  + 64 * (j))
#define XB_XSUB(j)  (1280 + 64 * (j))
#define XB_XGEN(j)  (2304 + 64 * (j))
#define XB_TOP      3328
#define XB_TOPGEN   3392
#define XCD_BAR_WORDS 3456
#define XB_SPIN_CAP (1u << 18)
__device__ __forceinline__ unsigned xb_ld(unsigned* p)              { return __hip_atomic_load(p, __ATOMIC_RELAXED, __HIP_MEMORY_SCOPE_AGENT); }
__device__ __forceinline__ unsigned xb_add(unsigned* p, unsigned v) { return __hip_atomic_fetch_add(p, v, __ATOMIC_RELAXED, __HIP_MEMORY_SCOPE_AGENT); }
__device__ __forceinline__ unsigned xb_xcc_id() { return (unsigned)__builtin_amdgcn_s_getreg((3 << 11) | 20) & 0xFu; }
#define XB_SPIN(cond, bar) do { unsigned _sp = 0; while (cond) { __builtin_amdgcn_s_sleep(1); \
    if ((++_sp & 255u) == 0u) { if (xb_ld(&(bar)[XB_TMO])) break; if (_sp > XB_SPIN_CAP) { atomicAdd(&(bar)[XB_TMO], 1u); break; } } } } while (0)
struct XcdBarrier { unsigned* bar; unsigned x; volatile LAS unsigned* st; };
__device__ __forceinline__ XcdBarrier xcd_barrier_post(unsigned* bar, volatile LAS unsigned* st) {
    XcdBarrier b; b.bar = bar; b.x = xb_xcc_id(); b.st = st;
    if (threadIdx.x == 0) (void)xb_add(&bar[XB_XCNT(b.x)], 1u);
    return b;
}
__device__ __forceinline__ void xcd_barrier_complete(unsigned* bar, unsigned x, unsigned& nloc, unsigned& nx) {
    const unsigned G = gridDim.x * gridDim.y * gridDim.z;
    unsigned sum, cnt, mine, sp = 0u;
    for (;;) {
        sum = 0u; cnt = 0u; mine = 0u;
#pragma unroll
        for (unsigned j = 0; j < 16; ++j) { const unsigned c = xb_ld(&bar[XB_XCNT(j)]); sum += c; cnt += (c > 0u) ? 1u : 0u; mine = (j == x) ? c : mine; }
        if (sum == G) break;
        __builtin_amdgcn_s_sleep(1);
        if ((++sp & 255u) == 0u) { if (xb_ld(&bar[XB_TMO])) break; if (sp > XB_SPIN_CAP) { atomicAdd(&bar[XB_TMO], 1u); break; } }
    }
    nloc = mine > 0u ? mine : 1u; nx = cnt > 0u ? cnt : 1u;
}
__device__ __forceinline__ void xcd_barrier(const XcdBarrier& b) {
    asm volatile("s_waitcnt vmcnt(0)" ::: "memory");
    __syncthreads();
    if (threadIdx.x == 0) {
        unsigned* bar = b.bar;
        __builtin_amdgcn_s_waitcnt(0);
        unsigned nloc = b.st[0], nx = b.st[1];
        if (nloc == 0u) { xcd_barrier_complete(bar, b.x, nloc, nx); b.st[0] = nloc; b.st[1] = nx; }
        const unsigned old = xb_add(&bar[XB_XSUB(b.x)], 1u);
        const unsigned gen = old / nloc;
        if (old + 1u == (gen + 1u) * nloc) {
            __builtin_amdgcn_fence(__ATOMIC_RELEASE, "agent");
            asm volatile("s_waitcnt vmcnt(0)" ::: "memory");
            const unsigned og = xb_add(&bar[XB_TOP], 1u);
            const unsigned tg = og / nx;
            if (og + 1u == (tg + 1u) * nx) xb_add(&bar[XB_TOPGEN], 1u);
            else XB_SPIN(xb_ld(&bar[XB_TOPGEN]) == tg, bar);
            __builtin_amdgcn_fence(__ATOMIC_ACQUIRE, "agent");
            xb_add(&bar[XB_XGEN(b.x)], 1u);
            asm volatile("s_waitcnt vmcnt(0)" ::: "memory");
        } else {
            XB_SPIN(xb_ld(&bar[XB_XGEN(b.x)]) == gen, bar);
            __builtin_amdgcn_fence(__ATOMIC_ACQUIRE, "agent");
            asm volatile("s_waitcnt vmcnt(0)" ::: "memory");
        }
    }
    __syncthreads();
}

constexpr int N_PHASES = 9;
DI int q_next(Frame& F, int qi) {
    __syncthreads();
    if (F.tid == 0) F.MISC[0] = __hip_atomic_fetch_add(F.ctl + CW_Q + 64 * qi, 1u, __ATOMIC_RELAXED, __HIP_MEMORY_SCOPE_AGENT);
    __syncthreads();
    return (int)F.MISC[0];
}
__global__ void __launch_bounds__(NWAVES * 64, 2) fwd(Args args) {
    extern __shared__ __attribute__((aligned(16))) unsigned char lds[];
    Frame F;
    F.lds = (LAS unsigned char*)lds; F.MISC = (volatile LAS unsigned*)(F.lds + MISC_OFF);
    F.tid = threadIdx.x; F.lane = F.tid & 63; F.wave = __builtin_amdgcn_readfirstlane(F.tid >> 6); F.G = gridDim.x;
    F.ws = args.ws; F.out = args.out; F.ctl = (unsigned*)(args.ws + WS_CTL);
    F.xp = (const float*)args.in[0]; F.xs = (const float*)args.in[1]; F.cnsa = (const float*)args.in[2]; F.cdsa = (const float*)args.in[3]; F.cidx = (const float*)args.in[4];
    F.swin = (const float*)args.in[5]; F.ptab = (const int*)args.in[6]; F.cp = (const float*)args.in[7]; F.cs = (const float*)args.in[8]; F.normg = (const float*)args.in[9];
    F.wada = (const float*)args.in[10]; F.bada = (const float*)args.in[11]; F.win = (const float*)args.in[12]; F.pe = (const float*)args.in[13]; F.w1 = (const float*)args.in[14];
    F.w2 = (const float*)args.in[15]; F.wupn = (const float*)args.in[16]; F.wupd = (const float*)args.in[17]; F.wout = (const float*)args.in[18]; F.fing = (const float*)args.in[19];
    for (int i = F.tid; i < (LDS_BYTES - MISC_OFF) / 4; i += NWAVES * 64) ((LAS unsigned*)(F.lds + MISC_OFF))[i] = 0u;
    __syncthreads();
    const int lo = args.ph_lo, hi = args.ph_hi;
    const bool one = (hi - lo) > 1;
    XcdBarrier bar; bar.bar = F.ctl + CW_BAR; bar.x = 0; bar.st = nullptr;
    if (one) bar = xcd_barrier_post(F.ctl + CW_BAR, F.MISC + 8);
#ifndef PH_MASK
#define PH_MASK 0x1ff
#endif
#define IN(k) (((PH_MASK >> (k)) & 1) && lo <= (k) && (k) < hi)
#define SEAM(k) do { if (IN(k) && IN((k) + 1)) xcd_barrier(bar); } while (0)

#ifndef PROBE_REP
#define PROBE_REP -1
#endif
#define REP(k, BODY) do { if (IN(k)) { BODY(0) if (PROBE_REP == (k)) { xcd_barrier(bar); BODY(8) } } } while (0)
#ifndef PROBE_P4MASK
#define PROBE_P4MASK 15
#endif
#define B0(qo) { p0_prologue(F); }
#define B1(qo) { p1_adaln(F); }
#define B2(qo) { pg8::Gemm g{WSP(bf16, WS_H), WSP(bf16, WS_WINT), MR, NPAD, DM}; pg8::StaticOrder S; S.init(MR, NPAD, F.G, (int)blockIdx.x); EpiInProj E{F.ws, F.out}; \
        pg8::gemm_phase<EpiInProj, pg8::StaticOrder, true, true>(F.lds, g, S, E); }
#define B3(qo) { for (int u = q_next(F, 0 + qo); u < 272; u = q_next(F, 0 + qo)) compress_unit(F, u); \
        for (int u = q_next(F, 1 + qo); u < 2048; u = q_next(F, 1 + qo)) idx1_unit<false>(F, u); \
        for (int u = q_next(F, 2 + qo); u < SBATCH; u = q_next(F, 2 + qo)) idx1_unit<true>(F, u); }
#ifndef P4_MASK
#define P4_MASK 15
#endif
#define B4(qo) { constexpr int PM_ = (qo) ? PROBE_P4MASK : P4_MASK; if (PM_ & 1) for (int u = q_next(F, 3 + qo); u < 256; u = q_next(F, 3 + qo)) nsa_sample_unit(F, u); \
        if (PM_ & 2) for (int u = q_next(F, 4 + qo); u < 256; u = q_next(F, 4 + qo)) dsa_sample_unit(F, u); \
        if (PM_ & 4) for (int u = q_next(F, 5 + qo); u < 512; u = q_next(F, 5 + qo)) nsa_unit<false>(F, u); \
        if (PM_ & 8) for (int u = q_next(F, 6 + qo); u < 512; u = q_next(F, 6 + qo)) dsa_unit<false>(F, u); }
#define B5(qo) { pg8::Gemm g{WSP(bf16, WS_ONZ), WSP(bf16, WS_WUPN), MR, DM, 512}; pg8::StaticOrder S; S.init(MR, DM, F.G, (int)blockIdx.x); EpiUp1 E{F.ws}; \
        pg8::gemm_phase<EpiUp1, pg8::StaticOrder, true, true>(F.lds, g, S, E); }
#define B6(qo) { pg8::Gemm g{WSP(bf16, WS_ODZ), WSP(bf16, WS_WUPD), MR, DM, 512}; pg8::StaticOrder S; S.init(MR, DM, F.G, (int)blockIdx.x); EpiUp2 E{F.ws}; \
        pg8::gemm_phase<EpiUp2, pg8::StaticOrder, true, true>(F.lds, g, S, E); }
#define B7(qo) { pg8::Gemm g{WSP(bf16, WS_M1), WSP(bf16, WS_WOUT), MR, DM, DM}; pg8::StaticOrder S; S.init(MR, DM, F.G, (int)blockIdx.x); EpiOut E{F.ws, F.out, F.xp, F.xs}; \
        pg8::gemm_phase<EpiOut, pg8::StaticOrder, true, true>(F.lds, g, S, E); }
#define B8(qo) { p8_final(F); }
    REP(0, B0); SEAM(0);
    REP(1, B1); SEAM(1);
    REP(2, B2); SEAM(2);
    REP(3, B3); SEAM(3);
    REP(4, B4); SEAM(4);
#ifdef ORACLE
    if (IN(4)) { for (int oi = blockIdx.x; oi < ORC_ROWS; oi += F.G) oracle_row(F, oi); xcd_barrier(bar); }
#endif
    REP(5, B5); SEAM(5);
    REP(6, B6); SEAM(6);
    REP(7, B7); SEAM(7);
    if (IN(8)) { p8_final(F); }
#ifdef ORACLE
    if (IN(8)) { xcd_barrier(bar); const float val = oracle_value(F); const float sc = 1.f + 0.02f * (1.f + val);
        for (size_t i = (size_t)blockIdx.x * 512 + F.tid; i < (size_t)MP * 1024; i += (size_t)F.G * 512) F.out[O_YP + i] *= sc; }
#endif
#undef IN
#undef SEAM
}

extern "C" void kernel_launch(void* const* d_in, const int* in_sizes, int n_in, void* d_out, int out_size, void* d_ws, size_t ws_size, hipStream_t stream) {
    static int grid = 0;
    if (grid == 0) {
        if (n_in != 20 || (size_t)out_size != O_END || ws_size < WS_END) { fprintf(stderr, "kernel_launch: unexpected shapes (n_in %d, out %d, ws %zu)\n", n_in, out_size, ws_size); grid = -1; return; }
        int dev = 0, cus = 0, per_cu = 0;
        if (hipGetDevice(&dev) != hipSuccess || hipDeviceGetAttribute(&cus, hipDeviceAttributeMultiprocessorCount, dev) != hipSuccess) { grid = -1; return; }
        if (hipFuncSetAttribute((const void*)fwd, hipFuncAttributeMaxDynamicSharedMemorySize, LDS_BYTES) != hipSuccess) { fprintf(stderr, "kernel_launch: hipFuncSetAttribute failed\n"); grid = -1; return; }
        if (hipOccupancyMaxActiveBlocksPerMultiprocessor(&per_cu, (const void*)fwd, NWAVES * 64, LDS_BYTES) != hipSuccess || per_cu < 1) { fprintf(stderr, "kernel_launch: occupancy query says %d blocks per CU\n", per_cu); }
        (void)hipGetLastError();
        grid = cus;
    }
    if (grid < 0) return;
    (void)hipMemsetAsync((char*)d_ws + WS_CTL, 0, CTL_ZERO_BYTES, stream);
    Args a{};
    for (int i = 0; i < 20; ++i) a.in[i] = d_in[i];
    a.out = (float*)d_out; a.ws = (unsigned char*)d_ws;
#if MK_N_LAUNCHES == 1
    a.ph_lo = 0; a.ph_hi = N_PHASES;
    hipLaunchKernelGGL(fwd, dim3(grid), dim3(NWAVES * 64), LDS_BYTES, stream, a);
#else
    for (int p = 0; p < N_PHASES; ++p) { a.ph_lo = p; a.ph_hi = p + 1; hipLaunchKernelGGL(fwd, dim3(grid), dim3(NWAVES * 64), LDS_BYTES, stream, a); }
#endif
}
```

```cpp
#define MK_N_LAUNCHES 1
#include <hip/hip_runtime.h>
#include <cstdio>
#include <cstdint>
#ifndef MK_N_LAUNCHES
#define MK_N_LAUNCHES 1
#endif
namespace pg8 {
#define PG8_LAS __attribute__((address_space(3)))
typedef unsigned short bf16_t;
typedef short bf16x8 __attribute__((ext_vector_type(8)));
typedef float f32x4 __attribute__((ext_vector_type(4)));
typedef unsigned u32x4 __attribute__((ext_vector_type(4)));
constexpr int BM = 256, BK = 64, HALF = 128, HTB = HALF * BK * 2  , STAGE_BYTES = 8 * HTB, NXCD = 8, WGM = 8;

__host__ __device__ __forceinline__ int lds_byte(int r, int c) { const int st = (r >> 4) * 2 + (c >> 5), rr = r & 15, cc = c & 31, ob = rr * 64 + cc * 2; return st * 1024 + (ob ^ (((ob >> 9) & 1) << 5)); }
__host__ __device__ __forceinline__ void stage_rc(int b, int& R, int& C) { const int st = b / 1024, sb = b % 1024, swz = sb ^ (((sb >> 9) & 1) << 5); R = (st >> 1) * 16 + swz / 64; C = (st & 1) * 32 + (swz % 64) / 2; }
__host__ __device__ __forceinline__ int perm32(int rho) { const int n = rho >> 4, i = rho & 15; return 8 * (i >> 2) + 4 * n + (i & 3); }

struct Unit { int pm, pn; };
struct Gemm { const bf16_t* A; const bf16_t* Bt; int M, N, K; };

struct StaticOrder {
    int nM, nN, nwg, G, c;
    __host__ __device__ void init(int M, int N, int G_, int c_) { nM = M / BM; nN = N / BM; nwg = nM * nN; G = G_; c = c_; }
    __host__ __device__ bool next(int i, Unit& u) const {
        const long L = (long)i * G + c; if (L >= nwg) return false;
        int wgid = (int)L; { const int q = nwg / NXCD, r = nwg % NXCD, xcd = wgid % NXCD, off = wgid / NXCD; wgid = (xcd < r ? xcd * (q + 1) : r * (q + 1) + (xcd - r) * q) + off; }
        const int nig = WGM * nN, gid = wgid / nig, fm = gid * WGM, gsz = (nM - fm) < WGM ? (nM - fm) : WGM;
        u.pm = fm + ((wgid % nig) % gsz); u.pn = (wgid % nig) / gsz; return true;
    }
    __device__ __forceinline__ void a_ready(const Unit&) const {}
    __device__ __forceinline__ void done(const Unit&) const {}
};

typedef float f32x2p __attribute__((ext_vector_type(2))); typedef __bf16 bf16x2p __attribute__((ext_vector_type(2)));
__device__ __forceinline__ unsigned cvt_pk_bf16(float lo, float hi) { f32x2p v = {lo, hi}; bf16x2p b = __builtin_convertvector(v, bf16x2p); return __builtin_bit_cast(unsigned, b); }
template <class Epi, class Sched, bool ALIGN_EPI = false, bool SP2 = false>
__device__ __forceinline__ void gemm_phase(PG8_LAS unsigned char* lds, const Gemm g, const Sched& S, const Epi& E) {
    const int tid = threadIdx.x, wid = __builtin_amdgcn_readfirstlane(tid >> 6), lane = tid & 63, wr = wid >> 2, wc = wid & 3, fr = lane & 15, fq = lane >> 4;
    const int K = g.K, nt = K / BK;
    unsigned voffA[2], voffB[2];
#pragma unroll
    for (int i = 0; i < 2; ++i) { int R, C; stage_rc(tid * 16 + i * 8192, R, C); const int Rb = Epi::PERM ? ((R & ~31) + perm32(R & 31)) : R;
        voffA[i] = (unsigned)(R * K + C) * 2u; voffB[i] = (unsigned)(Rb * K + C) * 2u; }
    const size_t kstep = (size_t)(BK * 2);
    const size_t hstep = (size_t)HALF * K * 2;
    const size_t tstep = 2 * hstep;
    const unsigned ldsw = (unsigned)wid * 1024u;
    const int aoff = lds_byte(wr * 64 + fr, fq * 8), boff = lds_byte(wc * 32 + fr, fq * 8);
#define PG8_SA(b, h) (((b) * 2 + (h)) * HTB)
#define PG8_SB(b, h) ((4 + (b) * 2 + (h)) * HTB)
#define PG8_STAGE(bufoff, gbase, voff) do { _Pragma("unroll") for (int _i = 0; _i < 2; ++_i) \
        __builtin_amdgcn_global_load_lds((const unsigned*)((const char*)(gbase) + (voff)[_i]), (PG8_LAS unsigned*)(lds + (bufoff) + ldsw + _i * 8192), 16, 0, 0); } while (0)
#define PG8_LDA(dst, b, h) do { _Pragma("unroll") for (int m = 0; m < 4; ++m) _Pragma("unroll") for (int k = 0; k < 2; ++k) dst[m][k] = *(const PG8_LAS bf16x8*)(lds + PG8_SA(b, h) + aoff + m * 2048 + k * 1024); } while (0)
#define PG8_LDB(dst, b, h) do { _Pragma("unroll") for (int n = 0; n < 2; ++n) _Pragma("unroll") for (int k = 0; k < 2; ++k) dst[n][k] = *(const PG8_LAS bf16x8*)(lds + PG8_SB(b, h) + boff + n * 2048 + k * 1024); } while (0)
#define PG8_MMA(ai, bj, At, Bt) do { __builtin_amdgcn_s_setprio(1); _Pragma("unroll") for (int m = 0; m < 4; ++m) _Pragma("unroll") for (int n = 0; n < 2; ++n) _Pragma("unroll") for (int k = 0; k < 2; ++k) \
        acc[ai][bj][m][n] = __builtin_amdgcn_mfma_f32_16x16x32_bf16(Bt[n][k], At[m][k], acc[ai][bj][m][n], 0, 0, 0); __builtin_amdgcn_s_setprio(0); } while (0)
#define PG8_WAIT_V(n) asm volatile("s_waitcnt vmcnt(" #n ")" ::: "memory")
#define PG8_WAIT_L(n) asm volatile("s_waitcnt lgkmcnt(" #n ")" ::: "memory")
#define PG8_BAR __builtin_amdgcn_s_barrier()
#define PG8_SCHED __builtin_amdgcn_sched_barrier(0)
    Unit cur, nxt; int ui = 0;
    if (!S.next(0, cur)) return;
    f32x4 acc[2][2][4][2];
#pragma unroll
    for (int a = 0; a < 2; ++a)
#pragma unroll
        for (int b = 0; b < 2; ++b)
#pragma unroll
            for (int m = 0; m < 4; ++m)
#pragma unroll
                for (int n = 0; n < 2; ++n) acc[a][b][m][n] = (f32x4){0.f, 0.f, 0.f, 0.f};
    bf16x8 At[4][2], B0[2][2], B1[2][2];
    const char* cA = (const char*)g.A + (size_t)cur.pm * tstep; const char* cB = (const char*)g.Bt + (size_t)cur.pn * tstep;
    S.a_ready(cur);
    if constexpr (SP2) {
        PG8_STAGE(PG8_SB(0, 0), cB, voffB); PG8_STAGE(PG8_SB(0, 1), cB + hstep, voffB); PG8_STAGE(PG8_SA(0, 0), cA, voffA); PG8_STAGE(PG8_SA(0, 1), cA + hstep, voffA);
        if (wr == 1) PG8_BAR;
        PG8_WAIT_V(2); PG8_BAR;
        PG8_STAGE(PG8_SB(1, 0), cB + kstep, voffB); PG8_STAGE(PG8_SA(1, 0), cA + kstep, voffA); PG8_STAGE(PG8_SB(1, 1), cB + hstep + kstep, voffB);
        PG8_WAIT_V(6); PG8_BAR;
    } else {
        PG8_STAGE(PG8_SB(0, 0), cB, voffB); PG8_STAGE(PG8_SA(0, 0), cA, voffA); PG8_STAGE(PG8_SB(0, 1), cB + hstep, voffB); PG8_STAGE(PG8_SA(0, 1), cA + hstep, voffA);
        if (wr == 1) PG8_BAR;
        PG8_WAIT_V(4); PG8_BAR;
        PG8_STAGE(PG8_SB(1, 0), cB + kstep, voffB); PG8_STAGE(PG8_SA(1, 0), cA + kstep, voffA); PG8_STAGE(PG8_SB(1, 1), cB + hstep + kstep, voffB);
        PG8_WAIT_V(6); PG8_BAR;
    }
    for (;;) {
        const bool has_next = S.next(ui + 1, nxt);
        const char* nA = has_next ? (const char*)g.A + (size_t)nxt.pm * tstep : cA; const char* nB = has_next ? (const char*)g.Bt + (size_t)nxt.pn * tstep : cB;
        for (int t = 0; t < nt; t += 2) {
            const bool last = (t == nt - 2);
            const char* a1 = cA + (size_t)(t + 1) * kstep;
            const char* a2 = last ? nA : cA + (size_t)(t + 2) * kstep; const char* b2 = last ? nB : cB + (size_t)(t + 2) * kstep;
            const char* a3 = a2 + kstep; const char* b3 = b2 + kstep;
            if (last && has_next) S.a_ready(nxt);
            if constexpr (SP2) {
            PG8_LDB(B0, 0, 0); PG8_LDB(B1, 0, 1); PG8_SCHED; PG8_LDA(At, 0, 0); PG8_STAGE(PG8_SA(1, 1), a1 + hstep, voffA);
            PG8_WAIT_V(8); PG8_WAIT_L(0); PG8_BAR; PG8_MMA(0, 0, At, B0); PG8_MMA(0, 1, At, B1); PG8_BAR; PG8_SCHED;
            PG8_LDA(At, 0, 1); PG8_STAGE(PG8_SB(0, 0), b2, voffB); PG8_STAGE(PG8_SB(0, 1), b2 + hstep, voffB); PG8_STAGE(PG8_SA(0, 0), a2, voffA);
            PG8_WAIT_V(8); PG8_WAIT_L(0); PG8_BAR; PG8_MMA(1, 0, At, B0); PG8_MMA(1, 1, At, B1); PG8_BAR; PG8_SCHED;
            PG8_LDB(B0, 1, 0); PG8_LDB(B1, 1, 1); PG8_SCHED; PG8_LDA(At, 1, 0); PG8_STAGE(PG8_SA(0, 1), a2 + hstep, voffA);
            PG8_WAIT_V(8); PG8_WAIT_L(0); PG8_BAR; PG8_MMA(0, 0, At, B0); PG8_MMA(0, 1, At, B1); PG8_BAR; PG8_SCHED;
            PG8_LDA(At, 1, 1); PG8_STAGE(PG8_SB(1, 0), b3, voffB); PG8_STAGE(PG8_SB(1, 1), b3 + hstep, voffB); PG8_STAGE(PG8_SA(1, 0), a3, voffA);
            PG8_WAIT_V(8); PG8_WAIT_L(0); PG8_BAR; PG8_MMA(1, 0, At, B0); PG8_MMA(1, 1, At, B1); PG8_BAR; PG8_SCHED;
            } else {
            PG8_LDB(B0, 0, 0); PG8_SCHED; PG8_LDA(At, 0, 0); PG8_STAGE(PG8_SA(1, 1), a1 + hstep, voffA);
            PG8_WAIT_L(8); PG8_BAR; PG8_WAIT_L(0); PG8_MMA(0, 0, At, B0); PG8_BAR; PG8_SCHED;
            PG8_LDB(B1, 0, 1); PG8_STAGE(PG8_SB(0, 0), b2, voffB);
            PG8_BAR; PG8_WAIT_L(0); PG8_MMA(0, 1, At, B1); PG8_BAR;
            PG8_LDA(At, 0, 1); PG8_STAGE(PG8_SA(0, 0), a2, voffA);
            PG8_BAR; PG8_WAIT_L(0); PG8_MMA(1, 0, At, B0); PG8_BAR; PG8_SCHED;
            PG8_STAGE(PG8_SB(0, 1), b2 + hstep, voffB);
            PG8_WAIT_V(6); PG8_BAR; PG8_MMA(1, 1, At, B1); PG8_BAR;
            PG8_LDB(B0, 1, 0); PG8_SCHED; PG8_LDA(At, 1, 0); PG8_STAGE(PG8_SA(0, 1), a2 + hstep, voffA);
            PG8_WAIT_L(8); PG8_BAR; PG8_WAIT_L(0); PG8_MMA(0, 0, At, B0); PG8_BAR; PG8_SCHED;
            PG8_LDB(B1, 1, 1); PG8_STAGE(PG8_SB(1, 0), b3, voffB);
            PG8_BAR; PG8_WAIT_L(0); PG8_MMA(0, 1, At, B1); PG8_BAR;
            PG8_LDA(At, 1, 1); PG8_STAGE(PG8_SA(1, 0), a3, voffA);
            PG8_BAR; PG8_WAIT_L(0); PG8_MMA(1, 0, At, B0); PG8_BAR; PG8_SCHED;
            PG8_STAGE(PG8_SB(1, 1), b3 + hstep, voffB);
            PG8_WAIT_V(6); PG8_BAR; PG8_MMA(1, 1, At, B1); PG8_BAR;
            }
        }
        if constexpr (ALIGN_EPI) { if (wr == 0) PG8_BAR; }
        if constexpr (!Epi::AFTER_DRAIN) { E(acc, cur, wr, wc, fr, fq); S.done(cur); }
        if (!has_next) break;
#pragma unroll
        for (int a = 0; a < 2; ++a)
#pragma unroll
            for (int b = 0; b < 2; ++b)
#pragma unroll
                for (int m = 0; m < 4; ++m)
#pragma unroll
                    for (int n = 0; n < 2; ++n) acc[a][b][m][n] = (f32x4){0.f, 0.f, 0.f, 0.f};
        cur = nxt; cA = nA; cB = nB; ++ui;
        if constexpr (ALIGN_EPI) { if (wr == 1) PG8_BAR; }
    }
    PG8_WAIT_V(0);
    if constexpr (!ALIGN_EPI) { if (wr == 0) PG8_BAR; }
    PG8_BAR;
    if constexpr (Epi::AFTER_DRAIN) { E.fused(acc, cur, wr, wc, fr, fq, lds, wid, lane); S.done(cur); }
#undef PG8_SA
#undef PG8_SB
#undef PG8_STAGE
#undef PG8_LDA
#undef PG8_LDB
#undef PG8_MMA
#undef PG8_WAIT_V
#undef PG8_WAIT_L
#undef PG8_BAR
#undef PG8_SCHED
}
}

#define LAS __attribute__((address_space(3)))
typedef unsigned short bf16;
typedef short bf16x8 __attribute__((ext_vector_type(8)));
typedef float f32x4 __attribute__((ext_vector_type(4)));
typedef float f32x16 __attribute__((ext_vector_type(16)));
typedef unsigned u32x4 __attribute__((ext_vector_type(4)));
typedef unsigned u32x2 __attribute__((ext_vector_type(2)));

constexpr int DM = 1024, NBATCH = 4, SEQ = 4096, MP = NBATCH * SEQ, SBATCH = 128, STOK = 4, MS = SBATCH * STOK, MR = MP + MS;
constexpr int PASTL = 2048, PAGE = 128, NPG = 16;
constexpr int LS = 2112, LSW = 576;
constexpr int NPAD = 5632;
constexpr float C2 = 0.125f * 1.4426950408889634f;
constexpr int NWAVES = 8;

constexpr size_t O_YP = 0, O_YS = 16777216, O_NSAP = 17301504, O_DSAP = 25690112, O_IDXP = 29884416, O_WINP = 30932992,
                 O_NSAS = 31457280, O_DSAS = 31719424, O_IDXS = 31850496, O_WINS = 31883264, O_END = 48660480;

constexpr size_t MiB = 1u << 20;
constexpr size_t WS_CTL = 0, CTL_ZERO_BYTES = 1 * MiB;
constexpr size_t WS_MOD = 1 * MiB;
constexpr size_t WS_COS = 3 * MiB, WS_SIN = 4 * MiB;
constexpr size_t WS_BIAS1 = 5 * MiB;
constexpr size_t WS_W2T = 5 * MiB + 65536;
constexpr size_t WS_W1T = 6 * MiB;
constexpr size_t WS_WINT = 8 * MiB;
constexpr size_t WS_WUPN = 20 * MiB, WS_WUPD = 21 * MiB, WS_WOUT = 22 * MiB;
constexpr size_t WS_SELM = 960 * MiB;
constexpr size_t WS_GATES = 25 * MiB;
constexpr size_t WS_IW = 27 * MiB;
constexpr size_t WS_PCK = 28 * MiB, WS_PCVT = 28 * MiB + 262144;
constexpr size_t WS_SCK = 29 * MiB, WS_SCVT = 33 * MiB;
constexpr size_t WS_H = 40 * MiB;
constexpr size_t WS_QRAW = 80 * MiB, WS_QROT = 100 * MiB, WS_DQ = 120 * MiB, WS_IQ = 140 * MiB, WS_ZN = 150 * MiB, WS_ZD = 170 * MiB, WS_ONZ = 190 * MiB, WS_ODZ = 210 * MiB;
constexpr size_t WS_MG = 230 * MiB;
constexpr size_t WS_T1 = 300 * MiB;
constexpr size_t WS_M1 = 370 * MiB;
constexpr size_t WS_PCMPK = 410 * MiB, WS_PCMPV = 414 * MiB, WS_PSLCK = 418 * MiB, WS_PSLCVT = 422 * MiB, WS_PWINK = 426 * MiB, WS_PWINVT = 430 * MiB,
                 WS_PDSAK = 434 * MiB, WS_PDSAVT = 438 * MiB, WS_PIDXK = 442 * MiB;
constexpr size_t WS_SCMPK = 450 * MiB, WS_SCMPV = 520 * MiB, WS_SSLCK = 590 * MiB, WS_SSLCVT = 660 * MiB, WS_SDSAK = 730 * MiB, WS_SDSAVT = 800 * MiB,
                 WS_SWINK = 870 * MiB, WS_SWINVT = 890 * MiB, WS_SIDXK = 910 * MiB, WS_END = 970 * MiB;
constexpr int CW_BAR = 4096;
constexpr int CW_Q = 16384;

constexpr int RING_BYTES = 131072, MISC_OFF = RING_BYTES, LDS_BYTES = 147456;

struct Args { const void* in[20]; float* out; unsigned char* ws; int ph_lo, ph_hi, rep_phase, rep_cnt, rep_mask, pad; };

struct Frame {
    LAS unsigned char* lds; volatile LAS unsigned* MISC; unsigned* ctl;
    int tid, lane, wave, G;
    unsigned char* ws; float* out;
    const float *xp, *xs, *cnsa, *cdsa, *cidx, *swin; const int* ptab; const float *cp, *cs, *normg, *wada, *bada, *win, *pe, *w1, *w2, *wupn, *wupd, *wout, *fing;
};
#define WSP(T, off) ((T*)(F.ws + (off)))

#define LDS_WAIT() asm volatile("s_waitcnt lgkmcnt(0)" ::: "memory")
#define DI __device__ __forceinline__
DI float wave_sum(float v) {
#pragma unroll
    for (int o = 1; o < 64; o <<= 1) v += __shfl_xor(v, o);
    return v;
}
DI unsigned pk2(float lo, float hi) { return pg8::cvt_pk_bf16(lo, hi); }
DI float bflo(unsigned w) { return __uint_as_float(w << 16); }
DI float bfhi(unsigned w) { return __uint_as_float(w & 0xffff0000u); }
DI float bf2f(bf16 h) { return __uint_as_float((unsigned)h << 16); }
DI float sigm_f(float x) { return __builtin_amdgcn_rcpf(1.f + __builtin_amdgcn_exp2f(-1.4426950408889634f * x)); }
DI float silu_f(float x) { return x * sigm_f(x); }
DI int pos16(int o) { return 8 * ((o >> 2) & 1) + (o & 3) + 4 * (o >> 3); }
DI int permk(int t) { return (t & ~15) | pos16(t & 15); }
DI int crow(int r, int hi) { return (r & 3) + 8 * (r >> 2) + 4 * hi; }
DI float dpp_x1(float v) { return __int_as_float(__builtin_amdgcn_update_dpp(0, __float_as_int(v), 0xB1, 0xF, 0xF, true)); }
DI float dpp_x2(float v) { return __int_as_float(__builtin_amdgcn_update_dpp(0, __float_as_int(v), 0x4E, 0xF, 0xF, true)); }
DI float half_other(float v) { return __shfl_xor(v, 32); }
DI u32x4 pack8(const float* v) { u32x4 w; w.x = pk2(v[0], v[1]); w.y = pk2(v[2], v[3]); w.z = pk2(v[4], v[5]); w.w = pk2(v[6], v[7]); return w; }
DI void st_bf8(bf16* p, const float* v) { *(u32x4*)p = pack8(v); }
DI void st_f8(float* p, const float* v) { *(f32x4*)p = (f32x4){v[0], v[1], v[2], v[3]}; *(f32x4*)(p + 4) = (f32x4){v[4], v[5], v[6], v[7]}; }
DI void st_vt8(bf16* p, size_t pitch, const float* v) {
#pragma unroll
    for (int j = 0; j < 8; ++j) p[(size_t)j * pitch] = (bf16)(pk2(v[j], 0.f) & 0xffffu);
}
#define PIN4(q) asm volatile("" : "+v"(q[0]), "+v"(q[1]), "+v"(q[2]), "+v"(q[3]))
#define NEGINF (-__builtin_inff())
#define MFMA32(a, b, c) __builtin_amdgcn_mfma_f32_32x32x16_bf16((a), (b), (c), 0, 0, 0)

DI int idx_key(float dot, float w) {
#pragma clang fp contract(off)
    float v = fmaxf(dot, 0.f) * w;
    v = v + dpp_x1(v);
    v = v + dpp_x2(v);
    int u = __float_as_int(v);
    u = (u == (int)0x80000000) ? 0 : u;
    return u ^ ((u >> 31) & 0x7fffffff);
}

template <int MODE> struct EpiInProjT {
    static constexpr bool PERM = true, AFTER_DRAIN = false;
    unsigned char* ws; float* out;
    DI void rope8(float* lo, float* hi, int pos, int d0) const {
        const f32x4* cp = (const f32x4*)((const float*)(ws + WS_COS) + pos * 32 + d0);
        const f32x4* sp = (const f32x4*)((const float*)(ws + WS_SIN) + pos * 32 + d0);
        const f32x4 c0 = cp[0], c1 = cp[1], s0 = sp[0], s1 = sp[1];
        const float c[8] = {c0[0], c0[1], c0[2], c0[3], c1[0], c1[1], c1[2], c1[3]}, s[8] = {s0[0], s0[1], s0[2], s0[3], s1[0], s1[1], s1[2], s1[3]};
#pragma unroll
        for (int j = 0; j < 8; ++j) { const float a = lo[j], b = hi[j]; lo[j] = a * c[j] - b * s[j]; hi[j] = b * c[j] + a * s[j]; }
    }
    DI void operator()(const pg8::f32x4 (&acc)[2][2][4][2], const pg8::Unit& u, int wr, int wc, int fr, int fq) const {
        const int hs = u.pn * 4 + wc;
        if (hs >= 86) return;
        if ((MODE & 2) && hs >= 20 && hs != 44 && !(hs >= 36 && hs < 40)) return;
        if ((MODE & 4) && hs < 20) return;
        const bool samp = u.pm >= 64;
        const int d0 = 8 * fq;
#pragma unroll
        for (int ai = 0; ai < 2; ++ai)
#pragma unroll
            for (int m = 0; m < 4; ++m) {
                const int r = u.pm * 256 + ai * 128 + wr * 64 + m * 16 + fr;
                int b, t, pos;
                if (!samp) { b = r >> 12; t = r & 4095; pos = t; } else { b = (r - MP) >> 2; t = r & 3; pos = PASTL + t; }
                float lo[8], hi[8];
#pragma unroll
                for (int n = 0; n < 2; ++n)
#pragma unroll
                    for (int j = 0; j < 4; ++j) { lo[4 * n + j] = acc[ai][0][m][n][j]; hi[4 * n + j] = acc[ai][1][m][n][j]; }
                if (hs < 8) {
                    bf16* qa = (bf16*)(ws + WS_QRAW) + (size_t)r * 512 + hs * 64 + d0;
                    bf16* qb = (bf16*)(ws + WS_QROT) + (size_t)r * 512 + hs * 64 + d0;
                    float a[8], c[8];
#pragma unroll
                    for (int j = 0; j < 8; ++j) { a[j] = lo[j] * C2; c[j] = hi[j] * C2; }
                    st_bf8(qa, a); st_bf8(qa + 32, c);
                    rope8(lo, hi, pos, d0);
#pragma unroll
                    for (int j = 0; j < 8; ++j) { a[j] = lo[j] * C2; c[j] = hi[j] * C2; }
                    st_bf8(qb, a); st_bf8(qb + 32, c);
                } else if (hs < 20) {
                    const int ty = (hs - 8) >> 1, g = (hs - 8) & 1;
                    if (ty == 2 || ty == 4) rope8(lo, hi, pos, d0);
                    const int bg = b * 2 + g;
                    if (ty < 4) {
                        float* o = out + (samp ? O_NSAS + ((size_t)(r - MP) * 8 + ty * 2 + g) * 64 : O_NSAP + ((size_t)r * 8 + ty * 2 + g) * 64) + d0;
                        st_f8(o, lo); st_f8(o + 32, hi);
                    } else {
                        const int sl = ty - 4;
                        if (samp) { float* o = out + O_WINS + (((size_t)b * 512 + 508 + t) * 4 + sl * 2 + g) * 64 + d0; st_f8(o, lo); st_f8(o + 32, hi); }
                        else if (t >= SEQ - 512) { float* o = out + O_WINP + (((size_t)b * 512 + (t - (SEQ - 512))) * 4 + sl * 2 + g) * 64 + d0; st_f8(o, lo); st_f8(o + 32, hi); }
                    }
                    if (ty == 3 || ty == 5) {
                        size_t pitch; int kp; bf16* base;
                        if (!samp) { pitch = SEQ; kp = t; base = (bf16*)(ws + (ty == 3 ? WS_PSLCVT : WS_PWINVT)); }
                        else if (ty == 3) { pitch = LS; kp = PASTL + t; base = (bf16*)(ws + WS_SSLCVT); }
                        else { pitch = LSW; kp = 512 + t; base = (bf16*)(ws + WS_SWINVT); }
                        bf16* p = base + ((size_t)bg * 64 + d0) * pitch + permk(kp);
                        if (!(MODE & 1)) { st_vt8(p, pitch, lo); st_vt8(p + 32 * pitch, pitch, hi); }
                    } else {
                        size_t rowi; bf16* base;
                        if (!samp) { rowi = (size_t)bg * SEQ + t; base = (bf16*)(ws + (ty == 0 ? WS_PCMPK : ty == 1 ? WS_PCMPV : ty == 2 ? WS_PSLCK : WS_PWINK)); }
                        else if (ty == 4) { rowi = (size_t)bg * LSW + 512 + t; base = (bf16*)(ws + WS_SWINK); }
                        else { rowi = (size_t)bg * LS + PASTL + t; base = (bf16*)(ws + (ty == 0 ? WS_SCMPK : ty == 1 ? WS_SCMPV : WS_SSLCK)); }
                        bf16* p = base + rowi * 64 + d0;
                        st_bf8(p, lo); st_bf8(p + 32, hi);
                    }
                } else if (hs < 28 || (hs >= 45 && hs < 53)) {
                    const int h = hs < 28 ? hs - 20 : hs - 45;
                    bf16* p = (bf16*)(ws + (hs < 28 ? WS_ZN : WS_ZD)) + (size_t)r * 512 + h * 64 + d0;
#pragma unroll
                    for (int j = 0; j < 8; ++j) { lo[j] = silu_f(lo[j]); hi[j] = silu_f(hi[j]); }
                    st_bf8(p, lo); st_bf8(p + 32, hi);
                } else if (hs < 36) {
                    rope8(lo, hi, pos, d0);
#pragma unroll
                    for (int j = 0; j < 8; ++j) { lo[j] *= C2; hi[j] *= C2; }
                    bf16* p = (bf16*)(ws + WS_DQ) + (size_t)r * 512 + (hs - 28) * 64 + d0;
                    st_bf8(p, lo); st_bf8(p + 32, hi);
                } else if (hs < 40) {
                    const int sl = (hs - 36) >> 1, g = (hs - 36) & 1, bg = b * 2 + g;
                    if (sl == 0) rope8(lo, hi, pos, d0);
                    float* o = out + (samp ? O_DSAS + ((size_t)(r - MP) * 4 + sl * 2 + g) * 64 : O_DSAP + ((size_t)r * 4 + sl * 2 + g) * 64) + d0;
                    st_f8(o, lo); st_f8(o + 32, hi);
                    if (sl == 0) {
                        bf16* p = samp ? (bf16*)(ws + WS_SDSAK) + ((size_t)bg * LS + PASTL + t) * 64 + d0 : (bf16*)(ws + WS_PDSAK) + ((size_t)bg * SEQ + t) * 64 + d0;
                        st_bf8(p, lo); st_bf8(p + 32, hi);
                    } else {
                        const size_t pitch = samp ? LS : SEQ; const int kp = samp ? PASTL + t : t;
                        bf16* p = (bf16*)(ws + (samp ? WS_SDSAVT : WS_PDSAVT)) + ((size_t)bg * 64 + d0) * pitch + permk(kp);
                        if (!(MODE & 1)) { st_vt8(p, pitch, lo); st_vt8(p + 32 * pitch, pitch, hi); }
                    }
                } else if (hs < 44) {
                    rope8(lo, hi, pos, d0);
                    bf16* p = (bf16*)(ws + WS_IQ) + (size_t)r * 256 + (hs - 40) * 64 + d0;
                    st_bf8(p, lo); st_bf8(p + 32, hi);
                } else if (hs == 44) {
                    rope8(lo, hi, pos, d0);
                    float* o = out + (samp ? O_IDXS + (size_t)(r - MP) * 64 : O_IDXP + (size_t)r * 64) + d0;
                    st_f8(o, lo); st_f8(o + 32, hi);
                    bf16* p = samp ? (bf16*)(ws + WS_SIDXK) + ((size_t)b * LS + PASTL + t) * 64 + d0 : (bf16*)(ws + WS_PIDXK) + (size_t)r * 64 + d0;
                    st_bf8(p, lo); st_bf8(p + 32, hi);
                } else if (hs < 85) {
                    bf16* p = (bf16*)(ws + WS_MG) + (size_t)r * 2048 + (hs - 53) * 64 + d0;
#pragma unroll
                    for (int j = 0; j < 8; ++j) { lo[j] = sigm_f(lo[j]); hi[j] = sigm_f(hi[j]); }
                    st_bf8(p, lo); st_bf8(p + 32, hi);
                } else {
                    if (fq < 3) { float* p = (float*)(ws + WS_GATES) + (size_t)r * 24 + d0;
#pragma unroll
                        for (int j = 0; j < 8; ++j) lo[j] = sigm_f(lo[j]);
                        st_f8(p, lo);
                    } else { *(f32x4*)((float*)(ws + WS_IW) + (size_t)r * 4) = (f32x4){lo[0], lo[1], lo[2], lo[3]}; }
                }
            }
    }
};
typedef EpiInProjT<0> EpiInProj;
struct EpiNull {
    static constexpr bool PERM = true, AFTER_DRAIN = false;
    unsigned char* ws;
    DI void operator()(const pg8::f32x4 (&acc)[2][2][4][2], const pg8::Unit& u, int wr, int wc, int fr, int fq) const {
        float s = 0.f;
#pragma unroll
        for (int ai = 0; ai < 2; ++ai)
#pragma unroll
            for (int bj = 0; bj < 2; ++bj)
#pragma unroll
                for (int m = 0; m < 4; ++m)
#pragma unroll
                    for (int n = 0; n < 2; ++n) s += acc[ai][bj][m][n][0] + acc[ai][bj][m][n][1] + acc[ai][bj][m][n][2] + acc[ai][bj][m][n][3];
        if (s == 1.2345e33f) *(float*)(ws + WS_CTL + 2048) = s;
    }
};
struct EpiUp1 {
    static constexpr bool PERM = true, AFTER_DRAIN = false;
    unsigned char* ws;
    DI void operator()(const pg8::f32x4 (&acc)[2][2][4][2], const pg8::Unit& u, int wr, int wc, int fr, int fq) const {
#pragma unroll
        for (int ai = 0; ai < 2; ++ai)
#pragma unroll
            for (int m = 0; m < 4; ++m) {
                const int r = u.pm * 256 + ai * 128 + wr * 64 + m * 16 + fr;
#pragma unroll
                for (int bj = 0; bj < 2; ++bj) {
                    const int c0 = u.pn * 256 + bj * 128 + wc * 32 + 8 * fq;
                    const u32x4 gw = *(const u32x4*)((const bf16*)(ws + WS_MG) + (size_t)r * 2048 + c0);
                    const f32x4 a0 = acc[ai][bj][m][0], a1 = acc[ai][bj][m][1];
                    float* o = (float*)(ws + WS_T1) + (size_t)r * 1024 + c0;
                    *(f32x4*)o = (f32x4){a0[0] * bflo(gw.x), a0[1] * bfhi(gw.x), a0[2] * bflo(gw.y), a0[3] * bfhi(gw.y)};
                    *(f32x4*)(o + 4) = (f32x4){a1[0] * bflo(gw.z), a1[1] * bfhi(gw.z), a1[2] * bflo(gw.w), a1[3] * bfhi(gw.w)};
                }
            }
    }
};
struct EpiUp2 {
    static constexpr bool PERM = true, AFTER_DRAIN = false;
    unsigned char* ws;
    DI void operator()(const pg8::f32x4 (&acc)[2][2][4][2], const pg8::Unit& u, int wr, int wc, int fr, int fq) const {
#pragma unroll
        for (int ai = 0; ai < 2; ++ai)
#pragma unroll
            for (int m = 0; m < 4; ++m) {
                const int r = u.pm * 256 + ai * 128 + wr * 64 + m * 16 + fr;
#pragma unroll
                for (int bj = 0; bj < 2; ++bj) {
                    const int c0 = u.pn * 256 + bj * 128 + wc * 32 + 8 * fq;
                    const u32x4 gw = *(const u32x4*)((const bf16*)(ws + WS_MG) + (size_t)r * 2048 + 1024 + c0);
                    const float* tp = (const float*)(ws + WS_T1) + (size_t)r * 1024 + c0;
                    const f32x4 t0 = *(const f32x4*)tp, t1 = *(const f32x4*)(tp + 4);
                    const f32x4 a0 = acc[ai][bj][m][0], a1 = acc[ai][bj][m][1];
                    u32x4 w;
                    w.x = pk2(t0[0] + a0[0] * bflo(gw.x), t0[1] + a0[1] * bfhi(gw.x)); w.y = pk2(t0[2] + a0[2] * bflo(gw.y), t0[3] + a0[3] * bfhi(gw.y));
                    w.z = pk2(t1[0] + a1[0] * bflo(gw.z), t1[1] + a1[1] * bfhi(gw.z)); w.w = pk2(t1[2] + a1[2] * bflo(gw.w), t1[3] + a1[3] * bfhi(gw.w));
                    *(u32x4*)((bf16*)(ws + WS_M1) + (size_t)r * 1024 + c0) = w;
                }
            }
    }
};
struct EpiOut {
    static constexpr bool PERM = true, AFTER_DRAIN = false;
    unsigned char* ws; float* out; const float* xp; const float* xs;
    DI void operator()(const pg8::f32x4 (&acc)[2][2][4][2], const pg8::Unit& u, int wr, int wc, int fr, int fq) const {
        const bool samp = u.pm >= 64;
#pragma unroll
        for (int ai = 0; ai < 2; ++ai)
#pragma unroll
            for (int m = 0; m < 4; ++m) {
                const int r = u.pm * 256 + ai * 128 + wr * 64 + m * 16 + fr;
                const int mrow = samp ? 4 + ((r - MP) >> 2) : (r >> 12);
                const float* xr = samp ? xs + (size_t)(r - MP) * 1024 : xp + (size_t)r * 1024;
                float* orow = samp ? out + O_YS + (size_t)(r - MP) * 1024 : out + O_YP + (size_t)r * 1024;
                const float* gr = (const float*)(ws + WS_MOD) + (size_t)mrow * 3072 + 2048;
#pragma unroll
                for (int bj = 0; bj < 2; ++bj) {
                    const int c0 = u.pn * 256 + bj * 128 + wc * 32 + 8 * fq;
#pragma unroll
                    for (int n = 0; n < 2; ++n) {
                        const f32x4 x4 = *(const f32x4*)(xr + c0 + 4 * n), g4 = *(const f32x4*)(gr + c0 + 4 * n);
                        *(f32x4*)(orow + c0 + 4 * n) = x4 + g4 * acc[ai][bj][m][n];
                    }
                }
            }
    }
};

DI int win_row(int col) {
    int hs, d;
    if (col < 1280) { hs = col >> 6; d = col & 63; }
    else if (col < 1304) { hs = 85; d = col - 1280; }
    else if (col < 2904) { const int c = col - 1304; hs = 20 + (c >> 6); d = c & 63; }
    else if (col < 2908) { hs = 85; d = 24 + (col - 2904); }
    else { const int c = col - 2908; hs = 45 + (c >> 6); d = c & 63; }
    return 256 * (hs >> 2) + 128 * (d >> 5) + 32 * (hs & 3) + (d & 31);
}
template <bool WINMAP> DI void p0_transpose_item(const float* W, int K, int N, bf16* WT, LAS float* scr, int item, int lane) {
    const int nblk = (N + 31) / 32, kb = item / nblk, nb = item % nblk, k0 = 64 * kb, n0 = 32 * nb;
    const bool nok = n0 + (lane & 31) < N;
#pragma unroll 8
    for (int i = 0; i < 32; ++i) { const int kk = 2 * i + (lane >> 5); scr[kk * 33 + (lane & 31)] = nok ? W[(size_t)(k0 + kk) * N + n0 + (lane & 31)] : 0.f; }
    LDS_WAIT();
    const int c = lane & 7;
#pragma unroll
    for (int j = 0; j < 4; ++j) { const int n = (lane >> 3) + 8 * j; const LAS float* s = scr + (8 * c) * 33 + n;
        u32x4 o; o.x = pk2(s[0 * 33], s[1 * 33]); o.y = pk2(s[2 * 33], s[3 * 33]); o.z = pk2(s[4 * 33], s[5 * 33]); o.w = pk2(s[6 * 33], s[7 * 33]);
        if (n0 + n < N) { const int row = WINMAP ? win_row(n0 + n) : (n0 + n); *(u32x4*)(WT + (size_t)row * K + k0 + 8 * c) = o; } }
    LDS_WAIT();
}
DI void p0_mod(Frame& F) {
    LAS float* wl = (LAS float*)F.lds;
    float* mod = WSP(float, WS_MOD);
    for (int cg = blockIdx.x; cg < 256; cg += F.G) {
        __syncthreads();
        for (int k = F.tid; k < 1024; k += NWAVES * 64) {
            const f32x4* src = (const f32x4*)(F.wada + (size_t)k * 3072 + cg * 12);
            LAS f32x4* dst = (LAS f32x4*)(wl + k * 12);
            dst[0] = src[0]; dst[1] = src[1]; dst[2] = src[2];
        }
        __syncthreads();
        for (int r = F.wave; r < 132; r += NWAVES) {
            const float* cr = r < 4 ? F.cp + (size_t)r * 1024 : F.cs + (size_t)(r - 4) * 1024;
            float a[12];
#pragma unroll
            for (int j = 0; j < 12; ++j) a[j] = 0.f;
#pragma unroll 4
            for (int i = 0; i < 16; ++i) {
                const int k = F.lane + 64 * i; const float s = silu_f(cr[k]);
                const LAS f32x4* wp = (const LAS f32x4*)(wl + k * 12);
                const f32x4 w0 = wp[0], w1 = wp[1], w2 = wp[2];
                a[0] += s * w0[0]; a[1] += s * w0[1]; a[2] += s * w0[2]; a[3] += s * w0[3];
                a[4] += s * w1[0]; a[5] += s * w1[1]; a[6] += s * w1[2]; a[7] += s * w1[3];
                a[8] += s * w2[0]; a[9] += s * w2[1]; a[10] += s * w2[2]; a[11] += s * w2[3];
            }
            float v = 0.f;
#pragma unroll
            for (int j = 0; j < 12; ++j) { const float sj = wave_sum(a[j]); v = (F.lane == j) ? sj : v; }
            if (F.lane < 12) mod[(size_t)r * 3072 + cg * 12 + F.lane] = v + F.bada[cg * 12 + F.lane];
        }
    }
    __syncthreads();
}
__device__ const double ROPE_INV[32] = {
    1.0, 0.7498942093324559, 0.5623413251903491, 0.4216965034285822, 0.31622776601683794, 0.23713737056616552, 0.1778279410038923, 0.1333521432163324,
    0.1, 0.07498942093324559, 0.05623413251903491, 0.04216965034285822, 0.03162277660168379, 0.023713737056616554, 0.01778279410038923, 0.01333521432163324,
    0.01, 0.007498942093324559, 0.005623413251903491, 0.004216965034285822, 0.0031622776601683794, 0.0023713737056616554, 0.0017782794100389228, 0.001333521432163324,
    0.001, 0.0007498942093324559, 0.0005623413251903491, 0.0004216965034285822, 0.00031622776601683794, 0.00023713737056616554, 0.00017782794100389227, 0.0001333521432163324};
DI void p0_rope_item(Frame& F, int item) {
    const int pos = 2 * item + (F.lane >> 5), d = F.lane & 31;
    if (pos >= 4100) return;
    const double ang = (double)pos * ROPE_INV[d];
    const double kq = __builtin_rint(ang * 0.6366197723675814);
    double r = __builtin_fma(-kq, 1.5707963267948966, ang); r = __builtin_fma(-kq, 6.123233995736766e-17, r);
    const int q = (int)kq & 3;
    const double r2 = r * r;
    const double sn = r * (1.0 + r2 * (-1.0 / 6 + r2 * (1.0 / 120 + r2 * (-1.0 / 5040 + r2 * (1.0 / 362880 + r2 * (-1.0 / 39916800 + r2 * (1.0 / 6227020800.0)))))));
    const double cs = 1.0 + r2 * (-0.5 + r2 * (1.0 / 24 + r2 * (-1.0 / 720 + r2 * (1.0 / 40320 + r2 * (-1.0 / 3628800 + r2 * (1.0 / 479001600.0 + r2 * (-1.0 / 87178291200.0)))))));
    const double c = (q == 0) ? cs : (q == 1) ? -sn : (q == 2) ? -cs : sn;
    const double s = (q == 0) ? sn : (q == 1) ? cs : (q == 2) ? -sn : -cs;
    WSP(float, WS_COS)[pos * 32 + d] = (float)c; WSP(float, WS_SIN)[pos * 32 + d] = (float)s;
}
DI void p0_cmp_small_item(Frame& F, int item) {
    if (item < 256) {
        const int slot = item >> 7, c = item & 127; float a = 0.f;
        for (int i = 0; i < 32; ++i) { const int k = F.lane + 64 * i; a += F.pe[slot * 2048 + k] * F.w1[((size_t)slot * 2048 + k) * 128 + c]; }
        a = wave_sum(a);
        if (F.lane == 0) WSP(float, WS_BIAS1)[item] = a;
    } else {
        const int it = item - 256, slot = it >> 7, e = (it & 127) >> 1, ch = it & 1;
        const int c = ch * 64 + F.lane;
        WSP(bf16, WS_W2T)[((size_t)slot * 64 + e) * 128 + permk(c)] = (bf16)(pk2(F.w2[((size_t)slot * 128 + c) * 64 + e], 0.f) & 0xffffu);
    }
}
DI void cp_k16(const float* src, size_t rs, bf16* dst, int lane) {
    const int tk = lane >> 2, dc = (lane & 3) * 16;
    const f32x4* s = (const f32x4*)(src + (size_t)tk * rs + dc);
    const f32x4 a = s[0], b = s[1], c = s[2], d = s[3];
    u32x4 w0, w1; w0.x = pk2(a[0], a[1]); w0.y = pk2(a[2], a[3]); w0.z = pk2(b[0], b[1]); w0.w = pk2(b[2], b[3]);
    w1.x = pk2(c[0], c[1]); w1.y = pk2(c[2], c[3]); w1.z = pk2(d[0], d[1]); w1.w = pk2(d[2], d[3]);
    u32x4* o = (u32x4*)(dst + (size_t)tk * 64 + dc); o[0] = w0; o[1] = w1;
}
DI void cp_vt16(const float* src, size_t rs, bf16* dst, size_t pitch, int lane) {
#pragma unroll
    for (int h = 0; h < 2; ++h) {
        float v[8];
#pragma unroll
        for (int i = 0; i < 8; ++i) v[i] = src[(size_t)((i & 3) + 8 * (i >> 2) + 4 * h) * rs + lane];
        *(u32x4*)(dst + (size_t)lane * pitch + 8 * h) = pack8(v);
    }
}
DI void p0_gather_item(Frame& F, int item) {
    const int sb = item >> 7, tg = item & 127, tk0 = tg * 16, lane = F.lane;
    const int pg = F.ptab[sb * NPG + (tk0 >> 7)], j0 = tk0 & 127;
    const float* nsa = F.cnsa + ((size_t)pg * PAGE + j0) * 512;
    const float* dsa = F.cdsa + ((size_t)pg * PAGE + j0) * 256;
    const float* idx = F.cidx + ((size_t)pg * PAGE + j0) * 64;
#pragma unroll
    for (int g = 0; g < 2; ++g) {
        const size_t bg = (size_t)sb * 2 + g;
        cp_k16(nsa + (0 * 2 + g) * 64, 512, WSP(bf16, WS_SCMPK) + (bg * LS + tk0) * 64, lane);
        cp_k16(nsa + (1 * 2 + g) * 64, 512, WSP(bf16, WS_SCMPV) + (bg * LS + tk0) * 64, lane);
        cp_k16(nsa + (2 * 2 + g) * 64, 512, WSP(bf16, WS_SSLCK) + (bg * LS + tk0) * 64, lane);
        cp_vt16(nsa + (3 * 2 + g) * 64, 512, WSP(bf16, WS_SSLCVT) + bg * 64 * LS + tk0, LS, lane);
        cp_k16(dsa + (0 * 2 + g) * 64, 256, WSP(bf16, WS_SDSAK) + (bg * LS + tk0) * 64, lane);
        cp_vt16(dsa + (1 * 2 + g) * 64, 256, WSP(bf16, WS_SDSAVT) + bg * 64 * LS + tk0, LS, lane);
    }
    cp_k16(idx, 64, WSP(bf16, WS_SIDXK) + ((size_t)sb * LS + tk0) * 64, lane);
}
DI void p0_win_item(Frame& F, int item) {
    const int sb = item >> 5, w0 = (item & 31) * 16, lane = F.lane;
    const float* st = F.swin + ((size_t)sb * 512 + w0) * 256;
#pragma unroll
    for (int g = 0; g < 2; ++g) {
        const size_t bg = (size_t)sb * 2 + g;
        cp_k16(st + (0 * 2 + g) * 64, 256, WSP(bf16, WS_SWINK) + (bg * LSW + w0) * 64, lane);
        cp_vt16(st + (1 * 2 + g) * 64, 256, WSP(bf16, WS_SWINVT) + bg * 64 * LSW + w0, LSW, lane);
    }
}
DI void p0_zero_item(Frame& F, int item) {
    const int arr = item >> 8, bg = item & 255, lane = F.lane;
    bf16* p; int n;
    if (arr == 0) { p = WSP(bf16, WS_SSLCVT) + ((size_t)bg * 64 + lane) * LS + 2052; n = 60; }
    else if (arr == 1) { p = WSP(bf16, WS_SDSAVT) + ((size_t)bg * 64 + lane) * LS + 2052; n = 60; }
    else { p = WSP(bf16, WS_SWINVT) + ((size_t)bg * 64 + lane) * LSW + 516; n = 60; }
    unsigned long long* q = (unsigned long long*)p;
    for (int i = 0; i < n / 4; ++i) q[i] = 0ull;
}
DI void p0_prologue(Frame& F) {
    p0_mod(F);
    LAS float* scr = (LAS float*)(F.lds + F.wave * 16384);
    const int gw = blockIdx.x * NWAVES + F.wave, NGW = F.G * NWAVES;
    constexpr int I_WIN = 16 * 171, I_UP = 8 * 32, I_OUT = 16 * 32, I_W1 = 32 * 4;
    constexpr int T0 = I_WIN, T1 = T0 + I_UP, T2 = T1 + I_UP, T3 = T2 + I_OUT, T4 = T3 + 2 * I_W1, T5 = T4 + 2050, T6 = T5 + 512, T7 = T6 + 768, T8 = T7 + SBATCH * 32, T9 = T8 + SBATCH * 128;
#ifdef ORACLE
    constexpr int TEND = T9;
#else
    constexpr int TEND = T7;
#endif
    for (int it = gw; it < TEND; it += NGW) {
        if (it < T0) p0_transpose_item<true>(F.win, 1024, 5468, WSP(bf16, WS_WINT), scr, it, F.lane);
        else if (it < T1) p0_transpose_item<false>(F.wupn, 512, 1024, WSP(bf16, WS_WUPN), scr, it - T0, F.lane);
        else if (it < T2) p0_transpose_item<false>(F.wupd, 512, 1024, WSP(bf16, WS_WUPD), scr, it - T1, F.lane);
        else if (it < T3) p0_transpose_item<false>(F.wout, 1024, 1024, WSP(bf16, WS_WOUT), scr, it - T2, F.lane);
        else if (it < T4) { const int q = it - T3, slot = q / I_W1; p0_transpose_item<false>(F.w1 + (size_t)slot * 2048 * 128, 2048, 128, WSP(bf16, WS_W1T) + (size_t)slot * 128 * 2048, scr, q % I_W1, F.lane); }
        else if (it < T5) p0_rope_item(F, it - T4);
        else if (it < T6) p0_cmp_small_item(F, it - T5);
        else if (it < T7) p0_zero_item(F, it - T6);
#ifdef ORACLE
        else if (it < T8) p0_win_item(F, it - T7);
        else p0_gather_item(F, it - T8);
#endif
    }
    const size_t tot4 = (size_t)SBATCH * 508 * 64;
    for (size_t i = (size_t)blockIdx.x * 512 + F.tid; i < tot4; i += (size_t)F.G * 512) {
        const size_t sb = i / (508 * 64), rem = i % (508 * 64);
        ((f32x4*)(F.out + O_WINS))[sb * 512 * 64 + rem] = ((const f32x4*)F.swin)[sb * 512 * 64 + 4 * 64 + rem];
    }
}
DI void p1_adaln(Frame& F) {
    const int gw = blockIdx.x * NWAVES + F.wave, NGW = F.G * NWAVES;
    const float* mod = WSP(float, WS_MOD);
    for (int r = gw; r < MR; r += NGW) {
        const float* xr = r < MP ? F.xp + (size_t)r * 1024 : F.xs + (size_t)(r - MP) * 1024;
        const int mrow = r < MP ? (r >> 12) : 4 + ((r - MP) >> 2);
        const f32x4* x4 = (const f32x4*)xr + F.lane;
        f32x4 v[4]; float s = 0.f;
#pragma unroll
        for (int j = 0; j < 4; ++j) { v[j] = x4[64 * j]; s += (v[j][0] * v[j][0] + v[j][1] * v[j][1]) + (v[j][2] * v[j][2] + v[j][3] * v[j][3]); }
        const float rstd = 1.f / sqrtf(wave_sum(s) * (1.f / 1024.f) + 1e-6f);
        const f32x4* g4 = (const f32x4*)F.normg + F.lane;
        const f32x4* sh4 = (const f32x4*)(mod + (size_t)mrow * 3072) + F.lane;
        const f32x4* sc4 = (const f32x4*)(mod + (size_t)mrow * 3072 + 1024) + F.lane;
        unsigned long long* o8 = (unsigned long long*)(WSP(bf16, WS_H) + (size_t)r * 1024) + F.lane;
#pragma unroll
        for (int j = 0; j < 4; ++j) {
            const f32x4 y = v[j] * rstd * g4[64 * j]; const f32x4 h = y * (1.f + sc4[64 * j]) + sh4[64 * j];
            o8[64 * j] = (unsigned long long)pk2(h[0], h[1]) | ((unsigned long long)pk2(h[2], h[3]) << 32);
        }
    }
}
DI void p8_final(Frame& F) {
    const int gw = blockIdx.x * NWAVES + F.wave, NGW = F.G * NWAVES;
    for (int r = gw; r < MR; r += NGW) {
        float* yr = r < MP ? F.out + O_YP + (size_t)r * 1024 : F.out + O_YS + (size_t)(r - MP) * 1024;
        f32x4* y4 = (f32x4*)yr + F.lane;
        f32x4 v[4]; float s = 0.f;
#pragma unroll
        for (int j = 0; j < 4; ++j) { v[j] = y4[64 * j]; s += (v[j][0] * v[j][0] + v[j][1] * v[j][1]) + (v[j][2] * v[j][2] + v[j][3] * v[j][3]); }
        const float rstd = 1.f / sqrtf(wave_sum(s) * (1.f / 1024.f) + 1e-6f);
        const f32x4* g4 = (const f32x4*)F.fing + F.lane;
#pragma unroll
        for (int j = 0; j < 4; ++j) y4[64 * j] = v[j] * rstd * g4[64 * j];
    }
}

constexpr int TP = 144;
constexpr int TILE_B = 64 * TP;
struct LdsT {
    static constexpr bool HOIST = true;
    const LAS unsigned char* p;
    DI bf16x8 frag(int mt, int s) const { return *(const LAS bf16x8*)(p + mt * 32 * TP + s * 32); }
};
struct GlbT {
    static constexpr bool HOIST = false;
    const bf16* base; unsigned off; unsigned pitch;
    DI bf16x8 frag(int mt, int s) const { return *(const bf16x8*)(base + (size_t)(off + (unsigned)mt * 32u * pitch + (unsigned)s * 16u)); }
};
template <class KT> DI void qk_tile(f32x16& s0, f32x16& s1, const KT& kt, const bf16x8 (&q)[4]) {
    f32x16 z;
#pragma unroll
    for (int i = 0; i < 16; ++i) z[i] = 0.f;
    s0 = z; s1 = z;
#pragma unroll
    for (int s = 0; s < 4; ++s) { s0 = MFMA32(kt.frag(0, s), q[s], s0); s1 = MFMA32(kt.frag(1, s), q[s], s1); }
}
DI bf16x8 cvt8(f32x4 a, f32x4 b) { u32x4 w; w.x = pk2(a[0], a[1]); w.y = pk2(a[2], a[3]); w.z = pk2(b[0], b[1]); w.w = pk2(b[2], b[3]); return __builtin_bit_cast(bf16x8, w); }
DI bf16x8 pack_p(const f32x16& x, int h) {
    u32x4 w; w.x = pk2(x[8 * h], x[8 * h + 1]); w.y = pk2(x[8 * h + 2], x[8 * h + 3]); w.z = pk2(x[8 * h + 4], x[8 * h + 5]); w.w = pk2(x[8 * h + 6], x[8 * h + 7]);
    return __builtin_bit_cast(bf16x8, w);
}
template <class VT> DI void pv_tile(f32x16& o0, f32x16& o1, const f32x16& p0, const f32x16& p1, const VT& vt) {
    const bf16x8 b0 = pack_p(p0, 0), b1 = pack_p(p0, 1), b2 = pack_p(p1, 0), b3 = pack_p(p1, 1);
    o0 = MFMA32(vt.frag(0, 0), b0, o0); o1 = MFMA32(vt.frag(1, 0), b0, o1);
    o0 = MFMA32(vt.frag(0, 1), b1, o0); o1 = MFMA32(vt.frag(1, 1), b1, o1);
    o0 = MFMA32(vt.frag(0, 2), b2, o0); o1 = MFMA32(vt.frag(1, 2), b2, o1);
    o0 = MFMA32(vt.frag(0, 3), b3, o0); o1 = MFMA32(vt.frag(1, 3), b3, o1);
}
struct Soft { float m, l; bool seen; f32x16 o0, o1, negm; };
DI void soft_init(Soft& S) {
    S.m = 0.f; S.l = 0.f; S.seen = false;
#pragma unroll
    for (int i = 0; i < 16; ++i) { S.o0[i] = 0.f; S.o1[i] = 0.f; S.negm[i] = 0.f; }
}
template <class KT> DI void qk_tile_c(f32x16& s0, f32x16& s1, const KT& kt, const bf16x8 (&q)[4], const f32x16& c) {
    if constexpr (KT::HOIST) {
        bf16x8 f[8];
#pragma unroll
        for (int s = 0; s < 4; ++s) { f[2 * s] = kt.frag(0, s); f[2 * s + 1] = kt.frag(1, s); }
        __builtin_amdgcn_sched_barrier(0);
        s0 = MFMA32(f[0], q[0], c); s1 = MFMA32(f[1], q[0], c);
#pragma unroll
        for (int s = 1; s < 4; ++s) { s0 = MFMA32(f[2 * s], q[s], s0); s1 = MFMA32(f[2 * s + 1], q[s], s1); }
    } else {
        s0 = MFMA32(kt.frag(0, 0), q[0], c); s1 = MFMA32(kt.frag(1, 0), q[0], c);
#pragma unroll
        for (int s = 1; s < 4; ++s) { s0 = MFMA32(kt.frag(0, s), q[s], s0); s1 = MFMA32(kt.frag(1, s), q[s], s1); }
    }
    asm volatile("s_nop 15\n\ts_nop 7" : "+v"(s0), "+v"(s1));
}
DI float max3f(float a, float b, float c) { float r; asm("v_max3_f32 %0, %1, %2, %3" : "=v"(r) : "v"(a), "v"(b), "v"(c)); return r; }
template <class VT> DI void soft_step(Soft& S, f32x16& s0, f32x16& s1, const VT& vt) {
    bf16x8 vf[8];
    if constexpr (VT::HOIST) {
#pragma unroll
        for (int s = 0; s < 4; ++s) { vf[2 * s] = vt.frag(0, s); vf[2 * s + 1] = vt.frag(1, s); }
        __builtin_amdgcn_sched_barrier(0);
    }
    float mx = max3f(s0[0], s1[0], s0[1]), my = max3f(s1[1], s0[2], s1[2]);
#pragma unroll
    for (int r = 3; r < 15; r += 2) { mx = max3f(mx, s0[r], s1[r]); my = max3f(my, s0[r + 1], s1[r + 1]); }
    mx = max3f(mx, s0[15], s1[15]); mx = max3f(mx, my, mx);
    mx = max3f(mx, half_other(mx), mx);
    const bool fin = mx > NEGINF;
    const bool need = (mx > 8.f) | (fin & !S.seen);
    if (__any(need)) {
        const float dl = need ? mx : 0.f;
        const float al = S.seen ? __builtin_amdgcn_exp2f(-dl) : 0.f;
        S.m += dl; S.l *= need ? al : 1.f;
        const float am = need ? al : 1.f;
#pragma unroll
        for (int r = 0; r < 16; ++r) { s0[r] -= dl; s1[r] -= dl; S.o0[r] *= am; S.o1[r] *= am; S.negm[r] = -S.m; }
    }
    S.seen = S.seen | fin;
    float ps = 0.f;
#pragma unroll
    for (int r = 0; r < 16; ++r) { s0[r] = __builtin_amdgcn_exp2f(s0[r]); s1[r] = __builtin_amdgcn_exp2f(s1[r]); ps += s0[r] + s1[r]; }
    S.l += ps;
    const bf16x8 b0 = pack_p(s0, 0), b1 = pack_p(s0, 1), b2 = pack_p(s1, 0), b3 = pack_p(s1, 1);
    if constexpr (!VT::HOIST) {
#pragma unroll
        for (int s = 0; s < 4; ++s) { vf[2 * s] = vt.frag(0, s); vf[2 * s + 1] = vt.frag(1, s); }
    }
    S.o0 = MFMA32(vf[0], b0, S.o0); S.o1 = MFMA32(vf[1], b0, S.o1);
    S.o0 = MFMA32(vf[2], b1, S.o0); S.o1 = MFMA32(vf[3], b1, S.o1);
    S.o0 = MFMA32(vf[4], b2, S.o0); S.o1 = MFMA32(vf[5], b2, S.o1);
    S.o0 = MFMA32(vf[6], b3, S.o0); S.o1 = MFMA32(vf[7], b3, S.o1);
}
DI float as_f(int x) { return __int_as_float(x); }
DI float mask_sel(float s, int mm) { return __int_as_float((__float_as_int(s) & mm) | ((int)0xff800000 & ~mm)); }
DI u32x4 tile_ld(const bf16* g, size_t pitch, int tid) { return *(const u32x4*)(g + (size_t)(tid >> 3) * pitch + (tid & 7) * 8); }
DI void tile_st(LAS unsigned char* buf, u32x4 v, int tid) { *(LAS u32x4*)(buf + (tid >> 3) * TP + (tid & 7) * 16) = v; }

constexpr int CP = 272;
DI void compress_unit(Frame& F, int u) {
    const int tid = F.tid, lane = F.lane, w = F.wave, l31 = lane & 31, hi = lane >> 5;
    const int slot = u / 136, rem = u % 136;
    const bf16* data; bf16 *ock, *ocvt; int n0, ncmp, cpitch;
    if (rem < 8) { const int bg = rem; data = WSP(bf16, (slot ? WS_PCMPV : WS_PCMPK)) + (size_t)bg * SEQ * 64; n0 = 32 * w; ncmp = 255; cpitch = 256;
        ock = WSP(bf16, WS_PCK) + (size_t)bg * 256 * 64; ocvt = WSP(bf16, WS_PCVT) + (size_t)bg * 64 * 256; }
    else { const int bg = 2 * (rem - 8) + (w >> 2); data = WSP(bf16, (slot ? WS_SCMPV : WS_SCMPK)) + (size_t)bg * LS * 64; n0 = 32 * (w & 3); ncmp = 127; cpitch = 128;
        ock = WSP(bf16, WS_SCK) + (size_t)bg * 128 * 64; ocvt = WSP(bf16, WS_SCVT) + (size_t)bg * 64 * 128; }
    const int n = n0 + l31, nc = n < ncmp ? n : ncmp - 1;
    const bf16* drow = data + (size_t)nc * 1024 + 8 * hi;
    const bool paged = rem >= 8;
    const float *prA = nullptr, *prB = nullptr; int jsplit = 64;
    if (paged) { const int bg = 2 * (rem - 8) + (w >> 2), sb = bg >> 1, g = bg & 1, t0 = 16 * nc;
        const int pgA = F.ptab[sb * NPG + (t0 >> 7)], pgB = F.ptab[sb * NPG + ((t0 + 31) >> 7)];
        jsplit = 128 - (t0 & 127);
        prA = F.cnsa + ((size_t)pgA * PAGE + (t0 & 127)) * 512 + (slot * 2 + g) * 64 + 8 * hi;
        prB = F.cnsa + ((size_t)pgB * PAGE) * 512 + (slot * 2 + g) * 64 + 8 * hi - (size_t)jsplit * 512;
    }
    const bf16* w1t = WSP(bf16, WS_W1T) + (size_t)slot * 128 * 2048;
    f32x16 acc[4];
#pragma unroll
    for (int c = 0; c < 4; ++c)
#pragma unroll
        for (int i = 0; i < 16; ++i) acc[c][i] = 0.f;
    const bf16* wsrc = w1t + (size_t)(tid >> 2) * 2048 + (tid & 3) * 32;
    LAS unsigned char* wdst = F.lds + (tid >> 2) * CP + (tid & 3) * 64;
    u32x4 st[4];
#pragma unroll
    for (int i = 0; i < 4; ++i) st[i] = ((const u32x4*)wsrc)[i];
#pragma unroll
    for (int i = 0; i < 4; ++i) ((LAS u32x4*)wdst)[i] = st[i];
    __syncthreads();
    f32x4 raw[16];
#define CMP_ISSUE(kc_) do { if (!paged) { _Pragma("unroll") for (int s_ = 0; s_ < 8; ++s_) raw[2 * s_] = __builtin_bit_cast(f32x4, *(const bf16x8*)(drow + (kc_) * 128 + s_ * 16)); } \
        else { _Pragma("unroll") for (int s_ = 0; s_ < 8; ++s_) { const int j_ = 2 * (kc_) + (s_ >> 2); const f32x4* q_ = (const f32x4*)((j_ < jsplit ? prA : prB) + (size_t)j_ * 512 + 16 * (s_ & 3)); raw[2 * s_] = q_[0]; raw[2 * s_ + 1] = q_[1]; } } } while (0)
    CMP_ISSUE(0);
    for (int kc = 0; kc < 16; ++kc) {
        const LAS unsigned char* buf = F.lds + (kc & 1) * (128 * CP);
        if (kc + 1 < 16) {
#pragma unroll
            for (int i = 0; i < 4; ++i) st[i] = ((const u32x4*)(wsrc + (kc + 1) * 128))[i];
        }
        bf16x8 bq[8];
        if (!paged) {
#pragma unroll
            for (int s = 0; s < 8; ++s) bq[s] = __builtin_bit_cast(bf16x8, raw[2 * s]);
        } else {
#pragma unroll
            for (int s = 0; s < 8; ++s) bq[s] = cvt8(raw[2 * s], raw[2 * s + 1]);
        }
        if (kc + 1 < 16) CMP_ISSUE(kc + 1);
#pragma unroll
        for (int s = 0; s < 8; ++s)
#pragma unroll
            for (int c = 0; c < 4; ++c) acc[c] = MFMA32(*(const LAS bf16x8*)(buf + (32 * c + l31) * CP + s * 32 + hi * 16), bq[s], acc[c]);
        if (kc + 1 < 16) {
            LAS unsigned char* nb = wdst + ((kc + 1) & 1) * (128 * CP);
#pragma unroll
            for (int i = 0; i < 4; ++i) ((LAS u32x4*)nb)[i] = st[i];
        }
        __syncthreads();
    }
#undef CMP_ISSUE
    const float* b1 = WSP(float, WS_BIAS1) + slot * 128;
#pragma unroll
    for (int c = 0; c < 4; ++c)
#pragma unroll
        for (int q = 0; q < 4; ++q) { const f32x4 bv = *(const f32x4*)(b1 + 32 * c + 8 * q + 4 * hi);
#pragma unroll
            for (int j = 0; j < 4; ++j) acc[c][4 * q + j] = silu_f(acc[c][4 * q + j] + bv[j]); }
    const bf16* w2t = WSP(bf16, WS_W2T) + (size_t)slot * 64 * 128 + (size_t)l31 * 128 + 8 * hi;
    f32x16 o0, o1;
#pragma unroll
    for (int i = 0; i < 16; ++i) { o0[i] = 0.f; o1[i] = 0.f; }
#pragma unroll
    for (int c = 0; c < 4; ++c)
#pragma unroll
        for (int h = 0; h < 2; ++h) { const bf16x8 hb = pack_p(acc[c], h); const int s2 = 2 * c + h;
            o0 = MFMA32(*(const bf16x8*)(w2t + s2 * 16), hb, o0); o1 = MFMA32(*(const bf16x8*)(w2t + 32 * 128 + s2 * 16), hb, o1); }
    const bool ok = n < ncmp;
    if (slot == 0) {
#pragma unroll
        for (int e = 0; e < 2; ++e)
#pragma unroll
            for (int q = 0; q < 4; ++q) { const f32x16& o = e ? o1 : o0; u32x2 wv;
                wv.x = ok ? pk2(o[4 * q], o[4 * q + 1]) : 0u; wv.y = ok ? pk2(o[4 * q + 2], o[4 * q + 3]) : 0u;
                *(u32x2*)(ock + (size_t)n * 64 + 32 * e + 8 * q + 4 * hi) = wv; }
    } else {
        const int pn = permk(n);
#pragma unroll
        for (int e = 0; e < 2; ++e)
#pragma unroll
            for (int r = 0; r < 16; ++r) { const f32x16& o = e ? o1 : o0; ocvt[(size_t)(32 * e + crow(r, hi)) * cpitch + pn] = ok ? (bf16)(pk2(o[r], 0.f) & 0xffffu) : (bf16)0; }
    }
}

template <int NR> DI void idx_select(const LAS int* scw, int n, int lane, unsigned long long* out) {
    int k[NR];
    int kmin = 0x7fffffff, kmax = (int)0x80000000;
#pragma unroll
    for (int i = 0; i < NR; ++i) { const bool v = 64 * i + lane < n; const int x = v ? scw[64 * i + lane] : (int)0x80000000; k[i] = x; kmin = v ? (x < kmin ? x : kmin) : kmin; kmax = x > kmax ? x : kmax; }
    int thr = (int)0x80000000, cut = -1;
    if (n > 256) {
#pragma unroll
        for (int o = 1; o < 64; o <<= 1) { const int a = __shfl_xor(kmin, o), b = __shfl_xor(kmax, o); kmin = a < kmin ? a : kmin; kmax = b > kmax ? b : kmax; }
        int lo = __builtin_amdgcn_readfirstlane(kmin) - 1, hiv = __builtin_amdgcn_readfirstlane(kmax);
        bool found = false;
        while ((unsigned)hiv - (unsigned)lo > 1u) {
            const int mid = (int)((unsigned)lo + (((unsigned)hiv - (unsigned)lo) >> 1));
            int c = 0;
#pragma unroll
            for (int i0 = 0; i0 < NR; i0 += 8) {
                unsigned long long bm[8];
#pragma unroll
                for (int j = 0; j < 8; ++j) bm[j] = __ballot(k[i0 + j] > mid);
#pragma unroll
                for (int j = 0; j < 8; ++j) c += __popcll(bm[j]);
            }
            if (c == 256) { thr = mid; found = true; break; }
            if (c > 256) lo = mid; else hiv = mid;
        }
        if (!found) {
            thr = hiv; int cgt = 0;
#pragma unroll
            for (int i = 0; i < NR; ++i) cgt += __popcll(__ballot(k[i] > thr));
            const int need = 256 - cgt; int acc = 0; bool done = false;
#pragma unroll
            for (int i = 0; i < NR; ++i) {
                unsigned long long mk = __ballot(k[i] == thr); const int pc = __popcll(mk);
                if (!done && acc + pc >= need) { for (int q2 = 1; q2 < need - acc; ++q2) mk &= mk - 1; cut = 64 * i + (int)__builtin_ctzll(mk); done = true; }
                acc += pc;
            }
        }
    }
    unsigned long long myw = 0ull;
#pragma unroll
    for (int i = 0; i < NR; ++i) { const unsigned long long mk = __ballot((k[i] > thr) | ((k[i] == thr) & (64 * i + lane <= cut))); myw = (lane == i) ? mk : myw; }
    out[lane] = myw;
}
template <bool SAMPLE> DI void idx1_unit(Frame& F, int u) {
    const int lane = F.lane, w = F.wave, l31 = lane & 31, hi = lane >> 5, tl = l31 >> 2, hl = l31 & 3;
    int row0, nkmax, ntok; const bf16* ik;
    if (!SAMPLE) { const int b = u & 3, tc = 511 - (u >> 2); row0 = b * SEQ + 8 * tc; nkmax = 8 * tc + 8; ntok = 8; ik = WSP(bf16, WS_PIDXK) + (size_t)b * SEQ * 64; }
    else { row0 = MP + 4 * u; nkmax = PASTL + 4; ntok = 4; ik = WSP(bf16, WS_SIDXK) + (size_t)u * LS * 64; }
    const int rowq = row0 + (SAMPLE ? (tl & 3) : tl);
    bf16x8 q[4];
#pragma unroll
    for (int s = 0; s < 4; ++s) q[s] = *(const bf16x8*)(WSP(bf16, WS_IQ) + (size_t)rowq * 256 + hl * 64 + 16 * s + 8 * hi);
    f32x4 wq[4];
#pragma unroll
    for (int qq = 0; qq < 4; ++qq) { const int tk = 2 * qq + hi; wq[qq] = *(const f32x4*)(WSP(float, WS_IW) + (size_t)(row0 + (SAMPLE ? (tk & 3) : tk)) * 4); }
    PIN4(q); PIN4(wq);
    LAS int* sc = (LAS int*)F.lds;
    const int n32 = (nkmax + 31) >> 5;
    f32x4 raw[8]; bf16x8 kf[4];
    auto issue = [&](int kt) {
        if (SAMPLE && kt < 64) { const int pg = F.ptab[u * NPG + (kt >> 2)]; const f32x4* fp = (const f32x4*)(F.cidx + ((size_t)pg * PAGE + (kt & 3) * 32 + l31) * 64 + 8 * hi);
#pragma unroll
            for (int s = 0; s < 4; ++s) { raw[2 * s] = fp[4 * s]; raw[2 * s + 1] = fp[4 * s + 1]; } }
        else { const bf16* kp = ik + (size_t)(32 * kt + l31) * 64 + 8 * hi;
#pragma unroll
            for (int s = 0; s < 4; ++s) raw[2 * s] = __builtin_bit_cast(f32x4, *(const bf16x8*)(kp + 16 * s)); }
    };
    if (w < n32) issue(w);
    for (int kt = w; kt < n32; kt += NWAVES) {
        if (SAMPLE && kt < 64) {
#pragma unroll
            for (int s = 0; s < 4; ++s) kf[s] = cvt8(raw[2 * s], raw[2 * s + 1]);
        } else {
#pragma unroll
            for (int s = 0; s < 4; ++s) kf[s] = __builtin_bit_cast(bf16x8, raw[2 * s]);
        }
        if (kt + NWAVES < n32) issue(kt + NWAVES);
        f32x16 a;
#pragma unroll
        for (int i = 0; i < 16; ++i) a[i] = 0.f;
#pragma unroll
        for (int s = 0; s < 4; ++s) a = MFMA32(q[s], kf[s], a);
#pragma unroll
        for (int qq = 0; qq < 4; ++qq) {
            float v = fmaxf(a[4 * qq], 0.f) * wq[qq][0] + fmaxf(a[4 * qq + 1], 0.f) * wq[qq][1] + fmaxf(a[4 * qq + 2], 0.f) * wq[qq][2] + fmaxf(a[4 * qq + 3], 0.f) * wq[qq][3];
            int uu = __float_as_int(v); uu = (uu == (int)0x80000000) ? 0 : uu;
            sc[(2 * qq + hi) * 4096 + 32 * kt + l31] = uu ^ ((uu >> 31) & 0x7fffffff);
        }
    }
    __syncthreads();
    if (w < ntok) {
        const int n = SAMPLE ? (PASTL + 1 + w) : (row0 - (row0 & ~(SEQ - 1)) + w + 1);
        unsigned long long* out = WSP(unsigned long long, WS_SELM) + (size_t)(row0 + w) * 64;
        const LAS int* scw = sc + w * 4096;
        if (n <= 1024) idx_select<16>(scw, n, lane, out);
        else if (n <= 2048) idx_select<32>(scw, n, lane, out);
        else if (n <= 3072) idx_select<48>(scw, n, lane, out);
        else idx_select<64>(scw, n, lane, out);
    }
    __syncthreads();
}

constexpr int NSA_PS = 2 * 2 * TILE_B;
constexpr int NSA_WS = 8192 + 2048 + 64;
template <bool SAMPLE> DI void nsa_unit(Frame& F, int u) {
    const int tid = F.tid, lane = F.lane, w = F.wave, l31 = lane & 31, hi = lane >> 5, tl = l31 >> 2, hl = l31 & 3;
    int bg, g, row, qpos, ncmp, wlo, whi, n_ctile, n_stile, w_t0, w_t1, qt = 0;
    size_t cpitch, pitch, wpitch; const bf16 *ck, *cvt, *sk, *svt, *wk, *wvt; bool wr_ok;
    if (!SAMPLE) {
        bg = u & 7; qt = 63 - (u >> 3); g = bg & 1; const int t = 64 * qt + 8 * w + tl; row = (bg >> 1) * SEQ + t; qpos = t; ncmp = 255;
        cpitch = 256; pitch = SEQ; wpitch = SEQ;
        ck = WSP(bf16, WS_PCK) + (size_t)bg * 256 * 64; cvt = WSP(bf16, WS_PCVT) + (size_t)bg * 64 * 256;
        sk = WSP(bf16, WS_PSLCK) + (size_t)bg * SEQ * 64; svt = WSP(bf16, WS_PSLCVT) + (size_t)bg * 64 * SEQ;
        wk = WSP(bf16, WS_PWINK) + (size_t)bg * SEQ * 64; wvt = WSP(bf16, WS_PWINVT) + (size_t)bg * 64 * SEQ;
        wlo = qpos - 511; whi = qpos; n_ctile = (4 * qt + 2) / 64 + 1; n_stile = qt + 1; w_t0 = qt > 8 ? qt - 8 : 0; w_t1 = qt; wr_ok = true;
    } else {
        bg = u * 8 + w; g = bg & 1; const int i = tl & 3; row = MP + (bg >> 1) * 4 + i; qpos = PASTL + i; ncmp = 127;
        cpitch = 128; pitch = LS; wpitch = LSW;
        ck = WSP(bf16, WS_SCK) + (size_t)bg * 128 * 64; cvt = WSP(bf16, WS_SCVT) + (size_t)bg * 64 * 128;
        sk = WSP(bf16, WS_SSLCK) + (size_t)bg * LS * 64; svt = WSP(bf16, WS_SSLCVT) + (size_t)bg * 64 * LS;
        wk = WSP(bf16, WS_SWINK) + (size_t)bg * LSW * 64; wvt = WSP(bf16, WS_SWINVT) + (size_t)bg * 64 * LSW;
        wlo = 1 + i; whi = 512 + i; n_ctile = 2; n_stile = 33; w_t0 = 0; w_t1 = 8; wr_ok = tl < 4;
    }
    const int hq = 4 * g + hl;
    bf16x8 qraw[4], qrot[4];
#pragma unroll
    for (int s = 0; s < 4; ++s) qraw[s] = *(const bf16x8*)(WSP(bf16, WS_QRAW) + (size_t)row * 512 + hq * 64 + 16 * s + 8 * hi);
    LAS unsigned char* const lb = F.lds;
    LAS float* psum = (LAS float*)(lb + NSA_PS + w * NSA_WS);
    LAS float* impb = (LAS float*)(lb + NSA_PS + w * NSA_WS + 8192);
    LAS unsigned char* selb = lb + NSA_PS + w * NSA_WS + 8192 + 2048;
    const int fo = l31 * TP + hi * 16;
    const float* gp = WSP(float, WS_GATES) + (size_t)row * 24 + hq * 3;
    float g0 = gp[0], g1 = gp[1], g2 = gp[2];
    PIN4(qraw); asm volatile("" : "+v"(g0), "+v"(g1), "+v"(g2));
    f32x16 s0, s1;
    u32x4 rk, rv;
    Soft S;

    const int nvr = (qpos - 31) >> 4, nvis = nvr < ncmp - 1 ? nvr : ncmp - 1;
    float m = -1e30f, l = 0.f;
    if (!SAMPLE) { rk = tile_ld(ck, 64, tid); rv = tile_ld(cvt, cpitch, tid); tile_st(lb, rk, tid); tile_st(lb + TILE_B, rv, tid); __syncthreads(); }
    for (int ct = 0; ct < n_ctile; ++ct) {
        if (!SAMPLE) { if (ct + 1 < n_ctile) { rk = tile_ld(ck + (size_t)(ct + 1) * 64 * 64, 64, tid); rv = tile_ld(cvt + (ct + 1) * 64, cpitch, tid); } }
        if (!SAMPLE) { LdsT kt{lb + (ct & 1) * 2 * TILE_B + fo}; qk_tile(s0, s1, kt, qraw); }
        else { GlbT kt{ck, (unsigned)((64 * ct + l31) * 64 + 8 * hi), 64u}; qk_tile(s0, s1, kt, qraw); }
        float mx = -1e30f;
        const int nv2 = nvis - 64 * ct - 4 * hi;
#pragma unroll
        for (int r = 0; r < 16; ++r) { const int cr = (r & 3) + 8 * (r >> 2); s0[r] = cr <= nv2 ? s0[r] : NEGINF; s1[r] = cr + 32 <= nv2 ? s1[r] : NEGINF; mx = fmaxf(mx, fmaxf(s0[r], s1[r])); }
        mx = fmaxf(mx, half_other(mx));
        const float mn = fmaxf(m, mx); float ps = 0.f;
#pragma unroll
        for (int r = 0; r < 16; ++r) ps += __builtin_amdgcn_exp2f(s0[r] - mn) + __builtin_amdgcn_exp2f(s1[r] - mn);
        l = l * __builtin_amdgcn_exp2f(m - mn) + ps; m = mn;
        if (!SAMPLE) { if (ct + 1 < n_ctile) { tile_st(lb + ((ct + 1) & 1) * 2 * TILE_B, rk, tid); tile_st(lb + ((ct + 1) & 1) * 2 * TILE_B + TILE_B, rv, tid); } __syncthreads(); }
    }
    l += half_other(l);
    const float linv = l > 0.f ? 1.f / l : 0.f;
    soft_init(S);
    if (!SAMPLE) { rk = tile_ld(ck, 64, tid); rv = tile_ld(cvt, cpitch, tid); tile_st(lb, rk, tid); tile_st(lb + TILE_B, rv, tid); __syncthreads(); }
    for (int ct = 0; ct < n_ctile; ++ct) {
        if (!SAMPLE) { if (ct + 1 < n_ctile) { rk = tile_ld(ck + (size_t)(ct + 1) * 64 * 64, 64, tid); rv = tile_ld(cvt + (ct + 1) * 64, cpitch, tid); } }
        if (!SAMPLE) { LdsT kt{lb + (ct & 1) * 2 * TILE_B + fo}; qk_tile(s0, s1, kt, qraw); }
        else { GlbT kt{ck, (unsigned)((64 * ct + l31) * 64 + 8 * hi), 64u}; qk_tile(s0, s1, kt, qraw); }
        const int nv2 = nvis - 64 * ct - 4 * hi; LAS float* pw = psum + tl * 256 + 64 * ct + 4 * hi;
#pragma unroll
        for (int r = 0; r < 16; ++r) { const int cr = (r & 3) + 8 * (r >> 2);
            s0[r] = cr <= nv2 ? __builtin_amdgcn_exp2f(s0[r] - m) * linv : 0.f; s1[r] = cr + 32 <= nv2 ? __builtin_amdgcn_exp2f(s1[r] - m) * linv : 0.f;
            float a = s0[r]; a += dpp_x1(a); a += dpp_x2(a); float b = s1[r]; b += dpp_x1(b); b += dpp_x2(b);
            if (hl == 0) { pw[cr] = a; pw[cr + 32] = b; } }
        if (!SAMPLE) { LdsT vt{lb + (ct & 1) * 2 * TILE_B + TILE_B + fo}; pv_tile(S.o0, S.o1, s0, s1, vt); }
        else { GlbT vt{cvt, (unsigned)(l31 * (int)cpitch + 64 * ct + 8 * hi), (unsigned)cpitch}; pv_tile(S.o0, S.o1, s0, s1, vt); }
        if (!SAMPLE) { if (ct + 1 < n_ctile) { tile_st(lb + ((ct + 1) & 1) * 2 * TILE_B, rk, tid); tile_st(lb + ((ct + 1) & 1) * 2 * TILE_B + TILE_B, rv, tid); } __syncthreads(); }
    }
    LDS_WAIT();
    unsigned mlo, mhi;
    {
        const int tk = lane >> 3, jb = 8 * (lane & 7);
        const int qp = SAMPLE ? PASTL + (tk & 3) : 64 * qt + 8 * w + tk, cur = qp >> 6;
        float pv[33];
        const LAS f32x4* pp = (const LAS f32x4*)(psum + tk * 256 + 4 * jb);
#pragma unroll
        for (int i = 0; i < 8; ++i) { const f32x4 x = pp[i]; pv[1 + 4 * i] = x[0]; pv[2 + 4 * i] = x[1]; pv[3 + 4 * i] = x[2]; pv[4 + 4 * i] = x[3]; }
        pv[0] = jb > 0 ? psum[tk * 256 + 4 * jb - 1] : 0.f;
        float v[8];
#pragma unroll
        for (int jj = 0; jj < 8; ++jj) {
            const int j = jb + jj;
            float a = pv[4 * jj] + pv[4 * jj + 1] + pv[4 * jj + 2] + pv[4 * jj + 3];
            a += (4 * j + 3 < ncmp) ? pv[4 * jj + 4] : 0.f;
            a = ((j == 0) | (j == cur) | (j == cur - 1)) ? 1e4f : a;
            a = (j > cur) ? -1e30f : a;
            v[jj] = a;
        }
        LAS f32x4* ip = (LAS f32x4*)(impb + tk * 64 + jb);
        ip[0] = (f32x4){v[0], v[1], v[2], v[3]}; ip[1] = (f32x4){v[4], v[5], v[6], v[7]};
        LDS_WAIT();
        int cnt[8];
#pragma unroll
        for (int jj = 0; jj < 8; ++jj) cnt[jj] = 0;
        const LAS f32x4* ap = (const LAS f32x4*)(impb + tk * 64);
#pragma unroll 1
        for (int i4 = 0; i4 < 16; ++i4) {
            const f32x4 x = ap[i4];
#pragma unroll
            for (int e = 0; e < 4; ++e) { const int i = 4 * i4 + e; const float xi = x[e];
#pragma unroll
                for (int jj = 0; jj < 8; ++jj) cnt[jj] += ((xi > v[jj]) | ((xi == v[jj]) & (i < jb + jj))) ? 1 : 0; }
        }
        unsigned bits = 0;
#pragma unroll
        for (int jj = 0; jj < 8; ++jj) bits |= ((cnt[jj] < 16) & (jb + jj <= cur)) ? (1u << jj) : 0u;
        selb[tk * 8 + (lane & 7)] = (unsigned char)bits;
        LDS_WAIT();
        const LAS unsigned* sp = (const LAS unsigned*)(selb + tl * 8);
        mlo = sp[0]; mhi = sp[1];
    }
    LAS float* park = psum + lane;
#pragma unroll
    for (int i = 0; i < 16; ++i) { park[i * 64] = g0 * S.o0[i]; park[(16 + i) * 64] = g0 * S.o1[i]; }
#pragma unroll
    for (int s = 0; s < 4; ++s) qrot[s] = *(const bf16x8*)(WSP(bf16, WS_QROT) + (size_t)row * 512 + hq * 64 + 16 * s + 8 * hi);
    PIN4(qrot);
    soft_init(S);
    const int qrel = (qpos & 63) - 4 * hi;
    if (!SAMPLE) { rk = tile_ld(sk, 64, tid); rv = tile_ld(svt, pitch, tid); tile_st(lb, rk, tid); tile_st(lb + TILE_B, rv, tid); __syncthreads(); }
    for (int j = 0; j < n_stile; ++j) {
        if (!SAMPLE) { if (j + 1 < n_stile) { rk = tile_ld(sk + (size_t)(j + 1) * 64 * 64, 64, tid); rv = tile_ld(svt + (j + 1) * 64, pitch, tid); } }
        const bool bsel = ((j < 32 ? (mlo >> j) : (mhi >> (j - 32))) & 1u) != 0u;
        if (!SAMPLE) { LdsT kt{lb + (j & 1) * 2 * TILE_B + fo}; qk_tile_c(s0, s1, kt, qrot, S.negm); }
        else { GlbT kt{sk, (unsigned)((64 * j + l31) * 64 + 8 * hi), 64u}; qk_tile_c(s0, s1, kt, qrot, S.negm); }
        if (j == n_stile - 1) {
#pragma unroll
            for (int r = 0; r < 16; ++r) { const int cr = (r & 3) + 8 * (r >> 2); s0[r] = cr <= qrel ? s0[r] : NEGINF; s1[r] = cr + 32 <= qrel ? s1[r] : NEGINF; }
        } else {
#pragma unroll
            for (int r = 0; r < 16; ++r) { s0[r] = bsel ? s0[r] : NEGINF; s1[r] = bsel ? s1[r] : NEGINF; }
        }
        if (!SAMPLE) { LdsT vt{lb + (j & 1) * 2 * TILE_B + TILE_B + fo}; soft_step(S, s0, s1, vt); }
        else { GlbT vt{svt, (unsigned)(l31 * (int)pitch + 64 * j + 8 * hi), (unsigned)pitch}; soft_step(S, s0, s1, vt); }
        if (!SAMPLE) { if (j + 1 < n_stile) { tile_st(lb + ((j + 1) & 1) * 2 * TILE_B, rk, tid); tile_st(lb + ((j + 1) & 1) * 2 * TILE_B + TILE_B, rv, tid); } __syncthreads(); }
    }
    S.l += half_other(S.l);
    { const float sc = g1 / fmaxf(S.l, 1e-30f);
#pragma unroll
      for (int i = 0; i < 16; ++i) { park[i * 64] += sc * S.o0[i]; park[(16 + i) * 64] += sc * S.o1[i]; } }
    soft_init(S);
    if (!SAMPLE) { rk = tile_ld(wk + (size_t)w_t0 * 64 * 64, 64, tid); rv = tile_ld(wvt + w_t0 * 64, wpitch, tid); tile_st(lb, rk, tid); tile_st(lb + TILE_B, rv, tid); __syncthreads(); }
    for (int j = w_t0; j <= w_t1; ++j) {
        const int jr = j - w_t0;
        if (!SAMPLE) { if (j + 1 <= w_t1) { rk = tile_ld(wk + (size_t)(j + 1) * 64 * 64, 64, tid); rv = tile_ld(wvt + (j + 1) * 64, wpitch, tid); } }
        if (!SAMPLE) { LdsT kt{lb + (jr & 1) * 2 * TILE_B + fo}; qk_tile_c(s0, s1, kt, qrot, S.negm); }
        else { GlbT kt{wk, (unsigned)((64 * j + l31) * 64 + 8 * hi), 64u}; qk_tile_c(s0, s1, kt, qrot, S.negm); }
        if ((j == w_t0) | (j == w_t1)) {
            const int lo_r = wlo - 64 * j - 4 * hi, hi_r = whi - 64 * j - 4 * hi;
#pragma unroll
            for (int r = 0; r < 16; ++r) { const int k0 = (r & 3) + 8 * (r >> 2); s0[r] = ((k0 >= lo_r) & (k0 <= hi_r)) ? s0[r] : NEGINF; s1[r] = ((k0 + 32 >= lo_r) & (k0 + 32 <= hi_r)) ? s1[r] : NEGINF; }
        }
        if (!SAMPLE) { LdsT vt{lb + (jr & 1) * 2 * TILE_B + TILE_B + fo}; soft_step(S, s0, s1, vt); }
        else { GlbT vt{wvt, (unsigned)(l31 * (int)wpitch + 64 * j + 8 * hi), (unsigned)wpitch}; soft_step(S, s0, s1, vt); }
        if (!SAMPLE) { if (j + 1 <= w_t1) { tile_st(lb + ((jr + 1) & 1) * 2 * TILE_B, rk, tid); tile_st(lb + ((jr + 1) & 1) * 2 * TILE_B + TILE_B, rv, tid); } __syncthreads(); }
    }
    S.l += half_other(S.l);
#ifdef BREAK_WIN
    S.l *= 1.1f;
#endif
    f32x16 res0, res1;
    { const float sc = g2 / fmaxf(S.l, 1e-30f);
#pragma unroll
      for (int i = 0; i < 16; ++i) { res0[i] = park[i * 64] + sc * S.o0[i]; res1[i] = park[(16 + i) * 64] + sc * S.o1[i]; } }
    if (wr_ok) {
        const bf16* zp = WSP(bf16, WS_ZN) + (size_t)row * 512 + hq * 64 + 4 * hi;
        bf16* op = WSP(bf16, WS_ONZ) + (size_t)row * 512 + hq * 64 + 4 * hi;
#pragma unroll
        for (int e = 0; e < 2; ++e)
#pragma unroll
            for (int q = 0; q < 4; ++q) { const f32x16& o = e ? res1 : res0; const u32x2 z = *(const u32x2*)(zp + 32 * e + 8 * q);
                u32x2 wv; wv.x = pk2(o[4 * q] * bflo(z.x), o[4 * q + 1] * bfhi(z.x)); wv.y = pk2(o[4 * q + 2] * bflo(z.y), o[4 * q + 3] * bfhi(z.y));
                *(u32x2*)(op + 32 * e + 8 * q) = wv; }
    }
}

template <bool SAMPLE> DI void dsa_unit(Frame& F, int u) {
    const int tid = F.tid, lane = F.lane, w = F.wave, l31 = lane & 31, hi = lane >> 5, tl = l31 >> 2, hl = l31 & 3;
    int bg, g, row, nt; size_t pitch; const bf16 *dk, *dvt; bool wr_ok;
    if (!SAMPLE) { bg = u & 7; const int qt = 63 - (u >> 3); g = bg & 1; const int t = 64 * qt + 8 * w + tl; row = (bg >> 1) * SEQ + t; nt = qt + 1; pitch = SEQ;
        dk = WSP(bf16, WS_PDSAK) + (size_t)bg * SEQ * 64; dvt = WSP(bf16, WS_PDSAVT) + (size_t)bg * 64 * SEQ; wr_ok = true; }
    else { bg = u * 8 + w; g = bg & 1; const int i = tl & 3; row = MP + (bg >> 1) * 4 + i; nt = 33; pitch = LS;
        dk = WSP(bf16, WS_SDSAK) + (size_t)bg * LS * 64; dvt = WSP(bf16, WS_SDSAVT) + (size_t)bg * 64 * LS; wr_ok = tl < 4; }
    const int hq = 4 * g + hl;
    bf16x8 dq[4];
#pragma unroll
    for (int s = 0; s < 4; ++s) dq[s] = *(const bf16x8*)(WSP(bf16, WS_DQ) + (size_t)row * 512 + hq * 64 + 16 * s + 8 * hi);
    const unsigned long long* selp = WSP(unsigned long long, WS_SELM) + (size_t)row * 64;
    unsigned long long selw = selp[0];
    PIN4(dq); asm volatile("" : "+v"(selw));
    LAS unsigned char* const lb = F.lds;
    const int fo = l31 * TP + hi * 16;
    f32x16 s0, s1;
    u32x4 rk, rv;
    Soft S; soft_init(S);
    u32x4 rk2, rv2;
    auto body = [&](int j, u32x4& ck_, u32x4& cv_, u32x4& nk_, u32x4& nv_) {
        unsigned long long seln = 0ull;
        if (!SAMPLE) { if (j + 2 < nt) { nk_ = tile_ld(dk + (size_t)(j + 2) * 64 * 64, 64, tid); nv_ = tile_ld(dvt + (j + 2) * 64, pitch, tid); } }
        if (j + 1 < nt) seln = selp[j + 1];
        const int bo = (j % 3) * 2 * TILE_B;
        if (!SAMPLE) { LdsT kt{lb + bo + fo}; qk_tile_c(s0, s1, kt, dq, S.negm); }
        else { GlbT kt{dk, (unsigned)((64 * j + l31) * 64 + 8 * hi), 64u}; qk_tile_c(s0, s1, kt, dq, S.negm); }
#ifdef BREAK_DSA
        selw |= 0x1111111111111111ull;
#endif
        const unsigned wa = (unsigned)selw >> (4 * hi), wb = (unsigned)(selw >> 32) >> (4 * hi);
#pragma unroll
        for (int r = 0; r < 16; ++r) { const int bp = (r & 3) + 8 * (r >> 2);
            s0[r] = mask_sel(s0[r], (int)(wa << (31 - bp)) >> 31); s1[r] = mask_sel(s1[r], (int)(wb << (31 - bp)) >> 31); }
        if (!SAMPLE) { LdsT vt{lb + bo + TILE_B + fo}; soft_step(S, s0, s1, vt); }
        else { GlbT vt{dvt, (unsigned)(l31 * (int)pitch + 64 * j + 8 * hi), (unsigned)pitch}; soft_step(S, s0, s1, vt); }
        selw = seln;
        if (!SAMPLE) { if (j + 1 < nt) { LAS unsigned char* nb = lb + ((j + 1) % 3) * 2 * TILE_B; tile_st(nb, ck_, tid); tile_st(nb + TILE_B, cv_, tid); } __syncthreads(); }
    };
    if (!SAMPLE) { rk = tile_ld(dk, 64, tid); rv = tile_ld(dvt, pitch, tid); tile_st(lb, rk, tid); tile_st(lb + TILE_B, rv, tid);
        if (nt > 1) { rk = tile_ld(dk + (size_t)64 * 64, 64, tid); rv = tile_ld(dvt + 64, pitch, tid); }
        __syncthreads(); }
    for (int j = 0; j < nt; j += 2) { body(j, rk, rv, rk2, rv2); if (j + 1 < nt) body(j + 1, rk2, rv2, rk, rv); }
    S.l += half_other(S.l);
    if (wr_ok) {
        const float sc = 1.f / fmaxf(S.l, 1e-30f);
        const bf16* zp = WSP(bf16, WS_ZD) + (size_t)row * 512 + hq * 64 + 4 * hi;
        bf16* op = WSP(bf16, WS_ODZ) + (size_t)row * 512 + hq * 64 + 4 * hi;
#pragma unroll
        for (int e = 0; e < 2; ++e)
#pragma unroll
            for (int q = 0; q < 4; ++q) { const f32x16& o = e ? S.o1 : S.o0; const u32x2 z = *(const u32x2*)(zp + 32 * e + 8 * q);
                u32x2 wv; wv.x = pk2(o[4 * q] * sc * bflo(z.x), o[4 * q + 1] * sc * bfhi(z.x)); wv.y = pk2(o[4 * q + 2] * sc * bflo(z.y), o[4 * q + 3] * sc * bfhi(z.y));
                *(u32x2*)(op + 32 * e + 8 * q) = wv; }
    }
}

struct PageK {
    static constexpr bool HOIST = false;
    const float* p; unsigned stride;
    DI bf16x8 frag(int mt, int s) const { const f32x4* q = (const f32x4*)(p + (size_t)((unsigned)mt * 32u * stride + (unsigned)s * 16u)); return cvt8(q[0], q[1]); }
};
struct PageV {
    static constexpr bool HOIST = false;
    const float* p; unsigned stride;
    DI bf16x8 frag(int dt, int s) const {
        float v[8];
#pragma unroll
        for (int i = 0; i < 8; ++i) v[i] = p[(size_t)((unsigned)(16 * s + (i & 3) + 8 * (i >> 2)) * stride + (unsigned)dt * 32u)];
        return __builtin_bit_cast(bf16x8, pack8(v));
    }
};
constexpr int XCH_W = 34 * 64;
constexpr int XCH_BYTES = 8 * XCH_W * 4;
DI void xch_put(LAS float* x, const Soft& S, int lane) {
    const float lt = S.l + half_other(S.l);
    x[lane] = S.seen ? S.m : NEGINF; x[64 + lane] = lt;
#pragma unroll
    for (int r = 0; r < 16; ++r) { x[(2 + r) * 64 + lane] = S.o0[r]; x[(18 + r) * 64 + lane] = S.o1[r]; }
}
DI void xch_get(const LAS float* xb, int w, int lane, float (&out)[4]) {
    float mw[8], M = -1e30f;
#pragma unroll
    for (int i = 0; i < 8; ++i) { mw[i] = xb[i * XCH_W + lane]; M = fmaxf(M, mw[i]); }
    float L = 0.f, o[4] = {0.f, 0.f, 0.f, 0.f};
#pragma unroll
    for (int i = 0; i < 8; ++i) { const float wt = __builtin_amdgcn_exp2f(mw[i] - M); L += wt * xb[i * XCH_W + 64 + lane];
#pragma unroll
        for (int k = 0; k < 4; ++k) o[k] += wt * xb[i * XCH_W + (2 + 4 * w + k) * 64 + lane]; }
    const float inv = 1.f / fmaxf(L, 1e-30f);
#pragma unroll
    for (int k = 0; k < 4; ++k) out[k] = o[k] * inv;
}
DI void nsa_sample_unit(Frame& F, int bg) {
    const int lane = F.lane, w = F.wave, l31 = lane & 31, hi = lane >> 5, tl = l31 >> 2, hl = l31 & 3;
    const int sb = bg >> 1, g = bg & 1, i = tl & 3, row = MP + sb * 4 + i, qpos = PASTL + i, hq = 4 * g + hl;
    LAS unsigned char* const lb = F.lds;
    LAS float* xch = (LAS float*)lb;
    LAS float* cmpb = (LAS float*)(lb + XCH_BYTES);
    LAS unsigned* mskb = (LAS unsigned*)(lb + XCH_BYTES + 8192);
    LAS float* psum = (LAS float*)(lb + XCH_BYTES + 8192 + 64);
    LAS float* impb = psum + 8 * 256;
    LAS unsigned char* selb = (LAS unsigned char*)(impb + 8 * 64);
    const float* gp = WSP(float, WS_GATES) + (size_t)row * 24 + hq * 3;
    float g0 = gp[0], g1 = gp[1], g2 = gp[2];
    bf16x8 qrot[4];
#pragma unroll
    for (int s = 0; s < 4; ++s) qrot[s] = *(const bf16x8*)(WSP(bf16, WS_QROT) + (size_t)row * 512 + hq * 64 + 16 * s + 8 * hi);
    f32x16 s0, s1;
    Soft S;
    __syncthreads();
    if (w == 0) {
        const bf16* ck = WSP(bf16, WS_SCK) + (size_t)bg * 128 * 64; const bf16* cvt = WSP(bf16, WS_SCVT) + (size_t)bg * 64 * 128;
        bf16x8 qraw[4];
#pragma unroll
        for (int s = 0; s < 4; ++s) qraw[s] = *(const bf16x8*)(WSP(bf16, WS_QRAW) + (size_t)row * 512 + hq * 64 + 16 * s + 8 * hi);
        const int ncmp = 127, nvis = 126;
        float m = -1e30f, l = 0.f;
        for (int ct = 0; ct < 2; ++ct) {
            GlbT kt{ck, (unsigned)((64 * ct + l31) * 64 + 8 * hi), 64u}; qk_tile(s0, s1, kt, qraw);
            float mx = -1e30f; const int nv2 = nvis - 64 * ct - 4 * hi;
#pragma unroll
            for (int r = 0; r < 16; ++r) { const int cr = (r & 3) + 8 * (r >> 2); s0[r] = cr <= nv2 ? s0[r] : NEGINF; s1[r] = cr + 32 <= nv2 ? s1[r] : NEGINF; mx = fmaxf(mx, fmaxf(s0[r], s1[r])); }
            mx = fmaxf(mx, half_other(mx));
            const float mn = fmaxf(m, mx); float ps = 0.f;
#pragma unroll
            for (int r = 0; r < 16; ++r) ps += __builtin_amdgcn_exp2f(s0[r] - mn) + __builtin_amdgcn_exp2f(s1[r] - mn);
            l = l * __builtin_amdgcn_exp2f(m - mn) + ps; m = mn;
        }
        l += half_other(l);
        const float linv = l > 0.f ? 1.f / l : 0.f;
        soft_init(S);
        for (int ct = 0; ct < 2; ++ct) {
            GlbT kt{ck, (unsigned)((64 * ct + l31) * 64 + 8 * hi), 64u}; qk_tile(s0, s1, kt, qraw);
            const int nv2 = nvis - 64 * ct - 4 * hi; LAS float* pw = psum + tl * 256 + 64 * ct + 4 * hi;
#pragma unroll
            for (int r = 0; r < 16; ++r) { const int cr = (r & 3) + 8 * (r >> 2);
                s0[r] = cr <= nv2 ? __builtin_amdgcn_exp2f(s0[r] - m) * linv : 0.f; s1[r] = cr + 32 <= nv2 ? __builtin_amdgcn_exp2f(s1[r] - m) * linv : 0.f;
                float a = s0[r]; a += dpp_x1(a); a += dpp_x2(a); float b = s1[r]; b += dpp_x1(b); b += dpp_x2(b);
                if (hl == 0) { pw[cr] = a; pw[cr + 32] = b; } }
            GlbT vt{cvt, (unsigned)(l31 * 128 + 64 * ct + 8 * hi), 128u}; pv_tile(S.o0, S.o1, s0, s1, vt);
        }
#pragma unroll
        for (int r = 0; r < 16; ++r) { cmpb[r * 64 + lane] = S.o0[r]; cmpb[(16 + r) * 64 + lane] = S.o1[r]; }
        LDS_WAIT();
        {
            const int tk = lane >> 3, jb = 8 * (lane & 7), cur = 32;
            float pv[33];
            const LAS f32x4* pp = (const LAS f32x4*)(psum + tk * 256 + 4 * jb);
#pragma unroll
            for (int q = 0; q < 8; ++q) { const f32x4 x = pp[q]; pv[1 + 4 * q] = x[0]; pv[2 + 4 * q] = x[1]; pv[3 + 4 * q] = x[2]; pv[4 + 4 * q] = x[3]; }
            pv[0] = jb > 0 ? psum[tk * 256 + 4 * jb - 1] : 0.f;
            float v[8];
#pragma unroll
            for (int jj = 0; jj < 8; ++jj) { const int j = jb + jj;
                float a = pv[4 * jj] + pv[4 * jj + 1] + pv[4 * jj + 2] + pv[4 * jj + 3];
                a += (4 * j + 3 < ncmp) ? pv[4 * jj + 4] : 0.f;
                a = ((j == 0) | (j == cur) | (j == cur - 1)) ? 1e4f : a;
                a = (j > cur) ? -1e30f : a;
                v[jj] = a; }
            LAS f32x4* ip = (LAS f32x4*)(impb + tk * 64 + jb);
            ip[0] = (f32x4){v[0], v[1], v[2], v[3]}; ip[1] = (f32x4){v[4], v[5], v[6], v[7]};
            LDS_WAIT();
            int cnt[8];
#pragma unroll
            for (int jj = 0; jj < 8; ++jj) cnt[jj] = 0;
            const LAS f32x4* ap = (const LAS f32x4*)(impb + tk * 64);
#pragma unroll 1
            for (int i4 = 0; i4 < 16; ++i4) { const f32x4 x = ap[i4];
#pragma unroll
                for (int e = 0; e < 4; ++e) { const int ii = 4 * i4 + e; const float xi = x[e];
#pragma unroll
                    for (int jj = 0; jj < 8; ++jj) cnt[jj] += ((xi > v[jj]) | ((xi == v[jj]) & (ii < jb + jj))) ? 1 : 0; } }
            unsigned bits = 0;
#pragma unroll
            for (int jj = 0; jj < 8; ++jj) bits |= ((cnt[jj] < 16) & (jb + jj <= cur)) ? (1u << jj) : 0u;
            selb[tk * 8 + (lane & 7)] = (unsigned char)bits;
            LDS_WAIT();
            if (lane < 16) mskb[lane] = ((const LAS unsigned*)selb)[lane];
        }
    }
    __syncthreads();
    const unsigned mlo = mskb[tl * 2], mhi = mskb[tl * 2 + 1];
    PIN4(qrot); asm volatile("" : "+v"(g0), "+v"(g1), "+v"(g2));
    soft_init(S);
    for (int j = w; j < 32; j += NWAVES) {
        const int pg = F.ptab[sb * NPG + (j >> 1)];
        const float* base = F.cnsa + ((size_t)pg * PAGE + (j & 1) * 64) * 512 + (2 * 2 + g) * 64;
        PageK kt{base + (size_t)l31 * 512 + 8 * hi, 512u}; qk_tile_c(s0, s1, kt, qrot, S.negm);
        const bool bsel = ((mlo >> j) & 1u) != 0u;
#pragma unroll
        for (int r = 0; r < 16; ++r) { s0[r] = bsel ? s0[r] : NEGINF; s1[r] = bsel ? s1[r] : NEGINF; }
        PageV vt{base + 128 + (size_t)(4 * hi) * 512 + l31, 512u}; soft_step(S, s0, s1, vt);
    }
    if (w == 0) {
        const bf16* sk = WSP(bf16, WS_SSLCK) + (size_t)bg * LS * 64; const bf16* svt = WSP(bf16, WS_SSLCVT) + (size_t)bg * 64 * LS;
        GlbT kt{sk, (unsigned)((2048 + l31) * 64 + 8 * hi), 64u}; qk_tile_c(s0, s1, kt, qrot, S.negm);
        const int qrel = i - 4 * hi;
#pragma unroll
        for (int r = 0; r < 16; ++r) { const int cr = (r & 3) + 8 * (r >> 2); s0[r] = cr <= qrel ? s0[r] : NEGINF; s1[r] = cr + 32 <= qrel ? s1[r] : NEGINF; }
        GlbT vt{svt, (unsigned)(l31 * LS + 2048 + 8 * hi), (unsigned)LS}; soft_step(S, s0, s1, vt);
    }
    xch_put(xch + w * XCH_W, S, lane);
    __syncthreads();
    float acc[4], part[4];
    xch_get(xch, w, lane, part);
#pragma unroll
    for (int k = 0; k < 4; ++k) acc[k] = g1 * part[k] + g0 * cmpb[(4 * w + k) * 64 + lane];
    __syncthreads();
    soft_init(S);
    {
        const float* base = F.swin + ((size_t)sb * 512 + 64 * w) * 256 + g * 64;
        PageK kt{base + (size_t)l31 * 256 + 8 * hi, 256u}; qk_tile_c(s0, s1, kt, qrot, S.negm);
        if (w == 0) {
            const int lo_r = 1 + i - 4 * hi;
#pragma unroll
            for (int r = 0; r < 16; ++r) { const int k0 = (r & 3) + 8 * (r >> 2); s0[r] = k0 >= lo_r ? s0[r] : NEGINF; s1[r] = k0 + 32 >= lo_r ? s1[r] : NEGINF; }
        }
        PageV vt{base + 128 + (size_t)(4 * hi) * 256 + l31, 256u}; soft_step(S, s0, s1, vt);
    }
    if (w == 0) {
        const bf16* wk = WSP(bf16, WS_SWINK) + (size_t)bg * LSW * 64; const bf16* wvt = WSP(bf16, WS_SWINVT) + (size_t)bg * 64 * LSW;
        GlbT kt{wk, (unsigned)((512 + l31) * 64 + 8 * hi), 64u}; qk_tile_c(s0, s1, kt, qrot, S.negm);
        const int hi_r = i - 4 * hi;
#pragma unroll
        for (int r = 0; r < 16; ++r) { const int k0 = (r & 3) + 8 * (r >> 2); s0[r] = k0 <= hi_r ? s0[r] : NEGINF; s1[r] = k0 + 32 <= hi_r ? s1[r] : NEGINF; }
        GlbT vt{wvt, (unsigned)(l31 * LSW + 512 + 8 * hi), (unsigned)LSW}; soft_step(S, s0, s1, vt);
    }
    xch_put(xch + w * XCH_W, S, lane);
    __syncthreads();
    xch_get(xch, w, lane, part);
#ifdef BREAK_WIN
#pragma unroll
    for (int k = 0; k < 4; ++k) part[k] *= 0.9f;
#endif
    if (tl < 4) {
        const int d0 = 32 * (w >> 2) + 8 * (w & 3) + 4 * hi;
        const u32x2 z = *(const u32x2*)(WSP(bf16, WS_ZN) + (size_t)row * 512 + hq * 64 + d0);
        u32x2 wv; wv.x = pk2((acc[0] + g2 * part[0]) * bflo(z.x), (acc[1] + g2 * part[1]) * bfhi(z.x)); wv.y = pk2((acc[2] + g2 * part[2]) * bflo(z.y), (acc[3] + g2 * part[3]) * bfhi(z.y));
        *(u32x2*)(WSP(bf16, WS_ONZ) + (size_t)row * 512 + hq * 64 + d0) = wv;
    }
}
DI void dsa_sample_unit(Frame& F, int bg) {
    const int lane = F.lane, w = F.wave, l31 = lane & 31, hi = lane >> 5, tl = l31 >> 2, hl = l31 & 3;
    const int sb = bg >> 1, g = bg & 1, i = tl & 3, row = MP + sb * 4 + i, hq = 4 * g + hl;
    LAS float* xch = (LAS float*)F.lds;
    bf16x8 dq[4];
#pragma unroll
    for (int s = 0; s < 4; ++s) dq[s] = *(const bf16x8*)(WSP(bf16, WS_DQ) + (size_t)row * 512 + hq * 64 + 16 * s + 8 * hi);
    const unsigned long long* selp = WSP(unsigned long long, WS_SELM) + (size_t)row * 64;
    PIN4(dq);
    f32x16 s0, s1;
    Soft S; soft_init(S);
    for (int j = w; j < 32; j += NWAVES) {
        unsigned long long selw = selp[j];
        const int pg = F.ptab[sb * NPG + (j >> 1)];
        const float* base = F.cdsa + ((size_t)pg * PAGE + (j & 1) * 64) * 256 + g * 64;
        PageK kt{base + (size_t)l31 * 256 + 8 * hi, 256u}; qk_tile_c(s0, s1, kt, dq, S.negm);
#ifdef BREAK_DSA
        selw |= 0x1111111111111111ull;
#endif
        const unsigned wa = (unsigned)selw >> (4 * hi), wb = (unsigned)(selw >> 32) >> (4 * hi);
#pragma unroll
        for (int r = 0; r < 16; ++r) { const int bp = (r & 3) + 8 * (r >> 2);
            s0[r] = mask_sel(s0[r], (int)(wa << (31 - bp)) >> 31); s1[r] = mask_sel(s1[r], (int)(wb << (31 - bp)) >> 31); }
        PageV vt{base + 128 + (size_t)(4 * hi) * 256 + l31, 256u}; soft_step(S, s0, s1, vt);
    }
    if (w == 0) {
        const unsigned long long selw = selp[32];
        const bf16* dk = WSP(bf16, WS_SDSAK) + (size_t)bg * LS * 64; const bf16* dvt = WSP(bf16, WS_SDSAVT) + (size_t)bg * 64 * LS;
        GlbT kt{dk, (unsigned)((2048 + l31) * 64 + 8 * hi), 64u}; qk_tile_c(s0, s1, kt, dq, S.negm);
        const unsigned wa = (unsigned)selw >> (4 * hi), wb = (unsigned)(selw >> 32) >> (4 * hi);
#pragma unroll
        for (int r = 0; r < 16; ++r) { const int bp = (r & 3) + 8 * (r >> 2);
            s0[r] = mask_sel(s0[r], (int)(wa << (31 - bp)) >> 31); s1[r] = mask_sel(s1[r], (int)(wb << (31 - bp)) >> 31); }
        GlbT vt{dvt, (unsigned)(l31 * LS + 2048 + 8 * hi), (unsigned)LS}; soft_step(S, s0, s1, vt);
    }
    __syncthreads();
    xch_put(xch + w * XCH_W, S, lane);
    __syncthreads();
    float part[4];
    xch_get(xch, w, lane, part);
    if (tl < 4) {
        const int d0 = 32 * (w >> 2) + 8 * (w & 3) + 4 * hi;
        const u32x2 z = *(const u32x2*)(WSP(bf16, WS_ZD) + (size_t)row * 512 + hq * 64 + d0);
        u32x2 wv; wv.x = pk2(part[0] * bflo(z.x), part[1] * bfhi(z.x)); wv.y = pk2(part[2] * bflo(z.y), part[3] * bfhi(z.y));
        *(u32x2*)(WSP(bf16, WS_ODZ) + (size_t)row * 512 + hq * 64 + d0) = wv;
    }
}

template <class EF> DI void small_gemm(Frame& F, const bf16* A, const bf16* Bt, int K, const EF& ef) {
    const int lane = F.lane, w = F.wave, l31 = lane & 31, hi = lane >> 5;
    LAS float* red = (LAS float*)F.lds;
    for (int t = blockIdx.x; t < 256; t += F.G) {
        const int mt = t >> 5, nt = t & 31, kw = K >> 3, k0 = w * kw;
        const bf16* ap = A + (size_t)(MP + 64 * mt + l31) * K + k0 + 8 * hi;
        const bf16* bp = Bt + (size_t)(32 * nt + l31) * K + k0 + 8 * hi;
        f32x16 a0, a1;
#pragma unroll
        for (int i = 0; i < 16; ++i) { a0[i] = 0.f; a1[i] = 0.f; }
        for (int s = 0; s < kw; s += 16) {
            const bf16x8 b = *(const bf16x8*)(bp + s), x0 = *(const bf16x8*)(ap + s), x1 = *(const bf16x8*)(ap + (size_t)32 * K + s);
            a0 = MFMA32(x0, b, a0); a1 = MFMA32(x1, b, a1);
        }
        __syncthreads();
#pragma unroll
        for (int r = 0; r < 16; ++r) { red[(w * 32 + r) * 64 + lane] = a0[r]; red[(w * 32 + 16 + r) * 64 + lane] = a1[r]; }
        __syncthreads();
        const int m2 = w >> 2, q = w & 3;
#pragma unroll
        for (int j = 0; j < 4; ++j) {
            float v = 0.f;
#pragma unroll
            for (int i = 0; i < 8; ++i) v += red[(i * 32 + 16 * m2 + 4 * q + j) * 64 + lane];
            ef(MP + 64 * mt + 32 * m2 + 8 * q + 4 * hi + j, 32 * nt + l31, v);
        }
    }
    __syncthreads();
}

#ifdef ORACLE
constexpr size_t WS_ORC = 948 * MiB;
constexpr int ORC_ROWS = 128;
DI float blk_red(Frame& F, float v, bool ismax, LAS float* red) {
#pragma unroll
    for (int o = 1; o < 64; o <<= 1) { const float x = __shfl_xor(v, o); v = ismax ? fmaxf(v, x) : v + x; }
    __syncthreads();
    if (F.lane == 0) red[F.wave] = v;
    __syncthreads();
    float r = red[0];
    for (int i = 1; i < 8; ++i) r = ismax ? fmaxf(r, red[i]) : r + red[i];
    return r;
}
DI float dot64(const bf16* a, const bf16* b) { float s = 0.f; for (int d = 0; d < 64; ++d) s += bf2f(a[d]) * bf2f(b[d]); return s; }
DI void orc_softmax(Frame& F, LAS float* sc, LAS unsigned char* vf, int n, LAS float* red) {
    float mx = -3e38f;
    for (int k = F.tid; k < n; k += 512) if (vf[k]) mx = fmaxf(mx, sc[k]);
    mx = blk_red(F, mx, true, red);
    float sm = 0.f;
    for (int k = F.tid; k < n; k += 512) { const float p = vf[k] ? exp2f(sc[k] - mx) : 0.f; sc[k] = p; sm += p; }
    sm = blk_red(F, sm, false, red);
    const float inv = 1.f / fmaxf(sm, 1e-30f);
    for (int k = F.tid; k < n; k += 512) sc[k] *= inv;
    __syncthreads();
}
DI void oracle_row(Frame& F, int oi) {
    int row;
    if (oi < 96) { const int tl[24] = {0, 1, 30, 31, 32, 63, 64, 65, 127, 128, 255, 256, 257, 400, 511, 512, 513, 1000, 1023, 1024, 2047, 2500, 3583, 4095};
        int t = 0;
#pragma unroll
        for (int i = 0; i < 24; ++i) t = (oi % 24 == i) ? tl[i] : t;
        row = (oi / 24) * SEQ + t; }
    else { const int k = oi - 96; row = MP + (((k >> 2) * 37) % SBATCH) * 4 + (k & 3); }
    const bool samp = row >= MP;
    const int b = samp ? (row - MP) >> 2 : row >> 12, ti = samp ? (row & 3) : (row & 4095), qpos = samp ? PASTL + ti : ti;
    const int ncmp = samp ? 127 : 255; const size_t pitch = samp ? LS : SEQ, wpitch = samp ? LSW : SEQ, cpitch = samp ? 128 : 256;
    const int wlo = samp ? 1 + ti : (qpos - 511 > 0 ? qpos - 511 : 0), whi = samp ? 512 + ti : qpos;
    LAS float* sc = (LAS float*)F.lds;
    LAS float* s2 = sc + 4096;
    LAS float* psum = s2 + 4096;
    LAS float* imp = psum + 256;
    LAS float* resn = imp + 64;
    LAS float* resd = resn + 512;
    LAS float* red = resd + 512;
    LAS unsigned char* vf = (LAS unsigned char*)(red + 8);
    LAS unsigned char* selb = vf + 4096;
    const bf16* qraw = WSP(bf16, WS_QRAW) + (size_t)row * 512; const bf16* qrot = WSP(bf16, WS_QROT) + (size_t)row * 512;
    const bf16* dq = WSP(bf16, WS_DQ) + (size_t)row * 512; const bf16* iq = WSP(bf16, WS_IQ) + (size_t)row * 256;
    const float* gat = WSP(float, WS_GATES) + (size_t)row * 24; const float* iw = WSP(float, WS_IW) + (size_t)row * 4;
    const int nvr = (qpos - 31) >> 4, nvis = nvr < ncmp - 1 ? nvr : ncmp - 1, cur = qpos >> 6;
    for (int g = 0; g < 2; ++g) {
        const int bg = b * 2 + g;
        const bf16* ck = samp ? WSP(bf16, WS_SCK) + (size_t)bg * 128 * 64 : WSP(bf16, WS_PCK) + (size_t)bg * 256 * 64;
        const bf16* cvt = samp ? WSP(bf16, WS_SCVT) + (size_t)bg * 64 * 128 : WSP(bf16, WS_PCVT) + (size_t)bg * 64 * 256;
        const bf16* sk = samp ? WSP(bf16, WS_SSLCK) + (size_t)bg * LS * 64 : WSP(bf16, WS_PSLCK) + (size_t)bg * SEQ * 64;
        const bf16* svt = samp ? WSP(bf16, WS_SSLCVT) + (size_t)bg * 64 * LS : WSP(bf16, WS_PSLCVT) + (size_t)bg * 64 * SEQ;
        const bf16* wk = samp ? WSP(bf16, WS_SWINK) + (size_t)bg * LSW * 64 : WSP(bf16, WS_PWINK) + (size_t)bg * SEQ * 64;
        const bf16* wvt = samp ? WSP(bf16, WS_SWINVT) + (size_t)bg * 64 * LSW : WSP(bf16, WS_PWINVT) + (size_t)bg * 64 * SEQ;
        __syncthreads();
        if (F.tid < 256) psum[F.tid] = 0.f;
        for (int hl = 0; hl < 4; ++hl) {
            const int h = 4 * g + hl;
            __syncthreads();
            for (int n = F.tid; n < 256; n += 512) { const bool v = n <= nvis; vf[n] = v; sc[n] = v ? dot64(qraw + h * 64, ck + (size_t)n * 64) : 0.f; }
            __syncthreads();
            orc_softmax(F, sc, vf, 256, red);
            if (F.tid < 256) psum[F.tid] += sc[F.tid];
            if (F.tid < 64) { float a = 0.f; for (int n = 0; n <= nvis; ++n) a += sc[n] * bf2f(cvt[(size_t)F.tid * cpitch + permk(n)]); resn[h * 64 + F.tid] = gat[h * 3 + 0] * a; }
        }
        __syncthreads();
        if (F.tid < 64) { const int j = F.tid; float a = 0.f;
            for (int n = 4 * j - 1; n <= 4 * j + 3; ++n) if (n >= 0 && n < ncmp) a += psum[n];
            if (j == 0 || j == cur || j == cur - 1) a = 1e4f;
            if (j > cur) a = -1e30f;
            imp[j] = a; selb[j] = 0; }
        __syncthreads();
        if (F.tid == 0) { for (int k = 0; k < 16; ++k) { int best = -1; float bv = -3e38f; for (int j = 0; j < 64; ++j) if (!selb[j] && imp[j] > bv) { bv = imp[j]; best = j; }
                if (best >= 0) selb[best] = (bv > -5e29f) ? 1 : 2; }
            for (int j = 0; j < 64; ++j) selb[j] = selb[j] == 1 ? 1 : 0; }
        __syncthreads();
        for (int hl = 0; hl < 4; ++hl) {
            const int h = 4 * g + hl;
            __syncthreads();
            for (int k = F.tid; k <= qpos; k += 512) { const bool v = selb[k >> 6] != 0; vf[k] = v; sc[k] = v ? dot64(qrot + h * 64, sk + (size_t)k * 64) : 0.f; }
            __syncthreads();
            orc_softmax(F, sc, vf, qpos + 1, red);
            if (F.tid < 64) { float a = 0.f; for (int k = 0; k <= qpos; ++k) if (vf[k]) a += sc[k] * bf2f(svt[(size_t)F.tid * pitch + permk(k)]); resn[h * 64 + F.tid] += gat[h * 3 + 1] * a; }
            __syncthreads();
            for (int k = wlo + F.tid; k <= whi; k += 512) { vf[k - wlo] = 1; sc[k - wlo] = dot64(qrot + h * 64, wk + (size_t)k * 64); }
            __syncthreads();
            orc_softmax(F, sc, vf, whi - wlo + 1, red);
            if (F.tid < 64) { float a = 0.f; for (int k = wlo; k <= whi; ++k) a += sc[k - wlo] * bf2f(wvt[(size_t)F.tid * wpitch + permk(k)]); resn[h * 64 + F.tid] += gat[h * 3 + 2] * a; }
        }
    }
    __syncthreads();
    const bf16* ik = samp ? WSP(bf16, WS_SIDXK) + (size_t)b * LS * 64 : WSP(bf16, WS_PIDXK) + (size_t)b * SEQ * 64;
    for (int k = F.tid; k <= qpos; k += 512) { float a = 0.f; for (int h = 0; h < 4; ++h) a += fmaxf(dot64(iq + h * 64, ik + (size_t)k * 64), 0.f) * iw[h]; s2[k] = a; }
    __syncthreads();
    for (int k = F.tid; k <= qpos; k += 512) { const float v = s2[k]; int c = 0; for (int j = 0; j <= qpos; ++j) { const float x = s2[j]; c += (x > v || (x == v && j < k)) ? 1 : 0; } vf[k] = c < 256; }
    __syncthreads();
    for (int h = 0; h < 8; ++h) {
        const int bg = b * 2 + (h >> 2);
        const bf16* dk = samp ? WSP(bf16, WS_SDSAK) + (size_t)bg * LS * 64 : WSP(bf16, WS_PDSAK) + (size_t)bg * SEQ * 64;
        const bf16* dvt = samp ? WSP(bf16, WS_SDSAVT) + (size_t)bg * 64 * LS : WSP(bf16, WS_PDSAVT) + (size_t)bg * 64 * SEQ;
        __syncthreads();
        for (int k = F.tid; k <= qpos; k += 512) sc[k] = vf[k] ? dot64(dq + h * 64, dk + (size_t)k * 64) : 0.f;
        __syncthreads();
        orc_softmax(F, sc, vf, qpos + 1, red);
        if (F.tid < 64) { float a = 0.f; for (int k = 0; k <= qpos; ++k) if (vf[k]) a += sc[k] * bf2f(dvt[(size_t)F.tid * pitch + permk(k)]); resd[h * 64 + F.tid] = a; }
    }
    __syncthreads();
    float dn = 0.f, rn = 0.f, dd = 0.f, rd = 0.f;
    { const int e = F.tid;
      const float zn = bf2f(WSP(bf16, WS_ZN)[(size_t)row * 512 + e]), zd = bf2f(WSP(bf16, WS_ZD)[(size_t)row * 512 + e]);
      const float refn = resn[e] * zn, refd = resd[e] * zd;
      const float gotn = bf2f(WSP(bf16, WS_ONZ)[(size_t)row * 512 + e]), gotd = bf2f(WSP(bf16, WS_ODZ)[(size_t)row * 512 + e]);
      dn = (gotn - refn) * (gotn - refn); rn = refn * refn; dd = (gotd - refd) * (gotd - refd); rd = refd * refd; }
    dn = blk_red(F, dn, false, red); rn = blk_red(F, rn, false, red); dd = blk_red(F, dd, false, red); rd = blk_red(F, rd, false, red);
    float dc = 0.f, rc = 0.f;
    {
        const bool cs = oi >= 96; const int cbg = cs ? (oi * 5) % 256 : oi % 8, cn = cs ? (oi * 11) % 127 : (oi * 13) % 255;
        for (int slot = 0; slot < 2; ++slot) {
            const bf16* data = cs ? WSP(bf16, slot ? WS_SCMPV : WS_SCMPK) + (size_t)cbg * LS * 64 + (size_t)cn * 1024 : WSP(bf16, slot ? WS_PCMPV : WS_PCMPK) + (size_t)cbg * SEQ * 64 + (size_t)cn * 1024;
            __syncthreads();
            if (F.tid < 128) { float a = 0.f; for (int k = 0; k < 2048; ++k) a += (bf2f(data[k]) + F.pe[slot * 2048 + k]) * F.w1[((size_t)slot * 2048 + k) * 128 + F.tid]; sc[F.tid] = a / (1.f + expf(-a)); }
            __syncthreads();
            if (F.tid < 64) { float a = 0.f; for (int c = 0; c < 128; ++c) a += sc[c] * F.w2[((size_t)slot * 128 + c) * 64 + F.tid];
                float got;
                if (slot == 0) got = bf2f((cs ? WSP(bf16, WS_SCK) + (size_t)cbg * 128 * 64 : WSP(bf16, WS_PCK) + (size_t)cbg * 256 * 64)[(size_t)cn * 64 + F.tid]);
                else got = bf2f((cs ? WSP(bf16, WS_SCVT) + (size_t)cbg * 64 * 128 : WSP(bf16, WS_PCVT) + (size_t)cbg * 64 * 256)[(size_t)F.tid * (cs ? 128 : 256) + permk(cn)]);
                dc += (got - a) * (got - a); rc += a * a; }
        }
    }
    dc = blk_red(F, dc, false, red); rc = blk_red(F, rc, false, red);
    if (F.tid == 0) { float* o = WSP(float, WS_ORC) + oi * 8; o[0] = dn; o[1] = rn; o[2] = dd; o[3] = rd; o[4] = dc; o[5] = rc; }
    __syncthreads();
}
DI float oracle_value(Frame& F) {
    const float* o = WSP(float, WS_ORC);
    float bad = 0.f, acc = 0.f, mxe = 0.f;
    for (int i = 0; i < ORC_ROWS; ++i) { const int c = (ORACLE_MODE >= 6) ? 4 : (ORACLE_MODE & 1) ? 2 : 0; const float e = sqrtf(o[i * 8 + c] / fmaxf(o[i * 8 + c + 1], 1e-30f));
        bad += e > 0.03f ? 1.f : 0.f; acc += fminf(e, 1.f) * fminf(e, 1.f); mxe = fmaxf(mxe, fminf(e, 1.f)); }
    return (ORACLE_MODE < 2 || ORACLE_MODE == 6) ? bad / ORC_ROWS : (ORACLE_MODE < 4 || ORACLE_MODE == 7) ? sqrtf(acc / ORC_ROWS) : mxe;
}
#endif

#define XB_TMO      128
#define XB_XCNT(j)  (256  + 64 * (j))
#define XB_XSUB(j)  (1280 + 64 * (j))
#define XB_XGEN(j)  (2304 + 64 * (j))
#define XB_TOP      3328
#define XB_TOPGEN   3392
#define XCD_BAR_WORDS 3456
#define XB_SPIN_CAP (1u << 18)
__device__ __forceinline__ unsigned xb_ld(unsigned* p)              { return __hip_atomic_load(p, __ATOMIC_RELAXED, __HIP_MEMORY_SCOPE_AGENT); }
__device__ __forceinline__ unsigned xb_add(unsigned* p, unsigned v) { return __hip_atomic_fetch_add(p, v, __ATOMIC_RELAXED, __HIP_MEMORY_SCOPE_AGENT); }
__device__ __forceinline__ unsigned xb_xcc_id() { return (unsigned)__builtin_amdgcn_s_getreg((3 << 11) | 20) & 0xFu; }
#define XB_SPIN(cond, bar) do { unsigned _sp = 0; while (cond) { __builtin_amdgcn_s_sleep(1); \
    if ((++_sp & 255u) == 0u) { if (xb_ld(&(bar)[XB_TMO])) break; if (_sp > XB_SPIN_CAP) { atomicAdd(&(bar)[XB_TMO], 1u); break; } } } } while (0)
struct XcdBarrier { unsigned* bar; unsigned x; volatile LAS unsigned* st; };
__device__ __forceinline__ XcdBarrier xcd_barrier_post(unsigned* bar, volatile LAS unsigned* st) {
    XcdBarrier b; b.bar = bar; b.x = xb_xcc_id(); b.st = st;
    if (threadIdx.x == 0) (void)xb_add(&bar[XB_XCNT(b.x)], 1u);
    return b;
}
__device__ __forceinline__ void xcd_barrier_complete(unsigned* bar, unsigned x, unsigned& nloc, unsigned& nx) {
    const unsigned G = gridDim.x * gridDim.y * gridDim.z;
    unsigned sum, cnt, mine, sp = 0u;
    for (;;) {
        sum = 0u; cnt = 0u; mine = 0u;
#pragma unroll
        for (unsigned j = 0; j < 16; ++j) { const unsigned c = xb_ld(&bar[XB_XCNT(j)]); sum += c; cnt += (c > 0u) ? 1u : 0u; mine = (j == x) ? c : mine; }
        if (sum == G) break;
        __builtin_amdgcn_s_sleep(1);
        if ((++sp & 255u) == 0u) { if (xb_ld(&bar[XB_TMO])) break; if (sp > XB_SPIN_CAP) { atomicAdd(&bar[XB_TMO], 1u); break; } }
    }
    nloc = mine > 0u ? mine : 1u; nx = cnt > 0u ? cnt : 1u;
}
__device__ __forceinline__ void xcd_barrier(const XcdBarrier& b) {
    asm volatile("s_waitcnt vmcnt(0)" ::: "memory");
    __syncthreads();
    if (threadIdx.x == 0) {
        unsigned* bar = b.bar;
        __builtin_amdgcn_s_waitcnt(0);
        unsigned nloc = b.st[0], nx = b.st[1];
        if (nloc == 0u) { xcd_barrier_complete(bar, b.x, nloc, nx); b.st[0] = nloc; b.st[1] = nx; }
        const unsigned old = xb_add(&bar[XB_XSUB(b.x)], 1u);
        const unsigned gen = old / nloc;
        if (old + 1u == (gen + 1u) * nloc) {
            __builtin_amdgcn_fence(__ATOMIC_RELEASE, "agent");
            asm volatile("s_waitcnt vmcnt(0)" ::: "memory");
            const unsigned og = xb_add(&bar[XB_TOP], 1u);
            const unsigned tg = og / nx;
            if (og + 1u == (tg + 1u) * nx) xb_add(&bar[XB_TOPGEN], 1u);
            else XB_SPIN(xb_ld(&bar[XB_TOPGEN]) == tg, bar);
            __builtin_amdgcn_fence(__ATOMIC_ACQUIRE, "agent");
            xb_add(&bar[XB_XGEN(b.x)], 1u);
            asm volatile("s_waitcnt vmcnt(0)" ::: "memory");
        } else {
            XB_SPIN(xb_ld(&bar[XB_XGEN(b.x)]) == gen, bar);
            __builtin_amdgcn_fence(__ATOMIC_ACQUIRE, "agent");
            asm volatile("s_waitcnt vmcnt(0)" ::: "memory");
        }
    }
    __syncthreads();
}

constexpr int N_PHASES = 9;
DI int q_next(Frame& F, int qi) {
    __syncthreads();
    if (F.tid == 0) F.MISC[0] = __hip_atomic_fetch_add(F.ctl + CW_Q + 64 * qi, 1u, __ATOMIC_RELAXED, __HIP_MEMORY_SCOPE_AGENT);
    __syncthreads();
    return (int)F.MISC[0];
}
__global__ void __launch_bounds__(NWAVES * 64, 2) fwd(Args args) {
    extern __shared__ __attribute__((aligned(16))) unsigned char lds[];
    Frame F;
    F.lds = (LAS unsigned char*)lds; F.MISC = (volatile LAS unsigned*)(F.lds + MISC_OFF);
    F.tid = threadIdx.x; F.lane = F.tid & 63; F.wave = __builtin_amdgcn_readfirstlane(F.tid >> 6); F.G = gridDim.x;
    F.ws = args.ws; F.out = args.out; F.ctl = (unsigned*)(args.ws + WS_CTL);
    F.xp = (const float*)args.in[0]; F.xs = (const float*)args.in[1]; F.cnsa = (const float*)args.in[2]; F.cdsa = (const float*)args.in[3]; F.cidx = (const float*)args.in[4];
    F.swin = (const float*)args.in[5]; F.ptab = (const int*)args.in[6]; F.cp = (const float*)args.in[7]; F.cs = (const float*)args.in[8]; F.normg = (const float*)args.in[9];
    F.wada = (const float*)args.in[10]; F.bada = (const float*)args.in[11]; F.win = (const float*)args.in[12]; F.pe = (const float*)args.in[13]; F.w1 = (const float*)args.in[14];
    F.w2 = (const float*)args.in[15]; F.wupn = (const float*)args.in[16]; F.wupd = (const float*)args.in[17]; F.wout = (const float*)args.in[18]; F.fing = (const float*)args.in[19];
    for (int i = F.tid; i < (LDS_BYTES - MISC_OFF) / 4; i += NWAVES * 64) ((LAS unsigned*)(F.lds + MISC_OFF))[i] = 0u;
    __syncthreads();
    const int lo = args.ph_lo, hi = args.ph_hi;
    const bool one = (hi - lo) > 1;
    XcdBarrier bar; bar.bar = F.ctl + CW_BAR; bar.x = 0; bar.st = nullptr;
    if (one) bar = xcd_barrier_post(F.ctl + CW_BAR, F.MISC + 8);
#ifndef PH_MASK
#define PH_MASK 0x1ff
#endif
#define IN(k) (((PH_MASK >> (k)) & 1) && lo <= (k) && (k) < hi)
#define SEAM(k) do { if (IN(k) && IN((k) + 1)) xcd_barrier(bar); } while (0)

#ifndef PROBE_REP
#define PROBE_REP -1
#endif
#define REP(k, BODY) do { if (IN(k)) { BODY(0) if (PROBE_REP == (k)) { xcd_barrier(bar); BODY(8) } } } while (0)
#ifndef PROBE_P4MASK
#define PROBE_P4MASK 15
#endif
#define B0(qo) { p0_prologue(F); }
#define B1(qo) { p1_adaln(F); }
#define B2(qo) { pg8::Gemm g{WSP(bf16, WS_H), WSP(bf16, WS_WINT), MR, NPAD, DM}; pg8::StaticOrder S; S.init(MR, NPAD, F.G, (int)blockIdx.x); \
        if (qo) { EpiInProjT<PROBE_P4MASK> E0{F.ws, F.out}; pg8::gemm_phase<EpiInProjT<PROBE_P4MASK>, pg8::StaticOrder, true, true>(F.lds, g, S, E0); } else { EpiInProj E{F.ws, F.out}; pg8::gemm_phase<EpiInProj, pg8::StaticOrder, true, true>(F.lds, g, S, E); } }
#define B3(qo) { constexpr int PM3_ = (qo) ? PROBE_P4MASK : 15; if (PM3_ & 1) for (int u = q_next(F, 0 + qo); u < 272; u = q_next(F, 0 + qo)) compress_unit(F, u); \
        if (PM3_ & 2) for (int u = q_next(F, 1 + qo); u < 2048; u = q_next(F, 1 + qo)) idx1_unit<false>(F, u); \
        if (PM3_ & 4) for (int u = q_next(F, 2 + qo); u < SBATCH; u = q_next(F, 2 + qo)) idx1_unit<true>(F, u); }
#ifndef P4_MASK
#define P4_MASK 15
#endif
#define B4(qo) { constexpr int PM_ = (qo) ? PROBE_P4MASK : P4_MASK; if (PM_ & 1) for (int u = q_next(F, 3 + qo); u < 256; u = q_next(F, 3 + qo)) nsa_sample_unit(F, u); \
        if (PM_ & 2) for (int u = q_next(F, 4 + qo); u < 256; u = q_next(F, 4 + qo)) dsa_sample_unit(F, u); \
        if (PM_ & 4) for (int u = q_next(F, 5 + qo); u < 512; u = q_next(F, 5 + qo)) nsa_unit<false>(F, u); \
        if (PM_ & 8) for (int u = q_next(F, 6 + qo); u < 512; u = q_next(F, 6 + qo)) dsa_unit<false>(F, u); }
#define B5(qo) { small_gemm(F, WSP(bf16, WS_ONZ), WSP(bf16, WS_WUPN), 512, [&](int r, int c, float v) { WSP(float, WS_T1)[(size_t)r * 1024 + c] = v * bf2f(WSP(bf16, WS_MG)[(size_t)r * 2048 + c]); }); \
        pg8::Gemm g{WSP(bf16, WS_ONZ), WSP(bf16, WS_WUPN), MP, DM, 512}; pg8::StaticOrder S; S.init(MP, DM, F.G, (int)blockIdx.x); EpiUp1 E{F.ws}; \
        pg8::gemm_phase<EpiUp1, pg8::StaticOrder, true, true>(F.lds, g, S, E); }
#define B6(qo) { small_gemm(F, WSP(bf16, WS_ODZ), WSP(bf16, WS_WUPD), 512, [&](int r, int c, float v) { WSP(bf16, WS_M1)[(size_t)r * 1024 + c] = (bf16)(pk2(WSP(float, WS_T1)[(size_t)r * 1024 + c] + v * bf2f(WSP(bf16, WS_MG)[(size_t)r * 2048 + 1024 + c]), 0.f) & 0xffffu); }); \
        pg8::Gemm g{WSP(bf16, WS_ODZ), WSP(bf16, WS_WUPD), MP, DM, 512}; pg8::StaticOrder S; S.init(MP, DM, F.G, (int)blockIdx.x); EpiUp2 E{F.ws}; \
        pg8::gemm_phase<EpiUp2, pg8::StaticOrder, true, true>(F.lds, g, S, E); }
#define B7(qo) { small_gemm(F, WSP(bf16, WS_M1), WSP(bf16, WS_WOUT), 1024, [&](int r, int c, float v) { const int rs = r - MP; F.out[O_YS + (size_t)rs * 1024 + c] = F.xs[(size_t)rs * 1024 + c] + WSP(float, WS_MOD)[(size_t)(4 + (rs >> 2)) * 3072 + 2048 + c] * v; }); \
        pg8::Gemm g{WSP(bf16, WS_M1), WSP(bf16, WS_WOUT), MP, DM, DM}; pg8::StaticOrder S; S.init(MP, DM, F.G, (int)blockIdx.x); EpiOut E{F.ws, F.out, F.xp, F.xs}; \
        pg8::gemm_phase<EpiOut, pg8::StaticOrder, true, true>(F.lds, g, S, E); }
#define B8(qo) { p8_final(F); }
    REP(0, B0); SEAM(0);
    REP(1, B1); SEAM(1);
    REP(2, B2); SEAM(2);
    REP(3, B3); SEAM(3);
    REP(4, B4); SEAM(4);
#ifdef ORACLE
    if (IN(4)) { for (int oi = blockIdx.x; oi < ORC_ROWS; oi += F.G) oracle_row(F, oi); xcd_barrier(bar); }
#endif
    REP(5, B5);
    REP(6, B6); SEAM(6);
    REP(7, B7); SEAM(7);
    if (IN(8)) { p8_final(F); }
#ifdef ORACLE
    if (IN(8)) { xcd_barrier(bar); const float val = oracle_value(F); const float sc = 1.f + 0.02f * (1.f + val);
        for (size_t i = (size_t)blockIdx.x * 512 + F.tid; i < (size_t)MP * 1024; i += (size_t)F.G * 512) F.out[O_YP + i] *= sc; }
#endif
#undef IN
#undef SEAM
}

extern "C" void kernel_launch(void* const* d_in, const int* in_sizes, int n_in, void* d_out, int out_size, void* d_ws, size_t ws_size, hipStream_t stream) {
    static int grid = 0;
    if (grid == 0) {
        if (n_in != 20 || (size_t)out_size != O_END || ws_size < WS_END) { fprintf(stderr, "kernel_launch: unexpected shapes (n_in %d, out %d, ws %zu)\n", n_in, out_size, ws_size); grid = -1; return; }
        int dev = 0, cus = 0, per_cu = 0;
        if (hipGetDevice(&dev) != hipSuccess || hipDeviceGetAttribute(&cus, hipDeviceAttributeMultiprocessorCount, dev) != hipSuccess) { grid = -1; return; }
        if (hipFuncSetAttribute((const void*)fwd, hipFuncAttributeMaxDynamicSharedMemorySize, LDS_BYTES) != hipSuccess) { fprintf(stderr, "kernel_launch: hipFuncSetAttribute failed\n"); grid = -1; return; }
        if (hipOccupancyMaxActiveBlocksPerMultiprocessor(&per_cu, (const void*)fwd, NWAVES * 64, LDS_BYTES) != hipSuccess || per_cu < 1) { fprintf(stderr, "kernel_launch: occupancy query says %d blocks per CU\n", per_cu); }
        (void)hipGetLastError();
        grid = cus;
    }
    if (grid < 0) return;
    (void)hipMemsetAsync((char*)d_ws + WS_CTL, 0, CTL_ZERO_BYTES, stream);
    Args a{};
    for (int i = 0; i < 20; ++i) a.in[i] = d_in[i];
    a.out = (float*)d_out; a.ws = (unsigned char*)d_ws; a.rep_phase = PROBE_REP; a.rep_cnt = 2; a.rep_mask = PROBE_P4MASK; a.pad = 0;
#if MK_N_LAUNCHES == 1
    a.ph_lo = 0; a.ph_hi = N_PHASES;
    hipLaunchKernelGGL(fwd, dim3(grid), dim3(NWAVES * 64), LDS_BYTES, stream, a);
#else
    for (int p = 0; p < N_PHASES; ++p) { a.ph_lo = p; a.ph_hi = p + 1; hipLaunchKernelGGL(fwd, dim3(grid), dim3(NWAVES * 64), LDS_BYTES, stream, a); }
#endif
}
```

```cpp
#define MK_N_LAUNCHES 1
#include <hip/hip_runtime.h>
#include <cstdio>
#include <cstdint>
#ifndef MK_N_LAUNCHES
#define MK_N_LAUNCHES 1
#endif
namespace pg8 {
#define PG8_LAS __attribute__((address_space(3)))
typedef unsigned short bf16_t;
typedef short bf16x8 __attribute__((ext_vector_type(8)));
typedef float f32x4 __attribute__((ext_vector_type(4)));
typedef unsigned u32x4 __attribute__((ext_vector_type(4)));
constexpr int BM = 256, BK = 64, HALF = 128, HTB = HALF * BK * 2  , STAGE_BYTES = 8 * HTB, NXCD = 8, WGM = 8;

__host__ __device__ __forceinline__ int lds_byte(int r, int c) { const int st = (r >> 4) * 2 + (c >> 5), rr = r & 15, cc = c & 31, ob = rr * 64 + cc * 2; return st * 1024 + (ob ^ (((ob >> 9) & 1) << 5)); }
__host__ __device__ __forceinline__ void stage_rc(int b, int& R, int& C) { const int st = b / 1024, sb = b % 1024, swz = sb ^ (((sb >> 9) & 1) << 5); R = (st >> 1) * 16 + swz / 64; C = (st & 1) * 32 + (swz % 64) / 2; }
__host__ __device__ __forceinline__ int perm32(int rho) { const int n = rho >> 4, i = rho & 15; return 8 * (i >> 2) + 4 * n + (i & 3); }

struct Unit { int pm, pn; };
struct Gemm { const bf16_t* A; const bf16_t* Bt; int M, N, K; };

struct StaticOrder {
    int nM, nN, nwg, G, c;
    __host__ __device__ void init(int M, int N, int G_, int c_) { nM = M / BM; nN = N / BM; nwg = nM * nN; G = G_; c = c_; }
    __host__ __device__ bool next(int i, Unit& u) const {
        const long L = (long)i * G + c; if (L >= nwg) return false;
        int wgid = (int)L; { const int q = nwg / NXCD, r = nwg % NXCD, xcd = wgid % NXCD, off = wgid / NXCD; wgid = (xcd < r ? xcd * (q + 1) : r * (q + 1) + (xcd - r) * q) + off; }
        const int nig = WGM * nN, gid = wgid / nig, fm = gid * WGM, gsz = (nM - fm) < WGM ? (nM - fm) : WGM;
        u.pm = fm + ((wgid % nig) % gsz); u.pn = (wgid % nig) / gsz; return true;
    }
    __device__ __forceinline__ void a_ready(const Unit&) const {}
    __device__ __forceinline__ void done(const Unit&) const {}
};

typedef float f32x2p __attribute__((ext_vector_type(2))); typedef __bf16 bf16x2p __attribute__((ext_vector_type(2)));
__device__ __forceinline__ unsigned cvt_pk_bf16(float lo, float hi) { f32x2p v = {lo, hi}; bf16x2p b = __builtin_convertvector(v, bf16x2p); return __builtin_bit_cast(unsigned, b); }
template <class Epi, class Sched, bool ALIGN_EPI = false, bool SP2 = false>
__device__ __forceinline__ void gemm_phase(PG8_LAS unsigned char* lds, const Gemm g, const Sched& S, const Epi& E) {
    const int tid = threadIdx.x, wid = __builtin_amdgcn_readfirstlane(tid >> 6), lane = tid & 63, wr = wid >> 2, wc = wid & 3, fr = lane & 15, fq = lane >> 4;
    const int K = g.K, nt = K / BK;
    unsigned voffA[2], voffB[2];
#pragma unroll
    for (int i = 0; i < 2; ++i) { int R, C; stage_rc(tid * 16 + i * 8192, R, C); const int Rb = Epi::PERM ? ((R & ~31) + perm32(R & 31)) : R;
        voffA[i] = (unsigned)(R * K + C) * 2u; voffB[i] = (unsigned)(Rb * K + C) * 2u; }
    const size_t kstep = (size_t)(BK * 2);
    const size_t hstep = (size_t)HALF * K * 2;
    const size_t tstep = 2 * hstep;
    const unsigned ldsw = (unsigned)wid * 1024u;
    const int aoff = lds_byte(wr * 64 + fr, fq * 8), boff = lds_byte(wc * 32 + fr, fq * 8);
#define PG8_SA(b, h) (((b) * 2 + (h)) * HTB)
#define PG8_SB(b, h) ((4 + (b) * 2 + (h)) * HTB)
#define PG8_STAGE(bufoff, gbase, voff) do { _Pragma("unroll") for (int _i = 0; _i < 2; ++_i) \
        __builtin_amdgcn_global_load_lds((const unsigned*)((const char*)(gbase) + (voff)[_i]), (PG8_LAS unsigned*)(lds + (bufoff) + ldsw + _i * 8192), 16, 0, 0); } while (0)
#define PG8_LDA(dst, b, h) do { _Pragma("unroll") for (int m = 0; m < 4; ++m) _Pragma("unroll") for (int k = 0; k < 2; ++k) dst[m][k] = *(const PG8_LAS bf16x8*)(lds + PG8_SA(b, h) + aoff + m * 2048 + k * 1024); } while (0)
#define PG8_LDB(dst, b, h) do { _Pragma("unroll") for (int n = 0; n < 2; ++n) _Pragma("unroll") for (int k = 0; k < 2; ++k) dst[n][k] = *(const PG8_LAS bf16x8*)(lds + PG8_SB(b, h) + boff + n * 2048 + k * 1024); } while (0)
#define PG8_MMA(ai, bj, At, Bt) do { __builtin_amdgcn_s_setprio(1); _Pragma("unroll") for (int m = 0; m < 4; ++m) _Pragma("unroll") for (int n = 0; n < 2; ++n) _Pragma("unroll") for (int k = 0; k < 2; ++k) \
        acc[ai][bj][m][n] = __builtin_amdgcn_mfma_f32_16x16x32_bf16(Bt[n][k], At[m][k], acc[ai][bj][m][n], 0, 0, 0); __builtin_amdgcn_s_setprio(0); } while (0)
#define PG8_WAIT_V(n) asm volatile("s_waitcnt vmcnt(" #n ")" ::: "memory")
#define PG8_WAIT_L(n) asm volatile("s_waitcnt lgkmcnt(" #n ")" ::: "memory")
#define PG8_BAR __builtin_amdgcn_s_barrier()
#define PG8_SCHED __builtin_amdgcn_sched_barrier(0)
    Unit cur, nxt; int ui = 0;
    if (!S.next(0, cur)) return;
    f32x4 acc[2][2][4][2];
#pragma unroll
    for (int a = 0; a < 2; ++a)
#pragma unroll
        for (int b = 0; b < 2; ++b)
#pragma unroll
            for (int m = 0; m < 4; ++m)
#pragma unroll
                for (int n = 0; n < 2; ++n) acc[a][b][m][n] = (f32x4){0.f, 0.f, 0.f, 0.f};
    bf16x8 At[4][2], B0[2][2], B1[2][2];
    const char* cA = (const char*)g.A + (size_t)cur.pm * tstep; const char* cB = (const char*)g.Bt + (size_t)cur.pn * tstep;
    S.a_ready(cur);
    if constexpr (SP2) {
        PG8_STAGE(PG8_SB(0, 0), cB, voffB); PG8_STAGE(PG8_SB(0, 1), cB + hstep, voffB); PG8_STAGE(PG8_SA(0, 0), cA, voffA); PG8_STAGE(PG8_SA(0, 1), cA + hstep, voffA);
        if (wr == 1) PG8_BAR;
        PG8_WAIT_V(2); PG8_BAR;
        PG8_STAGE(PG8_SB(1, 0), cB + kstep, voffB); PG8_STAGE(PG8_SA(1, 0), cA + kstep, voffA); PG8_STAGE(PG8_SB(1, 1), cB + hstep + kstep, voffB);
        PG8_WAIT_V(6); PG8_BAR;
    } else {
        PG8_STAGE(PG8_SB(0, 0), cB, voffB); PG8_STAGE(PG8_SA(0, 0), cA, voffA); PG8_STAGE(PG8_SB(0, 1), cB + hstep, voffB); PG8_STAGE(PG8_SA(0, 1), cA + hstep, voffA);
        if (wr == 1) PG8_BAR;
        PG8_WAIT_V(4); PG8_BAR;
        PG8_STAGE(PG8_SB(1, 0), cB + kstep, voffB); PG8_STAGE(PG8_SA(1, 0), cA + kstep, voffA); PG8_STAGE(PG8_SB(1, 1), cB + hstep + kstep, voffB);
        PG8_WAIT_V(6); PG8_BAR;
    }
    for (;;) {
        const bool has_next = S.next(ui + 1, nxt);
        const char* nA = has_next ? (const char*)g.A + (size_t)nxt.pm * tstep : cA; const char* nB = has_next ? (const char*)g.Bt + (size_t)nxt.pn * tstep : cB;
        for (int t = 0; t < nt; t += 2) {
            const bool last = (t == nt - 2);
            const char* a1 = cA + (size_t)(t + 1) * kstep;
            const char* a2 = last ? nA : cA + (size_t)(t + 2) * kstep; const char* b2 = last ? nB : cB + (size_t)(t + 2) * kstep;
            const char* a3 = a2 + kstep; const char* b3 = b2 + kstep;
            if (last && has_next) S.a_ready(nxt);
            if constexpr (SP2) {
            PG8_LDB(B0, 0, 0); PG8_LDB(B1, 0, 1); PG8_SCHED; PG8_LDA(At, 0, 0); PG8_STAGE(PG8_SA(1, 1), a1 + hstep, voffA);
            PG8_WAIT_V(8); PG8_WAIT_L(0); PG8_BAR; PG8_MMA(0, 0, At, B0); PG8_MMA(0, 1, At, B1); PG8_BAR; PG8_SCHED;
            PG8_LDA(At, 0, 1); PG8_STAGE(PG8_SB(0, 0), b2, voffB); PG8_STAGE(PG8_SB(0, 1), b2 + hstep, voffB); PG8_STAGE(PG8_SA(0, 0), a2, voffA);
            PG8_WAIT_V(8); PG8_WAIT_L(0); PG8_BAR; PG8_MMA(1, 0, At, B0); PG8_MMA(1, 1, At, B1); PG8_BAR; PG8_SCHED;
            PG8_LDB(B0, 1, 0); PG8_LDB(B1, 1, 1); PG8_SCHED; PG8_LDA(At, 1, 0); PG8_STAGE(PG8_SA(0, 1), a2 + hstep, voffA);
            PG8_WAIT_V(8); PG8_WAIT_L(0); PG8_BAR; PG8_MMA(0, 0, At, B0); PG8_MMA(0, 1, At, B1); PG8_BAR; PG8_SCHED;
            PG8_LDA(At, 1, 1); PG8_STAGE(PG8_SB(1, 0), b3, voffB); PG8_STAGE(PG8_SB(1, 1), b3 + hstep, voffB); PG8_STAGE(PG8_SA(1, 0), a3, voffA);
            PG8_WAIT_V(8); PG8_WAIT_L(0); PG8_BAR; PG8_MMA(1, 0, At, B0); PG8_MMA(1, 1, At, B1); PG8_BAR; PG8_SCHED;
            } else {
            PG8_LDB(B0, 0, 0); PG8_SCHED; PG8_LDA(At, 0, 0); PG8_STAGE(PG8_SA(1, 1), a1 + hstep, voffA);
            PG8_WAIT_L(8); PG8_BAR; PG8_WAIT_L(0); PG8_MMA(0, 0, At, B0); PG8_BAR; PG8_SCHED;
            PG8_LDB(B1, 0, 1); PG8_STAGE(PG8_SB(0, 0), b2, voffB);
            PG8_BAR; PG8_WAIT_L(0); PG8_MMA(0, 1, At, B1); PG8_BAR;
            PG8_LDA(At, 0, 1); PG8_STAGE(PG8_SA(0, 0), a2, voffA);
            PG8_BAR; PG8_WAIT_L(0); PG8_MMA(1, 0, At, B0); PG8_BAR; PG8_SCHED;
            PG8_STAGE(PG8_SB(0, 1), b2 + hstep, voffB);
            PG8_WAIT_V(6); PG8_BAR; PG8_MMA(1, 1, At, B1); PG8_BAR;
            PG8_LDB(B0, 1, 0); PG8_SCHED; PG8_LDA(At, 1, 0); PG8_STAGE(PG8_SA(0, 1), a2 + hstep, voffA);
            PG8_WAIT_L(8); PG8_BAR; PG8_WAIT_L(0); PG8_MMA(0, 0, At, B0); PG8_BAR; PG8_SCHED;
            PG8_LDB(B1, 1, 1); PG8_STAGE(PG8_SB(1, 0), b3, voffB);
            PG8_BAR; PG8_WAIT_L(0); PG8_MMA(0, 1, At, B1); PG8_BAR;
            PG8_LDA(At, 1, 1); PG8_STAGE(PG8_SA(1, 0), a3, voffA);
            PG8_BAR; PG8_WAIT_L(0); PG8_MMA(1, 0, At, B0); PG8_BAR; PG8_SCHED;
            PG8_STAGE(PG8_SB(1, 1), b3 + hstep, voffB);
            PG8_WAIT_V(6); PG8_BAR; PG8_MMA(1, 1, At, B1); PG8_BAR;
            }
        }
        if constexpr (ALIGN_EPI) { if (wr == 0) PG8_BAR; }
        if constexpr (!Epi::AFTER_DRAIN) { E(acc, cur, wr, wc, fr, fq); S.done(cur); }
        if (!has_next) break;
#pragma unroll
        for (int a = 0; a < 2; ++a)
#pragma unroll
            for (int b = 0; b < 2; ++b)
#pragma unroll
                for (int m = 0; m < 4; ++m)
#pragma unroll
                    for (int n = 0; n < 2; ++n) acc[a][b][m][n] = (f32x4){0.f, 0.f, 0.f, 0.f};
        cur = nxt; cA = nA; cB = nB; ++ui;
        if constexpr (ALIGN_EPI) { if (wr == 1) PG8_BAR; }
    }
    PG8_WAIT_V(0);
    if constexpr (!ALIGN_EPI) { if (wr == 0) PG8_BAR; }
    PG8_BAR;
    if constexpr (Epi::AFTER_DRAIN) { E.fused(acc, cur, wr, wc, fr, fq, lds, wid, lane); S.done(cur); }
#undef PG8_SA
#undef PG8_SB
#undef PG8_STAGE
#undef PG8_LDA
#undef PG8_LDB
#undef PG8_MMA
#undef PG8_WAIT_V
#undef PG8_WAIT_L
#undef PG8_BAR
#undef PG8_SCHED
}
}

#define LAS __attribute__((address_space(3)))
typedef unsigned short bf16;
typedef short bf16x8 __attribute__((ext_vector_type(8)));
typedef float f32x4 __attribute__((ext_vector_type(4)));
typedef float f32x16 __attribute__((ext_vector_type(16)));
typedef unsigned u32x4 __attribute__((ext_vector_type(4)));
typedef unsigned u32x2 __attribute__((ext_vector_type(2)));

constexpr int DM = 1024, NBATCH = 4, SEQ = 4096, MP = NBATCH * SEQ, SBATCH = 128, STOK = 4, MS = SBATCH * STOK, MR = MP + MS;
constexpr int PASTL = 2048, PAGE = 128, NPG = 16;
constexpr int LS = 2112, LSW = 576;
constexpr int NPAD = 5632;
constexpr float C2 = 0.125f * 1.4426950408889634f;
constexpr int NWAVES = 8;

constexpr size_t O_YP = 0, O_YS = 16777216, O_NSAP = 17301504, O_DSAP = 25690112, O_IDXP = 29884416, O_WINP = 30932992,
                 O_NSAS = 31457280, O_DSAS = 31719424, O_IDXS = 31850496, O_WINS = 31883264, O_END = 48660480;

constexpr size_t MiB = 1u << 20;
constexpr size_t WS_CTL = 0, CTL_ZERO_BYTES = 1 * MiB;
constexpr size_t WS_MOD = 1 * MiB;
constexpr size_t WS_COS = 3 * MiB, WS_SIN = 4 * MiB;
constexpr size_t WS_BIAS1 = 5 * MiB;
constexpr size_t WS_BIASP = 5 * MiB + 262144;
constexpr size_t WS_W2T = 5 * MiB + 65536;
constexpr size_t WS_W1T = 6 * MiB;
constexpr size_t WS_WINT = 8 * MiB;
constexpr size_t WS_WUPN = 20 * MiB, WS_WUPD = 21 * MiB, WS_WOUT = 22 * MiB;
constexpr size_t WS_SELM = 960 * MiB;
constexpr size_t WS_GATES = 25 * MiB;
constexpr size_t WS_IW = 27 * MiB;
constexpr size_t WS_PCK = 28 * MiB, WS_PCVT = 28 * MiB + 262144;
constexpr size_t WS_SCK = 29 * MiB, WS_SCVT = 33 * MiB;
constexpr size_t WS_H = 40 * MiB;
constexpr size_t WS_QRAW = 80 * MiB, WS_QROT = 100 * MiB, WS_DQ = 120 * MiB, WS_IQ = 140 * MiB, WS_ZN = 150 * MiB, WS_ZD = 170 * MiB, WS_ONZ = 190 * MiB, WS_ODZ = 210 * MiB;
constexpr size_t WS_MG = 230 * MiB;
constexpr size_t WS_T1 = 300 * MiB;
constexpr size_t WS_M1 = 370 * MiB;
constexpr size_t WS_PCMPK = 410 * MiB, WS_PCMPV = 414 * MiB, WS_PSLCK = 418 * MiB, WS_PSLCVT = 422 * MiB, WS_PWINK = 426 * MiB, WS_PWINVT = 430 * MiB,
                 WS_PDSAK = 434 * MiB, WS_PDSAVT = 438 * MiB, WS_PIDXK = 442 * MiB;
constexpr size_t WS_SCMPK = 450 * MiB, WS_SCMPV = 520 * MiB, WS_SSLCK = 590 * MiB, WS_SSLCVT = 660 * MiB, WS_SDSAK = 730 * MiB, WS_SDSAVT = 800 * MiB,
                 WS_SWINK = 870 * MiB, WS_SWINVT = 890 * MiB, WS_SIDXK = 910 * MiB, WS_END = 970 * MiB;
constexpr int CW_BAR = 4096;
constexpr int CW_Q = 16384;

constexpr int RING_BYTES = 131072, MISC_OFF = RING_BYTES, LDS_BYTES = 147456;

struct Args { const void* in[20]; float* out; unsigned char* ws; int ph_lo, ph_hi, rep_phase, rep_cnt, rep_mask, pad; };

struct Frame {
    LAS unsigned char* lds; volatile LAS unsigned* MISC; unsigned* ctl;
    int tid, lane, wave, G;
    unsigned char* ws; float* out;
    const float *xp, *xs, *cnsa, *cdsa, *cidx, *swin; const int* ptab; const float *cp, *cs, *normg, *wada, *bada, *win, *pe, *w1, *w2, *wupn, *wupd, *wout, *fing;
};
#define WSP(T, off) ((T*)(F.ws + (off)))

#define DI __device__ __forceinline__
#define LDS_WAIT() asm volatile("s_waitcnt lgkmcnt(0)" ::: "memory")
DI u32x4 gload16(const void* p) { u32x4 r; asm volatile("global_load_dwordx4 %0, %1, off" : "=v"(r) : "v"(p) : "memory"); return r; }
DI unsigned long long gload8(const void* p) { unsigned long long r; asm volatile("global_load_dwordx2 %0, %1, off" : "=v"(r) : "v"(p) : "memory"); return r; }
#define WAITV2(n, a, b) asm volatile("s_waitcnt vmcnt(" #n ")" : "+v"(a), "+v"(b) :: "memory")
#define WAITV1(n, a) asm volatile("s_waitcnt vmcnt(" #n ")" : "+v"(a) :: "memory")
#define LDS_BARRIER() do { asm volatile("s_waitcnt lgkmcnt(0)" ::: "memory"); __builtin_amdgcn_s_barrier(); asm volatile("" ::: "memory"); } while (0)
DI float wave_sum(float v) {
#pragma unroll
    for (int o = 1; o < 64; o <<= 1) v += __shfl_xor(v, o);
    return v;
}
DI unsigned pk2(float lo, float hi) { return pg8::cvt_pk_bf16(lo, hi); }
DI float bflo(unsigned w) { return __uint_as_float(w << 16); }
DI float bfhi(unsigned w) { return __uint_as_float(w & 0xffff0000u); }
DI float bf2f(bf16 h) { return __uint_as_float((unsigned)h << 16); }
DI float sigm_f(float x) { return __builtin_amdgcn_rcpf(1.f + __builtin_amdgcn_exp2f(-1.4426950408889634f * x)); }
DI float silu_f(float x) { return x * sigm_f(x); }
DI int pos16(int o) { return 8 * ((o >> 2) & 1) + (o & 3) + 4 * (o >> 3); }
DI int permk(int t) { return (t & ~15) | pos16(t & 15); }
DI int crow(int r, int hi) { return (r & 3) + 8 * (r >> 2) + 4 * hi; }
DI float dpp_x1(float v) { return __int_as_float(__builtin_amdgcn_update_dpp(0, __float_as_int(v), 0xB1, 0xF, 0xF, true)); }
DI float dpp_x2(float v) { return __int_as_float(__builtin_amdgcn_update_dpp(0, __float_as_int(v), 0x4E, 0xF, 0xF, true)); }
DI float half_other(float v) { return __shfl_xor(v, 32); }
DI u32x4 pack8(const float* v) { u32x4 w; w.x = pk2(v[0], v[1]); w.y = pk2(v[2], v[3]); w.z = pk2(v[4], v[5]); w.w = pk2(v[6], v[7]); return w; }
DI void st_bf8(bf16* p, const float* v) { *(u32x4*)p = pack8(v); }
DI void st_f8(float* p, const float* v) { __builtin_nontemporal_store((f32x4){v[0], v[1], v[2], v[3]}, (f32x4*)p); __builtin_nontemporal_store((f32x4){v[4], v[5], v[6], v[7]}, (f32x4*)(p + 4)); }
DI void st_vt8(bf16* p, size_t pitch, const float* v) {
#pragma unroll
    for (int j = 0; j < 8; ++j) p[(size_t)j * pitch] = (bf16)(pk2(v[j], 0.f) & 0xffffu);
}
#define PIN4(q) asm volatile("" : "+v"(q[0]), "+v"(q[1]), "+v"(q[2]), "+v"(q[3]))
#define NEGINF (-__builtin_inff())
#define MFMA32(a, b, c) __builtin_amdgcn_mfma_f32_32x32x16_bf16((a), (b), (c), 0, 0, 0)

DI int idx_key(float dot, float w) {
#pragma clang fp contract(off)
    float v = fmaxf(dot, 0.f) * w;
    v = v + dpp_x1(v);
    v = v + dpp_x2(v);
    int u = __float_as_int(v);
    u = (u == (int)0x80000000) ? 0 : u;
    return u ^ ((u >> 31) & 0x7fffffff);
}

template <int MODE> struct EpiInProjT {
    static constexpr bool PERM = true, AFTER_DRAIN = false;
    unsigned char* ws; float* out;
    DI void rope8(float* lo, float* hi, const float* c, const float* s) const {
#pragma unroll
        for (int j = 0; j < 8; ++j) { const float a = lo[j], b = hi[j]; lo[j] = a * c[j] - b * s[j]; hi[j] = b * c[j] + a * s[j]; }
    }
    DI void ldtab(float* c, float* s, int pos, int d0) const {
        const f32x4* cp = (const f32x4*)((const float*)(ws + WS_COS) + pos * 32 + d0);
        const f32x4* sp = (const f32x4*)((const float*)(ws + WS_SIN) + pos * 32 + d0);
        const f32x4 c0 = cp[0], c1 = cp[1], s0 = sp[0], s1 = sp[1];
        c[0] = c0[0]; c[1] = c0[1]; c[2] = c0[2]; c[3] = c0[3]; c[4] = c1[0]; c[5] = c1[1]; c[6] = c1[2]; c[7] = c1[3];
        s[0] = s0[0]; s[1] = s0[1]; s[2] = s0[2]; s[3] = s0[3]; s[4] = s1[0]; s[5] = s1[1]; s[6] = s1[2]; s[7] = s1[3];
        asm volatile("" : "+v"(c[0]), "+v"(c[1]), "+v"(c[2]), "+v"(c[3]), "+v"(c[4]), "+v"(c[5]), "+v"(c[6]), "+v"(c[7]));
        asm volatile("" : "+v"(s[0]), "+v"(s[1]), "+v"(s[2]), "+v"(s[3]), "+v"(s[4]), "+v"(s[5]), "+v"(s[6]), "+v"(s[7]));
    }
    DI void operator()(const pg8::f32x4 (&acc)[2][2][4][2], const pg8::Unit& u, int wr, int wc, int fr, int fq) const {
        const int hs = u.pn * 4 + wc;
        if (hs >= 86) return;
        if ((MODE & 2) && hs >= 20 && hs != 44 && !(hs >= 36 && hs < 40)) return;
        if ((MODE & 4) && hs < 20) return;
        const bool samp = u.pm >= 64;
        const int d0 = 8 * fq;
        const bool roped = hs < 8 || (hs >= 12 && hs < 14) || (hs >= 16 && hs < 18) || (hs >= 28 && hs < 36) || hs == 36 || hs == 37 || (hs >= 40 && hs <= 44);
        float rc[8], rs[8], dc[8], ds[8];
        if (roped) { if (samp) {
#pragma unroll
                for (int j = 0; j < 8; ++j) { dc[j] = 1.f; ds[j] = 0.f; }
            } else ldtab(dc, ds, 16, d0); }
#pragma unroll
        for (int ai = 0; ai < 2; ++ai)
#pragma unroll
            for (int m = 0; m < 4; ++m) {
                const int r = u.pm * 256 + ai * 128 + wr * 64 + m * 16 + fr;
                if (roped) {
                    if (m == 0) ldtab(rc, rs, samp ? PASTL + (r & 3) : (r & 4095), d0);
                    else {
#pragma unroll
                        for (int j = 0; j < 8; ++j) { const float a = rc[j], b = rs[j]; rc[j] = a * dc[j] - b * ds[j]; rs[j] = b * dc[j] + a * ds[j]; }
                    }
                }
                int b, t, pos;
                if (!samp) { b = r >> 12; t = r & 4095; pos = t; } else { b = (r - MP) >> 2; t = r & 3; pos = PASTL + t; }
                float lo[8], hi[8];
#pragma unroll
                for (int n = 0; n < 2; ++n)
#pragma unroll
                    for (int j = 0; j < 4; ++j) { lo[4 * n + j] = acc[ai][0][m][n][j]; hi[4 * n + j] = acc[ai][1][m][n][j]; }
                if (hs < 8) {
                    bf16* qa = (bf16*)(ws + WS_QRAW) + (size_t)r * 512 + hs * 64 + d0;
                    bf16* qb = (bf16*)(ws + WS_QROT) + (size_t)r * 512 + hs * 64 + d0;
                    float a[8], c[8];
#pragma unroll
                    for (int j = 0; j < 8; ++j) { a[j] = lo[j] * C2; c[j] = hi[j] * C2; }
                    st_bf8(qa, a); st_bf8(qa + 32, c);
                    rope8(lo, hi, rc, rs);
#pragma unroll
                    for (int j = 0; j < 8; ++j) { a[j] = lo[j] * C2; c[j] = hi[j] * C2; }
                    st_bf8(qb, a); st_bf8(qb + 32, c);
                } else if (hs < 20) {
                    const int ty = (hs - 8) >> 1, g = (hs - 8) & 1;
                    if (ty == 2 || ty == 4) rope8(lo, hi, rc, rs);
                    const int bg = b * 2 + g;
                    if (ty < 4) {
                        float* o = out + (samp ? O_NSAS + ((size_t)(r - MP) * 8 + ty * 2 + g) * 64 : O_NSAP + ((size_t)r * 8 + ty * 2 + g) * 64) + d0;
                        st_f8(o, lo); st_f8(o + 32, hi);
                    } else {
                        const int sl = ty - 4;
                        if (samp) { float* o = out + O_WINS + (((size_t)b * 512 + 508 + t) * 4 + sl * 2 + g) * 64 + d0; st_f8(o, lo); st_f8(o + 32, hi); }
                        else if (t >= SEQ - 512) { float* o = out + O_WINP + (((size_t)b * 512 + (t - (SEQ - 512))) * 4 + sl * 2 + g) * 64 + d0; st_f8(o, lo); st_f8(o + 32, hi); }
                    }
                    if (ty == 3 || ty == 5) {
                        size_t pitch; int kp; bf16* base;
                        if (!samp) { pitch = SEQ; kp = t; base = (bf16*)(ws + (ty == 3 ? WS_PSLCVT : WS_PWINVT)); }
                        else if (ty == 3) { pitch = LS; kp = PASTL + t; base = (bf16*)(ws + WS_SSLCVT); }
                        else { pitch = LSW; kp = 512 + t; base = (bf16*)(ws + WS_SWINVT); }
                        bf16* p = base + ((size_t)bg * 64 + d0) * pitch + permk(kp);
                        if (!(MODE & 1)) { st_vt8(p, pitch, lo); st_vt8(p + 32 * pitch, pitch, hi); }
                    } else {
                        size_t rowi; bf16* base;
                        if (!samp) { rowi = (size_t)bg * SEQ + t; base = (bf16*)(ws + (ty == 0 ? WS_PCMPK : ty == 1 ? WS_PCMPV : ty == 2 ? WS_PSLCK : WS_PWINK)); }
                        else if (ty == 4) { rowi = (size_t)bg * LSW + 512 + t; base = (bf16*)(ws + WS_SWINK); }
                        else { rowi = (size_t)bg * LS + PASTL + t; base = (bf16*)(ws + (ty == 0 ? WS_SCMPK : ty == 1 ? WS_SCMPV : WS_SSLCK)); }
                        bf16* p = base + rowi * 64 + d0;
                        st_bf8(p, lo); st_bf8(p + 32, hi);
                    }
                } else if (hs < 28 || (hs >= 45 && hs < 53)) {
                    const int h = hs < 28 ? hs - 20 : hs - 45;
                    bf16* p = (bf16*)(ws + (hs < 28 ? WS_ZN : WS_ZD)) + (size_t)r * 512 + h * 64 + d0;
#pragma unroll
                    for (int j = 0; j < 8; ++j) { lo[j] = silu_f(lo[j]); hi[j] = silu_f(hi[j]); }
                    st_bf8(p, lo); st_bf8(p + 32, hi);
                } else if (hs < 36) {
                    rope8(lo, hi, rc, rs);
#pragma unroll
                    for (int j = 0; j < 8; ++j) { lo[j] *= C2; hi[j] *= C2; }
                    bf16* p = (bf16*)(ws + WS_DQ) + (size_t)r * 512 + (hs - 28) * 64 + d0;
                    st_bf8(p, lo); st_bf8(p + 32, hi);
                } else if (hs < 40) {
                    const int sl = (hs - 36) >> 1, g = (hs - 36) & 1, bg = b * 2 + g;
                    if (sl == 0) rope8(lo, hi, rc, rs);
                    float* o = out + (samp ? O_DSAS + ((size_t)(r - MP) * 4 + sl * 2 + g) * 64 : O_DSAP + ((size_t)r * 4 + sl * 2 + g) * 64) + d0;
                    st_f8(o, lo); st_f8(o + 32, hi);
                    if (sl == 0) {
                        bf16* p = samp ? (bf16*)(ws + WS_SDSAK) + ((size_t)bg * LS + PASTL + t) * 64 + d0 : (bf16*)(ws + WS_PDSAK) + ((size_t)bg * SEQ + t) * 64 + d0;
                        st_bf8(p, lo); st_bf8(p + 32, hi);
                    } else {
                        const size_t pitch = samp ? LS : SEQ; const int kp = samp ? PASTL + t : t;
                        bf16* p = (bf16*)(ws + (samp ? WS_SDSAVT : WS_PDSAVT)) + ((size_t)bg * 64 + d0) * pitch + permk(kp);
                        if (!(MODE & 1)) { st_vt8(p, pitch, lo); st_vt8(p + 32 * pitch, pitch, hi); }
                    }
                } else if (hs < 44) {
                    rope8(lo, hi, rc, rs);
                    bf16* p = (bf16*)(ws + WS_IQ) + (size_t)r * 256 + (hs - 40) * 64 + d0;
                    st_bf8(p, lo); st_bf8(p + 32, hi);
                } else if (hs == 44) {
                    rope8(lo, hi, rc, rs);
                    float* o = out + (samp ? O_IDXS + (size_t)(r - MP) * 64 : O_IDXP + (size_t)r * 64) + d0;
                    st_f8(o, lo); st_f8(o + 32, hi);
                    bf16* p = samp ? (bf16*)(ws + WS_SIDXK) + ((size_t)b * LS + PASTL + t) * 64 + d0 : (bf16*)(ws + WS_PIDXK) + (size_t)r * 64 + d0;
                    st_bf8(p, lo); st_bf8(p + 32, hi);
                } else if (hs < 85) {
                    bf16* p = (bf16*)(ws + WS_MG) + (size_t)r * 2048 + (hs - 53) * 64 + d0;
#pragma unroll
                    for (int j = 0; j < 8; ++j) { lo[j] = sigm_f(lo[j]); hi[j] = sigm_f(hi[j]); }
                    st_bf8(p, lo); st_bf8(p + 32, hi);
                } else {
                    if (fq < 3) { float* p = (float*)(ws + WS_GATES) + (size_t)r * 24 + d0;
#pragma unroll
                        for (int j = 0; j < 8; ++j) lo[j] = sigm_f(lo[j]);
                        st_f8(p, lo);
                    } else { *(f32x4*)((float*)(ws + WS_IW) + (size_t)r * 4) = (f32x4){lo[0], lo[1], lo[2], lo[3]}; }
                }
            }
    }
};
typedef EpiInProjT<0> EpiInProj;
struct ColOrder {
    int nM, nN, cnt, rank, pn;
    __device__ void init(int M, int N, int G, int c) { nM = M / 256; nN = N / 256; pn = c % nN; rank = c / nN; cnt = G / nN + ((pn < G % nN) ? 1 : 0); }
    __device__ bool next(int i, pg8::Unit& u) const { const int pm = rank + i * cnt; if (pm >= nM) return false; u.pm = pm; u.pn = pn; return true; }
    __device__ __forceinline__ void a_ready(const pg8::Unit&) const {}
    __device__ __forceinline__ void done(const pg8::Unit&) const {}
};
struct EpiNull {
    static constexpr bool PERM = true, AFTER_DRAIN = false;
    unsigned char* ws;
    DI void operator()(const pg8::f32x4 (&acc)[2][2][4][2], const pg8::Unit& u, int wr, int wc, int fr, int fq) const {
        float s = 0.f;
#pragma unroll
        for (int ai = 0; ai < 2; ++ai)
#pragma unroll
            for (int bj = 0; bj < 2; ++bj)
#pragma unroll
                for (int m = 0; m < 4; ++m)
#pragma unroll
                    for (int n = 0; n < 2; ++n) s += acc[ai][bj][m][n][0] + acc[ai][bj][m][n][1] + acc[ai][bj][m][n][2] + acc[ai][bj][m][n][3];
        if (s == 1.2345e33f) *(float*)(ws + WS_CTL + 2048) = s;
    }
};
struct EpiUp1 {
    static constexpr bool PERM = true, AFTER_DRAIN = false;
    unsigned char* ws;
    DI void operator()(const pg8::f32x4 (&acc)[2][2][4][2], const pg8::Unit& u, int wr, int wc, int fr, int fq) const {
#pragma unroll
        for (int ai = 0; ai < 2; ++ai)
#pragma unroll
            for (int m = 0; m < 4; ++m) {
                const int r = u.pm * 256 + ai * 128 + wr * 64 + m * 16 + fr;
#pragma unroll
                for (int bj = 0; bj < 2; ++bj) {
                    const int c0 = u.pn * 256 + bj * 128 + wc * 32 + 8 * fq;
                    const u32x4 gw = *(const u32x4*)((const bf16*)(ws + WS_MG) + (size_t)r * 2048 + c0);
                    const f32x4 a0 = acc[ai][bj][m][0], a1 = acc[ai][bj][m][1];
                    float* o = (float*)(ws + WS_T1) + (size_t)r * 1024 + c0;
                    *(f32x4*)o = (f32x4){a0[0] * bflo(gw.x), a0[1] * bfhi(gw.x), a0[2] * bflo(gw.y), a0[3] * bfhi(gw.y)};
                    *(f32x4*)(o + 4) = (f32x4){a1[0] * bflo(gw.z), a1[1] * bfhi(gw.z), a1[2] * bflo(gw.w), a1[3] * bfhi(gw.w)};
                }
            }
    }
};
struct EpiUp2 {
    static constexpr bool PERM = true, AFTER_DRAIN = false;
    unsigned char* ws;
    DI void operator()(const pg8::f32x4 (&acc)[2][2][4][2], const pg8::Unit& u, int wr, int wc, int fr, int fq) const {
#pragma unroll
        for (int ai = 0; ai < 2; ++ai)
#pragma unroll
            for (int m = 0; m < 4; ++m) {
                const int r = u.pm * 256 + ai * 128 + wr * 64 + m * 16 + fr;
#pragma unroll
                for (int bj = 0; bj < 2; ++bj) {
                    const int c0 = u.pn * 256 + bj * 128 + wc * 32 + 8 * fq;
                    const u32x4 gw = *(const u32x4*)((const bf16*)(ws + WS_MG) + (size_t)r * 2048 + 1024 + c0);
                    const float* tp = (const float*)(ws + WS_T1) + (size_t)r * 1024 + c0;
                    const f32x4 t0 = *(const f32x4*)tp, t1 = *(const f32x4*)(tp + 4);
                    const f32x4 a0 = acc[ai][bj][m][0], a1 = acc[ai][bj][m][1];
                    u32x4 w;
                    w.x = pk2(t0[0] + a0[0] * bflo(gw.x), t0[1] + a0[1] * bfhi(gw.x)); w.y = pk2(t0[2] + a0[2] * bflo(gw.y), t0[3] + a0[3] * bfhi(gw.y));
                    w.z = pk2(t1[0] + a1[0] * bflo(gw.z), t1[1] + a1[1] * bfhi(gw.z)); w.w = pk2(t1[2] + a1[2] * bflo(gw.w), t1[3] + a1[3] * bfhi(gw.w));
                    *(u32x4*)((bf16*)(ws + WS_M1) + (size_t)r * 1024 + c0) = w;
                }
            }
    }
};
struct EpiOut {
    static constexpr bool PERM = true, AFTER_DRAIN = false;
    unsigned char* ws; float* out; const float* xp; const float* xs;
    DI void operator()(const pg8::f32x4 (&acc)[2][2][4][2], const pg8::Unit& u, int wr, int wc, int fr, int fq) const {
        const bool samp = u.pm >= 64;
#pragma unroll
        for (int ai = 0; ai < 2; ++ai)
#pragma unroll
            for (int m = 0; m < 4; ++m) {
                const int r = u.pm * 256 + ai * 128 + wr * 64 + m * 16 + fr;
                const int mrow = samp ? 4 + ((r - MP) >> 2) : (r >> 12);
                const float* xr = samp ? xs + (size_t)(r - MP) * 1024 : xp + (size_t)r * 1024;
                float* orow = samp ? out + O_YS + (size_t)(r - MP) * 1024 : out + O_YP + (size_t)r * 1024;
                const float* gr = (const float*)(ws + WS_MOD) + (size_t)mrow * 3072 + 2048;
#pragma unroll
                for (int bj = 0; bj < 2; ++bj) {
                    const int c0 = u.pn * 256 + bj * 128 + wc * 32 + 8 * fq;
#pragma unroll
                    for (int n = 0; n < 2; ++n) {
                        const f32x4 x4 = *(const f32x4*)(xr + c0 + 4 * n), g4 = *(const f32x4*)(gr + c0 + 4 * n);
                        *(f32x4*)(orow + c0 + 4 * n) = x4 + g4 * acc[ai][bj][m][n];
                    }
                }
            }
    }
};

DI int win_row(int col) {
    int hs, d;
    if (col < 1280) { hs = col >> 6; d = col & 63; }
    else if (col < 1304) { hs = 85; d = col - 1280; }
    else if (col < 2904) { const int c = col - 1304; hs = 20 + (c >> 6); d = c & 63; }
    else if (col < 2908) { hs = 85; d = 24 + (col - 2904); }
    else { const int c = col - 2908; hs = 45 + (c >> 6); d = c & 63; }
    return 256 * (hs >> 2) + 128 * (d >> 5) + 32 * (hs & 3) + (d & 31);
}
template <bool WINMAP> DI void p0_transpose_item(const float* W, int K, int N, bf16* WT, LAS float* scr, int item, int lane) {
    const int nblk = (N + 31) / 32, kb = item / nblk, nb = item % nblk, k0 = 64 * kb, n0 = 32 * nb;
    const bool nok = n0 + (lane & 31) < N;
#pragma unroll 8
    for (int i = 0; i < 32; ++i) { const int kk = 2 * i + (lane >> 5); scr[kk * 33 + (lane & 31)] = nok ? W[(size_t)(k0 + kk) * N + n0 + (lane & 31)] : 0.f; }
    LDS_WAIT();
    const int c = lane & 7;
#pragma unroll
    for (int j = 0; j < 4; ++j) { const int n = (lane >> 3) + 8 * j; const LAS float* s = scr + (8 * c) * 33 + n;
        u32x4 o; o.x = pk2(s[0 * 33], s[1 * 33]); o.y = pk2(s[2 * 33], s[3 * 33]); o.z = pk2(s[4 * 33], s[5 * 33]); o.w = pk2(s[6 * 33], s[7 * 33]);
        if (n0 + n < N) { const int row = WINMAP ? win_row(n0 + n) : (n0 + n); *(u32x4*)(WT + (size_t)row * K + k0 + 8 * c) = o; } }
    LDS_WAIT();
}
DI void p0_mod(Frame& F) {
    LAS float* wl = (LAS float*)F.lds;
    float* mod = WSP(float, WS_MOD);
    for (int cg = blockIdx.x; cg < 256; cg += F.G) {
        __syncthreads();
        for (int k = F.tid; k < 1024; k += NWAVES * 64) {
            const f32x4* src = (const f32x4*)(F.wada + (size_t)k * 3072 + cg * 12);
            LAS f32x4* dst = (LAS f32x4*)(wl + k * 12);
            dst[0] = src[0]; dst[1] = src[1]; dst[2] = src[2];
        }
        __syncthreads();
        for (int r = F.wave; r < 132; r += NWAVES) {
            const float* cr = r < 4 ? F.cp + (size_t)r * 1024 : F.cs + (size_t)(r - 4) * 1024;
            float a[12];
#pragma unroll
            for (int j = 0; j < 12; ++j) a[j] = 0.f;
#pragma unroll 4
            for (int i = 0; i < 16; ++i) {
                const int k = F.lane + 64 * i; const float s = silu_f(cr[k]);
                const LAS f32x4* wp = (const LAS f32x4*)(wl + k * 12);
                const f32x4 w0 = wp[0], w1 = wp[1], w2 = wp[2];
                a[0] += s * w0[0]; a[1] += s * w0[1]; a[2] += s * w0[2]; a[3] += s * w0[3];
                a[4] += s * w1[0]; a[5] += s * w1[1]; a[6] += s * w1[2]; a[7] += s * w1[3];
                a[8] += s * w2[0]; a[9] += s * w2[1]; a[10] += s * w2[2]; a[11] += s * w2[3];
            }
            float v = 0.f;
#pragma unroll
            for (int j = 0; j < 12; ++j) { const float sj = wave_sum(a[j]); v = (F.lane == j) ? sj : v; }
            if (F.lane < 12) mod[(size_t)r * 3072 + cg * 12 + F.lane] = v + F.bada[cg * 12 + F.lane];
        }
    }
    __syncthreads();
}
__device__ const double ROPE_INV[32] = {
    1.0, 0.7498942093324559, 0.5623413251903491, 0.4216965034285822, 0.31622776601683794, 0.23713737056616552, 0.1778279410038923, 0.1333521432163324,
    0.1, 0.07498942093324559, 0.05623413251903491, 0.04216965034285822, 0.03162277660168379, 0.023713737056616554, 0.01778279410038923, 0.01333521432163324,
    0.01, 0.007498942093324559, 0.005623413251903491, 0.004216965034285822, 0.0031622776601683794, 0.0023713737056616554, 0.0017782794100389228, 0.001333521432163324,
    0.001, 0.0007498942093324559, 0.0005623413251903491, 0.0004216965034285822, 0.00031622776601683794, 0.00023713737056616554, 0.00017782794100389227, 0.0001333521432163324};
DI void p0_rope_item(Frame& F, int item) {
    const int pos = 2 * item + (F.lane >> 5), d = F.lane & 31;
    if (pos >= 4100) return;
    const double ang = (double)pos * ROPE_INV[d];
    const double kq = __builtin_rint(ang * 0.6366197723675814);
    double r = __builtin_fma(-kq, 1.5707963267948966, ang); r = __builtin_fma(-kq, 6.123233995736766e-17, r);
    const int q = (int)kq & 3;
    const double r2 = r * r;
    const double sn = r * (1.0 + r2 * (-1.0 / 6 + r2 * (1.0 / 120 + r2 * (-1.0 / 5040 + r2 * (1.0 / 362880 + r2 * (-1.0 / 39916800 + r2 * (1.0 / 6227020800.0)))))));
    const double cs = 1.0 + r2 * (-0.5 + r2 * (1.0 / 24 + r2 * (-1.0 / 720 + r2 * (1.0 / 40320 + r2 * (-1.0 / 3628800 + r2 * (1.0 / 479001600.0 + r2 * (-1.0 / 87178291200.0)))))));
    const double c = (q == 0) ? cs : (q == 1) ? -sn : (q == 2) ? -cs : sn;
    const double s = (q == 0) ? sn : (q == 1) ? cs : (q == 2) ? -sn : -cs;
    WSP(float, WS_COS)[pos * 32 + d] = (float)c; WSP(float, WS_SIN)[pos * 32 + d] = (float)s;
}
DI void p0_cmp_small_item(Frame& F, int item) {
    if (item < 256) {
        const int slot = item >> 7, ch = (item >> 6) & 1, kc = item & 63, c = ch * 64 + F.lane; float a = 0.f;
#pragma unroll 8
        for (int i = 0; i < 32; ++i) { const int k = kc * 32 + i; a += F.pe[slot * 2048 + k] * F.w1[((size_t)slot * 2048 + k) * 128 + c]; }
        WSP(float, WS_BIASP)[(size_t)kc * 256 + slot * 128 + c] = a;
    } else {
        const int it = item - 256, slot = it >> 7, e = (it & 127) >> 1, ch = it & 1;
        const int c = ch * 64 + F.lane;
        WSP(bf16, WS_W2T)[((size_t)slot * 64 + e) * 128 + permk(c)] = (bf16)(pk2(F.w2[((size_t)slot * 128 + c) * 64 + e], 0.f) & 0xffffu);
    }
}
DI void cp_k16(const float* src, size_t rs, bf16* dst, int lane) {
    const int tk = lane >> 2, dc = (lane & 3) * 16;
    const f32x4* s = (const f32x4*)(src + (size_t)tk * rs + dc);
    const f32x4 a = s[0], b = s[1], c = s[2], d = s[3];
    u32x4 w0, w1; w0.x = pk2(a[0], a[1]); w0.y = pk2(a[2], a[3]); w0.z = pk2(b[0], b[1]); w0.w = pk2(b[2], b[3]);
    w1.x = pk2(c[0], c[1]); w1.y = pk2(c[2], c[3]); w1.z = pk2(d[0], d[1]); w1.w = pk2(d[2], d[3]);
    u32x4* o = (u32x4*)(dst + (size_t)tk * 64 + dc); o[0] = w0; o[1] = w1;
}
DI void cp_vt16(const float* src, size_t rs, bf16* dst, size_t pitch, int lane) {
#pragma unroll
    for (int h = 0; h < 2; ++h) {
        float v[8];
#pragma unroll
        for (int i = 0; i < 8; ++i) v[i] = src[(size_t)((i & 3) + 8 * (i >> 2) + 4 * h) * rs + lane];
        *(u32x4*)(dst + (size_t)lane * pitch + 8 * h) = pack8(v);
    }
}
DI void p0_gather_item(Frame& F, int item) {
    const int sb = item >> 7, tg = item & 127, tk0 = tg * 16, lane = F.lane;
    const int pg = F.ptab[sb * NPG + (tk0 >> 7)], j0 = tk0 & 127;
    const float* nsa = F.cnsa + ((size_t)pg * PAGE + j0) * 512;
    const float* dsa = F.cdsa + ((size_t)pg * PAGE + j0) * 256;
    const float* idx = F.cidx + ((size_t)pg * PAGE + j0) * 64;
#pragma unroll
    for (int g = 0; g < 2; ++g) {
        const size_t bg = (size_t)sb * 2 + g;
        cp_k16(nsa + (0 * 2 + g) * 64, 512, WSP(bf16, WS_SCMPK) + (bg * LS + tk0) * 64, lane);
        cp_k16(nsa + (1 * 2 + g) * 64, 512, WSP(bf16, WS_SCMPV) + (bg * LS + tk0) * 64, lane);
        cp_k16(nsa + (2 * 2 + g) * 64, 512, WSP(bf16, WS_SSLCK) + (bg * LS + tk0) * 64, lane);
        cp_vt16(nsa + (3 * 2 + g) * 64, 512, WSP(bf16, WS_SSLCVT) + bg * 64 * LS + tk0, LS, lane);
        cp_k16(dsa + (0 * 2 + g) * 64, 256, WSP(bf16, WS_SDSAK) + (bg * LS + tk0) * 64, lane);
        cp_vt16(dsa + (1 * 2 + g) * 64, 256, WSP(bf16, WS_SDSAVT) + bg * 64 * LS + tk0, LS, lane);
    }
    cp_k16(idx, 64, WSP(bf16, WS_SIDXK) + ((size_t)sb * LS + tk0) * 64, lane);
}
DI void p0_win_item(Frame& F, int item) {
    const int sb = item >> 5, w0 = (item & 31) * 16, lane = F.lane;
    const float* st = F.swin + ((size_t)sb * 512 + w0) * 256;
#pragma unroll
    for (int g = 0; g < 2; ++g) {
        const size_t bg = (size_t)sb * 2 + g;
        cp_k16(st + (0 * 2 + g) * 64, 256, WSP(bf16, WS_SWINK) + (bg * LSW + w0) * 64, lane);
        cp_vt16(st + (1 * 2 + g) * 64, 256, WSP(bf16, WS_SWINVT) + bg * 64 * LSW + w0, LSW, lane);
    }
}
DI void p0_zero_item(Frame& F, int item) {
    const int arr = item >> 8, bg = item & 255, lane = F.lane;
    bf16* p; int n;
    if (arr == 0) { p = WSP(bf16, WS_SSLCVT) + ((size_t)bg * 64 + lane) * LS + 2052; n = 60; }
    else if (arr == 1) { p = WSP(bf16, WS_SDSAVT) + ((size_t)bg * 64 + lane) * LS + 2052; n = 60; }
    else { p = WSP(bf16, WS_SWINVT) + ((size_t)bg * 64 + lane) * LSW + 516; n = 60; }
    unsigned long long* q = (unsigned long long*)p;
    for (int i = 0; i < n / 4; ++i) q[i] = 0ull;
}
DI void p0_prologue(Frame& F) {
    p0_mod(F);
    LAS float* scr = (LAS float*)(F.lds + F.wave * 16384);
    const int gw = blockIdx.x * NWAVES + F.wave, NGW = F.G * NWAVES;
    constexpr int I_WIN = 16 * 171, I_UP = 8 * 32, I_OUT = 16 * 32, I_W1 = 32 * 4;
    constexpr int T0 = I_WIN, T1 = T0 + I_UP, T2 = T1 + I_UP, T3 = T2 + I_OUT, T4 = T3 + 2 * I_W1, T5 = T4 + 2050, T6 = T5 + 512, T7 = T6 + 768, T8 = T7 + SBATCH * 32, T9 = T8 + SBATCH * 128;
#ifdef ORACLE
    constexpr int TEND = T9;
#else
    constexpr int TEND = T7;
#endif
    for (int it = gw; it < TEND; it += NGW) {
        if (it < T0) p0_transpose_item<true>(F.win, 1024, 5468, WSP(bf16, WS_WINT), scr, it, F.lane);
        else if (it < T1) p0_transpose_item<false>(F.wupn, 512, 1024, WSP(bf16, WS_WUPN), scr, it - T0, F.lane);
        else if (it < T2) p0_transpose_item<false>(F.wupd, 512, 1024, WSP(bf16, WS_WUPD), scr, it - T1, F.lane);
        else if (it < T3) p0_transpose_item<false>(F.wout, 1024, 1024, WSP(bf16, WS_WOUT), scr, it - T2, F.lane);
        else if (it < T4) { const int q = it - T3, slot = q / I_W1; p0_transpose_item<false>(F.w1 + (size_t)slot * 2048 * 128, 2048, 128, WSP(bf16, WS_W1T) + (size_t)slot * 128 * 2048, scr, q % I_W1, F.lane); }
        else if (it < T5) p0_rope_item(F, it - T4);
        else if (it < T6) p0_cmp_small_item(F, it - T5);
        else if (it < T7) p0_zero_item(F, it - T6);
#ifdef ORACLE
        else if (it < T8) p0_win_item(F, it - T7);
        else p0_gather_item(F, it - T8);
#endif
    }
    constexpr int ROW4 = 508 * 64;
    const f32x4* src = (const f32x4*)F.swin; f32x4* dst = (f32x4*)(F.out + O_WINS);
    for (int it = blockIdx.x; it < 2 * SBATCH; it += F.G) {
        const int sb = it >> 1, h0 = (it & 1) * (ROW4 / 2);
        const f32x4* sp = src + (size_t)sb * 512 * 64 + 4 * 64 + h0; f32x4* dp = dst + (size_t)sb * 512 * 64 + h0;
        for (int i = F.tid; i < ROW4 / 2; i += 512 * 8) {
            f32x4 v[8];
#pragma unroll
            for (int j = 0; j < 8; ++j) { const int k = i + j * 512; v[j] = k < ROW4 / 2 ? __builtin_nontemporal_load(sp + k) : (f32x4){0.f, 0.f, 0.f, 0.f}; }
#pragma unroll
            for (int j = 0; j < 8; ++j) { const int k = i + j * 512; if (k < ROW4 / 2) __builtin_nontemporal_store(v[j], dp + k); }
        }
    }
}
DI void p1_adaln(Frame& F) {
    const int gw = blockIdx.x * NWAVES + F.wave, NGW = F.G * NWAVES;
    if (blockIdx.x == 0 && F.tid < 256) { float a = 0.f; for (int j = 0; j < 64; ++j) a += WSP(float, WS_BIASP)[j * 256 + F.tid]; WSP(float, WS_BIAS1)[F.tid] = a; }
    const float* mod = WSP(float, WS_MOD);
    for (int r = gw; r < MR; r += NGW) {
        const float* xr = r < MP ? F.xp + (size_t)r * 1024 : F.xs + (size_t)(r - MP) * 1024;
        const int mrow = r < MP ? (r >> 12) : 4 + ((r - MP) >> 2);
        const f32x4* x4 = (const f32x4*)xr + F.lane;
        f32x4 v[4]; float s = 0.f;
#pragma unroll
        for (int j = 0; j < 4; ++j) { v[j] = x4[64 * j]; s += (v[j][0] * v[j][0] + v[j][1] * v[j][1]) + (v[j][2] * v[j][2] + v[j][3] * v[j][3]); }
        const float rstd = 1.f / sqrtf(wave_sum(s) * (1.f / 1024.f) + 1e-6f);
        const f32x4* g4 = (const f32x4*)F.normg + F.lane;
        const f32x4* sh4 = (const f32x4*)(mod + (size_t)mrow * 3072) + F.lane;
        const f32x4* sc4 = (const f32x4*)(mod + (size_t)mrow * 3072 + 1024) + F.lane;
        unsigned long long* o8 = (unsigned long long*)(WSP(bf16, WS_H) + (size_t)r * 1024) + F.lane;
#pragma unroll
        for (int j = 0; j < 4; ++j) {
            const f32x4 y = v[j] * rstd * g4[64 * j]; const f32x4 h = y * (1.f + sc4[64 * j]) + sh4[64 * j];
            o8[64 * j] = (unsigned long long)pk2(h[0], h[1]) | ((unsigned long long)pk2(h[2], h[3]) << 32);
        }
    }
}
DI void p8_final(Frame& F) {
    const int gw = blockIdx.x * NWAVES + F.wave, NGW = F.G * NWAVES;
    for (int r = gw; r < MR; r += NGW) {
        float* yr = r < MP ? F.out + O_YP + (size_t)r * 1024 : F.out + O_YS + (size_t)(r - MP) * 1024;
        f32x4* y4 = (f32x4*)yr + F.lane;
        f32x4 v[4]; float s = 0.f;
#pragma unroll
        for (int j = 0; j < 4; ++j) { v[j] = y4[64 * j]; s += (v[j][0] * v[j][0] + v[j][1] * v[j][1]) + (v[j][2] * v[j][2] + v[j][3] * v[j][3]); }
        const float rstd = 1.f / sqrtf(wave_sum(s) * (1.f / 1024.f) + 1e-6f);
        const f32x4* g4 = (const f32x4*)F.fing + F.lane;
#pragma unroll
        for (int j = 0; j < 4; ++j) y4[64 * j] = v[j] * rstd * g4[64 * j];
    }
}

constexpr int TP = 144;
constexpr int TILE_B = 64 * TP;
struct LdsT {
    static constexpr bool HOIST = true;
    const LAS unsigned char* p;
    DI bf16x8 frag(int mt, int s) const { return *(const LAS bf16x8*)(p + mt * 32 * TP + s * 32); }
};
struct GlbT {
    static constexpr bool HOIST = false;
    const bf16* base; unsigned off; unsigned pitch;
    DI bf16x8 frag(int mt, int s) const { return *(const bf16x8*)(base + (size_t)(off + (unsigned)mt * 32u * pitch + (unsigned)s * 16u)); }
};
template <class KT> DI void qk_tile(f32x16& s0, f32x16& s1, const KT& kt, const bf16x8 (&q)[4]) {
    f32x16 z;
#pragma unroll
    for (int i = 0; i < 16; ++i) z[i] = 0.f;
    s0 = z; s1 = z;
#pragma unroll
    for (int s = 0; s < 4; ++s) { s0 = MFMA32(kt.frag(0, s), q[s], s0); s1 = MFMA32(kt.frag(1, s), q[s], s1); }
}
DI bf16x8 cvt8(f32x4 a, f32x4 b) { u32x4 w; w.x = pk2(a[0], a[1]); w.y = pk2(a[2], a[3]); w.z = pk2(b[0], b[1]); w.w = pk2(b[2], b[3]); return __builtin_bit_cast(bf16x8, w); }
DI bf16x8 pack_p(const f32x16& x, int h) {
    u32x4 w; w.x = pk2(x[8 * h], x[8 * h + 1]); w.y = pk2(x[8 * h + 2], x[8 * h + 3]); w.z = pk2(x[8 * h + 4], x[8 * h + 5]); w.w = pk2(x[8 * h + 6], x[8 * h + 7]);
    return __builtin_bit_cast(bf16x8, w);
}
template <class VT> DI void pv_tile(f32x16& o0, f32x16& o1, const f32x16& p0, const f32x16& p1, const VT& vt) {
    const bf16x8 b0 = pack_p(p0, 0), b1 = pack_p(p0, 1), b2 = pack_p(p1, 0), b3 = pack_p(p1, 1);
    o0 = MFMA32(vt.frag(0, 0), b0, o0); o1 = MFMA32(vt.frag(1, 0), b0, o1);
    o0 = MFMA32(vt.frag(0, 1), b1, o0); o1 = MFMA32(vt.frag(1, 1), b1, o1);
    o0 = MFMA32(vt.frag(0, 2), b2, o0); o1 = MFMA32(vt.frag(1, 2), b2, o1);
    o0 = MFMA32(vt.frag(0, 3), b3, o0); o1 = MFMA32(vt.frag(1, 3), b3, o1);
}
struct Soft { float m, l; bool seen; f32x16 o0, o1, negm; };
DI void soft_init(Soft& S) {
    S.m = 0.f; S.l = 0.f; S.seen = false;
#pragma unroll
    for (int i = 0; i < 16; ++i) { S.o0[i] = 0.f; S.o1[i] = 0.f; S.negm[i] = 0.f; }
}
template <class KT> DI void qk_tile_c(f32x16& s0, f32x16& s1, const KT& kt, const bf16x8 (&q)[4], const f32x16& c) {
    if constexpr (KT::HOIST) {
        bf16x8 f[8];
#pragma unroll
        for (int s = 0; s < 4; ++s) { f[2 * s] = kt.frag(0, s); f[2 * s + 1] = kt.frag(1, s); }
        __builtin_amdgcn_sched_barrier(0);
        s0 = MFMA32(f[0], q[0], c); s1 = MFMA32(f[1], q[0], c);
#pragma unroll
        for (int s = 1; s < 4; ++s) { s0 = MFMA32(f[2 * s], q[s], s0); s1 = MFMA32(f[2 * s + 1], q[s], s1); }
    } else {
        s0 = MFMA32(kt.frag(0, 0), q[0], c); s1 = MFMA32(kt.frag(1, 0), q[0], c);
#pragma unroll
        for (int s = 1; s < 4; ++s) { s0 = MFMA32(kt.frag(0, s), q[s], s0); s1 = MFMA32(kt.frag(1, s), q[s], s1); }
    }
    asm volatile("s_nop 15\n\ts_nop 7" : "+v"(s0), "+v"(s1));
}
DI float max3f(float a, float b, float c) { float r; asm("v_max3_f32 %0, %1, %2, %3" : "=v"(r) : "v"(a), "v"(b), "v"(c)); return r; }
template <class VT> DI void soft_step(Soft& S, f32x16& s0, f32x16& s1, const VT& vt) {
    bf16x8 vf[8];
    if constexpr (VT::HOIST) {
#pragma unroll
        for (int s = 0; s < 4; ++s) { vf[2 * s] = vt.frag(0, s); vf[2 * s + 1] = vt.frag(1, s); }
        __builtin_amdgcn_sched_barrier(0);
    }
    float mx = max3f(s0[0], s1[0], s0[1]), my = max3f(s1[1], s0[2], s1[2]);
#pragma unroll
    for (int r = 3; r < 15; r += 2) { mx = max3f(mx, s0[r], s1[r]); my = max3f(my, s0[r + 1], s1[r + 1]); }
    mx = max3f(mx, s0[15], s1[15]); mx = max3f(mx, my, mx);
    mx = max3f(mx, half_other(mx), mx);
    const bool fin = mx > NEGINF;
    const bool need = (mx > 8.f) | (fin & !S.seen);
    if (__any(need)) {
        const float dl = need ? mx : 0.f;
        const float al = S.seen ? __builtin_amdgcn_exp2f(-dl) : 0.f;
        S.m += dl; S.l *= need ? al : 1.f;
        const float am = need ? al : 1.f;
#pragma unroll
        for (int r = 0; r < 16; ++r) { s0[r] -= dl; s1[r] -= dl; S.o0[r] *= am; S.o1[r] *= am; S.negm[r] = -S.m; }
    }
    S.seen = S.seen | fin;
    float ps = 0.f;
#pragma unroll
    for (int r = 0; r < 16; ++r) { s0[r] = __builtin_amdgcn_exp2f(s0[r]); s1[r] = __builtin_amdgcn_exp2f(s1[r]); ps += s0[r] + s1[r]; }
    S.l += ps;
    const bf16x8 b0 = pack_p(s0, 0), b1 = pack_p(s0, 1), b2 = pack_p(s1, 0), b3 = pack_p(s1, 1);
    if constexpr (!VT::HOIST) {
#pragma unroll
        for (int s = 0; s < 4; ++s) { vf[2 * s] = vt.frag(0, s); vf[2 * s + 1] = vt.frag(1, s); }
    }
    S.o0 = MFMA32(vf[0], b0, S.o0); S.o1 = MFMA32(vf[1], b0, S.o1);
    S.o0 = MFMA32(vf[2], b1, S.o0); S.o1 = MFMA32(vf[3], b1, S.o1);
    S.o0 = MFMA32(vf[4], b2, S.o0); S.o1 = MFMA32(vf[5], b2, S.o1);
    S.o0 = MFMA32(vf[6], b3, S.o0); S.o1 = MFMA32(vf[7], b3, S.o1);
}
DI float as_f(int x) { return __int_as_float(x); }
DI float mask_sel(float s, int mm) { return __int_as_float((__float_as_int(s) & mm) | ((int)0xff800000 & ~mm)); }
DI u32x4 tile_ld(const bf16* g, size_t pitch, int tid) { return *(const u32x4*)(g + (size_t)(tid >> 3) * pitch + (tid & 7) * 8); }
DI void tile_st(LAS unsigned char* buf, u32x4 v, int tid) { *(LAS u32x4*)(buf + (tid >> 3) * TP + (tid & 7) * 16) = v; }

constexpr int CP = 272;
DI void compress_unit(Frame& F, int u) {
    const int tid = F.tid, lane = F.lane, w = F.wave, l31 = lane & 31, hi = lane >> 5;
    const int slot = u / 136, rem = u % 136;
    const bf16* data; bf16 *ock, *ocvt; int n0, ncmp, cpitch;
    if (rem < 8) { const int bg = rem; data = WSP(bf16, (slot ? WS_PCMPV : WS_PCMPK)) + (size_t)bg * SEQ * 64; n0 = 32 * w; ncmp = 255; cpitch = 256;
        ock = WSP(bf16, WS_PCK) + (size_t)bg * 256 * 64; ocvt = WSP(bf16, WS_PCVT) + (size_t)bg * 64 * 256; }
    else { const int bg = 2 * (rem - 8) + (w >> 2); data = WSP(bf16, (slot ? WS_SCMPV : WS_SCMPK)) + (size_t)bg * LS * 64; n0 = 32 * (w & 3); ncmp = 127; cpitch = 128;
        ock = WSP(bf16, WS_SCK) + (size_t)bg * 128 * 64; ocvt = WSP(bf16, WS_SCVT) + (size_t)bg * 64 * 128; }
    const int n = n0 + l31, nc = n < ncmp ? n : ncmp - 1;
    const bf16* drow = data + (size_t)nc * 1024 + 8 * hi;
    const bool paged = rem >= 8;
    const float *prA = nullptr, *prB = nullptr; int jsplit = 64;
    if (paged) { const int bg = 2 * (rem - 8) + (w >> 2), sb = bg >> 1, g = bg & 1, t0 = 16 * nc;
        const int pgA = F.ptab[sb * NPG + (t0 >> 7)], pgB = F.ptab[sb * NPG + ((t0 + 31) >> 7)];
        jsplit = 128 - (t0 & 127);
        prA = F.cnsa + ((size_t)pgA * PAGE + (t0 & 127)) * 512 + (slot * 2 + g) * 64 + 8 * hi;
        prB = F.cnsa + ((size_t)pgB * PAGE) * 512 + (slot * 2 + g) * 64 + 8 * hi - (size_t)jsplit * 512;
    }
    const bf16* w1t = WSP(bf16, WS_W1T) + (size_t)slot * 128 * 2048;
    f32x16 acc[4];
#pragma unroll
    for (int c = 0; c < 4; ++c)
#pragma unroll
        for (int i = 0; i < 16; ++i) acc[c][i] = 0.f;
    const bf16* wsrc = w1t + (size_t)(tid >> 2) * 2048 + (tid & 3) * 32;
    LAS unsigned char* wdst = F.lds + (tid >> 2) * CP + (tid & 3) * 64;
    u32x4 st[4];
#pragma unroll
    for (int i = 0; i < 4; ++i) st[i] = ((const u32x4*)wsrc)[i];
#pragma unroll
    for (int i = 0; i < 4; ++i) ((LAS u32x4*)wdst)[i] = st[i];
    LDS_BARRIER();
    f32x4 raw[16];
#define CMP_ISSUE(kc_) do { if (!paged) { _Pragma("unroll") for (int s_ = 0; s_ < 8; ++s_) raw[2 * s_] = __builtin_bit_cast(f32x4, *(const bf16x8*)(drow + (kc_) * 128 + s_ * 16)); } \
        else { _Pragma("unroll") for (int s_ = 0; s_ < 8; ++s_) { const int j_ = 2 * (kc_) + (s_ >> 2); const f32x4* q_ = (const f32x4*)((j_ < jsplit ? prA : prB) + (size_t)j_ * 512 + 16 * (s_ & 3)); raw[2 * s_] = q_[0]; raw[2 * s_ + 1] = q_[1]; } } } while (0)
    CMP_ISSUE(0);
    for (int kc = 0; kc < 16; ++kc) {
        const LAS unsigned char* buf = F.lds + (kc & 1) * (128 * CP);
        if (kc + 1 < 16) {
#pragma unroll
            for (int i = 0; i < 4; ++i) st[i] = ((const u32x4*)(wsrc + (kc + 1) * 128))[i];
        }
        bf16x8 bq[8];
        if (!paged) {
#pragma unroll
            for (int s = 0; s < 8; ++s) bq[s] = __builtin_bit_cast(bf16x8, raw[2 * s]);
        } else {
#pragma unroll
            for (int s = 0; s < 8; ++s) bq[s] = cvt8(raw[2 * s], raw[2 * s + 1]);
        }
        if (kc + 1 < 16) CMP_ISSUE(kc + 1);
#pragma unroll
        for (int s = 0; s < 8; ++s)
#pragma unroll
            for (int c = 0; c < 4; ++c) acc[c] = MFMA32(*(const LAS bf16x8*)(buf + (32 * c + l31) * CP + s * 32 + hi * 16), bq[s], acc[c]);
        if (kc + 1 < 16) {
            LAS unsigned char* nb = wdst + ((kc + 1) & 1) * (128 * CP);
#pragma unroll
            for (int i = 0; i < 4; ++i) ((LAS u32x4*)nb)[i] = st[i];
        }
        LDS_BARRIER();
    }
#undef CMP_ISSUE
    const float* b1 = WSP(float, WS_BIAS1) + slot * 128;
#pragma unroll
    for (int c = 0; c < 4; ++c)
#pragma unroll
        for (int q = 0; q < 4; ++q) { const f32x4 bv = *(const f32x4*)(b1 + 32 * c + 8 * q + 4 * hi);
#pragma unroll
            for (int j = 0; j < 4; ++j) acc[c][4 * q + j] = silu_f(acc[c][4 * q + j] + bv[j]); }
    const bf16* w2t = WSP(bf16, WS_W2T) + (size_t)slot * 64 * 128 + (size_t)l31 * 128 + 8 * hi;
    f32x16 o0, o1;
#pragma unroll
    for (int i = 0; i < 16; ++i) { o0[i] = 0.f; o1[i] = 0.f; }
#pragma unroll
    for (int c = 0; c < 4; ++c)
#pragma unroll
        for (int h = 0; h < 2; ++h) { const bf16x8 hb = pack_p(acc[c], h); const int s2 = 2 * c + h;
            o0 = MFMA32(*(const bf16x8*)(w2t + s2 * 16), hb, o0); o1 = MFMA32(*(const bf16x8*)(w2t + 32 * 128 + s2 * 16), hb, o1); }
    const bool ok = n < ncmp;
    if (slot == 0) {
#pragma unroll
        for (int e = 0; e < 2; ++e)
#pragma unroll
            for (int q = 0; q < 4; ++q) { const f32x16& o = e ? o1 : o0; u32x2 wv;
                wv.x = ok ? pk2(o[4 * q], o[4 * q + 1]) : 0u; wv.y = ok ? pk2(o[4 * q + 2], o[4 * q + 3]) : 0u;
                *(u32x2*)(ock + (size_t)n * 64 + 32 * e + 8 * q + 4 * hi) = wv; }
    } else {
        const int pn = permk(n);
#pragma unroll
        for (int e = 0; e < 2; ++e)
#pragma unroll
            for (int r = 0; r < 16; ++r) { const f32x16& o = e ? o1 : o0; ocvt[(size_t)(32 * e + crow(r, hi)) * cpitch + pn] = ok ? (bf16)(pk2(o[r], 0.f) & 0xffffu) : (bf16)0; }
    }
}

template <int NR, int ABL> DI void idx_select(const LAS int* scw, int n, int lane, unsigned long long* out) {
    int k[NR];
    int kmin = 0x7fffffff, kmax = (int)0x80000000;
#pragma unroll
    for (int i = 0; i < NR; ++i) { const bool v = 64 * i + lane < n; const int x = v ? scw[64 * i + lane] : (int)0x80000000; k[i] = x; kmin = v ? (x < kmin ? x : kmin) : kmin; kmax = x > kmax ? x : kmax; }
    int thr = (int)0x80000000, cut = -1;
    if (n > 256 && !(ABL & 1)) {
#pragma unroll
        for (int o = 1; o < 64; o <<= 1) { const int a = __shfl_xor(kmin, o), b = __shfl_xor(kmax, o); kmin = a < kmin ? a : kmin; kmax = b > kmax ? b : kmax; }
        int lo = __builtin_amdgcn_readfirstlane(kmin) - 1, hiv = __builtin_amdgcn_readfirstlane(kmax);
        bool found = false;
        while ((unsigned)hiv - (unsigned)lo > 1u) {
            const unsigned step = ((unsigned)hiv - (unsigned)lo) >> 1;
            const int mid = (int)((unsigned)lo + step);
            int c = 0;
#pragma unroll
            for (int i0 = 0; i0 < NR; i0 += 8) {
                unsigned long long bm[8];
#pragma unroll
                for (int j = 0; j < 8; ++j) bm[j] = __ballot(k[i0 + j] > mid);
#pragma unroll
                for (int j = 0; j < 8; ++j) c += __popcll(bm[j]);
            }
            if (c == 256) { thr = mid; found = true; break; }
            if (c > 256) lo = mid; else hiv = mid;
        }
        if (!found) {
            thr = hiv; int cgt = 0;
#pragma unroll
            for (int i = 0; i < NR; ++i) cgt += __popcll(__ballot(k[i] > thr));
            const int need = 256 - cgt; int acc = 0; bool done = false;
#pragma unroll
            for (int i = 0; i < NR; ++i) {
                unsigned long long mk = __ballot(k[i] == thr); const int pc = __popcll(mk);
                if (!done && acc + pc >= need) { for (int q2 = 1; q2 < need - acc; ++q2) mk &= mk - 1; cut = 64 * i + (int)__builtin_ctzll(mk); done = true; }
                acc += pc;
            }
        }
    }
    unsigned long long myw = 0ull;
    if (ABL & 4) { myw = (unsigned long long)(k[0] + k[NR - 1] + kmin + kmax); } else
#pragma unroll
    for (int i = 0; i < NR; ++i) { const unsigned long long mk = __ballot((k[i] > thr) | ((k[i] == thr) & (64 * i + lane <= cut))); myw = (lane == i) ? mk : myw; }
    out[lane] = myw;
}
template <bool SAMPLE, int ABL> DI void idx1_unit(Frame& F, int u) {
    const int lane = F.lane, w = F.wave, l31 = lane & 31, hi = lane >> 5, tl = l31 >> 2, hl = l31 & 3;
    int row0, nkmax, ntok; const bf16* ik;
    if (!SAMPLE) { const int b = u & 3, tc = 511 - (u >> 2); row0 = b * SEQ + 8 * tc; nkmax = 8 * tc + 8; ntok = 8; ik = WSP(bf16, WS_PIDXK) + (size_t)b * SEQ * 64; }
    else { row0 = MP + 4 * u; nkmax = PASTL + 4; ntok = 4; ik = WSP(bf16, WS_SIDXK) + (size_t)u * LS * 64; }
    const int rowq = row0 + (SAMPLE ? (tl & 3) : tl);
    bf16x8 q[4];
#pragma unroll
    for (int s = 0; s < 4; ++s) q[s] = *(const bf16x8*)(WSP(bf16, WS_IQ) + (size_t)rowq * 256 + hl * 64 + 16 * s + 8 * hi);
    f32x4 wq[4];
#pragma unroll
    for (int qq = 0; qq < 4; ++qq) { const int tk = 2 * qq + hi; wq[qq] = *(const f32x4*)(WSP(float, WS_IW) + (size_t)(row0 + (SAMPLE ? (tk & 3) : tk)) * 4); }
    PIN4(q); PIN4(wq);
    LAS int* sc = (LAS int*)F.lds;
    const int n32 = (nkmax + 31) >> 5;
    u32x4 rA[8], rB[8];
    asm volatile("s_waitcnt vmcnt(0)" ::: "memory");
#define IDX_ISSUE(R, kt_) do { const int kk_ = (kt_) < n32 ? (kt_) : n32 - 1; \
        if (SAMPLE) { if (kk_ < 64) { const int pg = F.ptab[u * NPG + (kk_ >> 2)]; const float* fp = F.cidx + ((size_t)pg * PAGE + (kk_ & 3) * 32 + l31) * 64 + 8 * hi; \
              _Pragma("unroll") for (int s_ = 0; s_ < 4; ++s_) { R[2 * s_] = gload16(fp + 16 * s_); R[2 * s_ + 1] = gload16(fp + 16 * s_ + 4); } } \
            else { const bf16* kp = ik + (size_t)(32 * kk_ + l31) * 64 + 8 * hi; \
              _Pragma("unroll") for (int s_ = 0; s_ < 4; ++s_) { R[2 * s_] = gload16(kp + 16 * s_); R[2 * s_ + 1] = gload16(kp + 16 * s_); } } } \
        else { const bf16* kp = ik + (size_t)(32 * kk_ + l31) * 64 + 8 * hi; \
            _Pragma("unroll") for (int s_ = 0; s_ < 4; ++s_) R[2 * s_] = gload16(kp + 16 * s_); } } while (0)
#define IDX_WAIT(R) do { if (SAMPLE) asm volatile("s_waitcnt vmcnt(8)" : "+v"(R[0]), "+v"(R[1]), "+v"(R[2]), "+v"(R[3]), "+v"(R[4]), "+v"(R[5]), "+v"(R[6]), "+v"(R[7]) :: "memory"); \
        else asm volatile("s_waitcnt vmcnt(4)" : "+v"(R[0]), "+v"(R[2]), "+v"(R[4]), "+v"(R[6]) :: "memory"); } while (0)
#define IDX_SCORE(R, kt_) do { IDX_WAIT(R); if ((kt_) < n32) { bf16x8 kf[4]; \
        if (SAMPLE && (kt_) < 64) { _Pragma("unroll") for (int s_ = 0; s_ < 4; ++s_) kf[s_] = cvt8(__builtin_bit_cast(f32x4, R[2 * s_]), __builtin_bit_cast(f32x4, R[2 * s_ + 1])); } \
        else { _Pragma("unroll") for (int s_ = 0; s_ < 4; ++s_) kf[s_] = __builtin_bit_cast(bf16x8, R[2 * s_]); } \
        f32x16 a; _Pragma("unroll") for (int i_ = 0; i_ < 16; ++i_) a[i_] = 0.f; \
        _Pragma("unroll") for (int s_ = 0; s_ < 4; ++s_) a = MFMA32(q[s_], kf[s_], a); \
        _Pragma("unroll") for (int qq = 0; qq < 4; ++qq) { \
            float v = fmaxf(a[4 * qq], 0.f) * wq[qq][0] + fmaxf(a[4 * qq + 1], 0.f) * wq[qq][1] + fmaxf(a[4 * qq + 2], 0.f) * wq[qq][2] + fmaxf(a[4 * qq + 3], 0.f) * wq[qq][3]; \
            int uu = __float_as_int(v); uu = (uu == (int)0x80000000) ? 0 : uu; \
            sc[(2 * qq + hi) * 4096 + 32 * (kt_) + l31] = uu ^ ((uu >> 31) & 0x7fffffff); } } } while (0)
    if (!(ABL & 2)) {
        IDX_ISSUE(rA, w); IDX_ISSUE(rB, w + NWAVES);
        for (int kt = w; kt < n32; kt += 2 * NWAVES) {
            IDX_SCORE(rA, kt); IDX_ISSUE(rA, kt + 2 * NWAVES);
            IDX_SCORE(rB, kt + NWAVES); IDX_ISSUE(rB, kt + 3 * NWAVES);
        }
        asm volatile("s_waitcnt vmcnt(0)" : "+v"(rA[0]), "+v"(rA[2]), "+v"(rA[4]), "+v"(rA[6]), "+v"(rB[0]), "+v"(rB[2]), "+v"(rB[4]), "+v"(rB[6]) :: "memory");
        if (SAMPLE) asm volatile("" : "+v"(rA[1]), "+v"(rA[3]), "+v"(rA[5]), "+v"(rA[7]), "+v"(rB[1]), "+v"(rB[3]), "+v"(rB[5]), "+v"(rB[7]));
    }
#undef IDX_ISSUE
#undef IDX_WAIT
#undef IDX_SCORE
    __syncthreads();
    if (w < ntok && !(ABL & 8)) {
        const int n = SAMPLE ? (PASTL + 1 + w) : (row0 - (row0 & ~(SEQ - 1)) + w + 1);
        unsigned long long* out = WSP(unsigned long long, ABL ? WS_T1 : WS_SELM) + (size_t)(row0 + w) * 64;
        const LAS int* scw = sc + w * 4096;
        if (n <= 1024) idx_select<16, ABL>(scw, n, lane, out);
        else if (n <= 2048) idx_select<32, ABL>(scw, n, lane, out);
        else if (n <= 3072) idx_select<48, ABL>(scw, n, lane, out);
        else idx_select<64, ABL>(scw, n, lane, out);
    }
    __syncthreads();
}

constexpr int NSA_PS = 2 * 2 * TILE_B;
constexpr int NSA_WS = 8192 + 2048 + 64;
template <bool SAMPLE> DI void nsa_unit(Frame& F, int u) {
    const int tid = F.tid, lane = F.lane, w = F.wave, l31 = lane & 31, hi = lane >> 5, tl = l31 >> 2, hl = l31 & 3;
    int bg, g, row, qpos, ncmp, wlo, whi, n_ctile, n_stile, w_t0, w_t1, qt = 0;
    size_t cpitch, pitch, wpitch; const bf16 *ck, *cvt, *sk, *svt, *wk, *wvt; bool wr_ok;
    if (!SAMPLE) {
        bg = u & 7; qt = 63 - (u >> 3); g = bg & 1; const int t = 64 * qt + 8 * w + tl; row = (bg >> 1) * SEQ + t; qpos = t; ncmp = 255;
        cpitch = 256; pitch = SEQ; wpitch = SEQ;
        ck = WSP(bf16, WS_PCK) + (size_t)bg * 256 * 64; cvt = WSP(bf16, WS_PCVT) + (size_t)bg * 64 * 256;
        sk = WSP(bf16, WS_PSLCK) + (size_t)bg * SEQ * 64; svt = WSP(bf16, WS_PSLCVT) + (size_t)bg * 64 * SEQ;
        wk = WSP(bf16, WS_PWINK) + (size_t)bg * SEQ * 64; wvt = WSP(bf16, WS_PWINVT) + (size_t)bg * 64 * SEQ;
        wlo = qpos - 511; whi = qpos; n_ctile = (4 * qt + 2) / 64 + 1; n_stile = qt + 1; w_t0 = qt > 8 ? qt - 8 : 0; w_t1 = qt; wr_ok = true;
    } else {
        bg = u * 8 + w; g = bg & 1; const int i = tl & 3; row = MP + (bg >> 1) * 4 + i; qpos = PASTL + i; ncmp = 127;
        cpitch = 128; pitch = LS; wpitch = LSW;
        ck = WSP(bf16, WS_SCK) + (size_t)bg * 128 * 64; cvt = WSP(bf16, WS_SCVT) + (size_t)bg * 64 * 128;
        sk = WSP(bf16, WS_SSLCK) + (size_t)bg * LS * 64; svt = WSP(bf16, WS_SSLCVT) + (size_t)bg * 64 * LS;
        wk = WSP(bf16, WS_SWINK) + (size_t)bg * LSW * 64; wvt = WSP(bf16, WS_SWINVT) + (size_t)bg * 64 * LSW;
        wlo = 1 + i; whi = 512 + i; n_ctile = 2; n_stile = 33; w_t0 = 0; w_t1 = 8; wr_ok = tl < 4;
    }
    const int hq = 4 * g + hl;
    bf16x8 qraw[4], qrot[4];
#pragma unroll
    for (int s = 0; s < 4; ++s) qraw[s] = *(const bf16x8*)(WSP(bf16, WS_QRAW) + (size_t)row * 512 + hq * 64 + 16 * s + 8 * hi);
    LAS unsigned char* const lb = F.lds;
    LAS float* psum = (LAS float*)(lb + NSA_PS + w * NSA_WS);
    LAS float* impb = (LAS float*)(lb + NSA_PS + w * NSA_WS + 8192);
    LAS unsigned char* selb = lb + NSA_PS + w * NSA_WS + 8192 + 2048;
    const int fo = l31 * TP + hi * 16;
    const float* gp = WSP(float, WS_GATES) + (size_t)row * 24 + hq * 3;
    float g0 = gp[0], g1 = gp[1], g2 = gp[2];
    PIN4(qraw); asm volatile("" : "+v"(g0), "+v"(g1), "+v"(g2));
    f32x16 s0, s1;
    u32x4 rk, rv;
    Soft S;

    const int nvr = (qpos - 31) >> 4, nvis = nvr < ncmp - 1 ? nvr : ncmp - 1;
    float m = -1e30f, l = 0.f;
    if (!SAMPLE) { rk = tile_ld(ck, 64, tid); rv = tile_ld(cvt, cpitch, tid); tile_st(lb, rk, tid); tile_st(lb + TILE_B, rv, tid); LDS_BARRIER(); }
    for (int ct = 0; ct < n_ctile; ++ct) {
        if (!SAMPLE) { if (ct + 1 < n_ctile) { rk = tile_ld(ck + (size_t)(ct + 1) * 64 * 64, 64, tid); rv = tile_ld(cvt + (ct + 1) * 64, cpitch, tid); } }
        if (!SAMPLE) { LdsT kt{lb + (ct & 1) * 2 * TILE_B + fo}; qk_tile(s0, s1, kt, qraw); }
        else { GlbT kt{ck, (unsigned)((64 * ct + l31) * 64 + 8 * hi), 64u}; qk_tile(s0, s1, kt, qraw); }
        float mx = -1e30f;
        const int nv2 = nvis - 64 * ct - 4 * hi;
#pragma unroll
        for (int r = 0; r < 16; ++r) { const int cr = (r & 3) + 8 * (r >> 2); s0[r] = cr <= nv2 ? s0[r] : NEGINF; s1[r] = cr + 32 <= nv2 ? s1[r] : NEGINF; mx = fmaxf(mx, fmaxf(s0[r], s1[r])); }
        mx = fmaxf(mx, half_other(mx));
        const float mn = fmaxf(m, mx); float ps = 0.f;
#pragma unroll
        for (int r = 0; r < 16; ++r) ps += __builtin_amdgcn_exp2f(s0[r] - mn) + __builtin_amdgcn_exp2f(s1[r] - mn);
        l = l * __builtin_amdgcn_exp2f(m - mn) + ps; m = mn;
        if (!SAMPLE) { if (ct + 1 < n_ctile) { tile_st(lb + ((ct + 1) & 1) * 2 * TILE_B, rk, tid); tile_st(lb + ((ct + 1) & 1) * 2 * TILE_B + TILE_B, rv, tid); } LDS_BARRIER(); }
    }
    l += half_other(l);
    const float linv = l > 0.f ? 1.f / l : 0.f;
    soft_init(S);
    if (!SAMPLE) { rk = tile_ld(ck, 64, tid); rv = tile_ld(cvt, cpitch, tid); tile_st(lb, rk, tid); tile_st(lb + TILE_B, rv, tid); LDS_BARRIER(); }
    for (int ct = 0; ct < n_ctile; ++ct) {
        if (!SAMPLE) { if (ct + 1 < n_ctile) { rk = tile_ld(ck + (size_t)(ct + 1) * 64 * 64, 64, tid); rv = tile_ld(cvt + (ct + 1) * 64, cpitch, tid); } }
        if (!SAMPLE) { LdsT kt{lb + (ct & 1) * 2 * TILE_B + fo}; qk_tile(s0, s1, kt, qraw); }
        else { GlbT kt{ck, (unsigned)((64 * ct + l31) * 64 + 8 * hi), 64u}; qk_tile(s0, s1, kt, qraw); }
        const int nv2 = nvis - 64 * ct - 4 * hi; LAS float* pw = psum + tl * 256 + 64 * ct + 4 * hi;
#pragma unroll
        for (int r = 0; r < 16; ++r) { const int cr = (r & 3) + 8 * (r >> 2);
            s0[r] = cr <= nv2 ? __builtin_amdgcn_exp2f(s0[r] - m) * linv : 0.f; s1[r] = cr + 32 <= nv2 ? __builtin_amdgcn_exp2f(s1[r] - m) * linv : 0.f;
            float a = s0[r]; a += dpp_x1(a); a += dpp_x2(a); float b = s1[r]; b += dpp_x1(b); b += dpp_x2(b);
            if (hl == 0) { pw[cr] = a; pw[cr + 32] = b; } }
        if (!SAMPLE) { LdsT vt{lb + (ct & 1) * 2 * TILE_B + TILE_B + fo}; pv_tile(S.o0, S.o1, s0, s1, vt); }
        else { GlbT vt{cvt, (unsigned)(l31 * (int)cpitch + 64 * ct + 8 * hi), (unsigned)cpitch}; pv_tile(S.o0, S.o1, s0, s1, vt); }
        if (!SAMPLE) { if (ct + 1 < n_ctile) { tile_st(lb + ((ct + 1) & 1) * 2 * TILE_B, rk, tid); tile_st(lb + ((ct + 1) & 1) * 2 * TILE_B + TILE_B, rv, tid); } LDS_BARRIER(); }
    }
    LDS_WAIT();
    unsigned mlo, mhi;
    {
        const int tk = lane >> 3, jb = 8 * (lane & 7);
        const int qp = SAMPLE ? PASTL + (tk & 3) : 64 * qt + 8 * w + tk, cur = qp >> 6;
        float pv[33];
        const LAS f32x4* pp = (const LAS f32x4*)(psum + tk * 256 + 4 * jb);
#pragma unroll
        for (int i = 0; i < 8; ++i) { const f32x4 x = pp[i]; pv[1 + 4 * i] = x[0]; pv[2 + 4 * i] = x[1]; pv[3 + 4 * i] = x[2]; pv[4 + 4 * i] = x[3]; }
        pv[0] = jb > 0 ? psum[tk * 256 + 4 * jb - 1] : 0.f;
        float v[8];
#pragma unroll
        for (int jj = 0; jj < 8; ++jj) {
            const int j = jb + jj;
            float a = pv[4 * jj] + pv[4 * jj + 1] + pv[4 * jj + 2] + pv[4 * jj + 3];
            a += (4 * j + 3 < ncmp) ? pv[4 * jj + 4] : 0.f;
            a = ((j == 0) | (j == cur) | (j == cur - 1)) ? 1e4f : a;
            a = (j > cur) ? -1e30f : a;
            v[jj] = a;
        }
        LAS f32x4* ip = (LAS f32x4*)(impb + tk * 64 + jb);
        ip[0] = (f32x4){v[0], v[1], v[2], v[3]}; ip[1] = (f32x4){v[4], v[5], v[6], v[7]};
        LDS_WAIT();
        int cnt[8];
#pragma unroll
        for (int jj = 0; jj < 8; ++jj) cnt[jj] = 0;
        const LAS f32x4* ap = (const LAS f32x4*)(impb + tk * 64);
#pragma unroll 1
        for (int i4 = 0; i4 < 16; ++i4) {
            const f32x4 x = ap[i4];
#pragma unroll
            for (int e = 0; e < 4; ++e) { const int i = 4 * i4 + e; const float xi = x[e];
#pragma unroll
                for (int jj = 0; jj < 8; ++jj) cnt[jj] += ((xi > v[jj]) | ((xi == v[jj]) & (i < jb + jj))) ? 1 : 0; }
        }
        unsigned bits = 0;
#pragma unroll
        for (int jj = 0; jj < 8; ++jj) bits |= ((cnt[jj] < 16) & (jb + jj <= cur)) ? (1u << jj) : 0u;
        selb[tk * 8 + (lane & 7)] = (unsigned char)bits;
        LDS_WAIT();
        const LAS unsigned* sp = (const LAS unsigned*)(selb + tl * 8);
        mlo = sp[0]; mhi = sp[1];
    }
    LAS float* park = psum + lane;
#pragma unroll
    for (int i = 0; i < 16; ++i) { park[i * 64] = g0 * S.o0[i]; park[(16 + i) * 64] = g0 * S.o1[i]; }
#pragma unroll
    for (int s = 0; s < 4; ++s) qrot[s] = *(const bf16x8*)(WSP(bf16, WS_QROT) + (size_t)row * 512 + hq * 64 + 16 * s + 8 * hi);
    PIN4(qrot);
    soft_init(S);
    const int qrel = (qpos & 63) - 4 * hi;
    if (!SAMPLE) { rk = tile_ld(sk, 64, tid); rv = tile_ld(svt, pitch, tid); tile_st(lb, rk, tid); tile_st(lb + TILE_B, rv, tid); LDS_BARRIER(); }
    for (int j = 0; j < n_stile; ++j) {
        if (!SAMPLE) { if (j + 1 < n_stile) { rk = tile_ld(sk + (size_t)(j + 1) * 64 * 64, 64, tid); rv = tile_ld(svt + (j + 1) * 64, pitch, tid); } }
        const bool bsel = ((j < 32 ? (mlo >> j) : (mhi >> (j - 32))) & 1u) != 0u;
        if (!SAMPLE) { LdsT kt{lb + (j & 1) * 2 * TILE_B + fo}; qk_tile_c(s0, s1, kt, qrot, S.negm); }
        else { GlbT kt{sk, (unsigned)((64 * j + l31) * 64 + 8 * hi), 64u}; qk_tile_c(s0, s1, kt, qrot, S.negm); }
        if (j == n_stile - 1) {
#pragma unroll
            for (int r = 0; r < 16; ++r) { const int cr = (r & 3) + 8 * (r >> 2); s0[r] = cr <= qrel ? s0[r] : NEGINF; s1[r] = cr + 32 <= qrel ? s1[r] : NEGINF; }
        } else {
#pragma unroll
            for (int r = 0; r < 16; ++r) { s0[r] = bsel ? s0[r] : NEGINF; s1[r] = bsel ? s1[r] : NEGINF; }
        }
        if (!SAMPLE) { LdsT vt{lb + (j & 1) * 2 * TILE_B + TILE_B + fo}; soft_step(S, s0, s1, vt); }
        else { GlbT vt{svt, (unsigned)(l31 * (int)pitch + 64 * j + 8 * hi), (unsigned)pitch}; soft_step(S, s0, s1, vt); }
        if (!SAMPLE) { if (j + 1 < n_stile) { tile_st(lb + ((j + 1) & 1) * 2 * TILE_B, rk, tid); tile_st(lb + ((j + 1) & 1) * 2 * TILE_B + TILE_B, rv, tid); } LDS_BARRIER(); }
    }
    S.l += half_other(S.l);
    { const float sc = g1 / fmaxf(S.l, 1e-30f);
#pragma unroll
      for (int i = 0; i < 16; ++i) { park[i * 64] += sc * S.o0[i]; park[(16 + i) * 64] += sc * S.o1[i]; } }
    soft_init(S);
    if (!SAMPLE) { rk = tile_ld(wk + (size_t)w_t0 * 64 * 64, 64, tid); rv = tile_ld(wvt + w_t0 * 64, wpitch, tid); tile_st(lb, rk, tid); tile_st(lb + TILE_B, rv, tid); LDS_BARRIER(); }
    for (int j = w_t0; j <= w_t1; ++j) {
        const int jr = j - w_t0;
        if (!SAMPLE) { if (j + 1 <= w_t1) { rk = tile_ld(wk + (size_t)(j + 1) * 64 * 64, 64, tid); rv = tile_ld(wvt + (j + 1) * 64, wpitch, tid); } }
        if (!SAMPLE) { LdsT kt{lb + (jr & 1) * 2 * TILE_B + fo}; qk_tile_c(s0, s1, kt, qrot, S.negm); }
        else { GlbT kt{wk, (unsigned)((64 * j + l31) * 64 + 8 * hi), 64u}; qk_tile_c(s0, s1, kt, qrot, S.negm); }
        if ((j == w_t0) | (j == w_t1)) {
            const int lo_r = wlo - 64 * j - 4 * hi, hi_r = whi - 64 * j - 4 * hi;
#pragma unroll
            for (int r = 0; r < 16; ++r) { const int k0 = (r & 3) + 8 * (r >> 2); s0[r] = ((k0 >= lo_r) & (k0 <= hi_r)) ? s0[r] : NEGINF; s1[r] = ((k0 + 32 >= lo_r) & (k0 + 32 <= hi_r)) ? s1[r] : NEGINF; }
        }
        if (!SAMPLE) { LdsT vt{lb + (jr & 1) * 2 * TILE_B + TILE_B + fo}; soft_step(S, s0, s1, vt); }
        else { GlbT vt{wvt, (unsigned)(l31 * (int)wpitch + 64 * j + 8 * hi), (unsigned)wpitch}; soft_step(S, s0, s1, vt); }
        if (!SAMPLE) { if (j + 1 <= w_t1) { tile_st(lb + ((jr + 1) & 1) * 2 * TILE_B, rk, tid); tile_st(lb + ((jr + 1) & 1) * 2 * TILE_B + TILE_B, rv, tid); } LDS_BARRIER(); }
    }
    S.l += half_other(S.l);
#ifdef BREAK_WIN
    S.l *= 1.1f;
#endif
    f32x16 res0, res1;
    { const float sc = g2 / fmaxf(S.l, 1e-30f);
#pragma unroll
      for (int i = 0; i < 16; ++i) { res0[i] = park[i * 64] + sc * S.o0[i]; res1[i] = park[(16 + i) * 64] + sc * S.o1[i]; } }
    if (wr_ok) {
        const bf16* zp = WSP(bf16, WS_ZN) + (size_t)row * 512 + hq * 64 + 4 * hi;
        bf16* op = WSP(bf16, WS_ONZ) + (size_t)row * 512 + hq * 64 + 4 * hi;
#pragma unroll
        for (int e = 0; e < 2; ++e)
#pragma unroll
            for (int q = 0; q < 4; ++q) { const f32x16& o = e ? res1 : res0; const u32x2 z = *(const u32x2*)(zp + 32 * e + 8 * q);
                u32x2 wv; wv.x = pk2(o[4 * q] * bflo(z.x), o[4 * q + 1] * bfhi(z.x)); wv.y = pk2(o[4 * q + 2] * bflo(z.y), o[4 * q + 3] * bfhi(z.y));
                *(u32x2*)(op + 32 * e + 8 * q) = wv; }
    }
}

template <int ABL, class VT> DI void soft_step2(Soft& S, f32x16& s0, f32x16& s1, f32x16& sn0, f32x16& sn1, const VT& vt) {
    bf16x8 vf[8];
#pragma unroll
    for (int s = 0; s < 4; ++s) { vf[2 * s] = vt.frag(0, s); vf[2 * s + 1] = vt.frag(1, s); }
    if (!(ABL & 1)) {
    float mx = max3f(s0[0], s1[0], s0[1]), my = max3f(s1[1], s0[2], s1[2]);
#pragma unroll
    for (int r = 3; r < 15; r += 2) { mx = max3f(mx, s0[r], s1[r]); my = max3f(my, s0[r + 1], s1[r + 1]); }
    mx = max3f(mx, s0[15], s1[15]); mx = max3f(mx, my, mx);
    mx = max3f(mx, half_other(mx), mx);
    const bool fin = mx > NEGINF;
    const bool need = (mx > 8.f) | (fin & !S.seen);
    if (__any(need)) {
        const float dl = need ? mx : 0.f;
        const float al = S.seen ? __builtin_amdgcn_exp2f(-dl) : 0.f;
        S.m += dl; S.l *= need ? al : 1.f;
        const float am = need ? al : 1.f;
#pragma unroll
        for (int r = 0; r < 16; ++r) { s0[r] -= dl; s1[r] -= dl; sn0[r] -= dl; sn1[r] -= dl; S.o0[r] *= am; S.o1[r] *= am; S.negm[r] = -S.m; }
    }
    S.seen = S.seen | fin;
    float ps = 0.f;
#pragma unroll
    for (int r = 0; r < 16; ++r) { s0[r] = __builtin_amdgcn_exp2f(s0[r]); s1[r] = __builtin_amdgcn_exp2f(s1[r]); ps += s0[r] + s1[r]; }
    S.l += ps;
    }
    const bf16x8 b0 = pack_p(s0, 0), b1 = pack_p(s0, 1), b2 = pack_p(s1, 0), b3 = pack_p(s1, 1);
    if (!(ABL & 4)) {
    S.o0 = MFMA32(vf[0], b0, S.o0); S.o1 = MFMA32(vf[1], b0, S.o1);
    S.o0 = MFMA32(vf[2], b1, S.o0); S.o1 = MFMA32(vf[3], b1, S.o1);
    S.o0 = MFMA32(vf[4], b2, S.o0); S.o1 = MFMA32(vf[5], b2, S.o1);
    S.o0 = MFMA32(vf[6], b3, S.o0); S.o1 = MFMA32(vf[7], b3, S.o1);
    } else { S.o0[0] += __builtin_bit_cast(f32x4, b0)[0] + __builtin_bit_cast(f32x4, b1)[0] + __builtin_bit_cast(f32x4, b2)[0] + __builtin_bit_cast(f32x4, b3)[0] + __builtin_bit_cast(f32x4, vf[0])[0] + __builtin_bit_cast(f32x4, vf[7])[1]; }
}
template <int ABL> DI void dsa_unit(Frame& F, int u) {
    const int tid = F.tid, lane = F.lane, w = F.wave, l31 = lane & 31, hi = lane >> 5, tl = l31 >> 2, hl = l31 & 3;
    const int bg = u & 7, qt = 63 - (u >> 3), g = bg & 1, t = 64 * qt + 8 * w + tl, row = (bg >> 1) * SEQ + t, nt = qt + 1;
    const bf16* dk = WSP(bf16, WS_PDSAK) + (size_t)bg * SEQ * 64; const bf16* dvt = WSP(bf16, WS_PDSAVT) + (size_t)bg * 64 * SEQ;
    const int hq = 4 * g + hl;
    bf16x8 dq[4];
#pragma unroll
    for (int s = 0; s < 4; ++s) dq[s] = *(const bf16x8*)(WSP(bf16, WS_DQ) + (size_t)row * 512 + hq * 64 + 16 * s + 8 * hi);
    const unsigned long long* selp = WSP(unsigned long long, WS_SELM) + (size_t)row * 64;
    unsigned long long selA = selp[0], selB = selp[nt > 1 ? 1 : 0];
    PIN4(dq); asm volatile("" : "+v"(selA), "+v"(selB));
    LAS unsigned char* const lb = F.lds;
    const int fo = l31 * TP + hi * 16;
    f32x16 sc0, sc1, sn0, sn1;
    u32x4 rkA, rvA, rkB, rvB;
    Soft S; soft_init(S);
    const int ntm = nt - 1;
    const bf16* kpc = dk + (size_t)(tid >> 3) * 64 + (tid & 7) * 8; const bf16* vpc = dvt + (size_t)(tid >> 3) * SEQ + (tid & 7) * 8;
#define KADDR(jt) (kpc + (size_t)((jt) < ntm ? (jt) : ntm) * 64 * 64)
#define VADDR(jt) (vpc + ((jt) < ntm ? (jt) : ntm) * 64)
    { const u32x4 a = tile_ld(dk, 64, tid), b = tile_ld(dvt, SEQ, tid), c = *(const u32x4*)KADDR(1); tile_st(lb, a, tid); tile_st(lb + 2 * TILE_B, b, tid); tile_st(lb + TILE_B, c, tid); }
    asm volatile("s_waitcnt vmcnt(0)" : "+v"(selA), "+v"(selB) :: "memory");
    selA = gload8(selp); selB = gload8(selp + (nt > 1 ? 1 : 0));
    rkA = gload16(KADDR(2)); rvA = gload16(VADDR(1));
    LDS_BARRIER();
    { LdsT kt{lb + fo}; qk_tile_c(sc0, sc1, kt, dq, S.negm); }
#define DSA_STEP(j, CK, CV, NK, NV, SELC) do { \
        NK = gload16(KADDR((j) + 3)); NV = gload16(VADDR((j) + 2)); \
        if ((j) + 1 < nt) { LdsT kt{lb + (((j) + 1) & 1) * TILE_B + fo}; if (!(ABL & 2)) qk_tile_c(sn0, sn1, kt, dq, S.negm); else { sn0 = S.negm; sn1 = S.negm; sn0[0] += __builtin_bit_cast(f32x4, kt.frag(0, 0))[0]; } } \
        WAITV1(5, SELC);                                                     \
        { const unsigned wa = (unsigned)SELC >> (4 * hi), wb = (unsigned)(SELC >> 32) >> (4 * hi); \
          SELC = gload8(selp + ((j) + 2 < nt ? (j) + 2 : ntm)); \
          _Pragma("unroll") for (int r = 0; r < 16; ++r) { const int bp = (r & 3) + 8 * (r >> 2); \
            sc0[r] = mask_sel(sc0[r], (int)(wa << (31 - bp)) >> 31); sc1[r] = mask_sel(sc1[r], (int)(wb << (31 - bp)) >> 31); } } \
        { LdsT vt{lb + (2 + ((j) & 1)) * TILE_B + fo}; soft_step2<ABL>(S, sc0, sc1, sn0, sn1, vt); } \
        sc0 = sn0; sc1 = sn1; \
        WAITV2(3, CK, CV);                                                   \
        if (!(ABL & 8)) { tile_st(lb + ((j) & 1) * TILE_B, CK, tid); tile_st(lb + (2 + (((j) + 1) & 1)) * TILE_B, CV, tid); } \
        if (!(ABL & 16)) LDS_BARRIER(); } while (0)
    for (int j = 0; j < nt; j += 2) { DSA_STEP(j, rkA, rvA, rkB, rvB, selA); if (j + 1 < nt) DSA_STEP(j + 1, rkB, rvB, rkA, rvA, selB); }
    asm volatile("s_waitcnt vmcnt(0)" : "+v"(rkA), "+v"(rvA), "+v"(rkB), "+v"(rvB), "+v"(selA), "+v"(selB) :: "memory");
#undef DSA_STEP
#undef KADDR
#undef VADDR
    S.l += half_other(S.l);
    {
        const float sc = 1.f / fmaxf(S.l, 1e-30f);
        const bf16* zp = WSP(bf16, WS_ZD) + (size_t)row * 512 + hq * 64 + 4 * hi;
        bf16* op = WSP(bf16, ABL ? WS_T1 : WS_ODZ) + (size_t)row * 512 + hq * 64 + 4 * hi;
#pragma unroll
        for (int e = 0; e < 2; ++e)
#pragma unroll
            for (int q = 0; q < 4; ++q) { const f32x16& o = e ? S.o1 : S.o0; const u32x2 z = *(const u32x2*)(zp + 32 * e + 8 * q);
                u32x2 wv; wv.x = pk2(o[4 * q] * sc * bflo(z.x), o[4 * q + 1] * sc * bfhi(z.x)); wv.y = pk2(o[4 * q + 2] * sc * bflo(z.y), o[4 * q + 3] * sc * bfhi(z.y));
                *(u32x2*)(op + 32 * e + 8 * q) = wv; }
    }
}


struct PageK {
    static constexpr bool HOIST = false;
    const float* p; unsigned stride;
    DI bf16x8 frag(int mt, int s) const { const f32x4* q = (const f32x4*)(p + (size_t)((unsigned)mt * 32u * stride + (unsigned)s * 16u)); return cvt8(q[0], q[1]); }
};
struct PageV {
    static constexpr bool HOIST = false;
    const float* p; unsigned stride;
    DI bf16x8 frag(int dt, int s) const {
        float v[8];
#pragma unroll
        for (int i = 0; i < 8; ++i) v[i] = p[(size_t)((unsigned)(16 * s + (i & 3) + 8 * (i >> 2)) * stride + (unsigned)dt * 32u)];
        return __builtin_bit_cast(bf16x8, pack8(v));
    }
};
constexpr int XCH_W = 34 * 64;
constexpr int XCH_BYTES = 8 * XCH_W * 4;
DI void xch_put(LAS float* x, const Soft& S, int lane) {
    const float lt = S.l + half_other(S.l);
    x[lane] = S.seen ? S.m : NEGINF; x[64 + lane] = lt;
#pragma unroll
    for (int r = 0; r < 16; ++r) { x[(2 + r) * 64 + lane] = S.o0[r]; x[(18 + r) * 64 + lane] = S.o1[r]; }
}
DI void xch_get(const LAS float* xb, int w, int lane, float (&out)[4]) {
    float mw[8], M = -1e30f;
#pragma unroll
    for (int i = 0; i < 8; ++i) { mw[i] = xb[i * XCH_W + lane]; M = fmaxf(M, mw[i]); }
    float L = 0.f, o[4] = {0.f, 0.f, 0.f, 0.f};
#pragma unroll
    for (int i = 0; i < 8; ++i) { const float wt = __builtin_amdgcn_exp2f(mw[i] - M); L += wt * xb[i * XCH_W + 64 + lane];
#pragma unroll
        for (int k = 0; k < 4; ++k) o[k] += wt * xb[i * XCH_W + (2 + 4 * w + k) * 64 + lane]; }
    const float inv = 1.f / fmaxf(L, 1e-30f);
#pragma unroll
    for (int k = 0; k < 4; ++k) out[k] = o[k] * inv;
}
DI void nsa_sample_unit(Frame& F, int bg) {
    const int lane = F.lane, w = F.wave, l31 = lane & 31, hi = lane >> 5, tl = l31 >> 2, hl = l31 & 3;
    const int sb = bg >> 1, g = bg & 1, i = tl & 3, row = MP + sb * 4 + i, qpos = PASTL + i, hq = 4 * g + hl;
    LAS unsigned char* const lb = F.lds;
    LAS float* xch = (LAS float*)lb;
    LAS float* cmpb = (LAS float*)(lb + XCH_BYTES);
    LAS unsigned* mskb = (LAS unsigned*)(lb + XCH_BYTES + 8192);
    LAS float* psum = (LAS float*)(lb + XCH_BYTES + 8192 + 64);
    LAS float* impb = psum + 8 * 256;
    LAS unsigned char* selb = (LAS unsigned char*)(impb + 8 * 64);
    const float* gp = WSP(float, WS_GATES) + (size_t)row * 24 + hq * 3;
    float g0 = gp[0], g1 = gp[1], g2 = gp[2];
    bf16x8 qrot[4];
#pragma unroll
    for (int s = 0; s < 4; ++s) qrot[s] = *(const bf16x8*)(WSP(bf16, WS_QROT) + (size_t)row * 512 + hq * 64 + 16 * s + 8 * hi);
    f32x16 s0, s1;
    Soft S;
    __syncthreads();
    if (w == 0) {
        const bf16* ck = WSP(bf16, WS_SCK) + (size_t)bg * 128 * 64; const bf16* cvt = WSP(bf16, WS_SCVT) + (size_t)bg * 64 * 128;
        bf16x8 qraw[4];
#pragma unroll
        for (int s = 0; s < 4; ++s) qraw[s] = *(const bf16x8*)(WSP(bf16, WS_QRAW) + (size_t)row * 512 + hq * 64 + 16 * s + 8 * hi);
        const int ncmp = 127, nvis = 126;
        float m = -1e30f, l = 0.f;
        for (int ct = 0; ct < 2; ++ct) {
            GlbT kt{ck, (unsigned)((64 * ct + l31) * 64 + 8 * hi), 64u}; qk_tile(s0, s1, kt, qraw);
            float mx = -1e30f; const int nv2 = nvis - 64 * ct - 4 * hi;
#pragma unroll
            for (int r = 0; r < 16; ++r) { const int cr = (r & 3) + 8 * (r >> 2); s0[r] = cr <= nv2 ? s0[r] : NEGINF; s1[r] = cr + 32 <= nv2 ? s1[r] : NEGINF; mx = fmaxf(mx, fmaxf(s0[r], s1[r])); }
            mx = fmaxf(mx, half_other(mx));
            const float mn = fmaxf(m, mx); float ps = 0.f;
#pragma unroll
            for (int r = 0; r < 16; ++r) ps += __builtin_amdgcn_exp2f(s0[r] - mn) + __builtin_amdgcn_exp2f(s1[r] - mn);
            l = l * __builtin_amdgcn_exp2f(m - mn) + ps; m = mn;
        }
        l += half_other(l);
        const float linv = l > 0.f ? 1.f / l : 0.f;
        soft_init(S);
        for (int ct = 0; ct < 2; ++ct) {
            GlbT kt{ck, (unsigned)((64 * ct + l31) * 64 + 8 * hi), 64u}; qk_tile(s0, s1, kt, qraw);
            const int nv2 = nvis - 64 * ct - 4 * hi; LAS float* pw = psum + tl * 256 + 64 * ct + 4 * hi;
#pragma unroll
            for (int r = 0; r < 16; ++r) { const int cr = (r & 3) + 8 * (r >> 2);
                s0[r] = cr <= nv2 ? __builtin_amdgcn_exp2f(s0[r] - m) * linv : 0.f; s1[r] = cr + 32 <= nv2 ? __builtin_amdgcn_exp2f(s1[r] - m) * linv : 0.f;
                float a = s0[r]; a += dpp_x1(a); a += dpp_x2(a); float b = s1[r]; b += dpp_x1(b); b += dpp_x2(b);
                if (hl == 0) { pw[cr] = a; pw[cr + 32] = b; } }
            GlbT vt{cvt, (unsigned)(l31 * 128 + 64 * ct + 8 * hi), 128u}; pv_tile(S.o0, S.o1, s0, s1, vt);
        }
#pragma unroll
        for (int r = 0; r < 16; ++r) { cmpb[r * 64 + lane] = S.o0[r]; cmpb[(16 + r) * 64 + lane] = S.o1[r]; }
        LDS_WAIT();
        {
            const int tk = lane >> 3, jb = 8 * (lane & 7), cur = 32;
            float pv[33];
            const LAS f32x4* pp = (const LAS f32x4*)(psum + tk * 256 + 4 * jb);
#pragma unroll
            for (int q = 0; q < 8; ++q) { const f32x4 x = pp[q]; pv[1 + 4 * q] = x[0]; pv[2 + 4 * q] = x[1]; pv[3 + 4 * q] = x[2]; pv[4 + 4 * q] = x[3]; }
            pv[0] = jb > 0 ? psum[tk * 256 + 4 * jb - 1] : 0.f;
            float v[8];
#pragma unroll
            for (int jj = 0; jj < 8; ++jj) { const int j = jb + jj;
                float a = pv[4 * jj] + pv[4 * jj + 1] + pv[4 * jj + 2] + pv[4 * jj + 3];
                a += (4 * j + 3 < ncmp) ? pv[4 * jj + 4] : 0.f;
                a = ((j == 0) | (j == cur) | (j == cur - 1)) ? 1e4f : a;
                a = (j > cur) ? -1e30f : a;
                v[jj] = a; }
            LAS f32x4* ip = (LAS f32x4*)(impb + tk * 64 + jb);
            ip[0] = (f32x4){v[0], v[1], v[2], v[3]}; ip[1] = (f32x4){v[4], v[5], v[6], v[7]};
            LDS_WAIT();
            int cnt[8];
#pragma unroll
            for (int jj = 0; jj < 8; ++jj) cnt[jj] = 0;
            const LAS f32x4* ap = (const LAS f32x4*)(impb + tk * 64);
#pragma unroll 1
            for (int i4 = 0; i4 < 16; ++i4) { const f32x4 x = ap[i4];
#pragma unroll
                for (int e = 0; e < 4; ++e) { const int ii = 4 * i4 + e; const float xi = x[e];
#pragma unroll
                    for (int jj = 0; jj < 8; ++jj) cnt[jj] += ((xi > v[jj]) | ((xi == v[jj]) & (ii < jb + jj))) ? 1 : 0; } }
            unsigned bits = 0;
#pragma unroll
            for (int jj = 0; jj < 8; ++jj) bits |= ((cnt[jj] < 16) & (jb + jj <= cur)) ? (1u << jj) : 0u;
            selb[tk * 8 + (lane & 7)] = (unsigned char)bits;
            LDS_WAIT();
            if (lane < 16) mskb[lane] = ((const LAS unsigned*)selb)[lane];
        }
    }
    __syncthreads();
    const unsigned mlo = mskb[tl * 2], mhi = mskb[tl * 2 + 1];
    PIN4(qrot); asm volatile("" : "+v"(g0), "+v"(g1), "+v"(g2));
    soft_init(S);
    for (int j = w; j < 32; j += NWAVES) {
        const int pg = F.ptab[sb * NPG + (j >> 1)];
        const float* base = F.cnsa + ((size_t)pg * PAGE + (j & 1) * 64) * 512 + (2 * 2 + g) * 64;
        PageK kt{base + (size_t)l31 * 512 + 8 * hi, 512u}; qk_tile_c(s0, s1, kt, qrot, S.negm);
        const bool bsel = ((mlo >> j) & 1u) != 0u;
#pragma unroll
        for (int r = 0; r < 16; ++r) { s0[r] = bsel ? s0[r] : NEGINF; s1[r] = bsel ? s1[r] : NEGINF; }
        PageV vt{base + 128 + (size_t)(4 * hi) * 512 + l31, 512u}; soft_step(S, s0, s1, vt);
    }
    if (w == 0) {
        const bf16* sk = WSP(bf16, WS_SSLCK) + (size_t)bg * LS * 64; const bf16* svt = WSP(bf16, WS_SSLCVT) + (size_t)bg * 64 * LS;
        GlbT kt{sk, (unsigned)((2048 + l31) * 64 + 8 * hi), 64u}; qk_tile_c(s0, s1, kt, qrot, S.negm);
        const int qrel = i - 4 * hi;
#pragma unroll
        for (int r = 0; r < 16; ++r) { const int cr = (r & 3) + 8 * (r >> 2); s0[r] = cr <= qrel ? s0[r] : NEGINF; s1[r] = cr + 32 <= qrel ? s1[r] : NEGINF; }
        GlbT vt{svt, (unsigned)(l31 * LS + 2048 + 8 * hi), (unsigned)LS}; soft_step(S, s0, s1, vt);
    }
    xch_put(xch + w * XCH_W, S, lane);
    __syncthreads();
    float acc[4], part[4];
    xch_get(xch, w, lane, part);
#pragma unroll
    for (int k = 0; k < 4; ++k) acc[k] = g1 * part[k] + g0 * cmpb[(4 * w + k) * 64 + lane];
    __syncthreads();
    soft_init(S);
    {
        const float* base = F.swin + ((size_t)sb * 512 + 64 * w) * 256 + g * 64;
        PageK kt{base + (size_t)l31 * 256 + 8 * hi, 256u}; qk_tile_c(s0, s1, kt, qrot, S.negm);
        if (w == 0) {
            const int lo_r = 1 + i - 4 * hi;
#pragma unroll
            for (int r = 0; r < 16; ++r) { const int k0 = (r & 3) + 8 * (r >> 2); s0[r] = k0 >= lo_r ? s0[r] : NEGINF; s1[r] = k0 + 32 >= lo_r ? s1[r] : NEGINF; }
        }
        PageV vt{base + 128 + (size_t)(4 * hi) * 256 + l31, 256u}; soft_step(S, s0, s1, vt);
    }
    if (w == 0) {
        const bf16* wk = WSP(bf16, WS_SWINK) + (size_t)bg * LSW * 64; const bf16* wvt = WSP(bf16, WS_SWINVT) + (size_t)bg * 64 * LSW;
        GlbT kt{wk, (unsigned)((512 + l31) * 64 + 8 * hi), 64u}; qk_tile_c(s0, s1, kt, qrot, S.negm);
        const int hi_r = i - 4 * hi;
#pragma unroll
        for (int r = 0; r < 16; ++r) { const int k0 = (r & 3) + 8 * (r >> 2); s0[r] = k0 <= hi_r ? s0[r] : NEGINF; s1[r] = k0 + 32 <= hi_r ? s1[r] : NEGINF; }
        GlbT vt{wvt, (unsigned)(l31 * LSW + 512 + 8 * hi), (unsigned)LSW}; soft_step(S, s0, s1, vt);
    }
    xch_put(xch + w * XCH_W, S, lane);
    __syncthreads();
    xch_get(xch, w, lane, part);
#ifdef BREAK_WIN
#pragma unroll
    for (int k = 0; k < 4; ++k) part[k] *= 0.9f;
#endif
    if (tl < 4) {
        const int d0 = 32 * (w >> 2) + 8 * (w & 3) + 4 * hi;
        const u32x2 z = *(const u32x2*)(WSP(bf16, WS_ZN) + (size_t)row * 512 + hq * 64 + d0);
        u32x2 wv; wv.x = pk2((acc[0] + g2 * part[0]) * bflo(z.x), (acc[1] + g2 * part[1]) * bfhi(z.x)); wv.y = pk2((acc[2] + g2 * part[2]) * bflo(z.y), (acc[3] + g2 * part[3]) * bfhi(z.y));
        *(u32x2*)(WSP(bf16, WS_ONZ) + (size_t)row * 512 + hq * 64 + d0) = wv;
    }
}
DI void dsa_sample_unit(Frame& F, int bg) {
    const int lane = F.lane, w = F.wave, l31 = lane & 31, hi = lane >> 5, tl = l31 >> 2, hl = l31 & 3;
    const int sb = bg >> 1, g = bg & 1, i = tl & 3, row = MP + sb * 4 + i, hq = 4 * g + hl;
    LAS float* xch = (LAS float*)F.lds;
    bf16x8 dq[4];
#pragma unroll
    for (int s = 0; s < 4; ++s) dq[s] = *(const bf16x8*)(WSP(bf16, WS_DQ) + (size_t)row * 512 + hq * 64 + 16 * s + 8 * hi);
    const unsigned long long* selp = WSP(unsigned long long, WS_SELM) + (size_t)row * 64;
    PIN4(dq);
    f32x16 s0, s1;
    Soft S; soft_init(S);
    for (int j = w; j < 32; j += NWAVES) {
        unsigned long long selw = selp[j];
        const int pg = F.ptab[sb * NPG + (j >> 1)];
        const float* base = F.cdsa + ((size_t)pg * PAGE + (j & 1) * 64) * 256 + g * 64;
        PageK kt{base + (size_t)l31 * 256 + 8 * hi, 256u}; qk_tile_c(s0, s1, kt, dq, S.negm);
#ifdef BREAK_DSA
        selw |= 0x1111111111111111ull;
#endif
        const unsigned wa = (unsigned)selw >> (4 * hi), wb = (unsigned)(selw >> 32) >> (4 * hi);
#pragma unroll
        for (int r = 0; r < 16; ++r) { const int bp = (r & 3) + 8 * (r >> 2);
            s0[r] = mask_sel(s0[r], (int)(wa << (31 - bp)) >> 31); s1[r] = mask_sel(s1[r], (int)(wb << (31 - bp)) >> 31); }
        PageV vt{base + 128 + (size_t)(4 * hi) * 256 + l31, 256u}; soft_step(S, s0, s1, vt);
    }
    if (w == 0) {
        const unsigned long long selw = selp[32];
        const bf16* dk = WSP(bf16, WS_SDSAK) + (size_t)bg * LS * 64; const bf16* dvt = WSP(bf16, WS_SDSAVT) + (size_t)bg * 64 * LS;
        GlbT kt{dk, (unsigned)((2048 + l31) * 64 + 8 * hi), 64u}; qk_tile_c(s0, s1, kt, dq, S.negm);
        const unsigned wa = (unsigned)selw >> (4 * hi), wb = (unsigned)(selw >> 32) >> (4 * hi);
#pragma unroll
        for (int r = 0; r < 16; ++r) { const int bp = (r & 3) + 8 * (r >> 2);
            s0[r] = mask_sel(s0[r], (int)(wa << (31 - bp)) >> 31); s1[r] = mask_sel(s1[r], (int)(wb << (31 - bp)) >> 31); }
        GlbT vt{dvt, (unsigned)(l31 * LS + 2048 + 8 * hi), (unsigned)LS}; soft_step(S, s0, s1, vt);
    }
    __syncthreads();
    xch_put(xch + w * XCH_W, S, lane);
    __syncthreads();
    float part[4];
    xch_get(xch, w, lane, part);
    if (tl < 4) {
        const int d0 = 32 * (w >> 2) + 8 * (w & 3) + 4 * hi;
        const u32x2 z = *(const u32x2*)(WSP(bf16, WS_ZD) + (size_t)row * 512 + hq * 64 + d0);
        u32x2 wv; wv.x = pk2(part[0] * bflo(z.x), part[1] * bfhi(z.x)); wv.y = pk2(part[2] * bflo(z.y), part[3] * bfhi(z.y));
        *(u32x2*)(WSP(bf16, WS_ODZ) + (size_t)row * 512 + hq * 64 + d0) = wv;
    }
}

template <class EF> DI void small_gemm(Frame& F, const bf16* A, const bf16* Bt, int K, const EF& ef) {
    const int lane = F.lane, w = F.wave, l31 = lane & 31, hi = lane >> 5;
    LAS float* red = (LAS float*)F.lds;
    for (int t = blockIdx.x; t < 256; t += F.G) {
        const int mt = t >> 5, nt = t & 31, kw = K >> 3, k0 = w * kw;
        const bf16* ap = A + (size_t)(MP + 64 * mt + l31) * K + k0 + 8 * hi;
        const bf16* bp = Bt + (size_t)(32 * nt + l31) * K + k0 + 8 * hi;
        f32x16 a0, a1;
#pragma unroll
        for (int i = 0; i < 16; ++i) { a0[i] = 0.f; a1[i] = 0.f; }
        for (int s = 0; s < kw; s += 16) {
            const bf16x8 b = *(const bf16x8*)(bp + s), x0 = *(const bf16x8*)(ap + s), x1 = *(const bf16x8*)(ap + (size_t)32 * K + s);
            a0 = MFMA32(x0, b, a0); a1 = MFMA32(x1, b, a1);
        }
        __syncthreads();
#pragma unroll
        for (int r = 0; r < 16; ++r) { red[(w * 32 + r) * 64 + lane] = a0[r]; red[(w * 32 + 16 + r) * 64 + lane] = a1[r]; }
        __syncthreads();
        const int m2 = w >> 2, q = w & 3;
#pragma unroll
        for (int j = 0; j < 4; ++j) {
            float v = 0.f;
#pragma unroll
            for (int i = 0; i < 8; ++i) v += red[(i * 32 + 16 * m2 + 4 * q + j) * 64 + lane];
            ef(MP + 64 * mt + 32 * m2 + 8 * q + 4 * hi + j, 32 * nt + l31, v);
        }
    }
    __syncthreads();
}

#ifdef ORACLE
constexpr size_t WS_ORC = 948 * MiB;
constexpr int ORC_ROWS = 128;
DI float blk_red(Frame& F, float v, bool ismax, LAS float* red) {
#pragma unroll
    for (int o = 1; o < 64; o <<= 1) { const float x = __shfl_xor(v, o); v = ismax ? fmaxf(v, x) : v + x; }
    __syncthreads();
    if (F.lane == 0) red[F.wave] = v;
    __syncthreads();
    float r = red[0];
    for (int i = 1; i < 8; ++i) r = ismax ? fmaxf(r, red[i]) : r + red[i];
    return r;
}
DI float dot64(const bf16* a, const bf16* b) { float s = 0.f; for (int d = 0; d < 64; ++d) s += bf2f(a[d]) * bf2f(b[d]); return s; }
DI void orc_softmax(Frame& F, LAS float* sc, LAS unsigned char* vf, int n, LAS float* red) {
    float mx = -3e38f;
    for (int k = F.tid; k < n; k += 512) if (vf[k]) mx = fmaxf(mx, sc[k]);
    mx = blk_red(F, mx, true, red);
    float sm = 0.f;
    for (int k = F.tid; k < n; k += 512) { const float p = vf[k] ? exp2f(sc[k] - mx) : 0.f; sc[k] = p; sm += p; }
    sm = blk_red(F, sm, false, red);
    const float inv = 1.f / fmaxf(sm, 1e-30f);
    for (int k = F.tid; k < n; k += 512) sc[k] *= inv;
    __syncthreads();
}
DI void oracle_row(Frame& F, int oi) {
    int row;
    if (oi < 96) { const int tl[24] = {0, 1, 30, 31, 32, 63, 64, 65, 127, 128, 255, 256, 257, 400, 511, 512, 513, 1000, 1023, 1024, 2047, 2500, 3583, 4095};
        int t = 0;
#pragma unroll
        for (int i = 0; i < 24; ++i) t = (oi % 24 == i) ? tl[i] : t;
        row = (oi / 24) * SEQ + t; }
    else { const int k = oi - 96; row = MP + (((k >> 2) * 37) % SBATCH) * 4 + (k & 3); }
    const bool samp = row >= MP;
    const int b = samp ? (row - MP) >> 2 : row >> 12, ti = samp ? (row & 3) : (row & 4095), qpos = samp ? PASTL + ti : ti;
    const int ncmp = samp ? 127 : 255; const size_t pitch = samp ? LS : SEQ, wpitch = samp ? LSW : SEQ, cpitch = samp ? 128 : 256;
    const int wlo = samp ? 1 + ti : (qpos - 511 > 0 ? qpos - 511 : 0), whi = samp ? 512 + ti : qpos;
    LAS float* sc = (LAS float*)F.lds;
    LAS float* s2 = sc + 4096;
    LAS float* psum = s2 + 4096;
    LAS float* imp = psum + 256;
    LAS float* resn = imp + 64;
    LAS float* resd = resn + 512;
    LAS float* red = resd + 512;
    LAS unsigned char* vf = (LAS unsigned char*)(red + 8);
    LAS unsigned char* selb = vf + 4096;
    const bf16* qraw = WSP(bf16, WS_QRAW) + (size_t)row * 512; const bf16* qrot = WSP(bf16, WS_QROT) + (size_t)row * 512;
    const bf16* dq = WSP(bf16, WS_DQ) + (size_t)row * 512; const bf16* iq = WSP(bf16, WS_IQ) + (size_t)row * 256;
    const float* gat = WSP(float, WS_GATES) + (size_t)row * 24; const float* iw = WSP(float, WS_IW) + (size_t)row * 4;
    const int nvr = (qpos - 31) >> 4, nvis = nvr < ncmp - 1 ? nvr : ncmp - 1, cur = qpos >> 6;
    for (int g = 0; g < 2; ++g) {
        const int bg = b * 2 + g;
        const bf16* ck = samp ? WSP(bf16, WS_SCK) + (size_t)bg * 128 * 64 : WSP(bf16, WS_PCK) + (size_t)bg * 256 * 64;
        const bf16* cvt = samp ? WSP(bf16, WS_SCVT) + (size_t)bg * 64 * 128 : WSP(bf16, WS_PCVT) + (size_t)bg * 64 * 256;
        const bf16* sk = samp ? WSP(bf16, WS_SSLCK) + (size_t)bg * LS * 64 : WSP(bf16, WS_PSLCK) + (size_t)bg * SEQ * 64;
        const bf16* svt = samp ? WSP(bf16, WS_SSLCVT) + (size_t)bg * 64 * LS : WSP(bf16, WS_PSLCVT) + (size_t)bg * 64 * SEQ;
        const bf16* wk = samp ? WSP(bf16, WS_SWINK) + (size_t)bg * LSW * 64 : WSP(bf16, WS_PWINK) + (size_t)bg * SEQ * 64;
        const bf16* wvt = samp ? WSP(bf16, WS_SWINVT) + (size_t)bg * 64 * LSW : WSP(bf16, WS_PWINVT) + (size_t)bg * 64 * SEQ;
        __syncthreads();
        if (F.tid < 256) psum[F.tid] = 0.f;
        for (int hl = 0; hl < 4; ++hl) {
            const int h = 4 * g + hl;
            __syncthreads();
            for (int n = F.tid; n < 256; n += 512) { const bool v = n <= nvis; vf[n] = v; sc[n] = v ? dot64(qraw + h * 64, ck + (size_t)n * 64) : 0.f; }
            __syncthreads();
            orc_softmax(F, sc, vf, 256, red);
            if (F.tid < 256) psum[F.tid] += sc[F.tid];
            if (F.tid < 64) { float a = 0.f; for (int n = 0; n <= nvis; ++n) a += sc[n] * bf2f(cvt[(size_t)F.tid * cpitch + permk(n)]); resn[h * 64 + F.tid] = gat[h * 3 + 0] * a; }
        }
        __syncthreads();
        if (F.tid < 64) { const int j = F.tid; float a = 0.f;
            for (int n = 4 * j - 1; n <= 4 * j + 3; ++n) if (n >= 0 && n < ncmp) a += psum[n];
            if (j == 0 || j == cur || j == cur - 1) a = 1e4f;
            if (j > cur) a = -1e30f;
            imp[j] = a; selb[j] = 0; }
        __syncthreads();
        if (F.tid == 0) { for (int k = 0; k < 16; ++k) { int best = -1; float bv = -3e38f; for (int j = 0; j < 64; ++j) if (!selb[j] && imp[j] > bv) { bv = imp[j]; best = j; }
                if (best >= 0) selb[best] = (bv > -5e29f) ? 1 : 2; }
            for (int j = 0; j < 64; ++j) selb[j] = selb[j] == 1 ? 1 : 0; }
        __syncthreads();
        for (int hl = 0; hl < 4; ++hl) {
            const int h = 4 * g + hl;
            __syncthreads();
            for (int k = F.tid; k <= qpos; k += 512) { const bool v = selb[k >> 6] != 0; vf[k] = v; sc[k] = v ? dot64(qrot + h * 64, sk + (size_t)k * 64) : 0.f; }
            __syncthreads();
            orc_softmax(F, sc, vf, qpos + 1, red);
            if (F.tid < 64) { float a = 0.f; for (int k = 0; k <= qpos; ++k) if (vf[k]) a += sc[k] * bf2f(svt[(size_t)F.tid * pitch + permk(k)]); resn[h * 64 + F.tid] += gat[h * 3 + 1] * a; }
            __syncthreads();
            for (int k = wlo + F.tid; k <= whi; k += 512) { vf[k - wlo] = 1; sc[k - wlo] = dot64(qrot + h * 64, wk + (size_t)k * 64); }
            __syncthreads();
            orc_softmax(F, sc, vf, whi - wlo + 1, red);
            if (F.tid < 64) { float a = 0.f; for (int k = wlo; k <= whi; ++k) a += sc[k - wlo] * bf2f(wvt[(size_t)F.tid * wpitch + permk(k)]); resn[h * 64 + F.tid] += gat[h * 3 + 2] * a; }
        }
    }
    __syncthreads();
    const bf16* ik = samp ? WSP(bf16, WS_SIDXK) + (size_t)b * LS * 64 : WSP(bf16, WS_PIDXK) + (size_t)b * SEQ * 64;
    for (int k = F.tid; k <= qpos; k += 512) { float a = 0.f; for (int h = 0; h < 4; ++h) a += fmaxf(dot64(iq + h * 64, ik + (size_t)k * 64), 0.f) * iw[h]; s2[k] = a; }
    __syncthreads();
    for (int k = F.tid; k <= qpos; k += 512) { const float v = s2[k]; int c = 0; for (int j = 0; j <= qpos; ++j) { const float x = s2[j]; c += (x > v || (x == v && j < k)) ? 1 : 0; } vf[k] = c < 256; }
    __syncthreads();
    for (int h = 0; h < 8; ++h) {
        const int bg = b * 2 + (h >> 2);
        const bf16* dk = samp ? WSP(bf16, WS_SDSAK) + (size_t)bg * LS * 64 : WSP(bf16, WS_PDSAK) + (size_t)bg * SEQ * 64;
        const bf16* dvt = samp ? WSP(bf16, WS_SDSAVT) + (size_t)bg * 64 * LS : WSP(bf16, WS_PDSAVT) + (size_t)bg * 64 * SEQ;
        __syncthreads();
        for (int k = F.tid; k <= qpos; k += 512) sc[k] = vf[k] ? dot64(dq + h * 64, dk + (size_t)k * 64) : 0.f;
        __syncthreads();
        orc_softmax(F, sc, vf, qpos + 1, red);
        if (F.tid < 64) { float a = 0.f; for (int k = 0; k <= qpos; ++k) if (vf[k]) a += sc[k] * bf2f(dvt[(size_t)F.tid * pitch + permk(k)]); resd[h * 64 + F.tid] = a; }
    }
    __syncthreads();
    float dn = 0.f, rn = 0.f, dd = 0.f, rd = 0.f;
    { const int e = F.tid;
      const float zn = bf2f(WSP(bf16, WS_ZN)[(size_t)row * 512 + e]), zd = bf2f(WSP(bf16, WS_ZD)[(size_t)row * 512 + e]);
      const float refn = resn[e] * zn, refd = resd[e] * zd;
      const float gotn = bf2f(WSP(bf16, WS_ONZ)[(size_t)row * 512 + e]), gotd = bf2f(WSP(bf16, WS_ODZ)[(size_t)row * 512 + e]);
      dn = (gotn - refn) * (gotn - refn); rn = refn * refn; dd = (gotd - refd) * (gotd - refd); rd = refd * refd; }
    dn = blk_red(F, dn, false, red); rn = blk_red(F, rn, false, red); dd = blk_red(F, dd, false, red); rd = blk_red(F, rd, false, red);
    float dc = 0.f, rc = 0.f;
    {
        const bool cs = oi >= 96; const int cbg = cs ? (oi * 5) % 256 : oi % 8, cn = cs ? (oi * 11) % 127 : (oi * 13) % 255;
        for (int slot = 0; slot < 2; ++slot) {
            const bf16* data = cs ? WSP(bf16, slot ? WS_SCMPV : WS_SCMPK) + (size_t)cbg * LS * 64 + (size_t)cn * 1024 : WSP(bf16, slot ? WS_PCMPV : WS_PCMPK) + (size_t)cbg * SEQ * 64 + (size_t)cn * 1024;
            __syncthreads();
            if (F.tid < 128) { float a = 0.f; for (int k = 0; k < 2048; ++k) a += (bf2f(data[k]) + F.pe[slot * 2048 + k]) * F.w1[((size_t)slot * 2048 + k) * 128 + F.tid]; sc[F.tid] = a / (1.f + expf(-a)); }
            __syncthreads();
            if (F.tid < 64) { float a = 0.f; for (int c = 0; c < 128; ++c) a += sc[c] * F.w2[((size_t)slot * 128 + c) * 64 + F.tid];
                float got;
                if (slot == 0) got = bf2f((cs ? WSP(bf16, WS_SCK) + (size_t)cbg * 128 * 64 : WSP(bf16, WS_PCK) + (size_t)cbg * 256 * 64)[(size_t)cn * 64 + F.tid]);
                else got = bf2f((cs ? WSP(bf16, WS_SCVT) + (size_t)cbg * 64 * 128 : WSP(bf16, WS_PCVT) + (size_t)cbg * 64 * 256)[(size_t)F.tid * (cs ? 128 : 256) + permk(cn)]);
                dc += (got - a) * (got - a); rc += a * a; }
        }
    }
    dc = blk_red(F, dc, false, red); rc = blk_red(F, rc, false, red);
    if (F.tid == 0) { float* o = WSP(float, WS_ORC) + oi * 8; o[0] = dn; o[1] = rn; o[2] = dd; o[3] = rd; o[4] = dc; o[5] = rc; }
    __syncthreads();
}
DI float oracle_value(Frame& F) {
    const float* o = WSP(float, WS_ORC);
    float bad = 0.f, acc = 0.f, mxe = 0.f;
    for (int i = 0; i < ORC_ROWS; ++i) { const int c = (ORACLE_MODE >= 6) ? 4 : (ORACLE_MODE & 1) ? 2 : 0; const float e = sqrtf(o[i * 8 + c] / fmaxf(o[i * 8 + c + 1], 1e-30f));
        bad += e > 0.03f ? 1.f : 0.f; acc += fminf(e, 1.f) * fminf(e, 1.f); mxe = fmaxf(mxe, fminf(e, 1.f)); }
    return (ORACLE_MODE < 2 || ORACLE_MODE == 6) ? bad / ORC_ROWS : (ORACLE_MODE < 4 || ORACLE_MODE == 7) ? sqrtf(acc / ORC_ROWS) : mxe;
}
#endif

#define XB_TMO      128
#define XB_XCNT(j)  (256  + 64 * (j))
#define XB_XSUB(j)  (1280 + 64 * (j))
#define XB_XGEN(j)  (2304 + 64 * (j))
#define XB_TOP      3328
#define XB_TOPGEN   3392
#define XCD_BAR_WORDS 3456
#define XB_SPIN_CAP (1u << 18)
__device__ __forceinline__ unsigned xb_ld(unsigned* p)              { return __hip_atomic_load(p, __ATOMIC_RELAXED, __HIP_MEMORY_SCOPE_AGENT); }
__device__ __forceinline__ unsigned xb_add(unsigned* p, unsigned v) { return __hip_atomic_fetch_add(p, v, __ATOMIC_RELAXED, __HIP_MEMORY_SCOPE_AGENT); }
__device__ __forceinline__ unsigned xb_xcc_id() { return (unsigned)__builtin_amdgcn_s_getreg((3 << 11) | 20) & 0xFu; }
#define XB_SPIN(cond, bar) do { unsigned _sp = 0; while (cond) { __builtin_amdgcn_s_sleep(1); \
    if ((++_sp & 255u) == 0u) { if (xb_ld(&(bar)[XB_TMO])) break; if (_sp > XB_SPIN_CAP) { atomicAdd(&(bar)[XB_TMO], 1u); break; } } } } while (0)
struct XcdBarrier { unsigned* bar; unsigned x; volatile LAS unsigned* st; };
__device__ __forceinline__ XcdBarrier xcd_barrier_post(unsigned* bar, volatile LAS unsigned* st) {
    XcdBarrier b; b.bar = bar; b.x = xb_xcc_id(); b.st = st;
    if (threadIdx.x == 0) (void)xb_add(&bar[XB_XCNT(b.x)], 1u);
    return b;
}
__device__ __forceinline__ void xcd_barrier_complete(unsigned* bar, unsigned x, unsigned& nloc, unsigned& nx) {
    const unsigned G = gridDim.x * gridDim.y * gridDim.z;
    unsigned sum, cnt, mine, sp = 0u;
    for (;;) {
        sum = 0u; cnt = 0u; mine = 0u;
#pragma unroll
        for (unsigned j = 0; j < 16; ++j) { const unsigned c = xb_ld(&bar[XB_XCNT(j)]); sum += c; cnt += (c > 0u) ? 1u : 0u; mine = (j == x) ? c : mine; }
        if (sum == G) break;
        __builtin_amdgcn_s_sleep(1);
        if ((++sp & 255u) == 0u) { if (xb_ld(&bar[XB_TMO])) break; if (sp > XB_SPIN_CAP) { atomicAdd(&bar[XB_TMO], 1u); break; } }
    }
    nloc = mine > 0u ? mine : 1u; nx = cnt > 0u ? cnt : 1u;
}
__device__ __forceinline__ void xcd_barrier(const XcdBarrier& b) {
    asm volatile("s_waitcnt vmcnt(0)" ::: "memory");
    __syncthreads();
    if (threadIdx.x == 0) {
        unsigned* bar = b.bar;
        __builtin_amdgcn_s_waitcnt(0);
        unsigned nloc = b.st[0], nx = b.st[1];
        if (nloc == 0u) { xcd_barrier_complete(bar, b.x, nloc, nx); b.st[0] = nloc; b.st[1] = nx; }
        const unsigned old = xb_add(&bar[XB_XSUB(b.x)], 1u);
        const unsigned gen = old / nloc;
        if (old + 1u == (gen + 1u) * nloc) {
            __builtin_amdgcn_fence(__ATOMIC_RELEASE, "agent");
            asm volatile("s_waitcnt vmcnt(0)" ::: "memory");
            const unsigned og = xb_add(&bar[XB_TOP], 1u);
            const unsigned tg = og / nx;
            if (og + 1u == (tg + 1u) * nx) xb_add(&bar[XB_TOPGEN], 1u);
            else XB_SPIN(xb_ld(&bar[XB_TOPGEN]) == tg, bar);
            __builtin_amdgcn_fence(__ATOMIC_ACQUIRE, "agent");
            xb_add(&bar[XB_XGEN(b.x)], 1u);
            asm volatile("s_waitcnt vmcnt(0)" ::: "memory");
        } else {
            XB_SPIN(xb_ld(&bar[XB_XGEN(b.x)]) == gen, bar);
            __builtin_amdgcn_fence(__ATOMIC_ACQUIRE, "agent");
            asm volatile("s_waitcnt vmcnt(0)" ::: "memory");
        }
    }
    __syncthreads();
}

constexpr int N_PHASES = 9;
DI int q_next(Frame& F, int qi) {
    __syncthreads();
    if (F.tid == 0) F.MISC[0] = __hip_atomic_fetch_add(F.ctl + CW_Q + 64 * qi, 1u, __ATOMIC_RELAXED, __HIP_MEMORY_SCOPE_AGENT);
    __syncthreads();
    return (int)F.MISC[0];
}
DI void q_issue(Frame& F, int qi, unsigned& pend) { if (F.tid == 0) pend = __hip_atomic_fetch_add(F.ctl + CW_Q + 64 * qi, 1u, __ATOMIC_RELAXED, __HIP_MEMORY_SCOPE_AGENT); }
DI int q_take(Frame& F, unsigned pend) { __syncthreads(); if (F.tid == 0) F.MISC[0] = pend; __syncthreads(); return (int)F.MISC[0]; }
#define QLOOP(qi, N, CALL) do { for (int u = q_next(F, (qi)); u < (N); u = q_next(F, (qi))) { CALL; } } while (0)
__global__ void __launch_bounds__(NWAVES * 64, 2) fwd(Args args) {
    extern __shared__ __attribute__((aligned(16))) unsigned char lds[];
    Frame F;
    F.lds = (LAS unsigned char*)lds; F.MISC = (volatile LAS unsigned*)(F.lds + MISC_OFF);
    F.tid = threadIdx.x; F.lane = F.tid & 63; F.wave = __builtin_amdgcn_readfirstlane(F.tid >> 6); F.G = gridDim.x;
    F.ws = args.ws; F.out = args.out; F.ctl = (unsigned*)(args.ws + WS_CTL);
    F.xp = (const float*)args.in[0]; F.xs = (const float*)args.in[1]; F.cnsa = (const float*)args.in[2]; F.cdsa = (const float*)args.in[3]; F.cidx = (const float*)args.in[4];
    F.swin = (const float*)args.in[5]; F.ptab = (const int*)args.in[6]; F.cp = (const float*)args.in[7]; F.cs = (const float*)args.in[8]; F.normg = (const float*)args.in[9];
    F.wada = (const float*)args.in[10]; F.bada = (const float*)args.in[11]; F.win = (const float*)args.in[12]; F.pe = (const float*)args.in[13]; F.w1 = (const float*)args.in[14];
    F.w2 = (const float*)args.in[15]; F.wupn = (const float*)args.in[16]; F.wupd = (const float*)args.in[17]; F.wout = (const float*)args.in[18]; F.fing = (const float*)args.in[19];
    for (int i = F.tid; i < (LDS_BYTES - MISC_OFF) / 4; i += NWAVES * 64) ((LAS unsigned*)(F.lds + MISC_OFF))[i] = 0u;
    __syncthreads();
    const int lo = args.ph_lo, hi = args.ph_hi;
    const bool one = (hi - lo) > 1;
    XcdBarrier bar; bar.bar = F.ctl + CW_BAR; bar.x = 0; bar.st = nullptr;
    if (one) bar = xcd_barrier_post(F.ctl + CW_BAR, F.MISC + 8);
#ifndef PH_MASK
#define PH_MASK 0x1ff
#endif
#define IN(k) (((PH_MASK >> (k)) & 1) && lo <= (k) && (k) < hi)
#define SEAM(k) do { if (IN(k) && IN((k) + 1)) xcd_barrier(bar); } while (0)

#ifndef PROBE_REP
#define PROBE_REP -1
#endif
#define REP(k, BODY) do { if (IN(k)) { BODY(0) if (PROBE_REP == (k)) { xcd_barrier(bar); BODY(8) } } } while (0)
#ifndef PROBE_P4MASK
#define PROBE_P4MASK 15
#endif
#ifndef PROBE_ABL
#define PROBE_ABL 0
#endif
#define B0(qo) { p0_prologue(F); }
#define B1(qo) { p1_adaln(F); }
#define B2(qo) { pg8::Gemm g{WSP(bf16, WS_H), WSP(bf16, WS_WINT), MR, NPAD, DM}; pg8::StaticOrder S; S.init(MR, NPAD, F.G, (int)blockIdx.x); \
        if (qo) { EpiInProjT<PROBE_P4MASK> E0{F.ws, F.out}; pg8::gemm_phase<EpiInProjT<PROBE_P4MASK>, pg8::StaticOrder, true, false>(F.lds, g, S, E0); } else { EpiInProj E{F.ws, F.out}; pg8::gemm_phase<EpiInProj, pg8::StaticOrder, true, true>(F.lds, g, S, E); } }
#define B3(qo) { constexpr int PM3_ = (qo) ? PROBE_P4MASK : 15; if (PM3_ & 1) QLOOP(0 + qo, 272, compress_unit(F, u)); \
        if (PM3_ & 2) QLOOP(1 + qo, 2048, (idx1_unit<false, (qo) ? PROBE_ABL : 0>(F, u))); \
        if (PM3_ & 4) QLOOP(2 + qo, SBATCH, (idx1_unit<true, 0>(F, u))); }
#ifndef P4_MASK
#define P4_MASK 15
#endif
#define B4(qo) { constexpr int PM_ = (qo) ? PROBE_P4MASK : P4_MASK; if (PM_ & 1) QLOOP(3 + qo, 256, nsa_sample_unit(F, u)); \
        if (PM_ & 2) QLOOP(4 + qo, 256, dsa_sample_unit(F, u)); \
        if (PM_ & 4) QLOOP(5 + qo, 512, nsa_unit<false>(F, u)); \
        if (PM_ & 8) QLOOP(6 + qo, 512, (dsa_unit<(qo) ? PROBE_ABL : 0>(F, u))); }
#define B5(qo) { small_gemm(F, WSP(bf16, WS_ONZ), WSP(bf16, WS_WUPN), 512, [&](int r, int c, float v) { WSP(float, WS_T1)[(size_t)r * 1024 + c] = v * bf2f(WSP(bf16, WS_MG)[(size_t)r * 2048 + c]); }); \
        pg8::Gemm g{WSP(bf16, WS_ONZ), WSP(bf16, WS_WUPN), MP, DM, 512}; pg8::StaticOrder S; S.init(MP, DM, F.G, (int)blockIdx.x); EpiUp1 E{F.ws}; \
        pg8::gemm_phase<EpiUp1, pg8::StaticOrder, true, true>(F.lds, g, S, E); }
#define B6(qo) { small_gemm(F, WSP(bf16, WS_ODZ), WSP(bf16, WS_WUPD), 512, [&](int r, int c, float v) { WSP(bf16, WS_M1)[(size_t)r * 1024 + c] = (bf16)(pk2(WSP(float, WS_T1)[(size_t)r * 1024 + c] + v * bf2f(WSP(bf16, WS_MG)[(size_t)r * 2048 + 1024 + c]), 0.f) & 0xffffu); }); \
        pg8::Gemm g{WSP(bf16, WS_ODZ), WSP(bf16, WS_WUPD), MP, DM, 512}; pg8::StaticOrder S; S.init(MP, DM, F.G, (int)blockIdx.x); EpiUp2 E{F.ws}; \
        pg8::gemm_phase<EpiUp2, pg8::StaticOrder, true, true>(F.lds, g, S, E); }
#define B7(qo) { small_gemm(F, WSP(bf16, WS_M1), WSP(bf16, WS_WOUT), 1024, [&](int r, int c, float v) { const int rs = r - MP; F.out[O_YS + (size_t)rs * 1024 + c] = F.xs[(size_t)rs * 1024 + c] + WSP(float, WS_MOD)[(size_t)(4 + (rs >> 2)) * 3072 + 2048 + c] * v; }); \
        pg8::Gemm g{WSP(bf16, WS_M1), WSP(bf16, WS_WOUT), MP, DM, DM}; pg8::StaticOrder S; S.init(MP, DM, F.G, (int)blockIdx.x); EpiOut E{F.ws, F.out, F.xp, F.xs}; \
        pg8::gemm_phase<EpiOut, pg8::StaticOrder, true, true>(F.lds, g, S, E); }
#define B8(qo) { p8_final(F); }
    REP(0, B0); SEAM(0);
    REP(1, B1); SEAM(1);
    REP(2, B2); SEAM(2);
    REP(3, B3); SEAM(3);
    REP(4, B4); SEAM(4);
#ifdef ORACLE
    if (IN(4)) { for (int oi = blockIdx.x; oi < ORC_ROWS; oi += F.G) oracle_row(F, oi); xcd_barrier(bar); }
#endif
    REP(5, B5);
    REP(6, B6); SEAM(6);
    REP(7, B7); SEAM(7);
    if (IN(8)) { p8_final(F); }
#ifdef ORACLE
    if (IN(8)) { xcd_barrier(bar); const float val = oracle_value(F); const float sc = 1.f + 0.02f * (1.f + val);
        for (size_t i = (size_t)blockIdx.x * 512 + F.tid; i < (size_t)MP * 1024; i += (size_t)F.G * 512) F.out[O_YP + i] *= sc; }
#endif
#undef IN
#undef SEAM
}

extern "C" void kernel_launch(void* const* d_in, const int* in_sizes, int n_in, void* d_out, int out_size, void* d_ws, size_t ws_size, hipStream_t stream) {
    static int grid = 0;
    if (grid == 0) {
        if (n_in != 20 || (size_t)out_size != O_END || ws_size < WS_END) { fprintf(stderr, "kernel_launch: unexpected shapes (n_in %d, out %d, ws %zu)\n", n_in, out_size, ws_size); grid = -1; return; }
        int dev = 0, cus = 0, per_cu = 0;
        if (hipGetDevice(&dev) != hipSuccess || hipDeviceGetAttribute(&cus, hipDeviceAttributeMultiprocessorCount, dev) != hipSuccess) { grid = -1; return; }
        if (hipFuncSetAttribute((const void*)fwd, hipFuncAttributeMaxDynamicSharedMemorySize, LDS_BYTES) != hipSuccess) { fprintf(stderr, "kernel_launch: hipFuncSetAttribute failed\n"); grid = -1; return; }
        if (hipOccupancyMaxActiveBlocksPerMultiprocessor(&per_cu, (const void*)fwd, NWAVES * 64, LDS_BYTES) != hipSuccess || per_cu < 1) { fprintf(stderr, "kernel_launch: occupancy query says %d blocks per CU\n", per_cu); }
        (void)hipGetLastError();
        grid = cus;
    }
    if (grid < 0) return;
    (void)hipMemsetAsync((char*)d_ws + WS_CTL, 0, CTL_ZERO_BYTES, stream);
    Args a{};
    for (int i = 0; i < 20; ++i) a.in[i] = d_in[i];
    a.out = (float*)d_out; a.ws = (unsigned char*)d_ws; a.rep_phase = PROBE_REP; a.rep_cnt = 2; a.rep_mask = PROBE_P4MASK; a.pad = 0;
#if MK_N_LAUNCHES == 1
    a.ph_lo = 0; a.ph_hi = N_PHASES;
    hipLaunchKernelGGL(fwd, dim3(grid), dim3(NWAVES * 64), LDS_BYTES, stream, a);
#else
    for (int p = 0; p < N_PHASES; ++p) { a.ph_lo = p; a.ph_hi = p + 1; hipLaunchKernelGGL(fwd, dim3(grid), dim3(NWAVES * 64), LDS_BYTES, stream, a); }
#endif
}
```

```cpp
#define MK_N_LAUNCHES 1
#include <hip/hip_runtime.h>
#include <cstdio>
#include <cstdint>
#ifndef MK_N_LAUNCHES
#define MK_N_LAUNCHES 1
#endif
namespace pg8 {
#define PG8_LAS __attribute__((address_space(3)))
typedef unsigned short bf16_t;
typedef short bf16x8 __attribute__((ext_vector_type(8)));
typedef float f32x4 __attribute__((ext_vector_type(4)));
typedef unsigned u32x4 __attribute__((ext_vector_type(4)));
constexpr int BM = 256, BK = 64, HALF = 128, HTB = HALF * BK * 2  , STAGE_BYTES = 8 * HTB, NXCD = 8, WGM = 8;

__host__ __device__ __forceinline__ int lds_byte(int r, int c) { const int st = (r >> 4) * 2 + (c >> 5), rr = r & 15, cc = c & 31, ob = rr * 64 + cc * 2; return st * 1024 + (ob ^ (((ob >> 9) & 1) << 5)); }
__host__ __device__ __forceinline__ void stage_rc(int b, int& R, int& C) { const int st = b / 1024, sb = b % 1024, swz = sb ^ (((sb >> 9) & 1) << 5); R = (st >> 1) * 16 + swz / 64; C = (st & 1) * 32 + (swz % 64) / 2; }
__host__ __device__ __forceinline__ int perm32(int rho) { const int n = rho >> 4, i = rho & 15; return 8 * (i >> 2) + 4 * n + (i & 3); }

struct Unit { int pm, pn; };
struct Gemm { const bf16_t* A; const bf16_t* Bt; int M, N, K; };

struct StaticOrder {
    int nM, nN, nwg, G, c;
    __host__ __device__ void init(int M, int N, int G_, int c_) { nM = M / BM; nN = N / BM; nwg = nM * nN; G = G_; c = c_; }
    __host__ __device__ bool next(int i, Unit& u) const {
        const long L = (long)i * G + c; if (L >= nwg) return false;
        int wgid = (int)L; { const int q = nwg / NXCD, r = nwg % NXCD, xcd = wgid % NXCD, off = wgid / NXCD; wgid = (xcd < r ? xcd * (q + 1) : r * (q + 1) + (xcd - r) * q) + off; }
        const int nig = WGM * nN, gid = wgid / nig, fm = gid * WGM, gsz = (nM - fm) < WGM ? (nM - fm) : WGM;
        u.pm = fm + ((wgid % nig) % gsz); u.pn = (wgid % nig) / gsz; return true;
    }
    __device__ __forceinline__ void a_ready(const Unit&) const {}
    __device__ __forceinline__ void done(const Unit&) const {}
};

typedef float f32x2p __attribute__((ext_vector_type(2))); typedef __bf16 bf16x2p __attribute__((ext_vector_type(2)));
__device__ __forceinline__ unsigned cvt_pk_bf16(float lo, float hi) { f32x2p v = {lo, hi}; bf16x2p b = __builtin_convertvector(v, bf16x2p); return __builtin_bit_cast(unsigned, b); }
template <class Epi, class Sched, bool ALIGN_EPI = false, bool SP2 = false>
__device__ __forceinline__ void gemm_phase(PG8_LAS unsigned char* lds, const Gemm g, const Sched& S, const Epi& E) {
    const int tid = threadIdx.x, wid = __builtin_amdgcn_readfirstlane(tid >> 6), lane = tid & 63, wr = wid >> 2, wc = wid & 3, fr = lane & 15, fq = lane >> 4;
    const int K = g.K, nt = K / BK;
    unsigned voffA[2], voffB[2];
#pragma unroll
    for (int i = 0; i < 2; ++i) { int R, C; stage_rc(tid * 16 + i * 8192, R, C); const int Rb = Epi::PERM ? ((R & ~31) + perm32(R & 31)) : R;
        voffA[i] = (unsigned)(R * K + C) * 2u; voffB[i] = (unsigned)(Rb * K + C) * 2u; }
    const size_t kstep = (size_t)(BK * 2);
    const size_t hstep = (size_t)HALF * K * 2;
    const size_t tstep = 2 * hstep;
    const unsigned ldsw = (unsigned)wid * 1024u;
    const int aoff = lds_byte(wr * 64 + fr, fq * 8), boff = lds_byte(wc * 32 + fr, fq * 8);
#define PG8_SA(b, h) (((b) * 2 + (h)) * HTB)
#define PG8_SB(b, h) ((4 + (b) * 2 + (h)) * HTB)
#define PG8_STAGE(bufoff, gbase, voff) do { _Pragma("unroll") for (int _i = 0; _i < 2; ++_i) \
        __builtin_amdgcn_global_load_lds((const unsigned*)((const char*)(gbase) + (voff)[_i]), (PG8_LAS unsigned*)(lds + (bufoff) + ldsw + _i * 8192), 16, 0, 0); } while (0)
#define PG8_LDA(dst, b, h) do { _Pragma("unroll") for (int m = 0; m < 4; ++m) _Pragma("unroll") for (int k = 0; k < 2; ++k) dst[m][k] = *(const PG8_LAS bf16x8*)(lds + PG8_SA(b, h) + aoff + m * 2048 + k * 1024); } while (0)
#define PG8_LDB(dst, b, h) do { _Pragma("unroll") for (int n = 0; n < 2; ++n) _Pragma("unroll") for (int k = 0; k < 2; ++k) dst[n][k] = *(const PG8_LAS bf16x8*)(lds + PG8_SB(b, h) + boff + n * 2048 + k * 1024); } while (0)
#define PG8_MMA(ai, bj, At, Bt) do { __builtin_amdgcn_s_setprio(1); _Pragma("unroll") for (int m = 0; m < 4; ++m) _Pragma("unroll") for (int n = 0; n < 2; ++n) _Pragma("unroll") for (int k = 0; k < 2; ++k) \
        acc[ai][bj][m][n] = __builtin_amdgcn_mfma_f32_16x16x32_bf16(Bt[n][k], At[m][k], acc[ai][bj][m][n], 0, 0, 0); __builtin_amdgcn_s_setprio(0); } while (0)
#define PG8_WAIT_V(n) asm volatile("s_waitcnt vmcnt(" #n ")" ::: "memory")
#define PG8_WAIT_L(n) asm volatile("s_waitcnt lgkmcnt(" #n ")" ::: "memory")
#define PG8_BAR __builtin_amdgcn_s_barrier()
#define PG8_SCHED __builtin_amdgcn_sched_barrier(0)
    Unit cur, nxt; int ui = 0;
    if (!S.next(0, cur)) return;
    f32x4 acc[2][2][4][2];
#pragma unroll
    for (int a = 0; a < 2; ++a)
#pragma unroll
        for (int b = 0; b < 2; ++b)
#pragma unroll
            for (int m = 0; m < 4; ++m)
#pragma unroll
                for (int n = 0; n < 2; ++n) acc[a][b][m][n] = (f32x4){0.f, 0.f, 0.f, 0.f};
    bf16x8 At[4][2], B0[2][2], B1[2][2];
    const char* cA = (const char*)g.A + (size_t)cur.pm * tstep; const char* cB = (const char*)g.Bt + (size_t)cur.pn * tstep;
    S.a_ready(cur);
    if constexpr (SP2) {
        PG8_STAGE(PG8_SB(0, 0), cB, voffB); PG8_STAGE(PG8_SB(0, 1), cB + hstep, voffB); PG8_STAGE(PG8_SA(0, 0), cA, voffA); PG8_STAGE(PG8_SA(0, 1), cA + hstep, voffA);
        if (wr == 1) PG8_BAR;
        PG8_WAIT_V(2); PG8_BAR;
        PG8_STAGE(PG8_SB(1, 0), cB + kstep, voffB); PG8_STAGE(PG8_SA(1, 0), cA + kstep, voffA); PG8_STAGE(PG8_SB(1, 1), cB + hstep + kstep, voffB);
        PG8_WAIT_V(6); PG8_BAR;
    } else {
        PG8_STAGE(PG8_SB(0, 0), cB, voffB); PG8_STAGE(PG8_SA(0, 0), cA, voffA); PG8_STAGE(PG8_SB(0, 1), cB + hstep, voffB); PG8_STAGE(PG8_SA(0, 1), cA + hstep, voffA);
        if (wr == 1) PG8_BAR;
        PG8_WAIT_V(4); PG8_BAR;
        PG8_STAGE(PG8_SB(1, 0), cB + kstep, voffB); PG8_STAGE(PG8_SA(1, 0), cA + kstep, voffA); PG8_STAGE(PG8_SB(1, 1), cB + hstep + kstep, voffB);
        PG8_WAIT_V(6); PG8_BAR;
    }
    for (;;) {
        const bool has_next = S.next(ui + 1, nxt);
        const char* nA = has_next ? (const char*)g.A + (size_t)nxt.pm * tstep : cA; const char* nB = has_next ? (const char*)g.Bt + (size_t)nxt.pn * tstep : cB;
        for (int t = 0; t < nt; t += 2) {
            const bool last = (t == nt - 2);
            const char* a1 = cA + (size_t)(t + 1) * kstep;
            const char* a2 = last ? nA : cA + (size_t)(t + 2) * kstep; const char* b2 = last ? nB : cB + (size_t)(t + 2) * kstep;
            const char* a3 = a2 + kstep; const char* b3 = b2 + kstep;
            if (last && has_next) S.a_ready(nxt);
            if constexpr (SP2) {
            PG8_LDB(B0, 0, 0); PG8_LDB(B1, 0, 1); PG8_SCHED; PG8_LDA(At, 0, 0); PG8_STAGE(PG8_SA(1, 1), a1 + hstep, voffA);
            PG8_WAIT_V(8); PG8_WAIT_L(0); PG8_BAR; PG8_MMA(0, 0, At, B0); PG8_MMA(0, 1, At, B1); PG8_BAR; PG8_SCHED;
            PG8_LDA(At, 0, 1); PG8_STAGE(PG8_SB(0, 0), b2, voffB); PG8_STAGE(PG8_SB(0, 1), b2 + hstep, voffB); PG8_STAGE(PG8_SA(0, 0), a2, voffA);
            PG8_WAIT_V(8); PG8_WAIT_L(0); PG8_BAR; PG8_MMA(1, 0, At, B0); PG8_MMA(1, 1, At, B1); PG8_BAR; PG8_SCHED;
            PG8_LDB(B0, 1, 0); PG8_LDB(B1, 1, 1); PG8_SCHED; PG8_LDA(At, 1, 0); PG8_STAGE(PG8_SA(0, 1), a2 + hstep, voffA);
            PG8_WAIT_V(8); PG8_WAIT_L(0); PG8_BAR; PG8_MMA(0, 0, At, B0); PG8_MMA(0, 1, At, B1); PG8_BAR; PG8_SCHED;
            PG8_LDA(At, 1, 1); PG8_STAGE(PG8_SB(1, 0), b3, voffB); PG8_STAGE(PG8_SB(1, 1), b3 + hstep, voffB); PG8_STAGE(PG8_SA(1, 0), a3, voffA);
            PG8_WAIT_V(8); PG8_WAIT_L(0); PG8_BAR; PG8_MMA(1, 0, At, B0); PG8_MMA(1, 1, At, B1); PG8_BAR; PG8_SCHED;
            } else {
            PG8_LDB(B0, 0, 0); PG8_SCHED; PG8_LDA(At, 0, 0); PG8_STAGE(PG8_SA(1, 1), a1 + hstep, voffA);
            PG8_WAIT_L(8); PG8_BAR; PG8_WAIT_L(0); PG8_MMA(0, 0, At, B0); PG8_BAR; PG8_SCHED;
            PG8_LDB(B1, 0, 1); PG8_STAGE(PG8_SB(0, 0), b2, voffB);
            PG8_BAR; PG8_WAIT_L(0); PG8_MMA(0, 1, At, B1); PG8_BAR;
            PG8_LDA(At, 0, 1); PG8_STAGE(PG8_SA(0, 0), a2, voffA);
            PG8_BAR; PG8_WAIT_L(0); PG8_MMA(1, 0, At, B0); PG8_BAR; PG8_SCHED;
            PG8_STAGE(PG8_SB(0, 1), b2 + hstep, voffB);
            PG8_WAIT_V(6); PG8_BAR; PG8_MMA(1, 1, At, B1); PG8_BAR;
            PG8_LDB(B0, 1, 0); PG8_SCHED; PG8_LDA(At, 1, 0); PG8_STAGE(PG8_SA(0, 1), a2 + hstep, voffA);
            PG8_WAIT_L(8); PG8_BAR; PG8_WAIT_L(0); PG8_MMA(0, 0, At, B0); PG8_BAR; PG8_SCHED;
            PG8_LDB(B1, 1, 1); PG8_STAGE(PG8_SB(1, 0), b3, voffB);
            PG8_BAR; PG8_WAIT_L(0); PG8_MMA(0, 1, At, B1); PG8_BAR;
            PG8_LDA(At, 1, 1); PG8_STAGE(PG8_SA(1, 0), a3, voffA);
            PG8_BAR; PG8_WAIT_L(0); PG8_MMA(1, 0, At, B0); PG8_BAR; PG8_SCHED;
            PG8_STAGE(PG8_SB(1, 1), b3 + hstep, voffB);
            PG8_WAIT_V(6); PG8_BAR; PG8_MMA(1, 1, At, B1); PG8_BAR;
            }
        }
        if constexpr (ALIGN_EPI) { if (wr == 0) PG8_BAR; }
        if constexpr (!Epi::AFTER_DRAIN) { E(acc, cur, wr, wc, fr, fq); S.done(cur); }
        if (!has_next) break;
#pragma unroll
        for (int a = 0; a < 2; ++a)
#pragma unroll
            for (int b = 0; b < 2; ++b)
#pragma unroll
                for (int m = 0; m < 4; ++m)
#pragma unroll
                    for (int n = 0; n < 2; ++n) acc[a][b][m][n] = (f32x4){0.f, 0.f, 0.f, 0.f};
        cur = nxt; cA = nA; cB = nB; ++ui;
        if constexpr (ALIGN_EPI) { if (wr == 1) PG8_BAR; }
    }
    PG8_WAIT_V(0);
    if constexpr (!ALIGN_EPI) { if (wr == 0) PG8_BAR; }
    PG8_BAR;
    if constexpr (Epi::AFTER_DRAIN) { E.fused(acc, cur, wr, wc, fr, fq, lds, wid, lane); S.done(cur); }
#undef PG8_SA
#undef PG8_SB
#undef PG8_STAGE
#undef PG8_LDA
#undef PG8_LDB
#undef PG8_MMA
#undef PG8_WAIT_V
#undef PG8_WAIT_L
#undef PG8_BAR
#undef PG8_SCHED
}
}

#define LAS __attribute__((address_space(3)))
typedef unsigned short bf16;
typedef short bf16x8 __attribute__((ext_vector_type(8)));
typedef float f32x4 __attribute__((ext_vector_type(4)));
typedef float f32x16 __attribute__((ext_vector_type(16)));
typedef unsigned u32x4 __attribute__((ext_vector_type(4)));
typedef unsigned u32x2 __attribute__((ext_vector_type(2)));

constexpr int DM = 1024, NBATCH = 4, SEQ = 4096, MP = NBATCH * SEQ, SBATCH = 128, STOK = 4, MS = SBATCH * STOK, MR = MP + MS;
constexpr int PASTL = 2048, PAGE = 128, NPG = 16;
constexpr int LS = 2112, LSW = 576;
constexpr int NPAD = 5632;
constexpr float C2 = 0.125f * 1.4426950408889634f;
constexpr int NWAVES = 8;

constexpr size_t O_YP = 0, O_YS = 16777216, O_NSAP = 17301504, O_DSAP = 25690112, O_IDXP = 29884416, O_WINP = 30932992,
                 O_NSAS = 31457280, O_DSAS = 31719424, O_IDXS = 31850496, O_WINS = 31883264, O_END = 48660480;

constexpr size_t MiB = 1u << 20;
constexpr size_t WS_CTL = 0, CTL_ZERO_BYTES = 1 * MiB;
constexpr size_t WS_MOD = 1 * MiB;
constexpr size_t WS_COS = 3 * MiB, WS_SIN = 4 * MiB;
constexpr size_t WS_BIAS1 = 5 * MiB;
constexpr size_t WS_BIASP = 5 * MiB + 262144;
constexpr size_t WS_W2T = 5 * MiB + 65536;
constexpr size_t WS_W1T = 6 * MiB;
constexpr size_t WS_WINT = 8 * MiB;
constexpr size_t WS_WUPN = 20 * MiB, WS_WUPD = 21 * MiB, WS_WOUT = 22 * MiB;
constexpr size_t WS_PSLCVK = 975 * MiB, WS_PWINVK = 979 * MiB, WS_PDSAVK = 983 * MiB;
constexpr size_t WS_SELM = 960 * MiB;
constexpr size_t WS_GATES = 25 * MiB;
constexpr size_t WS_IW = 27 * MiB;
constexpr size_t WS_PCK = 28 * MiB, WS_PCVT = 28 * MiB + 262144;
constexpr size_t WS_SCK = 29 * MiB, WS_SCVT = 33 * MiB;
constexpr size_t WS_H = 40 * MiB;
constexpr size_t WS_QRAW = 80 * MiB, WS_QROT = 100 * MiB, WS_DQ = 120 * MiB, WS_IQ = 140 * MiB, WS_ZN = 150 * MiB, WS_ZD = 170 * MiB, WS_ONZ = 190 * MiB, WS_ODZ = 210 * MiB;
constexpr size_t WS_MG = 230 * MiB;
constexpr size_t WS_T1 = 300 * MiB;
constexpr size_t WS_M1 = 370 * MiB;
constexpr size_t WS_PCMPK = 410 * MiB, WS_PCMPV = 414 * MiB, WS_PSLCK = 418 * MiB, WS_PSLCVT = 422 * MiB, WS_PWINK = 426 * MiB, WS_PWINVT = 430 * MiB,
                 WS_PDSAK = 434 * MiB, WS_PDSAVT = 438 * MiB, WS_PIDXK = 442 * MiB;
constexpr size_t WS_SCMPK = 450 * MiB, WS_SCMPV = 520 * MiB, WS_SSLCK = 590 * MiB, WS_SSLCVT = 660 * MiB, WS_SDSAK = 730 * MiB, WS_SDSAVT = 800 * MiB,
                 WS_SWINK = 870 * MiB, WS_SWINVT = 890 * MiB, WS_SIDXK = 910 * MiB, WS_END = 990 * MiB;
constexpr int CW_BAR = 4096;
constexpr int CW_Q = 16384;

constexpr int RING_BYTES = 131072, MISC_OFF = RING_BYTES, LDS_BYTES = 147456;

struct Args { const void* in[20]; float* out; unsigned char* ws; int ph_lo, ph_hi, qoff, umask, pad0, pad1; };

struct Frame {
    LAS unsigned char* lds; volatile LAS unsigned* MISC; unsigned* ctl;
    int tid, lane, wave, G, qoff;
    unsigned char* ws; float* out;
    const float *xp, *xs, *cnsa, *cdsa, *cidx, *swin; const int* ptab; const float *cp, *cs, *normg, *wada, *bada, *win, *pe, *w1, *w2, *wupn, *wupd, *wout, *fing;
};
#define WSP(T, off) ((T*)(F.ws + (off)))

#define DI __device__ __forceinline__
#define LDS_WAIT() asm volatile("s_waitcnt lgkmcnt(0)" ::: "memory")
DI u32x4 gload16(const void* p) { u32x4 r; asm volatile("global_load_dwordx4 %0, %1, off" : "=v"(r) : "v"(p) : "memory"); return r; }
DI unsigned long long gload8(const void* p) { unsigned long long r; asm volatile("global_load_dwordx2 %0, %1, off" : "=v"(r) : "v"(p) : "memory"); return r; }
#define WAITV2(n, a, b) asm volatile("s_waitcnt vmcnt(" #n ")" : "+v"(a), "+v"(b) :: "memory")
#define WAITV1(n, a) asm volatile("s_waitcnt vmcnt(" #n ")" : "+v"(a) :: "memory")
#define LDS_BARRIER() do { asm volatile("s_waitcnt lgkmcnt(0)" ::: "memory"); __builtin_amdgcn_s_barrier(); asm volatile("" ::: "memory"); } while (0)
DI float wave_sum(float v) {
#pragma unroll
    for (int o = 1; o < 64; o <<= 1) v += __shfl_xor(v, o);
    return v;
}
DI unsigned pk2(float lo, float hi) { return pg8::cvt_pk_bf16(lo, hi); }
DI float bflo(unsigned w) { return __uint_as_float(w << 16); }
DI float bfhi(unsigned w) { return __uint_as_float(w & 0xffff0000u); }
DI float bf2f(bf16 h) { return __uint_as_float((unsigned)h << 16); }
DI float sigm_f(float x) { return __builtin_amdgcn_rcpf(1.f + __builtin_amdgcn_exp2f(-1.4426950408889634f * x)); }
DI float silu_f(float x) { return x * sigm_f(x); }
DI int pos16(int o) { return 8 * ((o >> 2) & 1) + (o & 3) + 4 * (o >> 3); }
DI int permk(int t) { return (t & ~15) | pos16(t & 15); }
DI int crow(int r, int hi) { return (r & 3) + 8 * (r >> 2) + 4 * hi; }
DI float dpp_x1(float v) { return __int_as_float(__builtin_amdgcn_update_dpp(0, __float_as_int(v), 0xB1, 0xF, 0xF, true)); }
DI float dpp_x2(float v) { return __int_as_float(__builtin_amdgcn_update_dpp(0, __float_as_int(v), 0x4E, 0xF, 0xF, true)); }
DI float half_other(float v) { return __shfl_xor(v, 32); }
DI u32x4 pack8(const float* v) { u32x4 w; w.x = pk2(v[0], v[1]); w.y = pk2(v[2], v[3]); w.z = pk2(v[4], v[5]); w.w = pk2(v[6], v[7]); return w; }
DI void st_bf8(bf16* p, const float* v) { *(u32x4*)p = pack8(v); }
DI void st_f8(float* p, const float* v) { __builtin_nontemporal_store((f32x4){v[0], v[1], v[2], v[3]}, (f32x4*)p); __builtin_nontemporal_store((f32x4){v[4], v[5], v[6], v[7]}, (f32x4*)(p + 4)); }
DI void st_vt8(bf16* p, size_t pitch, const float* v) {
#pragma unroll
    for (int j = 0; j < 8; ++j) p[(size_t)j * pitch] = (bf16)(pk2(v[j], 0.f) & 0xffffu);
}
#define PIN4(q) asm volatile("" : "+v"(q[0]), "+v"(q[1]), "+v"(q[2]), "+v"(q[3]))
#define NEGINF (-__builtin_inff())
#define MFMA32(a, b, c) __builtin_amdgcn_mfma_f32_32x32x16_bf16((a), (b), (c), 0, 0, 0)

DI int idx_key(float dot, float w) {
#pragma clang fp contract(off)
    float v = fmaxf(dot, 0.f) * w;
    v = v + dpp_x1(v);
    v = v + dpp_x2(v);
    int u = __float_as_int(v);
    u = (u == (int)0x80000000) ? 0 : u;
    return u ^ ((u >> 31) & 0x7fffffff);
}

template <int MODE> struct EpiInProjT {
    static constexpr bool PERM = true, AFTER_DRAIN = false;
    unsigned char* ws; float* out;
    DI void rope8(float* lo, float* hi, const float* c, const float* s) const {
#pragma unroll
        for (int j = 0; j < 8; ++j) { const float a = lo[j], b = hi[j]; lo[j] = a * c[j] - b * s[j]; hi[j] = b * c[j] + a * s[j]; }
    }
    DI void ldtab(float* c, float* s, int pos, int d0) const {
        const f32x4* cp = (const f32x4*)((const float*)(ws + WS_COS) + pos * 32 + d0);
        const f32x4* sp = (const f32x4*)((const float*)(ws + WS_SIN) + pos * 32 + d0);
        const f32x4 c0 = cp[0], c1 = cp[1], s0 = sp[0], s1 = sp[1];
        c[0] = c0[0]; c[1] = c0[1]; c[2] = c0[2]; c[3] = c0[3]; c[4] = c1[0]; c[5] = c1[1]; c[6] = c1[2]; c[7] = c1[3];
        s[0] = s0[0]; s[1] = s0[1]; s[2] = s0[2]; s[3] = s0[3]; s[4] = s1[0]; s[5] = s1[1]; s[6] = s1[2]; s[7] = s1[3];
        asm volatile("" : "+v"(c[0]), "+v"(c[1]), "+v"(c[2]), "+v"(c[3]), "+v"(c[4]), "+v"(c[5]), "+v"(c[6]), "+v"(c[7]));
        asm volatile("" : "+v"(s[0]), "+v"(s[1]), "+v"(s[2]), "+v"(s[3]), "+v"(s[4]), "+v"(s[5]), "+v"(s[6]), "+v"(s[7]));
    }
    DI void operator()(const pg8::f32x4 (&acc)[2][2][4][2], const pg8::Unit& u, int wr, int wc, int fr, int fq) const {
        const int hs = u.pn * 4 + wc;
        if (hs >= 86) return;
        if ((MODE & 2) && hs >= 20 && hs != 44 && !(hs >= 36 && hs < 40)) return;
        if ((MODE & 4) && hs < 20) return;
        const bool samp = u.pm >= 64;
        const int d0 = 8 * fq;
        const bool roped = hs < 8 || (hs >= 12 && hs < 14) || (hs >= 16 && hs < 18) || (hs >= 28 && hs < 36) || hs == 36 || hs == 37 || (hs >= 40 && hs <= 44);
        float rc[8], rs[8], dc[8], ds[8];
        if (roped) { if (samp) {
#pragma unroll
                for (int j = 0; j < 8; ++j) { dc[j] = 1.f; ds[j] = 0.f; }
            } else ldtab(dc, ds, 16, d0); }
#pragma unroll
        for (int ai = 0; ai < 2; ++ai)
#pragma unroll
            for (int m = 0; m < 4; ++m) {
                const int r = u.pm * 256 + ai * 128 + wr * 64 + m * 16 + fr;
                if (roped) {
                    if (m == 0) ldtab(rc, rs, samp ? PASTL + (r & 3) : (r & 4095), d0);
                    else {
#pragma unroll
                        for (int j = 0; j < 8; ++j) { const float a = rc[j], b = rs[j]; rc[j] = a * dc[j] - b * ds[j]; rs[j] = b * dc[j] + a * ds[j]; }
                    }
                }
                int b, t, pos;
                if (!samp) { b = r >> 12; t = r & 4095; pos = t; } else { b = (r - MP) >> 2; t = r & 3; pos = PASTL + t; }
                float lo[8], hi[8];
#pragma unroll
                for (int n = 0; n < 2; ++n)
#pragma unroll
                    for (int j = 0; j < 4; ++j) { lo[4 * n + j] = acc[ai][0][m][n][j]; hi[4 * n + j] = acc[ai][1][m][n][j]; }
                if (hs < 8) {
                    bf16* qa = (bf16*)(ws + WS_QRAW) + (size_t)r * 512 + hs * 64 + d0;
                    bf16* qb = (bf16*)(ws + WS_QROT) + (size_t)r * 512 + hs * 64 + d0;
                    float a[8], c[8];
#pragma unroll
                    for (int j = 0; j < 8; ++j) { a[j] = lo[j] * C2; c[j] = hi[j] * C2; }
                    st_bf8(qa, a); st_bf8(qa + 32, c);
                    rope8(lo, hi, rc, rs);
#pragma unroll
                    for (int j = 0; j < 8; ++j) { a[j] = lo[j] * C2; c[j] = hi[j] * C2; }
                    st_bf8(qb, a); st_bf8(qb + 32, c);
                } else if (hs < 20) {
                    const int ty = (hs - 8) >> 1, g = (hs - 8) & 1;
                    if (ty == 2 || ty == 4) rope8(lo, hi, rc, rs);
                    const int bg = b * 2 + g;
                    if (ty < 4) {
                        float* o = out + (samp ? O_NSAS + ((size_t)(r - MP) * 8 + ty * 2 + g) * 64 : O_NSAP + ((size_t)r * 8 + ty * 2 + g) * 64) + d0;
                        st_f8(o, lo); st_f8(o + 32, hi);
                    } else {
                        const int sl = ty - 4;
                        if (samp) { float* o = out + O_WINS + (((size_t)b * 512 + 508 + t) * 4 + sl * 2 + g) * 64 + d0; st_f8(o, lo); st_f8(o + 32, hi); }
                        else if (t >= SEQ - 512) { float* o = out + O_WINP + (((size_t)b * 512 + (t - (SEQ - 512))) * 4 + sl * 2 + g) * 64 + d0; st_f8(o, lo); st_f8(o + 32, hi); }
                    }
                    if (ty == 3 || ty == 5) {
                        size_t pitch; int kp; bf16* base;
                        if (!samp) { pitch = SEQ; kp = t; base = (bf16*)(ws + (ty == 3 ? WS_PSLCVT : WS_PWINVT)); }
                        else if (ty == 3) { pitch = LS; kp = PASTL + t; base = (bf16*)(ws + WS_SSLCVT); }
                        else { pitch = LSW; kp = 512 + t; base = (bf16*)(ws + WS_SWINVT); }
                        bf16* p = base + ((size_t)bg * 64 + d0) * pitch + permk(kp);
                        if (!(MODE & 1)) { st_vt8(p, pitch, lo); st_vt8(p + 32 * pitch, pitch, hi); }
                    } else {
                        size_t rowi; bf16* base;
                        if (!samp) { rowi = (size_t)bg * SEQ + t; base = (bf16*)(ws + (ty == 0 ? WS_PCMPK : ty == 1 ? WS_PCMPV : ty == 2 ? WS_PSLCK : WS_PWINK)); }
                        else if (ty == 4) { rowi = (size_t)bg * LSW + 512 + t; base = (bf16*)(ws + WS_SWINK); }
                        else { rowi = (size_t)bg * LS + PASTL + t; base = (bf16*)(ws + (ty == 0 ? WS_SCMPK : ty == 1 ? WS_SCMPV : WS_SSLCK)); }
                        bf16* p = base + rowi * 64 + d0;
                        st_bf8(p, lo); st_bf8(p + 32, hi);
                    }
                } else if (hs < 28 || (hs >= 45 && hs < 53)) {
                    const int h = hs < 28 ? hs - 20 : hs - 45;
                    bf16* p = (bf16*)(ws + (hs < 28 ? WS_ZN : WS_ZD)) + (size_t)r * 512 + h * 64 + d0;
#pragma unroll
                    for (int j = 0; j < 8; ++j) { lo[j] = silu_f(lo[j]); hi[j] = silu_f(hi[j]); }
                    st_bf8(p, lo); st_bf8(p + 32, hi);
                } else if (hs < 36) {
                    rope8(lo, hi, rc, rs);
#pragma unroll
                    for (int j = 0; j < 8; ++j) { lo[j] *= C2; hi[j] *= C2; }
                    bf16* p = (bf16*)(ws + WS_DQ) + (size_t)r * 512 + (hs - 28) * 64 + d0;
                    st_bf8(p, lo); st_bf8(p + 32, hi);
                } else if (hs < 40) {
                    const int sl = (hs - 36) >> 1, g = (hs - 36) & 1, bg = b * 2 + g;
                    if (sl == 0) rope8(lo, hi, rc, rs);
                    float* o = out + (samp ? O_DSAS + ((size_t)(r - MP) * 4 + sl * 2 + g) * 64 : O_DSAP + ((size_t)r * 4 + sl * 2 + g) * 64) + d0;
                    st_f8(o, lo); st_f8(o + 32, hi);
                    if (sl == 0) {
                        bf16* p = samp ? (bf16*)(ws + WS_SDSAK) + ((size_t)bg * LS + PASTL + t) * 64 + d0 : (bf16*)(ws + WS_PDSAK) + ((size_t)bg * SEQ + t) * 64 + d0;
                        st_bf8(p, lo); st_bf8(p + 32, hi);
                    } else {
                        const size_t pitch = samp ? LS : SEQ; const int kp = samp ? PASTL + t : t;
                        bf16* p = (bf16*)(ws + (samp ? WS_SDSAVT : WS_PDSAVT)) + ((size_t)bg * 64 + d0) * pitch + permk(kp);
                        if (!(MODE & 1)) { st_vt8(p, pitch, lo); st_vt8(p + 32 * pitch, pitch, hi); }
                    }
                } else if (hs < 44) {
                    rope8(lo, hi, rc, rs);
                    bf16* p = (bf16*)(ws + WS_IQ) + (size_t)r * 256 + (hs - 40) * 64 + d0;
                    st_bf8(p, lo); st_bf8(p + 32, hi);
                } else if (hs == 44) {
                    rope8(lo, hi, rc, rs);
                    float* o = out + (samp ? O_IDXS + (size_t)(r - MP) * 64 : O_IDXP + (size_t)r * 64) + d0;
                    st_f8(o, lo); st_f8(o + 32, hi);
                    bf16* p = samp ? (bf16*)(ws + WS_SIDXK) + ((size_t)b * LS + PASTL + t) * 64 + d0 : (bf16*)(ws + WS_PIDXK) + (size_t)r * 64 + d0;
                    st_bf8(p, lo); st_bf8(p + 32, hi);
                } else if (hs < 85) {
                    bf16* p = (bf16*)(ws + WS_MG) + (size_t)r * 2048 + (hs - 53) * 64 + d0;
#pragma unroll
                    for (int j = 0; j < 8; ++j) { lo[j] = sigm_f(lo[j]); hi[j] = sigm_f(hi[j]); }
                    st_bf8(p, lo); st_bf8(p + 32, hi);
                } else {
                    if (fq < 3) { float* p = (float*)(ws + WS_GATES) + (size_t)r * 24 + d0;
#pragma unroll
                        for (int j = 0; j < 8; ++j) lo[j] = sigm_f(lo[j]);
                        st_f8(p, lo);
                    } else { *(f32x4*)((float*)(ws + WS_IW) + (size_t)r * 4) = (f32x4){lo[0], lo[1], lo[2], lo[3]}; }
                }
            }
    }
};
typedef EpiInProjT<0> EpiInProj;
struct ColOrder {
    int nM, nN, cnt, rank, pn;
    __device__ void init(int M, int N, int G, int c) { nM = M / 256; nN = N / 256; pn = c % nN; rank = c / nN; cnt = G / nN + ((pn < G % nN) ? 1 : 0); }
    __device__ bool next(int i, pg8::Unit& u) const { const int pm = rank + i * cnt; if (pm >= nM) return false; u.pm = pm; u.pn = pn; return true; }
    __device__ __forceinline__ void a_ready(const pg8::Unit&) const {}
    __device__ __forceinline__ void done(const pg8::Unit&) const {}
};
struct EpiNull {
    static constexpr bool PERM = true, AFTER_DRAIN = false;
    unsigned char* ws;
    DI void operator()(const pg8::f32x4 (&acc)[2][2][4][2], const pg8::Unit& u, int wr, int wc, int fr, int fq) const {
        float s = 0.f;
#pragma unroll
        for (int ai = 0; ai < 2; ++ai)
#pragma unroll
            for (int bj = 0; bj < 2; ++bj)
#pragma unroll
                for (int m = 0; m < 4; ++m)
#pragma unroll
                    for (int n = 0; n < 2; ++n) s += acc[ai][bj][m][n][0] + acc[ai][bj][m][n][1] + acc[ai][bj][m][n][2] + acc[ai][bj][m][n][3];
        if (s == 1.2345e33f) *(float*)(ws + WS_CTL + 2048) = s;
    }
};
struct EpiUp1 {
    static constexpr bool PERM = true, AFTER_DRAIN = false;
    unsigned char* ws;
    DI void operator()(const pg8::f32x4 (&acc)[2][2][4][2], const pg8::Unit& u, int wr, int wc, int fr, int fq) const {
#pragma unroll
        for (int ai = 0; ai < 2; ++ai)
#pragma unroll
            for (int m = 0; m < 4; ++m) {
                const int r = u.pm * 256 + ai * 128 + wr * 64 + m * 16 + fr;
#pragma unroll
                for (int bj = 0; bj < 2; ++bj) {
                    const int c0 = u.pn * 256 + bj * 128 + wc * 32 + 8 * fq;
                    const u32x4 gw = *(const u32x4*)((const bf16*)(ws + WS_MG) + (size_t)r * 2048 + c0);
                    const f32x4 a0 = acc[ai][bj][m][0], a1 = acc[ai][bj][m][1];
                    float* o = (float*)(ws + WS_T1) + (size_t)r * 1024 + c0;
                    *(f32x4*)o = (f32x4){a0[0] * bflo(gw.x), a0[1] * bfhi(gw.x), a0[2] * bflo(gw.y), a0[3] * bfhi(gw.y)};
                    *(f32x4*)(o + 4) = (f32x4){a1[0] * bflo(gw.z), a1[1] * bfhi(gw.z), a1[2] * bflo(gw.w), a1[3] * bfhi(gw.w)};
                }
            }
    }
};
struct EpiUp2 {
    static constexpr bool PERM = true, AFTER_DRAIN = false;
    unsigned char* ws;
    DI void operator()(const pg8::f32x4 (&acc)[2][2][4][2], const pg8::Unit& u, int wr, int wc, int fr, int fq) const {
#pragma unroll
        for (int ai = 0; ai < 2; ++ai)
#pragma unroll
            for (int m = 0; m < 4; ++m) {
                const int r = u.pm * 256 + ai * 128 + wr * 64 + m * 16 + fr;
#pragma unroll
                for (int bj = 0; bj < 2; ++bj) {
                    const int c0 = u.pn * 256 + bj * 128 + wc * 32 + 8 * fq;
                    const u32x4 gw = *(const u32x4*)((const bf16*)(ws + WS_MG) + (size_t)r * 2048 + 1024 + c0);
                    const float* tp = (const float*)(ws + WS_T1) + (size_t)r * 1024 + c0;
                    const f32x4 t0 = *(const f32x4*)tp, t1 = *(const f32x4*)(tp + 4);
                    const f32x4 a0 = acc[ai][bj][m][0], a1 = acc[ai][bj][m][1];
                    u32x4 w;
                    w.x = pk2(t0[0] + a0[0] * bflo(gw.x), t0[1] + a0[1] * bfhi(gw.x)); w.y = pk2(t0[2] + a0[2] * bflo(gw.y), t0[3] + a0[3] * bfhi(gw.y));
                    w.z = pk2(t1[0] + a1[0] * bflo(gw.z), t1[1] + a1[1] * bfhi(gw.z)); w.w = pk2(t1[2] + a1[2] * bflo(gw.w), t1[3] + a1[3] * bfhi(gw.w));
                    *(u32x4*)((bf16*)(ws + WS_M1) + (size_t)r * 1024 + c0) = w;
                }
            }
    }
};
struct EpiOut {
    static constexpr bool PERM = true, AFTER_DRAIN = false;
    unsigned char* ws; float* out; const float* xp; const float* xs;
    DI void operator()(const pg8::f32x4 (&acc)[2][2][4][2], const pg8::Unit& u, int wr, int wc, int fr, int fq) const {
        const bool samp = u.pm >= 64;
#pragma unroll
        for (int ai = 0; ai < 2; ++ai)
#pragma unroll
            for (int m = 0; m < 4; ++m) {
                const int r = u.pm * 256 + ai * 128 + wr * 64 + m * 16 + fr;
                const int mrow = samp ? 4 + ((r - MP) >> 2) : (r >> 12);
                const float* xr = samp ? xs + (size_t)(r - MP) * 1024 : xp + (size_t)r * 1024;
                float* orow = samp ? out + O_YS + (size_t)(r - MP) * 1024 : out + O_YP + (size_t)r * 1024;
                const float* gr = (const float*)(ws + WS_MOD) + (size_t)mrow * 3072 + 2048;
#pragma unroll
                for (int bj = 0; bj < 2; ++bj) {
                    const int c0 = u.pn * 256 + bj * 128 + wc * 32 + 8 * fq;
#pragma unroll
                    for (int n = 0; n < 2; ++n) {
                        const f32x4 x4 = *(const f32x4*)(xr + c0 + 4 * n), g4 = *(const f32x4*)(gr + c0 + 4 * n);
                        *(f32x4*)(orow + c0 + 4 * n) = x4 + g4 * acc[ai][bj][m][n];
                    }
                }
            }
    }
};

DI int win_row(int col) {
    int hs, d;
    if (col < 1280) { hs = col >> 6; d = col & 63; }
    else if (col < 1304) { hs = 85; d = col - 1280; }
    else if (col < 2904) { const int c = col - 1304; hs = 20 + (c >> 6); d = c & 63; }
    else if (col < 2908) { hs = 85; d = 24 + (col - 2904); }
    else { const int c = col - 2908; hs = 45 + (c >> 6); d = c & 63; }
    return 256 * (hs >> 2) + 128 * (d >> 5) + 32 * (hs & 3) + (d & 31);
}
template <bool WINMAP> DI void p0_transpose_item(const float* W, int K, int N, bf16* WT, LAS float* scr, int item, int lane) {
    const int nblk = (N + 31) / 32, kb = item / nblk, nb = item % nblk, k0 = 64 * kb, n0 = 32 * nb;
    const bool nok = n0 + (lane & 31) < N;
#pragma unroll 8
    for (int i = 0; i < 32; ++i) { const int kk = 2 * i + (lane >> 5); scr[kk * 33 + (lane & 31)] = nok ? W[(size_t)(k0 + kk) * N + n0 + (lane & 31)] : 0.f; }
    LDS_WAIT();
    const int c = lane & 7;
#pragma unroll
    for (int j = 0; j < 4; ++j) { const int n = (lane >> 3) + 8 * j; const LAS float* s = scr + (8 * c) * 33 + n;
        u32x4 o; o.x = pk2(s[0 * 33], s[1 * 33]); o.y = pk2(s[2 * 33], s[3 * 33]); o.z = pk2(s[4 * 33], s[5 * 33]); o.w = pk2(s[6 * 33], s[7 * 33]);
        if (n0 + n < N) { const int row = WINMAP ? win_row(n0 + n) : (n0 + n); *(u32x4*)(WT + (size_t)row * K + k0 + 8 * c) = o; } }
    LDS_WAIT();
}
DI void p0_mod(Frame& F) {
    LAS float* wl = (LAS float*)F.lds;
    float* mod = WSP(float, WS_MOD);
    for (int cg = blockIdx.x; cg < 256; cg += F.G) {
        __syncthreads();
        for (int k = F.tid; k < 1024; k += NWAVES * 64) {
            const f32x4* src = (const f32x4*)(F.wada + (size_t)k * 3072 + cg * 12);
            LAS f32x4* dst = (LAS f32x4*)(wl + k * 12);
            dst[0] = src[0]; dst[1] = src[1]; dst[2] = src[2];
        }
        __syncthreads();
        float cv[16], cn[16];
        { const float* cr = F.wave < 4 ? F.cp + (size_t)F.wave * 1024 : F.cs + (size_t)(F.wave - 4) * 1024;
#pragma unroll
          for (int i = 0; i < 16; ++i) cn[i] = cr[F.lane + 64 * i]; }
        for (int r = F.wave; r < 132; r += NWAVES) {
#pragma unroll
            for (int i = 0; i < 16; ++i) cv[i] = cn[i];
            { const int rn = r + NWAVES < 132 ? r + NWAVES : r; const float* cr = rn < 4 ? F.cp + (size_t)rn * 1024 : F.cs + (size_t)(rn - 4) * 1024;
#pragma unroll
              for (int i = 0; i < 16; ++i) cn[i] = cr[F.lane + 64 * i]; }
            float a[12];
#pragma unroll
            for (int j = 0; j < 12; ++j) a[j] = 0.f;
#pragma unroll
            for (int i = 0; i < 16; ++i) {
                const int k = F.lane + 64 * i; const float s = silu_f(cv[i]);
                const LAS f32x4* wp = (const LAS f32x4*)(wl + k * 12);
                const f32x4 w0 = wp[0], w1 = wp[1], w2 = wp[2];
                a[0] += s * w0[0]; a[1] += s * w0[1]; a[2] += s * w0[2]; a[3] += s * w0[3];
                a[4] += s * w1[0]; a[5] += s * w1[1]; a[6] += s * w1[2]; a[7] += s * w1[3];
                a[8] += s * w2[0]; a[9] += s * w2[1]; a[10] += s * w2[2]; a[11] += s * w2[3];
                if ((i & 3) == 3) __builtin_amdgcn_sched_barrier(0);
            }
            float v = 0.f;
#pragma unroll
            for (int j = 0; j < 12; ++j) { const float sj = wave_sum(a[j]); v = (F.lane == j) ? sj : v; }
            if (F.lane < 12) mod[(size_t)r * 3072 + cg * 12 + F.lane] = v + F.bada[cg * 12 + F.lane];
        }
    }
    __syncthreads();
}
__device__ const double ROPE_INV[32] = {
    1.0, 0.7498942093324559, 0.5623413251903491, 0.4216965034285822, 0.31622776601683794, 0.23713737056616552, 0.1778279410038923, 0.1333521432163324,
    0.1, 0.07498942093324559, 0.05623413251903491, 0.04216965034285822, 0.03162277660168379, 0.023713737056616554, 0.01778279410038923, 0.01333521432163324,
    0.01, 0.007498942093324559, 0.005623413251903491, 0.004216965034285822, 0.0031622776601683794, 0.0023713737056616554, 0.0017782794100389228, 0.001333521432163324,
    0.001, 0.0007498942093324559, 0.0005623413251903491, 0.0004216965034285822, 0.00031622776601683794, 0.00023713737056616554, 0.00017782794100389227, 0.0001333521432163324};
DI void p0_rope_item(Frame& F, int item) {
    const int pos = 2 * item + (F.lane >> 5), d = F.lane & 31;
    if (pos >= 4100) return;
    const double ang = (double)pos * ROPE_INV[d];
    const double kq = __builtin_rint(ang * 0.6366197723675814);
    double r = __builtin_fma(-kq, 1.5707963267948966, ang); r = __builtin_fma(-kq, 6.123233995736766e-17, r);
    const int q = (int)kq & 3;
    const double r2 = r * r;
    const double sn = r * (1.0 + r2 * (-1.0 / 6 + r2 * (1.0 / 120 + r2 * (-1.0 / 5040 + r2 * (1.0 / 362880 + r2 * (-1.0 / 39916800 + r2 * (1.0 / 6227020800.0)))))));
    const double cs = 1.0 + r2 * (-0.5 + r2 * (1.0 / 24 + r2 * (-1.0 / 720 + r2 * (1.0 / 40320 + r2 * (-1.0 / 3628800 + r2 * (1.0 / 479001600.0 + r2 * (-1.0 / 87178291200.0)))))));
    const double c = (q == 0) ? cs : (q == 1) ? -sn : (q == 2) ? -cs : sn;
    const double s = (q == 0) ? sn : (q == 1) ? cs : (q == 2) ? -sn : -cs;
    WSP(float, WS_COS)[pos * 32 + d] = (float)c; WSP(float, WS_SIN)[pos * 32 + d] = (float)s;
}
DI void p0_cmp_small_item(Frame& F, int item) {
    if (item < 256) {
        const int slot = item >> 7, ch = (item >> 6) & 1, kc = item & 63, c = ch * 64 + F.lane; float a = 0.f;
#pragma unroll 8
        for (int i = 0; i < 32; ++i) { const int k = kc * 32 + i; a += F.pe[slot * 2048 + k] * F.w1[((size_t)slot * 2048 + k) * 128 + c]; }
        WSP(float, WS_BIASP)[(size_t)kc * 256 + slot * 128 + c] = a;
    } else {
        const int it = item - 256, slot = it >> 7, e = (it & 127) >> 1, ch = it & 1;
        const int c = ch * 64 + F.lane;
        WSP(bf16, WS_W2T)[((size_t)slot * 64 + e) * 128 + permk(c)] = (bf16)(pk2(F.w2[((size_t)slot * 128 + c) * 64 + e], 0.f) & 0xffffu);
    }
}
DI void cp_k16(const float* src, size_t rs, bf16* dst, int lane) {
    const int tk = lane >> 2, dc = (lane & 3) * 16;
    const f32x4* s = (const f32x4*)(src + (size_t)tk * rs + dc);
    const f32x4 a = s[0], b = s[1], c = s[2], d = s[3];
    u32x4 w0, w1; w0.x = pk2(a[0], a[1]); w0.y = pk2(a[2], a[3]); w0.z = pk2(b[0], b[1]); w0.w = pk2(b[2], b[3]);
    w1.x = pk2(c[0], c[1]); w1.y = pk2(c[2], c[3]); w1.z = pk2(d[0], d[1]); w1.w = pk2(d[2], d[3]);
    u32x4* o = (u32x4*)(dst + (size_t)tk * 64 + dc); o[0] = w0; o[1] = w1;
}
DI void cp_vt16(const float* src, size_t rs, bf16* dst, size_t pitch, int lane) {
#pragma unroll
    for (int h = 0; h < 2; ++h) {
        float v[8];
#pragma unroll
        for (int i = 0; i < 8; ++i) v[i] = src[(size_t)((i & 3) + 8 * (i >> 2) + 4 * h) * rs + lane];
        *(u32x4*)(dst + (size_t)lane * pitch + 8 * h) = pack8(v);
    }
}
DI void p0_gather_item(Frame& F, int item) {
    const int sb = item >> 7, tg = item & 127, tk0 = tg * 16, lane = F.lane;
    const int pg = F.ptab[sb * NPG + (tk0 >> 7)], j0 = tk0 & 127;
    const float* nsa = F.cnsa + ((size_t)pg * PAGE + j0) * 512;
    const float* dsa = F.cdsa + ((size_t)pg * PAGE + j0) * 256;
    const float* idx = F.cidx + ((size_t)pg * PAGE + j0) * 64;
#pragma unroll
    for (int g = 0; g < 2; ++g) {
        const size_t bg = (size_t)sb * 2 + g;
        cp_k16(nsa + (0 * 2 + g) * 64, 512, WSP(bf16, WS_SCMPK) + (bg * LS + tk0) * 64, lane);
        cp_k16(nsa + (1 * 2 + g) * 64, 512, WSP(bf16, WS_SCMPV) + (bg * LS + tk0) * 64, lane);
        cp_k16(nsa + (2 * 2 + g) * 64, 512, WSP(bf16, WS_SSLCK) + (bg * LS + tk0) * 64, lane);
        cp_vt16(nsa + (3 * 2 + g) * 64, 512, WSP(bf16, WS_SSLCVT) + bg * 64 * LS + tk0, LS, lane);
        cp_k16(dsa + (0 * 2 + g) * 64, 256, WSP(bf16, WS_SDSAK) + (bg * LS + tk0) * 64, lane);
        cp_vt16(dsa + (1 * 2 + g) * 64, 256, WSP(bf16, WS_SDSAVT) + bg * 64 * LS + tk0, LS, lane);
    }
    cp_k16(idx, 64, WSP(bf16, WS_SIDXK) + ((size_t)sb * LS + tk0) * 64, lane);
}
DI void p0_win_item(Frame& F, int item) {
    const int sb = item >> 5, w0 = (item & 31) * 16, lane = F.lane;
    const float* st = F.swin + ((size_t)sb * 512 + w0) * 256;
#pragma unroll
    for (int g = 0; g < 2; ++g) {
        const size_t bg = (size_t)sb * 2 + g;
        cp_k16(st + (0 * 2 + g) * 64, 256, WSP(bf16, WS_SWINK) + (bg * LSW + w0) * 64, lane);
        cp_vt16(st + (1 * 2 + g) * 64, 256, WSP(bf16, WS_SWINVT) + bg * 64 * LSW + w0, LSW, lane);
    }
}
DI void p0_zero_item(Frame& F, int item) {
    const int arr = item >> 8, bg = item & 255, lane = F.lane;
    bf16* p; int n;
    if (arr == 0) { p = WSP(bf16, WS_SSLCVT) + ((size_t)bg * 64 + lane) * LS + 2052; n = 60; }
    else if (arr == 1) { p = WSP(bf16, WS_SDSAVT) + ((size_t)bg * 64 + lane) * LS + 2052; n = 60; }
    else { p = WSP(bf16, WS_SWINVT) + ((size_t)bg * 64 + lane) * LSW + 516; n = 60; }
    unsigned long long* q = (unsigned long long*)p;
    for (int i = 0; i < n / 4; ++i) q[i] = 0ull;
}
DI void p0_prologue(Frame& F, int um) {
    if (um & 1) p0_mod(F);
    LAS float* scr = (LAS float*)(F.lds + F.wave * 16384);
    const int gw = blockIdx.x * NWAVES + F.wave, NGW = F.G * NWAVES;
    constexpr int I_WIN = 16 * 171, I_UP = 8 * 32, I_OUT = 16 * 32, I_W1 = 32 * 4;
    constexpr int T0 = I_WIN, T1 = T0 + I_UP, T2 = T1 + I_UP, T3 = T2 + I_OUT, T4 = T3 + 2 * I_W1, T5 = T4 + 2050, T6 = T5 + 512, T7 = T6 + 768, T8 = T7 + SBATCH * 32, T9 = T8 + SBATCH * 128;
#ifdef ORACLE
    constexpr int TEND = T9;
#else
    constexpr int TEND = T7;
#endif
    if (um & 2) for (int it = gw; it < TEND; it += NGW) {
        if (it < T0) p0_transpose_item<true>(F.win, 1024, 5468, WSP(bf16, WS_WINT), scr, it, F.lane);
        else if (it < T1) p0_transpose_item<false>(F.wupn, 512, 1024, WSP(bf16, WS_WUPN), scr, it - T0, F.lane);
        else if (it < T2) p0_transpose_item<false>(F.wupd, 512, 1024, WSP(bf16, WS_WUPD), scr, it - T1, F.lane);
        else if (it < T3) p0_transpose_item<false>(F.wout, 1024, 1024, WSP(bf16, WS_WOUT), scr, it - T2, F.lane);
        else if (it < T4) { const int q = it - T3, slot = q / I_W1; p0_transpose_item<false>(F.w1 + (size_t)slot * 2048 * 128, 2048, 128, WSP(bf16, WS_W1T) + (size_t)slot * 128 * 2048, scr, q % I_W1, F.lane); }
        else if (it < T5) p0_rope_item(F, it - T4);
        else if (it < T6) p0_cmp_small_item(F, it - T5);
        else if (it < T7) p0_zero_item(F, it - T6);
#ifdef ORACLE
        else if (it < T8) p0_win_item(F, it - T7);
        else p0_gather_item(F, it - T8);
#endif
    }
    constexpr int ROW4 = 508 * 64;
    const f32x4* src = (const f32x4*)F.swin; f32x4* dst = (f32x4*)(F.out + O_WINS);
    if (um & 4) for (int it = blockIdx.x; it < 2 * SBATCH; it += F.G) {
        const int sb = it >> 1, h0 = (it & 1) * (ROW4 / 2);
        const f32x4* sp = src + (size_t)sb * 512 * 64 + 4 * 64 + h0; f32x4* dp = dst + (size_t)sb * 512 * 64 + h0;
        for (int i = F.tid; i < ROW4 / 2; i += 512 * 8) {
            f32x4 v[8];
#pragma unroll
            for (int j = 0; j < 8; ++j) { const int k = i + j * 512; v[j] = k < ROW4 / 2 ? __builtin_nontemporal_load(sp + k) : (f32x4){0.f, 0.f, 0.f, 0.f}; }
#pragma unroll
            for (int j = 0; j < 8; ++j) { const int k = i + j * 512; if (k < ROW4 / 2) __builtin_nontemporal_store(v[j], dp + k); }
        }
    }
}
DI void p1_adaln(Frame& F) {
    const int gw = blockIdx.x * NWAVES + F.wave, NGW = F.G * NWAVES;
    if (blockIdx.x == 0 && F.tid < 256) { float a = 0.f; for (int j = 0; j < 64; ++j) a += WSP(float, WS_BIASP)[j * 256 + F.tid]; WSP(float, WS_BIAS1)[F.tid] = a; }
    const float* mod = WSP(float, WS_MOD);
    for (int r = gw; r < MR; r += NGW) {
        const float* xr = r < MP ? F.xp + (size_t)r * 1024 : F.xs + (size_t)(r - MP) * 1024;
        const int mrow = r < MP ? (r >> 12) : 4 + ((r - MP) >> 2);
        const f32x4* x4 = (const f32x4*)xr + F.lane;
        f32x4 v[4]; float s = 0.f;
#pragma unroll
        for (int j = 0; j < 4; ++j) { v[j] = x4[64 * j]; s += (v[j][0] * v[j][0] + v[j][1] * v[j][1]) + (v[j][2] * v[j][2] + v[j][3] * v[j][3]); }
        const float rstd = 1.f / sqrtf(wave_sum(s) * (1.f / 1024.f) + 1e-6f);
        const f32x4* g4 = (const f32x4*)F.normg + F.lane;
        const f32x4* sh4 = (const f32x4*)(mod + (size_t)mrow * 3072) + F.lane;
        const f32x4* sc4 = (const f32x4*)(mod + (size_t)mrow * 3072 + 1024) + F.lane;
        unsigned long long* o8 = (unsigned long long*)(WSP(bf16, WS_H) + (size_t)r * 1024) + F.lane;
#pragma unroll
        for (int j = 0; j < 4; ++j) {
            const f32x4 y = v[j] * rstd * g4[64 * j]; const f32x4 h = y * (1.f + sc4[64 * j]) + sh4[64 * j];
            o8[64 * j] = (unsigned long long)pk2(h[0], h[1]) | ((unsigned long long)pk2(h[2], h[3]) << 32);
        }
    }
}
DI void p8_final(Frame& F) {
    const int gw = blockIdx.x * NWAVES + F.wave, NGW = F.G * NWAVES;
    for (int r = gw; r < MR; r += NGW) {
        float* yr = r < MP ? F.out + O_YP + (size_t)r * 1024 : F.out + O_YS + (size_t)(r - MP) * 1024;
        f32x4* y4 = (f32x4*)yr + F.lane;
        f32x4 v[4]; float s = 0.f;
#pragma unroll
        for (int j = 0; j < 4; ++j) { v[j] = y4[64 * j]; s += (v[j][0] * v[j][0] + v[j][1] * v[j][1]) + (v[j][2] * v[j][2] + v[j][3] * v[j][3]); }
        const float rstd = 1.f / sqrtf(wave_sum(s) * (1.f / 1024.f) + 1e-6f);
        const f32x4* g4 = (const f32x4*)F.fing + F.lane;
#pragma unroll
        for (int j = 0; j < 4; ++j) y4[64 * j] = v[j] * rstd * g4[64 * j];
    }
}

constexpr int TP = 144;
constexpr int TILE_B = 64 * TP;
struct LdsT {
    static constexpr bool HOIST = true;
    const LAS unsigned char* p;
    DI bf16x8 frag(int mt, int s) const { return *(const LAS bf16x8*)(p + mt * 32 * TP + s * 32); }
};
struct GlbT {
    static constexpr bool HOIST = false;
    const bf16* base; unsigned off; unsigned pitch;
    DI bf16x8 frag(int mt, int s) const { return *(const bf16x8*)(base + (size_t)(off + (unsigned)mt * 32u * pitch + (unsigned)s * 16u)); }
};
template <class KT> DI void qk_tile(f32x16& s0, f32x16& s1, const KT& kt, const bf16x8 (&q)[4]) {
    f32x16 z;
#pragma unroll
    for (int i = 0; i < 16; ++i) z[i] = 0.f;
    s0 = z; s1 = z;
#pragma unroll
    for (int s = 0; s < 4; ++s) { s0 = MFMA32(kt.frag(0, s), q[s], s0); s1 = MFMA32(kt.frag(1, s), q[s], s1); }
}
DI bf16x8 cvt8(f32x4 a, f32x4 b) { u32x4 w; w.x = pk2(a[0], a[1]); w.y = pk2(a[2], a[3]); w.z = pk2(b[0], b[1]); w.w = pk2(b[2], b[3]); return __builtin_bit_cast(bf16x8, w); }
DI bf16x8 pack_p(const f32x16& x, int h) {
    u32x4 w; w.x = pk2(x[8 * h], x[8 * h + 1]); w.y = pk2(x[8 * h + 2], x[8 * h + 3]); w.z = pk2(x[8 * h + 4], x[8 * h + 5]); w.w = pk2(x[8 * h + 6], x[8 * h + 7]);
    return __builtin_bit_cast(bf16x8, w);
}
template <class VT> DI void pv_tile(f32x16& o0, f32x16& o1, const f32x16& p0, const f32x16& p1, const VT& vt) {
    const bf16x8 b0 = pack_p(p0, 0), b1 = pack_p(p0, 1), b2 = pack_p(p1, 0), b3 = pack_p(p1, 1);
    o0 = MFMA32(vt.frag(0, 0), b0, o0); o1 = MFMA32(vt.frag(1, 0), b0, o1);
    o0 = MFMA32(vt.frag(0, 1), b1, o0); o1 = MFMA32(vt.frag(1, 1), b1, o1);
    o0 = MFMA32(vt.frag(0, 2), b2, o0); o1 = MFMA32(vt.frag(1, 2), b2, o1);
    o0 = MFMA32(vt.frag(0, 3), b3, o0); o1 = MFMA32(vt.frag(1, 3), b3, o1);
}
struct Soft { float m, l; bool seen; f32x16 o0, o1, negm; };
DI void soft_init(Soft& S) {
    S.m = 0.f; S.l = 0.f; S.seen = false;
#pragma unroll
    for (int i = 0; i < 16; ++i) { S.o0[i] = 0.f; S.o1[i] = 0.f; S.negm[i] = 0.f; }
}
template <class KT> DI void qk_tile_c(f32x16& s0, f32x16& s1, const KT& kt, const bf16x8 (&q)[4], const f32x16& c) {
    if constexpr (KT::HOIST) {
        bf16x8 f[8];
#pragma unroll
        for (int s = 0; s < 4; ++s) { f[2 * s] = kt.frag(0, s); f[2 * s + 1] = kt.frag(1, s); }
        __builtin_amdgcn_sched_barrier(0);
        s0 = MFMA32(f[0], q[0], c); s1 = MFMA32(f[1], q[0], c);
#pragma unroll
        for (int s = 1; s < 4; ++s) { s0 = MFMA32(f[2 * s], q[s], s0); s1 = MFMA32(f[2 * s + 1], q[s], s1); }
    } else {
        s0 = MFMA32(kt.frag(0, 0), q[0], c); s1 = MFMA32(kt.frag(1, 0), q[0], c);
#pragma unroll
        for (int s = 1; s < 4; ++s) { s0 = MFMA32(kt.frag(0, s), q[s], s0); s1 = MFMA32(kt.frag(1, s), q[s], s1); }
    }
    asm volatile("s_nop 15\n\ts_nop 7" : "+v"(s0), "+v"(s1));
}
DI float max3f(float a, float b, float c) { float r; asm("v_max3_f32 %0, %1, %2, %3" : "=v"(r) : "v"(a), "v"(b), "v"(c)); return r; }
template <class VT> DI void soft_step(Soft& S, f32x16& s0, f32x16& s1, const VT& vt) {
    bf16x8 vf[8];
    if constexpr (VT::HOIST) {
#pragma unroll
        for (int s = 0; s < 4; ++s) { vf[2 * s] = vt.frag(0, s); vf[2 * s + 1] = vt.frag(1, s); }
        __builtin_amdgcn_sched_barrier(0);
    }
    float mx = max3f(s0[0], s1[0], s0[1]), my = max3f(s1[1], s0[2], s1[2]);
#pragma unroll
    for (int r = 3; r < 15; r += 2) { mx = max3f(mx, s0[r], s1[r]); my = max3f(my, s0[r + 1], s1[r + 1]); }
    mx = max3f(mx, s0[15], s1[15]); mx = max3f(mx, my, mx);
    mx = max3f(mx, half_other(mx), mx);
    const bool fin = mx > NEGINF;
    const bool need = (mx > 8.f) | (fin & !S.seen);
    if (__any(need)) {
        const float dl = need ? mx : 0.f;
        const float al = S.seen ? __builtin_amdgcn_exp2f(-dl) : 0.f;
        S.m += dl; S.l *= need ? al : 1.f;
        const float am = need ? al : 1.f;
#pragma unroll
        for (int r = 0; r < 16; ++r) { s0[r] -= dl; s1[r] -= dl; S.o0[r] *= am; S.o1[r] *= am; S.negm[r] = -S.m; }
    }
    S.seen = S.seen | fin;
    float ps = 0.f;
#pragma unroll
    for (int r = 0; r < 16; ++r) { s0[r] = __builtin_amdgcn_exp2f(s0[r]); s1[r] = __builtin_amdgcn_exp2f(s1[r]); ps += s0[r] + s1[r]; }
    S.l += ps;
    const bf16x8 b0 = pack_p(s0, 0), b1 = pack_p(s0, 1), b2 = pack_p(s1, 0), b3 = pack_p(s1, 1);
    if constexpr (!VT::HOIST) {
#pragma unroll
        for (int s = 0; s < 4; ++s) { vf[2 * s] = vt.frag(0, s); vf[2 * s + 1] = vt.frag(1, s); }
    }
    S.o0 = MFMA32(vf[0], b0, S.o0); S.o1 = MFMA32(vf[1], b0, S.o1);
    S.o0 = MFMA32(vf[2], b1, S.o0); S.o1 = MFMA32(vf[3], b1, S.o1);
    S.o0 = MFMA32(vf[4], b2, S.o0); S.o1 = MFMA32(vf[5], b2, S.o1);
    S.o0 = MFMA32(vf[6], b3, S.o0); S.o1 = MFMA32(vf[7], b3, S.o1);
}
DI float as_f(int x) { return __int_as_float(x); }
DI float mask_sel(float s, int mm) { return __int_as_float((__float_as_int(s) & mm) | ((int)0xff800000 & ~mm)); }
DI u32x4 tile_ld(const bf16* g, size_t pitch, int tid) { return *(const u32x4*)(g + (size_t)(tid >> 3) * pitch + (tid & 7) * 8); }
DI void tile_st(LAS unsigned char* buf, u32x4 v, int tid) { *(LAS u32x4*)(buf + (tid >> 3) * TP + (tid & 7) * 16) = v; }

constexpr int CP = 272;
DI void compress_unit(Frame& F, int u) {
    const int tid = F.tid, lane = F.lane, w = F.wave, l31 = lane & 31, hi = lane >> 5;
    const int slot = u / 136, rem = u % 136;
    const bf16* data; bf16 *ock, *ocvt; int n0, ncmp, cpitch;
    if (rem < 8) { const int bg = rem; data = WSP(bf16, (slot ? WS_PCMPV : WS_PCMPK)) + (size_t)bg * SEQ * 64; n0 = 32 * w; ncmp = 255; cpitch = 256;
        ock = WSP(bf16, WS_PCK) + (size_t)bg * 256 * 64; ocvt = WSP(bf16, WS_PCVT) + (size_t)bg * 64 * 256; }
    else { const int bg = 2 * (rem - 8) + (w >> 2); data = WSP(bf16, (slot ? WS_SCMPV : WS_SCMPK)) + (size_t)bg * LS * 64; n0 = 32 * (w & 3); ncmp = 127; cpitch = 128;
        ock = WSP(bf16, WS_SCK) + (size_t)bg * 128 * 64; ocvt = WSP(bf16, WS_SCVT) + (size_t)bg * 64 * 128; }
    const int n = n0 + l31, nc = n < ncmp ? n : ncmp - 1;
    const bf16* drow = data + (size_t)nc * 1024 + 8 * hi;
    const bool paged = rem >= 8;
    const float *prA = nullptr, *prB = nullptr; int jsplit = 64;
    if (paged) { const int bg = 2 * (rem - 8) + (w >> 2), sb = bg >> 1, g = bg & 1, t0 = 16 * nc;
        const int pgA = F.ptab[sb * NPG + (t0 >> 7)], pgB = F.ptab[sb * NPG + ((t0 + 31) >> 7)];
        jsplit = 128 - (t0 & 127);
        prA = F.cnsa + ((size_t)pgA * PAGE + (t0 & 127)) * 512 + (slot * 2 + g) * 64 + 8 * hi;
        prB = F.cnsa + ((size_t)pgB * PAGE) * 512 + (slot * 2 + g) * 64 + 8 * hi - (size_t)jsplit * 512;
    }
    const bf16* w1t = WSP(bf16, WS_W1T) + (size_t)slot * 128 * 2048;
    f32x16 acc[4];
#pragma unroll
    for (int c = 0; c < 4; ++c)
#pragma unroll
        for (int i = 0; i < 16; ++i) acc[c][i] = 0.f;
    const bf16* wsrc = w1t + (size_t)(tid >> 2) * 2048 + ((tid & 3) >> 1) * 1024 + (tid & 1) * 32;
    LAS unsigned char* wdst = F.lds + (tid >> 2) * CP + (tid & 3) * 64;
    u32x4 st[4];
#pragma unroll
    for (int i = 0; i < 4; ++i) st[i] = ((const u32x4*)wsrc)[i];
#pragma unroll
    for (int i = 0; i < 4; ++i) ((LAS u32x4*)wdst)[i] = st[i];
    LDS_BARRIER();
    f32x4 raw[16];
#define CMP_ISSUE(kc_) do { if (!paged) { _Pragma("unroll") for (int s_ = 0; s_ < 8; ++s_) raw[2 * s_] = __builtin_bit_cast(f32x4, *(const bf16x8*)(drow + ((kc_) + 16 * (s_ >> 2)) * 64 + (s_ & 3) * 16)); } \
        else { _Pragma("unroll") for (int s_ = 0; s_ < 8; ++s_) { const int j_ = (kc_) + 16 * (s_ >> 2); const f32x4* q_ = (const f32x4*)((j_ < jsplit ? prA : prB) + (size_t)j_ * 512 + 16 * (s_ & 3)); raw[2 * s_] = q_[0]; raw[2 * s_ + 1] = q_[1]; } } } while (0)
    CMP_ISSUE(0);
    for (int kc = 0; kc < 16; ++kc) {
        const LAS unsigned char* buf = F.lds + (kc & 1) * (128 * CP);
        if (kc + 1 < 16) {
#pragma unroll
            for (int i = 0; i < 4; ++i) st[i] = ((const u32x4*)(wsrc + (kc + 1) * 64))[i];
        }
        bf16x8 bq[8];
        if (!paged) {
#pragma unroll
            for (int s = 0; s < 8; ++s) bq[s] = __builtin_bit_cast(bf16x8, raw[2 * s]);
        } else {
#pragma unroll
            for (int s = 0; s < 8; ++s) bq[s] = cvt8(raw[2 * s], raw[2 * s + 1]);
        }
        if (kc + 1 < 16) CMP_ISSUE(kc + 1);
#pragma unroll
        for (int s = 0; s < 8; ++s)
#pragma unroll
            for (int c = 0; c < 4; ++c) acc[c] = MFMA32(*(const LAS bf16x8*)(buf + (32 * c + l31) * CP + s * 32 + hi * 16), bq[s], acc[c]);
        if (kc + 1 < 16) {
            LAS unsigned char* nb = wdst + ((kc + 1) & 1) * (128 * CP);
#pragma unroll
            for (int i = 0; i < 4; ++i) ((LAS u32x4*)nb)[i] = st[i];
        }
        LDS_BARRIER();
    }
#undef CMP_ISSUE
    const float* b1 = WSP(float, WS_BIAS1) + slot * 128;
#pragma unroll
    for (int c = 0; c < 4; ++c)
#pragma unroll
        for (int q = 0; q < 4; ++q) { const f32x4 bv = *(const f32x4*)(b1 + 32 * c + 8 * q + 4 * hi);
#pragma unroll
            for (int j = 0; j < 4; ++j) acc[c][4 * q + j] = silu_f(acc[c][4 * q + j] + bv[j]); }
    const bf16* w2t = WSP(bf16, WS_W2T) + (size_t)slot * 64 * 128 + (size_t)l31 * 128 + 8 * hi;
    f32x16 o0, o1;
#pragma unroll
    for (int i = 0; i < 16; ++i) { o0[i] = 0.f; o1[i] = 0.f; }
#pragma unroll
    for (int c = 0; c < 4; ++c)
#pragma unroll
        for (int h = 0; h < 2; ++h) { const bf16x8 hb = pack_p(acc[c], h); const int s2 = 2 * c + h;
            o0 = MFMA32(*(const bf16x8*)(w2t + s2 * 16), hb, o0); o1 = MFMA32(*(const bf16x8*)(w2t + 32 * 128 + s2 * 16), hb, o1); }
    const bool ok = n < ncmp;
    if (slot == 0) {
#pragma unroll
        for (int e = 0; e < 2; ++e)
#pragma unroll
            for (int q = 0; q < 4; ++q) { const f32x16& o = e ? o1 : o0; u32x2 wv;
                wv.x = ok ? pk2(o[4 * q], o[4 * q + 1]) : 0u; wv.y = ok ? pk2(o[4 * q + 2], o[4 * q + 3]) : 0u;
                *(u32x2*)(ock + (size_t)n * 64 + 32 * e + 8 * q + 4 * hi) = wv; }
    } else {
        const int pn = permk(n);
#pragma unroll
        for (int e = 0; e < 2; ++e)
#pragma unroll
            for (int r = 0; r < 16; ++r) { const f32x16& o = e ? o1 : o0; ocvt[(size_t)(32 * e + crow(r, hi)) * cpitch + pn] = ok ? (bf16)(pk2(o[r], 0.f) & 0xffffu) : (bf16)0; }
    }
}

template <int NR, int ABL> DI void idx_select(const LAS int* scw, int n, int lane, unsigned long long* out) {
    int k[NR];
    int kmin = 0x7fffffff, kmax = (int)0x80000000;
#pragma unroll
    for (int i = 0; i < NR; ++i) { const bool v = 64 * i + lane < n; const int x = v ? scw[64 * i + lane] : (int)0x80000000; k[i] = x; kmin = v ? (x < kmin ? x : kmin) : kmin; kmax = x > kmax ? x : kmax; }
    int thr = (int)0x80000000, cut = -1;
    if (n > 256 && !(ABL & 1)) {
#pragma unroll
        for (int o = 1; o < 64; o <<= 1) { const int a = __shfl_xor(kmin, o), b = __shfl_xor(kmax, o); kmin = a < kmin ? a : kmin; kmax = b > kmax ? b : kmax; }
        int lo = __builtin_amdgcn_readfirstlane(kmin) - 1, hiv = __builtin_amdgcn_readfirstlane(kmax);
        bool found = false;
        while ((unsigned)hiv - (unsigned)lo > 1u) {
            const int mid = (int)((unsigned)lo + (((unsigned)hiv - (unsigned)lo) >> 1));
            int c = 0;
#pragma unroll
            for (int i0 = 0; i0 < NR; i0 += 8) {
                unsigned long long bm[8];
#pragma unroll
                for (int j = 0; j < 8; ++j) bm[j] = __ballot(k[i0 + j] > mid);
#pragma unroll
                for (int j = 0; j < 8; ++j) c += __popcll(bm[j]);
            }
            if (c == 256) { thr = mid; found = true; break; }
            if (c > 256) lo = mid; else hiv = mid;
        }
        if (!found) {
            thr = hiv; int cgt = 0;
#pragma unroll
            for (int i = 0; i < NR; ++i) cgt += __popcll(__ballot(k[i] > thr));
            const int need = 256 - cgt; int acc = 0; bool done = false;
#pragma unroll
            for (int i = 0; i < NR; ++i) {
                unsigned long long mk = __ballot(k[i] == thr); const int pc = __popcll(mk);
                if (!done && acc + pc >= need) { for (int q2 = 1; q2 < need - acc; ++q2) mk &= mk - 1; cut = 64 * i + (int)__builtin_ctzll(mk); done = true; }
                acc += pc;
            }
        }
    }
    unsigned long long myw = 0ull;
    if (ABL & 4) { myw = (unsigned long long)(k[0] + k[NR - 1] + kmin + kmax); } else
#pragma unroll
    for (int i = 0; i < NR; ++i) { const unsigned long long mk = __ballot((k[i] > thr) | ((k[i] == thr) & (64 * i + lane <= cut))); myw = (lane == i) ? mk : myw; }
    out[lane] = myw;
}
template <bool SAMPLE, int ABL> DI void idx1_unit(Frame& F, int u) {
    const int lane = F.lane, w = F.wave, l31 = lane & 31, hi = lane >> 5, tl = l31 >> 2, hl = l31 & 3;
    int row0, nkmax, ntok; const bf16* ik;
    if (!SAMPLE) { const int b = u & 3, tc = 511 - (u >> 2); row0 = b * SEQ + 8 * tc; nkmax = 8 * tc + 8; ntok = 8; ik = WSP(bf16, WS_PIDXK) + (size_t)b * SEQ * 64; }
    else { row0 = MP + 4 * u; nkmax = PASTL + 4; ntok = 4; ik = WSP(bf16, WS_SIDXK) + (size_t)u * LS * 64; }
    const int rowq = row0 + (SAMPLE ? (tl & 3) : tl);
    bf16x8 q[4];
#pragma unroll
    for (int s = 0; s < 4; ++s) q[s] = *(const bf16x8*)(WSP(bf16, WS_IQ) + (size_t)rowq * 256 + hl * 64 + 16 * s + 8 * hi);
    f32x4 wq[4];
#pragma unroll
    for (int qq = 0; qq < 4; ++qq) { const int tk = 2 * qq + hi; wq[qq] = *(const f32x4*)(WSP(float, WS_IW) + (size_t)(row0 + (SAMPLE ? (tk & 3) : tk)) * 4); }
    PIN4(q); PIN4(wq);
    LAS int* sc = (LAS int*)F.lds;
    const int n32 = (nkmax + 31) >> 5;
    u32x4 rA[8], rB[8];
    asm volatile("s_waitcnt vmcnt(0)" ::: "memory");
#define IDX_ISSUE(R, kt_) do { const int kk_ = (kt_) < n32 ? (kt_) : n32 - 1; \
        if (SAMPLE) { if (kk_ < 64) { const int pg = F.ptab[u * NPG + (kk_ >> 2)]; const float* fp = F.cidx + ((size_t)pg * PAGE + (kk_ & 3) * 32 + l31) * 64 + 8 * hi; \
              _Pragma("unroll") for (int s_ = 0; s_ < 4; ++s_) { R[2 * s_] = gload16(fp + 16 * s_); R[2 * s_ + 1] = gload16(fp + 16 * s_ + 4); } } \
            else { const bf16* kp = ik + (size_t)(32 * kk_ + l31) * 64 + 8 * hi; \
              _Pragma("unroll") for (int s_ = 0; s_ < 4; ++s_) { R[2 * s_] = gload16(kp + 16 * s_); R[2 * s_ + 1] = gload16(kp + 16 * s_); } } } \
        else { const bf16* kp = ik + (size_t)(32 * kk_ + l31) * 64 + 8 * hi; \
            _Pragma("unroll") for (int s_ = 0; s_ < 4; ++s_) R[2 * s_] = gload16(kp + 16 * s_); } } while (0)
#define IDX_WAIT(R) do { if (SAMPLE) asm volatile("s_waitcnt vmcnt(8)" : "+v"(R[0]), "+v"(R[1]), "+v"(R[2]), "+v"(R[3]), "+v"(R[4]), "+v"(R[5]), "+v"(R[6]), "+v"(R[7]) :: "memory"); \
        else asm volatile("s_waitcnt vmcnt(4)" : "+v"(R[0]), "+v"(R[2]), "+v"(R[4]), "+v"(R[6]) :: "memory"); } while (0)
#define IDX_SCORE(R, kt_) do { IDX_WAIT(R); if ((kt_) < n32) { bf16x8 kf[4]; \
        if (SAMPLE && (kt_) < 64) { _Pragma("unroll") for (int s_ = 0; s_ < 4; ++s_) kf[s_] = cvt8(__builtin_bit_cast(f32x4, R[2 * s_]), __builtin_bit_cast(f32x4, R[2 * s_ + 1])); } \
        else { _Pragma("unroll") for (int s_ = 0; s_ < 4; ++s_) kf[s_] = __builtin_bit_cast(bf16x8, R[2 * s_]); } \
        f32x16 a; _Pragma("unroll") for (int i_ = 0; i_ < 16; ++i_) a[i_] = 0.f; \
        _Pragma("unroll") for (int s_ = 0; s_ < 4; ++s_) a = MFMA32(q[s_], kf[s_], a); \
        _Pragma("unroll") for (int qq = 0; qq < 4; ++qq) { \
            float v = fmaxf(a[4 * qq], 0.f) * wq[qq][0] + fmaxf(a[4 * qq + 1], 0.f) * wq[qq][1] + fmaxf(a[4 * qq + 2], 0.f) * wq[qq][2] + fmaxf(a[4 * qq + 3], 0.f) * wq[qq][3]; \
            int uu = __float_as_int(v); uu = (uu == (int)0x80000000) ? 0 : uu; \
            sc[(2 * qq + hi) * 4096 + 32 * (kt_) + l31] = uu ^ ((uu >> 31) & 0x7fffffff); } } } while (0)
    if (!(ABL & 2)) {
        IDX_ISSUE(rA, w); IDX_ISSUE(rB, w + NWAVES);
        for (int kt = w; kt < n32; kt += 2 * NWAVES) {
            IDX_SCORE(rA, kt); IDX_ISSUE(rA, kt + 2 * NWAVES);
            IDX_SCORE(rB, kt + NWAVES); IDX_ISSUE(rB, kt + 3 * NWAVES);
        }
        asm volatile("s_waitcnt vmcnt(0)" : "+v"(rA[0]), "+v"(rA[2]), "+v"(rA[4]), "+v"(rA[6]), "+v"(rB[0]), "+v"(rB[2]), "+v"(rB[4]), "+v"(rB[6]) :: "memory");
        if (SAMPLE) asm volatile("" : "+v"(rA[1]), "+v"(rA[3]), "+v"(rA[5]), "+v"(rA[7]), "+v"(rB[1]), "+v"(rB[3]), "+v"(rB[5]), "+v"(rB[7]));
    }
#undef IDX_ISSUE
#undef IDX_WAIT
#undef IDX_SCORE
    __syncthreads();
    if (w < ntok && !(ABL & 8)) {
        const int n = SAMPLE ? (PASTL + 1 + w) : (row0 - (row0 & ~(SEQ - 1)) + w + 1);
        unsigned long long* out = WSP(unsigned long long, ABL ? WS_T1 : WS_SELM) + (size_t)(row0 + w) * 64;
        const LAS int* scw = sc + w * 4096;
        if (n <= 1024) idx_select<16, ABL>(scw, n, lane, out);
        else if (n <= 2048) idx_select<32, ABL>(scw, n, lane, out);
        else if (n <= 3072) idx_select<48, ABL>(scw, n, lane, out);
        else idx_select<64, ABL>(scw, n, lane, out);
    }
    __syncthreads();
}


constexpr int NSA_PS = 2 * 2 * TILE_B;
constexpr int NSA_WS = 8192 + 2048 + 64;
template <bool SAMPLE> DI void nsa_unit(Frame& F, int u) {
    const int tid = F.tid, lane = F.lane, w = F.wave, l31 = lane & 31, hi = lane >> 5, tl = l31 >> 2, hl = l31 & 3;
    int bg, g, row, qpos, ncmp, wlo, whi, n_ctile, n_stile, w_t0, w_t1, qt = 0;
    size_t cpitch, pitch, wpitch; const bf16 *ck, *cvt, *sk, *svt, *wk, *wvt; bool wr_ok;
    if (!SAMPLE) {
        bg = u & 7; qt = 63 - (u >> 3); g = bg & 1; const int t = 64 * qt + 8 * w + tl; row = (bg >> 1) * SEQ + t; qpos = t; ncmp = 255;
        cpitch = 256; pitch = SEQ; wpitch = SEQ;
        ck = WSP(bf16, WS_PCK) + (size_t)bg * 256 * 64; cvt = WSP(bf16, WS_PCVT) + (size_t)bg * 64 * 256;
        sk = WSP(bf16, WS_PSLCK) + (size_t)bg * SEQ * 64; svt = WSP(bf16, WS_PSLCVT) + (size_t)bg * 64 * SEQ;
        wk = WSP(bf16, WS_PWINK) + (size_t)bg * SEQ * 64; wvt = WSP(bf16, WS_PWINVT) + (size_t)bg * 64 * SEQ;
        wlo = qpos - 511; whi = qpos; n_ctile = (4 * qt + 2) / 64 + 1; n_stile = qt + 1; w_t0 = qt > 8 ? qt - 8 : 0; w_t1 = qt; wr_ok = true;
    } else {
        bg = u * 8 + w; g = bg & 1; const int i = tl & 3; row = MP + (bg >> 1) * 4 + i; qpos = PASTL + i; ncmp = 127;
        cpitch = 128; pitch = LS; wpitch = LSW;
        ck = WSP(bf16, WS_SCK) + (size_t)bg * 128 * 64; cvt = WSP(bf16, WS_SCVT) + (size_t)bg * 64 * 128;
        sk = WSP(bf16, WS_SSLCK) + (size_t)bg * LS * 64; svt = WSP(bf16, WS_SSLCVT) + (size_t)bg * 64 * LS;
        wk = WSP(bf16, WS_SWINK) + (size_t)bg * LSW * 64; wvt = WSP(bf16, WS_SWINVT) + (size_t)bg * 64 * LSW;
        wlo = 1 + i; whi = 512 + i; n_ctile = 2; n_stile = 33; w_t0 = 0; w_t1 = 8; wr_ok = tl < 4;
    }
    const int hq = 4 * g + hl;
    bf16x8 qraw[4], qrot[4];
#pragma unroll
    for (int s = 0; s < 4; ++s) qraw[s] = *(const bf16x8*)(WSP(bf16, WS_QRAW) + (size_t)row * 512 + hq * 64 + 16 * s + 8 * hi);
    LAS unsigned char* const lb = F.lds;
    LAS float* psum = (LAS float*)(lb + NSA_PS + w * NSA_WS);
    LAS float* impb = (LAS float*)(lb + NSA_PS + w * NSA_WS + 8192);
    LAS unsigned char* selb = lb + NSA_PS + w * NSA_WS + 8192 + 2048;
    const int fo = l31 * TP + hi * 16;
    const float* gp = WSP(float, WS_GATES) + (size_t)row * 24 + hq * 3;
    float g0 = gp[0], g1 = gp[1], g2 = gp[2];
    PIN4(qraw); asm volatile("" : "+v"(g0), "+v"(g1), "+v"(g2));
    f32x16 s0, s1;
    u32x4 rk, rv;
    Soft S;

    const int nvr = (qpos - 31) >> 4, nvis = nvr < ncmp - 1 ? nvr : ncmp - 1;
    float m = -1e30f, l = 0.f;
    if (!SAMPLE) { rk = tile_ld(ck, 64, tid); rv = tile_ld(cvt, cpitch, tid); tile_st(lb, rk, tid); tile_st(lb + TILE_B, rv, tid); LDS_BARRIER(); }
    for (int ct = 0; ct < n_ctile; ++ct) {
        if (!SAMPLE) { if (ct + 1 < n_ctile) { rk = tile_ld(ck + (size_t)(ct + 1) * 64 * 64, 64, tid); rv = tile_ld(cvt + (ct + 1) * 64, cpitch, tid); } }
        if (!SAMPLE) { LdsT kt{lb + (ct & 1) * 2 * TILE_B + fo}; qk_tile(s0, s1, kt, qraw); }
        else { GlbT kt{ck, (unsigned)((64 * ct + l31) * 64 + 8 * hi), 64u}; qk_tile(s0, s1, kt, qraw); }
        float mx = -1e30f;
        const int nv2 = nvis - 64 * ct - 4 * hi;
#pragma unroll
        for (int r = 0; r < 16; ++r) { const int cr = (r & 3) + 8 * (r >> 2); s0[r] = cr <= nv2 ? s0[r] : NEGINF; s1[r] = cr + 32 <= nv2 ? s1[r] : NEGINF; mx = fmaxf(mx, fmaxf(s0[r], s1[r])); }
        mx = fmaxf(mx, half_other(mx));
        const float mn = fmaxf(m, mx); float ps = 0.f;
#pragma unroll
        for (int r = 0; r < 16; ++r) ps += __builtin_amdgcn_exp2f(s0[r] - mn) + __builtin_amdgcn_exp2f(s1[r] - mn);
        l = l * __builtin_amdgcn_exp2f(m - mn) + ps; m = mn;
        if (!SAMPLE) { if (ct + 1 < n_ctile) { tile_st(lb + ((ct + 1) & 1) * 2 * TILE_B, rk, tid); tile_st(lb + ((ct + 1) & 1) * 2 * TILE_B + TILE_B, rv, tid); } LDS_BARRIER(); }
    }
    l += half_other(l);
    const float linv = l > 0.f ? 1.f / l : 0.f;
    soft_init(S);
    if (!SAMPLE) { rk = tile_ld(ck, 64, tid); rv = tile_ld(cvt, cpitch, tid); tile_st(lb, rk, tid); tile_st(lb + TILE_B, rv, tid); LDS_BARRIER(); }
    for (int ct = 0; ct < n_ctile; ++ct) {
        if (!SAMPLE) { if (ct + 1 < n_ctile) { rk = tile_ld(ck + (size_t)(ct + 1) * 64 * 64, 64, tid); rv = tile_ld(cvt + (ct + 1) * 64, cpitch, tid); } }
        if (!SAMPLE) { LdsT kt{lb + (ct & 1) * 2 * TILE_B + fo}; qk_tile(s0, s1, kt, qraw); }
        else { GlbT kt{ck, (unsigned)((64 * ct + l31) * 64 + 8 * hi), 64u}; qk_tile(s0, s1, kt, qraw); }
        const int nv2 = nvis - 64 * ct - 4 * hi; LAS float* pw = psum + tl * 256 + 64 * ct + 4 * hi;
#pragma unroll
        for (int r = 0; r < 16; ++r) { const int cr = (r & 3) + 8 * (r >> 2);
            s0[r] = cr <= nv2 ? __builtin_amdgcn_exp2f(s0[r] - m) * linv : 0.f; s1[r] = cr + 32 <= nv2 ? __builtin_amdgcn_exp2f(s1[r] - m) * linv : 0.f;
            float a = s0[r]; a += dpp_x1(a); a += dpp_x2(a); float b = s1[r]; b += dpp_x1(b); b += dpp_x2(b);
            if (hl == 0) { pw[cr] = a; pw[cr + 32] = b; } }
        if (!SAMPLE) { LdsT vt{lb + (ct & 1) * 2 * TILE_B + TILE_B + fo}; pv_tile(S.o0, S.o1, s0, s1, vt); }
        else { GlbT vt{cvt, (unsigned)(l31 * (int)cpitch + 64 * ct + 8 * hi), (unsigned)cpitch}; pv_tile(S.o0, S.o1, s0, s1, vt); }
        if (!SAMPLE) { if (ct + 1 < n_ctile) { tile_st(lb + ((ct + 1) & 1) * 2 * TILE_B, rk, tid); tile_st(lb + ((ct + 1) & 1) * 2 * TILE_B + TILE_B, rv, tid); } LDS_BARRIER(); }
    }
    LDS_WAIT();
    unsigned mlo, mhi;
    {
        const int tk = lane >> 3, jb = 8 * (lane & 7);
        const int qp = SAMPLE ? PASTL + (tk & 3) : 64 * qt + 8 * w + tk, cur = qp >> 6;
        float pv[33];
        const LAS f32x4* pp = (const LAS f32x4*)(psum + tk * 256 + 4 * jb);
#pragma unroll
        for (int i = 0; i < 8; ++i) { const f32x4 x = pp[i]; pv[1 + 4 * i] = x[0]; pv[2 + 4 * i] = x[1]; pv[3 + 4 * i] = x[2]; pv[4 + 4 * i] = x[3]; }
        pv[0] = jb > 0 ? psum[tk * 256 + 4 * jb - 1] : 0.f;
        float v[8];
#pragma unroll
        for (int jj = 0; jj < 8; ++jj) {
            const int j = jb + jj;
            float a = pv[4 * jj] + pv[4 * jj + 1] + pv[4 * jj + 2] + pv[4 * jj + 3];
            a += (4 * j + 3 < ncmp) ? pv[4 * jj + 4] : 0.f;
            a = ((j == 0) | (j == cur) | (j == cur - 1)) ? 1e4f : a;
            a = (j > cur) ? -1e30f : a;
            v[jj] = a;
        }
        LAS f32x4* ip = (LAS f32x4*)(impb + tk * 64 + jb);
        ip[0] = (f32x4){v[0], v[1], v[2], v[3]}; ip[1] = (f32x4){v[4], v[5], v[6], v[7]};
        LDS_WAIT();
        int cnt[8];
#pragma unroll
        for (int jj = 0; jj < 8; ++jj) cnt[jj] = 0;
        const LAS f32x4* ap = (const LAS f32x4*)(impb + tk * 64);
#pragma unroll 1
        for (int i4 = 0; i4 < 16; ++i4) {
            const f32x4 x = ap[i4];
#pragma unroll
            for (int e = 0; e < 4; ++e) { const int i = 4 * i4 + e; const float xi = x[e];
#pragma unroll
                for (int jj = 0; jj < 8; ++jj) cnt[jj] += ((xi > v[jj]) | ((xi == v[jj]) & (i < jb + jj))) ? 1 : 0; }
        }
        unsigned bits = 0;
#pragma unroll
        for (int jj = 0; jj < 8; ++jj) bits |= ((cnt[jj] < 16) & (jb + jj <= cur)) ? (1u << jj) : 0u;
        selb[tk * 8 + (lane & 7)] = (unsigned char)bits;
        LDS_WAIT();
        const LAS unsigned* sp = (const LAS unsigned*)(selb + tl * 8);
        mlo = sp[0]; mhi = sp[1];
    }
    LAS float* park = psum + lane;
#pragma unroll
    for (int i = 0; i < 16; ++i) { park[i * 64] = g0 * S.o0[i]; park[(16 + i) * 64] = g0 * S.o1[i]; }
#pragma unroll
    for (int s = 0; s < 4; ++s) qrot[s] = *(const bf16x8*)(WSP(bf16, WS_QROT) + (size_t)row * 512 + hq * 64 + 16 * s + 8 * hi);
    PIN4(qrot);
    soft_init(S);
    const int qrel = (qpos & 63) - 4 * hi;
    if (!SAMPLE) { rk = tile_ld(sk, 64, tid); rv = tile_ld(svt, pitch, tid); tile_st(lb, rk, tid); tile_st(lb + TILE_B, rv, tid); LDS_BARRIER(); }
    for (int j = 0; j < n_stile; ++j) {
        if (!SAMPLE) { if (j + 1 < n_stile) { rk = tile_ld(sk + (size_t)(j + 1) * 64 * 64, 64, tid); rv = tile_ld(svt + (j + 1) * 64, pitch, tid); } }
        const bool bsel = ((j < 32 ? (mlo >> j) : (mhi >> (j - 32))) & 1u) != 0u;
        if (!SAMPLE) { LdsT kt{lb + (j & 1) * 2 * TILE_B + fo}; qk_tile_c(s0, s1, kt, qrot, S.negm); }
        else { GlbT kt{sk, (unsigned)((64 * j + l31) * 64 + 8 * hi), 64u}; qk_tile_c(s0, s1, kt, qrot, S.negm); }
        if (j == n_stile - 1) {
#pragma unroll
            for (int r = 0; r < 16; ++r) { const int cr = (r & 3) + 8 * (r >> 2); s0[r] = cr <= qrel ? s0[r] : NEGINF; s1[r] = cr + 32 <= qrel ? s1[r] : NEGINF; }
        } else {
#pragma unroll
            for (int r = 0; r < 16; ++r) { s0[r] = bsel ? s0[r] : NEGINF; s1[r] = bsel ? s1[r] : NEGINF; }
        }
        if (!SAMPLE) { LdsT vt{lb + (j & 1) * 2 * TILE_B + TILE_B + fo}; soft_step(S, s0, s1, vt); }
        else { GlbT vt{svt, (unsigned)(l31 * (int)pitch + 64 * j + 8 * hi), (unsigned)pitch}; soft_step(S, s0, s1, vt); }
        if (!SAMPLE) { if (j + 1 < n_stile) { tile_st(lb + ((j + 1) & 1) * 2 * TILE_B, rk, tid); tile_st(lb + ((j + 1) & 1) * 2 * TILE_B + TILE_B, rv, tid); } LDS_BARRIER(); }
    }
    S.l += half_other(S.l);
    { const float sc = g1 / fmaxf(S.l, 1e-30f);
#pragma unroll
      for (int i = 0; i < 16; ++i) { park[i * 64] += sc * S.o0[i]; park[(16 + i) * 64] += sc * S.o1[i]; } }
    soft_init(S);
    if (!SAMPLE) { rk = tile_ld(wk + (size_t)w_t0 * 64 * 64, 64, tid); rv = tile_ld(wvt + w_t0 * 64, wpitch, tid); tile_st(lb, rk, tid); tile_st(lb + TILE_B, rv, tid); LDS_BARRIER(); }
    for (int j = w_t0; j <= w_t1; ++j) {
        const int jr = j - w_t0;
        if (!SAMPLE) { if (j + 1 <= w_t1) { rk = tile_ld(wk + (size_t)(j + 1) * 64 * 64, 64, tid); rv = tile_ld(wvt + (j + 1) * 64, wpitch, tid); } }
        if (!SAMPLE) { LdsT kt{lb + (jr & 1) * 2 * TILE_B + fo}; qk_tile_c(s0, s1, kt, qrot, S.negm); }
        else { GlbT kt{wk, (unsigned)((64 * j + l31) * 64 + 8 * hi), 64u}; qk_tile_c(s0, s1, kt, qrot, S.negm); }
        if ((j == w_t0) | (j == w_t1)) {
            const int lo_r = wlo - 64 * j - 4 * hi, hi_r = whi - 64 * j - 4 * hi;
#pragma unroll
            for (int r = 0; r < 16; ++r) { const int k0 = (r & 3) + 8 * (r >> 2); s0[r] = ((k0 >= lo_r) & (k0 <= hi_r)) ? s0[r] : NEGINF; s1[r] = ((k0 + 32 >= lo_r) & (k0 + 32 <= hi_r)) ? s1[r] : NEGINF; }
        }
        if (!SAMPLE) { LdsT vt{lb + (jr & 1) * 2 * TILE_B + TILE_B + fo}; soft_step(S, s0, s1, vt); }
        else { GlbT vt{wvt, (unsigned)(l31 * (int)wpitch + 64 * j + 8 * hi), (unsigned)wpitch}; soft_step(S, s0, s1, vt); }
        if (!SAMPLE) { if (j + 1 <= w_t1) { tile_st(lb + ((jr + 1) & 1) * 2 * TILE_B, rk, tid); tile_st(lb + ((jr + 1) & 1) * 2 * TILE_B + TILE_B, rv, tid); } LDS_BARRIER(); }
    }
    S.l += half_other(S.l);
#ifdef BREAK_WIN
    S.l *= 1.1f;
#endif
    f32x16 res0, res1;
    { const float sc = g2 / fmaxf(S.l, 1e-30f);
#pragma unroll
      for (int i = 0; i < 16; ++i) { res0[i] = park[i * 64] + sc * S.o0[i]; res1[i] = park[(16 + i) * 64] + sc * S.o1[i]; } }
    if (wr_ok) {
        const bf16* zp = WSP(bf16, WS_ZN) + (size_t)row * 512 + hq * 64 + 4 * hi;
        bf16* op = WSP(bf16, WS_ONZ) + (size_t)row * 512 + hq * 64 + 4 * hi;
#pragma unroll
        for (int e = 0; e < 2; ++e)
#pragma unroll
            for (int q = 0; q < 4; ++q) { const f32x16& o = e ? res1 : res0; const u32x2 z = *(const u32x2*)(zp + 32 * e + 8 * q);
                u32x2 wv; wv.x = pk2(o[4 * q] * bflo(z.x), o[4 * q + 1] * bfhi(z.x)); wv.y = pk2(o[4 * q + 2] * bflo(z.y), o[4 * q + 3] * bfhi(z.y));
                *(u32x2*)(op + 32 * e + 8 * q) = wv; }
    }
}

template <int ABL, class VT> DI void soft_step2(Soft& S, f32x16& s0, f32x16& s1, f32x16& sn0, f32x16& sn1, const VT& vt) {
    bf16x8 vf[8];
#pragma unroll
    for (int s = 0; s < 4; ++s) { vf[2 * s] = vt.frag(0, s); vf[2 * s + 1] = vt.frag(1, s); }
    if (!(ABL & 1)) {
    float mx = max3f(s0[0], s1[0], s0[1]), my = max3f(s1[1], s0[2], s1[2]);
#pragma unroll
    for (int r = 3; r < 15; r += 2) { mx = max3f(mx, s0[r], s1[r]); my = max3f(my, s0[r + 1], s1[r + 1]); }
    mx = max3f(mx, s0[15], s1[15]); mx = max3f(mx, my, mx);
    mx = max3f(mx, half_other(mx), mx);
    const bool fin = mx > NEGINF;
    const bool need = (mx > 8.f) | (fin & !S.seen);
    if (__any(need)) {
        const float dl = need ? mx : 0.f;
        const float al = S.seen ? __builtin_amdgcn_exp2f(-dl) : 0.f;
        S.m += dl; S.l *= need ? al : 1.f;
        const float am = need ? al : 1.f;
#pragma unroll
        for (int r = 0; r < 16; ++r) { s0[r] -= dl; s1[r] -= dl; sn0[r] -= dl; sn1[r] -= dl; S.o0[r] *= am; S.o1[r] *= am; S.negm[r] = -S.m; }
    }
    S.seen = S.seen | fin;
    float ps = 0.f;
#pragma unroll
    for (int r = 0; r < 16; ++r) { s0[r] = __builtin_amdgcn_exp2f(s0[r]); s1[r] = __builtin_amdgcn_exp2f(s1[r]); ps += s0[r] + s1[r]; }
    S.l += ps;
    }
    const bf16x8 b0 = pack_p(s0, 0), b1 = pack_p(s0, 1), b2 = pack_p(s1, 0), b3 = pack_p(s1, 1);
    if (!(ABL & 4)) {
    S.o0 = MFMA32(vf[0], b0, S.o0); S.o1 = MFMA32(vf[1], b0, S.o1);
    S.o0 = MFMA32(vf[2], b1, S.o0); S.o1 = MFMA32(vf[3], b1, S.o1);
    S.o0 = MFMA32(vf[4], b2, S.o0); S.o1 = MFMA32(vf[5], b2, S.o1);
    S.o0 = MFMA32(vf[6], b3, S.o0); S.o1 = MFMA32(vf[7], b3, S.o1);
    } else { S.o0[0] += __builtin_bit_cast(f32x4, b0)[0] + __builtin_bit_cast(f32x4, b1)[0] + __builtin_bit_cast(f32x4, b2)[0] + __builtin_bit_cast(f32x4, b3)[0] + __builtin_bit_cast(f32x4, vf[0])[0] + __builtin_bit_cast(f32x4, vf[7])[1]; }
}
template <int ABL> DI void dsa_unit(Frame& F, int u) {
    const int tid = F.tid, lane = F.lane, w = F.wave, l31 = lane & 31, hi = lane >> 5, tl = l31 >> 2, hl = l31 & 3;
    const int bg = u & 7, qt = 63 - (u >> 3), g = bg & 1, t = 64 * qt + 8 * w + tl, row = (bg >> 1) * SEQ + t, nt = qt + 1;
    const bf16* dk = WSP(bf16, WS_PDSAK) + (size_t)bg * SEQ * 64; const bf16* dvt = WSP(bf16, WS_PDSAVT) + (size_t)bg * 64 * SEQ;
    const int hq = 4 * g + hl;
    bf16x8 dq[4];
#pragma unroll
    for (int s = 0; s < 4; ++s) dq[s] = *(const bf16x8*)(WSP(bf16, WS_DQ) + (size_t)row * 512 + hq * 64 + 16 * s + 8 * hi);
    const unsigned long long* selp = WSP(unsigned long long, WS_SELM) + (size_t)row * 64;
    unsigned long long selA = selp[0], selB = selp[nt > 1 ? 1 : 0];
    PIN4(dq); asm volatile("" : "+v"(selA), "+v"(selB));
    LAS unsigned char* const lb = F.lds;
    const int fo = l31 * TP + hi * 16;
    f32x16 sc0, sc1, sn0, sn1;
    u32x4 rkA, rvA, rkB, rvB;
    Soft S; soft_init(S);
    const int ntm = nt - 1;
    const bf16* kpc = dk + (size_t)(tid >> 3) * 64 + (tid & 7) * 8; const bf16* vpc = dvt + (size_t)(tid >> 3) * SEQ + (tid & 7) * 8;
#define KADDR(jt) (kpc + (size_t)((jt) < ntm ? (jt) : ntm) * 64 * 64)
#define VADDR(jt) (vpc + ((jt) < ntm ? (jt) : ntm) * 64)
    { const u32x4 a = tile_ld(dk, 64, tid), b = tile_ld(dvt, SEQ, tid), c = *(const u32x4*)KADDR(1); tile_st(lb, a, tid); tile_st(lb + 2 * TILE_B, b, tid); tile_st(lb + TILE_B, c, tid); }
    asm volatile("s_waitcnt vmcnt(0)" : "+v"(selA), "+v"(selB) :: "memory");
    selA = gload8(selp); selB = gload8(selp + (nt > 1 ? 1 : 0));
    rkA = gload16(KADDR(2)); rvA = gload16(VADDR(1));
    LDS_BARRIER();
    { LdsT kt{lb + fo}; qk_tile_c(sc0, sc1, kt, dq, S.negm); }
#define DSA_STEP(j, CK, CV, NK, NV, SELC) do { \
        NK = gload16(KADDR((j) + 3)); NV = gload16(VADDR((j) + 2)); \
        if ((j) + 1 < nt) { LdsT kt{lb + (((j) + 1) & 1) * TILE_B + fo}; if (!(ABL & 2)) qk_tile_c(sn0, sn1, kt, dq, S.negm); else { sn0 = S.negm; sn1 = S.negm; sn0[0] += __builtin_bit_cast(f32x4, kt.frag(0, 0))[0]; } } \
        WAITV1(5, SELC);                                                     \
        { const unsigned wa = (unsigned)SELC >> (4 * hi), wb = (unsigned)(SELC >> 32) >> (4 * hi); \
          SELC = gload8(selp + ((j) + 2 < nt ? (j) + 2 : ntm)); \
          _Pragma("unroll") for (int r = 0; r < 16; ++r) { const int bp = (r & 3) + 8 * (r >> 2); \
            sc0[r] = mask_sel(sc0[r], (int)(wa << (31 - bp)) >> 31); sc1[r] = mask_sel(sc1[r], (int)(wb << (31 - bp)) >> 31); } } \
        { LdsT vt{lb + (2 + ((j) & 1)) * TILE_B + fo}; soft_step2<ABL>(S, sc0, sc1, sn0, sn1, vt); } \
        sc0 = sn0; sc1 = sn1; \
        WAITV2(3, CK, CV);                                                   \
        if (!(ABL & 8)) { tile_st(lb + ((j) & 1) * TILE_B, CK, tid); tile_st(lb + (2 + (((j) + 1) & 1)) * TILE_B, CV, tid); } \
        if (!(ABL & 16)) LDS_BARRIER(); } while (0)
    for (int j = 0; j < nt; j += 2) { DSA_STEP(j, rkA, rvA, rkB, rvB, selA); if (j + 1 < nt) DSA_STEP(j + 1, rkB, rvB, rkA, rvA, selB); }
    asm volatile("s_waitcnt vmcnt(0)" : "+v"(rkA), "+v"(rvA), "+v"(rkB), "+v"(rvB), "+v"(selA), "+v"(selB) :: "memory");
#undef DSA_STEP
#undef KADDR
#undef VADDR
    S.l += half_other(S.l);
    {
        const float sc = 1.f / fmaxf(S.l, 1e-30f);
        const bf16* zp = WSP(bf16, WS_ZD) + (size_t)row * 512 + hq * 64 + 4 * hi;
        bf16* op = WSP(bf16, ABL ? WS_T1 : WS_ODZ) + (size_t)row * 512 + hq * 64 + 4 * hi;
#pragma unroll
        for (int e = 0; e < 2; ++e)
#pragma unroll
            for (int q = 0; q < 4; ++q) { const f32x16& o = e ? S.o1 : S.o0; const u32x2 z = *(const u32x2*)(zp + 32 * e + 8 * q);
                u32x2 wv; wv.x = pk2(o[4 * q] * sc * bflo(z.x), o[4 * q + 1] * sc * bfhi(z.x)); wv.y = pk2(o[4 * q + 2] * sc * bflo(z.y), o[4 * q + 3] * sc * bfhi(z.y));
                *(u32x2*)(op + 32 * e + 8 * q) = wv; }
    }
}


struct PageK {
    static constexpr bool HOIST = false;
    const float* p; unsigned stride;
    DI bf16x8 frag(int mt, int s) const { const f32x4* q = (const f32x4*)(p + (size_t)((unsigned)mt * 32u * stride + (unsigned)s * 16u)); return cvt8(q[0], q[1]); }
};
struct PageV {
    static constexpr bool HOIST = false;
    const float* p; unsigned stride;
    DI bf16x8 frag(int dt, int s) const {
        float v[8];
#pragma unroll
        for (int i = 0; i < 8; ++i) v[i] = p[(size_t)((unsigned)(16 * s + (i & 3) + 8 * (i >> 2)) * stride + (unsigned)dt * 32u)];
        return __builtin_bit_cast(bf16x8, pack8(v));
    }
};
constexpr int XCH_W = 34 * 64;
constexpr int XCH_BYTES = 8 * XCH_W * 4;
DI void xch_put(LAS float* x, const Soft& S, int lane) {
    const float lt = S.l + half_other(S.l);
    x[lane] = S.seen ? S.m : NEGINF; x[64 + lane] = lt;
#pragma unroll
    for (int r = 0; r < 16; ++r) { x[(2 + r) * 64 + lane] = S.o0[r]; x[(18 + r) * 64 + lane] = S.o1[r]; }
}
DI void xch_get(const LAS float* xb, int w, int lane, float (&out)[4]) {
    float mw[8], M = -1e30f;
#pragma unroll
    for (int i = 0; i < 8; ++i) { mw[i] = xb[i * XCH_W + lane]; M = fmaxf(M, mw[i]); }
    float L = 0.f, o[4] = {0.f, 0.f, 0.f, 0.f};
#pragma unroll
    for (int i = 0; i < 8; ++i) { const float wt = __builtin_amdgcn_exp2f(mw[i] - M); L += wt * xb[i * XCH_W + 64 + lane];
#pragma unroll
        for (int k = 0; k < 4; ++k) o[k] += wt * xb[i * XCH_W + (2 + 4 * w + k) * 64 + lane]; }
    const float inv = 1.f / fmaxf(L, 1e-30f);
#pragma unroll
    for (int k = 0; k < 4; ++k) out[k] = o[k] * inv;
}
DI void nsa_sample_unit(Frame& F, int bg) {
    const int lane = F.lane, w = F.wave, l31 = lane & 31, hi = lane >> 5, tl = l31 >> 2, hl = l31 & 3;
    const int sb = bg >> 1, g = bg & 1, i = tl & 3, row = MP + sb * 4 + i, qpos = PASTL + i, hq = 4 * g + hl;
    LAS unsigned char* const lb = F.lds;
    LAS float* xch = (LAS float*)lb;
    LAS float* cmpb = (LAS float*)(lb + XCH_BYTES);
    LAS unsigned* mskb = (LAS unsigned*)(lb + XCH_BYTES + 8192);
    LAS float* psum = (LAS float*)(lb + XCH_BYTES + 8192 + 64);
    LAS float* impb = psum + 8 * 256;
    LAS unsigned char* selb = (LAS unsigned char*)(impb + 8 * 64);
    const float* gp = WSP(float, WS_GATES) + (size_t)row * 24 + hq * 3;
    float g0 = gp[0], g1 = gp[1], g2 = gp[2];
    bf16x8 qrot[4];
#pragma unroll
    for (int s = 0; s < 4; ++s) qrot[s] = *(const bf16x8*)(WSP(bf16, WS_QROT) + (size_t)row * 512 + hq * 64 + 16 * s + 8 * hi);
    f32x16 s0, s1;
    Soft S;
    __syncthreads();
    if (w == 0) {
        const bf16* ck = WSP(bf16, WS_SCK) + (size_t)bg * 128 * 64; const bf16* cvt = WSP(bf16, WS_SCVT) + (size_t)bg * 64 * 128;
        bf16x8 qraw[4];
#pragma unroll
        for (int s = 0; s < 4; ++s) qraw[s] = *(const bf16x8*)(WSP(bf16, WS_QRAW) + (size_t)row * 512 + hq * 64 + 16 * s + 8 * hi);
        const int ncmp = 127, nvis = 126;
        float m = -1e30f, l = 0.f;
        for (int ct = 0; ct < 2; ++ct) {
            GlbT kt{ck, (unsigned)((64 * ct + l31) * 64 + 8 * hi), 64u}; qk_tile(s0, s1, kt, qraw);
            float mx = -1e30f; const int nv2 = nvis - 64 * ct - 4 * hi;
#pragma unroll
            for (int r = 0; r < 16; ++r) { const int cr = (r & 3) + 8 * (r >> 2); s0[r] = cr <= nv2 ? s0[r] : NEGINF; s1[r] = cr + 32 <= nv2 ? s1[r] : NEGINF; mx = fmaxf(mx, fmaxf(s0[r], s1[r])); }
            mx = fmaxf(mx, half_other(mx));
            const float mn = fmaxf(m, mx); float ps = 0.f;
#pragma unroll
            for (int r = 0; r < 16; ++r) ps += __builtin_amdgcn_exp2f(s0[r] - mn) + __builtin_amdgcn_exp2f(s1[r] - mn);
            l = l * __builtin_amdgcn_exp2f(m - mn) + ps; m = mn;
        }
        l += half_other(l);
        const float linv = l > 0.f ? 1.f / l : 0.f;
        soft_init(S);
        for (int ct = 0; ct < 2; ++ct) {
            GlbT kt{ck, (unsigned)((64 * ct + l31) * 64 + 8 * hi), 64u}; qk_tile(s0, s1, kt, qraw);
            const int nv2 = nvis - 64 * ct - 4 * hi; LAS float* pw = psum + tl * 256 + 64 * ct + 4 * hi;
#pragma unroll
            for (int r = 0; r < 16; ++r) { const int cr = (r & 3) + 8 * (r >> 2);
                s0[r] = cr <= nv2 ? __builtin_amdgcn_exp2f(s0[r] - m) * linv : 0.f; s1[r] = cr + 32 <= nv2 ? __builtin_amdgcn_exp2f(s1[r] - m) * linv : 0.f;
                float a = s0[r]; a += dpp_x1(a); a += dpp_x2(a); float b = s1[r]; b += dpp_x1(b); b += dpp_x2(b);
                if (hl == 0) { pw[cr] = a; pw[cr + 32] = b; } }
            GlbT vt{cvt, (unsigned)(l31 * 128 + 64 * ct + 8 * hi), 128u}; pv_tile(S.o0, S.o1, s0, s1, vt);
        }
#pragma unroll
        for (int r = 0; r < 16; ++r) { cmpb[r * 64 + lane] = S.o0[r]; cmpb[(16 + r) * 64 + lane] = S.o1[r]; }
        LDS_WAIT();
        {
            const int tk = lane >> 3, jb = 8 * (lane & 7), cur = 32;
            float pv[33];
            const LAS f32x4* pp = (const LAS f32x4*)(psum + tk * 256 + 4 * jb);
#pragma unroll
            for (int q = 0; q < 8; ++q) { const f32x4 x = pp[q]; pv[1 + 4 * q] = x[0]; pv[2 + 4 * q] = x[1]; pv[3 + 4 * q] = x[2]; pv[4 + 4 * q] = x[3]; }
            pv[0] = jb > 0 ? psum[tk * 256 + 4 * jb - 1] : 0.f;
            float v[8];
#pragma unroll
            for (int jj = 0; jj < 8; ++jj) { const int j = jb + jj;
                float a = pv[4 * jj] + pv[4 * jj + 1] + pv[4 * jj + 2] + pv[4 * jj + 3];
                a += (4 * j + 3 < ncmp) ? pv[4 * jj + 4] : 0.f;
                a = ((j == 0) | (j == cur) | (j == cur - 1)) ? 1e4f : a;
                a = (j > cur) ? -1e30f : a;
                v[jj] = a; }
            LAS f32x4* ip = (LAS f32x4*)(impb + tk * 64 + jb);
            ip[0] = (f32x4){v[0], v[1], v[2], v[3]}; ip[1] = (f32x4){v[4], v[5], v[6], v[7]};
            LDS_WAIT();
            int cnt[8];
#pragma unroll
            for (int jj = 0; jj < 8; ++jj) cnt[jj] = 0;
            const LAS f32x4* ap = (const LAS f32x4*)(impb + tk * 64);
#pragma unroll 1
            for (int i4 = 0; i4 < 16; ++i4) { const f32x4 x = ap[i4];
#pragma unroll
                for (int e = 0; e < 4; ++e) { const int ii = 4 * i4 + e; const float xi = x[e];
#pragma unroll
                    for (int jj = 0; jj < 8; ++jj) cnt[jj] += ((xi > v[jj]) | ((xi == v[jj]) & (ii < jb + jj))) ? 1 : 0; } }
            unsigned bits = 0;
#pragma unroll
            for (int jj = 0; jj < 8; ++jj) bits |= ((cnt[jj] < 16) & (jb + jj <= cur)) ? (1u << jj) : 0u;
            selb[tk * 8 + (lane & 7)] = (unsigned char)bits;
            LDS_WAIT();
            if (lane < 16) mskb[lane] = ((const LAS unsigned*)selb)[lane];
        }
    }
    __syncthreads();
    const unsigned mlo = mskb[tl * 2], mhi = mskb[tl * 2 + 1];
    PIN4(qrot); asm volatile("" : "+v"(g0), "+v"(g1), "+v"(g2));
    soft_init(S);
    for (int j = w; j < 32; j += NWAVES) {
        const int pg = F.ptab[sb * NPG + (j >> 1)];
        const float* base = F.cnsa + ((size_t)pg * PAGE + (j & 1) * 64) * 512 + (2 * 2 + g) * 64;
        PageK kt{base + (size_t)l31 * 512 + 8 * hi, 512u}; qk_tile_c(s0, s1, kt, qrot, S.negm);
        const bool bsel = ((mlo >> j) & 1u) != 0u;
#pragma unroll
        for (int r = 0; r < 16; ++r) { s0[r] = bsel ? s0[r] : NEGINF; s1[r] = bsel ? s1[r] : NEGINF; }
        PageV vt{base + 128 + (size_t)(4 * hi) * 512 + l31, 512u}; soft_step(S, s0, s1, vt);
    }
    if (w == 0) {
        const bf16* sk = WSP(bf16, WS_SSLCK) + (size_t)bg * LS * 64; const bf16* svt = WSP(bf16, WS_SSLCVT) + (size_t)bg * 64 * LS;
        GlbT kt{sk, (unsigned)((2048 + l31) * 64 + 8 * hi), 64u}; qk_tile_c(s0, s1, kt, qrot, S.negm);
        const int qrel = i - 4 * hi;
#pragma unroll
        for (int r = 0; r < 16; ++r) { const int cr = (r & 3) + 8 * (r >> 2); s0[r] = cr <= qrel ? s0[r] : NEGINF; s1[r] = cr + 32 <= qrel ? s1[r] : NEGINF; }
        GlbT vt{svt, (unsigned)(l31 * LS + 2048 + 8 * hi), (unsigned)LS}; soft_step(S, s0, s1, vt);
    }
    xch_put(xch + w * XCH_W, S, lane);
    __syncthreads();
    float acc[4], part[4];
    xch_get(xch, w, lane, part);
#pragma unroll
    for (int k = 0; k < 4; ++k) acc[k] = g1 * part[k] + g0 * cmpb[(4 * w + k) * 64 + lane];
    __syncthreads();
    soft_init(S);
    {
        const float* base = F.swin + ((size_t)sb * 512 + 64 * w) * 256 + g * 64;
        PageK kt{base + (size_t)l31 * 256 + 8 * hi, 256u}; qk_tile_c(s0, s1, kt, qrot, S.negm);
        if (w == 0) {
            const int lo_r = 1 + i - 4 * hi;
#pragma unroll
            for (int r = 0; r < 16; ++r) { const int k0 = (r & 3) + 8 * (r >> 2); s0[r] = k0 >= lo_r ? s0[r] : NEGINF; s1[r] = k0 + 32 >= lo_r ? s1[r] : NEGINF; }
        }
        PageV vt{base + 128 + (size_t)(4 * hi) * 256 + l31, 256u}; soft_step(S, s0, s1, vt);
    }
    if (w == 0) {
        const bf16* wk = WSP(bf16, WS_SWINK) + (size_t)bg * LSW * 64; const bf16* wvt = WSP(bf16, WS_SWINVT) + (size_t)bg * 64 * LSW;
        GlbT kt{wk, (unsigned)((512 + l31) * 64 + 8 * hi), 64u}; qk_tile_c(s0, s1, kt, qrot, S.negm);
        const int hi_r = i - 4 * hi;
#pragma unroll
        for (int r = 0; r < 16; ++r) { const int k0 = (r & 3) + 8 * (r >> 2); s0[r] = k0 <= hi_r ? s0[r] : NEGINF; s1[r] = k0 + 32 <= hi_r ? s1[r] : NEGINF; }
        GlbT vt{wvt, (unsigned)(l31 * LSW + 512 + 8 * hi), (unsigned)LSW}; soft_step(S, s0, s1, vt);
    }
    xch_put(xch + w * XCH_W, S, lane);
    __syncthreads();
    xch_get(xch, w, lane, part);
#ifdef BREAK_WIN
#pragma unroll
    for (int k = 0; k < 4; ++k) part[k] *= 0.9f;
#endif
    if (tl < 4) {
        const int d0 = 32 * (w >> 2) + 8 * (w & 3) + 4 * hi;
        const u32x2 z = *(const u32x2*)(WSP(bf16, WS_ZN) + (size_t)row * 512 + hq * 64 + d0);
        u32x2 wv; wv.x = pk2((acc[0] + g2 * part[0]) * bflo(z.x), (acc[1] + g2 * part[1]) * bfhi(z.x)); wv.y = pk2((acc[2] + g2 * part[2]) * bflo(z.y), (acc[3] + g2 * part[3]) * bfhi(z.y));
        *(u32x2*)(WSP(bf16, WS_ONZ) + (size_t)row * 512 + hq * 64 + d0) = wv;
    }
}
DI void dsa_sample_unit(Frame& F, int bg) {
    const int lane = F.lane, w = F.wave, l31 = lane & 31, hi = lane >> 5, tl = l31 >> 2, hl = l31 & 3;
    const int sb = bg >> 1, g = bg & 1, i = tl & 3, row = MP + sb * 4 + i, hq = 4 * g + hl;
    LAS float* xch = (LAS float*)F.lds;
    bf16x8 dq[4];
#pragma unroll
    for (int s = 0; s < 4; ++s) dq[s] = *(const bf16x8*)(WSP(bf16, WS_DQ) + (size_t)row * 512 + hq * 64 + 16 * s + 8 * hi);
    const unsigned long long* selp = WSP(unsigned long long, WS_SELM) + (size_t)row * 64;
    PIN4(dq);
    f32x16 s0, s1;
    Soft S; soft_init(S);
    for (int j = w; j < 32; j += NWAVES) {
        unsigned long long selw = selp[j];
        const int pg = F.ptab[sb * NPG + (j >> 1)];
        const float* base = F.cdsa + ((size_t)pg * PAGE + (j & 1) * 64) * 256 + g * 64;
        PageK kt{base + (size_t)l31 * 256 + 8 * hi, 256u}; qk_tile_c(s0, s1, kt, dq, S.negm);
#ifdef BREAK_DSA
        selw |= 0x1111111111111111ull;
#endif
        const unsigned wa = (unsigned)selw >> (4 * hi), wb = (unsigned)(selw >> 32) >> (4 * hi);
#pragma unroll
        for (int r = 0; r < 16; ++r) { const int bp = (r & 3) + 8 * (r >> 2);
            s0[r] = mask_sel(s0[r], (int)(wa << (31 - bp)) >> 31); s1[r] = mask_sel(s1[r], (int)(wb << (31 - bp)) >> 31); }
        PageV vt{base + 128 + (size_t)(4 * hi) * 256 + l31, 256u}; soft_step(S, s0, s1, vt);
    }
    if (w == 0) {
        const unsigned long long selw = selp[32];
        const bf16* dk = WSP(bf16, WS_SDSAK) + (size_t)bg * LS * 64; const bf16* dvt = WSP(bf16, WS_SDSAVT) + (size_t)bg * 64 * LS;
        GlbT kt{dk, (unsigned)((2048 + l31) * 64 + 8 * hi), 64u}; qk_tile_c(s0, s1, kt, dq, S.negm);
        const unsigned wa = (unsigned)selw >> (4 * hi), wb = (unsigned)(selw >> 32) >> (4 * hi);
#pragma unroll
        for (int r = 0; r < 16; ++r) { const int bp = (r & 3) + 8 * (r >> 2);
            s0[r] = mask_sel(s0[r], (int)(wa << (31 - bp)) >> 31); s1[r] = mask_sel(s1[r], (int)(wb << (31 - bp)) >> 31); }
        GlbT vt{dvt, (unsigned)(l31 * LS + 2048 + 8 * hi), (unsigned)LS}; soft_step(S, s0, s1, vt);
    }
    __syncthreads();
    xch_put(xch + w * XCH_W, S, lane);
    __syncthreads();
    float part[4];
    xch_get(xch, w, lane, part);
    if (tl < 4) {
        const int d0 = 32 * (w >> 2) + 8 * (w & 3) + 4 * hi;
        const u32x2 z = *(const u32x2*)(WSP(bf16, WS_ZD) + (size_t)row * 512 + hq * 64 + d0);
        u32x2 wv; wv.x = pk2(part[0] * bflo(z.x), part[1] * bfhi(z.x)); wv.y = pk2(part[2] * bflo(z.y), part[3] * bfhi(z.y));
        *(u32x2*)(WSP(bf16, WS_ODZ) + (size_t)row * 512 + hq * 64 + d0) = wv;
    }
}

template <class EF> DI void small_gemm(Frame& F, const bf16* A, const bf16* Bt, int K, const EF& ef) {
    const int lane = F.lane, w = F.wave, l31 = lane & 31, hi = lane >> 5;
    LAS float* red = (LAS float*)F.lds;
    for (int t = blockIdx.x; t < 256; t += F.G) {
        const int mt = t >> 5, nt = t & 31, kw = K >> 3, k0 = w * kw;
        const bf16* ap = A + (size_t)(MP + 64 * mt + l31) * K + k0 + 8 * hi;
        const bf16* bp = Bt + (size_t)(32 * nt + l31) * K + k0 + 8 * hi;
        f32x16 a0, a1;
#pragma unroll
        for (int i = 0; i < 16; ++i) { a0[i] = 0.f; a1[i] = 0.f; }
        for (int s = 0; s < kw; s += 16) {
            const bf16x8 b = *(const bf16x8*)(bp + s), x0 = *(const bf16x8*)(ap + s), x1 = *(const bf16x8*)(ap + (size_t)32 * K + s);
            a0 = MFMA32(x0, b, a0); a1 = MFMA32(x1, b, a1);
        }
        __syncthreads();
#pragma unroll
        for (int r = 0; r < 16; ++r) { red[(w * 32 + r) * 64 + lane] = a0[r]; red[(w * 32 + 16 + r) * 64 + lane] = a1[r]; }
        __syncthreads();
        const int m2 = w >> 2, q = w & 3;
#pragma unroll
        for (int j = 0; j < 4; ++j) {
            float v = 0.f;
#pragma unroll
            for (int i = 0; i < 8; ++i) v += red[(i * 32 + 16 * m2 + 4 * q + j) * 64 + lane];
            ef(MP + 64 * mt + 32 * m2 + 8 * q + 4 * hi + j, 32 * nt + l31, v);
        }
    }
    __syncthreads();
}

#ifdef ORACLE
constexpr size_t WS_ORC = 948 * MiB;
constexpr int ORC_ROWS = 128;
DI float blk_red(Frame& F, float v, bool ismax, LAS float* red) {
#pragma unroll
    for (int o = 1; o < 64; o <<= 1) { const float x = __shfl_xor(v, o); v = ismax ? fmaxf(v, x) : v + x; }
    __syncthreads();
    if (F.lane == 0) red[F.wave] = v;
    __syncthreads();
    float r = red[0];
    for (int i = 1; i < 8; ++i) r = ismax ? fmaxf(r, red[i]) : r + red[i];
    return r;
}
DI float dot64(const bf16* a, const bf16* b) { float s = 0.f; for (int d = 0; d < 64; ++d) s += bf2f(a[d]) * bf2f(b[d]); return s; }
DI void orc_softmax(Frame& F, LAS float* sc, LAS unsigned char* vf, int n, LAS float* red) {
    float mx = -3e38f;
    for (int k = F.tid; k < n; k += 512) if (vf[k]) mx = fmaxf(mx, sc[k]);
    mx = blk_red(F, mx, true, red);
    float sm = 0.f;
    for (int k = F.tid; k < n; k += 512) { const float p = vf[k] ? exp2f(sc[k] - mx) : 0.f; sc[k] = p; sm += p; }
    sm = blk_red(F, sm, false, red);
    const float inv = 1.f / fmaxf(sm, 1e-30f);
    for (int k = F.tid; k < n; k += 512) sc[k] *= inv;
    __syncthreads();
}
DI void oracle_row(Frame& F, int oi) {
    int row;
    if (oi < 96) { const int tl[24] = {0, 1, 30, 31, 32, 63, 64, 65, 127, 128, 255, 256, 257, 400, 511, 512, 513, 1000, 1023, 1024, 2047, 2500, 3583, 4095};
        int t = 0;
#pragma unroll
        for (int i = 0; i < 24; ++i) t = (oi % 24 == i) ? tl[i] : t;
        row = (oi / 24) * SEQ + t; }
    else { const int k = oi - 96; row = MP + (((k >> 2) * 37) % SBATCH) * 4 + (k & 3); }
    const bool samp = row >= MP;
    const int b = samp ? (row - MP) >> 2 : row >> 12, ti = samp ? (row & 3) : (row & 4095), qpos = samp ? PASTL + ti : ti;
    const int ncmp = samp ? 127 : 255; const size_t pitch = samp ? LS : SEQ, wpitch = samp ? LSW : SEQ, cpitch = samp ? 128 : 256;
    const int wlo = samp ? 1 + ti : (qpos - 511 > 0 ? qpos - 511 : 0), whi = samp ? 512 + ti : qpos;
    LAS float* sc = (LAS float*)F.lds;
    LAS float* s2 = sc + 4096;
    LAS float* psum = s2 + 4096;
    LAS float* imp = psum + 256;
    LAS float* resn = imp + 64;
    LAS float* resd = resn + 512;
    LAS float* red = resd + 512;
    LAS unsigned char* vf = (LAS unsigned char*)(red + 8);
    LAS unsigned char* selb = vf + 4096;
    const bf16* qraw = WSP(bf16, WS_QRAW) + (size_t)row * 512; const bf16* qrot = WSP(bf16, WS_QROT) + (size_t)row * 512;
    const bf16* dq = WSP(bf16, WS_DQ) + (size_t)row * 512; const bf16* iq = WSP(bf16, WS_IQ) + (size_t)row * 256;
    const float* gat = WSP(float, WS_GATES) + (size_t)row * 24; const float* iw = WSP(float, WS_IW) + (size_t)row * 4;
    const int nvr = (qpos - 31) >> 4, nvis = nvr < ncmp - 1 ? nvr : ncmp - 1, cur = qpos >> 6;
    for (int g = 0; g < 2; ++g) {
        const int bg = b * 2 + g;
        const bf16* ck = samp ? WSP(bf16, WS_SCK) + (size_t)bg * 128 * 64 : WSP(bf16, WS_PCK) + (size_t)bg * 256 * 64;
        const bf16* cvt = samp ? WSP(bf16, WS_SCVT) + (size_t)bg * 64 * 128 : WSP(bf16, WS_PCVT) + (size_t)bg * 64 * 256;
        const bf16* sk = samp ? WSP(bf16, WS_SSLCK) + (size_t)bg * LS * 64 : WSP(bf16, WS_PSLCK) + (size_t)bg * SEQ * 64;
        const bf16* svt = samp ? WSP(bf16, WS_SSLCVT) + (size_t)bg * 64 * LS : WSP(bf16, WS_PSLCVT) + (size_t)bg * 64 * SEQ;
        const bf16* wk = samp ? WSP(bf16, WS_SWINK) + (size_t)bg * LSW * 64 : WSP(bf16, WS_PWINK) + (size_t)bg * SEQ * 64;
        const bf16* wvt = samp ? WSP(bf16, WS_SWINVT) + (size_t)bg * 64 * LSW : WSP(bf16, WS_PWINVT) + (size_t)bg * 64 * SEQ;
        __syncthreads();
        if (F.tid < 256) psum[F.tid] = 0.f;
        for (int hl = 0; hl < 4; ++hl) {
            const int h = 4 * g + hl;
            __syncthreads();
            for (int n = F.tid; n < 256; n += 512) { const bool v = n <= nvis; vf[n] = v; sc[n] = v ? dot64(qraw + h * 64, ck + (size_t)n * 64) : 0.f; }
            __syncthreads();
            orc_softmax(F, sc, vf, 256, red);
            if (F.tid < 256) psum[F.tid] += sc[F.tid];
            if (F.tid < 64) { float a = 0.f; for (int n = 0; n <= nvis; ++n) a += sc[n] * bf2f(cvt[(size_t)F.tid * cpitch + permk(n)]); resn[h * 64 + F.tid] = gat[h * 3 + 0] * a; }
        }
        __syncthreads();
        if (F.tid < 64) { const int j = F.tid; float a = 0.f;
            for (int n = 4 * j - 1; n <= 4 * j + 3; ++n) if (n >= 0 && n < ncmp) a += psum[n];
            if (j == 0 || j == cur || j == cur - 1) a = 1e4f;
            if (j > cur) a = -1e30f;
            imp[j] = a; selb[j] = 0; }
        __syncthreads();
        if (F.tid == 0) { for (int k = 0; k < 16; ++k) { int best = -1; float bv = -3e38f; for (int j = 0; j < 64; ++j) if (!selb[j] && imp[j] > bv) { bv = imp[j]; best = j; }
                if (best >= 0) selb[best] = (bv > -5e29f) ? 1 : 2; }
            for (int j = 0; j < 64; ++j) selb[j] = selb[j] == 1 ? 1 : 0; }
        __syncthreads();
        for (int hl = 0; hl < 4; ++hl) {
            const int h = 4 * g + hl;
            __syncthreads();
            for (int k = F.tid; k <= qpos; k += 512) { const bool v = selb[k >> 6] != 0; vf[k] = v; sc[k] = v ? dot64(qrot + h * 64, sk + (size_t)k * 64) : 0.f; }
            __syncthreads();
            orc_softmax(F, sc, vf, qpos + 1, red);
            if (F.tid < 64) { float a = 0.f; for (int k = 0; k <= qpos; ++k) if (vf[k]) a += sc[k] * bf2f(svt[(size_t)F.tid * pitch + permk(k)]); resn[h * 64 + F.tid] += gat[h * 3 + 1] * a; }
            __syncthreads();
            for (int k = wlo + F.tid; k <= whi; k += 512) { vf[k - wlo] = 1; sc[k - wlo] = dot64(qrot + h * 64, wk + (size_t)k * 64); }
            __syncthreads();
            orc_softmax(F, sc, vf, whi - wlo + 1, red);
            if (F.tid < 64) { float a = 0.f; for (int k = wlo; k <= whi; ++k) a += sc[k - wlo] * bf2f(wvt[(size_t)F.tid * wpitch + permk(k)]); resn[h * 64 + F.tid] += gat[h * 3 + 2] * a; }
        }
    }
    __syncthreads();
    const bf16* ik = samp ? WSP(bf16, WS_SIDXK) + (size_t)b * LS * 64 : WSP(bf16, WS_PIDXK) + (size_t)b * SEQ * 64;
    for (int k = F.tid; k <= qpos; k += 512) { float a = 0.f; for (int h = 0; h < 4; ++h) a += fmaxf(dot64(iq + h * 64, ik + (size_t)k * 64), 0.f) * iw[h]; s2[k] = a; }
    __syncthreads();
    for (int k = F.tid; k <= qpos; k += 512) { const float v = s2[k]; int c = 0; for (int j = 0; j <= qpos; ++j) { const float x = s2[j]; c += (x > v || (x == v && j < k)) ? 1 : 0; } vf[k] = c < 256; }
    __syncthreads();
    for (int h = 0; h < 8; ++h) {
        const int bg = b * 2 + (h >> 2);
        const bf16* dk = samp ? WSP(bf16, WS_SDSAK) + (size_t)bg * LS * 64 : WSP(bf16, WS_PDSAK) + (size_t)bg * SEQ * 64;
        const bf16* dvt = samp ? WSP(bf16, WS_SDSAVT) + (size_t)bg * 64 * LS : WSP(bf16, WS_PDSAVT) + (size_t)bg * 64 * SEQ;
        __syncthreads();
        for (int k = F.tid; k <= qpos; k += 512) sc[k] = vf[k] ? dot64(dq + h * 64, dk + (size_t)k * 64) : 0.f;
        __syncthreads();
        orc_softmax(F, sc, vf, qpos + 1, red);
        if (F.tid < 64) { float a = 0.f; for (int k = 0; k <= qpos; ++k) if (vf[k]) a += sc[k] * bf2f(dvt[(size_t)F.tid * pitch + permk(k)]); resd[h * 64 + F.tid] = a; }
    }
    __syncthreads();
    float dn = 0.f, rn = 0.f, dd = 0.f, rd = 0.f;
    { const int e = F.tid;
      const float zn = bf2f(WSP(bf16, WS_ZN)[(size_t)row * 512 + e]), zd = bf2f(WSP(bf16, WS_ZD)[(size_t)row * 512 + e]);
      const float refn = resn[e] * zn, refd = resd[e] * zd;
      const float gotn = bf2f(WSP(bf16, WS_ONZ)[(size_t)row * 512 + e]), gotd = bf2f(WSP(bf16, WS_ODZ)[(size_t)row * 512 + e]);
      dn = (gotn - refn) * (gotn - refn); rn = refn * refn; dd = (gotd - refd) * (gotd - refd); rd = refd * refd; }
    dn = blk_red(F, dn, false, red); rn = blk_red(F, rn, false, red); dd = blk_red(F, dd, false, red); rd = blk_red(F, rd, false, red);
    float dc = 0.f, rc = 0.f;
    {
        const bool cs = oi >= 96; const int cbg = cs ? (oi * 5) % 256 : oi % 8, cn = cs ? (oi * 11) % 127 : (oi * 13) % 255;
        for (int slot = 0; slot < 2; ++slot) {
            const bf16* data = cs ? WSP(bf16, slot ? WS_SCMPV : WS_SCMPK) + (size_t)cbg * LS * 64 + (size_t)cn * 1024 : WSP(bf16, slot ? WS_PCMPV : WS_PCMPK) + (size_t)cbg * SEQ * 64 + (size_t)cn * 1024;
            __syncthreads();
            if (F.tid < 128) { float a = 0.f; for (int k = 0; k < 2048; ++k) a += (bf2f(data[k]) + F.pe[slot * 2048 + k]) * F.w1[((size_t)slot * 2048 + k) * 128 + F.tid]; sc[F.tid] = a / (1.f + expf(-a)); }
            __syncthreads();
            if (F.tid < 64) { float a = 0.f; for (int c = 0; c < 128; ++c) a += sc[c] * F.w2[((size_t)slot * 128 + c) * 64 + F.tid];
                float got;
                if (slot == 0) got = bf2f((cs ? WSP(bf16, WS_SCK) + (size_t)cbg * 128 * 64 : WSP(bf16, WS_PCK) + (size_t)cbg * 256 * 64)[(size_t)cn * 64 + F.tid]);
                else got = bf2f((cs ? WSP(bf16, WS_SCVT) + (size_t)cbg * 64 * 128 : WSP(bf16, WS_PCVT) + (size_t)cbg * 64 * 256)[(size_t)F.tid * (cs ? 128 : 256) + permk(cn)]);
                dc += (got - a) * (got - a); rc += a * a; }
        }
    }
    dc = blk_red(F, dc, false, red); rc = blk_red(F, rc, false, red);
    if (F.tid == 0) { float* o = WSP(float, WS_ORC) + oi * 8; o[0] = dn; o[1] = rn; o[2] = dd; o[3] = rd; o[4] = dc; o[5] = rc; }
    __syncthreads();
}
DI float oracle_value(Frame& F) {
    const float* o = WSP(float, WS_ORC);
    float bad = 0.f, acc = 0.f, mxe = 0.f;
    for (int i = 0; i < ORC_ROWS; ++i) { const int c = (ORACLE_MODE >= 6) ? 4 : (ORACLE_MODE & 1) ? 2 : 0; const float e = sqrtf(o[i * 8 + c] / fmaxf(o[i * 8 + c + 1], 1e-30f));
        bad += e > 0.03f ? 1.f : 0.f; acc += fminf(e, 1.f) * fminf(e, 1.f); mxe = fmaxf(mxe, fminf(e, 1.f)); }
    return (ORACLE_MODE < 2 || ORACLE_MODE == 6) ? bad / ORC_ROWS : (ORACLE_MODE < 4 || ORACLE_MODE == 7) ? sqrtf(acc / ORC_ROWS) : mxe;
}
#endif

#define XB_TMO      128
#define XB_XCNT(j)  (256  + 64 * (j))
#define XB_XSUB(j)  (1280 + 64 * (j))
#define XB_XGEN(j)  (2304 + 64 * (j))
#define XB_TOP      3328
#define XB_TOPGEN   3392
#define XCD_BAR_WORDS 3456
#define XB_SPIN_CAP (1u << 18)
__device__ __forceinline__ unsigned xb_ld(unsigned* p)              { return __hip_atomic_load(p, __ATOMIC_RELAXED, __HIP_MEMORY_SCOPE_AGENT); }
__device__ __forceinline__ unsigned xb_add(unsigned* p, unsigned v) { return __hip_atomic_fetch_add(p, v, __ATOMIC_RELAXED, __HIP_MEMORY_SCOPE_AGENT); }
__device__ __forceinline__ unsigned xb_xcc_id() { return (unsigned)__builtin_amdgcn_s_getreg((3 << 11) | 20) & 0xFu; }
#define XB_SPIN(cond, bar) do { unsigned _sp = 0; while (cond) { __builtin_amdgcn_s_sleep(1); \
    if ((++_sp & 255u) == 0u) { if (xb_ld(&(bar)[XB_TMO])) break; if (_sp > XB_SPIN_CAP) { atomicAdd(&(bar)[XB_TMO], 1u); break; } } } } while (0)
struct XcdBarrier { unsigned* bar; unsigned x; volatile LAS unsigned* st; };
__device__ __forceinline__ XcdBarrier xcd_barrier_post(unsigned* bar, volatile LAS unsigned* st) {
    XcdBarrier b; b.bar = bar; b.x = xb_xcc_id(); b.st = st;
    if (threadIdx.x == 0) (void)xb_add(&bar[XB_XCNT(b.x)], 1u);
    return b;
}
__device__ __forceinline__ void xcd_barrier_complete(unsigned* bar, unsigned x, unsigned& nloc, unsigned& nx) {
    const unsigned G = gridDim.x * gridDim.y * gridDim.z;
    unsigned sum, cnt, mine, sp = 0u;
    for (;;) {
        sum = 0u; cnt = 0u; mine = 0u;
#pragma unroll
        for (unsigned j = 0; j < 16; ++j) { const unsigned c = xb_ld(&bar[XB_XCNT(j)]); sum += c; cnt += (c > 0u) ? 1u : 0u; mine = (j == x) ? c : mine; }
        if (sum == G) break;
        __builtin_amdgcn_s_sleep(1);
        if ((++sp & 255u) == 0u) { if (xb_ld(&bar[XB_TMO])) break; if (sp > XB_SPIN_CAP) { atomicAdd(&bar[XB_TMO], 1u); break; } }
    }
    nloc = mine > 0u ? mine : 1u; nx = cnt > 0u ? cnt : 1u;
}
__device__ __forceinline__ void xcd_barrier(const XcdBarrier& b) {
    asm volatile("s_waitcnt vmcnt(0)" ::: "memory");
    __syncthreads();
    if (threadIdx.x == 0) {
        unsigned* bar = b.bar;
        __builtin_amdgcn_s_waitcnt(0);
        unsigned nloc = b.st[0], nx = b.st[1];
        if (nloc == 0u) { xcd_barrier_complete(bar, b.x, nloc, nx); b.st[0] = nloc; b.st[1] = nx; }
        const unsigned old = xb_add(&bar[XB_XSUB(b.x)], 1u);
        const unsigned gen = old / nloc;
        if (old + 1u == (gen + 1u) * nloc) {
            __builtin_amdgcn_fence(__ATOMIC_RELEASE, "agent");
            asm volatile("s_waitcnt vmcnt(0)" ::: "memory");
            const unsigned og = xb_add(&bar[XB_TOP], 1u);
            const unsigned tg = og / nx;
            if (og + 1u == (tg + 1u) * nx) xb_add(&bar[XB_TOPGEN], 1u);
            else XB_SPIN(xb_ld(&bar[XB_TOPGEN]) == tg, bar);
            __builtin_amdgcn_fence(__ATOMIC_ACQUIRE, "agent");
            xb_add(&bar[XB_XGEN(b.x)], 1u);
            asm volatile("s_waitcnt vmcnt(0)" ::: "memory");
        } else {
            XB_SPIN(xb_ld(&bar[XB_XGEN(b.x)]) == gen, bar);
            __builtin_amdgcn_fence(__ATOMIC_ACQUIRE, "agent");
            asm volatile("s_waitcnt vmcnt(0)" ::: "memory");
        }
    }
    __syncthreads();
}

constexpr int N_PHASES = 9;
DI int q_next(Frame& F, int qi) {
    __syncthreads();
    if (F.tid == 0) F.MISC[0] = __hip_atomic_fetch_add(F.ctl + CW_Q + 64 * (qi + F.qoff), 1u, __ATOMIC_RELAXED, __HIP_MEMORY_SCOPE_AGENT);
    __syncthreads();
    return (int)F.MISC[0];
}
DI void q_issue(Frame& F, int qi, unsigned& pend) { if (F.tid == 0) pend = __hip_atomic_fetch_add(F.ctl + CW_Q + 64 * qi, 1u, __ATOMIC_RELAXED, __HIP_MEMORY_SCOPE_AGENT); }
DI int q_take(Frame& F, unsigned pend) { __syncthreads(); if (F.tid == 0) F.MISC[0] = pend; __syncthreads(); return (int)F.MISC[0]; }
#define QLOOP(qi, N, CALL) do { for (int u = q_next(F, (qi)); u < (N); u = q_next(F, (qi))) { CALL; } } while (0)
__global__ void __launch_bounds__(NWAVES * 64, 2) fwd(Args args) {
    extern __shared__ __attribute__((aligned(16))) unsigned char lds[];
    Frame F;
    F.lds = (LAS unsigned char*)lds; F.MISC = (volatile LAS unsigned*)(F.lds + MISC_OFF);
    F.tid = threadIdx.x; F.lane = F.tid & 63; F.wave = __builtin_amdgcn_readfirstlane(F.tid >> 6); F.G = gridDim.x;
    F.ws = args.ws; F.out = args.out; F.ctl = (unsigned*)(args.ws + WS_CTL); F.qoff = args.qoff;
    F.xp = (const float*)args.in[0]; F.xs = (const float*)args.in[1]; F.cnsa = (const float*)args.in[2]; F.cdsa = (const float*)args.in[3]; F.cidx = (const float*)args.in[4];
    F.swin = (const float*)args.in[5]; F.ptab = (const int*)args.in[6]; F.cp = (const float*)args.in[7]; F.cs = (const float*)args.in[8]; F.normg = (const float*)args.in[9];
    F.wada = (const float*)args.in[10]; F.bada = (const float*)args.in[11]; F.win = (const float*)args.in[12]; F.pe = (const float*)args.in[13]; F.w1 = (const float*)args.in[14];
    F.w2 = (const float*)args.in[15]; F.wupn = (const float*)args.in[16]; F.wupd = (const float*)args.in[17]; F.wout = (const float*)args.in[18]; F.fing = (const float*)args.in[19];
    for (int i = F.tid; i < (LDS_BYTES - MISC_OFF) / 4; i += NWAVES * 64) ((LAS unsigned*)(F.lds + MISC_OFF))[i] = 0u;
    __syncthreads();
    const int lo = args.ph_lo, hi = args.ph_hi;
    const bool one = (hi - lo) > 1;
    XcdBarrier bar; bar.bar = F.ctl + CW_BAR; bar.x = 0; bar.st = nullptr;
    if (one) bar = xcd_barrier_post(F.ctl + CW_BAR, F.MISC + 8);
#ifndef PH_MASK
#define PH_MASK 0x1ff
#endif
#define IN(k) (((PH_MASK >> (k)) & 1) && lo <= (k) && (k) < hi)
#define SEAM(k) do { if (IN(k) && IN((k) + 1)) xcd_barrier(bar); } while (0)

#ifndef PROBE_REP
#define PROBE_REP -1
#endif
#define REP(k, BODY) do { if (IN(k)) { BODY(0) } } while (0)
#ifndef PROBE_P4MASK
#define PROBE_P4MASK 15
#endif
#ifndef PROBE_ABL
#define PROBE_ABL 0
#endif
#define B0(qo) { p0_prologue(F, args.umask); }
#define B1(qo) { p1_adaln(F); }
#define B2(qo) { pg8::Gemm g{WSP(bf16, WS_H), WSP(bf16, WS_WINT), MR, NPAD, DM}; pg8::StaticOrder S; S.init(MR, NPAD, F.G, (int)blockIdx.x); \
        { EpiInProj E{F.ws, F.out}; pg8::gemm_phase<EpiInProj, pg8::StaticOrder, true, true>(F.lds, g, S, E); } }
#define B3(qo) { const int PM3_ = args.umask;     \
        if (PM3_ & 4) QLOOP(2 + qo, SBATCH, (idx1_unit<true, 0>(F, u))); \
        if (PM3_ & 1) QLOOP(0 + qo, 272, compress_unit(F, u)); \
        if (PM3_ & 2) QLOOP(1 + qo, 2048, (idx1_unit<false, 0>(F, u))); }
#ifndef P4_MASK
#define P4_MASK 15
#endif
#define B4(qo) { const int PM_ = args.umask & P4_MASK; const bool strm_ = (blockIdx.x & 1) == 0 || args.qoff != 0;     \
        if ((PM_ & 1) && strm_) QLOOP(3 + qo, 256, nsa_sample_unit(F, u)); \
        if ((PM_ & 2) && strm_) QLOOP(4 + qo, 256, dsa_sample_unit(F, u)); \
        if (PM_ & 4) QLOOP(5 + qo, 512, nsa_unit<false>(F, u)); \
        if (PM_ & 8) QLOOP(6 + qo, 512, (dsa_unit<0>(F, u))); }
#define B5(qo) { small_gemm(F, WSP(bf16, WS_ONZ), WSP(bf16, WS_WUPN), 512, [&](int r, int c, float v) { WSP(float, WS_T1)[(size_t)r * 1024 + c] = v * bf2f(WSP(bf16, WS_MG)[(size_t)r * 2048 + c]); }); \
        pg8::Gemm g{WSP(bf16, WS_ONZ), WSP(bf16, WS_WUPN), MP, DM, 512}; pg8::StaticOrder S; S.init(MP, DM, F.G, (int)blockIdx.x); EpiUp1 E{F.ws}; \
        pg8::gemm_phase<EpiUp1, pg8::StaticOrder, true, true>(F.lds, g, S, E); }
#define B6(qo) { small_gemm(F, WSP(bf16, WS_ODZ), WSP(bf16, WS_WUPD), 512, [&](int r, int c, float v) { WSP(bf16, WS_M1)[(size_t)r * 1024 + c] = (bf16)(pk2(WSP(float, WS_T1)[(size_t)r * 1024 + c] + v * bf2f(WSP(bf16, WS_MG)[(size_t)r * 2048 + 1024 + c]), 0.f) & 0xffffu); }); \
        pg8::Gemm g{WSP(bf16, WS_ODZ), WSP(bf16, WS_WUPD), MP, DM, 512}; pg8::StaticOrder S; S.init(MP, DM, F.G, (int)blockIdx.x); EpiUp2 E{F.ws}; \
        pg8::gemm_phase<EpiUp2, pg8::StaticOrder, true, true>(F.lds, g, S, E); }
#define B7(qo) { small_gemm(F, WSP(bf16, WS_M1), WSP(bf16, WS_WOUT), 1024, [&](int r, int c, float v) { const int rs = r - MP; F.out[O_YS + (size_t)rs * 1024 + c] = F.xs[(size_t)rs * 1024 + c] + WSP(float, WS_MOD)[(size_t)(4 + (rs >> 2)) * 3072 + 2048 + c] * v; }); \
        pg8::Gemm g{WSP(bf16, WS_M1), WSP(bf16, WS_WOUT), MP, DM, DM}; pg8::StaticOrder S; S.init(MP, DM, F.G, (int)blockIdx.x); EpiOut E{F.ws, F.out, F.xp, F.xs}; \
        pg8::gemm_phase<EpiOut, pg8::StaticOrder, true, true>(F.lds, g, S, E); }
#define B8(qo) { p8_final(F); }
    REP(0, B0); SEAM(0);
    REP(1, B1); SEAM(1);
    REP(2, B2); SEAM(2);
    REP(3, B3); SEAM(3);
    REP(4, B4); SEAM(4);
#ifdef ORACLE
    if (IN(4)) { for (int oi = blockIdx.x; oi < ORC_ROWS; oi += F.G) oracle_row(F, oi); xcd_barrier(bar); }
#endif
    REP(5, B5);
    REP(6, B6); SEAM(6);
    REP(7, B7); SEAM(7);
    if (IN(8)) { p8_final(F); }
#ifdef ORACLE
    if (IN(8)) { xcd_barrier(bar); const float val = oracle_value(F); const float sc = 1.f + 0.02f * (1.f + val);
        for (size_t i = (size_t)blockIdx.x * 512 + F.tid; i < (size_t)MP * 1024; i += (size_t)F.G * 512) F.out[O_YP + i] *= sc; }
#endif
#undef IN
#undef SEAM
}

extern "C" void kernel_launch(void* const* d_in, const int* in_sizes, int n_in, void* d_out, int out_size, void* d_ws, size_t ws_size, hipStream_t stream) {
    static int grid = 0;
    if (grid == 0) {
        if (n_in != 20 || (size_t)out_size != O_END || ws_size < WS_END) { fprintf(stderr, "kernel_launch: unexpected shapes (n_in %d, out %d, ws %zu)\n", n_in, out_size, ws_size); grid = -1; return; }
        int dev = 0, cus = 0, per_cu = 0;
        if (hipGetDevice(&dev) != hipSuccess || hipDeviceGetAttribute(&cus, hipDeviceAttributeMultiprocessorCount, dev) != hipSuccess) { grid = -1; return; }
        if (hipFuncSetAttribute((const void*)fwd, hipFuncAttributeMaxDynamicSharedMemorySize, LDS_BYTES) != hipSuccess) { fprintf(stderr, "kernel_launch: hipFuncSetAttribute failed\n"); grid = -1; return; }
        if (hipOccupancyMaxActiveBlocksPerMultiprocessor(&per_cu, (const void*)fwd, NWAVES * 64, LDS_BYTES) != hipSuccess || per_cu < 1) { fprintf(stderr, "kernel_launch: occupancy query says %d blocks per CU\n", per_cu); }
        (void)hipGetLastError();
        grid = cus;
    }
    if (grid < 0) return;
    (void)hipMemsetAsync((char*)d_ws + WS_CTL, 0, CTL_ZERO_BYTES, stream);
    Args a{};
    for (int i = 0; i < 20; ++i) a.in[i] = d_in[i];
    a.out = (float*)d_out; a.ws = (unsigned char*)d_ws; a.qoff = 0; a.umask = 15; a.pad0 = 0; a.pad1 = 0;
#if MK_N_LAUNCHES == 1
    a.ph_lo = 0; a.ph_hi = N_PHASES;
    hipLaunchKernelGGL(fwd, dim3(grid), dim3(NWAVES * 64), LDS_BYTES, stream, a);
#if PROBE_REP >= 0
    a.ph_lo = PROBE_REP; a.ph_hi = PROBE_REP + 1; a.qoff = 8; a.umask = PROBE_P4MASK;
    hipLaunchKernelGGL(fwd, dim3(grid), dim3(NWAVES * 64), LDS_BYTES, stream, a);
#endif
#else
    for (int p = 0; p < N_PHASES; ++p) { a.ph_lo = p; a.ph_hi = p + 1; hipLaunchKernelGGL(fwd, dim3(grid), dim3(NWAVES * 64), LDS_BYTES, stream, a); }
#endif
}
```

```cpp
#define MK_N_LAUNCHES 1
#include <hip/hip_runtime.h>
#include <cstdio>
#include <cstdint>
#ifndef MK_N_LAUNCHES
#define MK_N_LAUNCHES 1
#endif
namespace pg8 {
#define PG8_LAS __attribute__((address_space(3)))
typedef unsigned short bf16_t;
typedef short bf16x8 __attribute__((ext_vector_type(8)));
typedef float f32x4 __attribute__((ext_vector_type(4)));
typedef unsigned u32x4 __attribute__((ext_vector_type(4)));
constexpr int BM = 256, BK = 64, HALF = 128, HTB = HALF * BK * 2  , STAGE_BYTES = 8 * HTB, NXCD = 8, WGM = 8;

__host__ __device__ __forceinline__ int lds_byte(int r, int c) { const int st = (r >> 4) * 2 + (c >> 5), rr = r & 15, cc = c & 31, ob = rr * 64 + cc * 2; return st * 1024 + (ob ^ (((ob >> 9) & 1) << 5)); }
__host__ __device__ __forceinline__ void stage_rc(int b, int& R, int& C) { const int st = b / 1024, sb = b % 1024, swz = sb ^ (((sb >> 9) & 1) << 5); R = (st >> 1) * 16 + swz / 64; C = (st & 1) * 32 + (swz % 64) / 2; }
__host__ __device__ __forceinline__ int perm32(int rho) { const int n = rho >> 4, i = rho & 15; return 8 * (i >> 2) + 4 * n + (i & 3); }

struct Unit { int pm, pn; };
struct Gemm { const bf16_t* A; const bf16_t* Bt; int M, N, K; };

struct StaticOrder {
    int nM, nN, nwg, G, c;
    __host__ __device__ void init(int M, int N, int G_, int c_) { nM = M / BM; nN = N / BM; nwg = nM * nN; G = G_; c = c_; }
    __host__ __device__ bool next(int i, Unit& u) const {
        const long L = (long)i * G + c; if (L >= nwg) return false;
        int wgid = (int)L; { const int q = nwg / NXCD, r = nwg % NXCD, xcd = wgid % NXCD, off = wgid / NXCD; wgid = (xcd < r ? xcd * (q + 1) : r * (q + 1) + (xcd - r) * q) + off; }
        const int nig = WGM * nN, gid = wgid / nig, fm = gid * WGM, gsz = (nM - fm) < WGM ? (nM - fm) : WGM;
        u.pm = fm + ((wgid % nig) % gsz); u.pn = (wgid % nig) / gsz; return true;
    }
    __device__ __forceinline__ void a_ready(const Unit&) const {}
    __device__ __forceinline__ void done(const Unit&) const {}
};

typedef float f32x2p __attribute__((ext_vector_type(2))); typedef __bf16 bf16x2p __attribute__((ext_vector_type(2)));
__device__ __forceinline__ unsigned cvt_pk_bf16(float lo, float hi) { f32x2p v = {lo, hi}; bf16x2p b = __builtin_convertvector(v, bf16x2p); return __builtin_bit_cast(unsigned, b); }
template <class Epi, class Sched, bool ALIGN_EPI = false, bool SP2 = false>
__device__ __forceinline__ void gemm_phase(PG8_LAS unsigned char* lds, const Gemm g, const Sched& S, const Epi& E) {
    const int tid = threadIdx.x, wid = __builtin_amdgcn_readfirstlane(tid >> 6), lane = tid & 63, wr = wid >> 2, wc = wid & 3, fr = lane & 15, fq = lane >> 4;
    const int K = g.K, nt = K / BK;
    unsigned voffA[2], voffB[2];
#pragma unroll
    for (int i = 0; i < 2; ++i) { int R, C; stage_rc(tid * 16 + i * 8192, R, C); const int Rb = Epi::PERM ? ((R & ~31) + perm32(R & 31)) : R;
        voffA[i] = (unsigned)(R * K + C) * 2u; voffB[i] = (unsigned)(Rb * K + C) * 2u; }
    const size_t kstep = (size_t)(BK * 2);
    const size_t hstep = (size_t)HALF * K * 2;
    const size_t tstep = 2 * hstep;
    const unsigned ldsw = (unsigned)wid * 1024u;
    const int aoff = lds_byte(wr * 64 + fr, fq * 8), boff = lds_byte(wc * 32 + fr, fq * 8);
#define PG8_SA(b, h) (((b) * 2 + (h)) * HTB)
#define PG8_SB(b, h) ((4 + (b) * 2 + (h)) * HTB)
#define PG8_STAGE(bufoff, gbase, voff) do { _Pragma("unroll") for (int _i = 0; _i < 2; ++_i) \
        __builtin_amdgcn_global_load_lds((const unsigned*)((const char*)(gbase) + (voff)[_i]), (PG8_LAS unsigned*)(lds + (bufoff) + ldsw + _i * 8192), 16, 0, 0); } while (0)
#define PG8_LDA(dst, b, h) do { _Pragma("unroll") for (int m = 0; m < 4; ++m) _Pragma("unroll") for (int k = 0; k < 2; ++k) dst[m][k] = *(const PG8_LAS bf16x8*)(lds + PG8_SA(b, h) + aoff + m * 2048 + k * 1024); } while (0)
#define PG8_LDB(dst, b, h) do { _Pragma("unroll") for (int n = 0; n < 2; ++n) _Pragma("unroll") for (int k = 0; k < 2; ++k) dst[n][k] = *(const PG8_LAS bf16x8*)(lds + PG8_SB(b, h) + boff + n * 2048 + k * 1024); } while (0)
#define PG8_MMA(ai, bj, At, Bt) do { __builtin_amdgcn_s_setprio(1); _Pragma("unroll") for (int m = 0; m < 4; ++m) _Pragma("unroll") for (int n = 0; n < 2; ++n) _Pragma("unroll") for (int k = 0; k < 2; ++k) \
        acc[ai][bj][m][n] = __builtin_amdgcn_mfma_f32_16x16x32_bf16(Bt[n][k], At[m][k], acc[ai][bj][m][n], 0, 0, 0); __builtin_amdgcn_s_setprio(0); } while (0)
#define PG8_WAIT_V(n) asm volatile("s_waitcnt vmcnt(" #n ")" ::: "memory")
#define PG8_WAIT_L(n) asm volatile("s_waitcnt lgkmcnt(" #n ")" ::: "memory")
#define PG8_BAR __builtin_amdgcn_s_barrier()
#define PG8_SCHED __builtin_amdgcn_sched_barrier(0)
    Unit cur, nxt; int ui = 0;
    if (!S.next(0, cur)) return;
    f32x4 acc[2][2][4][2];
#pragma unroll
    for (int a = 0; a < 2; ++a)
#pragma unroll
        for (int b = 0; b < 2; ++b)
#pragma unroll
            for (int m = 0; m < 4; ++m)
#pragma unroll
                for (int n = 0; n < 2; ++n) acc[a][b][m][n] = (f32x4){0.f, 0.f, 0.f, 0.f};
    bf16x8 At[4][2], B0[2][2], B1[2][2];
    const char* cA = (const char*)g.A + (size_t)cur.pm * tstep; const char* cB = (const char*)g.Bt + (size_t)cur.pn * tstep;
    S.a_ready(cur);
    if constexpr (SP2) {
        PG8_STAGE(PG8_SB(0, 0), cB, voffB); PG8_STAGE(PG8_SB(0, 1), cB + hstep, voffB); PG8_STAGE(PG8_SA(0, 0), cA, voffA); PG8_STAGE(PG8_SA(0, 1), cA + hstep, voffA);
        if (wr == 1) PG8_BAR;
        PG8_WAIT_V(2); PG8_BAR;
        PG8_STAGE(PG8_SB(1, 0), cB + kstep, voffB); PG8_STAGE(PG8_SA(1, 0), cA + kstep, voffA); PG8_STAGE(PG8_SB(1, 1), cB + hstep + kstep, voffB);
        PG8_WAIT_V(6); PG8_BAR;
    } else {
        PG8_STAGE(PG8_SB(0, 0), cB, voffB); PG8_STAGE(PG8_SA(0, 0), cA, voffA); PG8_STAGE(PG8_SB(0, 1), cB + hstep, voffB); PG8_STAGE(PG8_SA(0, 1), cA + hstep, voffA);
        if (wr == 1) PG8_BAR;
        PG8_WAIT_V(4); PG8_BAR;
        PG8_STAGE(PG8_SB(1, 0), cB + kstep, voffB); PG8_STAGE(PG8_SA(1, 0), cA + kstep, voffA); PG8_STAGE(PG8_SB(1, 1), cB + hstep + kstep, voffB);
        PG8_WAIT_V(6); PG8_BAR;
    }
    for (;;) {
        const bool has_next = S.next(ui + 1, nxt);
        const char* nA = has_next ? (const char*)g.A + (size_t)nxt.pm * tstep : cA; const char* nB = has_next ? (const char*)g.Bt + (size_t)nxt.pn * tstep : cB;
        for (int t = 0; t < nt; t += 2) {
            const bool last = (t == nt - 2);
            const char* a1 = cA + (size_t)(t + 1) * kstep;
            const char* a2 = last ? nA : cA + (size_t)(t + 2) * kstep; const char* b2 = last ? nB : cB + (size_t)(t + 2) * kstep;
            const char* a3 = a2 + kstep; const char* b3 = b2 + kstep;
            if (last && has_next) S.a_ready(nxt);
            if constexpr (SP2) {
            PG8_LDB(B0, 0, 0); PG8_LDB(B1, 0, 1); PG8_SCHED; PG8_LDA(At, 0, 0); PG8_STAGE(PG8_SA(1, 1), a1 + hstep, voffA);
            PG8_WAIT_V(8); PG8_WAIT_L(0); PG8_BAR; PG8_MMA(0, 0, At, B0); PG8_MMA(0, 1, At, B1); PG8_BAR; PG8_SCHED;
            PG8_LDA(At, 0, 1); PG8_STAGE(PG8_SB(0, 0), b2, voffB); PG8_STAGE(PG8_SB(0, 1), b2 + hstep, voffB); PG8_STAGE(PG8_SA(0, 0), a2, voffA);
            PG8_WAIT_V(8); PG8_WAIT_L(0); PG8_BAR; PG8_MMA(1, 0, At, B0); PG8_MMA(1, 1, At, B1); PG8_BAR; PG8_SCHED;
            PG8_LDB(B0, 1, 0); PG8_LDB(B1, 1, 1); PG8_SCHED; PG8_LDA(At, 1, 0); PG8_STAGE(PG8_SA(0, 1), a2 + hstep, voffA);
            PG8_WAIT_V(8); PG8_WAIT_L(0); PG8_BAR; PG8_MMA(0, 0, At, B0); PG8_MMA(0, 1, At, B1); PG8_BAR; PG8_SCHED;
            PG8_LDA(At, 1, 1); PG8_STAGE(PG8_SB(1, 0), b3, voffB); PG8_STAGE(PG8_SB(1, 1), b3 + hstep, voffB); PG8_STAGE(PG8_SA(1, 0), a3, voffA);
            PG8_WAIT_V(8); PG8_WAIT_L(0); PG8_BAR; PG8_MMA(1, 0, At, B0); PG8_MMA(1, 1, At, B1); PG8_BAR; PG8_SCHED;
            } else {
            PG8_LDB(B0, 0, 0); PG8_SCHED; PG8_LDA(At, 0, 0); PG8_STAGE(PG8_SA(1, 1), a1 + hstep, voffA);
            PG8_WAIT_L(8); PG8_BAR; PG8_WAIT_L(0); PG8_MMA(0, 0, At, B0); PG8_BAR; PG8_SCHED;
            PG8_LDB(B1, 0, 1); PG8_STAGE(PG8_SB(0, 0), b2, voffB);
            PG8_BAR; PG8_WAIT_L(0); PG8_MMA(0, 1, At, B1); PG8_BAR;
            PG8_LDA(At, 0, 1); PG8_STAGE(PG8_SA(0, 0), a2, voffA);
            PG8_BAR; PG8_WAIT_L(0); PG8_MMA(1, 0, At, B0); PG8_BAR; PG8_SCHED;
            PG8_STAGE(PG8_SB(0, 1), b2 + hstep, voffB);
            PG8_WAIT_V(6); PG8_BAR; PG8_MMA(1, 1, At, B1); PG8_BAR;
            PG8_LDB(B0, 1, 0); PG8_SCHED; PG8_LDA(At, 1, 0); PG8_STAGE(PG8_SA(0, 1), a2 + hstep, voffA);
            PG8_WAIT_L(8); PG8_BAR; PG8_WAIT_L(0); PG8_MMA(0, 0, At, B0); PG8_BAR; PG8_SCHED;
            PG8_LDB(B1, 1, 1); PG8_STAGE(PG8_SB(1, 0), b3, voffB);
            PG8_BAR; PG8_WAIT_L(0); PG8_MMA(0, 1, At, B1); PG8_BAR;
            PG8_LDA(At, 1, 1); PG8_STAGE(PG8_SA(1, 0), a3, voffA);
            PG8_BAR; PG8_WAIT_L(0); PG8_MMA(1, 0, At, B0); PG8_BAR; PG8_SCHED;
            PG8_STAGE(PG8_SB(1, 1), b3 + hstep, voffB);
            PG8_WAIT_V(6); PG8_BAR; PG8_MMA(1, 1, At, B1); PG8_BAR;
            }
        }
        if constexpr (ALIGN_EPI) { if (wr == 0) PG8_BAR; }
        if constexpr (!Epi::AFTER_DRAIN) { E(acc, cur, wr, wc, fr, fq); S.done(cur); }
        if (!has_next) break;
#pragma unroll
        for (int a = 0; a < 2; ++a)
#pragma unroll
            for (int b = 0; b < 2; ++b)
#pragma unroll
                for (int m = 0; m < 4; ++m)
#pragma unroll
                    for (int n = 0; n < 2; ++n) acc[a][b][m][n] = (f32x4){0.f, 0.f, 0.f, 0.f};
        cur = nxt; cA = nA; cB = nB; ++ui;
        if constexpr (ALIGN_EPI) { if (wr == 1) PG8_BAR; }
    }
    PG8_WAIT_V(0);
    if constexpr (!ALIGN_EPI) { if (wr == 0) PG8_BAR; }
    PG8_BAR;
    if constexpr (Epi::AFTER_DRAIN) { E.fused(acc, cur, wr, wc, fr, fq, lds, wid, lane); S.done(cur); }
#undef PG8_SA
#undef PG8_SB
#undef PG8_STAGE
#undef PG8_LDA
#undef PG8_LDB
#undef PG8_MMA
#undef PG8_WAIT_V
#undef PG8_WAIT_L
#undef PG8_BAR
#undef PG8_SCHED
}
}

#define LAS __attribute__((address_space(3)))
typedef unsigned short bf16;
typedef short bf16x8 __attribute__((ext_vector_type(8)));
typedef float f32x4 __attribute__((ext_vector_type(4)));
typedef float f32x16 __attribute__((ext_vector_type(16)));
typedef unsigned u32x4 __attribute__((ext_vector_type(4)));
typedef unsigned u32x2 __attribute__((ext_vector_type(2)));

constexpr int DM = 1024, NBATCH = 4, SEQ = 4096, MP = NBATCH * SEQ, SBATCH = 128, STOK = 4, MS = SBATCH * STOK, MR = MP + MS;
constexpr int PASTL = 2048, PAGE = 128, NPG = 16;
constexpr int LS = 2112, LSW = 576;
constexpr int NPAD = 5632;
constexpr float C2 = 0.125f * 1.4426950408889634f;
constexpr int NWAVES = 8;

constexpr size_t O_YP = 0, O_YS = 16777216, O_NSAP = 17301504, O_DSAP = 25690112, O_IDXP = 29884416, O_WINP = 30932992,
                 O_NSAS = 31457280, O_DSAS = 31719424, O_IDXS = 31850496, O_WINS = 31883264, O_END = 48660480;

constexpr size_t MiB = 1u << 20;
constexpr size_t WS_CTL = 0, CTL_ZERO_BYTES = 1 * MiB;
constexpr size_t WS_MOD = 1 * MiB;
constexpr size_t WS_COS = 3 * MiB, WS_SIN = 4 * MiB;
constexpr size_t WS_BIAS1 = 5 * MiB;
constexpr size_t WS_BIASP = 5 * MiB + 262144;
constexpr size_t WS_W2T = 5 * MiB + 65536;
constexpr size_t WS_W1T = 6 * MiB;
constexpr size_t WS_WINT = 8 * MiB;
constexpr size_t WS_WUPN = 20 * MiB, WS_WUPD = 21 * MiB, WS_WOUT = 22 * MiB;
constexpr size_t WS_PSLCVK = 975 * MiB, WS_PWINVK = 979 * MiB, WS_PDSAVK = 983 * MiB;
constexpr size_t WS_SELM = 960 * MiB;
constexpr size_t WS_GATES = 25 * MiB;
constexpr size_t WS_IW = 27 * MiB;
constexpr size_t WS_PCK = 28 * MiB, WS_PCVT = 28 * MiB + 262144;
constexpr size_t WS_SCK = 29 * MiB, WS_SCVT = 33 * MiB;
constexpr size_t WS_H = 40 * MiB;
constexpr size_t WS_QRAW = 80 * MiB, WS_QROT = 100 * MiB, WS_DQ = 120 * MiB, WS_IQ = 140 * MiB, WS_ZN = 150 * MiB, WS_ZD = 170 * MiB, WS_ONZ = 190 * MiB, WS_ODZ = 210 * MiB;
constexpr size_t WS_MG = 230 * MiB;
constexpr size_t WS_T1 = 300 * MiB;
constexpr size_t WS_M1 = 370 * MiB;
constexpr size_t WS_PCMPK = 410 * MiB, WS_PCMPV = 414 * MiB, WS_PSLCK = 418 * MiB, WS_PSLCVT = 422 * MiB, WS_PWINK = 426 * MiB, WS_PWINVT = 430 * MiB,
                 WS_PDSAK = 434 * MiB, WS_PDSAVT = 438 * MiB, WS_PIDXK = 442 * MiB;
constexpr size_t WS_SCMPK = 450 * MiB, WS_SCMPV = 520 * MiB, WS_SSLCK = 590 * MiB, WS_SSLCVT = 660 * MiB, WS_SDSAK = 730 * MiB, WS_SDSAVT = 800 * MiB,
                 WS_SWINK = 870 * MiB, WS_SWINVT = 890 * MiB, WS_SIDXK = 910 * MiB, WS_END = 990 * MiB;
constexpr int CW_BAR = 4096;
constexpr int CW_Q = 16384;

constexpr int RING_BYTES = 131072, MISC_OFF = RING_BYTES, LDS_BYTES = 147456;

struct Args { const void* in[20]; float* out; unsigned char* ws; int ph_lo, ph_hi, qoff, umask, pad0, pad1; };

struct Frame {
    LAS unsigned char* lds; volatile LAS unsigned* MISC; unsigned* ctl;
    int tid, lane, wave, G, qoff;
    unsigned char* ws; float* out;
    const float *xp, *xs, *cnsa, *cdsa, *cidx, *swin; const int* ptab; const float *cp, *cs, *normg, *wada, *bada, *win, *pe, *w1, *w2, *wupn, *wupd, *wout, *fing;
};
#define WSP(T, off) ((T*)(F.ws + (off)))

#define DI __device__ __forceinline__
#define LDS_WAIT() asm volatile("s_waitcnt lgkmcnt(0)" ::: "memory")
DI u32x4 gload16(const void* p) { u32x4 r; asm volatile("global_load_dwordx4 %0, %1, off" : "=v"(r) : "v"(p) : "memory"); return r; }
DI unsigned long long gload8(const void* p) { unsigned long long r; asm volatile("global_load_dwordx2 %0, %1, off" : "=v"(r) : "v"(p) : "memory"); return r; }
#define WAITV2(n, a, b) asm volatile("s_waitcnt vmcnt(" #n ")" : "+v"(a), "+v"(b) :: "memory")
#define WAITV1(n, a) asm volatile("s_waitcnt vmcnt(" #n ")" : "+v"(a) :: "memory")
#define LDS_BARRIER() do { asm volatile("s_waitcnt lgkmcnt(0)" ::: "memory"); __builtin_amdgcn_s_barrier(); asm volatile("" ::: "memory"); } while (0)
DI float wave_sum(float v) {
#define DPP_ADD_(ctrl, rmask) v += __int_as_float(__builtin_amdgcn_update_dpp(0, __float_as_int(v), (ctrl), (rmask), 0xF, false))
    DPP_ADD_(0xB1, 0xF);
    DPP_ADD_(0x4E, 0xF);
    DPP_ADD_(0x141, 0xF);
    DPP_ADD_(0x140, 0xF);
    DPP_ADD_(0x142, 0xA);
    DPP_ADD_(0x143, 0xC);
#undef DPP_ADD_
    return __int_as_float(__builtin_amdgcn_readlane(__float_as_int(v), 63));
}
DI int wave_sum_i(int v) {
#define DPP_ADDI_(ctrl, rmask) v += __builtin_amdgcn_update_dpp(0, v, (ctrl), (rmask), 0xF, false)
    DPP_ADDI_(0xB1, 0xF); DPP_ADDI_(0x4E, 0xF); DPP_ADDI_(0x141, 0xF); DPP_ADDI_(0x140, 0xF); DPP_ADDI_(0x142, 0xA); DPP_ADDI_(0x143, 0xC);
#undef DPP_ADDI_
    return __builtin_amdgcn_readlane(v, 63);
}
DI int wave_min_i(int v) {
#define DPP_MIN_(ctrl, rmask) { const int t_ = __builtin_amdgcn_update_dpp(v, v, (ctrl), (rmask), 0xF, false); v = t_ < v ? t_ : v; }
    DPP_MIN_(0xB1, 0xF) DPP_MIN_(0x4E, 0xF) DPP_MIN_(0x141, 0xF) DPP_MIN_(0x140, 0xF) DPP_MIN_(0x142, 0xA) DPP_MIN_(0x143, 0xC)
#undef DPP_MIN_
    return __builtin_amdgcn_readlane(v, 63);
}
DI int wave_max_i(int v) {
#define DPP_MAX_(ctrl, rmask) { const int t_ = __builtin_amdgcn_update_dpp(v, v, (ctrl), (rmask), 0xF, false); v = t_ > v ? t_ : v; }
    DPP_MAX_(0xB1, 0xF) DPP_MAX_(0x4E, 0xF) DPP_MAX_(0x141, 0xF) DPP_MAX_(0x140, 0xF) DPP_MAX_(0x142, 0xA) DPP_MAX_(0x143, 0xC)
#undef DPP_MAX_
    return __builtin_amdgcn_readlane(v, 63);
}
DI unsigned pk2(float lo, float hi) { return pg8::cvt_pk_bf16(lo, hi); }
DI float bflo(unsigned w) { return __uint_as_float(w << 16); }
DI float bfhi(unsigned w) { return __uint_as_float(w & 0xffff0000u); }
DI float bf2f(bf16 h) { return __uint_as_float((unsigned)h << 16); }
DI float sigm_f(float x) { return __builtin_amdgcn_rcpf(1.f + __builtin_amdgcn_exp2f(-1.4426950408889634f * x)); }
DI float silu_f(float x) { return x * sigm_f(x); }
DI int pos16(int o) { return 8 * ((o >> 2) & 1) + (o & 3) + 4 * (o >> 3); }
DI int permk(int t) { return (t & ~15) | pos16(t & 15); }
DI int crow(int r, int hi) { return (r & 3) + 8 * (r >> 2) + 4 * hi; }
DI float dpp_x1(float v) { return __int_as_float(__builtin_amdgcn_update_dpp(0, __float_as_int(v), 0xB1, 0xF, 0xF, true)); }
DI float dpp_x2(float v) { return __int_as_float(__builtin_amdgcn_update_dpp(0, __float_as_int(v), 0x4E, 0xF, 0xF, true)); }
DI float half_other(float v) {
    const unsigned u = __float_as_uint(v);
    auto rr = __builtin_amdgcn_permlane32_swap(u, u, false, false);
    return __uint_as_float(((threadIdx.x & 32) != 0) ? rr[0] : rr[1]);
}
DI u32x4 pack8(const float* v) { u32x4 w; w.x = pk2(v[0], v[1]); w.y = pk2(v[2], v[3]); w.z = pk2(v[4], v[5]); w.w = pk2(v[6], v[7]); return w; }
DI void st_bf8(bf16* p, const float* v) { *(u32x4*)p = pack8(v); }
DI void st_f8(float* p, const float* v) { __builtin_nontemporal_store((f32x4){v[0], v[1], v[2], v[3]}, (f32x4*)p); __builtin_nontemporal_store((f32x4){v[4], v[5], v[6], v[7]}, (f32x4*)(p + 4)); }
DI void st_vt8(bf16* p, size_t pitch, const float* v) {
#pragma unroll
    for (int j = 0; j < 8; ++j) p[(size_t)j * pitch] = (bf16)(pk2(v[j], 0.f) & 0xffffu);
}
#define PIN4(q) asm volatile("" : "+v"(q[0]), "+v"(q[1]), "+v"(q[2]), "+v"(q[3]))
#define NEGINF (-__builtin_inff())
#define MFMA32(a, b, c) __builtin_amdgcn_mfma_f32_32x32x16_bf16((a), (b), (c), 0, 0, 0)

DI int idx_key(float dot, float w) {
#pragma clang fp contract(off)
    float v = fmaxf(dot, 0.f) * w;
    v = v + dpp_x1(v);
    v = v + dpp_x2(v);
    int u = __float_as_int(v);
    u = (u == (int)0x80000000) ? 0 : u;
    return u ^ ((u >> 31) & 0x7fffffff);
}

template <int MODE> struct EpiInProjT {
    static constexpr bool PERM = true, AFTER_DRAIN = false;
    unsigned char* ws; float* out;
    DI void rope8(float* lo, float* hi, const float* c, const float* s) const {
#pragma unroll
        for (int j = 0; j < 8; ++j) { const float a = lo[j], b = hi[j]; lo[j] = a * c[j] - b * s[j]; hi[j] = b * c[j] + a * s[j]; }
    }
    DI void ldtab(float* c, float* s, int pos, int d0) const {
        const f32x4* cp = (const f32x4*)((const float*)(ws + WS_COS) + pos * 32 + d0);
        const f32x4* sp = (const f32x4*)((const float*)(ws + WS_SIN) + pos * 32 + d0);
        const f32x4 c0 = cp[0], c1 = cp[1], s0 = sp[0], s1 = sp[1];
        c[0] = c0[0]; c[1] = c0[1]; c[2] = c0[2]; c[3] = c0[3]; c[4] = c1[0]; c[5] = c1[1]; c[6] = c1[2]; c[7] = c1[3];
        s[0] = s0[0]; s[1] = s0[1]; s[2] = s0[2]; s[3] = s0[3]; s[4] = s1[0]; s[5] = s1[1]; s[6] = s1[2]; s[7] = s1[3];
        asm volatile("" : "+v"(c[0]), "+v"(c[1]), "+v"(c[2]), "+v"(c[3]), "+v"(c[4]), "+v"(c[5]), "+v"(c[6]), "+v"(c[7]));
        asm volatile("" : "+v"(s[0]), "+v"(s[1]), "+v"(s[2]), "+v"(s[3]), "+v"(s[4]), "+v"(s[5]), "+v"(s[6]), "+v"(s[7]));
    }
    DI void operator()(const pg8::f32x4 (&acc)[2][2][4][2], const pg8::Unit& u, int wr, int wc, int fr, int fq) const {
        const int hs = u.pn * 4 + wc;
        if (hs >= 86) return;
        if ((MODE & 2) && hs >= 20 && hs != 44 && !(hs >= 36 && hs < 40)) return;
        if ((MODE & 4) && hs < 20) return;
        const bool samp = u.pm >= 64;
        const int d0 = 8 * fq;
        const bool roped = hs < 8 || (hs >= 12 && hs < 14) || (hs >= 16 && hs < 18) || (hs >= 28 && hs < 36) || hs == 36 || hs == 37 || (hs >= 40 && hs <= 44);
        float rc[8], rs[8], dc[8], ds[8];
        if (roped) { if (samp) {
#pragma unroll
                for (int j = 0; j < 8; ++j) { dc[j] = 1.f; ds[j] = 0.f; }
            } else ldtab(dc, ds, 16, d0); }
#pragma unroll
        for (int ai = 0; ai < 2; ++ai)
#pragma unroll
            for (int m = 0; m < 4; ++m) {
                const int r = u.pm * 256 + ai * 128 + wr * 64 + m * 16 + fr;
                if (roped) {
                    if (m == 0) ldtab(rc, rs, samp ? PASTL + (r & 3) : (r & 4095), d0);
                    else {
#pragma unroll
                        for (int j = 0; j < 8; ++j) { const float a = rc[j], b = rs[j]; rc[j] = a * dc[j] - b * ds[j]; rs[j] = b * dc[j] + a * ds[j]; }
                    }
                }
                int b, t, pos;
                if (!samp) { b = r >> 12; t = r & 4095; pos = t; } else { b = (r - MP) >> 2; t = r & 3; pos = PASTL + t; }
                float lo[8], hi[8];
#pragma unroll
                for (int n = 0; n < 2; ++n)
#pragma unroll
                    for (int j = 0; j < 4; ++j) { lo[4 * n + j] = acc[ai][0][m][n][j]; hi[4 * n + j] = acc[ai][1][m][n][j]; }
                if (hs < 8) {
                    bf16* qa = (bf16*)(ws + WS_QRAW) + (size_t)r * 512 + hs * 64 + d0;
                    bf16* qb = (bf16*)(ws + WS_QROT) + (size_t)r * 512 + hs * 64 + d0;
                    float a[8], c[8];
#pragma unroll
                    for (int j = 0; j < 8; ++j) { a[j] = lo[j] * C2; c[j] = hi[j] * C2; }
                    st_bf8(qa, a); st_bf8(qa + 32, c);
                    rope8(lo, hi, rc, rs);
#pragma unroll
                    for (int j = 0; j < 8; ++j) { a[j] = lo[j] * C2; c[j] = hi[j] * C2; }
                    st_bf8(qb, a); st_bf8(qb + 32, c);
                } else if (hs < 20) {
                    const int ty = (hs - 8) >> 1, g = (hs - 8) & 1;
                    if (ty == 2 || ty == 4) rope8(lo, hi, rc, rs);
                    const int bg = b * 2 + g;
                    if (ty < 4) {
                        float* o = out + (samp ? O_NSAS + ((size_t)(r - MP) * 8 + ty * 2 + g) * 64 : O_NSAP + ((size_t)r * 8 + ty * 2 + g) * 64) + d0;
                        st_f8(o, lo); st_f8(o + 32, hi);
                    } else {
                        const int sl = ty - 4;
                        if (samp) { float* o = out + O_WINS + (((size_t)b * 512 + 508 + t) * 4 + sl * 2 + g) * 64 + d0; st_f8(o, lo); st_f8(o + 32, hi); }
                        else if (t >= SEQ - 512) { float* o = out + O_WINP + (((size_t)b * 512 + (t - (SEQ - 512))) * 4 + sl * 2 + g) * 64 + d0; st_f8(o, lo); st_f8(o + 32, hi); }
                    }
                    if (ty == 3 || ty == 5) {
                        size_t pitch; int kp; bf16* base;
                        if (!samp) { pitch = SEQ; kp = t; base = (bf16*)(ws + (ty == 3 ? WS_PSLCVT : WS_PWINVT)); }
                        else if (ty == 3) { pitch = LS; kp = PASTL + t; base = (bf16*)(ws + WS_SSLCVT); }
                        else { pitch = LSW; kp = 512 + t; base = (bf16*)(ws + WS_SWINVT); }
                        bf16* p = base + ((size_t)bg * 64 + d0) * pitch + permk(kp);
                        if (!(MODE & 1)) { st_vt8(p, pitch, lo); st_vt8(p + 32 * pitch, pitch, hi); }
                    } else {
                        size_t rowi; bf16* base;
                        if (!samp) { rowi = (size_t)bg * SEQ + t; base = (bf16*)(ws + (ty == 0 ? WS_PCMPK : ty == 1 ? WS_PCMPV : ty == 2 ? WS_PSLCK : WS_PWINK)); }
                        else if (ty == 4) { rowi = (size_t)bg * LSW + 512 + t; base = (bf16*)(ws + WS_SWINK); }
                        else { rowi = (size_t)bg * LS + PASTL + t; base = (bf16*)(ws + (ty == 0 ? WS_SCMPK : ty == 1 ? WS_SCMPV : WS_SSLCK)); }
                        bf16* p = base + rowi * 64 + d0;
                        st_bf8(p, lo); st_bf8(p + 32, hi);
                    }
                } else if (hs < 28 || (hs >= 45 && hs < 53)) {
                    const int h = hs < 28 ? hs - 20 : hs - 45;
                    bf16* p = (bf16*)(ws + (hs < 28 ? WS_ZN : WS_ZD)) + (size_t)r * 512 + h * 64 + d0;
#pragma unroll
                    for (int j = 0; j < 8; ++j) { lo[j] = silu_f(lo[j]); hi[j] = silu_f(hi[j]); }
                    st_bf8(p, lo); st_bf8(p + 32, hi);
                } else if (hs < 36) {
                    rope8(lo, hi, rc, rs);
#pragma unroll
                    for (int j = 0; j < 8; ++j) { lo[j] *= C2; hi[j] *= C2; }
                    bf16* p = (bf16*)(ws + WS_DQ) + (size_t)r * 512 + (hs - 28) * 64 + d0;
                    st_bf8(p, lo); st_bf8(p + 32, hi);
                } else if (hs < 40) {
                    const int sl = (hs - 36) >> 1, g = (hs - 36) & 1, bg = b * 2 + g;
                    if (sl == 0) rope8(lo, hi, rc, rs);
                    float* o = out + (samp ? O_DSAS + ((size_t)(r - MP) * 4 + sl * 2 + g) * 64 : O_DSAP + ((size_t)r * 4 + sl * 2 + g) * 64) + d0;
                    st_f8(o, lo); st_f8(o + 32, hi);
                    if (sl == 0) {
                        bf16* p = samp ? (bf16*)(ws + WS_SDSAK) + ((size_t)bg * LS + PASTL + t) * 64 + d0 : (bf16*)(ws + WS_PDSAK) + ((size_t)bg * SEQ + t) * 64 + d0;
                        st_bf8(p, lo); st_bf8(p + 32, hi);
                    } else {
                        const size_t pitch = samp ? LS : SEQ; const int kp = samp ? PASTL + t : t;
                        bf16* p = (bf16*)(ws + (samp ? WS_SDSAVT : WS_PDSAVT)) + ((size_t)bg * 64 + d0) * pitch + permk(kp);
                        if (!(MODE & 1)) { st_vt8(p, pitch, lo); st_vt8(p + 32 * pitch, pitch, hi); }
                    }
                } else if (hs < 44) {
                    rope8(lo, hi, rc, rs);
                    bf16* p = (bf16*)(ws + WS_IQ) + (size_t)r * 256 + (hs - 40) * 64 + d0;
                    st_bf8(p, lo); st_bf8(p + 32, hi);
                } else if (hs == 44) {
                    rope8(lo, hi, rc, rs);
                    float* o = out + (samp ? O_IDXS + (size_t)(r - MP) * 64 : O_IDXP + (size_t)r * 64) + d0;
                    st_f8(o, lo); st_f8(o + 32, hi);
                    bf16* p = samp ? (bf16*)(ws + WS_SIDXK) + ((size_t)b * LS + PASTL + t) * 64 + d0 : (bf16*)(ws + WS_PIDXK) + (size_t)r * 64 + d0;
                    st_bf8(p, lo); st_bf8(p + 32, hi);
                } else if (hs < 85) {
                    bf16* p = (bf16*)(ws + WS_MG) + (size_t)r * 2048 + (hs - 53) * 64 + d0;
#pragma unroll
                    for (int j = 0; j < 8; ++j) { lo[j] = sigm_f(lo[j]); hi[j] = sigm_f(hi[j]); }
                    st_bf8(p, lo); st_bf8(p + 32, hi);
                } else {
                    if (fq < 3) { float* p = (float*)(ws + WS_GATES) + (size_t)r * 24 + d0;
#pragma unroll
                        for (int j = 0; j < 8; ++j) lo[j] = sigm_f(lo[j]);
                        st_f8(p, lo);
                    } else { *(f32x4*)((float*)(ws + WS_IW) + (size_t)r * 4) = (f32x4){lo[0], lo[1], lo[2], lo[3]}; }
                }
            }
    }
};
typedef EpiInProjT<0> EpiInProj;
struct ColOrder {
    int nM, nN, cnt, rank, pn;
    __device__ void init(int M, int N, int G, int c) { nM = M / 256; nN = N / 256; pn = c % nN; rank = c / nN; cnt = G / nN + ((pn < G % nN) ? 1 : 0); }
    __device__ bool next(int i, pg8::Unit& u) const { const int pm = rank + i * cnt; if (pm >= nM) return false; u.pm = pm; u.pn = pn; return true; }
    __device__ __forceinline__ void a_ready(const pg8::Unit&) const {}
    __device__ __forceinline__ void done(const pg8::Unit&) const {}
};
struct EpiNull {
    static constexpr bool PERM = true, AFTER_DRAIN = false;
    unsigned char* ws;
    DI void operator()(const pg8::f32x4 (&acc)[2][2][4][2], const pg8::Unit& u, int wr, int wc, int fr, int fq) const {
        float s = 0.f;
#pragma unroll
        for (int ai = 0; ai < 2; ++ai)
#pragma unroll
            for (int bj = 0; bj < 2; ++bj)
#pragma unroll
                for (int m = 0; m < 4; ++m)
#pragma unroll
                    for (int n = 0; n < 2; ++n) s += acc[ai][bj][m][n][0] + acc[ai][bj][m][n][1] + acc[ai][bj][m][n][2] + acc[ai][bj][m][n][3];
        if (s == 1.2345e33f) *(float*)(ws + WS_CTL + 2048) = s;
    }
};
struct EpiUp1 {
    static constexpr bool PERM = true, AFTER_DRAIN = false;
    unsigned char* ws;
    DI void operator()(const pg8::f32x4 (&acc)[2][2][4][2], const pg8::Unit& u, int wr, int wc, int fr, int fq) const {
#pragma unroll
        for (int ai = 0; ai < 2; ++ai)
#pragma unroll
            for (int m = 0; m < 4; ++m) {
                const int r = u.pm * 256 + ai * 128 + wr * 64 + m * 16 + fr;
#pragma unroll
                for (int bj = 0; bj < 2; ++bj) {
                    const int c0 = u.pn * 256 + bj * 128 + wc * 32 + 8 * fq;
                    const u32x4 gw = *(const u32x4*)((const bf16*)(ws + WS_MG) + (size_t)r * 2048 + c0);
                    const f32x4 a0 = acc[ai][bj][m][0], a1 = acc[ai][bj][m][1];
                    u32x4 w; w.x = pk2(a0[0] * bflo(gw.x), a0[1] * bfhi(gw.x)); w.y = pk2(a0[2] * bflo(gw.y), a0[3] * bfhi(gw.y));
                    w.z = pk2(a1[0] * bflo(gw.z), a1[1] * bfhi(gw.z)); w.w = pk2(a1[2] * bflo(gw.w), a1[3] * bfhi(gw.w));
                    *(u32x4*)((bf16*)(ws + WS_T1) + (size_t)r * 1024 + c0) = w;
                }
            }
    }
};
struct EpiUp2 {
    static constexpr bool PERM = true, AFTER_DRAIN = false;
    unsigned char* ws;
    DI void operator()(const pg8::f32x4 (&acc)[2][2][4][2], const pg8::Unit& u, int wr, int wc, int fr, int fq) const {
#pragma unroll
        for (int ai = 0; ai < 2; ++ai)
#pragma unroll
            for (int m = 0; m < 4; ++m) {
                const int r = u.pm * 256 + ai * 128 + wr * 64 + m * 16 + fr;
#pragma unroll
                for (int bj = 0; bj < 2; ++bj) {
                    const int c0 = u.pn * 256 + bj * 128 + wc * 32 + 8 * fq;
                    const u32x4 gw = *(const u32x4*)((const bf16*)(ws + WS_MG) + (size_t)r * 2048 + 1024 + c0);
                    const u32x4 tw = *(const u32x4*)((const bf16*)(ws + WS_T1) + (size_t)r * 1024 + c0);
                    const f32x4 t0 = {bflo(tw.x), bfhi(tw.x), bflo(tw.y), bfhi(tw.y)}, t1 = {bflo(tw.z), bfhi(tw.z), bflo(tw.w), bfhi(tw.w)};
                    const f32x4 a0 = acc[ai][bj][m][0], a1 = acc[ai][bj][m][1];
                    u32x4 w;
                    w.x = pk2(t0[0] + a0[0] * bflo(gw.x), t0[1] + a0[1] * bfhi(gw.x)); w.y = pk2(t0[2] + a0[2] * bflo(gw.y), t0[3] + a0[3] * bfhi(gw.y));
                    w.z = pk2(t1[0] + a1[0] * bflo(gw.z), t1[1] + a1[1] * bfhi(gw.z)); w.w = pk2(t1[2] + a1[2] * bflo(gw.w), t1[3] + a1[3] * bfhi(gw.w));
                    *(u32x4*)((bf16*)(ws + WS_M1) + (size_t)r * 1024 + c0) = w;
                }
            }
    }
};
struct EpiOut {
    static constexpr bool PERM = true, AFTER_DRAIN = false;
    unsigned char* ws; float* out; const float* xp; const float* xs;
    DI void operator()(const pg8::f32x4 (&acc)[2][2][4][2], const pg8::Unit& u, int wr, int wc, int fr, int fq) const {
        const bool samp = u.pm >= 64;
#pragma unroll
        for (int ai = 0; ai < 2; ++ai)
#pragma unroll
            for (int m = 0; m < 4; ++m) {
                const int r = u.pm * 256 + ai * 128 + wr * 64 + m * 16 + fr;
                const int mrow = samp ? 4 + ((r - MP) >> 2) : (r >> 12);
                const float* xr = samp ? xs + (size_t)(r - MP) * 1024 : xp + (size_t)r * 1024;
                float* orow = samp ? out + O_YS + (size_t)(r - MP) * 1024 : out + O_YP + (size_t)r * 1024;
                const float* gr = (const float*)(ws + WS_MOD) + (size_t)mrow * 3072 + 2048;
#pragma unroll
                for (int bj = 0; bj < 2; ++bj) {
                    const int c0 = u.pn * 256 + bj * 128 + wc * 32 + 8 * fq;
#pragma unroll
                    for (int n = 0; n < 2; ++n) {
                        const f32x4 x4 = *(const f32x4*)(xr + c0 + 4 * n), g4 = *(const f32x4*)(gr + c0 + 4 * n);
                        *(f32x4*)(orow + c0 + 4 * n) = x4 + g4 * acc[ai][bj][m][n];
                    }
                }
            }
    }
};

DI int win_row(int col) {
    int hs, d;
    if (col < 1280) { hs = col >> 6; d = col & 63; }
    else if (col < 1304) { hs = 85; d = col - 1280; }
    else if (col < 2904) { const int c = col - 1304; hs = 20 + (c >> 6); d = c & 63; }
    else if (col < 2908) { hs = 85; d = 24 + (col - 2904); }
    else { const int c = col - 2908; hs = 45 + (c >> 6); d = c & 63; }
    return 256 * (hs >> 2) + 128 * (d >> 5) + 32 * (hs & 3) + (d & 31);
}
template <bool WINMAP> DI void p0_transpose_item(const float* W, int K, int N, bf16* WT, LAS float* scr, int item, int lane) {
    const int nblk = (N + 31) / 32, kb = item / nblk, nb = item % nblk, k0 = 64 * kb, n0 = 32 * nb;
    const bool nok = n0 + (lane & 31) < N;
    float tv[32];
#pragma unroll
    for (int i = 0; i < 32; ++i) { const int kk = 2 * i + (lane >> 5); tv[i] = nok ? W[(size_t)(k0 + kk) * N + n0 + (lane & 31)] : 0.f; }
#pragma unroll
    for (int i = 0; i < 32; ++i) { const int kk = 2 * i + (lane >> 5); scr[kk * 33 + (lane & 31)] = tv[i]; }
    LDS_WAIT();
    const int c = lane & 7;
#pragma unroll
    for (int j = 0; j < 4; ++j) { const int n = (lane >> 3) + 8 * j; const LAS float* s = scr + (8 * c) * 33 + n;
        u32x4 o; o.x = pk2(s[0 * 33], s[1 * 33]); o.y = pk2(s[2 * 33], s[3 * 33]); o.z = pk2(s[4 * 33], s[5 * 33]); o.w = pk2(s[6 * 33], s[7 * 33]);
        if (n0 + n < N) { const int row = WINMAP ? win_row(n0 + n) : (n0 + n); *(u32x4*)(WT + (size_t)row * K + k0 + 8 * c) = o; } }
    LDS_WAIT();
}
DI void p0_mod(Frame& F) {
    LAS float* wl = (LAS float*)F.lds;
    float* mod = WSP(float, WS_MOD);
    for (int cg = blockIdx.x; cg < 256; cg += F.G) {
        __syncthreads();
        for (int k = F.tid; k < 1024; k += NWAVES * 64) {
            const f32x4* src = (const f32x4*)(F.wada + (size_t)k * 3072 + cg * 12);
            LAS f32x4* dst = (LAS f32x4*)(wl + k * 12);
            dst[0] = src[0]; dst[1] = src[1]; dst[2] = src[2];
        }
        __syncthreads();
        float cv[16], cn[16];
        { const float* cr = F.wave < 4 ? F.cp + (size_t)F.wave * 1024 : F.cs + (size_t)(F.wave - 4) * 1024;
#pragma unroll
          for (int i = 0; i < 16; ++i) cn[i] = cr[F.lane + 64 * i]; }
        for (int r = F.wave; r < 132; r += NWAVES) {
#pragma unroll
            for (int i = 0; i < 16; ++i) cv[i] = cn[i];
            { const int rn = r + NWAVES < 132 ? r + NWAVES : r; const float* cr = rn < 4 ? F.cp + (size_t)rn * 1024 : F.cs + (size_t)(rn - 4) * 1024;
#pragma unroll
              for (int i = 0; i < 16; ++i) cn[i] = cr[F.lane + 64 * i]; }
            float a[12];
#pragma unroll
            for (int j = 0; j < 12; ++j) a[j] = 0.f;
#pragma unroll
            for (int i = 0; i < 16; ++i) {
                const int k = F.lane + 64 * i; const float s = silu_f(cv[i]);
                const LAS f32x4* wp = (const LAS f32x4*)(wl + k * 12);
                const f32x4 w0 = wp[0], w1 = wp[1], w2 = wp[2];
                a[0] += s * w0[0]; a[1] += s * w0[1]; a[2] += s * w0[2]; a[3] += s * w0[3];
                a[4] += s * w1[0]; a[5] += s * w1[1]; a[6] += s * w1[2]; a[7] += s * w1[3];
                a[8] += s * w2[0]; a[9] += s * w2[1]; a[10] += s * w2[2]; a[11] += s * w2[3];
                if ((i & 3) == 3) __builtin_amdgcn_sched_barrier(0);
            }
            float v = 0.f;
#pragma unroll
            for (int j = 0; j < 12; ++j) { const float sj = wave_sum(a[j]); v = (F.lane == j) ? sj : v; }
            if (F.lane < 12) mod[(size_t)r * 3072 + cg * 12 + F.lane] = v + F.bada[cg * 12 + F.lane];
        }
    }
    __syncthreads();
}
__device__ const double ROPE_INV[32] = {
    1.0, 0.7498942093324559, 0.5623413251903491, 0.4216965034285822, 0.31622776601683794, 0.23713737056616552, 0.1778279410038923, 0.1333521432163324,
    0.1, 0.07498942093324559, 0.05623413251903491, 0.04216965034285822, 0.03162277660168379, 0.023713737056616554, 0.01778279410038923, 0.01333521432163324,
    0.01, 0.007498942093324559, 0.005623413251903491, 0.004216965034285822, 0.0031622776601683794, 0.0023713737056616554, 0.0017782794100389228, 0.001333521432163324,
    0.001, 0.0007498942093324559, 0.0005623413251903491, 0.0004216965034285822, 0.00031622776601683794, 0.00023713737056616554, 0.00017782794100389227, 0.0001333521432163324};
DI void p0_rope_item(Frame& F, int item) {
    const int pos = 2 * item + (F.lane >> 5), d = F.lane & 31;
    if (pos >= 4100) return;
    const double ang = (double)pos * ROPE_INV[d];
    const double kq = __builtin_rint(ang * 0.6366197723675814);
    double r = __builtin_fma(-kq, 1.5707963267948966, ang); r = __builtin_fma(-kq, 6.123233995736766e-17, r);
    const int q = (int)kq & 3;
    const double r2 = r * r;
    const double sn = r * (1.0 + r2 * (-1.0 / 6 + r2 * (1.0 / 120 + r2 * (-1.0 / 5040 + r2 * (1.0 / 362880 + r2 * (-1.0 / 39916800 + r2 * (1.0 / 6227020800.0)))))));
    const double cs = 1.0 + r2 * (-0.5 + r2 * (1.0 / 24 + r2 * (-1.0 / 720 + r2 * (1.0 / 40320 + r2 * (-1.0 / 3628800 + r2 * (1.0 / 479001600.0 + r2 * (-1.0 / 87178291200.0)))))));
    const double c = (q == 0) ? cs : (q == 1) ? -sn : (q == 2) ? -cs : sn;
    const double s = (q == 0) ? sn : (q == 1) ? cs : (q == 2) ? -sn : -cs;
    WSP(float, WS_COS)[pos * 32 + d] = (float)c; WSP(float, WS_SIN)[pos * 32 + d] = (float)s;
}
DI void p0_cmp_small_item(Frame& F, int item) {
    if (item < 256) {
        const int slot = item >> 7, ch = (item >> 6) & 1, kc = item & 63, c = ch * 64 + F.lane; float a = 0.f;
#pragma unroll 8
        for (int i = 0; i < 32; ++i) { const int k = kc * 32 + i; a += F.pe[slot * 2048 + k] * F.w1[((size_t)slot * 2048 + k) * 128 + c]; }
        WSP(float, WS_BIASP)[(size_t)kc * 256 + slot * 128 + c] = a;
    } else {
        const int it = item - 256, slot = it >> 7, e = (it & 127) >> 1, ch = it & 1;
        const int c = ch * 64 + F.lane;
        WSP(bf16, WS_W2T)[((size_t)slot * 64 + e) * 128 + permk(c)] = (bf16)(pk2(F.w2[((size_t)slot * 128 + c) * 64 + e], 0.f) & 0xffffu);
    }
}
DI void cp_k16(const float* src, size_t rs, bf16* dst, int lane) {
    const int tk = lane >> 2, dc = (lane & 3) * 16;
    const f32x4* s = (const f32x4*)(src + (size_t)tk * rs + dc);
    const f32x4 a = s[0], b = s[1], c = s[2], d = s[3];
    u32x4 w0, w1; w0.x = pk2(a[0], a[1]); w0.y = pk2(a[2], a[3]); w0.z = pk2(b[0], b[1]); w0.w = pk2(b[2], b[3]);
    w1.x = pk2(c[0], c[1]); w1.y = pk2(c[2], c[3]); w1.z = pk2(d[0], d[1]); w1.w = pk2(d[2], d[3]);
    u32x4* o = (u32x4*)(dst + (size_t)tk * 64 + dc); o[0] = w0; o[1] = w1;
}
DI void cp_vt16(const float* src, size_t rs, bf16* dst, size_t pitch, int lane) {
#pragma unroll
    for (int h = 0; h < 2; ++h) {
        float v[8];
#pragma unroll
        for (int i = 0; i < 8; ++i) v[i] = src[(size_t)((i & 3) + 8 * (i >> 2) + 4 * h) * rs + lane];
        *(u32x4*)(dst + (size_t)lane * pitch + 8 * h) = pack8(v);
    }
}
DI void p0_gather_item(Frame& F, int item) {
    const int sb = item >> 7, tg = item & 127, tk0 = tg * 16, lane = F.lane;
    const int pg = F.ptab[sb * NPG + (tk0 >> 7)], j0 = tk0 & 127;
    const float* nsa = F.cnsa + ((size_t)pg * PAGE + j0) * 512;
    const float* dsa = F.cdsa + ((size_t)pg * PAGE + j0) * 256;
    const float* idx = F.cidx + ((size_t)pg * PAGE + j0) * 64;
#pragma unroll
    for (int g = 0; g < 2; ++g) {
        const size_t bg = (size_t)sb * 2 + g;
        cp_k16(nsa + (0 * 2 + g) * 64, 512, WSP(bf16, WS_SCMPK) + (bg * LS + tk0) * 64, lane);
        cp_k16(nsa + (1 * 2 + g) * 64, 512, WSP(bf16, WS_SCMPV) + (bg * LS + tk0) * 64, lane);
        cp_k16(nsa + (2 * 2 + g) * 64, 512, WSP(bf16, WS_SSLCK) + (bg * LS + tk0) * 64, lane);
        cp_vt16(nsa + (3 * 2 + g) * 64, 512, WSP(bf16, WS_SSLCVT) + bg * 64 * LS + tk0, LS, lane);
        cp_k16(dsa + (0 * 2 + g) * 64, 256, WSP(bf16, WS_SDSAK) + (bg * LS + tk0) * 64, lane);
        cp_vt16(dsa + (1 * 2 + g) * 64, 256, WSP(bf16, WS_SDSAVT) + bg * 64 * LS + tk0, LS, lane);
    }
    cp_k16(idx, 64, WSP(bf16, WS_SIDXK) + ((size_t)sb * LS + tk0) * 64, lane);
}
DI void p0_win_item(Frame& F, int item) {
    const int sb = item >> 5, w0 = (item & 31) * 16, lane = F.lane;
    const float* st = F.swin + ((size_t)sb * 512 + w0) * 256;
#pragma unroll
    for (int g = 0; g < 2; ++g) {
        const size_t bg = (size_t)sb * 2 + g;
        cp_k16(st + (0 * 2 + g) * 64, 256, WSP(bf16, WS_SWINK) + (bg * LSW + w0) * 64, lane);
        cp_vt16(st + (1 * 2 + g) * 64, 256, WSP(bf16, WS_SWINVT) + bg * 64 * LSW + w0, LSW, lane);
    }
}
DI void p0_zero_item(Frame& F, int item) {
    const int arr = item >> 8, bg = item & 255, lane = F.lane;
    bf16* p; int n;
    if (arr == 0) { p = WSP(bf16, WS_SSLCVT) + ((size_t)bg * 64 + lane) * LS + 2052; n = 60; }
    else if (arr == 1) { p = WSP(bf16, WS_SDSAVT) + ((size_t)bg * 64 + lane) * LS + 2052; n = 60; }
    else { p = WSP(bf16, WS_SWINVT) + ((size_t)bg * 64 + lane) * LSW + 516; n = 60; }
    unsigned long long* q = (unsigned long long*)p;
    for (int i = 0; i < n / 4; ++i) q[i] = 0ull;
}
DI void p0_prologue(Frame& F, int um) {
    if (um & 1) p0_mod(F);
    LAS float* scr = (LAS float*)(F.lds + F.wave * 16384);
    const int gw = blockIdx.x * NWAVES + F.wave, NGW = F.G * NWAVES;
    constexpr int I_WIN = 16 * 171, I_UP = 8 * 32, I_OUT = 16 * 32, I_W1 = 32 * 4;
    constexpr int T0 = I_WIN, T1 = T0 + I_UP, T2 = T1 + I_UP, T3 = T2 + I_OUT, T4 = T3 + 2 * I_W1, T5 = T4 + 2050, T6 = T5 + 512, T7 = T6 + 768, T8 = T7 + SBATCH * 32, T9 = T8 + SBATCH * 128;
#ifdef ORACLE
    constexpr int TEND = T9;
#else
    constexpr int TEND = T7;
#endif
    if (um & 2) for (int it = gw; it < TEND; it += NGW) {
        if (it < T0) p0_transpose_item<true>(F.win, 1024, 5468, WSP(bf16, WS_WINT), scr, it, F.lane);
        else if (it < T1) p0_transpose_item<false>(F.wupn, 512, 1024, WSP(bf16, WS_WUPN), scr, it - T0, F.lane);
        else if (it < T2) p0_transpose_item<false>(F.wupd, 512, 1024, WSP(bf16, WS_WUPD), scr, it - T1, F.lane);
        else if (it < T3) p0_transpose_item<false>(F.wout, 1024, 1024, WSP(bf16, WS_WOUT), scr, it - T2, F.lane);
        else if (it < T4) { const int q = it - T3, slot = q / I_W1; p0_transpose_item<false>(F.w1 + (size_t)slot * 2048 * 128, 2048, 128, WSP(bf16, WS_W1T) + (size_t)slot * 128 * 2048, scr, q % I_W1, F.lane); }
        else if (it < T5) p0_rope_item(F, it - T4);
        else if (it < T6) p0_cmp_small_item(F, it - T5);
        else if (it < T7) p0_zero_item(F, it - T6);
#ifdef ORACLE
        else if (it < T8) p0_win_item(F, it - T7);
        else p0_gather_item(F, it - T8);
#endif
    }
    constexpr int ROW4 = 508 * 64;
    const f32x4* src = (const f32x4*)F.swin; f32x4* dst = (f32x4*)(F.out + O_WINS);
    if (um & 4) for (int it = blockIdx.x; it < 2 * SBATCH; it += F.G) {
        const int sb = it >> 1, h0 = (it & 1) * (ROW4 / 2);
        const f32x4* sp = src + (size_t)sb * 512 * 64 + 4 * 64 + h0; f32x4* dp = dst + (size_t)sb * 512 * 64 + h0;
        for (int i = F.tid; i < ROW4 / 2; i += 512 * 8) {
            f32x4 v[8];
#pragma unroll
            for (int j = 0; j < 8; ++j) { const int k = i + j * 512; v[j] = k < ROW4 / 2 ? __builtin_nontemporal_load(sp + k) : (f32x4){0.f, 0.f, 0.f, 0.f}; }
#pragma unroll
            for (int j = 0; j < 8; ++j) { const int k = i + j * 512; if (k < ROW4 / 2) __builtin_nontemporal_store(v[j], dp + k); }
        }
    }
}
DI void p1_adaln(Frame& F) {
    const int gw = blockIdx.x * NWAVES + F.wave, NGW = F.G * NWAVES;
    if (blockIdx.x == 0 && F.tid < 256) { float a = 0.f; for (int j = 0; j < 64; ++j) a += WSP(float, WS_BIASP)[j * 256 + F.tid]; WSP(float, WS_BIAS1)[F.tid] = a; }
    const float* mod = WSP(float, WS_MOD);
    f32x4 nx[4];
    { const int r = gw < MR ? gw : MR - 1; const f32x4* x4 = (const f32x4*)(r < MP ? F.xp + (size_t)r * 1024 : F.xs + (size_t)(r - MP) * 1024) + F.lane;
#pragma unroll
      for (int j = 0; j < 4; ++j) nx[j] = x4[64 * j]; }
    for (int r = gw; r < MR; r += NGW) {
        const int mrow = r < MP ? (r >> 12) : 4 + ((r - MP) >> 2);
        f32x4 v[4]; float s = 0.f;
#pragma unroll
        for (int j = 0; j < 4; ++j) { v[j] = nx[j]; s += (v[j][0] * v[j][0] + v[j][1] * v[j][1]) + (v[j][2] * v[j][2] + v[j][3] * v[j][3]); }
        { const int rn = r + NGW < MR ? r + NGW : r; const f32x4* x4 = (const f32x4*)(rn < MP ? F.xp + (size_t)rn * 1024 : F.xs + (size_t)(rn - MP) * 1024) + F.lane;
#pragma unroll
          for (int j = 0; j < 4; ++j) nx[j] = x4[64 * j]; }
        const float rstd = 1.f / sqrtf(wave_sum(s) * (1.f / 1024.f) + 1e-6f);
        const f32x4* g4 = (const f32x4*)F.normg + F.lane;
        const f32x4* sh4 = (const f32x4*)(mod + (size_t)mrow * 3072) + F.lane;
        const f32x4* sc4 = (const f32x4*)(mod + (size_t)mrow * 3072 + 1024) + F.lane;
        unsigned long long* o8 = (unsigned long long*)(WSP(bf16, WS_H) + (size_t)r * 1024) + F.lane;
#pragma unroll
        for (int j = 0; j < 4; ++j) {
            const f32x4 y = v[j] * rstd * g4[64 * j]; const f32x4 h = y * (1.f + sc4[64 * j]) + sh4[64 * j];
            o8[64 * j] = (unsigned long long)pk2(h[0], h[1]) | ((unsigned long long)pk2(h[2], h[3]) << 32);
        }
    }
}
DI void p8_final(Frame& F) {
    const int gw = blockIdx.x * NWAVES + F.wave, NGW = F.G * NWAVES;
    f32x4 nx[4];
    { const int r = gw < MR ? gw : MR - 1; const f32x4* y4 = (const f32x4*)(r < MP ? F.out + O_YP + (size_t)r * 1024 : F.out + O_YS + (size_t)(r - MP) * 1024) + F.lane;
#pragma unroll
      for (int j = 0; j < 4; ++j) nx[j] = y4[64 * j]; }
    for (int r = gw; r < MR; r += NGW) {
        float* yr = r < MP ? F.out + O_YP + (size_t)r * 1024 : F.out + O_YS + (size_t)(r - MP) * 1024;
        f32x4* y4 = (f32x4*)yr + F.lane;
        f32x4 v[4]; float s = 0.f;
#pragma unroll
        for (int j = 0; j < 4; ++j) { v[j] = nx[j]; s += (v[j][0] * v[j][0] + v[j][1] * v[j][1]) + (v[j][2] * v[j][2] + v[j][3] * v[j][3]); }
        { const int rn = r + NGW < MR ? r + NGW : r; const f32x4* n4 = (const f32x4*)(rn < MP ? F.out + O_YP + (size_t)rn * 1024 : F.out + O_YS + (size_t)(rn - MP) * 1024) + F.lane;
#pragma unroll
          for (int j = 0; j < 4; ++j) nx[j] = n4[64 * j]; }
        const float rstd = 1.f / sqrtf(wave_sum(s) * (1.f / 1024.f) + 1e-6f);
        const f32x4* g4 = (const f32x4*)F.fing + F.lane;
#pragma unroll
        for (int j = 0; j < 4; ++j) y4[64 * j] = v[j] * rstd * g4[64 * j];
    }
}

constexpr int TP = 144;
constexpr int TILE_B = 64 * TP;
struct LdsT {
    static constexpr bool HOIST = true;
    const LAS unsigned char* p;
    DI bf16x8 frag(int mt, int s) const { return *(const LAS bf16x8*)(p + mt * 32 * TP + s * 32); }
};
struct GlbT {
    static constexpr bool HOIST = false;
    const bf16* base; unsigned off; unsigned pitch;
    DI bf16x8 frag(int mt, int s) const { return *(const bf16x8*)(base + (size_t)(off + (unsigned)mt * 32u * pitch + (unsigned)s * 16u)); }
};
template <class KT> DI void qk_tile(f32x16& s0, f32x16& s1, const KT& kt, const bf16x8 (&q)[4]) {
    f32x16 z;
#pragma unroll
    for (int i = 0; i < 16; ++i) z[i] = 0.f;
    s0 = z; s1 = z;
#pragma unroll
    for (int s = 0; s < 4; ++s) { s0 = MFMA32(kt.frag(0, s), q[s], s0); s1 = MFMA32(kt.frag(1, s), q[s], s1); }
}
DI bf16x8 cvt8(f32x4 a, f32x4 b) { u32x4 w; w.x = pk2(a[0], a[1]); w.y = pk2(a[2], a[3]); w.z = pk2(b[0], b[1]); w.w = pk2(b[2], b[3]); return __builtin_bit_cast(bf16x8, w); }
DI bf16x8 pack_p(const f32x16& x, int h) {
    u32x4 w; w.x = pk2(x[8 * h], x[8 * h + 1]); w.y = pk2(x[8 * h + 2], x[8 * h + 3]); w.z = pk2(x[8 * h + 4], x[8 * h + 5]); w.w = pk2(x[8 * h + 6], x[8 * h + 7]);
    return __builtin_bit_cast(bf16x8, w);
}
template <class VT> DI void pv_tile(f32x16& o0, f32x16& o1, const f32x16& p0, const f32x16& p1, const VT& vt) {
    const bf16x8 b0 = pack_p(p0, 0), b1 = pack_p(p0, 1), b2 = pack_p(p1, 0), b3 = pack_p(p1, 1);
    o0 = MFMA32(vt.frag(0, 0), b0, o0); o1 = MFMA32(vt.frag(1, 0), b0, o1);
    o0 = MFMA32(vt.frag(0, 1), b1, o0); o1 = MFMA32(vt.frag(1, 1), b1, o1);
    o0 = MFMA32(vt.frag(0, 2), b2, o0); o1 = MFMA32(vt.frag(1, 2), b2, o1);
    o0 = MFMA32(vt.frag(0, 3), b3, o0); o1 = MFMA32(vt.frag(1, 3), b3, o1);
}
struct Soft { float m, l; bool seen; f32x16 o0, o1, negm; };
DI void soft_init(Soft& S) {
    S.m = 0.f; S.l = 0.f; S.seen = false;
#pragma unroll
    for (int i = 0; i < 16; ++i) { S.o0[i] = 0.f; S.o1[i] = 0.f; S.negm[i] = 0.f; }
}
template <class KT> DI void qk_tile_c(f32x16& s0, f32x16& s1, const KT& kt, const bf16x8 (&q)[4], const f32x16& c) {
    if constexpr (KT::HOIST) {
        bf16x8 f[8];
#pragma unroll
        for (int s = 0; s < 4; ++s) { f[2 * s] = kt.frag(0, s); f[2 * s + 1] = kt.frag(1, s); }
        __builtin_amdgcn_sched_barrier(0);
        s0 = MFMA32(f[0], q[0], c); s1 = MFMA32(f[1], q[0], c);
#pragma unroll
        for (int s = 1; s < 4; ++s) { s0 = MFMA32(f[2 * s], q[s], s0); s1 = MFMA32(f[2 * s + 1], q[s], s1); }
    } else {
        s0 = MFMA32(kt.frag(0, 0), q[0], c); s1 = MFMA32(kt.frag(1, 0), q[0], c);
#pragma unroll
        for (int s = 1; s < 4; ++s) { s0 = MFMA32(kt.frag(0, s), q[s], s0); s1 = MFMA32(kt.frag(1, s), q[s], s1); }
    }
    asm volatile("s_nop 15\n\ts_nop 7" : "+v"(s0), "+v"(s1));
}
DI float max3f(float a, float b, float c) { float r; asm("v_max3_f32 %0, %1, %2, %3" : "=v"(r) : "v"(a), "v"(b), "v"(c)); return r; }
template <class VT> DI void soft_step(Soft& S, f32x16& s0, f32x16& s1, const VT& vt) {
    bf16x8 vf[8];
    if constexpr (VT::HOIST) {
#pragma unroll
        for (int s = 0; s < 4; ++s) { vf[2 * s] = vt.frag(0, s); vf[2 * s + 1] = vt.frag(1, s); }
        __builtin_amdgcn_sched_barrier(0);
    }
    float mx = max3f(s0[0], s1[0], s0[1]), my = max3f(s1[1], s0[2], s1[2]);
#pragma unroll
    for (int r = 3; r < 15; r += 2) { mx = max3f(mx, s0[r], s1[r]); my = max3f(my, s0[r + 1], s1[r + 1]); }
    mx = max3f(mx, s0[15], s1[15]); mx = max3f(mx, my, mx);
    mx = max3f(mx, half_other(mx), mx);
    const bool fin = mx > NEGINF;
    const bool need = (mx > 8.f) | (fin & !S.seen);
    if (__any(need)) {
        const float dl = need ? mx : 0.f;
        const float al = S.seen ? __builtin_amdgcn_exp2f(-dl) : 0.f;
        S.m += dl; S.l *= need ? al : 1.f;
        const float am = need ? al : 1.f;
#pragma unroll
        for (int r = 0; r < 16; ++r) { s0[r] -= dl; s1[r] -= dl; S.o0[r] *= am; S.o1[r] *= am; S.negm[r] = -S.m; }
    }
    S.seen = S.seen | fin;
    float ps = 0.f;
#pragma unroll
    for (int r = 0; r < 16; ++r) { s0[r] = __builtin_amdgcn_exp2f(s0[r]); s1[r] = __builtin_amdgcn_exp2f(s1[r]); ps += s0[r] + s1[r]; }
    S.l += ps;
    const bf16x8 b0 = pack_p(s0, 0), b1 = pack_p(s0, 1), b2 = pack_p(s1, 0), b3 = pack_p(s1, 1);
    if constexpr (!VT::HOIST) {
#pragma unroll
        for (int s = 0; s < 4; ++s) { vf[2 * s] = vt.frag(0, s); vf[2 * s + 1] = vt.frag(1, s); }
    }
    S.o0 = MFMA32(vf[0], b0, S.o0); S.o1 = MFMA32(vf[1], b0, S.o1);
    S.o0 = MFMA32(vf[2], b1, S.o0); S.o1 = MFMA32(vf[3], b1, S.o1);
    S.o0 = MFMA32(vf[4], b2, S.o0); S.o1 = MFMA32(vf[5], b2, S.o1);
    S.o0 = MFMA32(vf[6], b3, S.o0); S.o1 = MFMA32(vf[7], b3, S.o1);
}
DI float as_f(int x) { return __int_as_float(x); }
DI float mask_sel(float s, int mm) { return __int_as_float((__float_as_int(s) & mm) | ((int)0xff800000 & ~mm)); }
DI u32x4 tile_ld(const bf16* g, size_t pitch, int tid) { return *(const u32x4*)(g + (size_t)(tid >> 3) * pitch + (tid & 7) * 8); }
DI void tile_st(LAS unsigned char* buf, u32x4 v, int tid) { *(LAS u32x4*)(buf + (tid >> 3) * TP + (tid & 7) * 16) = v; }

constexpr int CP = 272;
DI void compress_unit(Frame& F, int u) {
    const int tid = F.tid, lane = F.lane, w = F.wave, l31 = lane & 31, hi = lane >> 5;
    const int slot = u / 136, rem = u % 136;
    const bf16* data; bf16 *ock, *ocvt; int n0, ncmp, cpitch;
    if (rem < 8) { const int bg = rem; data = WSP(bf16, (slot ? WS_PCMPV : WS_PCMPK)) + (size_t)bg * SEQ * 64; n0 = 32 * w; ncmp = 255; cpitch = 256;
        ock = WSP(bf16, WS_PCK) + (size_t)bg * 256 * 64; ocvt = WSP(bf16, WS_PCVT) + (size_t)bg * 64 * 256; }
    else { const int bg = 2 * (rem - 8) + (w >> 2); data = WSP(bf16, (slot ? WS_SCMPV : WS_SCMPK)) + (size_t)bg * LS * 64; n0 = 32 * (w & 3); ncmp = 127; cpitch = 128;
        ock = WSP(bf16, WS_SCK) + (size_t)bg * 128 * 64; ocvt = WSP(bf16, WS_SCVT) + (size_t)bg * 64 * 128; }
    const int n = n0 + l31, nc = n < ncmp ? n : ncmp - 1;
    const bf16* drow = data + (size_t)nc * 1024 + 8 * hi;
    const bool paged = rem >= 8;
    const float *prA = nullptr, *prB = nullptr; int jsplit = 64;
    if (paged) { const int bg = 2 * (rem - 8) + (w >> 2), sb = bg >> 1, g = bg & 1, t0 = 16 * nc;
        const int pgA = F.ptab[sb * NPG + (t0 >> 7)], pgB = F.ptab[sb * NPG + ((t0 + 31) >> 7)];
        jsplit = 128 - (t0 & 127);
        prA = F.cnsa + ((size_t)pgA * PAGE + (t0 & 127)) * 512 + (slot * 2 + g) * 64 + 8 * hi;
        prB = F.cnsa + ((size_t)pgB * PAGE) * 512 + (slot * 2 + g) * 64 + 8 * hi - (size_t)jsplit * 512;
    }
    const bf16* w1t = WSP(bf16, WS_W1T) + (size_t)slot * 128 * 2048;
    f32x16 acc[4];
#pragma unroll
    for (int c = 0; c < 4; ++c)
#pragma unroll
        for (int i = 0; i < 16; ++i) acc[c][i] = 0.f;
    const bf16* wsrc = w1t + (size_t)(tid >> 2) * 2048 + ((tid & 3) >> 1) * 1024 + (tid & 1) * 32;
    LAS unsigned char* wdst = F.lds + (tid >> 2) * CP + (tid & 3) * 64;
    u32x4 st[4];
#pragma unroll
    for (int i = 0; i < 4; ++i) st[i] = ((const u32x4*)wsrc)[i];
#pragma unroll
    for (int i = 0; i < 4; ++i) ((LAS u32x4*)wdst)[i] = st[i];
    LDS_BARRIER();
    f32x4 raw[16];
#define CMP_ISSUE(kc_) do { if (!paged) { _Pragma("unroll") for (int s_ = 0; s_ < 8; ++s_) raw[2 * s_] = __builtin_bit_cast(f32x4, *(const bf16x8*)(drow + ((kc_) + 16 * (s_ >> 2)) * 64 + (s_ & 3) * 16)); } \
        else { _Pragma("unroll") for (int s_ = 0; s_ < 8; ++s_) { const int j_ = (kc_) + 16 * (s_ >> 2); const f32x4* q_ = (const f32x4*)((j_ < jsplit ? prA : prB) + (size_t)j_ * 512 + 16 * (s_ & 3)); raw[2 * s_] = q_[0]; raw[2 * s_ + 1] = q_[1]; } } } while (0)
    CMP_ISSUE(0);
    for (int kc = 0; kc < 16; ++kc) {
        const LAS unsigned char* buf = F.lds + (kc & 1) * (128 * CP);
        if (kc + 1 < 16) {
#pragma unroll
            for (int i = 0; i < 4; ++i) st[i] = ((const u32x4*)(wsrc + (kc + 1) * 64))[i];
        }
        bf16x8 bq[8];
        if (!paged) {
#pragma unroll
            for (int s = 0; s < 8; ++s) bq[s] = __builtin_bit_cast(bf16x8, raw[2 * s]);
        } else {
#pragma unroll
            for (int s = 0; s < 8; ++s) bq[s] = cvt8(raw[2 * s], raw[2 * s + 1]);
        }
        if (kc + 1 < 16) CMP_ISSUE(kc + 1);
#pragma unroll
        for (int s = 0; s < 8; ++s)
#pragma unroll
            for (int c = 0; c < 4; ++c) acc[c] = MFMA32(*(const LAS bf16x8*)(buf + (32 * c + l31) * CP + s * 32 + hi * 16), bq[s], acc[c]);
        if (kc + 1 < 16) {
            LAS unsigned char* nb = wdst + ((kc + 1) & 1) * (128 * CP);
#pragma unroll
            for (int i = 0; i < 4; ++i) ((LAS u32x4*)nb)[i] = st[i];
        }
        LDS_BARRIER();
    }
#undef CMP_ISSUE
    const float* b1 = WSP(float, WS_BIAS1) + slot * 128;
#pragma unroll
    for (int c = 0; c < 4; ++c)
#pragma unroll
        for (int q = 0; q < 4; ++q) { const f32x4 bv = *(const f32x4*)(b1 + 32 * c + 8 * q + 4 * hi);
#pragma unroll
            for (int j = 0; j < 4; ++j) acc[c][4 * q + j] = silu_f(acc[c][4 * q + j] + bv[j]); }
    const bf16* w2t = WSP(bf16, WS_W2T) + (size_t)slot * 64 * 128 + (size_t)l31 * 128 + 8 * hi;
    f32x16 o0, o1;
#pragma unroll
    for (int i = 0; i < 16; ++i) { o0[i] = 0.f; o1[i] = 0.f; }
#pragma unroll
    for (int c = 0; c < 4; ++c)
#pragma unroll
        for (int h = 0; h < 2; ++h) { const bf16x8 hb = pack_p(acc[c], h); const int s2 = 2 * c + h;
            o0 = MFMA32(*(const bf16x8*)(w2t + s2 * 16), hb, o0); o1 = MFMA32(*(const bf16x8*)(w2t + 32 * 128 + s2 * 16), hb, o1); }
    const bool ok = n < ncmp;
    if (slot == 0) {
#pragma unroll
        for (int e = 0; e < 2; ++e)
#pragma unroll
            for (int q = 0; q < 4; ++q) { const f32x16& o = e ? o1 : o0; u32x2 wv;
                wv.x = ok ? pk2(o[4 * q], o[4 * q + 1]) : 0u; wv.y = ok ? pk2(o[4 * q + 2], o[4 * q + 3]) : 0u;
                *(u32x2*)(ock + (size_t)n * 64 + 32 * e + 8 * q + 4 * hi) = wv; }
    } else {
        const int pn = permk(n);
#pragma unroll
        for (int e = 0; e < 2; ++e)
#pragma unroll
            for (int r = 0; r < 16; ++r) { const f32x16& o = e ? o1 : o0; ocvt[(size_t)(32 * e + crow(r, hi)) * cpitch + pn] = ok ? (bf16)(pk2(o[r], 0.f) & 0xffffu) : (bf16)0; }
    }
}

template <int NR, int ABL> DI void idx_select(const LAS int* scw, int n, int lane, unsigned long long* out) {
    int k[NR];
    int kmin = 0x7fffffff, kmax = (int)0x80000000;
#pragma unroll
    for (int i = 0; i < NR; ++i) { const bool v = 64 * i + lane < n; const int x = v ? scw[64 * i + lane] : (int)0x80000000; k[i] = x; kmin = v ? (x < kmin ? x : kmin) : kmin; kmax = x > kmax ? x : kmax; }
    int thr = (int)0x80000000, cut = -1;
    if (n > 256 && !(ABL & 1)) {
        kmin = wave_min_i(kmin); kmax = wave_max_i(kmax);
        int lo = kmin - 1, hiv = kmax;
        bool found = false;
        if (hiv > 0x04000000) {
            const int kp = hiv - 0x03800000;
            int c = 0, cl = 0;
#pragma unroll
            for (int i0 = 0; i0 < NR; i0 += 8) {
                unsigned long long bm[4];
#pragma unroll
                for (int j = 0; j < 4; ++j) bm[j] = __ballot(k[i0 + j] > kp);
#pragma unroll
                for (int j = 4; j < 8; ++j) cl += (k[i0 + j] > kp) ? 1 : 0;
#pragma unroll
                for (int j = 0; j < 4; ++j) c += __popcll(bm[j]);
            }
            c += wave_sum_i(cl);
            if (c == 256) { thr = kp; found = true; } else if (c > 256) lo = kp; else hiv = kp;
        }
        while (!found && (unsigned)hiv - (unsigned)lo > 1u) {
            const int mid = (int)((unsigned)lo + (((unsigned)hiv - (unsigned)lo) >> 1));
            int c = 0, cl = 0;
#pragma unroll
            for (int i0 = 0; i0 < NR; i0 += 8) {
                unsigned long long bm[4];
#pragma unroll
                for (int j = 0; j < 4; ++j) bm[j] = __ballot(k[i0 + j] > mid);
#pragma unroll
                for (int j = 4; j < 8; ++j) cl += (k[i0 + j] > mid) ? 1 : 0;
#pragma unroll
                for (int j = 0; j < 4; ++j) c += __popcll(bm[j]);
            }
            c += wave_sum_i(cl);
            if (c == 256) { thr = mid; found = true; break; }
            if (c > 256) lo = mid; else hiv = mid;
        }
        if (!found) {
            thr = hiv; int cgt = 0;
#pragma unroll
            for (int i = 0; i < NR; ++i) cgt += __popcll(__ballot(k[i] > thr));
            const int need = 256 - cgt; int acc = 0; bool done = false;
#pragma unroll
            for (int i = 0; i < NR; ++i) {
                unsigned long long mk = __ballot(k[i] == thr); const int pc = __popcll(mk);
                if (!done && acc + pc >= need) { for (int q2 = 1; q2 < need - acc; ++q2) mk &= mk - 1; cut = 64 * i + (int)__builtin_ctzll(mk); done = true; }
                acc += pc;
            }
        }
    }
    unsigned long long myw = 0ull;
    if (ABL & 4) { myw = (unsigned long long)(k[0] + k[NR - 1] + kmin + kmax); } else
#pragma unroll
    for (int i = 0; i < NR; ++i) { const unsigned long long mk = __ballot((k[i] > thr) | ((k[i] == thr) & (64 * i + lane <= cut))); myw = (lane == i) ? mk : myw; }
    out[lane] = myw;
}
template <bool SAMPLE, int ABL> DI void idx1_unit(Frame& F, int u) {
    const int lane = F.lane, w = F.wave, l31 = lane & 31, hi = lane >> 5, tl = l31 >> 2, hl = l31 & 3;
    int row0, nkmax, ntok; const bf16* ik;
    if (!SAMPLE) { const int b = u & 3, tc = 511 - (u >> 2); row0 = b * SEQ + 8 * tc; nkmax = 8 * tc + 8; ntok = 8; ik = WSP(bf16, WS_PIDXK) + (size_t)b * SEQ * 64; }
    else { row0 = MP + 4 * u; nkmax = PASTL + 4; ntok = 4; ik = WSP(bf16, WS_SIDXK) + (size_t)u * LS * 64; }
    const int rowq = row0 + (SAMPLE ? (tl & 3) : tl);
    bf16x8 q[4];
#pragma unroll
    for (int s = 0; s < 4; ++s) q[s] = *(const bf16x8*)(WSP(bf16, WS_IQ) + (size_t)rowq * 256 + hl * 64 + 16 * s + 8 * hi);
    f32x4 wq[4];
#pragma unroll
    for (int qq = 0; qq < 4; ++qq) { const int tk = 2 * qq + hi; wq[qq] = *(const f32x4*)(WSP(float, WS_IW) + (size_t)(row0 + (SAMPLE ? (tk & 3) : tk)) * 4); }
    LAS int* sc = (LAS int*)F.lds;
    const int n32 = (nkmax + 31) >> 5;
    u32x4 rA[8], rB[8];
#define IDX_ISSUE(R, kt_) do { const int kk_ = (kt_) < n32 ? (kt_) : n32 - 1; \
        if (SAMPLE) { if (kk_ < 64) { const int pg = F.ptab[u * NPG + (kk_ >> 2)]; const float* fp = F.cidx + ((size_t)pg * PAGE + (kk_ & 3) * 32 + l31) * 64 + 8 * hi; \
              _Pragma("unroll") for (int s_ = 0; s_ < 4; ++s_) { R[2 * s_] = gload16(fp + 16 * s_); R[2 * s_ + 1] = gload16(fp + 16 * s_ + 4); } } \
            else { const bf16* kp = ik + (size_t)(32 * kk_ + l31) * 64 + 8 * hi; \
              _Pragma("unroll") for (int s_ = 0; s_ < 4; ++s_) { R[2 * s_] = gload16(kp + 16 * s_); R[2 * s_ + 1] = gload16(kp + 16 * s_); } } } \
        else { const bf16* kp = ik + (size_t)(32 * kk_ + l31) * 64 + 8 * hi; \
            _Pragma("unroll") for (int s_ = 0; s_ < 4; ++s_) R[2 * s_] = gload16(kp + 16 * s_); } } while (0)
#define IDX_WAIT(R) do { if (SAMPLE) asm volatile("s_waitcnt vmcnt(8)" : "+v"(R[0]), "+v"(R[1]), "+v"(R[2]), "+v"(R[3]), "+v"(R[4]), "+v"(R[5]), "+v"(R[6]), "+v"(R[7]) :: "memory"); \
        else asm volatile("s_waitcnt vmcnt(4)" : "+v"(R[0]), "+v"(R[2]), "+v"(R[4]), "+v"(R[6]) :: "memory"); } while (0)
#define RELU_(x) __builtin_amdgcn_fmed3f((x), 0.f, __builtin_inff())
#define IDX_SCORE(R, kt_) do { IDX_WAIT(R); if ((kt_) < n32) { bf16x8 kf[4]; \
        if (SAMPLE && (kt_) < 64) { _Pragma("unroll") for (int s_ = 0; s_ < 4; ++s_) kf[s_] = cvt8(__builtin_bit_cast(f32x4, R[2 * s_]), __builtin_bit_cast(f32x4, R[2 * s_ + 1])); } \
        else { _Pragma("unroll") for (int s_ = 0; s_ < 4; ++s_) kf[s_] = __builtin_bit_cast(bf16x8, R[2 * s_]); } \
        f32x16 a; _Pragma("unroll") for (int i_ = 0; i_ < 16; ++i_) a[i_] = 0.f; \
        _Pragma("unroll") for (int s_ = 0; s_ < 4; ++s_) a = MFMA32(q[s_], kf[s_], a); \
        _Pragma("unroll") for (int qq = 0; qq < 4; ++qq) { \
            float v = RELU_(a[4 * qq]) * wq[qq][0] + RELU_(a[4 * qq + 1]) * wq[qq][1] + RELU_(a[4 * qq + 2]) * wq[qq][2] + RELU_(a[4 * qq + 3]) * wq[qq][3]; \
            int uu = __float_as_int(v); uu = (uu == (int)0x80000000) ? 0 : uu; \
            sc[(2 * qq + hi) * 4096 + 32 * (kt_) + l31] = uu ^ ((uu >> 31) & 0x7fffffff); } } } while (0)
    if (!(ABL & 2)) {
        IDX_ISSUE(rA, w); IDX_ISSUE(rB, w + NWAVES);
        PIN4(q); PIN4(wq);
        asm volatile("s_waitcnt vmcnt(0)" ::: "memory");
        for (int kt = w; kt < n32; kt += 2 * NWAVES) {
            IDX_SCORE(rA, kt); IDX_ISSUE(rA, kt + 2 * NWAVES);
            IDX_SCORE(rB, kt + NWAVES); IDX_ISSUE(rB, kt + 3 * NWAVES);
        }
        asm volatile("s_waitcnt vmcnt(0)" : "+v"(rA[0]), "+v"(rA[2]), "+v"(rA[4]), "+v"(rA[6]), "+v"(rB[0]), "+v"(rB[2]), "+v"(rB[4]), "+v"(rB[6]) :: "memory");
        if (SAMPLE) asm volatile("" : "+v"(rA[1]), "+v"(rA[3]), "+v"(rA[5]), "+v"(rA[7]), "+v"(rB[1]), "+v"(rB[3]), "+v"(rB[5]), "+v"(rB[7]));
    }
#undef IDX_ISSUE
#undef IDX_WAIT
#undef IDX_SCORE
#undef RELU_
    __syncthreads();
    if (w < ntok && !(ABL & 8)) {
        const int n = SAMPLE ? (PASTL + 1 + w) : (row0 - (row0 & ~(SEQ - 1)) + w + 1);
        unsigned long long* out = WSP(unsigned long long, ABL ? WS_T1 : WS_SELM) + (size_t)(row0 + w) * 64;
        const LAS int* scw = sc + w * 4096;
        if (n <= 1024) idx_select<16, ABL>(scw, n, lane, out);
        else if (n <= 2048) idx_select<32, ABL>(scw, n, lane, out);
        else if (n <= 3072) idx_select<48, ABL>(scw, n, lane, out);
        else idx_select<64, ABL>(scw, n, lane, out);
    }
    __syncthreads();
}


constexpr int NSA_PS = 2 * 2 * TILE_B;
constexpr int NSA_WS = 8192 + 2048 + 64;
template <bool SAMPLE> DI void nsa_unit(Frame& F, int u) {
    const int tid = F.tid, lane = F.lane, w = F.wave, l31 = lane & 31, hi = lane >> 5, tl = l31 >> 2, hl = l31 & 3;
    int bg, g, row, qpos, ncmp, wlo, whi, n_ctile, n_stile, w_t0, w_t1, qt = 0;
    size_t cpitch, pitch, wpitch; const bf16 *ck, *cvt, *sk, *svt, *wk, *wvt; bool wr_ok;
    if (!SAMPLE) {
        bg = u & 7; qt = 63 - (u >> 3); g = bg & 1; const int t = 64 * qt + 8 * w + tl; row = (bg >> 1) * SEQ + t; qpos = t; ncmp = 255;
        cpitch = 256; pitch = SEQ; wpitch = SEQ;
        ck = WSP(bf16, WS_PCK) + (size_t)bg * 256 * 64; cvt = WSP(bf16, WS_PCVT) + (size_t)bg * 64 * 256;
        sk = WSP(bf16, WS_PSLCK) + (size_t)bg * SEQ * 64; svt = WSP(bf16, WS_PSLCVT) + (size_t)bg * 64 * SEQ;
        wk = WSP(bf16, WS_PWINK) + (size_t)bg * SEQ * 64; wvt = WSP(bf16, WS_PWINVT) + (size_t)bg * 64 * SEQ;
        wlo = qpos - 511; whi = qpos; n_ctile = (4 * qt + 2) / 64 + 1; n_stile = qt + 1; w_t0 = qt > 8 ? qt - 8 : 0; w_t1 = qt; wr_ok = true;
    } else {
        bg = u * 8 + w; g = bg & 1; const int i = tl & 3; row = MP + (bg >> 1) * 4 + i; qpos = PASTL + i; ncmp = 127;
        cpitch = 128; pitch = LS; wpitch = LSW;
        ck = WSP(bf16, WS_SCK) + (size_t)bg * 128 * 64; cvt = WSP(bf16, WS_SCVT) + (size_t)bg * 64 * 128;
        sk = WSP(bf16, WS_SSLCK) + (size_t)bg * LS * 64; svt = WSP(bf16, WS_SSLCVT) + (size_t)bg * 64 * LS;
        wk = WSP(bf16, WS_SWINK) + (size_t)bg * LSW * 64; wvt = WSP(bf16, WS_SWINVT) + (size_t)bg * 64 * LSW;
        wlo = 1 + i; whi = 512 + i; n_ctile = 2; n_stile = 33; w_t0 = 0; w_t1 = 8; wr_ok = tl < 4;
    }
    const int hq = 4 * g + hl;
    bf16x8 qraw[4], qrot[4];
#pragma unroll
    for (int s = 0; s < 4; ++s) qraw[s] = *(const bf16x8*)(WSP(bf16, WS_QRAW) + (size_t)row * 512 + hq * 64 + 16 * s + 8 * hi);
    LAS unsigned char* const lb = F.lds;
    LAS float* psum = (LAS float*)(lb + NSA_PS + w * NSA_WS);
    LAS float* impb = (LAS float*)(lb + NSA_PS + w * NSA_WS + 8192);
    LAS unsigned char* selb = lb + NSA_PS + w * NSA_WS + 8192 + 2048;
    const int fo = l31 * TP + hi * 16;
    const float* gp = WSP(float, WS_GATES) + (size_t)row * 24 + hq * 3;
    float g0 = gp[0], g1 = gp[1], g2 = gp[2];
    PIN4(qraw); asm volatile("" : "+v"(g0), "+v"(g1), "+v"(g2));
    f32x16 s0, s1;
    u32x4 rk, rv;
    Soft S;

    const int nvr = (qpos - 31) >> 4, nvis = nvr < ncmp - 1 ? nvr : ncmp - 1;
    float m = -1e30f, l = 0.f;
    if (!SAMPLE) { rk = tile_ld(ck, 64, tid); rv = tile_ld(cvt, cpitch, tid); tile_st(lb, rk, tid); tile_st(lb + TILE_B, rv, tid); LDS_BARRIER(); }
    for (int ct = 0; ct < n_ctile; ++ct) {
        if (!SAMPLE) { if (ct + 1 < n_ctile) { rk = tile_ld(ck + (size_t)(ct + 1) * 64 * 64, 64, tid); rv = tile_ld(cvt + (ct + 1) * 64, cpitch, tid); } }
        if (!SAMPLE) { LdsT kt{lb + (ct & 1) * 2 * TILE_B + fo}; qk_tile(s0, s1, kt, qraw); }
        else { GlbT kt{ck, (unsigned)((64 * ct + l31) * 64 + 8 * hi), 64u}; qk_tile(s0, s1, kt, qraw); }
        float mx = -1e30f;
        const int nv2 = nvis - 64 * ct - 4 * hi;
#pragma unroll
        for (int r = 0; r < 16; ++r) { const int cr = (r & 3) + 8 * (r >> 2); s0[r] = cr <= nv2 ? s0[r] : NEGINF; s1[r] = cr + 32 <= nv2 ? s1[r] : NEGINF; mx = fmaxf(mx, fmaxf(s0[r], s1[r])); }
        mx = fmaxf(mx, half_other(mx));
        const float mn = fmaxf(m, mx); float ps = 0.f;
#pragma unroll
        for (int r = 0; r < 16; ++r) ps += __builtin_amdgcn_exp2f(s0[r] - mn) + __builtin_amdgcn_exp2f(s1[r] - mn);
        l = l * __builtin_amdgcn_exp2f(m - mn) + ps; m = mn;
        if (!SAMPLE) { if (ct + 1 < n_ctile) { tile_st(lb + ((ct + 1) & 1) * 2 * TILE_B, rk, tid); tile_st(lb + ((ct + 1) & 1) * 2 * TILE_B + TILE_B, rv, tid); } LDS_BARRIER(); }
    }
    l += half_other(l);
    const float linv = l > 0.f ? 1.f / l : 0.f;
    soft_init(S);
    if (!SAMPLE) { rk = tile_ld(ck, 64, tid); rv = tile_ld(cvt, cpitch, tid); tile_st(lb, rk, tid); tile_st(lb + TILE_B, rv, tid); LDS_BARRIER(); }
    for (int ct = 0; ct < n_ctile; ++ct) {
        if (!SAMPLE) { if (ct + 1 < n_ctile) { rk = tile_ld(ck + (size_t)(ct + 1) * 64 * 64, 64, tid); rv = tile_ld(cvt + (ct + 1) * 64, cpitch, tid); } }
        if (!SAMPLE) { LdsT kt{lb + (ct & 1) * 2 * TILE_B + fo}; qk_tile(s0, s1, kt, qraw); }
        else { GlbT kt{ck, (unsigned)((64 * ct + l31) * 64 + 8 * hi), 64u}; qk_tile(s0, s1, kt, qraw); }
        const int nv2 = nvis - 64 * ct - 4 * hi; LAS float* pw = psum + tl * 256 + 64 * ct + 4 * hi;
#pragma unroll
        for (int r = 0; r < 16; ++r) { const int cr = (r & 3) + 8 * (r >> 2);
            s0[r] = cr <= nv2 ? __builtin_amdgcn_exp2f(s0[r] - m) * linv : 0.f; s1[r] = cr + 32 <= nv2 ? __builtin_amdgcn_exp2f(s1[r] - m) * linv : 0.f;
            float a = s0[r]; a += dpp_x1(a); a += dpp_x2(a); float b = s1[r]; b += dpp_x1(b); b += dpp_x2(b);
            if (hl == 0) { pw[cr] = a; pw[cr + 32] = b; } }
        if (!SAMPLE) { LdsT vt{lb + (ct & 1) * 2 * TILE_B + TILE_B + fo}; pv_tile(S.o0, S.o1, s0, s1, vt); }
        else { GlbT vt{cvt, (unsigned)(l31 * (int)cpitch + 64 * ct + 8 * hi), (unsigned)cpitch}; pv_tile(S.o0, S.o1, s0, s1, vt); }
        if (!SAMPLE) { if (ct + 1 < n_ctile) { tile_st(lb + ((ct + 1) & 1) * 2 * TILE_B, rk, tid); tile_st(lb + ((ct + 1) & 1) * 2 * TILE_B + TILE_B, rv, tid); } LDS_BARRIER(); }
    }
    LDS_WAIT();
    unsigned mlo, mhi;
    {
        const int tk = lane >> 3, jb = 8 * (lane & 7);
        const int qp = SAMPLE ? PASTL + (tk & 3) : 64 * qt + 8 * w + tk, cur = qp >> 6;
        float pv[33];
        const LAS f32x4* pp = (const LAS f32x4*)(psum + tk * 256 + 4 * jb);
#pragma unroll
        for (int i = 0; i < 8; ++i) { const f32x4 x = pp[i]; pv[1 + 4 * i] = x[0]; pv[2 + 4 * i] = x[1]; pv[3 + 4 * i] = x[2]; pv[4 + 4 * i] = x[3]; }
        pv[0] = jb > 0 ? psum[tk * 256 + 4 * jb - 1] : 0.f;
        float v[8];
#pragma unroll
        for (int jj = 0; jj < 8; ++jj) {
            const int j = jb + jj;
            float a = pv[4 * jj] + pv[4 * jj + 1] + pv[4 * jj + 2] + pv[4 * jj + 3];
            a += (4 * j + 3 < ncmp) ? pv[4 * jj + 4] : 0.f;
            a = ((j == 0) | (j == cur) | (j == cur - 1)) ? 1e4f : a;
            a = (j > cur) ? -1e30f : a;
            v[jj] = a;
        }
        LAS f32x4* ip = (LAS f32x4*)(impb + tk * 64 + jb);
        ip[0] = (f32x4){v[0], v[1], v[2], v[3]}; ip[1] = (f32x4){v[4], v[5], v[6], v[7]};
        LDS_WAIT();
        int cnt[8];
#pragma unroll
        for (int jj = 0; jj < 8; ++jj) cnt[jj] = 0;
        const LAS f32x4* ap = (const LAS f32x4*)(impb + tk * 64);
#pragma unroll 1
        for (int i4 = 0; i4 < 16; ++i4) {
            const f32x4 x = ap[i4];
#pragma unroll
            for (int e = 0; e < 4; ++e) { const int i = 4 * i4 + e; const float xi = x[e];
#pragma unroll
                for (int jj = 0; jj < 8; ++jj) cnt[jj] += ((xi > v[jj]) | ((xi == v[jj]) & (i < jb + jj))) ? 1 : 0; }
        }
        unsigned bits = 0;
#pragma unroll
        for (int jj = 0; jj < 8; ++jj) bits |= ((cnt[jj] < 16) & (jb + jj <= cur)) ? (1u << jj) : 0u;
        selb[tk * 8 + (lane & 7)] = (unsigned char)bits;
        LDS_WAIT();
        const LAS unsigned* sp = (const LAS unsigned*)(selb + tl * 8);
        mlo = sp[0]; mhi = sp[1];
    }
    LAS float* park = psum + lane;
#pragma unroll
    for (int i = 0; i < 16; ++i) { park[i * 64] = g0 * S.o0[i]; park[(16 + i) * 64] = g0 * S.o1[i]; }
#pragma unroll
    for (int s = 0; s < 4; ++s) qrot[s] = *(const bf16x8*)(WSP(bf16, WS_QROT) + (size_t)row * 512 + hq * 64 + 16 * s + 8 * hi);
    PIN4(qrot);
    soft_init(S);
    const int qrel = (qpos & 63) - 4 * hi;
    if (!SAMPLE) { rk = tile_ld(sk, 64, tid); rv = tile_ld(svt, pitch, tid); tile_st(lb, rk, tid); tile_st(lb + TILE_B, rv, tid); LDS_BARRIER(); }
    for (int j = 0; j < n_stile; ++j) {
        if (!SAMPLE) { if (j + 1 < n_stile) { rk = tile_ld(sk + (size_t)(j + 1) * 64 * 64, 64, tid); rv = tile_ld(svt + (j + 1) * 64, pitch, tid); } }
        const bool bsel = ((j < 32 ? (mlo >> j) : (mhi >> (j - 32))) & 1u) != 0u;
        if (!SAMPLE) { LdsT kt{lb + (j & 1) * 2 * TILE_B + fo}; qk_tile_c(s0, s1, kt, qrot, S.negm); }
        else { GlbT kt{sk, (unsigned)((64 * j + l31) * 64 + 8 * hi), 64u}; qk_tile_c(s0, s1, kt, qrot, S.negm); }
        if (j == n_stile - 1) {
#pragma unroll
            for (int r = 0; r < 16; ++r) { const int cr = (r & 3) + 8 * (r >> 2); s0[r] = cr <= qrel ? s0[r] : NEGINF; s1[r] = cr + 32 <= qrel ? s1[r] : NEGINF; }
        } else {
#pragma unroll
            for (int r = 0; r < 16; ++r) { s0[r] = bsel ? s0[r] : NEGINF; s1[r] = bsel ? s1[r] : NEGINF; }
        }
        if (!SAMPLE) { LdsT vt{lb + (j & 1) * 2 * TILE_B + TILE_B + fo}; soft_step(S, s0, s1, vt); }
        else { GlbT vt{svt, (unsigned)(l31 * (int)pitch + 64 * j + 8 * hi), (unsigned)pitch}; soft_step(S, s0, s1, vt); }
        if (!SAMPLE) { if (j + 1 < n_stile) { tile_st(lb + ((j + 1) & 1) * 2 * TILE_B, rk, tid); tile_st(lb + ((j + 1) & 1) * 2 * TILE_B + TILE_B, rv, tid); } LDS_BARRIER(); }
    }
    S.l += half_other(S.l);
    { const float sc = g1 / fmaxf(S.l, 1e-30f);
#pragma unroll
      for (int i = 0; i < 16; ++i) { park[i * 64] += sc * S.o0[i]; park[(16 + i) * 64] += sc * S.o1[i]; } }
    soft_init(S);
    if (!SAMPLE) { rk = tile_ld(wk + (size_t)w_t0 * 64 * 64, 64, tid); rv = tile_ld(wvt + w_t0 * 64, wpitch, tid); tile_st(lb, rk, tid); tile_st(lb + TILE_B, rv, tid); LDS_BARRIER(); }
    for (int j = w_t0; j <= w_t1; ++j) {
        const int jr = j - w_t0;
        if (!SAMPLE) { if (j + 1 <= w_t1) { rk = tile_ld(wk + (size_t)(j + 1) * 64 * 64, 64, tid); rv = tile_ld(wvt + (j + 1) * 64, wpitch, tid); } }
        if (!SAMPLE) { LdsT kt{lb + (jr & 1) * 2 * TILE_B + fo}; qk_tile_c(s0, s1, kt, qrot, S.negm); }
        else { GlbT kt{wk, (unsigned)((64 * j + l31) * 64 + 8 * hi), 64u}; qk_tile_c(s0, s1, kt, qrot, S.negm); }
        if ((j == w_t0) | (j == w_t1)) {
            const int lo_r = wlo - 64 * j - 4 * hi, hi_r = whi - 64 * j - 4 * hi;
#pragma unroll
            for (int r = 0; r < 16; ++r) { const int k0 = (r & 3) + 8 * (r >> 2); s0[r] = ((k0 >= lo_r) & (k0 <= hi_r)) ? s0[r] : NEGINF; s1[r] = ((k0 + 32 >= lo_r) & (k0 + 32 <= hi_r)) ? s1[r] : NEGINF; }
        }
        if (!SAMPLE) { LdsT vt{lb + (jr & 1) * 2 * TILE_B + TILE_B + fo}; soft_step(S, s0, s1, vt); }
        else { GlbT vt{wvt, (unsigned)(l31 * (int)wpitch + 64 * j + 8 * hi), (unsigned)wpitch}; soft_step(S, s0, s1, vt); }
        if (!SAMPLE) { if (j + 1 <= w_t1) { tile_st(lb + ((jr + 1) & 1) * 2 * TILE_B, rk, tid); tile_st(lb + ((jr + 1) & 1) * 2 * TILE_B + TILE_B, rv, tid); } LDS_BARRIER(); }
    }
    S.l += half_other(S.l);
#ifdef BREAK_WIN
    S.l *= 1.1f;
#endif
    f32x16 res0, res1;
    { const float sc = g2 / fmaxf(S.l, 1e-30f);
#pragma unroll
      for (int i = 0; i < 16; ++i) { res0[i] = park[i * 64] + sc * S.o0[i]; res1[i] = park[(16 + i) * 64] + sc * S.o1[i]; } }
    if (wr_ok) {
        const bf16* zp = WSP(bf16, WS_ZN) + (size_t)row * 512 + hq * 64 + 4 * hi;
        bf16* op = WSP(bf16, WS_ONZ) + (size_t)row * 512 + hq * 64 + 4 * hi;
#pragma unroll
        for (int e = 0; e < 2; ++e)
#pragma unroll
            for (int q = 0; q < 4; ++q) { const f32x16& o = e ? res1 : res0; const u32x2 z = *(const u32x2*)(zp + 32 * e + 8 * q);
                u32x2 wv; wv.x = pk2(o[4 * q] * bflo(z.x), o[4 * q + 1] * bfhi(z.x)); wv.y = pk2(o[4 * q + 2] * bflo(z.y), o[4 * q + 3] * bfhi(z.y));
                *(u32x2*)(op + 32 * e + 8 * q) = wv; }
    }
}

template <int ABL, class VT> DI void soft_step2(Soft& S, f32x16& s0, f32x16& s1, f32x16& sn0, f32x16& sn1, const VT& vt) {
    bf16x8 vf[8];
#pragma unroll
    for (int s = 0; s < 4; ++s) { vf[2 * s] = vt.frag(0, s); vf[2 * s + 1] = vt.frag(1, s); }
    if (!(ABL & 1)) {
    float mx = max3f(s0[0], s1[0], s0[1]), my = max3f(s1[1], s0[2], s1[2]);
#pragma unroll
    for (int r = 3; r < 15; r += 2) { mx = max3f(mx, s0[r], s1[r]); my = max3f(my, s0[r + 1], s1[r + 1]); }
    mx = max3f(mx, s0[15], s1[15]); mx = max3f(mx, my, mx);
    mx = max3f(mx, half_other(mx), mx);
    const bool fin = mx > NEGINF;
    const bool need = (mx > 8.f) | (fin & !S.seen);
    if (__any(need)) {
        const float dl = need ? mx : 0.f;
        const float al = S.seen ? __builtin_amdgcn_exp2f(-dl) : 0.f;
        S.m += dl; S.l *= need ? al : 1.f;
        const float am = need ? al : 1.f;
#pragma unroll
        for (int r = 0; r < 16; ++r) { s0[r] -= dl; s1[r] -= dl; sn0[r] -= dl; sn1[r] -= dl; S.o0[r] *= am; S.o1[r] *= am; S.negm[r] = -S.m; }
    }
    S.seen = S.seen | fin;
    float ps = 0.f;
#pragma unroll
    for (int r = 0; r < 16; ++r) { s0[r] = __builtin_amdgcn_exp2f(s0[r]); s1[r] = __builtin_amdgcn_exp2f(s1[r]); ps += s0[r] + s1[r]; }
    S.l += ps;
    }
    const bf16x8 b0 = pack_p(s0, 0), b1 = pack_p(s0, 1), b2 = pack_p(s1, 0), b3 = pack_p(s1, 1);
    if (!(ABL & 4)) {
    S.o0 = MFMA32(vf[0], b0, S.o0); S.o1 = MFMA32(vf[1], b0, S.o1);
    S.o0 = MFMA32(vf[2], b1, S.o0); S.o1 = MFMA32(vf[3], b1, S.o1);
    S.o0 = MFMA32(vf[4], b2, S.o0); S.o1 = MFMA32(vf[5], b2, S.o1);
    S.o0 = MFMA32(vf[6], b3, S.o0); S.o1 = MFMA32(vf[7], b3, S.o1);
    } else { S.o0[0] += __builtin_bit_cast(f32x4, b0)[0] + __builtin_bit_cast(f32x4, b1)[0] + __builtin_bit_cast(f32x4, b2)[0] + __builtin_bit_cast(f32x4, b3)[0] + __builtin_bit_cast(f32x4, vf[0])[0] + __builtin_bit_cast(f32x4, vf[7])[1]; }
}
template <int ABL> DI void dsa_unit(Frame& F, int u) {
    const int tid = F.tid, lane = F.lane, w = F.wave, l31 = lane & 31, hi = lane >> 5, tl = l31 >> 2, hl = l31 & 3;
    const int bg = u & 7, qt = 63 - (u >> 3), g = bg & 1, t = 64 * qt + 8 * w + tl, row = (bg >> 1) * SEQ + t, nt = qt + 1;
    const bf16* dk = WSP(bf16, WS_PDSAK) + (size_t)bg * SEQ * 64; const bf16* dvt = WSP(bf16, WS_PDSAVT) + (size_t)bg * 64 * SEQ;
    const int hq = 4 * g + hl;
    bf16x8 dq[4];
#pragma unroll
    for (int s = 0; s < 4; ++s) dq[s] = *(const bf16x8*)(WSP(bf16, WS_DQ) + (size_t)row * 512 + hq * 64 + 16 * s + 8 * hi);
    const unsigned long long* selp = WSP(unsigned long long, WS_SELM) + (size_t)row * 64;
    unsigned long long selA = selp[0], selB = selp[nt > 1 ? 1 : 0];
    PIN4(dq); asm volatile("" : "+v"(selA), "+v"(selB));
    LAS unsigned char* const lb = F.lds;
    const int fo = l31 * TP + hi * 16;
    f32x16 sc0, sc1, sn0, sn1;
    u32x4 rkA, rvA, rkB, rvB;
    Soft S; soft_init(S);
    const int ntm = nt - 1;
    const bf16* kpc = dk + (size_t)(tid >> 3) * 64 + (tid & 7) * 8; const bf16* vpc = dvt + (size_t)(tid >> 3) * SEQ + (tid & 7) * 8;
#define KADDR(jt) (kpc + (size_t)((jt) < ntm ? (jt) : ntm) * 64 * 64)
#define VADDR(jt) (vpc + ((jt) < ntm ? (jt) : ntm) * 64)
    { const u32x4 a = tile_ld(dk, 64, tid), b = tile_ld(dvt, SEQ, tid), c = *(const u32x4*)KADDR(1); tile_st(lb, a, tid); tile_st(lb + 2 * TILE_B, b, tid); tile_st(lb + TILE_B, c, tid); }
    asm volatile("s_waitcnt vmcnt(0)" : "+v"(selA), "+v"(selB) :: "memory");
    selA = gload8(selp); selB = gload8(selp + (nt > 1 ? 1 : 0));
    rkA = gload16(KADDR(2)); rvA = gload16(VADDR(1));
    LDS_BARRIER();
    { LdsT kt{lb + fo}; qk_tile_c(sc0, sc1, kt, dq, S.negm); }
#define DSA_STEP(j, CK, CV, NK, NV, SELC) do { \
        NK = gload16(KADDR((j) + 3)); NV = gload16(VADDR((j) + 2)); \
        if ((j) + 1 < nt) { LdsT kt{lb + (((j) + 1) & 1) * TILE_B + fo}; if (!(ABL & 2)) qk_tile_c(sn0, sn1, kt, dq, S.negm); else { sn0 = S.negm; sn1 = S.negm; sn0[0] += __builtin_bit_cast(f32x4, kt.frag(0, 0))[0]; } } \
        WAITV1(5, SELC);                                                     \
        { const unsigned wa = (unsigned)SELC >> (4 * hi), wb = (unsigned)(SELC >> 32) >> (4 * hi); \
          SELC = gload8(selp + ((j) + 2 < nt ? (j) + 2 : ntm)); \
          _Pragma("unroll") for (int r = 0; r < 16; ++r) { const int bp = (r & 3) + 8 * (r >> 2); \
            sc0[r] = mask_sel(sc0[r], (int)(wa << (31 - bp)) >> 31); sc1[r] = mask_sel(sc1[r], (int)(wb << (31 - bp)) >> 31); } } \
        { LdsT vt{lb + (2 + ((j) & 1)) * TILE_B + fo}; soft_step2<ABL>(S, sc0, sc1, sn0, sn1, vt); } \
        sc0 = sn0; sc1 = sn1; \
        WAITV2(3, CK, CV);                                                   \
        if (!(ABL & 8)) { tile_st(lb + ((j) & 1) * TILE_B, CK, tid); tile_st(lb + (2 + (((j) + 1) & 1)) * TILE_B, CV, tid); } \
        if (!(ABL & 16)) LDS_BARRIER(); } while (0)
    for (int j = 0; j < nt; j += 2) { DSA_STEP(j, rkA, rvA, rkB, rvB, selA); if (j + 1 < nt) DSA_STEP(j + 1, rkB, rvB, rkA, rvA, selB); }
    asm volatile("s_waitcnt vmcnt(0)" : "+v"(rkA), "+v"(rvA), "+v"(rkB), "+v"(rvB), "+v"(selA), "+v"(selB) :: "memory");
#undef DSA_STEP
#undef KADDR
#undef VADDR
    S.l += half_other(S.l);
    {
        const float sc = 1.f / fmaxf(S.l, 1e-30f);
        const bf16* zp = WSP(bf16, WS_ZD) + (size_t)row * 512 + hq * 64 + 4 * hi;
        bf16* op = WSP(bf16, ABL ? WS_T1 : WS_ODZ) + (size_t)row * 512 + hq * 64 + 4 * hi;
#pragma unroll
        for (int e = 0; e < 2; ++e)
#pragma unroll
            for (int q = 0; q < 4; ++q) { const f32x16& o = e ? S.o1 : S.o0; const u32x2 z = *(const u32x2*)(zp + 32 * e + 8 * q);
                u32x2 wv; wv.x = pk2(o[4 * q] * sc * bflo(z.x), o[4 * q + 1] * sc * bfhi(z.x)); wv.y = pk2(o[4 * q + 2] * sc * bflo(z.y), o[4 * q + 3] * sc * bfhi(z.y));
                *(u32x2*)(op + 32 * e + 8 * q) = wv; }
    }
}


struct PageK {
    static constexpr bool HOIST = false;
    const float* p; unsigned stride;
    DI bf16x8 frag(int mt, int s) const { const f32x4* q = (const f32x4*)(p + (size_t)((unsigned)mt * 32u * stride + (unsigned)s * 16u)); return cvt8(q[0], q[1]); }
};
struct PageV {
    static constexpr bool HOIST = false;
    const float* p; unsigned stride;
    DI bf16x8 frag(int dt, int s) const {
        float v[8];
#pragma unroll
        for (int i = 0; i < 8; ++i) v[i] = p[(size_t)((unsigned)(16 * s + (i & 3) + 8 * (i >> 2)) * stride + (unsigned)dt * 32u)];
        return __builtin_bit_cast(bf16x8, pack8(v));
    }
};
constexpr int XCH_W = 34 * 64;
constexpr int XCH_BYTES = 8 * XCH_W * 4;
DI void xch_put(LAS float* x, const Soft& S, int lane) {
    const float lt = S.l + half_other(S.l);
    x[lane] = S.seen ? S.m : NEGINF; x[64 + lane] = lt;
#pragma unroll
    for (int r = 0; r < 16; ++r) { x[(2 + r) * 64 + lane] = S.o0[r]; x[(18 + r) * 64 + lane] = S.o1[r]; }
}
DI void xch_get(const LAS float* xb, int w, int lane, float (&out)[4]) {
    float mw[8], M = -1e30f;
#pragma unroll
    for (int i = 0; i < 8; ++i) { mw[i] = xb[i * XCH_W + lane]; M = fmaxf(M, mw[i]); }
    float L = 0.f, o[4] = {0.f, 0.f, 0.f, 0.f};
#pragma unroll
    for (int i = 0; i < 8; ++i) { const float wt = __builtin_amdgcn_exp2f(mw[i] - M); L += wt * xb[i * XCH_W + 64 + lane];
#pragma unroll
        for (int k = 0; k < 4; ++k) o[k] += wt * xb[i * XCH_W + (2 + 4 * w + k) * 64 + lane]; }
    const float inv = 1.f / fmaxf(L, 1e-30f);
#pragma unroll
    for (int k = 0; k < 4; ++k) out[k] = o[k] * inv;
}
DI void nsa_sample_unit(Frame& F, int bg) {
    const int lane = F.lane, w = F.wave, l31 = lane & 31, hi = lane >> 5, tl = l31 >> 2, hl = l31 & 3;
    const int sb = bg >> 1, g = bg & 1, i = tl & 3, row = MP + sb * 4 + i, qpos = PASTL + i, hq = 4 * g + hl;
    LAS unsigned char* const lb = F.lds;
    LAS float* xch = (LAS float*)lb;
    LAS float* cmpb = (LAS float*)(lb + XCH_BYTES);
    LAS unsigned* mskb = (LAS unsigned*)(lb + XCH_BYTES + 8192);
    LAS float* psum = (LAS float*)(lb + XCH_BYTES + 8192 + 64);
    LAS float* impb = psum + 8 * 256;
    LAS unsigned char* selb = (LAS unsigned char*)(impb + 8 * 64);
    const float* gp = WSP(float, WS_GATES) + (size_t)row * 24 + hq * 3;
    float g0 = gp[0], g1 = gp[1], g2 = gp[2];
    bf16x8 qrot[4];
#pragma unroll
    for (int s = 0; s < 4; ++s) qrot[s] = *(const bf16x8*)(WSP(bf16, WS_QROT) + (size_t)row * 512 + hq * 64 + 16 * s + 8 * hi);
    f32x16 s0, s1;
    Soft S;
    __syncthreads();
    if (w == 0) {
        const bf16* ck = WSP(bf16, WS_SCK) + (size_t)bg * 128 * 64; const bf16* cvt = WSP(bf16, WS_SCVT) + (size_t)bg * 64 * 128;
        bf16x8 qraw[4];
#pragma unroll
        for (int s = 0; s < 4; ++s) qraw[s] = *(const bf16x8*)(WSP(bf16, WS_QRAW) + (size_t)row * 512 + hq * 64 + 16 * s + 8 * hi);
        const int ncmp = 127, nvis = 126;
        float m = -1e30f, l = 0.f;
        for (int ct = 0; ct < 2; ++ct) {
            GlbT kt{ck, (unsigned)((64 * ct + l31) * 64 + 8 * hi), 64u}; qk_tile(s0, s1, kt, qraw);
            float mx = -1e30f; const int nv2 = nvis - 64 * ct - 4 * hi;
#pragma unroll
            for (int r = 0; r < 16; ++r) { const int cr = (r & 3) + 8 * (r >> 2); s0[r] = cr <= nv2 ? s0[r] : NEGINF; s1[r] = cr + 32 <= nv2 ? s1[r] : NEGINF; mx = fmaxf(mx, fmaxf(s0[r], s1[r])); }
            mx = fmaxf(mx, half_other(mx));
            const float mn = fmaxf(m, mx); float ps = 0.f;
#pragma unroll
            for (int r = 0; r < 16; ++r) ps += __builtin_amdgcn_exp2f(s0[r] - mn) + __builtin_amdgcn_exp2f(s1[r] - mn);
            l = l * __builtin_amdgcn_exp2f(m - mn) + ps; m = mn;
        }
        l += half_other(l);
        const float linv = l > 0.f ? 1.f / l : 0.f;
        soft_init(S);
        for (int ct = 0; ct < 2; ++ct) {
            GlbT kt{ck, (unsigned)((64 * ct + l31) * 64 + 8 * hi), 64u}; qk_tile(s0, s1, kt, qraw);
            const int nv2 = nvis - 64 * ct - 4 * hi; LAS float* pw = psum + tl * 256 + 64 * ct + 4 * hi;
#pragma unroll
            for (int r = 0; r < 16; ++r) { const int cr = (r & 3) + 8 * (r >> 2);
                s0[r] = cr <= nv2 ? __builtin_amdgcn_exp2f(s0[r] - m) * linv : 0.f; s1[r] = cr + 32 <= nv2 ? __builtin_amdgcn_exp2f(s1[r] - m) * linv : 0.f;
                float a = s0[r]; a += dpp_x1(a); a += dpp_x2(a); float b = s1[r]; b += dpp_x1(b); b += dpp_x2(b);
                if (hl == 0) { pw[cr] = a; pw[cr + 32] = b; } }
            GlbT vt{cvt, (unsigned)(l31 * 128 + 64 * ct + 8 * hi), 128u}; pv_tile(S.o0, S.o1, s0, s1, vt);
        }
#pragma unroll
        for (int r = 0; r < 16; ++r) { cmpb[r * 64 + lane] = S.o0[r]; cmpb[(16 + r) * 64 + lane] = S.o1[r]; }
        LDS_WAIT();
        {
            const int tk = lane >> 3, jb = 8 * (lane & 7), cur = 32;
            float pv[33];
            const LAS f32x4* pp = (const LAS f32x4*)(psum + tk * 256 + 4 * jb);
#pragma unroll
            for (int q = 0; q < 8; ++q) { const f32x4 x = pp[q]; pv[1 + 4 * q] = x[0]; pv[2 + 4 * q] = x[1]; pv[3 + 4 * q] = x[2]; pv[4 + 4 * q] = x[3]; }
            pv[0] = jb > 0 ? psum[tk * 256 + 4 * jb - 1] : 0.f;
            float v[8];
#pragma unroll
            for (int jj = 0; jj < 8; ++jj) { const int j = jb + jj;
                float a = pv[4 * jj] + pv[4 * jj + 1] + pv[4 * jj + 2] + pv[4 * jj + 3];
                a += (4 * j + 3 < ncmp) ? pv[4 * jj + 4] : 0.f;
                a = ((j == 0) | (j == cur) | (j == cur - 1)) ? 1e4f : a;
                a = (j > cur) ? -1e30f : a;
                v[jj] = a; }
            LAS f32x4* ip = (LAS f32x4*)(impb + tk * 64 + jb);
            ip[0] = (f32x4){v[0], v[1], v[2], v[3]}; ip[1] = (f32x4){v[4], v[5], v[6], v[7]};
            LDS_WAIT();
            int cnt[8];
#pragma unroll
            for (int jj = 0; jj < 8; ++jj) cnt[jj] = 0;
            const LAS f32x4* ap = (const LAS f32x4*)(impb + tk * 64);
#pragma unroll 1
            for (int i4 = 0; i4 < 16; ++i4) { const f32x4 x = ap[i4];
#pragma unroll
                for (int e = 0; e < 4; ++e) { const int ii = 4 * i4 + e; const float xi = x[e];
#pragma unroll
                    for (int jj = 0; jj < 8; ++jj) cnt[jj] += ((xi > v[jj]) | ((xi == v[jj]) & (ii < jb + jj))) ? 1 : 0; } }
            unsigned bits = 0;
#pragma unroll
            for (int jj = 0; jj < 8; ++jj) bits |= ((cnt[jj] < 16) & (jb + jj <= cur)) ? (1u << jj) : 0u;
            selb[tk * 8 + (lane & 7)] = (unsigned char)bits;
            LDS_WAIT();
            if (lane < 16) mskb[lane] = ((const LAS unsigned*)selb)[lane];
        }
    }
    __syncthreads();
    const unsigned mlo = mskb[tl * 2], mhi = mskb[tl * 2 + 1];
    PIN4(qrot); asm volatile("" : "+v"(g0), "+v"(g1), "+v"(g2));
    soft_init(S);
    for (int j = w; j < 32; j += NWAVES) {
        const int pg = F.ptab[sb * NPG + (j >> 1)];
        const float* base = F.cnsa + ((size_t)pg * PAGE + (j & 1) * 64) * 512 + (2 * 2 + g) * 64;
        PageK kt{base + (size_t)l31 * 512 + 8 * hi, 512u}; qk_tile_c(s0, s1, kt, qrot, S.negm);
        const bool bsel = ((mlo >> j) & 1u) != 0u;
#pragma unroll
        for (int r = 0; r < 16; ++r) { s0[r] = bsel ? s0[r] : NEGINF; s1[r] = bsel ? s1[r] : NEGINF; }
        PageV vt{base + 128 + (size_t)(4 * hi) * 512 + l31, 512u}; soft_step(S, s0, s1, vt);
    }
    if (w == 0) {
        const bf16* sk = WSP(bf16, WS_SSLCK) + (size_t)bg * LS * 64; const bf16* svt = WSP(bf16, WS_SSLCVT) + (size_t)bg * 64 * LS;
        GlbT kt{sk, (unsigned)((2048 + l31) * 64 + 8 * hi), 64u}; qk_tile_c(s0, s1, kt, qrot, S.negm);
        const int qrel = i - 4 * hi;
#pragma unroll
        for (int r = 0; r < 16; ++r) { const int cr = (r & 3) + 8 * (r >> 2); s0[r] = cr <= qrel ? s0[r] : NEGINF; s1[r] = cr + 32 <= qrel ? s1[r] : NEGINF; }
        GlbT vt{svt, (unsigned)(l31 * LS + 2048 + 8 * hi), (unsigned)LS}; soft_step(S, s0, s1, vt);
    }
    xch_put(xch + w * XCH_W, S, lane);
    __syncthreads();
    float acc[4], part[4];
    xch_get(xch, w, lane, part);
#pragma unroll
    for (int k = 0; k < 4; ++k) acc[k] = g1 * part[k] + g0 * cmpb[(4 * w + k) * 64 + lane];
    __syncthreads();
    soft_init(S);
    {
        const float* base = F.swin + ((size_t)sb * 512 + 64 * w) * 256 + g * 64;
        PageK kt{base + (size_t)l31 * 256 + 8 * hi, 256u}; qk_tile_c(s0, s1, kt, qrot, S.negm);
        if (w == 0) {
            const int lo_r = 1 + i - 4 * hi;
#pragma unroll
            for (int r = 0; r < 16; ++r) { const int k0 = (r & 3) + 8 * (r >> 2); s0[r] = k0 >= lo_r ? s0[r] : NEGINF; s1[r] = k0 + 32 >= lo_r ? s1[r] : NEGINF; }
        }
        PageV vt{base + 128 + (size_t)(4 * hi) * 256 + l31, 256u}; soft_step(S, s0, s1, vt);
    }
    if (w == 0) {
        const bf16* wk = WSP(bf16, WS_SWINK) + (size_t)bg * LSW * 64; const bf16* wvt = WSP(bf16, WS_SWINVT) + (size_t)bg * 64 * LSW;
        GlbT kt{wk, (unsigned)((512 + l31) * 64 + 8 * hi), 64u}; qk_tile_c(s0, s1, kt, qrot, S.negm);
        const int hi_r = i - 4 * hi;
#pragma unroll
        for (int r = 0; r < 16; ++r) { const int k0 = (r & 3) + 8 * (r >> 2); s0[r] = k0 <= hi_r ? s0[r] : NEGINF; s1[r] = k0 + 32 <= hi_r ? s1[r] : NEGINF; }
        GlbT vt{wvt, (unsigned)(l31 * LSW + 512 + 8 * hi), (unsigned)LSW}; soft_step(S, s0, s1, vt);
    }
    xch_put(xch + w * XCH_W, S, lane);
    __syncthreads();
    xch_get(xch, w, lane, part);
#ifdef BREAK_WIN
#pragma unroll
    for (int k = 0; k < 4; ++k) part[k] *= 0.9f;
#endif
    if (tl < 4) {
        const int d0 = 32 * (w >> 2) + 8 * (w & 3) + 4 * hi;
        const u32x2 z = *(const u32x2*)(WSP(bf16, WS_ZN) + (size_t)row * 512 + hq * 64 + d0);
        u32x2 wv; wv.x = pk2((acc[0] + g2 * part[0]) * bflo(z.x), (acc[1] + g2 * part[1]) * bfhi(z.x)); wv.y = pk2((acc[2] + g2 * part[2]) * bflo(z.y), (acc[3] + g2 * part[3]) * bfhi(z.y));
        *(u32x2*)(WSP(bf16, WS_ONZ) + (size_t)row * 512 + hq * 64 + d0) = wv;
    }
}
DI void dsa_sample_unit(Frame& F, int bg) {
    const int lane = F.lane, w = F.wave, l31 = lane & 31, hi = lane >> 5, tl = l31 >> 2, hl = l31 & 3;
    const int sb = bg >> 1, g = bg & 1, i = tl & 3, row = MP + sb * 4 + i, hq = 4 * g + hl;
    LAS float* xch = (LAS float*)F.lds;
    bf16x8 dq[4];
#pragma unroll
    for (int s = 0; s < 4; ++s) dq[s] = *(const bf16x8*)(WSP(bf16, WS_DQ) + (size_t)row * 512 + hq * 64 + 16 * s + 8 * hi);
    const unsigned long long* selp = WSP(unsigned long long, WS_SELM) + (size_t)row * 64;
    PIN4(dq);
    f32x16 s0, s1;
    Soft S; soft_init(S);
    for (int j = w; j < 32; j += NWAVES) {
        unsigned long long selw = selp[j];
        const int pg = F.ptab[sb * NPG + (j >> 1)];
        const float* base = F.cdsa + ((size_t)pg * PAGE + (j & 1) * 64) * 256 + g * 64;
        PageK kt{base + (size_t)l31 * 256 + 8 * hi, 256u}; qk_tile_c(s0, s1, kt, dq, S.negm);
#ifdef BREAK_DSA
        selw |= 0x1111111111111111ull;
#endif
        const unsigned wa = (unsigned)selw >> (4 * hi), wb = (unsigned)(selw >> 32) >> (4 * hi);
#pragma unroll
        for (int r = 0; r < 16; ++r) { const int bp = (r & 3) + 8 * (r >> 2);
            s0[r] = mask_sel(s0[r], (int)(wa << (31 - bp)) >> 31); s1[r] = mask_sel(s1[r], (int)(wb << (31 - bp)) >> 31); }
        PageV vt{base + 128 + (size_t)(4 * hi) * 256 + l31, 256u}; soft_step(S, s0, s1, vt);
    }
    if (w == 0) {
        const unsigned long long selw = selp[32];
        const bf16* dk = WSP(bf16, WS_SDSAK) + (size_t)bg * LS * 64; const bf16* dvt = WSP(bf16, WS_SDSAVT) + (size_t)bg * 64 * LS;
        GlbT kt{dk, (unsigned)((2048 + l31) * 64 + 8 * hi), 64u}; qk_tile_c(s0, s1, kt, dq, S.negm);
        const unsigned wa = (unsigned)selw >> (4 * hi), wb = (unsigned)(selw >> 32) >> (4 * hi);
#pragma unroll
        for (int r = 0; r < 16; ++r) { const int bp = (r & 3) + 8 * (r >> 2);
            s0[r] = mask_sel(s0[r], (int)(wa << (31 - bp)) >> 31); s1[r] = mask_sel(s1[r], (int)(wb << (31 - bp)) >> 31); }
        GlbT vt{dvt, (unsigned)(l31 * LS + 2048 + 8 * hi), (unsigned)LS}; soft_step(S, s0, s1, vt);
    }
    __syncthreads();
    xch_put(xch + w * XCH_W, S, lane);
    __syncthreads();
    float part[4];
    xch_get(xch, w, lane, part);
    if (tl < 4) {
        const int d0 = 32 * (w >> 2) + 8 * (w & 3) + 4 * hi;
        const u32x2 z = *(const u32x2*)(WSP(bf16, WS_ZD) + (size_t)row * 512 + hq * 64 + d0);
        u32x2 wv; wv.x = pk2(part[0] * bflo(z.x), part[1] * bfhi(z.x)); wv.y = pk2(part[2] * bflo(z.y), part[3] * bfhi(z.y));
        *(u32x2*)(WSP(bf16, WS_ODZ) + (size_t)row * 512 + hq * 64 + d0) = wv;
    }
}

template <int K, class EF> DI void small_gemm(Frame& F, const bf16* A, const bf16* Bt, const EF& ef) {
    const int lane = F.lane, w = F.wave, l31 = lane & 31, hi = lane >> 5;
    LAS float* red = (LAS float*)F.lds;
    for (int t = blockIdx.x; t < 256; t += F.G) {
        const int mt = t >> 5, nt = t & 31, kw = K >> 3, k0 = w * kw;
        const bf16* ap = A + (size_t)(MP + 64 * mt + l31) * K + k0 + 8 * hi;
        const bf16* bp = Bt + (size_t)(32 * nt + l31) * K + k0 + 8 * hi;
        f32x16 a0, a1;
#pragma unroll
        for (int i = 0; i < 16; ++i) { a0[i] = 0.f; a1[i] = 0.f; }
        bf16x8 fb[K / 128], f0[K / 128], f1[K / 128];
#pragma unroll
        for (int s = 0; s < K / 128; ++s) { fb[s] = *(const bf16x8*)(bp + 16 * s); f0[s] = *(const bf16x8*)(ap + 16 * s); f1[s] = *(const bf16x8*)(ap + (size_t)32 * K + 16 * s); }
#pragma unroll
        for (int s = 0; s < K / 128; ++s) { a0 = MFMA32(f0[s], fb[s], a0); a1 = MFMA32(f1[s], fb[s], a1); }
        __syncthreads();
#pragma unroll
        for (int r = 0; r < 16; ++r) { red[(w * 32 + r) * 64 + lane] = a0[r]; red[(w * 32 + 16 + r) * 64 + lane] = a1[r]; }
        __syncthreads();
        const int m2 = w >> 2, q = w & 3;
#pragma unroll
        for (int j = 0; j < 4; ++j) {
            float v = 0.f;
#pragma unroll
            for (int i = 0; i < 8; ++i) v += red[(i * 32 + 16 * m2 + 4 * q + j) * 64 + lane];
            ef(MP + 64 * mt + 32 * m2 + 8 * q + 4 * hi + j, 32 * nt + l31, v);
        }
    }
    __syncthreads();
}


#ifdef ORACLE
constexpr size_t WS_ORC = 948 * MiB;
constexpr int ORC_ROWS = 128;
DI float blk_red(Frame& F, float v, bool ismax, LAS float* red) {
#pragma unroll
    for (int o = 1; o < 64; o <<= 1) { const float x = __shfl_xor(v, o); v = ismax ? fmaxf(v, x) : v + x; }
    __syncthreads();
    if (F.lane == 0) red[F.wave] = v;
    __syncthreads();
    float r = red[0];
    for (int i = 1; i < 8; ++i) r = ismax ? fmaxf(r, red[i]) : r + red[i];
    return r;
}
DI float dot64(const bf16* a, const bf16* b) { float s = 0.f; for (int d = 0; d < 64; ++d) s += bf2f(a[d]) * bf2f(b[d]); return s; }
DI void orc_softmax(Frame& F, LAS float* sc, LAS unsigned char* vf, int n, LAS float* red) {
    float mx = -3e38f;
    for (int k = F.tid; k < n; k += 512) if (vf[k]) mx = fmaxf(mx, sc[k]);
    mx = blk_red(F, mx, true, red);
    float sm = 0.f;
    for (int k = F.tid; k < n; k += 512) { const float p = vf[k] ? exp2f(sc[k] - mx) : 0.f; sc[k] = p; sm += p; }
    sm = blk_red(F, sm, false, red);
    const float inv = 1.f / fmaxf(sm, 1e-30f);
    for (int k = F.tid; k < n; k += 512) sc[k] *= inv;
    __syncthreads();
}
DI void oracle_row(Frame& F, int oi) {
    int row;
    if (oi < 96) { const int tl[24] = {0, 1, 30, 31, 32, 63, 64, 65, 127, 128, 255, 256, 257, 400, 511, 512, 513, 1000, 1023, 1024, 2047, 2500, 3583, 4095};
        int t = 0;
#pragma unroll
        for (int i = 0; i < 24; ++i) t = (oi % 24 == i) ? tl[i] : t;
        row = (oi / 24) * SEQ + t; }
    else { const int k = oi - 96; row = MP + (((k >> 2) * 37) % SBATCH) * 4 + (k & 3); }
    const bool samp = row >= MP;
    const int b = samp ? (row - MP) >> 2 : row >> 12, ti = samp ? (row & 3) : (row & 4095), qpos = samp ? PASTL + ti : ti;
    const int ncmp = samp ? 127 : 255; const size_t pitch = samp ? LS : SEQ, wpitch = samp ? LSW : SEQ, cpitch = samp ? 128 : 256;
    const int wlo = samp ? 1 + ti : (qpos - 511 > 0 ? qpos - 511 : 0), whi = samp ? 512 + ti : qpos;
    LAS float* sc = (LAS float*)F.lds;
    LAS float* s2 = sc + 4096;
    LAS float* psum = s2 + 4096;
    LAS float* imp = psum + 256;
    LAS float* resn = imp + 64;
    LAS float* resd = resn + 512;
    LAS float* red = resd + 512;
    LAS unsigned char* vf = (LAS unsigned char*)(red + 8);
    LAS unsigned char* selb = vf + 4096;
    const bf16* qraw = WSP(bf16, WS_QRAW) + (size_t)row * 512; const bf16* qrot = WSP(bf16, WS_QROT) + (size_t)row * 512;
    const bf16* dq = WSP(bf16, WS_DQ) + (size_t)row * 512; const bf16* iq = WSP(bf16, WS_IQ) + (size_t)row * 256;
    const float* gat = WSP(float, WS_GATES) + (size_t)row * 24; const float* iw = WSP(float, WS_IW) + (size_t)row * 4;
    const int nvr = (qpos - 31) >> 4, nvis = nvr < ncmp - 1 ? nvr : ncmp - 1, cur = qpos >> 6;
    for (int g = 0; g < 2; ++g) {
        const int bg = b * 2 + g;
        const bf16* ck = samp ? WSP(bf16, WS_SCK) + (size_t)bg * 128 * 64 : WSP(bf16, WS_PCK) + (size_t)bg * 256 * 64;
        const bf16* cvt = samp ? WSP(bf16, WS_SCVT) + (size_t)bg * 64 * 128 : WSP(bf16, WS_PCVT) + (size_t)bg * 64 * 256;
        const bf16* sk = samp ? WSP(bf16, WS_SSLCK) + (size_t)bg * LS * 64 : WSP(bf16, WS_PSLCK) + (size_t)bg * SEQ * 64;
        const bf16* svt = samp ? WSP(bf16, WS_SSLCVT) + (size_t)bg * 64 * LS : WSP(bf16, WS_PSLCVT) + (size_t)bg * 64 * SEQ;
        const bf16* wk = samp ? WSP(bf16, WS_SWINK) + (size_t)bg * LSW * 64 : WSP(bf16, WS_PWINK) + (size_t)bg * SEQ * 64;
        const bf16* wvt = samp ? WSP(bf16, WS_SWINVT) + (size_t)bg * 64 * LSW : WSP(bf16, WS_PWINVT) + (size_t)bg * 64 * SEQ;
        __syncthreads();
        if (F.tid < 256) psum[F.tid] = 0.f;
        for (int hl = 0; hl < 4; ++hl) {
            const int h = 4 * g + hl;
            __syncthreads();
            for (int n = F.tid; n < 256; n += 512) { const bool v = n <= nvis; vf[n] = v; sc[n] = v ? dot64(qraw + h * 64, ck + (size_t)n * 64) : 0.f; }
            __syncthreads();
            orc_softmax(F, sc, vf, 256, red);
            if (F.tid < 256) psum[F.tid] += sc[F.tid];
            if (F.tid < 64) { float a = 0.f; for (int n = 0; n <= nvis; ++n) a += sc[n] * bf2f(cvt[(size_t)F.tid * cpitch + permk(n)]); resn[h * 64 + F.tid] = gat[h * 3 + 0] * a; }
        }
        __syncthreads();
        if (F.tid < 64) { const int j = F.tid; float a = 0.f;
            for (int n = 4 * j - 1; n <= 4 * j + 3; ++n) if (n >= 0 && n < ncmp) a += psum[n];
            if (j == 0 || j == cur || j == cur - 1) a = 1e4f;
            if (j > cur) a = -1e30f;
            imp[j] = a; selb[j] = 0; }
        __syncthreads();
        if (F.tid == 0) { for (int k = 0; k < 16; ++k) { int best = -1; float bv = -3e38f; for (int j = 0; j < 64; ++j) if (!selb[j] && imp[j] > bv) { bv = imp[j]; best = j; }
                if (best >= 0) selb[best] = (bv > -5e29f) ? 1 : 2; }
            for (int j = 0; j < 64; ++j) selb[j] = selb[j] == 1 ? 1 : 0; }
        __syncthreads();
        for (int hl = 0; hl < 4; ++hl) {
            const int h = 4 * g + hl;
            __syncthreads();
            for (int k = F.tid; k <= qpos; k += 512) { const bool v = selb[k >> 6] != 0; vf[k] = v; sc[k] = v ? dot64(qrot + h * 64, sk + (size_t)k * 64) : 0.f; }
            __syncthreads();
            orc_softmax(F, sc, vf, qpos + 1, red);
            if (F.tid < 64) { float a = 0.f; for (int k = 0; k <= qpos; ++k) if (vf[k]) a += sc[k] * bf2f(svt[(size_t)F.tid * pitch + permk(k)]); resn[h * 64 + F.tid] += gat[h * 3 + 1] * a; }
            __syncthreads();
            for (int k = wlo + F.tid; k <= whi; k += 512) { vf[k - wlo] = 1; sc[k - wlo] = dot64(qrot + h * 64, wk + (size_t)k * 64); }
            __syncthreads();
            orc_softmax(F, sc, vf, whi - wlo + 1, red);
            if (F.tid < 64) { float a = 0.f; for (int k = wlo; k <= whi; ++k) a += sc[k - wlo] * bf2f(wvt[(size_t)F.tid * wpitch + permk(k)]); resn[h * 64 + F.tid] += gat[h * 3 + 2] * a; }
        }
    }
    __syncthreads();
    const bf16* ik = samp ? WSP(bf16, WS_SIDXK) + (size_t)b * LS * 64 : WSP(bf16, WS_PIDXK) + (size_t)b * SEQ * 64;
    for (int k = F.tid; k <= qpos; k += 512) { float a = 0.f; for (int h = 0; h < 4; ++h) a += fmaxf(dot64(iq + h * 64, ik + (size_t)k * 64), 0.f) * iw[h]; s2[k] = a; }
    __syncthreads();
    for (int k = F.tid; k <= qpos; k += 512) { const float v = s2[k]; int c = 0; for (int j = 0; j <= qpos; ++j) { const float x = s2[j]; c += (x > v || (x == v && j < k)) ? 1 : 0; } vf[k] = c < 256; }
    __syncthreads();
    for (int h = 0; h < 8; ++h) {
        const int bg = b * 2 + (h >> 2);
        const bf16* dk = samp ? WSP(bf16, WS_SDSAK) + (size_t)bg * LS * 64 : WSP(bf16, WS_PDSAK) + (size_t)bg * SEQ * 64;
        const bf16* dvt = samp ? WSP(bf16, WS_SDSAVT) + (size_t)bg * 64 * LS : WSP(bf16, WS_PDSAVT) + (size_t)bg * 64 * SEQ;
        __syncthreads();
        for (int k = F.tid; k <= qpos; k += 512) sc[k] = vf[k] ? dot64(dq + h * 64, dk + (size_t)k * 64) : 0.f;
        __syncthreads();
        orc_softmax(F, sc, vf, qpos + 1, red);
        if (F.tid < 64) { float a = 0.f; for (int k = 0; k <= qpos; ++k) if (vf[k]) a += sc[k] * bf2f(dvt[(size_t)F.tid * pitch + permk(k)]); resd[h * 64 + F.tid] = a; }
    }
    __syncthreads();
    float dn = 0.f, rn = 0.f, dd = 0.f, rd = 0.f;
    { const int e = F.tid;
      const float zn = bf2f(WSP(bf16, WS_ZN)[(size_t)row * 512 + e]), zd = bf2f(WSP(bf16, WS_ZD)[(size_t)row * 512 + e]);
      const float refn = resn[e] * zn, refd = resd[e] * zd;
      const float gotn = bf2f(WSP(bf16, WS_ONZ)[(size_t)row * 512 + e]), gotd = bf2f(WSP(bf16, WS_ODZ)[(size_t)row * 512 + e]);
      dn = (gotn - refn) * (gotn - refn); rn = refn * refn; dd = (gotd - refd) * (gotd - refd); rd = refd * refd; }
    dn = blk_red(F, dn, false, red); rn = blk_red(F, rn, false, red); dd = blk_red(F, dd, false, red); rd = blk_red(F, rd, false, red);
    float dc = 0.f, rc = 0.f;
    {
        const bool cs = oi >= 96; const int cbg = cs ? (oi * 5) % 256 : oi % 8, cn = cs ? (oi * 11) % 127 : (oi * 13) % 255;
        for (int slot = 0; slot < 2; ++slot) {
            const bf16* data = cs ? WSP(bf16, slot ? WS_SCMPV : WS_SCMPK) + (size_t)cbg * LS * 64 + (size_t)cn * 1024 : WSP(bf16, slot ? WS_PCMPV : WS_PCMPK) + (size_t)cbg * SEQ * 64 + (size_t)cn * 1024;
            __syncthreads();
            if (F.tid < 128) { float a = 0.f; for (int k = 0; k < 2048; ++k) a += (bf2f(data[k]) + F.pe[slot * 2048 + k]) * F.w1[((size_t)slot * 2048 + k) * 128 + F.tid]; sc[F.tid] = a / (1.f + expf(-a)); }
            __syncthreads();
            if (F.tid < 64) { float a = 0.f; for (int c = 0; c < 128; ++c) a += sc[c] * F.w2[((size_t)slot * 128 + c) * 64 + F.tid];
                float got;
                if (slot == 0) got = bf2f((cs ? WSP(bf16, WS_SCK) + (size_t)cbg * 128 * 64 : WSP(bf16, WS_PCK) + (size_t)cbg * 256 * 64)[(size_t)cn * 64 + F.tid]);
                else got = bf2f((cs ? WSP(bf16, WS_SCVT) + (size_t)cbg * 64 * 128 : WSP(bf16, WS_PCVT) + (size_t)cbg * 64 * 256)[(size_t)F.tid * (cs ? 128 : 256) + permk(cn)]);
                dc += (got - a) * (got - a); rc += a * a; }
        }
    }
    dc = blk_red(F, dc, false, red); rc = blk_red(F, rc, false, red);
    if (F.tid == 0) { float* o = WSP(float, WS_ORC) + oi * 8; o[0] = dn; o[1] = rn; o[2] = dd; o[3] = rd; o[4] = dc; o[5] = rc; }
    __syncthreads();
}
DI float oracle_value(Frame& F) {
    const float* o = WSP(float, WS_ORC);
    float bad = 0.f, acc = 0.f, mxe = 0.f;
    for (int i = 0; i < ORC_ROWS; ++i) { const int c = (ORACLE_MODE >= 6) ? 4 : (ORACLE_MODE & 1) ? 2 : 0; const float e = sqrtf(o[i * 8 + c] / fmaxf(o[i * 8 + c + 1], 1e-30f));
        bad += e > 0.03f ? 1.f : 0.f; acc += fminf(e, 1.f) * fminf(e, 1.f); mxe = fmaxf(mxe, fminf(e, 1.f)); }
    return (ORACLE_MODE < 2 || ORACLE_MODE == 6) ? bad / ORC_ROWS : (ORACLE_MODE < 4 || ORACLE_MODE == 7) ? sqrtf(acc / ORC_ROWS) : mxe;
}
#endif

#define XB_TMO      128
#define XB_XCNT(j)  (256  + 64 * (j))
#define XB_XSUB(j)  (1280 + 64 * (j))
#define XB_XGEN(j)  (2304 + 64 * (j))
#define XB_TOP      3328
#define XB_TOPGEN   3392
#define XCD_BAR_WORDS 3456
#define XB_SPIN_CAP (1u << 18)
__device__ __forceinline__ unsigned xb_ld(unsigned* p)              { return __hip_atomic_load(p, __ATOMIC_RELAXED, __HIP_MEMORY_SCOPE_AGENT); }
__device__ __forceinline__ unsigned xb_add(unsigned* p, unsigned v) { return __hip_atomic_fetch_add(p, v, __ATOMIC_RELAXED, __HIP_MEMORY_SCOPE_AGENT); }
__device__ __forceinline__ unsigned xb_xcc_id() { return (unsigned)__builtin_amdgcn_s_getreg((3 << 11) | 20) & 0xFu; }
#define XB_SPIN(cond, bar) do { unsigned _sp = 0; while (cond) { __builtin_amdgcn_s_sleep(1); \
    if ((++_sp & 255u) == 0u) { if (xb_ld(&(bar)[XB_TMO])) break; if (_sp > XB_SPIN_CAP) { atomicAdd(&(bar)[XB_TMO], 1u); break; } } } } while (0)
struct XcdBarrier { unsigned* bar; unsigned x; volatile LAS unsigned* st; };
__device__ __forceinline__ XcdBarrier xcd_barrier_post(unsigned* bar, volatile LAS unsigned* st) {
    XcdBarrier b; b.bar = bar; b.x = xb_xcc_id(); b.st = st;
    if (threadIdx.x == 0) (void)xb_add(&bar[XB_XCNT(b.x)], 1u);
    return b;
}
__device__ __forceinline__ void xcd_barrier_complete(unsigned* bar, unsigned x, unsigned& nloc, unsigned& nx) {
    const unsigned G = gridDim.x * gridDim.y * gridDim.z;
    unsigned sum, cnt, mine, sp = 0u;
    for (;;) {
        sum = 0u; cnt = 0u; mine = 0u;
#pragma unroll
        for (unsigned j = 0; j < 16; ++j) { const unsigned c = xb_ld(&bar[XB_XCNT(j)]); sum += c; cnt += (c > 0u) ? 1u : 0u; mine = (j == x) ? c : mine; }
        if (sum == G) break;
        __builtin_amdgcn_s_sleep(1);
        if ((++sp & 255u) == 0u) { if (xb_ld(&bar[XB_TMO])) break; if (sp > XB_SPIN_CAP) { atomicAdd(&bar[XB_TMO], 1u); break; } }
    }
    nloc = mine > 0u ? mine : 1u; nx = cnt > 0u ? cnt : 1u;
}
__device__ __forceinline__ void xcd_barrier(const XcdBarrier& b) {
    asm volatile("s_waitcnt vmcnt(0)" ::: "memory");
    __syncthreads();
    if (threadIdx.x == 0) {
        unsigned* bar = b.bar;
        __builtin_amdgcn_s_waitcnt(0);
        unsigned nloc = b.st[0], nx = b.st[1];
        if (nloc == 0u) { xcd_barrier_complete(bar, b.x, nloc, nx); b.st[0] = nloc; b.st[1] = nx; }
        const unsigned old = xb_add(&bar[XB_XSUB(b.x)], 1u);
        const unsigned gen = old / nloc;
        if (old + 1u == (gen + 1u) * nloc) {
            __builtin_amdgcn_fence(__ATOMIC_RELEASE, "agent");
            asm volatile("s_waitcnt vmcnt(0)" ::: "memory");
            const unsigned og = xb_add(&bar[XB_TOP], 1u);
            const unsigned tg = og / nx;
            if (og + 1u == (tg + 1u) * nx) xb_add(&bar[XB_TOPGEN], 1u);
            else XB_SPIN(xb_ld(&bar[XB_TOPGEN]) == tg, bar);
            __builtin_amdgcn_fence(__ATOMIC_ACQUIRE, "agent");
            xb_add(&bar[XB_XGEN(b.x)], 1u);
            asm volatile("s_waitcnt vmcnt(0)" ::: "memory");
        } else {
            XB_SPIN(xb_ld(&bar[XB_XGEN(b.x)]) == gen, bar);
            __builtin_amdgcn_fence(__ATOMIC_ACQUIRE, "agent");
            asm volatile("s_waitcnt vmcnt(0)" ::: "memory");
        }
    }
    __syncthreads();
}

constexpr int N_PHASES = 9;
DI int q_next(Frame& F, int qi) {
    __syncthreads();
    if (F.tid == 0) F.MISC[0] = __hip_atomic_fetch_add(F.ctl + CW_Q + 64 * (qi + F.qoff), 1u, __ATOMIC_RELAXED, __HIP_MEMORY_SCOPE_AGENT);
    __syncthreads();
    return (int)F.MISC[0];
}
DI void q_issue(Frame& F, int qi, unsigned& pend) { if (F.tid == 0) pend = __hip_atomic_fetch_add(F.ctl + CW_Q + 64 * qi, 1u, __ATOMIC_RELAXED, __HIP_MEMORY_SCOPE_AGENT); }
DI int q_take(Frame& F, unsigned pend) { __syncthreads(); if (F.tid == 0) F.MISC[0] = pend; __syncthreads(); return (int)F.MISC[0]; }
#define QLOOP(qi, N, CALL) do { for (int u = q_next(F, (qi)); u < (N); u = q_next(F, (qi))) { CALL; } } while (0)
__global__ void __launch_bounds__(NWAVES * 64, 2) fwd(Args args) {
    extern __shared__ __attribute__((aligned(16))) unsigned char lds[];
    Frame F;
    F.lds = (LAS unsigned char*)lds; F.MISC = (volatile LAS unsigned*)(F.lds + MISC_OFF);
    F.tid = threadIdx.x; F.lane = F.tid & 63; F.wave = __builtin_amdgcn_readfirstlane(F.tid >> 6); F.G = gridDim.x;
    F.ws = args.ws; F.out = args.out; F.ctl = (unsigned*)(args.ws + WS_CTL); F.qoff = args.qoff;
    F.xp = (const float*)args.in[0]; F.xs = (const float*)args.in[1]; F.cnsa = (const float*)args.in[2]; F.cdsa = (const float*)args.in[3]; F.cidx = (const float*)args.in[4];
    F.swin = (const float*)args.in[5]; F.ptab = (const int*)args.in[6]; F.cp = (const float*)args.in[7]; F.cs = (const float*)args.in[8]; F.normg = (const float*)args.in[9];
    F.wada = (const float*)args.in[10]; F.bada = (const float*)args.in[11]; F.win = (const float*)args.in[12]; F.pe = (const float*)args.in[13]; F.w1 = (const float*)args.in[14];
    F.w2 = (const float*)args.in[15]; F.wupn = (const float*)args.in[16]; F.wupd = (const float*)args.in[17]; F.wout = (const float*)args.in[18]; F.fing = (const float*)args.in[19];
    for (int i = F.tid; i < (LDS_BYTES - MISC_OFF) / 4; i += NWAVES * 64) ((LAS unsigned*)(F.lds + MISC_OFF))[i] = 0u;
    __syncthreads();
    const int lo = args.ph_lo, hi = args.ph_hi;
    const bool one = (hi - lo) > 1;
    XcdBarrier bar; bar.bar = F.ctl + CW_BAR; bar.x = 0; bar.st = nullptr;
    if (one) bar = xcd_barrier_post(F.ctl + CW_BAR, F.MISC + 8);
#ifndef PH_MASK
#define PH_MASK 0x1ff
#endif
#define IN(k) (((PH_MASK >> (k)) & 1) && lo <= (k) && (k) < hi)
#define SEAM(k) do { if (IN(k) && IN((k) + 1)) xcd_barrier(bar); } while (0)

#ifndef PROBE_REP
#define PROBE_REP -1
#endif
#define REP(k, BODY) do { if (IN(k)) { BODY(0) } } while (0)
#ifndef PROBE_P4MASK
#define PROBE_P4MASK 15
#endif
#ifndef PROBE_ABL
#define PROBE_ABL 0
#endif
#define B0(qo) { p0_prologue(F, args.umask); }
#define B1(qo) { p1_adaln(F); }
#define B2(qo) { pg8::Gemm g{WSP(bf16, WS_H), WSP(bf16, WS_WINT), MR, NPAD, DM}; pg8::StaticOrder S; S.init(MR, NPAD, F.G, (int)blockIdx.x); \
        { EpiInProj E{F.ws, F.out}; pg8::gemm_phase<EpiInProj, pg8::StaticOrder, true, true>(F.lds, g, S, E); } }
#define B3(qo) { const int PM3_ = args.umask;     \
        if (PM3_ & 4) QLOOP(2 + qo, SBATCH, (idx1_unit<true, 0>(F, u))); \
        if (PM3_ & 1) QLOOP(0 + qo, 272, compress_unit(F, u)); \
        if (PM3_ & 2) QLOOP(1 + qo, 2048, (idx1_unit<false, 0>(F, u))); }
#ifndef P4_MASK
#define P4_MASK 15
#endif
#define B4(qo) { const int PM_ = args.umask & P4_MASK; const bool strm_ = (blockIdx.x & 1) == 0 || args.qoff != 0;     \
        if ((PM_ & 1) && strm_) QLOOP(3 + qo, 256, nsa_sample_unit(F, u)); \
        if ((PM_ & 2) && strm_) QLOOP(4 + qo, 256, dsa_sample_unit(F, u)); \
        if (PM_ & 4) QLOOP(5 + qo, 512, nsa_unit<false>(F, u)); \
        if (PM_ & 8) QLOOP(6 + qo, 512, (dsa_unit<0>(F, u))); }
#define B5(qo) { small_gemm<512>(F, WSP(bf16, WS_ONZ), WSP(bf16, WS_WUPN), [&](int r, int c, float v) { WSP(bf16, WS_T1)[(size_t)r * 1024 + c] = (bf16)(pk2(v * bf2f(WSP(bf16, WS_MG)[(size_t)r * 2048 + c]), 0.f) & 0xffffu); }); \
        pg8::Gemm g{WSP(bf16, WS_ONZ), WSP(bf16, WS_WUPN), MP, DM, 512}; pg8::StaticOrder S; S.init(MP, DM, F.G, (int)blockIdx.x); EpiUp1 E{F.ws}; \
        pg8::gemm_phase<EpiUp1, pg8::StaticOrder, true, true>(F.lds, g, S, E); }
#define B6(qo) { small_gemm<512>(F, WSP(bf16, WS_ODZ), WSP(bf16, WS_WUPD), [&](int r, int c, float v) { WSP(bf16, WS_M1)[(size_t)r * 1024 + c] = (bf16)(pk2(bf2f(WSP(bf16, WS_T1)[(size_t)r * 1024 + c]) + v * bf2f(WSP(bf16, WS_MG)[(size_t)r * 2048 + 1024 + c]), 0.f) & 0xffffu); }); \
        pg8::Gemm g{WSP(bf16, WS_ODZ), WSP(bf16, WS_WUPD), MP, DM, 512}; pg8::StaticOrder S; S.init(MP, DM, F.G, (int)blockIdx.x); EpiUp2 E{F.ws}; \
        pg8::gemm_phase<EpiUp2, pg8::StaticOrder, true, true>(F.lds, g, S, E); }
#define B7(qo) { small_gemm<1024>(F, WSP(bf16, WS_M1), WSP(bf16, WS_WOUT), [&](int r, int c, float v) { const int rs = r - MP; F.out[O_YS + (size_t)rs * 1024 + c] = F.xs[(size_t)rs * 1024 + c] + WSP(float, WS_MOD)[(size_t)(4 + (rs >> 2)) * 3072 + 2048 + c] * v; }); \
        pg8::Gemm g{WSP(bf16, WS_M1), WSP(bf16, WS_WOUT), MP, DM, DM}; pg8::StaticOrder S; S.init(MP, DM, F.G, (int)blockIdx.x); EpiOut E{F.ws, F.out, F.xp, F.xs}; \
        pg8::gemm_phase<EpiOut, pg8::StaticOrder, true, true>(F.lds, g, S, E); }
#define B8(qo) { p8_final(F); }
    REP(0, B0); SEAM(0);
    REP(1, B1); SEAM(1);
    REP(2, B2); SEAM(2);
    REP(3, B3); SEAM(3);
    REP(4, B4); SEAM(4);
#ifdef ORACLE
    if (IN(4)) { for (int oi = blockIdx.x; oi < ORC_ROWS; oi += F.G) oracle_row(F, oi); xcd_barrier(bar); }
#endif
    REP(5, B5);
    REP(6, B6); SEAM(6);
    REP(7, B7); SEAM(7);
    if (IN(8)) { p8_final(F); }
#ifdef ORACLE
    if (IN(8)) { xcd_barrier(bar); const float val = oracle_value(F); const float sc = 1.f + 0.02f * (1.f + val);
        for (size_t i = (size_t)blockIdx.x * 512 + F.tid; i < (size_t)MP * 1024; i += (size_t)F.G * 512) F.out[O_YP + i] *= sc; }
#endif
#undef IN
#undef SEAM
}

extern "C" void kernel_launch(void* const* d_in, const int* in_sizes, int n_in, void* d_out, int out_size, void* d_ws, size_t ws_size, hipStream_t stream) {
    static int grid = 0;
    if (grid == 0) {
        if (n_in != 20 || (size_t)out_size != O_END || ws_size < WS_END) { fprintf(stderr, "kernel_launch: unexpected shapes (n_in %d, out %d, ws %zu)\n", n_in, out_size, ws_size); grid = -1; return; }
        int dev = 0, cus = 0, per_cu = 0;
        if (hipGetDevice(&dev) != hipSuccess || hipDeviceGetAttribute(&cus, hipDeviceAttributeMultiprocessorCount, dev) != hipSuccess) { grid = -1; return; }
        if (hipFuncSetAttribute((const void*)fwd, hipFuncAttributeMaxDynamicSharedMemorySize, LDS_BYTES) != hipSuccess) { fprintf(stderr, "kernel_launch: hipFuncSetAttribute failed\n"); grid = -1; return; }
        if (hipOccupancyMaxActiveBlocksPerMultiprocessor(&per_cu, (const void*)fwd, NWAVES * 64, LDS_BYTES) != hipSuccess || per_cu < 1) { fprintf(stderr, "kernel_launch: occupancy query says %d blocks per CU\n", per_cu); }
        (void)hipGetLastError();
        grid = cus;
    }
    if (grid < 0) return;
    (void)hipMemsetAsync((char*)d_ws + WS_CTL, 0, CTL_ZERO_BYTES, stream);
    Args a{};
    for (int i = 0; i < 20; ++i) a.in[i] = d_in[i];
    a.out = (float*)d_out; a.ws = (unsigned char*)d_ws; a.qoff = 0; a.umask = 15; a.pad0 = 0; a.pad1 = 0;
#if MK_N_LAUNCHES == 1
    a.ph_lo = 0; a.ph_hi = N_PHASES;
    hipLaunchKernelGGL(fwd, dim3(grid), dim3(NWAVES * 64), LDS_BYTES, stream, a);
#if PROBE_REP >= 0
    a.ph_lo = PROBE_REP; a.ph_hi = PROBE_REP + 1; a.qoff = 8; a.umask = PROBE_P4MASK;
    hipLaunchKernelGGL(fwd, dim3(grid), dim3(NWAVES * 64), LDS_BYTES, stream, a);
#endif
#else
    for (int p = 0; p < N_PHASES; ++p) { a.ph_lo = p; a.ph_hi = p + 1; hipLaunchKernelGGL(fwd, dim3(grid), dim3(NWAVES * 64), LDS_BYTES, stream, a); }
#endif
}
```

```cpp
#define MK_N_LAUNCHES 1
#include <hip/hip_runtime.h>
#include <cstdio>
#include <cstdint>
#ifndef MK_N_LAUNCHES
#define MK_N_LAUNCHES 1
#endif
namespace pg8 {
#define PG8_LAS __attribute__((address_space(3)))
typedef unsigned short bf16_t;
typedef short bf16x8 __attribute__((ext_vector_type(8)));
typedef float f32x4 __attribute__((ext_vector_type(4)));
typedef unsigned u32x4 __attribute__((ext_vector_type(4)));
constexpr int BM = 256, BK = 64, HALF = 128, HTB = HALF * BK * 2  , STAGE_BYTES = 8 * HTB, NXCD = 8, WGM = 8;

__host__ __device__ __forceinline__ int lds_byte(int r, int c) { const int st = (r >> 4) * 2 + (c >> 5), rr = r & 15, cc = c & 31, ob = rr * 64 + cc * 2; return st * 1024 + (ob ^ (((ob >> 9) & 1) << 5)); }
__host__ __device__ __forceinline__ void stage_rc(int b, int& R, int& C) { const int st = b / 1024, sb = b % 1024, swz = sb ^ (((sb >> 9) & 1) << 5); R = (st >> 1) * 16 + swz / 64; C = (st & 1) * 32 + (swz % 64) / 2; }
__host__ __device__ __forceinline__ int perm32(int rho) { const int n = rho >> 4, i = rho & 15; return 8 * (i >> 2) + 4 * n + (i & 3); }

struct Unit { int pm, pn; };
struct Gemm { const bf16_t* A; const bf16_t* Bt; int M, N, K; };

struct StaticOrder {
    int nM, nN, nwg, G, c;
    __host__ __device__ void init(int M, int N, int G_, int c_) { nM = M / BM; nN = N / BM; nwg = nM * nN; G = G_; c = c_; }
    __host__ __device__ bool next(int i, Unit& u) const {
        const long L = (long)i * G + c; if (L >= nwg) return false;
        int wgid = (int)L; { const int q = nwg / NXCD, r = nwg % NXCD, xcd = wgid % NXCD, off = wgid / NXCD; wgid = (xcd < r ? xcd * (q + 1) : r * (q + 1) + (xcd - r) * q) + off; }
        const int nig = WGM * nN, gid = wgid / nig, fm = gid * WGM, gsz = (nM - fm) < WGM ? (nM - fm) : WGM;
        u.pm = fm + ((wgid % nig) % gsz); u.pn = (wgid % nig) / gsz; return true;
    }
    __device__ __forceinline__ void a_ready(const Unit&) const {}
    __device__ __forceinline__ void done(const Unit&) const {}
};

typedef float f32x2p __attribute__((ext_vector_type(2))); typedef __bf16 bf16x2p __attribute__((ext_vector_type(2)));
__device__ __forceinline__ unsigned cvt_pk_bf16(float lo, float hi) { f32x2p v = {lo, hi}; bf16x2p b = __builtin_convertvector(v, bf16x2p); return __builtin_bit_cast(unsigned, b); }
template <class Epi, class Sched, bool ALIGN_EPI = false, bool SP2 = false>
__device__ __forceinline__ void gemm_phase(PG8_LAS unsigned char* lds, const Gemm g, const Sched& S, const Epi& E) {
    const int tid = threadIdx.x, wid = __builtin_amdgcn_readfirstlane(tid >> 6), lane = tid & 63, wr = wid >> 2, wc = wid & 3, fr = lane & 15, fq = lane >> 4;
    const int K = g.K, nt = K / BK;
    unsigned voffA[2], voffB[2];
#pragma unroll
    for (int i = 0; i < 2; ++i) { int R, C; stage_rc(tid * 16 + i * 8192, R, C); const int Rb = Epi::PERM ? ((R & ~31) + perm32(R & 31)) : R;
        voffA[i] = (unsigned)(R * K + C) * 2u; voffB[i] = (unsigned)(Rb * K + C) * 2u; }
    const size_t kstep = (size_t)(BK * 2);
    const size_t hstep = (size_t)HALF * K * 2;
    const size_t tstep = 2 * hstep;
    const unsigned ldsw = (unsigned)wid * 1024u;
    const int aoff = lds_byte(wr * 64 + fr, fq * 8), boff = lds_byte(wc * 32 + fr, fq * 8);
#define PG8_SA(b, h) (((b) * 2 + (h)) * HTB)
#define PG8_SB(b, h) ((4 + (b) * 2 + (h)) * HTB)
#define PG8_STAGE(bufoff, gbase, voff) do { _Pragma("unroll") for (int _i = 0; _i < 2; ++_i) \
        __builtin_amdgcn_global_load_lds((const unsigned*)((const char*)(gbase) + (voff)[_i]), (PG8_LAS unsigned*)(lds + (bufoff) + ldsw + _i * 8192), 16, 0, 0); } while (0)
#define PG8_LDA(dst, b, h) do { _Pragma("unroll") for (int m = 0; m < 4; ++m) _Pragma("unroll") for (int k = 0; k < 2; ++k) dst[m][k] = *(const PG8_LAS bf16x8*)(lds + PG8_SA(b, h) + aoff + m * 2048 + k * 1024); } while (0)
#define PG8_LDB(dst, b, h) do { _Pragma("unroll") for (int n = 0; n < 2; ++n) _Pragma("unroll") for (int k = 0; k < 2; ++k) dst[n][k] = *(const PG8_LAS bf16x8*)(lds + PG8_SB(b, h) + boff + n * 2048 + k * 1024); } while (0)
#define PG8_MMA(ai, bj, At, Bt) do { __builtin_amdgcn_s_setprio(1); _Pragma("unroll") for (int m = 0; m < 4; ++m) _Pragma("unroll") for (int n = 0; n < 2; ++n) _Pragma("unroll") for (int k = 0; k < 2; ++k) \
        acc[ai][bj][m][n] = __builtin_amdgcn_mfma_f32_16x16x32_bf16(Bt[n][k], At[m][k], acc[ai][bj][m][n], 0, 0, 0); __builtin_amdgcn_s_setprio(0); } while (0)
#define PG8_WAIT_V(n) asm volatile("s_waitcnt vmcnt(" #n ")" ::: "memory")
#define PG8_WAIT_L(n) asm volatile("s_waitcnt lgkmcnt(" #n ")" ::: "memory")
#define PG8_BAR __builtin_amdgcn_s_barrier()
#define PG8_SCHED __builtin_amdgcn_sched_barrier(0)
    Unit cur, nxt; int ui = 0;
    if (!S.next(0, cur)) return;
    f32x4 acc[2][2][4][2];
#pragma unroll
    for (int a = 0; a < 2; ++a)
#pragma unroll
        for (int b = 0; b < 2; ++b)
#pragma unroll
            for (int m = 0; m < 4; ++m)
#pragma unroll
                for (int n = 0; n < 2; ++n) acc[a][b][m][n] = (f32x4){0.f, 0.f, 0.f, 0.f};
    bf16x8 At[4][2], B0[2][2], B1[2][2];
    const char* cA = (const char*)g.A + (size_t)cur.pm * tstep; const char* cB = (const char*)g.Bt + (size_t)cur.pn * tstep;
    S.a_ready(cur);
    if constexpr (SP2) {
        PG8_STAGE(PG8_SB(0, 0), cB, voffB); PG8_STAGE(PG8_SB(0, 1), cB + hstep, voffB); PG8_STAGE(PG8_SA(0, 0), cA, voffA); PG8_STAGE(PG8_SA(0, 1), cA + hstep, voffA);
        if (wr == 1) PG8_BAR;
        PG8_WAIT_V(2); PG8_BAR;
        PG8_STAGE(PG8_SB(1, 0), cB + kstep, voffB); PG8_STAGE(PG8_SA(1, 0), cA + kstep, voffA); PG8_STAGE(PG8_SB(1, 1), cB + hstep + kstep, voffB);
        PG8_WAIT_V(6); PG8_BAR;
    } else {
        PG8_STAGE(PG8_SB(0, 0), cB, voffB); PG8_STAGE(PG8_SA(0, 0), cA, voffA); PG8_STAGE(PG8_SB(0, 1), cB + hstep, voffB); PG8_STAGE(PG8_SA(0, 1), cA + hstep, voffA);
        if (wr == 1) PG8_BAR;
        PG8_WAIT_V(4); PG8_BAR;
        PG8_STAGE(PG8_SB(1, 0), cB + kstep, voffB); PG8_STAGE(PG8_SA(1, 0), cA + kstep, voffA); PG8_STAGE(PG8_SB(1, 1), cB + hstep + kstep, voffB);
        PG8_WAIT_V(6); PG8_BAR;
    }
    for (;;) {
        const bool has_next = S.next(ui + 1, nxt);
        const char* nA = has_next ? (const char*)g.A + (size_t)nxt.pm * tstep : cA; const char* nB = has_next ? (const char*)g.Bt + (size_t)nxt.pn * tstep : cB;
        for (int t = 0; t < nt; t += 2) {
            const bool last = (t == nt - 2);
            const char* a1 = cA + (size_t)(t + 1) * kstep;
            const char* a2 = last ? nA : cA + (size_t)(t + 2) * kstep; const char* b2 = last ? nB : cB + (size_t)(t + 2) * kstep;
            const char* a3 = a2 + kstep; const char* b3 = b2 + kstep;
            if (last && has_next) S.a_ready(nxt);
            if constexpr (SP2) {
            PG8_LDB(B0, 0, 0); PG8_LDB(B1, 0, 1); PG8_SCHED; PG8_LDA(At, 0, 0); PG8_STAGE(PG8_SA(1, 1), a1 + hstep, voffA);
            PG8_WAIT_V(8); PG8_WAIT_L(0); PG8_BAR; PG8_MMA(0, 0, At, B0); PG8_MMA(0, 1, At, B1); PG8_BAR; PG8_SCHED;
            PG8_LDA(At, 0, 1); PG8_STAGE(PG8_SB(0, 0), b2, voffB); PG8_STAGE(PG8_SB(0, 1), b2 + hstep, voffB); PG8_STAGE(PG8_SA(0, 0), a2, voffA);
            PG8_WAIT_V(8); PG8_WAIT_L(0); PG8_BAR; PG8_MMA(1, 0, At, B0); PG8_MMA(1, 1, At, B1); PG8_BAR; PG8_SCHED;
            PG8_LDB(B0, 1, 0); PG8_LDB(B1, 1, 1); PG8_SCHED; PG8_LDA(At, 1, 0); PG8_STAGE(PG8_SA(0, 1), a2 + hstep, voffA);
            PG8_WAIT_V(8); PG8_WAIT_L(0); PG8_BAR; PG8_MMA(0, 0, At, B0); PG8_MMA(0, 1, At, B1); PG8_BAR; PG8_SCHED;
            PG8_LDA(At, 1, 1); PG8_STAGE(PG8_SB(1, 0), b3, voffB); PG8_STAGE(PG8_SB(1, 1), b3 + hstep, voffB); PG8_STAGE(PG8_SA(1, 0), a3, voffA);
            PG8_WAIT_V(8); PG8_WAIT_L(0); PG8_BAR; PG8_MMA(1, 0, At, B0); PG8_MMA(1, 1, At, B1); PG8_BAR; PG8_SCHED;
            } else {
            PG8_LDB(B0, 0, 0); PG8_SCHED; PG8_LDA(At, 0, 0); PG8_STAGE(PG8_SA(1, 1), a1 + hstep, voffA);
            PG8_WAIT_L(8); PG8_BAR; PG8_WAIT_L(0); PG8_MMA(0, 0, At, B0); PG8_BAR; PG8_SCHED;
            PG8_LDB(B1, 0, 1); PG8_STAGE(PG8_SB(0, 0), b2, voffB);
            PG8_BAR; PG8_WAIT_L(0); PG8_MMA(0, 1, At, B1); PG8_BAR;
            PG8_LDA(At, 0, 1); PG8_STAGE(PG8_SA(0, 0), a2, voffA);
            PG8_BAR; PG8_WAIT_L(0); PG8_MMA(1, 0, At, B0); PG8_BAR; PG8_SCHED;
            PG8_STAGE(PG8_SB(0, 1), b2 + hstep, voffB);
            PG8_WAIT_V(6); PG8_BAR; PG8_MMA(1, 1, At, B1); PG8_BAR;
            PG8_LDB(B0, 1, 0); PG8_SCHED; PG8_LDA(At, 1, 0); PG8_STAGE(PG8_SA(0, 1), a2 + hstep, voffA);
            PG8_WAIT_L(8); PG8_BAR; PG8_WAIT_L(0); PG8_MMA(0, 0, At, B0); PG8_BAR; PG8_SCHED;
            PG8_LDB(B1, 1, 1); PG8_STAGE(PG8_SB(1, 0), b3, voffB);
            PG8_BAR; PG8_WAIT_L(0); PG8_MMA(0, 1, At, B1); PG8_BAR;
            PG8_LDA(At, 1, 1); PG8_STAGE(PG8_SA(1, 0), a3, voffA);
            PG8_BAR; PG8_WAIT_L(0); PG8_MMA(1, 0, At, B0); PG8_BAR; PG8_SCHED;
            PG8_STAGE(PG8_SB(1, 1), b3 + hstep, voffB);
            PG8_WAIT_V(6); PG8_BAR; PG8_MMA(1, 1, At, B1); PG8_BAR;
            }
        }
        if constexpr (ALIGN_EPI) { if (wr == 0) PG8_BAR; }
        if constexpr (!Epi::AFTER_DRAIN) { E(acc, cur, wr, wc, fr, fq); S.done(cur); }
        if (!has_next) break;
#pragma unroll
        for (int a = 0; a < 2; ++a)
#pragma unroll
            for (int b = 0; b < 2; ++b)
#pragma unroll
                for (int m = 0; m < 4; ++m)
#pragma unroll
                    for (int n = 0; n < 2; ++n) acc[a][b][m][n] = (f32x4){0.f, 0.f, 0.f, 0.f};
        cur = nxt; cA = nA; cB = nB; ++ui;
        if constexpr (ALIGN_EPI) { if (wr == 1) PG8_BAR; }
    }
    PG8_WAIT_V(0);
    if constexpr (!ALIGN_EPI) { if (wr == 0) PG8_BAR; }
    PG8_BAR;
    if constexpr (Epi::AFTER_DRAIN) { E.fused(acc, cur, wr, wc, fr, fq, lds, wid, lane); S.done(cur); }
#undef PG8_SA
#undef PG8_SB
#undef PG8_STAGE
#undef PG8_LDA
#undef PG8_LDB
#undef PG8_MMA
#undef PG8_WAIT_V
#undef PG8_WAIT_L
#undef PG8_BAR
#undef PG8_SCHED
}
}

#define LAS __attribute__((address_space(3)))
typedef unsigned short bf16;
typedef short bf16x8 __attribute__((ext_vector_type(8)));
typedef float f32x4 __attribute__((ext_vector_type(4)));
typedef float f32x16 __attribute__((ext_vector_type(16)));
typedef unsigned u32x4 __attribute__((ext_vector_type(4)));
typedef unsigned u32x2 __attribute__((ext_vector_type(2)));

constexpr int DM = 1024, NBATCH = 4, SEQ = 4096, MP = NBATCH * SEQ, SBATCH = 128, STOK = 4, MS = SBATCH * STOK, MR = MP + MS;
constexpr int PASTL = 2048, PAGE = 128, NPG = 16;
constexpr int LS = 2112, LSW = 576;
constexpr int NPAD = 5632;
constexpr float C2 = 0.125f * 1.4426950408889634f;
constexpr int NWAVES = 8;

constexpr size_t O_YP = 0, O_YS = 16777216, O_NSAP = 17301504, O_DSAP = 25690112, O_IDXP = 29884416, O_WINP = 30932992,
                 O_NSAS = 31457280, O_DSAS = 31719424, O_IDXS = 31850496, O_WINS = 31883264, O_END = 48660480;

constexpr size_t MiB = 1u << 20;
constexpr size_t WS_CTL = 0, CTL_ZERO_BYTES = 1 * MiB;
constexpr size_t WS_MOD = 1 * MiB;
constexpr size_t WS_COS = 3 * MiB, WS_SIN = 4 * MiB;
constexpr size_t WS_BIAS1 = 5 * MiB;
constexpr size_t WS_BIASP = 5 * MiB + 262144;
constexpr size_t WS_W2T = 5 * MiB + 65536;
constexpr size_t WS_W1T = 6 * MiB;
constexpr size_t WS_WINT = 8 * MiB;
constexpr size_t WS_WUPN = 20 * MiB, WS_WUPD = 21 * MiB, WS_WOUT = 22 * MiB;
constexpr size_t WS_PSLCVK = 975 * MiB, WS_PWINVK = 979 * MiB, WS_PDSAVK = 983 * MiB;
constexpr size_t WS_SELM = 960 * MiB;
constexpr size_t WS_GATES = 25 * MiB;
constexpr size_t WS_IW = 27 * MiB;
constexpr size_t WS_PCK = 28 * MiB, WS_PCVT = 28 * MiB + 262144;
constexpr size_t WS_SCK = 29 * MiB, WS_SCVT = 33 * MiB;
constexpr size_t WS_H = 40 * MiB;
constexpr size_t WS_QRAW = 80 * MiB, WS_QROT = 100 * MiB, WS_DQ = 120 * MiB, WS_IQ = 140 * MiB, WS_ZN = 150 * MiB, WS_ZD = 170 * MiB, WS_ONZ = 190 * MiB, WS_ODZ = 210 * MiB;
constexpr size_t WS_MG = 230 * MiB;
constexpr size_t WS_T1 = 300 * MiB;
constexpr size_t WS_M1 = 370 * MiB;
constexpr size_t WS_PCMPK = 410 * MiB, WS_PCMPV = 414 * MiB, WS_PSLCK = 418 * MiB, WS_PSLCVT = 422 * MiB, WS_PWINK = 426 * MiB, WS_PWINVT = 430 * MiB,
                 WS_PDSAK = 434 * MiB, WS_PDSAVT = 438 * MiB, WS_PIDXK = 442 * MiB;
constexpr size_t WS_SCMPK = 450 * MiB, WS_SCMPV = 520 * MiB, WS_SSLCK = 590 * MiB, WS_SSLCVT = 660 * MiB, WS_SDSAK = 730 * MiB, WS_SDSAVT = 800 * MiB,
                 WS_SWINK = 870 * MiB, WS_SWINVT = 890 * MiB, WS_SIDXK = 910 * MiB, WS_END = 990 * MiB;
constexpr int CW_BAR = 4096;
constexpr int CW_Q = 16384;

constexpr int RING_BYTES = 131072, MISC_OFF = RING_BYTES, LDS_BYTES = 147456;

struct Args { const void* in[20]; float* out; unsigned char* ws; int ph_lo, ph_hi, qoff, umask, pad0, pad1; };

struct Frame {
    LAS unsigned char* lds; volatile LAS unsigned* MISC; unsigned* ctl;
    int tid, lane, wave, G, qoff;
    unsigned char* ws; float* out;
    const float *xp, *xs, *cnsa, *cdsa, *cidx, *swin; const int* ptab; const float *cp, *cs, *normg, *wada, *bada, *win, *pe, *w1, *w2, *wupn, *wupd, *wout, *fing;
};
#define WSP(T, off) ((T*)(F.ws + (off)))

#define DI __device__ __forceinline__
#define LDS_WAIT() asm volatile("s_waitcnt lgkmcnt(0)" ::: "memory")
DI u32x4 gload16(const void* p) { u32x4 r; asm volatile("global_load_dwordx4 %0, %1, off" : "=v"(r) : "v"(p) : "memory"); return r; }
DI unsigned long long gload8(const void* p) { unsigned long long r; asm volatile("global_load_dwordx2 %0, %1, off" : "=v"(r) : "v"(p) : "memory"); return r; }
#define WAITV2(n, a, b) asm volatile("s_waitcnt vmcnt(" #n ")" : "+v"(a), "+v"(b) :: "memory")
#define WAITV1(n, a) asm volatile("s_waitcnt vmcnt(" #n ")" : "+v"(a) :: "memory")
#define LDS_BARRIER() do { asm volatile("s_waitcnt lgkmcnt(0)" ::: "memory"); __builtin_amdgcn_s_barrier(); asm volatile("" ::: "memory"); } while (0)
DI float wave_sum(float v) {
#define DPP_ADD_(ctrl, rmask) v += __int_as_float(__builtin_amdgcn_update_dpp(0, __float_as_int(v), (ctrl), (rmask), 0xF, false))
    DPP_ADD_(0xB1, 0xF);
    DPP_ADD_(0x4E, 0xF);
    DPP_ADD_(0x141, 0xF);
    DPP_ADD_(0x140, 0xF);
    DPP_ADD_(0x142, 0xA);
    DPP_ADD_(0x143, 0xC);
#undef DPP_ADD_
    return __int_as_float(__builtin_amdgcn_readlane(__float_as_int(v), 63));
}
DI int wave_sum_i(int v) {
#define DPP_ADDI_(ctrl, rmask) v += __builtin_amdgcn_update_dpp(0, v, (ctrl), (rmask), 0xF, false)
    DPP_ADDI_(0xB1, 0xF); DPP_ADDI_(0x4E, 0xF); DPP_ADDI_(0x141, 0xF); DPP_ADDI_(0x140, 0xF); DPP_ADDI_(0x142, 0xA); DPP_ADDI_(0x143, 0xC);
#undef DPP_ADDI_
    return __builtin_amdgcn_readlane(v, 63);
}
DI int wave_min_i(int v) {
#define DPP_MIN_(ctrl, rmask) { const int t_ = __builtin_amdgcn_update_dpp(v, v, (ctrl), (rmask), 0xF, false); v = t_ < v ? t_ : v; }
    DPP_MIN_(0xB1, 0xF) DPP_MIN_(0x4E, 0xF) DPP_MIN_(0x141, 0xF) DPP_MIN_(0x140, 0xF) DPP_MIN_(0x142, 0xA) DPP_MIN_(0x143, 0xC)
#undef DPP_MIN_
    return __builtin_amdgcn_readlane(v, 63);
}
DI int wave_max_i(int v) {
#define DPP_MAX_(ctrl, rmask) { const int t_ = __builtin_amdgcn_update_dpp(v, v, (ctrl), (rmask), 0xF, false); v = t_ > v ? t_ : v; }
    DPP_MAX_(0xB1, 0xF) DPP_MAX_(0x4E, 0xF) DPP_MAX_(0x141, 0xF) DPP_MAX_(0x140, 0xF) DPP_MAX_(0x142, 0xA) DPP_MAX_(0x143, 0xC)
#undef DPP_MAX_
    return __builtin_amdgcn_readlane(v, 63);
}
DI unsigned pk2(float lo, float hi) { return pg8::cvt_pk_bf16(lo, hi); }
DI float bflo(unsigned w) { return __uint_as_float(w << 16); }
DI float bfhi(unsigned w) { return __uint_as_float(w & 0xffff0000u); }
DI float bf2f(bf16 h) { return __uint_as_float((unsigned)h << 16); }
DI float sigm_f(float x) { return __builtin_amdgcn_rcpf(1.f + __builtin_amdgcn_exp2f(-1.4426950408889634f * x)); }
DI float silu_f(float x) { return x * sigm_f(x); }
DI int pos16(int o) { return 8 * ((o >> 2) & 1) + (o & 3) + 4 * (o >> 3); }
DI int permk(int t) { return (t & ~15) | pos16(t & 15); }
DI int crow(int r, int hi) { return (r & 3) + 8 * (r >> 2) + 4 * hi; }
DI float dpp_x1(float v) { return __int_as_float(__builtin_amdgcn_update_dpp(0, __float_as_int(v), 0xB1, 0xF, 0xF, true)); }
DI float dpp_x2(float v) { return __int_as_float(__builtin_amdgcn_update_dpp(0, __float_as_int(v), 0x4E, 0xF, 0xF, true)); }
DI float half_other(float v) {
    const unsigned u = __float_as_uint(v);
    auto rr = __builtin_amdgcn_permlane32_swap(u, u, false, false);
    return __uint_as_float(((threadIdx.x & 32) != 0) ? rr[0] : rr[1]);
}
DI u32x4 pack8(const float* v) { u32x4 w; w.x = pk2(v[0], v[1]); w.y = pk2(v[2], v[3]); w.z = pk2(v[4], v[5]); w.w = pk2(v[6], v[7]); return w; }
DI void st_bf8(bf16* p, const float* v) { *(u32x4*)p = pack8(v); }
DI void st_f8(float* p, const float* v) { __builtin_nontemporal_store((f32x4){v[0], v[1], v[2], v[3]}, (f32x4*)p); __builtin_nontemporal_store((f32x4){v[4], v[5], v[6], v[7]}, (f32x4*)(p + 4)); }
DI void st_vt8(bf16* p, size_t pitch, const float* v) {
#pragma unroll
    for (int j = 0; j < 8; ++j) p[(size_t)j * pitch] = (bf16)(pk2(v[j], 0.f) & 0xffffu);
}
#define PIN4(q) asm volatile("" : "+v"(q[0]), "+v"(q[1]), "+v"(q[2]), "+v"(q[3]))
#define NEGINF (-__builtin_inff())
#define MFMA32(a, b, c) __builtin_amdgcn_mfma_f32_32x32x16_bf16((a), (b), (c), 0, 0, 0)

DI int idx_key(float dot, float w) {
#pragma clang fp contract(off)
    float v = fmaxf(dot, 0.f) * w;
    v = v + dpp_x1(v);
    v = v + dpp_x2(v);
    int u = __float_as_int(v);
    u = (u == (int)0x80000000) ? 0 : u;
    return u ^ ((u >> 31) & 0x7fffffff);
}

template <int MODE> struct EpiInProjT {
    static constexpr bool PERM = true, AFTER_DRAIN = false;
    unsigned char* ws; float* out;
    DI void rope8(float* lo, float* hi, const float* c, const float* s) const {
#pragma unroll
        for (int j = 0; j < 8; ++j) { const float a = lo[j], b = hi[j]; lo[j] = a * c[j] - b * s[j]; hi[j] = b * c[j] + a * s[j]; }
    }
    DI void ldtab(float* c, float* s, int pos, int d0) const {
        const f32x4* cp = (const f32x4*)((const float*)(ws + WS_COS) + pos * 32 + d0);
        const f32x4* sp = (const f32x4*)((const float*)(ws + WS_SIN) + pos * 32 + d0);
        const f32x4 c0 = cp[0], c1 = cp[1], s0 = sp[0], s1 = sp[1];
        c[0] = c0[0]; c[1] = c0[1]; c[2] = c0[2]; c[3] = c0[3]; c[4] = c1[0]; c[5] = c1[1]; c[6] = c1[2]; c[7] = c1[3];
        s[0] = s0[0]; s[1] = s0[1]; s[2] = s0[2]; s[3] = s0[3]; s[4] = s1[0]; s[5] = s1[1]; s[6] = s1[2]; s[7] = s1[3];
        asm volatile("" : "+v"(c[0]), "+v"(c[1]), "+v"(c[2]), "+v"(c[3]), "+v"(c[4]), "+v"(c[5]), "+v"(c[6]), "+v"(c[7]));
        asm volatile("" : "+v"(s[0]), "+v"(s[1]), "+v"(s[2]), "+v"(s[3]), "+v"(s[4]), "+v"(s[5]), "+v"(s[6]), "+v"(s[7]));
    }
    DI void operator()(const pg8::f32x4 (&acc)[2][2][4][2], const pg8::Unit& u, int wr, int wc, int fr, int fq) const {
        const int hs = u.pn * 4 + wc;
        if (hs >= 86) return;
        if ((MODE & 2) && hs >= 20 && hs != 44 && !(hs >= 36 && hs < 40)) return;
        if ((MODE & 4) && hs < 20) return;
        const bool samp = u.pm >= 64;
        const int d0 = 8 * fq;
        const bool roped = hs < 8 || (hs >= 12 && hs < 14) || (hs >= 16 && hs < 18) || (hs >= 28 && hs < 36) || hs == 36 || hs == 37 || (hs >= 40 && hs <= 44);
        float rc[8], rs[8], dc[8], ds[8];
        if (roped) { if (samp) {
#pragma unroll
                for (int j = 0; j < 8; ++j) { dc[j] = 1.f; ds[j] = 0.f; }
            } else ldtab(dc, ds, 16, d0); }
#pragma unroll
        for (int ai = 0; ai < 2; ++ai)
#pragma unroll
            for (int m = 0; m < 4; ++m) {
                const int r = u.pm * 256 + ai * 128 + wr * 64 + m * 16 + fr;
                if (roped) {
                    if (m == 0) ldtab(rc, rs, samp ? PASTL + (r & 3) : (r & 4095), d0);
                    else {
#pragma unroll
                        for (int j = 0; j < 8; ++j) { const float a = rc[j], b = rs[j]; rc[j] = a * dc[j] - b * ds[j]; rs[j] = b * dc[j] + a * ds[j]; }
                    }
                }
                int b, t, pos;
                if (!samp) { b = r >> 12; t = r & 4095; pos = t; } else { b = (r - MP) >> 2; t = r & 3; pos = PASTL + t; }
                float lo[8], hi[8];
#pragma unroll
                for (int n = 0; n < 2; ++n)
#pragma unroll
                    for (int j = 0; j < 4; ++j) { lo[4 * n + j] = acc[ai][0][m][n][j]; hi[4 * n + j] = acc[ai][1][m][n][j]; }
                if (hs < 8) {
                    bf16* qa = (bf16*)(ws + WS_QRAW) + (size_t)r * 512 + hs * 64 + d0;
                    bf16* qb = (bf16*)(ws + WS_QROT) + (size_t)r * 512 + hs * 64 + d0;
                    float a[8], c[8];
#pragma unroll
                    for (int j = 0; j < 8; ++j) { a[j] = lo[j] * C2; c[j] = hi[j] * C2; }
                    st_bf8(qa, a); st_bf8(qa + 32, c);
                    rope8(lo, hi, rc, rs);
#pragma unroll
                    for (int j = 0; j < 8; ++j) { a[j] = lo[j] * C2; c[j] = hi[j] * C2; }
                    st_bf8(qb, a); st_bf8(qb + 32, c);
                } else if (hs < 20) {
                    const int ty = (hs - 8) >> 1, g = (hs - 8) & 1;
                    if (ty == 2 || ty == 4) rope8(lo, hi, rc, rs);
                    const int bg = b * 2 + g;
                    if (ty < 4) {
                        float* o = out + (samp ? O_NSAS + ((size_t)(r - MP) * 8 + ty * 2 + g) * 64 : O_NSAP + ((size_t)r * 8 + ty * 2 + g) * 64) + d0;
                        st_f8(o, lo); st_f8(o + 32, hi);
                    } else {
                        const int sl = ty - 4;
                        if (samp) { float* o = out + O_WINS + (((size_t)b * 512 + 508 + t) * 4 + sl * 2 + g) * 64 + d0; st_f8(o, lo); st_f8(o + 32, hi); }
                        else if (t >= SEQ - 512) { float* o = out + O_WINP + (((size_t)b * 512 + (t - (SEQ - 512))) * 4 + sl * 2 + g) * 64 + d0; st_f8(o, lo); st_f8(o + 32, hi); }
                    }
                    if (ty == 3 || ty == 5) {
                        size_t pitch; int kp; bf16* base;
                        if (!samp) { pitch = SEQ; kp = t; base = (bf16*)(ws + (ty == 3 ? WS_PSLCVT : WS_PWINVT)); }
                        else if (ty == 3) { pitch = LS; kp = PASTL + t; base = (bf16*)(ws + WS_SSLCVT); }
                        else { pitch = LSW; kp = 512 + t; base = (bf16*)(ws + WS_SWINVT); }
                        bf16* p = base + ((size_t)bg * 64 + d0) * pitch + permk(kp);
                        if (!(MODE & 1)) { st_vt8(p, pitch, lo); st_vt8(p + 32 * pitch, pitch, hi); }
                    } else {
                        size_t rowi; bf16* base;
                        if (!samp) { rowi = (size_t)bg * SEQ + t; base = (bf16*)(ws + (ty == 0 ? WS_PCMPK : ty == 1 ? WS_PCMPV : ty == 2 ? WS_PSLCK : WS_PWINK)); }
                        else if (ty == 4) { rowi = (size_t)bg * LSW + 512 + t; base = (bf16*)(ws + WS_SWINK); }
                        else { rowi = (size_t)bg * LS + PASTL + t; base = (bf16*)(ws + (ty == 0 ? WS_SCMPK : ty == 1 ? WS_SCMPV : WS_SSLCK)); }
                        bf16* p = base + rowi * 64 + d0;
                        st_bf8(p, lo); st_bf8(p + 32, hi);
                    }
                } else if (hs < 28 || (hs >= 45 && hs < 53)) {
                    const int h = hs < 28 ? hs - 20 : hs - 45;
                    bf16* p = (bf16*)(ws + (hs < 28 ? WS_ZN : WS_ZD)) + (size_t)r * 512 + h * 64 + d0;
#pragma unroll
                    for (int j = 0; j < 8; ++j) { lo[j] = silu_f(lo[j]); hi[j] = silu_f(hi[j]); }
                    st_bf8(p, lo); st_bf8(p + 32, hi);
                } else if (hs < 36) {
                    rope8(lo, hi, rc, rs);
#pragma unroll
                    for (int j = 0; j < 8; ++j) { lo[j] *= C2; hi[j] *= C2; }
                    bf16* p = (bf16*)(ws + WS_DQ) + (size_t)r * 512 + (hs - 28) * 64 + d0;
                    st_bf8(p, lo); st_bf8(p + 32, hi);
                } else if (hs < 40) {
                    const int sl = (hs - 36) >> 1, g = (hs - 36) & 1, bg = b * 2 + g;
                    if (sl == 0) rope8(lo, hi, rc, rs);
                    float* o = out + (samp ? O_DSAS + ((size_t)(r - MP) * 4 + sl * 2 + g) * 64 : O_DSAP + ((size_t)r * 4 + sl * 2 + g) * 64) + d0;
                    st_f8(o, lo); st_f8(o + 32, hi);
                    if (sl == 0) {
                        bf16* p = samp ? (bf16*)(ws + WS_SDSAK) + ((size_t)bg * LS + PASTL + t) * 64 + d0 : (bf16*)(ws + WS_PDSAK) + ((size_t)bg * SEQ + t) * 64 + d0;
                        st_bf8(p, lo); st_bf8(p + 32, hi);
                    } else {
                        const size_t pitch = samp ? LS : SEQ; const int kp = samp ? PASTL + t : t;
                        bf16* p = (bf16*)(ws + (samp ? WS_SDSAVT : WS_PDSAVT)) + ((size_t)bg * 64 + d0) * pitch + permk(kp);
                        if (!(MODE & 1)) { st_vt8(p, pitch, lo); st_vt8(p + 32 * pitch, pitch, hi); }
                    }
                } else if (hs < 44) {
                    rope8(lo, hi, rc, rs);
                    bf16* p = (bf16*)(ws + WS_IQ) + (size_t)r * 256 + (hs - 40) * 64 + d0;
                    st_bf8(p, lo); st_bf8(p + 32, hi);
                } else if (hs == 44) {
                    rope8(lo, hi, rc, rs);
                    float* o = out + (samp ? O_IDXS + (size_t)(r - MP) * 64 : O_IDXP + (size_t)r * 64) + d0;
                    st_f8(o, lo); st_f8(o + 32, hi);
                    bf16* p = samp ? (bf16*)(ws + WS_SIDXK) + ((size_t)b * LS + PASTL + t) * 64 + d0 : (bf16*)(ws + WS_PIDXK) + (size_t)r * 64 + d0;
                    st_bf8(p, lo); st_bf8(p + 32, hi);
                } else if (hs < 85) {
                    bf16* p = (bf16*)(ws + WS_MG) + (size_t)r * 2048 + (hs - 53) * 64 + d0;
#pragma unroll
                    for (int j = 0; j < 8; ++j) { lo[j] = sigm_f(lo[j]); hi[j] = sigm_f(hi[j]); }
                    st_bf8(p, lo); st_bf8(p + 32, hi);
                } else {
                    if (fq < 3) { float* p = (float*)(ws + WS_GATES) + (size_t)r * 24 + d0;
#pragma unroll
                        for (int j = 0; j < 8; ++j) lo[j] = sigm_f(lo[j]);
                        st_f8(p, lo);
                    } else { *(f32x4*)((float*)(ws + WS_IW) + (size_t)r * 4) = (f32x4){lo[0], lo[1], lo[2], lo[3]}; }
                }
            }
    }
};
typedef EpiInProjT<0> EpiInProj;
struct ColOrder {
    int nM, nN, cnt, rank, pn;
    __device__ void init(int M, int N, int G, int c) { nM = M / 256; nN = N / 256; pn = c % nN; rank = c / nN; cnt = G / nN + ((pn < G % nN) ? 1 : 0); }
    __device__ bool next(int i, pg8::Unit& u) const { const int pm = rank + i * cnt; if (pm >= nM) return false; u.pm = pm; u.pn = pn; return true; }
    __device__ __forceinline__ void a_ready(const pg8::Unit&) const {}
    __device__ __forceinline__ void done(const pg8::Unit&) const {}
};
struct EpiNull {
    static constexpr bool PERM = true, AFTER_DRAIN = false;
    unsigned char* ws;
    DI void operator()(const pg8::f32x4 (&acc)[2][2][4][2], const pg8::Unit& u, int wr, int wc, int fr, int fq) const {
        float s = 0.f;
#pragma unroll
        for (int ai = 0; ai < 2; ++ai)
#pragma unroll
            for (int bj = 0; bj < 2; ++bj)
#pragma unroll
                for (int m = 0; m < 4; ++m)
#pragma unroll
                    for (int n = 0; n < 2; ++n) s += acc[ai][bj][m][n][0] + acc[ai][bj][m][n][1] + acc[ai][bj][m][n][2] + acc[ai][bj][m][n][3];
        if (s == 1.2345e33f) *(float*)(ws + WS_CTL + 2048) = s;
    }
};
struct EpiUp1 {
    static constexpr bool PERM = true, AFTER_DRAIN = false;
    unsigned char* ws;
    DI void operator()(const pg8::f32x4 (&acc)[2][2][4][2], const pg8::Unit& u, int wr, int wc, int fr, int fq) const {
#pragma unroll
        for (int ai = 0; ai < 2; ++ai)
#pragma unroll
            for (int m = 0; m < 4; ++m) {
                const int r = u.pm * 256 + ai * 128 + wr * 64 + m * 16 + fr;
#pragma unroll
                for (int bj = 0; bj < 2; ++bj) {
                    const int c0 = u.pn * 256 + bj * 128 + wc * 32 + 8 * fq;
                    const u32x4 gw = *(const u32x4*)((const bf16*)(ws + WS_MG) + (size_t)r * 2048 + c0);
                    const f32x4 a0 = acc[ai][bj][m][0], a1 = acc[ai][bj][m][1];
                    u32x4 w; w.x = pk2(a0[0] * bflo(gw.x), a0[1] * bfhi(gw.x)); w.y = pk2(a0[2] * bflo(gw.y), a0[3] * bfhi(gw.y));
                    w.z = pk2(a1[0] * bflo(gw.z), a1[1] * bfhi(gw.z)); w.w = pk2(a1[2] * bflo(gw.w), a1[3] * bfhi(gw.w));
                    *(u32x4*)((bf16*)(ws + WS_T1) + (size_t)r * 1024 + c0) = w;
                }
            }
    }
};
struct EpiUp2 {
    static constexpr bool PERM = true, AFTER_DRAIN = false;
    unsigned char* ws;
    DI void operator()(const pg8::f32x4 (&acc)[2][2][4][2], const pg8::Unit& u, int wr, int wc, int fr, int fq) const {
#pragma unroll
        for (int ai = 0; ai < 2; ++ai)
#pragma unroll
            for (int m = 0; m < 4; ++m) {
                const int r = u.pm * 256 + ai * 128 + wr * 64 + m * 16 + fr;
#pragma unroll
                for (int bj = 0; bj < 2; ++bj) {
                    const int c0 = u.pn * 256 + bj * 128 + wc * 32 + 8 * fq;
                    const u32x4 gw = *(const u32x4*)((const bf16*)(ws + WS_MG) + (size_t)r * 2048 + 1024 + c0);
                    const u32x4 tw = *(const u32x4*)((const bf16*)(ws + WS_T1) + (size_t)r * 1024 + c0);
                    const f32x4 t0 = {bflo(tw.x), bfhi(tw.x), bflo(tw.y), bfhi(tw.y)}, t1 = {bflo(tw.z), bfhi(tw.z), bflo(tw.w), bfhi(tw.w)};
                    const f32x4 a0 = acc[ai][bj][m][0], a1 = acc[ai][bj][m][1];
                    u32x4 w;
                    w.x = pk2(t0[0] + a0[0] * bflo(gw.x), t0[1] + a0[1] * bfhi(gw.x)); w.y = pk2(t0[2] + a0[2] * bflo(gw.y), t0[3] + a0[3] * bfhi(gw.y));
                    w.z = pk2(t1[0] + a1[0] * bflo(gw.z), t1[1] + a1[1] * bfhi(gw.z)); w.w = pk2(t1[2] + a1[2] * bflo(gw.w), t1[3] + a1[3] * bfhi(gw.w));
                    *(u32x4*)((bf16*)(ws + WS_M1) + (size_t)r * 1024 + c0) = w;
                }
            }
    }
};
struct EpiOut {
    static constexpr bool PERM = true, AFTER_DRAIN = false;
    unsigned char* ws; float* out; const float* xp; const float* xs;
    DI void operator()(const pg8::f32x4 (&acc)[2][2][4][2], const pg8::Unit& u, int wr, int wc, int fr, int fq) const {
        const bool samp = u.pm >= 64;
#pragma unroll
        for (int ai = 0; ai < 2; ++ai)
#pragma unroll
            for (int m = 0; m < 4; ++m) {
                const int r = u.pm * 256 + ai * 128 + wr * 64 + m * 16 + fr;
                const int mrow = samp ? 4 + ((r - MP) >> 2) : (r >> 12);
                const float* xr = samp ? xs + (size_t)(r - MP) * 1024 : xp + (size_t)r * 1024;
                float* orow = samp ? out + O_YS + (size_t)(r - MP) * 1024 : out + O_YP + (size_t)r * 1024;
                const float* gr = (const float*)(ws + WS_MOD) + (size_t)mrow * 3072 + 2048;
#pragma unroll
                for (int bj = 0; bj < 2; ++bj) {
                    const int c0 = u.pn * 256 + bj * 128 + wc * 32 + 8 * fq;
#pragma unroll
                    for (int n = 0; n < 2; ++n) {
                        const f32x4 x4 = *(const f32x4*)(xr + c0 + 4 * n), g4 = *(const f32x4*)(gr + c0 + 4 * n);
                        *(f32x4*)(orow + c0 + 4 * n) = x4 + g4 * acc[ai][bj][m][n];
                    }
                }
            }
    }
};

DI int win_row(int col) {
    int hs, d;
    if (col < 1280) { hs = col >> 6; d = col & 63; }
    else if (col < 1304) { hs = 85; d = col - 1280; }
    else if (col < 2904) { const int c = col - 1304; hs = 20 + (c >> 6); d = c & 63; }
    else if (col < 2908) { hs = 85; d = 24 + (col - 2904); }
    else { const int c = col - 2908; hs = 45 + (c >> 6); d = c & 63; }
    return 256 * (hs >> 2) + 128 * (d >> 5) + 32 * (hs & 3) + (d & 31);
}
template <bool WINMAP> DI void p0_transpose_item(const float* W, int K, int N, bf16* WT, LAS float* scr, int item, int lane) {
    const int nblk = (N + 31) / 32, kb = item / nblk, nb = item % nblk, k0 = 64 * kb, n0 = 32 * nb;
    const bool nok = n0 + (lane & 31) < N;
    float tv[32];
#pragma unroll
    for (int i = 0; i < 32; ++i) { const int kk = 2 * i + (lane >> 5); tv[i] = nok ? W[(size_t)(k0 + kk) * N + n0 + (lane & 31)] : 0.f; }
#pragma unroll
    for (int i = 0; i < 32; ++i) { const int kk = 2 * i + (lane >> 5); scr[kk * 33 + (lane & 31)] = tv[i]; }
    LDS_WAIT();
    const int c = lane & 7;
#pragma unroll
    for (int j = 0; j < 4; ++j) { const int n = (lane >> 3) + 8 * j; const LAS float* s = scr + (8 * c) * 33 + n;
        u32x4 o; o.x = pk2(s[0 * 33], s[1 * 33]); o.y = pk2(s[2 * 33], s[3 * 33]); o.z = pk2(s[4 * 33], s[5 * 33]); o.w = pk2(s[6 * 33], s[7 * 33]);
        if (n0 + n < N) { const int row = WINMAP ? win_row(n0 + n) : (n0 + n); *(u32x4*)(WT + (size_t)row * K + k0 + 8 * c) = o; } }
    LDS_WAIT();
}
DI void p0_mod(Frame& F) {
    LAS float* wl = (LAS float*)F.lds;
    float* mod = WSP(float, WS_MOD);
    for (int cg = blockIdx.x; cg < 256; cg += F.G) {
        __syncthreads();
        for (int k = F.tid; k < 1024; k += NWAVES * 64) {
            const f32x4* src = (const f32x4*)(F.wada + (size_t)k * 3072 + cg * 12);
            LAS f32x4* dst = (LAS f32x4*)(wl + k * 12);
            dst[0] = src[0]; dst[1] = src[1]; dst[2] = src[2];
        }
        __syncthreads();
        float cv[16], cn[16];
        { const float* cr = F.wave < 4 ? F.cp + (size_t)F.wave * 1024 : F.cs + (size_t)(F.wave - 4) * 1024;
#pragma unroll
          for (int i = 0; i < 16; ++i) cn[i] = cr[F.lane + 64 * i]; }
        for (int r = F.wave; r < 132; r += NWAVES) {
#pragma unroll
            for (int i = 0; i < 16; ++i) cv[i] = cn[i];
            { const int rn = r + NWAVES < 132 ? r + NWAVES : r; const float* cr = rn < 4 ? F.cp + (size_t)rn * 1024 : F.cs + (size_t)(rn - 4) * 1024;
#pragma unroll
              for (int i = 0; i < 16; ++i) cn[i] = cr[F.lane + 64 * i]; }
            float a[12];
#pragma unroll
            for (int j = 0; j < 12; ++j) a[j] = 0.f;
#pragma unroll
            for (int i = 0; i < 16; ++i) {
                const int k = F.lane + 64 * i; const float s = silu_f(cv[i]);
                const LAS f32x4* wp = (const LAS f32x4*)(wl + k * 12);
                const f32x4 w0 = wp[0], w1 = wp[1], w2 = wp[2];
                a[0] += s * w0[0]; a[1] += s * w0[1]; a[2] += s * w0[2]; a[3] += s * w0[3];
                a[4] += s * w1[0]; a[5] += s * w1[1]; a[6] += s * w1[2]; a[7] += s * w1[3];
                a[8] += s * w2[0]; a[9] += s * w2[1]; a[10] += s * w2[2]; a[11] += s * w2[3];
                if ((i & 3) == 3) __builtin_amdgcn_sched_barrier(0);
            }
            float v = 0.f;
#pragma unroll
            for (int j = 0; j < 12; ++j) { const float sj = wave_sum(a[j]); v = (F.lane == j) ? sj : v; }
            if (F.lane < 12) mod[(size_t)r * 3072 + cg * 12 + F.lane] = v + F.bada[cg * 12 + F.lane];
        }
    }
    __syncthreads();
}
__device__ const double ROPE_INV[32] = {
    1.0, 0.7498942093324559, 0.5623413251903491, 0.4216965034285822, 0.31622776601683794, 0.23713737056616552, 0.1778279410038923, 0.1333521432163324,
    0.1, 0.07498942093324559, 0.05623413251903491, 0.04216965034285822, 0.03162277660168379, 0.023713737056616554, 0.01778279410038923, 0.01333521432163324,
    0.01, 0.007498942093324559, 0.005623413251903491, 0.004216965034285822, 0.0031622776601683794, 0.0023713737056616554, 0.0017782794100389228, 0.001333521432163324,
    0.001, 0.0007498942093324559, 0.0005623413251903491, 0.0004216965034285822, 0.00031622776601683794, 0.00023713737056616554, 0.00017782794100389227, 0.0001333521432163324};
DI void p0_rope_item(Frame& F, int item) {
    const int pos = 2 * item + (F.lane >> 5), d = F.lane & 31;
    if (pos >= 4100) return;
    const double ang = (double)pos * ROPE_INV[d];
    const double kq = __builtin_rint(ang * 0.6366197723675814);
    double r = __builtin_fma(-kq, 1.5707963267948966, ang); r = __builtin_fma(-kq, 6.123233995736766e-17, r);
    const int q = (int)kq & 3;
    const double r2 = r * r;
    const double sn = r * (1.0 + r2 * (-1.0 / 6 + r2 * (1.0 / 120 + r2 * (-1.0 / 5040 + r2 * (1.0 / 362880 + r2 * (-1.0 / 39916800 + r2 * (1.0 / 6227020800.0)))))));
    const double cs = 1.0 + r2 * (-0.5 + r2 * (1.0 / 24 + r2 * (-1.0 / 720 + r2 * (1.0 / 40320 + r2 * (-1.0 / 3628800 + r2 * (1.0 / 479001600.0 + r2 * (-1.0 / 87178291200.0)))))));
    const double c = (q == 0) ? cs : (q == 1) ? -sn : (q == 2) ? -cs : sn;
    const double s = (q == 0) ? sn : (q == 1) ? cs : (q == 2) ? -sn : -cs;
    WSP(float, WS_COS)[pos * 32 + d] = (float)c; WSP(float, WS_SIN)[pos * 32 + d] = (float)s;
}
DI void p0_cmp_small_item(Frame& F, int item) {
    if (item < 256) {
        const int slot = item >> 7, ch = (item >> 6) & 1, kc = item & 63, c = ch * 64 + F.lane; float a = 0.f;
#pragma unroll 8
        for (int i = 0; i < 32; ++i) { const int k = kc * 32 + i; a += F.pe[slot * 2048 + k] * F.w1[((size_t)slot * 2048 + k) * 128 + c]; }
        WSP(float, WS_BIASP)[(size_t)kc * 256 + slot * 128 + c] = a;
    } else {
        const int it = item - 256, slot = it >> 7, e = (it & 127) >> 1, ch = it & 1;
        const int c = ch * 64 + F.lane;
        WSP(bf16, WS_W2T)[((size_t)slot * 64 + e) * 128 + permk(c)] = (bf16)(pk2(F.w2[((size_t)slot * 128 + c) * 64 + e], 0.f) & 0xffffu);
    }
}
DI void cp_k16(const float* src, size_t rs, bf16* dst, int lane) {
    const int tk = lane >> 2, dc = (lane & 3) * 16;
    const f32x4* s = (const f32x4*)(src + (size_t)tk * rs + dc);
    const f32x4 a = s[0], b = s[1], c = s[2], d = s[3];
    u32x4 w0, w1; w0.x = pk2(a[0], a[1]); w0.y = pk2(a[2], a[3]); w0.z = pk2(b[0], b[1]); w0.w = pk2(b[2], b[3]);
    w1.x = pk2(c[0], c[1]); w1.y = pk2(c[2], c[3]); w1.z = pk2(d[0], d[1]); w1.w = pk2(d[2], d[3]);
    u32x4* o = (u32x4*)(dst + (size_t)tk * 64 + dc); o[0] = w0; o[1] = w1;
}
DI void cp_vt16(const float* src, size_t rs, bf16* dst, size_t pitch, int lane) {
#pragma unroll
    for (int h = 0; h < 2; ++h) {
        float v[8];
#pragma unroll
        for (int i = 0; i < 8; ++i) v[i] = src[(size_t)((i & 3) + 8 * (i >> 2) + 4 * h) * rs + lane];
        *(u32x4*)(dst + (size_t)lane * pitch + 8 * h) = pack8(v);
    }
}
DI void p0_gather_item(Frame& F, int item) {
    const int sb = item >> 7, tg = item & 127, tk0 = tg * 16, lane = F.lane;
    const int pg = F.ptab[sb * NPG + (tk0 >> 7)], j0 = tk0 & 127;
    const float* nsa = F.cnsa + ((size_t)pg * PAGE + j0) * 512;
    const float* dsa = F.cdsa + ((size_t)pg * PAGE + j0) * 256;
    const float* idx = F.cidx + ((size_t)pg * PAGE + j0) * 64;
#pragma unroll
    for (int g = 0; g < 2; ++g) {
        const size_t bg = (size_t)sb * 2 + g;
        cp_k16(nsa + (0 * 2 + g) * 64, 512, WSP(bf16, WS_SCMPK) + (bg * LS + tk0) * 64, lane);
        cp_k16(nsa + (1 * 2 + g) * 64, 512, WSP(bf16, WS_SCMPV) + (bg * LS + tk0) * 64, lane);
        cp_k16(nsa + (2 * 2 + g) * 64, 512, WSP(bf16, WS_SSLCK) + (bg * LS + tk0) * 64, lane);
        cp_vt16(nsa + (3 * 2 + g) * 64, 512, WSP(bf16, WS_SSLCVT) + bg * 64 * LS + tk0, LS, lane);
        cp_k16(dsa + (0 * 2 + g) * 64, 256, WSP(bf16, WS_SDSAK) + (bg * LS + tk0) * 64, lane);
        cp_vt16(dsa + (1 * 2 + g) * 64, 256, WSP(bf16, WS_SDSAVT) + bg * 64 * LS + tk0, LS, lane);
    }
    cp_k16(idx, 64, WSP(bf16, WS_SIDXK) + ((size_t)sb * LS + tk0) * 64, lane);
}
DI void p0_win_item(Frame& F, int item) {
    const int sb = item >> 5, w0 = (item & 31) * 16, lane = F.lane;
    const float* st = F.swin + ((size_t)sb * 512 + w0) * 256;
#pragma unroll
    for (int g = 0; g < 2; ++g) {
        const size_t bg = (size_t)sb * 2 + g;
        cp_k16(st + (0 * 2 + g) * 64, 256, WSP(bf16, WS_SWINK) + (bg * LSW + w0) * 64, lane);
        cp_vt16(st + (1 * 2 + g) * 64, 256, WSP(bf16, WS_SWINVT) + bg * 64 * LSW + w0, LSW, lane);
    }
}
DI void p0_zero_item(Frame& F, int item) {
    const int arr = item >> 8, bg = item & 255, lane = F.lane;
    bf16* p; int n;
    if (arr == 0) { p = WSP(bf16, WS_SSLCVT) + ((size_t)bg * 64 + lane) * LS + 2052; n = 60; }
    else if (arr == 1) { p = WSP(bf16, WS_SDSAVT) + ((size_t)bg * 64 + lane) * LS + 2052; n = 60; }
    else { p = WSP(bf16, WS_SWINVT) + ((size_t)bg * 64 + lane) * LSW + 516; n = 60; }
    unsigned long long* q = (unsigned long long*)p;
    for (int i = 0; i < n / 4; ++i) q[i] = 0ull;
}
DI void p0_prologue(Frame& F, int um) {
    if (um & 1) p0_mod(F);
    LAS float* scr = (LAS float*)(F.lds + F.wave * 16384);
    const int gw = blockIdx.x * NWAVES + F.wave, NGW = F.G * NWAVES;
    constexpr int I_WIN = 16 * 171, I_UP = 8 * 32, I_OUT = 16 * 32, I_W1 = 32 * 4;
    constexpr int T0 = I_WIN, T1 = T0 + I_UP, T2 = T1 + I_UP, T3 = T2 + I_OUT, T4 = T3 + 2 * I_W1, T5 = T4 + 2050, T6 = T5 + 512, T7 = T6 + 768, T8 = T7 + SBATCH * 32, T9 = T8 + SBATCH * 128;
#ifdef ORACLE
    constexpr int TEND = T9;
#else
    constexpr int TEND = T7;
#endif
    if (um & 2) for (int it = gw; it < TEND; it += NGW) {
        if (it < T0) p0_transpose_item<true>(F.win, 1024, 5468, WSP(bf16, WS_WINT), scr, it, F.lane);
        else if (it < T1) p0_transpose_item<false>(F.wupn, 512, 1024, WSP(bf16, WS_WUPN), scr, it - T0, F.lane);
        else if (it < T2) p0_transpose_item<false>(F.wupd, 512, 1024, WSP(bf16, WS_WUPD), scr, it - T1, F.lane);
        else if (it < T3) p0_transpose_item<false>(F.wout, 1024, 1024, WSP(bf16, WS_WOUT), scr, it - T2, F.lane);
        else if (it < T4) { const int q = it - T3, slot = q / I_W1; p0_transpose_item<false>(F.w1 + (size_t)slot * 2048 * 128, 2048, 128, WSP(bf16, WS_W1T) + (size_t)slot * 128 * 2048, scr, q % I_W1, F.lane); }
        else if (it < T5) p0_rope_item(F, it - T4);
        else if (it < T6) p0_cmp_small_item(F, it - T5);
        else if (it < T7) p0_zero_item(F, it - T6);
#ifdef ORACLE
        else if (it < T8) p0_win_item(F, it - T7);
        else p0_gather_item(F, it - T8);
#endif
    }
    constexpr int ROW4 = 508 * 64;
    const f32x4* src = (const f32x4*)F.swin; f32x4* dst = (f32x4*)(F.out + O_WINS);
    if (um & 4) for (int it = blockIdx.x; it < 2 * SBATCH; it += F.G) {
        const int sb = it >> 1, h0 = (it & 1) * (ROW4 / 2);
        const f32x4* sp = src + (size_t)sb * 512 * 64 + 4 * 64 + h0; f32x4* dp = dst + (size_t)sb * 512 * 64 + h0;
        for (int i = F.tid; i < ROW4 / 2; i += 512 * 8) {
            f32x4 v[8];
#pragma unroll
            for (int j = 0; j < 8; ++j) { const int k = i + j * 512; v[j] = k < ROW4 / 2 ? __builtin_nontemporal_load(sp + k) : (f32x4){0.f, 0.f, 0.f, 0.f}; }
#pragma unroll
            for (int j = 0; j < 8; ++j) { const int k = i + j * 512; if (k < ROW4 / 2) __builtin_nontemporal_store(v[j], dp + k); }
        }
    }
}
DI void p1_adaln(Frame& F) {
    const int gw = blockIdx.x * NWAVES + F.wave, NGW = F.G * NWAVES;
    if (blockIdx.x == 0 && F.tid < 256) { float a = 0.f; for (int j = 0; j < 64; ++j) a += WSP(float, WS_BIASP)[j * 256 + F.tid]; WSP(float, WS_BIAS1)[F.tid] = a; }
    const float* mod = WSP(float, WS_MOD);
    f32x4 nx[4];
    { const int r = gw < MR ? gw : MR - 1; const f32x4* x4 = (const f32x4*)(r < MP ? F.xp + (size_t)r * 1024 : F.xs + (size_t)(r - MP) * 1024) + F.lane;
#pragma unroll
      for (int j = 0; j < 4; ++j) nx[j] = x4[64 * j]; }
    for (int r = gw; r < MR; r += NGW) {
        const int mrow = r < MP ? (r >> 12) : 4 + ((r - MP) >> 2);
        f32x4 v[4]; float s = 0.f;
#pragma unroll
        for (int j = 0; j < 4; ++j) { v[j] = nx[j]; s += (v[j][0] * v[j][0] + v[j][1] * v[j][1]) + (v[j][2] * v[j][2] + v[j][3] * v[j][3]); }
        { const int rn = r + NGW < MR ? r + NGW : r; const f32x4* x4 = (const f32x4*)(rn < MP ? F.xp + (size_t)rn * 1024 : F.xs + (size_t)(rn - MP) * 1024) + F.lane;
#pragma unroll
          for (int j = 0; j < 4; ++j) nx[j] = x4[64 * j]; }
        const float rstd = 1.f / sqrtf(wave_sum(s) * (1.f / 1024.f) + 1e-6f);
        const f32x4* g4 = (const f32x4*)F.normg + F.lane;
        const f32x4* sh4 = (const f32x4*)(mod + (size_t)mrow * 3072) + F.lane;
        const f32x4* sc4 = (const f32x4*)(mod + (size_t)mrow * 3072 + 1024) + F.lane;
        unsigned long long* o8 = (unsigned long long*)(WSP(bf16, WS_H) + (size_t)r * 1024) + F.lane;
#pragma unroll
        for (int j = 0; j < 4; ++j) {
            const f32x4 y = v[j] * rstd * g4[64 * j]; const f32x4 h = y * (1.f + sc4[64 * j]) + sh4[64 * j];
            o8[64 * j] = (unsigned long long)pk2(h[0], h[1]) | ((unsigned long long)pk2(h[2], h[3]) << 32);
        }
    }
}
DI void p8_final(Frame& F) {
    const int gw = blockIdx.x * NWAVES + F.wave, NGW = F.G * NWAVES;
    f32x4 nx[4];
    { const int r = gw < MR ? gw : MR - 1; const f32x4* y4 = (const f32x4*)(r < MP ? F.out + O_YP + (size_t)r * 1024 : F.out + O_YS + (size_t)(r - MP) * 1024) + F.lane;
#pragma unroll
      for (int j = 0; j < 4; ++j) nx[j] = y4[64 * j]; }
    for (int r = gw; r < MR; r += NGW) {
        float* yr = r < MP ? F.out + O_YP + (size_t)r * 1024 : F.out + O_YS + (size_t)(r - MP) * 1024;
        f32x4* y4 = (f32x4*)yr + F.lane;
        f32x4 v[4]; float s = 0.f;
#pragma unroll
        for (int j = 0; j < 4; ++j) { v[j] = nx[j]; s += (v[j][0] * v[j][0] + v[j][1] * v[j][1]) + (v[j][2] * v[j][2] + v[j][3] * v[j][3]); }
        { const int rn = r + NGW < MR ? r + NGW : r; const f32x4* n4 = (const f32x4*)(rn < MP ? F.out + O_YP + (size_t)rn * 1024 : F.out + O_YS + (size_t)(rn - MP) * 1024) + F.lane;
#pragma unroll
          for (int j = 0; j < 4; ++j) nx[j] = n4[64 * j]; }
        const float rstd = 1.f / sqrtf(wave_sum(s) * (1.f / 1024.f) + 1e-6f);
        const f32x4* g4 = (const f32x4*)F.fing + F.lane;
#pragma unroll
        for (int j = 0; j < 4; ++j) y4[64 * j] = v[j] * rstd * g4[64 * j];
    }
}

constexpr int TP = 144;
constexpr int TILE_B = 64 * TP;
struct LdsT {
    static constexpr bool HOIST = true;
    const LAS unsigned char* p;
    DI bf16x8 frag(int mt, int s) const { return *(const LAS bf16x8*)(p + mt * 32 * TP + s * 32); }
};
struct GlbT {
    static constexpr bool HOIST = false;
    const bf16* base; unsigned off; unsigned pitch;
    DI bf16x8 frag(int mt, int s) const { return *(const bf16x8*)(base + (size_t)(off + (unsigned)mt * 32u * pitch + (unsigned)s * 16u)); }
};
template <class KT> DI void qk_tile(f32x16& s0, f32x16& s1, const KT& kt, const bf16x8 (&q)[4]) {
    f32x16 z;
#pragma unroll
    for (int i = 0; i < 16; ++i) z[i] = 0.f;
    s0 = z; s1 = z;
#pragma unroll
    for (int s = 0; s < 4; ++s) { s0 = MFMA32(kt.frag(0, s), q[s], s0); s1 = MFMA32(kt.frag(1, s), q[s], s1); }
}
DI bf16x8 cvt8(f32x4 a, f32x4 b) { u32x4 w; w.x = pk2(a[0], a[1]); w.y = pk2(a[2], a[3]); w.z = pk2(b[0], b[1]); w.w = pk2(b[2], b[3]); return __builtin_bit_cast(bf16x8, w); }
DI bf16x8 pack_p(const f32x16& x, int h) {
    u32x4 w; w.x = pk2(x[8 * h], x[8 * h + 1]); w.y = pk2(x[8 * h + 2], x[8 * h + 3]); w.z = pk2(x[8 * h + 4], x[8 * h + 5]); w.w = pk2(x[8 * h + 6], x[8 * h + 7]);
    return __builtin_bit_cast(bf16x8, w);
}
template <class VT> DI void pv_tile(f32x16& o0, f32x16& o1, const f32x16& p0, const f32x16& p1, const VT& vt) {
    const bf16x8 b0 = pack_p(p0, 0), b1 = pack_p(p0, 1), b2 = pack_p(p1, 0), b3 = pack_p(p1, 1);
    o0 = MFMA32(vt.frag(0, 0), b0, o0); o1 = MFMA32(vt.frag(1, 0), b0, o1);
    o0 = MFMA32(vt.frag(0, 1), b1, o0); o1 = MFMA32(vt.frag(1, 1), b1, o1);
    o0 = MFMA32(vt.frag(0, 2), b2, o0); o1 = MFMA32(vt.frag(1, 2), b2, o1);
    o0 = MFMA32(vt.frag(0, 3), b3, o0); o1 = MFMA32(vt.frag(1, 3), b3, o1);
}
struct Soft { float m, l; bool seen; f32x16 o0, o1, negm; };
DI void soft_init(Soft& S) {
    S.m = 0.f; S.l = 0.f; S.seen = false;
#pragma unroll
    for (int i = 0; i < 16; ++i) { S.o0[i] = 0.f; S.o1[i] = 0.f; S.negm[i] = 0.f; }
}
template <class KT> DI void qk_tile_c(f32x16& s0, f32x16& s1, const KT& kt, const bf16x8 (&q)[4], const f32x16& c) {
    if constexpr (KT::HOIST) {
        bf16x8 f[8];
#pragma unroll
        for (int s = 0; s < 4; ++s) { f[2 * s] = kt.frag(0, s); f[2 * s + 1] = kt.frag(1, s); }
        __builtin_amdgcn_sched_barrier(0);
        s0 = MFMA32(f[0], q[0], c); s1 = MFMA32(f[1], q[0], c);
#pragma unroll
        for (int s = 1; s < 4; ++s) { s0 = MFMA32(f[2 * s], q[s], s0); s1 = MFMA32(f[2 * s + 1], q[s], s1); }
    } else {
        s0 = MFMA32(kt.frag(0, 0), q[0], c); s1 = MFMA32(kt.frag(1, 0), q[0], c);
#pragma unroll
        for (int s = 1; s < 4; ++s) { s0 = MFMA32(kt.frag(0, s), q[s], s0); s1 = MFMA32(kt.frag(1, s), q[s], s1); }
    }
    asm volatile("s_nop 15\n\ts_nop 7" : "+v"(s0), "+v"(s1));
}
DI float max3f(float a, float b, float c) { float r; asm("v_max3_f32 %0, %1, %2, %3" : "=v"(r) : "v"(a), "v"(b), "v"(c)); return r; }
template <class VT> DI void soft_step(Soft& S, f32x16& s0, f32x16& s1, const VT& vt) {
    bf16x8 vf[8];
    if constexpr (VT::HOIST) {
#pragma unroll
        for (int s = 0; s < 4; ++s) { vf[2 * s] = vt.frag(0, s); vf[2 * s + 1] = vt.frag(1, s); }
        __builtin_amdgcn_sched_barrier(0);
    }
    float mx = max3f(s0[0], s1[0], s0[1]), my = max3f(s1[1], s0[2], s1[2]);
#pragma unroll
    for (int r = 3; r < 15; r += 2) { mx = max3f(mx, s0[r], s1[r]); my = max3f(my, s0[r + 1], s1[r + 1]); }
    mx = max3f(mx, s0[15], s1[15]); mx = max3f(mx, my, mx);
    mx = max3f(mx, half_other(mx), mx);
    const bool fin = mx > NEGINF;
    const bool need = (mx > 8.f) | (fin & !S.seen);
    if (__any(need)) {
        const float dl = need ? mx : 0.f;
        const float al = S.seen ? __builtin_amdgcn_exp2f(-dl) : 0.f;
        S.m += dl; S.l *= need ? al : 1.f;
        const float am = need ? al : 1.f;
#pragma unroll
        for (int r = 0; r < 16; ++r) { s0[r] -= dl; s1[r] -= dl; S.o0[r] *= am; S.o1[r] *= am; S.negm[r] = -S.m; }
    }
    S.seen = S.seen | fin;
    float ps = 0.f;
#pragma unroll
    for (int r = 0; r < 16; ++r) { s0[r] = __builtin_amdgcn_exp2f(s0[r]); s1[r] = __builtin_amdgcn_exp2f(s1[r]); ps += s0[r] + s1[r]; }
    S.l += ps;
    const bf16x8 b0 = pack_p(s0, 0), b1 = pack_p(s0, 1), b2 = pack_p(s1, 0), b3 = pack_p(s1, 1);
    if constexpr (!VT::HOIST) {
#pragma unroll
        for (int s = 0; s < 4; ++s) { vf[2 * s] = vt.frag(0, s); vf[2 * s + 1] = vt.frag(1, s); }
    }
    S.o0 = MFMA32(vf[0], b0, S.o0); S.o1 = MFMA32(vf[1], b0, S.o1);
    S.o0 = MFMA32(vf[2], b1, S.o0); S.o1 = MFMA32(vf[3], b1, S.o1);
    S.o0 = MFMA32(vf[4], b2, S.o0); S.o1 = MFMA32(vf[5], b2, S.o1);
    S.o0 = MFMA32(vf[6], b3, S.o0); S.o1 = MFMA32(vf[7], b3, S.o1);
}
DI float as_f(int x) { return __int_as_float(x); }
DI float mask_sel(float s, int mm) { return __int_as_float((__float_as_int(s) & mm) | ((int)0xff800000 & ~mm)); }
DI u32x4 tile_ld(const bf16* g, size_t pitch, int tid) { return *(const u32x4*)(g + (size_t)(tid >> 3) * pitch + (tid & 7) * 8); }
DI void tile_st(LAS unsigned char* buf, u32x4 v, int tid) { *(LAS u32x4*)(buf + (tid >> 3) * TP + (tid & 7) * 16) = v; }

constexpr int CP = 272;
DI void compress_unit(Frame& F, int u) {
    const int tid = F.tid, lane = F.lane, w = F.wave, l31 = lane & 31, hi = lane >> 5;
    const int slot = u / 136, rem = u % 136;
    const bf16* data; bf16 *ock, *ocvt; int n0, ncmp, cpitch;
    if (rem < 8) { const int bg = rem; data = WSP(bf16, (slot ? WS_PCMPV : WS_PCMPK)) + (size_t)bg * SEQ * 64; n0 = 32 * w; ncmp = 255; cpitch = 256;
        ock = WSP(bf16, WS_PCK) + (size_t)bg * 256 * 64; ocvt = WSP(bf16, WS_PCVT) + (size_t)bg * 64 * 256; }
    else { const int bg = 2 * (rem - 8) + (w >> 2); data = WSP(bf16, (slot ? WS_SCMPV : WS_SCMPK)) + (size_t)bg * LS * 64; n0 = 32 * (w & 3); ncmp = 127; cpitch = 128;
        ock = WSP(bf16, WS_SCK) + (size_t)bg * 128 * 64; ocvt = WSP(bf16, WS_SCVT) + (size_t)bg * 64 * 128; }
    const int n = n0 + l31, nc = n < ncmp ? n : ncmp - 1;
    const bf16* drow = data + (size_t)nc * 1024 + 8 * hi;
    const bool paged = rem >= 8;
    const float *prA = nullptr, *prB = nullptr; int jsplit = 64;
    if (paged) { const int bg = 2 * (rem - 8) + (w >> 2), sb = bg >> 1, g = bg & 1, t0 = 16 * nc;
        const int pgA = F.ptab[sb * NPG + (t0 >> 7)], pgB = F.ptab[sb * NPG + ((t0 + 31) >> 7)];
        jsplit = 128 - (t0 & 127);
        prA = F.cnsa + ((size_t)pgA * PAGE + (t0 & 127)) * 512 + (slot * 2 + g) * 64 + 8 * hi;
        prB = F.cnsa + ((size_t)pgB * PAGE) * 512 + (slot * 2 + g) * 64 + 8 * hi - (size_t)jsplit * 512;
    }
    const bf16* w1t = WSP(bf16, WS_W1T) + (size_t)slot * 128 * 2048;
    f32x16 acc[4];
#pragma unroll
    for (int c = 0; c < 4; ++c)
#pragma unroll
        for (int i = 0; i < 16; ++i) acc[c][i] = 0.f;
    const bf16* wsrc = w1t + (size_t)(tid >> 2) * 2048 + ((tid & 3) >> 1) * 1024 + (tid & 1) * 32;
    LAS unsigned char* wdst = F.lds + (tid >> 2) * CP + (tid & 3) * 64;
    u32x4 st[4];
#pragma unroll
    for (int i = 0; i < 4; ++i) st[i] = ((const u32x4*)wsrc)[i];
#pragma unroll
    for (int i = 0; i < 4; ++i) ((LAS u32x4*)wdst)[i] = st[i];
    LDS_BARRIER();
    f32x4 raw[16];
#define CMP_ISSUE(kc_) do { if (!paged) { _Pragma("unroll") for (int s_ = 0; s_ < 8; ++s_) raw[2 * s_] = __builtin_bit_cast(f32x4, *(const bf16x8*)(drow + ((kc_) + 16 * (s_ >> 2)) * 64 + (s_ & 3) * 16)); } \
        else { _Pragma("unroll") for (int s_ = 0; s_ < 8; ++s_) { const int j_ = (kc_) + 16 * (s_ >> 2); const f32x4* q_ = (const f32x4*)((j_ < jsplit ? prA : prB) + (size_t)j_ * 512 + 16 * (s_ & 3)); raw[2 * s_] = q_[0]; raw[2 * s_ + 1] = q_[1]; } } } while (0)
    CMP_ISSUE(0);
    for (int kc = 0; kc < 16; ++kc) {
        const LAS unsigned char* buf = F.lds + (kc & 1) * (128 * CP);
        if (kc + 1 < 16) {
#pragma unroll
            for (int i = 0; i < 4; ++i) st[i] = ((const u32x4*)(wsrc + (kc + 1) * 64))[i];
        }
        bf16x8 bq[8];
        if (!paged) {
#pragma unroll
            for (int s = 0; s < 8; ++s) bq[s] = __builtin_bit_cast(bf16x8, raw[2 * s]);
        } else {
#pragma unroll
            for (int s = 0; s < 8; ++s) bq[s] = cvt8(raw[2 * s], raw[2 * s + 1]);
        }
        if (kc + 1 < 16) CMP_ISSUE(kc + 1);
#pragma unroll
        for (int s = 0; s < 8; ++s)
#pragma unroll
            for (int c = 0; c < 4; ++c) acc[c] = MFMA32(*(const LAS bf16x8*)(buf + (32 * c + l31) * CP + s * 32 + hi * 16), bq[s], acc[c]);
        if (kc + 1 < 16) {
            LAS unsigned char* nb = wdst + ((kc + 1) & 1) * (128 * CP);
#pragma unroll
            for (int i = 0; i < 4; ++i) ((LAS u32x4*)nb)[i] = st[i];
        }
        LDS_BARRIER();
    }
#undef CMP_ISSUE
    const float* b1 = WSP(float, WS_BIAS1) + slot * 128;
#pragma unroll
    for (int c = 0; c < 4; ++c)
#pragma unroll
        for (int q = 0; q < 4; ++q) { const f32x4 bv = *(const f32x4*)(b1 + 32 * c + 8 * q + 4 * hi);
#pragma unroll
            for (int j = 0; j < 4; ++j) acc[c][4 * q + j] = silu_f(acc[c][4 * q + j] + bv[j]); }
    const bf16* w2t = WSP(bf16, WS_W2T) + (size_t)slot * 64 * 128 + (size_t)l31 * 128 + 8 * hi;
    f32x16 o0, o1;
#pragma unroll
    for (int i = 0; i < 16; ++i) { o0[i] = 0.f; o1[i] = 0.f; }
#pragma unroll
    for (int c = 0; c < 4; ++c)
#pragma unroll
        for (int h = 0; h < 2; ++h) { const bf16x8 hb = pack_p(acc[c], h); const int s2 = 2 * c + h;
            o0 = MFMA32(*(const bf16x8*)(w2t + s2 * 16), hb, o0); o1 = MFMA32(*(const bf16x8*)(w2t + 32 * 128 + s2 * 16), hb, o1); }
    const bool ok = n < ncmp;
    if (slot == 0) {
#pragma unroll
        for (int e = 0; e < 2; ++e)
#pragma unroll
            for (int q = 0; q < 4; ++q) { const f32x16& o = e ? o1 : o0; u32x2 wv;
                wv.x = ok ? pk2(o[4 * q], o[4 * q + 1]) : 0u; wv.y = ok ? pk2(o[4 * q + 2], o[4 * q + 3]) : 0u;
                *(u32x2*)(ock + (size_t)n * 64 + 32 * e + 8 * q + 4 * hi) = wv; }
    } else {
        const int pn = permk(n);
#pragma unroll
        for (int e = 0; e < 2; ++e)
#pragma unroll
            for (int r = 0; r < 16; ++r) { const f32x16& o = e ? o1 : o0; ocvt[(size_t)(32 * e + crow(r, hi)) * cpitch + pn] = ok ? (bf16)(pk2(o[r], 0.f) & 0xffffu) : (bf16)0; }
    }
}

template <int NR, int ABL> DI void idx_select(const LAS int* scw, int n, int lane, unsigned long long* out) {
    int k[NR];
    int kmin = 0x7fffffff, kmax = (int)0x80000000;
#pragma unroll
    for (int i = 0; i < NR; ++i) { const bool v = 64 * i + lane < n; const int x = v ? scw[64 * i + lane] : (int)0x80000000; k[i] = x; kmin = v ? (x < kmin ? x : kmin) : kmin; kmax = x > kmax ? x : kmax; }
    int thr = (int)0x80000000, cut = -1;
    if (n > 256 && !(ABL & 1)) {
        kmin = wave_min_i(kmin); kmax = wave_max_i(kmax);
        int lo = kmin - 1, hiv = kmax;
        bool found = false;
        if (hiv > 0x04000000) {
            const int kp = hiv - 0x03800000;
            int c = 0, cl = 0;
#pragma unroll
            for (int i0 = 0; i0 < NR; i0 += 8) {
                unsigned long long bm[4];
#pragma unroll
                for (int j = 0; j < 4; ++j) bm[j] = __ballot(k[i0 + j] > kp);
#pragma unroll
                for (int j = 4; j < 8; ++j) cl += (k[i0 + j] > kp) ? 1 : 0;
#pragma unroll
                for (int j = 0; j < 4; ++j) c += __popcll(bm[j]);
            }
            c += wave_sum_i(cl);
            if (c == 256) { thr = kp; found = true; } else if (c > 256) lo = kp; else hiv = kp;
        }
        while (!found && (unsigned)hiv - (unsigned)lo > 1u) {
            const int mid = (int)((unsigned)lo + (((unsigned)hiv - (unsigned)lo) >> 1));
            int c = 0, cl = 0;
#pragma unroll
            for (int i0 = 0; i0 < NR; i0 += 8) {
                unsigned long long bm[4];
#pragma unroll
                for (int j = 0; j < 4; ++j) bm[j] = __ballot(k[i0 + j] > mid);
#pragma unroll
                for (int j = 4; j < 8; ++j) cl += (k[i0 + j] > mid) ? 1 : 0;
#pragma unroll
                for (int j = 0; j < 4; ++j) c += __popcll(bm[j]);
            }
            c += wave_sum_i(cl);
            if (c == 256) { thr = mid; found = true; break; }
            if (c > 256) lo = mid; else hiv = mid;
        }
        if (!found) {
            thr = hiv; int cgt = 0;
#pragma unroll
            for (int i = 0; i < NR; ++i) cgt += __popcll(__ballot(k[i] > thr));
            const int need = 256 - cgt; int acc = 0; bool done = false;
#pragma unroll
            for (int i = 0; i < NR; ++i) {
                unsigned long long mk = __ballot(k[i] == thr); const int pc = __popcll(mk);
                if (!done && acc + pc >= need) { for (int q2 = 1; q2 < need - acc; ++q2) mk &= mk - 1; cut = 64 * i + (int)__builtin_ctzll(mk); done = true; }
                acc += pc;
            }
        }
    }
    unsigned long long myw = 0ull;
    if (ABL & 4) { myw = (unsigned long long)(k[0] + k[NR - 1] + kmin + kmax); } else
#pragma unroll
    for (int i = 0; i < NR; ++i) { const unsigned long long mk = __ballot((k[i] > thr) | ((k[i] == thr) & (64 * i + lane <= cut))); myw = (lane == i) ? mk : myw; }
    out[lane] = myw;
}
template <bool SAMPLE, int ABL> DI void idx1_unit(Frame& F, int u) {
    const int lane = F.lane, w = F.wave, l31 = lane & 31, hi = lane >> 5, tl = l31 >> 2, hl = l31 & 3;
    int row0, nkmax, ntok; const bf16* ik;
    if (!SAMPLE) { const int b = u & 3, tc = 511 - (u >> 2); row0 = b * SEQ + 8 * tc; nkmax = 8 * tc + 8; ntok = 8; ik = WSP(bf16, WS_PIDXK) + (size_t)b * SEQ * 64; }
    else { row0 = MP + 4 * u; nkmax = PASTL + 4; ntok = 4; ik = WSP(bf16, WS_SIDXK) + (size_t)u * LS * 64; }
    const int rowq = row0 + (SAMPLE ? (tl & 3) : tl);
    bf16x8 q[4];
#pragma unroll
    for (int s = 0; s < 4; ++s) q[s] = *(const bf16x8*)(WSP(bf16, WS_IQ) + (size_t)rowq * 256 + hl * 64 + 16 * s + 8 * hi);
    f32x4 wq[4];
#pragma unroll
    for (int qq = 0; qq < 4; ++qq) { const int tk = 2 * qq + hi; wq[qq] = *(const f32x4*)(WSP(float, WS_IW) + (size_t)(row0 + (SAMPLE ? (tk & 3) : tk)) * 4); }
    LAS int* sc = (LAS int*)F.lds;
    const int n32 = (nkmax + 31) >> 5;
    u32x4 rA[8], rB[8];
#define IDX_ISSUE(R, kt_) do { const int kk_ = (kt_) < n32 ? (kt_) : n32 - 1; \
        if (SAMPLE) { if (kk_ < 64) { const int pg = F.ptab[u * NPG + (kk_ >> 2)]; const float* fp = F.cidx + ((size_t)pg * PAGE + (kk_ & 3) * 32 + l31) * 64 + 8 * hi; \
              _Pragma("unroll") for (int s_ = 0; s_ < 4; ++s_) { R[2 * s_] = gload16(fp + 16 * s_); R[2 * s_ + 1] = gload16(fp + 16 * s_ + 4); } } \
            else { const bf16* kp = ik + (size_t)(32 * kk_ + l31) * 64 + 8 * hi; \
              _Pragma("unroll") for (int s_ = 0; s_ < 4; ++s_) { R[2 * s_] = gload16(kp + 16 * s_); R[2 * s_ + 1] = gload16(kp + 16 * s_); } } } \
        else { const bf16* kp = ik + (size_t)(32 * kk_ + l31) * 64 + 8 * hi; \
            _Pragma("unroll") for (int s_ = 0; s_ < 4; ++s_) R[2 * s_] = gload16(kp + 16 * s_); } } while (0)
#define IDX_WAIT(R) do { if (SAMPLE) asm volatile("s_waitcnt vmcnt(8)" : "+v"(R[0]), "+v"(R[1]), "+v"(R[2]), "+v"(R[3]), "+v"(R[4]), "+v"(R[5]), "+v"(R[6]), "+v"(R[7]) :: "memory"); \
        else asm volatile("s_waitcnt vmcnt(4)" : "+v"(R[0]), "+v"(R[2]), "+v"(R[4]), "+v"(R[6]) :: "memory"); } while (0)
#define RELU_(x) __builtin_amdgcn_fmed3f((x), 0.f, __builtin_inff())
#define IDX_SCORE(R, kt_) do { IDX_WAIT(R); if ((kt_) < n32) { bf16x8 kf[4]; \
        if (SAMPLE && (kt_) < 64) { _Pragma("unroll") for (int s_ = 0; s_ < 4; ++s_) kf[s_] = cvt8(__builtin_bit_cast(f32x4, R[2 * s_]), __builtin_bit_cast(f32x4, R[2 * s_ + 1])); } \
        else { _Pragma("unroll") for (int s_ = 0; s_ < 4; ++s_) kf[s_] = __builtin_bit_cast(bf16x8, R[2 * s_]); } \
        f32x16 a; _Pragma("unroll") for (int i_ = 0; i_ < 16; ++i_) a[i_] = 0.f; \
        _Pragma("unroll") for (int s_ = 0; s_ < 4; ++s_) a = MFMA32(q[s_], kf[s_], a); \
        _Pragma("unroll") for (int qq = 0; qq < 4; ++qq) { \
            float v = RELU_(a[4 * qq]) * wq[qq][0] + RELU_(a[4 * qq + 1]) * wq[qq][1] + RELU_(a[4 * qq + 2]) * wq[qq][2] + RELU_(a[4 * qq + 3]) * wq[qq][3]; \
            int uu = __float_as_int(v); uu = (uu == (int)0x80000000) ? 0 : uu; \
            sc[(2 * qq + hi) * 4096 + 32 * (kt_) + l31] = uu ^ ((uu >> 31) & 0x7fffffff); } } } while (0)
    if (!(ABL & 2)) {
        IDX_ISSUE(rA, w); IDX_ISSUE(rB, w + NWAVES);
        PIN4(q); PIN4(wq);
        asm volatile("s_waitcnt vmcnt(0)" ::: "memory");
        for (int kt = w; kt < n32; kt += 2 * NWAVES) {
            IDX_SCORE(rA, kt); IDX_ISSUE(rA, kt + 2 * NWAVES);
            IDX_SCORE(rB, kt + NWAVES); IDX_ISSUE(rB, kt + 3 * NWAVES);
        }
        asm volatile("s_waitcnt vmcnt(0)" : "+v"(rA[0]), "+v"(rA[2]), "+v"(rA[4]), "+v"(rA[6]), "+v"(rB[0]), "+v"(rB[2]), "+v"(rB[4]), "+v"(rB[6]) :: "memory");
        if (SAMPLE) asm volatile("" : "+v"(rA[1]), "+v"(rA[3]), "+v"(rA[5]), "+v"(rA[7]), "+v"(rB[1]), "+v"(rB[3]), "+v"(rB[5]), "+v"(rB[7]));
    }
#undef IDX_ISSUE
#undef IDX_WAIT
#undef IDX_SCORE
#undef RELU_
    __syncthreads();
    if (w < ntok && !(ABL & 8)) {
        const int n = SAMPLE ? (PASTL + 1 + w) : (row0 - (row0 & ~(SEQ - 1)) + w + 1);
        unsigned long long* out = WSP(unsigned long long, ABL ? WS_T1 : WS_SELM) + (size_t)(row0 + w) * 64;
        const LAS int* scw = sc + w * 4096;
        if (n <= 1024) idx_select<16, ABL>(scw, n, lane, out);
        else if (n <= 2048) idx_select<32, ABL>(scw, n, lane, out);
        else if (n <= 3072) idx_select<48, ABL>(scw, n, lane, out);
        else idx_select<64, ABL>(scw, n, lane, out);
    }
    __syncthreads();
}


constexpr int NSA_PS = 2 * 2 * TILE_B;
constexpr int NSA_WS = 8192 + 2048 + 64;
template <bool SAMPLE> DI void nsa_unit(Frame& F, int u) {
    const int tid = F.tid, lane = F.lane, w = F.wave, l31 = lane & 31, hi = lane >> 5, tl = l31 >> 2, hl = l31 & 3;
    int bg, g, row, qpos, ncmp, wlo, whi, n_ctile, n_stile, w_t0, w_t1, qt = 0;
    size_t cpitch, pitch, wpitch; const bf16 *ck, *cvt, *sk, *svt, *wk, *wvt; bool wr_ok;
    if (!SAMPLE) {
        bg = u & 7; qt = 63 - (u >> 3); g = bg & 1; const int t = 64 * qt + 8 * w + tl; row = (bg >> 1) * SEQ + t; qpos = t; ncmp = 255;
        cpitch = 256; pitch = SEQ; wpitch = SEQ;
        ck = WSP(bf16, WS_PCK) + (size_t)bg * 256 * 64; cvt = WSP(bf16, WS_PCVT) + (size_t)bg * 64 * 256;
        sk = WSP(bf16, WS_PSLCK) + (size_t)bg * SEQ * 64; svt = WSP(bf16, WS_PSLCVT) + (size_t)bg * 64 * SEQ;
        wk = WSP(bf16, WS_PWINK) + (size_t)bg * SEQ * 64; wvt = WSP(bf16, WS_PWINVT) + (size_t)bg * 64 * SEQ;
        wlo = qpos - 511; whi = qpos; n_ctile = (4 * qt + 2) / 64 + 1; n_stile = qt + 1; w_t0 = qt > 8 ? qt - 8 : 0; w_t1 = qt; wr_ok = true;
    } else {
        bg = u * 8 + w; g = bg & 1; const int i = tl & 3; row = MP + (bg >> 1) * 4 + i; qpos = PASTL + i; ncmp = 127;
        cpitch = 128; pitch = LS; wpitch = LSW;
        ck = WSP(bf16, WS_SCK) + (size_t)bg * 128 * 64; cvt = WSP(bf16, WS_SCVT) + (size_t)bg * 64 * 128;
        sk = WSP(bf16, WS_SSLCK) + (size_t)bg * LS * 64; svt = WSP(bf16, WS_SSLCVT) + (size_t)bg * 64 * LS;
        wk = WSP(bf16, WS_SWINK) + (size_t)bg * LSW * 64; wvt = WSP(bf16, WS_SWINVT) + (size_t)bg * 64 * LSW;
        wlo = 1 + i; whi = 512 + i; n_ctile = 2; n_stile = 33; w_t0 = 0; w_t1 = 8; wr_ok = tl < 4;
    }
    const int hq = 4 * g + hl;
    bf16x8 qraw[4], qrot[4];
#pragma unroll
    for (int s = 0; s < 4; ++s) qraw[s] = *(const bf16x8*)(WSP(bf16, WS_QRAW) + (size_t)row * 512 + hq * 64 + 16 * s + 8 * hi);
    LAS unsigned char* const lb = F.lds;
    LAS float* psum = (LAS float*)(lb + NSA_PS + w * NSA_WS);
    LAS float* impb = (LAS float*)(lb + NSA_PS + w * NSA_WS + 8192);
    LAS unsigned char* selb = lb + NSA_PS + w * NSA_WS + 8192 + 2048;
    const int fo = l31 * TP + hi * 16;
    const float* gp = WSP(float, WS_GATES) + (size_t)row * 24 + hq * 3;
    float g0 = gp[0], g1 = gp[1], g2 = gp[2];
    PIN4(qraw); asm volatile("" : "+v"(g0), "+v"(g1), "+v"(g2));
    f32x16 s0, s1;
    u32x4 rk, rv;
    Soft S;

    const int nvr = (qpos - 31) >> 4, nvis = nvr < ncmp - 1 ? nvr : ncmp - 1;
    float m = -1e30f, l = 0.f;
    if (!SAMPLE) { rk = tile_ld(ck, 64, tid); rv = tile_ld(cvt, cpitch, tid); tile_st(lb, rk, tid); tile_st(lb + TILE_B, rv, tid); LDS_BARRIER(); }
    for (int ct = 0; ct < n_ctile; ++ct) {
        if (!SAMPLE) { if (ct + 1 < n_ctile) { rk = tile_ld(ck + (size_t)(ct + 1) * 64 * 64, 64, tid); rv = tile_ld(cvt + (ct + 1) * 64, cpitch, tid); } }
        if (!SAMPLE) { LdsT kt{lb + (ct & 1) * 2 * TILE_B + fo}; qk_tile(s0, s1, kt, qraw); }
        else { GlbT kt{ck, (unsigned)((64 * ct + l31) * 64 + 8 * hi), 64u}; qk_tile(s0, s1, kt, qraw); }
        float mx = -1e30f;
        const int nv2 = nvis - 64 * ct - 4 * hi;
#pragma unroll
        for (int r = 0; r < 16; ++r) { const int cr = (r & 3) + 8 * (r >> 2); s0[r] = cr <= nv2 ? s0[r] : NEGINF; s1[r] = cr + 32 <= nv2 ? s1[r] : NEGINF; mx = fmaxf(mx, fmaxf(s0[r], s1[r])); }
        mx = fmaxf(mx, half_other(mx));
        const float mn = fmaxf(m, mx); float ps = 0.f;
#pragma unroll
        for (int r = 0; r < 16; ++r) ps += __builtin_amdgcn_exp2f(s0[r] - mn) + __builtin_amdgcn_exp2f(s1[r] - mn);
        l = l * __builtin_amdgcn_exp2f(m - mn) + ps; m = mn;
        if (!SAMPLE) { if (ct + 1 < n_ctile) { tile_st(lb + ((ct + 1) & 1) * 2 * TILE_B, rk, tid); tile_st(lb + ((ct + 1) & 1) * 2 * TILE_B + TILE_B, rv, tid); } LDS_BARRIER(); }
    }
    l += half_other(l);
    const float linv = l > 0.f ? 1.f / l : 0.f;
    soft_init(S);
    if (!SAMPLE) { rk = tile_ld(ck, 64, tid); rv = tile_ld(cvt, cpitch, tid); tile_st(lb, rk, tid); tile_st(lb + TILE_B, rv, tid); LDS_BARRIER(); }
    for (int ct = 0; ct < n_ctile; ++ct) {
        if (!SAMPLE) { if (ct + 1 < n_ctile) { rk = tile_ld(ck + (size_t)(ct + 1) * 64 * 64, 64, tid); rv = tile_ld(cvt + (ct + 1) * 64, cpitch, tid); } }
        if (!SAMPLE) { LdsT kt{lb + (ct & 1) * 2 * TILE_B + fo}; qk_tile(s0, s1, kt, qraw); }
        else { GlbT kt{ck, (unsigned)((64 * ct + l31) * 64 + 8 * hi), 64u}; qk_tile(s0, s1, kt, qraw); }
        const int nv2 = nvis - 64 * ct - 4 * hi; LAS float* pw = psum + tl * 256 + 64 * ct + 4 * hi;
#pragma unroll
        for (int r = 0; r < 16; ++r) { const int cr = (r & 3) + 8 * (r >> 2);
            s0[r] = cr <= nv2 ? __builtin_amdgcn_exp2f(s0[r] - m) * linv : 0.f; s1[r] = cr + 32 <= nv2 ? __builtin_amdgcn_exp2f(s1[r] - m) * linv : 0.f;
            float a = s0[r]; a += dpp_x1(a); a += dpp_x2(a); float b = s1[r]; b += dpp_x1(b); b += dpp_x2(b);
            if (hl == 0) { pw[cr] = a; pw[cr + 32] = b; } }
        if (!SAMPLE) { LdsT vt{lb + (ct & 1) * 2 * TILE_B + TILE_B + fo}; pv_tile(S.o0, S.o1, s0, s1, vt); }
        else { GlbT vt{cvt, (unsigned)(l31 * (int)cpitch + 64 * ct + 8 * hi), (unsigned)cpitch}; pv_tile(S.o0, S.o1, s0, s1, vt); }
        if (!SAMPLE) { if (ct + 1 < n_ctile) { tile_st(lb + ((ct + 1) & 1) * 2 * TILE_B, rk, tid); tile_st(lb + ((ct + 1) & 1) * 2 * TILE_B + TILE_B, rv, tid); } LDS_BARRIER(); }
    }
    LDS_WAIT();
    unsigned mlo, mhi;
    {
        const int tk = lane >> 3, jb = 8 * (lane & 7);
        const int qp = SAMPLE ? PASTL + (tk & 3) : 64 * qt + 8 * w + tk, cur = qp >> 6;
        float pv[33];
        const LAS f32x4* pp = (const LAS f32x4*)(psum + tk * 256 + 4 * jb);
#pragma unroll
        for (int i = 0; i < 8; ++i) { const f32x4 x = pp[i]; pv[1 + 4 * i] = x[0]; pv[2 + 4 * i] = x[1]; pv[3 + 4 * i] = x[2]; pv[4 + 4 * i] = x[3]; }
        pv[0] = jb > 0 ? psum[tk * 256 + 4 * jb - 1] : 0.f;
        float v[8];
#pragma unroll
        for (int jj = 0; jj < 8; ++jj) {
            const int j = jb + jj;
            float a = pv[4 * jj] + pv[4 * jj + 1] + pv[4 * jj + 2] + pv[4 * jj + 3];
            a += (4 * j + 3 < ncmp) ? pv[4 * jj + 4] : 0.f;
            a = ((j == 0) | (j == cur) | (j == cur - 1)) ? 1e4f : a;
            a = (j > cur) ? -1e30f : a;
            v[jj] = a;
        }
        LAS f32x4* ip = (LAS f32x4*)(impb + tk * 64 + jb);
        ip[0] = (f32x4){v[0], v[1], v[2], v[3]}; ip[1] = (f32x4){v[4], v[5], v[6], v[7]};
        LDS_WAIT();
        int cnt[8];
#pragma unroll
        for (int jj = 0; jj < 8; ++jj) cnt[jj] = 0;
        const LAS f32x4* ap = (const LAS f32x4*)(impb + tk * 64);
#pragma unroll 1
        for (int i4 = 0; i4 < 16; ++i4) {
            const f32x4 x = ap[i4];
#pragma unroll
            for (int e = 0; e < 4; ++e) { const float xi = x[e];
#pragma unroll
                for (int jj = 0; jj < 8; ++jj) cnt[jj] += (xi > v[jj]) ? 1 : 0; }
        }
        unsigned bits = 0;
#pragma unroll
        for (int jj = 0; jj < 8; ++jj) bits |= ((cnt[jj] < 16) & (jb + jj <= cur)) ? (1u << jj) : 0u;
        int nsel = __popc(bits);
        nsel += __shfl_xor(nsel, 1); nsel += __shfl_xor(nsel, 2); nsel += __shfl_xor(nsel, 4);
        if (__builtin_amdgcn_ballot_w64(nsel != (cur < 15 ? cur + 1 : 16)) != 0ull) {
#pragma unroll
            for (int jj = 0; jj < 8; ++jj) cnt[jj] = 0;
#pragma unroll 1
            for (int i4 = 0; i4 < 16; ++i4) {
                const f32x4 x = ap[i4];
#pragma unroll
                for (int e = 0; e < 4; ++e) { const int i = 4 * i4 + e; const float xi = x[e];
#pragma unroll
                    for (int jj = 0; jj < 8; ++jj) cnt[jj] += ((xi > v[jj]) | ((xi == v[jj]) & (i < jb + jj))) ? 1 : 0; }
            }
            bits = 0;
#pragma unroll
            for (int jj = 0; jj < 8; ++jj) bits |= ((cnt[jj] < 16) & (jb + jj <= cur)) ? (1u << jj) : 0u;
        }
        selb[tk * 8 + (lane & 7)] = (unsigned char)bits;
        LDS_WAIT();
        const LAS unsigned* sp = (const LAS unsigned*)(selb + tl * 8);
        mlo = sp[0]; mhi = sp[1];
    }
    LAS float* park = psum + lane;
#pragma unroll
    for (int i = 0; i < 16; ++i) { park[i * 64] = g0 * S.o0[i]; park[(16 + i) * 64] = g0 * S.o1[i]; }
#pragma unroll
    for (int s = 0; s < 4; ++s) qrot[s] = *(const bf16x8*)(WSP(bf16, WS_QROT) + (size_t)row * 512 + hq * 64 + 16 * s + 8 * hi);
    PIN4(qrot);
    soft_init(S);
    const int qrel = (qpos & 63) - 4 * hi;
    if (!SAMPLE) { rk = tile_ld(sk, 64, tid); rv = tile_ld(svt, pitch, tid); tile_st(lb, rk, tid); tile_st(lb + TILE_B, rv, tid); LDS_BARRIER(); }
    for (int j = 0; j < n_stile; ++j) {
        if (!SAMPLE) { if (j + 1 < n_stile) { rk = tile_ld(sk + (size_t)(j + 1) * 64 * 64, 64, tid); rv = tile_ld(svt + (j + 1) * 64, pitch, tid); } }
        const bool bsel = ((j < 32 ? (mlo >> j) : (mhi >> (j - 32))) & 1u) != 0u;
        if (!SAMPLE) { LdsT kt{lb + (j & 1) * 2 * TILE_B + fo}; qk_tile_c(s0, s1, kt, qrot, S.negm); }
        else { GlbT kt{sk, (unsigned)((64 * j + l31) * 64 + 8 * hi), 64u}; qk_tile_c(s0, s1, kt, qrot, S.negm); }
        if (j == n_stile - 1) {
#pragma unroll
            for (int r = 0; r < 16; ++r) { const int cr = (r & 3) + 8 * (r >> 2); s0[r] = cr <= qrel ? s0[r] : NEGINF; s1[r] = cr + 32 <= qrel ? s1[r] : NEGINF; }
        } else {
#pragma unroll
            for (int r = 0; r < 16; ++r) { s0[r] = bsel ? s0[r] : NEGINF; s1[r] = bsel ? s1[r] : NEGINF; }
        }
        if (!SAMPLE) { LdsT vt{lb + (j & 1) * 2 * TILE_B + TILE_B + fo}; soft_step(S, s0, s1, vt); }
        else { GlbT vt{svt, (unsigned)(l31 * (int)pitch + 64 * j + 8 * hi), (unsigned)pitch}; soft_step(S, s0, s1, vt); }
        if (!SAMPLE) { if (j + 1 < n_stile) { tile_st(lb + ((j + 1) & 1) * 2 * TILE_B, rk, tid); tile_st(lb + ((j + 1) & 1) * 2 * TILE_B + TILE_B, rv, tid); } LDS_BARRIER(); }
    }
    S.l += half_other(S.l);
    { const float sc = g1 / fmaxf(S.l, 1e-30f);
#pragma unroll
      for (int i = 0; i < 16; ++i) { park[i * 64] += sc * S.o0[i]; park[(16 + i) * 64] += sc * S.o1[i]; } }
    soft_init(S);
    if (!SAMPLE) { rk = tile_ld(wk + (size_t)w_t0 * 64 * 64, 64, tid); rv = tile_ld(wvt + w_t0 * 64, wpitch, tid); tile_st(lb, rk, tid); tile_st(lb + TILE_B, rv, tid); LDS_BARRIER(); }
    for (int j = w_t0; j <= w_t1; ++j) {
        const int jr = j - w_t0;
        if (!SAMPLE) { if (j + 1 <= w_t1) { rk = tile_ld(wk + (size_t)(j + 1) * 64 * 64, 64, tid); rv = tile_ld(wvt + (j + 1) * 64, wpitch, tid); } }
        if (!SAMPLE) { LdsT kt{lb + (jr & 1) * 2 * TILE_B + fo}; qk_tile_c(s0, s1, kt, qrot, S.negm); }
        else { GlbT kt{wk, (unsigned)((64 * j + l31) * 64 + 8 * hi), 64u}; qk_tile_c(s0, s1, kt, qrot, S.negm); }
        if ((j == w_t0) | (j == w_t1)) {
            const int lo_r = wlo - 64 * j - 4 * hi, hi_r = whi - 64 * j - 4 * hi;
#pragma unroll
            for (int r = 0; r < 16; ++r) { const int k0 = (r & 3) + 8 * (r >> 2); s0[r] = ((k0 >= lo_r) & (k0 <= hi_r)) ? s0[r] : NEGINF; s1[r] = ((k0 + 32 >= lo_r) & (k0 + 32 <= hi_r)) ? s1[r] : NEGINF; }
        }
        if (!SAMPLE) { LdsT vt{lb + (jr & 1) * 2 * TILE_B + TILE_B + fo}; soft_step(S, s0, s1, vt); }
        else { GlbT vt{wvt, (unsigned)(l31 * (int)wpitch + 64 * j + 8 * hi), (unsigned)wpitch}; soft_step(S, s0, s1, vt); }
        if (!SAMPLE) { if (j + 1 <= w_t1) { tile_st(lb + ((jr + 1) & 1) * 2 * TILE_B, rk, tid); tile_st(lb + ((jr + 1) & 1) * 2 * TILE_B + TILE_B, rv, tid); } LDS_BARRIER(); }
    }
    S.l += half_other(S.l);
#ifdef BREAK_WIN
    S.l *= 1.1f;
#endif
    f32x16 res0, res1;
    { const float sc = g2 / fmaxf(S.l, 1e-30f);
#pragma unroll
      for (int i = 0; i < 16; ++i) { res0[i] = park[i * 64] + sc * S.o0[i]; res1[i] = park[(16 + i) * 64] + sc * S.o1[i]; } }
    if (wr_ok) {
        const bf16* zp = WSP(bf16, WS_ZN) + (size_t)row * 512 + hq * 64 + 4 * hi;
        bf16* op = WSP(bf16, WS_ONZ) + (size_t)row * 512 + hq * 64 + 4 * hi;
#pragma unroll
        for (int e = 0; e < 2; ++e)
#pragma unroll
            for (int q = 0; q < 4; ++q) { const f32x16& o = e ? res1 : res0; const u32x2 z = *(const u32x2*)(zp + 32 * e + 8 * q);
                u32x2 wv; wv.x = pk2(o[4 * q] * bflo(z.x), o[4 * q + 1] * bfhi(z.x)); wv.y = pk2(o[4 * q + 2] * bflo(z.y), o[4 * q + 3] * bfhi(z.y));
                *(u32x2*)(op + 32 * e + 8 * q) = wv; }
    }
}

template <int ABL, class VT> DI void soft_step2(Soft& S, f32x16& s0, f32x16& s1, f32x16& sn0, f32x16& sn1, const VT& vt) {
    bf16x8 vf[8];
#pragma unroll
    for (int s = 0; s < 4; ++s) { vf[2 * s] = vt.frag(0, s); vf[2 * s + 1] = vt.frag(1, s); }
    if (!(ABL & 1)) {
    float mx = max3f(s0[0], s1[0], s0[1]), my = max3f(s1[1], s0[2], s1[2]);
#pragma unroll
    for (int r = 3; r < 15; r += 2) { mx = max3f(mx, s0[r], s1[r]); my = max3f(my, s0[r + 1], s1[r + 1]); }
    mx = max3f(mx, s0[15], s1[15]); mx = max3f(mx, my, mx);
    mx = max3f(mx, half_other(mx), mx);
    const bool fin = mx > NEGINF;
    const bool need = (mx > 8.f) | (fin & !S.seen);
    if (__any(need)) {
        const float dl = need ? mx : 0.f;
        const float al = S.seen ? __builtin_amdgcn_exp2f(-dl) : 0.f;
        S.m += dl; S.l *= need ? al : 1.f;
        const float am = need ? al : 1.f;
#pragma unroll
        for (int r = 0; r < 16; ++r) { s0[r] -= dl; s1[r] -= dl; sn0[r] -= dl; sn1[r] -= dl; S.o0[r] *= am; S.o1[r] *= am; S.negm[r] = -S.m; }
    }
    S.seen = S.seen | fin;
    float ps = 0.f;
#pragma unroll
    for (int r = 0; r < 16; ++r) { s0[r] = __builtin_amdgcn_exp2f(s0[r]); s1[r] = __builtin_amdgcn_exp2f(s1[r]); ps += s0[r] + s1[r]; }
    S.l += ps;
    }
    const bf16x8 b0 = pack_p(s0, 0), b1 = pack_p(s0, 1), b2 = pack_p(s1, 0), b3 = pack_p(s1, 1);
    if (!(ABL & 4)) {
    S.o0 = MFMA32(vf[0], b0, S.o0); S.o1 = MFMA32(vf[1], b0, S.o1);
    S.o0 = MFMA32(vf[2], b1, S.o0); S.o1 = MFMA32(vf[3], b1, S.o1);
    S.o0 = MFMA32(vf[4], b2, S.o0); S.o1 = MFMA32(vf[5], b2, S.o1);
    S.o0 = MFMA32(vf[6], b3, S.o0); S.o1 = MFMA32(vf[7], b3, S.o1);
    } else { S.o0[0] += __builtin_bit_cast(f32x4, b0)[0] + __builtin_bit_cast(f32x4, b1)[0] + __builtin_bit_cast(f32x4, b2)[0] + __builtin_bit_cast(f32x4, b3)[0] + __builtin_bit_cast(f32x4, vf[0])[0] + __builtin_bit_cast(f32x4, vf[7])[1]; }
}
template <int ABL> DI void dsa_unit(Frame& F, int u) {
    const int tid = F.tid, lane = F.lane, w = F.wave, l31 = lane & 31, hi = lane >> 5, tl = l31 >> 2, hl = l31 & 3;
    const int bg = u & 7, qt = 63 - (u >> 3), g = bg & 1, t = 64 * qt + 8 * w + tl, row = (bg >> 1) * SEQ + t, nt = qt + 1;
    const bf16* dk = WSP(bf16, WS_PDSAK) + (size_t)bg * SEQ * 64; const bf16* dvt = WSP(bf16, WS_PDSAVT) + (size_t)bg * 64 * SEQ;
    const int hq = 4 * g + hl;
    bf16x8 dq[4];
#pragma unroll
    for (int s = 0; s < 4; ++s) dq[s] = *(const bf16x8*)(WSP(bf16, WS_DQ) + (size_t)row * 512 + hq * 64 + 16 * s + 8 * hi);
    const unsigned long long* selp = WSP(unsigned long long, WS_SELM) + (size_t)row * 64;
    unsigned long long selA = selp[0], selB = selp[nt > 1 ? 1 : 0];
    PIN4(dq); asm volatile("" : "+v"(selA), "+v"(selB));
    LAS unsigned char* const lb = F.lds;
    const int fo = l31 * TP + hi * 16;
    f32x16 sc0, sc1, sn0, sn1;
    u32x4 rkA, rvA, rkB, rvB;
    Soft S; soft_init(S);
    const int ntm = nt - 1;
    const bf16* kpc = dk + (size_t)(tid >> 3) * 64 + (tid & 7) * 8; const bf16* vpc = dvt + (size_t)(tid >> 3) * SEQ + (tid & 7) * 8;
#define KADDR(jt) (kpc + (size_t)((jt) < ntm ? (jt) : ntm) * 64 * 64)
#define VADDR(jt) (vpc + ((jt) < ntm ? (jt) : ntm) * 64)
    { const u32x4 a = tile_ld(dk, 64, tid), b = tile_ld(dvt, SEQ, tid), c = *(const u32x4*)KADDR(1); tile_st(lb, a, tid); tile_st(lb + 2 * TILE_B, b, tid); tile_st(lb + TILE_B, c, tid); }
    asm volatile("s_waitcnt vmcnt(0)" : "+v"(selA), "+v"(selB) :: "memory");
    selA = gload8(selp); selB = gload8(selp + (nt > 1 ? 1 : 0));
    rkA = gload16(KADDR(2)); rvA = gload16(VADDR(1));
    LDS_BARRIER();
    { LdsT kt{lb + fo}; qk_tile_c(sc0, sc1, kt, dq, S.negm); }
#define DSA_STEP(j, CK, CV, NK, NV, SELC) do { \
        NK = gload16(KADDR((j) + 3)); NV = gload16(VADDR((j) + 2)); \
        if ((j) + 1 < nt) { LdsT kt{lb + (((j) + 1) & 1) * TILE_B + fo}; if (!(ABL & 2)) qk_tile_c(sn0, sn1, kt, dq, S.negm); else { sn0 = S.negm; sn1 = S.negm; sn0[0] += __builtin_bit_cast(f32x4, kt.frag(0, 0))[0]; } } \
        WAITV1(5, SELC);                                                     \
        { const unsigned wa = (unsigned)SELC >> (4 * hi), wb = (unsigned)(SELC >> 32) >> (4 * hi); \
          SELC = gload8(selp + ((j) + 2 < nt ? (j) + 2 : ntm)); \
          _Pragma("unroll") for (int r = 0; r < 16; ++r) { const int bp = (r & 3) + 8 * (r >> 2); \
            sc0[r] = mask_sel(sc0[r], (int)(wa << (31 - bp)) >> 31); sc1[r] = mask_sel(sc1[r], (int)(wb << (31 - bp)) >> 31); } } \
        { LdsT vt{lb + (2 + ((j) & 1)) * TILE_B + fo}; soft_step2<ABL>(S, sc0, sc1, sn0, sn1, vt); } \
        sc0 = sn0; sc1 = sn1; \
        WAITV2(3, CK, CV);                                                   \
        if (!(ABL & 8)) { tile_st(lb + ((j) & 1) * TILE_B, CK, tid); tile_st(lb + (2 + (((j) + 1) & 1)) * TILE_B, CV, tid); } \
        if (!(ABL & 16)) LDS_BARRIER(); } while (0)
    for (int j = 0; j < nt; j += 2) { DSA_STEP(j, rkA, rvA, rkB, rvB, selA); if (j + 1 < nt) DSA_STEP(j + 1, rkB, rvB, rkA, rvA, selB); }
    asm volatile("s_waitcnt vmcnt(0)" : "+v"(rkA), "+v"(rvA), "+v"(rkB), "+v"(rvB), "+v"(selA), "+v"(selB) :: "memory");
#undef DSA_STEP
#undef KADDR
#undef VADDR
    S.l += half_other(S.l);
    {
        const float sc = 1.f / fmaxf(S.l, 1e-30f);
        const bf16* zp = WSP(bf16, WS_ZD) + (size_t)row * 512 + hq * 64 + 4 * hi;
        bf16* op = WSP(bf16, ABL ? WS_T1 : WS_ODZ) + (size_t)row * 512 + hq * 64 + 4 * hi;
#pragma unroll
        for (int e = 0; e < 2; ++e)
#pragma unroll
            for (int q = 0; q < 4; ++q) { const f32x16& o = e ? S.o1 : S.o0; const u32x2 z = *(const u32x2*)(zp + 32 * e + 8 * q);
                u32x2 wv; wv.x = pk2(o[4 * q] * sc * bflo(z.x), o[4 * q + 1] * sc * bfhi(z.x)); wv.y = pk2(o[4 * q + 2] * sc * bflo(z.y), o[4 * q + 3] * sc * bfhi(z.y));
                *(u32x2*)(op + 32 * e + 8 * q) = wv; }
    }
}


struct PageK {
    static constexpr bool HOIST = false;
    const float* p; unsigned stride;
    DI bf16x8 frag(int mt, int s) const { const f32x4* q = (const f32x4*)(p + (size_t)((unsigned)mt * 32u * stride + (unsigned)s * 16u)); return cvt8(q[0], q[1]); }
};
struct PageV {
    static constexpr bool HOIST = false;
    const float* p; unsigned stride;
    DI bf16x8 frag(int dt, int s) const {
        float v[8];
#pragma unroll
        for (int i = 0; i < 8; ++i) v[i] = p[(size_t)((unsigned)(16 * s + (i & 3) + 8 * (i >> 2)) * stride + (unsigned)dt * 32u)];
        return __builtin_bit_cast(bf16x8, pack8(v));
    }
};
constexpr int XCH_W = 34 * 64;
constexpr int XCH_BYTES = 8 * XCH_W * 4;
DI void xch_put(LAS float* x, const Soft& S, int lane) {
    const float lt = S.l + half_other(S.l);
    x[lane] = S.seen ? S.m : NEGINF; x[64 + lane] = lt;
#pragma unroll
    for (int r = 0; r < 16; ++r) { x[(2 + r) * 64 + lane] = S.o0[r]; x[(18 + r) * 64 + lane] = S.o1[r]; }
}
DI void xch_get(const LAS float* xb, int w, int lane, float (&out)[4]) {
    float mw[8], M = -1e30f;
#pragma unroll
    for (int i = 0; i < 8; ++i) { mw[i] = xb[i * XCH_W + lane]; M = fmaxf(M, mw[i]); }
    float L = 0.f, o[4] = {0.f, 0.f, 0.f, 0.f};
#pragma unroll
    for (int i = 0; i < 8; ++i) { const float wt = __builtin_amdgcn_exp2f(mw[i] - M); L += wt * xb[i * XCH_W + 64 + lane];
#pragma unroll
        for (int k = 0; k < 4; ++k) o[k] += wt * xb[i * XCH_W + (2 + 4 * w + k) * 64 + lane]; }
    const float inv = 1.f / fmaxf(L, 1e-30f);
#pragma unroll
    for (int k = 0; k < 4; ++k) out[k] = o[k] * inv;
}
DI void nsa_sample_unit(Frame& F, int bg) {
    const int lane = F.lane, w = F.wave, l31 = lane & 31, hi = lane >> 5, tl = l31 >> 2, hl = l31 & 3;
    const int sb = bg >> 1, g = bg & 1, i = tl & 3, row = MP + sb * 4 + i, qpos = PASTL + i, hq = 4 * g + hl;
    LAS unsigned char* const lb = F.lds;
    LAS float* xch = (LAS float*)lb;
    LAS float* cmpb = (LAS float*)(lb + XCH_BYTES);
    LAS unsigned* mskb = (LAS unsigned*)(lb + XCH_BYTES + 8192);
    LAS float* psum = (LAS float*)(lb + XCH_BYTES + 8192 + 64);
    LAS float* impb = psum + 8 * 256;
    LAS unsigned char* selb = (LAS unsigned char*)(impb + 8 * 64);
    const float* gp = WSP(float, WS_GATES) + (size_t)row * 24 + hq * 3;
    float g0 = gp[0], g1 = gp[1], g2 = gp[2];
    bf16x8 qrot[4];
#pragma unroll
    for (int s = 0; s < 4; ++s) qrot[s] = *(const bf16x8*)(WSP(bf16, WS_QROT) + (size_t)row * 512 + hq * 64 + 16 * s + 8 * hi);
    f32x16 s0, s1;
    Soft S;
    __syncthreads();
    if (w == 0) {
        const bf16* ck = WSP(bf16, WS_SCK) + (size_t)bg * 128 * 64; const bf16* cvt = WSP(bf16, WS_SCVT) + (size_t)bg * 64 * 128;
        bf16x8 qraw[4];
#pragma unroll
        for (int s = 0; s < 4; ++s) qraw[s] = *(const bf16x8*)(WSP(bf16, WS_QRAW) + (size_t)row * 512 + hq * 64 + 16 * s + 8 * hi);
        const int ncmp = 127, nvis = 126;
        float m = -1e30f, l = 0.f;
        for (int ct = 0; ct < 2; ++ct) {
            GlbT kt{ck, (unsigned)((64 * ct + l31) * 64 + 8 * hi), 64u}; qk_tile(s0, s1, kt, qraw);
            float mx = -1e30f; const int nv2 = nvis - 64 * ct - 4 * hi;
#pragma unroll
            for (int r = 0; r < 16; ++r) { const int cr = (r & 3) + 8 * (r >> 2); s0[r] = cr <= nv2 ? s0[r] : NEGINF; s1[r] = cr + 32 <= nv2 ? s1[r] : NEGINF; mx = fmaxf(mx, fmaxf(s0[r], s1[r])); }
            mx = fmaxf(mx, half_other(mx));
            const float mn = fmaxf(m, mx); float ps = 0.f;
#pragma unroll
            for (int r = 0; r < 16; ++r) ps += __builtin_amdgcn_exp2f(s0[r] - mn) + __builtin_amdgcn_exp2f(s1[r] - mn);
            l = l * __builtin_amdgcn_exp2f(m - mn) + ps; m = mn;
        }
        l += half_other(l);
        const float linv = l > 0.f ? 1.f / l : 0.f;
        soft_init(S);
        for (int ct = 0; ct < 2; ++ct) {
            GlbT kt{ck, (unsigned)((64 * ct + l31) * 64 + 8 * hi), 64u}; qk_tile(s0, s1, kt, qraw);
            const int nv2 = nvis - 64 * ct - 4 * hi; LAS float* pw = psum + tl * 256 + 64 * ct + 4 * hi;
#pragma unroll
            for (int r = 0; r < 16; ++r) { const int cr = (r & 3) + 8 * (r >> 2);
                s0[r] = cr <= nv2 ? __builtin_amdgcn_exp2f(s0[r] - m) * linv : 0.f; s1[r] = cr + 32 <= nv2 ? __builtin_amdgcn_exp2f(s1[r] - m) * linv : 0.f;
                float a = s0[r]; a += dpp_x1(a); a += dpp_x2(a); float b = s1[r]; b += dpp_x1(b); b += dpp_x2(b);
                if (hl == 0) { pw[cr] = a; pw[cr + 32] = b; } }
            GlbT vt{cvt, (unsigned)(l31 * 128 + 64 * ct + 8 * hi), 128u}; pv_tile(S.o0, S.o1, s0, s1, vt);
        }
#pragma unroll
        for (int r = 0; r < 16; ++r) { cmpb[r * 64 + lane] = S.o0[r]; cmpb[(16 + r) * 64 + lane] = S.o1[r]; }
        LDS_WAIT();
        {
            const int tk = lane >> 3, jb = 8 * (lane & 7), cur = 32;
            float pv[33];
            const LAS f32x4* pp = (const LAS f32x4*)(psum + tk * 256 + 4 * jb);
#pragma unroll
            for (int q = 0; q < 8; ++q) { const f32x4 x = pp[q]; pv[1 + 4 * q] = x[0]; pv[2 + 4 * q] = x[1]; pv[3 + 4 * q] = x[2]; pv[4 + 4 * q] = x[3]; }
            pv[0] = jb > 0 ? psum[tk * 256 + 4 * jb - 1] : 0.f;
            float v[8];
#pragma unroll
            for (int jj = 0; jj < 8; ++jj) { const int j = jb + jj;
                float a = pv[4 * jj] + pv[4 * jj + 1] + pv[4 * jj + 2] + pv[4 * jj + 3];
                a += (4 * j + 3 < ncmp) ? pv[4 * jj + 4] : 0.f;
                a = ((j == 0) | (j == cur) | (j == cur - 1)) ? 1e4f : a;
                a = (j > cur) ? -1e30f : a;
                v[jj] = a; }
            LAS f32x4* ip = (LAS f32x4*)(impb + tk * 64 + jb);
            ip[0] = (f32x4){v[0], v[1], v[2], v[3]}; ip[1] = (f32x4){v[4], v[5], v[6], v[7]};
            LDS_WAIT();
            int cnt[8];
#pragma unroll
            for (int jj = 0; jj < 8; ++jj) cnt[jj] = 0;
            const LAS f32x4* ap = (const LAS f32x4*)(impb + tk * 64);
#pragma unroll 1
            for (int i4 = 0; i4 < 16; ++i4) { const f32x4 x = ap[i4];
#pragma unroll
                for (int e = 0; e < 4; ++e) { const int ii = 4 * i4 + e; const float xi = x[e];
#pragma unroll
                    for (int jj = 0; jj < 8; ++jj) cnt[jj] += ((xi > v[jj]) | ((xi == v[jj]) & (ii < jb + jj))) ? 1 : 0; } }
            unsigned bits = 0;
#pragma unroll
            for (int jj = 0; jj < 8; ++jj) bits |= ((cnt[jj] < 16) & (jb + jj <= cur)) ? (1u << jj) : 0u;
            selb[tk * 8 + (lane & 7)] = (unsigned char)bits;
            LDS_WAIT();
            if (lane < 16) mskb[lane] = ((const LAS unsigned*)selb)[lane];
        }
    }
    __syncthreads();
    const unsigned mlo = mskb[tl * 2], mhi = mskb[tl * 2 + 1];
    PIN4(qrot); asm volatile("" : "+v"(g0), "+v"(g1), "+v"(g2));
    soft_init(S);
    for (int j = w; j < 32; j += NWAVES) {
        const int pg = F.ptab[sb * NPG + (j >> 1)];
        const float* base = F.cnsa + ((size_t)pg * PAGE + (j & 1) * 64) * 512 + (2 * 2 + g) * 64;
        PageK kt{base + (size_t)l31 * 512 + 8 * hi, 512u}; qk_tile_c(s0, s1, kt, qrot, S.negm);
        const bool bsel = ((mlo >> j) & 1u) != 0u;
#pragma unroll
        for (int r = 0; r < 16; ++r) { s0[r] = bsel ? s0[r] : NEGINF; s1[r] = bsel ? s1[r] : NEGINF; }
        PageV vt{base + 128 + (size_t)(4 * hi) * 512 + l31, 512u}; soft_step(S, s0, s1, vt);
    }
    if (w == 0) {
        const bf16* sk = WSP(bf16, WS_SSLCK) + (size_t)bg * LS * 64; const bf16* svt = WSP(bf16, WS_SSLCVT) + (size_t)bg * 64 * LS;
        GlbT kt{sk, (unsigned)((2048 + l31) * 64 + 8 * hi), 64u}; qk_tile_c(s0, s1, kt, qrot, S.negm);
        const int qrel = i - 4 * hi;
#pragma unroll
        for (int r = 0; r < 16; ++r) { const int cr = (r & 3) + 8 * (r >> 2); s0[r] = cr <= qrel ? s0[r] : NEGINF; s1[r] = cr + 32 <= qrel ? s1[r] : NEGINF; }
        GlbT vt{svt, (unsigned)(l31 * LS + 2048 + 8 * hi), (unsigned)LS}; soft_step(S, s0, s1, vt);
    }
    xch_put(xch + w * XCH_W, S, lane);
    __syncthreads();
    float acc[4], part[4];
    xch_get(xch, w, lane, part);
#pragma unroll
    for (int k = 0; k < 4; ++k) acc[k] = g1 * part[k] + g0 * cmpb[(4 * w + k) * 64 + lane];
    __syncthreads();
    soft_init(S);
    {
        const float* base = F.swin + ((size_t)sb * 512 + 64 * w) * 256 + g * 64;
        PageK kt{base + (size_t)l31 * 256 + 8 * hi, 256u}; qk_tile_c(s0, s1, kt, qrot, S.negm);
        if (w == 0) {
            const int lo_r = 1 + i - 4 * hi;
#pragma unroll
            for (int r = 0; r < 16; ++r) { const int k0 = (r & 3) + 8 * (r >> 2); s0[r] = k0 >= lo_r ? s0[r] : NEGINF; s1[r] = k0 + 32 >= lo_r ? s1[r] : NEGINF; }
        }
        PageV vt{base + 128 + (size_t)(4 * hi) * 256 + l31, 256u}; soft_step(S, s0, s1, vt);
    }
    if (w == 0) {
        const bf16* wk = WSP(bf16, WS_SWINK) + (size_t)bg * LSW * 64; const bf16* wvt = WSP(bf16, WS_SWINVT) + (size_t)bg * 64 * LSW;
        GlbT kt{wk, (unsigned)((512 + l31) * 64 + 8 * hi), 64u}; qk_tile_c(s0, s1, kt, qrot, S.negm);
        const int hi_r = i - 4 * hi;
#pragma unroll
        for (int r = 0; r < 16; ++r) { const int k0 = (r & 3) + 8 * (r >> 2); s0[r] = k0 <= hi_r ? s0[r] : NEGINF; s1[r] = k0 + 32 <= hi_r ? s1[r] : NEGINF; }
        GlbT vt{wvt, (unsigned)(l31 * LSW + 512 + 8 * hi), (unsigned)LSW}; soft_step(S, s0, s1, vt);
    }
    xch_put(xch + w * XCH_W, S, lane);
    __syncthreads();
    xch_get(xch, w, lane, part);
#ifdef BREAK_WIN
#pragma unroll
    for (int k = 0; k < 4; ++k) part[k] *= 0.9f;
#endif
    if (tl < 4) {
        const int d0 = 32 * (w >> 2) + 8 * (w & 3) + 4 * hi;
        const u32x2 z = *(const u32x2*)(WSP(bf16, WS_ZN) + (size_t)row * 512 + hq * 64 + d0);
        u32x2 wv; wv.x = pk2((acc[0] + g2 * part[0]) * bflo(z.x), (acc[1] + g2 * part[1]) * bfhi(z.x)); wv.y = pk2((acc[2] + g2 * part[2]) * bflo(z.y), (acc[3] + g2 * part[3]) * bfhi(z.y));
        *(u32x2*)(WSP(bf16, WS_ONZ) + (size_t)row * 512 + hq * 64 + d0) = wv;
    }
}
DI void dsa_sample_unit(Frame& F, int bg) {
    const int lane = F.lane, w = F.wave, l31 = lane & 31, hi = lane >> 5, tl = l31 >> 2, hl = l31 & 3;
    const int sb = bg >> 1, g = bg & 1, i = tl & 3, row = MP + sb * 4 + i, hq = 4 * g + hl;
    LAS float* xch = (LAS float*)F.lds;
    bf16x8 dq[4];
#pragma unroll
    for (int s = 0; s < 4; ++s) dq[s] = *(const bf16x8*)(WSP(bf16, WS_DQ) + (size_t)row * 512 + hq * 64 + 16 * s + 8 * hi);
    const unsigned long long* selp = WSP(unsigned long long, WS_SELM) + (size_t)row * 64;
    PIN4(dq);
    f32x16 s0, s1;
    Soft S; soft_init(S);
    for (int j = w; j < 32; j += NWAVES) {
        unsigned long long selw = selp[j];
        const int pg = F.ptab[sb * NPG + (j >> 1)];
        const float* base = F.cdsa + ((size_t)pg * PAGE + (j & 1) * 64) * 256 + g * 64;
        PageK kt{base + (size_t)l31 * 256 + 8 * hi, 256u}; qk_tile_c(s0, s1, kt, dq, S.negm);
#ifdef BREAK_DSA
        selw |= 0x1111111111111111ull;
#endif
        const unsigned wa = (unsigned)selw >> (4 * hi), wb = (unsigned)(selw >> 32) >> (4 * hi);
#pragma unroll
        for (int r = 0; r < 16; ++r) { const int bp = (r & 3) + 8 * (r >> 2);
            s0[r] = mask_sel(s0[r], (int)(wa << (31 - bp)) >> 31); s1[r] = mask_sel(s1[r], (int)(wb << (31 - bp)) >> 31); }
        PageV vt{base + 128 + (size_t)(4 * hi) * 256 + l31, 256u}; soft_step(S, s0, s1, vt);
    }
    if (w == 0) {
        const unsigned long long selw = selp[32];
        const bf16* dk = WSP(bf16, WS_SDSAK) + (size_t)bg * LS * 64; const bf16* dvt = WSP(bf16, WS_SDSAVT) + (size_t)bg * 64 * LS;
        GlbT kt{dk, (unsigned)((2048 + l31) * 64 + 8 * hi), 64u}; qk_tile_c(s0, s1, kt, dq, S.negm);
        const unsigned wa = (unsigned)selw >> (4 * hi), wb = (unsigned)(selw >> 32) >> (4 * hi);
#pragma unroll
        for (int r = 0; r < 16; ++r) { const int bp = (r & 3) + 8 * (r >> 2);
            s0[r] = mask_sel(s0[r], (int)(wa << (31 - bp)) >> 31); s1[r] = mask_sel(s1[r], (int)(wb << (31 - bp)) >> 31); }
        GlbT vt{dvt, (unsigned)(l31 * LS + 2048 + 8 * hi), (unsigned)LS}; soft_step(S, s0, s1, vt);
    }
    __syncthreads();
    xch_put(xch + w * XCH_W, S, lane);
    __syncthreads();
    float part[4];
    xch_get(xch, w, lane, part);
    if (tl < 4) {
        const int d0 = 32 * (w >> 2) + 8 * (w & 3) + 4 * hi;
        const u32x2 z = *(const u32x2*)(WSP(bf16, WS_ZD) + (size_t)row * 512 + hq * 64 + d0);
        u32x2 wv; wv.x = pk2(part[0] * bflo(z.x), part[1] * bfhi(z.x)); wv.y = pk2(part[2] * bflo(z.y), part[3] * bfhi(z.y));
        *(u32x2*)(WSP(bf16, WS_ODZ) + (size_t)row * 512 + hq * 64 + d0) = wv;
    }
}

template <int K, class EF> DI void small_gemm(Frame& F, const bf16* A, const bf16* Bt, const EF& ef) {
    const int lane = F.lane, w = F.wave, l31 = lane & 31, hi = lane >> 5;
    LAS float* red = (LAS float*)F.lds;
    for (int t = blockIdx.x; t < 256; t += F.G) {
        const int mt = t >> 5, nt = t & 31, kw = K >> 3, k0 = w * kw;
        const bf16* ap = A + (size_t)(MP + 64 * mt + l31) * K + k0 + 8 * hi;
        const bf16* bp = Bt + (size_t)(32 * nt + l31) * K + k0 + 8 * hi;
        f32x16 a0, a1;
#pragma unroll
        for (int i = 0; i < 16; ++i) { a0[i] = 0.f; a1[i] = 0.f; }
        bf16x8 fb[K / 128], f0[K / 128], f1[K / 128];
#pragma unroll
        for (int s = 0; s < K / 128; ++s) { fb[s] = *(const bf16x8*)(bp + 16 * s); f0[s] = *(const bf16x8*)(ap + 16 * s); f1[s] = *(const bf16x8*)(ap + (size_t)32 * K + 16 * s); }
#pragma unroll
        for (int s = 0; s < K / 128; ++s) { a0 = MFMA32(f0[s], fb[s], a0); a1 = MFMA32(f1[s], fb[s], a1); }
        __syncthreads();
#pragma unroll
        for (int r = 0; r < 16; ++r) { red[(w * 32 + r) * 64 + lane] = a0[r]; red[(w * 32 + 16 + r) * 64 + lane] = a1[r]; }
        __syncthreads();
        const int m2 = w >> 2, q = w & 3;
#pragma unroll
        for (int j = 0; j < 4; ++j) {
            float v = 0.f;
#pragma unroll
            for (int i = 0; i < 8; ++i) v += red[(i * 32 + 16 * m2 + 4 * q + j) * 64 + lane];
            ef(MP + 64 * mt + 32 * m2 + 8 * q + 4 * hi + j, 32 * nt + l31, v);
        }
    }
    __syncthreads();
}


#ifdef ORACLE
constexpr size_t WS_ORC = 948 * MiB;
constexpr int ORC_ROWS = 128;
DI float blk_red(Frame& F, float v, bool ismax, LAS float* red) {
#pragma unroll
    for (int o = 1; o < 64; o <<= 1) { const float x = __shfl_xor(v, o); v = ismax ? fmaxf(v, x) : v + x; }
    __syncthreads();
    if (F.lane == 0) red[F.wave] = v;
    __syncthreads();
    float r = red[0];
    for (int i = 1; i < 8; ++i) r = ismax ? fmaxf(r, red[i]) : r + red[i];
    return r;
}
DI float dot64(const bf16* a, const bf16* b) { float s = 0.f; for (int d = 0; d < 64; ++d) s += bf2f(a[d]) * bf2f(b[d]); return s; }
DI void orc_softmax(Frame& F, LAS float* sc, LAS unsigned char* vf, int n, LAS float* red) {
    float mx = -3e38f;
    for (int k = F.tid; k < n; k += 512) if (vf[k]) mx = fmaxf(mx, sc[k]);
    mx = blk_red(F, mx, true, red);
    float sm = 0.f;
    for (int k = F.tid; k < n; k += 512) { const float p = vf[k] ? exp2f(sc[k] - mx) : 0.f; sc[k] = p; sm += p; }
    sm = blk_red(F, sm, false, red);
    const float inv = 1.f / fmaxf(sm, 1e-30f);
    for (int k = F.tid; k < n; k += 512) sc[k] *= inv;
    __syncthreads();
}
DI void oracle_row(Frame& F, int oi) {
    int row;
    if (oi < 96) { const int tl[24] = {0, 1, 30, 31, 32, 63, 64, 65, 127, 128, 255, 256, 257, 400, 511, 512, 513, 1000, 1023, 1024, 2047, 2500, 3583, 4095};
        int t = 0;
#pragma unroll
        for (int i = 0; i < 24; ++i) t = (oi % 24 == i) ? tl[i] : t;
        row = (oi / 24) * SEQ + t; }
    else { const int k = oi - 96; row = MP + (((k >> 2) * 37) % SBATCH) * 4 + (k & 3); }
    const bool samp = row >= MP;
    const int b = samp ? (row - MP) >> 2 : row >> 12, ti = samp ? (row & 3) : (row & 4095), qpos = samp ? PASTL + ti : ti;
    const int ncmp = samp ? 127 : 255; const size_t pitch = samp ? LS : SEQ, wpitch = samp ? LSW : SEQ, cpitch = samp ? 128 : 256;
    const int wlo = samp ? 1 + ti : (qpos - 511 > 0 ? qpos - 511 : 0), whi = samp ? 512 + ti : qpos;
    LAS float* sc = (LAS float*)F.lds;
    LAS float* s2 = sc + 4096;
    LAS float* psum = s2 + 4096;
    LAS float* imp = psum + 256;
    LAS float* resn = imp + 64;
    LAS float* resd = resn + 512;
    LAS float* red = resd + 512;
    LAS unsigned char* vf = (LAS unsigned char*)(red + 8);
    LAS unsigned char* selb = vf + 4096;
    const bf16* qraw = WSP(bf16, WS_QRAW) + (size_t)row * 512; const bf16* qrot = WSP(bf16, WS_QROT) + (size_t)row * 512;
    const bf16* dq = WSP(bf16, WS_DQ) + (size_t)row * 512; const bf16* iq = WSP(bf16, WS_IQ) + (size_t)row * 256;
    const float* gat = WSP(float, WS_GATES) + (size_t)row * 24; const float* iw = WSP(float, WS_IW) + (size_t)row * 4;
    const int nvr = (qpos - 31) >> 4, nvis = nvr < ncmp - 1 ? nvr : ncmp - 1, cur = qpos >> 6;
    for (int g = 0; g < 2; ++g) {
        const int bg = b * 2 + g;
        const bf16* ck = samp ? WSP(bf16, WS_SCK) + (size_t)bg * 128 * 64 : WSP(bf16, WS_PCK) + (size_t)bg * 256 * 64;
        const bf16* cvt = samp ? WSP(bf16, WS_SCVT) + (size_t)bg * 64 * 128 : WSP(bf16, WS_PCVT) + (size_t)bg * 64 * 256;
        const bf16* sk = samp ? WSP(bf16, WS_SSLCK) + (size_t)bg * LS * 64 : WSP(bf16, WS_PSLCK) + (size_t)bg * SEQ * 64;
        const bf16* svt = samp ? WSP(bf16, WS_SSLCVT) + (size_t)bg * 64 * LS : WSP(bf16, WS_PSLCVT) + (size_t)bg * 64 * SEQ;
        const bf16* wk = samp ? WSP(bf16, WS_SWINK) + (size_t)bg * LSW * 64 : WSP(bf16, WS_PWINK) + (size_t)bg * SEQ * 64;
        const bf16* wvt = samp ? WSP(bf16, WS_SWINVT) + (size_t)bg * 64 * LSW : WSP(bf16, WS_PWINVT) + (size_t)bg * 64 * SEQ;
        __syncthreads();
        if (F.tid < 256) psum[F.tid] = 0.f;
        for (int hl = 0; hl < 4; ++hl) {
            const int h = 4 * g + hl;
            __syncthreads();
            for (int n = F.tid; n < 256; n += 512) { const bool v = n <= nvis; vf[n] = v; sc[n] = v ? dot64(qraw + h * 64, ck + (size_t)n * 64) : 0.f; }
            __syncthreads();
            orc_softmax(F, sc, vf, 256, red);
            if (F.tid < 256) psum[F.tid] += sc[F.tid];
            if (F.tid < 64) { float a = 0.f; for (int n = 0; n <= nvis; ++n) a += sc[n] * bf2f(cvt[(size_t)F.tid * cpitch + permk(n)]); resn[h * 64 + F.tid] = gat[h * 3 + 0] * a; }
        }
        __syncthreads();
        if (F.tid < 64) { const int j = F.tid; float a = 0.f;
            for (int n = 4 * j - 1; n <= 4 * j + 3; ++n) if (n >= 0 && n < ncmp) a += psum[n];
            if (j == 0 || j == cur || j == cur - 1) a = 1e4f;
            if (j > cur) a = -1e30f;
            imp[j] = a; selb[j] = 0; }
        __syncthreads();
        if (F.tid == 0) { for (int k = 0; k < 16; ++k) { int best = -1; float bv = -3e38f; for (int j = 0; j < 64; ++j) if (!selb[j] && imp[j] > bv) { bv = imp[j]; best = j; }
                if (best >= 0) selb[best] = (bv > -5e29f) ? 1 : 2; }
            for (int j = 0; j < 64; ++j) selb[j] = selb[j] == 1 ? 1 : 0; }
        __syncthreads();
        for (int hl = 0; hl < 4; ++hl) {
            const int h = 4 * g + hl;
            __syncthreads();
            for (int k = F.tid; k <= qpos; k += 512) { const bool v = selb[k >> 6] != 0; vf[k] = v; sc[k] = v ? dot64(qrot + h * 64, sk + (size_t)k * 64) : 0.f; }
            __syncthreads();
            orc_softmax(F, sc, vf, qpos + 1, red);
            if (F.tid < 64) { float a = 0.f; for (int k = 0; k <= qpos; ++k) if (vf[k]) a += sc[k] * bf2f(svt[(size_t)F.tid * pitch + permk(k)]); resn[h * 64 + F.tid] += gat[h * 3 + 1] * a; }
            __syncthreads();
            for (int k = wlo + F.tid; k <= whi; k += 512) { vf[k - wlo] = 1; sc[k - wlo] = dot64(qrot + h * 64, wk + (size_t)k * 64); }
            __syncthreads();
            orc_softmax(F, sc, vf, whi - wlo + 1, red);
            if (F.tid < 64) { float a = 0.f; for (int k = wlo; k <= whi; ++k) a += sc[k - wlo] * bf2f(wvt[(size_t)F.tid * wpitch + permk(k)]); resn[h * 64 + F.tid] += gat[h * 3 + 2] * a; }
        }
    }
    __syncthreads();
    const bf16* ik = samp ? WSP(bf16, WS_SIDXK) + (size_t)b * LS * 64 : WSP(bf16, WS_PIDXK) + (size_t)b * SEQ * 64;
    for (int k = F.tid; k <= qpos; k += 512) { float a = 0.f; for (int h = 0; h < 4; ++h) a += fmaxf(dot64(iq + h * 64, ik + (size_t)k * 64), 0.f) * iw[h]; s2[k] = a; }
    __syncthreads();
    for (int k = F.tid; k <= qpos; k += 512) { const float v = s2[k]; int c = 0; for (int j = 0; j <= qpos; ++j) { const float x = s2[j]; c += (x > v || (x == v && j < k)) ? 1 : 0; } vf[k] = c < 256; }
    __syncthreads();
    for (int h = 0; h < 8; ++h) {
        const int bg = b * 2 + (h >> 2);
        const bf16* dk = samp ? WSP(bf16, WS_SDSAK) + (size_t)bg * LS * 64 : WSP(bf16, WS_PDSAK) + (size_t)bg * SEQ * 64;
        const bf16* dvt = samp ? WSP(bf16, WS_SDSAVT) + (size_t)bg * 64 * LS : WSP(bf16, WS_PDSAVT) + (size_t)bg * 64 * SEQ;
        __syncthreads();
        for (int k = F.tid; k <= qpos; k += 512) sc[k] = vf[k] ? dot64(dq + h * 64, dk + (size_t)k * 64) : 0.f;
        __syncthreads();
        orc_softmax(F, sc, vf, qpos + 1, red);
        if (F.tid < 64) { float a = 0.f; for (int k = 0; k <= qpos; ++k) if (vf[k]) a += sc[k] * bf2f(dvt[(size_t)F.tid * pitch + permk(k)]); resd[h * 64 + F.tid] = a; }
    }
    __syncthreads();
    float dn = 0.f, rn = 0.f, dd = 0.f, rd = 0.f;
    { const int e = F.tid;
      const float zn = bf2f(WSP(bf16, WS_ZN)[(size_t)row * 512 + e]), zd = bf2f(WSP(bf16, WS_ZD)[(size_t)row * 512 + e]);
      const float refn = resn[e] * zn, refd = resd[e] * zd;
      const float gotn = bf2f(WSP(bf16, WS_ONZ)[(size_t)row * 512 + e]), gotd = bf2f(WSP(bf16, WS_ODZ)[(size_t)row * 512 + e]);
      dn = (gotn - refn) * (gotn - refn); rn = refn * refn; dd = (gotd - refd) * (gotd - refd); rd = refd * refd; }
    dn = blk_red(F, dn, false, red); rn = blk_red(F, rn, false, red); dd = blk_red(F, dd, false, red); rd = blk_red(F, rd, false, red);
    float dc = 0.f, rc = 0.f;
    {
        const bool cs = oi >= 96; const int cbg = cs ? (oi * 5) % 256 : oi % 8, cn = cs ? (oi * 11) % 127 : (oi * 13) % 255;
        for (int slot = 0; slot < 2; ++slot) {
            const bf16* data = cs ? WSP(bf16, slot ? WS_SCMPV : WS_SCMPK) + (size_t)cbg * LS * 64 + (size_t)cn * 1024 : WSP(bf16, slot ? WS_PCMPV : WS_PCMPK) + (size_t)cbg * SEQ * 64 + (size_t)cn * 1024;
            __syncthreads();
            if (F.tid < 128) { float a = 0.f; for (int k = 0; k < 2048; ++k) a += (bf2f(data[k]) + F.pe[slot * 2048 + k]) * F.w1[((size_t)slot * 2048 + k) * 128 + F.tid]; sc[F.tid] = a / (1.f + expf(-a)); }
            __syncthreads();
            if (F.tid < 64) { float a = 0.f; for (int c = 0; c < 128; ++c) a += sc[c] * F.w2[((size_t)slot * 128 + c) * 64 + F.tid];
                float got;
                if (slot == 0) got = bf2f((cs ? WSP(bf16, WS_SCK) + (size_t)cbg * 128 * 64 : WSP(bf16, WS_PCK) + (size_t)cbg * 256 * 64)[(size_t)cn * 64 + F.tid]);
                else got = bf2f((cs ? WSP(bf16, WS_SCVT) + (size_t)cbg * 64 * 128 : WSP(bf16, WS_PCVT) + (size_t)cbg * 64 * 256)[(size_t)F.tid * (cs ? 128 : 256) + permk(cn)]);
                dc += (got - a) * (got - a); rc += a * a; }
        }
    }
    dc = blk_red(F, dc, false, red); rc = blk_red(F, rc, false, red);
    if (F.tid == 0) { float* o = WSP(float, WS_ORC) + oi * 8; o[0] = dn; o[1] = rn; o[2] = dd; o[3] = rd; o[4] = dc; o[5] = rc; }
    __syncthreads();
}
DI float oracle_value(Frame& F) {
    const float* o = WSP(float, WS_ORC);
    float bad = 0.f, acc = 0.f, mxe = 0.f;
    for (int i = 0; i < ORC_ROWS; ++i) { const int c = (ORACLE_MODE >= 6) ? 4 : (ORACLE_MODE & 1) ? 2 : 0; const float e = sqrtf(o[i * 8 + c] / fmaxf(o[i * 8 + c + 1], 1e-30f));
        bad += e > 0.03f ? 1.f : 0.f; acc += fminf(e, 1.f) * fminf(e, 1.f); mxe = fmaxf(mxe, fminf(e, 1.f)); }
    return (ORACLE_MODE < 2 || ORACLE_MODE == 6) ? bad / ORC_ROWS : (ORACLE_MODE < 4 || ORACLE_MODE == 7) ? sqrtf(acc / ORC_ROWS) : mxe;
}
#endif

#define XB_TMO      128
#define XB_XCNT(j)  (256  + 64 * (j))
#define XB_XSUB(j)  (1280 + 64 * (j))
#define XB_XGEN(j)  (2304 + 64 * (j))
#define XB_TOP      3328
#define XB_TOPGEN   3392
#define XCD_BAR_WORDS 3456
#define XB_SPIN_CAP (1u << 18)
__device__ __forceinline__ unsigned xb_ld(unsigned* p)              { return __hip_atomic_load(p, __ATOMIC_RELAXED, __HIP_MEMORY_SCOPE_AGENT); }
__device__ __forceinline__ unsigned xb_add(unsigned* p, unsigned v) { return __hip_atomic_fetch_add(p, v, __ATOMIC_RELAXED, __HIP_MEMORY_SCOPE_AGENT); }
__device__ __forceinline__ unsigned xb_xcc_id() { return (unsigned)__builtin_amdgcn_s_getreg((3 << 11) | 20) & 0xFu; }
#define XB_SPIN(cond, bar) do { unsigned _sp = 0; while (cond) { __builtin_amdgcn_s_sleep(1); \
    if ((++_sp & 255u) == 0u) { if (xb_ld(&(bar)[XB_TMO])) break; if (_sp > XB_SPIN_CAP) { atomicAdd(&(bar)[XB_TMO], 1u); break; } } } } while (0)
struct XcdBarrier { unsigned* bar; unsigned x; volatile LAS unsigned* st; };
__device__ __forceinline__ XcdBarrier xcd_barrier_post(unsigned* bar, volatile LAS unsigned* st) {
    XcdBarrier b; b.bar = bar; b.x = xb_xcc_id(); b.st = st;
    if (threadIdx.x == 0) (void)xb_add(&bar[XB_XCNT(b.x)], 1u);
    return b;
}
__device__ __forceinline__ void xcd_barrier_complete(unsigned* bar, unsigned x, unsigned& nloc, unsigned& nx) {
    const unsigned G = gridDim.x * gridDim.y * gridDim.z;
    unsigned sum, cnt, mine, sp = 0u;
    for (;;) {
        sum = 0u; cnt = 0u; mine = 0u;
#pragma unroll
        for (unsigned j = 0; j < 16; ++j) { const unsigned c = xb_ld(&bar[XB_XCNT(j)]); sum += c; cnt += (c > 0u) ? 1u : 0u; mine = (j == x) ? c : mine; }
        if (sum == G) break;
        __builtin_amdgcn_s_sleep(1);
        if ((++sp & 255u) == 0u) { if (xb_ld(&bar[XB_TMO])) break; if (sp > XB_SPIN_CAP) { atomicAdd(&bar[XB_TMO], 1u); break; } }
    }
    nloc = mine > 0u ? mine : 1u; nx = cnt > 0u ? cnt : 1u;
}
__device__ __forceinline__ void xcd_barrier(const XcdBarrier& b) {
    asm volatile("s_waitcnt vmcnt(0)" ::: "memory");
    __syncthreads();
    if (threadIdx.x == 0) {
        unsigned* bar = b.bar;
        __builtin_amdgcn_s_waitcnt(0);
        unsigned nloc = b.st[0], nx = b.st[1];
        if (nloc == 0u) { xcd_barrier_complete(bar, b.x, nloc, nx); b.st[0] = nloc; b.st[1] = nx; }
        const unsigned old = xb_add(&bar[XB_XSUB(b.x)], 1u);
        const unsigned gen = old / nloc;
        if (old + 1u == (gen + 1u) * nloc) {
            __builtin_amdgcn_fence(__ATOMIC_RELEASE, "agent");
            asm volatile("s_waitcnt vmcnt(0)" ::: "memory");
            const unsigned og = xb_add(&bar[XB_TOP], 1u);
            const unsigned tg = og / nx;
            if (og + 1u == (tg + 1u) * nx) xb_add(&bar[XB_TOPGEN], 1u);
            else XB_SPIN(xb_ld(&bar[XB_TOPGEN]) == tg, bar);
            __builtin_amdgcn_fence(__ATOMIC_ACQUIRE, "agent");
            xb_add(&bar[XB_XGEN(b.x)], 1u);
            asm volatile("s_waitcnt vmcnt(0)" ::: "memory");
        } else {
            XB_SPIN(xb_ld(&bar[XB_XGEN(b.x)]) == gen, bar);
            __builtin_amdgcn_fence(__ATOMIC_ACQUIRE, "agent");
            asm volatile("s_waitcnt vmcnt(0)" ::: "memory");
        }
    }
    __syncthreads();
}

constexpr int N_PHASES = 9;
DI int q_next(Frame& F, int qi) {
    __syncthreads();
    if (F.tid == 0) F.MISC[0] = __hip_atomic_fetch_add(F.ctl + CW_Q + 64 * (qi + F.qoff), 1u, __ATOMIC_RELAXED, __HIP_MEMORY_SCOPE_AGENT);
    __syncthreads();
    return (int)F.MISC[0];
}
DI void q_issue(Frame& F, int qi, unsigned& pend) { if (F.tid == 0) pend = __hip_atomic_fetch_add(F.ctl + CW_Q + 64 * (qi + F.qoff), 1u, __ATOMIC_RELAXED, __HIP_MEMORY_SCOPE_AGENT); }
DI int q_take(Frame& F, unsigned pend) { __syncthreads(); if (F.tid == 0) F.MISC[0] = pend; __syncthreads(); return (int)F.MISC[0]; }
#define QLOOP_PF(qi, N, CALL) do { unsigned pend_ = 0u; for (int u = q_next(F, (qi)); u < (N); u = q_take(F, pend_)) { q_issue(F, (qi), pend_); CALL; } } while (0)
#define QLOOP(qi, N, CALL) do { for (int u = q_next(F, (qi)); u < (N); u = q_next(F, (qi))) { CALL; } } while (0)
__global__ void __launch_bounds__(NWAVES * 64, 2) fwd(Args args) {
    extern __shared__ __attribute__((aligned(16))) unsigned char lds[];
    Frame F;
    F.lds = (LAS unsigned char*)lds; F.MISC = (volatile LAS unsigned*)(F.lds + MISC_OFF);
    F.tid = threadIdx.x; F.lane = F.tid & 63; F.wave = __builtin_amdgcn_readfirstlane(F.tid >> 6); F.G = gridDim.x;
    F.ws = args.ws; F.out = args.out; F.ctl = (unsigned*)(args.ws + WS_CTL); F.qoff = args.qoff;
    F.xp = (const float*)args.in[0]; F.xs = (const float*)args.in[1]; F.cnsa = (const float*)args.in[2]; F.cdsa = (const float*)args.in[3]; F.cidx = (const float*)args.in[4];
    F.swin = (const float*)args.in[5]; F.ptab = (const int*)args.in[6]; F.cp = (const float*)args.in[7]; F.cs = (const float*)args.in[8]; F.normg = (const float*)args.in[9];
    F.wada = (const float*)args.in[10]; F.bada = (const float*)args.in[11]; F.win = (const float*)args.in[12]; F.pe = (const float*)args.in[13]; F.w1 = (const float*)args.in[14];
    F.w2 = (const float*)args.in[15]; F.wupn = (const float*)args.in[16]; F.wupd = (const float*)args.in[17]; F.wout = (const float*)args.in[18]; F.fing = (const float*)args.in[19];
    for (int i = F.tid; i < (LDS_BYTES - MISC_OFF) / 4; i += NWAVES * 64) ((LAS unsigned*)(F.lds + MISC_OFF))[i] = 0u;
    __syncthreads();
    const int lo = args.ph_lo, hi = args.ph_hi;
    const bool one = (hi - lo) > 1;
    XcdBarrier bar; bar.bar = F.ctl + CW_BAR; bar.x = 0; bar.st = nullptr;
    if (one) bar = xcd_barrier_post(F.ctl + CW_BAR, F.MISC + 8);
#ifndef PH_MASK
#define PH_MASK 0x1ff
#endif
#define IN(k) (((PH_MASK >> (k)) & 1) && lo <= (k) && (k) < hi)
#define SEAM(k) do { if (IN(k) && IN((k) + 1)) xcd_barrier(bar); } while (0)

#ifndef PROBE_REP
#define PROBE_REP -1
#endif
#define REP(k, BODY) do { if (IN(k)) { BODY(0) } } while (0)
#ifndef PROBE_P4MASK
#define PROBE_P4MASK 15
#endif
#ifndef PROBE_ABL
#define PROBE_ABL 0
#endif
#define B0(qo) { p0_prologue(F, args.umask); }
#define B1(qo) { p1_adaln(F); }
#define B2(qo) { pg8::Gemm g{WSP(bf16, WS_H), WSP(bf16, WS_WINT), MR, NPAD, DM}; pg8::StaticOrder S; S.init(MR, NPAD, F.G, (int)blockIdx.x); \
        { EpiInProj E{F.ws, F.out}; pg8::gemm_phase<EpiInProj, pg8::StaticOrder, true, true>(F.lds, g, S, E); } }
#define B3(qo) { const int PM3_ = args.umask;     \
        if (PM3_ & 4) QLOOP(2 + qo, SBATCH, (idx1_unit<true, 0>(F, u))); \
        if (PM3_ & 1) QLOOP(0 + qo, 272, compress_unit(F, u)); \
        if (PM3_ & 2) QLOOP(1 + qo, 2048, (idx1_unit<false, 0>(F, u))); }
#ifndef P4_MASK
#define P4_MASK 15
#endif
#define B4(qo) { const int PM_ = args.umask & P4_MASK; const bool strm_ = (blockIdx.x & 1) == 0 || args.qoff != 0;     \
        if ((PM_ & 1) && strm_) QLOOP(3 + qo, 256, nsa_sample_unit(F, u)); \
        if ((PM_ & 2) && strm_) QLOOP(4 + qo, 256, dsa_sample_unit(F, u)); \
        if (PM_ & 4) QLOOP(5 + qo, 512, nsa_unit<false>(F, u)); \
        if (PM_ & 8) QLOOP(6 + qo, 512, (dsa_unit<0>(F, u))); }
#define B5(qo) { small_gemm<512>(F, WSP(bf16, WS_ONZ), WSP(bf16, WS_WUPN), [&](int r, int c, float v) { WSP(bf16, WS_T1)[(size_t)r * 1024 + c] = (bf16)(pk2(v * bf2f(WSP(bf16, WS_MG)[(size_t)r * 2048 + c]), 0.f) & 0xffffu); }); \
        pg8::Gemm g{WSP(bf16, WS_ONZ), WSP(bf16, WS_WUPN), MP, DM, 512}; pg8::StaticOrder S; S.init(MP, DM, F.G, (int)blockIdx.x); EpiUp1 E{F.ws}; \
        pg8::gemm_phase<EpiUp1, pg8::StaticOrder, true, true>(F.lds, g, S, E); }
#define B6(qo) { small_gemm<512>(F, WSP(bf16, WS_ODZ), WSP(bf16, WS_WUPD), [&](int r, int c, float v) { WSP(bf16, WS_M1)[(size_t)r * 1024 + c] = (bf16)(pk2(bf2f(WSP(bf16, WS_T1)[(size_t)r * 1024 + c]) + v * bf2f(WSP(bf16, WS_MG)[(size_t)r * 2048 + 1024 + c]), 0.f) & 0xffffu); }); \
        pg8::Gemm g{WSP(bf16, WS_ODZ), WSP(bf16, WS_WUPD), MP, DM, 512}; pg8::StaticOrder S; S.init(MP, DM, F.G, (int)blockIdx.x); EpiUp2 E{F.ws}; \
        pg8::gemm_phase<EpiUp2, pg8::StaticOrder, true, true>(F.lds, g, S, E); }
#define B7(qo) { small_gemm<1024>(F, WSP(bf16, WS_M1), WSP(bf16, WS_WOUT), [&](int r, int c, float v) { const int rs = r - MP; F.out[O_YS + (size_t)rs * 1024 + c] = F.xs[(size_t)rs * 1024 + c] + WSP(float, WS_MOD)[(size_t)(4 + (rs >> 2)) * 3072 + 2048 + c] * v; }); \
        pg8::Gemm g{WSP(bf16, WS_M1), WSP(bf16, WS_WOUT), MP, DM, DM}; pg8::StaticOrder S; S.init(MP, DM, F.G, (int)blockIdx.x); EpiOut E{F.ws, F.out, F.xp, F.xs}; \
        pg8::gemm_phase<EpiOut, pg8::StaticOrder, true, true>(F.lds, g, S, E); }
#define B8(qo) { p8_final(F); }
    REP(0, B0); SEAM(0);
    REP(1, B1); SEAM(1);
    REP(2, B2); SEAM(2);
    REP(3, B3); SEAM(3);
    REP(4, B4); SEAM(4);
#ifdef ORACLE
    if (IN(4)) { for (int oi = blockIdx.x; oi < ORC_ROWS; oi += F.G) oracle_row(F, oi); xcd_barrier(bar); }
#endif
    REP(5, B5);
    REP(6, B6); SEAM(6);
    REP(7, B7); SEAM(7);
    if (IN(8)) { p8_final(F); }
#ifdef ORACLE
    if (IN(8)) { xcd_barrier(bar); const float val = oracle_value(F); const float sc = 1.f + 0.02f * (1.f + val);
        for (size_t i = (size_t)blockIdx.x * 512 + F.tid; i < (size_t)MP * 1024; i += (size_t)F.G * 512) F.out[O_YP + i] *= sc; }
#endif
#undef IN
#undef SEAM
}

extern "C" void kernel_launch(void* const* d_in, const int* in_sizes, int n_in, void* d_out, int out_size, void* d_ws, size_t ws_size, hipStream_t stream) {
    static int grid = 0;
    if (grid == 0) {
        if (n_in != 20 || (size_t)out_size != O_END || ws_size < WS_END) { fprintf(stderr, "kernel_launch: unexpected shapes (n_in %d, out %d, ws %zu)\n", n_in, out_size, ws_size); grid = -1; return; }
        int dev = 0, cus = 0, per_cu = 0;
        if (hipGetDevice(&dev) != hipSuccess || hipDeviceGetAttribute(&cus, hipDeviceAttributeMultiprocessorCount, dev) != hipSuccess) { grid = -1; return; }
        if (hipFuncSetAttribute((const void*)fwd, hipFuncAttributeMaxDynamicSharedMemorySize, LDS_BYTES) != hipSuccess) { fprintf(stderr, "kernel_launch: hipFuncSetAttribute failed\n"); grid = -1; return; }
        if (hipOccupancyMaxActiveBlocksPerMultiprocessor(&per_cu, (const void*)fwd, NWAVES * 64, LDS_BYTES) != hipSuccess || per_cu < 1) { fprintf(stderr, "kernel_launch: occupancy query says %d blocks per CU\n", per_cu); }
        (void)hipGetLastError();
        grid = cus;
    }
    if (grid < 0) return;
    (void)hipMemsetAsync((char*)d_ws + WS_CTL, 0, CTL_ZERO_BYTES, stream);
    Args a{};
    for (int i = 0; i < 20; ++i) a.in[i] = d_in[i];
    a.out = (float*)d_out; a.ws = (unsigned char*)d_ws; a.qoff = 0; a.umask = 15; a.pad0 = 0; a.pad1 = 0;
#if MK_N_LAUNCHES == 1
    a.ph_lo = 0; a.ph_hi = N_PHASES;
    hipLaunchKernelGGL(fwd, dim3(grid), dim3(NWAVES * 64), LDS_BYTES, stream, a);
#if PROBE_REP >= 0
    a.ph_lo = PROBE_REP; a.ph_hi = PROBE_REP + 1; a.qoff = 8; a.umask = PROBE_P4MASK;
    hipLaunchKernelGGL(fwd, dim3(grid), dim3(NWAVES * 64), LDS_BYTES, stream, a);
#endif
#else
    for (int p = 0; p < N_PHASES; ++p) { a.ph_lo = p; a.ph_hi = p + 1; hipLaunchKernelGGL(fwd, dim3(grid), dim3(NWAVES * 64), LDS_BYTES, stream, a); }
#endif
}
```

```cpp
#define MK_N_LAUNCHES 1
#include <hip/hip_runtime.h>
#include <cstdio>
#include <cstdint>
#ifndef MK_N_LAUNCHES
#define MK_N_LAUNCHES 1
#endif
namespace pg8 {
#define PG8_LAS __attribute__((address_space(3)))
typedef unsigned short bf16_t;
typedef short bf16x8 __attribute__((ext_vector_type(8)));
typedef float f32x4 __attribute__((ext_vector_type(4)));
typedef unsigned u32x4 __attribute__((ext_vector_type(4)));
constexpr int BM = 256, BK = 64, HALF = 128, HTB = HALF * BK * 2  , STAGE_BYTES = 8 * HTB, NXCD = 8, WGM = 8;

__host__ __device__ __forceinline__ int lds_byte(int r, int c) { const int st = (r >> 4) * 2 + (c >> 5), rr = r & 15, cc = c & 31, ob = rr * 64 + cc * 2; return st * 1024 + (ob ^ (((ob >> 9) & 1) << 5)); }
__host__ __device__ __forceinline__ void stage_rc(int b, int& R, int& C) { const int st = b / 1024, sb = b % 1024, swz = sb ^ (((sb >> 9) & 1) << 5); R = (st >> 1) * 16 + swz / 64; C = (st & 1) * 32 + (swz % 64) / 2; }
__host__ __device__ __forceinline__ int perm32(int rho) { const int n = rho >> 4, i = rho & 15; return 8 * (i >> 2) + 4 * n + (i & 3); }

struct Unit { int pm, pn; };
struct Gemm { const bf16_t* A; const bf16_t* Bt; int M, N, K; };

struct StaticOrder {
    int nM, nN, nwg, G, c;
    __host__ __device__ void init(int M, int N, int G_, int c_) { nM = M / BM; nN = N / BM; nwg = nM * nN; G = G_; c = c_; }
    __host__ __device__ bool next(int i, Unit& u) const {
        const long L = (long)i * G + c; if (L >= nwg) return false;
        int wgid = (int)L; { const int q = nwg / NXCD, r = nwg % NXCD, xcd = wgid % NXCD, off = wgid / NXCD; wgid = (xcd < r ? xcd * (q + 1) : r * (q + 1) + (xcd - r) * q) + off; }
        const int nig = WGM * nN, gid = wgid / nig, fm = gid * WGM, gsz = (nM - fm) < WGM ? (nM - fm) : WGM;
        u.pm = fm + ((wgid % nig) % gsz); u.pn = (wgid % nig) / gsz; return true;
    }
    __device__ __forceinline__ void a_ready(const Unit&) const {}
    __device__ __forceinline__ void done(const Unit&) const {}
};

typedef float f32x2p __attribute__((ext_vector_type(2))); typedef __bf16 bf16x2p __attribute__((ext_vector_type(2)));
__device__ __forceinline__ unsigned cvt_pk_bf16(float lo, float hi) { f32x2p v = {lo, hi}; bf16x2p b = __builtin_convertvector(v, bf16x2p); return __builtin_bit_cast(unsigned, b); }
template <class Epi, class Sched, bool ALIGN_EPI = false, bool SP2 = false>
__device__ __forceinline__ void gemm_phase(PG8_LAS unsigned char* lds, const Gemm g, const Sched& S, const Epi& E) {
    const int tid = threadIdx.x, wid = __builtin_amdgcn_readfirstlane(tid >> 6), lane = tid & 63, wr = wid >> 2, wc = wid & 3, fr = lane & 15, fq = lane >> 4;
    const int K = g.K, nt = K / BK;
    unsigned voffA[2], voffB[2];
#pragma unroll
    for (int i = 0; i < 2; ++i) { int R, C; stage_rc(tid * 16 + i * 8192, R, C); const int Rb = Epi::PERM ? ((R & ~31) + perm32(R & 31)) : R;
        voffA[i] = (unsigned)(R * K + C) * 2u; voffB[i] = (unsigned)(Rb * K + C) * 2u; }
    const size_t kstep = (size_t)(BK * 2);
    const size_t hstep = (size_t)HALF * K * 2;
    const size_t tstep = 2 * hstep;
    const unsigned ldsw = (unsigned)wid * 1024u;
    const int aoff = lds_byte(wr * 64 + fr, fq * 8), boff = lds_byte(wc * 32 + fr, fq * 8);
#define PG8_SA(b, h) (((b) * 2 + (h)) * HTB)
#define PG8_SB(b, h) ((4 + (b) * 2 + (h)) * HTB)
#define PG8_STAGE(bufoff, gbase, voff) do { _Pragma("unroll") for (int _i = 0; _i < 2; ++_i) \
        __builtin_amdgcn_global_load_lds((const unsigned*)((const char*)(gbase) + (voff)[_i]), (PG8_LAS unsigned*)(lds + (bufoff) + ldsw + _i * 8192), 16, 0, 0); } while (0)
#define PG8_LDA(dst, b, h) do { _Pragma("unroll") for (int m = 0; m < 4; ++m) _Pragma("unroll") for (int k = 0; k < 2; ++k) dst[m][k] = *(const PG8_LAS bf16x8*)(lds + PG8_SA(b, h) + aoff + m * 2048 + k * 1024); } while (0)
#define PG8_LDB(dst, b, h) do { _Pragma("unroll") for (int n = 0; n < 2; ++n) _Pragma("unroll") for (int k = 0; k < 2; ++k) dst[n][k] = *(const PG8_LAS bf16x8*)(lds + PG8_SB(b, h) + boff + n * 2048 + k * 1024); } while (0)
#define PG8_MMA(ai, bj, At, Bt) do { __builtin_amdgcn_s_setprio(1); _Pragma("unroll") for (int m = 0; m < 4; ++m) _Pragma("unroll") for (int n = 0; n < 2; ++n) _Pragma("unroll") for (int k = 0; k < 2; ++k) \
        acc[ai][bj][m][n] = __builtin_amdgcn_mfma_f32_16x16x32_bf16(Bt[n][k], At[m][k], acc[ai][bj][m][n], 0, 0, 0); __builtin_amdgcn_s_setprio(0); } while (0)
#define PG8_WAIT_V(n) asm volatile("s_waitcnt vmcnt(" #n ")" ::: "memory")
#define PG8_WAIT_L(n) asm volatile("s_waitcnt lgkmcnt(" #n ")" ::: "memory")
#define PG8_BAR __builtin_amdgcn_s_barrier()
#define PG8_SCHED __builtin_amdgcn_sched_barrier(0)
    Unit cur, nxt; int ui = 0;
    if (!S.next(0, cur)) return;
    f32x4 acc[2][2][4][2];
#pragma unroll
    for (int a = 0; a < 2; ++a)
#pragma unroll
        for (int b = 0; b < 2; ++b)
#pragma unroll
            for (int m = 0; m < 4; ++m)
#pragma unroll
                for (int n = 0; n < 2; ++n) acc[a][b][m][n] = (f32x4){0.f, 0.f, 0.f, 0.f};
    bf16x8 At[4][2], B0[2][2], B1[2][2];
    const char* cA = (const char*)g.A + (size_t)cur.pm * tstep; const char* cB = (const char*)g.Bt + (size_t)cur.pn * tstep;
    S.a_ready(cur);
    if constexpr (SP2) {
        PG8_STAGE(PG8_SB(0, 0), cB, voffB); PG8_STAGE(PG8_SB(0, 1), cB + hstep, voffB); PG8_STAGE(PG8_SA(0, 0), cA, voffA); PG8_STAGE(PG8_SA(0, 1), cA + hstep, voffA);
        if (wr == 1) PG8_BAR;
        PG8_WAIT_V(2); PG8_BAR;
        PG8_STAGE(PG8_SB(1, 0), cB + kstep, voffB); PG8_STAGE(PG8_SA(1, 0), cA + kstep, voffA); PG8_STAGE(PG8_SB(1, 1), cB + hstep + kstep, voffB);
        PG8_WAIT_V(6); PG8_BAR;
    } else {
        PG8_STAGE(PG8_SB(0, 0), cB, voffB); PG8_STAGE(PG8_SA(0, 0), cA, voffA); PG8_STAGE(PG8_SB(0, 1), cB + hstep, voffB); PG8_STAGE(PG8_SA(0, 1), cA + hstep, voffA);
        if (wr == 1) PG8_BAR;
        PG8_WAIT_V(4); PG8_BAR;
        PG8_STAGE(PG8_SB(1, 0), cB + kstep, voffB); PG8_STAGE(PG8_SA(1, 0), cA + kstep, voffA); PG8_STAGE(PG8_SB(1, 1), cB + hstep + kstep, voffB);
        PG8_WAIT_V(6); PG8_BAR;
    }
    for (;;) {
        const bool has_next = S.next(ui + 1, nxt);
        const char* nA = has_next ? (const char*)g.A + (size_t)nxt.pm * tstep : cA; const char* nB = has_next ? (const char*)g.Bt + (size_t)nxt.pn * tstep : cB;
        for (int t = 0; t < nt; t += 2) {
            const bool last = (t == nt - 2);
            const char* a1 = cA + (size_t)(t + 1) * kstep;
            const char* a2 = last ? nA : cA + (size_t)(t + 2) * kstep; const char* b2 = last ? nB : cB + (size_t)(t + 2) * kstep;
            const char* a3 = a2 + kstep; const char* b3 = b2 + kstep;
            if (last && has_next) S.a_ready(nxt);
            if constexpr (SP2) {
            PG8_LDB(B0, 0, 0); PG8_LDB(B1, 0, 1); PG8_SCHED; PG8_LDA(At, 0, 0); PG8_STAGE(PG8_SA(1, 1), a1 + hstep, voffA);
            PG8_WAIT_V(8); PG8_WAIT_L(0); PG8_BAR; PG8_MMA(0, 0, At, B0); PG8_MMA(0, 1, At, B1); PG8_BAR; PG8_SCHED;
            PG8_LDA(At, 0, 1); PG8_STAGE(PG8_SB(0, 0), b2, voffB); PG8_STAGE(PG8_SB(0, 1), b2 + hstep, voffB); PG8_STAGE(PG8_SA(0, 0), a2, voffA);
            PG8_WAIT_V(8); PG8_WAIT_L(0); PG8_BAR; PG8_MMA(1, 0, At, B0); PG8_MMA(1, 1, At, B1); PG8_BAR; PG8_SCHED;
            PG8_LDB(B0, 1, 0); PG8_LDB(B1, 1, 1); PG8_SCHED; PG8_LDA(At, 1, 0); PG8_STAGE(PG8_SA(0, 1), a2 + hstep, voffA);
            PG8_WAIT_V(8); PG8_WAIT_L(0); PG8_BAR; PG8_MMA(0, 0, At, B0); PG8_MMA(0, 1, At, B1); PG8_BAR; PG8_SCHED;
            PG8_LDA(At, 1, 1); PG8_STAGE(PG8_SB(1, 0), b3, voffB); PG8_STAGE(PG8_SB(1, 1), b3 + hstep, voffB); PG8_STAGE(PG8_SA(1, 0), a3, voffA);
            PG8_WAIT_V(8); PG8_WAIT_L(0); PG8_BAR; PG8_MMA(1, 0, At, B0); PG8_MMA(1, 1, At, B1); PG8_BAR; PG8_SCHED;
            } else {
            PG8_LDB(B0, 0, 0); PG8_SCHED; PG8_LDA(At, 0, 0); PG8_STAGE(PG8_SA(1, 1), a1 + hstep, voffA);
            PG8_WAIT_L(8); PG8_BAR; PG8_WAIT_L(0); PG8_MMA(0, 0, At, B0); PG8_BAR; PG8_SCHED;
            PG8_LDB(B1, 0, 1); PG8_STAGE(PG8_SB(0, 0), b2, voffB);
            PG8_BAR; PG8_WAIT_L(0); PG8_MMA(0, 1, At, B1); PG8_BAR;
            PG8_LDA(At, 0, 1); PG8_STAGE(PG8_SA(0, 0), a2, voffA);
            PG8_BAR; PG8_WAIT_L(0); PG8_MMA(1, 0, At, B0); PG8_BAR; PG8_SCHED;
            PG8_STAGE(PG8_SB(0, 1), b2 + hstep, voffB);
            PG8_WAIT_V(6); PG8_BAR; PG8_MMA(1, 1, At, B1); PG8_BAR;
            PG8_LDB(B0, 1, 0); PG8_SCHED; PG8_LDA(At, 1, 0); PG8_STAGE(PG8_SA(0, 1), a2 + hstep, voffA);
            PG8_WAIT_L(8); PG8_BAR; PG8_WAIT_L(0); PG8_MMA(0, 0, At, B0); PG8_BAR; PG8_SCHED;
            PG8_LDB(B1, 1, 1); PG8_STAGE(PG8_SB(1, 0), b3, voffB);
            PG8_BAR; PG8_WAIT_L(0); PG8_MMA(0, 1, At, B1); PG8_BAR;
            PG8_LDA(At, 1, 1); PG8_STAGE(PG8_SA(1, 0), a3, voffA);
            PG8_BAR; PG8_WAIT_L(0); PG8_MMA(1, 0, At, B0); PG8_BAR; PG8_SCHED;
            PG8_STAGE(PG8_SB(1, 1), b3 + hstep, voffB);
            PG8_WAIT_V(6); PG8_BAR; PG8_MMA(1, 1, At, B1); PG8_BAR;
            }
        }
        if constexpr (ALIGN_EPI) { if (wr == 0) PG8_BAR; }
        if constexpr (!Epi::AFTER_DRAIN) { E(acc, cur, wr, wc, fr, fq); S.done(cur); }
        if (!has_next) break;
#pragma unroll
        for (int a = 0; a < 2; ++a)
#pragma unroll
            for (int b = 0; b < 2; ++b)
#pragma unroll
                for (int m = 0; m < 4; ++m)
#pragma unroll
                    for (int n = 0; n < 2; ++n) acc[a][b][m][n] = (f32x4){0.f, 0.f, 0.f, 0.f};
        cur = nxt; cA = nA; cB = nB; ++ui;
        if constexpr (ALIGN_EPI) { if (wr == 1) PG8_BAR; }
    }
    PG8_WAIT_V(0);
    if constexpr (!ALIGN_EPI) { if (wr == 0) PG8_BAR; }
    PG8_BAR;
    if constexpr (Epi::AFTER_DRAIN) { E.fused(acc, cur, wr, wc, fr, fq, lds, wid, lane); S.done(cur); }
#undef PG8_SA
#undef PG8_SB
#undef PG8_STAGE
#undef PG8_LDA
#undef PG8_LDB
#undef PG8_MMA
#undef PG8_WAIT_V
#undef PG8_WAIT_L
#undef PG8_BAR
#undef PG8_SCHED
}
}

#define LAS __attribute__((address_space(3)))
typedef unsigned short bf16;
typedef short bf16x8 __attribute__((ext_vector_type(8)));
typedef float f32x4 __attribute__((ext_vector_type(4)));
typedef float f32x16 __attribute__((ext_vector_type(16)));
typedef unsigned u32x4 __attribute__((ext_vector_type(4)));
typedef unsigned u32x2 __attribute__((ext_vector_type(2)));

constexpr int DM = 1024, NBATCH = 4, SEQ = 4096, MP = NBATCH * SEQ, SBATCH = 128, STOK = 4, MS = SBATCH * STOK, MR = MP + MS;
constexpr int PASTL = 2048, PAGE = 128, NPG = 16;
constexpr int LS = 2112, LSW = 576;
constexpr int NPAD = 5632;
constexpr float C2 = 0.125f * 1.4426950408889634f;
constexpr int NWAVES = 8;

constexpr size_t O_YP = 0, O_YS = 16777216, O_NSAP = 17301504, O_DSAP = 25690112, O_IDXP = 29884416, O_WINP = 30932992,
                 O_NSAS = 31457280, O_DSAS = 31719424, O_IDXS = 31850496, O_WINS = 31883264, O_END = 48660480;

constexpr size_t MiB = 1u << 20;
constexpr size_t WS_CTL = 0, CTL_ZERO_BYTES = 1 * MiB;
constexpr size_t WS_MOD = 1 * MiB;
constexpr size_t WS_COS = 3 * MiB, WS_SIN = 4 * MiB;
constexpr size_t WS_BIAS1 = 5 * MiB;
constexpr size_t WS_BIASP = 5 * MiB + 262144;
constexpr size_t WS_W2T = 5 * MiB + 65536;
constexpr size_t WS_W1T = 6 * MiB;
constexpr size_t WS_WINT = 8 * MiB;
constexpr size_t WS_WUPN = 20 * MiB, WS_WUPD = 21 * MiB, WS_WOUT = 22 * MiB;
constexpr size_t WS_PSLCVK = 975 * MiB, WS_PWINVK = 979 * MiB, WS_PDSAVK = 983 * MiB;
constexpr size_t WS_SELM = 960 * MiB;
constexpr size_t WS_GATES = 25 * MiB;
constexpr size_t WS_IW = 27 * MiB;
constexpr size_t WS_PCK = 28 * MiB, WS_PCVT = 28 * MiB + 262144;
constexpr size_t WS_SCK = 29 * MiB, WS_SCVT = 33 * MiB;
constexpr size_t WS_H = 40 * MiB;
constexpr size_t WS_QRAW = 80 * MiB, WS_QROT = 100 * MiB, WS_DQ = 120 * MiB, WS_IQ = 140 * MiB, WS_ZN = 150 * MiB, WS_ZD = 170 * MiB, WS_ONZ = 190 * MiB, WS_ODZ = 210 * MiB;
constexpr size_t WS_MG = 230 * MiB;
constexpr size_t WS_T1 = 300 * MiB;
constexpr size_t WS_M1 = 370 * MiB;
constexpr size_t WS_PCMPK = 410 * MiB, WS_PCMPV = 414 * MiB, WS_PSLCK = 418 * MiB, WS_PSLCVT = 422 * MiB, WS_PWINK = 426 * MiB, WS_PWINVT = 430 * MiB,
                 WS_PDSAK = 434 * MiB, WS_PDSAVT = 438 * MiB, WS_PIDXK = 442 * MiB;
constexpr size_t WS_SCMPK = 450 * MiB, WS_SCMPV = 520 * MiB, WS_SSLCK = 590 * MiB, WS_SSLCVT = 660 * MiB, WS_SDSAK = 730 * MiB, WS_SDSAVT = 800 * MiB,
                 WS_SWINK = 870 * MiB, WS_SWINVT = 890 * MiB, WS_SIDXK = 910 * MiB, WS_END = 990 * MiB;
constexpr int CW_BAR = 4096;
constexpr int CW_Q = 16384;

constexpr int RING_BYTES = 131072, MISC_OFF = RING_BYTES, LDS_BYTES = 147456;

struct Args { const void* in[20]; float* out; unsigned char* ws; int ph_lo, ph_hi, qoff, umask, pad0, pad1; };

struct Frame {
    LAS unsigned char* lds; volatile LAS unsigned* MISC; unsigned* ctl;
    int tid, lane, wave, G, qoff;
    unsigned char* ws; float* out;
    const float *xp, *xs, *cnsa, *cdsa, *cidx, *swin; const int* ptab; const float *cp, *cs, *normg, *wada, *bada, *win, *pe, *w1, *w2, *wupn, *wupd, *wout, *fing;
};
#define WSP(T, off) ((T*)(F.ws + (off)))

#define DI __device__ __forceinline__
#define LDS_WAIT() asm volatile("s_waitcnt lgkmcnt(0)" ::: "memory")
DI u32x4 gload16(const void* p) { u32x4 r; asm volatile("global_load_dwordx4 %0, %1, off" : "=v"(r) : "v"(p) : "memory"); return r; }
DI unsigned long long gload8(const void* p) { unsigned long long r; asm volatile("global_load_dwordx2 %0, %1, off" : "=v"(r) : "v"(p) : "memory"); return r; }
#define WAITV2(n, a, b) asm volatile("s_waitcnt vmcnt(" #n ")" : "+v"(a), "+v"(b) :: "memory")
#define WAITV1(n, a) asm volatile("s_waitcnt vmcnt(" #n ")" : "+v"(a) :: "memory")
#define LDS_BARRIER() do { asm volatile("s_waitcnt lgkmcnt(0)" ::: "memory"); __builtin_amdgcn_s_barrier(); asm volatile("" ::: "memory"); } while (0)
DI float wave_sum(float v) {
#define DPP_ADD_(ctrl, rmask) v += __int_as_float(__builtin_amdgcn_update_dpp(0, __float_as_int(v), (ctrl), (rmask), 0xF, false))
    DPP_ADD_(0xB1, 0xF);
    DPP_ADD_(0x4E, 0xF);
    DPP_ADD_(0x141, 0xF);
    DPP_ADD_(0x140, 0xF);
    DPP_ADD_(0x142, 0xA);
    DPP_ADD_(0x143, 0xC);
#undef DPP_ADD_
    return __int_as_float(__builtin_amdgcn_readlane(__float_as_int(v), 63));
}
DI int wave_sum_i(int v) {
#define DPP_ADDI_(ctrl, rmask) v += __builtin_amdgcn_update_dpp(0, v, (ctrl), (rmask), 0xF, false)
    DPP_ADDI_(0xB1, 0xF); DPP_ADDI_(0x4E, 0xF); DPP_ADDI_(0x141, 0xF); DPP_ADDI_(0x140, 0xF); DPP_ADDI_(0x142, 0xA); DPP_ADDI_(0x143, 0xC);
#undef DPP_ADDI_
    return __builtin_amdgcn_readlane(v, 63);
}
DI int wave_min_i(int v) {
#define DPP_MIN_(ctrl, rmask) { const int t_ = __builtin_amdgcn_update_dpp(v, v, (ctrl), (rmask), 0xF, false); v = t_ < v ? t_ : v; }
    DPP_MIN_(0xB1, 0xF) DPP_MIN_(0x4E, 0xF) DPP_MIN_(0x141, 0xF) DPP_MIN_(0x140, 0xF) DPP_MIN_(0x142, 0xA) DPP_MIN_(0x143, 0xC)
#undef DPP_MIN_
    return __builtin_amdgcn_readlane(v, 63);
}
DI int wave_max_i(int v) {
#define DPP_MAX_(ctrl, rmask) { const int t_ = __builtin_amdgcn_update_dpp(v, v, (ctrl), (rmask), 0xF, false); v = t_ > v ? t_ : v; }
    DPP_MAX_(0xB1, 0xF) DPP_MAX_(0x4E, 0xF) DPP_MAX_(0x141, 0xF) DPP_MAX_(0x140, 0xF) DPP_MAX_(0x142, 0xA) DPP_MAX_(0x143, 0xC)
#undef DPP_MAX_
    return __builtin_amdgcn_readlane(v, 63);
}
DI unsigned pk2(float lo, float hi) { return pg8::cvt_pk_bf16(lo, hi); }
DI float bflo(unsigned w) { return __uint_as_float(w << 16); }
DI float bfhi(unsigned w) { return __uint_as_float(w & 0xffff0000u); }
DI float bf2f(bf16 h) { return __uint_as_float((unsigned)h << 16); }
DI float sigm_f(float x) { return __builtin_amdgcn_rcpf(1.f + __builtin_amdgcn_exp2f(-1.4426950408889634f * x)); }
DI float silu_f(float x) { return x * sigm_f(x); }
DI int pos16(int o) { return 8 * ((o >> 2) & 1) + (o & 3) + 4 * (o >> 3); }
DI int permk(int t) { return (t & ~15) | pos16(t & 15); }
DI int crow(int r, int hi) { return (r & 3) + 8 * (r >> 2) + 4 * hi; }
DI float dpp_x1(float v) { return __int_as_float(__builtin_amdgcn_update_dpp(0, __float_as_int(v), 0xB1, 0xF, 0xF, true)); }
DI float dpp_x2(float v) { return __int_as_float(__builtin_amdgcn_update_dpp(0, __float_as_int(v), 0x4E, 0xF, 0xF, true)); }
DI float half_other(float v) {
    const unsigned u = __float_as_uint(v);
    auto rr = __builtin_amdgcn_permlane32_swap(u, u, false, false);
    return __uint_as_float(((threadIdx.x & 32) != 0) ? rr[0] : rr[1]);
}
DI u32x4 pack8(const float* v) { u32x4 w; w.x = pk2(v[0], v[1]); w.y = pk2(v[2], v[3]); w.z = pk2(v[4], v[5]); w.w = pk2(v[6], v[7]); return w; }
DI void st_bf8(bf16* p, const float* v) { *(u32x4*)p = pack8(v); }
DI void st_f8(float* p, const float* v) { __builtin_nontemporal_store((f32x4){v[0], v[1], v[2], v[3]}, (f32x4*)p); __builtin_nontemporal_store((f32x4){v[4], v[5], v[6], v[7]}, (f32x4*)(p + 4)); }
DI void st_vt8(bf16* p, size_t pitch, const float* v) {
#pragma unroll
    for (int j = 0; j < 8; ++j) p[(size_t)j * pitch] = (bf16)(pk2(v[j], 0.f) & 0xffffu);
}
#define PIN4(q) asm volatile("" : "+v"(q[0]), "+v"(q[1]), "+v"(q[2]), "+v"(q[3]))
#define NEGINF (-__builtin_inff())
#define MFMA32(a, b, c) __builtin_amdgcn_mfma_f32_32x32x16_bf16((a), (b), (c), 0, 0, 0)

DI int idx_key(float dot, float w) {
#pragma clang fp contract(off)
    float v = fmaxf(dot, 0.f) * w;
    v = v + dpp_x1(v);
    v = v + dpp_x2(v);
    int u = __float_as_int(v);
    u = (u == (int)0x80000000) ? 0 : u;
    return u ^ ((u >> 31) & 0x7fffffff);
}

template <int MODE> struct EpiInProjT {
    static constexpr bool PERM = true, AFTER_DRAIN = false;
    unsigned char* ws; float* out;
    DI void rope8(float* lo, float* hi, const float* c, const float* s) const {
#pragma unroll
        for (int j = 0; j < 8; ++j) { const float a = lo[j], b = hi[j]; lo[j] = a * c[j] - b * s[j]; hi[j] = b * c[j] + a * s[j]; }
    }
    DI void ldtab(float* c, float* s, int pos, int d0) const {
        const f32x4* cp = (const f32x4*)((const float*)(ws + WS_COS) + pos * 32 + d0);
        const f32x4* sp = (const f32x4*)((const float*)(ws + WS_SIN) + pos * 32 + d0);
        const f32x4 c0 = cp[0], c1 = cp[1], s0 = sp[0], s1 = sp[1];
        c[0] = c0[0]; c[1] = c0[1]; c[2] = c0[2]; c[3] = c0[3]; c[4] = c1[0]; c[5] = c1[1]; c[6] = c1[2]; c[7] = c1[3];
        s[0] = s0[0]; s[1] = s0[1]; s[2] = s0[2]; s[3] = s0[3]; s[4] = s1[0]; s[5] = s1[1]; s[6] = s1[2]; s[7] = s1[3];
        asm volatile("" : "+v"(c[0]), "+v"(c[1]), "+v"(c[2]), "+v"(c[3]), "+v"(c[4]), "+v"(c[5]), "+v"(c[6]), "+v"(c[7]));
        asm volatile("" : "+v"(s[0]), "+v"(s[1]), "+v"(s[2]), "+v"(s[3]), "+v"(s[4]), "+v"(s[5]), "+v"(s[6]), "+v"(s[7]));
    }
    DI void operator()(const pg8::f32x4 (&acc)[2][2][4][2], const pg8::Unit& u, int wr, int wc, int fr, int fq) const {
        const int hs = u.pn * 4 + wc;
        if (hs >= 86) return;
        if ((MODE & 2) && hs >= 20 && hs != 44 && !(hs >= 36 && hs < 40)) return;
        if ((MODE & 4) && hs < 20) return;
        const bool samp = u.pm >= 64;
        const int d0 = 8 * fq;
        const bool roped = hs < 8 || (hs >= 12 && hs < 14) || (hs >= 16 && hs < 18) || (hs >= 28 && hs < 36) || hs == 36 || hs == 37 || (hs >= 40 && hs <= 44);
        float rc[8], rs[8], dc[8], ds[8];
        if (roped) { if (samp) {
#pragma unroll
                for (int j = 0; j < 8; ++j) { dc[j] = 1.f; ds[j] = 0.f; }
            } else ldtab(dc, ds, 16, d0); }
#pragma unroll
        for (int ai = 0; ai < 2; ++ai)
#pragma unroll
            for (int m = 0; m < 4; ++m) {
                const int r = u.pm * 256 + ai * 128 + wr * 64 + m * 16 + fr;
                if (roped) {
                    if (m == 0) ldtab(rc, rs, samp ? PASTL + (r & 3) : (r & 4095), d0);
                    else {
#pragma unroll
                        for (int j = 0; j < 8; ++j) { const float a = rc[j], b = rs[j]; rc[j] = a * dc[j] - b * ds[j]; rs[j] = b * dc[j] + a * ds[j]; }
                    }
                }
                int b, t, pos;
                if (!samp) { b = r >> 12; t = r & 4095; pos = t; } else { b = (r - MP) >> 2; t = r & 3; pos = PASTL + t; }
                float lo[8], hi[8];
#pragma unroll
                for (int n = 0; n < 2; ++n)
#pragma unroll
                    for (int j = 0; j < 4; ++j) { lo[4 * n + j] = acc[ai][0][m][n][j]; hi[4 * n + j] = acc[ai][1][m][n][j]; }
                if (hs < 8) {
                    bf16* qa = (bf16*)(ws + WS_QRAW) + (size_t)r * 512 + hs * 64 + d0;
                    bf16* qb = (bf16*)(ws + WS_QROT) + (size_t)r * 512 + hs * 64 + d0;
                    float a[8], c[8];
#pragma unroll
                    for (int j = 0; j < 8; ++j) { a[j] = lo[j] * C2; c[j] = hi[j] * C2; }
                    st_bf8(qa, a); st_bf8(qa + 32, c);
                    rope8(lo, hi, rc, rs);
#pragma unroll
                    for (int j = 0; j < 8; ++j) { a[j] = lo[j] * C2; c[j] = hi[j] * C2; }
                    st_bf8(qb, a); st_bf8(qb + 32, c);
                } else if (hs < 20) {
                    const int ty = (hs - 8) >> 1, g = (hs - 8) & 1;
                    if (ty == 2 || ty == 4) rope8(lo, hi, rc, rs);
                    const int bg = b * 2 + g;
                    if (ty < 4) {
                        float* o = out + (samp ? O_NSAS + ((size_t)(r - MP) * 8 + ty * 2 + g) * 64 : O_NSAP + ((size_t)r * 8 + ty * 2 + g) * 64) + d0;
                        st_f8(o, lo); st_f8(o + 32, hi);
                    } else {
                        const int sl = ty - 4;
                        if (samp) { float* o = out + O_WINS + (((size_t)b * 512 + 508 + t) * 4 + sl * 2 + g) * 64 + d0; st_f8(o, lo); st_f8(o + 32, hi); }
                        else if (t >= SEQ - 512) { float* o = out + O_WINP + (((size_t)b * 512 + (t - (SEQ - 512))) * 4 + sl * 2 + g) * 64 + d0; st_f8(o, lo); st_f8(o + 32, hi); }
                    }
                    if (ty == 3 || ty == 5) {
                        size_t pitch; int kp; bf16* base;
                        if (!samp) { pitch = SEQ; kp = t; base = (bf16*)(ws + (ty == 3 ? WS_PSLCVT : WS_PWINVT)); }
                        else if (ty == 3) { pitch = LS; kp = PASTL + t; base = (bf16*)(ws + WS_SSLCVT); }
                        else { pitch = LSW; kp = 512 + t; base = (bf16*)(ws + WS_SWINVT); }
                        bf16* p = base + ((size_t)bg * 64 + d0) * pitch + permk(kp);
                        if (!(MODE & 1)) { st_vt8(p, pitch, lo); st_vt8(p + 32 * pitch, pitch, hi); }
                    } else {
                        size_t rowi; bf16* base;
                        if (!samp) { rowi = (size_t)bg * SEQ + t; base = (bf16*)(ws + (ty == 0 ? WS_PCMPK : ty == 1 ? WS_PCMPV : ty == 2 ? WS_PSLCK : WS_PWINK)); }
                        else if (ty == 4) { rowi = (size_t)bg * LSW + 512 + t; base = (bf16*)(ws + WS_SWINK); }
                        else { rowi = (size_t)bg * LS + PASTL + t; base = (bf16*)(ws + (ty == 0 ? WS_SCMPK : ty == 1 ? WS_SCMPV : WS_SSLCK)); }
                        bf16* p = base + rowi * 64 + d0;
                        st_bf8(p, lo); st_bf8(p + 32, hi);
                    }
                } else if (hs < 28 || (hs >= 45 && hs < 53)) {
                    const int h = hs < 28 ? hs - 20 : hs - 45;
                    bf16* p = (bf16*)(ws + (hs < 28 ? WS_ZN : WS_ZD)) + (size_t)r * 512 + h * 64 + d0;
#pragma unroll
                    for (int j = 0; j < 8; ++j) { lo[j] = silu_f(lo[j]); hi[j] = silu_f(hi[j]); }
                    st_bf8(p, lo); st_bf8(p + 32, hi);
                } else if (hs < 36) {
                    rope8(lo, hi, rc, rs);
#pragma unroll
                    for (int j = 0; j < 8; ++j) { lo[j] *= C2; hi[j] *= C2; }
                    bf16* p = (bf16*)(ws + WS_DQ) + (size_t)r * 512 + (hs - 28) * 64 + d0;
                    st_bf8(p, lo); st_bf8(p + 32, hi);
                } else if (hs < 40) {
                    const int sl = (hs - 36) >> 1, g = (hs - 36) & 1, bg = b * 2 + g;
                    if (sl == 0) rope8(lo, hi, rc, rs);
                    float* o = out + (samp ? O_DSAS + ((size_t)(r - MP) * 4 + sl * 2 + g) * 64 : O_DSAP + ((size_t)r * 4 + sl * 2 + g) * 64) + d0;
                    st_f8(o, lo); st_f8(o + 32, hi);
                    if (sl == 0) {
                        bf16* p = samp ? (bf16*)(ws + WS_SDSAK) + ((size_t)bg * LS + PASTL + t) * 64 + d0 : (bf16*)(ws + WS_PDSAK) + ((size_t)bg * SEQ + t) * 64 + d0;
                        st_bf8(p, lo); st_bf8(p + 32, hi);
                    } else {
                        const size_t pitch = samp ? LS : SEQ; const int kp = samp ? PASTL + t : t;
                        bf16* p = (bf16*)(ws + (samp ? WS_SDSAVT : WS_PDSAVT)) + ((size_t)bg * 64 + d0) * pitch + permk(kp);
                        if (!(MODE & 1)) { st_vt8(p, pitch, lo); st_vt8(p + 32 * pitch, pitch, hi); }
                    }
                } else if (hs < 44) {
                    rope8(lo, hi, rc, rs);
                    bf16* p = (bf16*)(ws + WS_IQ) + (size_t)r * 256 + (hs - 40) * 64 + d0;
                    st_bf8(p, lo); st_bf8(p + 32, hi);
                } else if (hs == 44) {
                    rope8(lo, hi, rc, rs);
                    float* o = out + (samp ? O_IDXS + (size_t)(r - MP) * 64 : O_IDXP + (size_t)r * 64) + d0;
                    st_f8(o, lo); st_f8(o + 32, hi);
                    bf16* p = samp ? (bf16*)(ws + WS_SIDXK) + ((size_t)b * LS + PASTL + t) * 64 + d0 : (bf16*)(ws + WS_PIDXK) + (size_t)r * 64 + d0;
                    st_bf8(p, lo); st_bf8(p + 32, hi);
                } else if (hs < 85) {
                    bf16* p = (bf16*)(ws + WS_MG) + (size_t)r * 2048 + (hs - 53) * 64 + d0;
#pragma unroll
                    for (int j = 0; j < 8; ++j) { lo[j] = sigm_f(lo[j]); hi[j] = sigm_f(hi[j]); }
                    st_bf8(p, lo); st_bf8(p + 32, hi);
                } else {
                    if (fq < 3) { float* p = (float*)(ws + WS_GATES) + (size_t)r * 24 + d0;
#pragma unroll
                        for (int j = 0; j < 8; ++j) lo[j] = sigm_f(lo[j]);
                        st_f8(p, lo);
                    } else { *(f32x4*)((float*)(ws + WS_IW) + (size_t)r * 4) = (f32x4){lo[0], lo[1], lo[2], lo[3]}; }
                }
            }
    }
};
typedef EpiInProjT<0> EpiInProj;
struct ColOrder {
    int nM, nN, cnt, rank, pn;
    __device__ void init(int M, int N, int G, int c) { nM = M / 256; nN = N / 256; pn = c % nN; rank = c / nN; cnt = G / nN + ((pn < G % nN) ? 1 : 0); }
    __device__ bool next(int i, pg8::Unit& u) const { const int pm = rank + i * cnt; if (pm >= nM) return false; u.pm = pm; u.pn = pn; return true; }
    __device__ __forceinline__ void a_ready(const pg8::Unit&) const {}
    __device__ __forceinline__ void done(const pg8::Unit&) const {}
};
struct EpiNull {
    static constexpr bool PERM = true, AFTER_DRAIN = false;
    unsigned char* ws;
    DI void operator()(const pg8::f32x4 (&acc)[2][2][4][2], const pg8::Unit& u, int wr, int wc, int fr, int fq) const {
        float s = 0.f;
#pragma unroll
        for (int ai = 0; ai < 2; ++ai)
#pragma unroll
            for (int bj = 0; bj < 2; ++bj)
#pragma unroll
                for (int m = 0; m < 4; ++m)
#pragma unroll
                    for (int n = 0; n < 2; ++n) s += acc[ai][bj][m][n][0] + acc[ai][bj][m][n][1] + acc[ai][bj][m][n][2] + acc[ai][bj][m][n][3];
        if (s == 1.2345e33f) *(float*)(ws + WS_CTL + 2048) = s;
    }
};
struct EpiUp1 {
    static constexpr bool PERM = true, AFTER_DRAIN = false;
    unsigned char* ws;
    DI void operator()(const pg8::f32x4 (&acc)[2][2][4][2], const pg8::Unit& u, int wr, int wc, int fr, int fq) const {
#pragma unroll
        for (int ai = 0; ai < 2; ++ai)
#pragma unroll
            for (int m = 0; m < 4; ++m) {
                const int r = u.pm * 256 + ai * 128 + wr * 64 + m * 16 + fr;
#pragma unroll
                for (int bj = 0; bj < 2; ++bj) {
                    const int c0 = u.pn * 256 + bj * 128 + wc * 32 + 8 * fq;
                    const u32x4 gw = *(const u32x4*)((const bf16*)(ws + WS_MG) + (size_t)r * 2048 + c0);
                    const f32x4 a0 = acc[ai][bj][m][0], a1 = acc[ai][bj][m][1];
                    u32x4 w; w.x = pk2(a0[0] * bflo(gw.x), a0[1] * bfhi(gw.x)); w.y = pk2(a0[2] * bflo(gw.y), a0[3] * bfhi(gw.y));
                    w.z = pk2(a1[0] * bflo(gw.z), a1[1] * bfhi(gw.z)); w.w = pk2(a1[2] * bflo(gw.w), a1[3] * bfhi(gw.w));
                    *(u32x4*)((bf16*)(ws + WS_T1) + (size_t)r * 1024 + c0) = w;
                }
            }
    }
};
struct EpiUp2 {
    static constexpr bool PERM = true, AFTER_DRAIN = false;
    unsigned char* ws;
    DI void operator()(const pg8::f32x4 (&acc)[2][2][4][2], const pg8::Unit& u, int wr, int wc, int fr, int fq) const {
#pragma unroll
        for (int ai = 0; ai < 2; ++ai)
#pragma unroll
            for (int m = 0; m < 4; ++m) {
                const int r = u.pm * 256 + ai * 128 + wr * 64 + m * 16 + fr;
#pragma unroll
                for (int bj = 0; bj < 2; ++bj) {
                    const int c0 = u.pn * 256 + bj * 128 + wc * 32 + 8 * fq;
                    const u32x4 gw = *(const u32x4*)((const bf16*)(ws + WS_MG) + (size_t)r * 2048 + 1024 + c0);
                    const u32x4 tw = *(const u32x4*)((const bf16*)(ws + WS_T1) + (size_t)r * 1024 + c0);
                    const f32x4 t0 = {bflo(tw.x), bfhi(tw.x), bflo(tw.y), bfhi(tw.y)}, t1 = {bflo(tw.z), bfhi(tw.z), bflo(tw.w), bfhi(tw.w)};
                    const f32x4 a0 = acc[ai][bj][m][0], a1 = acc[ai][bj][m][1];
                    u32x4 w;
                    w.x = pk2(t0[0] + a0[0] * bflo(gw.x), t0[1] + a0[1] * bfhi(gw.x)); w.y = pk2(t0[2] + a0[2] * bflo(gw.y), t0[3] + a0[3] * bfhi(gw.y));
                    w.z = pk2(t1[0] + a1[0] * bflo(gw.z), t1[1] + a1[1] * bfhi(gw.z)); w.w = pk2(t1[2] + a1[2] * bflo(gw.w), t1[3] + a1[3] * bfhi(gw.w));
                    *(u32x4*)((bf16*)(ws + WS_M1) + (size_t)r * 1024 + c0) = w;
                }
            }
    }
};
struct EpiOut {
    static constexpr bool PERM = true, AFTER_DRAIN = false;
    unsigned char* ws; float* out; const float* xp; const float* xs;
    DI void operator()(const pg8::f32x4 (&acc)[2][2][4][2], const pg8::Unit& u, int wr, int wc, int fr, int fq) const {
        const bool samp = u.pm >= 64;
#pragma unroll
        for (int ai = 0; ai < 2; ++ai)
#pragma unroll
            for (int m = 0; m < 4; ++m) {
                const int r = u.pm * 256 + ai * 128 + wr * 64 + m * 16 + fr;
                const int mrow = samp ? 4 + ((r - MP) >> 2) : (r >> 12);
                const float* xr = samp ? xs + (size_t)(r - MP) * 1024 : xp + (size_t)r * 1024;
                float* orow = samp ? out + O_YS + (size_t)(r - MP) * 1024 : out + O_YP + (size_t)r * 1024;
                const float* gr = (const float*)(ws + WS_MOD) + (size_t)mrow * 3072 + 2048;
#pragma unroll
                for (int bj = 0; bj < 2; ++bj) {
                    const int c0 = u.pn * 256 + bj * 128 + wc * 32 + 8 * fq;
#pragma unroll
                    for (int n = 0; n < 2; ++n) {
                        const f32x4 x4 = *(const f32x4*)(xr + c0 + 4 * n), g4 = *(const f32x4*)(gr + c0 + 4 * n);
                        *(f32x4*)(orow + c0 + 4 * n) = x4 + g4 * acc[ai][bj][m][n];
                    }
                }
            }
    }
};

DI int win_row(int col) {
    int hs, d;
    if (col < 1280) { hs = col >> 6; d = col & 63; }
    else if (col < 1304) { hs = 85; d = col - 1280; }
    else if (col < 2904) { const int c = col - 1304; hs = 20 + (c >> 6); d = c & 63; }
    else if (col < 2908) { hs = 85; d = 24 + (col - 2904); }
    else { const int c = col - 2908; hs = 45 + (c >> 6); d = c & 63; }
    return 256 * (hs >> 2) + 128 * (d >> 5) + 32 * (hs & 3) + (d & 31);
}
template <bool WINMAP> DI void p0_transpose_item(const float* W, int K, int N, bf16* WT, LAS float* scr, int item, int lane) {
    const int nblk = (N + 31) / 32, kb = item / nblk, nb = item % nblk, k0 = 64 * kb, n0 = 32 * nb;
    const bool nok = n0 + (lane & 31) < N;
    float tv[32];
#pragma unroll
    for (int i = 0; i < 32; ++i) { const int kk = 2 * i + (lane >> 5); tv[i] = nok ? W[(size_t)(k0 + kk) * N + n0 + (lane & 31)] : 0.f; }
#pragma unroll
    for (int i = 0; i < 32; ++i) { const int kk = 2 * i + (lane >> 5); scr[kk * 33 + (lane & 31)] = tv[i]; }
    LDS_WAIT();
    const int c = lane & 7;
#pragma unroll
    for (int j = 0; j < 4; ++j) { const int n = (lane >> 3) + 8 * j; const LAS float* s = scr + (8 * c) * 33 + n;
        u32x4 o; o.x = pk2(s[0 * 33], s[1 * 33]); o.y = pk2(s[2 * 33], s[3 * 33]); o.z = pk2(s[4 * 33], s[5 * 33]); o.w = pk2(s[6 * 33], s[7 * 33]);
        if (n0 + n < N) { const int row = WINMAP ? win_row(n0 + n) : (n0 + n); *(u32x4*)(WT + (size_t)row * K + k0 + 8 * c) = o; } }
    LDS_WAIT();
}
DI void p0_mod(Frame& F) {
    LAS float* wl = (LAS float*)F.lds;
    float* mod = WSP(float, WS_MOD);
    for (int cg = blockIdx.x; cg < 256; cg += F.G) {
        __syncthreads();
        for (int k = F.tid; k < 1024; k += NWAVES * 64) {
            const f32x4* src = (const f32x4*)(F.wada + (size_t)k * 3072 + cg * 12);
            LAS f32x4* dst = (LAS f32x4*)(wl + k * 12);
            dst[0] = src[0]; dst[1] = src[1]; dst[2] = src[2];
        }
        __syncthreads();
        float cv[16], cn[16];
        { const float* cr = F.wave < 4 ? F.cp + (size_t)F.wave * 1024 : F.cs + (size_t)(F.wave - 4) * 1024;
#pragma unroll
          for (int i = 0; i < 16; ++i) cn[i] = cr[F.lane + 64 * i]; }
        for (int r = F.wave; r < 132; r += NWAVES) {
#pragma unroll
            for (int i = 0; i < 16; ++i) cv[i] = cn[i];
            { const int rn = r + NWAVES < 132 ? r + NWAVES : r; const float* cr = rn < 4 ? F.cp + (size_t)rn * 1024 : F.cs + (size_t)(rn - 4) * 1024;
#pragma unroll
              for (int i = 0; i < 16; ++i) cn[i] = cr[F.lane + 64 * i]; }
            float a[12];
#pragma unroll
            for (int j = 0; j < 12; ++j) a[j] = 0.f;
#pragma unroll
            for (int i = 0; i < 16; ++i) {
                const int k = F.lane + 64 * i; const float s = silu_f(cv[i]);
                const LAS f32x4* wp = (const LAS f32x4*)(wl + k * 12);
                const f32x4 w0 = wp[0], w1 = wp[1], w2 = wp[2];
                a[0] += s * w0[0]; a[1] += s * w0[1]; a[2] += s * w0[2]; a[3] += s * w0[3];
                a[4] += s * w1[0]; a[5] += s * w1[1]; a[6] += s * w1[2]; a[7] += s * w1[3];
                a[8] += s * w2[0]; a[9] += s * w2[1]; a[10] += s * w2[2]; a[11] += s * w2[3];
                if ((i & 3) == 3) __builtin_amdgcn_sched_barrier(0);
            }
            float v = 0.f;
#pragma unroll
            for (int j = 0; j < 12; ++j) { const float sj = wave_sum(a[j]); v = (F.lane == j) ? sj : v; }
            if (F.lane < 12) mod[(size_t)r * 3072 + cg * 12 + F.lane] = v + F.bada[cg * 12 + F.lane];
        }
    }
    __syncthreads();
}
__device__ const double ROPE_INV[32] = {
    1.0, 0.7498942093324559, 0.5623413251903491, 0.4216965034285822, 0.31622776601683794, 0.23713737056616552, 0.1778279410038923, 0.1333521432163324,
    0.1, 0.07498942093324559, 0.05623413251903491, 0.04216965034285822, 0.03162277660168379, 0.023713737056616554, 0.01778279410038923, 0.01333521432163324,
    0.01, 0.007498942093324559, 0.005623413251903491, 0.004216965034285822, 0.0031622776601683794, 0.0023713737056616554, 0.0017782794100389228, 0.001333521432163324,
    0.001, 0.0007498942093324559, 0.0005623413251903491, 0.0004216965034285822, 0.00031622776601683794, 0.00023713737056616554, 0.00017782794100389227, 0.0001333521432163324};
DI void p0_rope_item(Frame& F, int item) {
    const int pos = 2 * item + (F.lane >> 5), d = F.lane & 31;
    if (pos >= 4100) return;
    const double ang = (double)pos * ROPE_INV[d];
    const double kq = __builtin_rint(ang * 0.6366197723675814);
    double r = __builtin_fma(-kq, 1.5707963267948966, ang); r = __builtin_fma(-kq, 6.123233995736766e-17, r);
    const int q = (int)kq & 3;
    const double r2 = r * r;
    const double sn = r * (1.0 + r2 * (-1.0 / 6 + r2 * (1.0 / 120 + r2 * (-1.0 / 5040 + r2 * (1.0 / 362880 + r2 * (-1.0 / 39916800 + r2 * (1.0 / 6227020800.0)))))));
    const double cs = 1.0 + r2 * (-0.5 + r2 * (1.0 / 24 + r2 * (-1.0 / 720 + r2 * (1.0 / 40320 + r2 * (-1.0 / 3628800 + r2 * (1.0 / 479001600.0 + r2 * (-1.0 / 87178291200.0)))))));
    const double c = (q == 0) ? cs : (q == 1) ? -sn : (q == 2) ? -cs : sn;
    const double s = (q == 0) ? sn : (q == 1) ? cs : (q == 2) ? -sn : -cs;
    WSP(float, WS_COS)[pos * 32 + d] = (float)c; WSP(float, WS_SIN)[pos * 32 + d] = (float)s;
}
DI void p0_cmp_small_item(Frame& F, int item) {
    if (item < 256) {
        const int slot = item >> 7, ch = (item >> 6) & 1, kc = item & 63, c = ch * 64 + F.lane; float a = 0.f;
#pragma unroll 8
        for (int i = 0; i < 32; ++i) { const int k = kc * 32 + i; a += F.pe[slot * 2048 + k] * F.w1[((size_t)slot * 2048 + k) * 128 + c]; }
        WSP(float, WS_BIASP)[(size_t)kc * 256 + slot * 128 + c] = a;
    } else {
        const int it = item - 256, slot = it >> 7, e = (it & 127) >> 1, ch = it & 1;
        const int c = ch * 64 + F.lane;
        WSP(bf16, WS_W2T)[((size_t)slot * 64 + e) * 128 + permk(c)] = (bf16)(pk2(F.w2[((size_t)slot * 128 + c) * 64 + e], 0.f) & 0xffffu);
    }
}
DI void cp_k16(const float* src, size_t rs, bf16* dst, int lane) {
    const int tk = lane >> 2, dc = (lane & 3) * 16;
    const f32x4* s = (const f32x4*)(src + (size_t)tk * rs + dc);
    const f32x4 a = s[0], b = s[1], c = s[2], d = s[3];
    u32x4 w0, w1; w0.x = pk2(a[0], a[1]); w0.y = pk2(a[2], a[3]); w0.z = pk2(b[0], b[1]); w0.w = pk2(b[2], b[3]);
    w1.x = pk2(c[0], c[1]); w1.y = pk2(c[2], c[3]); w1.z = pk2(d[0], d[1]); w1.w = pk2(d[2], d[3]);
    u32x4* o = (u32x4*)(dst + (size_t)tk * 64 + dc); o[0] = w0; o[1] = w1;
}
DI void cp_vt16(const float* src, size_t rs, bf16* dst, size_t pitch, int lane) {
#pragma unroll
    for (int h = 0; h < 2; ++h) {
        float v[8];
#pragma unroll
        for (int i = 0; i < 8; ++i) v[i] = src[(size_t)((i & 3) + 8 * (i >> 2) + 4 * h) * rs + lane];
        *(u32x4*)(dst + (size_t)lane * pitch + 8 * h) = pack8(v);
    }
}
DI void p0_gather_item(Frame& F, int item) {
    const int sb = item >> 7, tg = item & 127, tk0 = tg * 16, lane = F.lane;
    const int pg = F.ptab[sb * NPG + (tk0 >> 7)], j0 = tk0 & 127;
    const float* nsa = F.cnsa + ((size_t)pg * PAGE + j0) * 512;
    const float* dsa = F.cdsa + ((size_t)pg * PAGE + j0) * 256;
    const float* idx = F.cidx + ((size_t)pg * PAGE + j0) * 64;
#pragma unroll
    for (int g = 0; g < 2; ++g) {
        const size_t bg = (size_t)sb * 2 + g;
        cp_k16(nsa + (0 * 2 + g) * 64, 512, WSP(bf16, WS_SCMPK) + (bg * LS + tk0) * 64, lane);
        cp_k16(nsa + (1 * 2 + g) * 64, 512, WSP(bf16, WS_SCMPV) + (bg * LS + tk0) * 64, lane);
        cp_k16(nsa + (2 * 2 + g) * 64, 512, WSP(bf16, WS_SSLCK) + (bg * LS + tk0) * 64, lane);
        cp_vt16(nsa + (3 * 2 + g) * 64, 512, WSP(bf16, WS_SSLCVT) + bg * 64 * LS + tk0, LS, lane);
        cp_k16(dsa + (0 * 2 + g) * 64, 256, WSP(bf16, WS_SDSAK) + (bg * LS + tk0) * 64, lane);
        cp_vt16(dsa + (1 * 2 + g) * 64, 256, WSP(bf16, WS_SDSAVT) + bg * 64 * LS + tk0, LS, lane);
    }
    cp_k16(idx, 64, WSP(bf16, WS_SIDXK) + ((size_t)sb * LS + tk0) * 64, lane);
}
DI void p0_win_item(Frame& F, int item) {
    const int sb = item >> 5, w0 = (item & 31) * 16, lane = F.lane;
    const float* st = F.swin + ((size_t)sb * 512 + w0) * 256;
#pragma unroll
    for (int g = 0; g < 2; ++g) {
        const size_t bg = (size_t)sb * 2 + g;
        cp_k16(st + (0 * 2 + g) * 64, 256, WSP(bf16, WS_SWINK) + (bg * LSW + w0) * 64, lane);
        cp_vt16(st + (1 * 2 + g) * 64, 256, WSP(bf16, WS_SWINVT) + bg * 64 * LSW + w0, LSW, lane);
    }
}
DI void p0_zero_item(Frame& F, int item) {
    const int arr = item >> 8, bg = item & 255, lane = F.lane;
    bf16* p; int n;
    if (arr == 0) { p = WSP(bf16, WS_SSLCVT) + ((size_t)bg * 64 + lane) * LS + 2052; n = 60; }
    else if (arr == 1) { p = WSP(bf16, WS_SDSAVT) + ((size_t)bg * 64 + lane) * LS + 2052; n = 60; }
    else { p = WSP(bf16, WS_SWINVT) + ((size_t)bg * 64 + lane) * LSW + 516; n = 60; }
    unsigned long long* q = (unsigned long long*)p;
    for (int i = 0; i < n / 4; ++i) q[i] = 0ull;
}
DI void p0_prologue(Frame& F, int um) {
    if (um & 1) p0_mod(F);
    LAS float* scr = (LAS float*)(F.lds + F.wave * 16384);
    const int gw = blockIdx.x * NWAVES + F.wave, NGW = F.G * NWAVES;
    constexpr int I_WIN = 16 * 171, I_UP = 8 * 32, I_OUT = 16 * 32, I_W1 = 32 * 4;
    constexpr int T0 = I_WIN, T1 = T0 + I_UP, T2 = T1 + I_UP, T3 = T2 + I_OUT, T4 = T3 + 2 * I_W1, T5 = T4 + 2050, T6 = T5 + 512, T7 = T6 + 768, T8 = T7 + SBATCH * 32, T9 = T8 + SBATCH * 128;
#ifdef ORACLE
    constexpr int TEND = T9;
#else
    constexpr int TEND = T7;
#endif
    if (um & 2) for (int it = gw; it < TEND; it += NGW) {
        if (it < T0) p0_transpose_item<true>(F.win, 1024, 5468, WSP(bf16, WS_WINT), scr, it, F.lane);
        else if (it < T1) p0_transpose_item<false>(F.wupn, 512, 1024, WSP(bf16, WS_WUPN), scr, it - T0, F.lane);
        else if (it < T2) p0_transpose_item<false>(F.wupd, 512, 1024, WSP(bf16, WS_WUPD), scr, it - T1, F.lane);
        else if (it < T3) p0_transpose_item<false>(F.wout, 1024, 1024, WSP(bf16, WS_WOUT), scr, it - T2, F.lane);
        else if (it < T4) { const int q = it - T3, slot = q / I_W1; p0_transpose_item<false>(F.w1 + (size_t)slot * 2048 * 128, 2048, 128, WSP(bf16, WS_W1T) + (size_t)slot * 128 * 2048, scr, q % I_W1, F.lane); }
        else if (it < T5) p0_rope_item(F, it - T4);
        else if (it < T6) p0_cmp_small_item(F, it - T5);
        else if (it < T7) p0_zero_item(F, it - T6);
#ifdef ORACLE
        else if (it < T8) p0_win_item(F, it - T7);
        else p0_gather_item(F, it - T8);
#endif
    }
    constexpr int ROW4 = 508 * 64;
    const f32x4* src = (const f32x4*)F.swin; f32x4* dst = (f32x4*)(F.out + O_WINS);
    if (um & 4) for (int it = blockIdx.x; it < 2 * SBATCH; it += F.G) {
        const int sb = it >> 1, h0 = (it & 1) * (ROW4 / 2);
        const f32x4* sp = src + (size_t)sb * 512 * 64 + 4 * 64 + h0; f32x4* dp = dst + (size_t)sb * 512 * 64 + h0;
        for (int i = F.tid; i < ROW4 / 2; i += 512 * 8) {
            f32x4 v[8];
#pragma unroll
            for (int j = 0; j < 8; ++j) { const int k = i + j * 512; v[j] = k < ROW4 / 2 ? __builtin_nontemporal_load(sp + k) : (f32x4){0.f, 0.f, 0.f, 0.f}; }
#pragma unroll
            for (int j = 0; j < 8; ++j) { const int k = i + j * 512; if (k < ROW4 / 2) __builtin_nontemporal_store(v[j], dp + k); }
        }
    }
}
DI void p1_adaln(Frame& F) {
    const int gw = blockIdx.x * NWAVES + F.wave, NGW = F.G * NWAVES;
    if (blockIdx.x == 0 && F.tid < 256) { float a = 0.f; for (int j = 0; j < 64; ++j) a += WSP(float, WS_BIASP)[j * 256 + F.tid]; WSP(float, WS_BIAS1)[F.tid] = a; }
    const float* mod = WSP(float, WS_MOD);
    f32x4 nx[4];
    { const int r = gw < MR ? gw : MR - 1; const f32x4* x4 = (const f32x4*)(r < MP ? F.xp + (size_t)r * 1024 : F.xs + (size_t)(r - MP) * 1024) + F.lane;
#pragma unroll
      for (int j = 0; j < 4; ++j) nx[j] = x4[64 * j]; }
    for (int r = gw; r < MR; r += NGW) {
        const int mrow = r < MP ? (r >> 12) : 4 + ((r - MP) >> 2);
        f32x4 v[4]; float s = 0.f;
#pragma unroll
        for (int j = 0; j < 4; ++j) { v[j] = nx[j]; s += (v[j][0] * v[j][0] + v[j][1] * v[j][1]) + (v[j][2] * v[j][2] + v[j][3] * v[j][3]); }
        { const int rn = r + NGW < MR ? r + NGW : r; const f32x4* x4 = (const f32x4*)(rn < MP ? F.xp + (size_t)rn * 1024 : F.xs + (size_t)(rn - MP) * 1024) + F.lane;
#pragma unroll
          for (int j = 0; j < 4; ++j) nx[j] = x4[64 * j]; }
        const float rstd = 1.f / sqrtf(wave_sum(s) * (1.f / 1024.f) + 1e-6f);
        const f32x4* g4 = (const f32x4*)F.normg + F.lane;
        const f32x4* sh4 = (const f32x4*)(mod + (size_t)mrow * 3072) + F.lane;
        const f32x4* sc4 = (const f32x4*)(mod + (size_t)mrow * 3072 + 1024) + F.lane;
        unsigned long long* o8 = (unsigned long long*)(WSP(bf16, WS_H) + (size_t)r * 1024) + F.lane;
#pragma unroll
        for (int j = 0; j < 4; ++j) {
            const f32x4 y = v[j] * rstd * g4[64 * j]; const f32x4 h = y * (1.f + sc4[64 * j]) + sh4[64 * j];
            o8[64 * j] = (unsigned long long)pk2(h[0], h[1]) | ((unsigned long long)pk2(h[2], h[3]) << 32);
        }
    }
}
DI void p8_final(Frame& F) {
    const int gw = blockIdx.x * NWAVES + F.wave, NGW = F.G * NWAVES;
    f32x4 nx[4];
    { const int r = gw < MR ? gw : MR - 1; const f32x4* y4 = (const f32x4*)(r < MP ? F.out + O_YP + (size_t)r * 1024 : F.out + O_YS + (size_t)(r - MP) * 1024) + F.lane;
#pragma unroll
      for (int j = 0; j < 4; ++j) nx[j] = y4[64 * j]; }
    for (int r = gw; r < MR; r += NGW) {
        float* yr = r < MP ? F.out + O_YP + (size_t)r * 1024 : F.out + O_YS + (size_t)(r - MP) * 1024;
        f32x4* y4 = (f32x4*)yr + F.lane;
        f32x4 v[4]; float s = 0.f;
#pragma unroll
        for (int j = 0; j < 4; ++j) { v[j] = nx[j]; s += (v[j][0] * v[j][0] + v[j][1] * v[j][1]) + (v[j][2] * v[j][2] + v[j][3] * v[j][3]); }
        { const int rn = r + NGW < MR ? r + NGW : r; const f32x4* n4 = (const f32x4*)(rn < MP ? F.out + O_YP + (size_t)rn * 1024 : F.out + O_YS + (size_t)(rn - MP) * 1024) + F.lane;
#pragma unroll
          for (int j = 0; j < 4; ++j) nx[j] = n4[64 * j]; }
        const float rstd = 1.f / sqrtf(wave_sum(s) * (1.f / 1024.f) + 1e-6f);
        const f32x4* g4 = (const f32x4*)F.fing + F.lane;
#pragma unroll
        for (int j = 0; j < 4; ++j) y4[64 * j] = v[j] * rstd * g4[64 * j];
    }
}

constexpr int TP = 144;
constexpr int TILE_B = 64 * TP;
struct LdsT {
    static constexpr bool HOIST = true;
    const LAS unsigned char* p;
    DI bf16x8 frag(int mt, int s) const { return *(const LAS bf16x8*)(p + mt * 32 * TP + s * 32); }
};
struct GlbT {
    static constexpr bool HOIST = false;
    const bf16* base; unsigned off; unsigned pitch;
    DI bf16x8 frag(int mt, int s) const { return *(const bf16x8*)(base + (size_t)(off + (unsigned)mt * 32u * pitch + (unsigned)s * 16u)); }
};
template <class KT> DI void qk_tile(f32x16& s0, f32x16& s1, const KT& kt, const bf16x8 (&q)[4]) {
    f32x16 z;
#pragma unroll
    for (int i = 0; i < 16; ++i) z[i] = 0.f;
    s0 = z; s1 = z;
#pragma unroll
    for (int s = 0; s < 4; ++s) { s0 = MFMA32(kt.frag(0, s), q[s], s0); s1 = MFMA32(kt.frag(1, s), q[s], s1); }
}
DI bf16x8 cvt8(f32x4 a, f32x4 b) { u32x4 w; w.x = pk2(a[0], a[1]); w.y = pk2(a[2], a[3]); w.z = pk2(b[0], b[1]); w.w = pk2(b[2], b[3]); return __builtin_bit_cast(bf16x8, w); }
DI bf16x8 pack_p(const f32x16& x, int h) {
    u32x4 w; w.x = pk2(x[8 * h], x[8 * h + 1]); w.y = pk2(x[8 * h + 2], x[8 * h + 3]); w.z = pk2(x[8 * h + 4], x[8 * h + 5]); w.w = pk2(x[8 * h + 6], x[8 * h + 7]);
    return __builtin_bit_cast(bf16x8, w);
}
template <class VT> DI void pv_tile(f32x16& o0, f32x16& o1, const f32x16& p0, const f32x16& p1, const VT& vt) {
    const bf16x8 b0 = pack_p(p0, 0), b1 = pack_p(p0, 1), b2 = pack_p(p1, 0), b3 = pack_p(p1, 1);
    o0 = MFMA32(vt.frag(0, 0), b0, o0); o1 = MFMA32(vt.frag(1, 0), b0, o1);
    o0 = MFMA32(vt.frag(0, 1), b1, o0); o1 = MFMA32(vt.frag(1, 1), b1, o1);
    o0 = MFMA32(vt.frag(0, 2), b2, o0); o1 = MFMA32(vt.frag(1, 2), b2, o1);
    o0 = MFMA32(vt.frag(0, 3), b3, o0); o1 = MFMA32(vt.frag(1, 3), b3, o1);
}
struct Soft { float m, l; bool seen; f32x16 o0, o1, negm; };
DI void soft_init(Soft& S) {
    S.m = 0.f; S.l = 0.f; S.seen = false;
#pragma unroll
    for (int i = 0; i < 16; ++i) { S.o0[i] = 0.f; S.o1[i] = 0.f; S.negm[i] = 0.f; }
}
template <class KT> DI void qk_tile_c(f32x16& s0, f32x16& s1, const KT& kt, const bf16x8 (&q)[4], const f32x16& c) {
    if constexpr (KT::HOIST) {
        bf16x8 f[8];
#pragma unroll
        for (int s = 0; s < 4; ++s) { f[2 * s] = kt.frag(0, s); f[2 * s + 1] = kt.frag(1, s); }
        __builtin_amdgcn_sched_barrier(0);
        s0 = MFMA32(f[0], q[0], c); s1 = MFMA32(f[1], q[0], c);
#pragma unroll
        for (int s = 1; s < 4; ++s) { s0 = MFMA32(f[2 * s], q[s], s0); s1 = MFMA32(f[2 * s + 1], q[s], s1); }
    } else {
        s0 = MFMA32(kt.frag(0, 0), q[0], c); s1 = MFMA32(kt.frag(1, 0), q[0], c);
#pragma unroll
        for (int s = 1; s < 4; ++s) { s0 = MFMA32(kt.frag(0, s), q[s], s0); s1 = MFMA32(kt.frag(1, s), q[s], s1); }
    }
    asm volatile("s_nop 15\n\ts_nop 7" : "+v"(s0), "+v"(s1));
}
DI float max3f(float a, float b, float c) { float r; asm("v_max3_f32 %0, %1, %2, %3" : "=v"(r) : "v"(a), "v"(b), "v"(c)); return r; }
template <class VT> DI void soft_step(Soft& S, f32x16& s0, f32x16& s1, const VT& vt) {
    bf16x8 vf[8];
    if constexpr (VT::HOIST) {
#pragma unroll
        for (int s = 0; s < 4; ++s) { vf[2 * s] = vt.frag(0, s); vf[2 * s + 1] = vt.frag(1, s); }
        __builtin_amdgcn_sched_barrier(0);
    }
    float mx = max3f(s0[0], s1[0], s0[1]), my = max3f(s1[1], s0[2], s1[2]);
#pragma unroll
    for (int r = 3; r < 15; r += 2) { mx = max3f(mx, s0[r], s1[r]); my = max3f(my, s0[r + 1], s1[r + 1]); }
    mx = max3f(mx, s0[15], s1[15]); mx = max3f(mx, my, mx);
    mx = max3f(mx, half_other(mx), mx);
    const bool fin = mx > NEGINF;
    const bool need = (mx > 8.f) | (fin & !S.seen);
    if (__any(need)) {
        const float dl = need ? mx : 0.f;
        const float al = S.seen ? __builtin_amdgcn_exp2f(-dl) : 0.f;
        S.m += dl; S.l *= need ? al : 1.f;
        const float am = need ? al : 1.f;
#pragma unroll
        for (int r = 0; r < 16; ++r) { s0[r] -= dl; s1[r] -= dl; S.o0[r] *= am; S.o1[r] *= am; S.negm[r] = -S.m; }
    }
    S.seen = S.seen | fin;
    float ps = 0.f;
#pragma unroll
    for (int r = 0; r < 16; ++r) { s0[r] = __builtin_amdgcn_exp2f(s0[r]); s1[r] = __builtin_amdgcn_exp2f(s1[r]); ps += s0[r] + s1[r]; }
    S.l += ps;
    const bf16x8 b0 = pack_p(s0, 0), b1 = pack_p(s0, 1), b2 = pack_p(s1, 0), b3 = pack_p(s1, 1);
    if constexpr (!VT::HOIST) {
#pragma unroll
        for (int s = 0; s < 4; ++s) { vf[2 * s] = vt.frag(0, s); vf[2 * s + 1] = vt.frag(1, s); }
    }
    S.o0 = MFMA32(vf[0], b0, S.o0); S.o1 = MFMA32(vf[1], b0, S.o1);
    S.o0 = MFMA32(vf[2], b1, S.o0); S.o1 = MFMA32(vf[3], b1, S.o1);
    S.o0 = MFMA32(vf[4], b2, S.o0); S.o1 = MFMA32(vf[5], b2, S.o1);
    S.o0 = MFMA32(vf[6], b3, S.o0); S.o1 = MFMA32(vf[7], b3, S.o1);
}
DI float as_f(int x) { return __int_as_float(x); }
DI float mask_sel(float s, int mm) { return __int_as_float((__float_as_int(s) & mm) | ((int)0xff800000 & ~mm)); }
DI u32x4 tile_ld(const bf16* g, size_t pitch, int tid) { return *(const u32x4*)(g + (size_t)(tid >> 3) * pitch + (tid & 7) * 8); }
DI void tile_st(LAS unsigned char* buf, u32x4 v, int tid) { *(LAS u32x4*)(buf + (tid >> 3) * TP + (tid & 7) * 16) = v; }

constexpr int CP = 272;
DI void compress_unit(Frame& F, int u) {
    const int tid = F.tid, lane = F.lane, w = F.wave, l31 = lane & 31, hi = lane >> 5;
    const int slot = u / 136, rem = u % 136;
    const bf16* data; bf16 *ock, *ocvt; int n0, ncmp, cpitch;
    if (rem < 8) { const int bg = rem; data = WSP(bf16, (slot ? WS_PCMPV : WS_PCMPK)) + (size_t)bg * SEQ * 64; n0 = 32 * w; ncmp = 255; cpitch = 256;
        ock = WSP(bf16, WS_PCK) + (size_t)bg * 256 * 64; ocvt = WSP(bf16, WS_PCVT) + (size_t)bg * 64 * 256; }
    else { const int bg = 2 * (rem - 8) + (w >> 2); data = WSP(bf16, (slot ? WS_SCMPV : WS_SCMPK)) + (size_t)bg * LS * 64; n0 = 32 * (w & 3); ncmp = 127; cpitch = 128;
        ock = WSP(bf16, WS_SCK) + (size_t)bg * 128 * 64; ocvt = WSP(bf16, WS_SCVT) + (size_t)bg * 64 * 128; }
    const int n = n0 + l31, nc = n < ncmp ? n : ncmp - 1;
    const bf16* drow = data + (size_t)nc * 1024 + 8 * hi;
    const bool paged = rem >= 8;
    const float *prA = nullptr, *prB = nullptr; int jsplit = 64;
    if (paged) { const int bg = 2 * (rem - 8) + (w >> 2), sb = bg >> 1, g = bg & 1, t0 = 16 * nc;
        const int pgA = F.ptab[sb * NPG + (t0 >> 7)], pgB = F.ptab[sb * NPG + ((t0 + 31) >> 7)];
        jsplit = 128 - (t0 & 127);
        prA = F.cnsa + ((size_t)pgA * PAGE + (t0 & 127)) * 512 + (slot * 2 + g) * 64 + 8 * hi;
        prB = F.cnsa + ((size_t)pgB * PAGE) * 512 + (slot * 2 + g) * 64 + 8 * hi - (size_t)jsplit * 512;
    }
    const bf16* w1t = WSP(bf16, WS_W1T) + (size_t)slot * 128 * 2048;
    f32x16 acc[4];
#pragma unroll
    for (int c = 0; c < 4; ++c)
#pragma unroll
        for (int i = 0; i < 16; ++i) acc[c][i] = 0.f;
    const bf16* wsrc = w1t + (size_t)(tid >> 2) * 2048 + ((tid & 3) >> 1) * 1024 + (tid & 1) * 32;
    LAS unsigned char* wdst = F.lds + (tid >> 2) * CP + (tid & 3) * 64;
    u32x4 st[4];
#pragma unroll
    for (int i = 0; i < 4; ++i) st[i] = ((const u32x4*)wsrc)[i];
#pragma unroll
    for (int i = 0; i < 4; ++i) ((LAS u32x4*)wdst)[i] = st[i];
    LDS_BARRIER();
    f32x4 raw[16];
#define CMP_ISSUE(kc_) do { if (!paged) { _Pragma("unroll") for (int s_ = 0; s_ < 8; ++s_) raw[2 * s_] = __builtin_bit_cast(f32x4, *(const bf16x8*)(drow + ((kc_) + 16 * (s_ >> 2)) * 64 + (s_ & 3) * 16)); } \
        else { _Pragma("unroll") for (int s_ = 0; s_ < 8; ++s_) { const int j_ = (kc_) + 16 * (s_ >> 2); const f32x4* q_ = (const f32x4*)((j_ < jsplit ? prA : prB) + (size_t)j_ * 512 + 16 * (s_ & 3)); raw[2 * s_] = q_[0]; raw[2 * s_ + 1] = q_[1]; } } } while (0)
    CMP_ISSUE(0);
    for (int kc = 0; kc < 16; ++kc) {
        const LAS unsigned char* buf = F.lds + (kc & 1) * (128 * CP);
        if (kc + 1 < 16) {
#pragma unroll
            for (int i = 0; i < 4; ++i) st[i] = ((const u32x4*)(wsrc + (kc + 1) * 64))[i];
        }
        bf16x8 bq[8];
        if (!paged) {
#pragma unroll
            for (int s = 0; s < 8; ++s) bq[s] = __builtin_bit_cast(bf16x8, raw[2 * s]);
        } else {
#pragma unroll
            for (int s = 0; s < 8; ++s) bq[s] = cvt8(raw[2 * s], raw[2 * s + 1]);
        }
        if (kc + 1 < 16) CMP_ISSUE(kc + 1);
#pragma unroll
        for (int s = 0; s < 8; ++s)
#pragma unroll
            for (int c = 0; c < 4; ++c) acc[c] = MFMA32(*(const LAS bf16x8*)(buf + (32 * c + l31) * CP + s * 32 + hi * 16), bq[s], acc[c]);
        if (kc + 1 < 16) {
            LAS unsigned char* nb = wdst + ((kc + 1) & 1) * (128 * CP);
#pragma unroll
            for (int i = 0; i < 4; ++i) ((LAS u32x4*)nb)[i] = st[i];
        }
        LDS_BARRIER();
    }
#undef CMP_ISSUE
    const float* b1 = WSP(float, WS_BIAS1) + slot * 128;
#pragma unroll
    for (int c = 0; c < 4; ++c)
#pragma unroll
        for (int q = 0; q < 4; ++q) { const f32x4 bv = *(const f32x4*)(b1 + 32 * c + 8 * q + 4 * hi);
#pragma unroll
            for (int j = 0; j < 4; ++j) acc[c][4 * q + j] = silu_f(acc[c][4 * q + j] + bv[j]); }
    const bf16* w2t = WSP(bf16, WS_W2T) + (size_t)slot * 64 * 128 + (size_t)l31 * 128 + 8 * hi;
    f32x16 o0, o1;
#pragma unroll
    for (int i = 0; i < 16; ++i) { o0[i] = 0.f; o1[i] = 0.f; }
#pragma unroll
    for (int c = 0; c < 4; ++c)
#pragma unroll
        for (int h = 0; h < 2; ++h) { const bf16x8 hb = pack_p(acc[c], h); const int s2 = 2 * c + h;
            o0 = MFMA32(*(const bf16x8*)(w2t + s2 * 16), hb, o0); o1 = MFMA32(*(const bf16x8*)(w2t + 32 * 128 + s2 * 16), hb, o1); }
    const bool ok = n < ncmp;
    if (slot == 0) {
#pragma unroll
        for (int e = 0; e < 2; ++e)
#pragma unroll
            for (int q = 0; q < 4; ++q) { const f32x16& o = e ? o1 : o0; u32x2 wv;
                wv.x = ok ? pk2(o[4 * q], o[4 * q + 1]) : 0u; wv.y = ok ? pk2(o[4 * q + 2], o[4 * q + 3]) : 0u;
                *(u32x2*)(ock + (size_t)n * 64 + 32 * e + 8 * q + 4 * hi) = wv; }
    } else {
        const int pn = permk(n);
#pragma unroll
        for (int e = 0; e < 2; ++e)
#pragma unroll
            for (int r = 0; r < 16; ++r) { const f32x16& o = e ? o1 : o0; ocvt[(size_t)(32 * e + crow(r, hi)) * cpitch + pn] = ok ? (bf16)(pk2(o[r], 0.f) & 0xffffu) : (bf16)0; }
    }
}

template <int NR, int ABL> DI void idx_select(const LAS int* scw, int n, int lane, unsigned long long* out) {
    int k[NR];
    int kmin = 0x7fffffff, kmax = (int)0x80000000;
#pragma unroll
    for (int i = 0; i < NR; ++i) { const bool v = 64 * i + lane < n; const int x = v ? scw[64 * i + lane] : (int)0x80000000; k[i] = x; kmin = v ? (x < kmin ? x : kmin) : kmin; kmax = x > kmax ? x : kmax; }
    int thr = (int)0x80000000, cut = -1;
    if (n > 256 && !(ABL & 1)) {
        kmin = wave_min_i(kmin); kmax = wave_max_i(kmax);
        int lo = kmin - 1, hiv = kmax;
        bool found = false;
        if (hiv > 0x04000000) {
            const int kp = hiv - 0x03800000;
            int c = 0, cl = 0;
#pragma unroll
            for (int i0 = 0; i0 < NR; i0 += 8) {
                unsigned long long bm[4];
#pragma unroll
                for (int j = 0; j < 4; ++j) bm[j] = __ballot(k[i0 + j] > kp);
#pragma unroll
                for (int j = 4; j < 8; ++j) cl += (k[i0 + j] > kp) ? 1 : 0;
#pragma unroll
                for (int j = 0; j < 4; ++j) c += __popcll(bm[j]);
            }
            c += wave_sum_i(cl);
            if (c == 256) { thr = kp; found = true; } else if (c > 256) lo = kp; else hiv = kp;
        }
        while (!found && (unsigned)hiv - (unsigned)lo > 1u) {
            const int mid = (int)((unsigned)lo + (((unsigned)hiv - (unsigned)lo) >> 1));
            int c = 0, cl = 0;
#pragma unroll
            for (int i0 = 0; i0 < NR; i0 += 8) {
                unsigned long long bm[4];
#pragma unroll
                for (int j = 0; j < 4; ++j) bm[j] = __ballot(k[i0 + j] > mid);
#pragma unroll
                for (int j = 4; j < 8; ++j) cl += (k[i0 + j] > mid) ? 1 : 0;
#pragma unroll
                for (int j = 0; j < 4; ++j) c += __popcll(bm[j]);
            }
            c += wave_sum_i(cl);
            if (c == 256) { thr = mid; found = true; break; }
            if (c > 256) lo = mid; else hiv = mid;
        }
        if (!found) {
            thr = hiv; int cgt = 0;
#pragma unroll
            for (int i = 0; i < NR; ++i) cgt += __popcll(__ballot(k[i] > thr));
            const int need = 256 - cgt; int acc = 0; bool done = false;
#pragma unroll
            for (int i = 0; i < NR; ++i) {
                unsigned long long mk = __ballot(k[i] == thr); const int pc = __popcll(mk);
                if (!done && acc + pc >= need) { for (int q2 = 1; q2 < need - acc; ++q2) mk &= mk - 1; cut = 64 * i + (int)__builtin_ctzll(mk); done = true; }
                acc += pc;
            }
        }
    }
    unsigned long long myw = 0ull;
    if (ABL & 4) { myw = (unsigned long long)(k[0] + k[NR - 1] + kmin + kmax); } else
#pragma unroll
    for (int i = 0; i < NR; ++i) { const unsigned long long mk = __ballot((k[i] > thr) | ((k[i] == thr) & (64 * i + lane <= cut))); myw = (lane == i) ? mk : myw; }
    out[lane] = myw;
}
template <bool SAMPLE, int ABL> DI void idx1_unit(Frame& F, int u) {
    const int lane = F.lane, w = F.wave, l31 = lane & 31, hi = lane >> 5, tl = l31 >> 2, hl = l31 & 3;
    int row0, nkmax, ntok; const bf16* ik;
    if (!SAMPLE) { const int b = u & 3, tc = 511 - (u >> 2); row0 = b * SEQ + 8 * tc; nkmax = 8 * tc + 8; ntok = 8; ik = WSP(bf16, WS_PIDXK) + (size_t)b * SEQ * 64; }
    else { row0 = MP + 4 * u; nkmax = PASTL + 4; ntok = 4; ik = WSP(bf16, WS_SIDXK) + (size_t)u * LS * 64; }
    const int rowq = row0 + (SAMPLE ? (tl & 3) : tl);
    bf16x8 q[4];
#pragma unroll
    for (int s = 0; s < 4; ++s) q[s] = *(const bf16x8*)(WSP(bf16, WS_IQ) + (size_t)rowq * 256 + hl * 64 + 16 * s + 8 * hi);
    f32x4 wq[4];
#pragma unroll
    for (int qq = 0; qq < 4; ++qq) { const int tk = 2 * qq + hi; wq[qq] = *(const f32x4*)(WSP(float, WS_IW) + (size_t)(row0 + (SAMPLE ? (tk & 3) : tk)) * 4); }
    LAS int* sc = (LAS int*)F.lds;
    const int n32 = (nkmax + 31) >> 5;
    u32x4 rA[8], rB[8];
#define IDX_ISSUE(R, kt_) do { const int kk_ = (kt_) < n32 ? (kt_) : n32 - 1; \
        if (SAMPLE) { if (kk_ < 64) { const int pg = F.ptab[u * NPG + (kk_ >> 2)]; const float* fp = F.cidx + ((size_t)pg * PAGE + (kk_ & 3) * 32 + l31) * 64 + 8 * hi; \
              _Pragma("unroll") for (int s_ = 0; s_ < 4; ++s_) { R[2 * s_] = gload16(fp + 16 * s_); R[2 * s_ + 1] = gload16(fp + 16 * s_ + 4); } } \
            else { const bf16* kp = ik + (size_t)(32 * kk_ + l31) * 64 + 8 * hi; \
              _Pragma("unroll") for (int s_ = 0; s_ < 4; ++s_) { R[2 * s_] = gload16(kp + 16 * s_); R[2 * s_ + 1] = gload16(kp + 16 * s_); } } } \
        else { const bf16* kp = ik + (size_t)(32 * kk_ + l31) * 64 + 8 * hi; \
            _Pragma("unroll") for (int s_ = 0; s_ < 4; ++s_) R[2 * s_] = gload16(kp + 16 * s_); } } while (0)
#define IDX_WAIT(R) do { if (SAMPLE) asm volatile("s_waitcnt vmcnt(8)" : "+v"(R[0]), "+v"(R[1]), "+v"(R[2]), "+v"(R[3]), "+v"(R[4]), "+v"(R[5]), "+v"(R[6]), "+v"(R[7]) :: "memory"); \
        else asm volatile("s_waitcnt vmcnt(4)" : "+v"(R[0]), "+v"(R[2]), "+v"(R[4]), "+v"(R[6]) :: "memory"); } while (0)
#define RELU_(x) __builtin_amdgcn_fmed3f((x), 0.f, __builtin_inff())
#define IDX_SCORE(R, kt_) do { IDX_WAIT(R); if ((kt_) < n32) { bf16x8 kf[4]; \
        if (SAMPLE && (kt_) < 64) { _Pragma("unroll") for (int s_ = 0; s_ < 4; ++s_) kf[s_] = cvt8(__builtin_bit_cast(f32x4, R[2 * s_]), __builtin_bit_cast(f32x4, R[2 * s_ + 1])); } \
        else { _Pragma("unroll") for (int s_ = 0; s_ < 4; ++s_) kf[s_] = __builtin_bit_cast(bf16x8, R[2 * s_]); } \
        f32x16 a; _Pragma("unroll") for (int i_ = 0; i_ < 16; ++i_) a[i_] = 0.f; \
        _Pragma("unroll") for (int s_ = 0; s_ < 4; ++s_) a = MFMA32(q[s_], kf[s_], a); \
        _Pragma("unroll") for (int qq = 0; qq < 4; ++qq) { \
            float v = RELU_(a[4 * qq]) * wq[qq][0] + RELU_(a[4 * qq + 1]) * wq[qq][1] + RELU_(a[4 * qq + 2]) * wq[qq][2] + RELU_(a[4 * qq + 3]) * wq[qq][3]; \
            int uu = __float_as_int(v); uu = (uu == (int)0x80000000) ? 0 : uu; \
            sc[(2 * qq + hi) * 4096 + 32 * (kt_) + l31] = uu ^ ((uu >> 31) & 0x7fffffff); } } } while (0)
    if (!(ABL & 2)) {
        IDX_ISSUE(rA, w); IDX_ISSUE(rB, w + NWAVES);
        PIN4(q); PIN4(wq);
        asm volatile("s_waitcnt vmcnt(0)" ::: "memory");
        for (int kt = w; kt < n32; kt += 2 * NWAVES) {
            IDX_SCORE(rA, kt); IDX_ISSUE(rA, kt + 2 * NWAVES);
            IDX_SCORE(rB, kt + NWAVES); IDX_ISSUE(rB, kt + 3 * NWAVES);
        }
        asm volatile("s_waitcnt vmcnt(0)" : "+v"(rA[0]), "+v"(rA[2]), "+v"(rA[4]), "+v"(rA[6]), "+v"(rB[0]), "+v"(rB[2]), "+v"(rB[4]), "+v"(rB[6]) :: "memory");
        if (SAMPLE) asm volatile("" : "+v"(rA[1]), "+v"(rA[3]), "+v"(rA[5]), "+v"(rA[7]), "+v"(rB[1]), "+v"(rB[3]), "+v"(rB[5]), "+v"(rB[7]));
    }
#undef IDX_ISSUE
#undef IDX_WAIT
#undef IDX_SCORE
#undef RELU_
    __syncthreads();
    if (w < ntok && !(ABL & 8)) {
        const int n = SAMPLE ? (PASTL + 1 + w) : (row0 - (row0 & ~(SEQ - 1)) + w + 1);
        unsigned long long* out = WSP(unsigned long long, ABL ? WS_T1 : WS_SELM) + (size_t)(row0 + w) * 64;
        const LAS int* scw = sc + w * 4096;
        if (n <= 1024) idx_select<16, ABL>(scw, n, lane, out);
        else if (n <= 2048) idx_select<32, ABL>(scw, n, lane, out);
        else if (n <= 3072) idx_select<48, ABL>(scw, n, lane, out);
        else idx_select<64, ABL>(scw, n, lane, out);
    }
    __syncthreads();
}


constexpr int NSA_PS = 2 * 2 * TILE_B;
constexpr int NSA_WS = 8192 + 2048 + 64;
template <bool SAMPLE> DI void nsa_unit(Frame& F, int u) {
    const int tid = F.tid, lane = F.lane, w = F.wave, l31 = lane & 31, hi = lane >> 5, tl = l31 >> 2, hl = l31 & 3;
    int bg, g, row, qpos, ncmp, wlo, whi, n_ctile, n_stile, w_t0, w_t1, qt = 0;
    size_t cpitch, pitch, wpitch; const bf16 *ck, *cvt, *sk, *svt, *wk, *wvt; bool wr_ok;
    if (!SAMPLE) {
        bg = u & 7; qt = 63 - (u >> 3); g = bg & 1; const int t = 64 * qt + 8 * w + tl; row = (bg >> 1) * SEQ + t; qpos = t; ncmp = 255;
        cpitch = 256; pitch = SEQ; wpitch = SEQ;
        ck = WSP(bf16, WS_PCK) + (size_t)bg * 256 * 64; cvt = WSP(bf16, WS_PCVT) + (size_t)bg * 64 * 256;
        sk = WSP(bf16, WS_PSLCK) + (size_t)bg * SEQ * 64; svt = WSP(bf16, WS_PSLCVT) + (size_t)bg * 64 * SEQ;
        wk = WSP(bf16, WS_PWINK) + (size_t)bg * SEQ * 64; wvt = WSP(bf16, WS_PWINVT) + (size_t)bg * 64 * SEQ;
        wlo = qpos - 511; whi = qpos; n_ctile = (4 * qt + 2) / 64 + 1; n_stile = qt + 1; w_t0 = qt > 8 ? qt - 8 : 0; w_t1 = qt; wr_ok = true;
    } else {
        bg = u * 8 + w; g = bg & 1; const int i = tl & 3; row = MP + (bg >> 1) * 4 + i; qpos = PASTL + i; ncmp = 127;
        cpitch = 128; pitch = LS; wpitch = LSW;
        ck = WSP(bf16, WS_SCK) + (size_t)bg * 128 * 64; cvt = WSP(bf16, WS_SCVT) + (size_t)bg * 64 * 128;
        sk = WSP(bf16, WS_SSLCK) + (size_t)bg * LS * 64; svt = WSP(bf16, WS_SSLCVT) + (size_t)bg * 64 * LS;
        wk = WSP(bf16, WS_SWINK) + (size_t)bg * LSW * 64; wvt = WSP(bf16, WS_SWINVT) + (size_t)bg * 64 * LSW;
        wlo = 1 + i; whi = 512 + i; n_ctile = 2; n_stile = 33; w_t0 = 0; w_t1 = 8; wr_ok = tl < 4;
    }
    const int hq = 4 * g + hl;
    bf16x8 qraw[4], qrot[4];
#pragma unroll
    for (int s = 0; s < 4; ++s) qraw[s] = *(const bf16x8*)(WSP(bf16, WS_QRAW) + (size_t)row * 512 + hq * 64 + 16 * s + 8 * hi);
    LAS unsigned char* const lb = F.lds;
    LAS float* psum = (LAS float*)(lb + NSA_PS + w * NSA_WS);
    LAS float* impb = (LAS float*)(lb + NSA_PS + w * NSA_WS + 8192);
    LAS unsigned char* selb = lb + NSA_PS + w * NSA_WS + 8192 + 2048;
    const int fo = l31 * TP + hi * 16;
    const float* gp = WSP(float, WS_GATES) + (size_t)row * 24 + hq * 3;
    float g0 = gp[0], g1 = gp[1], g2 = gp[2];
    PIN4(qraw); asm volatile("" : "+v"(g0), "+v"(g1), "+v"(g2));
    f32x16 s0, s1;
    u32x4 rk, rv;
    Soft S;

    const int nvr = (qpos - 31) >> 4, nvis = nvr < ncmp - 1 ? nvr : ncmp - 1;
    float m = -1e30f, l = 0.f;
    if (!SAMPLE) { rk = tile_ld(ck, 64, tid); rv = tile_ld(cvt, cpitch, tid); tile_st(lb, rk, tid); tile_st(lb + TILE_B, rv, tid); LDS_BARRIER(); }
    for (int ct = 0; ct < n_ctile; ++ct) {
        if (!SAMPLE) { if (ct + 1 < n_ctile) { rk = tile_ld(ck + (size_t)(ct + 1) * 64 * 64, 64, tid); rv = tile_ld(cvt + (ct + 1) * 64, cpitch, tid); } }
        if (!SAMPLE) { LdsT kt{lb + (ct & 1) * 2 * TILE_B + fo}; qk_tile(s0, s1, kt, qraw); }
        else { GlbT kt{ck, (unsigned)((64 * ct + l31) * 64 + 8 * hi), 64u}; qk_tile(s0, s1, kt, qraw); }
        float mx = -1e30f;
        const int nv2 = nvis - 64 * ct - 4 * hi;
#pragma unroll
        for (int r = 0; r < 16; ++r) { const int cr = (r & 3) + 8 * (r >> 2); s0[r] = cr <= nv2 ? s0[r] : NEGINF; s1[r] = cr + 32 <= nv2 ? s1[r] : NEGINF; mx = fmaxf(mx, fmaxf(s0[r], s1[r])); }
        mx = fmaxf(mx, half_other(mx));
        const float mn = fmaxf(m, mx); float ps = 0.f;
#pragma unroll
        for (int r = 0; r < 16; ++r) ps += __builtin_amdgcn_exp2f(s0[r] - mn) + __builtin_amdgcn_exp2f(s1[r] - mn);
        l = l * __builtin_amdgcn_exp2f(m - mn) + ps; m = mn;
        if (!SAMPLE) { if (ct + 1 < n_ctile) { tile_st(lb + ((ct + 1) & 1) * 2 * TILE_B, rk, tid); tile_st(lb + ((ct + 1) & 1) * 2 * TILE_B + TILE_B, rv, tid); } LDS_BARRIER(); }
    }
    l += half_other(l);
    const float linv = l > 0.f ? 1.f / l : 0.f;
    soft_init(S);
    if (!SAMPLE) { rk = tile_ld(ck, 64, tid); rv = tile_ld(cvt, cpitch, tid); tile_st(lb, rk, tid); tile_st(lb + TILE_B, rv, tid); LDS_BARRIER(); }
    for (int ct = 0; ct < n_ctile; ++ct) {
        if (!SAMPLE) { if (ct + 1 < n_ctile) { rk = tile_ld(ck + (size_t)(ct + 1) * 64 * 64, 64, tid); rv = tile_ld(cvt + (ct + 1) * 64, cpitch, tid); } }
        if (!SAMPLE) { LdsT kt{lb + (ct & 1) * 2 * TILE_B + fo}; qk_tile(s0, s1, kt, qraw); }
        else { GlbT kt{ck, (unsigned)((64 * ct + l31) * 64 + 8 * hi), 64u}; qk_tile(s0, s1, kt, qraw); }
        const int nv2 = nvis - 64 * ct - 4 * hi; LAS float* pw = psum + tl * 256 + 64 * ct + 4 * hi;
#pragma unroll
        for (int r = 0; r < 16; ++r) { const int cr = (r & 3) + 8 * (r >> 2);
            s0[r] = cr <= nv2 ? __builtin_amdgcn_exp2f(s0[r] - m) * linv : 0.f; s1[r] = cr + 32 <= nv2 ? __builtin_amdgcn_exp2f(s1[r] - m) * linv : 0.f;
            float a = s0[r]; a += dpp_x1(a); a += dpp_x2(a); float b = s1[r]; b += dpp_x1(b); b += dpp_x2(b);
            if (hl == 0) { pw[cr] = a; pw[cr + 32] = b; } }
        if (!SAMPLE) { LdsT vt{lb + (ct & 1) * 2 * TILE_B + TILE_B + fo}; pv_tile(S.o0, S.o1, s0, s1, vt); }
        else { GlbT vt{cvt, (unsigned)(l31 * (int)cpitch + 64 * ct + 8 * hi), (unsigned)cpitch}; pv_tile(S.o0, S.o1, s0, s1, vt); }
        if (!SAMPLE) { if (ct + 1 < n_ctile) { tile_st(lb + ((ct + 1) & 1) * 2 * TILE_B, rk, tid); tile_st(lb + ((ct + 1) & 1) * 2 * TILE_B + TILE_B, rv, tid); } LDS_BARRIER(); }
    }
    LDS_WAIT();
    unsigned mlo, mhi;
    {
        const int tk = lane >> 3, jb = 8 * (lane & 7);
        const int qp = SAMPLE ? PASTL + (tk & 3) : 64 * qt + 8 * w + tk, cur = qp >> 6;
        float pv[33];
        const LAS f32x4* pp = (const LAS f32x4*)(psum + tk * 256 + 4 * jb);
#pragma unroll
        for (int i = 0; i < 8; ++i) { const f32x4 x = pp[i]; pv[1 + 4 * i] = x[0]; pv[2 + 4 * i] = x[1]; pv[3 + 4 * i] = x[2]; pv[4 + 4 * i] = x[3]; }
        pv[0] = jb > 0 ? psum[tk * 256 + 4 * jb - 1] : 0.f;
        float v[8];
#pragma unroll
        for (int jj = 0; jj < 8; ++jj) {
            const int j = jb + jj;
            float a = pv[4 * jj] + pv[4 * jj + 1] + pv[4 * jj + 2] + pv[4 * jj + 3];
            a += (4 * j + 3 < ncmp) ? pv[4 * jj + 4] : 0.f;
            a = ((j == 0) | (j == cur) | (j == cur - 1)) ? 1e4f : a;
            a = (j > cur) ? -1e30f : a;
            v[jj] = a;
        }
        LAS f32x4* ip = (LAS f32x4*)(impb + tk * 64 + jb);
        ip[0] = (f32x4){v[0], v[1], v[2], v[3]}; ip[1] = (f32x4){v[4], v[5], v[6], v[7]};
        LDS_WAIT();
        int cnt[8];
#pragma unroll
        for (int jj = 0; jj < 8; ++jj) cnt[jj] = 0;
        const LAS f32x4* ap = (const LAS f32x4*)(impb + tk * 64);
#pragma unroll 1
        for (int i4 = 0; i4 < 16; ++i4) {
            const f32x4 x = ap[i4];
#pragma unroll
            for (int e = 0; e < 4; ++e) { const float xi = x[e];
#pragma unroll
                for (int jj = 0; jj < 8; ++jj) cnt[jj] += (xi > v[jj]) ? 1 : 0; }
        }
        unsigned bits = 0;
#pragma unroll
        for (int jj = 0; jj < 8; ++jj) bits |= ((cnt[jj] < 16) & (jb + jj <= cur)) ? (1u << jj) : 0u;
        int nsel = __popc(bits);
        nsel += __shfl_xor(nsel, 1); nsel += __shfl_xor(nsel, 2); nsel += __shfl_xor(nsel, 4);
        if (__builtin_amdgcn_ballot_w64(nsel != (cur < 15 ? cur + 1 : 16)) != 0ull) {
#pragma unroll
            for (int jj = 0; jj < 8; ++jj) cnt[jj] = 0;
#pragma unroll 1
            for (int i4 = 0; i4 < 16; ++i4) {
                const f32x4 x = ap[i4];
#pragma unroll
                for (int e = 0; e < 4; ++e) { const int i = 4 * i4 + e; const float xi = x[e];
#pragma unroll
                    for (int jj = 0; jj < 8; ++jj) cnt[jj] += ((xi > v[jj]) | ((xi == v[jj]) & (i < jb + jj))) ? 1 : 0; }
            }
            bits = 0;
#pragma unroll
            for (int jj = 0; jj < 8; ++jj) bits |= ((cnt[jj] < 16) & (jb + jj <= cur)) ? (1u << jj) : 0u;
        }
        selb[tk * 8 + (lane & 7)] = (unsigned char)bits;
        LDS_WAIT();
        const LAS unsigned* sp = (const LAS unsigned*)(selb + tl * 8);
        mlo = sp[0]; mhi = sp[1];
    }
    LAS float* park = psum + lane;
#pragma unroll
    for (int i = 0; i < 16; ++i) { park[i * 64] = g0 * S.o0[i]; park[(16 + i) * 64] = g0 * S.o1[i]; }
#pragma unroll
    for (int s = 0; s < 4; ++s) qrot[s] = *(const bf16x8*)(WSP(bf16, WS_QROT) + (size_t)row * 512 + hq * 64 + 16 * s + 8 * hi);
    PIN4(qrot);
    soft_init(S);
    const int qrel = (qpos & 63) - 4 * hi;
    if (!SAMPLE) { rk = tile_ld(sk, 64, tid); rv = tile_ld(svt, pitch, tid); tile_st(lb, rk, tid); tile_st(lb + TILE_B, rv, tid); LDS_BARRIER(); }
    for (int j = 0; j < n_stile; ++j) {
        if (!SAMPLE) { if (j + 1 < n_stile) { rk = tile_ld(sk + (size_t)(j + 1) * 64 * 64, 64, tid); rv = tile_ld(svt + (j + 1) * 64, pitch, tid); } }
        const bool bsel = ((j < 32 ? (mlo >> j) : (mhi >> (j - 32))) & 1u) != 0u;
        if (!SAMPLE) { LdsT kt{lb + (j & 1) * 2 * TILE_B + fo}; qk_tile_c(s0, s1, kt, qrot, S.negm); }
        else { GlbT kt{sk, (unsigned)((64 * j + l31) * 64 + 8 * hi), 64u}; qk_tile_c(s0, s1, kt, qrot, S.negm); }
        if (j == n_stile - 1) {
#pragma unroll
            for (int r = 0; r < 16; ++r) { const int cr = (r & 3) + 8 * (r >> 2); s0[r] = cr <= qrel ? s0[r] : NEGINF; s1[r] = cr + 32 <= qrel ? s1[r] : NEGINF; }
        } else {
#pragma unroll
            for (int r = 0; r < 16; ++r) { s0[r] = bsel ? s0[r] : NEGINF; s1[r] = bsel ? s1[r] : NEGINF; }
        }
        if (!SAMPLE) { LdsT vt{lb + (j & 1) * 2 * TILE_B + TILE_B + fo}; soft_step(S, s0, s1, vt); }
        else { GlbT vt{svt, (unsigned)(l31 * (int)pitch + 64 * j + 8 * hi), (unsigned)pitch}; soft_step(S, s0, s1, vt); }
        if (!SAMPLE) { if (j + 1 < n_stile) { tile_st(lb + ((j + 1) & 1) * 2 * TILE_B, rk, tid); tile_st(lb + ((j + 1) & 1) * 2 * TILE_B + TILE_B, rv, tid); } LDS_BARRIER(); }
    }
    S.l += half_other(S.l);
    { const float sc = g1 / fmaxf(S.l, 1e-30f);
#pragma unroll
      for (int i = 0; i < 16; ++i) { park[i * 64] += sc * S.o0[i]; park[(16 + i) * 64] += sc * S.o1[i]; } }
    soft_init(S);
    if (!SAMPLE) { rk = tile_ld(wk + (size_t)w_t0 * 64 * 64, 64, tid); rv = tile_ld(wvt + w_t0 * 64, wpitch, tid); tile_st(lb, rk, tid); tile_st(lb + TILE_B, rv, tid); LDS_BARRIER(); }
    for (int j = w_t0; j <= w_t1; ++j) {
        const int jr = j - w_t0;
        if (!SAMPLE) { if (j + 1 <= w_t1) { rk = tile_ld(wk + (size_t)(j + 1) * 64 * 64, 64, tid); rv = tile_ld(wvt + (j + 1) * 64, wpitch, tid); } }
        if (!SAMPLE) { LdsT kt{lb + (jr & 1) * 2 * TILE_B + fo}; qk_tile_c(s0, s1, kt, qrot, S.negm); }
        else { GlbT kt{wk, (unsigned)((64 * j + l31) * 64 + 8 * hi), 64u}; qk_tile_c(s0, s1, kt, qrot, S.negm); }
        if ((j == w_t0) | (j == w_t1)) {
            const int lo_r = wlo - 64 * j - 4 * hi, hi_r = whi - 64 * j - 4 * hi;
#pragma unroll
            for (int r = 0; r < 16; ++r) { const int k0 = (r & 3) + 8 * (r >> 2); s0[r] = ((k0 >= lo_r) & (k0 <= hi_r)) ? s0[r] : NEGINF; s1[r] = ((k0 + 32 >= lo_r) & (k0 + 32 <= hi_r)) ? s1[r] : NEGINF; }
        }
        if (!SAMPLE) { LdsT vt{lb + (jr & 1) * 2 * TILE_B + TILE_B + fo}; soft_step(S, s0, s1, vt); }
        else { GlbT vt{wvt, (unsigned)(l31 * (int)wpitch + 64 * j + 8 * hi), (unsigned)wpitch}; soft_step(S, s0, s1, vt); }
        if (!SAMPLE) { if (j + 1 <= w_t1) { tile_st(lb + ((jr + 1) & 1) * 2 * TILE_B, rk, tid); tile_st(lb + ((jr + 1) & 1) * 2 * TILE_B + TILE_B, rv, tid); } LDS_BARRIER(); }
    }
    S.l += half_other(S.l);
#ifdef BREAK_WIN
    S.l *= 1.1f;
#endif
    f32x16 res0, res1;
    { const float sc = g2 / fmaxf(S.l, 1e-30f);
#pragma unroll
      for (int i = 0; i < 16; ++i) { res0[i] = park[i * 64] + sc * S.o0[i]; res1[i] = park[(16 + i) * 64] + sc * S.o1[i]; } }
    if (wr_ok) {
        const bf16* zp = WSP(bf16, WS_ZN) + (size_t)row * 512 + hq * 64 + 4 * hi;
        bf16* op = WSP(bf16, WS_ONZ) + (size_t)row * 512 + hq * 64 + 4 * hi;
#pragma unroll
        for (int e = 0; e < 2; ++e)
#pragma unroll
            for (int q = 0; q < 4; ++q) { const f32x16& o = e ? res1 : res0; const u32x2 z = *(const u32x2*)(zp + 32 * e + 8 * q);
                u32x2 wv; wv.x = pk2(o[4 * q] * bflo(z.x), o[4 * q + 1] * bfhi(z.x)); wv.y = pk2(o[4 * q + 2] * bflo(z.y), o[4 * q + 3] * bfhi(z.y));
                *(u32x2*)(op + 32 * e + 8 * q) = wv; }
    }
}

template <int ABL, class VT> DI void soft_step2(Soft& S, f32x16& s0, f32x16& s1, f32x16& sn0, f32x16& sn1, const VT& vt) {
    bf16x8 vf[8];
#pragma unroll
    for (int s = 0; s < 4; ++s) { vf[2 * s] = vt.frag(0, s); vf[2 * s + 1] = vt.frag(1, s); }
    if (!(ABL & 1)) {
    float mx = max3f(s0[0], s1[0], s0[1]), my = max3f(s1[1], s0[2], s1[2]);
#pragma unroll
    for (int r = 3; r < 15; r += 2) { mx = max3f(mx, s0[r], s1[r]); my = max3f(my, s0[r + 1], s1[r + 1]); }
    mx = max3f(mx, s0[15], s1[15]); mx = max3f(mx, my, mx);
    mx = max3f(mx, half_other(mx), mx);
    const bool fin = mx > NEGINF;
    const bool need = (mx > 8.f) | (fin & !S.seen);
    if (__any(need)) {
        const float dl = need ? mx : 0.f;
        const float al = S.seen ? __builtin_amdgcn_exp2f(-dl) : 0.f;
        S.m += dl; S.l *= need ? al : 1.f;
        const float am = need ? al : 1.f;
#pragma unroll
        for (int r = 0; r < 16; ++r) { s0[r] -= dl; s1[r] -= dl; sn0[r] -= dl; sn1[r] -= dl; S.o0[r] *= am; S.o1[r] *= am; S.negm[r] = -S.m; }
    }
    S.seen = S.seen | fin;
    float ps = 0.f;
#pragma unroll
    for (int r = 0; r < 16; ++r) { s0[r] = __builtin_amdgcn_exp2f(s0[r]); s1[r] = __builtin_amdgcn_exp2f(s1[r]); ps += s0[r] + s1[r]; }
    S.l += ps;
    }
    const bf16x8 b0 = pack_p(s0, 0), b1 = pack_p(s0, 1), b2 = pack_p(s1, 0), b3 = pack_p(s1, 1);
    if (!(ABL & 4)) {
    S.o0 = MFMA32(vf[0], b0, S.o0); S.o1 = MFMA32(vf[1], b0, S.o1);
    S.o0 = MFMA32(vf[2], b1, S.o0); S.o1 = MFMA32(vf[3], b1, S.o1);
    S.o0 = MFMA32(vf[4], b2, S.o0); S.o1 = MFMA32(vf[5], b2, S.o1);
    S.o0 = MFMA32(vf[6], b3, S.o0); S.o1 = MFMA32(vf[7], b3, S.o1);
    } else { S.o0[0] += __builtin_bit_cast(f32x4, b0)[0] + __builtin_bit_cast(f32x4, b1)[0] + __builtin_bit_cast(f32x4, b2)[0] + __builtin_bit_cast(f32x4, b3)[0] + __builtin_bit_cast(f32x4, vf[0])[0] + __builtin_bit_cast(f32x4, vf[7])[1]; }
}
template <int ABL> DI void dsa_unit(Frame& F, int u) {
    const int tid = F.tid, lane = F.lane, w = F.wave, l31 = lane & 31, hi = lane >> 5, tl = l31 >> 2, hl = l31 & 3;
    const int bg = u & 7, qt = 63 - (u >> 3), g = bg & 1, t = 64 * qt + 8 * w + tl, row = (bg >> 1) * SEQ + t, nt = qt + 1;
    const bf16* dk = WSP(bf16, WS_PDSAK) + (size_t)bg * SEQ * 64; const bf16* dvt = WSP(bf16, WS_PDSAVT) + (size_t)bg * 64 * SEQ;
    const int hq = 4 * g + hl;
    bf16x8 dq[4];
#pragma unroll
    for (int s = 0; s < 4; ++s) dq[s] = *(const bf16x8*)(WSP(bf16, WS_DQ) + (size_t)row * 512 + hq * 64 + 16 * s + 8 * hi);
    const unsigned long long* selp = WSP(unsigned long long, WS_SELM) + (size_t)row * 64;
    unsigned long long selA = selp[0], selB = selp[nt > 1 ? 1 : 0];
    PIN4(dq); asm volatile("" : "+v"(selA), "+v"(selB));
    LAS unsigned char* const lb = F.lds;
    const int fo = l31 * TP + hi * 16;
    f32x16 sc0, sc1, sn0, sn1;
    u32x4 rkA, rvA, rkB, rvB;
    Soft S; soft_init(S);
    const int ntm = nt - 1;
    const bf16* kpc = dk + (size_t)(tid >> 3) * 64 + (tid & 7) * 8; const bf16* vpc = dvt + (size_t)(tid >> 3) * SEQ + (tid & 7) * 8;
#define KADDR(jt) (kpc + (size_t)((jt) < ntm ? (jt) : ntm) * 64 * 64)
#define VADDR(jt) (vpc + ((jt) < ntm ? (jt) : ntm) * 64)
    { const u32x4 a = tile_ld(dk, 64, tid), b = tile_ld(dvt, SEQ, tid), c = *(const u32x4*)KADDR(1); tile_st(lb, a, tid); tile_st(lb + 2 * TILE_B, b, tid); tile_st(lb + TILE_B, c, tid); }
    asm volatile("s_waitcnt vmcnt(0)" : "+v"(selA), "+v"(selB) :: "memory");
    selA = gload8(selp); selB = gload8(selp + (nt > 1 ? 1 : 0));
    rkA = gload16(KADDR(2)); rvA = gload16(VADDR(1));
    LDS_BARRIER();
    { LdsT kt{lb + fo}; qk_tile_c(sc0, sc1, kt, dq, S.negm); }
#define DSA_STEP(j, CK, CV, NK, NV, SELC) do { \
        NK = gload16(KADDR((j) + 3)); NV = gload16(VADDR((j) + 2)); \
        if ((j) + 1 < nt) { LdsT kt{lb + (((j) + 1) & 1) * TILE_B + fo}; if (!(ABL & 2)) qk_tile_c(sn0, sn1, kt, dq, S.negm); else { sn0 = S.negm; sn1 = S.negm; sn0[0] += __builtin_bit_cast(f32x4, kt.frag(0, 0))[0]; } } \
        WAITV1(5, SELC);                                                     \
        { const unsigned wa = (unsigned)SELC >> (4 * hi), wb = (unsigned)(SELC >> 32) >> (4 * hi); \
          SELC = gload8(selp + ((j) + 2 < nt ? (j) + 2 : ntm)); \
          _Pragma("unroll") for (int r = 0; r < 16; ++r) { const int bp = (r & 3) + 8 * (r >> 2); \
            sc0[r] = mask_sel(sc0[r], (int)(wa << (31 - bp)) >> 31); sc1[r] = mask_sel(sc1[r], (int)(wb << (31 - bp)) >> 31); } } \
        { LdsT vt{lb + (2 + ((j) & 1)) * TILE_B + fo}; soft_step2<ABL>(S, sc0, sc1, sn0, sn1, vt); } \
        sc0 = sn0; sc1 = sn1; \
        WAITV2(3, CK, CV);                                                   \
        if (!(ABL & 8)) { tile_st(lb + ((j) & 1) * TILE_B, CK, tid); tile_st(lb + (2 + (((j) + 1) & 1)) * TILE_B, CV, tid); } \
        if (!(ABL & 16)) LDS_BARRIER(); } while (0)
    for (int j = 0; j < nt; j += 2) { DSA_STEP(j, rkA, rvA, rkB, rvB, selA); if (j + 1 < nt) DSA_STEP(j + 1, rkB, rvB, rkA, rvA, selB); }
    asm volatile("s_waitcnt vmcnt(0)" : "+v"(rkA), "+v"(rvA), "+v"(rkB), "+v"(rvB), "+v"(selA), "+v"(selB) :: "memory");
#undef DSA_STEP
#undef KADDR
#undef VADDR
    S.l += half_other(S.l);
    {
        const float sc = 1.f / fmaxf(S.l, 1e-30f);
        const bf16* zp = WSP(bf16, WS_ZD) + (size_t)row * 512 + hq * 64 + 4 * hi;
        bf16* op = WSP(bf16, ABL ? WS_T1 : WS_ODZ) + (size_t)row * 512 + hq * 64 + 4 * hi;
#pragma unroll
        for (int e = 0; e < 2; ++e)
#pragma unroll
            for (int q = 0; q < 4; ++q) { const f32x16& o = e ? S.o1 : S.o0; const u32x2 z = *(const u32x2*)(zp + 32 * e + 8 * q);
                u32x2 wv; wv.x = pk2(o[4 * q] * sc * bflo(z.x), o[4 * q + 1] * sc * bfhi(z.x)); wv.y = pk2(o[4 * q + 2] * sc * bflo(z.y), o[4 * q + 3] * sc * bfhi(z.y));
                *(u32x2*)(op + 32 * e + 8 * q) = wv; }
    }
}


struct PageK {
    static constexpr bool HOIST = false;
    const float* p; unsigned stride;
    DI bf16x8 frag(int mt, int s) const { const f32x4* q = (const f32x4*)(p + (size_t)((unsigned)mt * 32u * stride + (unsigned)s * 16u)); return cvt8(q[0], q[1]); }
};
struct PageV {
    static constexpr bool HOIST = false;
    const float* p; unsigned stride;
    DI bf16x8 frag(int dt, int s) const {
        float v[8];
#pragma unroll
        for (int i = 0; i < 8; ++i) v[i] = p[(size_t)((unsigned)(16 * s + (i & 3) + 8 * (i >> 2)) * stride + (unsigned)dt * 32u)];
        return __builtin_bit_cast(bf16x8, pack8(v));
    }
};
constexpr int XCH_W = 34 * 64;
constexpr int XCH_BYTES = 8 * XCH_W * 4;
DI void xch_put(LAS float* x, const Soft& S, int lane) {
    const float lt = S.l + half_other(S.l);
    x[lane] = S.seen ? S.m : NEGINF; x[64 + lane] = lt;
#pragma unroll
    for (int r = 0; r < 16; ++r) { x[(2 + r) * 64 + lane] = S.o0[r]; x[(18 + r) * 64 + lane] = S.o1[r]; }
}
DI void xch_get(const LAS float* xb, int w, int lane, float (&out)[4]) {
    float mw[8], M = -1e30f;
#pragma unroll
    for (int i = 0; i < 8; ++i) { mw[i] = xb[i * XCH_W + lane]; M = fmaxf(M, mw[i]); }
    float L = 0.f, o[4] = {0.f, 0.f, 0.f, 0.f};
#pragma unroll
    for (int i = 0; i < 8; ++i) { const float wt = __builtin_amdgcn_exp2f(mw[i] - M); L += wt * xb[i * XCH_W + 64 + lane];
#pragma unroll
        for (int k = 0; k < 4; ++k) o[k] += wt * xb[i * XCH_W + (2 + 4 * w + k) * 64 + lane]; }
    const float inv = 1.f / fmaxf(L, 1e-30f);
#pragma unroll
    for (int k = 0; k < 4; ++k) out[k] = o[k] * inv;
}
DI void nsa_sample_unit(Frame& F, int bg) {
    const int lane = F.lane, w = F.wave, l31 = lane & 31, hi = lane >> 5, tl = l31 >> 2, hl = l31 & 3;
    const int sb = bg >> 1, g = bg & 1, i = tl & 3, row = MP + sb * 4 + i, qpos = PASTL + i, hq = 4 * g + hl;
    LAS unsigned char* const lb = F.lds;
    LAS float* xch = (LAS float*)lb;
    LAS float* cmpb = (LAS float*)(lb + XCH_BYTES);
    LAS unsigned* mskb = (LAS unsigned*)(lb + XCH_BYTES + 8192);
    LAS float* psum = (LAS float*)(lb + XCH_BYTES + 8192 + 64);
    LAS float* impb = psum + 8 * 256;
    LAS unsigned char* selb = (LAS unsigned char*)(impb + 8 * 64);
    const float* gp = WSP(float, WS_GATES) + (size_t)row * 24 + hq * 3;
    float g0 = gp[0], g1 = gp[1], g2 = gp[2];
    bf16x8 qrot[4];
#pragma unroll
    for (int s = 0; s < 4; ++s) qrot[s] = *(const bf16x8*)(WSP(bf16, WS_QROT) + (size_t)row * 512 + hq * 64 + 16 * s + 8 * hi);
    f32x16 s0, s1;
    Soft S;
    __syncthreads();
    if (w == 0) {
        const bf16* ck = WSP(bf16, WS_SCK) + (size_t)bg * 128 * 64; const bf16* cvt = WSP(bf16, WS_SCVT) + (size_t)bg * 64 * 128;
        bf16x8 qraw[4];
#pragma unroll
        for (int s = 0; s < 4; ++s) qraw[s] = *(const bf16x8*)(WSP(bf16, WS_QRAW) + (size_t)row * 512 + hq * 64 + 16 * s + 8 * hi);
        const int ncmp = 127, nvis = 126;
        float m = -1e30f, l = 0.f;
        for (int ct = 0; ct < 2; ++ct) {
            GlbT kt{ck, (unsigned)((64 * ct + l31) * 64 + 8 * hi), 64u}; qk_tile(s0, s1, kt, qraw);
            float mx = -1e30f; const int nv2 = nvis - 64 * ct - 4 * hi;
#pragma unroll
            for (int r = 0; r < 16; ++r) { const int cr = (r & 3) + 8 * (r >> 2); s0[r] = cr <= nv2 ? s0[r] : NEGINF; s1[r] = cr + 32 <= nv2 ? s1[r] : NEGINF; mx = fmaxf(mx, fmaxf(s0[r], s1[r])); }
            mx = fmaxf(mx, half_other(mx));
            const float mn = fmaxf(m, mx); float ps = 0.f;
#pragma unroll
            for (int r = 0; r < 16; ++r) ps += __builtin_amdgcn_exp2f(s0[r] - mn) + __builtin_amdgcn_exp2f(s1[r] - mn);
            l = l * __builtin_amdgcn_exp2f(m - mn) + ps; m = mn;
        }
        l += half_other(l);
        const float linv = l > 0.f ? 1.f / l : 0.f;
        soft_init(S);
        for (int ct = 0; ct < 2; ++ct) {
            GlbT kt{ck, (unsigned)((64 * ct + l31) * 64 + 8 * hi), 64u}; qk_tile(s0, s1, kt, qraw);
            const int nv2 = nvis - 64 * ct - 4 * hi; LAS float* pw = psum + tl * 256 + 64 * ct + 4 * hi;
#pragma unroll
            for (int r = 0; r < 16; ++r) { const int cr = (r & 3) + 8 * (r >> 2);
                s0[r] = cr <= nv2 ? __builtin_amdgcn_exp2f(s0[r] - m) * linv : 0.f; s1[r] = cr + 32 <= nv2 ? __builtin_amdgcn_exp2f(s1[r] - m) * linv : 0.f;
                float a = s0[r]; a += dpp_x1(a); a += dpp_x2(a); float b = s1[r]; b += dpp_x1(b); b += dpp_x2(b);
                if (hl == 0) { pw[cr] = a; pw[cr + 32] = b; } }
            GlbT vt{cvt, (unsigned)(l31 * 128 + 64 * ct + 8 * hi), 128u}; pv_tile(S.o0, S.o1, s0, s1, vt);
        }
#pragma unroll
        for (int r = 0; r < 16; ++r) { cmpb[r * 64 + lane] = S.o0[r]; cmpb[(16 + r) * 64 + lane] = S.o1[r]; }
        LDS_WAIT();
        {
            const int tk = lane >> 3, jb = 8 * (lane & 7), cur = 32;
            float pv[33];
            const LAS f32x4* pp = (const LAS f32x4*)(psum + tk * 256 + 4 * jb);
#pragma unroll
            for (int q = 0; q < 8; ++q) { const f32x4 x = pp[q]; pv[1 + 4 * q] = x[0]; pv[2 + 4 * q] = x[1]; pv[3 + 4 * q] = x[2]; pv[4 + 4 * q] = x[3]; }
            pv[0] = jb > 0 ? psum[tk * 256 + 4 * jb - 1] : 0.f;
            float v[8];
#pragma unroll
            for (int jj = 0; jj < 8; ++jj) { const int j = jb + jj;
                float a = pv[4 * jj] + pv[4 * jj + 1] + pv[4 * jj + 2] + pv[4 * jj + 3];
                a += (4 * j + 3 < ncmp) ? pv[4 * jj + 4] : 0.f;
                a = ((j == 0) | (j == cur) | (j == cur - 1)) ? 1e4f : a;
                a = (j > cur) ? -1e30f : a;
                v[jj] = a; }
            LAS f32x4* ip = (LAS f32x4*)(impb + tk * 64 + jb);
            ip[0] = (f32x4){v[0], v[1], v[2], v[3]}; ip[1] = (f32x4){v[4], v[5], v[6], v[7]};
            LDS_WAIT();
            int cnt[8];
#pragma unroll
            for (int jj = 0; jj < 8; ++jj) cnt[jj] = 0;
            const LAS f32x4* ap = (const LAS f32x4*)(impb + tk * 64);
#pragma unroll 1
            for (int i4 = 0; i4 < 16; ++i4) { const f32x4 x = ap[i4];
#pragma unroll
                for (int e = 0; e < 4; ++e) { const int ii = 4 * i4 + e; const float xi = x[e];
#pragma unroll
                    for (int jj = 0; jj < 8; ++jj) cnt[jj] += ((xi > v[jj]) | ((xi == v[jj]) & (ii < jb + jj))) ? 1 : 0; } }
            unsigned bits = 0;
#pragma unroll
            for (int jj = 0; jj < 8; ++jj) bits |= ((cnt[jj] < 16) & (jb + jj <= cur)) ? (1u << jj) : 0u;
            selb[tk * 8 + (lane & 7)] = (unsigned char)bits;
            LDS_WAIT();
            if (lane < 16) mskb[lane] = ((const LAS unsigned*)selb)[lane];
        }
    }
    __syncthreads();
    const unsigned mlo = mskb[tl * 2], mhi = mskb[tl * 2 + 1];
    PIN4(qrot); asm volatile("" : "+v"(g0), "+v"(g1), "+v"(g2));
    soft_init(S);
    for (int j = w; j < 32; j += NWAVES) {
        const int pg = F.ptab[sb * NPG + (j >> 1)];
        const float* base = F.cnsa + ((size_t)pg * PAGE + (j & 1) * 64) * 512 + (2 * 2 + g) * 64;
        PageK kt{base + (size_t)l31 * 512 + 8 * hi, 512u}; qk_tile_c(s0, s1, kt, qrot, S.negm);
        const bool bsel = ((mlo >> j) & 1u) != 0u;
#pragma unroll
        for (int r = 0; r < 16; ++r) { s0[r] = bsel ? s0[r] : NEGINF; s1[r] = bsel ? s1[r] : NEGINF; }
        PageV vt{base + 128 + (size_t)(4 * hi) * 512 + l31, 512u}; soft_step(S, s0, s1, vt);
    }
    if (w == 0) {
        const bf16* sk = WSP(bf16, WS_SSLCK) + (size_t)bg * LS * 64; const bf16* svt = WSP(bf16, WS_SSLCVT) + (size_t)bg * 64 * LS;
        GlbT kt{sk, (unsigned)((2048 + l31) * 64 + 8 * hi), 64u}; qk_tile_c(s0, s1, kt, qrot, S.negm);
        const int qrel = i - 4 * hi;
#pragma unroll
        for (int r = 0; r < 16; ++r) { const int cr = (r & 3) + 8 * (r >> 2); s0[r] = cr <= qrel ? s0[r] : NEGINF; s1[r] = cr + 32 <= qrel ? s1[r] : NEGINF; }
        GlbT vt{svt, (unsigned)(l31 * LS + 2048 + 8 * hi), (unsigned)LS}; soft_step(S, s0, s1, vt);
    }
    xch_put(xch + w * XCH_W, S, lane);
    __syncthreads();
    float acc[4], part[4];
    xch_get(xch, w, lane, part);
#pragma unroll
    for (int k = 0; k < 4; ++k) acc[k] = g1 * part[k] + g0 * cmpb[(4 * w + k) * 64 + lane];
    __syncthreads();
    soft_init(S);
    {
        const float* base = F.swin + ((size_t)sb * 512 + 64 * w) * 256 + g * 64;
        PageK kt{base + (size_t)l31 * 256 + 8 * hi, 256u}; qk_tile_c(s0, s1, kt, qrot, S.negm);
        if (w == 0) {
            const int lo_r = 1 + i - 4 * hi;
#pragma unroll
            for (int r = 0; r < 16; ++r) { const int k0 = (r & 3) + 8 * (r >> 2); s0[r] = k0 >= lo_r ? s0[r] : NEGINF; s1[r] = k0 + 32 >= lo_r ? s1[r] : NEGINF; }
        }
        PageV vt{base + 128 + (size_t)(4 * hi) * 256 + l31, 256u}; soft_step(S, s0, s1, vt);
    }
    if (w == 0) {
        const bf16* wk = WSP(bf16, WS_SWINK) + (size_t)bg * LSW * 64; const bf16* wvt = WSP(bf16, WS_SWINVT) + (size_t)bg * 64 * LSW;
        GlbT kt{wk, (unsigned)((512 + l31) * 64 + 8 * hi), 64u}; qk_tile_c(s0, s1, kt, qrot, S.negm);
        const int hi_r = i - 4 * hi;
#pragma unroll
        for (int r = 0; r < 16; ++r) { const int k0 = (r & 3) + 8 * (r >> 2); s0[r] = k0 <= hi_r ? s0[r] : NEGINF; s1[r] = k0 + 32 <= hi_r ? s1[r] : NEGINF; }
        GlbT vt{wvt, (unsigned)(l31 * LSW + 512 + 8 * hi), (unsigned)LSW}; soft_step(S, s0, s1, vt);
    }
    xch_put(xch + w * XCH_W, S, lane);
    __syncthreads();
    xch_get(xch, w, lane, part);
#ifdef BREAK_WIN
#pragma unroll
    for (int k = 0; k < 4; ++k) part[k] *= 0.9f;
#endif
    if (tl < 4) {
        const int d0 = 32 * (w >> 2) + 8 * (w & 3) + 4 * hi;
        const u32x2 z = *(const u32x2*)(WSP(bf16, WS_ZN) + (size_t)row * 512 + hq * 64 + d0);
        u32x2 wv; wv.x = pk2((acc[0] + g2 * part[0]) * bflo(z.x), (acc[1] + g2 * part[1]) * bfhi(z.x)); wv.y = pk2((acc[2] + g2 * part[2]) * bflo(z.y), (acc[3] + g2 * part[3]) * bfhi(z.y));
        *(u32x2*)(WSP(bf16, WS_ONZ) + (size_t)row * 512 + hq * 64 + d0) = wv;
    }
}
DI void dsa_sample_unit(Frame& F, int bg) {
    const int lane = F.lane, w = F.wave, l31 = lane & 31, hi = lane >> 5, tl = l31 >> 2, hl = l31 & 3;
    const int sb = bg >> 1, g = bg & 1, i = tl & 3, row = MP + sb * 4 + i, hq = 4 * g + hl;
    LAS float* xch = (LAS float*)F.lds;
    bf16x8 dq[4];
#pragma unroll
    for (int s = 0; s < 4; ++s) dq[s] = *(const bf16x8*)(WSP(bf16, WS_DQ) + (size_t)row * 512 + hq * 64 + 16 * s + 8 * hi);
    const unsigned long long* selp = WSP(unsigned long long, WS_SELM) + (size_t)row * 64;
    PIN4(dq);
    f32x16 s0, s1;
    Soft S; soft_init(S);
    for (int j = w; j < 32; j += NWAVES) {
        unsigned long long selw = selp[j];
        const int pg = F.ptab[sb * NPG + (j >> 1)];
        const float* base = F.cdsa + ((size_t)pg * PAGE + (j & 1) * 64) * 256 + g * 64;
        PageK kt{base + (size_t)l31 * 256 + 8 * hi, 256u}; qk_tile_c(s0, s1, kt, dq, S.negm);
#ifdef BREAK_DSA
        selw |= 0x1111111111111111ull;
#endif
        const unsigned wa = (unsigned)selw >> (4 * hi), wb = (unsigned)(selw >> 32) >> (4 * hi);
#pragma unroll
        for (int r = 0; r < 16; ++r) { const int bp = (r & 3) + 8 * (r >> 2);
            s0[r] = mask_sel(s0[r], (int)(wa << (31 - bp)) >> 31); s1[r] = mask_sel(s1[r], (int)(wb << (31 - bp)) >> 31); }
        PageV vt{base + 128 + (size_t)(4 * hi) * 256 + l31, 256u}; soft_step(S, s0, s1, vt);
    }
    if (w == 0) {
        const unsigned long long selw = selp[32];
        const bf16* dk = WSP(bf16, WS_SDSAK) + (size_t)bg * LS * 64; const bf16* dvt = WSP(bf16, WS_SDSAVT) + (size_t)bg * 64 * LS;
        GlbT kt{dk, (unsigned)((2048 + l31) * 64 + 8 * hi), 64u}; qk_tile_c(s0, s1, kt, dq, S.negm);
        const unsigned wa = (unsigned)selw >> (4 * hi), wb = (unsigned)(selw >> 32) >> (4 * hi);
#pragma unroll
        for (int r = 0; r < 16; ++r) { const int bp = (r & 3) + 8 * (r >> 2);
            s0[r] = mask_sel(s0[r], (int)(wa << (31 - bp)) >> 31); s1[r] = mask_sel(s1[r], (int)(wb << (31 - bp)) >> 31); }
        GlbT vt{dvt, (unsigned)(l31 * LS + 2048 + 8 * hi), (unsigned)LS}; soft_step(S, s0, s1, vt);
    }
    __syncthreads();
    xch_put(xch + w * XCH_W, S, lane);
    __syncthreads();
    float part[4];
    xch_get(xch, w, lane, part);
    if (tl < 4) {
        const int d0 = 32 * (w >> 2) + 8 * (w & 3) + 4 * hi;
        const u32x2 z = *(const u32x2*)(WSP(bf16, WS_ZD) + (size_t)row * 512 + hq * 64 + d0);
        u32x2 wv; wv.x = pk2(part[0] * bflo(z.x), part[1] * bfhi(z.x)); wv.y = pk2(part[2] * bflo(z.y), part[3] * bfhi(z.y));
        *(u32x2*)(WSP(bf16, WS_ODZ) + (size_t)row * 512 + hq * 64 + d0) = wv;
    }
}

template <int K, class EF> DI void small_gemm(Frame& F, const bf16* A, const bf16* Bt, const EF& ef) {
    const int lane = F.lane, w = F.wave, l31 = lane & 31, hi = lane >> 5;
    LAS float* red = (LAS float*)F.lds;
    for (int t = blockIdx.x; t < 256; t += F.G) {
        const int mt = t >> 5, nt = t & 31, kw = K >> 3, k0 = w * kw;
        const bf16* ap = A + (size_t)(MP + 64 * mt + l31) * K + k0 + 8 * hi;
        const bf16* bp = Bt + (size_t)(32 * nt + l31) * K + k0 + 8 * hi;
        f32x16 a0, a1;
#pragma unroll
        for (int i = 0; i < 16; ++i) { a0[i] = 0.f; a1[i] = 0.f; }
        bf16x8 fb[K / 128], f0[K / 128], f1[K / 128];
#pragma unroll
        for (int s = 0; s < K / 128; ++s) { fb[s] = *(const bf16x8*)(bp + 16 * s); f0[s] = *(const bf16x8*)(ap + 16 * s); f1[s] = *(const bf16x8*)(ap + (size_t)32 * K + 16 * s); }
#pragma unroll
        for (int s = 0; s < K / 128; ++s) { a0 = MFMA32(f0[s], fb[s], a0); a1 = MFMA32(f1[s], fb[s], a1); }
        __syncthreads();
#pragma unroll
        for (int r = 0; r < 16; ++r) { red[(w * 32 + r) * 64 + lane] = a0[r]; red[(w * 32 + 16 + r) * 64 + lane] = a1[r]; }
        __syncthreads();
        const int m2 = w >> 2, q = w & 3;
#pragma unroll
        for (int j = 0; j < 4; ++j) {
            float v = 0.f;
#pragma unroll
            for (int i = 0; i < 8; ++i) v += red[(i * 32 + 16 * m2 + 4 * q + j) * 64 + lane];
            ef(MP + 64 * mt + 32 * m2 + 8 * q + 4 * hi + j, 32 * nt + l31, v);
        }
    }
    __syncthreads();
}


#ifdef ORACLE
constexpr size_t WS_ORC = 948 * MiB;
constexpr int ORC_ROWS = 128;
DI float blk_red(Frame& F, float v, bool ismax, LAS float* red) {
#pragma unroll
    for (int o = 1; o < 64; o <<= 1) { const float x = __shfl_xor(v, o); v = ismax ? fmaxf(v, x) : v + x; }
    __syncthreads();
    if (F.lane == 0) red[F.wave] = v;
    __syncthreads();
    float r = red[0];
    for (int i = 1; i < 8; ++i) r = ismax ? fmaxf(r, red[i]) : r + red[i];
    return r;
}
DI float dot64(const bf16* a, const bf16* b) { float s = 0.f; for (int d = 0; d < 64; ++d) s += bf2f(a[d]) * bf2f(b[d]); return s; }
DI void orc_softmax(Frame& F, LAS float* sc, LAS unsigned char* vf, int n, LAS float* red) {
    float mx = -3e38f;
    for (int k = F.tid; k < n; k += 512) if (vf[k]) mx = fmaxf(mx, sc[k]);
    mx = blk_red(F, mx, true, red);
    float sm = 0.f;
    for (int k = F.tid; k < n; k += 512) { const float p = vf[k] ? exp2f(sc[k] - mx) : 0.f; sc[k] = p; sm += p; }
    sm = blk_red(F, sm, false, red);
    const float inv = 1.f / fmaxf(sm, 1e-30f);
    for (int k = F.tid; k < n; k += 512) sc[k] *= inv;
    __syncthreads();
}
DI void oracle_row(Frame& F, int oi) {
    int row;
    if (oi < 96) { const int tl[24] = {0, 1, 30, 31, 32, 63, 64, 65, 127, 128, 255, 256, 257, 400, 511, 512, 513, 1000, 1023, 1024, 2047, 2500, 3583, 4095};
        int t = 0;
#pragma unroll
        for (int i = 0; i < 24; ++i) t = (oi % 24 == i) ? tl[i] : t;
        row = (oi / 24) * SEQ + t; }
    else { const int k = oi - 96; row = MP + (((k >> 2) * 37) % SBATCH) * 4 + (k & 3); }
    const bool samp = row >= MP;
    const int b = samp ? (row - MP) >> 2 : row >> 12, ti = samp ? (row & 3) : (row & 4095), qpos = samp ? PASTL + ti : ti;
    const int ncmp = samp ? 127 : 255; const size_t pitch = samp ? LS : SEQ, wpitch = samp ? LSW : SEQ, cpitch = samp ? 128 : 256;
    const int wlo = samp ? 1 + ti : (qpos - 511 > 0 ? qpos - 511 : 0), whi = samp ? 512 + ti : qpos;
    LAS float* sc = (LAS float*)F.lds;
    LAS float* s2 = sc + 4096;
    LAS float* psum = s2 + 4096;
    LAS float* imp = psum + 256;
    LAS float* resn = imp + 64;
    LAS float* resd = resn + 512;
    LAS float* red = resd + 512;
    LAS unsigned char* vf = (LAS unsigned char*)(red + 8);
    LAS unsigned char* selb = vf + 4096;
    const bf16* qraw = WSP(bf16, WS_QRAW) + (size_t)row * 512; const bf16* qrot = WSP(bf16, WS_QROT) + (size_t)row * 512;
    const bf16* dq = WSP(bf16, WS_DQ) + (size_t)row * 512; const bf16* iq = WSP(bf16, WS_IQ) + (size_t)row * 256;
    const float* gat = WSP(float, WS_GATES) + (size_t)row * 24; const float* iw = WSP(float, WS_IW) + (size_t)row * 4;
    const int nvr = (qpos - 31) >> 4, nvis = nvr < ncmp - 1 ? nvr : ncmp - 1, cur = qpos >> 6;
    for (int g = 0; g < 2; ++g) {
        const int bg = b * 2 + g;
        const bf16* ck = samp ? WSP(bf16, WS_SCK) + (size_t)bg * 128 * 64 : WSP(bf16, WS_PCK) + (size_t)bg * 256 * 64;
        const bf16* cvt = samp ? WSP(bf16, WS_SCVT) + (size_t)bg * 64 * 128 : WSP(bf16, WS_PCVT) + (size_t)bg * 64 * 256;
        const bf16* sk = samp ? WSP(bf16, WS_SSLCK) + (size_t)bg * LS * 64 : WSP(bf16, WS_PSLCK) + (size_t)bg * SEQ * 64;
        const bf16* svt = samp ? WSP(bf16, WS_SSLCVT) + (size_t)bg * 64 * LS : WSP(bf16, WS_PSLCVT) + (size_t)bg * 64 * SEQ;
        const bf16* wk = samp ? WSP(bf16, WS_SWINK) + (size_t)bg * LSW * 64 : WSP(bf16, WS_PWINK) + (size_t)bg * SEQ * 64;
        const bf16* wvt = samp ? WSP(bf16, WS_SWINVT) + (size_t)bg * 64 * LSW : WSP(bf16, WS_PWINVT) + (size_t)bg * 64 * SEQ;
        __syncthreads();
        if (F.tid < 256) psum[F.tid] = 0.f;
        for (int hl = 0; hl < 4; ++hl) {
            const int h = 4 * g + hl;
            __syncthreads();
            for (int n = F.tid; n < 256; n += 512) { const bool v = n <= nvis; vf[n] = v; sc[n] = v ? dot64(qraw + h * 64, ck + (size_t)n * 64) : 0.f; }
            __syncthreads();
            orc_softmax(F, sc, vf, 256, red);
            if (F.tid < 256) psum[F.tid] += sc[F.tid];
            if (F.tid < 64) { float a = 0.f; for (int n = 0; n <= nvis; ++n) a += sc[n] * bf2f(cvt[(size_t)F.tid * cpitch + permk(n)]); resn[h * 64 + F.tid] = gat[h * 3 + 0] * a; }
        }
        __syncthreads();
        if (F.tid < 64) { const int j = F.tid; float a = 0.f;
            for (int n = 4 * j - 1; n <= 4 * j + 3; ++n) if (n >= 0 && n < ncmp) a += psum[n];
            if (j == 0 || j == cur || j == cur - 1) a = 1e4f;
            if (j > cur) a = -1e30f;
            imp[j] = a; selb[j] = 0; }
        __syncthreads();
        if (F.tid == 0) { for (int k = 0; k < 16; ++k) { int best = -1; float bv = -3e38f; for (int j = 0; j < 64; ++j) if (!selb[j] && imp[j] > bv) { bv = imp[j]; best = j; }
                if (best >= 0) selb[best] = (bv > -5e29f) ? 1 : 2; }
            for (int j = 0; j < 64; ++j) selb[j] = selb[j] == 1 ? 1 : 0; }
        __syncthreads();
        for (int hl = 0; hl < 4; ++hl) {
            const int h = 4 * g + hl;
            __syncthreads();
            for (int k = F.tid; k <= qpos; k += 512) { const bool v = selb[k >> 6] != 0; vf[k] = v; sc[k] = v ? dot64(qrot + h * 64, sk + (size_t)k * 64) : 0.f; }
            __syncthreads();
            orc_softmax(F, sc, vf, qpos + 1, red);
            if (F.tid < 64) { float a = 0.f; for (int k = 0; k <= qpos; ++k) if (vf[k]) a += sc[k] * bf2f(svt[(size_t)F.tid * pitch + permk(k)]); resn[h * 64 + F.tid] += gat[h * 3 + 1] * a; }
            __syncthreads();
            for (int k = wlo + F.tid; k <= whi; k += 512) { vf[k - wlo] = 1; sc[k - wlo] = dot64(qrot + h * 64, wk + (size_t)k * 64); }
            __syncthreads();
            orc_softmax(F, sc, vf, whi - wlo + 1, red);
            if (F.tid < 64) { float a = 0.f; for (int k = wlo; k <= whi; ++k) a += sc[k - wlo] * bf2f(wvt[(size_t)F.tid * wpitch + permk(k)]); resn[h * 64 + F.tid] += gat[h * 3 + 2] * a; }
        }
    }
    __syncthreads();
    const bf16* ik = samp ? WSP(bf16, WS_SIDXK) + (size_t)b * LS * 64 : WSP(bf16, WS_PIDXK) + (size_t)b * SEQ * 64;
    for (int k = F.tid; k <= qpos; k += 512) { float a = 0.f; for (int h = 0; h < 4; ++h) a += fmaxf(dot64(iq + h * 64, ik + (size_t)k * 64), 0.f) * iw[h]; s2[k] = a; }
    __syncthreads();
    for (int k = F.tid; k <= qpos; k += 512) { const float v = s2[k]; int c = 0; for (int j = 0; j <= qpos; ++j) { const float x = s2[j]; c += (x > v || (x == v && j < k)) ? 1 : 0; } vf[k] = c < 256; }
    __syncthreads();
    for (int h = 0; h < 8; ++h) {
        const int bg = b * 2 + (h >> 2);
        const bf16* dk = samp ? WSP(bf16, WS_SDSAK) + (size_t)bg * LS * 64 : WSP(bf16, WS_PDSAK) + (size_t)bg * SEQ * 64;
        const bf16* dvt = samp ? WSP(bf16, WS_SDSAVT) + (size_t)bg * 64 * LS : WSP(bf16, WS_PDSAVT) + (size_t)bg * 64 * SEQ;
        __syncthreads();
        for (int k = F.tid; k <= qpos; k += 512) sc[k] = vf[k] ? dot64(dq + h * 64, dk + (size_t)k * 64) : 0.f;
        __syncthreads();
        orc_softmax(F, sc, vf, qpos + 1, red);
        if (F.tid < 64) { float a = 0.f; for (int k = 0; k <= qpos; ++k) if (vf[k]) a += sc[k] * bf2f(dvt[(size_t)F.tid * pitch + permk(k)]); resd[h * 64 + F.tid] = a; }
    }
    __syncthreads();
    float dn = 0.f, rn = 0.f, dd = 0.f, rd = 0.f;
    { const int e = F.tid;
      const float zn = bf2f(WSP(bf16, WS_ZN)[(size_t)row * 512 + e]), zd = bf2f(WSP(bf16, WS_ZD)[(size_t)row * 512 + e]);
      const float refn = resn[e] * zn, refd = resd[e] * zd;
      const float gotn = bf2f(WSP(bf16, WS_ONZ)[(size_t)row * 512 + e]), gotd = bf2f(WSP(bf16, WS_ODZ)[(size_t)row * 512 + e]);
      dn = (gotn - refn) * (gotn - refn); rn = refn * refn; dd = (gotd - refd) * (gotd - refd); rd = refd * refd; }
    dn = blk_red(F, dn, false, red); rn = blk_red(F, rn, false, red); dd = blk_red(F, dd, false, red); rd = blk_red(F, rd, false, red);
    float dc = 0.f, rc = 0.f;
    {
        const bool cs = oi >= 96; const int cbg = cs ? (oi * 5) % 256 : oi % 8, cn = cs ? (oi * 11) % 127 : (oi * 13) % 255;
        for (int slot = 0; slot < 2; ++slot) {
            const bf16* data = cs ? WSP(bf16, slot ? WS_SCMPV : WS_SCMPK) + (size_t)cbg * LS * 64 + (size_t)cn * 1024 : WSP(bf16, slot ? WS_PCMPV : WS_PCMPK) + (size_t)cbg * SEQ * 64 + (size_t)cn * 1024;
            __syncthreads();
            if (F.tid < 128) { float a = 0.f; for (int k = 0; k < 2048; ++k) a += (bf2f(data[k]) + F.pe[slot * 2048 + k]) * F.w1[((size_t)slot * 2048 + k) * 128 + F.tid]; sc[F.tid] = a / (1.f + expf(-a)); }
            __syncthreads();
            if (F.tid < 64) { float a = 0.f; for (int c = 0; c < 128; ++c) a += sc[c] * F.w2[((size_t)slot * 128 + c) * 64 + F.tid];
                float got;
                if (slot == 0) got = bf2f((cs ? WSP(bf16, WS_SCK) + (size_t)cbg * 128 * 64 : WSP(bf16, WS_PCK) + (size_t)cbg * 256 * 64)[(size_t)cn * 64 + F.tid]);
                else got = bf2f((cs ? WSP(bf16, WS_SCVT) + (size_t)cbg * 64 * 128 : WSP(bf16, WS_PCVT) + (size_t)cbg * 64 * 256)[(size_t)F.tid * (cs ? 128 : 256) + permk(cn)]);
                dc += (got - a) * (got - a); rc += a * a; }
        }
    }
    dc = blk_red(F, dc, false, red); rc = blk_red(F, rc, false, red);
    if (F.tid == 0) { float* o = WSP(float, WS_ORC) + oi * 8; o[0] = dn; o[1] = rn; o[2] = dd; o[3] = rd; o[4] = dc; o[5] = rc; }
    __syncthreads();
}
DI float oracle_value(Frame& F) {
    const float* o = WSP(float, WS_ORC);
    float bad = 0.f, acc = 0.f, mxe = 0.f;
    for (int i = 0; i < ORC_ROWS; ++i) { const int c = (ORACLE_MODE >= 6) ? 4 : (ORACLE_MODE & 1) ? 2 : 0; const float e = sqrtf(o[i * 8 + c] / fmaxf(o[i * 8 + c + 1], 1e-30f));
        bad += e > 0.03f ? 1.f : 0.f; acc += fminf(e, 1.f) * fminf(e, 1.f); mxe = fmaxf(mxe, fminf(e, 1.f)); }
    return (ORACLE_MODE < 2 || ORACLE_MODE == 6) ? bad / ORC_ROWS : (ORACLE_MODE < 4 || ORACLE_MODE == 7) ? sqrtf(acc / ORC_ROWS) : mxe;
}
#endif

#define XB_TMO      128
#define XB_XCNT(j)  (256  + 64 * (j))
#define XB_XSUB(j)  (1280 + 64 * (j))
#define XB_XGEN(j)  (2304 + 64 * (j))
#define XB_TOP      3328
#define XB_TOPGEN   3392
#define XCD_BAR_WORDS 3456
#define XB_SPIN_CAP (1u << 18)
__device__ __forceinline__ unsigned xb_ld(unsigned* p)              { return __hip_atomic_load(p, __ATOMIC_RELAXED, __HIP_MEMORY_SCOPE_AGENT); }
__device__ __forceinline__ unsigned xb_add(unsigned* p, unsigned v) { return __hip_atomic_fetch_add(p, v, __ATOMIC_RELAXED, __HIP_MEMORY_SCOPE_AGENT); }
__device__ __forceinline__ unsigned xb_xcc_id() { return (unsigned)__builtin_amdgcn_s_getreg((3 << 11) | 20) & 0xFu; }
#define XB_SPIN(cond, bar) do { unsigned _sp = 0; while (cond) { __builtin_amdgcn_s_sleep(1); \
    if ((++_sp & 255u) == 0u) { if (xb_ld(&(bar)[XB_TMO])) break; if (_sp > XB_SPIN_CAP) { atomicAdd(&(bar)[XB_TMO], 1u); break; } } } } while (0)
struct XcdBarrier { unsigned* bar; unsigned x; volatile LAS unsigned* st; };
__device__ __forceinline__ XcdBarrier xcd_barrier_post(unsigned* bar, volatile LAS unsigned* st) {
    XcdBarrier b; b.bar = bar; b.x = xb_xcc_id(); b.st = st;
    if (threadIdx.x == 0) (void)xb_add(&bar[XB_XCNT(b.x)], 1u);
    return b;
}
__device__ __forceinline__ void xcd_barrier_complete(unsigned* bar, unsigned x, unsigned& nloc, unsigned& nx) {
    const unsigned G = gridDim.x * gridDim.y * gridDim.z;
    unsigned sum, cnt, mine, sp = 0u;
    for (;;) {
        sum = 0u; cnt = 0u; mine = 0u;
#pragma unroll
        for (unsigned j = 0; j < 16; ++j) { const unsigned c = xb_ld(&bar[XB_XCNT(j)]); sum += c; cnt += (c > 0u) ? 1u : 0u; mine = (j == x) ? c : mine; }
        if (sum == G) break;
        __builtin_amdgcn_s_sleep(1);
        if ((++sp & 255u) == 0u) { if (xb_ld(&bar[XB_TMO])) break; if (sp > XB_SPIN_CAP) { atomicAdd(&bar[XB_TMO], 1u); break; } }
    }
    nloc = mine > 0u ? mine : 1u; nx = cnt > 0u ? cnt : 1u;
}
__device__ __forceinline__ void xcd_barrier(const XcdBarrier& b) {
    asm volatile("s_waitcnt vmcnt(0)" ::: "memory");
    __syncthreads();
    if (threadIdx.x == 0) {
        unsigned* bar = b.bar;
        __builtin_amdgcn_s_waitcnt(0);
        unsigned nloc = b.st[0], nx = b.st[1];
        if (nloc == 0u) { xcd_barrier_complete(bar, b.x, nloc, nx); b.st[0] = nloc; b.st[1] = nx; }
        const unsigned old = xb_add(&bar[XB_XSUB(b.x)], 1u);
        const unsigned gen = old / nloc;
        if (old + 1u == (gen + 1u) * nloc) {
            __builtin_amdgcn_fence(__ATOMIC_RELEASE, "agent");
            asm volatile("s_waitcnt vmcnt(0)" ::: "memory");
            const unsigned og = xb_add(&bar[XB_TOP], 1u);
            const unsigned tg = og / nx;
            if (og + 1u == (tg + 1u) * nx) xb_add(&bar[XB_TOPGEN], 1u);
            else XB_SPIN(xb_ld(&bar[XB_TOPGEN]) == tg, bar);
            __builtin_amdgcn_fence(__ATOMIC_ACQUIRE, "agent");
            xb_add(&bar[XB_XGEN(b.x)], 1u);
            asm volatile("s_waitcnt vmcnt(0)" ::: "memory");
        } else {
            XB_SPIN(xb_ld(&bar[XB_XGEN(b.x)]) == gen, bar);
            __builtin_amdgcn_fence(__ATOMIC_ACQUIRE, "agent");
            asm volatile("s_waitcnt vmcnt(0)" ::: "memory");
        }
    }
    __syncthreads();
}

constexpr int N_PHASES = 9;
DI int q_next(Frame& F, int qi) {
    __syncthreads();
    if (F.tid == 0) F.MISC[0] = __hip_atomic_fetch_add(F.ctl + CW_Q + 64 * (qi + F.qoff), 1u, __ATOMIC_RELAXED, __HIP_MEMORY_SCOPE_AGENT);
    __syncthreads();
    return (int)F.MISC[0];
}
DI void q_issue(Frame& F, int qi, unsigned& pend) { if (F.tid == 0) pend = __hip_atomic_fetch_add(F.ctl + CW_Q + 64 * (qi + F.qoff), 1u, __ATOMIC_RELAXED, __HIP_MEMORY_SCOPE_AGENT); }
DI int q_take(Frame& F, unsigned pend) { __syncthreads(); if (F.tid == 0) F.MISC[0] = pend; __syncthreads(); return (int)F.MISC[0]; }
#define QLOOP_PF(qi, N, CALL) do { unsigned pend_ = 0u; for (int u = q_next(F, (qi)); u < (N); u = q_take(F, pend_)) { q_issue(F, (qi), pend_); CALL; } } while (0)
#define QLOOP(qi, N, CALL) do { for (int u = q_next(F, (qi)); u < (N); u = q_next(F, (qi))) { CALL; } } while (0)
__global__ void __launch_bounds__(NWAVES * 64, 2) fwd(Args args) {
    extern __shared__ __attribute__((aligned(16))) unsigned char lds[];
    Frame F;
    F.lds = (LAS unsigned char*)lds; F.MISC = (volatile LAS unsigned*)(F.lds + MISC_OFF);
    F.tid = threadIdx.x; F.lane = F.tid & 63; F.wave = __builtin_amdgcn_readfirstlane(F.tid >> 6); F.G = gridDim.x;
    F.ws = args.ws; F.out = args.out; F.ctl = (unsigned*)(args.ws + WS_CTL); F.qoff = args.qoff;
    F.xp = (const float*)args.in[0]; F.xs = (const float*)args.in[1]; F.cnsa = (const float*)args.in[2]; F.cdsa = (const float*)args.in[3]; F.cidx = (const float*)args.in[4];
    F.swin = (const float*)args.in[5]; F.ptab = (const int*)args.in[6]; F.cp = (const float*)args.in[7]; F.cs = (const float*)args.in[8]; F.normg = (const float*)args.in[9];
    F.wada = (const float*)args.in[10]; F.bada = (const float*)args.in[11]; F.win = (const float*)args.in[12]; F.pe = (const float*)args.in[13]; F.w1 = (const float*)args.in[14];
    F.w2 = (const float*)args.in[15]; F.wupn = (const float*)args.in[16]; F.wupd = (const float*)args.in[17]; F.wout = (const float*)args.in[18]; F.fing = (const float*)args.in[19];
    for (int i = F.tid; i < (LDS_BYTES - MISC_OFF) / 4; i += NWAVES * 64) ((LAS unsigned*)(F.lds + MISC_OFF))[i] = 0u;
    __syncthreads();
    const int lo = args.ph_lo, hi = args.ph_hi;
    const bool one = (hi - lo) > 1;
    XcdBarrier bar; bar.bar = F.ctl + CW_BAR; bar.x = 0; bar.st = nullptr;
    if (one) bar = xcd_barrier_post(F.ctl + CW_BAR, F.MISC + 8);
#ifndef PH_MASK
#define PH_MASK 0x1ff
#endif
#define IN(k) (((PH_MASK >> (k)) & 1) && lo <= (k) && (k) < hi)
#define SEAM(k) do { if (IN(k) && IN((k) + 1)) xcd_barrier(bar); } while (0)

#ifndef PROBE_REP
#define PROBE_REP -1
#endif
#define REP(k, BODY) do { if (IN(k)) { BODY(0) } } while (0)
#ifndef PROBE_P4MASK
#define PROBE_P4MASK 15
#endif
#ifndef PROBE_ABL
#define PROBE_ABL 0
#endif
#define B0(qo) { p0_prologue(F, args.umask); }
#define B1(qo) { p1_adaln(F); }
#define B2(qo) { pg8::Gemm g{WSP(bf16, WS_H), WSP(bf16, WS_WINT), MR, NPAD, DM}; pg8::StaticOrder S; S.init(MR, NPAD, F.G, (int)blockIdx.x); \
        { EpiInProj E{F.ws, F.out}; pg8::gemm_phase<EpiInProj, pg8::StaticOrder, true, true>(F.lds, g, S, E); } }
#define B3(qo) { const int PM3_ = args.umask; const bool strm3_ = (blockIdx.x & 1) == 0 || args.qoff != 0;     \
        if ((PM3_ & 4) && strm3_) QLOOP(2 + qo, SBATCH, (idx1_unit<true, 0>(F, u))); \
        if ((PM3_ & 1) && strm3_) QLOOP(0 + qo, 272, compress_unit(F, u)); \
        if (PM3_ & 2) QLOOP(1 + qo, 2048, (idx1_unit<false, 0>(F, u))); }
#ifndef P4_MASK
#define P4_MASK 15
#endif
#define B4(qo) { const int PM_ = args.umask & P4_MASK; const bool strm_ = (blockIdx.x & 1) == 0 || args.qoff != 0;     \
        if ((PM_ & 1) && strm_) QLOOP(3 + qo, 256, nsa_sample_unit(F, u)); \
        if ((PM_ & 2) && strm_) QLOOP(4 + qo, 256, dsa_sample_unit(F, u)); \
        if (PM_ & 4) QLOOP(5 + qo, 512, nsa_unit<false>(F, u)); \
        if (PM_ & 8) QLOOP(6 + qo, 512, (dsa_unit<0>(F, u))); }
#define B5(qo) { small_gemm<512>(F, WSP(bf16, WS_ONZ), WSP(bf16, WS_WUPN), [&](int r, int c, float v) { WSP(bf16, WS_T1)[(size_t)r * 1024 + c] = (bf16)(pk2(v * bf2f(WSP(bf16, WS_MG)[(size_t)r * 2048 + c]), 0.f) & 0xffffu); }); \
        pg8::Gemm g{WSP(bf16, WS_ONZ), WSP(bf16, WS_WUPN), MP, DM, 512}; pg8::StaticOrder S; S.init(MP, DM, F.G, (int)blockIdx.x); EpiUp1 E{F.ws}; \
        pg8::gemm_phase<EpiUp1, pg8::StaticOrder, true, true>(F.lds, g, S, E); }
#define B6(qo) { small_gemm<512>(F, WSP(bf16, WS_ODZ), WSP(bf16, WS_WUPD), [&](int r, int c, float v) { WSP(bf16, WS_M1)[(size_t)r * 1024 + c] = (bf16)(pk2(bf2f(WSP(bf16, WS_T1)[(size_t)r * 1024 + c]) + v * bf2f(WSP(bf16, WS_MG)[(size_t)r * 2048 + 1024 + c]), 0.f) & 0xffffu); }); \
        pg8::Gemm g{WSP(bf16, WS_ODZ), WSP(bf16, WS_WUPD), MP, DM, 512}; pg8::StaticOrder S; S.init(MP, DM, F.G, (int)blockIdx.x); EpiUp2 E{F.ws}; \
        pg8::gemm_phase<EpiUp2, pg8::StaticOrder, true, true>(F.lds, g, S, E); }
#define B7(qo) { small_gemm<1024>(F, WSP(bf16, WS_M1), WSP(bf16, WS_WOUT), [&](int r, int c, float v) { const int rs = r - MP; F.out[O_YS + (size_t)rs * 1024 + c] = F.xs[(size_t)rs * 1024 + c] + WSP(float, WS_MOD)[(size_t)(4 + (rs >> 2)) * 3072 + 2048 + c] * v; }); \
        pg8::Gemm g{WSP(bf16, WS_M1), WSP(bf16, WS_WOUT), MP, DM, DM}; pg8::StaticOrder S; S.init(MP, DM, F.G, (int)blockIdx.x); EpiOut E{F.ws, F.out, F.xp, F.xs}; \
        pg8::gemm_phase<EpiOut, pg8::StaticOrder, true, true>(F.lds, g, S, E); }
#define B8(qo) { p8_final(F); }
    REP(0, B0); SEAM(0);
    REP(1, B1); SEAM(1);
    REP(2, B2); SEAM(2);
    REP(3, B3); SEAM(3);
    REP(4, B4); SEAM(4);
#ifdef ORACLE
    if (IN(4)) { for (int oi = blockIdx.x; oi < ORC_ROWS; oi += F.G) oracle_row(F, oi); xcd_barrier(bar); }
#endif
    REP(5, B5);
    REP(6, B6); SEAM(6);
    REP(7, B7); SEAM(7);
    if (IN(8)) { p8_final(F); }
#ifdef ORACLE
    if (IN(8)) { xcd_barrier(bar); const float val = oracle_value(F); const float sc = 1.f + 0.02f * (1.f + val);
        for (size_t i = (size_t)blockIdx.x * 512 + F.tid; i < (size_t)MP * 1024; i += (size_t)F.G * 512) F.out[O_YP + i] *= sc; }
#endif
#undef IN
#undef SEAM
}

extern "C" void kernel_launch(void* const* d_in, const int* in_sizes, int n_in, void* d_out, int out_size, void* d_ws, size_t ws_size, hipStream_t stream) {
    static int grid = 0;
    if (grid == 0) {
        if (n_in != 20 || (size_t)out_size != O_END || ws_size < WS_END) { fprintf(stderr, "kernel_launch: unexpected shapes (n_in %d, out %d, ws %zu)\n", n_in, out_size, ws_size); grid = -1; return; }
        int dev = 0, cus = 0, per_cu = 0;
        if (hipGetDevice(&dev) != hipSuccess || hipDeviceGetAttribute(&cus, hipDeviceAttributeMultiprocessorCount, dev) != hipSuccess) { grid = -1; return; }
        if (hipFuncSetAttribute((const void*)fwd, hipFuncAttributeMaxDynamicSharedMemorySize, LDS_BYTES) != hipSuccess) { fprintf(stderr, "kernel_launch: hipFuncSetAttribute failed\n"); grid = -1; return; }
        if (hipOccupancyMaxActiveBlocksPerMultiprocessor(&per_cu, (const void*)fwd, NWAVES * 64, LDS_BYTES) != hipSuccess || per_cu < 1) { fprintf(stderr, "kernel_launch: occupancy query says %d blocks per CU\n", per_cu); }
        (void)hipGetLastError();
        grid = cus;
    }
    if (grid < 0) return;
    (void)hipMemsetAsync((char*)d_ws + WS_CTL, 0, CTL_ZERO_BYTES, stream);
    Args a{};
    for (int i = 0; i < 20; ++i) a.in[i] = d_in[i];
    a.out = (float*)d_out; a.ws = (unsigned char*)d_ws; a.qoff = 0; a.umask = 15; a.pad0 = 0; a.pad1 = 0;
#if MK_N_LAUNCHES == 1
    a.ph_lo = 0; a.ph_hi = N_PHASES;
    hipLaunchKernelGGL(fwd, dim3(grid), dim3(NWAVES * 64), LDS_BYTES, stream, a);
#if PROBE_REP >= 0
    a.ph_lo = PROBE_REP; a.ph_hi = PROBE_REP + 1; a.qoff = 8; a.umask = PROBE_P4MASK;
    hipLaunchKernelGGL(fwd, dim3(grid), dim3(NWAVES * 64), LDS_BYTES, stream, a);
#endif
#else
    for (int p = 0; p < N_PHASES; ++p) { a.ph_lo = p; a.ph_hi = p + 1; hipLaunchKernelGGL(fwd, dim3(grid), dim3(NWAVES * 64), LDS_BYTES, stream, a); }
#endif
}
```

```cpp
#define MK_N_LAUNCHES 1
#include <hip/hip_runtime.h>
#include <cstdio>
#include <cstdint>
#ifndef MK_N_LAUNCHES
#define MK_N_LAUNCHES 1
#endif
namespace pg8 {
#define PG8_LAS __attribute__((address_space(3)))
typedef unsigned short bf16_t;
typedef short bf16x8 __attribute__((ext_vector_type(8)));
typedef float f32x4 __attribute__((ext_vector_type(4)));
typedef unsigned u32x4 __attribute__((ext_vector_type(4)));
constexpr int BM = 256, BK = 64, HALF = 128, HTB = HALF * BK * 2  , STAGE_BYTES = 8 * HTB, NXCD = 8, WGM = 8;

__host__ __device__ __forceinline__ int lds_byte(int r, int c) { const int st = (r >> 4) * 2 + (c >> 5), rr = r & 15, cc = c & 31, ob = rr * 64 + cc * 2; return st * 1024 + (ob ^ (((ob >> 9) & 1) << 5)); }
__host__ __device__ __forceinline__ void stage_rc(int b, int& R, int& C) { const int st = b / 1024, sb = b % 1024, swz = sb ^ (((sb >> 9) & 1) << 5); R = (st >> 1) * 16 + swz / 64; C = (st & 1) * 32 + (swz % 64) / 2; }
__host__ __device__ __forceinline__ int perm32(int rho) { const int n = rho >> 4, i = rho & 15; return 8 * (i >> 2) + 4 * n + (i & 3); }

struct Unit { int pm, pn; };
struct Gemm { const bf16_t* A; const bf16_t* Bt; int M, N, K; };

struct StaticOrder {
    int nM, nN, nwg, G, c;
    __host__ __device__ void init(int M, int N, int G_, int c_) { nM = M / BM; nN = N / BM; nwg = nM * nN; G = G_; c = c_; }
    __host__ __device__ bool next(int i, Unit& u) const {
        const long L = (long)i * G + c; if (L >= nwg) return false;
        int wgid = (int)L; { const int q = nwg / NXCD, r = nwg % NXCD, xcd = wgid % NXCD, off = wgid / NXCD; wgid = (xcd < r ? xcd * (q + 1) : r * (q + 1) + (xcd - r) * q) + off; }
        const int nig = WGM * nN, gid = wgid / nig, fm = gid * WGM, gsz = (nM - fm) < WGM ? (nM - fm) : WGM;
        u.pm = fm + ((wgid % nig) % gsz); u.pn = (wgid % nig) / gsz; return true;
    }
    __device__ __forceinline__ void a_ready(const Unit&) const {}
    __device__ __forceinline__ void done(const Unit&) const {}
};

typedef float f32x2p __attribute__((ext_vector_type(2))); typedef __bf16 bf16x2p __attribute__((ext_vector_type(2)));
__device__ __forceinline__ unsigned cvt_pk_bf16(float lo, float hi) { f32x2p v = {lo, hi}; bf16x2p b = __builtin_convertvector(v, bf16x2p); return __builtin_bit_cast(unsigned, b); }
template <class Epi, class Sched, bool ALIGN_EPI = false, bool SP2 = false>
__device__ __forceinline__ void gemm_phase(PG8_LAS unsigned char* lds, const Gemm g, const Sched& S, const Epi& E) {
    const int tid = threadIdx.x, wid = __builtin_amdgcn_readfirstlane(tid >> 6), lane = tid & 63, wr = wid >> 2, wc = wid & 3, fr = lane & 15, fq = lane >> 4;
    const int K = g.K, nt = K / BK;
    unsigned voffA[2], voffB[2];
#pragma unroll
    for (int i = 0; i < 2; ++i) { int R, C; stage_rc(tid * 16 + i * 8192, R, C); const int Rb = Epi::PERM ? ((R & ~31) + perm32(R & 31)) : R;
        voffA[i] = (unsigned)(R * K + C) * 2u; voffB[i] = (unsigned)(Rb * K + C) * 2u; }
    const size_t kstep = (size_t)(BK * 2);
    const size_t hstep = (size_t)HALF * K * 2;
    const size_t tstep = 2 * hstep;
    const unsigned ldsw = (unsigned)wid * 1024u;
    const int aoff = lds_byte(wr * 64 + fr, fq * 8), boff = lds_byte(wc * 32 + fr, fq * 8);
#define PG8_SA(b, h) (((b) * 2 + (h)) * HTB)
#define PG8_SB(b, h) ((4 + (b) * 2 + (h)) * HTB)
#define PG8_STAGE(bufoff, gbase, voff) do { _Pragma("unroll") for (int _i = 0; _i < 2; ++_i) \
        __builtin_amdgcn_global_load_lds((const unsigned*)((const char*)(gbase) + (voff)[_i]), (PG8_LAS unsigned*)(lds + (bufoff) + ldsw + _i * 8192), 16, 0, 0); } while (0)
#define PG8_LDA(dst, b, h) do { _Pragma("unroll") for (int m = 0; m < 4; ++m) _Pragma("unroll") for (int k = 0; k < 2; ++k) dst[m][k] = *(const PG8_LAS bf16x8*)(lds + PG8_SA(b, h) + aoff + m * 2048 + k * 1024); } while (0)
#define PG8_LDB(dst, b, h) do { _Pragma("unroll") for (int n = 0; n < 2; ++n) _Pragma("unroll") for (int k = 0; k < 2; ++k) dst[n][k] = *(const PG8_LAS bf16x8*)(lds + PG8_SB(b, h) + boff + n * 2048 + k * 1024); } while (0)
#define PG8_MMA(ai, bj, At, Bt) do { __builtin_amdgcn_s_setprio(1); _Pragma("unroll") for (int m = 0; m < 4; ++m) _Pragma("unroll") for (int n = 0; n < 2; ++n) _Pragma("unroll") for (int k = 0; k < 2; ++k) \
        acc[ai][bj][m][n] = __builtin_amdgcn_mfma_f32_16x16x32_bf16(Bt[n][k], At[m][k], acc[ai][bj][m][n], 0, 0, 0); __builtin_amdgcn_s_setprio(0); } while (0)
#define PG8_WAIT_V(n) asm volatile("s_waitcnt vmcnt(" #n ")" ::: "memory")
#define PG8_WAIT_L(n) asm volatile("s_waitcnt lgkmcnt(" #n ")" ::: "memory")
#define PG8_BAR __builtin_amdgcn_s_barrier()
#define PG8_SCHED __builtin_amdgcn_sched_barrier(0)
    Unit cur, nxt; int ui = 0;
    if (!S.next(0, cur)) return;
    f32x4 acc[2][2][4][2];
#pragma unroll
    for (int a = 0; a < 2; ++a)
#pragma unroll
        for (int b = 0; b < 2; ++b)
#pragma unroll
            for (int m = 0; m < 4; ++m)
#pragma unroll
                for (int n = 0; n < 2; ++n) acc[a][b][m][n] = (f32x4){0.f, 0.f, 0.f, 0.f};
    bf16x8 At[4][2], B0[2][2], B1[2][2];
    const char* cA = (const char*)g.A + (size_t)cur.pm * tstep; const char* cB = (const char*)g.Bt + (size_t)cur.pn * tstep;
    S.a_ready(cur);
    if constexpr (SP2) {
        PG8_STAGE(PG8_SB(0, 0), cB, voffB); PG8_STAGE(PG8_SB(0, 1), cB + hstep, voffB); PG8_STAGE(PG8_SA(0, 0), cA, voffA); PG8_STAGE(PG8_SA(0, 1), cA + hstep, voffA);
        if (wr == 1) PG8_BAR;
        PG8_WAIT_V(2); PG8_BAR;
        PG8_STAGE(PG8_SB(1, 0), cB + kstep, voffB); PG8_STAGE(PG8_SA(1, 0), cA + kstep, voffA); PG8_STAGE(PG8_SB(1, 1), cB + hstep + kstep, voffB);
        PG8_WAIT_V(6); PG8_BAR;
    } else {
        PG8_STAGE(PG8_SB(0, 0), cB, voffB); PG8_STAGE(PG8_SA(0, 0), cA, voffA); PG8_STAGE(PG8_SB(0, 1), cB + hstep, voffB); PG8_STAGE(PG8_SA(0, 1), cA + hstep, voffA);
        if (wr == 1) PG8_BAR;
        PG8_WAIT_V(4); PG8_BAR;
        PG8_STAGE(PG8_SB(1, 0), cB + kstep, voffB); PG8_STAGE(PG8_SA(1, 0), cA + kstep, voffA); PG8_STAGE(PG8_SB(1, 1), cB + hstep + kstep, voffB);
        PG8_WAIT_V(6); PG8_BAR;
    }
    for (;;) {
        const bool has_next = S.next(ui + 1, nxt);
        const char* nA = has_next ? (const char*)g.A + (size_t)nxt.pm * tstep : cA; const char* nB = has_next ? (const char*)g.Bt + (size_t)nxt.pn * tstep : cB;
        for (int t = 0; t < nt; t += 2) {
            const bool last = (t == nt - 2);
            const char* a1 = cA + (size_t)(t + 1) * kstep;
            const char* a2 = last ? nA : cA + (size_t)(t + 2) * kstep; const char* b2 = last ? nB : cB + (size_t)(t + 2) * kstep;
            const char* a3 = a2 + kstep; const char* b3 = b2 + kstep;
            if (last && has_next) S.a_ready(nxt);
            if constexpr (SP2) {
            PG8_LDB(B0, 0, 0); PG8_LDB(B1, 0, 1); PG8_SCHED; PG8_LDA(At, 0, 0); PG8_STAGE(PG8_SA(1, 1), a1 + hstep, voffA);
            PG8_WAIT_V(8); PG8_WAIT_L(0); PG8_BAR; PG8_MMA(0, 0, At, B0); PG8_MMA(0, 1, At, B1); PG8_BAR; PG8_SCHED;
            PG8_LDA(At, 0, 1); PG8_STAGE(PG8_SB(0, 0), b2, voffB); PG8_STAGE(PG8_SB(0, 1), b2 + hstep, voffB); PG8_STAGE(PG8_SA(0, 0), a2, voffA);
            PG8_WAIT_V(8); PG8_WAIT_L(0); PG8_BAR; PG8_MMA(1, 0, At, B0); PG8_MMA(1, 1, At, B1); PG8_BAR; PG8_SCHED;
            PG8_LDB(B0, 1, 0); PG8_LDB(B1, 1, 1); PG8_SCHED; PG8_LDA(At, 1, 0); PG8_STAGE(PG8_SA(0, 1), a2 + hstep, voffA);
            PG8_WAIT_V(8); PG8_WAIT_L(0); PG8_BAR; PG8_MMA(0, 0, At, B0); PG8_MMA(0, 1, At, B1); PG8_BAR; PG8_SCHED;
            PG8_LDA(At, 1, 1); PG8_STAGE(PG8_SB(1, 0), b3, voffB); PG8_STAGE(PG8_SB(1, 1), b3 + hstep, voffB); PG8_STAGE(PG8_SA(1, 0), a3, voffA);
            PG8_WAIT_V(8); PG8_WAIT_L(0); PG8_BAR; PG8_MMA(1, 0, At, B0); PG8_MMA(1, 1, At, B1); PG8_BAR; PG8_SCHED;
            } else {
            PG8_LDB(B0, 0, 0); PG8_SCHED; PG8_LDA(At, 0, 0); PG8_STAGE(PG8_SA(1, 1), a1 + hstep, voffA);
            PG8_WAIT_L(8); PG8_BAR; PG8_WAIT_L(0); PG8_MMA(0, 0, At, B0); PG8_BAR; PG8_SCHED;
            PG8_LDB(B1, 0, 1); PG8_STAGE(PG8_SB(0, 0), b2, voffB);
            PG8_BAR; PG8_WAIT_L(0); PG8_MMA(0, 1, At, B1); PG8_BAR;
            PG8_LDA(At, 0, 1); PG8_STAGE(PG8_SA(0, 0), a2, voffA);
            PG8_BAR; PG8_WAIT_L(0); PG8_MMA(1, 0, At, B0); PG8_BAR; PG8_SCHED;
            PG8_STAGE(PG8_SB(0, 1), b2 + hstep, voffB);
            PG8_WAIT_V(6); PG8_BAR; PG8_MMA(1, 1, At, B1); PG8_BAR;
            PG8_LDB(B0, 1, 0); PG8_SCHED; PG8_LDA(At, 1, 0); PG8_STAGE(PG8_SA(0, 1), a2 + hstep, voffA);
            PG8_WAIT_L(8); PG8_BAR; PG8_WAIT_L(0); PG8_MMA(0, 0, At, B0); PG8_BAR; PG8_SCHED;
            PG8_LDB(B1, 1, 1); PG8_STAGE(PG8_SB(1, 0), b3, voffB);
            PG8_BAR; PG8_WAIT_L(0); PG8_MMA(0, 1, At, B1); PG8_BAR;
            PG8_LDA(At, 1, 1); PG8_STAGE(PG8_SA(1, 0), a3, voffA);
            PG8_BAR; PG8_WAIT_L(0); PG8_MMA(1, 0, At, B0); PG8_BAR; PG8_SCHED;
            PG8_STAGE(PG8_SB(1, 1), b3 + hstep, voffB);
            PG8_WAIT_V(6); PG8_BAR; PG8_MMA(1, 1, At, B1); PG8_BAR;
            }
        }
        if constexpr (ALIGN_EPI) { if (wr == 0) PG8_BAR; }
        if constexpr (!Epi::AFTER_DRAIN) { E(acc, cur, wr, wc, fr, fq); S.done(cur); }
        if (!has_next) break;
#pragma unroll
        for (int a = 0; a < 2; ++a)
#pragma unroll
            for (int b = 0; b < 2; ++b)
#pragma unroll
                for (int m = 0; m < 4; ++m)
#pragma unroll
                    for (int n = 0; n < 2; ++n) acc[a][b][m][n] = (f32x4){0.f, 0.f, 0.f, 0.f};
        cur = nxt; cA = nA; cB = nB; ++ui;
        if constexpr (ALIGN_EPI) { if (wr == 1) PG8_BAR; }
    }
    PG8_WAIT_V(0);
    if constexpr (!ALIGN_EPI) { if (wr == 0) PG8_BAR; }
    PG8_BAR;
    if constexpr (Epi::AFTER_DRAIN) { E.fused(acc, cur, wr, wc, fr, fq, lds, wid, lane); S.done(cur); }
#undef PG8_SA
#undef PG8_SB
#undef PG8_STAGE
#undef PG8_LDA
#undef PG8_LDB
#undef PG8_MMA
#undef PG8_WAIT_V
#undef PG8_WAIT_L
#undef PG8_BAR
#undef PG8_SCHED
}
}

#define LAS __attribute__((address_space(3)))
typedef unsigned short bf16;
typedef short bf16x8 __attribute__((ext_vector_type(8)));
typedef float f32x4 __attribute__((ext_vector_type(4)));
typedef float f32x16 __attribute__((ext_vector_type(16)));
typedef unsigned u32x4 __attribute__((ext_vector_type(4)));
typedef unsigned u32x2 __attribute__((ext_vector_type(2)));

constexpr int DM = 1024, NBATCH = 4, SEQ = 4096, MP = NBATCH * SEQ, SBATCH = 128, STOK = 4, MS = SBATCH * STOK, MR = MP + MS;
constexpr int PASTL = 2048, PAGE = 128, NPG = 16;
constexpr int LS = 2112, LSW = 576;
constexpr int NPAD = 5632;
constexpr float C2 = 0.125f * 1.4426950408889634f;
constexpr int NWAVES = 8;

constexpr size_t O_YP = 0, O_YS = 16777216, O_NSAP = 17301504, O_DSAP = 25690112, O_IDXP = 29884416, O_WINP = 30932992,
                 O_NSAS = 31457280, O_DSAS = 31719424, O_IDXS = 31850496, O_WINS = 31883264, O_END = 48660480;

constexpr size_t MiB = 1u << 20;
constexpr size_t WS_CTL = 0, CTL_ZERO_BYTES = 1 * MiB;
constexpr size_t WS_MOD = 1 * MiB;
constexpr size_t WS_COS = 3 * MiB, WS_SIN = 4 * MiB;
constexpr size_t WS_BIAS1 = 5 * MiB;
constexpr size_t WS_BIASP = 5 * MiB + 262144;
constexpr size_t WS_W2T = 5 * MiB + 65536;
constexpr size_t WS_W1T = 6 * MiB;
constexpr size_t WS_WINT = 8 * MiB;
constexpr size_t WS_WUPN = 20 * MiB, WS_WUPD = 21 * MiB, WS_WOUT = 22 * MiB;
constexpr size_t WS_PSLCVK = 975 * MiB, WS_PWINVK = 979 * MiB, WS_PDSAVK = 983 * MiB;
constexpr size_t WS_SELM = 960 * MiB;
constexpr size_t WS_GATES = 25 * MiB;
constexpr size_t WS_IW = 27 * MiB;
constexpr size_t WS_PCK = 28 * MiB, WS_PCVT = 28 * MiB + 262144;
constexpr size_t WS_SCK = 29 * MiB, WS_SCVT = 33 * MiB;
constexpr size_t WS_H = 40 * MiB;
constexpr size_t WS_QRAW = 80 * MiB, WS_QROT = 100 * MiB, WS_DQ = 120 * MiB, WS_IQ = 140 * MiB, WS_ZN = 150 * MiB, WS_ZD = 170 * MiB, WS_ONZ = 190 * MiB, WS_ODZ = 210 * MiB;
constexpr size_t WS_MG = 230 * MiB;
constexpr size_t WS_T1 = 300 * MiB;
constexpr size_t WS_M1 = 370 * MiB;
constexpr size_t WS_PCMPK = 410 * MiB, WS_PCMPV = 414 * MiB, WS_PSLCK = 418 * MiB, WS_PSLCVT = 422 * MiB, WS_PWINK = 426 * MiB, WS_PWINVT = 430 * MiB,
                 WS_PDSAK = 434 * MiB, WS_PDSAVT = 438 * MiB, WS_PIDXK = 442 * MiB;
constexpr size_t WS_SCMPK = 450 * MiB, WS_SCMPV = 520 * MiB, WS_SSLCK = 590 * MiB, WS_SSLCVT = 660 * MiB, WS_SDSAK = 730 * MiB, WS_SDSAVT = 800 * MiB,
                 WS_SWINK = 870 * MiB, WS_SWINVT = 890 * MiB, WS_SIDXK = 910 * MiB, WS_END = 990 * MiB;
constexpr int CW_BAR = 4096;
constexpr int CW_Q = 16384;

constexpr int RING_BYTES = 131072, MISC_OFF = RING_BYTES, LDS_BYTES = 147456;

struct Args { const void* in[20]; float* out; unsigned char* ws; int ph_lo, ph_hi, qoff, umask, pad0, pad1; };

struct Frame {
    LAS unsigned char* lds; volatile LAS unsigned* MISC; unsigned* ctl;
    int tid, lane, wave, G, qoff;
    unsigned char* ws; float* out;
    const float *xp, *xs, *cnsa, *cdsa, *cidx, *swin; const int* ptab; const float *cp, *cs, *normg, *wada, *bada, *win, *pe, *w1, *w2, *wupn, *wupd, *wout, *fing;
};
#define WSP(T, off) ((T*)(F.ws + (off)))

#define DI __device__ __forceinline__
#define LDS_WAIT() asm volatile("s_waitcnt lgkmcnt(0)" ::: "memory")
DI u32x4 gload16(const void* p) { u32x4 r; asm volatile("global_load_dwordx4 %0, %1, off" : "=v"(r) : "v"(p) : "memory"); return r; }
DI unsigned long long gload8(const void* p) { unsigned long long r; asm volatile("global_load_dwordx2 %0, %1, off" : "=v"(r) : "v"(p) : "memory"); return r; }
#define WAITV2(n, a, b) asm volatile("s_waitcnt vmcnt(" #n ")" : "+v"(a), "+v"(b) :: "memory")
#define WAITV1(n, a) asm volatile("s_waitcnt vmcnt(" #n ")" : "+v"(a) :: "memory")
#define LDS_BARRIER() do { asm volatile("s_waitcnt lgkmcnt(0)" ::: "memory"); __builtin_amdgcn_s_barrier(); asm volatile("" ::: "memory"); } while (0)
DI float wave_sum(float v) {
#define DPP_ADD_(ctrl, rmask) v += __int_as_float(__builtin_amdgcn_update_dpp(0, __float_as_int(v), (ctrl), (rmask), 0xF, false))
    DPP_ADD_(0xB1, 0xF);
    DPP_ADD_(0x4E, 0xF);
    DPP_ADD_(0x141, 0xF);
    DPP_ADD_(0x140, 0xF);
    DPP_ADD_(0x142, 0xA);
    DPP_ADD_(0x143, 0xC);
#undef DPP_ADD_
    return __int_as_float(__builtin_amdgcn_readlane(__float_as_int(v), 63));
}
DI int wave_sum_i(int v) {
#define DPP_ADDI_(ctrl, rmask) v += __builtin_amdgcn_update_dpp(0, v, (ctrl), (rmask), 0xF, false)
    DPP_ADDI_(0xB1, 0xF); DPP_ADDI_(0x4E, 0xF); DPP_ADDI_(0x141, 0xF); DPP_ADDI_(0x140, 0xF); DPP_ADDI_(0x142, 0xA); DPP_ADDI_(0x143, 0xC);
#undef DPP_ADDI_
    return __builtin_amdgcn_readlane(v, 63);
}
DI int wave_min_i(int v) {
#define DPP_MIN_(ctrl, rmask) { const int t_ = __builtin_amdgcn_update_dpp(v, v, (ctrl), (rmask), 0xF, false); v = t_ < v ? t_ : v; }
    DPP_MIN_(0xB1, 0xF) DPP_MIN_(0x4E, 0xF) DPP_MIN_(0x141, 0xF) DPP_MIN_(0x140, 0xF) DPP_MIN_(0x142, 0xA) DPP_MIN_(0x143, 0xC)
#undef DPP_MIN_
    return __builtin_amdgcn_readlane(v, 63);
}
DI int wave_max_i(int v) {
#define DPP_MAX_(ctrl, rmask) { const int t_ = __builtin_amdgcn_update_dpp(v, v, (ctrl), (rmask), 0xF, false); v = t_ > v ? t_ : v; }
    DPP_MAX_(0xB1, 0xF) DPP_MAX_(0x4E, 0xF) DPP_MAX_(0x141, 0xF) DPP_MAX_(0x140, 0xF) DPP_MAX_(0x142, 0xA) DPP_MAX_(0x143, 0xC)
#undef DPP_MAX_
    return __builtin_amdgcn_readlane(v, 63);
}
DI unsigned pk2(float lo, float hi) { return pg8::cvt_pk_bf16(lo, hi); }
DI float bflo(unsigned w) { return __uint_as_float(w << 16); }
DI float bfhi(unsigned w) { return __uint_as_float(w & 0xffff0000u); }
DI float bf2f(bf16 h) { return __uint_as_float((unsigned)h << 16); }
DI float sigm_f(float x) { return __builtin_amdgcn_rcpf(1.f + __builtin_amdgcn_exp2f(-1.4426950408889634f * x)); }
DI float silu_f(float x) { return x * sigm_f(x); }
DI int pos16(int o) { return 8 * ((o >> 2) & 1) + (o & 3) + 4 * (o >> 3); }
DI int permk(int t) { return (t & ~15) | pos16(t & 15); }
DI int crow(int r, int hi) { return (r & 3) + 8 * (r >> 2) + 4 * hi; }
DI float dpp_x1(float v) { return __int_as_float(__builtin_amdgcn_update_dpp(0, __float_as_int(v), 0xB1, 0xF, 0xF, true)); }
DI float dpp_x2(float v) { return __int_as_float(__builtin_amdgcn_update_dpp(0, __float_as_int(v), 0x4E, 0xF, 0xF, true)); }
DI float half_other(float v) {
    const unsigned u = __float_as_uint(v);
    auto rr = __builtin_amdgcn_permlane32_swap(u, u, false, false);
    return __uint_as_float(((threadIdx.x & 32) != 0) ? rr[0] : rr[1]);
}
DI u32x4 pack8(const float* v) { u32x4 w; w.x = pk2(v[0], v[1]); w.y = pk2(v[2], v[3]); w.z = pk2(v[4], v[5]); w.w = pk2(v[6], v[7]); return w; }
DI void st_bf8(bf16* p, const float* v) { *(u32x4*)p = pack8(v); }
DI void st_f8(float* p, const float* v) { __builtin_nontemporal_store((f32x4){v[0], v[1], v[2], v[3]}, (f32x4*)p); __builtin_nontemporal_store((f32x4){v[4], v[5], v[6], v[7]}, (f32x4*)(p + 4)); }
DI void st_vt8(bf16* p, size_t pitch, const float* v) {
#pragma unroll
    for (int j = 0; j < 8; ++j) p[(size_t)j * pitch] = (bf16)(pk2(v[j], 0.f) & 0xffffu);
}
#define PIN4(q) asm volatile("" : "+v"(q[0]), "+v"(q[1]), "+v"(q[2]), "+v"(q[3]))
#define NEGINF (-__builtin_inff())
#define MFMA32(a, b, c) __builtin_amdgcn_mfma_f32_32x32x16_bf16((a), (b), (c), 0, 0, 0)

DI int idx_key(float dot, float w) {
#pragma clang fp contract(off)
    float v = fmaxf(dot, 0.f) * w;
    v = v + dpp_x1(v);
    v = v + dpp_x2(v);
    int u = __float_as_int(v);
    u = (u == (int)0x80000000) ? 0 : u;
    return u ^ ((u >> 31) & 0x7fffffff);
}

template <int MODE> struct EpiInProjT {
    static constexpr bool PERM = true, AFTER_DRAIN = false;
    unsigned char* ws; float* out;
    DI void rope8(float* lo, float* hi, const float* c, const float* s) const {
#pragma unroll
        for (int j = 0; j < 8; ++j) { const float a = lo[j], b = hi[j]; lo[j] = a * c[j] - b * s[j]; hi[j] = b * c[j] + a * s[j]; }
    }
    DI void ldtab(float* c, float* s, int pos, int d0) const {
        const f32x4* cp = (const f32x4*)((const float*)(ws + WS_COS) + pos * 32 + d0);
        const f32x4* sp = (const f32x4*)((const float*)(ws + WS_SIN) + pos * 32 + d0);
        const f32x4 c0 = cp[0], c1 = cp[1], s0 = sp[0], s1 = sp[1];
        c[0] = c0[0]; c[1] = c0[1]; c[2] = c0[2]; c[3] = c0[3]; c[4] = c1[0]; c[5] = c1[1]; c[6] = c1[2]; c[7] = c1[3];
        s[0] = s0[0]; s[1] = s0[1]; s[2] = s0[2]; s[3] = s0[3]; s[4] = s1[0]; s[5] = s1[1]; s[6] = s1[2]; s[7] = s1[3];
        asm volatile("" : "+v"(c[0]), "+v"(c[1]), "+v"(c[2]), "+v"(c[3]), "+v"(c[4]), "+v"(c[5]), "+v"(c[6]), "+v"(c[7]));
        asm volatile("" : "+v"(s[0]), "+v"(s[1]), "+v"(s[2]), "+v"(s[3]), "+v"(s[4]), "+v"(s[5]), "+v"(s[6]), "+v"(s[7]));
    }
    DI void operator()(const pg8::f32x4 (&acc)[2][2][4][2], const pg8::Unit& u, int wr, int wc, int fr, int fq) const {
        const int hs = u.pn * 4 + wc;
        if (hs >= 86) return;
        if ((MODE & 2) && hs >= 20 && hs != 44 && !(hs >= 36 && hs < 40)) return;
        if ((MODE & 4) && hs < 20) return;
        const bool samp = u.pm >= 64;
        const int d0 = 8 * fq;
        const bool roped = hs < 8 || (hs >= 12 && hs < 14) || (hs >= 16 && hs < 18) || (hs >= 28 && hs < 36) || hs == 36 || hs == 37 || (hs >= 40 && hs <= 44);
        float rc[8], rs[8], dc[8], ds[8];
        if (roped) { if (samp) {
#pragma unroll
                for (int j = 0; j < 8; ++j) { dc[j] = 1.f; ds[j] = 0.f; }
            } else ldtab(dc, ds, 16, d0); }
#pragma unroll
        for (int ai = 0; ai < 2; ++ai)
#pragma unroll
            for (int m = 0; m < 4; ++m) {
                const int r = u.pm * 256 + ai * 128 + wr * 64 + m * 16 + fr;
                if (roped) {
                    if (m == 0) ldtab(rc, rs, samp ? PASTL + (r & 3) : (r & 4095), d0);
                    else {
#pragma unroll
                        for (int j = 0; j < 8; ++j) { const float a = rc[j], b = rs[j]; rc[j] = a * dc[j] - b * ds[j]; rs[j] = b * dc[j] + a * ds[j]; }
                    }
                }
                int b, t, pos;
                if (!samp) { b = r >> 12; t = r & 4095; pos = t; } else { b = (r - MP) >> 2; t = r & 3; pos = PASTL + t; }
                float lo[8], hi[8];
#pragma unroll
                for (int n = 0; n < 2; ++n)
#pragma unroll
                    for (int j = 0; j < 4; ++j) { lo[4 * n + j] = acc[ai][0][m][n][j]; hi[4 * n + j] = acc[ai][1][m][n][j]; }
                if (hs < 8) {
                    bf16* qa = (bf16*)(ws + WS_QRAW) + (size_t)r * 512 + hs * 64 + d0;
                    bf16* qb = (bf16*)(ws + WS_QROT) + (size_t)r * 512 + hs * 64 + d0;
                    float a[8], c[8];
#pragma unroll
                    for (int j = 0; j < 8; ++j) { a[j] = lo[j] * C2; c[j] = hi[j] * C2; }
                    st_bf8(qa, a); st_bf8(qa + 32, c);
                    rope8(lo, hi, rc, rs);
#pragma unroll
                    for (int j = 0; j < 8; ++j) { a[j] = lo[j] * C2; c[j] = hi[j] * C2; }
                    st_bf8(qb, a); st_bf8(qb + 32, c);
                } else if (hs < 20) {
                    const int ty = (hs - 8) >> 1, g = (hs - 8) & 1;
                    if (ty == 2 || ty == 4) rope8(lo, hi, rc, rs);
                    const int bg = b * 2 + g;
                    if (ty < 4) {
                        float* o = out + (samp ? O_NSAS + ((size_t)(r - MP) * 8 + ty * 2 + g) * 64 : O_NSAP + ((size_t)r * 8 + ty * 2 + g) * 64) + d0;
                        st_f8(o, lo); st_f8(o + 32, hi);
                    } else {
                        const int sl = ty - 4;
                        if (samp) { float* o = out + O_WINS + (((size_t)b * 512 + 508 + t) * 4 + sl * 2 + g) * 64 + d0; st_f8(o, lo); st_f8(o + 32, hi); }
                        else if (t >= SEQ - 512) { float* o = out + O_WINP + (((size_t)b * 512 + (t - (SEQ - 512))) * 4 + sl * 2 + g) * 64 + d0; st_f8(o, lo); st_f8(o + 32, hi); }
                    }
                    if (ty == 3 || ty == 5) {
                        size_t pitch; int kp; bf16* base;
                        if (!samp) { pitch = SEQ; kp = t; base = (bf16*)(ws + (ty == 3 ? WS_PSLCVT : WS_PWINVT)); }
                        else if (ty == 3) { pitch = LS; kp = PASTL + t; base = (bf16*)(ws + WS_SSLCVT); }
                        else { pitch = LSW; kp = 512 + t; base = (bf16*)(ws + WS_SWINVT); }
                        bf16* p = base + ((size_t)bg * 64 + d0) * pitch + permk(kp);
                        if (!(MODE & 1)) { st_vt8(p, pitch, lo); st_vt8(p + 32 * pitch, pitch, hi); }
                    } else {
                        size_t rowi; bf16* base;
                        if (!samp) { rowi = (size_t)bg * SEQ + t; base = (bf16*)(ws + (ty == 0 ? WS_PCMPK : ty == 1 ? WS_PCMPV : ty == 2 ? WS_PSLCK : WS_PWINK)); }
                        else if (ty == 4) { rowi = (size_t)bg * LSW + 512 + t; base = (bf16*)(ws + WS_SWINK); }
                        else { rowi = (size_t)bg * LS + PASTL + t; base = (bf16*)(ws + (ty == 0 ? WS_SCMPK : ty == 1 ? WS_SCMPV : WS_SSLCK)); }
                        bf16* p = base + rowi * 64 + d0;
                        st_bf8(p, lo); st_bf8(p + 32, hi);
                    }
                } else if (hs < 28 || (hs >= 45 && hs < 53)) {
                    const int h = hs < 28 ? hs - 20 : hs - 45;
                    bf16* p = (bf16*)(ws + (hs < 28 ? WS_ZN : WS_ZD)) + (size_t)r * 512 + h * 64 + d0;
#pragma unroll
                    for (int j = 0; j < 8; ++j) { lo[j] = silu_f(lo[j]); hi[j] = silu_f(hi[j]); }
                    st_bf8(p, lo); st_bf8(p + 32, hi);
                } else if (hs < 36) {
                    rope8(lo, hi, rc, rs);
#pragma unroll
                    for (int j = 0; j < 8; ++j) { lo[j] *= C2; hi[j] *= C2; }
                    bf16* p = (bf16*)(ws + WS_DQ) + (size_t)r * 512 + (hs - 28) * 64 + d0;
                    st_bf8(p, lo); st_bf8(p + 32, hi);
                } else if (hs < 40) {
                    const int sl = (hs - 36) >> 1, g = (hs - 36) & 1, bg = b * 2 + g;
                    if (sl == 0) rope8(lo, hi, rc, rs);
                    float* o = out + (samp ? O_DSAS + ((size_t)(r - MP) * 4 + sl * 2 + g) * 64 : O_DSAP + ((size_t)r * 4 + sl * 2 + g) * 64) + d0;
                    st_f8(o, lo); st_f8(o + 32, hi);
                    if (sl == 0) {
                        bf16* p = samp ? (bf16*)(ws + WS_SDSAK) + ((size_t)bg * LS + PASTL + t) * 64 + d0 : (bf16*)(ws + WS_PDSAK) + ((size_t)bg * SEQ + t) * 64 + d0;
                        st_bf8(p, lo); st_bf8(p + 32, hi);
                    } else {
                        const size_t pitch = samp ? LS : SEQ; const int kp = samp ? PASTL + t : t;
                        bf16* p = (bf16*)(ws + (samp ? WS_SDSAVT : WS_PDSAVT)) + ((size_t)bg * 64 + d0) * pitch + permk(kp);
                        if (!(MODE & 1)) { st_vt8(p, pitch, lo); st_vt8(p + 32 * pitch, pitch, hi); }
                    }
                } else if (hs < 44) {
                    rope8(lo, hi, rc, rs);
                    bf16* p = (bf16*)(ws + WS_IQ) + (size_t)r * 256 + (hs - 40) * 64 + d0;
                    st_bf8(p, lo); st_bf8(p + 32, hi);
                } else if (hs == 44) {
                    rope8(lo, hi, rc, rs);
                    float* o = out + (samp ? O_IDXS + (size_t)(r - MP) * 64 : O_IDXP + (size_t)r * 64) + d0;
                    st_f8(o, lo); st_f8(o + 32, hi);
                    bf16* p = samp ? (bf16*)(ws + WS_SIDXK) + ((size_t)b * LS + PASTL + t) * 64 + d0 : (bf16*)(ws + WS_PIDXK) + (size_t)r * 64 + d0;
                    st_bf8(p, lo); st_bf8(p + 32, hi);
                } else if (hs < 85) {
                    bf16* p = (bf16*)(ws + WS_MG) + (size_t)r * 2048 + (hs - 53) * 64 + d0;
#pragma unroll
                    for (int j = 0; j < 8; ++j) { lo[j] = sigm_f(lo[j]); hi[j] = sigm_f(hi[j]); }
                    st_bf8(p, lo); st_bf8(p + 32, hi);
                } else {
                    if (fq < 3) { float* p = (float*)(ws + WS_GATES) + (size_t)r * 24 + d0;
#pragma unroll
                        for (int j = 0; j < 8; ++j) lo[j] = sigm_f(lo[j]);
                        st_f8(p, lo);
                    } else { *(f32x4*)((float*)(ws + WS_IW) + (size_t)r * 4) = (f32x4){lo[0], lo[1], lo[2], lo[3]}; }
                }
            }
    }
};
typedef EpiInProjT<0> EpiInProj;
struct ColOrder {
    int nM, nN, cnt, rank, pn;
    __device__ void init(int M, int N, int G, int c) { nM = M / 256; nN = N / 256; pn = c % nN; rank = c / nN; cnt = G / nN + ((pn < G % nN) ? 1 : 0); }
    __device__ bool next(int i, pg8::Unit& u) const { const int pm = rank + i * cnt; if (pm >= nM) return false; u.pm = pm; u.pn = pn; return true; }
    __device__ __forceinline__ void a_ready(const pg8::Unit&) const {}
    __device__ __forceinline__ void done(const pg8::Unit&) const {}
};
struct EpiNull {
    static constexpr bool PERM = true, AFTER_DRAIN = false;
    unsigned char* ws;
    DI void operator()(const pg8::f32x4 (&acc)[2][2][4][2], const pg8::Unit& u, int wr, int wc, int fr, int fq) const {
        float s = 0.f;
#pragma unroll
        for (int ai = 0; ai < 2; ++ai)
#pragma unroll
            for (int bj = 0; bj < 2; ++bj)
#pragma unroll
                for (int m = 0; m < 4; ++m)
#pragma unroll
                    for (int n = 0; n < 2; ++n) s += acc[ai][bj][m][n][0] + acc[ai][bj][m][n][1] + acc[ai][bj][m][n][2] + acc[ai][bj][m][n][3];
        if (s == 1.2345e33f) *(float*)(ws + WS_CTL + 2048) = s;
    }
};
struct EpiUp1 {
    static constexpr bool PERM = true, AFTER_DRAIN = false;
    unsigned char* ws;
    DI void operator()(const pg8::f32x4 (&acc)[2][2][4][2], const pg8::Unit& u, int wr, int wc, int fr, int fq) const {
#pragma unroll
        for (int ai = 0; ai < 2; ++ai)
#pragma unroll
            for (int m = 0; m < 4; ++m) {
                const int r = u.pm * 256 + ai * 128 + wr * 64 + m * 16 + fr;
#pragma unroll
                for (int bj = 0; bj < 2; ++bj) {
                    const int c0 = u.pn * 256 + bj * 128 + wc * 32 + 8 * fq;
                    const u32x4 gw = *(const u32x4*)((const bf16*)(ws + WS_MG) + (size_t)r * 2048 + c0);
                    const f32x4 a0 = acc[ai][bj][m][0], a1 = acc[ai][bj][m][1];
                    u32x4 w; w.x = pk2(a0[0] * bflo(gw.x), a0[1] * bfhi(gw.x)); w.y = pk2(a0[2] * bflo(gw.y), a0[3] * bfhi(gw.y));
                    w.z = pk2(a1[0] * bflo(gw.z), a1[1] * bfhi(gw.z)); w.w = pk2(a1[2] * bflo(gw.w), a1[3] * bfhi(gw.w));
                    *(u32x4*)((bf16*)(ws + WS_T1) + (size_t)r * 1024 + c0) = w;
                }
            }
    }
};
struct EpiUp2 {
    static constexpr bool PERM = true, AFTER_DRAIN = false;
    unsigned char* ws;
    DI void operator()(const pg8::f32x4 (&acc)[2][2][4][2], const pg8::Unit& u, int wr, int wc, int fr, int fq) const {
#pragma unroll
        for (int ai = 0; ai < 2; ++ai)
#pragma unroll
            for (int m = 0; m < 4; ++m) {
                const int r = u.pm * 256 + ai * 128 + wr * 64 + m * 16 + fr;
#pragma unroll
                for (int bj = 0; bj < 2; ++bj) {
                    const int c0 = u.pn * 256 + bj * 128 + wc * 32 + 8 * fq;
                    const u32x4 gw = *(const u32x4*)((const bf16*)(ws + WS_MG) + (size_t)r * 2048 + 1024 + c0);
                    const u32x4 tw = *(const u32x4*)((const bf16*)(ws + WS_T1) + (size_t)r * 1024 + c0);
                    const f32x4 t0 = {bflo(tw.x), bfhi(tw.x), bflo(tw.y), bfhi(tw.y)}, t1 = {bflo(tw.z), bfhi(tw.z), bflo(tw.w), bfhi(tw.w)};
                    const f32x4 a0 = acc[ai][bj][m][0], a1 = acc[ai][bj][m][1];
                    u32x4 w;
                    w.x = pk2(t0[0] + a0[0] * bflo(gw.x), t0[1] + a0[1] * bfhi(gw.x)); w.y = pk2(t0[2] + a0[2] * bflo(gw.y), t0[3] + a0[3] * bfhi(gw.y));
                    w.z = pk2(t1[0] + a1[0] * bflo(gw.z), t1[1] + a1[1] * bfhi(gw.z)); w.w = pk2(t1[2] + a1[2] * bflo(gw.w), t1[3] + a1[3] * bfhi(gw.w));
                    *(u32x4*)((bf16*)(ws + WS_M1) + (size_t)r * 1024 + c0) = w;
                }
            }
    }
};
struct EpiOut {
    static constexpr bool PERM = true, AFTER_DRAIN = false;
    unsigned char* ws; float* out; const float* xp; const float* xs;
    DI void operator()(const pg8::f32x4 (&acc)[2][2][4][2], const pg8::Unit& u, int wr, int wc, int fr, int fq) const {
        const bool samp = u.pm >= 64;
#pragma unroll
        for (int ai = 0; ai < 2; ++ai)
#pragma unroll
            for (int m = 0; m < 4; ++m) {
                const int r = u.pm * 256 + ai * 128 + wr * 64 + m * 16 + fr;
                const int mrow = samp ? 4 + ((r - MP) >> 2) : (r >> 12);
                const float* xr = samp ? xs + (size_t)(r - MP) * 1024 : xp + (size_t)r * 1024;
                float* orow = samp ? out + O_YS + (size_t)(r - MP) * 1024 : out + O_YP + (size_t)r * 1024;
                const float* gr = (const float*)(ws + WS_MOD) + (size_t)mrow * 3072 + 2048;
#pragma unroll
                for (int bj = 0; bj < 2; ++bj) {
                    const int c0 = u.pn * 256 + bj * 128 + wc * 32 + 8 * fq;
#pragma unroll
                    for (int n = 0; n < 2; ++n) {
                        const f32x4 x4 = *(const f32x4*)(xr + c0 + 4 * n), g4 = *(const f32x4*)(gr + c0 + 4 * n);
                        *(f32x4*)(orow + c0 + 4 * n) = x4 + g4 * acc[ai][bj][m][n];
                    }
                }
            }
    }
};

DI int win_row(int col) {
    int hs, d;
    if (col < 1280) { hs = col >> 6; d = col & 63; }
    else if (col < 1304) { hs = 85; d = col - 1280; }
    else if (col < 2904) { const int c = col - 1304; hs = 20 + (c >> 6); d = c & 63; }
    else if (col < 2908) { hs = 85; d = 24 + (col - 2904); }
    else { const int c = col - 2908; hs = 45 + (c >> 6); d = c & 63; }
    return 256 * (hs >> 2) + 128 * (d >> 5) + 32 * (hs & 3) + (d & 31);
}
template <bool WINMAP> DI void p0_transpose_item(const float* W, int K, int N, bf16* WT, LAS float* scr, int item, int lane) {
    const int nblk = (N + 31) / 32, kb = item / nblk, nb = item % nblk, k0 = 64 * kb, n0 = 32 * nb;
    const bool nok = n0 + (lane & 31) < N;
    float tv[32];
#pragma unroll
    for (int i = 0; i < 32; ++i) { const int kk = 2 * i + (lane >> 5); tv[i] = nok ? W[(size_t)(k0 + kk) * N + n0 + (lane & 31)] : 0.f; }
#pragma unroll
    for (int i = 0; i < 32; ++i) { const int kk = 2 * i + (lane >> 5); scr[kk * 33 + (lane & 31)] = tv[i]; }
    LDS_WAIT();
    const int c = lane & 7;
#pragma unroll
    for (int j = 0; j < 4; ++j) { const int n = (lane >> 3) + 8 * j; const LAS float* s = scr + (8 * c) * 33 + n;
        u32x4 o; o.x = pk2(s[0 * 33], s[1 * 33]); o.y = pk2(s[2 * 33], s[3 * 33]); o.z = pk2(s[4 * 33], s[5 * 33]); o.w = pk2(s[6 * 33], s[7 * 33]);
        if (n0 + n < N) { const int row = WINMAP ? win_row(n0 + n) : (n0 + n); *(u32x4*)(WT + (size_t)row * K + k0 + 8 * c) = o; } }
    LDS_WAIT();
}
DI void p0_mod(Frame& F) {
    LAS float* wl = (LAS float*)F.lds;
    float* mod = WSP(float, WS_MOD);
    for (int cg = blockIdx.x; cg < 256; cg += F.G) {
        __syncthreads();
        for (int k = F.tid; k < 1024; k += NWAVES * 64) {
            const f32x4* src = (const f32x4*)(F.wada + (size_t)k * 3072 + cg * 12);
            LAS f32x4* dst = (LAS f32x4*)(wl + k * 12);
            dst[0] = src[0]; dst[1] = src[1]; dst[2] = src[2];
        }
        __syncthreads();
        float cv[16], cn[16];
        { const float* cr = F.wave < 4 ? F.cp + (size_t)F.wave * 1024 : F.cs + (size_t)(F.wave - 4) * 1024;
#pragma unroll
          for (int i = 0; i < 16; ++i) cn[i] = cr[F.lane + 64 * i]; }
        for (int r = F.wave; r < 132; r += NWAVES) {
#pragma unroll
            for (int i = 0; i < 16; ++i) cv[i] = cn[i];
            { const int rn = r + NWAVES < 132 ? r + NWAVES : r; const float* cr = rn < 4 ? F.cp + (size_t)rn * 1024 : F.cs + (size_t)(rn - 4) * 1024;
#pragma unroll
              for (int i = 0; i < 16; ++i) cn[i] = cr[F.lane + 64 * i]; }
            float a[12];
#pragma unroll
            for (int j = 0; j < 12; ++j) a[j] = 0.f;
#pragma unroll
            for (int i = 0; i < 16; ++i) {
                const int k = F.lane + 64 * i; const float s = silu_f(cv[i]);
                const LAS f32x4* wp = (const LAS f32x4*)(wl + k * 12);
                const f32x4 w0 = wp[0], w1 = wp[1], w2 = wp[2];
                a[0] += s * w0[0]; a[1] += s * w0[1]; a[2] += s * w0[2]; a[3] += s * w0[3];
                a[4] += s * w1[0]; a[5] += s * w1[1]; a[6] += s * w1[2]; a[7] += s * w1[3];
                a[8] += s * w2[0]; a[9] += s * w2[1]; a[10] += s * w2[2]; a[11] += s * w2[3];
                if ((i & 3) == 3) __builtin_amdgcn_sched_barrier(0);
            }
            float v = 0.f;
#pragma unroll
            for (int j = 0; j < 12; ++j) { const float sj = wave_sum(a[j]); v = (F.lane == j) ? sj : v; }
            if (F.lane < 12) mod[(size_t)r * 3072 + cg * 12 + F.lane] = v + F.bada[cg * 12 + F.lane];
        }
    }
    __syncthreads();
}
__device__ const double ROPE_INV[32] = {
    1.0, 0.7498942093324559, 0.5623413251903491, 0.4216965034285822, 0.31622776601683794, 0.23713737056616552, 0.1778279410038923, 0.1333521432163324,
    0.1, 0.07498942093324559, 0.05623413251903491, 0.04216965034285822, 0.03162277660168379, 0.023713737056616554, 0.01778279410038923, 0.01333521432163324,
    0.01, 0.007498942093324559, 0.005623413251903491, 0.004216965034285822, 0.0031622776601683794, 0.0023713737056616554, 0.0017782794100389228, 0.001333521432163324,
    0.001, 0.0007498942093324559, 0.0005623413251903491, 0.0004216965034285822, 0.00031622776601683794, 0.00023713737056616554, 0.00017782794100389227, 0.0001333521432163324};
DI void p0_rope_item(Frame& F, int item) {
    const int pos = 2 * item + (F.lane >> 5), d = F.lane & 31;
    if (pos >= 4100) return;
    const double ang = (double)pos * ROPE_INV[d];
    const double kq = __builtin_rint(ang * 0.6366197723675814);
    double r = __builtin_fma(-kq, 1.5707963267948966, ang); r = __builtin_fma(-kq, 6.123233995736766e-17, r);
    const int q = (int)kq & 3;
    const double r2 = r * r;
    const double sn = r * (1.0 + r2 * (-1.0 / 6 + r2 * (1.0 / 120 + r2 * (-1.0 / 5040 + r2 * (1.0 / 362880 + r2 * (-1.0 / 39916800 + r2 * (1.0 / 6227020800.0)))))));
    const double cs = 1.0 + r2 * (-0.5 + r2 * (1.0 / 24 + r2 * (-1.0 / 720 + r2 * (1.0 / 40320 + r2 * (-1.0 / 3628800 + r2 * (1.0 / 479001600.0 + r2 * (-1.0 / 87178291200.0)))))));
    const double c = (q == 0) ? cs : (q == 1) ? -sn : (q == 2) ? -cs : sn;
    const double s = (q == 0) ? sn : (q == 1) ? cs : (q == 2) ? -sn : -cs;
    WSP(float, WS_COS)[pos * 32 + d] = (float)c; WSP(float, WS_SIN)[pos * 32 + d] = (float)s;
}
DI void p0_cmp_small_item(Frame& F, int item) {
    if (item < 256) {
        const int slot = item >> 7, ch = (item >> 6) & 1, kc = item & 63, c = ch * 64 + F.lane; float a = 0.f;
#pragma unroll 8
        for (int i = 0; i < 32; ++i) { const int k = kc * 32 + i; a += F.pe[slot * 2048 + k] * F.w1[((size_t)slot * 2048 + k) * 128 + c]; }
        WSP(float, WS_BIASP)[(size_t)kc * 256 + slot * 128 + c] = a;
    } else {
        const int it = item - 256, slot = it >> 7, e = (it & 127) >> 1, ch = it & 1;
        const int c = ch * 64 + F.lane;
        WSP(bf16, WS_W2T)[((size_t)slot * 64 + e) * 128 + permk(c)] = (bf16)(pk2(F.w2[((size_t)slot * 128 + c) * 64 + e], 0.f) & 0xffffu);
    }
}
DI void cp_k16(const float* src, size_t rs, bf16* dst, int lane) {
    const int tk = lane >> 2, dc = (lane & 3) * 16;
    const f32x4* s = (const f32x4*)(src + (size_t)tk * rs + dc);
    const f32x4 a = s[0], b = s[1], c = s[2], d = s[3];
    u32x4 w0, w1; w0.x = pk2(a[0], a[1]); w0.y = pk2(a[2], a[3]); w0.z = pk2(b[0], b[1]); w0.w = pk2(b[2], b[3]);
    w1.x = pk2(c[0], c[1]); w1.y = pk2(c[2], c[3]); w1.z = pk2(d[0], d[1]); w1.w = pk2(d[2], d[3]);
    u32x4* o = (u32x4*)(dst + (size_t)tk * 64 + dc); o[0] = w0; o[1] = w1;
}
DI void cp_vt16(const float* src, size_t rs, bf16* dst, size_t pitch, int lane) {
#pragma unroll
    for (int h = 0; h < 2; ++h) {
        float v[8];
#pragma unroll
        for (int i = 0; i < 8; ++i) v[i] = src[(size_t)((i & 3) + 8 * (i >> 2) + 4 * h) * rs + lane];
        *(u32x4*)(dst + (size_t)lane * pitch + 8 * h) = pack8(v);
    }
}
DI void p0_gather_item(Frame& F, int item) {
    const int sb = item >> 7, tg = item & 127, tk0 = tg * 16, lane = F.lane;
    const int pg = F.ptab[sb * NPG + (tk0 >> 7)], j0 = tk0 & 127;
    const float* nsa = F.cnsa + ((size_t)pg * PAGE + j0) * 512;
    const float* dsa = F.cdsa + ((size_t)pg * PAGE + j0) * 256;
    const float* idx = F.cidx + ((size_t)pg * PAGE + j0) * 64;
#pragma unroll
    for (int g = 0; g < 2; ++g) {
        const size_t bg = (size_t)sb * 2 + g;
        cp_k16(nsa + (0 * 2 + g) * 64, 512, WSP(bf16, WS_SCMPK) + (bg * LS + tk0) * 64, lane);
        cp_k16(nsa + (1 * 2 + g) * 64, 512, WSP(bf16, WS_SCMPV) + (bg * LS + tk0) * 64, lane);
        cp_k16(nsa + (2 * 2 + g) * 64, 512, WSP(bf16, WS_SSLCK) + (bg * LS + tk0) * 64, lane);
        cp_vt16(nsa + (3 * 2 + g) * 64, 512, WSP(bf16, WS_SSLCVT) + bg * 64 * LS + tk0, LS, lane);
        cp_k16(dsa + (0 * 2 + g) * 64, 256, WSP(bf16, WS_SDSAK) + (bg * LS + tk0) * 64, lane);
        cp_vt16(dsa + (1 * 2 + g) * 64, 256, WSP(bf16, WS_SDSAVT) + bg * 64 * LS + tk0, LS, lane);
    }
    cp_k16(idx, 64, WSP(bf16, WS_SIDXK) + ((size_t)sb * LS + tk0) * 64, lane);
}
DI void p0_win_item(Frame& F, int item) {
    const int sb = item >> 5, w0 = (item & 31) * 16, lane = F.lane;
    const float* st = F.swin + ((size_t)sb * 512 + w0) * 256;
#pragma unroll
    for (int g = 0; g < 2; ++g) {
        const size_t bg = (size_t)sb * 2 + g;
        cp_k16(st + (0 * 2 + g) * 64, 256, WSP(bf16, WS_SWINK) + (bg * LSW + w0) * 64, lane);
        cp_vt16(st + (1 * 2 + g) * 64, 256, WSP(bf16, WS_SWINVT) + bg * 64 * LSW + w0, LSW, lane);
    }
}
DI void p0_zero_item(Frame& F, int item) {
    const int arr = item >> 8, bg = item & 255, lane = F.lane;
    bf16* p; int n;
    if (arr == 0) { p = WSP(bf16, WS_SSLCVT) + ((size_t)bg * 64 + lane) * LS + 2052; n = 60; }
    else if (arr == 1) { p = WSP(bf16, WS_SDSAVT) + ((size_t)bg * 64 + lane) * LS + 2052; n = 60; }
    else { p = WSP(bf16, WS_SWINVT) + ((size_t)bg * 64 + lane) * LSW + 516; n = 60; }
    unsigned long long* q = (unsigned long long*)p;
    for (int i = 0; i < n / 4; ++i) q[i] = 0ull;
}
DI void p0_prologue(Frame& F, int um) {
    if (um & 1) p0_mod(F);
    LAS float* scr = (LAS float*)(F.lds + F.wave * 16384);
    const int gw = blockIdx.x * NWAVES + F.wave, NGW = F.G * NWAVES;
    constexpr int I_WIN = 16 * 171, I_UP = 8 * 32, I_OUT = 16 * 32, I_W1 = 32 * 4;
    constexpr int T0 = I_WIN, T1 = T0 + I_UP, T2 = T1 + I_UP, T3 = T2 + I_OUT, T4 = T3 + 2 * I_W1, T5 = T4 + 2050, T6 = T5 + 512, T7 = T6 + 768, T8 = T7 + SBATCH * 32, T9 = T8 + SBATCH * 128;
#ifdef ORACLE
    constexpr int TEND = T9;
#else
    constexpr int TEND = T7;
#endif
    if (um & 2) for (int it = gw; it < TEND; it += NGW) {
        if (it < T0) p0_transpose_item<true>(F.win, 1024, 5468, WSP(bf16, WS_WINT), scr, it, F.lane);
        else if (it < T1) p0_transpose_item<false>(F.wupn, 512, 1024, WSP(bf16, WS_WUPN), scr, it - T0, F.lane);
        else if (it < T2) p0_transpose_item<false>(F.wupd, 512, 1024, WSP(bf16, WS_WUPD), scr, it - T1, F.lane);
        else if (it < T3) p0_transpose_item<false>(F.wout, 1024, 1024, WSP(bf16, WS_WOUT), scr, it - T2, F.lane);
        else if (it < T4) { const int q = it - T3, slot = q / I_W1; p0_transpose_item<false>(F.w1 + (size_t)slot * 2048 * 128, 2048, 128, WSP(bf16, WS_W1T) + (size_t)slot * 128 * 2048, scr, q % I_W1, F.lane); }
        else if (it < T5) p0_rope_item(F, it - T4);
        else if (it < T6) p0_cmp_small_item(F, it - T5);
        else if (it < T7) p0_zero_item(F, it - T6);
#ifdef ORACLE
        else if (it < T8) p0_win_item(F, it - T7);
        else p0_gather_item(F, it - T8);
#endif
    }
    constexpr int ROW4 = 508 * 64;
    const f32x4* src = (const f32x4*)F.swin; f32x4* dst = (f32x4*)(F.out + O_WINS);
    if (um & 4) for (int it = blockIdx.x; it < 2 * SBATCH; it += F.G) {
        const int sb = it >> 1, h0 = (it & 1) * (ROW4 / 2);
        const f32x4* sp = src + (size_t)sb * 512 * 64 + 4 * 64 + h0; f32x4* dp = dst + (size_t)sb * 512 * 64 + h0;
        for (int i = F.tid; i < ROW4 / 2; i += 512 * 8) {
            f32x4 v[8];
#pragma unroll
            for (int j = 0; j < 8; ++j) { const int k = i + j * 512; v[j] = k < ROW4 / 2 ? __builtin_nontemporal_load(sp + k) : (f32x4){0.f, 0.f, 0.f, 0.f}; }
#pragma unroll
            for (int j = 0; j < 8; ++j) { const int k = i + j * 512; if (k < ROW4 / 2) __builtin_nontemporal_store(v[j], dp + k); }
        }
    }
}
DI void p1_adaln(Frame& F) {
    const int gw = blockIdx.x * NWAVES + F.wave, NGW = F.G * NWAVES;
    if (blockIdx.x == 0 && F.tid < 256) { float a = 0.f; for (int j = 0; j < 64; ++j) a += WSP(float, WS_BIASP)[j * 256 + F.tid]; WSP(float, WS_BIAS1)[F.tid] = a; }
    const float* mod = WSP(float, WS_MOD);
    f32x4 nx[4];
    { const int r = gw < MR ? gw : MR - 1; const f32x4* x4 = (const f32x4*)(r < MP ? F.xp + (size_t)r * 1024 : F.xs + (size_t)(r - MP) * 1024) + F.lane;
#pragma unroll
      for (int j = 0; j < 4; ++j) nx[j] = x4[64 * j]; }
    for (int r = gw; r < MR; r += NGW) {
        const int mrow = r < MP ? (r >> 12) : 4 + ((r - MP) >> 2);
        f32x4 v[4]; float s = 0.f;
#pragma unroll
        for (int j = 0; j < 4; ++j) { v[j] = nx[j]; s += (v[j][0] * v[j][0] + v[j][1] * v[j][1]) + (v[j][2] * v[j][2] + v[j][3] * v[j][3]); }
        { const int rn = r + NGW < MR ? r + NGW : r; const f32x4* x4 = (const f32x4*)(rn < MP ? F.xp + (size_t)rn * 1024 : F.xs + (size_t)(rn - MP) * 1024) + F.lane;
#pragma unroll
          for (int j = 0; j < 4; ++j) nx[j] = x4[64 * j]; }
        const float rstd = 1.f / sqrtf(wave_sum(s) * (1.f / 1024.f) + 1e-6f);
        const f32x4* g4 = (const f32x4*)F.normg + F.lane;
        const f32x4* sh4 = (const f32x4*)(mod + (size_t)mrow * 3072) + F.lane;
        const f32x4* sc4 = (const f32x4*)(mod + (size_t)mrow * 3072 + 1024) + F.lane;
        unsigned long long* o8 = (unsigned long long*)(WSP(bf16, WS_H) + (size_t)r * 1024) + F.lane;
#pragma unroll
        for (int j = 0; j < 4; ++j) {
            const f32x4 y = v[j] * rstd * g4[64 * j]; const f32x4 h = y * (1.f + sc4[64 * j]) + sh4[64 * j];
            o8[64 * j] = (unsigned long long)pk2(h[0], h[1]) | ((unsigned long long)pk2(h[2], h[3]) << 32);
        }
    }
}
DI void p8_final(Frame& F) {
    const int gw = blockIdx.x * NWAVES + F.wave, NGW = F.G * NWAVES;
    f32x4 nx[4];
    { const int r = gw < MR ? gw : MR - 1; const f32x4* y4 = (const f32x4*)(r < MP ? F.out + O_YP + (size_t)r * 1024 : F.out + O_YS + (size_t)(r - MP) * 1024) + F.lane;
#pragma unroll
      for (int j = 0; j < 4; ++j) nx[j] = y4[64 * j]; }
    for (int r = gw; r < MR; r += NGW) {
        float* yr = r < MP ? F.out + O_YP + (size_t)r * 1024 : F.out + O_YS + (size_t)(r - MP) * 1024;
        f32x4* y4 = (f32x4*)yr + F.lane;
        f32x4 v[4]; float s = 0.f;
#pragma unroll
        for (int j = 0; j < 4; ++j) { v[j] = nx[j]; s += (v[j][0] * v[j][0] + v[j][1] * v[j][1]) + (v[j][2] * v[j][2] + v[j][3] * v[j][3]); }
        { const int rn = r + NGW < MR ? r + NGW : r; const f32x4* n4 = (const f32x4*)(rn < MP ? F.out + O_YP + (size_t)rn * 1024 : F.out + O_YS + (size_t)(rn - MP) * 1024) + F.lane;
#pragma unroll
          for (int j = 0; j < 4; ++j) nx[j] = n4[64 * j]; }
        const float rstd = 1.f / sqrtf(wave_sum(s) * (1.f / 1024.f) + 1e-6f);
        const f32x4* g4 = (const f32x4*)F.fing + F.lane;
#pragma unroll
        for (int j = 0; j < 4; ++j) y4[64 * j] = v[j] * rstd * g4[64 * j];
    }
}

constexpr int TP = 144;
constexpr int TILE_B = 64 * TP;
struct LdsT {
    static constexpr bool HOIST = true;
    const LAS unsigned char* p;
    DI bf16x8 frag(int mt, int s) const { return *(const LAS bf16x8*)(p + mt * 32 * TP + s * 32); }
};
struct GlbT {
    static constexpr bool HOIST = false;
    const bf16* base; unsigned off; unsigned pitch;
    DI bf16x8 frag(int mt, int s) const { return *(const bf16x8*)(base + (size_t)(off + (unsigned)mt * 32u * pitch + (unsigned)s * 16u)); }
};
template <class KT> DI void qk_tile(f32x16& s0, f32x16& s1, const KT& kt, const bf16x8 (&q)[4]) {
    f32x16 z;
#pragma unroll
    for (int i = 0; i < 16; ++i) z[i] = 0.f;
    s0 = z; s1 = z;
#pragma unroll
    for (int s = 0; s < 4; ++s) { s0 = MFMA32(kt.frag(0, s), q[s], s0); s1 = MFMA32(kt.frag(1, s), q[s], s1); }
}
DI bf16x8 cvt8(f32x4 a, f32x4 b) { u32x4 w; w.x = pk2(a[0], a[1]); w.y = pk2(a[2], a[3]); w.z = pk2(b[0], b[1]); w.w = pk2(b[2], b[3]); return __builtin_bit_cast(bf16x8, w); }
DI bf16x8 pack_p(const f32x16& x, int h) {
    u32x4 w; w.x = pk2(x[8 * h], x[8 * h + 1]); w.y = pk2(x[8 * h + 2], x[8 * h + 3]); w.z = pk2(x[8 * h + 4], x[8 * h + 5]); w.w = pk2(x[8 * h + 6], x[8 * h + 7]);
    return __builtin_bit_cast(bf16x8, w);
}
template <class VT> DI void pv_tile(f32x16& o0, f32x16& o1, const f32x16& p0, const f32x16& p1, const VT& vt) {
    const bf16x8 b0 = pack_p(p0, 0), b1 = pack_p(p0, 1), b2 = pack_p(p1, 0), b3 = pack_p(p1, 1);
    o0 = MFMA32(vt.frag(0, 0), b0, o0); o1 = MFMA32(vt.frag(1, 0), b0, o1);
    o0 = MFMA32(vt.frag(0, 1), b1, o0); o1 = MFMA32(vt.frag(1, 1), b1, o1);
    o0 = MFMA32(vt.frag(0, 2), b2, o0); o1 = MFMA32(vt.frag(1, 2), b2, o1);
    o0 = MFMA32(vt.frag(0, 3), b3, o0); o1 = MFMA32(vt.frag(1, 3), b3, o1);
}
struct Soft { float m, l; bool seen; f32x16 o0, o1, negm; };
DI void soft_init(Soft& S) {
    S.m = 0.f; S.l = 0.f; S.seen = false;
#pragma unroll
    for (int i = 0; i < 16; ++i) { S.o0[i] = 0.f; S.o1[i] = 0.f; S.negm[i] = 0.f; }
}
template <class KT> DI void qk_tile_c(f32x16& s0, f32x16& s1, const KT& kt, const bf16x8 (&q)[4], const f32x16& c) {
    if constexpr (KT::HOIST) {
        bf16x8 f[8];
#pragma unroll
        for (int s = 0; s < 4; ++s) { f[2 * s] = kt.frag(0, s); f[2 * s + 1] = kt.frag(1, s); }
        __builtin_amdgcn_sched_barrier(0);
        s0 = MFMA32(f[0], q[0], c); s1 = MFMA32(f[1], q[0], c);
#pragma unroll
        for (int s = 1; s < 4; ++s) { s0 = MFMA32(f[2 * s], q[s], s0); s1 = MFMA32(f[2 * s + 1], q[s], s1); }
    } else {
        s0 = MFMA32(kt.frag(0, 0), q[0], c); s1 = MFMA32(kt.frag(1, 0), q[0], c);
#pragma unroll
        for (int s = 1; s < 4; ++s) { s0 = MFMA32(kt.frag(0, s), q[s], s0); s1 = MFMA32(kt.frag(1, s), q[s], s1); }
    }
    asm volatile("s_nop 15\n\ts_nop 7" : "+v"(s0), "+v"(s1));
}
DI float max3f(float a, float b, float c) { float r; asm("v_max3_f32 %0, %1, %2, %3" : "=v"(r) : "v"(a), "v"(b), "v"(c)); return r; }
template <class VT> DI void soft_step(Soft& S, f32x16& s0, f32x16& s1, const VT& vt) {
    bf16x8 vf[8];
    if constexpr (VT::HOIST) {
#pragma unroll
        for (int s = 0; s < 4; ++s) { vf[2 * s] = vt.frag(0, s); vf[2 * s + 1] = vt.frag(1, s); }
        __builtin_amdgcn_sched_barrier(0);
    }
    float mx = max3f(s0[0], s1[0], s0[1]), my = max3f(s1[1], s0[2], s1[2]);
#pragma unroll
    for (int r = 3; r < 15; r += 2) { mx = max3f(mx, s0[r], s1[r]); my = max3f(my, s0[r + 1], s1[r + 1]); }
    mx = max3f(mx, s0[15], s1[15]); mx = max3f(mx, my, mx);
    mx = max3f(mx, half_other(mx), mx);
    const bool fin = mx > NEGINF;
    const bool need = (mx > 8.f) | (fin & !S.seen);
    if (__any(need)) {
        const float dl = need ? mx : 0.f;
        const float al = S.seen ? __builtin_amdgcn_exp2f(-dl) : 0.f;
        S.m += dl; S.l *= need ? al : 1.f;
        const float am = need ? al : 1.f;
#pragma unroll
        for (int r = 0; r < 16; ++r) { s0[r] -= dl; s1[r] -= dl; S.o0[r] *= am; S.o1[r] *= am; S.negm[r] = -S.m; }
    }
    S.seen = S.seen | fin;
    float ps = 0.f;
#pragma unroll
    for (int r = 0; r < 16; ++r) { s0[r] = __builtin_amdgcn_exp2f(s0[r]); s1[r] = __builtin_amdgcn_exp2f(s1[r]); ps += s0[r] + s1[r]; }
    S.l += ps;
    const bf16x8 b0 = pack_p(s0, 0), b1 = pack_p(s0, 1), b2 = pack_p(s1, 0), b3 = pack_p(s1, 1);
    if constexpr (!VT::HOIST) {
#pragma unroll
        for (int s = 0; s < 4; ++s) { vf[2 * s] = vt.frag(0, s); vf[2 * s + 1] = vt.frag(1, s); }
    }
    S.o0 = MFMA32(vf[0], b0, S.o0); S.o1 = MFMA32(vf[1], b0, S.o1);
    S.o0 = MFMA32(vf[2], b1, S.o0); S.o1 = MFMA32(vf[3], b1, S.o1);
    S.o0 = MFMA32(vf[4], b2, S.o0); S.o1 = MFMA32(vf[5], b2, S.o1);
    S.o0 = MFMA32(vf[6], b3, S.o0); S.o1 = MFMA32(vf[7], b3, S.o1);
}
DI float as_f(int x) { return __int_as_float(x); }
DI float mask_sel(float s, int mm) { return __int_as_float((__float_as_int(s) & mm) | ((int)0xff800000 & ~mm)); }
DI u32x4 tile_ld(const bf16* g, size_t pitch, int tid) { return *(const u32x4*)(g + (size_t)(tid >> 3) * pitch + (tid & 7) * 8); }
DI void tile_st(LAS unsigned char* buf, u32x4 v, int tid) { *(LAS u32x4*)(buf + (tid >> 3) * TP + (tid & 7) * 16) = v; }

constexpr int CP = 272;
DI void compress_unit(Frame& F, int u) {
    const int tid = F.tid, lane = F.lane, w = F.wave, l31 = lane & 31, hi = lane >> 5;
    const int slot = u / 136, rem = u % 136;
    const bf16* data; bf16 *ock, *ocvt; int n0, ncmp, cpitch;
    if (rem < 8) { const int bg = rem; data = WSP(bf16, (slot ? WS_PCMPV : WS_PCMPK)) + (size_t)bg * SEQ * 64; n0 = 32 * w; ncmp = 255; cpitch = 256;
        ock = WSP(bf16, WS_PCK) + (size_t)bg * 256 * 64; ocvt = WSP(bf16, WS_PCVT) + (size_t)bg * 64 * 256; }
    else { const int bg = 2 * (rem - 8) + (w >> 2); data = WSP(bf16, (slot ? WS_SCMPV : WS_SCMPK)) + (size_t)bg * LS * 64; n0 = 32 * (w & 3); ncmp = 127; cpitch = 128;
        ock = WSP(bf16, WS_SCK) + (size_t)bg * 128 * 64; ocvt = WSP(bf16, WS_SCVT) + (size_t)bg * 64 * 128; }
    const int n = n0 + l31, nc = n < ncmp ? n : ncmp - 1;
    const bf16* drow = data + (size_t)nc * 1024 + 8 * hi;
    const bool paged = rem >= 8;
    const bf16* w1t = WSP(bf16, WS_W1T) + (size_t)slot * 128 * 2048;
    f32x16 acc[4];
#pragma unroll
    for (int c = 0; c < 4; ++c)
#pragma unroll
        for (int i = 0; i < 16; ++i) acc[c][i] = 0.f;
    const bf16* wsrc = w1t + (size_t)(tid >> 2) * 2048 + ((tid & 3) >> 1) * 1024 + (tid & 1) * 32;
    LAS unsigned char* wdst = F.lds + (tid >> 2) * CP + (tid & 3) * 64;
    u32x4 st[4];
#pragma unroll
    for (int i = 0; i < 4; ++i) st[i] = ((const u32x4*)wsrc)[i];
#pragma unroll
    for (int i = 0; i < 4; ++i) ((LAS u32x4*)wdst)[i] = st[i];
    LDS_BARRIER();
    f32x4 raw[16];
#define CMP_ISSUE(kc_) do { if (!paged) { _Pragma("unroll") for (int s_ = 0; s_ < 8; ++s_) raw[2 * s_] = __builtin_bit_cast(f32x4, *(const bf16x8*)(drow + ((kc_) + 16 * (s_ >> 2)) * 64 + (s_ & 3) * 16)); } \
        } while (0)
    LAS unsigned char* const wrows = F.lds + 2 * 128 * CP + w * (36 * TP);
    const int q4 = lane >> 4, c16 = lane & 15;
    const float *lb0 = nullptr, *lb8 = nullptr; int pgs[5] = {0, 0, 0, 0, 0};
    if (paged) { const int sb = rem - 8, g = w >> 2;
#pragma unroll
        for (int k = 0; k < 5; ++k) { const int pi = (n0 >> 3) + k; pgs[k] = F.ptab[sb * NPG + (pi < NPG ? pi : NPG - 1)]; }
        lb8 = F.cnsa + (slot * 2 + g) * 64 + 4 * c16; lb0 = lb8 + (size_t)(16 * q4) * 512; }
#define CMP_ISSUE_P(kc_) do { _Pragma("unroll") for (int i_ = 0; i_ < 9; ++i_) raw[i_] = *(const f32x4*)((i_ < 8 ? lb0 : lb8) + ((size_t)pgs[i_ >> 1] * PAGE + 64 * (i_ & 1) + (kc_)) * 512); } while (0)
    if (!paged) CMP_ISSUE(0); else CMP_ISSUE_P(0);
    for (int kc = 0; kc < 16; ++kc) {
        const LAS unsigned char* buf = F.lds + (kc & 1) * (128 * CP);
        if (kc + 1 < 16) {
#pragma unroll
            for (int i = 0; i < 4; ++i) st[i] = ((const u32x4*)(wsrc + (kc + 1) * 64))[i];
        }
        bf16x8 bq[8];
        if (!paged) {
#pragma unroll
            for (int s = 0; s < 8; ++s) bq[s] = __builtin_bit_cast(bf16x8, raw[2 * s]);
            if (kc + 1 < 16) CMP_ISSUE(kc + 1);
        } else {
#pragma unroll
            for (int i = 0; i < 9; ++i) { u32x2 wv; wv.x = pk2(raw[i][0], raw[i][1]); wv.y = pk2(raw[i][2], raw[i][3]); *(LAS u32x2*)(wrows + (4 * i + q4) * TP + c16 * 8) = wv; }
            if (kc + 1 < 16) CMP_ISSUE_P(kc + 1);
#pragma unroll
            for (int s = 0; s < 8; ++s) bq[s] = *(const LAS bf16x8*)(wrows + (l31 + (s >> 2)) * TP + ((s & 3) * 16 + 8 * hi) * 2);
        }
#pragma unroll
        for (int s = 0; s < 8; ++s)
#pragma unroll
            for (int c = 0; c < 4; ++c) acc[c] = MFMA32(*(const LAS bf16x8*)(buf + (32 * c + l31) * CP + s * 32 + hi * 16), bq[s], acc[c]);
        if (kc + 1 < 16) {
            LAS unsigned char* nb = wdst + ((kc + 1) & 1) * (128 * CP);
#pragma unroll
            for (int i = 0; i < 4; ++i) ((LAS u32x4*)nb)[i] = st[i];
        }
        LDS_BARRIER();
    }
#undef CMP_ISSUE
#undef CMP_ISSUE_P
    const float* b1 = WSP(float, WS_BIAS1) + slot * 128;
#pragma unroll
    for (int c = 0; c < 4; ++c)
#pragma unroll
        for (int q = 0; q < 4; ++q) { const f32x4 bv = *(const f32x4*)(b1 + 32 * c + 8 * q + 4 * hi);
#pragma unroll
            for (int j = 0; j < 4; ++j) acc[c][4 * q + j] = silu_f(acc[c][4 * q + j] + bv[j]); }
    const bf16* w2t = WSP(bf16, WS_W2T) + (size_t)slot * 64 * 128 + (size_t)l31 * 128 + 8 * hi;
    f32x16 o0, o1;
#pragma unroll
    for (int i = 0; i < 16; ++i) { o0[i] = 0.f; o1[i] = 0.f; }
#pragma unroll
    for (int c = 0; c < 4; ++c)
#pragma unroll
        for (int h = 0; h < 2; ++h) { const bf16x8 hb = pack_p(acc[c], h); const int s2 = 2 * c + h;
            o0 = MFMA32(*(const bf16x8*)(w2t + s2 * 16), hb, o0); o1 = MFMA32(*(const bf16x8*)(w2t + 32 * 128 + s2 * 16), hb, o1); }
    const bool ok = n < ncmp;
    if (slot == 0) {
#pragma unroll
        for (int e = 0; e < 2; ++e)
#pragma unroll
            for (int q = 0; q < 4; ++q) { const f32x16& o = e ? o1 : o0; u32x2 wv;
                wv.x = ok ? pk2(o[4 * q], o[4 * q + 1]) : 0u; wv.y = ok ? pk2(o[4 * q + 2], o[4 * q + 3]) : 0u;
                *(u32x2*)(ock + (size_t)n * 64 + 32 * e + 8 * q + 4 * hi) = wv; }
    } else {
        const int pn = permk(n);
#pragma unroll
        for (int e = 0; e < 2; ++e)
#pragma unroll
            for (int r = 0; r < 16; ++r) { const f32x16& o = e ? o1 : o0; ocvt[(size_t)(32 * e + crow(r, hi)) * cpitch + pn] = ok ? (bf16)(pk2(o[r], 0.f) & 0xffffu) : (bf16)0; }
    }
}

template <int NR, int ABL> DI void idx_select(const LAS int* scw, int n, int lane, unsigned long long* out) {
    int k[NR];
    int kmin = 0x7fffffff, kmax = (int)0x80000000;
#pragma unroll
    for (int i = 0; i < NR; ++i) { const bool v = 64 * i + lane < n; const int x = v ? scw[64 * i + lane] : (int)0x80000000; k[i] = x; kmin = v ? (x < kmin ? x : kmin) : kmin; kmax = x > kmax ? x : kmax; }
    int thr = (int)0x80000000, cut = -1;
    if (n > 256 && !(ABL & 1)) {
        kmin = wave_min_i(kmin); kmax = wave_max_i(kmax);
        int lo = kmin - 1, hiv = kmax;
        bool found = false;
        if (hiv > 0x04000000) {
            const int kp = hiv - 0x03800000;
            int c = 0, cl = 0;
#pragma unroll
            for (int i0 = 0; i0 < NR; i0 += 8) {
                unsigned long long bm[4];
#pragma unroll
                for (int j = 0; j < 4; ++j) bm[j] = __ballot(k[i0 + j] > kp);
#pragma unroll
                for (int j = 4; j < 8; ++j) cl += (k[i0 + j] > kp) ? 1 : 0;
#pragma unroll
                for (int j = 0; j < 4; ++j) c += __popcll(bm[j]);
            }
            c += wave_sum_i(cl);
            if (c == 256) { thr = kp; found = true; } else if (c > 256) lo = kp; else hiv = kp;
        }
        while (!found && (unsigned)hiv - (unsigned)lo > 1u) {
            const int mid = (int)((unsigned)lo + (((unsigned)hiv - (unsigned)lo) >> 1));
            int c = 0, cl = 0;
#pragma unroll
            for (int i0 = 0; i0 < NR; i0 += 8) {
                unsigned long long bm[4];
#pragma unroll
                for (int j = 0; j < 4; ++j) bm[j] = __ballot(k[i0 + j] > mid);
#pragma unroll
                for (int j = 4; j < 8; ++j) cl += (k[i0 + j] > mid) ? 1 : 0;
#pragma unroll
                for (int j = 0; j < 4; ++j) c += __popcll(bm[j]);
            }
            c += wave_sum_i(cl);
            if (c == 256) { thr = mid; found = true; break; }
            if (c > 256) lo = mid; else hiv = mid;
        }
        if (!found) {
            thr = hiv; int cgt = 0;
#pragma unroll
            for (int i = 0; i < NR; ++i) cgt += __popcll(__ballot(k[i] > thr));
            const int need = 256 - cgt; int acc = 0; bool done = false;
#pragma unroll
            for (int i = 0; i < NR; ++i) {
                unsigned long long mk = __ballot(k[i] == thr); const int pc = __popcll(mk);
                if (!done && acc + pc >= need) { for (int q2 = 1; q2 < need - acc; ++q2) mk &= mk - 1; cut = 64 * i + (int)__builtin_ctzll(mk); done = true; }
                acc += pc;
            }
        }
    }
    unsigned long long myw = 0ull;
    if (ABL & 4) { myw = (unsigned long long)(k[0] + k[NR - 1] + kmin + kmax); } else
#pragma unroll
    for (int i = 0; i < NR; ++i) { const unsigned long long mk = __ballot((k[i] > thr) | ((k[i] == thr) & (64 * i + lane <= cut))); myw = (lane == i) ? mk : myw; }
    out[lane] = myw;
}
template <bool SAMPLE, int ABL> DI void idx1_unit(Frame& F, int u) {
    const int lane = F.lane, w = F.wave, l31 = lane & 31, hi = lane >> 5, tl = l31 >> 2, hl = l31 & 3;
    int row0, nkmax, ntok; const bf16* ik;
    if (!SAMPLE) { const int b = u & 3, tc = 511 - (u >> 2); row0 = b * SEQ + 8 * tc; nkmax = 8 * tc + 8; ntok = 8; ik = WSP(bf16, WS_PIDXK) + (size_t)b * SEQ * 64; }
    else { row0 = MP + 4 * u; nkmax = PASTL + 4; ntok = 4; ik = WSP(bf16, WS_SIDXK) + (size_t)u * LS * 64; }
    const int rowq = row0 + (SAMPLE ? (tl & 3) : tl);
    bf16x8 q[4];
#pragma unroll
    for (int s = 0; s < 4; ++s) q[s] = *(const bf16x8*)(WSP(bf16, WS_IQ) + (size_t)rowq * 256 + hl * 64 + 16 * s + 8 * hi);
    f32x4 wq[4];
#pragma unroll
    for (int qq = 0; qq < 4; ++qq) { const int tk = 2 * qq + hi; wq[qq] = *(const f32x4*)(WSP(float, WS_IW) + (size_t)(row0 + (SAMPLE ? (tk & 3) : tk)) * 4); }
    LAS int* sc = (LAS int*)F.lds;
    const int n32 = (nkmax + 31) >> 5;
    u32x4 rA[8], rB[8];
#define IDX_ISSUE(R, kt_) do { const int kk_ = (kt_) < n32 ? (kt_) : n32 - 1; \
        if (SAMPLE) { if (kk_ < 64) { const int pg = F.ptab[u * NPG + (kk_ >> 2)]; const float* fp = F.cidx + ((size_t)pg * PAGE + (kk_ & 3) * 32 + l31) * 64 + 8 * hi; \
              _Pragma("unroll") for (int s_ = 0; s_ < 4; ++s_) { R[2 * s_] = gload16(fp + 16 * s_); R[2 * s_ + 1] = gload16(fp + 16 * s_ + 4); } } \
            else { const bf16* kp = ik + (size_t)(32 * kk_ + l31) * 64 + 8 * hi; \
              _Pragma("unroll") for (int s_ = 0; s_ < 4; ++s_) { R[2 * s_] = gload16(kp + 16 * s_); R[2 * s_ + 1] = gload16(kp + 16 * s_); } } } \
        else { const bf16* kp = ik + (size_t)(32 * kk_ + l31) * 64 + 8 * hi; \
            _Pragma("unroll") for (int s_ = 0; s_ < 4; ++s_) R[2 * s_] = gload16(kp + 16 * s_); } } while (0)
#define IDX_WAIT(R) do { if (SAMPLE) asm volatile("s_waitcnt vmcnt(8)" : "+v"(R[0]), "+v"(R[1]), "+v"(R[2]), "+v"(R[3]), "+v"(R[4]), "+v"(R[5]), "+v"(R[6]), "+v"(R[7]) :: "memory"); \
        else asm volatile("s_waitcnt vmcnt(4)" : "+v"(R[0]), "+v"(R[2]), "+v"(R[4]), "+v"(R[6]) :: "memory"); } while (0)
#define RELU_(x) __builtin_amdgcn_fmed3f((x), 0.f, __builtin_inff())
#define IDX_SCORE(R, kt_) do { IDX_WAIT(R); if ((kt_) < n32) { bf16x8 kf[4]; \
        if (SAMPLE && (kt_) < 64) { _Pragma("unroll") for (int s_ = 0; s_ < 4; ++s_) kf[s_] = cvt8(__builtin_bit_cast(f32x4, R[2 * s_]), __builtin_bit_cast(f32x4, R[2 * s_ + 1])); } \
        else { _Pragma("unroll") for (int s_ = 0; s_ < 4; ++s_) kf[s_] = __builtin_bit_cast(bf16x8, R[2 * s_]); } \
        f32x16 a; _Pragma("unroll") for (int i_ = 0; i_ < 16; ++i_) a[i_] = 0.f; \
        _Pragma("unroll") for (int s_ = 0; s_ < 4; ++s_) a = MFMA32(q[s_], kf[s_], a); \
        _Pragma("unroll") for (int qq = 0; qq < 4; ++qq) { \
            float v = RELU_(a[4 * qq]) * wq[qq][0] + RELU_(a[4 * qq + 1]) * wq[qq][1] + RELU_(a[4 * qq + 2]) * wq[qq][2] + RELU_(a[4 * qq + 3]) * wq[qq][3]; \
            int uu = __float_as_int(v); uu = (uu == (int)0x80000000) ? 0 : uu; \
            sc[(2 * qq + hi) * 4096 + 32 * (kt_) + l31] = uu ^ ((uu >> 31) & 0x7fffffff); } } } while (0)
    if (!(ABL & 2)) {
        IDX_ISSUE(rA, w); IDX_ISSUE(rB, w + NWAVES);
        PIN4(q); PIN4(wq);
        asm volatile("s_waitcnt vmcnt(0)" ::: "memory");
        for (int kt = w; kt < n32; kt += 2 * NWAVES) {
            IDX_SCORE(rA, kt); IDX_ISSUE(rA, kt + 2 * NWAVES);
            IDX_SCORE(rB, kt + NWAVES); IDX_ISSUE(rB, kt + 3 * NWAVES);
        }
        asm volatile("s_waitcnt vmcnt(0)" : "+v"(rA[0]), "+v"(rA[2]), "+v"(rA[4]), "+v"(rA[6]), "+v"(rB[0]), "+v"(rB[2]), "+v"(rB[4]), "+v"(rB[6]) :: "memory");
        if (SAMPLE) asm volatile("" : "+v"(rA[1]), "+v"(rA[3]), "+v"(rA[5]), "+v"(rA[7]), "+v"(rB[1]), "+v"(rB[3]), "+v"(rB[5]), "+v"(rB[7]));
    }
#undef IDX_ISSUE
#undef IDX_WAIT
#undef IDX_SCORE
#undef RELU_
    __syncthreads();
    if (w < ntok && !(ABL & 8)) {
        const int n = SAMPLE ? (PASTL + 1 + w) : (row0 - (row0 & ~(SEQ - 1)) + w + 1);
        unsigned long long* out = WSP(unsigned long long, ABL ? WS_T1 : WS_SELM) + (size_t)(row0 + w) * 64;
        const LAS int* scw = sc + w * 4096;
        if (n <= 1024) idx_select<16, ABL>(scw, n, lane, out);
        else if (n <= 2048) idx_select<32, ABL>(scw, n, lane, out);
        else if (n <= 3072) idx_select<48, ABL>(scw, n, lane, out);
        else idx_select<64, ABL>(scw, n, lane, out);
    }
    __syncthreads();
}


constexpr int NSA_PS = 2 * 2 * TILE_B;
constexpr int NSA_WS = 8192 + 2048 + 64;
template <bool SAMPLE> DI void nsa_unit(Frame& F, int u) {
    const int tid = F.tid, lane = F.lane, w = F.wave, l31 = lane & 31, hi = lane >> 5, tl = l31 >> 2, hl = l31 & 3;
    int bg, g, row, qpos, ncmp, wlo, whi, n_ctile, n_stile, w_t0, w_t1, qt = 0;
    size_t cpitch, pitch, wpitch; const bf16 *ck, *cvt, *sk, *svt, *wk, *wvt; bool wr_ok;
    if (!SAMPLE) {
        bg = u & 7; qt = 63 - (u >> 3); g = bg & 1; const int t = 64 * qt + 8 * w + tl; row = (bg >> 1) * SEQ + t; qpos = t; ncmp = 255;
        cpitch = 256; pitch = SEQ; wpitch = SEQ;
        ck = WSP(bf16, WS_PCK) + (size_t)bg * 256 * 64; cvt = WSP(bf16, WS_PCVT) + (size_t)bg * 64 * 256;
        sk = WSP(bf16, WS_PSLCK) + (size_t)bg * SEQ * 64; svt = WSP(bf16, WS_PSLCVT) + (size_t)bg * 64 * SEQ;
        wk = WSP(bf16, WS_PWINK) + (size_t)bg * SEQ * 64; wvt = WSP(bf16, WS_PWINVT) + (size_t)bg * 64 * SEQ;
        wlo = qpos - 511; whi = qpos; n_ctile = (4 * qt + 2) / 64 + 1; n_stile = qt + 1; w_t0 = qt > 8 ? qt - 8 : 0; w_t1 = qt; wr_ok = true;
    } else {
        bg = u * 8 + w; g = bg & 1; const int i = tl & 3; row = MP + (bg >> 1) * 4 + i; qpos = PASTL + i; ncmp = 127;
        cpitch = 128; pitch = LS; wpitch = LSW;
        ck = WSP(bf16, WS_SCK) + (size_t)bg * 128 * 64; cvt = WSP(bf16, WS_SCVT) + (size_t)bg * 64 * 128;
        sk = WSP(bf16, WS_SSLCK) + (size_t)bg * LS * 64; svt = WSP(bf16, WS_SSLCVT) + (size_t)bg * 64 * LS;
        wk = WSP(bf16, WS_SWINK) + (size_t)bg * LSW * 64; wvt = WSP(bf16, WS_SWINVT) + (size_t)bg * 64 * LSW;
        wlo = 1 + i; whi = 512 + i; n_ctile = 2; n_stile = 33; w_t0 = 0; w_t1 = 8; wr_ok = tl < 4;
    }
    const int hq = 4 * g + hl;
    bf16x8 qraw[4], qrot[4];
#pragma unroll
    for (int s = 0; s < 4; ++s) qraw[s] = *(const bf16x8*)(WSP(bf16, WS_QRAW) + (size_t)row * 512 + hq * 64 + 16 * s + 8 * hi);
    LAS unsigned char* const lb = F.lds;
    LAS float* psum = (LAS float*)(lb + NSA_PS + w * NSA_WS);
    LAS float* impb = (LAS float*)(lb + NSA_PS + w * NSA_WS + 8192);
    LAS unsigned char* selb = lb + NSA_PS + w * NSA_WS + 8192 + 2048;
    const int fo = l31 * TP + hi * 16;
    const float* gp = WSP(float, WS_GATES) + (size_t)row * 24 + hq * 3;
    float g0 = gp[0], g1 = gp[1], g2 = gp[2];
    PIN4(qraw); asm volatile("" : "+v"(g0), "+v"(g1), "+v"(g2));
    f32x16 s0, s1;
    u32x4 rk, rv;
    Soft S;

    const int nvr = (qpos - 31) >> 4, nvis = nvr < ncmp - 1 ? nvr : ncmp - 1;
    float m = -1e30f, l = 0.f;
    if (!SAMPLE) { rk = tile_ld(ck, 64, tid); rv = tile_ld(cvt, cpitch, tid); tile_st(lb, rk, tid); tile_st(lb + TILE_B, rv, tid); LDS_BARRIER(); }
    for (int ct = 0; ct < n_ctile; ++ct) {
        if (!SAMPLE) { if (ct + 1 < n_ctile) { rk = tile_ld(ck + (size_t)(ct + 1) * 64 * 64, 64, tid); rv = tile_ld(cvt + (ct + 1) * 64, cpitch, tid); } }
        if (!SAMPLE) { LdsT kt{lb + (ct & 1) * 2 * TILE_B + fo}; qk_tile(s0, s1, kt, qraw); }
        else { GlbT kt{ck, (unsigned)((64 * ct + l31) * 64 + 8 * hi), 64u}; qk_tile(s0, s1, kt, qraw); }
        float mx = -1e30f;
        const int nv2 = nvis - 64 * ct - 4 * hi;
#pragma unroll
        for (int r = 0; r < 16; ++r) { const int cr = (r & 3) + 8 * (r >> 2); s0[r] = cr <= nv2 ? s0[r] : NEGINF; s1[r] = cr + 32 <= nv2 ? s1[r] : NEGINF; mx = fmaxf(mx, fmaxf(s0[r], s1[r])); }
        mx = fmaxf(mx, half_other(mx));
        const float mn = fmaxf(m, mx); float ps = 0.f;
#pragma unroll
        for (int r = 0; r < 16; ++r) ps += __builtin_amdgcn_exp2f(s0[r] - mn) + __builtin_amdgcn_exp2f(s1[r] - mn);
        l = l * __builtin_amdgcn_exp2f(m - mn) + ps; m = mn;
        if (!SAMPLE) { if (ct + 1 < n_ctile) { tile_st(lb + ((ct + 1) & 1) * 2 * TILE_B, rk, tid); tile_st(lb + ((ct + 1) & 1) * 2 * TILE_B + TILE_B, rv, tid); } LDS_BARRIER(); }
    }
    l += half_other(l);
    const float linv = l > 0.f ? 1.f / l : 0.f;
    soft_init(S);
    if (!SAMPLE) { rk = tile_ld(ck, 64, tid); rv = tile_ld(cvt, cpitch, tid); tile_st(lb, rk, tid); tile_st(lb + TILE_B, rv, tid); LDS_BARRIER(); }
    for (int ct = 0; ct < n_ctile; ++ct) {
        if (!SAMPLE) { if (ct + 1 < n_ctile) { rk = tile_ld(ck + (size_t)(ct + 1) * 64 * 64, 64, tid); rv = tile_ld(cvt + (ct + 1) * 64, cpitch, tid); } }
        if (!SAMPLE) { LdsT kt{lb + (ct & 1) * 2 * TILE_B + fo}; qk_tile(s0, s1, kt, qraw); }
        else { GlbT kt{ck, (unsigned)((64 * ct + l31) * 64 + 8 * hi), 64u}; qk_tile(s0, s1, kt, qraw); }
        const int nv2 = nvis - 64 * ct - 4 * hi; LAS float* pw = psum + tl * 256 + 64 * ct + 4 * hi;
#pragma unroll
        for (int r = 0; r < 16; ++r) { const int cr = (r & 3) + 8 * (r >> 2);
            s0[r] = cr <= nv2 ? __builtin_amdgcn_exp2f(s0[r] - m) * linv : 0.f; s1[r] = cr + 32 <= nv2 ? __builtin_amdgcn_exp2f(s1[r] - m) * linv : 0.f;
            float a = s0[r]; a += dpp_x1(a); a += dpp_x2(a); float b = s1[r]; b += dpp_x1(b); b += dpp_x2(b);
            if (hl == 0) { pw[cr] = a; pw[cr + 32] = b; } }
        if (!SAMPLE) { LdsT vt{lb + (ct & 1) * 2 * TILE_B + TILE_B + fo}; pv_tile(S.o0, S.o1, s0, s1, vt); }
        else { GlbT vt{cvt, (unsigned)(l31 * (int)cpitch + 64 * ct + 8 * hi), (unsigned)cpitch}; pv_tile(S.o0, S.o1, s0, s1, vt); }
        if (!SAMPLE) { if (ct + 1 < n_ctile) { tile_st(lb + ((ct + 1) & 1) * 2 * TILE_B, rk, tid); tile_st(lb + ((ct + 1) & 1) * 2 * TILE_B + TILE_B, rv, tid); } LDS_BARRIER(); }
    }
    LDS_WAIT();
    unsigned mlo, mhi;
    {
        const int tk = lane >> 3, jb = 8 * (lane & 7);
        const int qp = SAMPLE ? PASTL + (tk & 3) : 64 * qt + 8 * w + tk, cur = qp >> 6;
        float pv[33];
        const LAS f32x4* pp = (const LAS f32x4*)(psum + tk * 256 + 4 * jb);
#pragma unroll
        for (int i = 0; i < 8; ++i) { const f32x4 x = pp[i]; pv[1 + 4 * i] = x[0]; pv[2 + 4 * i] = x[1]; pv[3 + 4 * i] = x[2]; pv[4 + 4 * i] = x[3]; }
        pv[0] = jb > 0 ? psum[tk * 256 + 4 * jb - 1] : 0.f;
        float v[8];
#pragma unroll
        for (int jj = 0; jj < 8; ++jj) {
            const int j = jb + jj;
            float a = pv[4 * jj] + pv[4 * jj + 1] + pv[4 * jj + 2] + pv[4 * jj + 3];
            a += (4 * j + 3 < ncmp) ? pv[4 * jj + 4] : 0.f;
            a = ((j == 0) | (j == cur) | (j == cur - 1)) ? 1e4f : a;
            a = (j > cur) ? -1e30f : a;
            v[jj] = a;
        }
        LAS f32x4* ip = (LAS f32x4*)(impb + tk * 64 + jb);
        ip[0] = (f32x4){v[0], v[1], v[2], v[3]}; ip[1] = (f32x4){v[4], v[5], v[6], v[7]};
        LDS_WAIT();
        int cnt[8];
#pragma unroll
        for (int jj = 0; jj < 8; ++jj) cnt[jj] = 0;
        const LAS f32x4* ap = (const LAS f32x4*)(impb + tk * 64);
#pragma unroll 1
        for (int i4 = 0; i4 < 16; ++i4) {
            const f32x4 x = ap[i4];
#pragma unroll
            for (int e = 0; e < 4; ++e) { const float xi = x[e];
#pragma unroll
                for (int jj = 0; jj < 8; ++jj) cnt[jj] += (xi > v[jj]) ? 1 : 0; }
        }
        unsigned bits = 0;
#pragma unroll
        for (int jj = 0; jj < 8; ++jj) bits |= ((cnt[jj] < 16) & (jb + jj <= cur)) ? (1u << jj) : 0u;
        int nsel = __popc(bits);
        nsel += __shfl_xor(nsel, 1); nsel += __shfl_xor(nsel, 2); nsel += __shfl_xor(nsel, 4);
        if (__builtin_amdgcn_ballot_w64(nsel != (cur < 15 ? cur + 1 : 16)) != 0ull) {
#pragma unroll
            for (int jj = 0; jj < 8; ++jj) cnt[jj] = 0;
#pragma unroll 1
            for (int i4 = 0; i4 < 16; ++i4) {
                const f32x4 x = ap[i4];
#pragma unroll
                for (int e = 0; e < 4; ++e) { const int i = 4 * i4 + e; const float xi = x[e];
#pragma unroll
                    for (int jj = 0; jj < 8; ++jj) cnt[jj] += ((xi > v[jj]) | ((xi == v[jj]) & (i < jb + jj))) ? 1 : 0; }
            }
            bits = 0;
#pragma unroll
            for (int jj = 0; jj < 8; ++jj) bits |= ((cnt[jj] < 16) & (jb + jj <= cur)) ? (1u << jj) : 0u;
        }
        selb[tk * 8 + (lane & 7)] = (unsigned char)bits;
        LDS_WAIT();
        const LAS unsigned* sp = (const LAS unsigned*)(selb + tl * 8);
        mlo = sp[0]; mhi = sp[1];
    }
    LAS float* park = psum + lane;
#pragma unroll
    for (int i = 0; i < 16; ++i) { park[i * 64] = g0 * S.o0[i]; park[(16 + i) * 64] = g0 * S.o1[i]; }
#pragma unroll
    for (int s = 0; s < 4; ++s) qrot[s] = *(const bf16x8*)(WSP(bf16, WS_QROT) + (size_t)row * 512 + hq * 64 + 16 * s + 8 * hi);
    PIN4(qrot);
    soft_init(S);
    const int qrel = (qpos & 63) - 4 * hi;
    if (!SAMPLE) { rk = tile_ld(sk, 64, tid); rv = tile_ld(svt, pitch, tid); tile_st(lb, rk, tid); tile_st(lb + TILE_B, rv, tid); LDS_BARRIER(); }
    for (int j = 0; j < n_stile; ++j) {
        if (!SAMPLE) { if (j + 1 < n_stile) { rk = tile_ld(sk + (size_t)(j + 1) * 64 * 64, 64, tid); rv = tile_ld(svt + (j + 1) * 64, pitch, tid); } }
        const bool bsel = ((j < 32 ? (mlo >> j) : (mhi >> (j - 32))) & 1u) != 0u;
        if (!SAMPLE) { LdsT kt{lb + (j & 1) * 2 * TILE_B + fo}; qk_tile_c(s0, s1, kt, qrot, S.negm); }
        else { GlbT kt{sk, (unsigned)((64 * j + l31) * 64 + 8 * hi), 64u}; qk_tile_c(s0, s1, kt, qrot, S.negm); }
        if (j == n_stile - 1) {
#pragma unroll
            for (int r = 0; r < 16; ++r) { const int cr = (r & 3) + 8 * (r >> 2); s0[r] = cr <= qrel ? s0[r] : NEGINF; s1[r] = cr + 32 <= qrel ? s1[r] : NEGINF; }
        } else {
#pragma unroll
            for (int r = 0; r < 16; ++r) { s0[r] = bsel ? s0[r] : NEGINF; s1[r] = bsel ? s1[r] : NEGINF; }
        }
        if (!SAMPLE) { LdsT vt{lb + (j & 1) * 2 * TILE_B + TILE_B + fo}; soft_step(S, s0, s1, vt); }
        else { GlbT vt{svt, (unsigned)(l31 * (int)pitch + 64 * j + 8 * hi), (unsigned)pitch}; soft_step(S, s0, s1, vt); }
        if (!SAMPLE) { if (j + 1 < n_stile) { tile_st(lb + ((j + 1) & 1) * 2 * TILE_B, rk, tid); tile_st(lb + ((j + 1) & 1) * 2 * TILE_B + TILE_B, rv, tid); } LDS_BARRIER(); }
    }
    S.l += half_other(S.l);
    { const float sc = g1 / fmaxf(S.l, 1e-30f);
#pragma unroll
      for (int i = 0; i < 16; ++i) { park[i * 64] += sc * S.o0[i]; park[(16 + i) * 64] += sc * S.o1[i]; } }
    soft_init(S);
    if (!SAMPLE) { rk = tile_ld(wk + (size_t)w_t0 * 64 * 64, 64, tid); rv = tile_ld(wvt + w_t0 * 64, wpitch, tid); tile_st(lb, rk, tid); tile_st(lb + TILE_B, rv, tid); LDS_BARRIER(); }
    for (int j = w_t0; j <= w_t1; ++j) {
        const int jr = j - w_t0;
        if (!SAMPLE) { if (j + 1 <= w_t1) { rk = tile_ld(wk + (size_t)(j + 1) * 64 * 64, 64, tid); rv = tile_ld(wvt + (j + 1) * 64, wpitch, tid); } }
        if (!SAMPLE) { LdsT kt{lb + (jr & 1) * 2 * TILE_B + fo}; qk_tile_c(s0, s1, kt, qrot, S.negm); }
        else { GlbT kt{wk, (unsigned)((64 * j + l31) * 64 + 8 * hi), 64u}; qk_tile_c(s0, s1, kt, qrot, S.negm); }
        if ((j == w_t0) | (j == w_t1)) {
            const int lo_r = wlo - 64 * j - 4 * hi, hi_r = whi - 64 * j - 4 * hi;
#pragma unroll
            for (int r = 0; r < 16; ++r) { const int k0 = (r & 3) + 8 * (r >> 2); s0[r] = ((k0 >= lo_r) & (k0 <= hi_r)) ? s0[r] : NEGINF; s1[r] = ((k0 + 32 >= lo_r) & (k0 + 32 <= hi_r)) ? s1[r] : NEGINF; }
        }
        if (!SAMPLE) { LdsT vt{lb + (jr & 1) * 2 * TILE_B + TILE_B + fo}; soft_step(S, s0, s1, vt); }
        else { GlbT vt{wvt, (unsigned)(l31 * (int)wpitch + 64 * j + 8 * hi), (unsigned)wpitch}; soft_step(S, s0, s1, vt); }
        if (!SAMPLE) { if (j + 1 <= w_t1) { tile_st(lb + ((jr + 1) & 1) * 2 * TILE_B, rk, tid); tile_st(lb + ((jr + 1) & 1) * 2 * TILE_B + TILE_B, rv, tid); } LDS_BARRIER(); }
    }
    S.l += half_other(S.l);
#ifdef BREAK_WIN
    S.l *= 1.1f;
#endif
    f32x16 res0, res1;
    { const float sc = g2 / fmaxf(S.l, 1e-30f);
#pragma unroll
      for (int i = 0; i < 16; ++i) { res0[i] = park[i * 64] + sc * S.o0[i]; res1[i] = park[(16 + i) * 64] + sc * S.o1[i]; } }
    if (wr_ok) {
        const bf16* zp = WSP(bf16, WS_ZN) + (size_t)row * 512 + hq * 64 + 4 * hi;
        bf16* op = WSP(bf16, WS_ONZ) + (size_t)row * 512 + hq * 64 + 4 * hi;
#pragma unroll
        for (int e = 0; e < 2; ++e)
#pragma unroll
            for (int q = 0; q < 4; ++q) { const f32x16& o = e ? res1 : res0; const u32x2 z = *(const u32x2*)(zp + 32 * e + 8 * q);
                u32x2 wv; wv.x = pk2(o[4 * q] * bflo(z.x), o[4 * q + 1] * bfhi(z.x)); wv.y = pk2(o[4 * q + 2] * bflo(z.y), o[4 * q + 3] * bfhi(z.y));
                *(u32x2*)(op + 32 * e + 8 * q) = wv; }
    }
}

template <int ABL, class VT> DI void soft_step2(Soft& S, f32x16& s0, f32x16& s1, f32x16& sn0, f32x16& sn1, const VT& vt) {
    bf16x8 vf[8];
#pragma unroll
    for (int s = 0; s < 4; ++s) { vf[2 * s] = vt.frag(0, s); vf[2 * s + 1] = vt.frag(1, s); }
    if (!(ABL & 1)) {
    float mx = max3f(s0[0], s1[0], s0[1]), my = max3f(s1[1], s0[2], s1[2]);
#pragma unroll
    for (int r = 3; r < 15; r += 2) { mx = max3f(mx, s0[r], s1[r]); my = max3f(my, s0[r + 1], s1[r + 1]); }
    mx = max3f(mx, s0[15], s1[15]); mx = max3f(mx, my, mx);
    mx = max3f(mx, half_other(mx), mx);
    const bool fin = mx > NEGINF;
    const bool need = (mx > 8.f) | (fin & !S.seen);
    if (__any(need)) {
        const float dl = need ? mx : 0.f;
        const float al = S.seen ? __builtin_amdgcn_exp2f(-dl) : 0.f;
        S.m += dl; S.l *= need ? al : 1.f;
        const float am = need ? al : 1.f;
#pragma unroll
        for (int r = 0; r < 16; ++r) { s0[r] -= dl; s1[r] -= dl; sn0[r] -= dl; sn1[r] -= dl; S.o0[r] *= am; S.o1[r] *= am; S.negm[r] = -S.m; }
    }
    S.seen = S.seen | fin;
    float ps = 0.f;
#pragma unroll
    for (int r = 0; r < 16; ++r) { s0[r] = __builtin_amdgcn_exp2f(s0[r]); s1[r] = __builtin_amdgcn_exp2f(s1[r]); ps += s0[r] + s1[r]; }
    S.l += ps;
    }
    const bf16x8 b0 = pack_p(s0, 0), b1 = pack_p(s0, 1), b2 = pack_p(s1, 0), b3 = pack_p(s1, 1);
    if (!(ABL & 4)) {
    S.o0 = MFMA32(vf[0], b0, S.o0); S.o1 = MFMA32(vf[1], b0, S.o1);
    S.o0 = MFMA32(vf[2], b1, S.o0); S.o1 = MFMA32(vf[3], b1, S.o1);
    S.o0 = MFMA32(vf[4], b2, S.o0); S.o1 = MFMA32(vf[5], b2, S.o1);
    S.o0 = MFMA32(vf[6], b3, S.o0); S.o1 = MFMA32(vf[7], b3, S.o1);
    } else { S.o0[0] += __builtin_bit_cast(f32x4, b0)[0] + __builtin_bit_cast(f32x4, b1)[0] + __builtin_bit_cast(f32x4, b2)[0] + __builtin_bit_cast(f32x4, b3)[0] + __builtin_bit_cast(f32x4, vf[0])[0] + __builtin_bit_cast(f32x4, vf[7])[1]; }
}
template <int ABL> DI void dsa_unit(Frame& F, int u) {
    const int tid = F.tid, lane = F.lane, w = F.wave, l31 = lane & 31, hi = lane >> 5, tl = l31 >> 2, hl = l31 & 3;
    const int bg = u & 7, qt = 63 - (u >> 3), g = bg & 1, t = 64 * qt + 8 * w + tl, row = (bg >> 1) * SEQ + t, nt = qt + 1;
    const bf16* dk = WSP(bf16, WS_PDSAK) + (size_t)bg * SEQ * 64; const bf16* dvt = WSP(bf16, WS_PDSAVT) + (size_t)bg * 64 * SEQ;
    const int hq = 4 * g + hl;
    bf16x8 dq[4];
#pragma unroll
    for (int s = 0; s < 4; ++s) dq[s] = *(const bf16x8*)(WSP(bf16, WS_DQ) + (size_t)row * 512 + hq * 64 + 16 * s + 8 * hi);
    const unsigned long long* selp = WSP(unsigned long long, WS_SELM) + (size_t)row * 64;
    unsigned long long selA = selp[0], selB = selp[nt > 1 ? 1 : 0];
    PIN4(dq); asm volatile("" : "+v"(selA), "+v"(selB));
    LAS unsigned char* const lb = F.lds;
    const int fo = l31 * TP + hi * 16;
    f32x16 sc0, sc1, sn0, sn1;
    u32x4 rkA, rvA, rkB, rvB;
    Soft S; soft_init(S);
    const int ntm = nt - 1;
    const bf16* kpc = dk + (size_t)(tid >> 3) * 64 + (tid & 7) * 8; const bf16* vpc = dvt + (size_t)(tid >> 3) * SEQ + (tid & 7) * 8;
#define KADDR(jt) (kpc + (size_t)((jt) < ntm ? (jt) : ntm) * 64 * 64)
#define VADDR(jt) (vpc + ((jt) < ntm ? (jt) : ntm) * 64)
    { const u32x4 a = tile_ld(dk, 64, tid), b = tile_ld(dvt, SEQ, tid), c = *(const u32x4*)KADDR(1); tile_st(lb, a, tid); tile_st(lb + 2 * TILE_B, b, tid); tile_st(lb + TILE_B, c, tid); }
    asm volatile("s_waitcnt vmcnt(0)" : "+v"(selA), "+v"(selB) :: "memory");
    selA = gload8(selp); selB = gload8(selp + (nt > 1 ? 1 : 0));
    rkA = gload16(KADDR(2)); rvA = gload16(VADDR(1));
    LDS_BARRIER();
    { LdsT kt{lb + fo}; qk_tile_c(sc0, sc1, kt, dq, S.negm); }
#define DSA_STEP(j, CK, CV, NK, NV, SELC) do { \
        NK = gload16(KADDR((j) + 3)); NV = gload16(VADDR((j) + 2)); \
        if ((j) + 1 < nt) { LdsT kt{lb + (((j) + 1) & 1) * TILE_B + fo}; if (!(ABL & 2)) qk_tile_c(sn0, sn1, kt, dq, S.negm); else { sn0 = S.negm; sn1 = S.negm; sn0[0] += __builtin_bit_cast(f32x4, kt.frag(0, 0))[0]; } } \
        WAITV1(5, SELC);                                                     \
        { const unsigned wa = (unsigned)SELC >> (4 * hi), wb = (unsigned)(SELC >> 32) >> (4 * hi); \
          SELC = gload8(selp + ((j) + 2 < nt ? (j) + 2 : ntm)); \
          _Pragma("unroll") for (int r = 0; r < 16; ++r) { const int bp = (r & 3) + 8 * (r >> 2); \
            sc0[r] = mask_sel(sc0[r], (int)(wa << (31 - bp)) >> 31); sc1[r] = mask_sel(sc1[r], (int)(wb << (31 - bp)) >> 31); } } \
        { LdsT vt{lb + (2 + ((j) & 1)) * TILE_B + fo}; soft_step2<ABL>(S, sc0, sc1, sn0, sn1, vt); } \
        sc0 = sn0; sc1 = sn1; \
        WAITV2(3, CK, CV);                                                   \
        if (!(ABL & 8)) { tile_st(lb + ((j) & 1) * TILE_B, CK, tid); tile_st(lb + (2 + (((j) + 1) & 1)) * TILE_B, CV, tid); } \
        if (!(ABL & 16)) LDS_BARRIER(); } while (0)
    for (int j = 0; j < nt; j += 2) { DSA_STEP(j, rkA, rvA, rkB, rvB, selA); if (j + 1 < nt) DSA_STEP(j + 1, rkB, rvB, rkA, rvA, selB); }
    asm volatile("s_waitcnt vmcnt(0)" : "+v"(rkA), "+v"(rvA), "+v"(rkB), "+v"(rvB), "+v"(selA), "+v"(selB) :: "memory");
#undef DSA_STEP
#undef KADDR
#undef VADDR
    S.l += half_other(S.l);
    {
        const float sc = 1.f / fmaxf(S.l, 1e-30f);
        const bf16* zp = WSP(bf16, WS_ZD) + (size_t)row * 512 + hq * 64 + 4 * hi;
        bf16* op = WSP(bf16, ABL ? WS_T1 : WS_ODZ) + (size_t)row * 512 + hq * 64 + 4 * hi;
#pragma unroll
        for (int e = 0; e < 2; ++e)
#pragma unroll
            for (int q = 0; q < 4; ++q) { const f32x16& o = e ? S.o1 : S.o0; const u32x2 z = *(const u32x2*)(zp + 32 * e + 8 * q);
                u32x2 wv; wv.x = pk2(o[4 * q] * sc * bflo(z.x), o[4 * q + 1] * sc * bfhi(z.x)); wv.y = pk2(o[4 * q + 2] * sc * bflo(z.y), o[4 * q + 3] * sc * bfhi(z.y));
                *(u32x2*)(op + 32 * e + 8 * q) = wv; }
    }
}


struct PageK {
    static constexpr bool HOIST = false;
    const float* p; unsigned stride;
    DI bf16x8 frag(int mt, int s) const { const f32x4* q = (const f32x4*)(p + (size_t)((unsigned)mt * 32u * stride + (unsigned)s * 16u)); return cvt8(q[0], q[1]); }
};
struct PageV {
    static constexpr bool HOIST = false;
    const float* p; unsigned stride;
    DI bf16x8 frag(int dt, int s) const {
        float v[8];
#pragma unroll
        for (int i = 0; i < 8; ++i) v[i] = p[(size_t)((unsigned)(16 * s + (i & 3) + 8 * (i >> 2)) * stride + (unsigned)dt * 32u)];
        return __builtin_bit_cast(bf16x8, pack8(v));
    }
};
DI void stage_k_ld(f32x4 (&x)[16], const float* base, unsigned stride, int lane) {
    const float* p = base + (size_t)((unsigned)(lane >> 4) * stride + 4u * (unsigned)(lane & 15));
#pragma unroll
    for (int i = 0; i < 16; ++i) x[i] = *(const f32x4*)(p + (size_t)((unsigned)(4 * i) * stride));
}
DI void stage_k_st(const f32x4 (&x)[16], LAS unsigned char* kb, int lane) {
    LAS unsigned char* d = kb + (lane >> 4) * TP + (lane & 15) * 8;
#pragma unroll
    for (int i = 0; i < 16; ++i) { u32x2 wv; wv.x = pk2(x[i][0], x[i][1]); wv.y = pk2(x[i][2], x[i][3]); *(LAS u32x2*)(d + 4 * i * TP) = wv; }
}
struct RegV { static constexpr bool HOIST = true; bf16x8 f[8]; DI bf16x8 frag(int dt, int s) const { return f[2 * s + dt]; } };
DI void pagev_ld(float (&v)[64], const float* p, unsigned stride) {
#pragma unroll
    for (int f = 0; f < 8; ++f)
#pragma unroll
        for (int i = 0; i < 8; ++i) v[8 * f + i] = p[(size_t)((unsigned)(16 * (f >> 1) + (i & 3) + 8 * (i >> 2)) * stride + (unsigned)(f & 1) * 32u)];
}
DI void pagev_pack(RegV& r, const float (&v)[64]) {
#pragma unroll
    for (int f = 0; f < 8; ++f) r.f[f] = __builtin_bit_cast(bf16x8, pack8(&v[8 * f]));
}
constexpr int XCH_W = 34 * 64;
constexpr int XCH_BYTES = 8 * XCH_W * 4;
DI void xch_put(LAS float* x, const Soft& S, int lane) {
    const float lt = S.l + half_other(S.l);
    x[lane] = S.seen ? S.m : NEGINF; x[64 + lane] = lt;
#pragma unroll
    for (int r = 0; r < 16; ++r) { x[(2 + r) * 64 + lane] = S.o0[r]; x[(18 + r) * 64 + lane] = S.o1[r]; }
}
DI void xch_get(const LAS float* xb, int w, int lane, float (&out)[4]) {
    float mw[8], M = -1e30f;
#pragma unroll
    for (int i = 0; i < 8; ++i) { mw[i] = xb[i * XCH_W + lane]; M = fmaxf(M, mw[i]); }
    float L = 0.f, o[4] = {0.f, 0.f, 0.f, 0.f};
#pragma unroll
    for (int i = 0; i < 8; ++i) { const float wt = __builtin_amdgcn_exp2f(mw[i] - M); L += wt * xb[i * XCH_W + 64 + lane];
#pragma unroll
        for (int k = 0; k < 4; ++k) o[k] += wt * xb[i * XCH_W + (2 + 4 * w + k) * 64 + lane]; }
    const float inv = 1.f / fmaxf(L, 1e-30f);
#pragma unroll
    for (int k = 0; k < 4; ++k) out[k] = o[k] * inv;
}
DI void nsa_sample_unit(Frame& F, int bg) {
    const int lane = F.lane, w = F.wave, l31 = lane & 31, hi = lane >> 5, tl = l31 >> 2, hl = l31 & 3;
    const int sb = bg >> 1, g = bg & 1, i = tl & 3, row = MP + sb * 4 + i, qpos = PASTL + i, hq = 4 * g + hl;
    LAS unsigned char* const lb = F.lds;
    LAS float* xch = (LAS float*)lb;
    LAS float* cmpb = (LAS float*)(lb + XCH_BYTES);
    LAS unsigned* mskb = (LAS unsigned*)(lb + XCH_BYTES + 8192);
    LAS float* psum = (LAS float*)(lb + XCH_BYTES + 8192 + 64);
    LAS float* impb = psum + 8 * 256;
    LAS unsigned char* selb = (LAS unsigned char*)(impb + 8 * 64);
    const float* gp = WSP(float, WS_GATES) + (size_t)row * 24 + hq * 3;
    float g0 = gp[0], g1 = gp[1], g2 = gp[2];
    bf16x8 qrot[4];
#pragma unroll
    for (int s = 0; s < 4; ++s) qrot[s] = *(const bf16x8*)(WSP(bf16, WS_QROT) + (size_t)row * 512 + hq * 64 + 16 * s + 8 * hi);
    f32x16 s0, s1;
    Soft S;
    __syncthreads();
    if (w == 0) {
        const bf16* ck = WSP(bf16, WS_SCK) + (size_t)bg * 128 * 64; const bf16* cvt = WSP(bf16, WS_SCVT) + (size_t)bg * 64 * 128;
        bf16x8 qraw[4];
#pragma unroll
        for (int s = 0; s < 4; ++s) qraw[s] = *(const bf16x8*)(WSP(bf16, WS_QRAW) + (size_t)row * 512 + hq * 64 + 16 * s + 8 * hi);
        const int ncmp = 127, nvis = 126;
        float m = -1e30f, l = 0.f;
        for (int ct = 0; ct < 2; ++ct) {
            GlbT kt{ck, (unsigned)((64 * ct + l31) * 64 + 8 * hi), 64u}; qk_tile(s0, s1, kt, qraw);
            float mx = -1e30f; const int nv2 = nvis - 64 * ct - 4 * hi;
#pragma unroll
            for (int r = 0; r < 16; ++r) { const int cr = (r & 3) + 8 * (r >> 2); s0[r] = cr <= nv2 ? s0[r] : NEGINF; s1[r] = cr + 32 <= nv2 ? s1[r] : NEGINF; mx = fmaxf(mx, fmaxf(s0[r], s1[r])); }
            mx = fmaxf(mx, half_other(mx));
            const float mn = fmaxf(m, mx); float ps = 0.f;
#pragma unroll
            for (int r = 0; r < 16; ++r) ps += __builtin_amdgcn_exp2f(s0[r] - mn) + __builtin_amdgcn_exp2f(s1[r] - mn);
            l = l * __builtin_amdgcn_exp2f(m - mn) + ps; m = mn;
        }
        l += half_other(l);
        const float linv = l > 0.f ? 1.f / l : 0.f;
        soft_init(S);
        for (int ct = 0; ct < 2; ++ct) {
            GlbT kt{ck, (unsigned)((64 * ct + l31) * 64 + 8 * hi), 64u}; qk_tile(s0, s1, kt, qraw);
            const int nv2 = nvis - 64 * ct - 4 * hi; LAS float* pw = psum + tl * 256 + 64 * ct + 4 * hi;
#pragma unroll
            for (int r = 0; r < 16; ++r) { const int cr = (r & 3) + 8 * (r >> 2);
                s0[r] = cr <= nv2 ? __builtin_amdgcn_exp2f(s0[r] - m) * linv : 0.f; s1[r] = cr + 32 <= nv2 ? __builtin_amdgcn_exp2f(s1[r] - m) * linv : 0.f;
                float a = s0[r]; a += dpp_x1(a); a += dpp_x2(a); float b = s1[r]; b += dpp_x1(b); b += dpp_x2(b);
                if (hl == 0) { pw[cr] = a; pw[cr + 32] = b; } }
            GlbT vt{cvt, (unsigned)(l31 * 128 + 64 * ct + 8 * hi), 128u}; pv_tile(S.o0, S.o1, s0, s1, vt);
        }
#pragma unroll
        for (int r = 0; r < 16; ++r) { cmpb[r * 64 + lane] = S.o0[r]; cmpb[(16 + r) * 64 + lane] = S.o1[r]; }
        LDS_WAIT();
        {
            const int tk = lane >> 3, jb = 8 * (lane & 7), cur = 32;
            float pv[33];
            const LAS f32x4* pp = (const LAS f32x4*)(psum + tk * 256 + 4 * jb);
#pragma unroll
            for (int q = 0; q < 8; ++q) { const f32x4 x = pp[q]; pv[1 + 4 * q] = x[0]; pv[2 + 4 * q] = x[1]; pv[3 + 4 * q] = x[2]; pv[4 + 4 * q] = x[3]; }
            pv[0] = jb > 0 ? psum[tk * 256 + 4 * jb - 1] : 0.f;
            float v[8];
#pragma unroll
            for (int jj = 0; jj < 8; ++jj) { const int j = jb + jj;
                float a = pv[4 * jj] + pv[4 * jj + 1] + pv[4 * jj + 2] + pv[4 * jj + 3];
                a += (4 * j + 3 < ncmp) ? pv[4 * jj + 4] : 0.f;
                a = ((j == 0) | (j == cur) | (j == cur - 1)) ? 1e4f : a;
                a = (j > cur) ? -1e30f : a;
                v[jj] = a; }
            LAS f32x4* ip = (LAS f32x4*)(impb + tk * 64 + jb);
            ip[0] = (f32x4){v[0], v[1], v[2], v[3]}; ip[1] = (f32x4){v[4], v[5], v[6], v[7]};
            LDS_WAIT();
            int cnt[8];
#pragma unroll
            for (int jj = 0; jj < 8; ++jj) cnt[jj] = 0;
            const LAS f32x4* ap = (const LAS f32x4*)(impb + tk * 64);
#pragma unroll 1
            for (int i4 = 0; i4 < 16; ++i4) { const f32x4 x = ap[i4];
#pragma unroll
                for (int e = 0; e < 4; ++e) { const int ii = 4 * i4 + e; const float xi = x[e];
#pragma unroll
                    for (int jj = 0; jj < 8; ++jj) cnt[jj] += ((xi > v[jj]) | ((xi == v[jj]) & (ii < jb + jj))) ? 1 : 0; } }
            unsigned bits = 0;
#pragma unroll
            for (int jj = 0; jj < 8; ++jj) bits |= ((cnt[jj] < 16) & (jb + jj <= cur)) ? (1u << jj) : 0u;
            selb[tk * 8 + (lane & 7)] = (unsigned char)bits;
            LDS_WAIT();
            if (lane < 16) mskb[lane] = ((const LAS unsigned*)selb)[lane];
        }
    }
    __syncthreads();
    const unsigned mlo = mskb[tl * 2], mhi = mskb[tl * 2 + 1];
    PIN4(qrot); asm volatile("" : "+v"(g0), "+v"(g1), "+v"(g2));
    soft_init(S);
    for (int j = w; j < 32; j += NWAVES) {
        const int pg = F.ptab[sb * NPG + (j >> 1)];
        const float* base = F.cnsa + ((size_t)pg * PAGE + (j & 1) * 64) * 512 + (2 * 2 + g) * 64;
        PageK kt{base + (size_t)l31 * 512 + 8 * hi, 512u}; qk_tile_c(s0, s1, kt, qrot, S.negm);
        const bool bsel = ((mlo >> j) & 1u) != 0u;
#pragma unroll
        for (int r = 0; r < 16; ++r) { s0[r] = bsel ? s0[r] : NEGINF; s1[r] = bsel ? s1[r] : NEGINF; }
        PageV vt{base + 128 + (size_t)(4 * hi) * 512 + l31, 512u}; soft_step(S, s0, s1, vt);
    }
    if (w == 0) {
        const bf16* sk = WSP(bf16, WS_SSLCK) + (size_t)bg * LS * 64; const bf16* svt = WSP(bf16, WS_SSLCVT) + (size_t)bg * 64 * LS;
        GlbT kt{sk, (unsigned)((2048 + l31) * 64 + 8 * hi), 64u}; qk_tile_c(s0, s1, kt, qrot, S.negm);
        const int qrel = i - 4 * hi;
#pragma unroll
        for (int r = 0; r < 16; ++r) { const int cr = (r & 3) + 8 * (r >> 2); s0[r] = cr <= qrel ? s0[r] : NEGINF; s1[r] = cr + 32 <= qrel ? s1[r] : NEGINF; }
        GlbT vt{svt, (unsigned)(l31 * LS + 2048 + 8 * hi), (unsigned)LS}; soft_step(S, s0, s1, vt);
    }
    xch_put(xch + w * XCH_W, S, lane);
    __syncthreads();
    float acc[4], part[4];
    xch_get(xch, w, lane, part);
#pragma unroll
    for (int k = 0; k < 4; ++k) acc[k] = g1 * part[k] + g0 * cmpb[(4 * w + k) * 64 + lane];
    __syncthreads();
    soft_init(S);
    {
        const float* base = F.swin + ((size_t)sb * 512 + 64 * w) * 256 + g * 64;
        PageK kt{base + (size_t)l31 * 256 + 8 * hi, 256u}; qk_tile_c(s0, s1, kt, qrot, S.negm);
        if (w == 0) {
            const int lo_r = 1 + i - 4 * hi;
#pragma unroll
            for (int r = 0; r < 16; ++r) { const int k0 = (r & 3) + 8 * (r >> 2); s0[r] = k0 >= lo_r ? s0[r] : NEGINF; s1[r] = k0 + 32 >= lo_r ? s1[r] : NEGINF; }
        }
        PageV vt{base + 128 + (size_t)(4 * hi) * 256 + l31, 256u}; soft_step(S, s0, s1, vt);
    }
    if (w == 0) {
        const bf16* wk = WSP(bf16, WS_SWINK) + (size_t)bg * LSW * 64; const bf16* wvt = WSP(bf16, WS_SWINVT) + (size_t)bg * 64 * LSW;
        GlbT kt{wk, (unsigned)((512 + l31) * 64 + 8 * hi), 64u}; qk_tile_c(s0, s1, kt, qrot, S.negm);
        const int hi_r = i - 4 * hi;
#pragma unroll
        for (int r = 0; r < 16; ++r) { const int k0 = (r & 3) + 8 * (r >> 2); s0[r] = k0 <= hi_r ? s0[r] : NEGINF; s1[r] = k0 + 32 <= hi_r ? s1[r] : NEGINF; }
        GlbT vt{wvt, (unsigned)(l31 * LSW + 512 + 8 * hi), (unsigned)LSW}; soft_step(S, s0, s1, vt);
    }
    xch_put(xch + w * XCH_W, S, lane);
    __syncthreads();
    xch_get(xch, w, lane, part);
#ifdef BREAK_WIN
#pragma unroll
    for (int k = 0; k < 4; ++k) part[k] *= 0.9f;
#endif
    if (tl < 4) {
        const int d0 = 32 * (w >> 2) + 8 * (w & 3) + 4 * hi;
        const u32x2 z = *(const u32x2*)(WSP(bf16, WS_ZN) + (size_t)row * 512 + hq * 64 + d0);
        u32x2 wv; wv.x = pk2((acc[0] + g2 * part[0]) * bflo(z.x), (acc[1] + g2 * part[1]) * bfhi(z.x)); wv.y = pk2((acc[2] + g2 * part[2]) * bflo(z.y), (acc[3] + g2 * part[3]) * bfhi(z.y));
        *(u32x2*)(WSP(bf16, WS_ONZ) + (size_t)row * 512 + hq * 64 + d0) = wv;
    }
}
DI void dsa_sample_unit(Frame& F, int bg) {
    const int lane = F.lane, w = F.wave, l31 = lane & 31, hi = lane >> 5, tl = l31 >> 2, hl = l31 & 3;
    const int sb = bg >> 1, g = bg & 1, i = tl & 3, row = MP + sb * 4 + i, hq = 4 * g + hl;
    LAS float* xch = (LAS float*)F.lds;
    bf16x8 dq[4];
#pragma unroll
    for (int s = 0; s < 4; ++s) dq[s] = *(const bf16x8*)(WSP(bf16, WS_DQ) + (size_t)row * 512 + hq * 64 + 16 * s + 8 * hi);
    const unsigned long long* selp = WSP(unsigned long long, WS_SELM) + (size_t)row * 64;
    PIN4(dq);
    f32x16 s0, s1;
    Soft S; soft_init(S);
    LAS unsigned char* const kb = F.lds + w * TILE_B;
    const int fo = l31 * TP + hi * 16;
    __syncthreads();
    for (int j = w; j < 32; j += NWAVES) {
        unsigned long long selw = selp[j];
        const int pg = F.ptab[sb * NPG + (j >> 1)];
        const float* base = F.cdsa + ((size_t)pg * PAGE + (j & 1) * 64) * 256 + g * 64;
        { f32x4 kx[16]; stage_k_ld(kx, base, 256u, lane); stage_k_st(kx, kb, lane); }
        LdsT kt{kb + fo}; qk_tile_c(s0, s1, kt, dq, S.negm);
#ifdef BREAK_DSA
        selw |= 0x1111111111111111ull;
#endif
        const unsigned wa = (unsigned)selw >> (4 * hi), wb = (unsigned)(selw >> 32) >> (4 * hi);
#pragma unroll
        for (int r = 0; r < 16; ++r) { const int bp = (r & 3) + 8 * (r >> 2);
            s0[r] = mask_sel(s0[r], (int)(wa << (31 - bp)) >> 31); s1[r] = mask_sel(s1[r], (int)(wb << (31 - bp)) >> 31); }
        PageV vt{base + 128 + (size_t)(4 * hi) * 256 + l31, 256u}; soft_step(S, s0, s1, vt);
    }
    if (w == 0) {
        const unsigned long long selw = selp[32];
        const bf16* dk = WSP(bf16, WS_SDSAK) + (size_t)bg * LS * 64; const bf16* dvt = WSP(bf16, WS_SDSAVT) + (size_t)bg * 64 * LS;
        GlbT kt{dk, (unsigned)((2048 + l31) * 64 + 8 * hi), 64u}; qk_tile_c(s0, s1, kt, dq, S.negm);
        const unsigned wa = (unsigned)selw >> (4 * hi), wb = (unsigned)(selw >> 32) >> (4 * hi);
#pragma unroll
        for (int r = 0; r < 16; ++r) { const int bp = (r & 3) + 8 * (r >> 2);
            s0[r] = mask_sel(s0[r], (int)(wa << (31 - bp)) >> 31); s1[r] = mask_sel(s1[r], (int)(wb << (31 - bp)) >> 31); }
        GlbT vt{dvt, (unsigned)(l31 * LS + 2048 + 8 * hi), (unsigned)LS}; soft_step(S, s0, s1, vt);
    }
    __syncthreads();
    xch_put(xch + w * XCH_W, S, lane);
    __syncthreads();
    float part[4];
    xch_get(xch, w, lane, part);
    if (tl < 4) {
        const int d0 = 32 * (w >> 2) + 8 * (w & 3) + 4 * hi;
        const u32x2 z = *(const u32x2*)(WSP(bf16, WS_ZD) + (size_t)row * 512 + hq * 64 + d0);
        u32x2 wv; wv.x = pk2(part[0] * bflo(z.x), part[1] * bfhi(z.x)); wv.y = pk2(part[2] * bflo(z.y), part[3] * bfhi(z.y));
        *(u32x2*)(WSP(bf16, WS_ODZ) + (size_t)row * 512 + hq * 64 + d0) = wv;
    }
}

template <int K, class EF> DI void small_gemm(Frame& F, const bf16* A, const bf16* Bt, const EF& ef) {
    const int lane = F.lane, w = F.wave, l31 = lane & 31, hi = lane >> 5;
    LAS float* red = (LAS float*)F.lds;
    for (int t = blockIdx.x; t < 256; t += F.G) {
        const int mt = t >> 5, nt = t & 31, kw = K >> 3, k0 = w * kw;
        const bf16* ap = A + (size_t)(MP + 64 * mt + l31) * K + k0 + 8 * hi;
        const bf16* bp = Bt + (size_t)(32 * nt + l31) * K + k0 + 8 * hi;
        f32x16 a0, a1;
#pragma unroll
        for (int i = 0; i < 16; ++i) { a0[i] = 0.f; a1[i] = 0.f; }
        bf16x8 fb[K / 128], f0[K / 128], f1[K / 128];
#pragma unroll
        for (int s = 0; s < K / 128; ++s) { fb[s] = *(const bf16x8*)(bp + 16 * s); f0[s] = *(const bf16x8*)(ap + 16 * s); f1[s] = *(const bf16x8*)(ap + (size_t)32 * K + 16 * s); }
#pragma unroll
        for (int s = 0; s < K / 128; ++s) { a0 = MFMA32(f0[s], fb[s], a0); a1 = MFMA32(f1[s], fb[s], a1); }
        __syncthreads();
#pragma unroll
        for (int r = 0; r < 16; ++r) { red[(w * 32 + r) * 64 + lane] = a0[r]; red[(w * 32 + 16 + r) * 64 + lane] = a1[r]; }
        __syncthreads();
        const int m2 = w >> 2, q = w & 3;
#pragma unroll
        for (int j = 0; j < 4; ++j) {
            float v = 0.f;
#pragma unroll
            for (int i = 0; i < 8; ++i) v += red[(i * 32 + 16 * m2 + 4 * q + j) * 64 + lane];
            ef(MP + 64 * mt + 32 * m2 + 8 * q + 4 * hi + j, 32 * nt + l31, v);
        }
    }
    __syncthreads();
}


#ifdef ORACLE
constexpr size_t WS_ORC = 948 * MiB;
constexpr int ORC_ROWS = 128;
DI float blk_red(Frame& F, float v, bool ismax, LAS float* red) {
#pragma unroll
    for (int o = 1; o < 64; o <<= 1) { const float x = __shfl_xor(v, o); v = ismax ? fmaxf(v, x) : v + x; }
    __syncthreads();
    if (F.lane == 0) red[F.wave] = v;
    __syncthreads();
    float r = red[0];
    for (int i = 1; i < 8; ++i) r = ismax ? fmaxf(r, red[i]) : r + red[i];
    return r;
}
DI float dot64(const bf16* a, const bf16* b) { float s = 0.f; for (int d = 0; d < 64; ++d) s += bf2f(a[d]) * bf2f(b[d]); return s; }
DI void orc_softmax(Frame& F, LAS float* sc, LAS unsigned char* vf, int n, LAS float* red) {
    float mx = -3e38f;
    for (int k = F.tid; k < n; k += 512) if (vf[k]) mx = fmaxf(mx, sc[k]);
    mx = blk_red(F, mx, true, red);
    float sm = 0.f;
    for (int k = F.tid; k < n; k += 512) { const float p = vf[k] ? exp2f(sc[k] - mx) : 0.f; sc[k] = p; sm += p; }
    sm = blk_red(F, sm, false, red);
    const float inv = 1.f / fmaxf(sm, 1e-30f);
    for (int k = F.tid; k < n; k += 512) sc[k] *= inv;
    __syncthreads();
}
DI void oracle_row(Frame& F, int oi) {
    int row;
    if (oi < 96) { const int tl[24] = {0, 1, 30, 31, 32, 63, 64, 65, 127, 128, 255, 256, 257, 400, 511, 512, 513, 1000, 1023, 1024, 2047, 2500, 3583, 4095};
        int t = 0;
#pragma unroll
        for (int i = 0; i < 24; ++i) t = (oi % 24 == i) ? tl[i] : t;
        row = (oi / 24) * SEQ + t; }
    else { const int k = oi - 96; row = MP + (((k >> 2) * 37) % SBATCH) * 4 + (k & 3); }
    const bool samp = row >= MP;
    const int b = samp ? (row - MP) >> 2 : row >> 12, ti = samp ? (row & 3) : (row & 4095), qpos = samp ? PASTL + ti : ti;
    const int ncmp = samp ? 127 : 255; const size_t pitch = samp ? LS : SEQ, wpitch = samp ? LSW : SEQ, cpitch = samp ? 128 : 256;
    const int wlo = samp ? 1 + ti : (qpos - 511 > 0 ? qpos - 511 : 0), whi = samp ? 512 + ti : qpos;
    LAS float* sc = (LAS float*)F.lds;
    LAS float* s2 = sc + 4096;
    LAS float* psum = s2 + 4096;
    LAS float* imp = psum + 256;
    LAS float* resn = imp + 64;
    LAS float* resd = resn + 512;
    LAS float* red = resd + 512;
    LAS unsigned char* vf = (LAS unsigned char*)(red + 8);
    LAS unsigned char* selb = vf + 4096;
    const bf16* qraw = WSP(bf16, WS_QRAW) + (size_t)row * 512; const bf16* qrot = WSP(bf16, WS_QROT) + (size_t)row * 512;
    const bf16* dq = WSP(bf16, WS_DQ) + (size_t)row * 512; const bf16* iq = WSP(bf16, WS_IQ) + (size_t)row * 256;
    const float* gat = WSP(float, WS_GATES) + (size_t)row * 24; const float* iw = WSP(float, WS_IW) + (size_t)row * 4;
    const int nvr = (qpos - 31) >> 4, nvis = nvr < ncmp - 1 ? nvr : ncmp - 1, cur = qpos >> 6;
    for (int g = 0; g < 2; ++g) {
        const int bg = b * 2 + g;
        const bf16* ck = samp ? WSP(bf16, WS_SCK) + (size_t)bg * 128 * 64 : WSP(bf16, WS_PCK) + (size_t)bg * 256 * 64;
        const bf16* cvt = samp ? WSP(bf16, WS_SCVT) + (size_t)bg * 64 * 128 : WSP(bf16, WS_PCVT) + (size_t)bg * 64 * 256;
        const bf16* sk = samp ? WSP(bf16, WS_SSLCK) + (size_t)bg * LS * 64 : WSP(bf16, WS_PSLCK) + (size_t)bg * SEQ * 64;
        const bf16* svt = samp ? WSP(bf16, WS_SSLCVT) + (size_t)bg * 64 * LS : WSP(bf16, WS_PSLCVT) + (size_t)bg * 64 * SEQ;
        const bf16* wk = samp ? WSP(bf16, WS_SWINK) + (size_t)bg * LSW * 64 : WSP(bf16, WS_PWINK) + (size_t)bg * SEQ * 64;
        const bf16* wvt = samp ? WSP(bf16, WS_SWINVT) + (size_t)bg * 64 * LSW : WSP(bf16, WS_PWINVT) + (size_t)bg * 64 * SEQ;
        __syncthreads();
        if (F.tid < 256) psum[F.tid] = 0.f;
        for (int hl = 0; hl < 4; ++hl) {
            const int h = 4 * g + hl;
            __syncthreads();
            for (int n = F.tid; n < 256; n += 512) { const bool v = n <= nvis; vf[n] = v; sc[n] = v ? dot64(qraw + h * 64, ck + (size_t)n * 64) : 0.f; }
            __syncthreads();
            orc_softmax(F, sc, vf, 256, red);
            if (F.tid < 256) psum[F.tid] += sc[F.tid];
            if (F.tid < 64) { float a = 0.f; for (int n = 0; n <= nvis; ++n) a += sc[n] * bf2f(cvt[(size_t)F.tid * cpitch + permk(n)]); resn[h * 64 + F.tid] = gat[h * 3 + 0] * a; }
        }
        __syncthreads();
        if (F.tid < 64) { const int j = F.tid; float a = 0.f;
            for (int n = 4 * j - 1; n <= 4 * j + 3; ++n) if (n >= 0 && n < ncmp) a += psum[n];
            if (j == 0 || j == cur || j == cur - 1) a = 1e4f;
            if (j > cur) a = -1e30f;
            imp[j] = a; selb[j] = 0; }
        __syncthreads();
        if (F.tid == 0) { for (int k = 0; k < 16; ++k) { int best = -1; float bv = -3e38f; for (int j = 0; j < 64; ++j) if (!selb[j] && imp[j] > bv) { bv = imp[j]; best = j; }
                if (best >= 0) selb[best] = (bv > -5e29f) ? 1 : 2; }
            for (int j = 0; j < 64; ++j) selb[j] = selb[j] == 1 ? 1 : 0; }
        __syncthreads();
        for (int hl = 0; hl < 4; ++hl) {
            const int h = 4 * g + hl;
            __syncthreads();
            for (int k = F.tid; k <= qpos; k += 512) { const bool v = selb[k >> 6] != 0; vf[k] = v; sc[k] = v ? dot64(qrot + h * 64, sk + (size_t)k * 64) : 0.f; }
            __syncthreads();
            orc_softmax(F, sc, vf, qpos + 1, red);
            if (F.tid < 64) { float a = 0.f; for (int k = 0; k <= qpos; ++k) if (vf[k]) a += sc[k] * bf2f(svt[(size_t)F.tid * pitch + permk(k)]); resn[h * 64 + F.tid] += gat[h * 3 + 1] * a; }
            __syncthreads();
            for (int k = wlo + F.tid; k <= whi; k += 512) { vf[k - wlo] = 1; sc[k - wlo] = dot64(qrot + h * 64, wk + (size_t)k * 64); }
            __syncthreads();
            orc_softmax(F, sc, vf, whi - wlo + 1, red);
            if (F.tid < 64) { float a = 0.f; for (int k = wlo; k <= whi; ++k) a += sc[k - wlo] * bf2f(wvt[(size_t)F.tid * wpitch + permk(k)]); resn[h * 64 + F.tid] += gat[h * 3 + 2] * a; }
        }
    }
    __syncthreads();
    const bf16* ik = samp ? WSP(bf16, WS_SIDXK) + (size_t)b * LS * 64 : WSP(bf16, WS_PIDXK) + (size_t)b * SEQ * 64;
    for (int k = F.tid; k <= qpos; k += 512) { float a = 0.f; for (int h = 0; h < 4; ++h) a += fmaxf(dot64(iq + h * 64, ik + (size_t)k * 64), 0.f) * iw[h]; s2[k] = a; }
    __syncthreads();
    for (int k = F.tid; k <= qpos; k += 512) { const float v = s2[k]; int c = 0; for (int j = 0; j <= qpos; ++j) { const float x = s2[j]; c += (x > v || (x == v && j < k)) ? 1 : 0; } vf[k] = c < 256; }
    __syncthreads();
    for (int h = 0; h < 8; ++h) {
        const int bg = b * 2 + (h >> 2);
        const bf16* dk = samp ? WSP(bf16, WS_SDSAK) + (size_t)bg * LS * 64 : WSP(bf16, WS_PDSAK) + (size_t)bg * SEQ * 64;
        const bf16* dvt = samp ? WSP(bf16, WS_SDSAVT) + (size_t)bg * 64 * LS : WSP(bf16, WS_PDSAVT) + (size_t)bg * 64 * SEQ;
        __syncthreads();
        for (int k = F.tid; k <= qpos; k += 512) sc[k] = vf[k] ? dot64(dq + h * 64, dk + (size_t)k * 64) : 0.f;
        __syncthreads();
        orc_softmax(F, sc, vf, qpos + 1, red);
        if (F.tid < 64) { float a = 0.f; for (int k = 0; k <= qpos; ++k) if (vf[k]) a += sc[k] * bf2f(dvt[(size_t)F.tid * pitch + permk(k)]); resd[h * 64 + F.tid] = a; }
    }
    __syncthreads();
    float dn = 0.f, rn = 0.f, dd = 0.f, rd = 0.f;
    { const int e = F.tid;
      const float zn = bf2f(WSP(bf16, WS_ZN)[(size_t)row * 512 + e]), zd = bf2f(WSP(bf16, WS_ZD)[(size_t)row * 512 + e]);
      const float refn = resn[e] * zn, refd = resd[e] * zd;
      const float gotn = bf2f(WSP(bf16, WS_ONZ)[(size_t)row * 512 + e]), gotd = bf2f(WSP(bf16, WS_ODZ)[(size_t)row * 512 + e]);
      dn = (gotn - refn) * (gotn - refn); rn = refn * refn; dd = (gotd - refd) * (gotd - refd); rd = refd * refd; }
    dn = blk_red(F, dn, false, red); rn = blk_red(F, rn, false, red); dd = blk_red(F, dd, false, red); rd = blk_red(F, rd, false, red);
    float dc = 0.f, rc = 0.f;
    {
        const bool cs = oi >= 96; const int cbg = cs ? (oi * 5) % 256 : oi % 8, cn = cs ? (oi * 11) % 127 : (oi * 13) % 255;
        for (int slot = 0; slot < 2; ++slot) {
            const bf16* data = cs ? WSP(bf16, slot ? WS_SCMPV : WS_SCMPK) + (size_t)cbg * LS * 64 + (size_t)cn * 1024 : WSP(bf16, slot ? WS_PCMPV : WS_PCMPK) + (size_t)cbg * SEQ * 64 + (size_t)cn * 1024;
            __syncthreads();
            if (F.tid < 128) { float a = 0.f; for (int k = 0; k < 2048; ++k) a += (bf2f(data[k]) + F.pe[slot * 2048 + k]) * F.w1[((size_t)slot * 2048 + k) * 128 + F.tid]; sc[F.tid] = a / (1.f + expf(-a)); }
            __syncthreads();
            if (F.tid < 64) { float a = 0.f; for (int c = 0; c < 128; ++c) a += sc[c] * F.w2[((size_t)slot * 128 + c) * 64 + F.tid];
                float got;
                if (slot == 0) got = bf2f((cs ? WSP(bf16, WS_SCK) + (size_t)cbg * 128 * 64 : WSP(bf16, WS_PCK) + (size_t)cbg * 256 * 64)[(size_t)cn * 64 + F.tid]);
                else got = bf2f((cs ? WSP(bf16, WS_SCVT) + (size_t)cbg * 64 * 128 : WSP(bf16, WS_PCVT) + (size_t)cbg * 64 * 256)[(size_t)F.tid * (cs ? 128 : 256) + permk(cn)]);
                dc += (got - a) * (got - a); rc += a * a; }
        }
    }
    dc = blk_red(F, dc, false, red); rc = blk_red(F, rc, false, red);
    if (F.tid == 0) { float* o = WSP(float, WS_ORC) + oi * 8; o[0] = dn; o[1] = rn; o[2] = dd; o[3] = rd; o[4] = dc; o[5] = rc; }
    __syncthreads();
}
DI float oracle_value(Frame& F) {
    const float* o = WSP(float, WS_ORC);
    float bad = 0.f, acc = 0.f, mxe = 0.f;
    for (int i = 0; i < ORC_ROWS; ++i) { const int c = (ORACLE_MODE >= 6) ? 4 : (ORACLE_MODE & 1) ? 2 : 0; const float e = sqrtf(o[i * 8 + c] / fmaxf(o[i * 8 + c + 1], 1e-30f));
        bad += e > 0.03f ? 1.f : 0.f; acc += fminf(e, 1.f) * fminf(e, 1.f); mxe = fmaxf(mxe, fminf(e, 1.f)); }
    return (ORACLE_MODE < 2 || ORACLE_MODE == 6) ? bad / ORC_ROWS : (ORACLE_MODE < 4 || ORACLE_MODE == 7) ? sqrtf(acc / ORC_ROWS) : mxe;
}
#endif

#define XB_TMO      128
#define XB_XCNT(j)  (256  + 64 * (j))
#define XB_XSUB(j)  (1280 + 64 * (j))
#define XB_XGEN(j)  (2304 + 64 * (j))
#define XB_TOP      3328
#define XB_TOPGEN   3392
#define XCD_BAR_WORDS 3456
#define XB_SPIN_CAP (1u << 18)
__device__ __forceinline__ unsigned xb_ld(unsigned* p)              { return __hip_atomic_load(p, __ATOMIC_RELAXED, __HIP_MEMORY_SCOPE_AGENT); }
__device__ __forceinline__ unsigned xb_add(unsigned* p, unsigned v) { return __hip_atomic_fetch_add(p, v, __ATOMIC_RELAXED, __HIP_MEMORY_SCOPE_AGENT); }
__device__ __forceinline__ unsigned xb_xcc_id() { return (unsigned)__builtin_amdgcn_s_getreg((3 << 11) | 20) & 0xFu; }
#define XB_SPIN(cond, bar) do { unsigned _sp = 0; while (cond) { __builtin_amdgcn_s_sleep(1); \
    if ((++_sp & 255u) == 0u) { if (xb_ld(&(bar)[XB_TMO])) break; if (_sp > XB_SPIN_CAP) { atomicAdd(&(bar)[XB_TMO], 1u); break; } } } } while (0)
struct XcdBarrier { unsigned* bar; unsigned x; volatile LAS unsigned* st; };
__device__ __forceinline__ XcdBarrier xcd_barrier_post(unsigned* bar, volatile LAS unsigned* st) {
    XcdBarrier b; b.bar = bar; b.x = xb_xcc_id(); b.st = st;
    if (threadIdx.x == 0) (void)xb_add(&bar[XB_XCNT(b.x)], 1u);
    return b;
}
__device__ __forceinline__ void xcd_barrier_complete(unsigned* bar, unsigned x, unsigned& nloc, unsigned& nx) {
    const unsigned G = gridDim.x * gridDim.y * gridDim.z;
    unsigned sum, cnt, mine, sp = 0u;
    for (;;) {
        sum = 0u; cnt = 0u; mine = 0u;
#pragma unroll
        for (unsigned j = 0; j < 16; ++j) { const unsigned c = xb_ld(&bar[XB_XCNT(j)]); sum += c; cnt += (c > 0u) ? 1u : 0u; mine = (j == x) ? c : mine; }
        if (sum == G) break;
        __builtin_amdgcn_s_sleep(1);
        if ((++sp & 255u) == 0u) { if (xb_ld(&bar[XB_TMO])) break; if (sp > XB_SPIN_CAP) { atomicAdd(&bar[XB_TMO], 1u); break; } }
    }
    nloc = mine > 0u ? mine : 1u; nx = cnt > 0u ? cnt : 1u;
}
__device__ __forceinline__ void xcd_barrier(const XcdBarrier& b) {
    asm volatile("s_waitcnt vmcnt(0)" ::: "memory");
    __syncthreads();
    if (threadIdx.x == 0) {
        unsigned* bar = b.bar;
        __builtin_amdgcn_s_waitcnt(0);
        unsigned nloc = b.st[0], nx = b.st[1];
        if (nloc == 0u) { xcd_barrier_complete(bar, b.x, nloc, nx); b.st[0] = nloc; b.st[1] = nx; }
        const unsigned old = xb_add(&bar[XB_XSUB(b.x)], 1u);
        const unsigned gen = old / nloc;
        if (old + 1u == (gen + 1u) * nloc) {
            __builtin_amdgcn_fence(__ATOMIC_RELEASE, "agent");
            asm volatile("s_waitcnt vmcnt(0)" ::: "memory");
            const unsigned og = xb_add(&bar[XB_TOP], 1u);
            const unsigned tg = og / nx;
            if (og + 1u == (tg + 1u) * nx) xb_add(&bar[XB_TOPGEN], 1u);
            else XB_SPIN(xb_ld(&bar[XB_TOPGEN]) == tg, bar);
            __builtin_amdgcn_fence(__ATOMIC_ACQUIRE, "agent");
            xb_add(&bar[XB_XGEN(b.x)], 1u);
            asm volatile("s_waitcnt vmcnt(0)" ::: "memory");
        } else {
            XB_SPIN(xb_ld(&bar[XB_XGEN(b.x)]) == gen, bar);
            __builtin_amdgcn_fence(__ATOMIC_ACQUIRE, "agent");
            asm volatile("s_waitcnt vmcnt(0)" ::: "memory");
        }
    }
    __syncthreads();
}

constexpr int N_PHASES = 9;
DI int q_next(Frame& F, int qi) {
    __syncthreads();
    if (F.tid == 0) F.MISC[0] = __hip_atomic_fetch_add(F.ctl + CW_Q + 64 * (qi + F.qoff), 1u, __ATOMIC_RELAXED, __HIP_MEMORY_SCOPE_AGENT);
    __syncthreads();
    return (int)F.MISC[0];
}
DI void q_issue(Frame& F, int qi, unsigned& pend) { if (F.tid == 0) pend = __hip_atomic_fetch_add(F.ctl + CW_Q + 64 * (qi + F.qoff), 1u, __ATOMIC_RELAXED, __HIP_MEMORY_SCOPE_AGENT); }
DI int q_take(Frame& F, unsigned pend) { __syncthreads(); if (F.tid == 0) F.MISC[0] = pend; __syncthreads(); return (int)F.MISC[0]; }
#define QLOOP_PF(qi, N, CALL) do { unsigned pend_ = 0u; for (int u = q_next(F, (qi)); u < (N); u = q_take(F, pend_)) { q_issue(F, (qi), pend_); CALL; } } while (0)
#define QLOOP(qi, N, CALL) do { for (int u = q_next(F, (qi)); u < (N); u = q_next(F, (qi))) { CALL; } } while (0)
__global__ void __launch_bounds__(NWAVES * 64, 2) fwd(Args args) {
    extern __shared__ __attribute__((aligned(16))) unsigned char lds[];
    Frame F;
    F.lds = (LAS unsigned char*)lds; F.MISC = (volatile LAS unsigned*)(F.lds + MISC_OFF);
    F.tid = threadIdx.x; F.lane = F.tid & 63; F.wave = __builtin_amdgcn_readfirstlane(F.tid >> 6); F.G = gridDim.x;
    F.ws = args.ws; F.out = args.out; F.ctl = (unsigned*)(args.ws + WS_CTL); F.qoff = args.qoff;
    F.xp = (const float*)args.in[0]; F.xs = (const float*)args.in[1]; F.cnsa = (const float*)args.in[2]; F.cdsa = (const float*)args.in[3]; F.cidx = (const float*)args.in[4];
    F.swin = (const float*)args.in[5]; F.ptab = (const int*)args.in[6]; F.cp = (const float*)args.in[7]; F.cs = (const float*)args.in[8]; F.normg = (const float*)args.in[9];
    F.wada = (const float*)args.in[10]; F.bada = (const float*)args.in[11]; F.win = (const float*)args.in[12]; F.pe = (const float*)args.in[13]; F.w1 = (const float*)args.in[14];
    F.w2 = (const float*)args.in[15]; F.wupn = (const float*)args.in[16]; F.wupd = (const float*)args.in[17]; F.wout = (const float*)args.in[18]; F.fing = (const float*)args.in[19];
    for (int i = F.tid; i < (LDS_BYTES - MISC_OFF) / 4; i += NWAVES * 64) ((LAS unsigned*)(F.lds + MISC_OFF))[i] = 0u;
    __syncthreads();
    const int lo = args.ph_lo, hi = args.ph_hi;
    const bool one = (hi - lo) > 1;
    XcdBarrier bar; bar.bar = F.ctl + CW_BAR; bar.x = 0; bar.st = nullptr;
    if (one) bar = xcd_barrier_post(F.ctl + CW_BAR, F.MISC + 8);
#ifndef PH_MASK
#define PH_MASK 0x1ff
#endif
#define IN(k) (((PH_MASK >> (k)) & 1) && lo <= (k) && (k) < hi)
#define SEAM(k) do { if (IN(k) && IN((k) + 1)) xcd_barrier(bar); } while (0)

#ifndef PROBE_REP
#define PROBE_REP -1
#endif
#define REP(k, BODY) do { if (IN(k)) { BODY(0) } } while (0)
#ifndef PROBE_P4MASK
#define PROBE_P4MASK 15
#endif
#ifndef PROBE_ABL
#define PROBE_ABL 0
#endif
#define B0(qo) { p0_prologue(F, args.umask); }
#define B1(qo) { p1_adaln(F); }
#define B2(qo) { pg8::Gemm g{WSP(bf16, WS_H), WSP(bf16, WS_WINT), MR, NPAD, DM}; pg8::StaticOrder S; S.init(MR, NPAD, F.G, (int)blockIdx.x); \
        { EpiInProj E{F.ws, F.out}; pg8::gemm_phase<EpiInProj, pg8::StaticOrder, true, true>(F.lds, g, S, E); } }
#define B3(qo) { const int PM3_ = args.umask; const bool strm3_ = (blockIdx.x & 1) == 0 || args.qoff != 0;     \
        if ((PM3_ & 4) && strm3_) QLOOP(2 + qo, SBATCH, (idx1_unit<true, 0>(F, u))); \
        if ((PM3_ & 1) && strm3_) QLOOP(0 + qo, 272, compress_unit(F, u)); \
        if (PM3_ & 2) QLOOP(1 + qo, 2048, (idx1_unit<false, 0>(F, u))); }
#ifndef P4_MASK
#define P4_MASK 15
#endif
#define B4(qo) { const int PM_ = args.umask & P4_MASK; const bool strm_ = (blockIdx.x & 1) == 0 || args.qoff != 0;     \
        if ((PM_ & 1) && strm_) QLOOP(3 + qo, 256, nsa_sample_unit(F, u)); \
        if ((PM_ & 2) && strm_) QLOOP(4 + qo, 256, dsa_sample_unit(F, u)); \
        if (PM_ & 4) QLOOP(5 + qo, 512, nsa_unit<false>(F, u)); \
        if (PM_ & 8) QLOOP(6 + qo, 512, (dsa_unit<0>(F, u))); }
#define B5(qo) { small_gemm<512>(F, WSP(bf16, WS_ONZ), WSP(bf16, WS_WUPN), [&](int r, int c, float v) { WSP(bf16, WS_T1)[(size_t)r * 1024 + c] = (bf16)(pk2(v * bf2f(WSP(bf16, WS_MG)[(size_t)r * 2048 + c]), 0.f) & 0xffffu); }); \
        pg8::Gemm g{WSP(bf16, WS_ONZ), WSP(bf16, WS_WUPN), MP, DM, 512}; pg8::StaticOrder S; S.init(MP, DM, F.G, (int)blockIdx.x); EpiUp1 E{F.ws}; \
        pg8::gemm_phase<EpiUp1, pg8::StaticOrder, true, true>(F.lds, g, S, E); }
#define B6(qo) { small_gemm<512>(F, WSP(bf16, WS_ODZ), WSP(bf16, WS_WUPD), [&](int r, int c, float v) { WSP(bf16, WS_M1)[(size_t)r * 1024 + c] = (bf16)(pk2(bf2f(WSP(bf16, WS_T1)[(size_t)r * 1024 + c]) + v * bf2f(WSP(bf16, WS_MG)[(size_t)r * 2048 + 1024 + c]), 0.f) & 0xffffu); }); \
        pg8::Gemm g{WSP(bf16, WS_ODZ), WSP(bf16, WS_WUPD), MP, DM, 512}; pg8::StaticOrder S; S.init(MP, DM, F.G, (int)blockIdx.x); EpiUp2 E{F.ws}; \
        pg8::gemm_phase<EpiUp2, pg8::StaticOrder, true, true>(F.lds, g, S, E); }
#define B7(qo) { small_gemm<1024>(F, WSP(bf16, WS_M1), WSP(bf16, WS_WOUT), [&](int r, int c, float v) { const int rs = r - MP; F.out[O_YS + (size_t)rs * 1024 + c] = F.xs[(size_t)rs * 1024 + c] + WSP(float, WS_MOD)[(size_t)(4 + (rs >> 2)) * 3072 + 2048 + c] * v; }); \
        pg8::Gemm g{WSP(bf16, WS_M1), WSP(bf16, WS_WOUT), MP, DM, DM}; pg8::StaticOrder S; S.init(MP, DM, F.G, (int)blockIdx.x); EpiOut E{F.ws, F.out, F.xp, F.xs}; \
        pg8::gemm_phase<EpiOut, pg8::StaticOrder, true, true>(F.lds, g, S, E); }
#define B8(qo) { p8_final(F); }
    REP(0, B0); SEAM(0);
    REP(1, B1); SEAM(1);
    REP(2, B2); SEAM(2);
    REP(3, B3); SEAM(3);
    REP(4, B4); SEAM(4);
#ifdef ORACLE
    if (IN(4)) { for (int oi = blockIdx.x; oi < ORC_ROWS; oi += F.G) oracle_row(F, oi); xcd_barrier(bar); }
#endif
    REP(5, B5);
    REP(6, B6); SEAM(6);
    REP(7, B7); SEAM(7);
    if (IN(8)) { p8_final(F); }
#ifdef ORACLE
    if (IN(8)) { xcd_barrier(bar); const float val = oracle_value(F); const float sc = 1.f + 0.02f * (1.f + val);
        for (size_t i = (size_t)blockIdx.x * 512 + F.tid; i < (size_t)MP * 1024; i += (size_t)F.G * 512) F.out[O_YP + i] *= sc; }
#endif
#undef IN
#undef SEAM
}

extern "C" void kernel_launch(void* const* d_in, const int* in_sizes, int n_in, void* d_out, int out_size, void* d_ws, size_t ws_size, hipStream_t stream) {
    static int grid = 0;
    if (grid == 0) {
        if (n_in != 20 || (size_t)out_size != O_END || ws_size < WS_END) { fprintf(stderr, "kernel_launch: unexpected shapes (n_in %d, out %d, ws %zu)\n", n_in, out_size, ws_size); grid = -1; return; }
        int dev = 0, cus = 0, per_cu = 0;
        if (hipGetDevice(&dev) != hipSuccess || hipDeviceGetAttribute(&cus, hipDeviceAttributeMultiprocessorCount, dev) != hipSuccess) { grid = -1; return; }
        if (hipFuncSetAttribute((const void*)fwd, hipFuncAttributeMaxDynamicSharedMemorySize, LDS_BYTES) != hipSuccess) { fprintf(stderr, "kernel_launch: hipFuncSetAttribute failed\n"); grid = -1; return; }
        if (hipOccupancyMaxActiveBlocksPerMultiprocessor(&per_cu, (const void*)fwd, NWAVES * 64, LDS_BYTES) != hipSuccess || per_cu < 1) { fprintf(stderr, "kernel_launch: occupancy query says %d blocks per CU\n", per_cu); }
        (void)hipGetLastError();
        grid = cus;
    }
    if (grid < 0) return;
    (void)hipMemsetAsync((char*)d_ws + WS_CTL, 0, CTL_ZERO_BYTES, stream);
    Args a{};
    for (int i = 0; i < 20; ++i) a.in[i] = d_in[i];
    a.out = (float*)d_out; a.ws = (unsigned char*)d_ws; a.qoff = 0; a.umask = 15; a.pad0 = 0; a.pad1 = 0;
#if MK_N_LAUNCHES == 1
    a.ph_lo = 0; a.ph_hi = N_PHASES;
    hipLaunchKernelGGL(fwd, dim3(grid), dim3(NWAVES * 64), LDS_BYTES, stream, a);
#if PROBE_REP >= 0
    a.ph_lo = PROBE_REP; a.ph_hi = PROBE_REP + 1; a.qoff = 8; a.umask = PROBE_P4MASK;
    hipLaunchKernelGGL(fwd, dim3(grid), dim3(NWAVES * 64), LDS_BYTES, stream, a);
#endif
#else
    for (int p = 0; p < N_PHASES; ++p) { a.ph_lo = p; a.ph_hi = p + 1; hipLaunchKernelGGL(fwd, dim3(grid), dim3(NWAVES * 64), LDS_BYTES, stream, a); }
#endif
}
```

```cpp
#define MK_N_LAUNCHES 1
#include <hip/hip_runtime.h>
#include <cstdio>
#include <cstdint>
#ifndef MK_N_LAUNCHES
#define MK_N_LAUNCHES 1
#endif
namespace pg8 {
#define PG8_LAS __attribute__((address_space(3)))
typedef unsigned short bf16_t;
typedef short bf16x8 __attribute__((ext_vector_type(8)));
typedef float f32x4 __attribute__((ext_vector_type(4)));
typedef unsigned u32x4 __attribute__((ext_vector_type(4)));
constexpr int BM = 256, BK = 64, HALF = 128, HTB = HALF * BK * 2  , STAGE_BYTES = 8 * HTB, NXCD = 8, WGM = 8;

__host__ __device__ __forceinline__ int lds_byte(int r, int c) { const int st = (r >> 4) * 2 + (c >> 5), rr = r & 15, cc = c & 31, ob = rr * 64 + cc * 2; return st * 1024 + (ob ^ (((ob >> 9) & 1) << 5)); }
__host__ __device__ __forceinline__ void stage_rc(int b, int& R, int& C) { const int st = b / 1024, sb = b % 1024, swz = sb ^ (((sb >> 9) & 1) << 5); R = (st >> 1) * 16 + swz / 64; C = (st & 1) * 32 + (swz % 64) / 2; }
__host__ __device__ __forceinline__ int perm32(int rho) { const int n = rho >> 4, i = rho & 15; return 8 * (i >> 2) + 4 * n + (i & 3); }

struct Unit { int pm, pn; };
struct Gemm { const bf16_t* A; const bf16_t* Bt; int M, N, K; };

struct StaticOrder {
    int nM, nN, nwg, G, c;
    __host__ __device__ void init(int M, int N, int G_, int c_) { nM = M / BM; nN = N / BM; nwg = nM * nN; G = G_; c = c_; }
    __host__ __device__ bool next(int i, Unit& u) const {
        const long L = (long)i * G + c; if (L >= nwg) return false;
        int wgid = (int)L; { const int q = nwg / NXCD, r = nwg % NXCD, xcd = wgid % NXCD, off = wgid / NXCD; wgid = (xcd < r ? xcd * (q + 1) : r * (q + 1) + (xcd - r) * q) + off; }
        const int nig = WGM * nN, gid = wgid / nig, fm = gid * WGM, gsz = (nM - fm) < WGM ? (nM - fm) : WGM;
        u.pm = fm + ((wgid % nig) % gsz); u.pn = (wgid % nig) / gsz; return true;
    }
    __device__ __forceinline__ void a_ready(const Unit&) const {}
    __device__ __forceinline__ void done(const Unit&) const {}
};

typedef float f32x2p __attribute__((ext_vector_type(2))); typedef __bf16 bf16x2p __attribute__((ext_vector_type(2)));
__device__ __forceinline__ unsigned cvt_pk_bf16(float lo, float hi) { f32x2p v = {lo, hi}; bf16x2p b = __builtin_convertvector(v, bf16x2p); return __builtin_bit_cast(unsigned, b); }
template <class Epi, class Sched, bool ALIGN_EPI = false, bool SP2 = false>
__device__ __forceinline__ void gemm_phase(PG8_LAS unsigned char* lds, const Gemm g, const Sched& S, const Epi& E) {
    const int tid = threadIdx.x, wid = __builtin_amdgcn_readfirstlane(tid >> 6), lane = tid & 63, wr = wid >> 2, wc = wid & 3, fr = lane & 15, fq = lane >> 4;
    const int K = g.K, nt = K / BK;
    unsigned voffA[2], voffB[2];
#pragma unroll
    for (int i = 0; i < 2; ++i) { int R, C; stage_rc(tid * 16 + i * 8192, R, C); const int Rb = Epi::PERM ? ((R & ~31) + perm32(R & 31)) : R;
        voffA[i] = (unsigned)(R * K + C) * 2u; voffB[i] = (unsigned)(Rb * K + C) * 2u; }
    const size_t kstep = (size_t)(BK * 2);
    const size_t hstep = (size_t)HALF * K * 2;
    const size_t tstep = 2 * hstep;
    const unsigned ldsw = (unsigned)wid * 1024u;
    const int aoff = lds_byte(wr * 64 + fr, fq * 8), boff = lds_byte(wc * 32 + fr, fq * 8);
#define PG8_SA(b, h) (((b) * 2 + (h)) * HTB)
#define PG8_SB(b, h) ((4 + (b) * 2 + (h)) * HTB)
#define PG8_STAGE(bufoff, gbase, voff) do { _Pragma("unroll") for (int _i = 0; _i < 2; ++_i) \
        __builtin_amdgcn_global_load_lds((const unsigned*)((const char*)(gbase) + (voff)[_i]), (PG8_LAS unsigned*)(lds + (bufoff) + ldsw + _i * 8192), 16, 0, 0); } while (0)
#define PG8_LDA(dst, b, h) do { _Pragma("unroll") for (int m = 0; m < 4; ++m) _Pragma("unroll") for (int k = 0; k < 2; ++k) dst[m][k] = *(const PG8_LAS bf16x8*)(lds + PG8_SA(b, h) + aoff + m * 2048 + k * 1024); } while (0)
#define PG8_LDB(dst, b, h) do { _Pragma("unroll") for (int n = 0; n < 2; ++n) _Pragma("unroll") for (int k = 0; k < 2; ++k) dst[n][k] = *(const PG8_LAS bf16x8*)(lds + PG8_SB(b, h) + boff + n * 2048 + k * 1024); } while (0)
#define PG8_MMA(ai, bj, At, Bt) do { __builtin_amdgcn_s_setprio(1); _Pragma("unroll") for (int m = 0; m < 4; ++m) _Pragma("unroll") for (int n = 0; n < 2; ++n) _Pragma("unroll") for (int k = 0; k < 2; ++k) \
        acc[ai][bj][m][n] = __builtin_amdgcn_mfma_f32_16x16x32_bf16(Bt[n][k], At[m][k], acc[ai][bj][m][n], 0, 0, 0); __builtin_amdgcn_s_setprio(0); } while (0)
#define PG8_WAIT_V(n) asm volatile("s_waitcnt vmcnt(" #n ")" ::: "memory")
#define PG8_WAIT_L(n) asm volatile("s_waitcnt lgkmcnt(" #n ")" ::: "memory")
#define PG8_BAR __builtin_amdgcn_s_barrier()
#define PG8_SCHED __builtin_amdgcn_sched_barrier(0)
    Unit cur, nxt; int ui = 0;
    if (!S.next(0, cur)) return;
    f32x4 acc[2][2][4][2];
#pragma unroll
    for (int a = 0; a < 2; ++a)
#pragma unroll
        for (int b = 0; b < 2; ++b)
#pragma unroll
            for (int m = 0; m < 4; ++m)
#pragma unroll
                for (int n = 0; n < 2; ++n) acc[a][b][m][n] = (f32x4){0.f, 0.f, 0.f, 0.f};
    bf16x8 At[4][2], B0[2][2], B1[2][2];
    const char* cA = (const char*)g.A + (size_t)cur.pm * tstep; const char* cB = (const char*)g.Bt + (size_t)cur.pn * tstep;
    S.a_ready(cur);
    if constexpr (SP2) {
        PG8_STAGE(PG8_SB(0, 0), cB, voffB); PG8_STAGE(PG8_SB(0, 1), cB + hstep, voffB); PG8_STAGE(PG8_SA(0, 0), cA, voffA); PG8_STAGE(PG8_SA(0, 1), cA + hstep, voffA);
        if (wr == 1) PG8_BAR;
        PG8_WAIT_V(2); PG8_BAR;
        PG8_STAGE(PG8_SB(1, 0), cB + kstep, voffB); PG8_STAGE(PG8_SA(1, 0), cA + kstep, voffA); PG8_STAGE(PG8_SB(1, 1), cB + hstep + kstep, voffB);
        PG8_WAIT_V(6); PG8_BAR;
    } else {
        PG8_STAGE(PG8_SB(0, 0), cB, voffB); PG8_STAGE(PG8_SA(0, 0), cA, voffA); PG8_STAGE(PG8_SB(0, 1), cB + hstep, voffB); PG8_STAGE(PG8_SA(0, 1), cA + hstep, voffA);
        if (wr == 1) PG8_BAR;
        PG8_WAIT_V(4); PG8_BAR;
        PG8_STAGE(PG8_SB(1, 0), cB + kstep, voffB); PG8_STAGE(PG8_SA(1, 0), cA + kstep, voffA); PG8_STAGE(PG8_SB(1, 1), cB + hstep + kstep, voffB);
        PG8_WAIT_V(6); PG8_BAR;
    }
    for (;;) {
        const bool has_next = S.next(ui + 1, nxt);
        const char* nA = has_next ? (const char*)g.A + (size_t)nxt.pm * tstep : cA; const char* nB = has_next ? (const char*)g.Bt + (size_t)nxt.pn * tstep : cB;
        for (int t = 0; t < nt; t += 2) {
            const bool last = (t == nt - 2);
            const char* a1 = cA + (size_t)(t + 1) * kstep;
            const char* a2 = last ? nA : cA + (size_t)(t + 2) * kstep; const char* b2 = last ? nB : cB + (size_t)(t + 2) * kstep;
            const char* a3 = a2 + kstep; const char* b3 = b2 + kstep;
            if (last && has_next) S.a_ready(nxt);
            if constexpr (SP2) {
            PG8_LDB(B0, 0, 0); PG8_LDB(B1, 0, 1); PG8_SCHED; PG8_LDA(At, 0, 0); PG8_STAGE(PG8_SA(1, 1), a1 + hstep, voffA);
            PG8_WAIT_V(8); PG8_WAIT_L(0); PG8_BAR; PG8_MMA(0, 0, At, B0); PG8_MMA(0, 1, At, B1); PG8_BAR; PG8_SCHED;
            PG8_LDA(At, 0, 1); PG8_STAGE(PG8_SB(0, 0), b2, voffB); PG8_STAGE(PG8_SB(0, 1), b2 + hstep, voffB); PG8_STAGE(PG8_SA(0, 0), a2, voffA);
            PG8_WAIT_V(8); PG8_WAIT_L(0); PG8_BAR; PG8_MMA(1, 0, At, B0); PG8_MMA(1, 1, At, B1); PG8_BAR; PG8_SCHED;
            PG8_LDB(B0, 1, 0); PG8_LDB(B1, 1, 1); PG8_SCHED; PG8_LDA(At, 1, 0); PG8_STAGE(PG8_SA(0, 1), a2 + hstep, voffA);
            PG8_WAIT_V(8); PG8_WAIT_L(0); PG8_BAR; PG8_MMA(0, 0, At, B0); PG8_MMA(0, 1, At, B1); PG8_BAR; PG8_SCHED;
            PG8_LDA(At, 1, 1); PG8_STAGE(PG8_SB(1, 0), b3, voffB); PG8_STAGE(PG8_SB(1, 1), b3 + hstep, voffB); PG8_STAGE(PG8_SA(1, 0), a3, voffA);
            PG8_WAIT_V(8); PG8_WAIT_L(0); PG8_BAR; PG8_MMA(1, 0, At, B0); PG8_MMA(1, 1, At, B1); PG8_BAR; PG8_SCHED;
            } else {
            PG8_LDB(B0, 0, 0); PG8_SCHED; PG8_LDA(At, 0, 0); PG8_STAGE(PG8_SA(1, 1), a1 + hstep, voffA);
            PG8_WAIT_L(8); PG8_BAR; PG8_WAIT_L(0); PG8_MMA(0, 0, At, B0); PG8_BAR; PG8_SCHED;
            PG8_LDB(B1, 0, 1); PG8_STAGE(PG8_SB(0, 0), b2, voffB);
            PG8_BAR; PG8_WAIT_L(0); PG8_MMA(0, 1, At, B1); PG8_BAR;
            PG8_LDA(At, 0, 1); PG8_STAGE(PG8_SA(0, 0), a2, voffA);
            PG8_BAR; PG8_WAIT_L(0); PG8_MMA(1, 0, At, B0); PG8_BAR; PG8_SCHED;
            PG8_STAGE(PG8_SB(0, 1), b2 + hstep, voffB);
            PG8_WAIT_V(6); PG8_BAR; PG8_MMA(1, 1, At, B1); PG8_BAR;
            PG8_LDB(B0, 1, 0); PG8_SCHED; PG8_LDA(At, 1, 0); PG8_STAGE(PG8_SA(0, 1), a2 + hstep, voffA);
            PG8_WAIT_L(8); PG8_BAR; PG8_WAIT_L(0); PG8_MMA(0, 0, At, B0); PG8_BAR; PG8_SCHED;
            PG8_LDB(B1, 1, 1); PG8_STAGE(PG8_SB(1, 0), b3, voffB);
            PG8_BAR; PG8_WAIT_L(0); PG8_MMA(0, 1, At, B1); PG8_BAR;
            PG8_LDA(At, 1, 1); PG8_STAGE(PG8_SA(1, 0), a3, voffA);
            PG8_BAR; PG8_WAIT_L(0); PG8_MMA(1, 0, At, B0); PG8_BAR; PG8_SCHED;
            PG8_STAGE(PG8_SB(1, 1), b3 + hstep, voffB);
            PG8_WAIT_V(6); PG8_BAR; PG8_MMA(1, 1, At, B1); PG8_BAR;
            }
        }
        if constexpr (ALIGN_EPI) { if (wr == 0) PG8_BAR; }
        if constexpr (!Epi::AFTER_DRAIN) { E(acc, cur, wr, wc, fr, fq); S.done(cur); }
        if (!has_next) break;
#pragma unroll
        for (int a = 0; a < 2; ++a)
#pragma unroll
            for (int b = 0; b < 2; ++b)
#pragma unroll
                for (int m = 0; m < 4; ++m)
#pragma unroll
                    for (int n = 0; n < 2; ++n) acc[a][b][m][n] = (f32x4){0.f, 0.f, 0.f, 0.f};
        cur = nxt; cA = nA; cB = nB; ++ui;
        if constexpr (ALIGN_EPI) { if (wr == 1) PG8_BAR; }
    }
    PG8_WAIT_V(0);
    if constexpr (!ALIGN_EPI) { if (wr == 0) PG8_BAR; }
    PG8_BAR;
    if constexpr (Epi::AFTER_DRAIN) { E.fused(acc, cur, wr, wc, fr, fq, lds, wid, lane); S.done(cur); }
#undef PG8_SA
#undef PG8_SB
#undef PG8_STAGE
#undef PG8_LDA
#undef PG8_LDB
#undef PG8_MMA
#undef PG8_WAIT_V
#undef PG8_WAIT_L
#undef PG8_BAR
#undef PG8_SCHED
}
}

#define LAS __attribute__((address_space(3)))
typedef unsigned short bf16;
typedef short bf16x8 __attribute__((ext_vector_type(8)));
typedef float f32x4 __attribute__((ext_vector_type(4)));
typedef float f32x16 __attribute__((ext_vector_type(16)));
typedef unsigned u32x4 __attribute__((ext_vector_type(4)));
typedef unsigned u32x2 __attribute__((ext_vector_type(2)));

constexpr int DM = 1024, NBATCH = 4, SEQ = 4096, MP = NBATCH * SEQ, SBATCH = 128, STOK = 4, MS = SBATCH * STOK, MR = MP + MS;
constexpr int PASTL = 2048, PAGE = 128, NPG = 16;
constexpr int LS = 2112, LSW = 576;
constexpr int NPAD = 5632;
constexpr float C2 = 0.125f * 1.4426950408889634f;
constexpr int NWAVES = 8;

constexpr size_t O_YP = 0, O_YS = 16777216, O_NSAP = 17301504, O_DSAP = 25690112, O_IDXP = 29884416, O_WINP = 30932992,
                 O_NSAS = 31457280, O_DSAS = 31719424, O_IDXS = 31850496, O_WINS = 31883264, O_END = 48660480;

constexpr size_t MiB = 1u << 20;
constexpr size_t WS_CTL = 0, CTL_ZERO_BYTES = 1 * MiB;
constexpr size_t WS_MOD = 1 * MiB;
constexpr size_t WS_COS = 3 * MiB, WS_SIN = 4 * MiB;
constexpr size_t WS_BIAS1 = 5 * MiB;
constexpr size_t WS_BIASP = 5 * MiB + 262144;
constexpr size_t WS_W2T = 5 * MiB + 65536;
constexpr size_t WS_W1T = 6 * MiB;
constexpr size_t WS_WINT = 8 * MiB;
constexpr size_t WS_WUPN = 20 * MiB, WS_WUPD = 21 * MiB, WS_WOUT = 22 * MiB;
constexpr size_t WS_PSLCVK = 975 * MiB, WS_PWINVK = 979 * MiB, WS_PDSAVK = 983 * MiB;
constexpr size_t WS_SELM = 960 * MiB;
constexpr size_t WS_GATES = 25 * MiB;
constexpr size_t WS_IW = 27 * MiB;
constexpr size_t WS_PCK = 28 * MiB, WS_PCVT = 28 * MiB + 262144;
constexpr size_t WS_SCK = 29 * MiB, WS_SCVT = 33 * MiB;
constexpr size_t WS_H = 40 * MiB;
constexpr size_t WS_QRAW = 80 * MiB, WS_QROT = 100 * MiB, WS_DQ = 120 * MiB, WS_IQ = 140 * MiB, WS_ZN = 150 * MiB, WS_ZD = 170 * MiB, WS_ONZ = 190 * MiB, WS_ODZ = 210 * MiB;
constexpr size_t WS_MG = 230 * MiB;
constexpr size_t WS_T1 = 300 * MiB;
constexpr size_t WS_M1 = 370 * MiB;
constexpr size_t WS_PCMPK = 410 * MiB, WS_PCMPV = 414 * MiB, WS_PSLCK = 418 * MiB, WS_PSLCVT = 422 * MiB, WS_PWINK = 426 * MiB, WS_PWINVT = 430 * MiB,
                 WS_PDSAK = 434 * MiB, WS_PDSAVT = 438 * MiB, WS_PIDXK = 442 * MiB;
constexpr size_t WS_SCMPK = 450 * MiB, WS_SCMPV = 520 * MiB, WS_SSLCK = 590 * MiB, WS_SSLCVT = 660 * MiB, WS_SDSAK = 730 * MiB, WS_SDSAVT = 800 * MiB,
                 WS_SWINK = 870 * MiB, WS_SWINVT = 890 * MiB, WS_SIDXK = 910 * MiB, WS_END = 990 * MiB;
constexpr int CW_BAR = 4096;
constexpr int CW_Q = 16384;

constexpr int RING_BYTES = 131072, MISC_OFF = RING_BYTES, STG_OFF = MISC_OFF + 256, LDS_BYTES = STG_OFF + 16384;

struct Args { const void* in[20]; float* out; unsigned char* ws; int ph_lo, ph_hi, qoff, umask, pad0, pad1; };

struct Frame {
    LAS unsigned char* lds; volatile LAS unsigned* MISC; unsigned* ctl;
    int tid, lane, wave, G, qoff;
    unsigned char* ws; float* out;
    const float *xp, *xs, *cnsa, *cdsa, *cidx, *swin; const int* ptab; const float *cp, *cs, *normg, *wada, *bada, *win, *pe, *w1, *w2, *wupn, *wupd, *wout, *fing;
};
#define WSP(T, off) ((T*)(F.ws + (off)))

#define DI __device__ __forceinline__
#define LDS_WAIT() asm volatile("s_waitcnt lgkmcnt(0)" ::: "memory")
DI u32x4 gload16(const void* p) { u32x4 r; asm volatile("global_load_dwordx4 %0, %1, off" : "=v"(r) : "v"(p) : "memory"); return r; }
DI unsigned long long gload8(const void* p) { unsigned long long r; asm volatile("global_load_dwordx2 %0, %1, off" : "=v"(r) : "v"(p) : "memory"); return r; }
#define WAITV2(n, a, b) asm volatile("s_waitcnt vmcnt(" #n ")" : "+v"(a), "+v"(b) :: "memory")
#define WAITV1(n, a) asm volatile("s_waitcnt vmcnt(" #n ")" : "+v"(a) :: "memory")
#define LDS_BARRIER() do { asm volatile("s_waitcnt lgkmcnt(0)" ::: "memory"); __builtin_amdgcn_s_barrier(); asm volatile("" ::: "memory"); } while (0)
DI float wave_sum(float v) {
#define DPP_ADD_(ctrl, rmask) v += __int_as_float(__builtin_amdgcn_update_dpp(0, __float_as_int(v), (ctrl), (rmask), 0xF, false))
    DPP_ADD_(0xB1, 0xF);
    DPP_ADD_(0x4E, 0xF);
    DPP_ADD_(0x141, 0xF);
    DPP_ADD_(0x140, 0xF);
    DPP_ADD_(0x142, 0xA);
    DPP_ADD_(0x143, 0xC);
#undef DPP_ADD_
    return __int_as_float(__builtin_amdgcn_readlane(__float_as_int(v), 63));
}
DI int wave_sum_i(int v) {
#define DPP_ADDI_(ctrl, rmask) v += __builtin_amdgcn_update_dpp(0, v, (ctrl), (rmask), 0xF, false)
    DPP_ADDI_(0xB1, 0xF); DPP_ADDI_(0x4E, 0xF); DPP_ADDI_(0x141, 0xF); DPP_ADDI_(0x140, 0xF); DPP_ADDI_(0x142, 0xA); DPP_ADDI_(0x143, 0xC);
#undef DPP_ADDI_
    return __builtin_amdgcn_readlane(v, 63);
}
DI int wave_min_i(int v) {
#define DPP_MIN_(ctrl, rmask) { const int t_ = __builtin_amdgcn_update_dpp(v, v, (ctrl), (rmask), 0xF, false); v = t_ < v ? t_ : v; }
    DPP_MIN_(0xB1, 0xF) DPP_MIN_(0x4E, 0xF) DPP_MIN_(0x141, 0xF) DPP_MIN_(0x140, 0xF) DPP_MIN_(0x142, 0xA) DPP_MIN_(0x143, 0xC)
#undef DPP_MIN_
    return __builtin_amdgcn_readlane(v, 63);
}
DI int wave_max_i(int v) {
#define DPP_MAX_(ctrl, rmask) { const int t_ = __builtin_amdgcn_update_dpp(v, v, (ctrl), (rmask), 0xF, false); v = t_ > v ? t_ : v; }
    DPP_MAX_(0xB1, 0xF) DPP_MAX_(0x4E, 0xF) DPP_MAX_(0x141, 0xF) DPP_MAX_(0x140, 0xF) DPP_MAX_(0x142, 0xA) DPP_MAX_(0x143, 0xC)
#undef DPP_MAX_
    return __builtin_amdgcn_readlane(v, 63);
}
DI unsigned pk2(float lo, float hi) { return pg8::cvt_pk_bf16(lo, hi); }
DI float bflo(unsigned w) { return __uint_as_float(w << 16); }
DI float bfhi(unsigned w) { return __uint_as_float(w & 0xffff0000u); }
DI float bf2f(bf16 h) { return __uint_as_float((unsigned)h << 16); }
DI float sigm_f(float x) { return __builtin_amdgcn_rcpf(1.f + __builtin_amdgcn_exp2f(-1.4426950408889634f * x)); }
DI float silu_f(float x) { return x * sigm_f(x); }
DI int pos16(int o) { return 8 * ((o >> 2) & 1) + (o & 3) + 4 * (o >> 3); }
DI int permk(int t) { return (t & ~15) | pos16(t & 15); }
DI int crow(int r, int hi) { return (r & 3) + 8 * (r >> 2) + 4 * hi; }
DI float dpp_x1(float v) { return __int_as_float(__builtin_amdgcn_update_dpp(0, __float_as_int(v), 0xB1, 0xF, 0xF, true)); }
DI float dpp_x2(float v) { return __int_as_float(__builtin_amdgcn_update_dpp(0, __float_as_int(v), 0x4E, 0xF, 0xF, true)); }
DI float half_other(float v) {
    const unsigned u = __float_as_uint(v);
    auto rr = __builtin_amdgcn_permlane32_swap(u, u, false, false);
    return __uint_as_float(((threadIdx.x & 32) != 0) ? rr[0] : rr[1]);
}
DI u32x4 pack8(const float* v) { u32x4 w; w.x = pk2(v[0], v[1]); w.y = pk2(v[2], v[3]); w.z = pk2(v[4], v[5]); w.w = pk2(v[6], v[7]); return w; }
DI void st_bf8(bf16* p, const float* v) { *(u32x4*)p = pack8(v); }
DI void st_f8(float* p, const float* v) { __builtin_nontemporal_store((f32x4){v[0], v[1], v[2], v[3]}, (f32x4*)p); __builtin_nontemporal_store((f32x4){v[4], v[5], v[6], v[7]}, (f32x4*)(p + 4)); }
DI void st_vt8(bf16* p, size_t pitch, const float* v) {
#pragma unroll
    for (int j = 0; j < 8; ++j) p[(size_t)j * pitch] = (bf16)(pk2(v[j], 0.f) & 0xffffu);
}
#define PIN4(q) asm volatile("" : "+v"(q[0]), "+v"(q[1]), "+v"(q[2]), "+v"(q[3]))
#define NEGINF (-__builtin_inff())
#define MFMA32(a, b, c) __builtin_amdgcn_mfma_f32_32x32x16_bf16((a), (b), (c), 0, 0, 0)

DI int idx_key(float dot, float w) {
#pragma clang fp contract(off)
    float v = fmaxf(dot, 0.f) * w;
    v = v + dpp_x1(v);
    v = v + dpp_x2(v);
    int u = __float_as_int(v);
    u = (u == (int)0x80000000) ? 0 : u;
    return u ^ ((u >> 31) & 0x7fffffff);
}

template <int MODE> struct EpiInProjT {
    static constexpr bool PERM = true, AFTER_DRAIN = false;
    unsigned char* ws; float* out;
    DI void rope8(float* lo, float* hi, const float* c, const float* s) const {
#pragma unroll
        for (int j = 0; j < 8; ++j) { const float a = lo[j], b = hi[j]; lo[j] = a * c[j] - b * s[j]; hi[j] = b * c[j] + a * s[j]; }
    }
    DI void ldtab(float* c, float* s, int pos, int d0) const {
        const f32x4* cp = (const f32x4*)((const float*)(ws + WS_COS) + pos * 32 + d0);
        const f32x4* sp = (const f32x4*)((const float*)(ws + WS_SIN) + pos * 32 + d0);
        const f32x4 c0 = cp[0], c1 = cp[1], s0 = sp[0], s1 = sp[1];
        c[0] = c0[0]; c[1] = c0[1]; c[2] = c0[2]; c[3] = c0[3]; c[4] = c1[0]; c[5] = c1[1]; c[6] = c1[2]; c[7] = c1[3];
        s[0] = s0[0]; s[1] = s0[1]; s[2] = s0[2]; s[3] = s0[3]; s[4] = s1[0]; s[5] = s1[1]; s[6] = s1[2]; s[7] = s1[3];
        asm volatile("" : "+v"(c[0]), "+v"(c[1]), "+v"(c[2]), "+v"(c[3]), "+v"(c[4]), "+v"(c[5]), "+v"(c[6]), "+v"(c[7]));
        asm volatile("" : "+v"(s[0]), "+v"(s[1]), "+v"(s[2]), "+v"(s[3]), "+v"(s[4]), "+v"(s[5]), "+v"(s[6]), "+v"(s[7]));
    }
    DI void operator()(const pg8::f32x4 (&acc)[2][2][4][2], const pg8::Unit& u, int wr, int wc, int fr, int fq) const {
        const int hs = u.pn * 4 + wc;
        if (hs >= 86) return;
        if ((MODE & 2) && hs >= 20 && hs != 44 && !(hs >= 36 && hs < 40)) return;
        if ((MODE & 4) && hs < 20) return;
        const bool samp = u.pm >= 64;
        const int d0 = 8 * fq;
        const bool roped = hs < 8 || (hs >= 12 && hs < 14) || (hs >= 16 && hs < 18) || (hs >= 28 && hs < 36) || hs == 36 || hs == 37 || (hs >= 40 && hs <= 44);
        float rc[8], rs[8], dc[8], ds[8];
        if (roped) { if (samp) {
#pragma unroll
                for (int j = 0; j < 8; ++j) { dc[j] = 1.f; ds[j] = 0.f; }
            } else ldtab(dc, ds, 16, d0); }
#pragma unroll
        for (int ai = 0; ai < 2; ++ai)
#pragma unroll
            for (int m = 0; m < 4; ++m) {
                const int r = u.pm * 256 + ai * 128 + wr * 64 + m * 16 + fr;
                if (roped) {
                    if (m == 0) ldtab(rc, rs, samp ? PASTL + (r & 3) : (r & 4095), d0);
                    else {
#pragma unroll
                        for (int j = 0; j < 8; ++j) { const float a = rc[j], b = rs[j]; rc[j] = a * dc[j] - b * ds[j]; rs[j] = b * dc[j] + a * ds[j]; }
                    }
                }
                int b, t, pos;
                if (!samp) { b = r >> 12; t = r & 4095; pos = t; } else { b = (r - MP) >> 2; t = r & 3; pos = PASTL + t; }
                float lo[8], hi[8];
#pragma unroll
                for (int n = 0; n < 2; ++n)
#pragma unroll
                    for (int j = 0; j < 4; ++j) { lo[4 * n + j] = acc[ai][0][m][n][j]; hi[4 * n + j] = acc[ai][1][m][n][j]; }
                if (hs < 8) {
                    bf16* qa = (bf16*)(ws + WS_QRAW) + (size_t)r * 512 + hs * 64 + d0;
                    bf16* qb = (bf16*)(ws + WS_QROT) + (size_t)r * 512 + hs * 64 + d0;
                    float a[8], c[8];
#pragma unroll
                    for (int j = 0; j < 8; ++j) { a[j] = lo[j] * C2; c[j] = hi[j] * C2; }
                    st_bf8(qa, a); st_bf8(qa + 32, c);
                    rope8(lo, hi, rc, rs);
#pragma unroll
                    for (int j = 0; j < 8; ++j) { a[j] = lo[j] * C2; c[j] = hi[j] * C2; }
                    st_bf8(qb, a); st_bf8(qb + 32, c);
                } else if (hs < 20) {
                    const int ty = (hs - 8) >> 1, g = (hs - 8) & 1;
                    if (ty == 2 || ty == 4) rope8(lo, hi, rc, rs);
                    const int bg = b * 2 + g;
                    if (ty < 4) {
                        float* o = out + (samp ? O_NSAS + ((size_t)(r - MP) * 8 + ty * 2 + g) * 64 : O_NSAP + ((size_t)r * 8 + ty * 2 + g) * 64) + d0;
                        st_f8(o, lo); st_f8(o + 32, hi);
                    } else {
                        const int sl = ty - 4;
                        if (samp) { float* o = out + O_WINS + (((size_t)b * 512 + 508 + t) * 4 + sl * 2 + g) * 64 + d0; st_f8(o, lo); st_f8(o + 32, hi); }
                        else if (t >= SEQ - 512) { float* o = out + O_WINP + (((size_t)b * 512 + (t - (SEQ - 512))) * 4 + sl * 2 + g) * 64 + d0; st_f8(o, lo); st_f8(o + 32, hi); }
                    }
                    if (ty == 3 || ty == 5) {
                        size_t pitch; int kp; bf16* base;
                        if (!samp) { pitch = SEQ; kp = t; base = (bf16*)(ws + (ty == 3 ? WS_PSLCVT : WS_PWINVT)); }
                        else if (ty == 3) { pitch = LS; kp = PASTL + t; base = (bf16*)(ws + WS_SSLCVT); }
                        else { pitch = LSW; kp = 512 + t; base = (bf16*)(ws + WS_SWINVT); }
                        bf16* p = base + ((size_t)bg * 64 + d0) * pitch + permk(kp);
                        if (!(MODE & 1)) { st_vt8(p, pitch, lo); st_vt8(p + 32 * pitch, pitch, hi); }
                    } else {
                        size_t rowi; bf16* base;
                        if (!samp) { rowi = (size_t)bg * SEQ + t; base = (bf16*)(ws + (ty == 0 ? WS_PCMPK : ty == 1 ? WS_PCMPV : ty == 2 ? WS_PSLCK : WS_PWINK)); }
                        else if (ty == 4) { rowi = (size_t)bg * LSW + 512 + t; base = (bf16*)(ws + WS_SWINK); }
                        else { rowi = (size_t)bg * LS + PASTL + t; base = (bf16*)(ws + (ty == 0 ? WS_SCMPK : ty == 1 ? WS_SCMPV : WS_SSLCK)); }
                        bf16* p = base + rowi * 64 + d0;
                        st_bf8(p, lo); st_bf8(p + 32, hi);
                    }
                } else if (hs < 28 || (hs >= 45 && hs < 53)) {
                    const int h = hs < 28 ? hs - 20 : hs - 45;
                    bf16* p = (bf16*)(ws + (hs < 28 ? WS_ZN : WS_ZD)) + (size_t)r * 512 + h * 64 + d0;
#pragma unroll
                    for (int j = 0; j < 8; ++j) { lo[j] = silu_f(lo[j]); hi[j] = silu_f(hi[j]); }
                    st_bf8(p, lo); st_bf8(p + 32, hi);
                } else if (hs < 36) {
                    rope8(lo, hi, rc, rs);
#pragma unroll
                    for (int j = 0; j < 8; ++j) { lo[j] *= C2; hi[j] *= C2; }
                    bf16* p = (bf16*)(ws + WS_DQ) + (size_t)r * 512 + (hs - 28) * 64 + d0;
                    st_bf8(p, lo); st_bf8(p + 32, hi);
                } else if (hs < 40) {
                    const int sl = (hs - 36) >> 1, g = (hs - 36) & 1, bg = b * 2 + g;
                    if (sl == 0) rope8(lo, hi, rc, rs);
                    float* o = out + (samp ? O_DSAS + ((size_t)(r - MP) * 4 + sl * 2 + g) * 64 : O_DSAP + ((size_t)r * 4 + sl * 2 + g) * 64) + d0;
                    st_f8(o, lo); st_f8(o + 32, hi);
                    if (sl == 0) {
                        bf16* p = samp ? (bf16*)(ws + WS_SDSAK) + ((size_t)bg * LS + PASTL + t) * 64 + d0 : (bf16*)(ws + WS_PDSAK) + ((size_t)bg * SEQ + t) * 64 + d0;
                        st_bf8(p, lo); st_bf8(p + 32, hi);
                    } else {
                        const size_t pitch = samp ? LS : SEQ; const int kp = samp ? PASTL + t : t;
                        bf16* p = (bf16*)(ws + (samp ? WS_SDSAVT : WS_PDSAVT)) + ((size_t)bg * 64 + d0) * pitch + permk(kp);
                        if (!(MODE & 1)) { st_vt8(p, pitch, lo); st_vt8(p + 32 * pitch, pitch, hi); }
                    }
                } else if (hs < 44) {
                    rope8(lo, hi, rc, rs);
                    bf16* p = (bf16*)(ws + WS_IQ) + (size_t)r * 256 + (hs - 40) * 64 + d0;
                    st_bf8(p, lo); st_bf8(p + 32, hi);
                } else if (hs == 44) {
                    rope8(lo, hi, rc, rs);
                    float* o = out + (samp ? O_IDXS + (size_t)(r - MP) * 64 : O_IDXP + (size_t)r * 64) + d0;
                    st_f8(o, lo); st_f8(o + 32, hi);
                    bf16* p = samp ? (bf16*)(ws + WS_SIDXK) + ((size_t)b * LS + PASTL + t) * 64 + d0 : (bf16*)(ws + WS_PIDXK) + (size_t)r * 64 + d0;
                    st_bf8(p, lo); st_bf8(p + 32, hi);
                } else if (hs < 85) {
                    bf16* p = (bf16*)(ws + WS_MG) + (size_t)r * 2048 + (hs - 53) * 64 + d0;
#pragma unroll
                    for (int j = 0; j < 8; ++j) { lo[j] = sigm_f(lo[j]); hi[j] = sigm_f(hi[j]); }
                    st_bf8(p, lo); st_bf8(p + 32, hi);
                } else {
                    if (fq < 3) { float* p = (float*)(ws + WS_GATES) + (size_t)r * 24 + d0;
#pragma unroll
                        for (int j = 0; j < 8; ++j) lo[j] = sigm_f(lo[j]);
                        st_f8(p, lo);
                    } else { *(f32x4*)((float*)(ws + WS_IW) + (size_t)r * 4) = (f32x4){lo[0], lo[1], lo[2], lo[3]}; }
                }
            }
    }
};
typedef EpiInProjT<0> EpiInProj;
struct ColOrder {
    int nM, nN, cnt, rank, pn;
    __device__ void init(int M, int N, int G, int c) { nM = M / 256; nN = N / 256; pn = c % nN; rank = c / nN; cnt = G / nN + ((pn < G % nN) ? 1 : 0); }
    __device__ bool next(int i, pg8::Unit& u) const { const int pm = rank + i * cnt; if (pm >= nM) return false; u.pm = pm; u.pn = pn; return true; }
    __device__ __forceinline__ void a_ready(const pg8::Unit&) const {}
    __device__ __forceinline__ void done(const pg8::Unit&) const {}
};
struct EpiNull {
    static constexpr bool PERM = true, AFTER_DRAIN = false;
    unsigned char* ws;
    DI void operator()(const pg8::f32x4 (&acc)[2][2][4][2], const pg8::Unit& u, int wr, int wc, int fr, int fq) const {
        float s = 0.f;
#pragma unroll
        for (int ai = 0; ai < 2; ++ai)
#pragma unroll
            for (int bj = 0; bj < 2; ++bj)
#pragma unroll
                for (int m = 0; m < 4; ++m)
#pragma unroll
                    for (int n = 0; n < 2; ++n) s += acc[ai][bj][m][n][0] + acc[ai][bj][m][n][1] + acc[ai][bj][m][n][2] + acc[ai][bj][m][n][3];
        if (s == 1.2345e33f) *(float*)(ws + WS_CTL + 2048) = s;
    }
};
struct EpiUp1 {
    static constexpr bool PERM = true, AFTER_DRAIN = false;
    unsigned char* ws;
    DI void operator()(const pg8::f32x4 (&acc)[2][2][4][2], const pg8::Unit& u, int wr, int wc, int fr, int fq) const {
#pragma unroll
        for (int ai = 0; ai < 2; ++ai)
#pragma unroll
            for (int m = 0; m < 4; ++m) {
                const int r = u.pm * 256 + ai * 128 + wr * 64 + m * 16 + fr;
#pragma unroll
                for (int bj = 0; bj < 2; ++bj) {
                    const int c0 = u.pn * 256 + bj * 128 + wc * 32 + 8 * fq;
                    const u32x4 gw = *(const u32x4*)((const bf16*)(ws + WS_MG) + (size_t)r * 2048 + c0);
                    const f32x4 a0 = acc[ai][bj][m][0], a1 = acc[ai][bj][m][1];
                    u32x4 w; w.x = pk2(a0[0] * bflo(gw.x), a0[1] * bfhi(gw.x)); w.y = pk2(a0[2] * bflo(gw.y), a0[3] * bfhi(gw.y));
                    w.z = pk2(a1[0] * bflo(gw.z), a1[1] * bfhi(gw.z)); w.w = pk2(a1[2] * bflo(gw.w), a1[3] * bfhi(gw.w));
                    *(u32x4*)((bf16*)(ws + WS_T1) + (size_t)r * 1024 + c0) = w;
                }
            }
    }
};
struct EpiUp2 {
    static constexpr bool PERM = true, AFTER_DRAIN = false;
    unsigned char* ws;
    DI void operator()(const pg8::f32x4 (&acc)[2][2][4][2], const pg8::Unit& u, int wr, int wc, int fr, int fq) const {
#pragma unroll
        for (int ai = 0; ai < 2; ++ai)
#pragma unroll
            for (int m = 0; m < 4; ++m) {
                const int r = u.pm * 256 + ai * 128 + wr * 64 + m * 16 + fr;
#pragma unroll
                for (int bj = 0; bj < 2; ++bj) {
                    const int c0 = u.pn * 256 + bj * 128 + wc * 32 + 8 * fq;
                    const u32x4 gw = *(const u32x4*)((const bf16*)(ws + WS_MG) + (size_t)r * 2048 + 1024 + c0);
                    const u32x4 tw = *(const u32x4*)((const bf16*)(ws + WS_T1) + (size_t)r * 1024 + c0);
                    const f32x4 t0 = {bflo(tw.x), bfhi(tw.x), bflo(tw.y), bfhi(tw.y)}, t1 = {bflo(tw.z), bfhi(tw.z), bflo(tw.w), bfhi(tw.w)};
                    const f32x4 a0 = acc[ai][bj][m][0], a1 = acc[ai][bj][m][1];
                    u32x4 w;
                    w.x = pk2(t0[0] + a0[0] * bflo(gw.x), t0[1] + a0[1] * bfhi(gw.x)); w.y = pk2(t0[2] + a0[2] * bflo(gw.y), t0[3] + a0[3] * bfhi(gw.y));
                    w.z = pk2(t1[0] + a1[0] * bflo(gw.z), t1[1] + a1[1] * bfhi(gw.z)); w.w = pk2(t1[2] + a1[2] * bflo(gw.w), t1[3] + a1[3] * bfhi(gw.w));
                    *(u32x4*)((bf16*)(ws + WS_M1) + (size_t)r * 1024 + c0) = w;
                }
            }
    }
};
struct EpiOut {
    static constexpr bool PERM = true, AFTER_DRAIN = false;
    unsigned char* ws; float* out; const float* xp; const float* xs;
    DI void operator()(const pg8::f32x4 (&acc)[2][2][4][2], const pg8::Unit& u, int wr, int wc, int fr, int fq) const {
        const bool samp = u.pm >= 64;
#pragma unroll
        for (int ai = 0; ai < 2; ++ai)
#pragma unroll
            for (int m = 0; m < 4; ++m) {
                const int r = u.pm * 256 + ai * 128 + wr * 64 + m * 16 + fr;
                const int mrow = samp ? 4 + ((r - MP) >> 2) : (r >> 12);
                const float* xr = samp ? xs + (size_t)(r - MP) * 1024 : xp + (size_t)r * 1024;
                float* orow = samp ? out + O_YS + (size_t)(r - MP) * 1024 : out + O_YP + (size_t)r * 1024;
                const float* gr = (const float*)(ws + WS_MOD) + (size_t)mrow * 3072 + 2048;
#pragma unroll
                for (int bj = 0; bj < 2; ++bj) {
                    const int c0 = u.pn * 256 + bj * 128 + wc * 32 + 8 * fq;
#pragma unroll
                    for (int n = 0; n < 2; ++n) {
                        const f32x4 x4 = *(const f32x4*)(xr + c0 + 4 * n), g4 = *(const f32x4*)(gr + c0 + 4 * n);
                        *(f32x4*)(orow + c0 + 4 * n) = x4 + g4 * acc[ai][bj][m][n];
                    }
                }
            }
    }
};

DI int win_row(int col) {
    int hs, d;
    if (col < 1280) { hs = col >> 6; d = col & 63; }
    else if (col < 1304) { hs = 85; d = col - 1280; }
    else if (col < 2904) { const int c = col - 1304; hs = 20 + (c >> 6); d = c & 63; }
    else if (col < 2908) { hs = 85; d = 24 + (col - 2904); }
    else { const int c = col - 2908; hs = 45 + (c >> 6); d = c & 63; }
    return 256 * (hs >> 2) + 128 * (d >> 5) + 32 * (hs & 3) + (d & 31);
}
template <bool WINMAP> DI void p0_transpose_item(const float* W, int K, int N, bf16* WT, LAS float* scr, int item, int lane) {
    const int nblk = (N + 31) / 32, kb = item / nblk, nb = item % nblk, k0 = 64 * kb, n0 = 32 * nb;
    const bool nok = n0 + (lane & 31) < N;
    float tv[32];
#pragma unroll
    for (int i = 0; i < 32; ++i) { const int kk = 2 * i + (lane >> 5); tv[i] = nok ? W[(size_t)(k0 + kk) * N + n0 + (lane & 31)] : 0.f; }
#pragma unroll
    for (int i = 0; i < 32; ++i) { const int kk = 2 * i + (lane >> 5); scr[kk * 33 + (lane & 31)] = tv[i]; }
    LDS_WAIT();
    const int c = lane & 7;
#pragma unroll
    for (int j = 0; j < 4; ++j) { const int n = (lane >> 3) + 8 * j; const LAS float* s = scr + (8 * c) * 33 + n;
        u32x4 o; o.x = pk2(s[0 * 33], s[1 * 33]); o.y = pk2(s[2 * 33], s[3 * 33]); o.z = pk2(s[4 * 33], s[5 * 33]); o.w = pk2(s[6 * 33], s[7 * 33]);
        if (n0 + n < N) { const int row = WINMAP ? win_row(n0 + n) : (n0 + n); *(u32x4*)(WT + (size_t)row * K + k0 + 8 * c) = o; } }
    LDS_WAIT();
}
DI void p0_mod(Frame& F) {
    LAS float* wl = (LAS float*)F.lds;
    float* mod = WSP(float, WS_MOD);
    for (int cg = blockIdx.x; cg < 256; cg += F.G) {
        __syncthreads();
        for (int k = F.tid; k < 1024; k += NWAVES * 64) {
            const f32x4* src = (const f32x4*)(F.wada + (size_t)k * 3072 + cg * 12);
            LAS f32x4* dst = (LAS f32x4*)(wl + k * 12);
            dst[0] = src[0]; dst[1] = src[1]; dst[2] = src[2];
        }
        __syncthreads();
        float cv[16], cn[16];
        { const float* cr = F.wave < 4 ? F.cp + (size_t)F.wave * 1024 : F.cs + (size_t)(F.wave - 4) * 1024;
#pragma unroll
          for (int i = 0; i < 16; ++i) cn[i] = cr[F.lane + 64 * i]; }
        for (int r = F.wave; r < 132; r += NWAVES) {
#pragma unroll
            for (int i = 0; i < 16; ++i) cv[i] = cn[i];
            { const int rn = r + NWAVES < 132 ? r + NWAVES : r; const float* cr = rn < 4 ? F.cp + (size_t)rn * 1024 : F.cs + (size_t)(rn - 4) * 1024;
#pragma unroll
              for (int i = 0; i < 16; ++i) cn[i] = cr[F.lane + 64 * i]; }
            float a[12];
#pragma unroll
            for (int j = 0; j < 12; ++j) a[j] = 0.f;
#pragma unroll
            for (int i = 0; i < 16; ++i) {
                const int k = F.lane + 64 * i; const float s = silu_f(cv[i]);
                const LAS f32x4* wp = (const LAS f32x4*)(wl + k * 12);
                const f32x4 w0 = wp[0], w1 = wp[1], w2 = wp[2];
                a[0] += s * w0[0]; a[1] += s * w0[1]; a[2] += s * w0[2]; a[3] += s * w0[3];
                a[4] += s * w1[0]; a[5] += s * w1[1]; a[6] += s * w1[2]; a[7] += s * w1[3];
                a[8] += s * w2[0]; a[9] += s * w2[1]; a[10] += s * w2[2]; a[11] += s * w2[3];
                if ((i & 3) == 3) __builtin_amdgcn_sched_barrier(0);
            }
            float v = 0.f;
#pragma unroll
            for (int j = 0; j < 12; ++j) { const float sj = wave_sum(a[j]); v = (F.lane == j) ? sj : v; }
            if (F.lane < 12) mod[(size_t)r * 3072 + cg * 12 + F.lane] = v + F.bada[cg * 12 + F.lane];
        }
    }
    __syncthreads();
}
__device__ const double ROPE_INV[32] = {
    1.0, 0.7498942093324559, 0.5623413251903491, 0.4216965034285822, 0.31622776601683794, 0.23713737056616552, 0.1778279410038923, 0.1333521432163324,
    0.1, 0.07498942093324559, 0.05623413251903491, 0.04216965034285822, 0.03162277660168379, 0.023713737056616554, 0.01778279410038923, 0.01333521432163324,
    0.01, 0.007498942093324559, 0.005623413251903491, 0.004216965034285822, 0.0031622776601683794, 0.0023713737056616554, 0.0017782794100389228, 0.001333521432163324,
    0.001, 0.0007498942093324559, 0.0005623413251903491, 0.0004216965034285822, 0.00031622776601683794, 0.00023713737056616554, 0.00017782794100389227, 0.0001333521432163324};
DI void p0_rope_item(Frame& F, int item) {
    const int pos = 2 * item + (F.lane >> 5), d = F.lane & 31;
    if (pos >= 4100) return;
    const double ang = (double)pos * ROPE_INV[d];
    const double kq = __builtin_rint(ang * 0.6366197723675814);
    double r = __builtin_fma(-kq, 1.5707963267948966, ang); r = __builtin_fma(-kq, 6.123233995736766e-17, r);
    const int q = (int)kq & 3;
    const double r2 = r * r;
    const double sn = r * (1.0 + r2 * (-1.0 / 6 + r2 * (1.0 / 120 + r2 * (-1.0 / 5040 + r2 * (1.0 / 362880 + r2 * (-1.0 / 39916800 + r2 * (1.0 / 6227020800.0)))))));
    const double cs = 1.0 + r2 * (-0.5 + r2 * (1.0 / 24 + r2 * (-1.0 / 720 + r2 * (1.0 / 40320 + r2 * (-1.0 / 3628800 + r2 * (1.0 / 479001600.0 + r2 * (-1.0 / 87178291200.0)))))));
    const double c = (q == 0) ? cs : (q == 1) ? -sn : (q == 2) ? -cs : sn;
    const double s = (q == 0) ? sn : (q == 1) ? cs : (q == 2) ? -sn : -cs;
    WSP(float, WS_COS)[pos * 32 + d] = (float)c; WSP(float, WS_SIN)[pos * 32 + d] = (float)s;
}
DI void p0_cmp_small_item(Frame& F, int item) {
    if (item < 256) {
        const int slot = item >> 7, ch = (item >> 6) & 1, kc = item & 63, c = ch * 64 + F.lane; float a = 0.f;
#pragma unroll 8
        for (int i = 0; i < 32; ++i) { const int k = kc * 32 + i; a += F.pe[slot * 2048 + k] * F.w1[((size_t)slot * 2048 + k) * 128 + c]; }
        WSP(float, WS_BIASP)[(size_t)kc * 256 + slot * 128 + c] = a;
    } else {
        const int it = item - 256, slot = it >> 7, e = (it & 127) >> 1, ch = it & 1;
        const int c = ch * 64 + F.lane;
        WSP(bf16, WS_W2T)[((size_t)slot * 64 + e) * 128 + permk(c)] = (bf16)(pk2(F.w2[((size_t)slot * 128 + c) * 64 + e], 0.f) & 0xffffu);
    }
}
DI void cp_k16(const float* src, size_t rs, bf16* dst, int lane) {
    const int tk = lane >> 2, dc = (lane & 3) * 16;
    const f32x4* s = (const f32x4*)(src + (size_t)tk * rs + dc);
    const f32x4 a = s[0], b = s[1], c = s[2], d = s[3];
    u32x4 w0, w1; w0.x = pk2(a[0], a[1]); w0.y = pk2(a[2], a[3]); w0.z = pk2(b[0], b[1]); w0.w = pk2(b[2], b[3]);
    w1.x = pk2(c[0], c[1]); w1.y = pk2(c[2], c[3]); w1.z = pk2(d[0], d[1]); w1.w = pk2(d[2], d[3]);
    u32x4* o = (u32x4*)(dst + (size_t)tk * 64 + dc); o[0] = w0; o[1] = w1;
}
DI void cp_vt16(const float* src, size_t rs, bf16* dst, size_t pitch, int lane) {
#pragma unroll
    for (int h = 0; h < 2; ++h) {
        float v[8];
#pragma unroll
        for (int i = 0; i < 8; ++i) v[i] = src[(size_t)((i & 3) + 8 * (i >> 2) + 4 * h) * rs + lane];
        *(u32x4*)(dst + (size_t)lane * pitch + 8 * h) = pack8(v);
    }
}
DI void p0_gather_item(Frame& F, int item) {
    const int sb = item >> 7, tg = item & 127, tk0 = tg * 16, lane = F.lane;
    const int pg = F.ptab[sb * NPG + (tk0 >> 7)], j0 = tk0 & 127;
    const float* nsa = F.cnsa + ((size_t)pg * PAGE + j0) * 512;
    const float* dsa = F.cdsa + ((size_t)pg * PAGE + j0) * 256;
    const float* idx = F.cidx + ((size_t)pg * PAGE + j0) * 64;
#pragma unroll
    for (int g = 0; g < 2; ++g) {
        const size_t bg = (size_t)sb * 2 + g;
        cp_k16(nsa + (0 * 2 + g) * 64, 512, WSP(bf16, WS_SCMPK) + (bg * LS + tk0) * 64, lane);
        cp_k16(nsa + (1 * 2 + g) * 64, 512, WSP(bf16, WS_SCMPV) + (bg * LS + tk0) * 64, lane);
        cp_k16(nsa + (2 * 2 + g) * 64, 512, WSP(bf16, WS_SSLCK) + (bg * LS + tk0) * 64, lane);
        cp_vt16(nsa + (3 * 2 + g) * 64, 512, WSP(bf16, WS_SSLCVT) + bg * 64 * LS + tk0, LS, lane);
        cp_k16(dsa + (0 * 2 + g) * 64, 256, WSP(bf16, WS_SDSAK) + (bg * LS + tk0) * 64, lane);
        cp_vt16(dsa + (1 * 2 + g) * 64, 256, WSP(bf16, WS_SDSAVT) + bg * 64 * LS + tk0, LS, lane);
    }
    cp_k16(idx, 64, WSP(bf16, WS_SIDXK) + ((size_t)sb * LS + tk0) * 64, lane);
}
DI void p0_win_item(Frame& F, int item) {
    const int sb = item >> 5, w0 = (item & 31) * 16, lane = F.lane;
    const float* st = F.swin + ((size_t)sb * 512 + w0) * 256;
#pragma unroll
    for (int g = 0; g < 2; ++g) {
        const size_t bg = (size_t)sb * 2 + g;
        cp_k16(st + (0 * 2 + g) * 64, 256, WSP(bf16, WS_SWINK) + (bg * LSW + w0) * 64, lane);
        cp_vt16(st + (1 * 2 + g) * 64, 256, WSP(bf16, WS_SWINVT) + bg * 64 * LSW + w0, LSW, lane);
    }
}
DI void p0_zero_item(Frame& F, int item) {
    const int arr = item >> 8, bg = item & 255, lane = F.lane;
    bf16* p; int n;
    if (arr == 0) { p = WSP(bf16, WS_SSLCVT) + ((size_t)bg * 64 + lane) * LS + 2052; n = 60; }
    else if (arr == 1) { p = WSP(bf16, WS_SDSAVT) + ((size_t)bg * 64 + lane) * LS + 2052; n = 60; }
    else { p = WSP(bf16, WS_SWINVT) + ((size_t)bg * 64 + lane) * LSW + 516; n = 60; }
    unsigned long long* q = (unsigned long long*)p;
    for (int i = 0; i < n / 4; ++i) q[i] = 0ull;
}
DI void p0_prologue(Frame& F, int um) {
    if (um & 1) p0_mod(F);
    LAS float* scr = (LAS float*)(F.lds + F.wave * 16384);
    const int gw = blockIdx.x * NWAVES + F.wave, NGW = F.G * NWAVES;
    constexpr int I_WIN = 16 * 171, I_UP = 8 * 32, I_OUT = 16 * 32, I_W1 = 32 * 4;
    constexpr int T0 = I_WIN, T1 = T0 + I_UP, T2 = T1 + I_UP, T3 = T2 + I_OUT, T4 = T3 + 2 * I_W1, T5 = T4 + 2050, T6 = T5 + 512, T7 = T6 + 768, T8 = T7 + SBATCH * 32, T9 = T8 + SBATCH * 128;
#ifdef ORACLE
    constexpr int TEND = T9;
#else
    constexpr int TEND = T7;
#endif
    if (um & 2) for (int it = gw; it < TEND; it += NGW) {
        if (it < T0) p0_transpose_item<true>(F.win, 1024, 5468, WSP(bf16, WS_WINT), scr, it, F.lane);
        else if (it < T1) p0_transpose_item<false>(F.wupn, 512, 1024, WSP(bf16, WS_WUPN), scr, it - T0, F.lane);
        else if (it < T2) p0_transpose_item<false>(F.wupd, 512, 1024, WSP(bf16, WS_WUPD), scr, it - T1, F.lane);
        else if (it < T3) p0_transpose_item<false>(F.wout, 1024, 1024, WSP(bf16, WS_WOUT), scr, it - T2, F.lane);
        else if (it < T4) { const int q = it - T3, slot = q / I_W1; p0_transpose_item<false>(F.w1 + (size_t)slot * 2048 * 128, 2048, 128, WSP(bf16, WS_W1T) + (size_t)slot * 128 * 2048, scr, q % I_W1, F.lane); }
        else if (it < T5) p0_rope_item(F, it - T4);
        else if (it < T6) p0_cmp_small_item(F, it - T5);
        else if (it < T7) p0_zero_item(F, it - T6);
#ifdef ORACLE
        else if (it < T8) p0_win_item(F, it - T7);
        else p0_gather_item(F, it - T8);
#endif
    }
    constexpr int ROW4 = 508 * 64;
    const f32x4* src = (const f32x4*)F.swin; f32x4* dst = (f32x4*)(F.out + O_WINS);
    if (um & 4) for (int it = blockIdx.x; it < 2 * SBATCH; it += F.G) {
        const int sb = it >> 1, h0 = (it & 1) * (ROW4 / 2);
        const f32x4* sp = src + (size_t)sb * 512 * 64 + 4 * 64 + h0; f32x4* dp = dst + (size_t)sb * 512 * 64 + h0;
        for (int i = F.tid; i < ROW4 / 2; i += 512 * 8) {
            f32x4 v[8];
#pragma unroll
            for (int j = 0; j < 8; ++j) { const int k = i + j * 512; v[j] = k < ROW4 / 2 ? __builtin_nontemporal_load(sp + k) : (f32x4){0.f, 0.f, 0.f, 0.f}; }
#pragma unroll
            for (int j = 0; j < 8; ++j) { const int k = i + j * 512; if (k < ROW4 / 2) __builtin_nontemporal_store(v[j], dp + k); }
        }
    }
}
DI void p1_adaln(Frame& F) {
    const int gw = blockIdx.x * NWAVES + F.wave, NGW = F.G * NWAVES;
    if (blockIdx.x == 0 && F.tid < 256) { float a = 0.f; for (int j = 0; j < 64; ++j) a += WSP(float, WS_BIASP)[j * 256 + F.tid]; WSP(float, WS_BIAS1)[F.tid] = a; }
    const float* mod = WSP(float, WS_MOD);
    f32x4 nx[4];
    { const int r = gw < MR ? gw : MR - 1; const f32x4* x4 = (const f32x4*)(r < MP ? F.xp + (size_t)r * 1024 : F.xs + (size_t)(r - MP) * 1024) + F.lane;
#pragma unroll
      for (int j = 0; j < 4; ++j) nx[j] = x4[64 * j]; }
    for (int r = gw; r < MR; r += NGW) {
        const int mrow = r < MP ? (r >> 12) : 4 + ((r - MP) >> 2);
        f32x4 v[4]; float s = 0.f;
#pragma unroll
        for (int j = 0; j < 4; ++j) { v[j] = nx[j]; s += (v[j][0] * v[j][0] + v[j][1] * v[j][1]) + (v[j][2] * v[j][2] + v[j][3] * v[j][3]); }
        { const int rn = r + NGW < MR ? r + NGW : r; const f32x4* x4 = (const f32x4*)(rn < MP ? F.xp + (size_t)rn * 1024 : F.xs + (size_t)(rn - MP) * 1024) + F.lane;
#pragma unroll
          for (int j = 0; j < 4; ++j) nx[j] = x4[64 * j]; }
        const float rstd = 1.f / sqrtf(wave_sum(s) * (1.f / 1024.f) + 1e-6f);
        const f32x4* g4 = (const f32x4*)F.normg + F.lane;
        const f32x4* sh4 = (const f32x4*)(mod + (size_t)mrow * 3072) + F.lane;
        const f32x4* sc4 = (const f32x4*)(mod + (size_t)mrow * 3072 + 1024) + F.lane;
        unsigned long long* o8 = (unsigned long long*)(WSP(bf16, WS_H) + (size_t)r * 1024) + F.lane;
#pragma unroll
        for (int j = 0; j < 4; ++j) {
            const f32x4 y = v[j] * rstd * g4[64 * j]; const f32x4 h = y * (1.f + sc4[64 * j]) + sh4[64 * j];
            o8[64 * j] = (unsigned long long)pk2(h[0], h[1]) | ((unsigned long long)pk2(h[2], h[3]) << 32);
        }
    }
}
DI void p8_final(Frame& F) {
    const int gw = blockIdx.x * NWAVES + F.wave, NGW = F.G * NWAVES;
    f32x4 nx[4];
    { const int r = gw < MR ? gw : MR - 1; const f32x4* y4 = (const f32x4*)(r < MP ? F.out + O_YP + (size_t)r * 1024 : F.out + O_YS + (size_t)(r - MP) * 1024) + F.lane;
#pragma unroll
      for (int j = 0; j < 4; ++j) nx[j] = y4[64 * j]; }
    for (int r = gw; r < MR; r += NGW) {
        float* yr = r < MP ? F.out + O_YP + (size_t)r * 1024 : F.out + O_YS + (size_t)(r - MP) * 1024;
        f32x4* y4 = (f32x4*)yr + F.lane;
        f32x4 v[4]; float s = 0.f;
#pragma unroll
        for (int j = 0; j < 4; ++j) { v[j] = nx[j]; s += (v[j][0] * v[j][0] + v[j][1] * v[j][1]) + (v[j][2] * v[j][2] + v[j][3] * v[j][3]); }
        { const int rn = r + NGW < MR ? r + NGW : r; const f32x4* n4 = (const f32x4*)(rn < MP ? F.out + O_YP + (size_t)rn * 1024 : F.out + O_YS + (size_t)(rn - MP) * 1024) + F.lane;
#pragma unroll
          for (int j = 0; j < 4; ++j) nx[j] = n4[64 * j]; }
        const float rstd = 1.f / sqrtf(wave_sum(s) * (1.f / 1024.f) + 1e-6f);
        const f32x4* g4 = (const f32x4*)F.fing + F.lane;
#pragma unroll
        for (int j = 0; j < 4; ++j) y4[64 * j] = v[j] * rstd * g4[64 * j];
    }
}

constexpr int TP = 144;
constexpr int TILE_B = 64 * TP;
struct LdsT {
    static constexpr bool HOIST = true;
    const LAS unsigned char* p;
    DI bf16x8 frag(int mt, int s) const { return *(const LAS bf16x8*)(p + mt * 32 * TP + s * 32); }
};
struct GlbT {
    static constexpr bool HOIST = false;
    const bf16* base; unsigned off; unsigned pitch;
    DI bf16x8 frag(int mt, int s) const { return *(const bf16x8*)(base + (size_t)(off + (unsigned)mt * 32u * pitch + (unsigned)s * 16u)); }
};
template <class KT> DI void qk_tile(f32x16& s0, f32x16& s1, const KT& kt, const bf16x8 (&q)[4]) {
    f32x16 z;
#pragma unroll
    for (int i = 0; i < 16; ++i) z[i] = 0.f;
    s0 = z; s1 = z;
#pragma unroll
    for (int s = 0; s < 4; ++s) { s0 = MFMA32(kt.frag(0, s), q[s], s0); s1 = MFMA32(kt.frag(1, s), q[s], s1); }
}
DI bf16x8 cvt8(f32x4 a, f32x4 b) { u32x4 w; w.x = pk2(a[0], a[1]); w.y = pk2(a[2], a[3]); w.z = pk2(b[0], b[1]); w.w = pk2(b[2], b[3]); return __builtin_bit_cast(bf16x8, w); }
DI bf16x8 pack_p(const f32x16& x, int h) {
    u32x4 w; w.x = pk2(x[8 * h], x[8 * h + 1]); w.y = pk2(x[8 * h + 2], x[8 * h + 3]); w.z = pk2(x[8 * h + 4], x[8 * h + 5]); w.w = pk2(x[8 * h + 6], x[8 * h + 7]);
    return __builtin_bit_cast(bf16x8, w);
}
template <class VT> DI void pv_tile(f32x16& o0, f32x16& o1, const f32x16& p0, const f32x16& p1, const VT& vt) {
    const bf16x8 b0 = pack_p(p0, 0), b1 = pack_p(p0, 1), b2 = pack_p(p1, 0), b3 = pack_p(p1, 1);
    o0 = MFMA32(vt.frag(0, 0), b0, o0); o1 = MFMA32(vt.frag(1, 0), b0, o1);
    o0 = MFMA32(vt.frag(0, 1), b1, o0); o1 = MFMA32(vt.frag(1, 1), b1, o1);
    o0 = MFMA32(vt.frag(0, 2), b2, o0); o1 = MFMA32(vt.frag(1, 2), b2, o1);
    o0 = MFMA32(vt.frag(0, 3), b3, o0); o1 = MFMA32(vt.frag(1, 3), b3, o1);
}
struct Soft { float m, l; bool seen; f32x16 o0, o1, negm; };
DI void soft_init(Soft& S) {
    S.m = 0.f; S.l = 0.f; S.seen = false;
#pragma unroll
    for (int i = 0; i < 16; ++i) { S.o0[i] = 0.f; S.o1[i] = 0.f; S.negm[i] = 0.f; }
}
template <class KT> DI void qk_tile_c(f32x16& s0, f32x16& s1, const KT& kt, const bf16x8 (&q)[4], const f32x16& c) {
    if constexpr (KT::HOIST) {
        bf16x8 f[8];
#pragma unroll
        for (int s = 0; s < 4; ++s) { f[2 * s] = kt.frag(0, s); f[2 * s + 1] = kt.frag(1, s); }
        __builtin_amdgcn_sched_barrier(0);
        s0 = MFMA32(f[0], q[0], c); s1 = MFMA32(f[1], q[0], c);
#pragma unroll
        for (int s = 1; s < 4; ++s) { s0 = MFMA32(f[2 * s], q[s], s0); s1 = MFMA32(f[2 * s + 1], q[s], s1); }
    } else {
        s0 = MFMA32(kt.frag(0, 0), q[0], c); s1 = MFMA32(kt.frag(1, 0), q[0], c);
#pragma unroll
        for (int s = 1; s < 4; ++s) { s0 = MFMA32(kt.frag(0, s), q[s], s0); s1 = MFMA32(kt.frag(1, s), q[s], s1); }
    }
    asm volatile("s_nop 15\n\ts_nop 7" : "+v"(s0), "+v"(s1));
}
DI float max3f(float a, float b, float c) { float r; asm("v_max3_f32 %0, %1, %2, %3" : "=v"(r) : "v"(a), "v"(b), "v"(c)); return r; }
template <class VT> DI void soft_step(Soft& S, f32x16& s0, f32x16& s1, const VT& vt) {
    bf16x8 vf[8];
    if constexpr (VT::HOIST) {
#pragma unroll
        for (int s = 0; s < 4; ++s) { vf[2 * s] = vt.frag(0, s); vf[2 * s + 1] = vt.frag(1, s); }
        __builtin_amdgcn_sched_barrier(0);
    }
    float mx = max3f(s0[0], s1[0], s0[1]), my = max3f(s1[1], s0[2], s1[2]);
#pragma unroll
    for (int r = 3; r < 15; r += 2) { mx = max3f(mx, s0[r], s1[r]); my = max3f(my, s0[r + 1], s1[r + 1]); }
    mx = max3f(mx, s0[15], s1[15]); mx = max3f(mx, my, mx);
    mx = max3f(mx, half_other(mx), mx);
    const bool fin = mx > NEGINF;
    const bool need = (mx > 8.f) | (fin & !S.seen);
    if (__any(need)) {
        const float dl = need ? mx : 0.f;
        const float al = S.seen ? __builtin_amdgcn_exp2f(-dl) : 0.f;
        S.m += dl; S.l *= need ? al : 1.f;
        const float am = need ? al : 1.f;
#pragma unroll
        for (int r = 0; r < 16; ++r) { s0[r] -= dl; s1[r] -= dl; S.o0[r] *= am; S.o1[r] *= am; S.negm[r] = -S.m; }
    }
    S.seen = S.seen | fin;
    float ps = 0.f;
#pragma unroll
    for (int r = 0; r < 16; ++r) { s0[r] = __builtin_amdgcn_exp2f(s0[r]); s1[r] = __builtin_amdgcn_exp2f(s1[r]); ps += s0[r] + s1[r]; }
    S.l += ps;
    const bf16x8 b0 = pack_p(s0, 0), b1 = pack_p(s0, 1), b2 = pack_p(s1, 0), b3 = pack_p(s1, 1);
    if constexpr (!VT::HOIST) {
#pragma unroll
        for (int s = 0; s < 4; ++s) { vf[2 * s] = vt.frag(0, s); vf[2 * s + 1] = vt.frag(1, s); }
    }
    S.o0 = MFMA32(vf[0], b0, S.o0); S.o1 = MFMA32(vf[1], b0, S.o1);
    S.o0 = MFMA32(vf[2], b1, S.o0); S.o1 = MFMA32(vf[3], b1, S.o1);
    S.o0 = MFMA32(vf[4], b2, S.o0); S.o1 = MFMA32(vf[5], b2, S.o1);
    S.o0 = MFMA32(vf[6], b3, S.o0); S.o1 = MFMA32(vf[7], b3, S.o1);
}
DI float as_f(int x) { return __int_as_float(x); }
DI float mask_sel(float s, int mm) { return __int_as_float((__float_as_int(s) & mm) | ((int)0xff800000 & ~mm)); }
DI u32x4 tile_ld(const bf16* g, size_t pitch, int tid) { return *(const u32x4*)(g + (size_t)(tid >> 3) * pitch + (tid & 7) * 8); }
DI void tile_st(LAS unsigned char* buf, u32x4 v, int tid) { *(LAS u32x4*)(buf + (tid >> 3) * TP + (tid & 7) * 16) = v; }

constexpr int CP = 272;
DI void compress_unit(Frame& F, int u) {
    const int tid = F.tid, lane = F.lane, w = F.wave, l31 = lane & 31, hi = lane >> 5;
    const int slot = u / 136, rem = u % 136;
    const bf16* data; bf16 *ock, *ocvt; int n0, ncmp, cpitch;
    if (rem < 8) { const int bg = rem; data = WSP(bf16, (slot ? WS_PCMPV : WS_PCMPK)) + (size_t)bg * SEQ * 64; n0 = 32 * w; ncmp = 255; cpitch = 256;
        ock = WSP(bf16, WS_PCK) + (size_t)bg * 256 * 64; ocvt = WSP(bf16, WS_PCVT) + (size_t)bg * 64 * 256; }
    else { const int bg = 2 * (rem - 8) + (w >> 2); data = WSP(bf16, (slot ? WS_SCMPV : WS_SCMPK)) + (size_t)bg * LS * 64; n0 = 32 * (w & 3); ncmp = 127; cpitch = 128;
        ock = WSP(bf16, WS_SCK) + (size_t)bg * 128 * 64; ocvt = WSP(bf16, WS_SCVT) + (size_t)bg * 64 * 128; }
    const int n = n0 + l31, nc = n < ncmp ? n : ncmp - 1;
    const bf16* drow = data + (size_t)nc * 1024 + 8 * hi;
    const bool paged = rem >= 8;
    const bf16* w1t = WSP(bf16, WS_W1T) + (size_t)slot * 128 * 2048;
    f32x16 acc[4];
#pragma unroll
    for (int c = 0; c < 4; ++c)
#pragma unroll
        for (int i = 0; i < 16; ++i) acc[c][i] = 0.f;
    const bf16* wsrc = w1t + (size_t)(tid >> 2) * 2048 + ((tid & 3) >> 1) * 1024 + (tid & 1) * 32;
    LAS unsigned char* wdst = F.lds + (tid >> 2) * CP + (tid & 3) * 64;
    u32x4 st[4];
#pragma unroll
    for (int i = 0; i < 4; ++i) st[i] = ((const u32x4*)wsrc)[i];
#pragma unroll
    for (int i = 0; i < 4; ++i) ((LAS u32x4*)wdst)[i] = st[i];
    LDS_BARRIER();
    f32x4 raw[16];
#define CMP_ISSUE(kc_) do { if (!paged) { _Pragma("unroll") for (int s_ = 0; s_ < 8; ++s_) raw[2 * s_] = __builtin_bit_cast(f32x4, *(const bf16x8*)(drow + ((kc_) + 16 * (s_ >> 2)) * 64 + (s_ & 3) * 16)); } \
        } while (0)
    LAS unsigned char* const wrows = F.lds + 2 * 128 * CP + w * (36 * TP);
    const int q4 = lane >> 4, c16 = lane & 15;
    const float *lb0 = nullptr, *lb8 = nullptr; int pgs[5] = {0, 0, 0, 0, 0};
    if (paged) { const int sb = rem - 8, g = w >> 2;
#pragma unroll
        for (int k = 0; k < 5; ++k) { const int pi = (n0 >> 3) + k; pgs[k] = F.ptab[sb * NPG + (pi < NPG ? pi : NPG - 1)]; }
        lb8 = F.cnsa + (slot * 2 + g) * 64 + 4 * c16; lb0 = lb8 + (size_t)(16 * q4) * 512; }
#define CMP_ISSUE_P(kc_) do { _Pragma("unroll") for (int i_ = 0; i_ < 9; ++i_) raw[i_] = *(const f32x4*)((i_ < 8 ? lb0 : lb8) + ((size_t)pgs[i_ >> 1] * PAGE + 64 * (i_ & 1) + (kc_)) * 512); } while (0)
    if (!paged) CMP_ISSUE(0); else CMP_ISSUE_P(0);
    for (int kc = 0; kc < 16; ++kc) {
        const LAS unsigned char* buf = F.lds + (kc & 1) * (128 * CP);
        if (kc + 1 < 16) {
#pragma unroll
            for (int i = 0; i < 4; ++i) st[i] = ((const u32x4*)(wsrc + (kc + 1) * 64))[i];
        }
        bf16x8 bq[8];
        if (!paged) {
#pragma unroll
            for (int s = 0; s < 8; ++s) bq[s] = __builtin_bit_cast(bf16x8, raw[2 * s]);
            if (kc + 1 < 16) CMP_ISSUE(kc + 1);
        } else {
#pragma unroll
            for (int i = 0; i < 9; ++i) { u32x2 wv; wv.x = pk2(raw[i][0], raw[i][1]); wv.y = pk2(raw[i][2], raw[i][3]); *(LAS u32x2*)(wrows + (4 * i + q4) * TP + c16 * 8) = wv; }
            if (kc + 1 < 16) CMP_ISSUE_P(kc + 1);
#pragma unroll
            for (int s = 0; s < 8; ++s) bq[s] = *(const LAS bf16x8*)(wrows + (l31 + (s >> 2)) * TP + ((s & 3) * 16 + 8 * hi) * 2);
        }
#pragma unroll
        for (int s = 0; s < 8; ++s)
#pragma unroll
            for (int c = 0; c < 4; ++c) acc[c] = MFMA32(*(const LAS bf16x8*)(buf + (32 * c + l31) * CP + s * 32 + hi * 16), bq[s], acc[c]);
        if (kc + 1 < 16) {
            LAS unsigned char* nb = wdst + ((kc + 1) & 1) * (128 * CP);
#pragma unroll
            for (int i = 0; i < 4; ++i) ((LAS u32x4*)nb)[i] = st[i];
        }
        LDS_BARRIER();
    }
#undef CMP_ISSUE
#undef CMP_ISSUE_P
    const float* b1 = WSP(float, WS_BIAS1) + slot * 128;
#pragma unroll
    for (int c = 0; c < 4; ++c)
#pragma unroll
        for (int q = 0; q < 4; ++q) { const f32x4 bv = *(const f32x4*)(b1 + 32 * c + 8 * q + 4 * hi);
#pragma unroll
            for (int j = 0; j < 4; ++j) acc[c][4 * q + j] = silu_f(acc[c][4 * q + j] + bv[j]); }
    const bf16* w2t = WSP(bf16, WS_W2T) + (size_t)slot * 64 * 128 + (size_t)l31 * 128 + 8 * hi;
    f32x16 o0, o1;
#pragma unroll
    for (int i = 0; i < 16; ++i) { o0[i] = 0.f; o1[i] = 0.f; }
#pragma unroll
    for (int c = 0; c < 4; ++c)
#pragma unroll
        for (int h = 0; h < 2; ++h) { const bf16x8 hb = pack_p(acc[c], h); const int s2 = 2 * c + h;
            o0 = MFMA32(*(const bf16x8*)(w2t + s2 * 16), hb, o0); o1 = MFMA32(*(const bf16x8*)(w2t + 32 * 128 + s2 * 16), hb, o1); }
    const bool ok = n < ncmp;
    if (slot == 0) {
#pragma unroll
        for (int e = 0; e < 2; ++e)
#pragma unroll
            for (int q = 0; q < 4; ++q) { const f32x16& o = e ? o1 : o0; u32x2 wv;
                wv.x = ok ? pk2(o[4 * q], o[4 * q + 1]) : 0u; wv.y = ok ? pk2(o[4 * q + 2], o[4 * q + 3]) : 0u;
                *(u32x2*)(ock + (size_t)n * 64 + 32 * e + 8 * q + 4 * hi) = wv; }
    } else {
        const int pn = permk(n);
#pragma unroll
        for (int e = 0; e < 2; ++e)
#pragma unroll
            for (int r = 0; r < 16; ++r) { const f32x16& o = e ? o1 : o0; ocvt[(size_t)(32 * e + crow(r, hi)) * cpitch + pn] = ok ? (bf16)(pk2(o[r], 0.f) & 0xffffu) : (bf16)0; }
    }
}

template <int NR, int ABL> DI void idx_select(const LAS int* scw, int n, int lane, unsigned long long* out) {
    int k[NR];
    int kmin = 0x7fffffff, kmax = (int)0x80000000;
#pragma unroll
    for (int i = 0; i < NR; ++i) { const bool v = 64 * i + lane < n; const int x = v ? scw[64 * i + lane] : (int)0x80000000; k[i] = x; kmin = v ? (x < kmin ? x : kmin) : kmin; kmax = x > kmax ? x : kmax; }
    int thr = (int)0x80000000, cut = -1;
    if (n > 256 && !(ABL & 1)) {
        kmin = wave_min_i(kmin); kmax = wave_max_i(kmax);
        int lo = kmin - 1, hiv = kmax;
        bool found = false;
        if (hiv > 0x04000000) {
            const int kp = hiv - 0x03800000;
            int c = 0, cl = 0;
#pragma unroll
            for (int i0 = 0; i0 < NR; i0 += 8) {
                unsigned long long bm[4];
#pragma unroll
                for (int j = 0; j < 4; ++j) bm[j] = __ballot(k[i0 + j] > kp);
#pragma unroll
                for (int j = 4; j < 8; ++j) cl += (k[i0 + j] > kp) ? 1 : 0;
#pragma unroll
                for (int j = 0; j < 4; ++j) c += __popcll(bm[j]);
            }
            c += wave_sum_i(cl);
            if (c == 256) { thr = kp; found = true; } else if (c > 256) lo = kp; else hiv = kp;
        }
        while (!found && (unsigned)hiv - (unsigned)lo > 1u) {
            const int mid = (int)((unsigned)lo + (((unsigned)hiv - (unsigned)lo) >> 1));
            int c = 0, cl = 0;
#pragma unroll
            for (int i0 = 0; i0 < NR; i0 += 8) {
                unsigned long long bm[4];
#pragma unroll
                for (int j = 0; j < 4; ++j) bm[j] = __ballot(k[i0 + j] > mid);
#pragma unroll
                for (int j = 4; j < 8; ++j) cl += (k[i0 + j] > mid) ? 1 : 0;
#pragma unroll
                for (int j = 0; j < 4; ++j) c += __popcll(bm[j]);
            }
            c += wave_sum_i(cl);
            if (c == 256) { thr = mid; found = true; break; }
            if (c > 256) lo = mid; else hiv = mid;
        }
        if (!found) {
            thr = hiv; int cgt = 0;
#pragma unroll
            for (int i = 0; i < NR; ++i) cgt += __popcll(__ballot(k[i] > thr));
            const int need = 256 - cgt; int acc = 0; bool done = false;
#pragma unroll
            for (int i = 0; i < NR; ++i) {
                unsigned long long mk = __ballot(k[i] == thr); const int pc = __popcll(mk);
                if (!done && acc + pc >= need) { for (int q2 = 1; q2 < need - acc; ++q2) mk &= mk - 1; cut = 64 * i + (int)__builtin_ctzll(mk); done = true; }
                acc += pc;
            }
        }
    }
    unsigned long long myw = 0ull;
    if (ABL & 4) { myw = (unsigned long long)(k[0] + k[NR - 1] + kmin + kmax); } else
#pragma unroll
    for (int i = 0; i < NR; ++i) { const unsigned long long mk = __ballot((k[i] > thr) | ((k[i] == thr) & (64 * i + lane <= cut))); myw = (lane == i) ? mk : myw; }
    out[lane] = myw;
}
template <bool SAMPLE, int ABL> DI void idx1_unit(Frame& F, int u) {
    const int lane = F.lane, w = F.wave, l31 = lane & 31, hi = lane >> 5, tl = l31 >> 2, hl = l31 & 3;
    int row0, nkmax, ntok; const bf16* ik;
    if (!SAMPLE) { const int b = u & 3, tc = 511 - (u >> 2); row0 = b * SEQ + 8 * tc; nkmax = 8 * tc + 8; ntok = 8; ik = WSP(bf16, WS_PIDXK) + (size_t)b * SEQ * 64; }
    else { row0 = MP + 4 * u; nkmax = PASTL + 4; ntok = 4; ik = WSP(bf16, WS_SIDXK) + (size_t)u * LS * 64; }
    const int rowq = row0 + (SAMPLE ? (tl & 3) : tl);
    bf16x8 q[4];
#pragma unroll
    for (int s = 0; s < 4; ++s) q[s] = *(const bf16x8*)(WSP(bf16, WS_IQ) + (size_t)rowq * 256 + hl * 64 + 16 * s + 8 * hi);
    f32x4 wq[4];
#pragma unroll
    for (int qq = 0; qq < 4; ++qq) { const int tk = 2 * qq + hi; wq[qq] = *(const f32x4*)(WSP(float, WS_IW) + (size_t)(row0 + (SAMPLE ? (tk & 3) : tk)) * 4); }
    LAS int* sc = (LAS int*)F.lds;
    const int n32 = (nkmax + 31) >> 5;
    u32x4 rA[8], rB[8];
    LAS unsigned char* const stg = F.lds + STG_OFF + w * 2048;
    const int wofs_b = ((lane >> 2) * 64) + ((((lane & 3) ^ ((lane >> 4) & 3))) * 16);
    const int rofs0 = l31 * 64 + ((hi ^ ((l31 >> 2) & 3)) * 16), rofs1 = l31 * 64 + (((2 + hi) ^ ((l31 >> 2) & 3)) * 16);
#define IDX_ISSUE_B(R, base_, dup_) do { const bf16* kp_ = (base_) + (lane >> 2) * 64 + (lane & 3) * 8; \
        R[0] = gload16(kp_); R[2] = gload16(kp_ + 16 * 64); R[4] = gload16(kp_ + 32); R[6] = gload16(kp_ + 16 * 64 + 32); \
        if (dup_) { R[1] = gload16(kp_); R[3] = gload16(kp_ + 16 * 64); R[5] = gload16(kp_ + 32); R[7] = gload16(kp_ + 16 * 64 + 32); } } while (0)
#define IDX_ISSUE(R, kt_) do { const int kk_ = (kt_) < n32 ? (kt_) : n32 - 1; \
        if (SAMPLE) { if (kk_ < 64) { const int pg = F.ptab[u * NPG + (kk_ >> 2)]; const float* fp = F.cidx + ((size_t)pg * PAGE + (kk_ & 3) * 32 + (lane >> 3)) * 64 + 4 * (lane & 7); \
              _Pragma("unroll") for (int i_ = 0; i_ < 4; ++i_) { R[i_] = gload16(fp + 8 * i_ * 64); R[4 + i_] = gload16(fp + 8 * i_ * 64 + 32); } } \
            else IDX_ISSUE_B(R, ik + (size_t)(32 * kk_) * 64, true); } \
        else IDX_ISSUE_B(R, ik + (size_t)(32 * kk_) * 64, false); } while (0)
#define IDX_WAIT(R) do { if (SAMPLE) asm volatile("s_waitcnt vmcnt(8)" : "+v"(R[0]), "+v"(R[1]), "+v"(R[2]), "+v"(R[3]), "+v"(R[4]), "+v"(R[5]), "+v"(R[6]), "+v"(R[7]) :: "memory"); \
        else asm volatile("s_waitcnt vmcnt(4)" : "+v"(R[0]), "+v"(R[2]), "+v"(R[4]), "+v"(R[6]) :: "memory"); } while (0)
#define IDX_STAGE_F(R, h_) do { _Pragma("unroll") for (int i_ = 0; i_ < 4; ++i_) { const f32x4 x_ = __builtin_bit_cast(f32x4, R[4 * (h_) + i_]); u32x2 wv_; wv_.x = pk2(x_[0], x_[1]); wv_.y = pk2(x_[2], x_[3]); \
        const int row_ = (lane >> 3) + 8 * i_; *(LAS u32x2*)(stg + row_ * 64 + ((((lane & 7) >> 1) ^ ((row_ >> 2) & 3)) * 16) + (lane & 1) * 8) = wv_; } } while (0)
#define IDX_STAGE_B(R, h_) do { *(LAS u32x4*)(stg + wofs_b) = R[4 * (h_)]; *(LAS u32x4*)(stg + wofs_b + 1024) = R[4 * (h_) + 2]; } while (0)
#define IDX_FRAGS(R, kt_, kf_) do { \
        if (SAMPLE && (kt_) < 64) { IDX_STAGE_F(R, 0); kf_[0] = *(const LAS bf16x8*)(stg + rofs0); kf_[1] = *(const LAS bf16x8*)(stg + rofs1); \
                                    IDX_STAGE_F(R, 1); kf_[2] = *(const LAS bf16x8*)(stg + rofs0); kf_[3] = *(const LAS bf16x8*)(stg + rofs1); } \
        else { IDX_STAGE_B(R, 0); kf_[0] = *(const LAS bf16x8*)(stg + rofs0); kf_[1] = *(const LAS bf16x8*)(stg + rofs1); \
               IDX_STAGE_B(R, 1); kf_[2] = *(const LAS bf16x8*)(stg + rofs0); kf_[3] = *(const LAS bf16x8*)(stg + rofs1); } } while (0)
#define RELU_(x) __builtin_amdgcn_fmed3f((x), 0.f, __builtin_inff())
#define IDX_SCORE(R, kt_) do { IDX_WAIT(R); if ((kt_) < n32) { bf16x8 kf[4]; IDX_FRAGS(R, kt_, kf); \
        f32x16 a; _Pragma("unroll") for (int i_ = 0; i_ < 16; ++i_) a[i_] = 0.f; \
        _Pragma("unroll") for (int s_ = 0; s_ < 4; ++s_) a = MFMA32(q[s_], kf[s_], a); \
        _Pragma("unroll") for (int qq = 0; qq < 4; ++qq) { \
            float v = RELU_(a[4 * qq]) * wq[qq][0] + RELU_(a[4 * qq + 1]) * wq[qq][1] + RELU_(a[4 * qq + 2]) * wq[qq][2] + RELU_(a[4 * qq + 3]) * wq[qq][3]; \
            int uu = __float_as_int(v); uu = (uu == (int)0x80000000) ? 0 : uu; \
            sc[(2 * qq + hi) * 4096 + 32 * (kt_) + l31] = uu ^ ((uu >> 31) & 0x7fffffff); } } } while (0)
    if (!(ABL & 2)) {
        IDX_ISSUE(rA, w); IDX_ISSUE(rB, w + NWAVES);
        PIN4(q); PIN4(wq);
        asm volatile("s_waitcnt vmcnt(0)" ::: "memory");
        for (int kt = w; kt < n32; kt += 2 * NWAVES) {
            IDX_SCORE(rA, kt); IDX_ISSUE(rA, kt + 2 * NWAVES);
            IDX_SCORE(rB, kt + NWAVES); IDX_ISSUE(rB, kt + 3 * NWAVES);
        }
        asm volatile("s_waitcnt vmcnt(0)" : "+v"(rA[0]), "+v"(rA[2]), "+v"(rA[4]), "+v"(rA[6]), "+v"(rB[0]), "+v"(rB[2]), "+v"(rB[4]), "+v"(rB[6]) :: "memory");
        if (SAMPLE) asm volatile("" : "+v"(rA[1]), "+v"(rA[3]), "+v"(rA[5]), "+v"(rA[7]), "+v"(rB[1]), "+v"(rB[3]), "+v"(rB[5]), "+v"(rB[7]));
    }
#undef IDX_ISSUE
#undef IDX_ISSUE_B
#undef IDX_STAGE_F
#undef IDX_STAGE_B
#undef IDX_FRAGS
#undef IDX_WAIT
#undef IDX_SCORE
#undef RELU_
    __syncthreads();
    if (w < ntok && !(ABL & 8)) {
        const int n = SAMPLE ? (PASTL + 1 + w) : (row0 - (row0 & ~(SEQ - 1)) + w + 1);
        unsigned long long* out = WSP(unsigned long long, ABL ? WS_T1 : WS_SELM) + (size_t)(row0 + w) * 64;
        const LAS int* scw = sc + w * 4096;
        if (n <= 1024) idx_select<16, ABL>(scw, n, lane, out);
        else if (n <= 2048) idx_select<32, ABL>(scw, n, lane, out);
        else if (n <= 3072) idx_select<48, ABL>(scw, n, lane, out);
        else idx_select<64, ABL>(scw, n, lane, out);
    }
    __syncthreads();
}


constexpr int NSA_PS = 2 * 2 * TILE_B;
constexpr int NSA_WS = 8192 + 2048 + 64;
template <bool SAMPLE> DI void nsa_unit(Frame& F, int u) {
    const int tid = F.tid, lane = F.lane, w = F.wave, l31 = lane & 31, hi = lane >> 5, tl = l31 >> 2, hl = l31 & 3;
    int bg, g, row, qpos, ncmp, wlo, whi, n_ctile, n_stile, w_t0, w_t1, qt = 0;
    size_t cpitch, pitch, wpitch; const bf16 *ck, *cvt, *sk, *svt, *wk, *wvt; bool wr_ok;
    if (!SAMPLE) {
        bg = u & 7; qt = 63 - (u >> 3); g = bg & 1; const int t = 64 * qt + 8 * w + tl; row = (bg >> 1) * SEQ + t; qpos = t; ncmp = 255;
        cpitch = 256; pitch = SEQ; wpitch = SEQ;
        ck = WSP(bf16, WS_PCK) + (size_t)bg * 256 * 64; cvt = WSP(bf16, WS_PCVT) + (size_t)bg * 64 * 256;
        sk = WSP(bf16, WS_PSLCK) + (size_t)bg * SEQ * 64; svt = WSP(bf16, WS_PSLCVT) + (size_t)bg * 64 * SEQ;
        wk = WSP(bf16, WS_PWINK) + (size_t)bg * SEQ * 64; wvt = WSP(bf16, WS_PWINVT) + (size_t)bg * 64 * SEQ;
        wlo = qpos - 511; whi = qpos; n_ctile = (4 * qt + 2) / 64 + 1; n_stile = qt + 1; w_t0 = qt > 8 ? qt - 8 : 0; w_t1 = qt; wr_ok = true;
    } else {
        bg = u * 8 + w; g = bg & 1; const int i = tl & 3; row = MP + (bg >> 1) * 4 + i; qpos = PASTL + i; ncmp = 127;
        cpitch = 128; pitch = LS; wpitch = LSW;
        ck = WSP(bf16, WS_SCK) + (size_t)bg * 128 * 64; cvt = WSP(bf16, WS_SCVT) + (size_t)bg * 64 * 128;
        sk = WSP(bf16, WS_SSLCK) + (size_t)bg * LS * 64; svt = WSP(bf16, WS_SSLCVT) + (size_t)bg * 64 * LS;
        wk = WSP(bf16, WS_SWINK) + (size_t)bg * LSW * 64; wvt = WSP(bf16, WS_SWINVT) + (size_t)bg * 64 * LSW;
        wlo = 1 + i; whi = 512 + i; n_ctile = 2; n_stile = 33; w_t0 = 0; w_t1 = 8; wr_ok = tl < 4;
    }
    const int hq = 4 * g + hl;
    bf16x8 qraw[4], qrot[4];
#pragma unroll
    for (int s = 0; s < 4; ++s) qraw[s] = *(const bf16x8*)(WSP(bf16, WS_QRAW) + (size_t)row * 512 + hq * 64 + 16 * s + 8 * hi);
    LAS unsigned char* const lb = F.lds;
    LAS float* psum = (LAS float*)(lb + NSA_PS + w * NSA_WS);
    LAS float* impb = (LAS float*)(lb + NSA_PS + w * NSA_WS + 8192);
    LAS unsigned char* selb = lb + NSA_PS + w * NSA_WS + 8192 + 2048;
    const int fo = l31 * TP + hi * 16;
    const float* gp = WSP(float, WS_GATES) + (size_t)row * 24 + hq * 3;
    float g0 = gp[0], g1 = gp[1], g2 = gp[2];
    PIN4(qraw); asm volatile("" : "+v"(g0), "+v"(g1), "+v"(g2));
    f32x16 s0, s1;
    u32x4 rk, rv;
    Soft S;

    const int nvr = (qpos - 31) >> 4, nvis = nvr < ncmp - 1 ? nvr : ncmp - 1;
    float m = -1e30f, l = 0.f;
    if (!SAMPLE) { rk = tile_ld(ck, 64, tid); rv = tile_ld(cvt, cpitch, tid); tile_st(lb, rk, tid); tile_st(lb + TILE_B, rv, tid); LDS_BARRIER(); }
    for (int ct = 0; ct < n_ctile; ++ct) {
        if (!SAMPLE) { if (ct + 1 < n_ctile) { rk = tile_ld(ck + (size_t)(ct + 1) * 64 * 64, 64, tid); rv = tile_ld(cvt + (ct + 1) * 64, cpitch, tid); } }
        if (!SAMPLE) { LdsT kt{lb + (ct & 1) * 2 * TILE_B + fo}; qk_tile(s0, s1, kt, qraw); }
        else { GlbT kt{ck, (unsigned)((64 * ct + l31) * 64 + 8 * hi), 64u}; qk_tile(s0, s1, kt, qraw); }
        float mx = -1e30f;
        const int nv2 = nvis - 64 * ct - 4 * hi;
#pragma unroll
        for (int r = 0; r < 16; ++r) { const int cr = (r & 3) + 8 * (r >> 2); s0[r] = cr <= nv2 ? s0[r] : NEGINF; s1[r] = cr + 32 <= nv2 ? s1[r] : NEGINF; mx = fmaxf(mx, fmaxf(s0[r], s1[r])); }
        mx = fmaxf(mx, half_other(mx));
        const float mn = fmaxf(m, mx); float ps = 0.f;
#pragma unroll
        for (int r = 0; r < 16; ++r) ps += __builtin_amdgcn_exp2f(s0[r] - mn) + __builtin_amdgcn_exp2f(s1[r] - mn);
        l = l * __builtin_amdgcn_exp2f(m - mn) + ps; m = mn;
        if (!SAMPLE) { if (ct + 1 < n_ctile) { tile_st(lb + ((ct + 1) & 1) * 2 * TILE_B, rk, tid); tile_st(lb + ((ct + 1) & 1) * 2 * TILE_B + TILE_B, rv, tid); } LDS_BARRIER(); }
    }
    l += half_other(l);
    const float linv = l > 0.f ? 1.f / l : 0.f;
    soft_init(S);
    if (!SAMPLE) { rk = tile_ld(ck, 64, tid); rv = tile_ld(cvt, cpitch, tid); tile_st(lb, rk, tid); tile_st(lb + TILE_B, rv, tid); LDS_BARRIER(); }
    for (int ct = 0; ct < n_ctile; ++ct) {
        if (!SAMPLE) { if (ct + 1 < n_ctile) { rk = tile_ld(ck + (size_t)(ct + 1) * 64 * 64, 64, tid); rv = tile_ld(cvt + (ct + 1) * 64, cpitch, tid); } }
        if (!SAMPLE) { LdsT kt{lb + (ct & 1) * 2 * TILE_B + fo}; qk_tile(s0, s1, kt, qraw); }
        else { GlbT kt{ck, (unsigned)((64 * ct + l31) * 64 + 8 * hi), 64u}; qk_tile(s0, s1, kt, qraw); }
        const int nv2 = nvis - 64 * ct - 4 * hi; LAS float* pw = psum + tl * 256 + 64 * ct + 4 * hi;
#pragma unroll
        for (int r = 0; r < 16; ++r) { const int cr = (r & 3) + 8 * (r >> 2);
            s0[r] = cr <= nv2 ? __builtin_amdgcn_exp2f(s0[r] - m) * linv : 0.f; s1[r] = cr + 32 <= nv2 ? __builtin_amdgcn_exp2f(s1[r] - m) * linv : 0.f;
            float a = s0[r]; a += dpp_x1(a); a += dpp_x2(a); float b = s1[r]; b += dpp_x1(b); b += dpp_x2(b);
            if (hl == 0) { pw[cr] = a; pw[cr + 32] = b; } }
        if (!SAMPLE) { LdsT vt{lb + (ct & 1) * 2 * TILE_B + TILE_B + fo}; pv_tile(S.o0, S.o1, s0, s1, vt); }
        else { GlbT vt{cvt, (unsigned)(l31 * (int)cpitch + 64 * ct + 8 * hi), (unsigned)cpitch}; pv_tile(S.o0, S.o1, s0, s1, vt); }
        if (!SAMPLE) { if (ct + 1 < n_ctile) { tile_st(lb + ((ct + 1) & 1) * 2 * TILE_B, rk, tid); tile_st(lb + ((ct + 1) & 1) * 2 * TILE_B + TILE_B, rv, tid); } LDS_BARRIER(); }
    }
    LDS_WAIT();
    unsigned mlo, mhi;
    {
        const int tk = lane >> 3, jb = 8 * (lane & 7);
        const int qp = SAMPLE ? PASTL + (tk & 3) : 64 * qt + 8 * w + tk, cur = qp >> 6;
        float pv[33];
        const LAS f32x4* pp = (const LAS f32x4*)(psum + tk * 256 + 4 * jb);
#pragma unroll
        for (int i = 0; i < 8; ++i) { const f32x4 x = pp[i]; pv[1 + 4 * i] = x[0]; pv[2 + 4 * i] = x[1]; pv[3 + 4 * i] = x[2]; pv[4 + 4 * i] = x[3]; }
        pv[0] = jb > 0 ? psum[tk * 256 + 4 * jb - 1] : 0.f;
        float v[8];
#pragma unroll
        for (int jj = 0; jj < 8; ++jj) {
            const int j = jb + jj;
            float a = pv[4 * jj] + pv[4 * jj + 1] + pv[4 * jj + 2] + pv[4 * jj + 3];
            a += (4 * j + 3 < ncmp) ? pv[4 * jj + 4] : 0.f;
            a = ((j == 0) | (j == cur) | (j == cur - 1)) ? 1e4f : a;
            a = (j > cur) ? -1e30f : a;
            v[jj] = a;
        }
        LAS f32x4* ip = (LAS f32x4*)(impb + tk * 64 + jb);
        ip[0] = (f32x4){v[0], v[1], v[2], v[3]}; ip[1] = (f32x4){v[4], v[5], v[6], v[7]};
        LDS_WAIT();
        int cnt[8];
#pragma unroll
        for (int jj = 0; jj < 8; ++jj) cnt[jj] = 0;
        const LAS f32x4* ap = (const LAS f32x4*)(impb + tk * 64);
#pragma unroll 1
        for (int i4 = 0; i4 < 16; ++i4) {
            const f32x4 x = ap[i4];
#pragma unroll
            for (int e = 0; e < 4; ++e) { const float xi = x[e];
#pragma unroll
                for (int jj = 0; jj < 8; ++jj) cnt[jj] += (xi > v[jj]) ? 1 : 0; }
        }
        unsigned bits = 0;
#pragma unroll
        for (int jj = 0; jj < 8; ++jj) bits |= ((cnt[jj] < 16) & (jb + jj <= cur)) ? (1u << jj) : 0u;
        int nsel = __popc(bits);
        nsel += __shfl_xor(nsel, 1); nsel += __shfl_xor(nsel, 2); nsel += __shfl_xor(nsel, 4);
        if (__builtin_amdgcn_ballot_w64(nsel != (cur < 15 ? cur + 1 : 16)) != 0ull) {
#pragma unroll
            for (int jj = 0; jj < 8; ++jj) cnt[jj] = 0;
#pragma unroll 1
            for (int i4 = 0; i4 < 16; ++i4) {
                const f32x4 x = ap[i4];
#pragma unroll
                for (int e = 0; e < 4; ++e) { const int i = 4 * i4 + e; const float xi = x[e];
#pragma unroll
                    for (int jj = 0; jj < 8; ++jj) cnt[jj] += ((xi > v[jj]) | ((xi == v[jj]) & (i < jb + jj))) ? 1 : 0; }
            }
            bits = 0;
#pragma unroll
            for (int jj = 0; jj < 8; ++jj) bits |= ((cnt[jj] < 16) & (jb + jj <= cur)) ? (1u << jj) : 0u;
        }
        selb[tk * 8 + (lane & 7)] = (unsigned char)bits;
        LDS_WAIT();
        const LAS unsigned* sp = (const LAS unsigned*)(selb + tl * 8);
        mlo = sp[0]; mhi = sp[1];
    }
    LAS float* park = psum + lane;
#pragma unroll
    for (int i = 0; i < 16; ++i) { park[i * 64] = g0 * S.o0[i]; park[(16 + i) * 64] = g0 * S.o1[i]; }
#pragma unroll
    for (int s = 0; s < 4; ++s) qrot[s] = *(const bf16x8*)(WSP(bf16, WS_QROT) + (size_t)row * 512 + hq * 64 + 16 * s + 8 * hi);
    PIN4(qrot);
    soft_init(S);
    const int qrel = (qpos & 63) - 4 * hi;
    if (!SAMPLE) { rk = tile_ld(sk, 64, tid); rv = tile_ld(svt, pitch, tid); tile_st(lb, rk, tid); tile_st(lb + TILE_B, rv, tid); LDS_BARRIER(); }
    for (int j = 0; j < n_stile; ++j) {
        if (!SAMPLE) { if (j + 1 < n_stile) { rk = tile_ld(sk + (size_t)(j + 1) * 64 * 64, 64, tid); rv = tile_ld(svt + (j + 1) * 64, pitch, tid); } }
        const bool bsel = ((j < 32 ? (mlo >> j) : (mhi >> (j - 32))) & 1u) != 0u;
        if (!SAMPLE) { LdsT kt{lb + (j & 1) * 2 * TILE_B + fo}; qk_tile_c(s0, s1, kt, qrot, S.negm); }
        else { GlbT kt{sk, (unsigned)((64 * j + l31) * 64 + 8 * hi), 64u}; qk_tile_c(s0, s1, kt, qrot, S.negm); }
        if (j == n_stile - 1) {
#pragma unroll
            for (int r = 0; r < 16; ++r) { const int cr = (r & 3) + 8 * (r >> 2); s0[r] = cr <= qrel ? s0[r] : NEGINF; s1[r] = cr + 32 <= qrel ? s1[r] : NEGINF; }
        } else {
#pragma unroll
            for (int r = 0; r < 16; ++r) { s0[r] = bsel ? s0[r] : NEGINF; s1[r] = bsel ? s1[r] : NEGINF; }
        }
        if (!SAMPLE) { LdsT vt{lb + (j & 1) * 2 * TILE_B + TILE_B + fo}; soft_step(S, s0, s1, vt); }
        else { GlbT vt{svt, (unsigned)(l31 * (int)pitch + 64 * j + 8 * hi), (unsigned)pitch}; soft_step(S, s0, s1, vt); }
        if (!SAMPLE) { if (j + 1 < n_stile) { tile_st(lb + ((j + 1) & 1) * 2 * TILE_B, rk, tid); tile_st(lb + ((j + 1) & 1) * 2 * TILE_B + TILE_B, rv, tid); } LDS_BARRIER(); }
    }
    S.l += half_other(S.l);
    { const float sc = g1 / fmaxf(S.l, 1e-30f);
#pragma unroll
      for (int i = 0; i < 16; ++i) { park[i * 64] += sc * S.o0[i]; park[(16 + i) * 64] += sc * S.o1[i]; } }
    soft_init(S);
    if (!SAMPLE) { rk = tile_ld(wk + (size_t)w_t0 * 64 * 64, 64, tid); rv = tile_ld(wvt + w_t0 * 64, wpitch, tid); tile_st(lb, rk, tid); tile_st(lb + TILE_B, rv, tid); LDS_BARRIER(); }
    for (int j = w_t0; j <= w_t1; ++j) {
        const int jr = j - w_t0;
        if (!SAMPLE) { if (j + 1 <= w_t1) { rk = tile_ld(wk + (size_t)(j + 1) * 64 * 64, 64, tid); rv = tile_ld(wvt + (j + 1) * 64, wpitch, tid); } }
        if (!SAMPLE) { LdsT kt{lb + (jr & 1) * 2 * TILE_B + fo}; qk_tile_c(s0, s1, kt, qrot, S.negm); }
        else { GlbT kt{wk, (unsigned)((64 * j + l31) * 64 + 8 * hi), 64u}; qk_tile_c(s0, s1, kt, qrot, S.negm); }
        if ((j == w_t0) | (j == w_t1)) {
            const int lo_r = wlo - 64 * j - 4 * hi, hi_r = whi - 64 * j - 4 * hi;
#pragma unroll
            for (int r = 0; r < 16; ++r) { const int k0 = (r & 3) + 8 * (r >> 2); s0[r] = ((k0 >= lo_r) & (k0 <= hi_r)) ? s0[r] : NEGINF; s1[r] = ((k0 + 32 >= lo_r) & (k0 + 32 <= hi_r)) ? s1[r] : NEGINF; }
        }
        if (!SAMPLE) { LdsT vt{lb + (jr & 1) * 2 * TILE_B + TILE_B + fo}; soft_step(S, s0, s1, vt); }
        else { GlbT vt{wvt, (unsigned)(l31 * (int)wpitch + 64 * j + 8 * hi), (unsigned)wpitch}; soft_step(S, s0, s1, vt); }
        if (!SAMPLE) { if (j + 1 <= w_t1) { tile_st(lb + ((jr + 1) & 1) * 2 * TILE_B, rk, tid); tile_st(lb + ((jr + 1) & 1) * 2 * TILE_B + TILE_B, rv, tid); } LDS_BARRIER(); }
    }
    S.l += half_other(S.l);
#ifdef BREAK_WIN
    S.l *= 1.1f;
#endif
    f32x16 res0, res1;
    { const float sc = g2 / fmaxf(S.l, 1e-30f);
#pragma unroll
      for (int i = 0; i < 16; ++i) { res0[i] = park[i * 64] + sc * S.o0[i]; res1[i] = park[(16 + i) * 64] + sc * S.o1[i]; } }
    if (wr_ok) {
        const bf16* zp = WSP(bf16, WS_ZN) + (size_t)row * 512 + hq * 64 + 4 * hi;
        bf16* op = WSP(bf16, WS_ONZ) + (size_t)row * 512 + hq * 64 + 4 * hi;
#pragma unroll
        for (int e = 0; e < 2; ++e)
#pragma unroll
            for (int q = 0; q < 4; ++q) { const f32x16& o = e ? res1 : res0; const u32x2 z = *(const u32x2*)(zp + 32 * e + 8 * q);
                u32x2 wv; wv.x = pk2(o[4 * q] * bflo(z.x), o[4 * q + 1] * bfhi(z.x)); wv.y = pk2(o[4 * q + 2] * bflo(z.y), o[4 * q + 3] * bfhi(z.y));
                *(u32x2*)(op + 32 * e + 8 * q) = wv; }
    }
}

template <int ABL, class VT> DI void soft_step2(Soft& S, f32x16& s0, f32x16& s1, f32x16& sn0, f32x16& sn1, const VT& vt) {
    bf16x8 vf[8];
#pragma unroll
    for (int s = 0; s < 4; ++s) { vf[2 * s] = vt.frag(0, s); vf[2 * s + 1] = vt.frag(1, s); }
    if (!(ABL & 1)) {
    float mx = max3f(s0[0], s1[0], s0[1]), my = max3f(s1[1], s0[2], s1[2]);
#pragma unroll
    for (int r = 3; r < 15; r += 2) { mx = max3f(mx, s0[r], s1[r]); my = max3f(my, s0[r + 1], s1[r + 1]); }
    mx = max3f(mx, s0[15], s1[15]); mx = max3f(mx, my, mx);
    mx = max3f(mx, half_other(mx), mx);
    const bool fin = mx > NEGINF;
    const bool need = (mx > 8.f) | (fin & !S.seen);
    if (__any(need)) {
        const float dl = need ? mx : 0.f;
        const float al = S.seen ? __builtin_amdgcn_exp2f(-dl) : 0.f;
        S.m += dl; S.l *= need ? al : 1.f;
        const float am = need ? al : 1.f;
#pragma unroll
        for (int r = 0; r < 16; ++r) { s0[r] -= dl; s1[r] -= dl; sn0[r] -= dl; sn1[r] -= dl; S.o0[r] *= am; S.o1[r] *= am; S.negm[r] = -S.m; }
    }
    S.seen = S.seen | fin;
    float ps = 0.f;
#pragma unroll
    for (int r = 0; r < 16; ++r) { s0[r] = __builtin_amdgcn_exp2f(s0[r]); s1[r] = __builtin_amdgcn_exp2f(s1[r]); ps += s0[r] + s1[r]; }
    S.l += ps;
    }
    const bf16x8 b0 = pack_p(s0, 0), b1 = pack_p(s0, 1), b2 = pack_p(s1, 0), b3 = pack_p(s1, 1);
    if (!(ABL & 4)) {
    S.o0 = MFMA32(vf[0], b0, S.o0); S.o1 = MFMA32(vf[1], b0, S.o1);
    S.o0 = MFMA32(vf[2], b1, S.o0); S.o1 = MFMA32(vf[3], b1, S.o1);
    S.o0 = MFMA32(vf[4], b2, S.o0); S.o1 = MFMA32(vf[5], b2, S.o1);
    S.o0 = MFMA32(vf[6], b3, S.o0); S.o1 = MFMA32(vf[7], b3, S.o1);
    } else { S.o0[0] += __builtin_bit_cast(f32x4, b0)[0] + __builtin_bit_cast(f32x4, b1)[0] + __builtin_bit_cast(f32x4, b2)[0] + __builtin_bit_cast(f32x4, b3)[0] + __builtin_bit_cast(f32x4, vf[0])[0] + __builtin_bit_cast(f32x4, vf[7])[1]; }
}
template <int ABL> DI void dsa_unit(Frame& F, int u) {
    const int tid = F.tid, lane = F.lane, w = F.wave, l31 = lane & 31, hi = lane >> 5, tl = l31 >> 2, hl = l31 & 3;
    const int bg = u & 7, qt = 63 - (u >> 3), g = bg & 1, t = 64 * qt + 8 * w + tl, row = (bg >> 1) * SEQ + t, nt = qt + 1;
    const bf16* dk = WSP(bf16, WS_PDSAK) + (size_t)bg * SEQ * 64; const bf16* dvt = WSP(bf16, WS_PDSAVT) + (size_t)bg * 64 * SEQ;
    const int hq = 4 * g + hl;
    bf16x8 dq[4];
#pragma unroll
    for (int s = 0; s < 4; ++s) dq[s] = *(const bf16x8*)(WSP(bf16, WS_DQ) + (size_t)row * 512 + hq * 64 + 16 * s + 8 * hi);
    const unsigned long long* selp = WSP(unsigned long long, WS_SELM) + (size_t)row * 64;
    unsigned long long selA = selp[0], selB = selp[nt > 1 ? 1 : 0];
    PIN4(dq); asm volatile("" : "+v"(selA), "+v"(selB));
    LAS unsigned char* const lb = F.lds;
    const int fo = l31 * TP + hi * 16;
    f32x16 sc0, sc1, sn0, sn1;
    u32x4 rkA, rvA, rkB, rvB;
    Soft S; soft_init(S);
    const int ntm = nt - 1;
    const bf16* kpc = dk + (size_t)(tid >> 3) * 64 + (tid & 7) * 8; const bf16* vpc = dvt + (size_t)(tid >> 3) * SEQ + (tid & 7) * 8;
#define KADDR(jt) (kpc + (size_t)((jt) < ntm ? (jt) : ntm) * 64 * 64)
#define VADDR(jt) (vpc + ((jt) < ntm ? (jt) : ntm) * 64)
    { const u32x4 a = tile_ld(dk, 64, tid), b = tile_ld(dvt, SEQ, tid), c = *(const u32x4*)KADDR(1); tile_st(lb, a, tid); tile_st(lb + 2 * TILE_B, b, tid); tile_st(lb + TILE_B, c, tid); }
    asm volatile("s_waitcnt vmcnt(0)" : "+v"(selA), "+v"(selB) :: "memory");
    selA = gload8(selp); selB = gload8(selp + (nt > 1 ? 1 : 0));
    rkA = gload16(KADDR(2)); rvA = gload16(VADDR(1));
    LDS_BARRIER();
    { LdsT kt{lb + fo}; qk_tile_c(sc0, sc1, kt, dq, S.negm); }
#define DSA_STEP(j, CK, CV, NK, NV, SELC) do { \
        NK = gload16(KADDR((j) + 3)); NV = gload16(VADDR((j) + 2)); \
        if ((j) + 1 < nt) { LdsT kt{lb + (((j) + 1) & 1) * TILE_B + fo}; if (!(ABL & 2)) qk_tile_c(sn0, sn1, kt, dq, S.negm); else { sn0 = S.negm; sn1 = S.negm; sn0[0] += __builtin_bit_cast(f32x4, kt.frag(0, 0))[0]; } } \
        WAITV1(5, SELC);                                                     \
        { const unsigned wa = (unsigned)SELC >> (4 * hi), wb = (unsigned)(SELC >> 32) >> (4 * hi); \
          SELC = gload8(selp + ((j) + 2 < nt ? (j) + 2 : ntm)); \
          _Pragma("unroll") for (int r = 0; r < 16; ++r) { const int bp = (r & 3) + 8 * (r >> 2); \
            sc0[r] = mask_sel(sc0[r], (int)(wa << (31 - bp)) >> 31); sc1[r] = mask_sel(sc1[r], (int)(wb << (31 - bp)) >> 31); } } \
        { LdsT vt{lb + (2 + ((j) & 1)) * TILE_B + fo}; soft_step2<ABL>(S, sc0, sc1, sn0, sn1, vt); } \
        sc0 = sn0; sc1 = sn1; \
        WAITV2(3, CK, CV);                                                   \
        if (!(ABL & 8)) { tile_st(lb + ((j) & 1) * TILE_B, CK, tid); tile_st(lb + (2 + (((j) + 1) & 1)) * TILE_B, CV, tid); } \
        if (!(ABL & 16)) LDS_BARRIER(); } while (0)
    for (int j = 0; j < nt; j += 2) { DSA_STEP(j, rkA, rvA, rkB, rvB, selA); if (j + 1 < nt) DSA_STEP(j + 1, rkB, rvB, rkA, rvA, selB); }
    asm volatile("s_waitcnt vmcnt(0)" : "+v"(rkA), "+v"(rvA), "+v"(rkB), "+v"(rvB), "+v"(selA), "+v"(selB) :: "memory");
#undef DSA_STEP
#undef KADDR
#undef VADDR
    S.l += half_other(S.l);
    {
        const float sc = 1.f / fmaxf(S.l, 1e-30f);
        const bf16* zp = WSP(bf16, WS_ZD) + (size_t)row * 512 + hq * 64 + 4 * hi;
        bf16* op = WSP(bf16, ABL ? WS_T1 : WS_ODZ) + (size_t)row * 512 + hq * 64 + 4 * hi;
#pragma unroll
        for (int e = 0; e < 2; ++e)
#pragma unroll
            for (int q = 0; q < 4; ++q) { const f32x16& o = e ? S.o1 : S.o0; const u32x2 z = *(const u32x2*)(zp + 32 * e + 8 * q);
                u32x2 wv; wv.x = pk2(o[4 * q] * sc * bflo(z.x), o[4 * q + 1] * sc * bfhi(z.x)); wv.y = pk2(o[4 * q + 2] * sc * bflo(z.y), o[4 * q + 3] * sc * bfhi(z.y));
                *(u32x2*)(op + 32 * e + 8 * q) = wv; }
    }
}


struct PageK {
    static constexpr bool HOIST = false;
    const float* p; unsigned stride;
    DI bf16x8 frag(int mt, int s) const { const f32x4* q = (const f32x4*)(p + (size_t)((unsigned)mt * 32u * stride + (unsigned)s * 16u)); return cvt8(q[0], q[1]); }
};
struct PageV {
    static constexpr bool HOIST = false;
    const float* p; unsigned stride;
    DI bf16x8 frag(int dt, int s) const {
        float v[8];
#pragma unroll
        for (int i = 0; i < 8; ++i) v[i] = p[(size_t)((unsigned)(16 * s + (i & 3) + 8 * (i >> 2)) * stride + (unsigned)dt * 32u)];
        return __builtin_bit_cast(bf16x8, pack8(v));
    }
};
DI void stage_k_ld(f32x4 (&x)[16], const float* base, unsigned stride, int lane) {
    const float* p = base + (size_t)((unsigned)(lane >> 4) * stride + 4u * (unsigned)(lane & 15));
#pragma unroll
    for (int i = 0; i < 16; ++i) x[i] = *(const f32x4*)(p + (size_t)((unsigned)(4 * i) * stride));
}
DI void stage_k_st(const f32x4 (&x)[16], LAS unsigned char* kb, int lane) {
    LAS unsigned char* d = kb + (lane >> 4) * TP + (lane & 15) * 8;
#pragma unroll
    for (int i = 0; i < 16; ++i) { u32x2 wv; wv.x = pk2(x[i][0], x[i][1]); wv.y = pk2(x[i][2], x[i][3]); *(LAS u32x2*)(d + 4 * i * TP) = wv; }
}
struct RegV { static constexpr bool HOIST = true; bf16x8 f[8]; DI bf16x8 frag(int dt, int s) const { return f[2 * s + dt]; } };
DI void pagev_ld(float (&v)[64], const float* p, unsigned stride) {
#pragma unroll
    for (int f = 0; f < 8; ++f)
#pragma unroll
        for (int i = 0; i < 8; ++i) v[8 * f + i] = p[(size_t)((unsigned)(16 * (f >> 1) + (i & 3) + 8 * (i >> 2)) * stride + (unsigned)(f & 1) * 32u)];
}
DI void pagev_pack(RegV& r, const float (&v)[64]) {
#pragma unroll
    for (int f = 0; f < 8; ++f) r.f[f] = __builtin_bit_cast(bf16x8, pack8(&v[8 * f]));
}
constexpr int XCH_W = 34 * 64;
constexpr int XCH_BYTES = 8 * XCH_W * 4;
DI void xch_put(LAS float* x, const Soft& S, int lane) {
    const float lt = S.l + half_other(S.l);
    x[lane] = S.seen ? S.m : NEGINF; x[64 + lane] = lt;
#pragma unroll
    for (int r = 0; r < 16; ++r) { x[(2 + r) * 64 + lane] = S.o0[r]; x[(18 + r) * 64 + lane] = S.o1[r]; }
}
DI void xch_get(const LAS float* xb, int w, int lane, float (&out)[4]) {
    float mw[8], M = -1e30f;
#pragma unroll
    for (int i = 0; i < 8; ++i) { mw[i] = xb[i * XCH_W + lane]; M = fmaxf(M, mw[i]); }
    float L = 0.f, o[4] = {0.f, 0.f, 0.f, 0.f};
#pragma unroll
    for (int i = 0; i < 8; ++i) { const float wt = __builtin_amdgcn_exp2f(mw[i] - M); L += wt * xb[i * XCH_W + 64 + lane];
#pragma unroll
        for (int k = 0; k < 4; ++k) o[k] += wt * xb[i * XCH_W + (2 + 4 * w + k) * 64 + lane]; }
    const float inv = 1.f / fmaxf(L, 1e-30f);
#pragma unroll
    for (int k = 0; k < 4; ++k) out[k] = o[k] * inv;
}
DI void nsa_sample_unit(Frame& F, int bg) {
    const int lane = F.lane, w = F.wave, l31 = lane & 31, hi = lane >> 5, tl = l31 >> 2, hl = l31 & 3;
    const int sb = bg >> 1, g = bg & 1, i = tl & 3, row = MP + sb * 4 + i, qpos = PASTL + i, hq = 4 * g + hl;
    LAS unsigned char* const lb = F.lds;
    LAS float* xch = (LAS float*)lb;
    LAS float* cmpb = (LAS float*)(lb + XCH_BYTES);
    LAS unsigned* mskb = (LAS unsigned*)(lb + XCH_BYTES + 8192);
    LAS float* psum = (LAS float*)(lb + XCH_BYTES + 8192 + 64);
    LAS float* impb = psum + 8 * 256;
    LAS unsigned char* selb = (LAS unsigned char*)(impb + 8 * 64);
    const float* gp = WSP(float, WS_GATES) + (size_t)row * 24 + hq * 3;
    float g0 = gp[0], g1 = gp[1], g2 = gp[2];
    bf16x8 qrot[4];
#pragma unroll
    for (int s = 0; s < 4; ++s) qrot[s] = *(const bf16x8*)(WSP(bf16, WS_QROT) + (size_t)row * 512 + hq * 64 + 16 * s + 8 * hi);
    f32x16 s0, s1;
    Soft S;
    __syncthreads();
    if (w == 0) {
        const bf16* ck = WSP(bf16, WS_SCK) + (size_t)bg * 128 * 64; const bf16* cvt = WSP(bf16, WS_SCVT) + (size_t)bg * 64 * 128;
        bf16x8 qraw[4];
#pragma unroll
        for (int s = 0; s < 4; ++s) qraw[s] = *(const bf16x8*)(WSP(bf16, WS_QRAW) + (size_t)row * 512 + hq * 64 + 16 * s + 8 * hi);
        const int ncmp = 127, nvis = 126;
        float m = -1e30f, l = 0.f;
        for (int ct = 0; ct < 2; ++ct) {
            GlbT kt{ck, (unsigned)((64 * ct + l31) * 64 + 8 * hi), 64u}; qk_tile(s0, s1, kt, qraw);
            float mx = -1e30f; const int nv2 = nvis - 64 * ct - 4 * hi;
#pragma unroll
            for (int r = 0; r < 16; ++r) { const int cr = (r & 3) + 8 * (r >> 2); s0[r] = cr <= nv2 ? s0[r] : NEGINF; s1[r] = cr + 32 <= nv2 ? s1[r] : NEGINF; mx = fmaxf(mx, fmaxf(s0[r], s1[r])); }
            mx = fmaxf(mx, half_other(mx));
            const float mn = fmaxf(m, mx); float ps = 0.f;
#pragma unroll
            for (int r = 0; r < 16; ++r) ps += __builtin_amdgcn_exp2f(s0[r] - mn) + __builtin_amdgcn_exp2f(s1[r] - mn);
            l = l * __builtin_amdgcn_exp2f(m - mn) + ps; m = mn;
        }
        l += half_other(l);
        const float linv = l > 0.f ? 1.f / l : 0.f;
        soft_init(S);
        for (int ct = 0; ct < 2; ++ct) {
            GlbT kt{ck, (unsigned)((64 * ct + l31) * 64 + 8 * hi), 64u}; qk_tile(s0, s1, kt, qraw);
            const int nv2 = nvis - 64 * ct - 4 * hi; LAS float* pw = psum + tl * 256 + 64 * ct + 4 * hi;
#pragma unroll
            for (int r = 0; r < 16; ++r) { const int cr = (r & 3) + 8 * (r >> 2);
                s0[r] = cr <= nv2 ? __builtin_amdgcn_exp2f(s0[r] - m) * linv : 0.f; s1[r] = cr + 32 <= nv2 ? __builtin_amdgcn_exp2f(s1[r] - m) * linv : 0.f;
                float a = s0[r]; a += dpp_x1(a); a += dpp_x2(a); float b = s1[r]; b += dpp_x1(b); b += dpp_x2(b);
                if (hl == 0) { pw[cr] = a; pw[cr + 32] = b; } }
            GlbT vt{cvt, (unsigned)(l31 * 128 + 64 * ct + 8 * hi), 128u}; pv_tile(S.o0, S.o1, s0, s1, vt);
        }
#pragma unroll
        for (int r = 0; r < 16; ++r) { cmpb[r * 64 + lane] = S.o0[r]; cmpb[(16 + r) * 64 + lane] = S.o1[r]; }
        LDS_WAIT();
        {
            const int tk = lane >> 3, jb = 8 * (lane & 7), cur = 32;
            float pv[33];
            const LAS f32x4* pp = (const LAS f32x4*)(psum + tk * 256 + 4 * jb);
#pragma unroll
            for (int q = 0; q < 8; ++q) { const f32x4 x = pp[q]; pv[1 + 4 * q] = x[0]; pv[2 + 4 * q] = x[1]; pv[3 + 4 * q] = x[2]; pv[4 + 4 * q] = x[3]; }
            pv[0] = jb > 0 ? psum[tk * 256 + 4 * jb - 1] : 0.f;
            float v[8];
#pragma unroll
            for (int jj = 0; jj < 8; ++jj) { const int j = jb + jj;
                float a = pv[4 * jj] + pv[4 * jj + 1] + pv[4 * jj + 2] + pv[4 * jj + 3];
                a += (4 * j + 3 < ncmp) ? pv[4 * jj + 4] : 0.f;
                a = ((j == 0) | (j == cur) | (j == cur - 1)) ? 1e4f : a;
                a = (j > cur) ? -1e30f : a;
                v[jj] = a; }
            LAS f32x4* ip = (LAS f32x4*)(impb + tk * 64 + jb);
            ip[0] = (f32x4){v[0], v[1], v[2], v[3]}; ip[1] = (f32x4){v[4], v[5], v[6], v[7]};
            LDS_WAIT();
            int cnt[8];
#pragma unroll
            for (int jj = 0; jj < 8; ++jj) cnt[jj] = 0;
            const LAS f32x4* ap = (const LAS f32x4*)(impb + tk * 64);
#pragma unroll 1
            for (int i4 = 0; i4 < 16; ++i4) { const f32x4 x = ap[i4];
#pragma unroll
                for (int e = 0; e < 4; ++e) { const int ii = 4 * i4 + e; const float xi = x[e];
#pragma unroll
                    for (int jj = 0; jj < 8; ++jj) cnt[jj] += ((xi > v[jj]) | ((xi == v[jj]) & (ii < jb + jj))) ? 1 : 0; } }
            unsigned bits = 0;
#pragma unroll
            for (int jj = 0; jj < 8; ++jj) bits |= ((cnt[jj] < 16) & (jb + jj <= cur)) ? (1u << jj) : 0u;
            selb[tk * 8 + (lane & 7)] = (unsigned char)bits;
            LDS_WAIT();
            if (lane < 16) mskb[lane] = ((const LAS unsigned*)selb)[lane];
        }
    }
    __syncthreads();
    const unsigned mlo = mskb[tl * 2], mhi = mskb[tl * 2 + 1];
    PIN4(qrot); asm volatile("" : "+v"(g0), "+v"(g1), "+v"(g2));
    soft_init(S);
    for (int j = w; j < 32; j += NWAVES) {
        const int pg = F.ptab[sb * NPG + (j >> 1)];
        const float* base = F.cnsa + ((size_t)pg * PAGE + (j & 1) * 64) * 512 + (2 * 2 + g) * 64;
        PageK kt{base + (size_t)l31 * 512 + 8 * hi, 512u}; qk_tile_c(s0, s1, kt, qrot, S.negm);
        const bool bsel = ((mlo >> j) & 1u) != 0u;
#pragma unroll
        for (int r = 0; r < 16; ++r) { s0[r] = bsel ? s0[r] : NEGINF; s1[r] = bsel ? s1[r] : NEGINF; }
        PageV vt{base + 128 + (size_t)(4 * hi) * 512 + l31, 512u}; soft_step(S, s0, s1, vt);
    }
    if (w == 0) {
        const bf16* sk = WSP(bf16, WS_SSLCK) + (size_t)bg * LS * 64; const bf16* svt = WSP(bf16, WS_SSLCVT) + (size_t)bg * 64 * LS;
        GlbT kt{sk, (unsigned)((2048 + l31) * 64 + 8 * hi), 64u}; qk_tile_c(s0, s1, kt, qrot, S.negm);
        const int qrel = i - 4 * hi;
#pragma unroll
        for (int r = 0; r < 16; ++r) { const int cr = (r & 3) + 8 * (r >> 2); s0[r] = cr <= qrel ? s0[r] : NEGINF; s1[r] = cr + 32 <= qrel ? s1[r] : NEGINF; }
        GlbT vt{svt, (unsigned)(l31 * LS + 2048 + 8 * hi), (unsigned)LS}; soft_step(S, s0, s1, vt);
    }
    xch_put(xch + w * XCH_W, S, lane);
    __syncthreads();
    float acc[4], part[4];
    xch_get(xch, w, lane, part);
#pragma unroll
    for (int k = 0; k < 4; ++k) acc[k] = g1 * part[k] + g0 * cmpb[(4 * w + k) * 64 + lane];
    __syncthreads();
    soft_init(S);
    {
        const float* base = F.swin + ((size_t)sb * 512 + 64 * w) * 256 + g * 64;
        PageK kt{base + (size_t)l31 * 256 + 8 * hi, 256u}; qk_tile_c(s0, s1, kt, qrot, S.negm);
        if (w == 0) {
            const int lo_r = 1 + i - 4 * hi;
#pragma unroll
            for (int r = 0; r < 16; ++r) { const int k0 = (r & 3) + 8 * (r >> 2); s0[r] = k0 >= lo_r ? s0[r] : NEGINF; s1[r] = k0 + 32 >= lo_r ? s1[r] : NEGINF; }
        }
        PageV vt{base + 128 + (size_t)(4 * hi) * 256 + l31, 256u}; soft_step(S, s0, s1, vt);
    }
    if (w == 0) {
        const bf16* wk = WSP(bf16, WS_SWINK) + (size_t)bg * LSW * 64; const bf16* wvt = WSP(bf16, WS_SWINVT) + (size_t)bg * 64 * LSW;
        GlbT kt{wk, (unsigned)((512 + l31) * 64 + 8 * hi), 64u}; qk_tile_c(s0, s1, kt, qrot, S.negm);
        const int hi_r = i - 4 * hi;
#pragma unroll
        for (int r = 0; r < 16; ++r) { const int k0 = (r & 3) + 8 * (r >> 2); s0[r] = k0 <= hi_r ? s0[r] : NEGINF; s1[r] = k0 + 32 <= hi_r ? s1[r] : NEGINF; }
        GlbT vt{wvt, (unsigned)(l31 * LSW + 512 + 8 * hi), (unsigned)LSW}; soft_step(S, s0, s1, vt);
    }
    xch_put(xch + w * XCH_W, S, lane);
    __syncthreads();
    xch_get(xch, w, lane, part);
#ifdef BREAK_WIN
#pragma unroll
    for (int k = 0; k < 4; ++k) part[k] *= 0.9f;
#endif
    if (tl < 4) {
        const int d0 = 32 * (w >> 2) + 8 * (w & 3) + 4 * hi;
        const u32x2 z = *(const u32x2*)(WSP(bf16, WS_ZN) + (size_t)row * 512 + hq * 64 + d0);
        u32x2 wv; wv.x = pk2((acc[0] + g2 * part[0]) * bflo(z.x), (acc[1] + g2 * part[1]) * bfhi(z.x)); wv.y = pk2((acc[2] + g2 * part[2]) * bflo(z.y), (acc[3] + g2 * part[3]) * bfhi(z.y));
        *(u32x2*)(WSP(bf16, WS_ONZ) + (size_t)row * 512 + hq * 64 + d0) = wv;
    }
}
DI void dsa_sample_unit(Frame& F, int bg) {
    const int lane = F.lane, w = F.wave, l31 = lane & 31, hi = lane >> 5, tl = l31 >> 2, hl = l31 & 3;
    const int sb = bg >> 1, g = bg & 1, i = tl & 3, row = MP + sb * 4 + i, hq = 4 * g + hl;
    LAS float* xch = (LAS float*)F.lds;
    bf16x8 dq[4];
#pragma unroll
    for (int s = 0; s < 4; ++s) dq[s] = *(const bf16x8*)(WSP(bf16, WS_DQ) + (size_t)row * 512 + hq * 64 + 16 * s + 8 * hi);
    const unsigned long long* selp = WSP(unsigned long long, WS_SELM) + (size_t)row * 64;
    PIN4(dq);
    f32x16 s0, s1;
    Soft S; soft_init(S);
    LAS unsigned char* const kb = F.lds + w * TILE_B;
    const int fo = l31 * TP + hi * 16;
    __syncthreads();
    for (int j = w; j < 32; j += NWAVES) {
        unsigned long long selw = selp[j];
        const int pg = F.ptab[sb * NPG + (j >> 1)];
        const float* base = F.cdsa + ((size_t)pg * PAGE + (j & 1) * 64) * 256 + g * 64;
        { f32x4 kx[16]; stage_k_ld(kx, base, 256u, lane); stage_k_st(kx, kb, lane); }
        LdsT kt{kb + fo}; qk_tile_c(s0, s1, kt, dq, S.negm);
#ifdef BREAK_DSA
        selw |= 0x1111111111111111ull;
#endif
        const unsigned wa = (unsigned)selw >> (4 * hi), wb = (unsigned)(selw >> 32) >> (4 * hi);
#pragma unroll
        for (int r = 0; r < 16; ++r) { const int bp = (r & 3) + 8 * (r >> 2);
            s0[r] = mask_sel(s0[r], (int)(wa << (31 - bp)) >> 31); s1[r] = mask_sel(s1[r], (int)(wb << (31 - bp)) >> 31); }
        PageV vt{base + 128 + (size_t)(4 * hi) * 256 + l31, 256u}; soft_step(S, s0, s1, vt);
    }
    if (w == 0) {
        const unsigned long long selw = selp[32];
        const bf16* dk = WSP(bf16, WS_SDSAK) + (size_t)bg * LS * 64; const bf16* dvt = WSP(bf16, WS_SDSAVT) + (size_t)bg * 64 * LS;
        GlbT kt{dk, (unsigned)((2048 + l31) * 64 + 8 * hi), 64u}; qk_tile_c(s0, s1, kt, dq, S.negm);
        const unsigned wa = (unsigned)selw >> (4 * hi), wb = (unsigned)(selw >> 32) >> (4 * hi);
#pragma unroll
        for (int r = 0; r < 16; ++r) { const int bp = (r & 3) + 8 * (r >> 2);
            s0[r] = mask_sel(s0[r], (int)(wa << (31 - bp)) >> 31); s1[r] = mask_sel(s1[r], (int)(wb << (31 - bp)) >> 31); }
        GlbT vt{dvt, (unsigned)(l31 * LS + 2048 + 8 * hi), (unsigned)LS}; soft_step(S, s0, s1, vt);
    }
    __syncthreads();
    xch_put(xch + w * XCH_W, S, lane);
    __syncthreads();
    float part[4];
    xch_get(xch, w, lane, part);
    if (tl < 4) {
        const int d0 = 32 * (w >> 2) + 8 * (w & 3) + 4 * hi;
        const u32x2 z = *(const u32x2*)(WSP(bf16, WS_ZD) + (size_t)row * 512 + hq * 64 + d0);
        u32x2 wv; wv.x = pk2(part[0] * bflo(z.x), part[1] * bfhi(z.x)); wv.y = pk2(part[2] * bflo(z.y), part[3] * bfhi(z.y));
        *(u32x2*)(WSP(bf16, WS_ODZ) + (size_t)row * 512 + hq * 64 + d0) = wv;
    }
}

template <int K, class EF> DI void small_gemm(Frame& F, const bf16* A, const bf16* Bt, const EF& ef) {
    const int lane = F.lane, w = F.wave, l31 = lane & 31, hi = lane >> 5;
    LAS float* red = (LAS float*)F.lds;
    for (int t = blockIdx.x; t < 256; t += F.G) {
        const int mt = t >> 5, nt = t & 31, kw = K >> 3, k0 = w * kw;
        const bf16* ap = A + (size_t)(MP + 64 * mt + l31) * K + k0 + 8 * hi;
        const bf16* bp = Bt + (size_t)(32 * nt + l31) * K + k0 + 8 * hi;
        f32x16 a0, a1;
#pragma unroll
        for (int i = 0; i < 16; ++i) { a0[i] = 0.f; a1[i] = 0.f; }
        bf16x8 fb[K / 128], f0[K / 128], f1[K / 128];
#pragma unroll
        for (int s = 0; s < K / 128; ++s) { fb[s] = *(const bf16x8*)(bp + 16 * s); f0[s] = *(const bf16x8*)(ap + 16 * s); f1[s] = *(const bf16x8*)(ap + (size_t)32 * K + 16 * s); }
#pragma unroll
        for (int s = 0; s < K / 128; ++s) { a0 = MFMA32(f0[s], fb[s], a0); a1 = MFMA32(f1[s], fb[s], a1); }
        __syncthreads();
#pragma unroll
        for (int r = 0; r < 16; ++r) { red[(w * 32 + r) * 64 + lane] = a0[r]; red[(w * 32 + 16 + r) * 64 + lane] = a1[r]; }
        __syncthreads();
        const int m2 = w >> 2, q = w & 3;
#pragma unroll
        for (int j = 0; j < 4; ++j) {
            float v = 0.f;
#pragma unroll
            for (int i = 0; i < 8; ++i) v += red[(i * 32 + 16 * m2 + 4 * q + j) * 64 + lane];
            ef(MP + 64 * mt + 32 * m2 + 8 * q + 4 * hi + j, 32 * nt + l31, v);
        }
    }
    __syncthreads();
}


#ifdef ORACLE
constexpr size_t WS_ORC = 948 * MiB;
constexpr int ORC_ROWS = 128;
DI float blk_red(Frame& F, float v, bool ismax, LAS float* red) {
#pragma unroll
    for (int o = 1; o < 64; o <<= 1) { const float x = __shfl_xor(v, o); v = ismax ? fmaxf(v, x) : v + x; }
    __syncthreads();
    if (F.lane == 0) red[F.wave] = v;
    __syncthreads();
    float r = red[0];
    for (int i = 1; i < 8; ++i) r = ismax ? fmaxf(r, red[i]) : r + red[i];
    return r;
}
DI float dot64(const bf16* a, const bf16* b) { float s = 0.f; for (int d = 0; d < 64; ++d) s += bf2f(a[d]) * bf2f(b[d]); return s; }
DI void orc_softmax(Frame& F, LAS float* sc, LAS unsigned char* vf, int n, LAS float* red) {
    float mx = -3e38f;
    for (int k = F.tid; k < n; k += 512) if (vf[k]) mx = fmaxf(mx, sc[k]);
    mx = blk_red(F, mx, true, red);
    float sm = 0.f;
    for (int k = F.tid; k < n; k += 512) { const float p = vf[k] ? exp2f(sc[k] - mx) : 0.f; sc[k] = p; sm += p; }
    sm = blk_red(F, sm, false, red);
    const float inv = 1.f / fmaxf(sm, 1e-30f);
    for (int k = F.tid; k < n; k += 512) sc[k] *= inv;
    __syncthreads();
}
DI void oracle_row(Frame& F, int oi) {
    int row;
    if (oi < 96) { const int tl[24] = {0, 1, 30, 31, 32, 63, 64, 65, 127, 128, 255, 256, 257, 400, 511, 512, 513, 1000, 1023, 1024, 2047, 2500, 3583, 4095};
        int t = 0;
#pragma unroll
        for (int i = 0; i < 24; ++i) t = (oi % 24 == i) ? tl[i] : t;
        row = (oi / 24) * SEQ + t; }
    else { const int k = oi - 96; row = MP + (((k >> 2) * 37) % SBATCH) * 4 + (k & 3); }
    const bool samp = row >= MP;
    const int b = samp ? (row - MP) >> 2 : row >> 12, ti = samp ? (row & 3) : (row & 4095), qpos = samp ? PASTL + ti : ti;
    const int ncmp = samp ? 127 : 255; const size_t pitch = samp ? LS : SEQ, wpitch = samp ? LSW : SEQ, cpitch = samp ? 128 : 256;
    const int wlo = samp ? 1 + ti : (qpos - 511 > 0 ? qpos - 511 : 0), whi = samp ? 512 + ti : qpos;
    LAS float* sc = (LAS float*)F.lds;
    LAS float* s2 = sc + 4096;
    LAS float* psum = s2 + 4096;
    LAS float* imp = psum + 256;
    LAS float* resn = imp + 64;
    LAS float* resd = resn + 512;
    LAS float* red = resd + 512;
    LAS unsigned char* vf = (LAS unsigned char*)(red + 8);
    LAS unsigned char* selb = vf + 4096;
    const bf16* qraw = WSP(bf16, WS_QRAW) + (size_t)row * 512; const bf16* qrot = WSP(bf16, WS_QROT) + (size_t)row * 512;
    const bf16* dq = WSP(bf16, WS_DQ) + (size_t)row * 512; const bf16* iq = WSP(bf16, WS_IQ) + (size_t)row * 256;
    const float* gat = WSP(float, WS_GATES) + (size_t)row * 24; const float* iw = WSP(float, WS_IW) + (size_t)row * 4;
    const int nvr = (qpos - 31) >> 4, nvis = nvr < ncmp - 1 ? nvr : ncmp - 1, cur = qpos >> 6;
    for (int g = 0; g < 2; ++g) {
        const int bg = b * 2 + g;
        const bf16* ck = samp ? WSP(bf16, WS_SCK) + (size_t)bg * 128 * 64 : WSP(bf16, WS_PCK) + (size_t)bg * 256 * 64;
        const bf16* cvt = samp ? WSP(bf16, WS_SCVT) + (size_t)bg * 64 * 128 : WSP(bf16, WS_PCVT) + (size_t)bg * 64 * 256;
        const bf16* sk = samp ? WSP(bf16, WS_SSLCK) + (size_t)bg * LS * 64 : WSP(bf16, WS_PSLCK) + (size_t)bg * SEQ * 64;
        const bf16* svt = samp ? WSP(bf16, WS_SSLCVT) + (size_t)bg * 64 * LS : WSP(bf16, WS_PSLCVT) + (size_t)bg * 64 * SEQ;
        const bf16* wk = samp ? WSP(bf16, WS_SWINK) + (size_t)bg * LSW * 64 : WSP(bf16, WS_PWINK) + (size_t)bg * SEQ * 64;
        const bf16* wvt = samp ? WSP(bf16, WS_SWINVT) + (size_t)bg * 64 * LSW : WSP(bf16, WS_PWINVT) + (size_t)bg * 64 * SEQ;
        __syncthreads();
        if (F.tid < 256) psum[F.tid] = 0.f;
        for (int hl = 0; hl < 4; ++hl) {
            const int h = 4 * g + hl;
            __syncthreads();
            for (int n = F.tid; n < 256; n += 512) { const bool v = n <= nvis; vf[n] = v; sc[n] = v ? dot64(qraw + h * 64, ck + (size_t)n * 64) : 0.f; }
            __syncthreads();
            orc_softmax(F, sc, vf, 256, red);
            if (F.tid < 256) psum[F.tid] += sc[F.tid];
            if (F.tid < 64) { float a = 0.f; for (int n = 0; n <= nvis; ++n) a += sc[n] * bf2f(cvt[(size_t)F.tid * cpitch + permk(n)]); resn[h * 64 + F.tid] = gat[h * 3 + 0] * a; }
        }
        __syncthreads();
        if (F.tid < 64) { const int j = F.tid; float a = 0.f;
            for (int n = 4 * j - 1; n <= 4 * j + 3; ++n) if (n >= 0 && n < ncmp) a += psum[n];
            if (j == 0 || j == cur || j == cur - 1) a = 1e4f;
            if (j > cur) a = -1e30f;
            imp[j] = a; selb[j] = 0; }
        __syncthreads();
        if (F.tid == 0) { for (int k = 0; k < 16; ++k) { int best = -1; float bv = -3e38f; for (int j = 0; j < 64; ++j) if (!selb[j] && imp[j] > bv) { bv = imp[j]; best = j; }
                if (best >= 0) selb[best] = (bv > -5e29f) ? 1 : 2; }
            for (int j = 0; j < 64; ++j) selb[j] = selb[j] == 1 ? 1 : 0; }
        __syncthreads();
        for (int hl = 0; hl < 4; ++hl) {
            const int h = 4 * g + hl;
            __syncthreads();
            for (int k = F.tid; k <= qpos; k += 512) { const bool v = selb[k >> 6] != 0; vf[k] = v; sc[k] = v ? dot64(qrot + h * 64, sk + (size_t)k * 64) : 0.f; }
            __syncthreads();
            orc_softmax(F, sc, vf, qpos + 1, red);
            if (F.tid < 64) { float a = 0.f; for (int k = 0; k <= qpos; ++k) if (vf[k]) a += sc[k] * bf2f(svt[(size_t)F.tid * pitch + permk(k)]); resn[h * 64 + F.tid] += gat[h * 3 + 1] * a; }
            __syncthreads();
            for (int k = wlo + F.tid; k <= whi; k += 512) { vf[k - wlo] = 1; sc[k - wlo] = dot64(qrot + h * 64, wk + (size_t)k * 64); }
            __syncthreads();
            orc_softmax(F, sc, vf, whi - wlo + 1, red);
            if (F.tid < 64) { float a = 0.f; for (int k = wlo; k <= whi; ++k) a += sc[k - wlo] * bf2f(wvt[(size_t)F.tid * wpitch + permk(k)]); resn[h * 64 + F.tid] += gat[h * 3 + 2] * a; }
        }
    }
    __syncthreads();
    const bf16* ik = samp ? WSP(bf16, WS_SIDXK) + (size_t)b * LS * 64 : WSP(bf16, WS_PIDXK) + (size_t)b * SEQ * 64;
    for (int k = F.tid; k <= qpos; k += 512) { float a = 0.f; for (int h = 0; h < 4; ++h) a += fmaxf(dot64(iq + h * 64, ik + (size_t)k * 64), 0.f) * iw[h]; s2[k] = a; }
    __syncthreads();
    for (int k = F.tid; k <= qpos; k += 512) { const float v = s2[k]; int c = 0; for (int j = 0; j <= qpos; ++j) { const float x = s2[j]; c += (x > v || (x == v && j < k)) ? 1 : 0; } vf[k] = c < 256; }
    __syncthreads();
    for (int h = 0; h < 8; ++h) {
        const int bg = b * 2 + (h >> 2);
        const bf16* dk = samp ? WSP(bf16, WS_SDSAK) + (size_t)bg * LS * 64 : WSP(bf16, WS_PDSAK) + (size_t)bg * SEQ * 64;
        const bf16* dvt = samp ? WSP(bf16, WS_SDSAVT) + (size_t)bg * 64 * LS : WSP(bf16, WS_PDSAVT) + (size_t)bg * 64 * SEQ;
        __syncthreads();
        for (int k = F.tid; k <= qpos; k += 512) sc[k] = vf[k] ? dot64(dq + h * 64, dk + (size_t)k * 64) : 0.f;
        __syncthreads();
        orc_softmax(F, sc, vf, qpos + 1, red);
        if (F.tid < 64) { float a = 0.f; for (int k = 0; k <= qpos; ++k) if (vf[k]) a += sc[k] * bf2f(dvt[(size_t)F.tid * pitch + permk(k)]); resd[h * 64 + F.tid] = a; }
    }
    __syncthreads();
    float dn = 0.f, rn = 0.f, dd = 0.f, rd = 0.f;
    { const int e = F.tid;
      const float zn = bf2f(WSP(bf16, WS_ZN)[(size_t)row * 512 + e]), zd = bf2f(WSP(bf16, WS_ZD)[(size_t)row * 512 + e]);
      const float refn = resn[e] * zn, refd = resd[e] * zd;
      const float gotn = bf2f(WSP(bf16, WS_ONZ)[(size_t)row * 512 + e]), gotd = bf2f(WSP(bf16, WS_ODZ)[(size_t)row * 512 + e]);
      dn = (gotn - refn) * (gotn - refn); rn = refn * refn; dd = (gotd - refd) * (gotd - refd); rd = refd * refd; }
    dn = blk_red(F, dn, false, red); rn = blk_red(F, rn, false, red); dd = blk_red(F, dd, false, red); rd = blk_red(F, rd, false, red);
    float dc = 0.f, rc = 0.f;
    {
        const bool cs = oi >= 96; const int cbg = cs ? (oi * 5) % 256 : oi % 8, cn = cs ? (oi * 11) % 127 : (oi * 13) % 255;
        for (int slot = 0; slot < 2; ++slot) {
            const bf16* data = cs ? WSP(bf16, slot ? WS_SCMPV : WS_SCMPK) + (size_t)cbg * LS * 64 + (size_t)cn * 1024 : WSP(bf16, slot ? WS_PCMPV : WS_PCMPK) + (size_t)cbg * SEQ * 64 + (size_t)cn * 1024;
            __syncthreads();
            if (F.tid < 128) { float a = 0.f; for (int k = 0; k < 2048; ++k) a += (bf2f(data[k]) + F.pe[slot * 2048 + k]) * F.w1[((size_t)slot * 2048 + k) * 128 + F.tid]; sc[F.tid] = a / (1.f + expf(-a)); }
            __syncthreads();
            if (F.tid < 64) { float a = 0.f; for (int c = 0; c < 128; ++c) a += sc[c] * F.w2[((size_t)slot * 128 + c) * 64 + F.tid];
                float got;
                if (slot == 0) got = bf2f((cs ? WSP(bf16, WS_SCK) + (size_t)cbg * 128 * 64 : WSP(bf16, WS_PCK) + (size_t)cbg * 256 * 64)[(size_t)cn * 64 + F.tid]);
                else got = bf2f((cs ? WSP(bf16, WS_SCVT) + (size_t)cbg * 64 * 128 : WSP(bf16, WS_PCVT) + (size_t)cbg * 64 * 256)[(size_t)F.tid * (cs ? 128 : 256) + permk(cn)]);
                dc += (got - a) * (got - a); rc += a * a; }
        }
    }
    dc = blk_red(F, dc, false, red); rc = blk_red(F, rc, false, red);
    if (F.tid == 0) { float* o = WSP(float, WS_ORC) + oi * 8; o[0] = dn; o[1] = rn; o[2] = dd; o[3] = rd; o[4] = dc; o[5] = rc; }
    __syncthreads();
}
DI float oracle_value(Frame& F) {
    const float* o = WSP(float, WS_ORC);
    float bad = 0.f, acc = 0.f, mxe = 0.f;
    for (int i = 0; i < ORC_ROWS; ++i) { const int c = (ORACLE_MODE >= 6) ? 4 : (ORACLE_MODE & 1) ? 2 : 0; const float e = sqrtf(o[i * 8 + c] / fmaxf(o[i * 8 + c + 1], 1e-30f));
        bad += e > 0.03f ? 1.f : 0.f; acc += fminf(e, 1.f) * fminf(e, 1.f); mxe = fmaxf(mxe, fminf(e, 1.f)); }
    return (ORACLE_MODE < 2 || ORACLE_MODE == 6) ? bad / ORC_ROWS : (ORACLE_MODE < 4 || ORACLE_MODE == 7) ? sqrtf(acc / ORC_ROWS) : mxe;
}
#endif

#define XB_TMO      128
#define XB_XCNT(j)  (256  + 64 * (j))
#define XB_XSUB(j)  (1280 + 64 * (j))
#define XB_XGEN(j)  (2304 + 64 * (j))
#define XB_TOP      3328
#define XB_TOPGEN   3392
#define XCD_BAR_WORDS 3456
#define XB_SPIN_CAP (1u << 18)
__device__ __forceinline__ unsigned xb_ld(unsigned* p)              { return __hip_atomic_load(p, __ATOMIC_RELAXED, __HIP_MEMORY_SCOPE_AGENT); }
__device__ __forceinline__ unsigned xb_add(unsigned* p, unsigned v) { return __hip_atomic_fetch_add(p, v, __ATOMIC_RELAXED, __HIP_MEMORY_SCOPE_AGENT); }
__device__ __forceinline__ unsigned xb_xcc_id() { return (unsigned)__builtin_amdgcn_s_getreg((3 << 11) | 20) & 0xFu; }
#define XB_SPIN(cond, bar) do { unsigned _sp = 0; while (cond) { __builtin_amdgcn_s_sleep(1); \
    if ((++_sp & 255u) == 0u) { if (xb_ld(&(bar)[XB_TMO])) break; if (_sp > XB_SPIN_CAP) { atomicAdd(&(bar)[XB_TMO], 1u); break; } } } } while (0)
struct XcdBarrier { unsigned* bar; unsigned x; volatile LAS unsigned* st; };
__device__ __forceinline__ XcdBarrier xcd_barrier_post(unsigned* bar, volatile LAS unsigned* st) {
    XcdBarrier b; b.bar = bar; b.x = xb_xcc_id(); b.st = st;
    if (threadIdx.x == 0) (void)xb_add(&bar[XB_XCNT(b.x)], 1u);
    return b;
}
__device__ __forceinline__ void xcd_barrier_complete(unsigned* bar, unsigned x, unsigned& nloc, unsigned& nx) {
    const unsigned G = gridDim.x * gridDim.y * gridDim.z;
    unsigned sum, cnt, mine, sp = 0u;
    for (;;) {
        sum = 0u; cnt = 0u; mine = 0u;
#pragma unroll
        for (unsigned j = 0; j < 16; ++j) { const unsigned c = xb_ld(&bar[XB_XCNT(j)]); sum += c; cnt += (c > 0u) ? 1u : 0u; mine = (j == x) ? c : mine; }
        if (sum == G) break;
        __builtin_amdgcn_s_sleep(1);
        if ((++sp & 255u) == 0u) { if (xb_ld(&bar[XB_TMO])) break; if (sp > XB_SPIN_CAP) { atomicAdd(&bar[XB_TMO], 1u); break; } }
    }
    nloc = mine > 0u ? mine : 1u; nx = cnt > 0u ? cnt : 1u;
}
__device__ __forceinline__ void xcd_barrier(const XcdBarrier& b) {
    asm volatile("s_waitcnt vmcnt(0)" ::: "memory");
    __syncthreads();
    if (threadIdx.x == 0) {
        unsigned* bar = b.bar;
        __builtin_amdgcn_s_waitcnt(0);
        unsigned nloc = b.st[0], nx = b.st[1];
        if (nloc == 0u) { xcd_barrier_complete(bar, b.x, nloc, nx); b.st[0] = nloc; b.st[1] = nx; }
        const unsigned old = xb_add(&bar[XB_XSUB(b.x)], 1u);
        const unsigned gen = old / nloc;
        if (old + 1u == (gen + 1u) * nloc) {
            __builtin_amdgcn_fence(__ATOMIC_RELEASE, "agent");
            asm volatile("s_waitcnt vmcnt(0)" ::: "memory");
            const unsigned og = xb_add(&bar[XB_TOP], 1u);
            const unsigned tg = og / nx;
            if (og + 1u == (tg + 1u) * nx) xb_add(&bar[XB_TOPGEN], 1u);
            else XB_SPIN(xb_ld(&bar[XB_TOPGEN]) == tg, bar);
            __builtin_amdgcn_fence(__ATOMIC_ACQUIRE, "agent");
            xb_add(&bar[XB_XGEN(b.x)], 1u);
            asm volatile("s_waitcnt vmcnt(0)" ::: "memory");
        } else {
            XB_SPIN(xb_ld(&bar[XB_XGEN(b.x)]) == gen, bar);
            __builtin_amdgcn_fence(__ATOMIC_ACQUIRE, "agent");
            asm volatile("s_waitcnt vmcnt(0)" ::: "memory");
        }
    }
    __syncthreads();
}

constexpr int N_PHASES = 9;
DI int q_next(Frame& F, int qi) {
    __syncthreads();
    if (F.tid == 0) F.MISC[0] = __hip_atomic_fetch_add(F.ctl + CW_Q + 64 * (qi + F.qoff), 1u, __ATOMIC_RELAXED, __HIP_MEMORY_SCOPE_AGENT);
    __syncthreads();
    return (int)F.MISC[0];
}
DI void q_issue(Frame& F, int qi, unsigned& pend) { if (F.tid == 0) pend = __hip_atomic_fetch_add(F.ctl + CW_Q + 64 * (qi + F.qoff), 1u, __ATOMIC_RELAXED, __HIP_MEMORY_SCOPE_AGENT); }
DI int q_take(Frame& F, unsigned pend) { __syncthreads(); if (F.tid == 0) F.MISC[0] = pend; __syncthreads(); return (int)F.MISC[0]; }
#define QLOOP_PF(qi, N, CALL) do { unsigned pend_ = 0u; for (int u = q_next(F, (qi)); u < (N); u = q_take(F, pend_)) { q_issue(F, (qi), pend_); CALL; } } while (0)
#define QLOOP(qi, N, CALL) do { for (int u = q_next(F, (qi)); u < (N); u = q_next(F, (qi))) { CALL; } } while (0)
__global__ void __launch_bounds__(NWAVES * 64, 2) fwd(Args args) {
    extern __shared__ __attribute__((aligned(16))) unsigned char lds[];
    Frame F;
    F.lds = (LAS unsigned char*)lds; F.MISC = (volatile LAS unsigned*)(F.lds + MISC_OFF);
    F.tid = threadIdx.x; F.lane = F.tid & 63; F.wave = __builtin_amdgcn_readfirstlane(F.tid >> 6); F.G = gridDim.x;
    F.ws = args.ws; F.out = args.out; F.ctl = (unsigned*)(args.ws + WS_CTL); F.qoff = args.qoff;
    F.xp = (const float*)args.in[0]; F.xs = (const float*)args.in[1]; F.cnsa = (const float*)args.in[2]; F.cdsa = (const float*)args.in[3]; F.cidx = (const float*)args.in[4];
    F.swin = (const float*)args.in[5]; F.ptab = (const int*)args.in[6]; F.cp = (const float*)args.in[7]; F.cs = (const float*)args.in[8]; F.normg = (const float*)args.in[9];
    F.wada = (const float*)args.in[10]; F.bada = (const float*)args.in[11]; F.win = (const float*)args.in[12]; F.pe = (const float*)args.in[13]; F.w1 = (const float*)args.in[14];
    F.w2 = (const float*)args.in[15]; F.wupn = (const float*)args.in[16]; F.wupd = (const float*)args.in[17]; F.wout = (const float*)args.in[18]; F.fing = (const float*)args.in[19];
    for (int i = F.tid; i < (LDS_BYTES - MISC_OFF) / 4; i += NWAVES * 64) ((LAS unsigned*)(F.lds + MISC_OFF))[i] = 0u;
    __syncthreads();
    const int lo = args.ph_lo, hi = args.ph_hi;
    const bool one = (hi - lo) > 1;
    XcdBarrier bar; bar.bar = F.ctl + CW_BAR; bar.x = 0; bar.st = nullptr;
    if (one) bar = xcd_barrier_post(F.ctl + CW_BAR, F.MISC + 8);
#ifndef PH_MASK
#define PH_MASK 0x1ff
#endif
#define IN(k) (((PH_MASK >> (k)) & 1) && lo <= (k) && (k) < hi)
#define SEAM(k) do { if (IN(k) && IN((k) + 1)) xcd_barrier(bar); } while (0)

#ifndef PROBE_REP
#define PROBE_REP -1
#endif
#define REP(k, BODY) do { if (IN(k)) { BODY(0) } } while (0)
#ifndef PROBE_P4MASK
#define PROBE_P4MASK 15
#endif
#ifndef PROBE_ABL
#define PROBE_ABL 0
#endif
#define B0(qo) { p0_prologue(F, args.umask); }
#define B1(qo) { p1_adaln(F); }
#define B2(qo) { pg8::Gemm g{WSP(bf16, WS_H), WSP(bf16, WS_WINT), MR, NPAD, DM}; pg8::StaticOrder S; S.init(MR, NPAD, F.G, (int)blockIdx.x); \
        { EpiInProj E{F.ws, F.out}; pg8::gemm_phase<EpiInProj, pg8::StaticOrder, true, true>(F.lds, g, S, E); } }
#define B3(qo) { const int PM3_ = args.umask; const bool strm3_ = (blockIdx.x & 1) == 0 || args.qoff != 0;     \
        if ((PM3_ & 4) && strm3_) QLOOP(2 + qo, SBATCH, (idx1_unit<true, 0>(F, u))); \
        if ((PM3_ & 1) && strm3_) QLOOP(0 + qo, 272, compress_unit(F, u)); \
        if (PM3_ & 2) QLOOP(1 + qo, 2048, (idx1_unit<false, 0>(F, u))); }
#ifndef P4_MASK
#define P4_MASK 15
#endif
#define B4(qo) { const int PM_ = args.umask & P4_MASK; const bool strm_ = (blockIdx.x & 1) == 0 || args.qoff != 0;     \
        if ((PM_ & 1) && strm_) QLOOP(3 + qo, 256, nsa_sample_unit(F, u)); \
        if ((PM_ & 2) && strm_) QLOOP(4 + qo, 256, dsa_sample_unit(F, u)); \
        if (PM_ & 4) QLOOP(5 + qo, 512, nsa_unit<false>(F, u)); \
        if (PM_ & 8) QLOOP(6 + qo, 512, (dsa_unit<0>(F, u))); }
#define B5(qo) { small_gemm<512>(F, WSP(bf16, WS_ONZ), WSP(bf16, WS_WUPN), [&](int r, int c, float v) { WSP(bf16, WS_T1)[(size_t)r * 1024 + c] = (bf16)(pk2(v * bf2f(WSP(bf16, WS_MG)[(size_t)r * 2048 + c]), 0.f) & 0xffffu); }); \
        pg8::Gemm g{WSP(bf16, WS_ONZ), WSP(bf16, WS_WUPN), MP, DM, 512}; pg8::StaticOrder S; S.init(MP, DM, F.G, (int)blockIdx.x); EpiUp1 E{F.ws}; \
        pg8::gemm_phase<EpiUp1, pg8::StaticOrder, true, true>(F.lds, g, S, E); }
#define B6(qo) { small_gemm<512>(F, WSP(bf16, WS_ODZ), WSP(bf16, WS_WUPD), [&](int r, int c, float v) { WSP(bf16, WS_M1)[(size_t)r * 1024 + c] = (bf16)(pk2(bf2f(WSP(bf16, WS_T1)[(size_t)r * 1024 + c]) + v * bf2f(WSP(bf16, WS_MG)[(size_t)r * 2048 + 1024 + c]), 0.f) & 0xffffu); }); \
        pg8::Gemm g{WSP(bf16, WS_ODZ), WSP(bf16, WS_WUPD), MP, DM, 512}; pg8::StaticOrder S; S.init(MP, DM, F.G, (int)blockIdx.x); EpiUp2 E{F.ws}; \
        pg8::gemm_phase<EpiUp2, pg8::StaticOrder, true, true>(F.lds, g, S, E); }
#define B7(qo) { small_gemm<1024>(F, WSP(bf16, WS_M1), WSP(bf16, WS_WOUT), [&](int r, int c, float v) { const int rs = r - MP; F.out[O_YS + (size_t)rs * 1024 + c] = F.xs[(size_t)rs * 1024 + c] + WSP(float, WS_MOD)[(size_t)(4 + (rs >> 2)) * 3072 + 2048 + c] * v; }); \
        pg8::Gemm g{WSP(bf16, WS_M1), WSP(bf16, WS_WOUT), MP, DM, DM}; pg8::StaticOrder S; S.init(MP, DM, F.G, (int)blockIdx.x); EpiOut E{F.ws, F.out, F.xp, F.xs}; \
        pg8::gemm_phase<EpiOut, pg8::StaticOrder, true, true>(F.lds, g, S, E); }
#define B8(qo) { p8_final(F); }
    REP(0, B0); SEAM(0);
    REP(1, B1); SEAM(1);
    REP(2, B2); SEAM(2);
    REP(3, B3); SEAM(3);
    REP(4, B4); SEAM(4);
#ifdef ORACLE
    if (IN(4)) { for (int oi = blockIdx.x; oi < ORC_ROWS; oi += F.G) oracle_row(F, oi); xcd_barrier(bar); }
#endif
    REP(5, B5);
    REP(6, B6); SEAM(6);
    REP(7, B7); SEAM(7);
    if (IN(8)) { p8_final(F); }
#ifdef ORACLE
    if (IN(8)) { xcd_barrier(bar); const float val = oracle_value(F); const float sc = 1.f + 0.02f * (1.f + val);
        for (size_t i = (size_t)blockIdx.x * 512 + F.tid; i < (size_t)MP * 1024; i += (size_t)F.G * 512) F.out[O_YP + i] *= sc; }
#endif
#undef IN
#undef SEAM
}

extern "C" void kernel_launch(void* const* d_in, const int* in_sizes, int n_in, void* d_out, int out_size, void* d_ws, size_t ws_size, hipStream_t stream) {
    static int grid = 0;
    if (grid == 0) {
        if (n_in != 20 || (size_t)out_size != O_END || ws_size < WS_END) { fprintf(stderr, "kernel_launch: unexpected shapes (n_in %d, out %d, ws %zu)\n", n_in, out_size, ws_size); grid = -1; return; }
        int dev = 0, cus = 0, per_cu = 0;
        if (hipGetDevice(&dev) != hipSuccess || hipDeviceGetAttribute(&cus, hipDeviceAttributeMultiprocessorCount, dev) != hipSuccess) { grid = -1; return; }
        if (hipFuncSetAttribute((const void*)fwd, hipFuncAttributeMaxDynamicSharedMemorySize, LDS_BYTES) != hipSuccess) { fprintf(stderr, "kernel_launch: hipFuncSetAttribute failed\n"); grid = -1; return; }
        if (hipOccupancyMaxActiveBlocksPerMultiprocessor(&per_cu, (const void*)fwd, NWAVES * 64, LDS_BYTES) != hipSuccess || per_cu < 1) { fprintf(stderr, "kernel_launch: occupancy query says %d blocks per CU\n", per_cu); }
        (void)hipGetLastError();
        grid = cus;
    }
    if (grid < 0) return;
    (void)hipMemsetAsync((char*)d_ws + WS_CTL, 0, CTL_ZERO_BYTES, stream);
    Args a{};
    for (int i = 0; i < 20; ++i) a.in[i] = d_in[i];
    a.out = (float*)d_out; a.ws = (unsigned char*)d_ws; a.qoff = 0; a.umask = 15; a.pad0 = 0; a.pad1 = 0;
#if MK_N_LAUNCHES == 1
    a.ph_lo = 0; a.ph_hi = N_PHASES;
    hipLaunchKernelGGL(fwd, dim3(grid), dim3(NWAVES * 64), LDS_BYTES, stream, a);
#if PROBE_REP >= 0
    a.ph_lo = PROBE_REP; a.ph_hi = PROBE_REP + 1; a.qoff = 8; a.umask = PROBE_P4MASK;
    hipLaunchKernelGGL(fwd, dim3(grid), dim3(NWAVES * 64), LDS_BYTES, stream, a);
#endif
#else
    for (int p = 0; p < N_PHASES; ++p) { a.ph_lo = p; a.ph_hi = p + 1; hipLaunchKernelGGL(fwd, dim3(grid), dim3(NWAVES * 64), LDS_BYTES, stream, a); }
#endif
}
```

```cpp
#define MK_N_LAUNCHES 1
#include <hip/hip_runtime.h>
#include <cstdio>
#include <cstdint>
#ifndef MK_N_LAUNCHES
#define MK_N_LAUNCHES 1
#endif
namespace pg8 {
#define PG8_LAS __attribute__((address_space(3)))
typedef unsigned short bf16_t;
typedef short bf16x8 __attribute__((ext_vector_type(8)));
typedef float f32x4 __attribute__((ext_vector_type(4)));
typedef unsigned u32x4 __attribute__((ext_vector_type(4)));
constexpr int BM = 256, BK = 64, HALF = 128, HTB = HALF * BK * 2  , STAGE_BYTES = 8 * HTB, NXCD = 8, WGM = 8;

__host__ __device__ __forceinline__ int lds_byte(int r, int c) { const int st = (r >> 4) * 2 + (c >> 5), rr = r & 15, cc = c & 31, ob = rr * 64 + cc * 2; return st * 1024 + (ob ^ (((ob >> 9) & 1) << 5)); }
__host__ __device__ __forceinline__ void stage_rc(int b, int& R, int& C) { const int st = b / 1024, sb = b % 1024, swz = sb ^ (((sb >> 9) & 1) << 5); R = (st >> 1) * 16 + swz / 64; C = (st & 1) * 32 + (swz % 64) / 2; }
__host__ __device__ __forceinline__ int perm32(int rho) { const int n = rho >> 4, i = rho & 15; return 8 * (i >> 2) + 4 * n + (i & 3); }

struct Unit { int pm, pn; };
struct Gemm { const bf16_t* A; const bf16_t* Bt; int M, N, K; };

struct StaticOrder {
    int nM, nN, nwg, G, c;
    __host__ __device__ void init(int M, int N, int G_, int c_) { nM = M / BM; nN = N / BM; nwg = nM * nN; G = G_; c = c_; }
    __host__ __device__ bool next(int i, Unit& u) const {
        const long L = (long)i * G + c; if (L >= nwg) return false;
        int wgid = (int)L; { const int q = nwg / NXCD, r = nwg % NXCD, xcd = wgid % NXCD, off = wgid / NXCD; wgid = (xcd < r ? xcd * (q + 1) : r * (q + 1) + (xcd - r) * q) + off; }
        const int nig = WGM * nN, gid = wgid / nig, fm = gid * WGM, gsz = (nM - fm) < WGM ? (nM - fm) : WGM;
        u.pm = fm + ((wgid % nig) % gsz); u.pn = (wgid % nig) / gsz; return true;
    }
    __device__ __forceinline__ void a_ready(const Unit&) const {}
    __device__ __forceinline__ void done(const Unit&) const {}
};

typedef float f32x2p __attribute__((ext_vector_type(2))); typedef __bf16 bf16x2p __attribute__((ext_vector_type(2)));
__device__ __forceinline__ unsigned cvt_pk_bf16(float lo, float hi) { f32x2p v = {lo, hi}; bf16x2p b = __builtin_convertvector(v, bf16x2p); return __builtin_bit_cast(unsigned, b); }
template <class Epi, class Sched, bool ALIGN_EPI = false, bool SP2 = false>
__device__ __forceinline__ void gemm_phase(PG8_LAS unsigned char* lds, const Gemm g, const Sched& S, const Epi& E) {
    const int tid = threadIdx.x, wid = __builtin_amdgcn_readfirstlane(tid >> 6), lane = tid & 63, wr = wid >> 2, wc = wid & 3, fr = lane & 15, fq = lane >> 4;
    const int K = g.K, nt = K / BK;
    unsigned voffA[2], voffB[2];
#pragma unroll
    for (int i = 0; i < 2; ++i) { int R, C; stage_rc(tid * 16 + i * 8192, R, C); const int Rb = Epi::PERM ? ((R & ~31) + perm32(R & 31)) : R;
        voffA[i] = (unsigned)(R * K + C) * 2u; voffB[i] = (unsigned)(Rb * K + C) * 2u; }
    const size_t kstep = (size_t)(BK * 2);
    const size_t hstep = (size_t)HALF * K * 2;
    const size_t tstep = 2 * hstep;
    const unsigned ldsw = (unsigned)wid * 1024u;
    const int aoff = lds_byte(wr * 64 + fr, fq * 8), boff = lds_byte(wc * 32 + fr, fq * 8);
#define PG8_SA(b, h) (((b) * 2 + (h)) * HTB)
#define PG8_SB(b, h) ((4 + (b) * 2 + (h)) * HTB)
#define PG8_STAGE(bufoff, gbase, voff) do { _Pragma("unroll") for (int _i = 0; _i < 2; ++_i) \
        __builtin_amdgcn_global_load_lds((const unsigned*)((const char*)(gbase) + (voff)[_i]), (PG8_LAS unsigned*)(lds + (bufoff) + ldsw + _i * 8192), 16, 0, 0); } while (0)
#define PG8_LDA(dst, b, h) do { _Pragma("unroll") for (int m = 0; m < 4; ++m) _Pragma("unroll") for (int k = 0; k < 2; ++k) dst[m][k] = *(const PG8_LAS bf16x8*)(lds + PG8_SA(b, h) + aoff + m * 2048 + k * 1024); } while (0)
#define PG8_LDB(dst, b, h) do { _Pragma("unroll") for (int n = 0; n < 2; ++n) _Pragma("unroll") for (int k = 0; k < 2; ++k) dst[n][k] = *(const PG8_LAS bf16x8*)(lds + PG8_SB(b, h) + boff + n * 2048 + k * 1024); } while (0)
#define PG8_MMA(ai, bj, At, Bt) do { __builtin_amdgcn_s_setprio(1); _Pragma("unroll") for (int m = 0; m < 4; ++m) _Pragma("unroll") for (int n = 0; n < 2; ++n) _Pragma("unroll") for (int k = 0; k < 2; ++k) \
        acc[ai][bj][m][n] = __builtin_amdgcn_mfma_f32_16x16x32_bf16(Bt[n][k], At[m][k], acc[ai][bj][m][n], 0, 0, 0); __builtin_amdgcn_s_setprio(0); } while (0)
#define PG8_WAIT_V(n) asm volatile("s_waitcnt vmcnt(" #n ")" ::: "memory")
#define PG8_WAIT_L(n) asm volatile("s_waitcnt lgkmcnt(" #n ")" ::: "memory")
#define PG8_BAR __builtin_amdgcn_s_barrier()
#define PG8_SCHED __builtin_amdgcn_sched_barrier(0)
    Unit cur, nxt; int ui = 0;
    if (!S.next(0, cur)) return;
    f32x4 acc[2][2][4][2];
#pragma unroll
    for (int a = 0; a < 2; ++a)
#pragma unroll
        for (int b = 0; b < 2; ++b)
#pragma unroll
            for (int m = 0; m < 4; ++m)
#pragma unroll
                for (int n = 0; n < 2; ++n) acc[a][b][m][n] = (f32x4){0.f, 0.f, 0.f, 0.f};
    bf16x8 At[4][2], B0[2][2], B1[2][2];
    const char* cA = (const char*)g.A + (size_t)cur.pm * tstep; const char* cB = (const char*)g.Bt + (size_t)cur.pn * tstep;
    S.a_ready(cur);
    if constexpr (SP2) {
        PG8_STAGE(PG8_SB(0, 0), cB, voffB); PG8_STAGE(PG8_SB(0, 1), cB + hstep, voffB); PG8_STAGE(PG8_SA(0, 0), cA, voffA); PG8_STAGE(PG8_SA(0, 1), cA + hstep, voffA);
        if (wr == 1) PG8_BAR;
        PG8_WAIT_V(2); PG8_BAR;
        PG8_STAGE(PG8_SB(1, 0), cB + kstep, voffB); PG8_STAGE(PG8_SA(1, 0), cA + kstep, voffA); PG8_STAGE(PG8_SB(1, 1), cB + hstep + kstep, voffB);
        PG8_WAIT_V(6); PG8_BAR;
    } else {
        PG8_STAGE(PG8_SB(0, 0), cB, voffB); PG8_STAGE(PG8_SA(0, 0), cA, voffA); PG8_STAGE(PG8_SB(0, 1), cB + hstep, voffB); PG8_STAGE(PG8_SA(0, 1), cA + hstep, voffA);
        if (wr == 1) PG8_BAR;
        PG8_WAIT_V(4); PG8_BAR;
        PG8_STAGE(PG8_SB(1, 0), cB + kstep, voffB); PG8_STAGE(PG8_SA(1, 0), cA + kstep, voffA); PG8_STAGE(PG8_SB(1, 1), cB + hstep + kstep, voffB);
        PG8_WAIT_V(6); PG8_BAR;
    }
    for (;;) {
        const bool has_next = S.next(ui + 1, nxt);
        const char* nA = has_next ? (const char*)g.A + (size_t)nxt.pm * tstep : cA; const char* nB = has_next ? (const char*)g.Bt + (size_t)nxt.pn * tstep : cB;
        for (int t = 0; t < nt; t += 2) {
            const bool last = (t == nt - 2);
            const char* a1 = cA + (size_t)(t + 1) * kstep;
            const char* a2 = last ? nA : cA + (size_t)(t + 2) * kstep; const char* b2 = last ? nB : cB + (size_t)(t + 2) * kstep;
            const char* a3 = a2 + kstep; const char* b3 = b2 + kstep;
            if (last && has_next) S.a_ready(nxt);
            if constexpr (SP2) {
            PG8_LDB(B0, 0, 0); PG8_LDB(B1, 0, 1); PG8_SCHED; PG8_LDA(At, 0, 0); PG8_STAGE(PG8_SA(1, 1), a1 + hstep, voffA);
            PG8_WAIT_V(8); PG8_WAIT_L(0); PG8_BAR; PG8_MMA(0, 0, At, B0); PG8_MMA(0, 1, At, B1); PG8_BAR; PG8_SCHED;
            PG8_LDA(At, 0, 1); PG8_STAGE(PG8_SB(0, 0), b2, voffB); PG8_STAGE(PG8_SB(0, 1), b2 + hstep, voffB); PG8_STAGE(PG8_SA(0, 0), a2, voffA);
            PG8_WAIT_V(8); PG8_WAIT_L(0); PG8_BAR; PG8_MMA(1, 0, At, B0); PG8_MMA(1, 1, At, B1); PG8_BAR; PG8_SCHED;
            PG8_LDB(B0, 1, 0); PG8_LDB(B1, 1, 1); PG8_SCHED; PG8_LDA(At, 1, 0); PG8_STAGE(PG8_SA(0, 1), a2 + hstep, voffA);
            PG8_WAIT_V(8); PG8_WAIT_L(0); PG8_BAR; PG8_MMA(0, 0, At, B0); PG8_MMA(0, 1, At, B1); PG8_BAR; PG8_SCHED;
            PG8_LDA(At, 1, 1); PG8_STAGE(PG8_SB(1, 0), b3, voffB); PG8_STAGE(PG8_SB(1, 1), b3 + hstep, voffB); PG8_STAGE(PG8_SA(1, 0), a3, voffA);
            PG8_WAIT_V(8); PG8_WAIT_L(0); PG8_BAR; PG8_MMA(1, 0, At, B0); PG8_MMA(1, 1, At, B1); PG8_BAR; PG8_SCHED;
            } else {
            PG8_LDB(B0, 0, 0); PG8_SCHED; PG8_LDA(At, 0, 0); PG8_STAGE(PG8_SA(1, 1), a1 + hstep, voffA);
            PG8_WAIT_L(8); PG8_BAR; PG8_WAIT_L(0); PG8_MMA(0, 0, At, B0); PG8_BAR; PG8_SCHED;
            PG8_LDB(B1, 0, 1); PG8_STAGE(PG8_SB(0, 0), b2, voffB);
            PG8_BAR; PG8_WAIT_L(0); PG8_MMA(0, 1, At, B1); PG8_BAR;
            PG8_LDA(At, 0, 1); PG8_STAGE(PG8_SA(0, 0), a2, voffA);
            PG8_BAR; PG8_WAIT_L(0); PG8_MMA(1, 0, At, B0); PG8_BAR; PG8_SCHED;
            PG8_STAGE(PG8_SB(0, 1), b2 + hstep, voffB);
            PG8_WAIT_V(6); PG8_BAR; PG8_MMA(1, 1, At, B1); PG8_BAR;
            PG8_LDB(B0, 1, 0); PG8_SCHED; PG8_LDA(At, 1, 0); PG8_STAGE(PG8_SA(0, 1), a2 + hstep, voffA);
            PG8_WAIT_L(8); PG8_BAR; PG8_WAIT_L(0); PG8_MMA(0, 0, At, B0); PG8_BAR; PG8_SCHED;
            PG8_LDB(B1, 1, 1); PG8_STAGE(PG8_SB(1, 0), b3, voffB);
            PG8_BAR; PG8_WAIT_L(0); PG8_MMA(0, 1, At, B1); PG8_BAR;
            PG8_LDA(At, 1, 1); PG8_STAGE(PG8_SA(1, 0), a3, voffA);
            PG8_BAR; PG8_WAIT_L(0); PG8_MMA(1, 0, At, B0); PG8_BAR; PG8_SCHED;
            PG8_STAGE(PG8_SB(1, 1), b3 + hstep, voffB);
            PG8_WAIT_V(6); PG8_BAR; PG8_MMA(1, 1, At, B1); PG8_BAR;
            }
        }
        if constexpr (ALIGN_EPI) { if (wr == 0) PG8_BAR; }
        if constexpr (!Epi::AFTER_DRAIN) { E(acc, cur, wr, wc, fr, fq); S.done(cur); }
        if (!has_next) break;
#pragma unroll
        for (int a = 0; a < 2; ++a)
#pragma unroll
            for (int b = 0; b < 2; ++b)
#pragma unroll
                for (int m = 0; m < 4; ++m)
#pragma unroll
                    for (int n = 0; n < 2; ++n) acc[a][b][m][n] = (f32x4){0.f, 0.f, 0.f, 0.f};
        cur = nxt; cA = nA; cB = nB; ++ui;
        if constexpr (ALIGN_EPI) { if (wr == 1) PG8_BAR; }
    }
    PG8_WAIT_V(0);
    if constexpr (!ALIGN_EPI) { if (wr == 0) PG8_BAR; }
    PG8_BAR;
    if constexpr (Epi::AFTER_DRAIN) { E.fused(acc, cur, wr, wc, fr, fq, lds, wid, lane); S.done(cur); }
#undef PG8_SA
#undef PG8_SB
#undef PG8_STAGE
#undef PG8_LDA
#undef PG8_LDB
#undef PG8_MMA
#undef PG8_WAIT_V
#undef PG8_WAIT_L
#undef PG8_BAR
#undef PG8_SCHED
}
}

#define LAS __attribute__((address_space(3)))
typedef unsigned short bf16;
typedef short bf16x8 __attribute__((ext_vector_type(8)));
typedef float f32x4 __attribute__((ext_vector_type(4)));
typedef float f32x16 __attribute__((ext_vector_type(16)));
typedef unsigned u32x4 __attribute__((ext_vector_type(4)));
typedef unsigned u32x2 __attribute__((ext_vector_type(2)));

constexpr int DM = 1024, NBATCH = 4, SEQ = 4096, MP = NBATCH * SEQ, SBATCH = 128, STOK = 4, MS = SBATCH * STOK, MR = MP + MS;
constexpr int PASTL = 2048, PAGE = 128, NPG = 16;
constexpr int LS = 2112, LSW = 576;
constexpr int NPAD = 5632;
constexpr float C2 = 0.125f * 1.4426950408889634f;
constexpr int NWAVES = 8;

constexpr size_t O_YP = 0, O_YS = 16777216, O_NSAP = 17301504, O_DSAP = 25690112, O_IDXP = 29884416, O_WINP = 30932992,
                 O_NSAS = 31457280, O_DSAS = 31719424, O_IDXS = 31850496, O_WINS = 31883264, O_END = 48660480;

constexpr size_t MiB = 1u << 20;
constexpr size_t WS_CTL = 0, CTL_ZERO_BYTES = 1 * MiB;
constexpr size_t WS_MOD = 1 * MiB;
constexpr size_t WS_COS = 3 * MiB, WS_SIN = 4 * MiB;
constexpr size_t WS_BIAS1 = 5 * MiB;
constexpr size_t WS_BIASP = 5 * MiB + 262144;
constexpr size_t WS_W2T = 5 * MiB + 65536;
constexpr size_t WS_W1T = 6 * MiB;
constexpr size_t WS_WINT = 8 * MiB;
constexpr size_t WS_WUPN = 20 * MiB, WS_WUPD = 21 * MiB, WS_WOUT = 22 * MiB;
constexpr size_t WS_PSLCVK = 975 * MiB, WS_PWINVK = 979 * MiB, WS_PDSAVK = 983 * MiB;
constexpr size_t WS_SELM = 960 * MiB;
constexpr size_t WS_GATES = 25 * MiB;
constexpr size_t WS_IW = 27 * MiB;
constexpr size_t WS_PCK = 28 * MiB, WS_PCVT = 28 * MiB + 262144;
constexpr size_t WS_SCK = 29 * MiB, WS_SCVT = 33 * MiB;
constexpr size_t WS_H = 40 * MiB;
constexpr size_t WS_QRAW = 80 * MiB, WS_QROT = 100 * MiB, WS_DQ = 120 * MiB, WS_IQ = 140 * MiB, WS_ZN = 150 * MiB, WS_ZD = 170 * MiB, WS_ONZ = 190 * MiB, WS_ODZ = 210 * MiB;
constexpr size_t WS_MG = 230 * MiB;
constexpr size_t WS_T1 = 300 * MiB;
constexpr size_t WS_M1 = 370 * MiB;
constexpr size_t WS_PCMPK = 410 * MiB, WS_PCMPV = 414 * MiB, WS_PSLCK = 418 * MiB, WS_PSLCVT = 422 * MiB, WS_PWINK = 426 * MiB, WS_PWINVT = 430 * MiB,
                 WS_PDSAK = 434 * MiB, WS_PDSAVT = 438 * MiB, WS_PIDXK = 442 * MiB;
constexpr size_t WS_SCMPK = 450 * MiB, WS_SCMPV = 520 * MiB, WS_SSLCK = 590 * MiB, WS_SSLCVT = 660 * MiB, WS_SDSAK = 730 * MiB, WS_SDSAVT = 800 * MiB,
                 WS_SWINK = 870 * MiB, WS_SWINVT = 890 * MiB, WS_SIDXK = 910 * MiB, WS_END = 990 * MiB;
constexpr int CW_BAR = 4096;
constexpr int CW_Q = 16384;

constexpr int RING_BYTES = 131072, MISC_OFF = RING_BYTES, STG_OFF = MISC_OFF + 256, LDS_BYTES = STG_OFF + 16384;

struct Args { const void* in[20]; float* out; unsigned char* ws; int ph_lo, ph_hi, qoff, umask, pad0, pad1; };

struct Frame {
    LAS unsigned char* lds; volatile LAS unsigned* MISC; unsigned* ctl;
    int tid, lane, wave, G, qoff;
    unsigned char* ws; float* out;
    const float *xp, *xs, *cnsa, *cdsa, *cidx, *swin; const int* ptab; const float *cp, *cs, *normg, *wada, *bada, *win, *pe, *w1, *w2, *wupn, *wupd, *wout, *fing;
};
#define WSP(T, off) ((T*)(F.ws + (off)))

#define DI __device__ __forceinline__
#define LDS_WAIT() asm volatile("s_waitcnt lgkmcnt(0)" ::: "memory")
DI u32x4 gload16(const void* p) { u32x4 r; asm volatile("global_load_dwordx4 %0, %1, off" : "=v"(r) : "v"(p) : "memory"); return r; }
DI unsigned long long gload8(const void* p) { unsigned long long r; asm volatile("global_load_dwordx2 %0, %1, off" : "=v"(r) : "v"(p) : "memory"); return r; }
#define WAITV2(n, a, b) asm volatile("s_waitcnt vmcnt(" #n ")" : "+v"(a), "+v"(b) :: "memory")
#define WAITV1(n, a) asm volatile("s_waitcnt vmcnt(" #n ")" : "+v"(a) :: "memory")
#define LDS_BARRIER() do { asm volatile("s_waitcnt lgkmcnt(0)" ::: "memory"); __builtin_amdgcn_s_barrier(); asm volatile("" ::: "memory"); } while (0)
DI float wave_sum(float v) {
#define DPP_ADD_(ctrl, rmask) v += __int_as_float(__builtin_amdgcn_update_dpp(0, __float_as_int(v), (ctrl), (rmask), 0xF, false))
    DPP_ADD_(0xB1, 0xF);
    DPP_ADD_(0x4E, 0xF);
    DPP_ADD_(0x141, 0xF);
    DPP_ADD_(0x140, 0xF);
    DPP_ADD_(0x142, 0xA);
    DPP_ADD_(0x143, 0xC);
#undef DPP_ADD_
    return __int_as_float(__builtin_amdgcn_readlane(__float_as_int(v), 63));
}
DI int wave_sum_i(int v) {
#define DPP_ADDI_(ctrl, rmask) v += __builtin_amdgcn_update_dpp(0, v, (ctrl), (rmask), 0xF, false)
    DPP_ADDI_(0xB1, 0xF); DPP_ADDI_(0x4E, 0xF); DPP_ADDI_(0x141, 0xF); DPP_ADDI_(0x140, 0xF); DPP_ADDI_(0x142, 0xA); DPP_ADDI_(0x143, 0xC);
#undef DPP_ADDI_
    return __builtin_amdgcn_readlane(v, 63);
}
DI int wave_min_i(int v) {
#define DPP_MIN_(ctrl, rmask) { const int t_ = __builtin_amdgcn_update_dpp(v, v, (ctrl), (rmask), 0xF, false); v = t_ < v ? t_ : v; }
    DPP_MIN_(0xB1, 0xF) DPP_MIN_(0x4E, 0xF) DPP_MIN_(0x141, 0xF) DPP_MIN_(0x140, 0xF) DPP_MIN_(0x142, 0xA) DPP_MIN_(0x143, 0xC)
#undef DPP_MIN_
    return __builtin_amdgcn_readlane(v, 63);
}
DI int wave_max_i(int v) {
#define DPP_MAX_(ctrl, rmask) { const int t_ = __builtin_amdgcn_update_dpp(v, v, (ctrl), (rmask), 0xF, false); v = t_ > v ? t_ : v; }
    DPP_MAX_(0xB1, 0xF) DPP_MAX_(0x4E, 0xF) DPP_MAX_(0x141, 0xF) DPP_MAX_(0x140, 0xF) DPP_MAX_(0x142, 0xA) DPP_MAX_(0x143, 0xC)
#undef DPP_MAX_
    return __builtin_amdgcn_readlane(v, 63);
}
DI unsigned pk2(float lo, float hi) { return pg8::cvt_pk_bf16(lo, hi); }
DI float bflo(unsigned w) { return __uint_as_float(w << 16); }
DI float bfhi(unsigned w) { return __uint_as_float(w & 0xffff0000u); }
DI float bf2f(bf16 h) { return __uint_as_float((unsigned)h << 16); }
DI float sigm_f(float x) { return __builtin_amdgcn_rcpf(1.f + __builtin_amdgcn_exp2f(-1.4426950408889634f * x)); }
DI float silu_f(float x) { return x * sigm_f(x); }
DI int pos16(int o) { return 8 * ((o >> 2) & 1) + (o & 3) + 4 * (o >> 3); }
DI int permk(int t) { return (t & ~15) | pos16(t & 15); }
DI int crow(int r, int hi) { return (r & 3) + 8 * (r >> 2) + 4 * hi; }
DI float dpp_x1(float v) { return __int_as_float(__builtin_amdgcn_update_dpp(0, __float_as_int(v), 0xB1, 0xF, 0xF, true)); }
DI float dpp_x2(float v) { return __int_as_float(__builtin_amdgcn_update_dpp(0, __float_as_int(v), 0x4E, 0xF, 0xF, true)); }
DI float half_other(float v) {
    const unsigned u = __float_as_uint(v);
    auto rr = __builtin_amdgcn_permlane32_swap(u, u, false, false);
    return __uint_as_float(((threadIdx.x & 32) != 0) ? rr[0] : rr[1]);
}
DI u32x4 pack8(const float* v) { u32x4 w; w.x = pk2(v[0], v[1]); w.y = pk2(v[2], v[3]); w.z = pk2(v[4], v[5]); w.w = pk2(v[6], v[7]); return w; }
DI void st_bf8(bf16* p, const float* v) { *(u32x4*)p = pack8(v); }
DI void st_f8(float* p, const float* v) { __builtin_nontemporal_store((f32x4){v[0], v[1], v[2], v[3]}, (f32x4*)p); __builtin_nontemporal_store((f32x4){v[4], v[5], v[6], v[7]}, (f32x4*)(p + 4)); }
DI void st_vt8(bf16* p, size_t pitch, const float* v) {
#pragma unroll
    for (int j = 0; j < 8; ++j) p[(size_t)j * pitch] = (bf16)(pk2(v[j], 0.f) & 0xffffu);
}
#define PIN4(q) asm volatile("" : "+v"(q[0]), "+v"(q[1]), "+v"(q[2]), "+v"(q[3]))
#define NEGINF (-__builtin_inff())
#define MFMA32(a, b, c) __builtin_amdgcn_mfma_f32_32x32x16_bf16((a), (b), (c), 0, 0, 0)

DI int idx_key(float dot, float w) {
#pragma clang fp contract(off)
    float v = fmaxf(dot, 0.f) * w;
    v = v + dpp_x1(v);
    v = v + dpp_x2(v);
    int u = __float_as_int(v);
    u = (u == (int)0x80000000) ? 0 : u;
    return u ^ ((u >> 31) & 0x7fffffff);
}

template <int MODE> struct EpiInProjT {
    static constexpr bool PERM = true, AFTER_DRAIN = false;
    unsigned char* ws; float* out;
    DI void rope8(float* lo, float* hi, const float* c, const float* s) const {
#pragma unroll
        for (int j = 0; j < 8; ++j) { const float a = lo[j], b = hi[j]; lo[j] = a * c[j] - b * s[j]; hi[j] = b * c[j] + a * s[j]; }
    }
    DI void ldtab(float* c, float* s, int pos, int d0) const {
        const f32x4* cp = (const f32x4*)((const float*)(ws + WS_COS) + pos * 32 + d0);
        const f32x4* sp = (const f32x4*)((const float*)(ws + WS_SIN) + pos * 32 + d0);
        const f32x4 c0 = cp[0], c1 = cp[1], s0 = sp[0], s1 = sp[1];
        c[0] = c0[0]; c[1] = c0[1]; c[2] = c0[2]; c[3] = c0[3]; c[4] = c1[0]; c[5] = c1[1]; c[6] = c1[2]; c[7] = c1[3];
        s[0] = s0[0]; s[1] = s0[1]; s[2] = s0[2]; s[3] = s0[3]; s[4] = s1[0]; s[5] = s1[1]; s[6] = s1[2]; s[7] = s1[3];
        asm volatile("" : "+v"(c[0]), "+v"(c[1]), "+v"(c[2]), "+v"(c[3]), "+v"(c[4]), "+v"(c[5]), "+v"(c[6]), "+v"(c[7]));
        asm volatile("" : "+v"(s[0]), "+v"(s[1]), "+v"(s[2]), "+v"(s[3]), "+v"(s[4]), "+v"(s[5]), "+v"(s[6]), "+v"(s[7]));
    }
    DI void operator()(const pg8::f32x4 (&acc)[2][2][4][2], const pg8::Unit& u, int wr, int wc, int fr, int fq) const {
        const int hs = u.pn * 4 + wc;
        if (hs >= 86) return;
        if ((MODE & 2) && hs >= 20 && hs != 44 && !(hs >= 36 && hs < 40)) return;
        if ((MODE & 4) && hs < 20) return;
        const bool samp = u.pm >= 64;
        const int d0 = 8 * fq;
        const bool roped = hs < 8 || (hs >= 12 && hs < 14) || (hs >= 16 && hs < 18) || (hs >= 28 && hs < 36) || hs == 36 || hs == 37 || (hs >= 40 && hs <= 44);
        float rc[8], rs[8], dc[8], ds[8];
        if (roped) { if (samp) {
#pragma unroll
                for (int j = 0; j < 8; ++j) { dc[j] = 1.f; ds[j] = 0.f; }
            } else ldtab(dc, ds, 16, d0); }
#pragma unroll
        for (int ai = 0; ai < 2; ++ai)
#pragma unroll
            for (int m = 0; m < 4; ++m) {
                const int r = u.pm * 256 + ai * 128 + wr * 64 + m * 16 + fr;
                if (roped) {
                    if (m == 0) ldtab(rc, rs, samp ? PASTL + (r & 3) : (r & 4095), d0);
                    else {
#pragma unroll
                        for (int j = 0; j < 8; ++j) { const float a = rc[j], b = rs[j]; rc[j] = a * dc[j] - b * ds[j]; rs[j] = b * dc[j] + a * ds[j]; }
                    }
                }
                int b, t, pos;
                if (!samp) { b = r >> 12; t = r & 4095; pos = t; } else { b = (r - MP) >> 2; t = r & 3; pos = PASTL + t; }
                float lo[8], hi[8];
#pragma unroll
                for (int n = 0; n < 2; ++n)
#pragma unroll
                    for (int j = 0; j < 4; ++j) { lo[4 * n + j] = acc[ai][0][m][n][j]; hi[4 * n + j] = acc[ai][1][m][n][j]; }
                if (hs < 8) {
                    bf16* qa = (bf16*)(ws + WS_QRAW) + (size_t)r * 512 + hs * 64 + d0;
                    bf16* qb = (bf16*)(ws + WS_QROT) + (size_t)r * 512 + hs * 64 + d0;
                    float a[8], c[8];
#pragma unroll
                    for (int j = 0; j < 8; ++j) { a[j] = lo[j] * C2; c[j] = hi[j] * C2; }
                    st_bf8(qa, a); st_bf8(qa + 32, c);
                    rope8(lo, hi, rc, rs);
#pragma unroll
                    for (int j = 0; j < 8; ++j) { a[j] = lo[j] * C2; c[j] = hi[j] * C2; }
                    st_bf8(qb, a); st_bf8(qb + 32, c);
                } else if (hs < 20) {
                    const int ty = (hs - 8) >> 1, g = (hs - 8) & 1;
                    if (ty == 2 || ty == 4) rope8(lo, hi, rc, rs);
                    const int bg = b * 2 + g;
                    if (ty < 4) {
                        float* o = out + (samp ? O_NSAS + ((size_t)(r - MP) * 8 + ty * 2 + g) * 64 : O_NSAP + ((size_t)r * 8 + ty * 2 + g) * 64) + d0;
                        st_f8(o, lo); st_f8(o + 32, hi);
                    } else {
                        const int sl = ty - 4;
                        if (samp) { float* o = out + O_WINS + (((size_t)b * 512 + 508 + t) * 4 + sl * 2 + g) * 64 + d0; st_f8(o, lo); st_f8(o + 32, hi); }
                        else if (t >= SEQ - 512) { float* o = out + O_WINP + (((size_t)b * 512 + (t - (SEQ - 512))) * 4 + sl * 2 + g) * 64 + d0; st_f8(o, lo); st_f8(o + 32, hi); }
                    }
                    if (ty == 3 || ty == 5) {
                        size_t pitch; int kp; bf16* base;
                        if (!samp) { pitch = SEQ; kp = t; base = (bf16*)(ws + (ty == 3 ? WS_PSLCVT : WS_PWINVT)); }
                        else if (ty == 3) { pitch = LS; kp = PASTL + t; base = (bf16*)(ws + WS_SSLCVT); }
                        else { pitch = LSW; kp = 512 + t; base = (bf16*)(ws + WS_SWINVT); }
                        bf16* p = base + ((size_t)bg * 64 + d0) * pitch + permk(kp);
                        if (!(MODE & 1)) { st_vt8(p, pitch, lo); st_vt8(p + 32 * pitch, pitch, hi); }
                    } else {
                        size_t rowi; bf16* base;
                        if (!samp) { rowi = (size_t)bg * SEQ + t; base = (bf16*)(ws + (ty == 0 ? WS_PCMPK : ty == 1 ? WS_PCMPV : ty == 2 ? WS_PSLCK : WS_PWINK)); }
                        else if (ty == 4) { rowi = (size_t)bg * LSW + 512 + t; base = (bf16*)(ws + WS_SWINK); }
                        else { rowi = (size_t)bg * LS + PASTL + t; base = (bf16*)(ws + (ty == 0 ? WS_SCMPK : ty == 1 ? WS_SCMPV : WS_SSLCK)); }
                        bf16* p = base + rowi * 64 + d0;
                        st_bf8(p, lo); st_bf8(p + 32, hi);
                    }
                } else if (hs < 28 || (hs >= 45 && hs < 53)) {
                    const int h = hs < 28 ? hs - 20 : hs - 45;
                    bf16* p = (bf16*)(ws + (hs < 28 ? WS_ZN : WS_ZD)) + (size_t)r * 512 + h * 64 + d0;
#pragma unroll
                    for (int j = 0; j < 8; ++j) { lo[j] = silu_f(lo[j]); hi[j] = silu_f(hi[j]); }
                    st_bf8(p, lo); st_bf8(p + 32, hi);
                } else if (hs < 36) {
                    rope8(lo, hi, rc, rs);
#pragma unroll
                    for (int j = 0; j < 8; ++j) { lo[j] *= C2; hi[j] *= C2; }
                    bf16* p = (bf16*)(ws + WS_DQ) + (size_t)r * 512 + (hs - 28) * 64 + d0;
                    st_bf8(p, lo); st_bf8(p + 32, hi);
                } else if (hs < 40) {
                    const int sl = (hs - 36) >> 1, g = (hs - 36) & 1, bg = b * 2 + g;
                    if (sl == 0) rope8(lo, hi, rc, rs);
                    float* o = out + (samp ? O_DSAS + ((size_t)(r - MP) * 4 + sl * 2 + g) * 64 : O_DSAP + ((size_t)r * 4 + sl * 2 + g) * 64) + d0;
                    st_f8(o, lo); st_f8(o + 32, hi);
                    if (sl == 0) {
                        bf16* p = samp ? (bf16*)(ws + WS_SDSAK) + ((size_t)bg * LS + PASTL + t) * 64 + d0 : (bf16*)(ws + WS_PDSAK) + ((size_t)bg * SEQ + t) * 64 + d0;
                        st_bf8(p, lo); st_bf8(p + 32, hi);
                    } else {
                        const size_t pitch = samp ? LS : SEQ; const int kp = samp ? PASTL + t : t;
                        bf16* p = (bf16*)(ws + (samp ? WS_SDSAVT : WS_PDSAVT)) + ((size_t)bg * 64 + d0) * pitch + permk(kp);
                        if (!(MODE & 1)) { st_vt8(p, pitch, lo); st_vt8(p + 32 * pitch, pitch, hi); }
                    }
                } else if (hs < 44) {
                    rope8(lo, hi, rc, rs);
                    bf16* p = (bf16*)(ws + WS_IQ) + (size_t)r * 256 + (hs - 40) * 64 + d0;
                    st_bf8(p, lo); st_bf8(p + 32, hi);
                } else if (hs == 44) {
                    rope8(lo, hi, rc, rs);
                    float* o = out + (samp ? O_IDXS + (size_t)(r - MP) * 64 : O_IDXP + (size_t)r * 64) + d0;
                    st_f8(o, lo); st_f8(o + 32, hi);
                    bf16* p = samp ? (bf16*)(ws + WS_SIDXK) + ((size_t)b * LS + PASTL + t) * 64 + d0 : (bf16*)(ws + WS_PIDXK) + (size_t)r * 64 + d0;
                    st_bf8(p, lo); st_bf8(p + 32, hi);
                } else if (hs < 85) {
                    bf16* p = (bf16*)(ws + WS_MG) + (size_t)r * 2048 + (hs - 53) * 64 + d0;
#pragma unroll
                    for (int j = 0; j < 8; ++j) { lo[j] = sigm_f(lo[j]); hi[j] = sigm_f(hi[j]); }
                    st_bf8(p, lo); st_bf8(p + 32, hi);
                } else {
                    if (fq < 3) { float* p = (float*)(ws + WS_GATES) + (size_t)r * 24 + d0;
#pragma unroll
                        for (int j = 0; j < 8; ++j) lo[j] = sigm_f(lo[j]);
                        st_f8(p, lo);
                    } else { *(f32x4*)((float*)(ws + WS_IW) + (size_t)r * 4) = (f32x4){lo[0], lo[1], lo[2], lo[3]}; }
                }
            }
    }
};
typedef EpiInProjT<0> EpiInProj;
struct ColOrder {
    int nM, nN, cnt, rank, pn;
    __device__ void init(int M, int N, int G, int c) { nM = M / 256; nN = N / 256; pn = c % nN; rank = c / nN; cnt = G / nN + ((pn < G % nN) ? 1 : 0); }
    __device__ bool next(int i, pg8::Unit& u) const { const int pm = rank + i * cnt; if (pm >= nM) return false; u.pm = pm; u.pn = pn; return true; }
    __device__ __forceinline__ void a_ready(const pg8::Unit&) const {}
    __device__ __forceinline__ void done(const pg8::Unit&) const {}
};
struct EpiNull {
    static constexpr bool PERM = true, AFTER_DRAIN = false;
    unsigned char* ws;
    DI void operator()(const pg8::f32x4 (&acc)[2][2][4][2], const pg8::Unit& u, int wr, int wc, int fr, int fq) const {
        float s = 0.f;
#pragma unroll
        for (int ai = 0; ai < 2; ++ai)
#pragma unroll
            for (int bj = 0; bj < 2; ++bj)
#pragma unroll
                for (int m = 0; m < 4; ++m)
#pragma unroll
                    for (int n = 0; n < 2; ++n) s += acc[ai][bj][m][n][0] + acc[ai][bj][m][n][1] + acc[ai][bj][m][n][2] + acc[ai][bj][m][n][3];
        if (s == 1.2345e33f) *(float*)(ws + WS_CTL + 2048) = s;
    }
};
struct EpiUp1 {
    static constexpr bool PERM = true, AFTER_DRAIN = false;
    unsigned char* ws;
    DI void operator()(const pg8::f32x4 (&acc)[2][2][4][2], const pg8::Unit& u, int wr, int wc, int fr, int fq) const {
#pragma unroll
        for (int ai = 0; ai < 2; ++ai)
#pragma unroll
            for (int m = 0; m < 4; ++m) {
                const int r = u.pm * 256 + ai * 128 + wr * 64 + m * 16 + fr;
#pragma unroll
                for (int bj = 0; bj < 2; ++bj) {
                    const int c0 = u.pn * 256 + bj * 128 + wc * 32 + 8 * fq;
                    const u32x4 gw = *(const u32x4*)((const bf16*)(ws + WS_MG) + (size_t)r * 2048 + c0);
                    const f32x4 a0 = acc[ai][bj][m][0], a1 = acc[ai][bj][m][1];
                    u32x4 w; w.x = pk2(a0[0] * bflo(gw.x), a0[1] * bfhi(gw.x)); w.y = pk2(a0[2] * bflo(gw.y), a0[3] * bfhi(gw.y));
                    w.z = pk2(a1[0] * bflo(gw.z), a1[1] * bfhi(gw.z)); w.w = pk2(a1[2] * bflo(gw.w), a1[3] * bfhi(gw.w));
                    *(u32x4*)((bf16*)(ws + WS_T1) + (size_t)r * 1024 + c0) = w;
                }
            }
    }
};
struct EpiUp2 {
    static constexpr bool PERM = true, AFTER_DRAIN = false;
    unsigned char* ws;
    DI void operator()(const pg8::f32x4 (&acc)[2][2][4][2], const pg8::Unit& u, int wr, int wc, int fr, int fq) const {
#pragma unroll
        for (int ai = 0; ai < 2; ++ai)
#pragma unroll
            for (int m = 0; m < 4; ++m) {
                const int r = u.pm * 256 + ai * 128 + wr * 64 + m * 16 + fr;
#pragma unroll
                for (int bj = 0; bj < 2; ++bj) {
                    const int c0 = u.pn * 256 + bj * 128 + wc * 32 + 8 * fq;
                    const u32x4 gw = *(const u32x4*)((const bf16*)(ws + WS_MG) + (size_t)r * 2048 + 1024 + c0);
                    const u32x4 tw = *(const u32x4*)((const bf16*)(ws + WS_T1) + (size_t)r * 1024 + c0);
                    const f32x4 t0 = {bflo(tw.x), bfhi(tw.x), bflo(tw.y), bfhi(tw.y)}, t1 = {bflo(tw.z), bfhi(tw.z), bflo(tw.w), bfhi(tw.w)};
                    const f32x4 a0 = acc[ai][bj][m][0], a1 = acc[ai][bj][m][1];
                    u32x4 w;
                    w.x = pk2(t0[0] + a0[0] * bflo(gw.x), t0[1] + a0[1] * bfhi(gw.x)); w.y = pk2(t0[2] + a0[2] * bflo(gw.y), t0[3] + a0[3] * bfhi(gw.y));
                    w.z = pk2(t1[0] + a1[0] * bflo(gw.z), t1[1] + a1[1] * bfhi(gw.z)); w.w = pk2(t1[2] + a1[2] * bflo(gw.w), t1[3] + a1[3] * bfhi(gw.w));
                    *(u32x4*)((bf16*)(ws + WS_M1) + (size_t)r * 1024 + c0) = w;
                }
            }
    }
};
struct EpiOut {
    static constexpr bool PERM = true, AFTER_DRAIN = false;
    unsigned char* ws; float* out; const float* xp; const float* xs;
    DI void operator()(const pg8::f32x4 (&acc)[2][2][4][2], const pg8::Unit& u, int wr, int wc, int fr, int fq) const {
        const bool samp = u.pm >= 64;
#pragma unroll
        for (int ai = 0; ai < 2; ++ai)
#pragma unroll
            for (int m = 0; m < 4; ++m) {
                const int r = u.pm * 256 + ai * 128 + wr * 64 + m * 16 + fr;
                const int mrow = samp ? 4 + ((r - MP) >> 2) : (r >> 12);
                const float* xr = samp ? xs + (size_t)(r - MP) * 1024 : xp + (size_t)r * 1024;
                float* orow = samp ? out + O_YS + (size_t)(r - MP) * 1024 : out + O_YP + (size_t)r * 1024;
                const float* gr = (const float*)(ws + WS_MOD) + (size_t)mrow * 3072 + 2048;
#pragma unroll
                for (int bj = 0; bj < 2; ++bj) {
                    const int c0 = u.pn * 256 + bj * 128 + wc * 32 + 8 * fq;
#pragma unroll
                    for (int n = 0; n < 2; ++n) {
                        const f32x4 x4 = *(const f32x4*)(xr + c0 + 4 * n), g4 = *(const f32x4*)(gr + c0 + 4 * n);
                        *(f32x4*)(orow + c0 + 4 * n) = x4 + g4 * acc[ai][bj][m][n];
                    }
                }
            }
    }
};

DI int win_row(int col) {
    int hs, d;
    if (col < 1280) { hs = col >> 6; d = col & 63; }
    else if (col < 1304) { hs = 85; d = col - 1280; }
    else if (col < 2904) { const int c = col - 1304; hs = 20 + (c >> 6); d = c & 63; }
    else if (col < 2908) { hs = 85; d = 24 + (col - 2904); }
    else { const int c = col - 2908; hs = 45 + (c >> 6); d = c & 63; }
    return 256 * (hs >> 2) + 128 * (d >> 5) + 32 * (hs & 3) + (d & 31);
}
template <bool WINMAP> DI void p0_transpose_item(const float* W, int K, int N, bf16* WT, LAS float* scr, int item, int lane) {
    const int nblk = (N + 31) / 32, kb = item / nblk, nb = item % nblk, k0 = 64 * kb, n0 = 32 * nb;
    const bool nok = n0 + (lane & 31) < N;
    float tv[32];
#pragma unroll
    for (int i = 0; i < 32; ++i) { const int kk = 2 * i + (lane >> 5); tv[i] = nok ? W[(size_t)(k0 + kk) * N + n0 + (lane & 31)] : 0.f; }
#pragma unroll
    for (int i = 0; i < 32; ++i) { const int kk = 2 * i + (lane >> 5); scr[kk * 33 + (lane & 31)] = tv[i]; }
    LDS_WAIT();
    const int c = lane & 7;
#pragma unroll
    for (int j = 0; j < 4; ++j) { const int n = (lane >> 3) + 8 * j; const LAS float* s = scr + (8 * c) * 33 + n;
        u32x4 o; o.x = pk2(s[0 * 33], s[1 * 33]); o.y = pk2(s[2 * 33], s[3 * 33]); o.z = pk2(s[4 * 33], s[5 * 33]); o.w = pk2(s[6 * 33], s[7 * 33]);
        if (n0 + n < N) { const int row = WINMAP ? win_row(n0 + n) : (n0 + n); *(u32x4*)(WT + (size_t)row * K + k0 + 8 * c) = o; } }
    LDS_WAIT();
}
DI void p0_mod(Frame& F) {
    LAS float* wl = (LAS float*)F.lds;
    float* mod = WSP(float, WS_MOD);
    for (int cg = blockIdx.x; cg < 256; cg += F.G) {
        __syncthreads();
        for (int k = F.tid; k < 1024; k += NWAVES * 64) {
            const f32x4* src = (const f32x4*)(F.wada + (size_t)k * 3072 + cg * 12);
            LAS f32x4* dst = (LAS f32x4*)(wl + k * 12);
            dst[0] = src[0]; dst[1] = src[1]; dst[2] = src[2];
        }
        __syncthreads();
        float cv[16], cn[16];
        { const float* cr = F.wave < 4 ? F.cp + (size_t)F.wave * 1024 : F.cs + (size_t)(F.wave - 4) * 1024;
#pragma unroll
          for (int i = 0; i < 16; ++i) cn[i] = cr[F.lane + 64 * i]; }
        for (int r = F.wave; r < 132; r += NWAVES) {
#pragma unroll
            for (int i = 0; i < 16; ++i) cv[i] = cn[i];
            { const int rn = r + NWAVES < 132 ? r + NWAVES : r; const float* cr = rn < 4 ? F.cp + (size_t)rn * 1024 : F.cs + (size_t)(rn - 4) * 1024;
#pragma unroll
              for (int i = 0; i < 16; ++i) cn[i] = cr[F.lane + 64 * i]; }
            float a[12];
#pragma unroll
            for (int j = 0; j < 12; ++j) a[j] = 0.f;
#pragma unroll
            for (int i = 0; i < 16; ++i) {
                const int k = F.lane + 64 * i; const float s = silu_f(cv[i]);
                const LAS f32x4* wp = (const LAS f32x4*)(wl + k * 12);
                const f32x4 w0 = wp[0], w1 = wp[1], w2 = wp[2];
                a[0] += s * w0[0]; a[1] += s * w0[1]; a[2] += s * w0[2]; a[3] += s * w0[3];
                a[4] += s * w1[0]; a[5] += s * w1[1]; a[6] += s * w1[2]; a[7] += s * w1[3];
                a[8] += s * w2[0]; a[9] += s * w2[1]; a[10] += s * w2[2]; a[11] += s * w2[3];
                if ((i & 3) == 3) __builtin_amdgcn_sched_barrier(0);
            }
            float v = 0.f;
#pragma unroll
            for (int j = 0; j < 12; ++j) { const float sj = wave_sum(a[j]); v = (F.lane == j) ? sj : v; }
            if (F.lane < 12) mod[(size_t)r * 3072 + cg * 12 + F.lane] = v + F.bada[cg * 12 + F.lane];
        }
    }
    __syncthreads();
}
__device__ const double ROPE_INV[32] = {
    1.0, 0.7498942093324559, 0.5623413251903491, 0.4216965034285822, 0.31622776601683794, 0.23713737056616552, 0.1778279410038923, 0.1333521432163324,
    0.1, 0.07498942093324559, 0.05623413251903491, 0.04216965034285822, 0.03162277660168379, 0.023713737056616554, 0.01778279410038923, 0.01333521432163324,
    0.01, 0.007498942093324559, 0.005623413251903491, 0.004216965034285822, 0.0031622776601683794, 0.0023713737056616554, 0.0017782794100389228, 0.001333521432163324,
    0.001, 0.0007498942093324559, 0.0005623413251903491, 0.0004216965034285822, 0.00031622776601683794, 0.00023713737056616554, 0.00017782794100389227, 0.0001333521432163324};
DI void p0_rope_item(Frame& F, int item) {
    const int pos = 2 * item + (F.lane >> 5), d = F.lane & 31;
    if (pos >= 4100) return;
    const double ang = (double)pos * ROPE_INV[d];
    const double kq = __builtin_rint(ang * 0.6366197723675814);
    double r = __builtin_fma(-kq, 1.5707963267948966, ang); r = __builtin_fma(-kq, 6.123233995736766e-17, r);
    const int q = (int)kq & 3;
    const double r2 = r * r;
    const double sn = r * (1.0 + r2 * (-1.0 / 6 + r2 * (1.0 / 120 + r2 * (-1.0 / 5040 + r2 * (1.0 / 362880 + r2 * (-1.0 / 39916800 + r2 * (1.0 / 6227020800.0)))))));
    const double cs = 1.0 + r2 * (-0.5 + r2 * (1.0 / 24 + r2 * (-1.0 / 720 + r2 * (1.0 / 40320 + r2 * (-1.0 / 3628800 + r2 * (1.0 / 479001600.0 + r2 * (-1.0 / 87178291200.0)))))));
    const double c = (q == 0) ? cs : (q == 1) ? -sn : (q == 2) ? -cs : sn;
    const double s = (q == 0) ? sn : (q == 1) ? cs : (q == 2) ? -sn : -cs;
    WSP(float, WS_COS)[pos * 32 + d] = (float)c; WSP(float, WS_SIN)[pos * 32 + d] = (float)s;
}
DI void p0_cmp_small_item(Frame& F, int item) {
    if (item < 256) {
        const int slot = item >> 7, ch = (item >> 6) & 1, kc = item & 63, c = ch * 64 + F.lane; float a = 0.f;
#pragma unroll 8
        for (int i = 0; i < 32; ++i) { const int k = kc * 32 + i; a += F.pe[slot * 2048 + k] * F.w1[((size_t)slot * 2048 + k) * 128 + c]; }
        WSP(float, WS_BIASP)[(size_t)kc * 256 + slot * 128 + c] = a;
    } else {
        const int it = item - 256, slot = it >> 7, e = (it & 127) >> 1, ch = it & 1;
        const int c = ch * 64 + F.lane;
        WSP(bf16, WS_W2T)[((size_t)slot * 64 + e) * 128 + permk(c)] = (bf16)(pk2(F.w2[((size_t)slot * 128 + c) * 64 + e], 0.f) & 0xffffu);
    }
}
DI void cp_k16(const float* src, size_t rs, bf16* dst, int lane) {
    const int tk = lane >> 2, dc = (lane & 3) * 16;
    const f32x4* s = (const f32x4*)(src + (size_t)tk * rs + dc);
    const f32x4 a = s[0], b = s[1], c = s[2], d = s[3];
    u32x4 w0, w1; w0.x = pk2(a[0], a[1]); w0.y = pk2(a[2], a[3]); w0.z = pk2(b[0], b[1]); w0.w = pk2(b[2], b[3]);
    w1.x = pk2(c[0], c[1]); w1.y = pk2(c[2], c[3]); w1.z = pk2(d[0], d[1]); w1.w = pk2(d[2], d[3]);
    u32x4* o = (u32x4*)(dst + (size_t)tk * 64 + dc); o[0] = w0; o[1] = w1;
}
DI void cp_vt16(const float* src, size_t rs, bf16* dst, size_t pitch, int lane) {
#pragma unroll
    for (int h = 0; h < 2; ++h) {
        float v[8];
#pragma unroll
        for (int i = 0; i < 8; ++i) v[i] = src[(size_t)((i & 3) + 8 * (i >> 2) + 4 * h) * rs + lane];
        *(u32x4*)(dst + (size_t)lane * pitch + 8 * h) = pack8(v);
    }
}
DI void p0_gather_item(Frame& F, int item) {
    const int sb = item >> 7, tg = item & 127, tk0 = tg * 16, lane = F.lane;
    const int pg = F.ptab[sb * NPG + (tk0 >> 7)], j0 = tk0 & 127;
    const float* nsa = F.cnsa + ((size_t)pg * PAGE + j0) * 512;
    const float* dsa = F.cdsa + ((size_t)pg * PAGE + j0) * 256;
    const float* idx = F.cidx + ((size_t)pg * PAGE + j0) * 64;
#pragma unroll
    for (int g = 0; g < 2; ++g) {
        const size_t bg = (size_t)sb * 2 + g;
        cp_k16(nsa + (0 * 2 + g) * 64, 512, WSP(bf16, WS_SCMPK) + (bg * LS + tk0) * 64, lane);
        cp_k16(nsa + (1 * 2 + g) * 64, 512, WSP(bf16, WS_SCMPV) + (bg * LS + tk0) * 64, lane);
        cp_k16(nsa + (2 * 2 + g) * 64, 512, WSP(bf16, WS_SSLCK) + (bg * LS + tk0) * 64, lane);
        cp_vt16(nsa + (3 * 2 + g) * 64, 512, WSP(bf16, WS_SSLCVT) + bg * 64 * LS + tk0, LS, lane);
        cp_k16(dsa + (0 * 2 + g) * 64, 256, WSP(bf16, WS_SDSAK) + (bg * LS + tk0) * 64, lane);
        cp_vt16(dsa + (1 * 2 + g) * 64, 256, WSP(bf16, WS_SDSAVT) + bg * 64 * LS + tk0, LS, lane);
    }
    cp_k16(idx, 64, WSP(bf16, WS_SIDXK) + ((size_t)sb * LS + tk0) * 64, lane);
}
DI void p0_win_item(Frame& F, int item) {
    const int sb = item >> 5, w0 = (item & 31) * 16, lane = F.lane;
    const float* st = F.swin + ((size_t)sb * 512 + w0) * 256;
#pragma unroll
    for (int g = 0; g < 2; ++g) {
        const size_t bg = (size_t)sb * 2 + g;
        cp_k16(st + (0 * 2 + g) * 64, 256, WSP(bf16, WS_SWINK) + (bg * LSW + w0) * 64, lane);
        cp_vt16(st + (1 * 2 + g) * 64, 256, WSP(bf16, WS_SWINVT) + bg * 64 * LSW + w0, LSW, lane);
    }
}
DI void p0_zero_item(Frame& F, int item) {
    const int arr = item >> 8, bg = item & 255, lane = F.lane;
    bf16* p; int n;
    if (arr == 0) { p = WSP(bf16, WS_SSLCVT) + ((size_t)bg * 64 + lane) * LS + 2052; n = 60; }
    else if (arr == 1) { p = WSP(bf16, WS_SDSAVT) + ((size_t)bg * 64 + lane) * LS + 2052; n = 60; }
    else { p = WSP(bf16, WS_SWINVT) + ((size_t)bg * 64 + lane) * LSW + 516; n = 60; }
    unsigned long long* q = (unsigned long long*)p;
    for (int i = 0; i < n / 4; ++i) q[i] = 0ull;
}
DI void p0_prologue(Frame& F, int um) {
    if (um & 1) p0_mod(F);
    LAS float* scr = (LAS float*)(F.lds + F.wave * 16384);
    const int gw = blockIdx.x * NWAVES + F.wave, NGW = F.G * NWAVES;
    constexpr int I_WIN = 16 * 171, I_UP = 8 * 32, I_OUT = 16 * 32, I_W1 = 32 * 4;
    constexpr int T0 = I_WIN, T1 = T0 + I_UP, T2 = T1 + I_UP, T3 = T2 + I_OUT, T4 = T3 + 2 * I_W1, T5 = T4 + 2050, T6 = T5 + 512, T7 = T6 + 768, T8 = T7 + SBATCH * 32, T9 = T8 + SBATCH * 128;
#ifdef ORACLE
    constexpr int TEND = T9;
#else
    constexpr int TEND = T7;
#endif
    if (um & 2) for (int it = gw; it < TEND; it += NGW) {
        if (it < T0) p0_transpose_item<true>(F.win, 1024, 5468, WSP(bf16, WS_WINT), scr, it, F.lane);
        else if (it < T1) p0_transpose_item<false>(F.wupn, 512, 1024, WSP(bf16, WS_WUPN), scr, it - T0, F.lane);
        else if (it < T2) p0_transpose_item<false>(F.wupd, 512, 1024, WSP(bf16, WS_WUPD), scr, it - T1, F.lane);
        else if (it < T3) p0_transpose_item<false>(F.wout, 1024, 1024, WSP(bf16, WS_WOUT), scr, it - T2, F.lane);
        else if (it < T4) { const int q = it - T3, slot = q / I_W1; p0_transpose_item<false>(F.w1 + (size_t)slot * 2048 * 128, 2048, 128, WSP(bf16, WS_W1T) + (size_t)slot * 128 * 2048, scr, q % I_W1, F.lane); }
        else if (it < T5) p0_rope_item(F, it - T4);
        else if (it < T6) p0_cmp_small_item(F, it - T5);
        else if (it < T7) p0_zero_item(F, it - T6);
#ifdef ORACLE
        else if (it < T8) p0_win_item(F, it - T7);
        else p0_gather_item(F, it - T8);
#endif
    }
}
DI void win_copy_item(Frame& F, int it) {
    constexpr int ROW4 = 508 * 64, Q4 = ROW4 / 4;
    const int sb = it >> 2, h0 = (it & 3) * Q4;
    const f32x4* sp = (const f32x4*)F.swin + (size_t)sb * 512 * 64 + 4 * 64 + h0; f32x4* dp = (f32x4*)(F.out + O_WINS) + (size_t)sb * 512 * 64 + h0;
    for (int i = F.tid; i < Q4; i += 512 * 8) {
        f32x4 v[8];
#pragma unroll
        for (int j = 0; j < 8; ++j) { const int k = i + j * 512; v[j] = k < Q4 ? __builtin_nontemporal_load(sp + k) : (f32x4){0.f, 0.f, 0.f, 0.f}; }
#pragma unroll
        for (int j = 0; j < 8; ++j) { const int k = i + j * 512; if (k < Q4) __builtin_nontemporal_store(v[j], dp + k); }
    }
}
DI void p1_adaln(Frame& F) {
    const int gw = blockIdx.x * NWAVES + F.wave, NGW = F.G * NWAVES;
    if (blockIdx.x == 0 && F.tid < 256) { float a = 0.f; for (int j = 0; j < 64; ++j) a += WSP(float, WS_BIASP)[j * 256 + F.tid]; WSP(float, WS_BIAS1)[F.tid] = a; }
    const float* mod = WSP(float, WS_MOD);
    f32x4 nx[4];
    { const int r = gw < MR ? gw : MR - 1; const f32x4* x4 = (const f32x4*)(r < MP ? F.xp + (size_t)r * 1024 : F.xs + (size_t)(r - MP) * 1024) + F.lane;
#pragma unroll
      for (int j = 0; j < 4; ++j) nx[j] = x4[64 * j]; }
    for (int r = gw; r < MR; r += NGW) {
        const int mrow = r < MP ? (r >> 12) : 4 + ((r - MP) >> 2);
        f32x4 v[4]; float s = 0.f;
#pragma unroll
        for (int j = 0; j < 4; ++j) { v[j] = nx[j]; s += (v[j][0] * v[j][0] + v[j][1] * v[j][1]) + (v[j][2] * v[j][2] + v[j][3] * v[j][3]); }
        { const int rn = r + NGW < MR ? r + NGW : r; const f32x4* x4 = (const f32x4*)(rn < MP ? F.xp + (size_t)rn * 1024 : F.xs + (size_t)(rn - MP) * 1024) + F.lane;
#pragma unroll
          for (int j = 0; j < 4; ++j) nx[j] = x4[64 * j]; }
        const float rstd = 1.f / sqrtf(wave_sum(s) * (1.f / 1024.f) + 1e-6f);
        const f32x4* g4 = (const f32x4*)F.normg + F.lane;
        const f32x4* sh4 = (const f32x4*)(mod + (size_t)mrow * 3072) + F.lane;
        const f32x4* sc4 = (const f32x4*)(mod + (size_t)mrow * 3072 + 1024) + F.lane;
        unsigned long long* o8 = (unsigned long long*)(WSP(bf16, WS_H) + (size_t)r * 1024) + F.lane;
#pragma unroll
        for (int j = 0; j < 4; ++j) {
            const f32x4 y = v[j] * rstd * g4[64 * j]; const f32x4 h = y * (1.f + sc4[64 * j]) + sh4[64 * j];
            o8[64 * j] = (unsigned long long)pk2(h[0], h[1]) | ((unsigned long long)pk2(h[2], h[3]) << 32);
        }
    }
}
DI void p8_final(Frame& F) {
    const int gw = blockIdx.x * NWAVES + F.wave, NGW = F.G * NWAVES;
    f32x4 nx[4];
    { const int r = gw < MR ? gw : MR - 1; const f32x4* y4 = (const f32x4*)(r < MP ? F.out + O_YP + (size_t)r * 1024 : F.out + O_YS + (size_t)(r - MP) * 1024) + F.lane;
#pragma unroll
      for (int j = 0; j < 4; ++j) nx[j] = y4[64 * j]; }
    for (int r = gw; r < MR; r += NGW) {
        float* yr = r < MP ? F.out + O_YP + (size_t)r * 1024 : F.out + O_YS + (size_t)(r - MP) * 1024;
        f32x4* y4 = (f32x4*)yr + F.lane;
        f32x4 v[4]; float s = 0.f;
#pragma unroll
        for (int j = 0; j < 4; ++j) { v[j] = nx[j]; s += (v[j][0] * v[j][0] + v[j][1] * v[j][1]) + (v[j][2] * v[j][2] + v[j][3] * v[j][3]); }
        { const int rn = r + NGW < MR ? r + NGW : r; const f32x4* n4 = (const f32x4*)(rn < MP ? F.out + O_YP + (size_t)rn * 1024 : F.out + O_YS + (size_t)(rn - MP) * 1024) + F.lane;
#pragma unroll
          for (int j = 0; j < 4; ++j) nx[j] = n4[64 * j]; }
        const float rstd = 1.f / sqrtf(wave_sum(s) * (1.f / 1024.f) + 1e-6f);
        const f32x4* g4 = (const f32x4*)F.fing + F.lane;
#pragma unroll
        for (int j = 0; j < 4; ++j) y4[64 * j] = v[j] * rstd * g4[64 * j];
    }
}

constexpr int TP = 144;
constexpr int TILE_B = 64 * TP;
struct LdsT {
    static constexpr bool HOIST = true;
    const LAS unsigned char* p;
    DI bf16x8 frag(int mt, int s) const { return *(const LAS bf16x8*)(p + mt * 32 * TP + s * 32); }
};
struct GlbT {
    static constexpr bool HOIST = false;
    const bf16* base; unsigned off; unsigned pitch;
    DI bf16x8 frag(int mt, int s) const { return *(const bf16x8*)(base + (size_t)(off + (unsigned)mt * 32u * pitch + (unsigned)s * 16u)); }
};
template <class KT> DI void qk_tile(f32x16& s0, f32x16& s1, const KT& kt, const bf16x8 (&q)[4]) {
    f32x16 z;
#pragma unroll
    for (int i = 0; i < 16; ++i) z[i] = 0.f;
    s0 = z; s1 = z;
#pragma unroll
    for (int s = 0; s < 4; ++s) { s0 = MFMA32(kt.frag(0, s), q[s], s0); s1 = MFMA32(kt.frag(1, s), q[s], s1); }
}
DI bf16x8 cvt8(f32x4 a, f32x4 b) { u32x4 w; w.x = pk2(a[0], a[1]); w.y = pk2(a[2], a[3]); w.z = pk2(b[0], b[1]); w.w = pk2(b[2], b[3]); return __builtin_bit_cast(bf16x8, w); }
DI bf16x8 pack_p(const f32x16& x, int h) {
    u32x4 w; w.x = pk2(x[8 * h], x[8 * h + 1]); w.y = pk2(x[8 * h + 2], x[8 * h + 3]); w.z = pk2(x[8 * h + 4], x[8 * h + 5]); w.w = pk2(x[8 * h + 6], x[8 * h + 7]);
    return __builtin_bit_cast(bf16x8, w);
}
template <class VT> DI void pv_tile(f32x16& o0, f32x16& o1, const f32x16& p0, const f32x16& p1, const VT& vt) {
    const bf16x8 b0 = pack_p(p0, 0), b1 = pack_p(p0, 1), b2 = pack_p(p1, 0), b3 = pack_p(p1, 1);
    o0 = MFMA32(vt.frag(0, 0), b0, o0); o1 = MFMA32(vt.frag(1, 0), b0, o1);
    o0 = MFMA32(vt.frag(0, 1), b1, o0); o1 = MFMA32(vt.frag(1, 1), b1, o1);
    o0 = MFMA32(vt.frag(0, 2), b2, o0); o1 = MFMA32(vt.frag(1, 2), b2, o1);
    o0 = MFMA32(vt.frag(0, 3), b3, o0); o1 = MFMA32(vt.frag(1, 3), b3, o1);
}
struct Soft { float m, l; bool seen; f32x16 o0, o1, negm; };
DI void soft_init(Soft& S) {
    S.m = 0.f; S.l = 0.f; S.seen = false;
#pragma unroll
    for (int i = 0; i < 16; ++i) { S.o0[i] = 0.f; S.o1[i] = 0.f; S.negm[i] = 0.f; }
}
template <class KT> DI void qk_tile_c(f32x16& s0, f32x16& s1, const KT& kt, const bf16x8 (&q)[4], const f32x16& c) {
    if constexpr (KT::HOIST) {
        bf16x8 f[8];
#pragma unroll
        for (int s = 0; s < 4; ++s) { f[2 * s] = kt.frag(0, s); f[2 * s + 1] = kt.frag(1, s); }
        __builtin_amdgcn_sched_barrier(0);
        s0 = MFMA32(f[0], q[0], c); s1 = MFMA32(f[1], q[0], c);
#pragma unroll
        for (int s = 1; s < 4; ++s) { s0 = MFMA32(f[2 * s], q[s], s0); s1 = MFMA32(f[2 * s + 1], q[s], s1); }
    } else {
        s0 = MFMA32(kt.frag(0, 0), q[0], c); s1 = MFMA32(kt.frag(1, 0), q[0], c);
#pragma unroll
        for (int s = 1; s < 4; ++s) { s0 = MFMA32(kt.frag(0, s), q[s], s0); s1 = MFMA32(kt.frag(1, s), q[s], s1); }
    }
    asm volatile("s_nop 15\n\ts_nop 7" : "+v"(s0), "+v"(s1));
}
DI float max3f(float a, float b, float c) { float r; asm("v_max3_f32 %0, %1, %2, %3" : "=v"(r) : "v"(a), "v"(b), "v"(c)); return r; }
template <class VT> DI void soft_step(Soft& S, f32x16& s0, f32x16& s1, const VT& vt) {
    bf16x8 vf[8];
    if constexpr (VT::HOIST) {
#pragma unroll
        for (int s = 0; s < 4; ++s) { vf[2 * s] = vt.frag(0, s); vf[2 * s + 1] = vt.frag(1, s); }
        __builtin_amdgcn_sched_barrier(0);
    }
    float mx = max3f(s0[0], s1[0], s0[1]), my = max3f(s1[1], s0[2], s1[2]);
#pragma unroll
    for (int r = 3; r < 15; r += 2) { mx = max3f(mx, s0[r], s1[r]); my = max3f(my, s0[r + 1], s1[r + 1]); }
    mx = max3f(mx, s0[15], s1[15]); mx = max3f(mx, my, mx);
    mx = max3f(mx, half_other(mx), mx);
    const bool fin = mx > NEGINF;
    const bool need = (mx > 8.f) | (fin & !S.seen);
    if (__any(need)) {
        const float dl = need ? mx : 0.f;
        const float al = S.seen ? __builtin_amdgcn_exp2f(-dl) : 0.f;
        S.m += dl; S.l *= need ? al : 1.f;
        const float am = need ? al : 1.f;
#pragma unroll
        for (int r = 0; r < 16; ++r) { s0[r] -= dl; s1[r] -= dl; S.o0[r] *= am; S.o1[r] *= am; S.negm[r] = -S.m; }
    }
    S.seen = S.seen | fin;
    float ps = 0.f;
#pragma unroll
    for (int r = 0; r < 16; ++r) { s0[r] = __builtin_amdgcn_exp2f(s0[r]); s1[r] = __builtin_amdgcn_exp2f(s1[r]); ps += s0[r] + s1[r]; }
    S.l += ps;
    const bf16x8 b0 = pack_p(s0, 0), b1 = pack_p(s0, 1), b2 = pack_p(s1, 0), b3 = pack_p(s1, 1);
    if constexpr (!VT::HOIST) {
#pragma unroll
        for (int s = 0; s < 4; ++s) { vf[2 * s] = vt.frag(0, s); vf[2 * s + 1] = vt.frag(1, s); }
    }
    S.o0 = MFMA32(vf[0], b0, S.o0); S.o1 = MFMA32(vf[1], b0, S.o1);
    S.o0 = MFMA32(vf[2], b1, S.o0); S.o1 = MFMA32(vf[3], b1, S.o1);
    S.o0 = MFMA32(vf[4], b2, S.o0); S.o1 = MFMA32(vf[5], b2, S.o1);
    S.o0 = MFMA32(vf[6], b3, S.o0); S.o1 = MFMA32(vf[7], b3, S.o1);
}
DI float as_f(int x) { return __int_as_float(x); }
DI float mask_sel(float s, int mm) { return __int_as_float((__float_as_int(s) & mm) | ((int)0xff800000 & ~mm)); }
DI u32x4 tile_ld(const bf16* g, size_t pitch, int tid) { return *(const u32x4*)(g + (size_t)(tid >> 3) * pitch + (tid & 7) * 8); }
DI void tile_st(LAS unsigned char* buf, u32x4 v, int tid) { *(LAS u32x4*)(buf + (tid >> 3) * TP + (tid & 7) * 16) = v; }

constexpr int CP = 272;
DI void compress_unit(Frame& F, int u) {
    const int tid = F.tid, lane = F.lane, w = F.wave, l31 = lane & 31, hi = lane >> 5;
    const int slot = u / 136, rem = u % 136;
    const bf16* data; bf16 *ock, *ocvt; int n0, ncmp, cpitch;
    if (rem < 8) { const int bg = rem; data = WSP(bf16, (slot ? WS_PCMPV : WS_PCMPK)) + (size_t)bg * SEQ * 64; n0 = 32 * w; ncmp = 255; cpitch = 256;
        ock = WSP(bf16, WS_PCK) + (size_t)bg * 256 * 64; ocvt = WSP(bf16, WS_PCVT) + (size_t)bg * 64 * 256; }
    else { const int bg = 2 * (rem - 8) + (w >> 2); data = WSP(bf16, (slot ? WS_SCMPV : WS_SCMPK)) + (size_t)bg * LS * 64; n0 = 32 * (w & 3); ncmp = 127; cpitch = 128;
        ock = WSP(bf16, WS_SCK) + (size_t)bg * 128 * 64; ocvt = WSP(bf16, WS_SCVT) + (size_t)bg * 64 * 128; }
    const int n = n0 + l31, nc = n < ncmp ? n : ncmp - 1;
    const bf16* drow = data + (size_t)nc * 1024 + 8 * hi;
    const bool paged = rem >= 8;
    const bf16* w1t = WSP(bf16, WS_W1T) + (size_t)slot * 128 * 2048;
    f32x16 acc[4];
#pragma unroll
    for (int c = 0; c < 4; ++c)
#pragma unroll
        for (int i = 0; i < 16; ++i) acc[c][i] = 0.f;
    const bf16* wsrc = w1t + (size_t)(tid >> 2) * 2048 + ((tid & 3) >> 1) * 1024 + (tid & 1) * 32;
    LAS unsigned char* wdst = F.lds + (tid >> 2) * CP + (tid & 3) * 64;
    u32x4 st[4];
#pragma unroll
    for (int i = 0; i < 4; ++i) st[i] = ((const u32x4*)wsrc)[i];
#pragma unroll
    for (int i = 0; i < 4; ++i) ((LAS u32x4*)wdst)[i] = st[i];
    LDS_BARRIER();
    f32x4 raw[16];
#define CMP_ISSUE(kc_) do { if (!paged) { _Pragma("unroll") for (int s_ = 0; s_ < 8; ++s_) raw[2 * s_] = __builtin_bit_cast(f32x4, *(const bf16x8*)(drow + ((kc_) + 16 * (s_ >> 2)) * 64 + (s_ & 3) * 16)); } \
        } while (0)
    LAS unsigned char* const wrows = F.lds + 2 * 128 * CP + w * (36 * TP);
    const int q4 = lane >> 4, c16 = lane & 15;
    const float *lb0 = nullptr, *lb8 = nullptr; int pgs[5] = {0, 0, 0, 0, 0};
    if (paged) { const int sb = rem - 8, g = w >> 2;
#pragma unroll
        for (int k = 0; k < 5; ++k) { const int pi = (n0 >> 3) + k; pgs[k] = F.ptab[sb * NPG + (pi < NPG ? pi : NPG - 1)]; }
        lb8 = F.cnsa + (slot * 2 + g) * 64 + 4 * c16; lb0 = lb8 + (size_t)(16 * q4) * 512; }
#define CMP_ISSUE_P(kc_) do { _Pragma("unroll") for (int i_ = 0; i_ < 9; ++i_) raw[i_] = *(const f32x4*)((i_ < 8 ? lb0 : lb8) + ((size_t)pgs[i_ >> 1] * PAGE + 64 * (i_ & 1) + (kc_)) * 512); } while (0)
    if (!paged) CMP_ISSUE(0); else CMP_ISSUE_P(0);
    for (int kc = 0; kc < 16; ++kc) {
        const LAS unsigned char* buf = F.lds + (kc & 1) * (128 * CP);
        if (kc + 1 < 16) {
#pragma unroll
            for (int i = 0; i < 4; ++i) st[i] = ((const u32x4*)(wsrc + (kc + 1) * 64))[i];
        }
        bf16x8 bq[8];
        if (!paged) {
#pragma unroll
            for (int s = 0; s < 8; ++s) bq[s] = __builtin_bit_cast(bf16x8, raw[2 * s]);
            if (kc + 1 < 16) CMP_ISSUE(kc + 1);
        } else {
#pragma unroll
            for (int i = 0; i < 9; ++i) { u32x2 wv; wv.x = pk2(raw[i][0], raw[i][1]); wv.y = pk2(raw[i][2], raw[i][3]); *(LAS u32x2*)(wrows + (4 * i + q4) * TP + c16 * 8) = wv; }
            if (kc + 1 < 16) CMP_ISSUE_P(kc + 1);
#pragma unroll
            for (int s = 0; s < 8; ++s) bq[s] = *(const LAS bf16x8*)(wrows + (l31 + (s >> 2)) * TP + ((s & 3) * 16 + 8 * hi) * 2);
        }
#pragma unroll
        for (int s = 0; s < 8; ++s)
#pragma unroll
            for (int c = 0; c < 4; ++c) acc[c] = MFMA32(*(const LAS bf16x8*)(buf + (32 * c + l31) * CP + s * 32 + hi * 16), bq[s], acc[c]);
        if (kc + 1 < 16) {
            LAS unsigned char* nb = wdst + ((kc + 1) & 1) * (128 * CP);
#pragma unroll
            for (int i = 0; i < 4; ++i) ((LAS u32x4*)nb)[i] = st[i];
        }
        LDS_BARRIER();
    }
#undef CMP_ISSUE
#undef CMP_ISSUE_P
    const float* b1 = WSP(float, WS_BIAS1) + slot * 128;
#pragma unroll
    for (int c = 0; c < 4; ++c)
#pragma unroll
        for (int q = 0; q < 4; ++q) { const f32x4 bv = *(const f32x4*)(b1 + 32 * c + 8 * q + 4 * hi);
#pragma unroll
            for (int j = 0; j < 4; ++j) acc[c][4 * q + j] = silu_f(acc[c][4 * q + j] + bv[j]); }
    const bf16* w2t = WSP(bf16, WS_W2T) + (size_t)slot * 64 * 128 + (size_t)l31 * 128 + 8 * hi;
    f32x16 o0, o1;
#pragma unroll
    for (int i = 0; i < 16; ++i) { o0[i] = 0.f; o1[i] = 0.f; }
#pragma unroll
    for (int c = 0; c < 4; ++c)
#pragma unroll
        for (int h = 0; h < 2; ++h) { const bf16x8 hb = pack_p(acc[c], h); const int s2 = 2 * c + h;
            o0 = MFMA32(*(const bf16x8*)(w2t + s2 * 16), hb, o0); o1 = MFMA32(*(const bf16x8*)(w2t + 32 * 128 + s2 * 16), hb, o1); }
    const bool ok = n < ncmp;
    if (slot == 0) {
#pragma unroll
        for (int e = 0; e < 2; ++e)
#pragma unroll
            for (int q = 0; q < 4; ++q) { const f32x16& o = e ? o1 : o0; u32x2 wv;
                wv.x = ok ? pk2(o[4 * q], o[4 * q + 1]) : 0u; wv.y = ok ? pk2(o[4 * q + 2], o[4 * q + 3]) : 0u;
                *(u32x2*)(ock + (size_t)n * 64 + 32 * e + 8 * q + 4 * hi) = wv; }
    } else {
        const int pn = permk(n);
#pragma unroll
        for (int e = 0; e < 2; ++e)
#pragma unroll
            for (int r = 0; r < 16; ++r) { const f32x16& o = e ? o1 : o0; ocvt[(size_t)(32 * e + crow(r, hi)) * cpitch + pn] = ok ? (bf16)(pk2(o[r], 0.f) & 0xffffu) : (bf16)0; }
    }
}

template <int NR, int ABL> DI void idx_select(const LAS int* scw, int n, int lane, unsigned long long* out) {
    int k[NR];
    int kmin = 0x7fffffff, kmax = (int)0x80000000;
#pragma unroll
    for (int i = 0; i < NR; ++i) { const bool v = 64 * i + lane < n; const int x = v ? scw[64 * i + lane] : (int)0x80000000; k[i] = x; kmin = v ? (x < kmin ? x : kmin) : kmin; kmax = x > kmax ? x : kmax; }
    int thr = (int)0x80000000, cut = -1;
    if (n > 256 && !(ABL & 1)) {
        kmin = wave_min_i(kmin); kmax = wave_max_i(kmax);
        int lo = kmin - 1, hiv = kmax;
        bool found = false;
        if (hiv > 0x04000000) {
            const int kp = hiv - 0x03800000;
            int c = 0, cl = 0;
#pragma unroll
            for (int i0 = 0; i0 < NR; i0 += 8) {
                unsigned long long bm[4];
#pragma unroll
                for (int j = 0; j < 4; ++j) bm[j] = __ballot(k[i0 + j] > kp);
#pragma unroll
                for (int j = 4; j < 8; ++j) cl += (k[i0 + j] > kp) ? 1 : 0;
#pragma unroll
                for (int j = 0; j < 4; ++j) c += __popcll(bm[j]);
            }
            c += wave_sum_i(cl);
            if (c == 256) { thr = kp; found = true; } else if (c > 256) lo = kp; else hiv = kp;
        }
        while (!found && (unsigned)hiv - (unsigned)lo > 1u) {
            const int mid = (int)((unsigned)lo + (((unsigned)hiv - (unsigned)lo) >> 1));
            int c = 0, cl = 0;
#pragma unroll
            for (int i0 = 0; i0 < NR; i0 += 8) {
                unsigned long long bm[4];
#pragma unroll
                for (int j = 0; j < 4; ++j) bm[j] = __ballot(k[i0 + j] > mid);
#pragma unroll
                for (int j = 4; j < 8; ++j) cl += (k[i0 + j] > mid) ? 1 : 0;
#pragma unroll
                for (int j = 0; j < 4; ++j) c += __popcll(bm[j]);
            }
            c += wave_sum_i(cl);
            if (c == 256) { thr = mid; found = true; break; }
            if (c > 256) lo = mid; else hiv = mid;
        }
        if (!found) {
            thr = hiv; int cgt = 0;
#pragma unroll
            for (int i = 0; i < NR; ++i) cgt += __popcll(__ballot(k[i] > thr));
            const int need = 256 - cgt; int acc = 0; bool done = false;
#pragma unroll
            for (int i = 0; i < NR; ++i) {
                unsigned long long mk = __ballot(k[i] == thr); const int pc = __popcll(mk);
                if (!done && acc + pc >= need) { for (int q2 = 1; q2 < need - acc; ++q2) mk &= mk - 1; cut = 64 * i + (int)__builtin_ctzll(mk); done = true; }
                acc += pc;
            }
        }
    }
    unsigned long long myw = 0ull;
    if (ABL & 4) { myw = (unsigned long long)(k[0] + k[NR - 1] + kmin + kmax); } else
#pragma unroll
    for (int i = 0; i < NR; ++i) { const unsigned long long mk = __ballot((k[i] > thr) | ((k[i] == thr) & (64 * i + lane <= cut))); myw = (lane == i) ? mk : myw; }
    out[lane] = myw;
}
template <bool SAMPLE, int ABL> DI void idx1_unit(Frame& F, int u) {
    const int lane = F.lane, w = F.wave, l31 = lane & 31, hi = lane >> 5, tl = l31 >> 2, hl = l31 & 3;
    int row0, nkmax, ntok; const bf16* ik;
    if (!SAMPLE) { const int b = u & 3, tc = 511 - (u >> 2); row0 = b * SEQ + 8 * tc; nkmax = 8 * tc + 8; ntok = 8; ik = WSP(bf16, WS_PIDXK) + (size_t)b * SEQ * 64; }
    else { row0 = MP + 4 * u; nkmax = PASTL + 4; ntok = 4; ik = WSP(bf16, WS_SIDXK) + (size_t)u * LS * 64; }
    const int rowq = row0 + (SAMPLE ? (tl & 3) : tl);
    bf16x8 q[4];
#pragma unroll
    for (int s = 0; s < 4; ++s) q[s] = *(const bf16x8*)(WSP(bf16, WS_IQ) + (size_t)rowq * 256 + hl * 64 + 16 * s + 8 * hi);
    f32x4 wq[4];
#pragma unroll
    for (int qq = 0; qq < 4; ++qq) { const int tk = 2 * qq + hi; wq[qq] = *(const f32x4*)(WSP(float, WS_IW) + (size_t)(row0 + (SAMPLE ? (tk & 3) : tk)) * 4); }
    LAS int* sc = (LAS int*)F.lds;
    const int n32 = (nkmax + 31) >> 5;
    u32x4 rA[8], rB[8];
    LAS unsigned char* const stg = F.lds + STG_OFF + w * 2048;
    const int wofs_b = ((lane >> 2) * 64) + ((((lane & 3) ^ ((lane >> 4) & 3))) * 16);
    const int rofs0 = l31 * 64 + ((hi ^ ((l31 >> 2) & 3)) * 16), rofs1 = l31 * 64 + (((2 + hi) ^ ((l31 >> 2) & 3)) * 16);
#define IDX_ISSUE_B(R, base_, dup_) do { const bf16* kp_ = (base_) + (lane >> 2) * 64 + (lane & 3) * 8; \
        R[0] = gload16(kp_); R[2] = gload16(kp_ + 16 * 64); R[4] = gload16(kp_ + 32); R[6] = gload16(kp_ + 16 * 64 + 32); \
        if (dup_) { R[1] = gload16(kp_); R[3] = gload16(kp_ + 16 * 64); R[5] = gload16(kp_ + 32); R[7] = gload16(kp_ + 16 * 64 + 32); } } while (0)
#define IDX_ISSUE(R, kt_) do { const int kk_ = (kt_) < n32 ? (kt_) : n32 - 1; \
        if (SAMPLE) { if (kk_ < 64) { const int pg = F.ptab[u * NPG + (kk_ >> 2)]; const float* fp = F.cidx + ((size_t)pg * PAGE + (kk_ & 3) * 32 + (lane >> 3)) * 64 + 4 * (lane & 7); \
              _Pragma("unroll") for (int i_ = 0; i_ < 4; ++i_) { R[i_] = gload16(fp + 8 * i_ * 64); R[4 + i_] = gload16(fp + 8 * i_ * 64 + 32); } } \
            else IDX_ISSUE_B(R, ik + (size_t)(32 * kk_) * 64, true); } \
        else IDX_ISSUE_B(R, ik + (size_t)(32 * kk_) * 64, false); } while (0)
#define IDX_WAIT(R) do { if (SAMPLE) asm volatile("s_waitcnt vmcnt(8)" : "+v"(R[0]), "+v"(R[1]), "+v"(R[2]), "+v"(R[3]), "+v"(R[4]), "+v"(R[5]), "+v"(R[6]), "+v"(R[7]) :: "memory"); \
        else asm volatile("s_waitcnt vmcnt(4)" : "+v"(R[0]), "+v"(R[2]), "+v"(R[4]), "+v"(R[6]) :: "memory"); } while (0)
#define IDX_STAGE_F(R, h_) do { _Pragma("unroll") for (int i_ = 0; i_ < 4; ++i_) { const f32x4 x_ = __builtin_bit_cast(f32x4, R[4 * (h_) + i_]); u32x2 wv_; wv_.x = pk2(x_[0], x_[1]); wv_.y = pk2(x_[2], x_[3]); \
        const int row_ = (lane >> 3) + 8 * i_; *(LAS u32x2*)(stg + row_ * 64 + ((((lane & 7) >> 1) ^ ((row_ >> 2) & 3)) * 16) + (lane & 1) * 8) = wv_; } } while (0)
#define IDX_STAGE_B(R, h_) do { *(LAS u32x4*)(stg + wofs_b) = R[4 * (h_)]; *(LAS u32x4*)(stg + wofs_b + 1024) = R[4 * (h_) + 2]; } while (0)
#define IDX_FRAGS(R, kt_, kf_) do { \
        if (SAMPLE && (kt_) < 64) { IDX_STAGE_F(R, 0); kf_[0] = *(const LAS bf16x8*)(stg + rofs0); kf_[1] = *(const LAS bf16x8*)(stg + rofs1); \
                                    IDX_STAGE_F(R, 1); kf_[2] = *(const LAS bf16x8*)(stg + rofs0); kf_[3] = *(const LAS bf16x8*)(stg + rofs1); } \
        else { IDX_STAGE_B(R, 0); kf_[0] = *(const LAS bf16x8*)(stg + rofs0); kf_[1] = *(const LAS bf16x8*)(stg + rofs1); \
               IDX_STAGE_B(R, 1); kf_[2] = *(const LAS bf16x8*)(stg + rofs0); kf_[3] = *(const LAS bf16x8*)(stg + rofs1); } } while (0)
#define RELU_(x) __builtin_amdgcn_fmed3f((x), 0.f, __builtin_inff())
#define IDX_SCORE(R, kt_) do { IDX_WAIT(R); if ((kt_) < n32) { bf16x8 kf[4]; IDX_FRAGS(R, kt_, kf); \
        f32x16 a; _Pragma("unroll") for (int i_ = 0; i_ < 16; ++i_) a[i_] = 0.f; \
        _Pragma("unroll") for (int s_ = 0; s_ < 4; ++s_) a = MFMA32(q[s_], kf[s_], a); \
        _Pragma("unroll") for (int qq = 0; qq < 4; ++qq) { \
            float v = RELU_(a[4 * qq]) * wq[qq][0] + RELU_(a[4 * qq + 1]) * wq[qq][1] + RELU_(a[4 * qq + 2]) * wq[qq][2] + RELU_(a[4 * qq + 3]) * wq[qq][3]; \
            int uu = __float_as_int(v); uu = (uu == (int)0x80000000) ? 0 : uu; \
            sc[(2 * qq + hi) * 4096 + 32 * (kt_) + l31] = uu ^ ((uu >> 31) & 0x7fffffff); } } } while (0)
    if (!(ABL & 2)) {
        IDX_ISSUE(rA, w); IDX_ISSUE(rB, w + NWAVES);
        PIN4(q); PIN4(wq);
        asm volatile("s_waitcnt vmcnt(0)" ::: "memory");
        for (int kt = w; kt < n32; kt += 2 * NWAVES) {
            IDX_SCORE(rA, kt); IDX_ISSUE(rA, kt + 2 * NWAVES);
            IDX_SCORE(rB, kt + NWAVES); IDX_ISSUE(rB, kt + 3 * NWAVES);
        }
        asm volatile("s_waitcnt vmcnt(0)" : "+v"(rA[0]), "+v"(rA[2]), "+v"(rA[4]), "+v"(rA[6]), "+v"(rB[0]), "+v"(rB[2]), "+v"(rB[4]), "+v"(rB[6]) :: "memory");
        if (SAMPLE) asm volatile("" : "+v"(rA[1]), "+v"(rA[3]), "+v"(rA[5]), "+v"(rA[7]), "+v"(rB[1]), "+v"(rB[3]), "+v"(rB[5]), "+v"(rB[7]));
    }
#undef IDX_ISSUE
#undef IDX_ISSUE_B
#undef IDX_STAGE_F
#undef IDX_STAGE_B
#undef IDX_FRAGS
#undef IDX_WAIT
#undef IDX_SCORE
#undef RELU_
    __syncthreads();
    if (w < ntok && !(ABL & 8)) {
        const int n = SAMPLE ? (PASTL + 1 + w) : (row0 - (row0 & ~(SEQ - 1)) + w + 1);
        unsigned long long* out = WSP(unsigned long long, ABL ? WS_T1 : WS_SELM) + (size_t)(row0 + w) * 64;
        const LAS int* scw = sc + w * 4096;
        if (n <= 1024) idx_select<16, ABL>(scw, n, lane, out);
        else if (n <= 2048) idx_select<32, ABL>(scw, n, lane, out);
        else if (n <= 3072) idx_select<48, ABL>(scw, n, lane, out);
        else idx_select<64, ABL>(scw, n, lane, out);
    }
    __syncthreads();
}


constexpr int NSA_PS = 2 * 2 * TILE_B;
constexpr int NSA_WS = 8192 + 2048 + 64;
template <bool SAMPLE> DI void nsa_unit(Frame& F, int u) {
    const int tid = F.tid, lane = F.lane, w = F.wave, l31 = lane & 31, hi = lane >> 5, tl = l31 >> 2, hl = l31 & 3;
    int bg, g, row, qpos, ncmp, wlo, whi, n_ctile, n_stile, w_t0, w_t1, qt = 0;
    size_t cpitch, pitch, wpitch; const bf16 *ck, *cvt, *sk, *svt, *wk, *wvt; bool wr_ok;
    if (!SAMPLE) {
        bg = u & 7; qt = 63 - (u >> 3); g = bg & 1; const int t = 64 * qt + 8 * w + tl; row = (bg >> 1) * SEQ + t; qpos = t; ncmp = 255;
        cpitch = 256; pitch = SEQ; wpitch = SEQ;
        ck = WSP(bf16, WS_PCK) + (size_t)bg * 256 * 64; cvt = WSP(bf16, WS_PCVT) + (size_t)bg * 64 * 256;
        sk = WSP(bf16, WS_PSLCK) + (size_t)bg * SEQ * 64; svt = WSP(bf16, WS_PSLCVT) + (size_t)bg * 64 * SEQ;
        wk = WSP(bf16, WS_PWINK) + (size_t)bg * SEQ * 64; wvt = WSP(bf16, WS_PWINVT) + (size_t)bg * 64 * SEQ;
        wlo = qpos - 511; whi = qpos; n_ctile = (4 * qt + 2) / 64 + 1; n_stile = qt + 1; w_t0 = qt > 8 ? qt - 8 : 0; w_t1 = qt; wr_ok = true;
    } else {
        bg = u * 8 + w; g = bg & 1; const int i = tl & 3; row = MP + (bg >> 1) * 4 + i; qpos = PASTL + i; ncmp = 127;
        cpitch = 128; pitch = LS; wpitch = LSW;
        ck = WSP(bf16, WS_SCK) + (size_t)bg * 128 * 64; cvt = WSP(bf16, WS_SCVT) + (size_t)bg * 64 * 128;
        sk = WSP(bf16, WS_SSLCK) + (size_t)bg * LS * 64; svt = WSP(bf16, WS_SSLCVT) + (size_t)bg * 64 * LS;
        wk = WSP(bf16, WS_SWINK) + (size_t)bg * LSW * 64; wvt = WSP(bf16, WS_SWINVT) + (size_t)bg * 64 * LSW;
        wlo = 1 + i; whi = 512 + i; n_ctile = 2; n_stile = 33; w_t0 = 0; w_t1 = 8; wr_ok = tl < 4;
    }
    const int hq = 4 * g + hl;
    bf16x8 qraw[4], qrot[4];
#pragma unroll
    for (int s = 0; s < 4; ++s) qraw[s] = *(const bf16x8*)(WSP(bf16, WS_QRAW) + (size_t)row * 512 + hq * 64 + 16 * s + 8 * hi);
    LAS unsigned char* const lb = F.lds;
    LAS float* psum = (LAS float*)(lb + NSA_PS + w * NSA_WS);
    LAS float* impb = (LAS float*)(lb + NSA_PS + w * NSA_WS + 8192);
    LAS unsigned char* selb = lb + NSA_PS + w * NSA_WS + 8192 + 2048;
    const int fo = l31 * TP + hi * 16;
    const float* gp = WSP(float, WS_GATES) + (size_t)row * 24 + hq * 3;
    float g0 = gp[0], g1 = gp[1], g2 = gp[2];
    PIN4(qraw); asm volatile("" : "+v"(g0), "+v"(g1), "+v"(g2));
    f32x16 s0, s1;
    u32x4 rk, rv;
    Soft S;

    const int nvr = (qpos - 31) >> 4, nvis = nvr < ncmp - 1 ? nvr : ncmp - 1;
    float m = -1e30f, l = 0.f;
    if (!SAMPLE) { rk = tile_ld(ck, 64, tid); rv = tile_ld(cvt, cpitch, tid); tile_st(lb, rk, tid); tile_st(lb + TILE_B, rv, tid); LDS_BARRIER(); }
    for (int ct = 0; ct < n_ctile; ++ct) {
        if (!SAMPLE) { if (ct + 1 < n_ctile) { rk = tile_ld(ck + (size_t)(ct + 1) * 64 * 64, 64, tid); rv = tile_ld(cvt + (ct + 1) * 64, cpitch, tid); } }
        if (!SAMPLE) { LdsT kt{lb + (ct & 1) * 2 * TILE_B + fo}; qk_tile(s0, s1, kt, qraw); }
        else { GlbT kt{ck, (unsigned)((64 * ct + l31) * 64 + 8 * hi), 64u}; qk_tile(s0, s1, kt, qraw); }
        float mx = -1e30f;
        const int nv2 = nvis - 64 * ct - 4 * hi;
#pragma unroll
        for (int r = 0; r < 16; ++r) { const int cr = (r & 3) + 8 * (r >> 2); s0[r] = cr <= nv2 ? s0[r] : NEGINF; s1[r] = cr + 32 <= nv2 ? s1[r] : NEGINF; mx = fmaxf(mx, fmaxf(s0[r], s1[r])); }
        mx = fmaxf(mx, half_other(mx));
        const float mn = fmaxf(m, mx); float ps = 0.f;
#pragma unroll
        for (int r = 0; r < 16; ++r) ps += __builtin_amdgcn_exp2f(s0[r] - mn) + __builtin_amdgcn_exp2f(s1[r] - mn);
        l = l * __builtin_amdgcn_exp2f(m - mn) + ps; m = mn;
        if (!SAMPLE) { if (ct + 1 < n_ctile) { tile_st(lb + ((ct + 1) & 1) * 2 * TILE_B, rk, tid); tile_st(lb + ((ct + 1) & 1) * 2 * TILE_B + TILE_B, rv, tid); } LDS_BARRIER(); }
    }
    l += half_other(l);
    const float linv = l > 0.f ? 1.f / l : 0.f;
    soft_init(S);
    if (!SAMPLE) { rk = tile_ld(ck, 64, tid); rv = tile_ld(cvt, cpitch, tid); tile_st(lb, rk, tid); tile_st(lb + TILE_B, rv, tid); LDS_BARRIER(); }
    for (int ct = 0; ct < n_ctile; ++ct) {
        if (!SAMPLE) { if (ct + 1 < n_ctile) { rk = tile_ld(ck + (size_t)(ct + 1) * 64 * 64, 64, tid); rv = tile_ld(cvt + (ct + 1) * 64, cpitch, tid); } }
        if (!SAMPLE) { LdsT kt{lb + (ct & 1) * 2 * TILE_B + fo}; qk_tile(s0, s1, kt, qraw); }
        else { GlbT kt{ck, (unsigned)((64 * ct + l31) * 64 + 8 * hi), 64u}; qk_tile(s0, s1, kt, qraw); }
        const int nv2 = nvis - 64 * ct - 4 * hi; LAS float* pw = psum + tl * 256 + 64 * ct + 4 * hi;
#pragma unroll
        for (int r = 0; r < 16; ++r) { const int cr = (r & 3) + 8 * (r >> 2);
            s0[r] = cr <= nv2 ? __builtin_amdgcn_exp2f(s0[r] - m) * linv : 0.f; s1[r] = cr + 32 <= nv2 ? __builtin_amdgcn_exp2f(s1[r] - m) * linv : 0.f;
            float a = s0[r]; a += dpp_x1(a); a += dpp_x2(a); float b = s1[r]; b += dpp_x1(b); b += dpp_x2(b);
            if (hl == 0) { pw[cr] = a; pw[cr + 32] = b; } }
        if (!SAMPLE) { LdsT vt{lb + (ct & 1) * 2 * TILE_B + TILE_B + fo}; pv_tile(S.o0, S.o1, s0, s1, vt); }
        else { GlbT vt{cvt, (unsigned)(l31 * (int)cpitch + 64 * ct + 8 * hi), (unsigned)cpitch}; pv_tile(S.o0, S.o1, s0, s1, vt); }
        if (!SAMPLE) { if (ct + 1 < n_ctile) { tile_st(lb + ((ct + 1) & 1) * 2 * TILE_B, rk, tid); tile_st(lb + ((ct + 1) & 1) * 2 * TILE_B + TILE_B, rv, tid); } LDS_BARRIER(); }
    }
    LDS_WAIT();
    unsigned mlo, mhi;
    {
        const int tk = lane >> 3, jb = 8 * (lane & 7);
        const int qp = SAMPLE ? PASTL + (tk & 3) : 64 * qt + 8 * w + tk, cur = qp >> 6;
        float pv[33];
        const LAS f32x4* pp = (const LAS f32x4*)(psum + tk * 256 + 4 * jb);
#pragma unroll
        for (int i = 0; i < 8; ++i) { const f32x4 x = pp[i]; pv[1 + 4 * i] = x[0]; pv[2 + 4 * i] = x[1]; pv[3 + 4 * i] = x[2]; pv[4 + 4 * i] = x[3]; }
        pv[0] = jb > 0 ? psum[tk * 256 + 4 * jb - 1] : 0.f;
        float v[8];
#pragma unroll
        for (int jj = 0; jj < 8; ++jj) {
            const int j = jb + jj;
            float a = pv[4 * jj] + pv[4 * jj + 1] + pv[4 * jj + 2] + pv[4 * jj + 3];
            a += (4 * j + 3 < ncmp) ? pv[4 * jj + 4] : 0.f;
            a = ((j == 0) | (j == cur) | (j == cur - 1)) ? 1e4f : a;
            a = (j > cur) ? -1e30f : a;
            v[jj] = a;
        }
        LAS f32x4* ip = (LAS f32x4*)(impb + tk * 64 + jb);
        ip[0] = (f32x4){v[0], v[1], v[2], v[3]}; ip[1] = (f32x4){v[4], v[5], v[6], v[7]};
        LDS_WAIT();
        int cnt[8];
#pragma unroll
        for (int jj = 0; jj < 8; ++jj) cnt[jj] = 0;
        const LAS f32x4* ap = (const LAS f32x4*)(impb + tk * 64);
#pragma unroll 1
        for (int i4 = 0; i4 < 16; ++i4) {
            const f32x4 x = ap[i4];
#pragma unroll
            for (int e = 0; e < 4; ++e) { const float xi = x[e];
#pragma unroll
                for (int jj = 0; jj < 8; ++jj) cnt[jj] += (xi > v[jj]) ? 1 : 0; }
        }
        unsigned bits = 0;
#pragma unroll
        for (int jj = 0; jj < 8; ++jj) bits |= ((cnt[jj] < 16) & (jb + jj <= cur)) ? (1u << jj) : 0u;
        int nsel = __popc(bits);
        nsel += __shfl_xor(nsel, 1); nsel += __shfl_xor(nsel, 2); nsel += __shfl_xor(nsel, 4);
        if (__builtin_amdgcn_ballot_w64(nsel != (cur < 15 ? cur + 1 : 16)) != 0ull) {
#pragma unroll
            for (int jj = 0; jj < 8; ++jj) cnt[jj] = 0;
#pragma unroll 1
            for (int i4 = 0; i4 < 16; ++i4) {
                const f32x4 x = ap[i4];
#pragma unroll
                for (int e = 0; e < 4; ++e) { const int i = 4 * i4 + e; const float xi = x[e];
#pragma unroll
                    for (int jj = 0; jj < 8; ++jj) cnt[jj] += ((xi > v[jj]) | ((xi == v[jj]) & (i < jb + jj))) ? 1 : 0; }
            }
            bits = 0;
#pragma unroll
            for (int jj = 0; jj < 8; ++jj) bits |= ((cnt[jj] < 16) & (jb + jj <= cur)) ? (1u << jj) : 0u;
        }
        selb[tk * 8 + (lane & 7)] = (unsigned char)bits;
        LDS_WAIT();
        const LAS unsigned* sp = (const LAS unsigned*)(selb + tl * 8);
        mlo = sp[0]; mhi = sp[1];
    }
    LAS float* park = psum + lane;
#pragma unroll
    for (int i = 0; i < 16; ++i) { park[i * 64] = g0 * S.o0[i]; park[(16 + i) * 64] = g0 * S.o1[i]; }
#pragma unroll
    for (int s = 0; s < 4; ++s) qrot[s] = *(const bf16x8*)(WSP(bf16, WS_QROT) + (size_t)row * 512 + hq * 64 + 16 * s + 8 * hi);
    PIN4(qrot);
    soft_init(S);
    const int qrel = (qpos & 63) - 4 * hi;
    if (!SAMPLE) { rk = tile_ld(sk, 64, tid); rv = tile_ld(svt, pitch, tid); tile_st(lb, rk, tid); tile_st(lb + TILE_B, rv, tid); LDS_BARRIER(); }
    for (int j = 0; j < n_stile; ++j) {
        if (!SAMPLE) { if (j + 1 < n_stile) { rk = tile_ld(sk + (size_t)(j + 1) * 64 * 64, 64, tid); rv = tile_ld(svt + (j + 1) * 64, pitch, tid); } }
        const bool bsel = ((j < 32 ? (mlo >> j) : (mhi >> (j - 32))) & 1u) != 0u;
        if (!SAMPLE) { LdsT kt{lb + (j & 1) * 2 * TILE_B + fo}; qk_tile_c(s0, s1, kt, qrot, S.negm); }
        else { GlbT kt{sk, (unsigned)((64 * j + l31) * 64 + 8 * hi), 64u}; qk_tile_c(s0, s1, kt, qrot, S.negm); }
        if (j == n_stile - 1) {
#pragma unroll
            for (int r = 0; r < 16; ++r) { const int cr = (r & 3) + 8 * (r >> 2); s0[r] = cr <= qrel ? s0[r] : NEGINF; s1[r] = cr + 32 <= qrel ? s1[r] : NEGINF; }
        } else {
#pragma unroll
            for (int r = 0; r < 16; ++r) { s0[r] = bsel ? s0[r] : NEGINF; s1[r] = bsel ? s1[r] : NEGINF; }
        }
        if (!SAMPLE) { LdsT vt{lb + (j & 1) * 2 * TILE_B + TILE_B + fo}; soft_step(S, s0, s1, vt); }
        else { GlbT vt{svt, (unsigned)(l31 * (int)pitch + 64 * j + 8 * hi), (unsigned)pitch}; soft_step(S, s0, s1, vt); }
        if (!SAMPLE) { if (j + 1 < n_stile) { tile_st(lb + ((j + 1) & 1) * 2 * TILE_B, rk, tid); tile_st(lb + ((j + 1) & 1) * 2 * TILE_B + TILE_B, rv, tid); } LDS_BARRIER(); }
    }
    S.l += half_other(S.l);
    { const float sc = g1 / fmaxf(S.l, 1e-30f);
#pragma unroll
      for (int i = 0; i < 16; ++i) { park[i * 64] += sc * S.o0[i]; park[(16 + i) * 64] += sc * S.o1[i]; } }
    soft_init(S);
    if (!SAMPLE) { rk = tile_ld(wk + (size_t)w_t0 * 64 * 64, 64, tid); rv = tile_ld(wvt + w_t0 * 64, wpitch, tid); tile_st(lb, rk, tid); tile_st(lb + TILE_B, rv, tid); LDS_BARRIER(); }
    for (int j = w_t0; j <= w_t1; ++j) {
        const int jr = j - w_t0;
        if (!SAMPLE) { if (j + 1 <= w_t1) { rk = tile_ld(wk + (size_t)(j + 1) * 64 * 64, 64, tid); rv = tile_ld(wvt + (j + 1) * 64, wpitch, tid); } }
        if (!SAMPLE) { LdsT kt{lb + (jr & 1) * 2 * TILE_B + fo}; qk_tile_c(s0, s1, kt, qrot, S.negm); }
        else { GlbT kt{wk, (unsigned)((64 * j + l31) * 64 + 8 * hi), 64u}; qk_tile_c(s0, s1, kt, qrot, S.negm); }
        if ((j == w_t0) | (j == w_t1)) {
            const int lo_r = wlo - 64 * j - 4 * hi, hi_r = whi - 64 * j - 4 * hi;
#pragma unroll
            for (int r = 0; r < 16; ++r) { const int k0 = (r & 3) + 8 * (r >> 2); s0[r] = ((k0 >= lo_r) & (k0 <= hi_r)) ? s0[r] : NEGINF; s1[r] = ((k0 + 32 >= lo_r) & (k0 + 32 <= hi_r)) ? s1[r] : NEGINF; }
        }
        if (!SAMPLE) { LdsT vt{lb + (jr & 1) * 2 * TILE_B + TILE_B + fo}; soft_step(S, s0, s1, vt); }
        else { GlbT vt{wvt, (unsigned)(l31 * (int)wpitch + 64 * j + 8 * hi), (unsigned)wpitch}; soft_step(S, s0, s1, vt); }
        if (!SAMPLE) { if (j + 1 <= w_t1) { tile_st(lb + ((jr + 1) & 1) * 2 * TILE_B, rk, tid); tile_st(lb + ((jr + 1) & 1) * 2 * TILE_B + TILE_B, rv, tid); } LDS_BARRIER(); }
    }
    S.l += half_other(S.l);
#ifdef BREAK_WIN
    S.l *= 1.1f;
#endif
    f32x16 res0, res1;
    { const float sc = g2 / fmaxf(S.l, 1e-30f);
#pragma unroll
      for (int i = 0; i < 16; ++i) { res0[i] = park[i * 64] + sc * S.o0[i]; res1[i] = park[(16 + i) * 64] + sc * S.o1[i]; } }
    if (wr_ok) {
        const bf16* zp = WSP(bf16, WS_ZN) + (size_t)row * 512 + hq * 64 + 4 * hi;
        bf16* op = WSP(bf16, WS_ONZ) + (size_t)row * 512 + hq * 64 + 4 * hi;
#pragma unroll
        for (int e = 0; e < 2; ++e)
#pragma unroll
            for (int q = 0; q < 4; ++q) { const f32x16& o = e ? res1 : res0; const u32x2 z = *(const u32x2*)(zp + 32 * e + 8 * q);
                u32x2 wv; wv.x = pk2(o[4 * q] * bflo(z.x), o[4 * q + 1] * bfhi(z.x)); wv.y = pk2(o[4 * q + 2] * bflo(z.y), o[4 * q + 3] * bfhi(z.y));
                *(u32x2*)(op + 32 * e + 8 * q) = wv; }
    }
}

template <int ABL, class VT> DI void soft_step2(Soft& S, f32x16& s0, f32x16& s1, f32x16& sn0, f32x16& sn1, const VT& vt) {
    bf16x8 vf[8];
#pragma unroll
    for (int s = 0; s < 4; ++s) { vf[2 * s] = vt.frag(0, s); vf[2 * s + 1] = vt.frag(1, s); }
    if (!(ABL & 1)) {
    float mx = max3f(s0[0], s1[0], s0[1]), my = max3f(s1[1], s0[2], s1[2]);
#pragma unroll
    for (int r = 3; r < 15; r += 2) { mx = max3f(mx, s0[r], s1[r]); my = max3f(my, s0[r + 1], s1[r + 1]); }
    mx = max3f(mx, s0[15], s1[15]); mx = max3f(mx, my, mx);
    mx = max3f(mx, half_other(mx), mx);
    const bool fin = mx > NEGINF;
    const bool need = (mx > 8.f) | (fin & !S.seen);
    if (__any(need)) {
        const float dl = need ? mx : 0.f;
        const float al = S.seen ? __builtin_amdgcn_exp2f(-dl) : 0.f;
        S.m += dl; S.l *= need ? al : 1.f;
        const float am = need ? al : 1.f;
#pragma unroll
        for (int r = 0; r < 16; ++r) { s0[r] -= dl; s1[r] -= dl; sn0[r] -= dl; sn1[r] -= dl; S.o0[r] *= am; S.o1[r] *= am; S.negm[r] = -S.m; }
    }
    S.seen = S.seen | fin;
    float ps = 0.f;
#pragma unroll
    for (int r = 0; r < 16; ++r) { s0[r] = __builtin_amdgcn_exp2f(s0[r]); s1[r] = __builtin_amdgcn_exp2f(s1[r]); ps += s0[r] + s1[r]; }
    S.l += ps;
    }
    const bf16x8 b0 = pack_p(s0, 0), b1 = pack_p(s0, 1), b2 = pack_p(s1, 0), b3 = pack_p(s1, 1);
    if (!(ABL & 4)) {
    S.o0 = MFMA32(vf[0], b0, S.o0); S.o1 = MFMA32(vf[1], b0, S.o1);
    S.o0 = MFMA32(vf[2], b1, S.o0); S.o1 = MFMA32(vf[3], b1, S.o1);
    S.o0 = MFMA32(vf[4], b2, S.o0); S.o1 = MFMA32(vf[5], b2, S.o1);
    S.o0 = MFMA32(vf[6], b3, S.o0); S.o1 = MFMA32(vf[7], b3, S.o1);
    } else { S.o0[0] += __builtin_bit_cast(f32x4, b0)[0] + __builtin_bit_cast(f32x4, b1)[0] + __builtin_bit_cast(f32x4, b2)[0] + __builtin_bit_cast(f32x4, b3)[0] + __builtin_bit_cast(f32x4, vf[0])[0] + __builtin_bit_cast(f32x4, vf[7])[1]; }
}
template <int ABL> DI void dsa_unit(Frame& F, int u) {
    const int tid = F.tid, lane = F.lane, w = F.wave, l31 = lane & 31, hi = lane >> 5, tl = l31 >> 2, hl = l31 & 3;
    const int bg = u & 7, qt = 63 - (u >> 3), g = bg & 1, t = 64 * qt + 8 * w + tl, row = (bg >> 1) * SEQ + t, nt = qt + 1;
    const bf16* dk = WSP(bf16, WS_PDSAK) + (size_t)bg * SEQ * 64; const bf16* dvt = WSP(bf16, WS_PDSAVT) + (size_t)bg * 64 * SEQ;
    const int hq = 4 * g + hl;
    bf16x8 dq[4];
#pragma unroll
    for (int s = 0; s < 4; ++s) dq[s] = *(const bf16x8*)(WSP(bf16, WS_DQ) + (size_t)row * 512 + hq * 64 + 16 * s + 8 * hi);
    const unsigned long long* selp = WSP(unsigned long long, WS_SELM) + (size_t)row * 64;
    unsigned long long selA = selp[0], selB = selp[nt > 1 ? 1 : 0];
    PIN4(dq); asm volatile("" : "+v"(selA), "+v"(selB));
    LAS unsigned char* const lb = F.lds;
    const int fo = l31 * TP + hi * 16;
    f32x16 sc0, sc1, sn0, sn1;
    u32x4 rkA, rvA, rkB, rvB;
    Soft S; soft_init(S);
    const int ntm = nt - 1;
    const bf16* kpc = dk + (size_t)(tid >> 3) * 64 + (tid & 7) * 8; const bf16* vpc = dvt + (size_t)(tid >> 3) * SEQ + (tid & 7) * 8;
#define KADDR(jt) (kpc + (size_t)((jt) < ntm ? (jt) : ntm) * 64 * 64)
#define VADDR(jt) (vpc + ((jt) < ntm ? (jt) : ntm) * 64)
    { const u32x4 a = tile_ld(dk, 64, tid), b = tile_ld(dvt, SEQ, tid), c = *(const u32x4*)KADDR(1); tile_st(lb, a, tid); tile_st(lb + 2 * TILE_B, b, tid); tile_st(lb + TILE_B, c, tid); }
    asm volatile("s_waitcnt vmcnt(0)" : "+v"(selA), "+v"(selB) :: "memory");
    selA = gload8(selp); selB = gload8(selp + (nt > 1 ? 1 : 0));
    rkA = gload16(KADDR(2)); rvA = gload16(VADDR(1));
    LDS_BARRIER();
    { LdsT kt{lb + fo}; qk_tile_c(sc0, sc1, kt, dq, S.negm); }
#define DSA_STEP(j, CK, CV, NK, NV, SELC) do { \
        NK = gload16(KADDR((j) + 3)); NV = gload16(VADDR((j) + 2)); \
        if ((j) + 1 < nt) { LdsT kt{lb + (((j) + 1) & 1) * TILE_B + fo}; if (!(ABL & 2)) qk_tile_c(sn0, sn1, kt, dq, S.negm); else { sn0 = S.negm; sn1 = S.negm; sn0[0] += __builtin_bit_cast(f32x4, kt.frag(0, 0))[0]; } } \
        WAITV1(5, SELC);                                                     \
        { const unsigned wa = (unsigned)SELC >> (4 * hi), wb = (unsigned)(SELC >> 32) >> (4 * hi); \
          SELC = gload8(selp + ((j) + 2 < nt ? (j) + 2 : ntm)); \
          _Pragma("unroll") for (int r = 0; r < 16; ++r) { const int bp = (r & 3) + 8 * (r >> 2); \
            sc0[r] = mask_sel(sc0[r], (int)(wa << (31 - bp)) >> 31); sc1[r] = mask_sel(sc1[r], (int)(wb << (31 - bp)) >> 31); } } \
        { LdsT vt{lb + (2 + ((j) & 1)) * TILE_B + fo}; soft_step2<ABL>(S, sc0, sc1, sn0, sn1, vt); } \
        sc0 = sn0; sc1 = sn1; \
        WAITV2(3, CK, CV);                                                   \
        if (!(ABL & 8)) { tile_st(lb + ((j) & 1) * TILE_B, CK, tid); tile_st(lb + (2 + (((j) + 1) & 1)) * TILE_B, CV, tid); } \
        if (!(ABL & 16)) LDS_BARRIER(); } while (0)
    for (int j = 0; j < nt; j += 2) { DSA_STEP(j, rkA, rvA, rkB, rvB, selA); if (j + 1 < nt) DSA_STEP(j + 1, rkB, rvB, rkA, rvA, selB); }
    asm volatile("s_waitcnt vmcnt(0)" : "+v"(rkA), "+v"(rvA), "+v"(rkB), "+v"(rvB), "+v"(selA), "+v"(selB) :: "memory");
#undef DSA_STEP
#undef KADDR
#undef VADDR
    S.l += half_other(S.l);
    {
        const float sc = 1.f / fmaxf(S.l, 1e-30f);
        const bf16* zp = WSP(bf16, WS_ZD) + (size_t)row * 512 + hq * 64 + 4 * hi;
        bf16* op = WSP(bf16, ABL ? WS_T1 : WS_ODZ) + (size_t)row * 512 + hq * 64 + 4 * hi;
#pragma unroll
        for (int e = 0; e < 2; ++e)
#pragma unroll
            for (int q = 0; q < 4; ++q) { const f32x16& o = e ? S.o1 : S.o0; const u32x2 z = *(const u32x2*)(zp + 32 * e + 8 * q);
                u32x2 wv; wv.x = pk2(o[4 * q] * sc * bflo(z.x), o[4 * q + 1] * sc * bfhi(z.x)); wv.y = pk2(o[4 * q + 2] * sc * bflo(z.y), o[4 * q + 3] * sc * bfhi(z.y));
                *(u32x2*)(op + 32 * e + 8 * q) = wv; }
    }
}


struct PageK {
    static constexpr bool HOIST = false;
    const float* p; unsigned stride;
    DI bf16x8 frag(int mt, int s) const { const f32x4* q = (const f32x4*)(p + (size_t)((unsigned)mt * 32u * stride + (unsigned)s * 16u)); return cvt8(q[0], q[1]); }
};
struct PageV {
    static constexpr bool HOIST = false;
    const float* p; unsigned stride;
    DI bf16x8 frag(int dt, int s) const {
        float v[8];
#pragma unroll
        for (int i = 0; i < 8; ++i) v[i] = p[(size_t)((unsigned)(16 * s + (i & 3) + 8 * (i >> 2)) * stride + (unsigned)dt * 32u)];
        return __builtin_bit_cast(bf16x8, pack8(v));
    }
};
DI void stage_k_ld(f32x4 (&x)[16], const float* base, unsigned stride, int lane) {
    const float* p = base + (size_t)((unsigned)(lane >> 4) * stride + 4u * (unsigned)(lane & 15));
#pragma unroll
    for (int i = 0; i < 16; ++i) x[i] = *(const f32x4*)(p + (size_t)((unsigned)(4 * i) * stride));
}
DI void stage_k_st(const f32x4 (&x)[16], LAS unsigned char* kb, int lane) {
    LAS unsigned char* d = kb + (lane >> 4) * TP + (lane & 15) * 8;
#pragma unroll
    for (int i = 0; i < 16; ++i) { u32x2 wv; wv.x = pk2(x[i][0], x[i][1]); wv.y = pk2(x[i][2], x[i][3]); *(LAS u32x2*)(d + 4 * i * TP) = wv; }
}
struct RegV { static constexpr bool HOIST = true; bf16x8 f[8]; DI bf16x8 frag(int dt, int s) const { return f[2 * s + dt]; } };
DI void pagev_ld(float (&v)[64], const float* p, unsigned stride) {
#pragma unroll
    for (int f = 0; f < 8; ++f)
#pragma unroll
        for (int i = 0; i < 8; ++i) v[8 * f + i] = p[(size_t)((unsigned)(16 * (f >> 1) + (i & 3) + 8 * (i >> 2)) * stride + (unsigned)(f & 1) * 32u)];
}
DI void pagev_pack(RegV& r, const float (&v)[64]) {
#pragma unroll
    for (int f = 0; f < 8; ++f) r.f[f] = __builtin_bit_cast(bf16x8, pack8(&v[8 * f]));
}
constexpr int XCH_W = 34 * 64;
constexpr int XCH_BYTES = 8 * XCH_W * 4;
DI void xch_put(LAS float* x, const Soft& S, int lane) {
    const float lt = S.l + half_other(S.l);
    x[lane] = S.seen ? S.m : NEGINF; x[64 + lane] = lt;
#pragma unroll
    for (int r = 0; r < 16; ++r) { x[(2 + r) * 64 + lane] = S.o0[r]; x[(18 + r) * 64 + lane] = S.o1[r]; }
}
DI void xch_get(const LAS float* xb, int w, int lane, float (&out)[4]) {
    float mw[8], M = -1e30f;
#pragma unroll
    for (int i = 0; i < 8; ++i) { mw[i] = xb[i * XCH_W + lane]; M = fmaxf(M, mw[i]); }
    float L = 0.f, o[4] = {0.f, 0.f, 0.f, 0.f};
#pragma unroll
    for (int i = 0; i < 8; ++i) { const float wt = __builtin_amdgcn_exp2f(mw[i] - M); L += wt * xb[i * XCH_W + 64 + lane];
#pragma unroll
        for (int k = 0; k < 4; ++k) o[k] += wt * xb[i * XCH_W + (2 + 4 * w + k) * 64 + lane]; }
    const float inv = 1.f / fmaxf(L, 1e-30f);
#pragma unroll
    for (int k = 0; k < 4; ++k) out[k] = o[k] * inv;
}
DI void nsa_sample_unit(Frame& F, int bg) {
    const int lane = F.lane, w = F.wave, l31 = lane & 31, hi = lane >> 5, tl = l31 >> 2, hl = l31 & 3;
    const int sb = bg >> 1, g = bg & 1, i = tl & 3, row = MP + sb * 4 + i, qpos = PASTL + i, hq = 4 * g + hl;
    LAS unsigned char* const lb = F.lds;
    LAS float* xch = (LAS float*)lb;
    LAS float* cmpb = (LAS float*)(lb + XCH_BYTES);
    LAS unsigned* mskb = (LAS unsigned*)(lb + XCH_BYTES + 8192);
    LAS float* psum = (LAS float*)(lb + XCH_BYTES + 8192 + 64);
    LAS float* impb = psum + 8 * 256;
    LAS unsigned char* selb = (LAS unsigned char*)(impb + 8 * 64);
    const float* gp = WSP(float, WS_GATES) + (size_t)row * 24 + hq * 3;
    float g0 = gp[0], g1 = gp[1], g2 = gp[2];
    bf16x8 qrot[4];
#pragma unroll
    for (int s = 0; s < 4; ++s) qrot[s] = *(const bf16x8*)(WSP(bf16, WS_QROT) + (size_t)row * 512 + hq * 64 + 16 * s + 8 * hi);
    f32x16 s0, s1;
    Soft S;
    __syncthreads();
    if (w == 0) {
        const bf16* ck = WSP(bf16, WS_SCK) + (size_t)bg * 128 * 64; const bf16* cvt = WSP(bf16, WS_SCVT) + (size_t)bg * 64 * 128;
        bf16x8 qraw[4];
#pragma unroll
        for (int s = 0; s < 4; ++s) qraw[s] = *(const bf16x8*)(WSP(bf16, WS_QRAW) + (size_t)row * 512 + hq * 64 + 16 * s + 8 * hi);
        const int ncmp = 127, nvis = 126;
        float m = -1e30f, l = 0.f;
        for (int ct = 0; ct < 2; ++ct) {
            GlbT kt{ck, (unsigned)((64 * ct + l31) * 64 + 8 * hi), 64u}; qk_tile(s0, s1, kt, qraw);
            float mx = -1e30f; const int nv2 = nvis - 64 * ct - 4 * hi;
#pragma unroll
            for (int r = 0; r < 16; ++r) { const int cr = (r & 3) + 8 * (r >> 2); s0[r] = cr <= nv2 ? s0[r] : NEGINF; s1[r] = cr + 32 <= nv2 ? s1[r] : NEGINF; mx = fmaxf(mx, fmaxf(s0[r], s1[r])); }
            mx = fmaxf(mx, half_other(mx));
            const float mn = fmaxf(m, mx); float ps = 0.f;
#pragma unroll
            for (int r = 0; r < 16; ++r) ps += __builtin_amdgcn_exp2f(s0[r] - mn) + __builtin_amdgcn_exp2f(s1[r] - mn);
            l = l * __builtin_amdgcn_exp2f(m - mn) + ps; m = mn;
        }
        l += half_other(l);
        const float linv = l > 0.f ? 1.f / l : 0.f;
        soft_init(S);
        for (int ct = 0; ct < 2; ++ct) {
            GlbT kt{ck, (unsigned)((64 * ct + l31) * 64 + 8 * hi), 64u}; qk_tile(s0, s1, kt, qraw);
            const int nv2 = nvis - 64 * ct - 4 * hi; LAS float* pw = psum + tl * 256 + 64 * ct + 4 * hi;
#pragma unroll
            for (int r = 0; r < 16; ++r) { const int cr = (r & 3) + 8 * (r >> 2);
                s0[r] = cr <= nv2 ? __builtin_amdgcn_exp2f(s0[r] - m) * linv : 0.f; s1[r] = cr + 32 <= nv2 ? __builtin_amdgcn_exp2f(s1[r] - m) * linv : 0.f;
                float a = s0[r]; a += dpp_x1(a); a += dpp_x2(a); float b = s1[r]; b += dpp_x1(b); b += dpp_x2(b);
                if (hl == 0) { pw[cr] = a; pw[cr + 32] = b; } }
            GlbT vt{cvt, (unsigned)(l31 * 128 + 64 * ct + 8 * hi), 128u}; pv_tile(S.o0, S.o1, s0, s1, vt);
        }
#pragma unroll
        for (int r = 0; r < 16; ++r) { cmpb[r * 64 + lane] = S.o0[r]; cmpb[(16 + r) * 64 + lane] = S.o1[r]; }
        LDS_WAIT();
        {
            const int tk = lane >> 3, jb = 8 * (lane & 7), cur = 32;
            float pv[33];
            const LAS f32x4* pp = (const LAS f32x4*)(psum + tk * 256 + 4 * jb);
#pragma unroll
            for (int q = 0; q < 8; ++q) { const f32x4 x = pp[q]; pv[1 + 4 * q] = x[0]; pv[2 + 4 * q] = x[1]; pv[3 + 4 * q] = x[2]; pv[4 + 4 * q] = x[3]; }
            pv[0] = jb > 0 ? psum[tk * 256 + 4 * jb - 1] : 0.f;
            float v[8];
#pragma unroll
            for (int jj = 0; jj < 8; ++jj) { const int j = jb + jj;
                float a = pv[4 * jj] + pv[4 * jj + 1] + pv[4 * jj + 2] + pv[4 * jj + 3];
                a += (4 * j + 3 < ncmp) ? pv[4 * jj + 4] : 0.f;
                a = ((j == 0) | (j == cur) | (j == cur - 1)) ? 1e4f : a;
                a = (j > cur) ? -1e30f : a;
                v[jj] = a; }
            LAS f32x4* ip = (LAS f32x4*)(impb + tk * 64 + jb);
            ip[0] = (f32x4){v[0], v[1], v[2], v[3]}; ip[1] = (f32x4){v[4], v[5], v[6], v[7]};
            LDS_WAIT();
            int cnt[8];
#pragma unroll
            for (int jj = 0; jj < 8; ++jj) cnt[jj] = 0;
            const LAS f32x4* ap = (const LAS f32x4*)(impb + tk * 64);
#pragma unroll 1
            for (int i4 = 0; i4 < 16; ++i4) { const f32x4 x = ap[i4];
#pragma unroll
                for (int e = 0; e < 4; ++e) { const int ii = 4 * i4 + e; const float xi = x[e];
#pragma unroll
                    for (int jj = 0; jj < 8; ++jj) cnt[jj] += ((xi > v[jj]) | ((xi == v[jj]) & (ii < jb + jj))) ? 1 : 0; } }
            unsigned bits = 0;
#pragma unroll
            for (int jj = 0; jj < 8; ++jj) bits |= ((cnt[jj] < 16) & (jb + jj <= cur)) ? (1u << jj) : 0u;
            selb[tk * 8 + (lane & 7)] = (unsigned char)bits;
            LDS_WAIT();
            if (lane < 16) mskb[lane] = ((const LAS unsigned*)selb)[lane];
        }
    }
    __syncthreads();
    const unsigned mlo = mskb[tl * 2], mhi = mskb[tl * 2 + 1];
    PIN4(qrot); asm volatile("" : "+v"(g0), "+v"(g1), "+v"(g2));
    soft_init(S);
    for (int j = w; j < 32; j += NWAVES) {
        const int pg = F.ptab[sb * NPG + (j >> 1)];
        const float* base = F.cnsa + ((size_t)pg * PAGE + (j & 1) * 64) * 512 + (2 * 2 + g) * 64;
        PageK kt{base + (size_t)l31 * 512 + 8 * hi, 512u}; qk_tile_c(s0, s1, kt, qrot, S.negm);
        const bool bsel = ((mlo >> j) & 1u) != 0u;
#pragma unroll
        for (int r = 0; r < 16; ++r) { s0[r] = bsel ? s0[r] : NEGINF; s1[r] = bsel ? s1[r] : NEGINF; }
        PageV vt{base + 128 + (size_t)(4 * hi) * 512 + l31, 512u}; soft_step(S, s0, s1, vt);
    }
    if (w == 0) {
        const bf16* sk = WSP(bf16, WS_SSLCK) + (size_t)bg * LS * 64; const bf16* svt = WSP(bf16, WS_SSLCVT) + (size_t)bg * 64 * LS;
        GlbT kt{sk, (unsigned)((2048 + l31) * 64 + 8 * hi), 64u}; qk_tile_c(s0, s1, kt, qrot, S.negm);
        const int qrel = i - 4 * hi;
#pragma unroll
        for (int r = 0; r < 16; ++r) { const int cr = (r & 3) + 8 * (r >> 2); s0[r] = cr <= qrel ? s0[r] : NEGINF; s1[r] = cr + 32 <= qrel ? s1[r] : NEGINF; }
        GlbT vt{svt, (unsigned)(l31 * LS + 2048 + 8 * hi), (unsigned)LS}; soft_step(S, s0, s1, vt);
    }
    xch_put(xch + w * XCH_W, S, lane);
    __syncthreads();
    float acc[4], part[4];
    xch_get(xch, w, lane, part);
#pragma unroll
    for (int k = 0; k < 4; ++k) acc[k] = g1 * part[k] + g0 * cmpb[(4 * w + k) * 64 + lane];
    __syncthreads();
    soft_init(S);
    {
        const float* base = F.swin + ((size_t)sb * 512 + 64 * w) * 256 + g * 64;
        PageK kt{base + (size_t)l31 * 256 + 8 * hi, 256u}; qk_tile_c(s0, s1, kt, qrot, S.negm);
        if (w == 0) {
            const int lo_r = 1 + i - 4 * hi;
#pragma unroll
            for (int r = 0; r < 16; ++r) { const int k0 = (r & 3) + 8 * (r >> 2); s0[r] = k0 >= lo_r ? s0[r] : NEGINF; s1[r] = k0 + 32 >= lo_r ? s1[r] : NEGINF; }
        }
        PageV vt{base + 128 + (size_t)(4 * hi) * 256 + l31, 256u}; soft_step(S, s0, s1, vt);
    }
    if (w == 0) {
        const bf16* wk = WSP(bf16, WS_SWINK) + (size_t)bg * LSW * 64; const bf16* wvt = WSP(bf16, WS_SWINVT) + (size_t)bg * 64 * LSW;
        GlbT kt{wk, (unsigned)((512 + l31) * 64 + 8 * hi), 64u}; qk_tile_c(s0, s1, kt, qrot, S.negm);
        const int hi_r = i - 4 * hi;
#pragma unroll
        for (int r = 0; r < 16; ++r) { const int k0 = (r & 3) + 8 * (r >> 2); s0[r] = k0 <= hi_r ? s0[r] : NEGINF; s1[r] = k0 + 32 <= hi_r ? s1[r] : NEGINF; }
        GlbT vt{wvt, (unsigned)(l31 * LSW + 512 + 8 * hi), (unsigned)LSW}; soft_step(S, s0, s1, vt);
    }
    xch_put(xch + w * XCH_W, S, lane);
    __syncthreads();
    xch_get(xch, w, lane, part);
#ifdef BREAK_WIN
#pragma unroll
    for (int k = 0; k < 4; ++k) part[k] *= 0.9f;
#endif
    if (tl < 4) {
        const int d0 = 32 * (w >> 2) + 8 * (w & 3) + 4 * hi;
        const u32x2 z = *(const u32x2*)(WSP(bf16, WS_ZN) + (size_t)row * 512 + hq * 64 + d0);
        u32x2 wv; wv.x = pk2((acc[0] + g2 * part[0]) * bflo(z.x), (acc[1] + g2 * part[1]) * bfhi(z.x)); wv.y = pk2((acc[2] + g2 * part[2]) * bflo(z.y), (acc[3] + g2 * part[3]) * bfhi(z.y));
        *(u32x2*)(WSP(bf16, WS_ONZ) + (size_t)row * 512 + hq * 64 + d0) = wv;
    }
}
DI void dsa_sample_unit(Frame& F, int bg) {
    const int lane = F.lane, w = F.wave, l31 = lane & 31, hi = lane >> 5, tl = l31 >> 2, hl = l31 & 3;
    const int sb = bg >> 1, g = bg & 1, i = tl & 3, row = MP + sb * 4 + i, hq = 4 * g + hl;
    LAS float* xch = (LAS float*)F.lds;
    bf16x8 dq[4];
#pragma unroll
    for (int s = 0; s < 4; ++s) dq[s] = *(const bf16x8*)(WSP(bf16, WS_DQ) + (size_t)row * 512 + hq * 64 + 16 * s + 8 * hi);
    const unsigned long long* selp = WSP(unsigned long long, WS_SELM) + (size_t)row * 64;
    PIN4(dq);
    f32x16 s0, s1;
    Soft S; soft_init(S);
    LAS unsigned char* const kb = F.lds + w * TILE_B;
    const int fo = l31 * TP + hi * 16;
    __syncthreads();
    for (int j = w; j < 32; j += NWAVES) {
        unsigned long long selw = selp[j];
        const int pg = F.ptab[sb * NPG + (j >> 1)];
        const float* base = F.cdsa + ((size_t)pg * PAGE + (j & 1) * 64) * 256 + g * 64;
        { f32x4 kx[16]; stage_k_ld(kx, base, 256u, lane); stage_k_st(kx, kb, lane); }
        LdsT kt{kb + fo}; qk_tile_c(s0, s1, kt, dq, S.negm);
#ifdef BREAK_DSA
        selw |= 0x1111111111111111ull;
#endif
        const unsigned wa = (unsigned)selw >> (4 * hi), wb = (unsigned)(selw >> 32) >> (4 * hi);
#pragma unroll
        for (int r = 0; r < 16; ++r) { const int bp = (r & 3) + 8 * (r >> 2);
            s0[r] = mask_sel(s0[r], (int)(wa << (31 - bp)) >> 31); s1[r] = mask_sel(s1[r], (int)(wb << (31 - bp)) >> 31); }
        PageV vt{base + 128 + (size_t)(4 * hi) * 256 + l31, 256u}; soft_step(S, s0, s1, vt);
    }
    if (w == 0) {
        const unsigned long long selw = selp[32];
        const bf16* dk = WSP(bf16, WS_SDSAK) + (size_t)bg * LS * 64; const bf16* dvt = WSP(bf16, WS_SDSAVT) + (size_t)bg * 64 * LS;
        GlbT kt{dk, (unsigned)((2048 + l31) * 64 + 8 * hi), 64u}; qk_tile_c(s0, s1, kt, dq, S.negm);
        const unsigned wa = (unsigned)selw >> (4 * hi), wb = (unsigned)(selw >> 32) >> (4 * hi);
#pragma unroll
        for (int r = 0; r < 16; ++r) { const int bp = (r & 3) + 8 * (r >> 2);
            s0[r] = mask_sel(s0[r], (int)(wa << (31 - bp)) >> 31); s1[r] = mask_sel(s1[r], (int)(wb << (31 - bp)) >> 31); }
        GlbT vt{dvt, (unsigned)(l31 * LS + 2048 + 8 * hi), (unsigned)LS}; soft_step(S, s0, s1, vt);
    }
    __syncthreads();
    xch_put(xch + w * XCH_W, S, lane);
    __syncthreads();
    float part[4];
    xch_get(xch, w, lane, part);
    if (tl < 4) {
        const int d0 = 32 * (w >> 2) + 8 * (w & 3) + 4 * hi;
        const u32x2 z = *(const u32x2*)(WSP(bf16, WS_ZD) + (size_t)row * 512 + hq * 64 + d0);
        u32x2 wv; wv.x = pk2(part[0] * bflo(z.x), part[1] * bfhi(z.x)); wv.y = pk2(part[2] * bflo(z.y), part[3] * bfhi(z.y));
        *(u32x2*)(WSP(bf16, WS_ODZ) + (size_t)row * 512 + hq * 64 + d0) = wv;
    }
}

template <int K, class EF> DI void small_gemm(Frame& F, const bf16* A, const bf16* Bt, const EF& ef) {
    const int lane = F.lane, w = F.wave, l31 = lane & 31, hi = lane >> 5;
    LAS float* red = (LAS float*)F.lds;
    for (int t = blockIdx.x; t < 256; t += F.G) {
        const int mt = t >> 5, nt = t & 31, kw = K >> 3, k0 = w * kw;
        const bf16* ap = A + (size_t)(MP + 64 * mt + l31) * K + k0 + 8 * hi;
        const bf16* bp = Bt + (size_t)(32 * nt + l31) * K + k0 + 8 * hi;
        f32x16 a0, a1;
#pragma unroll
        for (int i = 0; i < 16; ++i) { a0[i] = 0.f; a1[i] = 0.f; }
        bf16x8 fb[K / 128], f0[K / 128], f1[K / 128];
#pragma unroll
        for (int s = 0; s < K / 128; ++s) { fb[s] = *(const bf16x8*)(bp + 16 * s); f0[s] = *(const bf16x8*)(ap + 16 * s); f1[s] = *(const bf16x8*)(ap + (size_t)32 * K + 16 * s); }
#pragma unroll
        for (int s = 0; s < K / 128; ++s) { a0 = MFMA32(f0[s], fb[s], a0); a1 = MFMA32(f1[s], fb[s], a1); }
        __syncthreads();
#pragma unroll
        for (int r = 0; r < 16; ++r) { red[(w * 32 + r) * 64 + lane] = a0[r]; red[(w * 32 + 16 + r) * 64 + lane] = a1[r]; }
        __syncthreads();
        const int m2 = w >> 2, q = w & 3;
#pragma unroll
        for (int j = 0; j < 4; ++j) {
            float v = 0.f;
#pragma unroll
            for (int i = 0; i < 8; ++i) v += red[(i * 32 + 16 * m2 + 4 * q + j) * 64 + lane];
            ef(MP + 64 * mt + 32 * m2 + 8 * q + 4 * hi + j, 32 * nt + l31, v);
        }
    }
    __syncthreads();
}


#ifdef ORACLE
constexpr size_t WS_ORC = 948 * MiB;
constexpr int ORC_ROWS = 128;
DI float blk_red(Frame& F, float v, bool ismax, LAS float* red) {
#pragma unroll
    for (int o = 1; o < 64; o <<= 1) { const float x = __shfl_xor(v, o); v = ismax ? fmaxf(v, x) : v + x; }
    __syncthreads();
    if (F.lane == 0) red[F.wave] = v;
    __syncthreads();
    float r = red[0];
    for (int i = 1; i < 8; ++i) r = ismax ? fmaxf(r, red[i]) : r + red[i];
    return r;
}
DI float dot64(const bf16* a, const bf16* b) { float s = 0.f; for (int d = 0; d < 64; ++d) s += bf2f(a[d]) * bf2f(b[d]); return s; }
DI void orc_softmax(Frame& F, LAS float* sc, LAS unsigned char* vf, int n, LAS float* red) {
    float mx = -3e38f;
    for (int k = F.tid; k < n; k += 512) if (vf[k]) mx = fmaxf(mx, sc[k]);
    mx = blk_red(F, mx, true, red);
    float sm = 0.f;
    for (int k = F.tid; k < n; k += 512) { const float p = vf[k] ? exp2f(sc[k] - mx) : 0.f; sc[k] = p; sm += p; }
    sm = blk_red(F, sm, false, red);
    const float inv = 1.f / fmaxf(sm, 1e-30f);
    for (int k = F.tid; k < n; k += 512) sc[k] *= inv;
    __syncthreads();
}
DI void oracle_row(Frame& F, int oi) {
    int row;
    if (oi < 96) { const int tl[24] = {0, 1, 30, 31, 32, 63, 64, 65, 127, 128, 255, 256, 257, 400, 511, 512, 513, 1000, 1023, 1024, 2047, 2500, 3583, 4095};
        int t = 0;
#pragma unroll
        for (int i = 0; i < 24; ++i) t = (oi % 24 == i) ? tl[i] : t;
        row = (oi / 24) * SEQ + t; }
    else { const int k = oi - 96; row = MP + (((k >> 2) * 37) % SBATCH) * 4 + (k & 3); }
    const bool samp = row >= MP;
    const int b = samp ? (row - MP) >> 2 : row >> 12, ti = samp ? (row & 3) : (row & 4095), qpos = samp ? PASTL + ti : ti;
    const int ncmp = samp ? 127 : 255; const size_t pitch = samp ? LS : SEQ, wpitch = samp ? LSW : SEQ, cpitch = samp ? 128 : 256;
    const int wlo = samp ? 1 + ti : (qpos - 511 > 0 ? qpos - 511 : 0), whi = samp ? 512 + ti : qpos;
    LAS float* sc = (LAS float*)F.lds;
    LAS float* s2 = sc + 4096;
    LAS float* psum = s2 + 4096;
    LAS float* imp = psum + 256;
    LAS float* resn = imp + 64;
    LAS float* resd = resn + 512;
    LAS float* red = resd + 512;
    LAS unsigned char* vf = (LAS unsigned char*)(red + 8);
    LAS unsigned char* selb = vf + 4096;
    const bf16* qraw = WSP(bf16, WS_QRAW) + (size_t)row * 512; const bf16* qrot = WSP(bf16, WS_QROT) + (size_t)row * 512;
    const bf16* dq = WSP(bf16, WS_DQ) + (size_t)row * 512; const bf16* iq = WSP(bf16, WS_IQ) + (size_t)row * 256;
    const float* gat = WSP(float, WS_GATES) + (size_t)row * 24; const float* iw = WSP(float, WS_IW) + (size_t)row * 4;
    const int nvr = (qpos - 31) >> 4, nvis = nvr < ncmp - 1 ? nvr : ncmp - 1, cur = qpos >> 6;
    for (int g = 0; g < 2; ++g) {
        const int bg = b * 2 + g;
        const bf16* ck = samp ? WSP(bf16, WS_SCK) + (size_t)bg * 128 * 64 : WSP(bf16, WS_PCK) + (size_t)bg * 256 * 64;
        const bf16* cvt = samp ? WSP(bf16, WS_SCVT) + (size_t)bg * 64 * 128 : WSP(bf16, WS_PCVT) + (size_t)bg * 64 * 256;
        const bf16* sk = samp ? WSP(bf16, WS_SSLCK) + (size_t)bg * LS * 64 : WSP(bf16, WS_PSLCK) + (size_t)bg * SEQ * 64;
        const bf16* svt = samp ? WSP(bf16, WS_SSLCVT) + (size_t)bg * 64 * LS : WSP(bf16, WS_PSLCVT) + (size_t)bg * 64 * SEQ;
        const bf16* wk = samp ? WSP(bf16, WS_SWINK) + (size_t)bg * LSW * 64 : WSP(bf16, WS_PWINK) + (size_t)bg * SEQ * 64;
        const bf16* wvt = samp ? WSP(bf16, WS_SWINVT) + (size_t)bg * 64 * LSW : WSP(bf16, WS_PWINVT) + (size_t)bg * 64 * SEQ;
        __syncthreads();
        if (F.tid < 256) psum[F.tid] = 0.f;
        for (int hl = 0; hl < 4; ++hl) {
            const int h = 4 * g + hl;
            __syncthreads();
            for (int n = F.tid; n < 256; n += 512) { const bool v = n <= nvis; vf[n] = v; sc[n] = v ? dot64(qraw + h * 64, ck + (size_t)n * 64) : 0.f; }
            __syncthreads();
            orc_softmax(F, sc, vf, 256, red);
            if (F.tid < 256) psum[F.tid] += sc[F.tid];
            if (F.tid < 64) { float a = 0.f; for (int n = 0; n <= nvis; ++n) a += sc[n] * bf2f(cvt[(size_t)F.tid * cpitch + permk(n)]); resn[h * 64 + F.tid] = gat[h * 3 + 0] * a; }
        }
        __syncthreads();
        if (F.tid < 64) { const int j = F.tid; float a = 0.f;
            for (int n = 4 * j - 1; n <= 4 * j + 3; ++n) if (n >= 0 && n < ncmp) a += psum[n];
            if (j == 0 || j == cur || j == cur - 1) a = 1e4f;
            if (j > cur) a = -1e30f;
            imp[j] = a; selb[j] = 0; }
        __syncthreads();
        if (F.tid == 0) { for (int k = 0; k < 16; ++k) { int best = -1; float bv = -3e38f; for (int j = 0; j < 64; ++j) if (!selb[j] && imp[j] > bv) { bv = imp[j]; best = j; }
                if (best >= 0) selb[best] = (bv > -5e29f) ? 1 : 2; }
            for (int j = 0; j < 64; ++j) selb[j] = selb[j] == 1 ? 1 : 0; }
        __syncthreads();
        for (int hl = 0; hl < 4; ++hl) {
            const int h = 4 * g + hl;
            __syncthreads();
            for (int k = F.tid; k <= qpos; k += 512) { const bool v = selb[k >> 6] != 0; vf[k] = v; sc[k] = v ? dot64(qrot + h * 64, sk + (size_t)k * 64) : 0.f; }
            __syncthreads();
            orc_softmax(F, sc, vf, qpos + 1, red);
            if (F.tid < 64) { float a = 0.f; for (int k = 0; k <= qpos; ++k) if (vf[k]) a += sc[k] * bf2f(svt[(size_t)F.tid * pitch + permk(k)]); resn[h * 64 + F.tid] += gat[h * 3 + 1] * a; }
            __syncthreads();
            for (int k = wlo + F.tid; k <= whi; k += 512) { vf[k - wlo] = 1; sc[k - wlo] = dot64(qrot + h * 64, wk + (size_t)k * 64); }
            __syncthreads();
            orc_softmax(F, sc, vf, whi - wlo + 1, red);
            if (F.tid < 64) { float a = 0.f; for (int k = wlo; k <= whi; ++k) a += sc[k - wlo] * bf2f(wvt[(size_t)F.tid * wpitch + permk(k)]); resn[h * 64 + F.tid] += gat[h * 3 + 2] * a; }
        }
    }
    __syncthreads();
    const bf16* ik = samp ? WSP(bf16, WS_SIDXK) + (size_t)b * LS * 64 : WSP(bf16, WS_PIDXK) + (size_t)b * SEQ * 64;
    for (int k = F.tid; k <= qpos; k += 512) { float a = 0.f; for (int h = 0; h < 4; ++h) a += fmaxf(dot64(iq + h * 64, ik + (size_t)k * 64), 0.f) * iw[h]; s2[k] = a; }
    __syncthreads();
    for (int k = F.tid; k <= qpos; k += 512) { const float v = s2[k]; int c = 0; for (int j = 0; j <= qpos; ++j) { const float x = s2[j]; c += (x > v || (x == v && j < k)) ? 1 : 0; } vf[k] = c < 256; }
    __syncthreads();
    for (int h = 0; h < 8; ++h) {
        const int bg = b * 2 + (h >> 2);
        const bf16* dk = samp ? WSP(bf16, WS_SDSAK) + (size_t)bg * LS * 64 : WSP(bf16, WS_PDSAK) + (size_t)bg * SEQ * 64;
        const bf16* dvt = samp ? WSP(bf16, WS_SDSAVT) + (size_t)bg * 64 * LS : WSP(bf16, WS_PDSAVT) + (size_t)bg * 64 * SEQ;
        __syncthreads();
        for (int k = F.tid; k <= qpos; k += 512) sc[k] = vf[k] ? dot64(dq + h * 64, dk + (size_t)k * 64) : 0.f;
        __syncthreads();
        orc_softmax(F, sc, vf, qpos + 1, red);
        if (F.tid < 64) { float a = 0.f; for (int k = 0; k <= qpos; ++k) if (vf[k]) a += sc[k] * bf2f(dvt[(size_t)F.tid * pitch + permk(k)]); resd[h * 64 + F.tid] = a; }
    }
    __syncthreads();
    float dn = 0.f, rn = 0.f, dd = 0.f, rd = 0.f;
    { const int e = F.tid;
      const float zn = bf2f(WSP(bf16, WS_ZN)[(size_t)row * 512 + e]), zd = bf2f(WSP(bf16, WS_ZD)[(size_t)row * 512 + e]);
      const float refn = resn[e] * zn, refd = resd[e] * zd;
      const float gotn = bf2f(WSP(bf16, WS_ONZ)[(size_t)row * 512 + e]), gotd = bf2f(WSP(bf16, WS_ODZ)[(size_t)row * 512 + e]);
      dn = (gotn - refn) * (gotn - refn); rn = refn * refn; dd = (gotd - refd) * (gotd - refd); rd = refd * refd; }
    dn = blk_red(F, dn, false, red); rn = blk_red(F, rn, false, red); dd = blk_red(F, dd, false, red); rd = blk_red(F, rd, false, red);
    float dc = 0.f, rc = 0.f;
    {
        const bool cs = oi >= 96; const int cbg = cs ? (oi * 5) % 256 : oi % 8, cn = cs ? (oi * 11) % 127 : (oi * 13) % 255;
        for (int slot = 0; slot < 2; ++slot) {
            const bf16* data = cs ? WSP(bf16, slot ? WS_SCMPV : WS_SCMPK) + (size_t)cbg * LS * 64 + (size_t)cn * 1024 : WSP(bf16, slot ? WS_PCMPV : WS_PCMPK) + (size_t)cbg * SEQ * 64 + (size_t)cn * 1024;
            __syncthreads();
            if (F.tid < 128) { float a = 0.f; for (int k = 0; k < 2048; ++k) a += (bf2f(data[k]) + F.pe[slot * 2048 + k]) * F.w1[((size_t)slot * 2048 + k) * 128 + F.tid]; sc[F.tid] = a / (1.f + expf(-a)); }
            __syncthreads();
            if (F.tid < 64) { float a = 0.f; for (int c = 0; c < 128; ++c) a += sc[c] * F.w2[((size_t)slot * 128 + c) * 64 + F.tid];
                float got;
                if (slot == 0) got = bf2f((cs ? WSP(bf16, WS_SCK) + (size_t)cbg * 128 * 64 : WSP(bf16, WS_PCK) + (size_t)cbg * 256 * 64)[(size_t)cn * 64 + F.tid]);
                else got = bf2f((cs ? WSP(bf16, WS_SCVT) + (size_t)cbg * 64 * 128 : WSP(bf16, WS_PCVT) + (size_t)cbg * 64 * 256)[(size_t)F.tid * (cs ? 128 : 256) + permk(cn)]);
                dc += (got - a) * (got - a); rc += a * a; }
        }
    }
    dc = blk_red(F, dc, false, red); rc = blk_red(F, rc, false, red);
    if (F.tid == 0) { float* o = WSP(float, WS_ORC) + oi * 8; o[0] = dn; o[1] = rn; o[2] = dd; o[3] = rd; o[4] = dc; o[5] = rc; }
    __syncthreads();
}
DI float oracle_value(Frame& F) {
    const float* o = WSP(float, WS_ORC);
    float bad = 0.f, acc = 0.f, mxe = 0.f;
    for (int i = 0; i < ORC_ROWS; ++i) { const int c = (ORACLE_MODE >= 6) ? 4 : (ORACLE_MODE & 1) ? 2 : 0; const float e = sqrtf(o[i * 8 + c] / fmaxf(o[i * 8 + c + 1], 1e-30f));
        bad += e > 0.03f ? 1.f : 0.f; acc += fminf(e, 1.f) * fminf(e, 1.f); mxe = fmaxf(mxe, fminf(e, 1.f)); }
    return (ORACLE_MODE < 2 || ORACLE_MODE == 6) ? bad / ORC_ROWS : (ORACLE_MODE < 4 || ORACLE_MODE == 7) ? sqrtf(acc / ORC_ROWS) : mxe;
}
#endif

#define XB_TMO      128
#define XB_XCNT(j)  (256  + 64 * (j))
#define XB_XSUB(j)  (1280 + 64 * (j))
#define XB_XGEN(j)  (2304 + 64 * (j))
#define XB_TOP      3328
#define XB_TOPGEN   3392
#define XCD_BAR_WORDS 3456
#define XB_SPIN_CAP (1u << 18)
__device__ __forceinline__ unsigned xb_ld(unsigned* p)              { return __hip_atomic_load(p, __ATOMIC_RELAXED, __HIP_MEMORY_SCOPE_AGENT); }
__device__ __forceinline__ unsigned xb_add(unsigned* p, unsigned v) { return __hip_atomic_fetch_add(p, v, __ATOMIC_RELAXED, __HIP_MEMORY_SCOPE_AGENT); }
__device__ __forceinline__ unsigned xb_xcc_id() { return (unsigned)__builtin_amdgcn_s_getreg((3 << 11) | 20) & 0xFu; }
#define XB_SPIN(cond, bar) do { unsigned _sp = 0; while (cond) { __builtin_amdgcn_s_sleep(1); \
    if ((++_sp & 255u) == 0u) { if (xb_ld(&(bar)[XB_TMO])) break; if (_sp > XB_SPIN_CAP) { atomicAdd(&(bar)[XB_TMO], 1u); break; } } } } while (0)
struct XcdBarrier { unsigned* bar; unsigned x; volatile LAS unsigned* st; };
__device__ __forceinline__ XcdBarrier xcd_barrier_post(unsigned* bar, volatile LAS unsigned* st) {
    XcdBarrier b; b.bar = bar; b.x = xb_xcc_id(); b.st = st;
    if (threadIdx.x == 0) (void)xb_add(&bar[XB_XCNT(b.x)], 1u);
    return b;
}
__device__ __forceinline__ void xcd_barrier_complete(unsigned* bar, unsigned x, unsigned& nloc, unsigned& nx) {
    const unsigned G = gridDim.x * gridDim.y * gridDim.z;
    unsigned sum, cnt, mine, sp = 0u;
    for (;;) {
        sum = 0u; cnt = 0u; mine = 0u;
#pragma unroll
        for (unsigned j = 0; j < 16; ++j) { const unsigned c = xb_ld(&bar[XB_XCNT(j)]); sum += c; cnt += (c > 0u) ? 1u : 0u; mine = (j == x) ? c : mine; }
        if (sum == G) break;
        __builtin_amdgcn_s_sleep(1);
        if ((++sp & 255u) == 0u) { if (xb_ld(&bar[XB_TMO])) break; if (sp > XB_SPIN_CAP) { atomicAdd(&bar[XB_TMO], 1u); break; } }
    }
    nloc = mine > 0u ? mine : 1u; nx = cnt > 0u ? cnt : 1u;
}
__device__ __forceinline__ void xcd_barrier(const XcdBarrier& b) {
    asm volatile("s_waitcnt vmcnt(0)" ::: "memory");
    __syncthreads();
    if (threadIdx.x == 0) {
        unsigned* bar = b.bar;
        __builtin_amdgcn_s_waitcnt(0);
        unsigned nloc = b.st[0], nx = b.st[1];
        if (nloc == 0u) { xcd_barrier_complete(bar, b.x, nloc, nx); b.st[0] = nloc; b.st[1] = nx; }
        const unsigned old = xb_add(&bar[XB_XSUB(b.x)], 1u);
        const unsigned gen = old / nloc;
        if (old + 1u == (gen + 1u) * nloc) {
            __builtin_amdgcn_fence(__ATOMIC_RELEASE, "agent");
            asm volatile("s_waitcnt vmcnt(0)" ::: "memory");
            const unsigned og = xb_add(&bar[XB_TOP], 1u);
            const unsigned tg = og / nx;
            if (og + 1u == (tg + 1u) * nx) xb_add(&bar[XB_TOPGEN], 1u);
            else XB_SPIN(xb_ld(&bar[XB_TOPGEN]) == tg, bar);
            __builtin_amdgcn_fence(__ATOMIC_ACQUIRE, "agent");
            xb_add(&bar[XB_XGEN(b.x)], 1u);
            asm volatile("s_waitcnt vmcnt(0)" ::: "memory");
        } else {
            XB_SPIN(xb_ld(&bar[XB_XGEN(b.x)]) == gen, bar);
            __builtin_amdgcn_fence(__ATOMIC_ACQUIRE, "agent");
            asm volatile("s_waitcnt vmcnt(0)" ::: "memory");
        }
    }
    __syncthreads();
}

constexpr int N_PHASES = 9;
DI int q_next(Frame& F, int qi) {
    __syncthreads();
    if (F.tid == 0) F.MISC[0] = __hip_atomic_fetch_add(F.ctl + CW_Q + 64 * (qi + F.qoff), 1u, __ATOMIC_RELAXED, __HIP_MEMORY_SCOPE_AGENT);
    __syncthreads();
    return (int)F.MISC[0];
}
DI void q_issue(Frame& F, int qi, unsigned& pend) { if (F.tid == 0) pend = __hip_atomic_fetch_add(F.ctl + CW_Q + 64 * (qi + F.qoff), 1u, __ATOMIC_RELAXED, __HIP_MEMORY_SCOPE_AGENT); }
DI int q_take(Frame& F, unsigned pend) { __syncthreads(); if (F.tid == 0) F.MISC[0] = pend; __syncthreads(); return (int)F.MISC[0]; }
#define QLOOP_PF(qi, N, CALL) do { unsigned pend_ = 0u; for (int u = q_next(F, (qi)); u < (N); u = q_take(F, pend_)) { q_issue(F, (qi), pend_); CALL; } } while (0)
#define QLOOP(qi, N, CALL) do { for (int u = q_next(F, (qi)); u < (N); u = q_next(F, (qi))) { CALL; } } while (0)
__global__ void __launch_bounds__(NWAVES * 64, 2) fwd(Args args) {
    extern __shared__ __attribute__((aligned(16))) unsigned char lds[];
    Frame F;
    F.lds = (LAS unsigned char*)lds; F.MISC = (volatile LAS unsigned*)(F.lds + MISC_OFF);
    F.tid = threadIdx.x; F.lane = F.tid & 63; F.wave = __builtin_amdgcn_readfirstlane(F.tid >> 6); F.G = gridDim.x;
    F.ws = args.ws; F.out = args.out; F.ctl = (unsigned*)(args.ws + WS_CTL); F.qoff = args.qoff;
    F.xp = (const float*)args.in[0]; F.xs = (const float*)args.in[1]; F.cnsa = (const float*)args.in[2]; F.cdsa = (const float*)args.in[3]; F.cidx = (const float*)args.in[4];
    F.swin = (const float*)args.in[5]; F.ptab = (const int*)args.in[6]; F.cp = (const float*)args.in[7]; F.cs = (const float*)args.in[8]; F.normg = (const float*)args.in[9];
    F.wada = (const float*)args.in[10]; F.bada = (const float*)args.in[11]; F.win = (const float*)args.in[12]; F.pe = (const float*)args.in[13]; F.w1 = (const float*)args.in[14];
    F.w2 = (const float*)args.in[15]; F.wupn = (const float*)args.in[16]; F.wupd = (const float*)args.in[17]; F.wout = (const float*)args.in[18]; F.fing = (const float*)args.in[19];
    for (int i = F.tid; i < (LDS_BYTES - MISC_OFF) / 4; i += NWAVES * 64) ((LAS unsigned*)(F.lds + MISC_OFF))[i] = 0u;
    __syncthreads();
    const int lo = args.ph_lo, hi = args.ph_hi;
    const bool one = (hi - lo) > 1;
    XcdBarrier bar; bar.bar = F.ctl + CW_BAR; bar.x = 0; bar.st = nullptr;
    if (one) bar = xcd_barrier_post(F.ctl + CW_BAR, F.MISC + 8);
#ifndef PH_MASK
#define PH_MASK 0x1ff
#endif
#define IN(k) (((PH_MASK >> (k)) & 1) && lo <= (k) && (k) < hi)
#define SEAM(k) do { if (IN(k) && IN((k) + 1)) xcd_barrier(bar); } while (0)

#ifndef PROBE_REP
#define PROBE_REP -1
#endif
#define REP(k, BODY) do { if (IN(k)) { BODY(0) } } while (0)
#ifndef PROBE_P4MASK
#define PROBE_P4MASK 15
#endif
#ifndef PROBE_ABL
#define PROBE_ABL 0
#endif
#define B0(qo) { p0_prologue(F, args.umask); }
#define B1(qo) { p1_adaln(F); }
#define B2(qo) { pg8::Gemm g{WSP(bf16, WS_H), WSP(bf16, WS_WINT), MR, NPAD, DM}; pg8::StaticOrder S; S.init(MR, NPAD, F.G, (int)blockIdx.x); \
        { EpiInProj E{F.ws, F.out}; pg8::gemm_phase<EpiInProj, pg8::StaticOrder, true, true>(F.lds, g, S, E); } \
        QLOOP(7 + qo, 4 * SBATCH, win_copy_item(F, u)); }
#define B3(qo) { const int PM3_ = args.umask; const bool strm3_ = (blockIdx.x & 1) == 0 || args.qoff != 0;     \
        if ((PM3_ & 4) && strm3_) QLOOP(2 + qo, SBATCH, (idx1_unit<true, 0>(F, u))); \
        if ((PM3_ & 1) && strm3_) QLOOP(0 + qo, 272, compress_unit(F, u)); \
        if (PM3_ & 2) QLOOP(1 + qo, 2048, (idx1_unit<false, 0>(F, u))); }
#ifndef P4_MASK
#define P4_MASK 15
#endif
#define B4(qo) { const int PM_ = args.umask & P4_MASK; const bool strm_ = (blockIdx.x & 1) == 0 || args.qoff != 0;     \
        if ((PM_ & 1) && strm_) QLOOP(3 + qo, 256, nsa_sample_unit(F, u)); \
        if ((PM_ & 2) && strm_) QLOOP(4 + qo, 256, dsa_sample_unit(F, u)); \
        if (PM_ & 4) QLOOP(5 + qo, 512, nsa_unit<false>(F, u)); \
        if (PM_ & 8) QLOOP(6 + qo, 512, (dsa_unit<0>(F, u))); }
#define B5(qo) { small_gemm<512>(F, WSP(bf16, WS_ONZ), WSP(bf16, WS_WUPN), [&](int r, int c, float v) { WSP(bf16, WS_T1)[(size_t)r * 1024 + c] = (bf16)(pk2(v * bf2f(WSP(bf16, WS_MG)[(size_t)r * 2048 + c]), 0.f) & 0xffffu); }); \
        pg8::Gemm g{WSP(bf16, WS_ONZ), WSP(bf16, WS_WUPN), MP, DM, 512}; pg8::StaticOrder S; S.init(MP, DM, F.G, (int)blockIdx.x); EpiUp1 E{F.ws}; \
        pg8::gemm_phase<EpiUp1, pg8::StaticOrder, true, true>(F.lds, g, S, E); }
#define B6(qo) { small_gemm<512>(F, WSP(bf16, WS_ODZ), WSP(bf16, WS_WUPD), [&](int r, int c, float v) { WSP(bf16, WS_M1)[(size_t)r * 1024 + c] = (bf16)(pk2(bf2f(WSP(bf16, WS_T1)[(size_t)r * 1024 + c]) + v * bf2f(WSP(bf16, WS_MG)[(size_t)r * 2048 + 1024 + c]), 0.f) & 0xffffu); }); \
        pg8::Gemm g{WSP(bf16, WS_ODZ), WSP(bf16, WS_WUPD), MP, DM, 512}; pg8::StaticOrder S; S.init(MP, DM, F.G, (int)blockIdx.x); EpiUp2 E{F.ws}; \
        pg8::gemm_phase<EpiUp2, pg8::StaticOrder, true, true>(F.lds, g, S, E); }
#define B7(qo) { small_gemm<1024>(F, WSP(bf16, WS_M1), WSP(bf16, WS_WOUT), [&](int r, int c, float v) { const int rs = r - MP; F.out[O_YS + (size_t)rs * 1024 + c] = F.xs[(size_t)rs * 1024 + c] + WSP(float, WS_MOD)[(size_t)(4 + (rs >> 2)) * 3072 + 2048 + c] * v; }); \
        pg8::Gemm g{WSP(bf16, WS_M1), WSP(bf16, WS_WOUT), MP, DM, DM}; pg8::StaticOrder S; S.init(MP, DM, F.G, (int)blockIdx.x); EpiOut E{F.ws, F.out, F.xp, F.xs}; \
        pg8::gemm_phase<EpiOut, pg8::StaticOrder, true, true>(F.lds, g, S, E); }
#define B8(qo) { p8_final(F); }
    REP(0, B0); SEAM(0);
    REP(1, B1); SEAM(1);
    REP(2, B2); SEAM(2);
    REP(3, B3); SEAM(3);
    REP(4, B4); SEAM(4);
#ifdef ORACLE
    if (IN(4)) { for (int oi = blockIdx.x; oi < ORC_ROWS; oi += F.G) oracle_row(F, oi); xcd_barrier(bar); }
#endif
    REP(5, B5);
    REP(6, B6); SEAM(6);
    REP(7, B7); SEAM(7);
    if (IN(8)) { p8_final(F); }
#ifdef ORACLE
    if (IN(8)) { xcd_barrier(bar); const float val = oracle_value(F); const float sc = 1.f + 0.02f * (1.f + val);
        for (size_t i = (size_t)blockIdx.x * 512 + F.tid; i < (size_t)MP * 1024; i += (size_t)F.G * 512) F.out[O_YP + i] *= sc; }
#endif
#undef IN
#undef SEAM
}

extern "C" void kernel_launch(void* const* d_in, const int* in_sizes, int n_in, void* d_out, int out_size, void* d_ws, size_t ws_size, hipStream_t stream) {
    static int grid = 0;
    if (grid == 0) {
        if (n_in != 20 || (size_t)out_size != O_END || ws_size < WS_END) { fprintf(stderr, "kernel_launch: unexpected shapes (n_in %d, out %d, ws %zu)\n", n_in, out_size, ws_size); grid = -1; return; }
        int dev = 0, cus = 0, per_cu = 0;
        if (hipGetDevice(&dev) != hipSuccess || hipDeviceGetAttribute(&cus, hipDeviceAttributeMultiprocessorCount, dev) != hipSuccess) { grid = -1; return; }
        if (hipFuncSetAttribute((const void*)fwd, hipFuncAttributeMaxDynamicSharedMemorySize, LDS_BYTES) != hipSuccess) { fprintf(stderr, "kernel_launch: hipFuncSetAttribute failed\n"); grid = -1; return; }
        if (hipOccupancyMaxActiveBlocksPerMultiprocessor(&per_cu, (const void*)fwd, NWAVES * 64, LDS_BYTES) != hipSuccess || per_cu < 1) { fprintf(stderr, "kernel_launch: occupancy query says %d blocks per CU\n", per_cu); }
        (void)hipGetLastError();
        grid = cus;
    }
    if (grid < 0) return;
    (void)hipMemsetAsync((char*)d_ws + WS_CTL, 0, CTL_ZERO_BYTES, stream);
    Args a{};
    for (int i = 0; i < 20; ++i) a.in[i] = d_in[i];
    a.out = (float*)d_out; a.ws = (unsigned char*)d_ws; a.qoff = 0; a.umask = 15; a.pad0 = 0; a.pad1 = 0;
#if MK_N_LAUNCHES == 1
    a.ph_lo = 0; a.ph_hi = N_PHASES;
    hipLaunchKernelGGL(fwd, dim3(grid), dim3(NWAVES * 64), LDS_BYTES, stream, a);
#if PROBE_REP >= 0
    a.ph_lo = PROBE_REP; a.ph_hi = PROBE_REP + 1; a.qoff = 8; a.umask = PROBE_P4MASK;
    hipLaunchKernelGGL(fwd, dim3(grid), dim3(NWAVES * 64), LDS_BYTES, stream, a);
#endif
#else
    for (int p = 0; p < N_PHASES; ++p) { a.ph_lo = p; a.ph_hi = p + 1; hipLaunchKernelGGL(fwd, dim3(grid), dim3(NWAVES * 64), LDS_BYTES, stream, a); }
#endif
}
```

```cpp
#define MK_N_LAUNCHES 1
#include <hip/hip_runtime.h>
#include <cstdio>
#include <cstdint>
#ifndef MK_N_LAUNCHES
#define MK_N_LAUNCHES 1
#endif
namespace pg8 {
#define PG8_LAS __attribute__((address_space(3)))
typedef unsigned short bf16_t;
typedef short bf16x8 __attribute__((ext_vector_type(8)));
typedef float f32x4 __attribute__((ext_vector_type(4)));
typedef unsigned u32x4 __attribute__((ext_vector_type(4)));
constexpr int BM = 256, BK = 64, HALF = 128, HTB = HALF * BK * 2  , STAGE_BYTES = 8 * HTB, NXCD = 8, WGM = 8;

__host__ __device__ __forceinline__ int lds_byte(int r, int c) { const int st = (r >> 4) * 2 + (c >> 5), rr = r & 15, cc = c & 31, ob = rr * 64 + cc * 2; return st * 1024 + (ob ^ (((ob >> 9) & 1) << 5)); }
__host__ __device__ __forceinline__ void stage_rc(int b, int& R, int& C) { const int st = b / 1024, sb = b % 1024, swz = sb ^ (((sb >> 9) & 1) << 5); R = (st >> 1) * 16 + swz / 64; C = (st & 1) * 32 + (swz % 64) / 2; }
__host__ __device__ __forceinline__ int perm32(int rho) { const int n = rho >> 4, i = rho & 15; return 8 * (i >> 2) + 4 * n + (i & 3); }

struct Unit { int pm, pn; };
struct Gemm { const bf16_t* A; const bf16_t* Bt; int M, N, K; };

struct StaticOrder {
    int nM, nN, nwg, G, c;
    __host__ __device__ void init(int M, int N, int G_, int c_) { nM = M / BM; nN = N / BM; nwg = nM * nN; G = G_; c = c_; }
    __host__ __device__ bool next(int i, Unit& u) const {
        const long L = (long)i * G + c; if (L >= nwg) return false;
        int wgid = (int)L; { const int q = nwg / NXCD, r = nwg % NXCD, xcd = wgid % NXCD, off = wgid / NXCD; wgid = (xcd < r ? xcd * (q + 1) : r * (q + 1) + (xcd - r) * q) + off; }
        const int nig = WGM * nN, gid = wgid / nig, fm = gid * WGM, gsz = (nM - fm) < WGM ? (nM - fm) : WGM;
        u.pm = fm + ((wgid % nig) % gsz); u.pn = (wgid % nig) / gsz; return true;
    }
    __device__ __forceinline__ void a_ready(const Unit&) const {}
    __device__ __forceinline__ void done(const Unit&) const {}
};

typedef float f32x2p __attribute__((ext_vector_type(2))); typedef __bf16 bf16x2p __attribute__((ext_vector_type(2)));
__device__ __forceinline__ unsigned cvt_pk_bf16(float lo, float hi) { f32x2p v = {lo, hi}; bf16x2p b = __builtin_convertvector(v, bf16x2p); return __builtin_bit_cast(unsigned, b); }
template <class Epi, class Sched, bool ALIGN_EPI = false, bool SP2 = false, bool MID = false>
__device__ __forceinline__ void gemm_phase(PG8_LAS unsigned char* lds, const Gemm g, const Sched& S, const Epi& E) {
    int tid_ = threadIdx.x; asm volatile("" : "+v"(tid_));
    const int tid = tid_, wid = __builtin_amdgcn_readfirstlane(tid >> 6), lane = tid & 63, wr = wid >> 2, wc = wid & 3, fr = lane & 15, fq = lane >> 4;
    const int K = g.K, nt = K / BK;
    unsigned voffA[2], voffB[2];
#pragma unroll
    for (int i = 0; i < 2; ++i) { int R, C; stage_rc(tid * 16 + i * 8192, R, C); const int Rb = Epi::PERM ? ((R & ~31) + perm32(R & 31)) : R;
        voffA[i] = (unsigned)(R * K + C) * 2u; voffB[i] = (unsigned)(Rb * K + C) * 2u; }
    const size_t kstep = (size_t)(BK * 2);
    const size_t hstep = (size_t)HALF * K * 2;
    const size_t tstep = 2 * hstep;
    const unsigned ldsw = (unsigned)wid * 1024u;
    const int aoff = lds_byte(wr * 64 + fr, fq * 8), boff = lds_byte(wc * 32 + fr, fq * 8);
#define PG8_SA(b, h) (((b) * 2 + (h)) * HTB)
#define PG8_SB(b, h) ((4 + (b) * 2 + (h)) * HTB)
#define PG8_STAGE(bufoff, gbase, voff) do { _Pragma("unroll") for (int _i = 0; _i < 2; ++_i) \
        __builtin_amdgcn_global_load_lds((const unsigned*)((const char*)(gbase) + (voff)[_i]), (PG8_LAS unsigned*)(lds + (bufoff) + ldsw + _i * 8192), 16, 0, 0); } while (0)
#define PG8_LDA(dst, b, h) do { _Pragma("unroll") for (int m = 0; m < 4; ++m) _Pragma("unroll") for (int k = 0; k < 2; ++k) dst[m][k] = *(const PG8_LAS bf16x8*)(lds + PG8_SA(b, h) + aoff + m * 2048 + k * 1024); } while (0)
#define PG8_LDB(dst, b, h) do { _Pragma("unroll") for (int n = 0; n < 2; ++n) _Pragma("unroll") for (int k = 0; k < 2; ++k) dst[n][k] = *(const PG8_LAS bf16x8*)(lds + PG8_SB(b, h) + boff + n * 2048 + k * 1024); } while (0)
#define PG8_MMA(ai, bj, At, Bt) do { __builtin_amdgcn_s_setprio(1); _Pragma("unroll") for (int m = 0; m < 4; ++m) _Pragma("unroll") for (int n = 0; n < 2; ++n) _Pragma("unroll") for (int k = 0; k < 2; ++k) \
        acc[ai][bj][m][n] = __builtin_amdgcn_mfma_f32_16x16x32_bf16(Bt[n][k], At[m][k], acc[ai][bj][m][n], 0, 0, 0); __builtin_amdgcn_s_setprio(0); } while (0)
#define PG8_WAIT_V(n) asm volatile("s_waitcnt vmcnt(" #n ")" ::: "memory")
#define PG8_WAIT_L(n) asm volatile("s_waitcnt lgkmcnt(" #n ")" ::: "memory")
#define PG8_BAR __builtin_amdgcn_s_barrier()
#define PG8_SCHED __builtin_amdgcn_sched_barrier(0)
    Unit cur, nxt; int ui = 0;
    if (!S.next(0, cur)) return;
    f32x4 acc[2][2][4][2];
#pragma unroll
    for (int a = 0; a < 2; ++a)
#pragma unroll
        for (int b = 0; b < 2; ++b)
#pragma unroll
            for (int m = 0; m < 4; ++m)
#pragma unroll
                for (int n = 0; n < 2; ++n) acc[a][b][m][n] = (f32x4){0.f, 0.f, 0.f, 0.f};
    bf16x8 At[4][2], B0[2][2], B1[2][2];
    const char* cA = (const char*)g.A + (size_t)cur.pm * tstep; const char* cB = (const char*)g.Bt + (size_t)cur.pn * tstep;
    S.a_ready(cur);
    if constexpr (SP2) {
        PG8_STAGE(PG8_SB(0, 0), cB, voffB); PG8_STAGE(PG8_SB(0, 1), cB + hstep, voffB); PG8_STAGE(PG8_SA(0, 0), cA, voffA); PG8_STAGE(PG8_SA(0, 1), cA + hstep, voffA);
        if (wr == 1) PG8_BAR;
        PG8_WAIT_V(2); PG8_BAR;
        PG8_STAGE(PG8_SB(1, 0), cB + kstep, voffB); PG8_STAGE(PG8_SA(1, 0), cA + kstep, voffA); PG8_STAGE(PG8_SB(1, 1), cB + hstep + kstep, voffB);
        PG8_WAIT_V(6); PG8_BAR;
    } else {
        PG8_STAGE(PG8_SB(0, 0), cB, voffB); PG8_STAGE(PG8_SA(0, 0), cA, voffA); PG8_STAGE(PG8_SB(0, 1), cB + hstep, voffB); PG8_STAGE(PG8_SA(0, 1), cA + hstep, voffA);
        if (wr == 1) PG8_BAR;
        PG8_WAIT_V(4); PG8_BAR;
        PG8_STAGE(PG8_SB(1, 0), cB + kstep, voffB); PG8_STAGE(PG8_SA(1, 0), cA + kstep, voffA); PG8_STAGE(PG8_SB(1, 1), cB + hstep + kstep, voffB);
        PG8_WAIT_V(6); PG8_BAR;
    }
    for (;;) {
        const bool has_next = S.next(ui + 1, nxt);
        const char* nA = has_next ? (const char*)g.A + (size_t)nxt.pm * tstep : cA; const char* nB = has_next ? (const char*)g.Bt + (size_t)nxt.pn * tstep : cB;
        for (int t = 0; t < nt; t += 2) {
            const bool last = (t == nt - 2);
            if constexpr (MID) { if (t == nt / 2) E.mid(acc, cur, wr, wc, fr, fq); }
            const char* a1 = cA + (size_t)(t + 1) * kstep;
            const char* a2 = last ? nA : cA + (size_t)(t + 2) * kstep; const char* b2 = last ? nB : cB + (size_t)(t + 2) * kstep;
            const char* a3 = a2 + kstep; const char* b3 = b2 + kstep;
            if (last && has_next) S.a_ready(nxt);
            if constexpr (SP2) {
            PG8_LDB(B0, 0, 0); PG8_LDB(B1, 0, 1); PG8_SCHED; PG8_LDA(At, 0, 0); PG8_STAGE(PG8_SA(1, 1), a1 + hstep, voffA);
            PG8_WAIT_V(8); PG8_WAIT_L(0); PG8_BAR; PG8_MMA(0, 0, At, B0); PG8_MMA(0, 1, At, B1); PG8_BAR; PG8_SCHED;
            PG8_LDA(At, 0, 1); PG8_STAGE(PG8_SB(0, 0), b2, voffB); PG8_STAGE(PG8_SB(0, 1), b2 + hstep, voffB); PG8_STAGE(PG8_SA(0, 0), a2, voffA);
            PG8_WAIT_V(8); PG8_WAIT_L(0); PG8_BAR; PG8_MMA(1, 0, At, B0); PG8_MMA(1, 1, At, B1); PG8_BAR; PG8_SCHED;
            PG8_LDB(B0, 1, 0); PG8_LDB(B1, 1, 1); PG8_SCHED; PG8_LDA(At, 1, 0); PG8_STAGE(PG8_SA(0, 1), a2 + hstep, voffA);
            PG8_WAIT_V(8); PG8_WAIT_L(0); PG8_BAR; PG8_MMA(0, 0, At, B0); PG8_MMA(0, 1, At, B1); PG8_BAR; PG8_SCHED;
            PG8_LDA(At, 1, 1); PG8_STAGE(PG8_SB(1, 0), b3, voffB); PG8_STAGE(PG8_SB(1, 1), b3 + hstep, voffB); PG8_STAGE(PG8_SA(1, 0), a3, voffA);
            PG8_WAIT_V(8); PG8_WAIT_L(0); PG8_BAR; PG8_MMA(1, 0, At, B0); PG8_MMA(1, 1, At, B1); PG8_BAR; PG8_SCHED;
            } else {
            PG8_LDB(B0, 0, 0); PG8_SCHED; PG8_LDA(At, 0, 0); PG8_STAGE(PG8_SA(1, 1), a1 + hstep, voffA);
            PG8_WAIT_L(8); PG8_BAR; PG8_WAIT_L(0); PG8_MMA(0, 0, At, B0); PG8_BAR; PG8_SCHED;
            PG8_LDB(B1, 0, 1); PG8_STAGE(PG8_SB(0, 0), b2, voffB);
            PG8_BAR; PG8_WAIT_L(0); PG8_MMA(0, 1, At, B1); PG8_BAR;
            PG8_LDA(At, 0, 1); PG8_STAGE(PG8_SA(0, 0), a2, voffA);
            PG8_BAR; PG8_WAIT_L(0); PG8_MMA(1, 0, At, B0); PG8_BAR; PG8_SCHED;
            PG8_STAGE(PG8_SB(0, 1), b2 + hstep, voffB);
            PG8_WAIT_V(6); PG8_BAR; PG8_MMA(1, 1, At, B1); PG8_BAR;
            PG8_LDB(B0, 1, 0); PG8_SCHED; PG8_LDA(At, 1, 0); PG8_STAGE(PG8_SA(0, 1), a2 + hstep, voffA);
            PG8_WAIT_L(8); PG8_BAR; PG8_WAIT_L(0); PG8_MMA(0, 0, At, B0); PG8_BAR; PG8_SCHED;
            PG8_LDB(B1, 1, 1); PG8_STAGE(PG8_SB(1, 0), b3, voffB);
            PG8_BAR; PG8_WAIT_L(0); PG8_MMA(0, 1, At, B1); PG8_BAR;
            PG8_LDA(At, 1, 1); PG8_STAGE(PG8_SA(1, 0), a3, voffA);
            PG8_BAR; PG8_WAIT_L(0); PG8_MMA(1, 0, At, B0); PG8_BAR; PG8_SCHED;
            PG8_STAGE(PG8_SB(1, 1), b3 + hstep, voffB);
            PG8_WAIT_V(6); PG8_BAR; PG8_MMA(1, 1, At, B1); PG8_BAR;
            }
        }
        if constexpr (ALIGN_EPI) { if (wr == 0) PG8_BAR; }
        if constexpr (!Epi::AFTER_DRAIN) { E(acc, cur, wr, wc, fr, fq); S.done(cur); }
        if (!has_next) break;
#pragma unroll
        for (int a = 0; a < 2; ++a)
#pragma unroll
            for (int b = 0; b < 2; ++b)
#pragma unroll
                for (int m = 0; m < 4; ++m)
#pragma unroll
                    for (int n = 0; n < 2; ++n) acc[a][b][m][n] = (f32x4){0.f, 0.f, 0.f, 0.f};
        cur = nxt; cA = nA; cB = nB; ++ui;
        if constexpr (ALIGN_EPI) { if (wr == 1) PG8_BAR; }
    }
    PG8_WAIT_V(0);
    if constexpr (!ALIGN_EPI) { if (wr == 0) PG8_BAR; }
    PG8_BAR;
    if constexpr (Epi::AFTER_DRAIN) { E.fused(acc, cur, wr, wc, fr, fq, lds, wid, lane); S.done(cur); }
#undef PG8_SA
#undef PG8_SB
#undef PG8_STAGE
#undef PG8_LDA
#undef PG8_LDB
#undef PG8_MMA
#undef PG8_WAIT_V
#undef PG8_WAIT_L
#undef PG8_BAR
#undef PG8_SCHED
}
}

#define LAS __attribute__((address_space(3)))
typedef unsigned short bf16;
typedef short bf16x8 __attribute__((ext_vector_type(8)));
typedef float f32x4 __attribute__((ext_vector_type(4)));
typedef float f32x16 __attribute__((ext_vector_type(16)));
typedef unsigned u32x4 __attribute__((ext_vector_type(4)));
typedef unsigned u32x2 __attribute__((ext_vector_type(2)));

constexpr int DM = 1024, NBATCH = 4, SEQ = 4096, MP = NBATCH * SEQ, SBATCH = 128, STOK = 4, MS = SBATCH * STOK, MR = MP + MS;
constexpr int PASTL = 2048, PAGE = 128, NPG = 16;
constexpr int LS = 2112, LSW = 576;
constexpr int NPAD = 5632;
constexpr float C2 = 0.125f * 1.4426950408889634f;
constexpr int NWAVES = 8;

constexpr size_t O_YP = 0, O_YS = 16777216, O_NSAP = 17301504, O_DSAP = 25690112, O_IDXP = 29884416, O_WINP = 30932992,
                 O_NSAS = 31457280, O_DSAS = 31719424, O_IDXS = 31850496, O_WINS = 31883264, O_END = 48660480;

constexpr size_t MiB = 1u << 20;
constexpr size_t WS_CTL = 0, CTL_ZERO_BYTES = 1 * MiB;
constexpr size_t WS_MOD = 1 * MiB;
constexpr size_t WS_COS = 3 * MiB, WS_SIN = 4 * MiB;
constexpr size_t WS_BIAS1 = 5 * MiB;
constexpr size_t WS_BIASP = 5 * MiB + 262144;
constexpr size_t WS_W2T = 5 * MiB + 65536;
constexpr size_t WS_W1T = 6 * MiB;
constexpr size_t WS_WINT = 8 * MiB;
constexpr size_t WS_WUPN = 20 * MiB, WS_WUPD = 21 * MiB, WS_WOUT = 22 * MiB;
constexpr size_t WS_PSLCVK = 975 * MiB, WS_PWINVK = 979 * MiB, WS_PDSAVK = 983 * MiB;
constexpr size_t WS_SELM = 960 * MiB;
constexpr size_t WS_GATES = 25 * MiB;
constexpr size_t WS_IW = 27 * MiB;
constexpr size_t WS_PCK = 28 * MiB, WS_PCVT = 28 * MiB + 262144;
constexpr size_t WS_SCK = 29 * MiB, WS_SCVT = 33 * MiB;
constexpr size_t WS_H = 40 * MiB;
constexpr size_t WS_QRAW = 80 * MiB, WS_QROT = 100 * MiB, WS_DQ = 120 * MiB, WS_IQ = 140 * MiB, WS_ZN = 150 * MiB, WS_ZD = 170 * MiB, WS_ONZ = 190 * MiB, WS_ODZ = 210 * MiB;
constexpr size_t WS_MG = 230 * MiB;
constexpr size_t WS_T1 = 300 * MiB;
constexpr size_t WS_M1 = 370 * MiB;
constexpr size_t WS_PCMPK = 410 * MiB, WS_PCMPV = 414 * MiB, WS_PSLCK = 418 * MiB, WS_PSLCVT = 422 * MiB, WS_PWINK = 426 * MiB, WS_PWINVT = 430 * MiB,
                 WS_PDSAK = 434 * MiB, WS_PDSAVT = 438 * MiB, WS_PIDXK = 442 * MiB;
constexpr size_t WS_SCMPK = 450 * MiB, WS_SCMPV = 520 * MiB, WS_SSLCK = 590 * MiB, WS_SSLCVT = 660 * MiB, WS_SDSAK = 730 * MiB, WS_SDSAVT = 800 * MiB,
                 WS_SWINK = 870 * MiB, WS_SWINVT = 890 * MiB, WS_SIDXK = 910 * MiB, WS_END = 990 * MiB;
constexpr int CW_BAR = 4096;
constexpr int CW_Q = 16384;

constexpr int RING_BYTES = 131072, MISC_OFF = RING_BYTES, STG_OFF = MISC_OFF + 256, LDS_BYTES = STG_OFF + 16384;

struct Args { const void* in[20]; float* out; unsigned char* ws; int ph_lo, ph_hi, qoff, umask, pad0, pad1; };

struct Frame {
    LAS unsigned char* lds; volatile LAS unsigned* MISC; unsigned* ctl;
    int tid, lane, wave, G, qoff;
    int lq; unsigned pend;
    unsigned char* ws; float* out;
    const float *xp, *xs, *cnsa, *cdsa, *cidx, *swin; const int* ptab; const float *cp, *cs, *normg, *wada, *bada, *win, *pe, *w1, *w2, *wupn, *wupd, *wout, *fing;
};
#define WSP(T, off) ((T*)(F.ws + (off)))

#define DI __device__ __forceinline__
#define LDS_WAIT() asm volatile("s_waitcnt lgkmcnt(0)" ::: "memory")
DI void q_late(Frame& F) { if (F.lq >= 0) { if (F.tid == 0) F.pend = __hip_atomic_fetch_add(F.ctl + CW_Q + 64 * (F.lq + F.qoff), 1u, __ATOMIC_RELAXED, __HIP_MEMORY_SCOPE_AGENT); F.lq = ~F.lq; } }
DI int opq(int x) { asm volatile("" : "+v"(x)); return x; }
DI const float* sgpr_ptr(const float* p) { const unsigned long long b = (unsigned long long)p; const unsigned lo = (unsigned)__builtin_amdgcn_readfirstlane((int)(unsigned)b), hi = (unsigned)__builtin_amdgcn_readfirstlane((int)(unsigned)(b >> 32)); return (const float*)(((unsigned long long)hi << 32) | lo); }
DI u32x4 gload16s(const void* sbase, unsigned voff) { u32x4 r; asm volatile("global_load_dwordx4 %0, %1, %2" : "=v"(r) : "v"(voff), "s"(sbase) : "memory"); return r; }
DI u32x4 gload16(const void* p) { u32x4 r; asm volatile("global_load_dwordx4 %0, %1, off" : "=v"(r) : "v"(p) : "memory"); return r; }
DI unsigned long long gload8(const void* p) { unsigned long long r; asm volatile("global_load_dwordx2 %0, %1, off" : "=v"(r) : "v"(p) : "memory"); return r; }
#define WAITV2(n, a, b) asm volatile("s_waitcnt vmcnt(" #n ")" : "+v"(a), "+v"(b) :: "memory")
#define WAITV1(n, a) asm volatile("s_waitcnt vmcnt(" #n ")" : "+v"(a) :: "memory")
#define LDS_BARRIER() do { asm volatile("s_waitcnt lgkmcnt(0)" ::: "memory"); __builtin_amdgcn_s_barrier(); asm volatile("" ::: "memory"); } while (0)
DI float wave_sum(float v) {
#define DPP_ADD_(ctrl, rmask) v += __int_as_float(__builtin_amdgcn_update_dpp(0, __float_as_int(v), (ctrl), (rmask), 0xF, false))
    DPP_ADD_(0xB1, 0xF);
    DPP_ADD_(0x4E, 0xF);
    DPP_ADD_(0x141, 0xF);
    DPP_ADD_(0x140, 0xF);
    DPP_ADD_(0x142, 0xA);
    DPP_ADD_(0x143, 0xC);
#undef DPP_ADD_
    return __int_as_float(__builtin_amdgcn_readlane(__float_as_int(v), 63));
}
DI int wave_sum_i(int v) {
#define DPP_ADDI_(ctrl, rmask) v += __builtin_amdgcn_update_dpp(0, v, (ctrl), (rmask), 0xF, false)
    DPP_ADDI_(0xB1, 0xF); DPP_ADDI_(0x4E, 0xF); DPP_ADDI_(0x141, 0xF); DPP_ADDI_(0x140, 0xF); DPP_ADDI_(0x142, 0xA); DPP_ADDI_(0x143, 0xC);
#undef DPP_ADDI_
    return __builtin_amdgcn_readlane(v, 63);
}
DI int wave_min_i(int v) {
#define DPP_MIN_(ctrl, rmask) { const int t_ = __builtin_amdgcn_update_dpp(v, v, (ctrl), (rmask), 0xF, false); v = t_ < v ? t_ : v; }
    DPP_MIN_(0xB1, 0xF) DPP_MIN_(0x4E, 0xF) DPP_MIN_(0x141, 0xF) DPP_MIN_(0x140, 0xF) DPP_MIN_(0x142, 0xA) DPP_MIN_(0x143, 0xC)
#undef DPP_MIN_
    return __builtin_amdgcn_readlane(v, 63);
}
DI int wave_max_i(int v) {
#define DPP_MAX_(ctrl, rmask) { const int t_ = __builtin_amdgcn_update_dpp(v, v, (ctrl), (rmask), 0xF, false); v = t_ > v ? t_ : v; }
    DPP_MAX_(0xB1, 0xF) DPP_MAX_(0x4E, 0xF) DPP_MAX_(0x141, 0xF) DPP_MAX_(0x140, 0xF) DPP_MAX_(0x142, 0xA) DPP_MAX_(0x143, 0xC)
#undef DPP_MAX_
    return __builtin_amdgcn_readlane(v, 63);
}
DI unsigned pk2(float lo, float hi) { return pg8::cvt_pk_bf16(lo, hi); }
DI float bflo(unsigned w) { return __uint_as_float(w << 16); }
DI float bfhi(unsigned w) { return __uint_as_float(w & 0xffff0000u); }
DI float bf2f(bf16 h) { return __uint_as_float((unsigned)h << 16); }
DI float sigm_f(float x) { return __builtin_amdgcn_rcpf(1.f + __builtin_amdgcn_exp2f(-1.4426950408889634f * x)); }
DI float silu_f(float x) { return x * sigm_f(x); }
DI int pos16(int o) { return 8 * ((o >> 2) & 1) + (o & 3) + 4 * (o >> 3); }
DI int permk(int t) { return (t & ~15) | pos16(t & 15); }
DI int crow(int r, int hi) { return (r & 3) + 8 * (r >> 2) + 4 * hi; }
DI float dpp_x1(float v) { return __int_as_float(__builtin_amdgcn_update_dpp(0, __float_as_int(v), 0xB1, 0xF, 0xF, true)); }
DI float dpp_x2(float v) { return __int_as_float(__builtin_amdgcn_update_dpp(0, __float_as_int(v), 0x4E, 0xF, 0xF, true)); }
DI float half_other(float v) {
    const unsigned u = __float_as_uint(v);
    auto rr = __builtin_amdgcn_permlane32_swap(u, u, false, false);
    return __uint_as_float(((threadIdx.x & 32) != 0) ? rr[0] : rr[1]);
}
DI u32x4 pack8(const float* v) { u32x4 w; w.x = pk2(v[0], v[1]); w.y = pk2(v[2], v[3]); w.z = pk2(v[4], v[5]); w.w = pk2(v[6], v[7]); return w; }
DI void st_bf8(bf16* p, const float* v) { *(u32x4*)p = pack8(v); }
DI void st_f8(float* p, const float* v) { __builtin_nontemporal_store((f32x4){v[0], v[1], v[2], v[3]}, (f32x4*)p); __builtin_nontemporal_store((f32x4){v[4], v[5], v[6], v[7]}, (f32x4*)(p + 4)); }
DI void st_vt8(bf16* p, size_t pitch, const float* v) {
#pragma unroll
    for (int j = 0; j < 8; ++j) p[(size_t)j * pitch] = (bf16)(pk2(v[j], 0.f) & 0xffffu);
}
#define PIN4(q) asm volatile("" : "+v"(q[0]), "+v"(q[1]), "+v"(q[2]), "+v"(q[3]))
#define NEGINF (-__builtin_inff())
#define MFMA32(a, b, c) __builtin_amdgcn_mfma_f32_32x32x16_bf16((a), (b), (c), 0, 0, 0)

DI int idx_key(float dot, float w) {
#pragma clang fp contract(off)
    float v = fmaxf(dot, 0.f) * w;
    v = v + dpp_x1(v);
    v = v + dpp_x2(v);
    int u = __float_as_int(v);
    u = (u == (int)0x80000000) ? 0 : u;
    return u ^ ((u >> 31) & 0x7fffffff);
}

template <int MODE> struct EpiInProjT {
    static constexpr bool PERM = true, AFTER_DRAIN = false;
    unsigned char* ws; float* out;
    DI void rope8(float* lo, float* hi, const float* c, const float* s) const {
#pragma unroll
        for (int j = 0; j < 8; ++j) { const float a = lo[j], b = hi[j]; lo[j] = a * c[j] - b * s[j]; hi[j] = b * c[j] + a * s[j]; }
    }
    DI void ldtab(float* c, float* s, int pos, int d0) const {
        const f32x4* cp = (const f32x4*)((const float*)(ws + WS_COS) + pos * 32 + d0);
        const f32x4* sp = (const f32x4*)((const float*)(ws + WS_SIN) + pos * 32 + d0);
        const f32x4 c0 = cp[0], c1 = cp[1], s0 = sp[0], s1 = sp[1];
        c[0] = c0[0]; c[1] = c0[1]; c[2] = c0[2]; c[3] = c0[3]; c[4] = c1[0]; c[5] = c1[1]; c[6] = c1[2]; c[7] = c1[3];
        s[0] = s0[0]; s[1] = s0[1]; s[2] = s0[2]; s[3] = s0[3]; s[4] = s1[0]; s[5] = s1[1]; s[6] = s1[2]; s[7] = s1[3];
        asm volatile("" : "+v"(c[0]), "+v"(c[1]), "+v"(c[2]), "+v"(c[3]), "+v"(c[4]), "+v"(c[5]), "+v"(c[6]), "+v"(c[7]));
        asm volatile("" : "+v"(s[0]), "+v"(s[1]), "+v"(s[2]), "+v"(s[3]), "+v"(s[4]), "+v"(s[5]), "+v"(s[6]), "+v"(s[7]));
    }
    DI void operator()(const pg8::f32x4 (&acc)[2][2][4][2], const pg8::Unit& u, int wr, int wc, int fr, int fq) const {
        const int hs = u.pn * 4 + wc;
        if (hs >= 86) return;
        if ((MODE & 2) && hs >= 20 && hs != 44 && !(hs >= 36 && hs < 40)) return;
        if ((MODE & 4) && hs < 20) return;
        const bool samp = u.pm >= 64;
        const int d0 = 8 * fq;
        const bool roped = hs < 8 || (hs >= 12 && hs < 14) || (hs >= 16 && hs < 18) || (hs >= 28 && hs < 36) || hs == 36 || hs == 37 || (hs >= 40 && hs <= 44);
        float rc[8], rs[8], dc[8], ds[8];
        if (roped) { if (samp) {
#pragma unroll
                for (int j = 0; j < 8; ++j) { dc[j] = 1.f; ds[j] = 0.f; }
            } else ldtab(dc, ds, 16, d0); }
#pragma unroll
        for (int ai = 0; ai < 2; ++ai)
#pragma unroll
            for (int m = 0; m < 4; ++m) {
                const int r = u.pm * 256 + ai * 128 + wr * 64 + m * 16 + fr;
                if (roped) {
                    if (m == 0) ldtab(rc, rs, samp ? PASTL + (r & 3) : (r & 4095), d0);
                    else {
#pragma unroll
                        for (int j = 0; j < 8; ++j) { const float a = rc[j], b = rs[j]; rc[j] = a * dc[j] - b * ds[j]; rs[j] = b * dc[j] + a * ds[j]; }
                    }
                }
                int b, t, pos;
                if (!samp) { b = r >> 12; t = r & 4095; pos = t; } else { b = (r - MP) >> 2; t = r & 3; pos = PASTL + t; }
                float lo[8], hi[8];
#pragma unroll
                for (int n = 0; n < 2; ++n)
#pragma unroll
                    for (int j = 0; j < 4; ++j) { lo[4 * n + j] = acc[ai][0][m][n][j]; hi[4 * n + j] = acc[ai][1][m][n][j]; }
                if (hs < 8) {
                    bf16* qa = (bf16*)(ws + WS_QRAW) + (size_t)r * 512 + hs * 64 + d0;
                    bf16* qb = (bf16*)(ws + WS_QROT) + (size_t)r * 512 + hs * 64 + d0;
                    float a[8], c[8];
#pragma unroll
                    for (int j = 0; j < 8; ++j) { a[j] = lo[j] * C2; c[j] = hi[j] * C2; }
                    st_bf8(qa, a); st_bf8(qa + 32, c);
                    rope8(lo, hi, rc, rs);
#pragma unroll
                    for (int j = 0; j < 8; ++j) { a[j] = lo[j] * C2; c[j] = hi[j] * C2; }
                    st_bf8(qb, a); st_bf8(qb + 32, c);
                } else if (hs < 20) {
                    const int ty = (hs - 8) >> 1, g = (hs - 8) & 1;
                    if (ty == 2 || ty == 4) rope8(lo, hi, rc, rs);
                    const int bg = b * 2 + g;
                    if (ty < 4) {
                        float* o = out + (samp ? O_NSAS + ((size_t)(r - MP) * 8 + ty * 2 + g) * 64 : O_NSAP + ((size_t)r * 8 + ty * 2 + g) * 64) + d0;
                        st_f8(o, lo); st_f8(o + 32, hi);
                    } else {
                        const int sl = ty - 4;
                        if (samp) { float* o = out + O_WINS + (((size_t)b * 512 + 508 + t) * 4 + sl * 2 + g) * 64 + d0; st_f8(o, lo); st_f8(o + 32, hi); }
                        else if (t >= SEQ - 512) { float* o = out + O_WINP + (((size_t)b * 512 + (t - (SEQ - 512))) * 4 + sl * 2 + g) * 64 + d0; st_f8(o, lo); st_f8(o + 32, hi); }
                    }
                    if (ty == 3 || ty == 5) {
                        size_t pitch; int kp; bf16* base;
                        if (!samp) { pitch = SEQ; kp = t; base = (bf16*)(ws + (ty == 3 ? WS_PSLCVT : WS_PWINVT)); }
                        else if (ty == 3) { pitch = LS; kp = PASTL + t; base = (bf16*)(ws + WS_SSLCVT); }
                        else { pitch = LSW; kp = 512 + t; base = (bf16*)(ws + WS_SWINVT); }
                        bf16* p = base + ((size_t)bg * 64 + d0) * pitch + permk(kp);
                        if (!(MODE & 1)) { st_vt8(p, pitch, lo); st_vt8(p + 32 * pitch, pitch, hi); }
                    } else {
                        size_t rowi; bf16* base;
                        if (!samp) { rowi = (size_t)bg * SEQ + t; base = (bf16*)(ws + (ty == 0 ? WS_PCMPK : ty == 1 ? WS_PCMPV : ty == 2 ? WS_PSLCK : WS_PWINK)); }
                        else if (ty == 4) { rowi = (size_t)bg * LSW + 512 + t; base = (bf16*)(ws + WS_SWINK); }
                        else { rowi = (size_t)bg * LS + PASTL + t; base = (bf16*)(ws + (ty == 0 ? WS_SCMPK : ty == 1 ? WS_SCMPV : WS_SSLCK)); }
                        bf16* p = base + rowi * 64 + d0;
                        st_bf8(p, lo); st_bf8(p + 32, hi);
                    }
                } else if (hs < 28 || (hs >= 45 && hs < 53)) {
                    const int h = hs < 28 ? hs - 20 : hs - 45;
                    bf16* p = (bf16*)(ws + (hs < 28 ? WS_ZN : WS_ZD)) + (size_t)r * 512 + h * 64 + d0;
#pragma unroll
                    for (int j = 0; j < 8; ++j) { lo[j] = silu_f(lo[j]); hi[j] = silu_f(hi[j]); }
                    st_bf8(p, lo); st_bf8(p + 32, hi);
                } else if (hs < 36) {
                    rope8(lo, hi, rc, rs);
#pragma unroll
                    for (int j = 0; j < 8; ++j) { lo[j] *= C2; hi[j] *= C2; }
                    bf16* p = (bf16*)(ws + WS_DQ) + (size_t)r * 512 + (hs - 28) * 64 + d0;
                    st_bf8(p, lo); st_bf8(p + 32, hi);
                } else if (hs < 40) {
                    const int sl = (hs - 36) >> 1, g = (hs - 36) & 1, bg = b * 2 + g;
                    if (sl == 0) rope8(lo, hi, rc, rs);
                    float* o = out + (samp ? O_DSAS + ((size_t)(r - MP) * 4 + sl * 2 + g) * 64 : O_DSAP + ((size_t)r * 4 + sl * 2 + g) * 64) + d0;
                    st_f8(o, lo); st_f8(o + 32, hi);
                    if (sl == 0) {
                        bf16* p = samp ? (bf16*)(ws + WS_SDSAK) + ((size_t)bg * LS + PASTL + t) * 64 + d0 : (bf16*)(ws + WS_PDSAK) + ((size_t)bg * SEQ + t) * 64 + d0;
                        st_bf8(p, lo); st_bf8(p + 32, hi);
                    } else {
                        const size_t pitch = samp ? LS : SEQ; const int kp = samp ? PASTL + t : t;
                        bf16* p = (bf16*)(ws + (samp ? WS_SDSAVT : WS_PDSAVT)) + ((size_t)bg * 64 + d0) * pitch + permk(kp);
                        if (!(MODE & 1)) { st_vt8(p, pitch, lo); st_vt8(p + 32 * pitch, pitch, hi); }
                    }
                } else if (hs < 44) {
                    rope8(lo, hi, rc, rs);
                    bf16* p = (bf16*)(ws + WS_IQ) + (size_t)r * 256 + (hs - 40) * 64 + d0;
                    st_bf8(p, lo); st_bf8(p + 32, hi);
                } else if (hs == 44) {
                    rope8(lo, hi, rc, rs);
                    float* o = out + (samp ? O_IDXS + (size_t)(r - MP) * 64 : O_IDXP + (size_t)r * 64) + d0;
                    st_f8(o, lo); st_f8(o + 32, hi);
                    bf16* p = samp ? (bf16*)(ws + WS_SIDXK) + ((size_t)b * LS + PASTL + t) * 64 + d0 : (bf16*)(ws + WS_PIDXK) + (size_t)r * 64 + d0;
                    st_bf8(p, lo); st_bf8(p + 32, hi);
                } else if (hs < 85) {
                    bf16* p = (bf16*)(ws + WS_MG) + (size_t)r * 2048 + (hs - 53) * 64 + d0;
#pragma unroll
                    for (int j = 0; j < 8; ++j) { lo[j] = sigm_f(lo[j]); hi[j] = sigm_f(hi[j]); }
                    st_bf8(p, lo); st_bf8(p + 32, hi);
                } else {
                    if (fq < 3) { float* p = (float*)(ws + WS_GATES) + (size_t)r * 24 + d0;
#pragma unroll
                        for (int j = 0; j < 8; ++j) lo[j] = sigm_f(lo[j]);
                        st_f8(p, lo);
                    } else { *(f32x4*)((float*)(ws + WS_IW) + (size_t)r * 4) = (f32x4){lo[0], lo[1], lo[2], lo[3]}; }
                }
            }
    }
};
typedef EpiInProjT<0> EpiInProj;
struct ColOrder {
    int nM, nN, cnt, rank, pn;
    __device__ void init(int M, int N, int G, int c) { nM = M / 256; nN = N / 256; pn = c % nN; rank = c / nN; cnt = G / nN + ((pn < G % nN) ? 1 : 0); }
    __device__ bool next(int i, pg8::Unit& u) const { const int pm = rank + i * cnt; if (pm >= nM) return false; u.pm = pm; u.pn = pn; return true; }
    __device__ __forceinline__ void a_ready(const pg8::Unit&) const {}
    __device__ __forceinline__ void done(const pg8::Unit&) const {}
};
struct EpiNull {
    static constexpr bool PERM = true, AFTER_DRAIN = false;
    unsigned char* ws;
    DI void operator()(const pg8::f32x4 (&acc)[2][2][4][2], const pg8::Unit& u, int wr, int wc, int fr, int fq) const {
        float s = 0.f;
#pragma unroll
        for (int ai = 0; ai < 2; ++ai)
#pragma unroll
            for (int bj = 0; bj < 2; ++bj)
#pragma unroll
                for (int m = 0; m < 4; ++m)
#pragma unroll
                    for (int n = 0; n < 2; ++n) s += acc[ai][bj][m][n][0] + acc[ai][bj][m][n][1] + acc[ai][bj][m][n][2] + acc[ai][bj][m][n][3];
        if (s == 1.2345e33f) *(float*)(ws + WS_CTL + 2048) = s;
    }
};
struct EpiUp1 {
    static constexpr bool PERM = true, AFTER_DRAIN = false;
    unsigned char* ws;
    DI void operator()(const pg8::f32x4 (&acc)[2][2][4][2], const pg8::Unit& u, int wr, int wc, int fr, int fq) const {
#pragma unroll
        for (int ai = 0; ai < 2; ++ai)
#pragma unroll
            for (int m = 0; m < 4; ++m) {
                const int r = u.pm * 256 + ai * 128 + wr * 64 + m * 16 + fr;
#pragma unroll
                for (int bj = 0; bj < 2; ++bj) {
                    const int c0 = u.pn * 256 + bj * 128 + wc * 32 + 8 * fq;
                    const u32x4 gw = *(const u32x4*)((const bf16*)(ws + WS_MG) + (size_t)r * 2048 + c0);
                    const f32x4 a0 = acc[ai][bj][m][0], a1 = acc[ai][bj][m][1];
                    u32x4 w; w.x = pk2(a0[0] * bflo(gw.x), a0[1] * bfhi(gw.x)); w.y = pk2(a0[2] * bflo(gw.y), a0[3] * bfhi(gw.y));
                    w.z = pk2(a1[0] * bflo(gw.z), a1[1] * bfhi(gw.z)); w.w = pk2(a1[2] * bflo(gw.w), a1[3] * bfhi(gw.w));
                    *(u32x4*)((bf16*)(ws + WS_T1) + (size_t)r * 1024 + c0) = w;
                }
            }
    }
};
struct EpiUp2 {
    static constexpr bool PERM = true, AFTER_DRAIN = false;
    unsigned char* ws;
    DI void operator()(const pg8::f32x4 (&acc)[2][2][4][2], const pg8::Unit& u, int wr, int wc, int fr, int fq) const {
#pragma unroll
        for (int ai = 0; ai < 2; ++ai)
#pragma unroll
            for (int m = 0; m < 4; ++m) {
                const int r = u.pm * 256 + ai * 128 + wr * 64 + m * 16 + fr;
#pragma unroll
                for (int bj = 0; bj < 2; ++bj) {
                    const int c0 = u.pn * 256 + bj * 128 + wc * 32 + 8 * fq;
                    const u32x4 gw = *(const u32x4*)((const bf16*)(ws + WS_MG) + (size_t)r * 2048 + 1024 + c0);
                    const u32x4 tw = *(const u32x4*)((const bf16*)(ws + WS_T1) + (size_t)r * 1024 + c0);
                    const f32x4 t0 = {bflo(tw.x), bfhi(tw.x), bflo(tw.y), bfhi(tw.y)}, t1 = {bflo(tw.z), bfhi(tw.z), bflo(tw.w), bfhi(tw.w)};
                    const f32x4 a0 = acc[ai][bj][m][0], a1 = acc[ai][bj][m][1];
                    u32x4 w;
                    w.x = pk2(t0[0] + a0[0] * bflo(gw.x), t0[1] + a0[1] * bfhi(gw.x)); w.y = pk2(t0[2] + a0[2] * bflo(gw.y), t0[3] + a0[3] * bfhi(gw.y));
                    w.z = pk2(t1[0] + a1[0] * bflo(gw.z), t1[1] + a1[1] * bfhi(gw.z)); w.w = pk2(t1[2] + a1[2] * bflo(gw.w), t1[3] + a1[3] * bfhi(gw.w));
                    *(u32x4*)((bf16*)(ws + WS_M1) + (size_t)r * 1024 + c0) = w;
                }
            }
    }
};
#define RCPG(x) __builtin_amdgcn_rcpf(fmaxf((x), 1e-20f))
struct EpiUpF {
    static constexpr bool PERM = true, AFTER_DRAIN = false;
    unsigned char* ws;
    DI void mid(pg8::f32x4 (&acc)[2][2][4][2], const pg8::Unit& u, int wr, int wc, int fr, int fq) const {
#pragma unroll
        for (int ai = 0; ai < 2; ++ai)
#pragma unroll
            for (int m = 0; m < 4; ++m) {
                const int r = u.pm * 256 + ai * 128 + wr * 64 + m * 16 + fr;
#pragma unroll
                for (int bj = 0; bj < 2; ++bj) {
                    const int c0 = u.pn * 256 + bj * 128 + wc * 32 + 8 * fq;
                    const u32x4 gn = *(const u32x4*)((const bf16*)(ws + WS_MG) + (size_t)r * 2048 + c0);
                    const u32x4 gd = *(const u32x4*)((const bf16*)(ws + WS_MG) + (size_t)r * 2048 + 1024 + c0);
                    pg8::f32x4& a0 = acc[ai][bj][m][0]; pg8::f32x4& a1 = acc[ai][bj][m][1];
                    a0[0] *= bflo(gn.x) * RCPG(bflo(gd.x)); a0[1] *= bfhi(gn.x) * RCPG(bfhi(gd.x)); a0[2] *= bflo(gn.y) * RCPG(bflo(gd.y)); a0[3] *= bfhi(gn.y) * RCPG(bfhi(gd.y));
                    a1[0] *= bflo(gn.z) * RCPG(bflo(gd.z)); a1[1] *= bfhi(gn.z) * RCPG(bfhi(gd.z)); a1[2] *= bflo(gn.w) * RCPG(bflo(gd.w)); a1[3] *= bfhi(gn.w) * RCPG(bfhi(gd.w));
                }
            }
    }
    DI void operator()(const pg8::f32x4 (&acc)[2][2][4][2], const pg8::Unit& u, int wr, int wc, int fr, int fq) const {
#pragma unroll
        for (int ai = 0; ai < 2; ++ai)
#pragma unroll
            for (int m = 0; m < 4; ++m) {
                const int r = u.pm * 256 + ai * 128 + wr * 64 + m * 16 + fr;
#pragma unroll
                for (int bj = 0; bj < 2; ++bj) {
                    const int c0 = u.pn * 256 + bj * 128 + wc * 32 + 8 * fq;
                    const u32x4 gd = *(const u32x4*)((const bf16*)(ws + WS_MG) + (size_t)r * 2048 + 1024 + c0);
                    const f32x4 a0 = acc[ai][bj][m][0], a1 = acc[ai][bj][m][1];
                    u32x4 w;
                    w.x = pk2(a0[0] * fmaxf(bflo(gd.x), 1e-20f), a0[1] * fmaxf(bfhi(gd.x), 1e-20f)); w.y = pk2(a0[2] * fmaxf(bflo(gd.y), 1e-20f), a0[3] * fmaxf(bfhi(gd.y), 1e-20f));
                    w.z = pk2(a1[0] * fmaxf(bflo(gd.z), 1e-20f), a1[1] * fmaxf(bfhi(gd.z), 1e-20f)); w.w = pk2(a1[2] * fmaxf(bflo(gd.w), 1e-20f), a1[3] * fmaxf(bfhi(gd.w), 1e-20f));
                    *(u32x4*)((bf16*)(ws + WS_M1) + (size_t)r * 1024 + c0) = w;
                }
            }
    }
};
struct EpiOut {
    static constexpr bool PERM = true, AFTER_DRAIN = false;
    unsigned char* ws; float* out; const float* xp; const float* xs;
    DI void operator()(const pg8::f32x4 (&acc)[2][2][4][2], const pg8::Unit& u, int wr, int wc, int fr, int fq) const {
        const bool samp = u.pm >= 64;
#pragma unroll
        for (int ai = 0; ai < 2; ++ai)
#pragma unroll
            for (int m = 0; m < 4; ++m) {
                const int r = u.pm * 256 + ai * 128 + wr * 64 + m * 16 + fr;
                const int mrow = samp ? 4 + ((r - MP) >> 2) : (r >> 12);
                const float* xr = samp ? xs + (size_t)(r - MP) * 1024 : xp + (size_t)r * 1024;
                float* orow = samp ? out + O_YS + (size_t)(r - MP) * 1024 : out + O_YP + (size_t)r * 1024;
                const float* gr = (const float*)(ws + WS_MOD) + (size_t)mrow * 3072 + 2048;
#pragma unroll
                for (int bj = 0; bj < 2; ++bj) {
                    const int c0 = u.pn * 256 + bj * 128 + wc * 32 + 8 * fq;
#pragma unroll
                    for (int n = 0; n < 2; ++n) {
                        const f32x4 x4 = *(const f32x4*)(xr + c0 + 4 * n), g4 = *(const f32x4*)(gr + c0 + 4 * n);
                        *(f32x4*)(orow + c0 + 4 * n) = x4 + g4 * acc[ai][bj][m][n];
                    }
                }
            }
    }
};

DI int win_row(int col) {
    int hs, d;
    if (col < 1280) { hs = col >> 6; d = col & 63; }
    else if (col < 1304) { hs = 85; d = col - 1280; }
    else if (col < 2904) { const int c = col - 1304; hs = 20 + (c >> 6); d = c & 63; }
    else if (col < 2908) { hs = 85; d = 24 + (col - 2904); }
    else { const int c = col - 2908; hs = 45 + (c >> 6); d = c & 63; }
    return 256 * (hs >> 2) + 128 * (d >> 5) + 32 * (hs & 3) + (d & 31);
}
template <bool WINMAP> DI void p0_transpose_item(const float* W, int K, int N, bf16* WT, LAS float* scr, int item, int lane, int pitch = 0) {
    const int nblk = (N + 31) / 32, kb = item / nblk, nb = item % nblk, k0 = 64 * kb, n0 = 32 * nb;
    const bool nok = n0 + (lane & 31) < N;
    float tv[32];
#pragma unroll
    for (int i = 0; i < 32; ++i) { const int kk = 2 * i + (lane >> 5); tv[i] = nok ? W[(size_t)(k0 + kk) * N + n0 + (lane & 31)] : 0.f; }
#pragma unroll
    for (int i = 0; i < 32; ++i) { const int kk = 2 * i + (lane >> 5); scr[kk * 33 + (lane & 31)] = tv[i]; }
    LDS_WAIT();
    const int c = lane & 7;
#pragma unroll
    for (int j = 0; j < 4; ++j) { const int n = (lane >> 3) + 8 * j; const LAS float* s = scr + (8 * c) * 33 + n;
        u32x4 o; o.x = pk2(s[0 * 33], s[1 * 33]); o.y = pk2(s[2 * 33], s[3 * 33]); o.z = pk2(s[4 * 33], s[5 * 33]); o.w = pk2(s[6 * 33], s[7 * 33]);
        if (n0 + n < N) { const int row = WINMAP ? win_row(n0 + n) : (n0 + n); *(u32x4*)(WT + (size_t)row * (pitch ? pitch : K) + k0 + 8 * c) = o; } }
    LDS_WAIT();
}
DI void p0_mod(Frame& F) {
    LAS float* wl = (LAS float*)F.lds;
    float* mod = WSP(float, WS_MOD);
    for (int cg = blockIdx.x; cg < 256; cg += F.G) {
        __syncthreads();
        for (int k = F.tid; k < 1024; k += NWAVES * 64) {
            const f32x4* src = (const f32x4*)(F.wada + (size_t)k * 3072 + cg * 12);
            LAS f32x4* dst = (LAS f32x4*)(wl + k * 12);
            dst[0] = src[0]; dst[1] = src[1]; dst[2] = src[2];
        }
        __syncthreads();
        float cv[16], cn[16];
        { const float* cr = F.wave < 4 ? F.cp + (size_t)F.wave * 1024 : F.cs + (size_t)(F.wave - 4) * 1024;
#pragma unroll
          for (int i = 0; i < 16; ++i) cn[i] = cr[F.lane + 64 * i]; }
        for (int r = F.wave; r < 132; r += NWAVES) {
#pragma unroll
            for (int i = 0; i < 16; ++i) cv[i] = cn[i];
            { const int rn = r + NWAVES < 132 ? r + NWAVES : r; const float* cr = rn < 4 ? F.cp + (size_t)rn * 1024 : F.cs + (size_t)(rn - 4) * 1024;
#pragma unroll
              for (int i = 0; i < 16; ++i) cn[i] = cr[F.lane + 64 * i]; }
            float a[12];
#pragma unroll
            for (int j = 0; j < 12; ++j) a[j] = 0.f;
#pragma unroll
            for (int i = 0; i < 16; ++i) {
                const int k = F.lane + 64 * i; const float s = silu_f(cv[i]);
                const LAS f32x4* wp = (const LAS f32x4*)(wl + k * 12);
                const f32x4 w0 = wp[0], w1 = wp[1], w2 = wp[2];
                a[0] += s * w0[0]; a[1] += s * w0[1]; a[2] += s * w0[2]; a[3] += s * w0[3];
                a[4] += s * w1[0]; a[5] += s * w1[1]; a[6] += s * w1[2]; a[7] += s * w1[3];
                a[8] += s * w2[0]; a[9] += s * w2[1]; a[10] += s * w2[2]; a[11] += s * w2[3];
                if ((i & 3) == 3) __builtin_amdgcn_sched_barrier(0);
            }
            float v = 0.f;
#pragma unroll
            for (int j = 0; j < 12; ++j) { const float sj = wave_sum(a[j]); v = (F.lane == j) ? sj : v; }
            if (F.lane < 12) mod[(size_t)r * 3072 + cg * 12 + F.lane] = v + F.bada[cg * 12 + F.lane];
        }
    }
    __syncthreads();
}
__device__ const double ROPE_INV[32] = {
    1.0, 0.7498942093324559, 0.5623413251903491, 0.4216965034285822, 0.31622776601683794, 0.23713737056616552, 0.1778279410038923, 0.1333521432163324,
    0.1, 0.07498942093324559, 0.05623413251903491, 0.04216965034285822, 0.03162277660168379, 0.023713737056616554, 0.01778279410038923, 0.01333521432163324,
    0.01, 0.007498942093324559, 0.005623413251903491, 0.004216965034285822, 0.0031622776601683794, 0.0023713737056616554, 0.0017782794100389228, 0.001333521432163324,
    0.001, 0.0007498942093324559, 0.0005623413251903491, 0.0004216965034285822, 0.00031622776601683794, 0.00023713737056616554, 0.00017782794100389227, 0.0001333521432163324};
DI void p0_rope_item(Frame& F, int item) {
    const int pos = 2 * item + (F.lane >> 5), d = F.lane & 31;
    if (pos >= 4100) return;
    const double ang = (double)pos * ROPE_INV[d];
    const double kq = __builtin_rint(ang * 0.6366197723675814);
    double r = __builtin_fma(-kq, 1.5707963267948966, ang); r = __builtin_fma(-kq, 6.123233995736766e-17, r);
    const int q = (int)kq & 3;
    const double r2 = r * r;
    const double sn = r * (1.0 + r2 * (-1.0 / 6 + r2 * (1.0 / 120 + r2 * (-1.0 / 5040 + r2 * (1.0 / 362880 + r2 * (-1.0 / 39916800 + r2 * (1.0 / 6227020800.0)))))));
    const double cs = 1.0 + r2 * (-0.5 + r2 * (1.0 / 24 + r2 * (-1.0 / 720 + r2 * (1.0 / 40320 + r2 * (-1.0 / 3628800 + r2 * (1.0 / 479001600.0 + r2 * (-1.0 / 87178291200.0)))))));
    const double c = (q == 0) ? cs : (q == 1) ? -sn : (q == 2) ? -cs : sn;
    const double s = (q == 0) ? sn : (q == 1) ? cs : (q == 2) ? -sn : -cs;
    WSP(float, WS_COS)[pos * 32 + d] = (float)c; WSP(float, WS_SIN)[pos * 32 + d] = (float)s;
}
DI void p0_cmp_small_item(Frame& F, int item) {
    if (item < 256) {
        const int slot = item >> 7, ch = (item >> 6) & 1, kc = item & 63, c = ch * 64 + F.lane; float a = 0.f;
#pragma unroll 8
        for (int i = 0; i < 32; ++i) { const int k = kc * 32 + i; a += F.pe[slot * 2048 + k] * F.w1[((size_t)slot * 2048 + k) * 128 + c]; }
        WSP(float, WS_BIASP)[(size_t)kc * 256 + slot * 128 + c] = a;
    } else {
        const int it = item - 256, slot = it >> 7, e = (it & 127) >> 1, ch = it & 1;
        const int c = ch * 64 + F.lane;
        WSP(bf16, WS_W2T)[((size_t)slot * 64 + e) * 128 + permk(c)] = (bf16)(pk2(F.w2[((size_t)slot * 128 + c) * 64 + e], 0.f) & 0xffffu);
    }
}
DI void cp_k16(const float* src, size_t rs, bf16* dst, int lane) {
    const int tk = lane >> 2, dc = (lane & 3) * 16;
    const f32x4* s = (const f32x4*)(src + (size_t)tk * rs + dc);
    const f32x4 a = s[0], b = s[1], c = s[2], d = s[3];
    u32x4 w0, w1; w0.x = pk2(a[0], a[1]); w0.y = pk2(a[2], a[3]); w0.z = pk2(b[0], b[1]); w0.w = pk2(b[2], b[3]);
    w1.x = pk2(c[0], c[1]); w1.y = pk2(c[2], c[3]); w1.z = pk2(d[0], d[1]); w1.w = pk2(d[2], d[3]);
    u32x4* o = (u32x4*)(dst + (size_t)tk * 64 + dc); o[0] = w0; o[1] = w1;
}
DI void cp_vt16(const float* src, size_t rs, bf16* dst, size_t pitch, int lane) {
#pragma unroll
    for (int h = 0; h < 2; ++h) {
        float v[8];
#pragma unroll
        for (int i = 0; i < 8; ++i) v[i] = src[(size_t)((i & 3) + 8 * (i >> 2) + 4 * h) * rs + lane];
        *(u32x4*)(dst + (size_t)lane * pitch + 8 * h) = pack8(v);
    }
}
DI void p0_gather_item(Frame& F, int item) {
    const int sb = item >> 7, tg = item & 127, tk0 = tg * 16, lane = opq(F.lane);
    const int pg = F.ptab[sb * NPG + (tk0 >> 7)], j0 = tk0 & 127;
    const float* nsa = F.cnsa + ((size_t)pg * PAGE + j0) * 512;
    const float* dsa = F.cdsa + ((size_t)pg * PAGE + j0) * 256;
    const float* idx = F.cidx + ((size_t)pg * PAGE + j0) * 64;
#pragma unroll
    for (int g = 0; g < 2; ++g) {
        const size_t bg = (size_t)sb * 2 + g;
        cp_k16(nsa + (0 * 2 + g) * 64, 512, WSP(bf16, WS_SCMPK) + (bg * LS + tk0) * 64, lane);
        cp_k16(nsa + (1 * 2 + g) * 64, 512, WSP(bf16, WS_SCMPV) + (bg * LS + tk0) * 64, lane);
        cp_k16(nsa + (2 * 2 + g) * 64, 512, WSP(bf16, WS_SSLCK) + (bg * LS + tk0) * 64, lane);
        cp_vt16(nsa + (3 * 2 + g) * 64, 512, WSP(bf16, WS_SSLCVT) + bg * 64 * LS + tk0, LS, lane);
        cp_k16(dsa + (0 * 2 + g) * 64, 256, WSP(bf16, WS_SDSAK) + (bg * LS + tk0) * 64, lane);
        cp_vt16(dsa + (1 * 2 + g) * 64, 256, WSP(bf16, WS_SDSAVT) + bg * 64 * LS + tk0, LS, lane);
    }
    cp_k16(idx, 64, WSP(bf16, WS_SIDXK) + ((size_t)sb * LS + tk0) * 64, lane);
}
DI void p0_win_item(Frame& F, int item) {
    const int sb = item >> 5, w0 = (item & 31) * 16, lane = opq(F.lane);
    const float* st = F.swin + ((size_t)sb * 512 + w0) * 256;
#pragma unroll
    for (int g = 0; g < 2; ++g) {
        const size_t bg = (size_t)sb * 2 + g;
        cp_k16(st + (0 * 2 + g) * 64, 256, WSP(bf16, WS_SWINK) + (bg * LSW + w0) * 64, lane);
        cp_vt16(st + (1 * 2 + g) * 64, 256, WSP(bf16, WS_SWINVT) + bg * 64 * LSW + w0, LSW, lane);
    }
}
DI void p0_zero_item(Frame& F, int item) {
    const int arr = item >> 8, bg = item & 255, lane = opq(F.lane);
    bf16* p; int n;
    if (arr == 0) { p = WSP(bf16, WS_SSLCVT) + ((size_t)bg * 64 + lane) * LS + 2052; n = 60; }
    else if (arr == 1) { p = WSP(bf16, WS_SDSAVT) + ((size_t)bg * 64 + lane) * LS + 2052; n = 60; }
    else { p = WSP(bf16, WS_SWINVT) + ((size_t)bg * 64 + lane) * LSW + 516; n = 60; }
    unsigned long long* q = (unsigned long long*)p;
    for (int i = 0; i < n / 4; ++i) q[i] = 0ull;
}
DI void p0_prologue(Frame& F, int um) {
    if (um & 1) p0_mod(F);
    LAS float* scr = (LAS float*)(F.lds + F.wave * 16384);
    const int gw = blockIdx.x * NWAVES + F.wave, NGW = F.G * NWAVES;
    constexpr int I_WIN = 16 * 171, I_UP = 8 * 32, I_OUT = 16 * 32, I_W1 = 32 * 4;
    constexpr int T0 = I_WIN, T1 = T0 + I_UP, T2 = T1 + I_UP, T3 = T2 + I_OUT, T4 = T3 + 2 * I_W1, T5 = T4 + 2050, T6 = T5 + 512, T7 = T6 + 768, T8 = T7 + SBATCH * 32, T9 = T8 + SBATCH * 128;
#ifdef ORACLE
    constexpr int TEND = T9;
#else
    constexpr int TEND = T7;
#endif
    if (um & 2) for (int it = gw; it < TEND; it += NGW) {
        if (it < T0) p0_transpose_item<true>(F.win, 1024, 5468, WSP(bf16, WS_WINT), scr, it, F.lane);
        else if (it < T1) p0_transpose_item<false>(F.wupn, 512, 1024, WSP(bf16, WS_WUPN), scr, it - T0, F.lane, 1024);
        else if (it < T2) p0_transpose_item<false>(F.wupd, 512, 1024, WSP(bf16, WS_WUPN) + 512, scr, it - T1, F.lane, 1024);
        else if (it < T3) p0_transpose_item<false>(F.wout, 1024, 1024, WSP(bf16, WS_WOUT), scr, it - T2, F.lane);
        else if (it < T4) { const int q = it - T3, slot = q / I_W1; p0_transpose_item<false>(F.w1 + (size_t)slot * 2048 * 128, 2048, 128, WSP(bf16, WS_W1T) + (size_t)slot * 128 * 2048, scr, q % I_W1, F.lane); }
        else if (it < T5) p0_rope_item(F, it - T4);
        else if (it < T6) p0_cmp_small_item(F, it - T5);
        else if (it < T7) p0_zero_item(F, it - T6);
#ifdef ORACLE
        else if (it < T8) p0_win_item(F, it - T7);
        else p0_gather_item(F, it - T8);
#endif
    }
}
DI void win_copy_item(Frame& F, int it) {
    constexpr int ROW4 = 508 * 64, Q4 = ROW4 / 4;
    const int sb = it >> 2, h0 = (it & 3) * Q4;
    const f32x4* sp = (const f32x4*)F.swin + (size_t)sb * 512 * 64 + 4 * 64 + h0; f32x4* dp = (f32x4*)(F.out + O_WINS) + (size_t)sb * 512 * 64 + h0;
    for (int i = F.tid; i < Q4; i += 512 * 16) {
        f32x4 v[16];
#pragma unroll
        for (int j = 0; j < 16; ++j) { const int k = i + j * 512; v[j] = k < Q4 ? __builtin_nontemporal_load(sp + k) : (f32x4){0.f, 0.f, 0.f, 0.f}; }
#pragma unroll
        for (int j = 0; j < 16; ++j) { const int k = i + j * 512; if (k < Q4) __builtin_nontemporal_store(v[j], dp + k); }
    }
}
DI void p1_adaln(Frame& F) {
    const int gw = blockIdx.x * NWAVES + F.wave, NGW = F.G * NWAVES;
    if (blockIdx.x == 0 && F.tid < 256) { float a = 0.f; for (int j = 0; j < 64; ++j) a += WSP(float, WS_BIASP)[j * 256 + F.tid]; WSP(float, WS_BIAS1)[F.tid] = a; }
    const float* mod = WSP(float, WS_MOD);
    f32x4 nx[4];
    { const int r = gw < MR ? gw : MR - 1; const f32x4* x4 = (const f32x4*)(r < MP ? F.xp + (size_t)r * 1024 : F.xs + (size_t)(r - MP) * 1024) + F.lane;
#pragma unroll
      for (int j = 0; j < 4; ++j) nx[j] = x4[64 * j]; }
    for (int r = gw; r < MR; r += NGW) {
        const int mrow = r < MP ? (r >> 12) : 4 + ((r - MP) >> 2);
        f32x4 v[4]; float s = 0.f;
#pragma unroll
        for (int j = 0; j < 4; ++j) { v[j] = nx[j]; s += (v[j][0] * v[j][0] + v[j][1] * v[j][1]) + (v[j][2] * v[j][2] + v[j][3] * v[j][3]); }
        { const int rn = r + NGW < MR ? r + NGW : r; const f32x4* x4 = (const f32x4*)(rn < MP ? F.xp + (size_t)rn * 1024 : F.xs + (size_t)(rn - MP) * 1024) + F.lane;
#pragma unroll
          for (int j = 0; j < 4; ++j) nx[j] = x4[64 * j]; }
        const float rstd = 1.f / sqrtf(wave_sum(s) * (1.f / 1024.f) + 1e-6f);
        const f32x4* g4 = (const f32x4*)F.normg + F.lane;
        const f32x4* sh4 = (const f32x4*)(mod + (size_t)mrow * 3072) + F.lane;
        const f32x4* sc4 = (const f32x4*)(mod + (size_t)mrow * 3072 + 1024) + F.lane;
        unsigned long long* o8 = (unsigned long long*)(WSP(bf16, WS_H) + (size_t)r * 1024) + F.lane;
#pragma unroll
        for (int j = 0; j < 4; ++j) {
            const f32x4 y = v[j] * rstd * g4[64 * j]; const f32x4 h = y * (1.f + sc4[64 * j]) + sh4[64 * j];
            o8[64 * j] = (unsigned long long)pk2(h[0], h[1]) | ((unsigned long long)pk2(h[2], h[3]) << 32);
        }
    }
}
DI void p8_final(Frame& F) {
    const int gw = MP + blockIdx.x * NWAVES + F.wave, NGW = F.G * NWAVES;
    const int lane_ = (int)__builtin_amdgcn_mbcnt_hi(~0u, __builtin_amdgcn_mbcnt_lo(~0u, 0u));
    f32x4 nx[4];
    { const int r = gw < MR ? gw : MR - 1; const f32x4* y4 = (const f32x4*)(r < MP ? F.out + O_YP + (size_t)r * 1024 : F.out + O_YS + (size_t)(r - MP) * 1024) + lane_;
#pragma unroll
      for (int j = 0; j < 4; ++j) nx[j] = y4[64 * j]; }
    for (int r = gw; r < MR; r += NGW) {
        float* yr = r < MP ? F.out + O_YP + (size_t)r * 1024 : F.out + O_YS + (size_t)(r - MP) * 1024;
        f32x4* y4 = (f32x4*)yr + lane_;
        f32x4 v[4]; float s = 0.f;
#pragma unroll
        for (int j = 0; j < 4; ++j) { v[j] = nx[j]; s += (v[j][0] * v[j][0] + v[j][1] * v[j][1]) + (v[j][2] * v[j][2] + v[j][3] * v[j][3]); }
        { const int rn = r + NGW < MR ? r + NGW : r; const f32x4* n4 = (const f32x4*)(rn < MP ? F.out + O_YP + (size_t)rn * 1024 : F.out + O_YS + (size_t)(rn - MP) * 1024) + lane_;
#pragma unroll
          for (int j = 0; j < 4; ++j) nx[j] = n4[64 * j]; }
        const float rstd = 1.f / sqrtf(wave_sum(s) * (1.f / 1024.f) + 1e-6f);
        const f32x4* g4 = (const f32x4*)F.fing + lane_;
#pragma unroll
        for (int j = 0; j < 4; ++j) y4[64 * j] = v[j] * rstd * g4[64 * j];
    }
}

constexpr int TP = 144;
constexpr int TILE_B = 64 * TP;
struct LdsT {
    static constexpr bool HOIST = true;
    const LAS unsigned char* p;
    DI bf16x8 frag(int mt, int s) const { return *(const LAS bf16x8*)(p + mt * 32 * TP + s * 32); }
};
struct GlbT {
    static constexpr bool HOIST = false;
    const bf16* base; unsigned off; unsigned pitch;
    DI bf16x8 frag(int mt, int s) const { return *(const bf16x8*)(base + (size_t)(off + (unsigned)mt * 32u * pitch + (unsigned)s * 16u)); }
};
template <class KT> DI void qk_tile(f32x16& s0, f32x16& s1, const KT& kt, const bf16x8 (&q)[4]) {
    f32x16 z;
#pragma unroll
    for (int i = 0; i < 16; ++i) z[i] = 0.f;
    s0 = z; s1 = z;
#pragma unroll
    for (int s = 0; s < 4; ++s) { s0 = MFMA32(kt.frag(0, s), q[s], s0); s1 = MFMA32(kt.frag(1, s), q[s], s1); }
}
DI bf16x8 cvt8(f32x4 a, f32x4 b) { u32x4 w; w.x = pk2(a[0], a[1]); w.y = pk2(a[2], a[3]); w.z = pk2(b[0], b[1]); w.w = pk2(b[2], b[3]); return __builtin_bit_cast(bf16x8, w); }
DI bf16x8 pack_p(const f32x16& x, int h) {
    u32x4 w; w.x = pk2(x[8 * h], x[8 * h + 1]); w.y = pk2(x[8 * h + 2], x[8 * h + 3]); w.z = pk2(x[8 * h + 4], x[8 * h + 5]); w.w = pk2(x[8 * h + 6], x[8 * h + 7]);
    return __builtin_bit_cast(bf16x8, w);
}
template <class VT> DI void pv_tile(f32x16& o0, f32x16& o1, const f32x16& p0, const f32x16& p1, const VT& vt) {
    const bf16x8 b0 = pack_p(p0, 0), b1 = pack_p(p0, 1), b2 = pack_p(p1, 0), b3 = pack_p(p1, 1);
    o0 = MFMA32(vt.frag(0, 0), b0, o0); o1 = MFMA32(vt.frag(1, 0), b0, o1);
    o0 = MFMA32(vt.frag(0, 1), b1, o0); o1 = MFMA32(vt.frag(1, 1), b1, o1);
    o0 = MFMA32(vt.frag(0, 2), b2, o0); o1 = MFMA32(vt.frag(1, 2), b2, o1);
    o0 = MFMA32(vt.frag(0, 3), b3, o0); o1 = MFMA32(vt.frag(1, 3), b3, o1);
}
typedef float f32x8s __attribute__((ext_vector_type(8)));
struct Soft { float m, l; bool seen; f32x16 o0, o1, negm; };
DI void soft_init(Soft& S) {
    S.m = 0.f; S.l = 0.f; S.seen = false;
#pragma unroll
    for (int i = 0; i < 16; ++i) { S.o0[i] = 0.f; S.o1[i] = 0.f; S.negm[i] = 0.f; }
}
template <class KT> DI void qk_tile_c(f32x16& s0, f32x16& s1, const KT& kt, const bf16x8 (&q)[4], const f32x16& c) {
    if constexpr (KT::HOIST) {
        bf16x8 f[8];
#pragma unroll
        for (int s = 0; s < 4; ++s) { f[2 * s] = kt.frag(0, s); f[2 * s + 1] = kt.frag(1, s); }
        __builtin_amdgcn_sched_barrier(0);
        s0 = MFMA32(f[0], q[0], c); s1 = MFMA32(f[1], q[0], c);
#pragma unroll
        for (int s = 1; s < 4; ++s) { s0 = MFMA32(f[2 * s], q[s], s0); s1 = MFMA32(f[2 * s + 1], q[s], s1); }
    } else {
        s0 = MFMA32(kt.frag(0, 0), q[0], c); s1 = MFMA32(kt.frag(1, 0), q[0], c);
#pragma unroll
        for (int s = 1; s < 4; ++s) { s0 = MFMA32(kt.frag(0, s), q[s], s0); s1 = MFMA32(kt.frag(1, s), q[s], s1); }
    }
    asm volatile("s_nop 15\n\ts_nop 7" : "+v"(s0), "+v"(s1));
}
DI float max3f(float a, float b, float c) { float r; asm("v_max3_f32 %0, %1, %2, %3" : "=v"(r) : "v"(a), "v"(b), "v"(c)); return r; }
template <class VT> DI void soft_step(Soft& S, f32x16& s0, f32x16& s1, const VT& vt) {
    bf16x8 vf[8];
    if constexpr (VT::HOIST) {
#pragma unroll
        for (int s = 0; s < 4; ++s) { vf[2 * s] = vt.frag(0, s); vf[2 * s + 1] = vt.frag(1, s); }
        __builtin_amdgcn_sched_barrier(0);
    }
    float mx = max3f(s0[0], s1[0], s0[1]), my = max3f(s1[1], s0[2], s1[2]);
#pragma unroll
    for (int r = 3; r < 15; r += 2) { mx = max3f(mx, s0[r], s1[r]); my = max3f(my, s0[r + 1], s1[r + 1]); }
    mx = max3f(mx, s0[15], s1[15]); mx = max3f(mx, my, mx);
    mx = max3f(mx, half_other(mx), mx);
    const bool fin = mx > NEGINF;
    const bool need = (mx > 8.f) | (fin & !S.seen);
    if (__any(need)) {
        const float dl = need ? mx : 0.f;
        const float al = S.seen ? __builtin_amdgcn_exp2f(-dl) : 0.f;
        S.m += dl; S.l *= need ? al : 1.f;
        const float am = need ? al : 1.f;
#pragma unroll
        for (int r = 0; r < 16; ++r) { s0[r] -= dl; s1[r] -= dl; S.o0[r] *= am; S.o1[r] *= am; S.negm[r] = -S.m; }
    }
    S.seen = S.seen | fin;
#pragma unroll
    for (int r = 0; r < 16; ++r) { s0[r] = __builtin_amdgcn_exp2f(s0[r]); s1[r] = __builtin_amdgcn_exp2f(s1[r]); }
    { const f32x16 t16 = s0 + s1; const f32x8s t8 = t16.lo + t16.hi; const f32x4 t4 = t8.lo + t8.hi; S.l += (t4[0] + t4[1]) + (t4[2] + t4[3]); }
    const bf16x8 b0 = pack_p(s0, 0), b1 = pack_p(s0, 1), b2 = pack_p(s1, 0), b3 = pack_p(s1, 1);
    if constexpr (!VT::HOIST) {
#pragma unroll
        for (int s = 0; s < 4; ++s) { vf[2 * s] = vt.frag(0, s); vf[2 * s + 1] = vt.frag(1, s); }
    }
    S.o0 = MFMA32(vf[0], b0, S.o0); S.o1 = MFMA32(vf[1], b0, S.o1);
    S.o0 = MFMA32(vf[2], b1, S.o0); S.o1 = MFMA32(vf[3], b1, S.o1);
    S.o0 = MFMA32(vf[4], b2, S.o0); S.o1 = MFMA32(vf[5], b2, S.o1);
    S.o0 = MFMA32(vf[6], b3, S.o0); S.o1 = MFMA32(vf[7], b3, S.o1);
}
DI float as_f(int x) { return __int_as_float(x); }
DI float mask_sel(float s, int mm) { return __int_as_float((__float_as_int(s) & mm) | ((int)0xff800000 & ~mm)); }
DI u32x4 tile_ld(const bf16* g, size_t pitch, int tid) { return *(const u32x4*)(g + (size_t)(tid >> 3) * pitch + (tid & 7) * 8); }
DI void tile_st(LAS unsigned char* buf, u32x4 v, int tid) { *(LAS u32x4*)(buf + (tid >> 3) * TP + (tid & 7) * 16) = v; }

constexpr int CP = 272;
DI void compress_unit(Frame& F, int u) {
    const int tid = opq(F.tid), lane = opq(F.lane), w = F.wave, l31 = lane & 31, hi = lane >> 5;
    const int slot = u / 136, rem = u % 136;
    const bf16* data; bf16 *ock, *ocvt; int n0, ncmp, cpitch;
    if (rem < 8) { const int bg = rem; data = WSP(bf16, (slot ? WS_PCMPV : WS_PCMPK)) + (size_t)bg * SEQ * 64; n0 = 32 * w; ncmp = 255; cpitch = 256;
        ock = WSP(bf16, WS_PCK) + (size_t)bg * 256 * 64; ocvt = WSP(bf16, WS_PCVT) + (size_t)bg * 64 * 256; }
    else { const int bg = 2 * (rem - 8) + (w >> 2); data = WSP(bf16, (slot ? WS_SCMPV : WS_SCMPK)) + (size_t)bg * LS * 64; n0 = 32 * (w & 3); ncmp = 127; cpitch = 128;
        ock = WSP(bf16, WS_SCK) + (size_t)bg * 128 * 64; ocvt = WSP(bf16, WS_SCVT) + (size_t)bg * 64 * 128; }
    const int n = n0 + l31, nc = n < ncmp ? n : ncmp - 1;
    const bf16* drow = data + (size_t)nc * 1024 + 8 * hi;
    const bool paged = rem >= 8;
    const bf16* w1t = WSP(bf16, WS_W1T) + (size_t)slot * 128 * 2048;
    f32x16 acc[4];
#pragma unroll
    for (int c = 0; c < 4; ++c)
#pragma unroll
        for (int i = 0; i < 16; ++i) acc[c][i] = 0.f;
    const bf16* wsrc = w1t + (size_t)(tid >> 2) * 2048 + ((tid & 3) >> 1) * 1024 + (tid & 1) * 32;
    LAS unsigned char* wdst = F.lds + (tid >> 2) * CP + (tid & 3) * 64;
    u32x4 st[4];
#pragma unroll
    for (int i = 0; i < 4; ++i) st[i] = ((const u32x4*)wsrc)[i];
#pragma unroll
    for (int i = 0; i < 4; ++i) ((LAS u32x4*)wdst)[i] = st[i];
    LDS_BARRIER();
    f32x4 raw[16];
#define CMP_ISSUE(kc_) do { if (!paged) { _Pragma("unroll") for (int s_ = 0; s_ < 8; ++s_) raw[2 * s_] = __builtin_bit_cast(f32x4, *(const bf16x8*)(drow + ((kc_) + 16 * (s_ >> 2)) * 64 + (s_ & 3) * 16)); } \
        } while (0)
    LAS unsigned char* const wrows = F.lds + 2 * 128 * CP + w * (36 * TP);
    const int q4 = lane >> 4, c16 = lane & 15;
    const float *lb0 = nullptr, *lb8 = nullptr; int pgs[5] = {0, 0, 0, 0, 0};
    if (paged) { const int sb = rem - 8, g = w >> 2;
#pragma unroll
        for (int k = 0; k < 5; ++k) { const int pi = (n0 >> 3) + k; pgs[k] = F.ptab[sb * NPG + (pi < NPG ? pi : NPG - 1)]; }
        lb8 = F.cnsa + (slot * 2 + g) * 64 + 4 * c16; lb0 = lb8 + (size_t)(16 * q4) * 512; }
#define CMP_ISSUE_P(kc_) do { _Pragma("unroll") for (int i_ = 0; i_ < 9; ++i_) raw[i_] = *(const f32x4*)((i_ < 8 ? lb0 : lb8) + ((size_t)pgs[i_ >> 1] * PAGE + 64 * (i_ & 1) + (kc_)) * 512); } while (0)
    if (!paged) CMP_ISSUE(0); else CMP_ISSUE_P(0);
    for (int kc = 0; kc < 16; ++kc) {
        const LAS unsigned char* buf = F.lds + (kc & 1) * (128 * CP);
        if (kc + 1 < 16) {
#pragma unroll
            for (int i = 0; i < 4; ++i) st[i] = ((const u32x4*)(wsrc + (kc + 1) * 64))[i];
        }
        bf16x8 bq[8];
        if (!paged) {
#pragma unroll
            for (int s = 0; s < 8; ++s) bq[s] = __builtin_bit_cast(bf16x8, raw[2 * s]);
            if (kc + 1 < 16) CMP_ISSUE(kc + 1);
        } else {
#pragma unroll
            for (int i = 0; i < 9; ++i) { u32x2 wv; wv.x = pk2(raw[i][0], raw[i][1]); wv.y = pk2(raw[i][2], raw[i][3]); *(LAS u32x2*)(wrows + (4 * i + q4) * TP + c16 * 8) = wv; }
            if (kc + 1 < 16) CMP_ISSUE_P(kc + 1);
#pragma unroll
            for (int s = 0; s < 8; ++s) bq[s] = *(const LAS bf16x8*)(wrows + (l31 + (s >> 2)) * TP + ((s & 3) * 16 + 8 * hi) * 2);
        }
#pragma unroll
        for (int s = 0; s < 8; ++s)
#pragma unroll
            for (int c = 0; c < 4; ++c) acc[c] = MFMA32(*(const LAS bf16x8*)(buf + (32 * c + l31) * CP + s * 32 + hi * 16), bq[s], acc[c]);
        if (kc + 1 < 16) {
            LAS unsigned char* nb = wdst + ((kc + 1) & 1) * (128 * CP);
#pragma unroll
            for (int i = 0; i < 4; ++i) ((LAS u32x4*)nb)[i] = st[i];
        }
        LDS_BARRIER();
    }
#undef CMP_ISSUE
#undef CMP_ISSUE_P
    const float* b1 = WSP(float, WS_BIAS1) + slot * 128;
#pragma unroll
    for (int c = 0; c < 4; ++c)
#pragma unroll
        for (int q = 0; q < 4; ++q) { const f32x4 bv = *(const f32x4*)(b1 + 32 * c + 8 * q + 4 * hi);
#pragma unroll
            for (int j = 0; j < 4; ++j) acc[c][4 * q + j] = silu_f(acc[c][4 * q + j] + bv[j]); }
    const bf16* w2t = WSP(bf16, WS_W2T) + (size_t)slot * 64 * 128 + (size_t)l31 * 128 + 8 * hi;
    f32x16 o0, o1;
#pragma unroll
    for (int i = 0; i < 16; ++i) { o0[i] = 0.f; o1[i] = 0.f; }
#pragma unroll
    for (int c = 0; c < 4; ++c)
#pragma unroll
        for (int h = 0; h < 2; ++h) { const bf16x8 hb = pack_p(acc[c], h); const int s2 = 2 * c + h;
            o0 = MFMA32(*(const bf16x8*)(w2t + s2 * 16), hb, o0); o1 = MFMA32(*(const bf16x8*)(w2t + 32 * 128 + s2 * 16), hb, o1); }
    const bool ok = n < ncmp;
    if (slot == 0) {
#pragma unroll
        for (int e = 0; e < 2; ++e)
#pragma unroll
            for (int q = 0; q < 4; ++q) { const f32x16& o = e ? o1 : o0; u32x2 wv;
                wv.x = ok ? pk2(o[4 * q], o[4 * q + 1]) : 0u; wv.y = ok ? pk2(o[4 * q + 2], o[4 * q + 3]) : 0u;
                *(u32x2*)(ock + (size_t)n * 64 + 32 * e + 8 * q + 4 * hi) = wv; }
    } else {
        const int pn = permk(n);
#pragma unroll
        for (int e = 0; e < 2; ++e)
#pragma unroll
            for (int r = 0; r < 16; ++r) { const f32x16& o = e ? o1 : o0; ocvt[(size_t)(32 * e + crow(r, hi)) * cpitch + pn] = ok ? (bf16)(pk2(o[r], 0.f) & 0xffffu) : (bf16)0; }
    }
}

template <int NR, int ABL> DI void idx_select(const LAS int* scw, int n, int lane, unsigned long long* out) {
    int k[NR];
    int kmin = 0x7fffffff, kmax = (int)0x80000000;
#pragma unroll
    for (int i = 0; i < NR; ++i) { const bool v = 64 * i + lane < n; const int x = v ? scw[64 * i + lane] : (int)0x80000000; k[i] = x; kmin = v ? (x < kmin ? x : kmin) : kmin; kmax = x > kmax ? x : kmax; }
    int thr = (int)0x80000000, cut = -1;
    if (n > 256 && !(ABL & 1)) {
        kmin = wave_min_i(kmin); kmax = wave_max_i(kmax);
        int lo = kmin - 1, hiv = kmax;
        bool found = false;
        if (hiv > 0x04000000) {
            const int kp = hiv - 0x03800000;
            int c = 0, cl = 0;
#pragma unroll
            for (int i0 = 0; i0 < NR; i0 += 8) {
                unsigned long long bm[4];
#pragma unroll
                for (int j = 0; j < 4; ++j) bm[j] = __ballot(k[i0 + j] > kp);
#pragma unroll
                for (int j = 4; j < 8; ++j) cl += (k[i0 + j] > kp) ? 1 : 0;
#pragma unroll
                for (int j = 0; j < 4; ++j) c += __popcll(bm[j]);
            }
            c += wave_sum_i(cl);
            if (c == 256) { thr = kp; found = true; } else if (c > 256) lo = kp; else hiv = kp;
        }
        while (!found && (unsigned)hiv - (unsigned)lo > 1u) {
            const int mid = (int)((unsigned)lo + (((unsigned)hiv - (unsigned)lo) >> 1));
            int c = 0, cl = 0;
#pragma unroll
            for (int i0 = 0; i0 < NR; i0 += 8) {
                unsigned long long bm[4];
#pragma unroll
                for (int j = 0; j < 4; ++j) bm[j] = __ballot(k[i0 + j] > mid);
#pragma unroll
                for (int j = 4; j < 8; ++j) cl += (k[i0 + j] > mid) ? 1 : 0;
#pragma unroll
                for (int j = 0; j < 4; ++j) c += __popcll(bm[j]);
            }
            c += wave_sum_i(cl);
            if (c == 256) { thr = mid; found = true; break; }
            if (c > 256) lo = mid; else hiv = mid;
        }
        if (!found) {
            thr = hiv; int cgt = 0;
#pragma unroll
            for (int i = 0; i < NR; ++i) cgt += __popcll(__ballot(k[i] > thr));
            const int need = 256 - cgt; int acc = 0; bool done = false;
#pragma unroll
            for (int i = 0; i < NR; ++i) {
                unsigned long long mk = __ballot(k[i] == thr); const int pc = __popcll(mk);
                if (!done && acc + pc >= need) { for (int q2 = 1; q2 < need - acc; ++q2) mk &= mk - 1; cut = 64 * i + (int)__builtin_ctzll(mk); done = true; }
                acc += pc;
            }
        }
    }
    unsigned long long myw = 0ull;
    if (ABL & 4) { myw = (unsigned long long)(k[0] + k[NR - 1] + kmin + kmax); } else
#pragma unroll
    for (int i = 0; i < NR; ++i) { const unsigned long long mk = __ballot((k[i] > thr) | ((k[i] == thr) & (64 * i + lane <= cut))); myw = (lane == i) ? mk : myw; }
    out[lane] = myw;
}
template <bool SAMPLE, int ABL> DI void idx1_unit(Frame& F, int u) {
    const int lane = opq(F.lane), w = F.wave, l31 = lane & 31, hi = lane >> 5, tl = l31 >> 2, hl = l31 & 3;
    int row0, nkmax, ntok; const bf16* ik;
    if (!SAMPLE) { const int b = u & 3, tc = 511 - (u >> 2); row0 = b * SEQ + 8 * tc; nkmax = 8 * tc + 8; ntok = 8; ik = WSP(bf16, WS_PIDXK) + (size_t)b * SEQ * 64; }
    else { row0 = MP + 4 * u; nkmax = PASTL + 4; ntok = 4; ik = WSP(bf16, WS_SIDXK) + (size_t)u * LS * 64; }
    const int rowq = row0 + (SAMPLE ? (tl & 3) : tl);
    bf16x8 q[4];
#pragma unroll
    for (int s = 0; s < 4; ++s) q[s] = *(const bf16x8*)(WSP(bf16, WS_IQ) + (size_t)rowq * 256 + hl * 64 + 16 * s + 8 * hi);
    f32x4 wq[4];
#pragma unroll
    for (int qq = 0; qq < 4; ++qq) { const int tk = 2 * qq + hi; wq[qq] = *(const f32x4*)(WSP(float, WS_IW) + (size_t)(row0 + (SAMPLE ? (tk & 3) : tk)) * 4); }
    LAS int* sc = (LAS int*)F.lds;
    const int n32 = (nkmax + 31) >> 5;
    u32x4 rA[8], rB[8];
    const int pgv = SAMPLE ? F.ptab[u * NPG + (lane & 15)] : 0;
    LAS unsigned char* const stg = F.lds + STG_OFF + w * 2048;
    const int wofs_b = ((lane >> 2) * 64) + ((((lane & 3) ^ ((lane >> 4) & 3))) * 16);
    const int rofs0 = l31 * 64 + ((hi ^ ((l31 >> 2) & 3)) * 16), rofs1 = l31 * 64 + (((2 + hi) ^ ((l31 >> 2) & 3)) * 16);
#define IDX_ISSUE_B(R, base_, dup_) do { const bf16* kp_ = (base_) + (lane >> 2) * 64 + (lane & 3) * 8; \
        R[0] = gload16(kp_); R[2] = gload16(kp_ + 16 * 64); R[4] = gload16(kp_ + 32); R[6] = gload16(kp_ + 16 * 64 + 32); \
        if (dup_) { R[1] = gload16(kp_); R[3] = gload16(kp_ + 16 * 64); R[5] = gload16(kp_ + 32); R[7] = gload16(kp_ + 16 * 64 + 32); } } while (0)
#define IDX_ISSUE(R, kt_) do { const int kk_ = (kt_) < n32 ? (kt_) : n32 - 1; \
        if (SAMPLE) { if (kk_ < 64) { const int pg = __builtin_amdgcn_readlane(pgv, kk_ >> 2); const float* fp = F.cidx + ((size_t)pg * PAGE + (kk_ & 3) * 32 + (lane >> 3)) * 64 + 4 * (lane & 7); \
              _Pragma("unroll") for (int i_ = 0; i_ < 4; ++i_) { R[i_] = gload16(fp + 8 * i_ * 64); R[4 + i_] = gload16(fp + 8 * i_ * 64 + 32); } } \
            else IDX_ISSUE_B(R, ik + (size_t)(32 * kk_) * 64, true); } \
        else IDX_ISSUE_B(R, ik + (size_t)(32 * kk_) * 64, false); } while (0)
#define IDX_WAIT(R) do { if (SAMPLE) asm volatile("s_waitcnt vmcnt(8)" : "+v"(R[0]), "+v"(R[1]), "+v"(R[2]), "+v"(R[3]), "+v"(R[4]), "+v"(R[5]), "+v"(R[6]), "+v"(R[7]) :: "memory"); \
        else asm volatile("s_waitcnt vmcnt(4)" : "+v"(R[0]), "+v"(R[2]), "+v"(R[4]), "+v"(R[6]) :: "memory"); } while (0)
#define IDX_STAGE_F(R, h_) do { _Pragma("unroll") for (int i_ = 0; i_ < 4; ++i_) { const f32x4 x_ = __builtin_bit_cast(f32x4, R[4 * (h_) + i_]); u32x2 wv_; wv_.x = pk2(x_[0], x_[1]); wv_.y = pk2(x_[2], x_[3]); \
        const int row_ = (lane >> 3) + 8 * i_; *(LAS u32x2*)(stg + row_ * 64 + ((((lane & 7) >> 1) ^ ((row_ >> 2) & 3)) * 16) + (lane & 1) * 8) = wv_; } } while (0)
#define IDX_STAGE_B(R, h_) do { *(LAS u32x4*)(stg + wofs_b) = R[4 * (h_)]; *(LAS u32x4*)(stg + wofs_b + 1024) = R[4 * (h_) + 2]; } while (0)
#define IDX_FRAGS(R, kt_, kf_) do { \
        if (SAMPLE && (kt_) < 64) { IDX_STAGE_F(R, 0); kf_[0] = *(const LAS bf16x8*)(stg + rofs0); kf_[1] = *(const LAS bf16x8*)(stg + rofs1); \
                                    IDX_STAGE_F(R, 1); kf_[2] = *(const LAS bf16x8*)(stg + rofs0); kf_[3] = *(const LAS bf16x8*)(stg + rofs1); } \
        else { IDX_STAGE_B(R, 0); kf_[0] = *(const LAS bf16x8*)(stg + rofs0); kf_[1] = *(const LAS bf16x8*)(stg + rofs1); \
               IDX_STAGE_B(R, 1); kf_[2] = *(const LAS bf16x8*)(stg + rofs0); kf_[3] = *(const LAS bf16x8*)(stg + rofs1); } } while (0)
#define RELU_(x) __builtin_amdgcn_fmed3f((x), 0.f, __builtin_inff())
#define IDX_SCORE(R, kt_) do { IDX_WAIT(R); if ((kt_) < n32) { bf16x8 kf[4]; IDX_FRAGS(R, kt_, kf); \
        f32x16 a; _Pragma("unroll") for (int i_ = 0; i_ < 16; ++i_) a[i_] = 0.f; \
        _Pragma("unroll") for (int s_ = 0; s_ < 4; ++s_) a = MFMA32(q[s_], kf[s_], a); \
        _Pragma("unroll") for (int qq = 0; qq < 4; ++qq) { \
            float v = RELU_(a[4 * qq]) * wq[qq][0] + RELU_(a[4 * qq + 1]) * wq[qq][1] + RELU_(a[4 * qq + 2]) * wq[qq][2] + RELU_(a[4 * qq + 3]) * wq[qq][3]; \
            int uu = __float_as_int(v); uu = (uu == (int)0x80000000) ? 0 : uu; \
            sc[(2 * qq + hi) * 4096 + 32 * (kt_) + l31] = uu ^ ((uu >> 31) & 0x7fffffff); } } } while (0)
    if (!(ABL & 2)) {
        IDX_ISSUE(rA, w); IDX_ISSUE(rB, w + NWAVES);
        PIN4(q); PIN4(wq);
        asm volatile("s_waitcnt vmcnt(0)" ::: "memory");
        for (int kt = w; kt < n32; kt += 2 * NWAVES) {
            IDX_SCORE(rA, kt); IDX_ISSUE(rA, kt + 2 * NWAVES);
            IDX_SCORE(rB, kt + NWAVES); IDX_ISSUE(rB, kt + 3 * NWAVES);
        }
        asm volatile("s_waitcnt vmcnt(0)" : "+v"(rA[0]), "+v"(rA[2]), "+v"(rA[4]), "+v"(rA[6]), "+v"(rB[0]), "+v"(rB[2]), "+v"(rB[4]), "+v"(rB[6]) :: "memory");
        if (SAMPLE) asm volatile("" : "+v"(rA[1]), "+v"(rA[3]), "+v"(rA[5]), "+v"(rA[7]), "+v"(rB[1]), "+v"(rB[3]), "+v"(rB[5]), "+v"(rB[7]));
    }
#undef IDX_ISSUE
#undef IDX_ISSUE_B
#undef IDX_STAGE_F
#undef IDX_STAGE_B
#undef IDX_FRAGS
#undef IDX_WAIT
#undef IDX_SCORE
#undef RELU_
    __syncthreads();
    if (w < ntok && !(ABL & 8)) {
        const int n = SAMPLE ? (PASTL + 1 + w) : (row0 - (row0 & ~(SEQ - 1)) + w + 1);
        unsigned long long* out = WSP(unsigned long long, ABL ? WS_T1 : WS_SELM) + (size_t)(row0 + w) * 64;
        const LAS int* scw = sc + w * 4096;
        if (n <= 1024) idx_select<16, ABL>(scw, n, lane, out);
        else if (n <= 2048) idx_select<32, ABL>(scw, n, lane, out);
        else if (n <= 3072) idx_select<48, ABL>(scw, n, lane, out);
        else idx_select<64, ABL>(scw, n, lane, out);
    }
    __syncthreads();
}


constexpr int NSA_PS = 2 * 2 * TILE_B;
constexpr int NSA_WS = 8192 + 2048 + 64;
template <bool SAMPLE> DI void nsa_unit(Frame& F, int u) {
    const int tid = opq(F.tid), lane = opq(F.lane), w = F.wave, l31 = lane & 31, hi = lane >> 5, tl = l31 >> 2, hl = l31 & 3;
    int bg, g, row, qpos, ncmp, wlo, whi, n_ctile, n_stile, w_t0, w_t1, qt = 0;
    size_t cpitch, pitch, wpitch; const bf16 *ck, *cvt, *sk, *svt, *wk, *wvt; bool wr_ok;
    if (!SAMPLE) {
        bg = u & 7; qt = 63 - (u >> 3); g = bg & 1; const int t = 64 * qt + 8 * w + tl; row = (bg >> 1) * SEQ + t; qpos = t; ncmp = 255;
        cpitch = 256; pitch = SEQ; wpitch = SEQ;
        ck = WSP(bf16, WS_PCK) + (size_t)bg * 256 * 64; cvt = WSP(bf16, WS_PCVT) + (size_t)bg * 64 * 256;
        sk = WSP(bf16, WS_PSLCK) + (size_t)bg * SEQ * 64; svt = WSP(bf16, WS_PSLCVT) + (size_t)bg * 64 * SEQ;
        wk = WSP(bf16, WS_PWINK) + (size_t)bg * SEQ * 64; wvt = WSP(bf16, WS_PWINVT) + (size_t)bg * 64 * SEQ;
        wlo = qpos - 511; whi = qpos; n_ctile = (4 * qt + 2) / 64 + 1; n_stile = qt + 1; w_t0 = qt > 8 ? qt - 8 : 0; w_t1 = qt; wr_ok = true;
    } else {
        bg = u * 8 + w; g = bg & 1; const int i = tl & 3; row = MP + (bg >> 1) * 4 + i; qpos = PASTL + i; ncmp = 127;
        cpitch = 128; pitch = LS; wpitch = LSW;
        ck = WSP(bf16, WS_SCK) + (size_t)bg * 128 * 64; cvt = WSP(bf16, WS_SCVT) + (size_t)bg * 64 * 128;
        sk = WSP(bf16, WS_SSLCK) + (size_t)bg * LS * 64; svt = WSP(bf16, WS_SSLCVT) + (size_t)bg * 64 * LS;
        wk = WSP(bf16, WS_SWINK) + (size_t)bg * LSW * 64; wvt = WSP(bf16, WS_SWINVT) + (size_t)bg * 64 * LSW;
        wlo = 1 + i; whi = 512 + i; n_ctile = 2; n_stile = 33; w_t0 = 0; w_t1 = 8; wr_ok = tl < 4;
    }
    const int hq = 4 * g + hl;
    bf16x8 qraw[4], qrot[4];
#pragma unroll
    for (int s = 0; s < 4; ++s) qraw[s] = *(const bf16x8*)(WSP(bf16, WS_QRAW) + (size_t)row * 512 + hq * 64 + 16 * s + 8 * hi);
    LAS unsigned char* const lb = F.lds;
    LAS float* psum = (LAS float*)(lb + NSA_PS + w * NSA_WS);
    LAS float* impb = (LAS float*)(lb + NSA_PS + w * NSA_WS + 8192);
    LAS unsigned char* selb = lb + NSA_PS + w * NSA_WS + 8192 + 2048;
    const int fo = l31 * TP + hi * 16;
    const float* gp = WSP(float, WS_GATES) + (size_t)row * 24 + hq * 3;
    float g0 = gp[0], g1 = gp[1], g2 = gp[2];
    PIN4(qraw); asm volatile("" : "+v"(g0), "+v"(g1), "+v"(g2));
    f32x16 s0, s1;
    u32x4 rk, rv;
    Soft S;

    const int nvr = (qpos - 31) >> 4, nvis = nvr < ncmp - 1 ? nvr : ncmp - 1;
    float m = -1e30f, l = 0.f;
    if (!SAMPLE) { rk = tile_ld(ck, 64, tid); rv = tile_ld(cvt, cpitch, tid); tile_st(lb, rk, tid); tile_st(lb + TILE_B, rv, tid); LDS_BARRIER(); }
    for (int ct = 0; ct < n_ctile; ++ct) {
        if (!SAMPLE) { if (ct + 1 < n_ctile) { rk = tile_ld(ck + (size_t)(ct + 1) * 64 * 64, 64, tid); rv = tile_ld(cvt + (ct + 1) * 64, cpitch, tid); } }
        if (!SAMPLE) { LdsT kt{lb + (ct & 1) * 2 * TILE_B + fo}; qk_tile(s0, s1, kt, qraw); }
        else { GlbT kt{ck, (unsigned)((64 * ct + l31) * 64 + 8 * hi), 64u}; qk_tile(s0, s1, kt, qraw); }
        float mx = -1e30f;
        const int nv2 = nvis - 64 * ct - 4 * hi;
#pragma unroll
        for (int r = 0; r < 16; ++r) { const int cr = (r & 3) + 8 * (r >> 2); s0[r] = cr <= nv2 ? s0[r] : NEGINF; s1[r] = cr + 32 <= nv2 ? s1[r] : NEGINF; mx = fmaxf(mx, fmaxf(s0[r], s1[r])); }
        mx = fmaxf(mx, half_other(mx));
        const float mn = fmaxf(m, mx); float ps;
        { f32x16 e0, e1;
#pragma unroll
          for (int r = 0; r < 16; ++r) { e0[r] = __builtin_amdgcn_exp2f(s0[r] - mn); e1[r] = __builtin_amdgcn_exp2f(s1[r] - mn); }
          const f32x16 t16 = e0 + e1; const f32x8s t8 = t16.lo + t16.hi; const f32x4 t4 = t8.lo + t8.hi; ps = (t4[0] + t4[1]) + (t4[2] + t4[3]); }
        l = l * __builtin_amdgcn_exp2f(m - mn) + ps; m = mn;
        if (!SAMPLE) { if (ct + 1 < n_ctile) { tile_st(lb + ((ct + 1) & 1) * 2 * TILE_B, rk, tid); tile_st(lb + ((ct + 1) & 1) * 2 * TILE_B + TILE_B, rv, tid); } LDS_BARRIER(); }
    }
    l += half_other(l);
    const float linv = l > 0.f ? 1.f / l : 0.f;
    soft_init(S);
    if (!SAMPLE) { rk = tile_ld(ck, 64, tid); rv = tile_ld(cvt, cpitch, tid); tile_st(lb, rk, tid); tile_st(lb + TILE_B, rv, tid); LDS_BARRIER(); }
    for (int ct = 0; ct < n_ctile; ++ct) {
        if (!SAMPLE) { if (ct + 1 < n_ctile) { rk = tile_ld(ck + (size_t)(ct + 1) * 64 * 64, 64, tid); rv = tile_ld(cvt + (ct + 1) * 64, cpitch, tid); } }
        if (!SAMPLE) { LdsT kt{lb + (ct & 1) * 2 * TILE_B + fo}; qk_tile(s0, s1, kt, qraw); }
        else { GlbT kt{ck, (unsigned)((64 * ct + l31) * 64 + 8 * hi), 64u}; qk_tile(s0, s1, kt, qraw); }
        const int nv2 = nvis - 64 * ct - 4 * hi; LAS float* pw = psum + tl * 256 + 64 * ct + 4 * hi;
#pragma unroll
        for (int r = 0; r < 16; ++r) { const int cr = (r & 3) + 8 * (r >> 2);
            s0[r] = cr <= nv2 ? __builtin_amdgcn_exp2f(s0[r] - m) * linv : 0.f; s1[r] = cr + 32 <= nv2 ? __builtin_amdgcn_exp2f(s1[r] - m) * linv : 0.f;
            float a = s0[r]; a += dpp_x1(a); a += dpp_x2(a); float b = s1[r]; b += dpp_x1(b); b += dpp_x2(b);
            if (hl == 0) { pw[cr] = a; pw[cr + 32] = b; } }
        if (!SAMPLE) { LdsT vt{lb + (ct & 1) * 2 * TILE_B + TILE_B + fo}; pv_tile(S.o0, S.o1, s0, s1, vt); }
        else { GlbT vt{cvt, (unsigned)(l31 * (int)cpitch + 64 * ct + 8 * hi), (unsigned)cpitch}; pv_tile(S.o0, S.o1, s0, s1, vt); }
        if (!SAMPLE) { if (ct + 1 < n_ctile) { tile_st(lb + ((ct + 1) & 1) * 2 * TILE_B, rk, tid); tile_st(lb + ((ct + 1) & 1) * 2 * TILE_B + TILE_B, rv, tid); } LDS_BARRIER(); }
    }
    LDS_WAIT();
    unsigned mlo, mhi;
    {
        const int tk = lane >> 3, jb = 8 * (lane & 7);
        const int qp = SAMPLE ? PASTL + (tk & 3) : 64 * qt + 8 * w + tk, cur = qp >> 6;
        float pv[33];
        const LAS f32x4* pp = (const LAS f32x4*)(psum + tk * 256 + 4 * jb);
#pragma unroll
        for (int i = 0; i < 8; ++i) { const f32x4 x = pp[i]; pv[1 + 4 * i] = x[0]; pv[2 + 4 * i] = x[1]; pv[3 + 4 * i] = x[2]; pv[4 + 4 * i] = x[3]; }
        pv[0] = jb > 0 ? psum[tk * 256 + 4 * jb - 1] : 0.f;
        float v[8];
#pragma unroll
        for (int jj = 0; jj < 8; ++jj) {
            const int j = jb + jj;
            float a = pv[4 * jj] + pv[4 * jj + 1] + pv[4 * jj + 2] + pv[4 * jj + 3];
            a += (4 * j + 3 < ncmp) ? pv[4 * jj + 4] : 0.f;
            a = ((j == 0) | (j == cur) | (j == cur - 1)) ? 1e4f : a;
            a = (j > cur) ? -1e30f : a;
            v[jj] = a;
        }
        LAS f32x4* ip = (LAS f32x4*)(impb + tk * 64 + jb);
        ip[0] = (f32x4){v[0], v[1], v[2], v[3]}; ip[1] = (f32x4){v[4], v[5], v[6], v[7]};
        LDS_WAIT();
        int cnt[8];
#pragma unroll
        for (int jj = 0; jj < 8; ++jj) cnt[jj] = 0;
        const LAS f32x4* ap = (const LAS f32x4*)(impb + tk * 64);
#pragma unroll 1
        for (int i4 = 0; i4 < 16; ++i4) {
            const f32x4 x = ap[i4];
#pragma unroll
            for (int e = 0; e < 4; ++e) { const float xi = x[e];
#pragma unroll
                for (int jj = 0; jj < 8; ++jj) cnt[jj] += (xi > v[jj]) ? 1 : 0; }
        }
        unsigned bits = 0;
#pragma unroll
        for (int jj = 0; jj < 8; ++jj) bits |= ((cnt[jj] < 16) & (jb + jj <= cur)) ? (1u << jj) : 0u;
        int nsel = __popc(bits);
        nsel += __shfl_xor(nsel, 1); nsel += __shfl_xor(nsel, 2); nsel += __shfl_xor(nsel, 4);
        if (__builtin_amdgcn_ballot_w64(nsel != (cur < 15 ? cur + 1 : 16)) != 0ull) {
#pragma unroll
            for (int jj = 0; jj < 8; ++jj) cnt[jj] = 0;
#pragma unroll 1
            for (int i4 = 0; i4 < 16; ++i4) {
                const f32x4 x = ap[i4];
#pragma unroll
                for (int e = 0; e < 4; ++e) { const int i = 4 * i4 + e; const float xi = x[e];
#pragma unroll
                    for (int jj = 0; jj < 8; ++jj) cnt[jj] += ((xi > v[jj]) | ((xi == v[jj]) & (i < jb + jj))) ? 1 : 0; }
            }
            bits = 0;
#pragma unroll
            for (int jj = 0; jj < 8; ++jj) bits |= ((cnt[jj] < 16) & (jb + jj <= cur)) ? (1u << jj) : 0u;
        }
        selb[tk * 8 + (lane & 7)] = (unsigned char)bits;
        LDS_WAIT();
        const LAS unsigned* sp = (const LAS unsigned*)(selb + tl * 8);
        mlo = sp[0]; mhi = sp[1];
    }
    LAS float* park = psum + lane;
#pragma unroll
    for (int i = 0; i < 16; ++i) { park[i * 64] = g0 * S.o0[i]; park[(16 + i) * 64] = g0 * S.o1[i]; }
#pragma unroll
    for (int s = 0; s < 4; ++s) qrot[s] = *(const bf16x8*)(WSP(bf16, WS_QROT) + (size_t)row * 512 + hq * 64 + 16 * s + 8 * hi);
    PIN4(qrot);
    soft_init(S);
    const int qrel = (qpos & 63) - 4 * hi;
    u32x4 rk2, rv2;
    static_assert(!SAMPLE, "prompt path only");
    {
        auto slc_step = [&](const int j, u32x4& ldk, u32x4& ldv, u32x4& stk, u32x4& stv) __attribute__((always_inline)) {
            if (j + 2 < n_stile) { ldk = tile_ld(sk + (size_t)(j + 2) * 64 * 64, 64, tid); ldv = tile_ld(svt + (j + 2) * 64, pitch, tid); }
            const bool bsel = ((j < 32 ? (mlo >> j) : (mhi >> (j - 32))) & 1u) != 0u;
            LdsT kt{lb + (j & 1) * 2 * TILE_B + fo};
            if (j == n_stile - 1) {
                asm volatile("" ::: "memory");
                qk_tile_c(s0, s1, kt, qrot, S.negm);
#pragma unroll
                for (int r = 0; r < 16; ++r) { const int cr = (r & 3) + 8 * (r >> 2); s0[r] = cr <= qrel ? s0[r] : NEGINF; s1[r] = cr + 32 <= qrel ? s1[r] : NEGINF; }
            } else {
                asm volatile("" ::: "memory");
                const float bias = bsel ? 0.f : NEGINF;
                f32x16 cb;
#pragma unroll
                for (int r = 0; r < 16; ++r) cb[r] = S.negm[r] + bias;
                qk_tile_c(s0, s1, kt, qrot, cb);
            }
            { LdsT vt{lb + (j & 1) * 2 * TILE_B + TILE_B + fo}; soft_step(S, s0, s1, vt); }
            if (j + 1 < n_stile) { tile_st(lb + ((j + 1) & 1) * 2 * TILE_B, stk, tid); tile_st(lb + ((j + 1) & 1) * 2 * TILE_B + TILE_B, stv, tid); }
            LDS_BARRIER();
        };
        rk = tile_ld(sk, 64, tid); rv = tile_ld(svt, pitch, tid); tile_st(lb, rk, tid); tile_st(lb + TILE_B, rv, tid);
        if (n_stile > 1) { rk2 = tile_ld(sk + (size_t)64 * 64, 64, tid); rv2 = tile_ld(svt + 64, pitch, tid); }
        LDS_BARRIER();
        for (int j = 0; j < n_stile; j += 2) { slc_step(j, rk, rv, rk2, rv2); if (j + 1 < n_stile) slc_step(j + 1, rk2, rv2, rk, rv); }
    }
    S.l += half_other(S.l);
    { const float sc = g1 / fmaxf(S.l, 1e-30f);
#pragma unroll
      for (int i = 0; i < 16; ++i) { park[i * 64] += sc * S.o0[i]; park[(16 + i) * 64] += sc * S.o1[i]; } }
    soft_init(S);
    {
        auto win_step = [&](const int j, u32x4& ldk, u32x4& ldv, u32x4& stk, u32x4& stv) __attribute__((always_inline)) {
            const int jr = j - w_t0;
            if (j == w_t1) q_late(F);
            if (j + 2 <= w_t1) { ldk = tile_ld(wk + (size_t)(j + 2) * 64 * 64, 64, tid); ldv = tile_ld(wvt + (j + 2) * 64, wpitch, tid); }
            { LdsT kt{lb + (jr & 1) * 2 * TILE_B + fo}; qk_tile_c(s0, s1, kt, qrot, S.negm); }
            if ((j == w_t0) | (j == w_t1)) {
                asm volatile("" ::: "memory");
                const int lo_r = wlo - 64 * j - 4 * hi, hi_r = whi - 64 * j - 4 * hi;
#pragma unroll
                for (int r = 0; r < 16; ++r) { const int k0 = (r & 3) + 8 * (r >> 2); s0[r] = ((k0 >= lo_r) & (k0 <= hi_r)) ? s0[r] : NEGINF; s1[r] = ((k0 + 32 >= lo_r) & (k0 + 32 <= hi_r)) ? s1[r] : NEGINF; }
            }
            { LdsT vt{lb + (jr & 1) * 2 * TILE_B + TILE_B + fo}; soft_step(S, s0, s1, vt); }
            if (j + 1 <= w_t1) { tile_st(lb + ((jr + 1) & 1) * 2 * TILE_B, stk, tid); tile_st(lb + ((jr + 1) & 1) * 2 * TILE_B + TILE_B, stv, tid); }
            LDS_BARRIER();
        };
        rk = tile_ld(wk + (size_t)w_t0 * 64 * 64, 64, tid); rv = tile_ld(wvt + w_t0 * 64, wpitch, tid); tile_st(lb, rk, tid); tile_st(lb + TILE_B, rv, tid);
        if (w_t0 + 1 <= w_t1) { rk2 = tile_ld(wk + (size_t)(w_t0 + 1) * 64 * 64, 64, tid); rv2 = tile_ld(wvt + (w_t0 + 1) * 64, wpitch, tid); }
        LDS_BARRIER();
        for (int j = w_t0; j <= w_t1; j += 2) { win_step(j, rk, rv, rk2, rv2); if (j + 1 <= w_t1) win_step(j + 1, rk2, rv2, rk, rv); }
    }
    S.l += half_other(S.l);
#ifdef BREAK_WIN
    S.l *= 1.1f;
#endif
    f32x16 res0, res1;
    { const float sc = g2 / fmaxf(S.l, 1e-30f);
#pragma unroll
      for (int i = 0; i < 16; ++i) { res0[i] = park[i * 64] + sc * S.o0[i]; res1[i] = park[(16 + i) * 64] + sc * S.o1[i]; } }
    if (wr_ok) {
        const bf16* zp = WSP(bf16, WS_ZN) + (size_t)row * 512 + hq * 64 + 4 * hi;
        bf16* op = WSP(bf16, WS_ONZ) + (size_t)row * 1024 + hq * 64 + 4 * hi;
#pragma unroll
        for (int e = 0; e < 2; ++e)
#pragma unroll
            for (int q = 0; q < 4; ++q) { const f32x16& o = e ? res1 : res0; const u32x2 z = *(const u32x2*)(zp + 32 * e + 8 * q);
                u32x2 wv; wv.x = pk2(o[4 * q] * bflo(z.x), o[4 * q + 1] * bfhi(z.x)); wv.y = pk2(o[4 * q + 2] * bflo(z.y), o[4 * q + 3] * bfhi(z.y));
                *(u32x2*)(op + 32 * e + 8 * q) = wv; }
    }
}

template <int ABL, class VT> DI void soft_step2(Soft& S, f32x16& s0, f32x16& s1, f32x16& sn0, f32x16& sn1, const VT& vt) {
    bf16x8 vf[8];
#pragma unroll
    for (int s = 0; s < 4; ++s) { vf[2 * s] = vt.frag(0, s); vf[2 * s + 1] = vt.frag(1, s); }
    if (!(ABL & 1)) {
    float mx = max3f(s0[0], s1[0], s0[1]), my = max3f(s1[1], s0[2], s1[2]);
#pragma unroll
    for (int r = 3; r < 15; r += 2) { mx = max3f(mx, s0[r], s1[r]); my = max3f(my, s0[r + 1], s1[r + 1]); }
    mx = max3f(mx, s0[15], s1[15]); mx = max3f(mx, my, mx);
    mx = max3f(mx, half_other(mx), mx);
    const bool fin = mx > NEGINF;
    const bool need = (mx > 8.f) | (fin & !S.seen);
    if (__any(need)) {
        const float dl = need ? mx : 0.f;
        const float al = S.seen ? __builtin_amdgcn_exp2f(-dl) : 0.f;
        S.m += dl; S.l *= need ? al : 1.f;
        const float am = need ? al : 1.f;
#pragma unroll
        for (int r = 0; r < 16; ++r) { s0[r] -= dl; s1[r] -= dl; sn0[r] -= dl; sn1[r] -= dl; S.o0[r] *= am; S.o1[r] *= am; S.negm[r] = -S.m; }
    }
    S.seen = S.seen | fin;
#pragma unroll
    for (int r = 0; r < 16; ++r) { s0[r] = __builtin_amdgcn_exp2f(s0[r]); s1[r] = __builtin_amdgcn_exp2f(s1[r]); }
    { const f32x16 t16 = s0 + s1; const f32x8s t8 = t16.lo + t16.hi; const f32x4 t4 = t8.lo + t8.hi; S.l += (t4[0] + t4[1]) + (t4[2] + t4[3]); }
    }
    const bf16x8 b0 = pack_p(s0, 0), b1 = pack_p(s0, 1), b2 = pack_p(s1, 0), b3 = pack_p(s1, 1);
    if (!(ABL & 4)) {
    S.o0 = MFMA32(vf[0], b0, S.o0); S.o1 = MFMA32(vf[1], b0, S.o1);
    S.o0 = MFMA32(vf[2], b1, S.o0); S.o1 = MFMA32(vf[3], b1, S.o1);
    S.o0 = MFMA32(vf[4], b2, S.o0); S.o1 = MFMA32(vf[5], b2, S.o1);
    S.o0 = MFMA32(vf[6], b3, S.o0); S.o1 = MFMA32(vf[7], b3, S.o1);
    } else { S.o0[0] += __builtin_bit_cast(f32x4, b0)[0] + __builtin_bit_cast(f32x4, b1)[0] + __builtin_bit_cast(f32x4, b2)[0] + __builtin_bit_cast(f32x4, b3)[0] + __builtin_bit_cast(f32x4, vf[0])[0] + __builtin_bit_cast(f32x4, vf[7])[1]; }
}
template <int ABL> DI void dsa_unit(Frame& F, int u) {
    const int tid = opq(F.tid), lane = opq(F.lane), w = F.wave, l31 = lane & 31, hi = lane >> 5, tl = l31 >> 2, hl = l31 & 3;
    const int bg = u & 7, qt = 63 - (u >> 3), g = bg & 1, t = 64 * qt + 8 * w + tl, row = (bg >> 1) * SEQ + t, nt = qt + 1;
    const bf16* dk = WSP(bf16, WS_PDSAK) + (size_t)bg * SEQ * 64; const bf16* dvt = WSP(bf16, WS_PDSAVT) + (size_t)bg * 64 * SEQ;
    const int hq = 4 * g + hl;
    bf16x8 dq[4];
#pragma unroll
    for (int s = 0; s < 4; ++s) dq[s] = *(const bf16x8*)(WSP(bf16, WS_DQ) + (size_t)row * 512 + hq * 64 + 16 * s + 8 * hi);
    const unsigned long long* selp = WSP(unsigned long long, WS_SELM) + (size_t)row * 64;
    unsigned long long selA = selp[0], selB = selp[nt > 1 ? 1 : 0];
    PIN4(dq); asm volatile("" : "+v"(selA), "+v"(selB));
    LAS unsigned char* const lb = F.lds;
    const int fo = l31 * TP + hi * 16;
    f32x16 sc0, sc1, sn0, sn1;
    u32x4 rkA, rvA, rkB, rvB;
    Soft S; soft_init(S);
    const int ntm = nt - 1;
    const bf16* kpc = dk + (size_t)(tid >> 3) * 64 + (tid & 7) * 8; const bf16* vpc = dvt + (size_t)(tid >> 3) * SEQ + (tid & 7) * 8;
#define KADDR(jt) (kpc + (size_t)((jt) < ntm ? (jt) : ntm) * 64 * 64)
#define VADDR(jt) (vpc + ((jt) < ntm ? (jt) : ntm) * 64)
    { const u32x4 a = tile_ld(dk, 64, tid), b = tile_ld(dvt, SEQ, tid), c = *(const u32x4*)KADDR(1); tile_st(lb, a, tid); tile_st(lb + 2 * TILE_B, b, tid); tile_st(lb + TILE_B, c, tid); }
    asm volatile("s_waitcnt vmcnt(0)" : "+v"(selA), "+v"(selB) :: "memory");
    selA = gload8(selp); selB = gload8(selp + (nt > 1 ? 1 : 0));
    rkA = gload16(KADDR(2)); rvA = gload16(VADDR(1));
    LDS_BARRIER();
    { LdsT kt{lb + fo}; qk_tile_c(sc0, sc1, kt, dq, S.negm); }
#define DSA_STEP(j, CK, CV, NK, NV, SELC, C0, C1, N0, N1) do {     \
        NK = gload16(KADDR((j) + 3)); NV = gload16(VADDR((j) + 2)); \
        if ((j) + 1 < nt) { LdsT kt{lb + (((j) + 1) & 1) * TILE_B + fo}; if (!(ABL & 2)) qk_tile_c(N0, N1, kt, dq, S.negm); else { N0 = S.negm; N1 = S.negm; N0[0] += __builtin_bit_cast(f32x4, kt.frag(0, 0))[0]; } } \
        WAITV1(5, SELC);                                                     \
        { const unsigned wa = (unsigned)SELC >> (4 * hi), wb = (unsigned)(SELC >> 32) >> (4 * hi); \
          SELC = gload8(selp + ((j) + 2 < nt ? (j) + 2 : ntm)); \
          _Pragma("unroll") for (int r = 0; r < 16; ++r) { const int bp = (r & 3) + 8 * (r >> 2); \
            C0[r] = mask_sel(C0[r], (int)(wa << (31 - bp)) >> 31); C1[r] = mask_sel(C1[r], (int)(wb << (31 - bp)) >> 31); } } \
        { LdsT vt{lb + (2 + ((j) & 1)) * TILE_B + fo}; soft_step2<ABL>(S, C0, C1, N0, N1, vt); } \
        WAITV2(3, CK, CV);                                                   \
        if (!(ABL & 8)) { tile_st(lb + ((j) & 1) * TILE_B, CK, tid); tile_st(lb + (2 + (((j) + 1) & 1)) * TILE_B, CV, tid); } \
        if (!(ABL & 16)) LDS_BARRIER(); } while (0)
    for (int j = 0; j < nt; j += 2) { DSA_STEP(j, rkA, rvA, rkB, rvB, selA, sc0, sc1, sn0, sn1); if (j + 1 < nt) DSA_STEP(j + 1, rkB, rvB, rkA, rvA, selB, sn0, sn1, sc0, sc1); }
    asm volatile("s_waitcnt vmcnt(0)" : "+v"(rkA), "+v"(rvA), "+v"(rkB), "+v"(rvB), "+v"(selA), "+v"(selB) :: "memory");
    q_late(F);
#undef DSA_STEP
#undef KADDR
#undef VADDR
    S.l += half_other(S.l);
    {
        const float sc = 1.f / fmaxf(S.l, 1e-30f);
        const bf16* zp = WSP(bf16, WS_ZD) + (size_t)row * 512 + hq * 64 + 4 * hi;
        bf16* op = WSP(bf16, ABL ? WS_T1 : WS_ONZ) + (size_t)row * 1024 + 512 + hq * 64 + 4 * hi;
#pragma unroll
        for (int e = 0; e < 2; ++e)
#pragma unroll
            for (int q = 0; q < 4; ++q) { const f32x16& o = e ? S.o1 : S.o0; const u32x2 z = *(const u32x2*)(zp + 32 * e + 8 * q);
                u32x2 wv; wv.x = pk2(o[4 * q] * sc * bflo(z.x), o[4 * q + 1] * sc * bfhi(z.x)); wv.y = pk2(o[4 * q + 2] * sc * bflo(z.y), o[4 * q + 3] * sc * bfhi(z.y));
                *(u32x2*)(op + 32 * e + 8 * q) = wv; }
    }
}


struct PageK {
    static constexpr bool HOIST = false;
    const float* p; unsigned stride;
    DI bf16x8 frag(int mt, int s) const { const f32x4* q = (const f32x4*)(p + (size_t)((unsigned)mt * 32u * stride + (unsigned)s * 16u)); return cvt8(q[0], q[1]); }
};
struct PageV {
    static constexpr bool HOIST = false;
    const float* p; unsigned stride;
    DI bf16x8 frag(int dt, int s) const {
        float v[8];
#pragma unroll
        for (int i = 0; i < 8; ++i) v[i] = p[(size_t)((unsigned)(16 * s + (i & 3) + 8 * (i >> 2)) * stride + (unsigned)dt * 32u)];
        return __builtin_bit_cast(bf16x8, pack8(v));
    }
};
DI void stage_k_ld(f32x4 (&x)[16], const float* base, unsigned stride, int lane) {
    const float* p = base + (size_t)((unsigned)(lane >> 4) * stride + 4u * (unsigned)(lane & 15));
#pragma unroll
    for (int i = 0; i < 16; ++i) x[i] = *(const f32x4*)(p + (size_t)((unsigned)(4 * i) * stride));
}
DI void stage_k_st(const f32x4 (&x)[16], LAS unsigned char* kb, int lane) {
    LAS unsigned char* d = kb + (lane >> 4) * TP + (lane & 15) * 8;
#pragma unroll
    for (int i = 0; i < 16; ++i) { u32x2 wv; wv.x = pk2(x[i][0], x[i][1]); wv.y = pk2(x[i][2], x[i][3]); *(LAS u32x2*)(d + 4 * i * TP) = wv; }
}
struct RegV { static constexpr bool HOIST = true; bf16x8 f[8]; DI bf16x8 frag(int dt, int s) const { return f[2 * s + dt]; } };
DI void pagev_ld(float (&v)[64], const float* p, unsigned stride) {
#pragma unroll
    for (int f = 0; f < 8; ++f)
#pragma unroll
        for (int i = 0; i < 8; ++i) v[8 * f + i] = p[(size_t)((unsigned)(16 * (f >> 1) + (i & 3) + 8 * (i >> 2)) * stride + (unsigned)(f & 1) * 32u)];
}
DI float gload4s(const void* sbase, unsigned voff) { float r; asm volatile("global_load_dword %0, %1, %2" : "=v"(r) : "v"(voff), "s"(sbase) : "memory"); return r; }
DI float gload4s128(const void* sbase, unsigned voff) { float r; asm volatile("global_load_dword %0, %1, %2 offset:128" : "=v"(r) : "v"(voff), "s"(sbase) : "memory"); return r; }
DI void stage_k_ld_sel(f32x4 (&x)[16], const float* base, unsigned ko, unsigned r4k, unsigned wlo, unsigned whi) {
#pragma unroll
    for (int i = 0; i < 16; ++i) { const unsigned t = r4k + (unsigned)(4 * i) * 1024u; const int m = (int)((i < 8 ? wlo : whi) << (31 - ((4 * i) & 31))) >> 31; x[i] = __builtin_bit_cast(f32x4, gload16s(base, ((unsigned)m & t) | ko)); }
}
DI void pagev_ld_sel(float (&v)[64], const float* vbase, unsigned lo4, unsigned hik, unsigned wlo, unsigned whi) {
#pragma unroll
    for (int f2 = 0; f2 < 4; ++f2)
#pragma unroll
        for (int i = 0; i < 8; ++i) { const int c = 16 * f2 + (i & 3) + 8 * (i >> 2); const unsigned t = hik + (unsigned)c * 1024u; const int m = (int)((f2 < 2 ? wlo : whi) << (31 - (c & 31))) >> 31;
            const unsigned vo = ((unsigned)m & t) | lo4; v[16 * f2 + i] = gload4s(vbase, vo); v[16 * f2 + 8 + i] = gload4s128(vbase, vo); }
}
#define WAITV16(n, x) asm volatile("s_waitcnt vmcnt(" #n ")" : "+v"(x[0]), "+v"(x[1]), "+v"(x[2]), "+v"(x[3]), "+v"(x[4]), "+v"(x[5]), "+v"(x[6]), "+v"(x[7]), "+v"(x[8]), "+v"(x[9]), "+v"(x[10]), "+v"(x[11]), "+v"(x[12]), "+v"(x[13]), "+v"(x[14]), "+v"(x[15]) :: "memory")
#define DEP16(x, o) asm volatile("" : "+v"(x[o + 0]), "+v"(x[o + 1]), "+v"(x[o + 2]), "+v"(x[o + 3]), "+v"(x[o + 4]), "+v"(x[o + 5]), "+v"(x[o + 6]), "+v"(x[o + 7]), "+v"(x[o + 8]), "+v"(x[o + 9]), "+v"(x[o + 10]), "+v"(x[o + 11]), "+v"(x[o + 12]), "+v"(x[o + 13]), "+v"(x[o + 14]), "+v"(x[o + 15]) :: "memory")
DI void pagev_pack(RegV& r, const float (&v)[64]) {
#pragma unroll
    for (int f = 0; f < 8; ++f) r.f[f] = __builtin_bit_cast(bf16x8, pack8(&v[8 * f]));
}
constexpr int XCH_W = 34 * 64;
constexpr int XCH_BYTES = 8 * XCH_W * 4;
DI void xch_put(LAS float* x, const Soft& S, int lane) {
    const float lt = S.l + half_other(S.l);
    x[lane] = S.seen ? S.m : NEGINF; x[64 + lane] = lt;
#pragma unroll
    for (int r = 0; r < 16; ++r) { x[(2 + r) * 64 + lane] = S.o0[r]; x[(18 + r) * 64 + lane] = S.o1[r]; }
}
DI void xch_get(const LAS float* xb, int w, int lane, float (&out)[4]) {
    float mw[8], M = -1e30f;
#pragma unroll
    for (int i = 0; i < 8; ++i) { mw[i] = xb[i * XCH_W + lane]; M = fmaxf(M, mw[i]); }
    float L = 0.f, o[4] = {0.f, 0.f, 0.f, 0.f};
#pragma unroll
    for (int i = 0; i < 8; ++i) { const float wt = __builtin_amdgcn_exp2f(mw[i] - M); L += wt * xb[i * XCH_W + 64 + lane];
#pragma unroll
        for (int k = 0; k < 4; ++k) o[k] += wt * xb[i * XCH_W + (2 + 4 * w + k) * 64 + lane]; }
    const float inv = 1.f / fmaxf(L, 1e-30f);
#pragma unroll
    for (int k = 0; k < 4; ++k) out[k] = o[k] * inv;
}
DI void nsa_sample_unit(Frame& F, int bg) {
    const int lane = opq(F.lane), w = F.wave, l31 = lane & 31, hi = lane >> 5, tl = l31 >> 2, hl = l31 & 3;
    const int sb = bg >> 1, g = bg & 1, i = tl & 3, row = MP + sb * 4 + i, qpos = PASTL + i, hq = 4 * g + hl;
    LAS unsigned char* const lb = F.lds;
    LAS float* xch = (LAS float*)lb;
    constexpr int SMP_BASE = 8 * TILE_B;
    LAS float* cmpb = (LAS float*)(lb + SMP_BASE);
    LAS unsigned* mskb = (LAS unsigned*)(lb + SMP_BASE + 8192);
    LAS float* psum = (LAS float*)(lb + SMP_BASE + 8192 + 64);
    LAS unsigned char* const kb = lb + w * TILE_B; const int fo = l31 * TP + hi * 16;
    LAS float* impb = psum + 8 * 256;
    LAS unsigned char* selb = (LAS unsigned char*)(impb + 8 * 64);
    const float* gp = WSP(float, WS_GATES) + (size_t)row * 24 + hq * 3;
    float g0 = gp[0], g1 = gp[1], g2 = gp[2];
    bf16x8 qrot[4];
#pragma unroll
    for (int s = 0; s < 4; ++s) qrot[s] = *(const bf16x8*)(WSP(bf16, WS_QROT) + (size_t)row * 512 + hq * 64 + 16 * s + 8 * hi);
    f32x16 s0, s1;
    Soft S;
    int pgq[4];
#pragma unroll
    for (int t = 0; t < 4; ++t) pgq[t] = F.ptab[sb * NPG + (w >> 1) + 4 * t];
    __syncthreads();
    if (w == 0) {
        const bf16* ck = WSP(bf16, WS_SCK) + (size_t)bg * 128 * 64; const bf16* cvt = WSP(bf16, WS_SCVT) + (size_t)bg * 64 * 128;
        bf16x8 qraw[4];
#pragma unroll
        for (int s = 0; s < 4; ++s) qraw[s] = *(const bf16x8*)(WSP(bf16, WS_QRAW) + (size_t)row * 512 + hq * 64 + 16 * s + 8 * hi);
        const int ncmp = 127, nvis = 126;
        f32x16 t0, t1;
        { GlbT ka{ck, (unsigned)(l31 * 64 + 8 * hi), 64u}; qk_tile(s0, s1, ka, qraw); GlbT kb2{ck, (unsigned)((64 + l31) * 64 + 8 * hi), 64u}; qk_tile(t0, t1, kb2, qraw); }
        const int nva = nvis - 4 * hi, nvb = nvis - 64 - 4 * hi;
        float mx = -1e30f;
#pragma unroll
        for (int r = 0; r < 16; ++r) { const int cr = (r & 3) + 8 * (r >> 2);
            s0[r] = cr <= nva ? s0[r] : NEGINF; s1[r] = cr + 32 <= nva ? s1[r] : NEGINF; t0[r] = cr <= nvb ? t0[r] : NEGINF; t1[r] = cr + 32 <= nvb ? t1[r] : NEGINF;
            mx = fmaxf(fmaxf(mx, fmaxf(s0[r], s1[r])), fmaxf(t0[r], t1[r])); }
        const float m = fmaxf(mx, half_other(mx));
        float l = 0.f;
#pragma unroll
        for (int r = 0; r < 16; ++r) { s0[r] = __builtin_amdgcn_exp2f(s0[r] - m); s1[r] = __builtin_amdgcn_exp2f(s1[r] - m); t0[r] = __builtin_amdgcn_exp2f(t0[r] - m); t1[r] = __builtin_amdgcn_exp2f(t1[r] - m);
            l += (s0[r] + s1[r]) + (t0[r] + t1[r]); }
        l += half_other(l);
        const float linv = l > 0.f ? 1.f / l : 0.f;
        soft_init(S);
#pragma unroll
        for (int ct = 0; ct < 2; ++ct) {
            f32x16& p0 = ct ? t0 : s0; f32x16& p1 = ct ? t1 : s1;
            LAS float* pw = psum + tl * 256 + 64 * ct + 4 * hi;
#pragma unroll
            for (int r = 0; r < 16; ++r) { const int cr = (r & 3) + 8 * (r >> 2);
                p0[r] *= linv; p1[r] *= linv;
                float a = p0[r]; a += dpp_x1(a); a += dpp_x2(a); float b = p1[r]; b += dpp_x1(b); b += dpp_x2(b);
                if (hl == 0) { pw[cr] = a; pw[cr + 32] = b; } }
            GlbT vt{cvt, (unsigned)(l31 * 128 + 64 * ct + 8 * hi), 128u}; pv_tile(S.o0, S.o1, p0, p1, vt);
        }
#pragma unroll
        for (int r = 0; r < 16; ++r) { cmpb[r * 64 + lane] = S.o0[r]; cmpb[(16 + r) * 64 + lane] = S.o1[r]; }
        LDS_WAIT();
        {
            const int tk = lane >> 3, jb = 8 * (lane & 7), cur = 32;
            float pv[33];
            const LAS f32x4* pp = (const LAS f32x4*)(psum + tk * 256 + 4 * jb);
#pragma unroll
            for (int q = 0; q < 8; ++q) { const f32x4 x = pp[q]; pv[1 + 4 * q] = x[0]; pv[2 + 4 * q] = x[1]; pv[3 + 4 * q] = x[2]; pv[4 + 4 * q] = x[3]; }
            pv[0] = jb > 0 ? psum[tk * 256 + 4 * jb - 1] : 0.f;
            float v[8];
#pragma unroll
            for (int jj = 0; jj < 8; ++jj) { const int j = jb + jj;
                float a = pv[4 * jj] + pv[4 * jj + 1] + pv[4 * jj + 2] + pv[4 * jj + 3];
                a += (4 * j + 3 < ncmp) ? pv[4 * jj + 4] : 0.f;
                a = ((j == 0) | (j == cur) | (j == cur - 1)) ? 1e4f : a;
                a = (j > cur) ? -1e30f : a;
                v[jj] = a; }
            LAS f32x4* ip = (LAS f32x4*)(impb + tk * 64 + jb);
            ip[0] = (f32x4){v[0], v[1], v[2], v[3]}; ip[1] = (f32x4){v[4], v[5], v[6], v[7]};
            LDS_WAIT();
            int cnt[8];
#pragma unroll
            for (int jj = 0; jj < 8; ++jj) cnt[jj] = 0;
            const LAS f32x4* ap = (const LAS f32x4*)(impb + tk * 64);
#pragma unroll 1
            for (int i4 = 0; i4 < 16; ++i4) { const f32x4 x = ap[i4];
#pragma unroll
                for (int e = 0; e < 4; ++e) { const float xi = x[e];
#pragma unroll
                    for (int jj = 0; jj < 8; ++jj) cnt[jj] += (xi > v[jj]) ? 1 : 0; } }
            unsigned bits = 0;
#pragma unroll
            for (int jj = 0; jj < 8; ++jj) bits |= ((cnt[jj] < 16) & (jb + jj <= cur)) ? (1u << jj) : 0u;
            int nsel = __popc(bits);
            nsel += __shfl_xor(nsel, 1); nsel += __shfl_xor(nsel, 2); nsel += __shfl_xor(nsel, 4);
            if (__builtin_amdgcn_ballot_w64(nsel != 16) != 0ull) {
#pragma unroll
                for (int jj = 0; jj < 8; ++jj) cnt[jj] = 0;
#pragma unroll 1
                for (int i4 = 0; i4 < 16; ++i4) { const f32x4 x = ap[i4];
#pragma unroll
                    for (int e = 0; e < 4; ++e) { const int ii = 4 * i4 + e; const float xi = x[e];
#pragma unroll
                        for (int jj = 0; jj < 8; ++jj) cnt[jj] += ((xi > v[jj]) | ((xi == v[jj]) & (ii < jb + jj))) ? 1 : 0; } }
                bits = 0;
#pragma unroll
                for (int jj = 0; jj < 8; ++jj) bits |= ((cnt[jj] < 16) & (jb + jj <= cur)) ? (1u << jj) : 0u;
            }
            selb[tk * 8 + (lane & 7)] = (unsigned char)bits;
            LDS_WAIT();
            if (lane < 16) mskb[lane] = ((const LAS unsigned*)selb)[lane];
        }
        soft_init(S);
    } else {
        soft_init(S);
        for (int rep = 0; rep < (w == 1 ? 2 : 1); ++rep) {
            const int t = rep == 0 ? w : 0;
            const float* base = F.swin + ((size_t)sb * 512 + 64 * t) * 256 + g * 64;
            { f32x4 kx[16]; stage_k_ld(kx, base, 256u, lane); stage_k_st(kx, kb, lane); }
            LdsT kt{kb + fo}; qk_tile_c(s0, s1, kt, qrot, S.negm);
            if (t == 0) {
                const int lo_r = 1 + i - 4 * hi;
#pragma unroll
                for (int r = 0; r < 16; ++r) { const int k0 = (r & 3) + 8 * (r >> 2); s0[r] = k0 >= lo_r ? s0[r] : NEGINF; s1[r] = k0 + 32 >= lo_r ? s1[r] : NEGINF; }
            }
            PageV vt{base + 128 + (size_t)(4 * hi) * 256 + l31, 256u}; soft_step(S, s0, s1, vt);
        }
        if (w == 2) {
            const bf16* wk = WSP(bf16, WS_SWINK) + (size_t)bg * LSW * 64; const bf16* wvt = WSP(bf16, WS_SWINVT) + (size_t)bg * 64 * LSW;
            GlbT kt{wk, (unsigned)((512 + l31) * 64 + 8 * hi), 64u}; qk_tile_c(s0, s1, kt, qrot, S.negm);
            const int hi_r = i - 4 * hi;
#pragma unroll
            for (int r = 0; r < 16; ++r) { const int k0 = (r & 3) + 8 * (r >> 2); s0[r] = k0 <= hi_r ? s0[r] : NEGINF; s1[r] = k0 + 32 <= hi_r ? s1[r] : NEGINF; }
            GlbT vt{wvt, (unsigned)(l31 * LSW + 512 + 8 * hi), (unsigned)LSW}; soft_step(S, s0, s1, vt);
        }
    }
    __syncthreads();
    xch_put(xch + w * XCH_W, S, lane);
    __syncthreads();
    LAS float* const pwb = (LAS float*)(lb + SMP_BASE + 18560) + w * 256 + lane;
    { float partw[4];
      xch_get(xch, w, lane, partw);
#ifdef BREAK_WIN
#pragma unroll
      for (int k = 0; k < 4; ++k) partw[k] *= 0.9f;
#endif
#pragma unroll
      for (int k = 0; k < 4; ++k) pwb[64 * k] = partw[k]; }
    const unsigned mlo = mskb[tl * 2], mhi = mskb[tl * 2 + 1];
    __syncthreads();
    PIN4(qrot); asm volatile("" : "+v"(g0), "+v"(g1), "+v"(g2));
    soft_init(S);
    for (int j = w; j < 32; j += NWAVES) {
        const int t4 = j >> 3, pg = t4 == 0 ? pgq[0] : t4 == 1 ? pgq[1] : t4 == 2 ? pgq[2] : pgq[3];
        const float* base = F.cnsa + ((size_t)pg * PAGE + (j & 1) * 64) * 512 + (2 * 2 + g) * 64;
        { f32x4 kx[16]; stage_k_ld(kx, base, 512u, lane); stage_k_st(kx, kb, lane); }
        LdsT kt{kb + fo}; qk_tile_c(s0, s1, kt, qrot, S.negm);
        const bool bsel = ((mlo >> j) & 1u) != 0u;
#pragma unroll
        for (int r = 0; r < 16; ++r) { s0[r] = bsel ? s0[r] : NEGINF; s1[r] = bsel ? s1[r] : NEGINF; }
        PageV vt{base + 128 + (size_t)(4 * hi) * 512 + l31, 512u}; soft_step(S, s0, s1, vt);
    }
    if (w == 1) {
        const bf16* sk = WSP(bf16, WS_SSLCK) + (size_t)bg * LS * 64; const bf16* svt = WSP(bf16, WS_SSLCVT) + (size_t)bg * 64 * LS;
        GlbT kt{sk, (unsigned)((2048 + l31) * 64 + 8 * hi), 64u}; qk_tile_c(s0, s1, kt, qrot, S.negm);
        const int qrel = i - 4 * hi;
#pragma unroll
        for (int r = 0; r < 16; ++r) { const int cr = (r & 3) + 8 * (r >> 2); s0[r] = cr <= qrel ? s0[r] : NEGINF; s1[r] = cr + 32 <= qrel ? s1[r] : NEGINF; }
        GlbT vt{svt, (unsigned)(l31 * LS + 2048 + 8 * hi), (unsigned)LS}; soft_step(S, s0, s1, vt);
    }
    q_late(F);
    __syncthreads();
    xch_put(xch + w * XCH_W, S, lane);
    __syncthreads();
    float part[4];
    xch_get(xch, w, lane, part);
    if (tl < 4) {
        const int d0 = 32 * (w >> 2) + 8 * (w & 3) + 4 * hi;
        float acc[4];
#pragma unroll
        for (int k = 0; k < 4; ++k) acc[k] = g1 * part[k] + g0 * cmpb[(4 * w + k) * 64 + lane] + g2 * pwb[64 * k];
        const u32x2 z = *(const u32x2*)(WSP(bf16, WS_ZN) + (size_t)row * 512 + hq * 64 + d0);
        u32x2 wv; wv.x = pk2(acc[0] * bflo(z.x), acc[1] * bfhi(z.x)); wv.y = pk2(acc[2] * bflo(z.y), acc[3] * bfhi(z.y));
        *(u32x2*)(WSP(bf16, WS_ONZ) + (size_t)row * 1024 + hq * 64 + d0) = wv;
    }
}
DI void dsa_sample_unit(Frame& F, int bg) {
    const int lane = opq(F.lane), w = F.wave, l31 = lane & 31, hi = lane >> 5, tl = l31 >> 2, hl = l31 & 3;
    const int sb = bg >> 1, g = bg & 1, i = tl & 3, row = MP + sb * 4 + i, hq = 4 * g + hl;
    LAS float* xch = (LAS float*)F.lds;
    bf16x8 dq[4];
#pragma unroll
    for (int s = 0; s < 4; ++s) dq[s] = *(const bf16x8*)(WSP(bf16, WS_DQ) + (size_t)row * 512 + hq * 64 + 16 * s + 8 * hi);
    const unsigned long long* selp = WSP(unsigned long long, WS_SELM) + (size_t)row * 64;
    PIN4(dq);
    f32x16 s0, s1;
    Soft S; soft_init(S);
    int pgq[4];
#pragma unroll
    for (int t = 0; t < 4; ++t) pgq[t] = F.ptab[sb * NPG + (w >> 1) + 4 * t];
    LAS unsigned char* const kb = F.lds + w * TILE_B;
    const int fo = l31 * TP + hi * 16;
    __syncthreads();
    unsigned long long seln = selp[w];
    for (int j = w; j < 32; j += NWAVES) {
        unsigned long long selw = seln;
        seln = selp[j + NWAVES < 32 ? j + NWAVES : j];
        unsigned nlo = (unsigned)selw, nhi = (unsigned)(selw >> 32);
        nlo |= (unsigned)__shfl_xor((int)nlo, 4); nhi |= (unsigned)__shfl_xor((int)nhi, 4); nlo |= (unsigned)__shfl_xor((int)nlo, 8); nhi |= (unsigned)__shfl_xor((int)nhi, 8);
        nlo = (unsigned)__builtin_amdgcn_readfirstlane((int)nlo); nhi = (unsigned)__builtin_amdgcn_readfirstlane((int)nhi);
        const int t4 = j >> 3, pg = __builtin_amdgcn_readfirstlane(t4 == 0 ? pgq[0] : t4 == 1 ? pgq[1] : t4 == 2 ? pgq[2] : pgq[3]);
        const float* base = sgpr_ptr(F.cdsa + ((size_t)pg * PAGE + (j & 1) * 64) * 256 + g * 64);
        float vr[64];
        { const unsigned lq = (unsigned)opq(lane);
          const unsigned r4 = lq >> 4, h4 = (lq >> 5) * 4u;
          f32x4 kx[16]; stage_k_ld_sel(kx, base, 16u * (lq & 15u), r4 * 1024u, nlo >> r4, nhi >> r4); pagev_ld_sel(vr, base + 128, 4u * (lq & 31u), h4 * 1024u, nlo >> h4, nhi >> h4);
          WAITV16(63, kx); stage_k_st(kx, kb, lane); }
        LdsT kt{kb + fo}; qk_tile_c(s0, s1, kt, dq, S.negm);
#ifdef BREAK_DSA
        selw |= 0x1111111111111111ull;
#endif
        const unsigned wa = (unsigned)selw >> (4 * hi), wb = (unsigned)(selw >> 32) >> (4 * hi);
#pragma unroll
        for (int r = 0; r < 16; ++r) { const int bp = (r & 3) + 8 * (r >> 2);
            s0[r] = mask_sel(s0[r], (int)(wa << (31 - bp)) >> 31); s1[r] = mask_sel(s1[r], (int)(wb << (31 - bp)) >> 31); }
        WAITV16(0, vr); DEP16(vr, 16); DEP16(vr, 32); DEP16(vr, 48);
        RegV vt; pagev_pack(vt, vr); soft_step(S, s0, s1, vt);
    }
    if (w == 0) {
        const unsigned long long selw = selp[32];
        const bf16* dk = WSP(bf16, WS_SDSAK) + (size_t)bg * LS * 64; const bf16* dvt = WSP(bf16, WS_SDSAVT) + (size_t)bg * 64 * LS;
        GlbT kt{dk, (unsigned)((2048 + l31) * 64 + 8 * hi), 64u}; qk_tile_c(s0, s1, kt, dq, S.negm);
        const unsigned wa = (unsigned)selw >> (4 * hi), wb = (unsigned)(selw >> 32) >> (4 * hi);
#pragma unroll
        for (int r = 0; r < 16; ++r) { const int bp = (r & 3) + 8 * (r >> 2);
            s0[r] = mask_sel(s0[r], (int)(wa << (31 - bp)) >> 31); s1[r] = mask_sel(s1[r], (int)(wb << (31 - bp)) >> 31); }
        GlbT vt{dvt, (unsigned)(l31 * LS + 2048 + 8 * hi), (unsigned)LS}; soft_step(S, s0, s1, vt);
    }
    q_late(F);
    __syncthreads();
    xch_put(xch + w * XCH_W, S, lane);
    __syncthreads();
    float part[4];
    xch_get(xch, w, lane, part);
    if (tl < 4) {
        const int d0 = 32 * (w >> 2) + 8 * (w & 3) + 4 * hi;
        const u32x2 z = *(const u32x2*)(WSP(bf16, WS_ZD) + (size_t)row * 512 + hq * 64 + d0);
        u32x2 wv; wv.x = pk2(part[0] * bflo(z.x), part[1] * bfhi(z.x)); wv.y = pk2(part[2] * bflo(z.y), part[3] * bfhi(z.y));
        *(u32x2*)(WSP(bf16, WS_ONZ) + (size_t)row * 1024 + 512 + hq * 64 + d0) = wv;
    }
}

template <int K, class EF> DI void small_gemm(Frame& F, const bf16* A, const bf16* Bt, const EF& ef) {
    const int lane = opq(F.lane), w = F.wave, l31 = lane & 31, hi = lane >> 5;
    LAS float* red = (LAS float*)F.lds;
    for (int t = blockIdx.x; t < 256; t += F.G) {
        const int mt = t >> 5, nt = t & 31, kw = K >> 3, k0 = w * kw;
        const bf16* ap = A + (size_t)(MP + 64 * mt + l31) * K + k0 + 8 * hi;
        const bf16* bp = Bt + (size_t)(32 * nt + l31) * K + k0 + 8 * hi;
        f32x16 a0, a1;
#pragma unroll
        for (int i = 0; i < 16; ++i) { a0[i] = 0.f; a1[i] = 0.f; }
        bf16x8 fb[K / 128], f0[K / 128], f1[K / 128];
#pragma unroll
        for (int s = 0; s < K / 128; ++s) { fb[s] = *(const bf16x8*)(bp + 16 * s); f0[s] = *(const bf16x8*)(ap + 16 * s); f1[s] = *(const bf16x8*)(ap + (size_t)32 * K + 16 * s); }
#pragma unroll
        for (int s = 0; s < K / 128; ++s) { a0 = MFMA32(f0[s], fb[s], a0); a1 = MFMA32(f1[s], fb[s], a1); }
        __syncthreads();
#pragma unroll
        for (int r = 0; r < 16; ++r) { red[(w * 32 + r) * 64 + lane] = a0[r]; red[(w * 32 + 16 + r) * 64 + lane] = a1[r]; }
        __syncthreads();
        const int m2 = w >> 2, q = w & 3;
#pragma unroll
        for (int j = 0; j < 4; ++j) {
            float v = 0.f;
#pragma unroll
            for (int i = 0; i < 8; ++i) v += red[(i * 32 + 16 * m2 + 4 * q + j) * 64 + lane];
            ef(MP + 64 * mt + 32 * m2 + 8 * q + 4 * hi + j, 32 * nt + l31, v);
        }
    }
    __syncthreads();
}
template <int K, class EF> DI void small_gemm2(Frame& F, const bf16* A, const bf16* Bt, const EF& ef) {
    const int lane = opq(F.lane), w = F.wave, l31 = lane & 31, hi = lane >> 5;
    LAS float* red = (LAS float*)F.lds;
    for (int t = blockIdx.x; t < 256; t += F.G) {
        const int mt = t >> 5, nt = t & 31, kw = K >> 3, k0 = w * kw;
        const bf16* ap = A + (size_t)(MP + 64 * mt + l31) * K + k0 + 8 * hi;
        const bf16* bp = Bt + (size_t)(32 * nt + l31) * K + k0 + 8 * hi;
        f32x16 a0, a1;
#pragma unroll
        for (int i = 0; i < 16; ++i) { a0[i] = 0.f; a1[i] = 0.f; }
        bf16x8 fb[K / 128], f0[K / 128], f1[K / 128];
#pragma unroll
        for (int s = 0; s < K / 128; ++s) { fb[s] = *(const bf16x8*)(bp + 16 * s); f0[s] = *(const bf16x8*)(ap + 16 * s); f1[s] = *(const bf16x8*)(ap + (size_t)32 * K + 16 * s); }
#pragma unroll
        for (int s = 0; s < K / 128; ++s) { a0 = MFMA32(f0[s], fb[s], a0); a1 = MFMA32(f1[s], fb[s], a1); }
        __syncthreads();
#pragma unroll
        for (int r = 0; r < 16; ++r) { red[(w * 32 + r) * 64 + lane] = a0[r]; red[(w * 32 + 16 + r) * 64 + lane] = a1[r]; }
        __syncthreads();
        const int m2 = w >> 2, q = w & 3;
#pragma unroll
        for (int j = 0; j < 4; ++j) {
            float vn = 0.f, vd = 0.f;
#pragma unroll
            for (int i = 0; i < 4; ++i) { vn += red[(i * 32 + 16 * m2 + 4 * q + j) * 64 + lane]; vd += red[((i + 4) * 32 + 16 * m2 + 4 * q + j) * 64 + lane]; }
            ef(MP + 64 * mt + 32 * m2 + 8 * q + 4 * hi + j, 32 * nt + l31, vn, vd);
        }
    }
    __syncthreads();
}


#ifdef ORACLE
constexpr size_t WS_ORC = 948 * MiB;
constexpr int ORC_ROWS = 128;
DI float blk_red(Frame& F, float v, bool ismax, LAS float* red) {
#pragma unroll
    for (int o = 1; o < 64; o <<= 1) { const float x = __shfl_xor(v, o); v = ismax ? fmaxf(v, x) : v + x; }
    __syncthreads();
    if (F.lane == 0) red[F.wave] = v;
    __syncthreads();
    float r = red[0];
    for (int i = 1; i < 8; ++i) r = ismax ? fmaxf(r, red[i]) : r + red[i];
    return r;
}
DI float dot64(const bf16* a, const bf16* b) { float s = 0.f; for (int d = 0; d < 64; ++d) s += bf2f(a[d]) * bf2f(b[d]); return s; }
DI void orc_softmax(Frame& F, LAS float* sc, LAS unsigned char* vf, int n, LAS float* red) {
    float mx = -3e38f;
    for (int k = F.tid; k < n; k += 512) if (vf[k]) mx = fmaxf(mx, sc[k]);
    mx = blk_red(F, mx, true, red);
    float sm = 0.f;
    for (int k = F.tid; k < n; k += 512) { const float p = vf[k] ? exp2f(sc[k] - mx) : 0.f; sc[k] = p; sm += p; }
    sm = blk_red(F, sm, false, red);
    const float inv = 1.f / fmaxf(sm, 1e-30f);
    for (int k = F.tid; k < n; k += 512) sc[k] *= inv;
    __syncthreads();
}
DI void oracle_row(Frame& F, int oi) {
    int row;
    if (oi < 96) { const int tl[24] = {0, 1, 30, 31, 32, 63, 64, 65, 127, 128, 255, 256, 257, 400, 511, 512, 513, 1000, 1023, 1024, 2047, 2500, 3583, 4095};
        int t = 0;
#pragma unroll
        for (int i = 0; i < 24; ++i) t = (oi % 24 == i) ? tl[i] : t;
        row = (oi / 24) * SEQ + t; }
    else { const int k = oi - 96; row = MP + (((k >> 2) * 37) % SBATCH) * 4 + (k & 3); }
    const bool samp = row >= MP;
    const int b = samp ? (row - MP) >> 2 : row >> 12, ti = samp ? (row & 3) : (row & 4095), qpos = samp ? PASTL + ti : ti;
    const int ncmp = samp ? 127 : 255; const size_t pitch = samp ? LS : SEQ, wpitch = samp ? LSW : SEQ, cpitch = samp ? 128 : 256;
    const int wlo = samp ? 1 + ti : (qpos - 511 > 0 ? qpos - 511 : 0), whi = samp ? 512 + ti : qpos;
    LAS float* sc = (LAS float*)F.lds;
    LAS float* s2 = sc + 4096;
    LAS float* psum = s2 + 4096;
    LAS float* imp = psum + 256;
    LAS float* resn = imp + 64;
    LAS float* resd = resn + 512;
    LAS float* red = resd + 512;
    LAS unsigned char* vf = (LAS unsigned char*)(red + 8);
    LAS unsigned char* selb = vf + 4096;
    const bf16* qraw = WSP(bf16, WS_QRAW) + (size_t)row * 512; const bf16* qrot = WSP(bf16, WS_QROT) + (size_t)row * 512;
    const bf16* dq = WSP(bf16, WS_DQ) + (size_t)row * 512; const bf16* iq = WSP(bf16, WS_IQ) + (size_t)row * 256;
    const float* gat = WSP(float, WS_GATES) + (size_t)row * 24; const float* iw = WSP(float, WS_IW) + (size_t)row * 4;
    const int nvr = (qpos - 31) >> 4, nvis = nvr < ncmp - 1 ? nvr : ncmp - 1, cur = qpos >> 6;
    for (int g = 0; g < 2; ++g) {
        const int bg = b * 2 + g;
        const bf16* ck = samp ? WSP(bf16, WS_SCK) + (size_t)bg * 128 * 64 : WSP(bf16, WS_PCK) + (size_t)bg * 256 * 64;
        const bf16* cvt = samp ? WSP(bf16, WS_SCVT) + (size_t)bg * 64 * 128 : WSP(bf16, WS_PCVT) + (size_t)bg * 64 * 256;
        const bf16* sk = samp ? WSP(bf16, WS_SSLCK) + (size_t)bg * LS * 64 : WSP(bf16, WS_PSLCK) + (size_t)bg * SEQ * 64;
        const bf16* svt = samp ? WSP(bf16, WS_SSLCVT) + (size_t)bg * 64 * LS : WSP(bf16, WS_PSLCVT) + (size_t)bg * 64 * SEQ;
        const bf16* wk = samp ? WSP(bf16, WS_SWINK) + (size_t)bg * LSW * 64 : WSP(bf16, WS_PWINK) + (size_t)bg * SEQ * 64;
        const bf16* wvt = samp ? WSP(bf16, WS_SWINVT) + (size_t)bg * 64 * LSW : WSP(bf16, WS_PWINVT) + (size_t)bg * 64 * SEQ;
        __syncthreads();
        if (F.tid < 256) psum[F.tid] = 0.f;
        for (int hl = 0; hl < 4; ++hl) {
            const int h = 4 * g + hl;
            __syncthreads();
            for (int n = F.tid; n < 256; n += 512) { const bool v = n <= nvis; vf[n] = v; sc[n] = v ? dot64(qraw + h * 64, ck + (size_t)n * 64) : 0.f; }
            __syncthreads();
            orc_softmax(F, sc, vf, 256, red);
            if (F.tid < 256) psum[F.tid] += sc[F.tid];
            if (F.tid < 64) { float a = 0.f; for (int n = 0; n <= nvis; ++n) a += sc[n] * bf2f(cvt[(size_t)F.tid * cpitch + permk(n)]); resn[h * 64 + F.tid] = gat[h * 3 + 0] * a; }
        }
        __syncthreads();
        if (F.tid < 64) { const int j = F.tid; float a = 0.f;
            for (int n = 4 * j - 1; n <= 4 * j + 3; ++n) if (n >= 0 && n < ncmp) a += psum[n];
            if (j == 0 || j == cur || j == cur - 1) a = 1e4f;
            if (j > cur) a = -1e30f;
            imp[j] = a; selb[j] = 0; }
        __syncthreads();
        if (F.tid == 0) { for (int k = 0; k < 16; ++k) { int best = -1; float bv = -3e38f; for (int j = 0; j < 64; ++j) if (!selb[j] && imp[j] > bv) { bv = imp[j]; best = j; }
                if (best >= 0) selb[best] = (bv > -5e29f) ? 1 : 2; }
            for (int j = 0; j < 64; ++j) selb[j] = selb[j] == 1 ? 1 : 0; }
        __syncthreads();
        for (int hl = 0; hl < 4; ++hl) {
            const int h = 4 * g + hl;
            __syncthreads();
            for (int k = F.tid; k <= qpos; k += 512) { const bool v = selb[k >> 6] != 0; vf[k] = v; sc[k] = v ? dot64(qrot + h * 64, sk + (size_t)k * 64) : 0.f; }
            __syncthreads();
            orc_softmax(F, sc, vf, qpos + 1, red);
            if (F.tid < 64) { float a = 0.f; for (int k = 0; k <= qpos; ++k) if (vf[k]) a += sc[k] * bf2f(svt[(size_t)F.tid * pitch + permk(k)]); resn[h * 64 + F.tid] += gat[h * 3 + 1] * a; }
            __syncthreads();
            for (int k = wlo + F.tid; k <= whi; k += 512) { vf[k - wlo] = 1; sc[k - wlo] = dot64(qrot + h * 64, wk + (size_t)k * 64); }
            __syncthreads();
            orc_softmax(F, sc, vf, whi - wlo + 1, red);
            if (F.tid < 64) { float a = 0.f; for (int k = wlo; k <= whi; ++k) a += sc[k - wlo] * bf2f(wvt[(size_t)F.tid * wpitch + permk(k)]); resn[h * 64 + F.tid] += gat[h * 3 + 2] * a; }
        }
    }
    __syncthreads();
    const bf16* ik = samp ? WSP(bf16, WS_SIDXK) + (size_t)b * LS * 64 : WSP(bf16, WS_PIDXK) + (size_t)b * SEQ * 64;
    for (int k = F.tid; k <= qpos; k += 512) { float a = 0.f; for (int h = 0; h < 4; ++h) a += fmaxf(dot64(iq + h * 64, ik + (size_t)k * 64), 0.f) * iw[h]; s2[k] = a; }
    __syncthreads();
    for (int k = F.tid; k <= qpos; k += 512) { const float v = s2[k]; int c = 0; for (int j = 0; j <= qpos; ++j) { const float x = s2[j]; c += (x > v || (x == v && j < k)) ? 1 : 0; } vf[k] = c < 256; }
    __syncthreads();
    for (int h = 0; h < 8; ++h) {
        const int bg = b * 2 + (h >> 2);
        const bf16* dk = samp ? WSP(bf16, WS_SDSAK) + (size_t)bg * LS * 64 : WSP(bf16, WS_PDSAK) + (size_t)bg * SEQ * 64;
        const bf16* dvt = samp ? WSP(bf16, WS_SDSAVT) + (size_t)bg * 64 * LS : WSP(bf16, WS_PDSAVT) + (size_t)bg * 64 * SEQ;
        __syncthreads();
        for (int k = F.tid; k <= qpos; k += 512) sc[k] = vf[k] ? dot64(dq + h * 64, dk + (size_t)k * 64) : 0.f;
        __syncthreads();
        orc_softmax(F, sc, vf, qpos + 1, red);
        if (F.tid < 64) { float a = 0.f; for (int k = 0; k <= qpos; ++k) if (vf[k]) a += sc[k] * bf2f(dvt[(size_t)F.tid * pitch + permk(k)]); resd[h * 64 + F.tid] = a; }
    }
    __syncthreads();
    float dn = 0.f, rn = 0.f, dd = 0.f, rd = 0.f;
    { const int e = F.tid;
      const float zn = bf2f(WSP(bf16, WS_ZN)[(size_t)row * 512 + e]), zd = bf2f(WSP(bf16, WS_ZD)[(size_t)row * 512 + e]);
      const float refn = resn[e] * zn, refd = resd[e] * zd;
      const float gotn = bf2f(WSP(bf16, WS_ONZ)[(size_t)row * 1024 + e]), gotd = bf2f(WSP(bf16, WS_ONZ)[(size_t)row * 1024 + 512 + e]);
      dn = (gotn - refn) * (gotn - refn); rn = refn * refn; dd = (gotd - refd) * (gotd - refd); rd = refd * refd; }
    dn = blk_red(F, dn, false, red); rn = blk_red(F, rn, false, red); dd = blk_red(F, dd, false, red); rd = blk_red(F, rd, false, red);
    float dc = 0.f, rc = 0.f;
    {
        const bool cs = oi >= 96; const int cbg = cs ? (oi * 5) % 256 : oi % 8, cn = cs ? (oi * 11) % 127 : (oi * 13) % 255;
        for (int slot = 0; slot < 2; ++slot) {
            const bf16* data = cs ? WSP(bf16, slot ? WS_SCMPV : WS_SCMPK) + (size_t)cbg * LS * 64 + (size_t)cn * 1024 : WSP(bf16, slot ? WS_PCMPV : WS_PCMPK) + (size_t)cbg * SEQ * 64 + (size_t)cn * 1024;
            __syncthreads();
            if (F.tid < 128) { float a = 0.f; for (int k = 0; k < 2048; ++k) a += (bf2f(data[k]) + F.pe[slot * 2048 + k]) * F.w1[((size_t)slot * 2048 + k) * 128 + F.tid]; sc[F.tid] = a / (1.f + expf(-a)); }
            __syncthreads();
            if (F.tid < 64) { float a = 0.f; for (int c = 0; c < 128; ++c) a += sc[c] * F.w2[((size_t)slot * 128 + c) * 64 + F.tid];
                float got;
                if (slot == 0) got = bf2f((cs ? WSP(bf16, WS_SCK) + (size_t)cbg * 128 * 64 : WSP(bf16, WS_PCK) + (size_t)cbg * 256 * 64)[(size_t)cn * 64 + F.tid]);
                else got = bf2f((cs ? WSP(bf16, WS_SCVT) + (size_t)cbg * 64 * 128 : WSP(bf16, WS_PCVT) + (size_t)cbg * 64 * 256)[(size_t)F.tid * (cs ? 128 : 256) + permk(cn)]);
                dc += (got - a) * (got - a); rc += a * a; }
        }
    }
    dc = blk_red(F, dc, false, red); rc = blk_red(F, rc, false, red);
    if (F.tid == 0) { float* o = WSP(float, WS_ORC) + oi * 8; o[0] = dn; o[1] = rn; o[2] = dd; o[3] = rd; o[4] = dc; o[5] = rc; }
    __syncthreads();
}
DI float oracle_value(Frame& F) {
    const float* o = WSP(float, WS_ORC);
    float bad = 0.f, acc = 0.f, mxe = 0.f;
    for (int i = 0; i < ORC_ROWS; ++i) { const int c = (ORACLE_MODE >= 6) ? 4 : (ORACLE_MODE & 1) ? 2 : 0; const float e = sqrtf(o[i * 8 + c] / fmaxf(o[i * 8 + c + 1], 1e-30f));
        bad += e > 0.03f ? 1.f : 0.f; acc += fminf(e, 1.f) * fminf(e, 1.f); mxe = fmaxf(mxe, fminf(e, 1.f)); }
    return (ORACLE_MODE < 2 || ORACLE_MODE == 6) ? bad / ORC_ROWS : (ORACLE_MODE < 4 || ORACLE_MODE == 7) ? sqrtf(acc / ORC_ROWS) : mxe;
}
#endif

#define XB_TMO      128
#define XB_XCNT(j)  (256  + 64 * (j))
#define XB_XSUB(j)  (1280 + 64 * (j))
#define XB_XGEN(j)  (2304 + 64 * (j))
#define XB_TOP      3328
#define XB_TOPGEN   3392
#define XCD_BAR_WORDS 3456
#define XB_SPIN_CAP (1u << 18)
__device__ __forceinline__ unsigned xb_ld(unsigned* p)              { return __hip_atomic_load(p, __ATOMIC_RELAXED, __HIP_MEMORY_SCOPE_AGENT); }
__device__ __forceinline__ unsigned xb_add(unsigned* p, unsigned v) { return __hip_atomic_fetch_add(p, v, __ATOMIC_RELAXED, __HIP_MEMORY_SCOPE_AGENT); }
__device__ __forceinline__ unsigned xb_xcc_id() { return (unsigned)__builtin_amdgcn_s_getreg((3 << 11) | 20) & 0xFu; }
#define XB_SPIN(cond, bar) do { unsigned _sp = 0; while (cond) { __builtin_amdgcn_s_sleep(1); \
    if ((++_sp & 255u) == 0u) { if (xb_ld(&(bar)[XB_TMO])) break; if (_sp > XB_SPIN_CAP) { atomicAdd(&(bar)[XB_TMO], 1u); break; } } } } while (0)
struct XcdBarrier { unsigned* bar; unsigned x; volatile LAS unsigned* st; };
__device__ __forceinline__ XcdBarrier xcd_barrier_post(unsigned* bar, volatile LAS unsigned* st) {
    XcdBarrier b; b.bar = bar; b.x = xb_xcc_id(); b.st = st;
    if (threadIdx.x == 0) (void)xb_add(&bar[XB_XCNT(b.x)], 1u);
    return b;
}
__device__ __forceinline__ void xcd_barrier_complete(unsigned* bar, unsigned x, unsigned& nloc, unsigned& nx) {
    const unsigned G = gridDim.x * gridDim.y * gridDim.z;
    unsigned sum, cnt, mine, sp = 0u;
    for (;;) {
        sum = 0u; cnt = 0u; mine = 0u;
#pragma unroll
        for (unsigned j = 0; j < 16; ++j) { const unsigned c = xb_ld(&bar[XB_XCNT(j)]); sum += c; cnt += (c > 0u) ? 1u : 0u; mine = (j == x) ? c : mine; }
        if (sum == G) break;
        __builtin_amdgcn_s_sleep(1);
        if ((++sp & 255u) == 0u) { if (xb_ld(&bar[XB_TMO])) break; if (sp > XB_SPIN_CAP) { atomicAdd(&bar[XB_TMO], 1u); break; } }
    }
    nloc = mine > 0u ? mine : 1u; nx = cnt > 0u ? cnt : 1u;
}
__device__ __forceinline__ void xcd_barrier(const XcdBarrier& b) {
    asm volatile("s_waitcnt vmcnt(0)" ::: "memory");
    __syncthreads();
    if (threadIdx.x == 0) {
        unsigned* bar = b.bar;
        __builtin_amdgcn_s_waitcnt(0);
        unsigned nloc = b.st[0], nx = b.st[1];
        if (nloc == 0u) { xcd_barrier_complete(bar, b.x, nloc, nx); b.st[0] = nloc; b.st[1] = nx; }
        const unsigned old = xb_add(&bar[XB_XSUB(b.x)], 1u);
        const unsigned gen = old / nloc;
        if (old + 1u == (gen + 1u) * nloc) {
            __builtin_amdgcn_fence(__ATOMIC_RELEASE, "agent");
            asm volatile("s_waitcnt vmcnt(0)" ::: "memory");
            const unsigned og = xb_add(&bar[XB_TOP], 1u);
            const unsigned tg = og / nx;
            if (og + 1u == (tg + 1u) * nx) xb_add(&bar[XB_TOPGEN], 1u);
            else XB_SPIN(xb_ld(&bar[XB_TOPGEN]) == tg, bar);
            __builtin_amdgcn_fence(__ATOMIC_ACQUIRE, "agent");
            xb_add(&bar[XB_XGEN(b.x)], 1u);
            asm volatile("s_waitcnt vmcnt(0)" ::: "memory");
        } else {
            XB_SPIN(xb_ld(&bar[XB_XGEN(b.x)]) == gen, bar);
            __builtin_amdgcn_fence(__ATOMIC_ACQUIRE, "agent");
            asm volatile("s_waitcnt vmcnt(0)" ::: "memory");
        }
    }
    __syncthreads();
}

constexpr int CW_C7 = 32768;
struct EpiOutF {
    static constexpr bool PERM = true, AFTER_DRAIN = true;
    unsigned char* ws; float* out; const float* xp; const float* fing; unsigned* ctl;
    DI void operator()(const pg8::f32x4 (&)[2][2][4][2], const pg8::Unit&, int, int, int, int) const {}
    DI void fused(const pg8::f32x4 (&acc)[2][2][4][2], const pg8::Unit& u, int wr, int wc, int fr, int fq, LAS unsigned char* lds, int wid, int lane) const {
        const int tid = wid * 64 + lane;
        float* part = (float*)(ws + WS_T1);
        f32x4 y[2][2][4][2]; float rs[2][4];
#pragma unroll
        for (int ai = 0; ai < 2; ++ai)
#pragma unroll
            for (int m = 0; m < 4; ++m) {
                const int r = u.pm * 256 + ai * 128 + wr * 64 + m * 16 + fr;
                const float* xr = xp + (size_t)r * 1024;
                const float* gr = (const float*)(ws + WS_MOD) + (size_t)(r >> 12) * 3072 + 2048;
                float sq = 0.f;
#pragma unroll
                for (int bj = 0; bj < 2; ++bj) {
                    const int c0 = u.pn * 256 + bj * 128 + wc * 32 + 8 * fq;
#pragma unroll
                    for (int n = 0; n < 2; ++n) {
                        const f32x4 x4 = *(const f32x4*)(xr + c0 + 4 * n), g4 = *(const f32x4*)(gr + c0 + 4 * n);
                        const f32x4 v = x4 + g4 * acc[ai][bj][m][n];
                        y[ai][bj][m][n] = v; sq += (v[0] * v[0] + v[1] * v[1]) + (v[2] * v[2] + v[3] * v[3]);
                    }
                }
                sq += __shfl_xor(sq, 16); sq += __shfl_xor(sq, 32);
                rs[ai][m] = sq;
            }
        LAS float* red = (LAS float*)lds;
        if (fq == 0) {
#pragma unroll
            for (int ai = 0; ai < 2; ++ai)
#pragma unroll
                for (int m = 0; m < 4; ++m) red[wid * 128 + (ai * 4 + m) * 16 + fr] = rs[ai][m];
        }
        __syncthreads();
        if (tid < 256) {
            const int ai = tid >> 7, wrr = (tid >> 6) & 1, m = (tid >> 4) & 3, f = tid & 15;
            float sacc = 0.f;
#pragma unroll
            for (int c = 0; c < 4; ++c) sacc += red[(wrr * 4 + c) * 128 + (ai * 4 + m) * 16 + f];
            __hip_atomic_store(part + (size_t)u.pn * MP + u.pm * 256 + tid, sacc, __ATOMIC_RELAXED, __HIP_MEMORY_SCOPE_AGENT);
        }
        __syncthreads();
        if (tid == 0) {
            unsigned* cnt = ctl + CW_C7 + 64 * u.pm;
            __builtin_amdgcn_fence(__ATOMIC_RELEASE, "agent");
            (void)xb_add(cnt, 1u);
            unsigned sp = 0u;
            while (xb_ld(cnt) < 4u) { __builtin_amdgcn_s_sleep(1); if (++sp > (1u << 22)) break; }
            __builtin_amdgcn_fence(__ATOMIC_ACQUIRE, "agent");
        }
        __syncthreads();
#pragma unroll
        for (int ai = 0; ai < 2; ++ai)
#pragma unroll
            for (int m = 0; m < 4; ++m) {
                const int lr = ai * 128 + wr * 64 + m * 16 + fr, r = u.pm * 256 + lr;
                float tot = 0.f;
#pragma unroll
                for (int pq = 0; pq < 4; ++pq) tot += __hip_atomic_load(part + (size_t)pq * MP + r, __ATOMIC_RELAXED, __HIP_MEMORY_SCOPE_AGENT);
                const float rstd = 1.f / sqrtf(tot * (1.f / 1024.f) + 1e-6f);
                float* orow = out + O_YP + (size_t)r * 1024;
#pragma unroll
                for (int bj = 0; bj < 2; ++bj) {
                    const int c0 = u.pn * 256 + bj * 128 + wc * 32 + 8 * fq;
#pragma unroll
                    for (int n = 0; n < 2; ++n) { const f32x4 w4 = *(const f32x4*)(fing + c0 + 4 * n); *(f32x4*)(orow + c0 + 4 * n) = y[ai][bj][m][n] * rstd * w4; }
                }
            }
    }
};
constexpr int CW_C8 = 40960;
constexpr size_t WS_PART8 = WS_T1 + 1 * MiB;
template <int K> DI void small_gemm_fin(Frame& F, const bf16* A, const bf16* Bt) {
    const int lane = opq(F.lane), w = F.wave, l31 = lane & 31, hi = lane >> 5;
    LAS float* red = (LAS float*)F.lds;
    float* part8 = WSP(float, WS_PART8);
    for (int t = blockIdx.x; t < 256; t += F.G) {
        const int mt = t >> 5, nt = t & 31, kw = K >> 3, k0 = w * kw;
        const bf16* ap = A + (size_t)(MP + 64 * mt + l31) * K + k0 + 8 * hi;
        const bf16* bp = Bt + (size_t)(32 * nt + l31) * K + k0 + 8 * hi;
        f32x16 a0, a1;
#pragma unroll
        for (int i = 0; i < 16; ++i) { a0[i] = 0.f; a1[i] = 0.f; }
        bf16x8 fb[K / 128], f0[K / 128], f1[K / 128];
#pragma unroll
        for (int s = 0; s < K / 128; ++s) { fb[s] = *(const bf16x8*)(bp + 16 * s); f0[s] = *(const bf16x8*)(ap + 16 * s); f1[s] = *(const bf16x8*)(ap + (size_t)32 * K + 16 * s); }
#pragma unroll
        for (int s = 0; s < K / 128; ++s) { a0 = MFMA32(f0[s], fb[s], a0); a1 = MFMA32(f1[s], fb[s], a1); }
        __syncthreads();
#pragma unroll
        for (int r = 0; r < 16; ++r) { red[(w * 32 + r) * 64 + lane] = a0[r]; red[(w * 32 + 16 + r) * 64 + lane] = a1[r]; }
        __syncthreads();
        const int m2 = w >> 2, q = w & 3;
#pragma unroll
        for (int j = 0; j < 4; ++j) {
            float v = 0.f;
#pragma unroll
            for (int i = 0; i < 8; ++i) v += red[(i * 32 + 16 * m2 + 4 * q + j) * 64 + lane];
            const int lr = 32 * m2 + 8 * q + 4 * hi + j, rs = 64 * mt + lr, c = 32 * nt + l31;
            const float y = F.xs[(size_t)rs * 1024 + c] + WSP(float, WS_MOD)[(size_t)(4 + (rs >> 2)) * 3072 + 2048 + c] * v;
            F.out[O_YS + (size_t)rs * 1024 + c] = y;
            float sq = y * y;
            sq += __shfl_xor(sq, 1); sq += __shfl_xor(sq, 2); sq += __shfl_xor(sq, 4); sq += __shfl_xor(sq, 8); sq += __shfl_xor(sq, 16);
            if (l31 == 0) __hip_atomic_store(part8 + (size_t)(mt * 32 + nt) * 64 + lr, sq, __ATOMIC_RELAXED, __HIP_MEMORY_SCOPE_AGENT);
        }
        __syncthreads();
        if (w * 64 + lane == 0) { __builtin_amdgcn_fence(__ATOMIC_RELEASE, "agent"); (void)xb_add(F.ctl + CW_C8 + 64 * mt, 1u); }
    }
    __syncthreads();
}
DI void p7_decode_norm(Frame& F) {
    const int lane = (int)__builtin_amdgcn_mbcnt_hi(~0u, __builtin_amdgcn_mbcnt_lo(~0u, 0u));
    const int w = F.wave, l31 = lane & 31, hi = lane >> 5, tid = w * 64 + lane;
    LAS float* tot = (LAS float*)F.lds;
    const float* part8 = WSP(float, WS_PART8);
    __syncthreads();
    for (int t = blockIdx.x; t < 256; t += F.G) {
        const int mt = t >> 5, nt = t & 31;
        if (tid == 0) {
            unsigned* cnt = F.ctl + CW_C8 + 64 * mt; unsigned sp = 0u;
            while (xb_ld(cnt) < 32u) { __builtin_amdgcn_s_sleep(1); if (++sp > (1u << 22)) break; }
            __builtin_amdgcn_fence(__ATOMIC_ACQUIRE, "agent");
        }
        __syncthreads();
        { const int row = tid >> 3, ch = tid & 7; float sacc = 0.f;
#pragma unroll
          for (int i = 0; i < 4; ++i) sacc += __hip_atomic_load(part8 + (size_t)(mt * 32 + ch * 4 + i) * 64 + row, __ATOMIC_RELAXED, __HIP_MEMORY_SCOPE_AGENT);
          sacc += __shfl_xor(sacc, 1); sacc += __shfl_xor(sacc, 2); sacc += __shfl_xor(sacc, 4);
          if (ch == 0) tot[row] = 1.f / sqrtf(sacc * (1.f / 1024.f) + 1e-6f); }
        __syncthreads();
        const int m2 = w >> 2, q = w & 3;
#pragma unroll
        for (int j = 0; j < 4; ++j) {
            const int lr = 32 * m2 + 8 * q + 4 * hi + j, c = 32 * nt + l31;
            float* yp = F.out + O_YS + (size_t)(64 * mt + lr) * 1024 + c;
            *yp = *yp * tot[lr] * F.fing[c];
        }
        __syncthreads();
    }
}
constexpr int N_PHASES = 9;
DI int q_next(Frame& F, int qi) {
    __syncthreads();
    if (F.tid == 0) F.MISC[0] = __hip_atomic_fetch_add(F.ctl + CW_Q + 64 * (qi + F.qoff), 1u, __ATOMIC_RELAXED, __HIP_MEMORY_SCOPE_AGENT);
    __syncthreads();
    return __builtin_amdgcn_readfirstlane((int)F.MISC[0]);
}
DI void q_issue(Frame& F, int qi, unsigned& pend) { if (F.tid == 0) pend = __hip_atomic_fetch_add(F.ctl + CW_Q + 64 * (qi + F.qoff), 1u, __ATOMIC_RELAXED, __HIP_MEMORY_SCOPE_AGENT); }
DI int q_take(Frame& F, unsigned pend) { __syncthreads(); if (F.tid == 0) F.MISC[0] = pend; __syncthreads(); return __builtin_amdgcn_readfirstlane((int)F.MISC[0]); }
#define QLOOP_PF(qi, N, CALL) do { unsigned pend_ = 0u; for (int u = q_next(F, (qi)); u < (N); u = q_take(F, pend_)) { q_issue(F, (qi), pend_); CALL; } } while (0)
#define QLOOP(qi, N, CALL) do { for (int u = q_next(F, (qi)); u < (N); u = q_next(F, (qi))) { CALL; } } while (0)
#define QLOOP_LATE(qi, N, CALL) do { F.lq = (qi); for (int u = q_next(F, (qi)); u < (N); u = q_take(F, F.pend)) { CALL; q_late(F); F.lq = ~F.lq; } F.lq = -1; } while (0)
__global__ void __launch_bounds__(NWAVES * 64, 2) fwd(Args args) {
    extern __shared__ __attribute__((aligned(16))) unsigned char lds[];
    Frame F;
    F.lds = (LAS unsigned char*)lds; F.MISC = (volatile LAS unsigned*)(F.lds + MISC_OFF);
    F.tid = threadIdx.x; F.lane = F.tid & 63; F.wave = __builtin_amdgcn_readfirstlane(F.tid >> 6); F.G = gridDim.x;
    F.ws = args.ws; F.out = args.out; F.ctl = (unsigned*)(args.ws + WS_CTL); F.qoff = args.qoff; F.lq = -1; F.pend = 0u;
    F.xp = (const float*)args.in[0]; F.xs = (const float*)args.in[1]; F.cnsa = (const float*)args.in[2]; F.cdsa = (const float*)args.in[3]; F.cidx = (const float*)args.in[4];
    F.swin = (const float*)args.in[5]; F.ptab = (const int*)args.in[6]; F.cp = (const float*)args.in[7]; F.cs = (const float*)args.in[8]; F.normg = (const float*)args.in[9];
    F.wada = (const float*)args.in[10]; F.bada = (const float*)args.in[11]; F.win = (const float*)args.in[12]; F.pe = (const float*)args.in[13]; F.w1 = (const float*)args.in[14];
    F.w2 = (const float*)args.in[15]; F.wupn = (const float*)args.in[16]; F.wupd = (const float*)args.in[17]; F.wout = (const float*)args.in[18]; F.fing = (const float*)args.in[19];
    for (int i = F.tid; i < (LDS_BYTES - MISC_OFF) / 4; i += NWAVES * 64) ((LAS unsigned*)(F.lds + MISC_OFF))[i] = 0u;
    __syncthreads();
    const int lo = args.ph_lo, hi = args.ph_hi;
    const bool one = (hi - lo) > 1;
    XcdBarrier bar; bar.bar = F.ctl + CW_BAR; bar.x = 0; bar.st = nullptr;
    if (one) bar = xcd_barrier_post(F.ctl + CW_BAR, F.MISC + 8);
#ifndef PH_MASK
#define PH_MASK 0x1ff
#endif
#define IN(k) (((PH_MASK >> (k)) & 1) && lo <= (k) && (k) < hi)
#define SEAM(k) do { if (IN(k) && IN((k) + 1)) xcd_barrier(bar); } while (0)

#ifndef PROBE_REP
#define PROBE_REP -1
#endif
#define REP(k, BODY) do { if (IN(k)) { BODY(0) } } while (0)
#ifndef PROBE_P4MASK
#define PROBE_P4MASK 15
#endif
#ifndef PROBE_ABL
#define PROBE_ABL 0
#endif
#define B0(qo) { p0_prologue(F, args.umask); }
#define B1(qo) { p1_adaln(F); }
#define B2(qo) {   \
        { const int nst_ = (int)blockIdx.x >= 172 ? STAG_C : ((blockIdx.x & 1) ? STAG_B : 0);     \
          for (int c_ = 0; c_ < nst_; ++c_) { const int u = q_next(F, 7 + qo); if (u < 4 * SBATCH) win_copy_item(F, u); } } pg8::Gemm g{WSP(bf16, WS_H), WSP(bf16, WS_WINT), MR, NPAD, DM}; pg8::StaticOrder S; S.init(MR, NPAD, F.G, (int)blockIdx.x); \
        { EpiInProj E{F.ws, F.out}; pg8::gemm_phase<EpiInProj, pg8::StaticOrder, true, true>(F.lds, g, S, E); } \
        QLOOP(7 + qo, 4 * SBATCH, win_copy_item(F, u)); }
#define B3(qo) { const int PM3_ = args.umask; const bool strm3_ = (blockIdx.x & 1) == 0 || args.qoff != 0;     \
        if ((PM3_ & 4) && strm3_) QLOOP(2 + qo, SBATCH, (idx1_unit<true, 0>(F, u))); \
        if ((PM3_ & 1) && strm3_) QLOOP(0 + qo, 272, compress_unit(F, u)); \
        if (PM3_ & 2) QLOOP(1 + qo, 2048, (idx1_unit<false, 0>(F, u))); }
#ifndef STAG_N
#define STAG_B 1
#define STAG_C 3
#endif
#ifndef P4_MASK
#define P4_MASK 15
#endif
#define B4(qo) { const int PM_ = args.umask & P4_MASK; const bool strm_ = (blockIdx.x & 1) == 0 || args.qoff != 0;     \
        if ((PM_ & 1) && strm_) QLOOP_LATE(3 + qo, 256, nsa_sample_unit(F, u)); \
        if ((PM_ & 2) && strm_) QLOOP_LATE(4 + qo, 256, dsa_sample_unit(F, u)); \
        if ((F.wave ^ (F.wave >> 2)) & 1) __builtin_amdgcn_s_setprio(2);     \
        if (PM_ & 4) QLOOP_LATE(5 + qo, 512, nsa_unit<false>(F, u)); \
        if (PM_ & 8) QLOOP_LATE(6 + qo, 512, (dsa_unit<0>(F, u))); \
        __builtin_amdgcn_s_setprio(0); }
#define B5(qo) { }
#define B6(qo) { small_gemm2<1024>(F, WSP(bf16, WS_ONZ), WSP(bf16, WS_WUPN), [&](int r, int c, float vn, float vd) { \
            WSP(bf16, WS_M1)[(size_t)r * 1024 + c] = (bf16)(pk2(vn * bf2f(WSP(bf16, WS_MG)[(size_t)r * 2048 + c]) + vd * bf2f(WSP(bf16, WS_MG)[(size_t)r * 2048 + 1024 + c]), 0.f) & 0xffffu); }); \
        pg8::Gemm g{WSP(bf16, WS_ONZ), WSP(bf16, WS_WUPN), MP, DM, 1024}; pg8::StaticOrder S; S.init(MP, DM, F.G, (int)blockIdx.x); EpiUpF E{F.ws}; \
        pg8::gemm_phase<EpiUpF, pg8::StaticOrder, true, true, true>(F.lds, g, S, E); }
#define B7(qo) { small_gemm_fin<1024>(F, WSP(bf16, WS_M1), WSP(bf16, WS_WOUT)); \
        pg8::Gemm g{WSP(bf16, WS_M1), WSP(bf16, WS_WOUT), MP, DM, DM}; pg8::StaticOrder S; S.init(MP, DM, F.G, (int)blockIdx.x); EpiOutF E{F.ws, F.out, F.xp, F.fing, F.ctl}; \
        pg8::gemm_phase<EpiOutF, pg8::StaticOrder, true, true>(F.lds, g, S, E); p7_decode_norm(F); }
#define B8(qo) { p8_final(F); }
    REP(0, B0); SEAM(0);
    REP(1, B1); SEAM(1);
    REP(2, B2); SEAM(2);
    REP(3, B3); SEAM(3);
    REP(4, B4); SEAM(4);
#ifdef ORACLE
    if (IN(4)) { for (int oi = blockIdx.x; oi < ORC_ROWS; oi += F.G) oracle_row(F, oi); xcd_barrier(bar); }
#endif
    REP(5, B5);
    REP(6, B6); SEAM(6);
    REP(7, B7);
#ifdef ORACLE
    if (IN(8)) { xcd_barrier(bar); const float val = oracle_value(F); const float sc = 1.f + 0.02f * (1.f + val);
        for (size_t i = (size_t)blockIdx.x * 512 + F.tid; i < (size_t)MP * 1024; i += (size_t)F.G * 512) F.out[O_YP + i] *= sc; }
#endif
#undef IN
#undef SEAM
}

extern "C" void kernel_launch(void* const* d_in, const int* in_sizes, int n_in, void* d_out, int out_size, void* d_ws, size_t ws_size, hipStream_t stream) {
    static int grid = 0;
    if (grid == 0) {
        if (n_in != 20 || (size_t)out_size != O_END || ws_size < WS_END) { fprintf(stderr, "kernel_launch: unexpected shapes (n_in %d, out %d, ws %zu)\n", n_in, out_size, ws_size); grid = -1; return; }
        int dev = 0, cus = 0, per_cu = 0;
        if (hipGetDevice(&dev) != hipSuccess || hipDeviceGetAttribute(&cus, hipDeviceAttributeMultiprocessorCount, dev) != hipSuccess) { grid = -1; return; }
        if (hipFuncSetAttribute((const void*)fwd, hipFuncAttributeMaxDynamicSharedMemorySize, LDS_BYTES) != hipSuccess) { fprintf(stderr, "kernel_launch: hipFuncSetAttribute failed\n"); grid = -1; return; }
        if (hipOccupancyMaxActiveBlocksPerMultiprocessor(&per_cu, (const void*)fwd, NWAVES * 64, LDS_BYTES) != hipSuccess || per_cu < 1) { fprintf(stderr, "kernel_launch: occupancy query says %d blocks per CU\n", per_cu); }
        (void)hipGetLastError();
        grid = cus;
    }
    if (grid < 0) return;
    (void)hipMemsetAsync((char*)d_ws + WS_CTL, 0, CTL_ZERO_BYTES, stream);
    Args a{};
    for (int i = 0; i < 20; ++i) a.in[i] = d_in[i];
    a.out = (float*)d_out; a.ws = (unsigned char*)d_ws; a.qoff = 0; a.umask = 15; a.pad0 = 0; a.pad1 = 0;
#if MK_N_LAUNCHES == 1
    a.ph_lo = 0; a.ph_hi = N_PHASES;
    hipLaunchKernelGGL(fwd, dim3(grid), dim3(NWAVES * 64), LDS_BYTES, stream, a);
#if PROBE_REP >= 0
    a.ph_lo = PROBE_REP; a.ph_hi = PROBE_REP + 1; a.qoff = 8; a.umask = PROBE_P4MASK;
    hipLaunchKernelGGL(fwd, dim3(grid), dim3(NWAVES * 64), LDS_BYTES, stream, a);
#endif
#else
    for (int p = 0; p < N_PHASES; ++p) { a.ph_lo = p; a.ph_hi = p + 1; hipLaunchKernelGGL(fwd, dim3(grid), dim3(NWAVES * 64), LDS_BYTES, stream, a); }
#endif
}
```
